# Optimizing an MI355X kernel written in HIP

```python
import math
import jax
import jax.numpy as jnp
from jax import lax
import numpy as np

D_MODEL = 2048
BATCH = 2
SEQ = 8192
DEPTH = 4

CTX_LEN = 256
GRID_W = 64
HEAD_DIM = 128
N_MIXERS = 4
GROUP_W = D_MODEL // N_MIXERS
GROUP_HEADS = GROUP_W // HEAD_DIM
N_MOD = 6
EPS = 1e-6

LRU_W = GROUP_W
LRU_BLOCKS = GROUP_HEADS
LRU_BW = LRU_W // LRU_BLOCKS
LRU_CONV = 4
LRU_C = 8.0

MLA_HEADS = GROUP_HEADS
MLA_Q_LORA = 3 * D_MODEL // 16
MLA_KV_LORA = D_MODEL // 8
MLA_NOPE = 128
MLA_ROPE = 64
MLA_V = GROUP_W // MLA_HEADS
MLA_QK = MLA_NOPE + MLA_ROPE
ROPE_BASE = 10000.0
Q_BLOCK = 128

GDN_HEADS = GROUP_HEADS
GDN_DK = 128
GDN_DV = GROUP_W // GDN_HEADS
GDN_CONV = 4
GDN_CHUNK = 64

NA_HEADS = GROUP_HEADS
NA_HD = GROUP_W // NA_HEADS
NA_KH = 8
NA_KW = 16

D_FF = 5 * D_MODEL // 2
FFN_CONV = 3

IN_LAYOUT = (
    ('lru_x', LRU_W), ('lru_gate', LRU_W),
    ('mla_cq', MLA_Q_LORA), ('mla_ckv', MLA_KV_LORA), ('mla_kr', MLA_ROPE),
    ('gdn_q', GDN_HEADS * GDN_DK), ('gdn_k', GDN_HEADS * GDN_DK),
    ('gdn_v', GDN_HEADS * GDN_DV), ('gdn_gate', GDN_HEADS * GDN_DV),
    ('gdn_beta', 2 * GDN_HEADS), ('gdn_alpha', 2 * GDN_HEADS),
    ('na_q', NA_HEADS * NA_HD), ('na_k', NA_HEADS * NA_HD), ('na_v', NA_HEADS * NA_HD),
)
IN_COLS = sum(n for _, n in IN_LAYOUT)

kernel_name = 'hybrid_parallel_group_diffusion_block'


def rms_norm(x, g):
    xf = x.astype(jnp.float32)
    y = xf * lax.rsqrt(jnp.mean(xf * xf, axis=-1, keepdims=True) + EPS)
    return (y * g.astype(jnp.float32)).astype(x.dtype)


def l2_norm(x):
    xf = x.astype(jnp.float32)
    return xf * lax.rsqrt(jnp.sum(xf * xf, axis=-1, keepdims=True) + EPS)


def modulate(x, shift, scale):
    return x * (1.0 + scale) + shift


def dw_conv(x, w, b=None):
    width = w.shape[0]
    left = (width - 1) // 2
    right = width - 1 - left
    T = x.shape[1]
    xp = jnp.pad(x, ((0, 0), (left, right), (0, 0)))
    y = xp[:, 0:T] * w[0]
    for i in range(1, width):
        y = y + xp[:, i:i + T] * w[i]
    if b is not None:
        y = y + b
    return y


def split_in(p):
    out, off = {}, 0
    for name, n in IN_LAYOUT:
        out[name] = p[..., off:off + n]
        off += n
    return out


def axial_rope_tables(n_tokens):
    t = jnp.arange(n_tokens)
    row = (t // GRID_W).astype(jnp.float32)
    col = (t % GRID_W).astype(jnp.float32)
    n_freq = MLA_ROPE // 4
    inv = ROPE_BASE ** (-jnp.arange(n_freq, dtype=jnp.float32) / n_freq)
    ang = jnp.concatenate([row[:, None] * inv, col[:, None] * inv], axis=-1)
    return jnp.cos(ang), jnp.sin(ang)


def apply_rope(x, cos, sin):
    extra = x.ndim - 3
    cos = cos.reshape(cos.shape[:1] + (1,) * extra + cos.shape[1:])
    sin = sin.reshape(sin.shape[:1] + (1,) * extra + sin.shape[1:])
    half = x.shape[-1] // 2
    x1, x2 = x[..., :half], x[..., half:]
    return jnp.concatenate([x1 * cos - x2 * sin, x1 * sin + x2 * cos], axis=-1).astype(x.dtype)


def context_attention(q, k, v, scale):
    s = jnp.einsum('bqhd,bkhd->bhqk', q, k).astype(jnp.float32) * scale
    p = jax.nn.softmax(s, axis=-1).astype(v.dtype)
    o = jnp.einsum('bhqk,bkhd->bqhd', p, v)
    return o.reshape(o.shape[0], o.shape[1], -1)


def latent_block_attention(q, k, v, k_ctx, v_ctx, scale):
    B, T, H, Dq = q.shape
    Dv = v.shape[-1]
    n_blk = T // Q_BLOCK
    q_blocks = jnp.moveaxis(q.reshape(B, n_blk, Q_BLOCK, H, Dq), 1, 0)

    def block(qb):
        s_lat = jnp.einsum('bqhd,bkhd->bhqk', qb, k).astype(jnp.float32) * scale
        s_ctx = jnp.einsum('bqhd,bchd->bhqc', qb, k_ctx).astype(jnp.float32) * scale
        p = jax.nn.softmax(jnp.concatenate([s_lat, s_ctx], axis=-1), axis=-1).astype(v.dtype)
        return (jnp.einsum('bhqk,bkhd->bqhd', p[..., :T], v)
                + jnp.einsum('bhqc,bchd->bqhd', p[..., T:], v_ctx))

    o = lax.map(block, q_blocks)
    return jnp.moveaxis(o, 0, 1).reshape(B, T, H * Dv)


def rglru_coeffs(u, wa, ba, wx, bx, lam):
    B, T, W = u.shape
    ub = u.reshape(B, T, LRU_BLOCKS, LRU_BW)
    r = jax.nn.sigmoid((jnp.einsum('btnd,nde->btne', ub, wa).reshape(B, T, W) + ba).astype(jnp.float32))
    i = jax.nn.sigmoid((jnp.einsum('btnd,nde->btne', ub, wx).reshape(B, T, W) + bx).astype(jnp.float32))
    log_a = -LRU_C * r * jax.nn.softplus(-lam.astype(jnp.float32))
    a = jnp.exp(log_a)
    b = jnp.sqrt(-jnp.expm1(2.0 * log_a)) * i * u.astype(jnp.float32)
    return a, b


def linear_scan(a, b, h0, reverse):
    def combine(lhs, rhs):
        a_l, b_l = lhs
        a_r, b_r = rhs
        return a_l * a_r, a_r * b_l + b_r
    a_cum, b_cum = lax.associative_scan(combine, (a, b), axis=1, reverse=reverse)
    if h0 is None:
        return b_cum
    return a_cum * h0[:, None, :] + b_cum


def mixer_rglru(xc, gc, xl, gl, conv_w, conv_b, wa, ba, wx, bx, lam, want_ctx):
    uc = dw_conv(xc, conv_w, conv_b)
    ul = dw_conv(xl, conv_w, conv_b)
    hc_dirs, hl_dirs = [], []
    for d in range(2):
        rev = d == 1
        a, b = rglru_coeffs(uc, wa[d], ba[d], wx[d], bx[d], lam[d])
        hc = linear_scan(a, b, None, rev)
        hc_last = hc[:, 0] if rev else hc[:, -1]
        a, b = rglru_coeffs(ul, wa[d], ba[d], wx[d], bx[d], lam[d])
        hl_dirs.append(linear_scan(a, b, hc_last, rev))
        hc_dirs.append(hc)
    yl = ((hl_dirs[0] + hl_dirs[1]) * jax.nn.gelu(gl.astype(jnp.float32))).astype(xl.dtype)
    yc = None
    if want_ctx:
        yc = ((hc_dirs[0] + hc_dirs[1]) * jax.nn.gelu(gc.astype(jnp.float32))).astype(xc.dtype)
    return yc, yl


def mla_heads(cq, ckv, kr, qa_g, w_uq, kva_g, w_ukv, qn_g, kn_g, rope):
    B, T, _ = cq.shape
    q = (rms_norm(cq, qa_g) @ w_uq).reshape(B, T, MLA_HEADS, MLA_QK)
    kv = (rms_norm(ckv, kva_g) @ w_ukv).reshape(B, T, MLA_HEADS, MLA_NOPE + MLA_V)
    k_nope, v = kv[..., :MLA_NOPE], kv[..., MLA_NOPE:]
    k_rope = jnp.broadcast_to(kr[:, :, None, :], (B, T, MLA_HEADS, MLA_ROPE))
    k = jnp.concatenate([k_nope, k_rope], axis=-1)
    q = rms_norm(q, qn_g)
    k = rms_norm(k, kn_g)
    if rope is not None:
        cos, sin = rope
        q = jnp.concatenate([q[..., :MLA_NOPE], apply_rope(q[..., MLA_NOPE:], cos, sin)], axis=-1)
        k = jnp.concatenate([k[..., :MLA_NOPE], apply_rope(k[..., MLA_NOPE:], cos, sin)], axis=-1)
    return q, k, v


def mixer_mla(pc, pl, qa_g, w_uq, kva_g, w_ukv, qn_g, kn_g, cos, sin, want_ctx):
    scale = MLA_QK ** -0.5
    qc, kc, vc = mla_heads(pc['mla_cq'], pc['mla_ckv'], pc['mla_kr'], qa_g, w_uq, kva_g, w_ukv, qn_g, kn_g, None)
    ql, kl, vl = mla_heads(pl['mla_cq'], pl['mla_ckv'], pl['mla_kr'], qa_g, w_uq, kva_g, w_ukv, qn_g, kn_g, (cos, sin))
    yl = latent_block_attention(ql, kl, vl, kc, vc, scale)
    yc = context_attention(qc, kc, vc, scale) if want_ctx else None
    return yc, yl


def chunked_gated_delta(q, k, v, g, beta, S0):
    B, T, H, DK = q.shape
    DV = v.shape[-1]
    C = GDN_CHUNK
    N = T // C

    def to_chunks(t):
        return jnp.moveaxis(t.reshape((B, N, C, H) + t.shape[3:]), (1, 3), (0, 2))

    q, k, v, g, beta = (to_chunks(t) for t in (q, k, v, g, beta))
    gc = jnp.cumsum(g, axis=-1)
    tril = jnp.tril(jnp.ones((C, C), dtype=bool))
    strict = jnp.tril(jnp.ones((C, C), dtype=bool), -1)
    diff = gc[..., :, None] - gc[..., None, :]
    decay = jnp.where(tril, jnp.exp(jnp.where(tril, diff, 0.0)), 0.0)
    kb = k * beta[..., None]
    a_strict = jnp.where(strict, jnp.einsum('nbhid,nbhjd->nbhij', kb, k) * decay, 0.0)
    eye = jnp.eye(C, dtype=jnp.float32)
    t_inv = lax.linalg.triangular_solve(eye + a_strict, jnp.broadcast_to(eye, a_strict.shape),
                                        left_side=True, lower=True, unit_diagonal=True)
    u = t_inv @ (v * beta[..., None])
    w = t_inv @ (kb * jnp.exp(gc)[..., None])
    qk = jnp.einsum('nbhid,nbhjd->nbhij', q, k) * decay
    q_dec = q * jnp.exp(gc)[..., None]
    k_dec = k * jnp.exp(gc[..., -1:] - gc)[..., None]
    g_tot = jnp.exp(gc[..., -1])

    def step(S, inp):
        qd, kd, ui, wi, qki, gt = inp
        v_new = ui - jnp.einsum('bhck,bhkv->bhcv', wi, S)
        o = jnp.einsum('bhck,bhkv->bhcv', qd, S) + jnp.einsum('bhij,bhjv->bhiv', qki, v_new)
        S = S * gt[..., None, None] + jnp.einsum('bhck,bhcv->bhkv', kd, v_new)
        return S, o

    S, o = lax.scan(step, S0, (q_dec, k_dec, u, w, qk, g_tot))
    o = jnp.moveaxis(o, (0, 2), (1, 3)).reshape(B, T, H, DV)
    return o, S


def gated_delta(q, k, v, g, beta, S0, reverse):
    if reverse:
        q, k, v, g, beta = (jnp.flip(t, axis=1) for t in (q, k, v, g, beta))
    o, S = chunked_gated_delta(q, k, v, g, beta, S0)
    if reverse:
        o = jnp.flip(o, axis=1)
    return o, S


def gdn_prepare(q, k, v, conv_w):
    B, T, _ = q.shape
    nq = GDN_HEADS * GDN_DK
    qkv = jax.nn.silu(dw_conv(jnp.concatenate([q, k, v], axis=-1), conv_w))
    qh = l2_norm(qkv[..., :nq].reshape(B, T, GDN_HEADS, GDN_DK)) * (GDN_DK ** -0.5)
    kh = l2_norm(qkv[..., nq:2 * nq].reshape(B, T, GDN_HEADS, GDN_DK))
    vh = qkv[..., 2 * nq:].reshape(B, T, GDN_HEADS, GDN_DV).astype(jnp.float32)
    return qh, kh, vh


def gdn_gates(beta_in, alpha_in, a_log, dt_bias, d):
    sl = slice(d * GDN_HEADS, (d + 1) * GDN_HEADS)
    beta = jax.nn.sigmoid(beta_in[..., sl].astype(jnp.float32))
    g = -jnp.exp(a_log[d].astype(jnp.float32)) * jax.nn.softplus(
        alpha_in[..., sl].astype(jnp.float32) + dt_bias[d].astype(jnp.float32))
    return g, beta


def gdn_finish(o, gate, norm_g):
    B, T, _ = gate.shape
    o = rms_norm(o, norm_g) * jax.nn.silu(gate.astype(jnp.float32).reshape(B, T, GDN_HEADS, GDN_DV))
    return o.reshape(B, T, GDN_HEADS * GDN_DV).astype(gate.dtype)


def mixer_gdn(pc, pl, conv_w, a_log, dt_bias, norm_g, want_ctx):
    qc, kc, vc = gdn_prepare(pc['gdn_q'], pc['gdn_k'], pc['gdn_v'], conv_w)
    ql, kl, vl = gdn_prepare(pl['gdn_q'], pl['gdn_k'], pl['gdn_v'], conv_w)
    B = qc.shape[0]
    oc_dirs, ol_dirs = [], []
    for d in range(2):
        rev = d == 1
        g_c, b_c = gdn_gates(pc['gdn_beta'], pc['gdn_alpha'], a_log, dt_bias, d)
        S0 = jnp.zeros((B, GDN_HEADS, GDN_DK, GDN_DV), jnp.float32)
        o_c, S_c = gated_delta(qc, kc, vc, g_c, b_c, S0, rev)
        g_l, b_l = gdn_gates(pl['gdn_beta'], pl['gdn_alpha'], a_log, dt_bias, d)
        o_l, _ = gated_delta(ql, kl, vl, g_l, b_l, S_c, rev)
        oc_dirs.append(o_c)
        ol_dirs.append(o_l)
    yl = gdn_finish(ol_dirs[0] + ol_dirs[1], pl['gdn_gate'], norm_g)
    yc = gdn_finish(oc_dirs[0] + oc_dirs[1], pc['gdn_gate'], norm_g) if want_ctx else None
    return yc, yl


def na_heads(q, k, v, qn_g, kn_g):
    B, T, _ = q.shape
    shp = (B, T, NA_HEADS, NA_HD)
    return rms_norm(q.reshape(shp), qn_g), rms_norm(k.reshape(shp), kn_g), v.reshape(shp)


def mixer_na(pc, pl, qn_g, kn_g, rpb, rows, want_ctx):
    scale = NA_HD ** -0.5
    qc, kc, vc = na_heads(pc['na_q'], pc['na_k'], pc['na_v'], qn_g, kn_g)
    ql, kl, vl = na_heads(pl['na_q'], pl['na_k'], pl['na_v'], qn_g, kn_g)
    B, T = ql.shape[:2]
    kh = min(NA_KH, rows)
    r = jnp.arange(rows)
    row_idx = jnp.clip(r - kh // 2, 0, rows - kh)[:, None] + jnp.arange(kh)[None, :]
    cq = jnp.arange(GRID_W)
    c0 = jnp.clip(cq - NA_KW // 2, 0, GRID_W - NA_KW)
    col_ok = (cq[None, :] >= c0[:, None]) & (cq[None, :] < c0[:, None] + NA_KW)
    dr = row_idx - r[:, None] + (NA_KH - 1)
    dc = jnp.clip(cq[None, :] - cq[:, None] + (NA_KW - 1), 0, 2 * NA_KW - 2)
    bias = rpb[:, dr[:, None, :, None], dc[None, :, None, :]]
    qg = ql.reshape(B, rows, GRID_W, NA_HEADS, NA_HD)
    kg = kl.reshape(B, rows, GRID_W, NA_HEADS, NA_HD)[:, row_idx]
    vg = vl.reshape(B, rows, GRID_W, NA_HEADS, NA_HD)[:, row_idx]
    s_loc = jnp.einsum('brqhd,brkwhd->bhrqkw', qg, kg).astype(jnp.float32) * scale + bias
    s_loc = jnp.where(col_ok[:, None, :], s_loc, -jnp.inf)
    s_ctx = jnp.einsum('brqhd,bchd->bhrqc', qg, kc).astype(jnp.float32) * scale
    n_loc = kh * GRID_W
    s = jnp.concatenate([s_loc.reshape(B, NA_HEADS, rows, GRID_W, n_loc), s_ctx], axis=-1)
    p = jax.nn.softmax(s, axis=-1).astype(vl.dtype)
    p_loc = p[..., :n_loc].reshape(B, NA_HEADS, rows, GRID_W, kh, GRID_W)
    o = (jnp.einsum('bhrqkw,brkwhd->brqhd', p_loc, vg)
         + jnp.einsum('bhrqc,bchd->brqhd', p[..., n_loc:], vc))
    yl = o.reshape(B, T, NA_HEADS * NA_HD)
    yc = context_attention(qc, kc, vc, scale) if want_ctx else None
    return yc, yl


def conv_ffn(h, w_up, conv_w, conv_b, w_down):
    u = dw_conv(h @ w_up, conv_w, conv_b)
    return (u[..., :D_FF] * jax.nn.silu(u[..., D_FF:])) @ w_down


def setup_inputs(seed: int = 0) -> dict:
    key = jax.random.key(seed)
    keys = iter(jax.random.split(key, 40))
    f32 = jnp.float32

    def nrm(shape, std):
        return jax.random.normal(next(keys), shape, f32) * std

    def gain(shape):
        return 1.0 + nrm(shape, 0.02)

    def unif(shape, lo, hi):
        return jax.random.uniform(next(keys), shape, f32, lo, hi)

    L, D = DEPTH, D_MODEL
    lru_a = unif((L, 2, LRU_W), 0.9, 0.999)
    lru_s = lru_a ** (1.0 / LRU_C)
    gdn_dt = jnp.exp(unif((L, 2, GDN_HEADS), math.log(1e-3), math.log(1e-1)))
    return {
        'x': nrm((BATCH, SEQ, D), 1.0),
        'c': nrm((BATCH, D), 1.0),
        'ctx': nrm((BATCH, CTX_LEN, D), 1.0),
        'c_ctx': nrm((D,), 1.0),
        'ada_w': nrm((L, D, N_MOD * D), 0.5 * D ** -0.5),
        'ada_b': nrm((L, N_MOD * D), 0.01),
        'norm_mix_g': gain((L, D)),
        'norm_ffn_g': gain((L, D)),
        'w_in': nrm((L, D, IN_COLS), D ** -0.5),
        'w_out': nrm((L, D, D), D ** -0.5),
        'lru_conv_w': nrm((L, LRU_CONV, LRU_W), LRU_CONV ** -0.5),
        'lru_conv_b': nrm((L, LRU_W), 0.01),
        'lru_wa': nrm((L, 2, LRU_BLOCKS, LRU_BW, LRU_BW), LRU_BW ** -0.5),
        'lru_ba': nrm((L, 2, LRU_W), 0.01),
        'lru_wx': nrm((L, 2, LRU_BLOCKS, LRU_BW, LRU_BW), LRU_BW ** -0.5),
        'lru_bx': nrm((L, 2, LRU_W), 0.01),
        'lru_lam': jnp.log(lru_s) - jnp.log1p(-lru_s),
        'mla_qa_g': gain((L, MLA_Q_LORA)),
        'mla_w_uq': nrm((L, MLA_Q_LORA, MLA_HEADS * MLA_QK), MLA_Q_LORA ** -0.5),
        'mla_kva_g': gain((L, MLA_KV_LORA)),
        'mla_w_ukv': nrm((L, MLA_KV_LORA, MLA_HEADS * (MLA_NOPE + MLA_V)), MLA_KV_LORA ** -0.5),
        'mla_qn_g': gain((L, MLA_QK)),
        'mla_kn_g': gain((L, MLA_QK)),
        'gdn_conv_w': nrm((L, GDN_CONV, GDN_HEADS * (2 * GDN_DK + GDN_DV)), GDN_CONV ** -0.5),
        'gdn_a_log': jnp.log(unif((L, 2, GDN_HEADS), 1.0, 16.0)),
        'gdn_dt_bias': gdn_dt + jnp.log(-jnp.expm1(-gdn_dt)),
        'gdn_norm_g': gain((L, GDN_DV)),
        'na_qn_g': gain((L, NA_HD)),
        'na_kn_g': gain((L, NA_HD)),
        'na_rpb': nrm((L, NA_HEADS, 2 * NA_KH - 1, 2 * NA_KW - 1), 0.05),
        'ffn_w_up': nrm((L, D, 2 * D_FF), D ** -0.5),
        'ffn_conv_w': nrm((L, FFN_CONV, 2 * D_FF), FFN_CONV ** -0.5),
        'ffn_conv_b': nrm((L, 2 * D_FF), 0.01),
        'ffn_w_down': nrm((L, D_FF, D), D_FF ** -0.5),
    }


def reference(x, c, ctx, c_ctx, ada_w, ada_b, norm_mix_g, norm_ffn_g, w_in, w_out,
              lru_conv_w, lru_conv_b, lru_wa, lru_ba, lru_wx, lru_bx, lru_lam,
              mla_qa_g, mla_w_uq, mla_kva_g, mla_w_ukv, mla_qn_g, mla_kn_g,
              gdn_conv_w, gdn_a_log, gdn_dt_bias, gdn_norm_g,
              na_qn_g, na_kn_g, na_rpb,
              ffn_w_up, ffn_conv_w, ffn_conv_b, ffn_w_down):
    T = x.shape[1]
    rows = T // GRID_W
    cos, sin = axial_rope_tables(T)
    silu_c = jax.nn.silu(c)
    silu_cc = jax.nn.silu(c_ctx)
    h_lat, h_ctx = x, ctx
    for l in range(DEPTH):
        want_ctx = l < DEPTH - 1
        mod_l = jnp.split((silu_c @ ada_w[l] + ada_b[l])[:, None, :], N_MOD, axis=-1)
        mod_c = jnp.split((silu_cc @ ada_w[l] + ada_b[l])[None, None, :], N_MOD, axis=-1)

        u_l = modulate(rms_norm(h_lat, norm_mix_g[l]), mod_l[0], mod_l[1])
        u_c = modulate(rms_norm(h_ctx, norm_mix_g[l]), mod_c[0], mod_c[1])
        pl = split_in(u_l @ w_in[l])
        pc = split_in(u_c @ w_in[l])
        ya_c, ya_l = mixer_rglru(pc['lru_x'], pc['lru_gate'], pl['lru_x'], pl['lru_gate'],
                                 lru_conv_w[l], lru_conv_b[l], lru_wa[l], lru_ba[l],
                                 lru_wx[l], lru_bx[l], lru_lam[l], want_ctx)
        yb_c, yb_l = mixer_mla(pc, pl, mla_qa_g[l], mla_w_uq[l], mla_kva_g[l], mla_w_ukv[l],
                               mla_qn_g[l], mla_kn_g[l], cos, sin, want_ctx)
        yc_c, yc_l = mixer_gdn(pc, pl, gdn_conv_w[l], gdn_a_log[l], gdn_dt_bias[l],
                               gdn_norm_g[l], want_ctx)
        yd_c, yd_l = mixer_na(pc, pl, na_qn_g[l], na_kn_g[l], na_rpb[l], rows, want_ctx)
        h_lat = h_lat + mod_l[2] * (jnp.concatenate([ya_l, yb_l, yc_l, yd_l], axis=-1) @ w_out[l])
        if want_ctx:
            h_ctx = h_ctx + mod_c[2] * (jnp.concatenate([ya_c, yb_c, yc_c, yd_c], axis=-1) @ w_out[l])

        v_l = modulate(rms_norm(h_lat, norm_ffn_g[l]), mod_l[3], mod_l[4])
        h_lat = h_lat + mod_l[5] * conv_ffn(v_l, ffn_w_up[l], ffn_conv_w[l], ffn_conv_b[l], ffn_w_down[l])
        if want_ctx:
            v_c = modulate(rms_norm(h_ctx, norm_ffn_g[l]), mod_c[3], mod_c[4])
            h_ctx = h_ctx + mod_c[5] * conv_ffn(v_c, ffn_w_up[l], ffn_conv_w[l], ffn_conv_b[l], ffn_w_down[l])
    return h_lat
```

```cpp
#include <hip/hip_runtime.h>
#include <cstdio>
#include <cstdint>
typedef hipStream_t STREAM_T;
#define LAUNCH(k, grid, block, st, ...) hipLaunchKernelGGL(k, dim3(grid), dim3(block), 0, st, __VA_ARGS__)
#include <math.h>
#include <stdint.h>

#ifdef CFG_SMALL
constexpr int D_MODEL = 256, BATCH = 2, SEQ = 512, DEPTH = 2, CTX_LEN = 64, GRID_W = 32, HEAD_DIM = 16;
#else
constexpr int D_MODEL = 2048, BATCH = 2, SEQ = 8192, DEPTH = 4, CTX_LEN = 256, GRID_W = 64, HEAD_DIM = 128;
#endif
constexpr int GROUP_W = D_MODEL / 4, NH = GROUP_W / HEAD_DIM;
constexpr int HD = HEAD_DIM;
constexpr int N_MOD = 6;
constexpr float EPS = 1e-6f;
constexpr int LRU_W = GROUP_W, LRU_BW = LRU_W / NH;
constexpr float LRU_C = 8.0f;
constexpr int MLA_Q_LORA = 3 * D_MODEL / 16, MLA_KV_LORA = D_MODEL / 8, MLA_NOPE = HD, MLA_ROPE = HD / 2, MLA_V = HD, MLA_QK = MLA_NOPE + MLA_ROPE;
constexpr int GDN_CHUNK = 64;
constexpr int NA_KH = 8, NA_KW = 16;
constexpr int D_FF = 5 * D_MODEL / 2;
constexpr int ROWS = SEQ / GRID_W;
constexpr int C_LRU_X = 0, C_LRU_G = C_LRU_X + LRU_W, C_CQ = C_LRU_G + LRU_W, C_CKV = C_CQ + MLA_Q_LORA, C_KR = C_CKV + MLA_KV_LORA,
              C_GQ = C_KR + MLA_ROPE, C_GK = C_GQ + GROUP_W, C_GV = C_GK + GROUP_W, C_GG = C_GV + GROUP_W, C_GB = C_GG + GROUP_W,
              C_GA = C_GB + 2 * NH, C_NQ = C_GA + 2 * NH, C_NK = C_NQ + GROUP_W, C_NV = C_NK + GROUP_W, IN_COLS = C_NV + GROUP_W;
constexpr int NP = (IN_COLS + 255) / 256 * 256;
constexpr int M_LAT = BATCH * SEQ, M_CTX = BATCH * CTX_LEN, M_ALL = M_LAT + M_CTX;
constexpr int NMODV = N_MOD * D_MODEL;

typedef unsigned short bf16_t;
__host__ __device__ __forceinline__ bf16_t f2bf(float f) { union { float f; unsigned u; } v; v.f = f; unsigned u = v.u; u += 0x7fffu + ((u >> 16) & 1u); return (bf16_t)(u >> 16); }
__host__ __device__ __forceinline__ float bf2f(bf16_t b) { union { float f; unsigned u; } v; v.u = ((unsigned)b) << 16; return v.f; }
__host__ __device__ __forceinline__ float sigmoidf_(float x) { return 1.0f / (1.0f + expf(-x)); }
__host__ __device__ __forceinline__ float siluf_(float x) { return x / (1.0f + expf(-x)); }
__host__ __device__ __forceinline__ float softplusf_(float x) { return fmaxf(x, 0.0f) + log1pf(expf(-fabsf(x))); }
__host__ __device__ __forceinline__ float geluf_(float x) { return 0.5f * x * (1.0f + tanhf(0.7978845608028654f * (x + 0.044715f * x * x * x))); }

struct RowInfo { int b, t, T, base, set; };
__host__ __device__ __forceinline__ RowInfo row_info(int r) {
    RowInfo i;
    if (r < M_LAT) { i.b = r / SEQ; i.t = r % SEQ; i.T = SEQ; i.base = i.b * SEQ; i.set = i.b; }
    else { const int rr = r - M_LAT; i.b = rr / CTX_LEN; i.t = rr % CTX_LEN; i.T = CTX_LEN; i.base = M_LAT + i.b * CTX_LEN; i.set = BATCH; }
    return i;
}

#define GID() ((long)blockIdx.x * blockDim.x + threadIdx.x)

__global__ void k_silu_c(const float* c, const float* c_ctx, float* SC) {
    const long i = GID(); if (i >= (long)(BATCH + 1) * D_MODEL) return;
    const int s = (int)(i / D_MODEL), k = (int)(i % D_MODEL);
    const float v = s < BATCH ? c[s * D_MODEL + k] : c_ctx[k];
    SC[i] = siluf_(v);
}
__global__ void k_ada(const float* SC, const float* ada_w, const float* ada_b, float* MOD) {
    const long i = GID(); if (i >= (long)DEPTH * NMODV) return;
    const int l = (int)(i / NMODV), j = (int)(i % NMODV);
    float acc[BATCH + 1];
    for (int s = 0; s <= BATCH; ++s) acc[s] = 0.f;
    const float* w = ada_w + (size_t)l * D_MODEL * NMODV + j;
    for (int k = 0; k < D_MODEL; ++k) { const float wv = w[(size_t)k * NMODV];
        for (int s = 0; s <= BATCH; ++s) acc[s] += SC[s * D_MODEL + k] * wv; }
    for (int s = 0; s <= BATCH; ++s) MOD[((size_t)l * (BATCH + 1) + s) * NMODV + j] = acc[s] + ada_b[(size_t)l * NMODV + j];
}
__global__ void k_convert_w(const float* W, bf16_t* Wt, int K, int N, int Npad) {
    const long i = GID(); const int K8 = K / 8; if (i >= (long)Npad * K8) return;
    const int k8 = (int)(i / Npad), n = (int)(i % Npad);
    for (int j = 0; j < 8; ++j) { const int k = k8 * 8 + j; Wt[(size_t)n * K + k] = n < N ? f2bf(W[(size_t)k * N + n]) : (bf16_t)0; }
}
__global__ void k_init_h(const float* x, const float* ctx, float* H) {
    const long i = GID(); if (i >= (long)M_ALL * D_MODEL) return;
    H[i] = i < (long)M_LAT * D_MODEL ? x[i] : ctx[i - (long)M_LAT * D_MODEL];
}

__global__ void k_norm_mod(const float* H, const float* g, const float* MODl, int sh_idx, bf16_t* U, int nrows) {
    const long r = GID(); if (r >= nrows) return;
    const RowInfo ri = row_info((int)r);
    const float* h = H + (size_t)r * D_MODEL;
    float ss = 0.f; for (int k = 0; k < D_MODEL; ++k) ss += h[k] * h[k];
    const float rstd = 1.0f / sqrtf(ss / D_MODEL + EPS);
    const float* shift = MODl + (size_t)ri.set * NMODV + (size_t)sh_idx * D_MODEL; const float* scale = shift + D_MODEL;
    for (int k = 0; k < D_MODEL; ++k) U[(size_t)r * D_MODEL + k] = f2bf(h[k] * rstd * g[k] * (1.0f + scale[k]) + shift[k]);
}

__global__ void k_lru_conv(const bf16_t* P, const float* cw, const float* cb, float* LU) {
    const long i = GID(); if (i >= (long)M_ALL * LRU_W) return;
    const int r = (int)(i / LRU_W), ch = (int)(i % LRU_W); const RowInfo ri = row_info(r);
    float acc = cb[ch];
    for (int j = 0; j < 4; ++j) { const int tt = ri.t + j - 1; if (tt >= 0 && tt < ri.T) acc += cw[j * LRU_W + ch] * bf2f(P[(size_t)(ri.base + tt) * NP + C_LRU_X + ch]); }
    LU[i] = acc;
}
__global__ void k_lru_coef(const float* LU, const float* wa, const float* ba, const float* wx, const float* bx, const float* lam, float* LA, float* LB) {
    const long i = GID(); if (i >= (long)2 * M_ALL * LRU_W) return;
    const int d = (int)(i / ((long)M_ALL * LRU_W)); const long rem = i % ((long)M_ALL * LRU_W);
    const int r = (int)(rem / LRU_W), ch = (int)(rem % LRU_W), nb = ch / LRU_BW, e = ch % LRU_BW;
    const float* u = LU + (size_t)r * LRU_W + nb * LRU_BW;
    const float* wap = wa + ((size_t)(d * NH + nb) * LRU_BW) * LRU_BW + e; const float* wxp = wx + ((size_t)(d * NH + nb) * LRU_BW) * LRU_BW + e;
    float za = ba[d * LRU_W + ch], zx = bx[d * LRU_W + ch];
    for (int k = 0; k < LRU_BW; ++k) { const float uv = u[k]; za += uv * wap[(size_t)k * LRU_BW]; zx += uv * wxp[(size_t)k * LRU_BW]; }
    const float rr = sigmoidf_(za), ii = sigmoidf_(zx);
    const float log_a = -LRU_C * rr * softplusf_(-lam[d * LRU_W + ch]);
    LA[i] = expf(log_a);
    LB[i] = sqrtf(-expm1f(2.0f * log_a)) * ii * LU[(size_t)r * LRU_W + ch];
}
__global__ void k_lru_scan(const float* LA, float* LB) {
    const long i = GID(); if (i >= (long)BATCH * 2 * LRU_W) return;
    const int ch = (int)(i % LRU_W), d = (int)((i / LRU_W) % 2), b = (int)(i / (2 * LRU_W));
    float h = 0.f;
    for (int seg = 0; seg < 2; ++seg) {
        const int T = seg == 0 ? CTX_LEN : SEQ, base = seg == 0 ? M_LAT + b * CTX_LEN : b * SEQ;
        for (int s = 0; s < T; ++s) { const int t = d == 0 ? s : T - 1 - s; const size_t idx = ((size_t)d * M_ALL + base + t) * LRU_W + ch;
            h = LA[idx] * h + LB[idx]; LB[idx] = h; }
    }
}
__global__ void k_lru_fin(const float* LB, const bf16_t* P, bf16_t* Y) {
    const long i = GID(); if (i >= (long)M_ALL * LRU_W) return;
    const int r = (int)(i / LRU_W), ch = (int)(i % LRU_W);
    const float h = LB[i] + LB[(size_t)M_ALL * LRU_W + i];
    Y[(size_t)r * D_MODEL + ch] = f2bf(h * geluf_(bf2f(P[(size_t)r * NP + C_LRU_G + ch])));
}

__global__ void k_mla_norm1(const bf16_t* P, const float* qa_g, const float* kva_g, bf16_t* CQN, bf16_t* CKVN) {
    const long r = GID(); if (r >= M_ALL) return;
    const bf16_t* p = P + (size_t)r * NP;
    float ss = 0.f; for (int k = 0; k < MLA_Q_LORA; ++k) { const float v = bf2f(p[C_CQ + k]); ss += v * v; }
    float rstd = 1.0f / sqrtf(ss / MLA_Q_LORA + EPS);
    for (int k = 0; k < MLA_Q_LORA; ++k) CQN[(size_t)r * MLA_Q_LORA + k] = f2bf(bf2f(p[C_CQ + k]) * rstd * qa_g[k]);
    ss = 0.f; for (int k = 0; k < MLA_KV_LORA; ++k) { const float v = bf2f(p[C_CKV + k]); ss += v * v; }
    rstd = 1.0f / sqrtf(ss / MLA_KV_LORA + EPS);
    for (int k = 0; k < MLA_KV_LORA; ++k) CKVN[(size_t)r * MLA_KV_LORA + k] = f2bf(bf2f(p[C_CKV + k]) * rstd * kva_g[k]);
}
__host__ __device__ __forceinline__ void rope_angle(int t, int i, float& cs, float& sn) {
    constexpr int NF = MLA_ROPE / 4;
    const int j = i < NF ? i : i - NF; const float pos = i < NF ? (float)(t / GRID_W) : (float)(t % GRID_W);
    const float inv = powf(10000.0f, -(float)j / (float)NF); const float ang = pos * inv; cs = cosf(ang); sn = sinf(ang);
}
__global__ void k_mla_qkv(const float* QR, const float* KVR, const bf16_t* P, const float* qn_g, const float* kn_g, bf16_t* QM, bf16_t* KM, bf16_t* VM) {
    const long i = GID(); if (i >= (long)M_ALL * NH) return;
    const int r = (int)(i / NH), h = (int)(i % NH); const RowInfo ri = row_info(r); const bool lat = r < M_LAT;
    constexpr int HR = MLA_ROPE / 2;
    for (int which = 0; which < 2; ++which) {
        const float* g = which == 0 ? qn_g : kn_g; bf16_t* O = (which == 0 ? QM : KM) + ((size_t)r * NH + h) * MLA_QK;
        const float* src = which == 0 ? QR + (size_t)r * (NH * MLA_QK) + h * MLA_QK : KVR + (size_t)r * (NH * (MLA_NOPE + MLA_V)) + h * (MLA_NOPE + MLA_V);
        const bf16_t* kr = P + (size_t)r * NP + C_KR;
        float ss = 0.f;
        for (int dd = 0; dd < MLA_QK; ++dd) { const float v = (which == 0 || dd < MLA_NOPE) ? src[dd] : bf2f(kr[dd - MLA_NOPE]); ss += v * v; }
        const float rstd = 1.0f / sqrtf(ss / MLA_QK + EPS);
        for (int dd = 0; dd < MLA_NOPE; ++dd) O[dd] = f2bf(src[dd] * rstd * g[dd]);
        for (int p2 = 0; p2 < HR; ++p2) {
            const int d1 = MLA_NOPE + p2, d2 = MLA_NOPE + HR + p2;
            float x1 = (which == 0 ? src[d1] : bf2f(kr[p2])) * rstd * g[d1], x2 = (which == 0 ? src[d2] : bf2f(kr[HR + p2])) * rstd * g[d2];
            if (lat) { float cs, sn; rope_angle(ri.t, p2, cs, sn); const float y1 = x1 * cs - x2 * sn, y2 = x1 * sn + x2 * cs; x1 = y1; x2 = y2; }
            O[d1] = f2bf(x1); O[d2] = f2bf(x2);
        }
    }
    const float* vs = KVR + (size_t)r * (NH * (MLA_NOPE + MLA_V)) + h * (MLA_NOPE + MLA_V) + MLA_NOPE;
    for (int dd = 0; dd < MLA_V; ++dd) VM[((size_t)r * NH + h) * MLA_V + dd] = f2bf(vs[dd]);
}
__host__ __device__ __forceinline__ float bflo(unsigned w) { union { float f; unsigned u; } v; v.u = w << 16; return v.f; }
__host__ __device__ __forceinline__ float bfhi(unsigned w) { union { float f; unsigned u; } v; v.u = w & 0xffff0000u; return v.f; }
template <int DQ, int DV>
__global__ void __launch_bounds__(256) k_attn_dense(const bf16_t* Q, const bf16_t* K, const bf16_t* V, int ldq, int ldk, int ldv, float scale, bf16_t* Y, int ycol0, int seg) {
    const int Tq = seg == 0 ? SEQ : CTX_LEN; const int nqb = (Tq + 127) / 128;
    const int blk = blockIdx.x, qb = blk % nqb, h = (blk / nqb) % NH, b = blk / (nqb * NH);
    const int ql = threadIdx.x >> 1, half = threadIdx.x & 1; const int tq = qb * 128 + ql; if (tq >= Tq) return;
    const int qrow = seg == 0 ? b * SEQ + tq : M_LAT + b * CTX_LEN + tq;
    constexpr int DH = DV / 2;
    unsigned q[DQ / 2]; { const unsigned* qp = (const unsigned*)(Q + (size_t)qrow * ldq + h * DQ); for (int d = 0; d < DQ / 2; ++d) q[d] = qp[d]; }
    float o[DH]; for (int d = 0; d < DH; ++d) o[d] = 0.f;
    float m = -INFINITY, l = 0.f;
    for (int ks = (seg == 0 ? 0 : 1); ks < 2; ++ks) {
        const int Tk = ks == 0 ? SEQ : CTX_LEN, kbase = ks == 0 ? b * SEQ : M_LAT + b * CTX_LEN;
        for (int j = 0; j < Tk; ++j) {
            const unsigned* kp = (const unsigned*)(K + (size_t)(kbase + j) * ldk + h * DQ); float s = 0.f;
            for (int d = 0; d < DQ / 2; ++d) { const unsigned kw = kp[d]; s += bflo(q[d]) * bflo(kw) + bfhi(q[d]) * bfhi(kw); }
            s *= scale;
            const float mn = fmaxf(m, s), corr = expf(m - mn), p = expf(s - mn);
            l = l * corr + p; const unsigned* vp = (const unsigned*)(V + (size_t)(kbase + j) * ldv + h * DV + half * DH);
            for (int d = 0; d < DH / 2; ++d) { const unsigned vw = vp[d]; o[2 * d] = o[2 * d] * corr + p * bflo(vw); o[2 * d + 1] = o[2 * d + 1] * corr + p * bfhi(vw); }
            m = mn;
        }
    }
    const float il = 1.0f / l;
    for (int d = 0; d < DH; ++d) Y[(size_t)qrow * D_MODEL + ycol0 + h * DV + half * DH + d] = f2bf(o[d] * il);
}

__global__ void k_gdn_conv(const bf16_t* P, const float* cw, float* GC) {
    const long i = GID(); if (i >= (long)M_ALL * 3 * GROUP_W) return;
    const int r = (int)(i / (3 * GROUP_W)), c = (int)(i % (3 * GROUP_W)); const RowInfo ri = row_info(r);
    float acc = 0.f;
    for (int j = 0; j < 4; ++j) { const int tt = ri.t + j - 1; if (tt >= 0 && tt < ri.T) acc += cw[j * 3 * GROUP_W + c] * bf2f(P[(size_t)(ri.base + tt) * NP + C_GQ + c]); }
    GC[i] = siluf_(acc);
}
__global__ void k_gdn_norm(float* GC) {
    const long i = GID(); if (i >= (long)M_ALL * NH) return;
    const int r = (int)(i / NH), h = (int)(i % NH);
    for (int which = 0; which < 2; ++which) { float* p = GC + (size_t)r * 3 * GROUP_W + which * GROUP_W + h * HD;
        float ss = 0.f; for (int d = 0; d < HD; ++d) ss += p[d] * p[d];
        const float sc = (1.0f / sqrtf(ss + EPS)) * (which == 0 ? 1.0f / sqrtf((float)HD) : 1.0f);
        for (int d = 0; d < HD; ++d) p[d] *= sc; }
}
__global__ void k_gdn_gates(const bf16_t* P, const float* a_log, const float* dt_bias, float* GG, float* GBt) {
    const long i = GID(); if (i >= (long)2 * M_ALL * NH) return;
    const int d = (int)(i / ((long)M_ALL * NH)); const long rem = i % ((long)M_ALL * NH); const int r = (int)(rem / NH), h = (int)(rem % NH);
    GBt[i] = sigmoidf_(bf2f(P[(size_t)r * NP + C_GB + d * NH + h]));
    GG[i] = -expf(a_log[d * NH + h]) * softplusf_(bf2f(P[(size_t)r * NP + C_GA + d * NH + h]) + dt_bias[d * NH + h]);
}
__global__ void __launch_bounds__(HD) k_gdn_seq(const float* GC, const float* GG, const float* GBt, float* GO) {
    const int blk = blockIdx.x, d = blk % 2, h = (blk / 2) % NH, b = blk / (2 * NH), vc = threadIdx.x;
    float S[HD]; for (int k = 0; k < HD; ++k) S[k] = 0.f;
    for (int seg = 0; seg < 2; ++seg) {
        const int T = seg == 0 ? CTX_LEN : SEQ, base = seg == 0 ? M_LAT + b * CTX_LEN : b * SEQ;
        for (int s = 0; s < T; ++s) { const int t = d == 0 ? s : T - 1 - s, r = base + t;
            const float* qp = GC + (size_t)r * 3 * GROUP_W + h * HD; const float* kp = qp + GROUP_W; const float v = qp[2 * GROUP_W + vc];
            const float g = GG[((size_t)d * M_ALL + r) * NH + h], beta = GBt[((size_t)d * M_ALL + r) * NH + h];
            const float eg = expf(g); float kS = 0.f;
            for (int k = 0; k < HD; ++k) { S[k] *= eg; kS += kp[k] * S[k]; }
            const float vn = beta * (v - kS); float o = 0.f;
            for (int k = 0; k < HD; ++k) { S[k] += kp[k] * vn; o += qp[k] * S[k]; }
            GO[((size_t)d * M_ALL + r) * GROUP_W + h * HD + vc] = o; }
    }
}
__global__ void k_gdn_fin(const float* GO, const bf16_t* P, const float* norm_g, bf16_t* Y) {
    const long i = GID(); if (i >= (long)M_ALL * NH) return;
    const int r = (int)(i / NH), h = (int)(i % NH);
    const float* o0 = GO + (size_t)r * GROUP_W + h * HD; const float* o1 = o0 + (size_t)M_ALL * GROUP_W;
    float ss = 0.f; for (int v = 0; v < HD; ++v) { const float o = o0[v] + o1[v]; ss += o * o; }
    const float rstd = 1.0f / sqrtf(ss / HD + EPS);
    for (int v = 0; v < HD; ++v) Y[(size_t)r * D_MODEL + 2 * GROUP_W + h * HD + v] = f2bf((o0[v] + o1[v]) * rstd * norm_g[v] * siluf_(bf2f(P[(size_t)r * NP + C_GG + h * HD + v])));
}

__global__ void k_na_norm(const bf16_t* P, const float* qn_g, const float* kn_g, bf16_t* NQ, bf16_t* NK) {
    const long i = GID(); if (i >= (long)M_ALL * NH) return;
    const int r = (int)(i / NH), h = (int)(i % NH);
    for (int which = 0; which < 2; ++which) { const bf16_t* p = P + (size_t)r * NP + (which == 0 ? C_NQ : C_NK) + h * HD; const float* g = which == 0 ? qn_g : kn_g;
        bf16_t* O = (which == 0 ? NQ : NK) + (size_t)r * GROUP_W + h * HD;
        float ss = 0.f; for (int d = 0; d < HD; ++d) { const float v = bf2f(p[d]); ss += v * v; }
        const float rstd = 1.0f / sqrtf(ss / HD + EPS);
        for (int d = 0; d < HD; ++d) O[d] = f2bf(bf2f(p[d]) * rstd * g[d]); }
}
__global__ void __launch_bounds__(256) k_na_attn(const bf16_t* NQ, const bf16_t* NK, const bf16_t* P, const float* rpb, bf16_t* Y) {
    const int nqb = SEQ / 128; const int blk = blockIdx.x, qb = blk % nqb, h = (blk / nqb) % NH, b = blk / (nqb * NH);
    const int ql = threadIdx.x >> 1, half = threadIdx.x & 1, tq = qb * 128 + ql, qrow = b * SEQ + tq;
    constexpr int DH = HD / 2; const float scale = 1.0f / sqrtf((float)HD);
    unsigned q[HD / 2]; { const unsigned* qp = (const unsigned*)(NQ + (size_t)qrow * GROUP_W + h * HD); for (int d = 0; d < HD / 2; ++d) q[d] = qp[d]; }
    float o[DH]; for (int d = 0; d < DH; ++d) o[d] = 0.f;
    float m = -INFINITY, l = 0.f;
    const int r = tq / GRID_W, c = tq % GRID_W; constexpr int kh = NA_KH < ROWS ? NA_KH : ROWS;
    int r0 = r - kh / 2; r0 = r0 < 0 ? 0 : (r0 > ROWS - kh ? ROWS - kh : r0);
    int c0 = c - NA_KW / 2; c0 = c0 < 0 ? 0 : (c0 > GRID_W - NA_KW ? GRID_W - NA_KW : c0);
    const int nloc = kh * NA_KW;
    for (int j = 0; j < nloc + CTX_LEN; ++j) {
        int krow; float bias = 0.f;
        if (j < nloc) { const int rr = r0 + j / NA_KW, cc = c0 + j % NA_KW; krow = b * SEQ + rr * GRID_W + cc;
            const int dr = rr - r + (NA_KH - 1); int dc = cc - c + (NA_KW - 1); dc = dc < 0 ? 0 : (dc > 2 * NA_KW - 2 ? 2 * NA_KW - 2 : dc);
            bias = rpb[((size_t)h * (2 * NA_KH - 1) + dr) * (2 * NA_KW - 1) + dc]; }
        else krow = M_LAT + b * CTX_LEN + (j - nloc);
        const unsigned* kp = (const unsigned*)(NK + (size_t)krow * GROUP_W + h * HD); float s = 0.f;
        for (int d = 0; d < HD / 2; ++d) { const unsigned kw = kp[d]; s += bflo(q[d]) * bflo(kw) + bfhi(q[d]) * bfhi(kw); }
        s = s * scale + bias;
        const float mn = fmaxf(m, s), corr = expf(m - mn), p = expf(s - mn);
        l = l * corr + p; const unsigned* vp = (const unsigned*)(P + (size_t)krow * NP + C_NV + h * HD + half * DH);
        for (int d = 0; d < DH / 2; ++d) { const unsigned vw = vp[d]; o[2 * d] = o[2 * d] * corr + p * bflo(vw); o[2 * d + 1] = o[2 * d + 1] * corr + p * bfhi(vw); }
        m = mn; }
    const float il = 1.0f / l;
    for (int d = 0; d < DH; ++d) Y[(size_t)qrow * D_MODEL + 3 * GROUP_W + h * HD + half * DH + d] = f2bf(o[d] * il);
}

__global__ void k_ffn_act(const bf16_t* UP, const float* cw, const float* cb, bf16_t* ACT, int nrows) {
    const long i = GID(); if (i >= (long)nrows * D_FF) return;
    const int r = (int)(i / D_FF), j = (int)(i % D_FF); const RowInfo ri = row_info(r);
    float a = cb[j], g = cb[D_FF + j];
    for (int k = 0; k < 3; ++k) { const int tt = ri.t + k - 1; if (tt >= 0 && tt < ri.T) { const bf16_t* u = UP + (size_t)(ri.base + tt) * (2 * D_FF);
        a += cw[k * 2 * D_FF + j] * bf2f(u[j]); g += cw[k * 2 * D_FF + D_FF + j] * bf2f(u[D_FF + j]); } }
    ACT[i] = f2bf(a * siluf_(g));
}

namespace pg8 {
#define PG8_LAS __attribute__((address_space(3)))
typedef unsigned short bf16_t;
typedef short bf16x8 __attribute__((ext_vector_type(8)));
typedef float f32x4 __attribute__((ext_vector_type(4)));
typedef unsigned u32x4 __attribute__((ext_vector_type(4)));
constexpr int BM = 256, BK = 64, HALF = 128, HTB = HALF * BK * 2  , STAGE_BYTES = 8 * HTB, NXCD = 8, WGM = 8;

__host__ __device__ __forceinline__ int lds_byte(int r, int c) { const int st = (r >> 4) * 2 + (c >> 5), rr = r & 15, cc = c & 31, ob = rr * 64 + cc * 2; return st * 1024 + (ob ^ (((ob >> 9) & 1) << 5)); }
__host__ __device__ __forceinline__ void stage_rc(int b, int& R, int& C) { const int st = b / 1024, sb = b % 1024, swz = sb ^ (((sb >> 9) & 1) << 5); R = (st >> 1) * 16 + swz / 64; C = (st & 1) * 32 + (swz % 64) / 2; }
__host__ __device__ __forceinline__ int perm32(int rho) { const int n = rho >> 4, i = rho & 15; return 8 * (i >> 2) + 4 * n + (i & 3); }

struct Unit { int pm, pn; };
struct Gemm { const bf16_t* A; const bf16_t* Bt; int M, N, K; };

struct StaticOrder {
    int nM, nN, nwg, G, c;
    __host__ __device__ void init(int M, int N, int G_, int c_) { nM = M / BM; nN = N / BM; nwg = nM * nN; G = G_; c = c_; }
    __host__ __device__ bool next(int i, Unit& u) const {
        const long L = (long)i * G + c; if (L >= nwg) return false;
        int wgid = (int)L; { const int q = nwg / NXCD, r = nwg % NXCD, xcd = wgid % NXCD, off = wgid / NXCD; wgid = (xcd < r ? xcd * (q + 1) : r * (q + 1) + (xcd - r) * q) + off; }
        const int nig = WGM * nN, gid = wgid / nig, fm = gid * WGM, gsz = (nM - fm) < WGM ? (nM - fm) : WGM;
        u.pm = fm + ((wgid % nig) % gsz); u.pn = (wgid % nig) / gsz; return true;
    }
    __device__ __forceinline__ void a_ready(const Unit&) const {}
    __device__ __forceinline__ void done(const Unit&) const {}
};
__device__ __forceinline__ unsigned cvt_pk_bf16(float lo, float hi) { unsigned r; asm volatile("v_cvt_pk_bf16_f32 %0, %1, %2" : "=v"(r) : "v"(lo), "v"(hi)); return r; }
typedef float f32x2 __attribute__((ext_vector_type(2)));
__device__ __forceinline__ f32x2 gelu_pk(f32x2 v) {
    const f32x2 av = __builtin_elementwise_abs(v), d = av * 0.2316418882f + 1.0f;
    f32x2 t; t.x = __builtin_amdgcn_rcpf(d.x); t.y = __builtin_amdgcn_rcpf(d.y);
    f32x2 q = t * 0.5307027145f + (-0.7265760135f); q = q * t + 0.7107068705f; q = q * t + (-0.142248368f); q = q * t + 0.127414796f; q = q * t;
    const f32x2 s = (v * v) * (-0.72134752044f);
    f32x2 e; e.x = __builtin_amdgcn_exp2f(s.x); e.y = __builtin_amdgcn_exp2f(s.y);
    const f32x2 m = v * (q * e), r = v - m;
    f32x2 o; o.x = v.x < 0.f ? m.x : r.x; o.y = v.y < 0.f ? m.y : r.y; return o;
}

template <int ACT  > struct EpiBf16 {
    static constexpr bool PERM = true, AFTER_DRAIN = false; static_assert(ACT == 0 || ACT == 1, "EpiBf16: ACT is 0 (none) or 1 (gelu_pk)");
    bf16_t* O; int ldc; const float* bias; int split_cols; size_t split_stride; float scale0;
    __device__ __forceinline__ void operator()(const f32x4 (&acc)[2][2][4][2], const Unit& u, int wr, int wc, int fr, int fq) const {
        const int row0 = u.pm * BM + wr * 64 + fr; int colt = u.pn * BM; bf16_t* base = O;
        float sc = 1.f; if (split_cols) { const int t = colt / split_cols; base += (size_t)t * split_stride; colt -= t * split_cols; if (t == 0) sc = scale0; }
        const int col0 = colt + wc * 32 + 8 * fq, bcol0 = u.pn * BM + wc * 32 + 8 * fq;
        f32x4 bv[2][2];
#pragma unroll
        for (int bj = 0; bj < 2; ++bj)
#pragma unroll
            for (int n = 0; n < 2; ++n) bv[bj][n] = bias ? *(const f32x4*)(bias + bcol0 + bj * HALF + 4 * n) : (f32x4){0.f, 0.f, 0.f, 0.f};
#pragma unroll
        for (int ai = 0; ai < 2; ++ai)
#pragma unroll
            for (int m = 0; m < 4; ++m) { bf16_t* rowp = base + (size_t)(row0 + ai * HALF + m * 16) * ldc + col0;
#pragma unroll
                for (int bj = 0; bj < 2; ++bj) { f32x4 v0 = acc[ai][bj][m][0] + bv[bj][0], v1 = acc[ai][bj][m][1] + bv[bj][1];
                    if (ACT == 1) { f32x2 a = gelu_pk((f32x2){v0[0], v0[1]}), b = gelu_pk((f32x2){v0[2], v0[3]}), c = gelu_pk((f32x2){v1[0], v1[1]}), d = gelu_pk((f32x2){v1[2], v1[3]});
                        v0 = (f32x4){a.x, a.y, b.x, b.y}; v1 = (f32x4){c.x, c.y, d.x, d.y}; }
                    v0 = v0 * sc; v1 = v1 * sc; u32x4 w; w.x = cvt_pk_bf16(v0[0], v0[1]); w.y = cvt_pk_bf16(v0[2], v0[3]); w.z = cvt_pk_bf16(v1[0], v1[1]); w.w = cvt_pk_bf16(v1[2], v1[3]);
                    *(u32x4*)(rowp + bj * HALF) = w; } }
    }
};

struct EpiF32 {
    static constexpr bool PERM = false, AFTER_DRAIN = false;
    float* C; int ldc;
    __device__ __forceinline__ void operator()(const f32x4 (&acc)[2][2][4][2], const Unit& u, int wr, int wc, int fr, int fq) const {
        const int row0 = u.pm * BM + wr * 64 + fr, col0 = u.pn * BM + wc * 32 + 4 * fq;
#pragma unroll
        for (int ai = 0; ai < 2; ++ai)
#pragma unroll
            for (int m = 0; m < 4; ++m) { float* rowp = C + (size_t)(row0 + ai * HALF + m * 16) * ldc + col0;
#pragma unroll
                for (int bj = 0; bj < 2; ++bj)
#pragma unroll
                    for (int n = 0; n < 2; ++n) *(f32x4*)(rowp + bj * HALF + n * 16) = acc[ai][bj][m][n]; }
    }
};
struct EpiGateRes {
    static constexpr bool PERM = false, AFTER_DRAIN = false;
    const float* base; float* out; int ldc; const float* gate; int set_stride; int rows_per_set; int nsets_lat; int lat_rows;
    __device__ __forceinline__ void operator()(const f32x4 (&acc)[2][2][4][2], const Unit& u, int wr, int wc, int fr, int fq) const {
        const int row0 = u.pm * BM + wr * 64 + fr, col0 = u.pn * BM + wc * 32 + 4 * fq;
        const int set = (u.pm * BM >= lat_rows) ? nsets_lat : (u.pm * BM) / rows_per_set;
        const float* gp = gate + (size_t)set * set_stride + col0;
        f32x4 gv[2][2];
#pragma unroll
        for (int bj = 0; bj < 2; ++bj)
#pragma unroll
            for (int n = 0; n < 2; ++n) gv[bj][n] = *(const f32x4*)(gp + bj * HALF + n * 16);
#pragma unroll
        for (int ai = 0; ai < 2; ++ai)
#pragma unroll
            for (int m = 0; m < 4; ++m) { const size_t off = (size_t)(row0 + ai * HALF + m * 16) * ldc + col0;
#pragma unroll
                for (int bj = 0; bj < 2; ++bj)
#pragma unroll
                    for (int n = 0; n < 2; ++n) { const f32x4 b = *(const f32x4*)(base + off + bj * HALF + n * 16); *(f32x4*)(out + off + bj * HALF + n * 16) = b + gv[bj][n] * acc[ai][bj][m][n]; } }
    }
};

template <class Epi, class Sched, bool ALIGN_EPI = false, bool SP2 = false>
__device__ __forceinline__ void gemm_phase(PG8_LAS unsigned char* lds, const Gemm g, const Sched& S, const Epi& E) {
    const int tid = threadIdx.x, wid = __builtin_amdgcn_readfirstlane(tid >> 6), lane = tid & 63, wr = wid >> 2, wc = wid & 3, fr = lane & 15, fq = lane >> 4;
    const int K = g.K, nt = K / BK;
    unsigned voffA[2], voffB[2];
#pragma unroll
    for (int i = 0; i < 2; ++i) { int R, C; stage_rc(tid * 16 + i * 8192, R, C); const int Rb = Epi::PERM ? ((R & ~31) + perm32(R & 31)) : R;
        voffA[i] = (unsigned)(R * K + C) * 2u; voffB[i] = (unsigned)(Rb * K + C) * 2u; }
    const size_t kstep = (size_t)(BK * 2);
    const size_t hstep = (size_t)HALF * K * 2;
    const size_t tstep = 2 * hstep;
    const unsigned ldsw = (unsigned)wid * 1024u;
    const int aoff = lds_byte(wr * 64 + fr, fq * 8), boff = lds_byte(wc * 32 + fr, fq * 8);
#define PG8_SA(b, h) (((b) * 2 + (h)) * HTB)
#define PG8_SB(b, h) ((4 + (b) * 2 + (h)) * HTB)
#define PG8_STAGE(bufoff, gbase, voff) do { _Pragma("unroll") for (int _i = 0; _i < 2; ++_i) \
        __builtin_amdgcn_global_load_lds((const unsigned*)((const char*)(gbase) + (voff)[_i]), (PG8_LAS unsigned*)(lds + (bufoff) + ldsw + _i * 8192), 16, 0, 0); } while (0)
#define PG8_LDA(dst, b, h) do { _Pragma("unroll") for (int m = 0; m < 4; ++m) _Pragma("unroll") for (int k = 0; k < 2; ++k) dst[m][k] = *(const PG8_LAS bf16x8*)(lds + PG8_SA(b, h) + aoff + m * 2048 + k * 1024); } while (0)
#define PG8_LDB(dst, b, h) do { _Pragma("unroll") for (int n = 0; n < 2; ++n) _Pragma("unroll") for (int k = 0; k < 2; ++k) dst[n][k] = *(const PG8_LAS bf16x8*)(lds + PG8_SB(b, h) + boff + n * 2048 + k * 1024); } while (0)
#define PG8_MMA(ai, bj, At, Bt) do { __builtin_amdgcn_s_setprio(1); _Pragma("unroll") for (int m = 0; m < 4; ++m) _Pragma("unroll") for (int n = 0; n < 2; ++n) _Pragma("unroll") for (int k = 0; k < 2; ++k) \
        acc[ai][bj][m][n] = __builtin_amdgcn_mfma_f32_16x16x32_bf16(Bt[n][k], At[m][k], acc[ai][bj][m][n], 0, 0, 0); __builtin_amdgcn_s_setprio(0); } while (0)
#define PG8_WAIT_V(n) asm volatile("s_waitcnt vmcnt(" #n ")" ::: "memory")
#define PG8_WAIT_L(n) asm volatile("s_waitcnt lgkmcnt(" #n ")" ::: "memory")
#define PG8_BAR __builtin_amdgcn_s_barrier()
#define PG8_SCHED __builtin_amdgcn_sched_barrier(0)
    Unit cur, nxt; int ui = 0;
    if (!S.next(0, cur)) return;
    f32x4 acc[2][2][4][2];
#pragma unroll
    for (int a = 0; a < 2; ++a)
#pragma unroll
        for (int b = 0; b < 2; ++b)
#pragma unroll
            for (int m = 0; m < 4; ++m)
#pragma unroll
                for (int n = 0; n < 2; ++n) acc[a][b][m][n] = (f32x4){0.f, 0.f, 0.f, 0.f};
    bf16x8 At[4][2], B0[2][2], B1[2][2];
    const char* cA = (const char*)g.A + (size_t)cur.pm * tstep; const char* cB = (const char*)g.Bt + (size_t)cur.pn * tstep;
    S.a_ready(cur);
    if constexpr (SP2) {
        PG8_STAGE(PG8_SB(0, 0), cB, voffB); PG8_STAGE(PG8_SB(0, 1), cB + hstep, voffB); PG8_STAGE(PG8_SA(0, 0), cA, voffA); PG8_STAGE(PG8_SA(0, 1), cA + hstep, voffA);
        if (wr == 1) PG8_BAR;
        PG8_WAIT_V(2); PG8_BAR;
        PG8_STAGE(PG8_SB(1, 0), cB + kstep, voffB); PG8_STAGE(PG8_SA(1, 0), cA + kstep, voffA); PG8_STAGE(PG8_SB(1, 1), cB + hstep + kstep, voffB);
        PG8_WAIT_V(6); PG8_BAR;
    } else {
        PG8_STAGE(PG8_SB(0, 0), cB, voffB); PG8_STAGE(PG8_SA(0, 0), cA, voffA); PG8_STAGE(PG8_SB(0, 1), cB + hstep, voffB); PG8_STAGE(PG8_SA(0, 1), cA + hstep, voffA);
        if (wr == 1) PG8_BAR;
        PG8_WAIT_V(4); PG8_BAR;
        PG8_STAGE(PG8_SB(1, 0), cB + kstep, voffB); PG8_STAGE(PG8_SA(1, 0), cA + kstep, voffA); PG8_STAGE(PG8_SB(1, 1), cB + hstep + kstep, voffB);
        PG8_WAIT_V(6); PG8_BAR;
    }
    for (;;) {
        const bool has_next = S.next(ui + 1, nxt);
        const char* nA = has_next ? (const char*)g.A + (size_t)nxt.pm * tstep : cA; const char* nB = has_next ? (const char*)g.Bt + (size_t)nxt.pn * tstep : cB;
        for (int t = 0; t < nt; t += 2) {
            const bool last = (t == nt - 2);
            const char* a1 = cA + (size_t)(t + 1) * kstep;
            const char* a2 = last ? nA : cA + (size_t)(t + 2) * kstep; const char* b2 = last ? nB : cB + (size_t)(t + 2) * kstep;
            const char* a3 = a2 + kstep; const char* b3 = b2 + kstep;
            if (last && has_next) S.a_ready(nxt);
            if constexpr (SP2) {
            PG8_LDB(B0, 0, 0); PG8_LDB(B1, 0, 1); PG8_SCHED; PG8_LDA(At, 0, 0); PG8_STAGE(PG8_SA(1, 1), a1 + hstep, voffA);
            PG8_WAIT_V(8); PG8_WAIT_L(0); PG8_BAR; PG8_MMA(0, 0, At, B0); PG8_MMA(0, 1, At, B1); PG8_BAR; PG8_SCHED;
            PG8_LDA(At, 0, 1); PG8_STAGE(PG8_SB(0, 0), b2, voffB); PG8_STAGE(PG8_SB(0, 1), b2 + hstep, voffB); PG8_STAGE(PG8_SA(0, 0), a2, voffA);
            PG8_WAIT_V(8); PG8_WAIT_L(0); PG8_BAR; PG8_MMA(1, 0, At, B0); PG8_MMA(1, 1, At, B1); PG8_BAR; PG8_SCHED;
            PG8_LDB(B0, 1, 0); PG8_LDB(B1, 1, 1); PG8_SCHED; PG8_LDA(At, 1, 0); PG8_STAGE(PG8_SA(0, 1), a2 + hstep, voffA);
            PG8_WAIT_V(8); PG8_WAIT_L(0); PG8_BAR; PG8_MMA(0, 0, At, B0); PG8_MMA(0, 1, At, B1); PG8_BAR; PG8_SCHED;
            PG8_LDA(At, 1, 1); PG8_STAGE(PG8_SB(1, 0), b3, voffB); PG8_STAGE(PG8_SB(1, 1), b3 + hstep, voffB); PG8_STAGE(PG8_SA(1, 0), a3, voffA);
            PG8_WAIT_V(8); PG8_WAIT_L(0); PG8_BAR; PG8_MMA(1, 0, At, B0); PG8_MMA(1, 1, At, B1); PG8_BAR; PG8_SCHED;
            } else {
            PG8_LDB(B0, 0, 0); PG8_SCHED; PG8_LDA(At, 0, 0); PG8_STAGE(PG8_SA(1, 1), a1 + hstep, voffA);
            PG8_WAIT_L(8); PG8_BAR; PG8_WAIT_L(0); PG8_MMA(0, 0, At, B0); PG8_BAR; PG8_SCHED;
            PG8_LDB(B1, 0, 1); PG8_STAGE(PG8_SB(0, 0), b2, voffB);
            PG8_BAR; PG8_WAIT_L(0); PG8_MMA(0, 1, At, B1); PG8_BAR;
            PG8_LDA(At, 0, 1); PG8_STAGE(PG8_SA(0, 0), a2, voffA);
            PG8_BAR; PG8_WAIT_L(0); PG8_MMA(1, 0, At, B0); PG8_BAR; PG8_SCHED;
            PG8_STAGE(PG8_SB(0, 1), b2 + hstep, voffB);
            PG8_WAIT_V(6); PG8_BAR; PG8_MMA(1, 1, At, B1); PG8_BAR;
            PG8_LDB(B0, 1, 0); PG8_SCHED; PG8_LDA(At, 1, 0); PG8_STAGE(PG8_SA(0, 1), a2 + hstep, voffA);
            PG8_WAIT_L(8); PG8_BAR; PG8_WAIT_L(0); PG8_MMA(0, 0, At, B0); PG8_BAR; PG8_SCHED;
            PG8_LDB(B1, 1, 1); PG8_STAGE(PG8_SB(1, 0), b3, voffB);
            PG8_BAR; PG8_WAIT_L(0); PG8_MMA(0, 1, At, B1); PG8_BAR;
            PG8_LDA(At, 1, 1); PG8_STAGE(PG8_SA(1, 0), a3, voffA);
            PG8_BAR; PG8_WAIT_L(0); PG8_MMA(1, 0, At, B0); PG8_BAR; PG8_SCHED;
            PG8_STAGE(PG8_SB(1, 1), b3 + hstep, voffB);
            PG8_WAIT_V(6); PG8_BAR; PG8_MMA(1, 1, At, B1); PG8_BAR;
            }
        }
        if constexpr (ALIGN_EPI) { if (wr == 0) PG8_BAR; }
        if constexpr (!Epi::AFTER_DRAIN) { E(acc, cur, wr, wc, fr, fq); S.done(cur); }
        if (!has_next) break;
#pragma unroll
        for (int a = 0; a < 2; ++a)
#pragma unroll
            for (int b = 0; b < 2; ++b)
#pragma unroll
                for (int m = 0; m < 4; ++m)
#pragma unroll
                    for (int n = 0; n < 2; ++n) acc[a][b][m][n] = (f32x4){0.f, 0.f, 0.f, 0.f};
        cur = nxt; cA = nA; cB = nB; ++ui;
        if constexpr (ALIGN_EPI) { if (wr == 1) PG8_BAR; }
    }
    PG8_WAIT_V(0);
    if constexpr (!ALIGN_EPI) { if (wr == 0) PG8_BAR; }
    PG8_BAR;
    if constexpr (Epi::AFTER_DRAIN) { E.fused(acc, cur, wr, wc, fr, fq, lds, wid, lane); S.done(cur); }
#undef PG8_SA
#undef PG8_SB
#undef PG8_STAGE
#undef PG8_LDA
#undef PG8_LDB
#undef PG8_MMA
#undef PG8_WAIT_V
#undef PG8_WAIT_L
#undef PG8_BAR
#undef PG8_SCHED
}
}


struct Inputs {
    const float *x, *c, *ctx, *c_ctx, *ada_w, *ada_b, *norm_mix_g, *norm_ffn_g, *w_in, *w_out,
        *lru_conv_w, *lru_conv_b, *lru_wa, *lru_ba, *lru_wx, *lru_bx, *lru_lam,
        *mla_qa_g, *mla_w_uq, *mla_kva_g, *mla_w_ukv, *mla_qn_g, *mla_kn_g,
        *gdn_conv_w, *gdn_a_log, *gdn_dt_bias, *gdn_norm_g, *na_qn_g, *na_kn_g, *na_rpb,
        *ffn_w_up, *ffn_conv_w, *ffn_conv_b, *ffn_w_down;
};
static inline Inputs make_inputs(void* const* d_in) { Inputs I; const float** p = (const float**)&I; for (int i = 0; i < 34; ++i) p[i] = (const float*)d_in[i]; return I; }

constexpr int NQ_MLA = NH * MLA_QK, NKV_MLA = NH * (MLA_NOPE + MLA_V);
struct WS {
    unsigned* ctl;
    float *SC, *MOD, *H;
    bf16_t *U, *Y;
    bf16_t *WIN, *WOUT, *WUP, *WDOWN, *WUQ, *WUKV;
    bf16_t* P; float *LU, *LA, *LB; bf16_t *CQN, *CKVN; float *QR, *KVR; bf16_t *QM, *KM, *VM; float *GC, *GG, *GBt, *GO; bf16_t *NQ, *NK;
    bf16_t *UP, *ACT;
    size_t total;
};
constexpr size_t SZ_WIN = (size_t)NP * D_MODEL, SZ_WOUT = (size_t)D_MODEL * D_MODEL, SZ_WUP = (size_t)2 * D_FF * D_MODEL, SZ_WDOWN = (size_t)D_MODEL * D_FF,
                 SZ_WUQ = (size_t)NQ_MLA * MLA_Q_LORA, SZ_WUKV = (size_t)NKV_MLA * MLA_KV_LORA;
static inline WS ws_carve(void* base) {
    WS w; size_t off = 0; char* b = (char*)base;
    auto take = [&](size_t bytes) { char* p = b + off; off += (bytes + 255) & ~(size_t)255; return p; };
    w.ctl = (unsigned*)take(1 << 20);
    w.SC = (float*)take(sizeof(float) * (BATCH + 1) * D_MODEL);
    w.MOD = (float*)take(sizeof(float) * (size_t)DEPTH * (BATCH + 1) * NMODV);
    w.H = (float*)take(sizeof(float) * (size_t)M_ALL * D_MODEL);
    w.U = (bf16_t*)take(2 * (size_t)M_ALL * D_MODEL);
    w.Y = (bf16_t*)take(2 * (size_t)M_ALL * D_MODEL);
    w.WIN = (bf16_t*)take(2 * SZ_WIN * DEPTH); w.WOUT = (bf16_t*)take(2 * SZ_WOUT * DEPTH); w.WUP = (bf16_t*)take(2 * SZ_WUP * DEPTH); w.WDOWN = (bf16_t*)take(2 * SZ_WDOWN * DEPTH);
    w.WUQ = (bf16_t*)take(2 * SZ_WUQ * DEPTH); w.WUKV = (bf16_t*)take(2 * SZ_WUKV * DEPTH);
    const size_t r0 = off;
    w.P = (bf16_t*)take(2 * (size_t)M_ALL * NP);
    w.LU = (float*)take(4 * (size_t)M_ALL * LRU_W); w.LA = (float*)take(4 * (size_t)2 * M_ALL * LRU_W); w.LB = (float*)take(4 * (size_t)2 * M_ALL * LRU_W);
    w.CQN = (bf16_t*)take(2 * (size_t)M_ALL * MLA_Q_LORA); w.CKVN = (bf16_t*)take(2 * (size_t)M_ALL * MLA_KV_LORA);
    w.QR = (float*)take(4 * (size_t)M_ALL * NQ_MLA); w.KVR = (float*)take(4 * (size_t)M_ALL * NKV_MLA);
    w.QM = (bf16_t*)take(2 * (size_t)M_ALL * NQ_MLA); w.KM = (bf16_t*)take(2 * (size_t)M_ALL * NQ_MLA); w.VM = (bf16_t*)take(2 * (size_t)M_ALL * NH * MLA_V);
    w.GC = (float*)take(4 * (size_t)M_ALL * 3 * GROUP_W); w.GG = (float*)take(4 * (size_t)2 * M_ALL * NH); w.GBt = (float*)take(4 * (size_t)2 * M_ALL * NH);
    w.GO = (float*)take(4 * (size_t)2 * M_ALL * GROUP_W);
    w.NQ = (bf16_t*)take(2 * (size_t)M_ALL * GROUP_W); w.NK = (bf16_t*)take(2 * (size_t)M_ALL * GROUP_W);
    const size_t r1 = off;
    off = r0;
    w.UP = (bf16_t*)take(2 * (size_t)M_ALL * 2 * D_FF); w.ACT = (bf16_t*)take(2 * (size_t)M_ALL * D_FF);
    const size_t f1 = off;
    w.total = r1 > f1 ? r1 : f1;
    return w;
}

void gemm_bf16out(STREAM_T st, const bf16_t* A, const bf16_t* Bt, int M, int N, int K, bf16_t* O, int ldc);
void gemm_f32out(STREAM_T st, const bf16_t* A, const bf16_t* Bt, int M, int N, int K, float* C, int ldc);
void gemm_gate_res(STREAM_T st, const bf16_t* A, const bf16_t* Bt, int M, int N, int K, const float* base, float* out, int ldc, const float* gate  );

static inline int cdiv(long a, long b) { return (int)((a + b - 1) / b); }
#define L1D(k, total, ...) LAUNCH(k, cdiv((total), 256), 256, st, __VA_ARGS__)

static void run_forward(const Inputs& I, float* d_out, const WS& w, STREAM_T st) {
    L1D(k_silu_c, (long)(BATCH + 1) * D_MODEL, I.c, I.c_ctx, w.SC);
    L1D(k_ada, (long)DEPTH * NMODV, w.SC, I.ada_w, I.ada_b, w.MOD);
    L1D(k_init_h, (long)M_ALL * D_MODEL, I.x, I.ctx, w.H);
    for (int l = 0; l < DEPTH; ++l) {
        L1D(k_convert_w, (long)NP * D_MODEL / 8, I.w_in + (size_t)l * D_MODEL * IN_COLS, w.WIN + l * SZ_WIN, D_MODEL, IN_COLS, NP);
        L1D(k_convert_w, (long)D_MODEL * D_MODEL / 8, I.w_out + (size_t)l * D_MODEL * D_MODEL, w.WOUT + l * SZ_WOUT, D_MODEL, D_MODEL, D_MODEL);
        L1D(k_convert_w, (long)2 * D_FF * D_MODEL / 8, I.ffn_w_up + (size_t)l * D_MODEL * 2 * D_FF, w.WUP + l * SZ_WUP, D_MODEL, 2 * D_FF, 2 * D_FF);
        L1D(k_convert_w, (long)D_MODEL * D_FF / 8, I.ffn_w_down + (size_t)l * D_FF * D_MODEL, w.WDOWN + l * SZ_WDOWN, D_FF, D_MODEL, D_MODEL);
        L1D(k_convert_w, (long)NQ_MLA * MLA_Q_LORA / 8, I.mla_w_uq + (size_t)l * MLA_Q_LORA * NQ_MLA, w.WUQ + l * SZ_WUQ, MLA_Q_LORA, NQ_MLA, NQ_MLA);
        L1D(k_convert_w, (long)NKV_MLA * MLA_KV_LORA / 8, I.mla_w_ukv + (size_t)l * MLA_KV_LORA * NKV_MLA, w.WUKV + l * SZ_WUKV, MLA_KV_LORA, NKV_MLA, NKV_MLA);
    }
    for (int l = 0; l < DEPTH; ++l) {
        const bool want_ctx = l < DEPTH - 1; const int Mo = want_ctx ? M_ALL : M_LAT;
        const float* MODl = w.MOD + (size_t)l * (BATCH + 1) * NMODV;
        L1D(k_norm_mod, M_ALL, w.H, I.norm_mix_g + (size_t)l * D_MODEL, MODl, 0, w.U, M_ALL);
        gemm_bf16out(st, w.U, w.WIN + l * SZ_WIN, M_ALL, NP, D_MODEL, w.P, NP);
        L1D(k_lru_conv, (long)M_ALL * LRU_W, w.P, I.lru_conv_w + (size_t)l * 4 * LRU_W, I.lru_conv_b + (size_t)l * LRU_W, w.LU);
        L1D(k_lru_coef, (long)2 * M_ALL * LRU_W, w.LU, I.lru_wa + (size_t)l * 2 * NH * LRU_BW * LRU_BW, I.lru_ba + (size_t)l * 2 * LRU_W,
            I.lru_wx + (size_t)l * 2 * NH * LRU_BW * LRU_BW, I.lru_bx + (size_t)l * 2 * LRU_W, I.lru_lam + (size_t)l * 2 * LRU_W, w.LA, w.LB);
        L1D(k_lru_scan, (long)BATCH * 2 * LRU_W, w.LA, w.LB);
        L1D(k_lru_fin, (long)M_ALL * LRU_W, w.LB, w.P, w.Y);
        L1D(k_mla_norm1, M_ALL, w.P, I.mla_qa_g + (size_t)l * MLA_Q_LORA, I.mla_kva_g + (size_t)l * MLA_KV_LORA, w.CQN, w.CKVN);
        gemm_f32out(st, w.CQN, w.WUQ + l * SZ_WUQ, M_ALL, NQ_MLA, MLA_Q_LORA, w.QR, NQ_MLA);
        gemm_f32out(st, w.CKVN, w.WUKV + l * SZ_WUKV, M_ALL, NKV_MLA, MLA_KV_LORA, w.KVR, NKV_MLA);
        L1D(k_mla_qkv, (long)M_ALL * NH, w.QR, w.KVR, w.P, I.mla_qn_g + (size_t)l * MLA_QK, I.mla_kn_g + (size_t)l * MLA_QK, w.QM, w.KM, w.VM);
        { const float sc = 1.0f / sqrtf((float)MLA_QK);
          LAUNCH((k_attn_dense<MLA_QK, MLA_V>), BATCH * NH * cdiv(SEQ, 128), 256, st, w.QM, w.KM, w.VM, NQ_MLA, NQ_MLA, NH * MLA_V, sc, w.Y, GROUP_W, 0);
          if (want_ctx) LAUNCH((k_attn_dense<MLA_QK, MLA_V>), BATCH * NH * cdiv(CTX_LEN, 128), 256, st, w.QM, w.KM, w.VM, NQ_MLA, NQ_MLA, NH * MLA_V, sc, w.Y, GROUP_W, 1); }
        L1D(k_gdn_conv, (long)M_ALL * 3 * GROUP_W, w.P, I.gdn_conv_w + (size_t)l * 4 * 3 * GROUP_W, w.GC);
        L1D(k_gdn_norm, (long)M_ALL * NH, w.GC);
        L1D(k_gdn_gates, (long)2 * M_ALL * NH, w.P, I.gdn_a_log + (size_t)l * 2 * NH, I.gdn_dt_bias + (size_t)l * 2 * NH, w.GG, w.GBt);
        LAUNCH(k_gdn_seq, BATCH * NH * 2, HD, st, w.GC, w.GG, w.GBt, w.GO);
        L1D(k_gdn_fin, (long)M_ALL * NH, w.GO, w.P, I.gdn_norm_g + (size_t)l * HD, w.Y);
        L1D(k_na_norm, (long)M_ALL * NH, w.P, I.na_qn_g + (size_t)l * HD, I.na_kn_g + (size_t)l * HD, w.NQ, w.NK);
        LAUNCH(k_na_attn, BATCH * NH * (SEQ / 128), 256, st, w.NQ, w.NK, w.P, I.na_rpb + (size_t)l * NH * (2 * NA_KH - 1) * (2 * NA_KW - 1), w.Y);
        if (want_ctx) LAUNCH((k_attn_dense<HD, HD>), BATCH * NH * cdiv(CTX_LEN, 128), 256, st, w.NQ, w.NK, w.P + C_NV, GROUP_W, GROUP_W, NP, 1.0f / sqrtf((float)HD), w.Y, 3 * GROUP_W, 1);
        gemm_gate_res(st, w.Y, w.WOUT + l * SZ_WOUT, Mo, D_MODEL, D_MODEL, w.H, w.H, D_MODEL, MODl + 2 * D_MODEL);
        L1D(k_norm_mod, Mo, w.H, I.norm_ffn_g + (size_t)l * D_MODEL, MODl, 3, w.U, Mo);
        gemm_bf16out(st, w.U, w.WUP + l * SZ_WUP, Mo, 2 * D_FF, D_MODEL, w.UP, 2 * D_FF);
        L1D(k_ffn_act, (long)Mo * D_FF, w.UP, I.ffn_conv_w + (size_t)l * 3 * 2 * D_FF, I.ffn_conv_b + (size_t)l * 2 * D_FF, w.ACT, Mo);
        gemm_gate_res(st, w.ACT, w.WDOWN + l * SZ_WDOWN, Mo, D_MODEL, D_FF, w.H, want_ctx ? w.H : d_out, D_MODEL, MODl + 5 * D_MODEL);
    }
}

template <class Epi> __global__ void __launch_bounds__(512, 2) k_gemm(pg8::Gemm g, Epi E) {
    extern __shared__ __attribute__((aligned(16))) unsigned char shm[];
    pg8::StaticOrder S; S.init(g.M, g.N, (int)gridDim.x, (int)blockIdx.x);
    pg8::gemm_phase<Epi, pg8::StaticOrder, true, true>((PG8_LAS unsigned char*)shm, g, S, E);
}
constexpr int GEMM_LDS = pg8::STAGE_BYTES;
static int g_grid = 0;
template <class Epi> static void gemm_launch(hipStream_t st, const bf16_t* A, const bf16_t* Bt, int M, int N, int K, const Epi& E) {
    static bool attr_done = false;
    if (!attr_done) { (void)hipFuncSetAttribute((const void*)k_gemm<Epi>, hipFuncAttributeMaxDynamicSharedMemorySize, GEMM_LDS); attr_done = true; }
    pg8::Gemm g{A, Bt, M, N, K};
    hipLaunchKernelGGL(k_gemm<Epi>, dim3(g_grid), dim3(512), GEMM_LDS, st, g, E);
}
void gemm_bf16out(STREAM_T st, const bf16_t* A, const bf16_t* Bt, int M, int N, int K, bf16_t* O, int ldc) {
    pg8::EpiBf16<0> E{O, ldc, nullptr, 0, 0, 1.0f}; gemm_launch(st, A, Bt, M, N, K, E); }
void gemm_f32out(STREAM_T st, const bf16_t* A, const bf16_t* Bt, int M, int N, int K, float* C, int ldc) {
    pg8::EpiF32 E{C, ldc}; gemm_launch(st, A, Bt, M, N, K, E); }
void gemm_gate_res(STREAM_T st, const bf16_t* A, const bf16_t* Bt, int M, int N, int K, const float* base, float* out, int ldc, const float* gate) {
    pg8::EpiGateRes E{base, out, ldc, gate, NMODV, SEQ, BATCH, M_LAT}; gemm_launch(st, A, Bt, M, N, K, E); }

extern "C" void kernel_launch(void* const* d_in, const int* in_sizes, int n_in, void* d_out, int out_size, void* d_ws, size_t ws_size, hipStream_t stream) {
    if (g_grid == 0) { int dev = 0, cus = 0; (void)hipGetDevice(&dev); (void)hipDeviceGetAttribute(&cus, hipDeviceAttributeMultiprocessorCount, dev); g_grid = cus > 0 ? cus : 256; }
    const WS w = ws_carve(d_ws);
    if (n_in != 34 || w.total > ws_size) { fprintf(stderr, "kernel_launch: bad inputs / workspace (need %zu, have %zu)\n", w.total, ws_size); return; }
    const Inputs I = make_inputs(d_in);
    run_forward(I, (float*)d_out, w, stream);
}
```

```cpp
#include <hip/hip_runtime.h>
#include <cstdio>
#include <cstdint>
#include <cstring>
typedef hipStream_t STREAM_T;
#define LAUNCH(k, grid, block, st, ...) hipLaunchKernelGGL(k, dim3(grid), dim3(block), 0, st, __VA_ARGS__)
#define FAST_ATTN 1
#include <math.h>
#include <stdint.h>

#ifdef CFG_SMALL
constexpr int D_MODEL = 256, BATCH = 2, SEQ = 512, DEPTH = 2, CTX_LEN = 64, GRID_W = 32, HEAD_DIM = 16;
#else
constexpr int D_MODEL = 2048, BATCH = 2, SEQ = 8192, DEPTH = 4, CTX_LEN = 256, GRID_W = 64, HEAD_DIM = 128;
#endif
constexpr int GROUP_W = D_MODEL / 4, NH = GROUP_W / HEAD_DIM;
constexpr int HD = HEAD_DIM;
constexpr int N_MOD = 6;
constexpr float EPS = 1e-6f;
constexpr int LRU_W = GROUP_W, LRU_BW = LRU_W / NH;
constexpr float LRU_C = 8.0f;
constexpr int MLA_Q_LORA = 3 * D_MODEL / 16, MLA_KV_LORA = D_MODEL / 8, MLA_NOPE = HD, MLA_ROPE = HD / 2, MLA_V = HD, MLA_QK = MLA_NOPE + MLA_ROPE;
constexpr int GDN_CHUNK = 64;
constexpr int NA_KH = 8, NA_KW = 16;
constexpr int D_FF = 5 * D_MODEL / 2;
constexpr int ROWS = SEQ / GRID_W;
constexpr int C_LRU_X = 0, C_LRU_G = C_LRU_X + LRU_W, C_CQ = C_LRU_G + LRU_W, C_CKV = C_CQ + MLA_Q_LORA, C_KR = C_CKV + MLA_KV_LORA,
              C_GQ = C_KR + MLA_ROPE, C_GK = C_GQ + GROUP_W, C_GV = C_GK + GROUP_W, C_GG = C_GV + GROUP_W, C_GB = C_GG + GROUP_W,
              C_GA = C_GB + 2 * NH, C_NQ = C_GA + 2 * NH, C_NK = C_NQ + GROUP_W, C_NV = C_NK + GROUP_W, IN_COLS = C_NV + GROUP_W;
constexpr int NP = (IN_COLS + 255) / 256 * 256;
constexpr int M_LAT = BATCH * SEQ, M_CTX = BATCH * CTX_LEN, M_ALL = M_LAT + M_CTX;
constexpr int NMODV = N_MOD * D_MODEL;

typedef unsigned short bf16_t;
__host__ __device__ __forceinline__ bf16_t f2bf(float f) { union { float f; unsigned u; } v; v.f = f; unsigned u = v.u; u += 0x7fffu + ((u >> 16) & 1u); return (bf16_t)(u >> 16); }
__host__ __device__ __forceinline__ float bf2f(bf16_t b) { union { float f; unsigned u; } v; v.u = ((unsigned)b) << 16; return v.f; }
__host__ __device__ __forceinline__ float sigmoidf_(float x) { return 1.0f / (1.0f + expf(-x)); }
__host__ __device__ __forceinline__ float siluf_(float x) { return x / (1.0f + expf(-x)); }
__host__ __device__ __forceinline__ float softplusf_(float x) { return fmaxf(x, 0.0f) + log1pf(expf(-fabsf(x))); }
__host__ __device__ __forceinline__ float geluf_(float x) { return 0.5f * x * (1.0f + tanhf(0.7978845608028654f * (x + 0.044715f * x * x * x))); }

struct RowInfo { int b, t, T, base, set; };
__host__ __device__ __forceinline__ RowInfo row_info(int r) {
    RowInfo i;
    if (r < M_LAT) { i.b = r / SEQ; i.t = r % SEQ; i.T = SEQ; i.base = i.b * SEQ; i.set = i.b; }
    else { const int rr = r - M_LAT; i.b = rr / CTX_LEN; i.t = rr % CTX_LEN; i.T = CTX_LEN; i.base = M_LAT + i.b * CTX_LEN; i.set = BATCH; }
    return i;
}

#define GID() ((long)blockIdx.x * blockDim.x + threadIdx.x)

__global__ void k_silu_c(const float* c, const float* c_ctx, float* SC) {
    const long i = GID(); if (i >= (long)(BATCH + 1) * D_MODEL) return;
    const int s = (int)(i / D_MODEL), k = (int)(i % D_MODEL);
    const float v = s < BATCH ? c[s * D_MODEL + k] : c_ctx[k];
    SC[i] = siluf_(v);
}
__global__ void k_ada(const float* SC, const float* ada_w, const float* ada_b, float* MOD) {
    const long i = GID(); if (i >= (long)DEPTH * NMODV) return;
    const int l = (int)(i / NMODV), j = (int)(i % NMODV);
    float acc[BATCH + 1];
    for (int s = 0; s <= BATCH; ++s) acc[s] = 0.f;
    const float* w = ada_w + (size_t)l * D_MODEL * NMODV + j;
    for (int k = 0; k < D_MODEL; ++k) { const float wv = w[(size_t)k * NMODV];
        for (int s = 0; s <= BATCH; ++s) acc[s] += SC[s * D_MODEL + k] * wv; }
    for (int s = 0; s <= BATCH; ++s) MOD[((size_t)l * (BATCH + 1) + s) * NMODV + j] = acc[s] + ada_b[(size_t)l * NMODV + j];
}
__global__ void k_convert_w(const float* W, bf16_t* Wt, int K, int N, int Npad) {
    const long i = GID(); const int K8 = K / 8; if (i >= (long)Npad * K8) return;
    const int k8 = (int)(i / Npad), n = (int)(i % Npad);
    for (int j = 0; j < 8; ++j) { const int k = k8 * 8 + j; Wt[(size_t)n * K + k] = n < N ? f2bf(W[(size_t)k * N + n]) : (bf16_t)0; }
}
__global__ void k_init_h(const float* x, const float* ctx, float* H) {
    const long i = GID(); if (i >= (long)M_ALL * D_MODEL) return;
    H[i] = i < (long)M_LAT * D_MODEL ? x[i] : ctx[i - (long)M_LAT * D_MODEL];
}

__global__ void k_norm_mod(const float* H, const float* g, const float* MODl, int sh_idx, bf16_t* U, int nrows) {
    const long r = GID(); if (r >= nrows) return;
    const RowInfo ri = row_info((int)r);
    const float* h = H + (size_t)r * D_MODEL;
    float ss = 0.f; for (int k = 0; k < D_MODEL; ++k) ss += h[k] * h[k];
    const float rstd = 1.0f / sqrtf(ss / D_MODEL + EPS);
    const float* shift = MODl + (size_t)ri.set * NMODV + (size_t)sh_idx * D_MODEL; const float* scale = shift + D_MODEL;
    for (int k = 0; k < D_MODEL; ++k) U[(size_t)r * D_MODEL + k] = f2bf(h[k] * rstd * g[k] * (1.0f + scale[k]) + shift[k]);
}

__global__ void k_lru_conv(const bf16_t* P, const float* cw, const float* cb, float* LU) {
    const long i = GID(); if (i >= (long)M_ALL * LRU_W) return;
    const int r = (int)(i / LRU_W), ch = (int)(i % LRU_W); const RowInfo ri = row_info(r);
    float acc = cb[ch];
    for (int j = 0; j < 4; ++j) { const int tt = ri.t + j - 1; if (tt >= 0 && tt < ri.T) acc += cw[j * LRU_W + ch] * bf2f(P[(size_t)(ri.base + tt) * NP + C_LRU_X + ch]); }
    LU[i] = acc;
}
__global__ void k_lru_coef(const float* LU, const float* wa, const float* ba, const float* wx, const float* bx, const float* lam, float* LA, float* LB) {
    const long i = GID(); if (i >= (long)2 * M_ALL * LRU_W) return;
    const int d = (int)(i / ((long)M_ALL * LRU_W)); const long rem = i % ((long)M_ALL * LRU_W);
    const int r = (int)(rem / LRU_W), ch = (int)(rem % LRU_W), nb = ch / LRU_BW, e = ch % LRU_BW;
    const float* u = LU + (size_t)r * LRU_W + nb * LRU_BW;
    const float* wap = wa + ((size_t)(d * NH + nb) * LRU_BW) * LRU_BW + e; const float* wxp = wx + ((size_t)(d * NH + nb) * LRU_BW) * LRU_BW + e;
    float za = ba[d * LRU_W + ch], zx = bx[d * LRU_W + ch];
    for (int k = 0; k < LRU_BW; ++k) { const float uv = u[k]; za += uv * wap[(size_t)k * LRU_BW]; zx += uv * wxp[(size_t)k * LRU_BW]; }
    const float rr = sigmoidf_(za), ii = sigmoidf_(zx);
    const float log_a = -LRU_C * rr * softplusf_(-lam[d * LRU_W + ch]);
    LA[i] = expf(log_a);
    LB[i] = sqrtf(-expm1f(2.0f * log_a)) * ii * LU[(size_t)r * LRU_W + ch];
}
__global__ void k_lru_scan(const float* LA, float* LB) {
    const long i = GID(); if (i >= (long)BATCH * 2 * LRU_W) return;
    const int ch = (int)(i % LRU_W), d = (int)((i / LRU_W) % 2), b = (int)(i / (2 * LRU_W));
    float h = 0.f;
    for (int seg = 0; seg < 2; ++seg) {
        const int T = seg == 0 ? CTX_LEN : SEQ, base = seg == 0 ? M_LAT + b * CTX_LEN : b * SEQ;
        for (int s = 0; s < T; ++s) { const int t = d == 0 ? s : T - 1 - s; const size_t idx = ((size_t)d * M_ALL + base + t) * LRU_W + ch;
            h = LA[idx] * h + LB[idx]; LB[idx] = h; }
    }
}
__global__ void k_lru_fin(const float* LB, const bf16_t* P, bf16_t* Y) {
    const long i = GID(); if (i >= (long)M_ALL * LRU_W) return;
    const int r = (int)(i / LRU_W), ch = (int)(i % LRU_W);
    const float h = LB[i] + LB[(size_t)M_ALL * LRU_W + i];
    Y[(size_t)r * D_MODEL + ch] = f2bf(h * geluf_(bf2f(P[(size_t)r * NP + C_LRU_G + ch])));
}

__global__ void k_mla_norm1(const bf16_t* P, const float* qa_g, const float* kva_g, bf16_t* CQN, bf16_t* CKVN) {
    const long r = GID(); if (r >= M_ALL) return;
    const bf16_t* p = P + (size_t)r * NP;
    float ss = 0.f; for (int k = 0; k < MLA_Q_LORA; ++k) { const float v = bf2f(p[C_CQ + k]); ss += v * v; }
    float rstd = 1.0f / sqrtf(ss / MLA_Q_LORA + EPS);
    for (int k = 0; k < MLA_Q_LORA; ++k) CQN[(size_t)r * MLA_Q_LORA + k] = f2bf(bf2f(p[C_CQ + k]) * rstd * qa_g[k]);
    ss = 0.f; for (int k = 0; k < MLA_KV_LORA; ++k) { const float v = bf2f(p[C_CKV + k]); ss += v * v; }
    rstd = 1.0f / sqrtf(ss / MLA_KV_LORA + EPS);
    for (int k = 0; k < MLA_KV_LORA; ++k) CKVN[(size_t)r * MLA_KV_LORA + k] = f2bf(bf2f(p[C_CKV + k]) * rstd * kva_g[k]);
}
__host__ __device__ __forceinline__ void rope_angle(int t, int i, float& cs, float& sn) {
    constexpr int NF = MLA_ROPE / 4;
    const int j = i < NF ? i : i - NF; const float pos = i < NF ? (float)(t / GRID_W) : (float)(t % GRID_W);
    const float inv = powf(10000.0f, -(float)j / (float)NF); const float ang = pos * inv; cs = cosf(ang); sn = sinf(ang);
}
__global__ void k_mla_qkv(const float* QR, const float* KVR, const bf16_t* P, const float* qn_g, const float* kn_g, bf16_t* QM, bf16_t* KM, bf16_t* VM) {
    const long i = GID(); if (i >= (long)M_ALL * NH) return;
    const int r = (int)(i / NH), h = (int)(i % NH); const RowInfo ri = row_info(r); const bool lat = r < M_LAT;
    constexpr int HR = MLA_ROPE / 2;
    for (int which = 0; which < 2; ++which) {
        const float* g = which == 0 ? qn_g : kn_g; bf16_t* O = (which == 0 ? QM : KM) + ((size_t)r * NH + h) * MLA_QK;
        const float* src = which == 0 ? QR + (size_t)r * (NH * MLA_QK) + h * MLA_QK : KVR + (size_t)r * (NH * (MLA_NOPE + MLA_V)) + h * (MLA_NOPE + MLA_V);
        const bf16_t* kr = P + (size_t)r * NP + C_KR;
        float ss = 0.f;
        for (int dd = 0; dd < MLA_QK; ++dd) { const float v = (which == 0 || dd < MLA_NOPE) ? src[dd] : bf2f(kr[dd - MLA_NOPE]); ss += v * v; }
        const float rstd = 1.0f / sqrtf(ss / MLA_QK + EPS);
        for (int dd = 0; dd < MLA_NOPE; ++dd) O[dd] = f2bf(src[dd] * rstd * g[dd]);
        for (int p2 = 0; p2 < HR; ++p2) {
            const int d1 = MLA_NOPE + p2, d2 = MLA_NOPE + HR + p2;
            float x1 = (which == 0 ? src[d1] : bf2f(kr[p2])) * rstd * g[d1], x2 = (which == 0 ? src[d2] : bf2f(kr[HR + p2])) * rstd * g[d2];
            if (lat) { float cs, sn; rope_angle(ri.t, p2, cs, sn); const float y1 = x1 * cs - x2 * sn, y2 = x1 * sn + x2 * cs; x1 = y1; x2 = y2; }
            O[d1] = f2bf(x1); O[d2] = f2bf(x2);
        }
    }
    const float* vs = KVR + (size_t)r * (NH * (MLA_NOPE + MLA_V)) + h * (MLA_NOPE + MLA_V) + MLA_NOPE;
    for (int dd = 0; dd < MLA_V; ++dd) VM[((size_t)r * NH + h) * MLA_V + dd] = f2bf(vs[dd]);
}
__host__ __device__ __forceinline__ float bflo(unsigned w) { union { float f; unsigned u; } v; v.u = w << 16; return v.f; }
__host__ __device__ __forceinline__ float bfhi(unsigned w) { union { float f; unsigned u; } v; v.u = w & 0xffff0000u; return v.f; }
template <int DQ, int DV>
__global__ void __launch_bounds__(256) k_attn_dense(const bf16_t* Q, const bf16_t* K, const bf16_t* V, int ldq, int ldk, int ldv, float scale, bf16_t* Y, int ycol0, int seg) {
    const int Tq = seg == 0 ? SEQ : CTX_LEN; const int nqb = (Tq + 127) / 128;
    const int blk = blockIdx.x, qb = blk % nqb, h = (blk / nqb) % NH, b = blk / (nqb * NH);
    const int ql = threadIdx.x >> 1, half = threadIdx.x & 1; const int tq = qb * 128 + ql; if (tq >= Tq) return;
    const int qrow = seg == 0 ? b * SEQ + tq : M_LAT + b * CTX_LEN + tq;
    constexpr int DH = DV / 2;
    unsigned q[DQ / 2]; { const unsigned* qp = (const unsigned*)(Q + (size_t)qrow * ldq + h * DQ); for (int d = 0; d < DQ / 2; ++d) q[d] = qp[d]; }
    float o[DH]; for (int d = 0; d < DH; ++d) o[d] = 0.f;
    float m = -INFINITY, l = 0.f;
    for (int ks = (seg == 0 ? 0 : 1); ks < 2; ++ks) {
        const int Tk = ks == 0 ? SEQ : CTX_LEN, kbase = ks == 0 ? b * SEQ : M_LAT + b * CTX_LEN;
        for (int j = 0; j < Tk; ++j) {
            const unsigned* kp = (const unsigned*)(K + (size_t)(kbase + j) * ldk + h * DQ); float s = 0.f;
            for (int d = 0; d < DQ / 2; ++d) { const unsigned kw = kp[d]; s += bflo(q[d]) * bflo(kw) + bfhi(q[d]) * bfhi(kw); }
            s *= scale;
            const float mn = fmaxf(m, s), corr = expf(m - mn), p = expf(s - mn);
            l = l * corr + p; const unsigned* vp = (const unsigned*)(V + (size_t)(kbase + j) * ldv + h * DV + half * DH);
            for (int d = 0; d < DH / 2; ++d) { const unsigned vw = vp[d]; o[2 * d] = o[2 * d] * corr + p * bflo(vw); o[2 * d + 1] = o[2 * d + 1] * corr + p * bfhi(vw); }
            m = mn;
        }
    }
    const float il = 1.0f / l;
    for (int d = 0; d < DH; ++d) Y[(size_t)qrow * D_MODEL + ycol0 + h * DV + half * DH + d] = f2bf(o[d] * il);
}

__global__ void k_gdn_conv(const bf16_t* P, const float* cw, float* GC) {
    const long i = GID(); if (i >= (long)M_ALL * 3 * GROUP_W) return;
    const int r = (int)(i / (3 * GROUP_W)), c = (int)(i % (3 * GROUP_W)); const RowInfo ri = row_info(r);
    float acc = 0.f;
    for (int j = 0; j < 4; ++j) { const int tt = ri.t + j - 1; if (tt >= 0 && tt < ri.T) acc += cw[j * 3 * GROUP_W + c] * bf2f(P[(size_t)(ri.base + tt) * NP + C_GQ + c]); }
    GC[i] = siluf_(acc);
}
__global__ void k_gdn_norm(float* GC) {
    const long i = GID(); if (i >= (long)M_ALL * NH) return;
    const int r = (int)(i / NH), h = (int)(i % NH);
    for (int which = 0; which < 2; ++which) { float* p = GC + (size_t)r * 3 * GROUP_W + which * GROUP_W + h * HD;
        float ss = 0.f; for (int d = 0; d < HD; ++d) ss += p[d] * p[d];
        const float sc = (1.0f / sqrtf(ss + EPS)) * (which == 0 ? 1.0f / sqrtf((float)HD) : 1.0f);
        for (int d = 0; d < HD; ++d) p[d] *= sc; }
}
__global__ void k_gdn_gates(const bf16_t* P, const float* a_log, const float* dt_bias, float* GG, float* GBt) {
    const long i = GID(); if (i >= (long)2 * M_ALL * NH) return;
    const int d = (int)(i / ((long)M_ALL * NH)); const long rem = i % ((long)M_ALL * NH); const int r = (int)(rem / NH), h = (int)(rem % NH);
    GBt[i] = sigmoidf_(bf2f(P[(size_t)r * NP + C_GB + d * NH + h]));
    GG[i] = -expf(a_log[d * NH + h]) * softplusf_(bf2f(P[(size_t)r * NP + C_GA + d * NH + h]) + dt_bias[d * NH + h]);
}
__global__ void __launch_bounds__(HD) k_gdn_seq(const float* GC, const float* GG, const float* GBt, float* GO) {
    const int blk = blockIdx.x, d = blk % 2, h = (blk / 2) % NH, b = blk / (2 * NH), vc = threadIdx.x;
    float S[HD]; for (int k = 0; k < HD; ++k) S[k] = 0.f;
    for (int seg = 0; seg < 2; ++seg) {
        const int T = seg == 0 ? CTX_LEN : SEQ, base = seg == 0 ? M_LAT + b * CTX_LEN : b * SEQ;
        for (int s = 0; s < T; ++s) { const int t = d == 0 ? s : T - 1 - s, r = base + t;
            const float* qp = GC + (size_t)r * 3 * GROUP_W + h * HD; const float* kp = qp + GROUP_W; const float v = qp[2 * GROUP_W + vc];
            const float g = GG[((size_t)d * M_ALL + r) * NH + h], beta = GBt[((size_t)d * M_ALL + r) * NH + h];
            const float eg = expf(g); float kS = 0.f;
            for (int k = 0; k < HD; ++k) { S[k] *= eg; kS += kp[k] * S[k]; }
            const float vn = beta * (v - kS); float o = 0.f;
            for (int k = 0; k < HD; ++k) { S[k] += kp[k] * vn; o += qp[k] * S[k]; }
            GO[((size_t)d * M_ALL + r) * GROUP_W + h * HD + vc] = o; }
    }
}
__global__ void k_gdn_fin(const float* GO, const bf16_t* P, const float* norm_g, bf16_t* Y) {
    const long i = GID(); if (i >= (long)M_ALL * NH) return;
    const int r = (int)(i / NH), h = (int)(i % NH);
    const float* o0 = GO + (size_t)r * GROUP_W + h * HD; const float* o1 = o0 + (size_t)M_ALL * GROUP_W;
    float ss = 0.f; for (int v = 0; v < HD; ++v) { const float o = o0[v] + o1[v]; ss += o * o; }
    const float rstd = 1.0f / sqrtf(ss / HD + EPS);
    for (int v = 0; v < HD; ++v) Y[(size_t)r * D_MODEL + 2 * GROUP_W + h * HD + v] = f2bf((o0[v] + o1[v]) * rstd * norm_g[v] * siluf_(bf2f(P[(size_t)r * NP + C_GG + h * HD + v])));
}

__global__ void k_na_norm(const bf16_t* P, const float* qn_g, const float* kn_g, bf16_t* NQ, bf16_t* NK) {
    const long i = GID(); if (i >= (long)M_ALL * NH) return;
    const int r = (int)(i / NH), h = (int)(i % NH);
    for (int which = 0; which < 2; ++which) { const bf16_t* p = P + (size_t)r * NP + (which == 0 ? C_NQ : C_NK) + h * HD; const float* g = which == 0 ? qn_g : kn_g;
        bf16_t* O = (which == 0 ? NQ : NK) + (size_t)r * GROUP_W + h * HD;
        float ss = 0.f; for (int d = 0; d < HD; ++d) { const float v = bf2f(p[d]); ss += v * v; }
        const float rstd = 1.0f / sqrtf(ss / HD + EPS);
        for (int d = 0; d < HD; ++d) O[d] = f2bf(bf2f(p[d]) * rstd * g[d]); }
}
__global__ void __launch_bounds__(256) k_na_attn(const bf16_t* NQ, const bf16_t* NK, const bf16_t* P, const float* rpb, bf16_t* Y) {
    const int nqb = SEQ / 128; const int blk = blockIdx.x, qb = blk % nqb, h = (blk / nqb) % NH, b = blk / (nqb * NH);
    const int ql = threadIdx.x >> 1, half = threadIdx.x & 1, tq = qb * 128 + ql, qrow = b * SEQ + tq;
    constexpr int DH = HD / 2; const float scale = 1.0f / sqrtf((float)HD);
    unsigned q[HD / 2]; { const unsigned* qp = (const unsigned*)(NQ + (size_t)qrow * GROUP_W + h * HD); for (int d = 0; d < HD / 2; ++d) q[d] = qp[d]; }
    float o[DH]; for (int d = 0; d < DH; ++d) o[d] = 0.f;
    float m = -INFINITY, l = 0.f;
    const int r = tq / GRID_W, c = tq % GRID_W; constexpr int kh = NA_KH < ROWS ? NA_KH : ROWS;
    int r0 = r - kh / 2; r0 = r0 < 0 ? 0 : (r0 > ROWS - kh ? ROWS - kh : r0);
    int c0 = c - NA_KW / 2; c0 = c0 < 0 ? 0 : (c0 > GRID_W - NA_KW ? GRID_W - NA_KW : c0);
    const int nloc = kh * NA_KW;
    for (int j = 0; j < nloc + CTX_LEN; ++j) {
        int krow; float bias = 0.f;
        if (j < nloc) { const int rr = r0 + j / NA_KW, cc = c0 + j % NA_KW; krow = b * SEQ + rr * GRID_W + cc;
            const int dr = rr - r + (NA_KH - 1); int dc = cc - c + (NA_KW - 1); dc = dc < 0 ? 0 : (dc > 2 * NA_KW - 2 ? 2 * NA_KW - 2 : dc);
            bias = rpb[((size_t)h * (2 * NA_KH - 1) + dr) * (2 * NA_KW - 1) + dc]; }
        else krow = M_LAT + b * CTX_LEN + (j - nloc);
        const unsigned* kp = (const unsigned*)(NK + (size_t)krow * GROUP_W + h * HD); float s = 0.f;
        for (int d = 0; d < HD / 2; ++d) { const unsigned kw = kp[d]; s += bflo(q[d]) * bflo(kw) + bfhi(q[d]) * bfhi(kw); }
        s = s * scale + bias;
        const float mn = fmaxf(m, s), corr = expf(m - mn), p = expf(s - mn);
        l = l * corr + p; const unsigned* vp = (const unsigned*)(P + (size_t)krow * NP + C_NV + h * HD + half * DH);
        for (int d = 0; d < DH / 2; ++d) { const unsigned vw = vp[d]; o[2 * d] = o[2 * d] * corr + p * bflo(vw); o[2 * d + 1] = o[2 * d + 1] * corr + p * bfhi(vw); }
        m = mn; }
    const float il = 1.0f / l;
    for (int d = 0; d < DH; ++d) Y[(size_t)qrow * D_MODEL + 3 * GROUP_W + h * HD + half * DH + d] = f2bf(o[d] * il);
}

__global__ void k_ffn_act(const bf16_t* UP, const float* cw, const float* cb, bf16_t* ACT, int nrows) {
    const long i = GID(); if (i >= (long)nrows * D_FF) return;
    const int r = (int)(i / D_FF), j = (int)(i % D_FF); const RowInfo ri = row_info(r);
    float a = cb[j], g = cb[D_FF + j];
    for (int k = 0; k < 3; ++k) { const int tt = ri.t + k - 1; if (tt >= 0 && tt < ri.T) { const bf16_t* u = UP + (size_t)(ri.base + tt) * (2 * D_FF);
        a += cw[k * 2 * D_FF + j] * bf2f(u[j]); g += cw[k * 2 * D_FF + D_FF + j] * bf2f(u[D_FF + j]); } }
    ACT[i] = f2bf(a * siluf_(g));
}

namespace pg8 {
#define PG8_LAS __attribute__((address_space(3)))
typedef unsigned short bf16_t;
typedef short bf16x8 __attribute__((ext_vector_type(8)));
typedef float f32x4 __attribute__((ext_vector_type(4)));
typedef unsigned u32x4 __attribute__((ext_vector_type(4)));
constexpr int BM = 256, BK = 64, HALF = 128, HTB = HALF * BK * 2  , STAGE_BYTES = 8 * HTB, NXCD = 8, WGM = 8;

__host__ __device__ __forceinline__ int lds_byte(int r, int c) { const int st = (r >> 4) * 2 + (c >> 5), rr = r & 15, cc = c & 31, ob = rr * 64 + cc * 2; return st * 1024 + (ob ^ (((ob >> 9) & 1) << 5)); }
__host__ __device__ __forceinline__ void stage_rc(int b, int& R, int& C) { const int st = b / 1024, sb = b % 1024, swz = sb ^ (((sb >> 9) & 1) << 5); R = (st >> 1) * 16 + swz / 64; C = (st & 1) * 32 + (swz % 64) / 2; }
__host__ __device__ __forceinline__ int perm32(int rho) { const int n = rho >> 4, i = rho & 15; return 8 * (i >> 2) + 4 * n + (i & 3); }

struct Unit { int pm, pn; };
struct Gemm { const bf16_t* A; const bf16_t* Bt; int M, N, K; };

struct StaticOrder {
    int nM, nN, nwg, G, c;
    __host__ __device__ void init(int M, int N, int G_, int c_) { nM = M / BM; nN = N / BM; nwg = nM * nN; G = G_; c = c_; }
    __host__ __device__ bool next(int i, Unit& u) const {
        const long L = (long)i * G + c; if (L >= nwg) return false;
        int wgid = (int)L; { const int q = nwg / NXCD, r = nwg % NXCD, xcd = wgid % NXCD, off = wgid / NXCD; wgid = (xcd < r ? xcd * (q + 1) : r * (q + 1) + (xcd - r) * q) + off; }
        const int nig = WGM * nN, gid = wgid / nig, fm = gid * WGM, gsz = (nM - fm) < WGM ? (nM - fm) : WGM;
        u.pm = fm + ((wgid % nig) % gsz); u.pn = (wgid % nig) / gsz; return true;
    }
    __device__ __forceinline__ void a_ready(const Unit&) const {}
    __device__ __forceinline__ void done(const Unit&) const {}
};
__device__ __forceinline__ unsigned cvt_pk_bf16(float lo, float hi) { unsigned r; asm volatile("v_cvt_pk_bf16_f32 %0, %1, %2" : "=v"(r) : "v"(lo), "v"(hi)); return r; }
typedef float f32x2 __attribute__((ext_vector_type(2)));
__device__ __forceinline__ f32x2 gelu_pk(f32x2 v) {
    const f32x2 av = __builtin_elementwise_abs(v), d = av * 0.2316418882f + 1.0f;
    f32x2 t; t.x = __builtin_amdgcn_rcpf(d.x); t.y = __builtin_amdgcn_rcpf(d.y);
    f32x2 q = t * 0.5307027145f + (-0.7265760135f); q = q * t + 0.7107068705f; q = q * t + (-0.142248368f); q = q * t + 0.127414796f; q = q * t;
    const f32x2 s = (v * v) * (-0.72134752044f);
    f32x2 e; e.x = __builtin_amdgcn_exp2f(s.x); e.y = __builtin_amdgcn_exp2f(s.y);
    const f32x2 m = v * (q * e), r = v - m;
    f32x2 o; o.x = v.x < 0.f ? m.x : r.x; o.y = v.y < 0.f ? m.y : r.y; return o;
}

template <int ACT  > struct EpiBf16 {
    static constexpr bool PERM = true, AFTER_DRAIN = false; static_assert(ACT == 0 || ACT == 1, "EpiBf16: ACT is 0 (none) or 1 (gelu_pk)");
    bf16_t* O; int ldc; const float* bias; int split_cols; size_t split_stride; float scale0;
    __device__ __forceinline__ void operator()(const f32x4 (&acc)[2][2][4][2], const Unit& u, int wr, int wc, int fr, int fq) const {
        const int row0 = u.pm * BM + wr * 64 + fr; int colt = u.pn * BM; bf16_t* base = O;
        float sc = 1.f; if (split_cols) { const int t = colt / split_cols; base += (size_t)t * split_stride; colt -= t * split_cols; if (t == 0) sc = scale0; }
        const int col0 = colt + wc * 32 + 8 * fq, bcol0 = u.pn * BM + wc * 32 + 8 * fq;
        f32x4 bv[2][2];
#pragma unroll
        for (int bj = 0; bj < 2; ++bj)
#pragma unroll
            for (int n = 0; n < 2; ++n) bv[bj][n] = bias ? *(const f32x4*)(bias + bcol0 + bj * HALF + 4 * n) : (f32x4){0.f, 0.f, 0.f, 0.f};
#pragma unroll
        for (int ai = 0; ai < 2; ++ai)
#pragma unroll
            for (int m = 0; m < 4; ++m) { bf16_t* rowp = base + (size_t)(row0 + ai * HALF + m * 16) * ldc + col0;
#pragma unroll
                for (int bj = 0; bj < 2; ++bj) { f32x4 v0 = acc[ai][bj][m][0] + bv[bj][0], v1 = acc[ai][bj][m][1] + bv[bj][1];
                    if (ACT == 1) { f32x2 a = gelu_pk((f32x2){v0[0], v0[1]}), b = gelu_pk((f32x2){v0[2], v0[3]}), c = gelu_pk((f32x2){v1[0], v1[1]}), d = gelu_pk((f32x2){v1[2], v1[3]});
                        v0 = (f32x4){a.x, a.y, b.x, b.y}; v1 = (f32x4){c.x, c.y, d.x, d.y}; }
                    v0 = v0 * sc; v1 = v1 * sc; u32x4 w; w.x = cvt_pk_bf16(v0[0], v0[1]); w.y = cvt_pk_bf16(v0[2], v0[3]); w.z = cvt_pk_bf16(v1[0], v1[1]); w.w = cvt_pk_bf16(v1[2], v1[3]);
                    *(u32x4*)(rowp + bj * HALF) = w; } }
    }
};

struct EpiF32 {
    static constexpr bool PERM = false, AFTER_DRAIN = false;
    float* C; int ldc;
    __device__ __forceinline__ void operator()(const f32x4 (&acc)[2][2][4][2], const Unit& u, int wr, int wc, int fr, int fq) const {
        const int row0 = u.pm * BM + wr * 64 + fr, col0 = u.pn * BM + wc * 32 + 4 * fq;
#pragma unroll
        for (int ai = 0; ai < 2; ++ai)
#pragma unroll
            for (int m = 0; m < 4; ++m) { float* rowp = C + (size_t)(row0 + ai * HALF + m * 16) * ldc + col0;
#pragma unroll
                for (int bj = 0; bj < 2; ++bj)
#pragma unroll
                    for (int n = 0; n < 2; ++n) *(f32x4*)(rowp + bj * HALF + n * 16) = acc[ai][bj][m][n]; }
    }
};
struct EpiGateRes {
    static constexpr bool PERM = false, AFTER_DRAIN = false;
    const float* base; float* out; int ldc; const float* gate; int set_stride; int rows_per_set; int nsets_lat; int lat_rows;
    __device__ __forceinline__ void operator()(const f32x4 (&acc)[2][2][4][2], const Unit& u, int wr, int wc, int fr, int fq) const {
        const int row0 = u.pm * BM + wr * 64 + fr, col0 = u.pn * BM + wc * 32 + 4 * fq;
        const int set = (u.pm * BM >= lat_rows) ? nsets_lat : (u.pm * BM) / rows_per_set;
        const float* gp = gate + (size_t)set * set_stride + col0;
        f32x4 gv[2][2];
#pragma unroll
        for (int bj = 0; bj < 2; ++bj)
#pragma unroll
            for (int n = 0; n < 2; ++n) gv[bj][n] = *(const f32x4*)(gp + bj * HALF + n * 16);
#pragma unroll
        for (int ai = 0; ai < 2; ++ai)
#pragma unroll
            for (int m = 0; m < 4; ++m) { const size_t off = (size_t)(row0 + ai * HALF + m * 16) * ldc + col0;
#pragma unroll
                for (int bj = 0; bj < 2; ++bj)
#pragma unroll
                    for (int n = 0; n < 2; ++n) { const f32x4 b = *(const f32x4*)(base + off + bj * HALF + n * 16); *(f32x4*)(out + off + bj * HALF + n * 16) = b + gv[bj][n] * acc[ai][bj][m][n]; } }
    }
};

template <class Epi, class Sched, bool ALIGN_EPI = false, bool SP2 = false>
__device__ __forceinline__ void gemm_phase(PG8_LAS unsigned char* lds, const Gemm g, const Sched& S, const Epi& E) {
    const int tid = threadIdx.x, wid = __builtin_amdgcn_readfirstlane(tid >> 6), lane = tid & 63, wr = wid >> 2, wc = wid & 3, fr = lane & 15, fq = lane >> 4;
    const int K = g.K, nt = K / BK;
    unsigned voffA[2], voffB[2];
#pragma unroll
    for (int i = 0; i < 2; ++i) { int R, C; stage_rc(tid * 16 + i * 8192, R, C); const int Rb = Epi::PERM ? ((R & ~31) + perm32(R & 31)) : R;
        voffA[i] = (unsigned)(R * K + C) * 2u; voffB[i] = (unsigned)(Rb * K + C) * 2u; }
    const size_t kstep = (size_t)(BK * 2);
    const size_t hstep = (size_t)HALF * K * 2;
    const size_t tstep = 2 * hstep;
    const unsigned ldsw = (unsigned)wid * 1024u;
    const int aoff = lds_byte(wr * 64 + fr, fq * 8), boff = lds_byte(wc * 32 + fr, fq * 8);
#define PG8_SA(b, h) (((b) * 2 + (h)) * HTB)
#define PG8_SB(b, h) ((4 + (b) * 2 + (h)) * HTB)
#define PG8_STAGE(bufoff, gbase, voff) do { _Pragma("unroll") for (int _i = 0; _i < 2; ++_i) \
        __builtin_amdgcn_global_load_lds((const unsigned*)((const char*)(gbase) + (voff)[_i]), (PG8_LAS unsigned*)(lds + (bufoff) + ldsw + _i * 8192), 16, 0, 0); } while (0)
#define PG8_LDA(dst, b, h) do { _Pragma("unroll") for (int m = 0; m < 4; ++m) _Pragma("unroll") for (int k = 0; k < 2; ++k) dst[m][k] = *(const PG8_LAS bf16x8*)(lds + PG8_SA(b, h) + aoff + m * 2048 + k * 1024); } while (0)
#define PG8_LDB(dst, b, h) do { _Pragma("unroll") for (int n = 0; n < 2; ++n) _Pragma("unroll") for (int k = 0; k < 2; ++k) dst[n][k] = *(const PG8_LAS bf16x8*)(lds + PG8_SB(b, h) + boff + n * 2048 + k * 1024); } while (0)
#define PG8_MMA(ai, bj, At, Bt) do { __builtin_amdgcn_s_setprio(1); _Pragma("unroll") for (int m = 0; m < 4; ++m) _Pragma("unroll") for (int n = 0; n < 2; ++n) _Pragma("unroll") for (int k = 0; k < 2; ++k) \
        acc[ai][bj][m][n] = __builtin_amdgcn_mfma_f32_16x16x32_bf16(Bt[n][k], At[m][k], acc[ai][bj][m][n], 0, 0, 0); __builtin_amdgcn_s_setprio(0); } while (0)
#define PG8_WAIT_V(n) asm volatile("s_waitcnt vmcnt(" #n ")" ::: "memory")
#define PG8_WAIT_L(n) asm volatile("s_waitcnt lgkmcnt(" #n ")" ::: "memory")
#define PG8_BAR __builtin_amdgcn_s_barrier()
#define PG8_SCHED __builtin_amdgcn_sched_barrier(0)
    Unit cur, nxt; int ui = 0;
    if (!S.next(0, cur)) return;
    f32x4 acc[2][2][4][2];
#pragma unroll
    for (int a = 0; a < 2; ++a)
#pragma unroll
        for (int b = 0; b < 2; ++b)
#pragma unroll
            for (int m = 0; m < 4; ++m)
#pragma unroll
                for (int n = 0; n < 2; ++n) acc[a][b][m][n] = (f32x4){0.f, 0.f, 0.f, 0.f};
    bf16x8 At[4][2], B0[2][2], B1[2][2];
    const char* cA = (const char*)g.A + (size_t)cur.pm * tstep; const char* cB = (const char*)g.Bt + (size_t)cur.pn * tstep;
    S.a_ready(cur);
    if constexpr (SP2) {
        PG8_STAGE(PG8_SB(0, 0), cB, voffB); PG8_STAGE(PG8_SB(0, 1), cB + hstep, voffB); PG8_STAGE(PG8_SA(0, 0), cA, voffA); PG8_STAGE(PG8_SA(0, 1), cA + hstep, voffA);
        if (wr == 1) PG8_BAR;
        PG8_WAIT_V(2); PG8_BAR;
        PG8_STAGE(PG8_SB(1, 0), cB + kstep, voffB); PG8_STAGE(PG8_SA(1, 0), cA + kstep, voffA); PG8_STAGE(PG8_SB(1, 1), cB + hstep + kstep, voffB);
        PG8_WAIT_V(6); PG8_BAR;
    } else {
        PG8_STAGE(PG8_SB(0, 0), cB, voffB); PG8_STAGE(PG8_SA(0, 0), cA, voffA); PG8_STAGE(PG8_SB(0, 1), cB + hstep, voffB); PG8_STAGE(PG8_SA(0, 1), cA + hstep, voffA);
        if (wr == 1) PG8_BAR;
        PG8_WAIT_V(4); PG8_BAR;
        PG8_STAGE(PG8_SB(1, 0), cB + kstep, voffB); PG8_STAGE(PG8_SA(1, 0), cA + kstep, voffA); PG8_STAGE(PG8_SB(1, 1), cB + hstep + kstep, voffB);
        PG8_WAIT_V(6); PG8_BAR;
    }
    for (;;) {
        const bool has_next = S.next(ui + 1, nxt);
        const char* nA = has_next ? (const char*)g.A + (size_t)nxt.pm * tstep : cA; const char* nB = has_next ? (const char*)g.Bt + (size_t)nxt.pn * tstep : cB;
        for (int t = 0; t < nt; t += 2) {
            const bool last = (t == nt - 2);
            const char* a1 = cA + (size_t)(t + 1) * kstep;
            const char* a2 = last ? nA : cA + (size_t)(t + 2) * kstep; const char* b2 = last ? nB : cB + (size_t)(t + 2) * kstep;
            const char* a3 = a2 + kstep; const char* b3 = b2 + kstep;
            if (last && has_next) S.a_ready(nxt);
            if constexpr (SP2) {
            PG8_LDB(B0, 0, 0); PG8_LDB(B1, 0, 1); PG8_SCHED; PG8_LDA(At, 0, 0); PG8_STAGE(PG8_SA(1, 1), a1 + hstep, voffA);
            PG8_WAIT_V(8); PG8_WAIT_L(0); PG8_BAR; PG8_MMA(0, 0, At, B0); PG8_MMA(0, 1, At, B1); PG8_BAR; PG8_SCHED;
            PG8_LDA(At, 0, 1); PG8_STAGE(PG8_SB(0, 0), b2, voffB); PG8_STAGE(PG8_SB(0, 1), b2 + hstep, voffB); PG8_STAGE(PG8_SA(0, 0), a2, voffA);
            PG8_WAIT_V(8); PG8_WAIT_L(0); PG8_BAR; PG8_MMA(1, 0, At, B0); PG8_MMA(1, 1, At, B1); PG8_BAR; PG8_SCHED;
            PG8_LDB(B0, 1, 0); PG8_LDB(B1, 1, 1); PG8_SCHED; PG8_LDA(At, 1, 0); PG8_STAGE(PG8_SA(0, 1), a2 + hstep, voffA);
            PG8_WAIT_V(8); PG8_WAIT_L(0); PG8_BAR; PG8_MMA(0, 0, At, B0); PG8_MMA(0, 1, At, B1); PG8_BAR; PG8_SCHED;
            PG8_LDA(At, 1, 1); PG8_STAGE(PG8_SB(1, 0), b3, voffB); PG8_STAGE(PG8_SB(1, 1), b3 + hstep, voffB); PG8_STAGE(PG8_SA(1, 0), a3, voffA);
            PG8_WAIT_V(8); PG8_WAIT_L(0); PG8_BAR; PG8_MMA(1, 0, At, B0); PG8_MMA(1, 1, At, B1); PG8_BAR; PG8_SCHED;
            } else {
            PG8_LDB(B0, 0, 0); PG8_SCHED; PG8_LDA(At, 0, 0); PG8_STAGE(PG8_SA(1, 1), a1 + hstep, voffA);
            PG8_WAIT_L(8); PG8_BAR; PG8_WAIT_L(0); PG8_MMA(0, 0, At, B0); PG8_BAR; PG8_SCHED;
            PG8_LDB(B1, 0, 1); PG8_STAGE(PG8_SB(0, 0), b2, voffB);
            PG8_BAR; PG8_WAIT_L(0); PG8_MMA(0, 1, At, B1); PG8_BAR;
            PG8_LDA(At, 0, 1); PG8_STAGE(PG8_SA(0, 0), a2, voffA);
            PG8_BAR; PG8_WAIT_L(0); PG8_MMA(1, 0, At, B0); PG8_BAR; PG8_SCHED;
            PG8_STAGE(PG8_SB(0, 1), b2 + hstep, voffB);
            PG8_WAIT_V(6); PG8_BAR; PG8_MMA(1, 1, At, B1); PG8_BAR;
            PG8_LDB(B0, 1, 0); PG8_SCHED; PG8_LDA(At, 1, 0); PG8_STAGE(PG8_SA(0, 1), a2 + hstep, voffA);
            PG8_WAIT_L(8); PG8_BAR; PG8_WAIT_L(0); PG8_MMA(0, 0, At, B0); PG8_BAR; PG8_SCHED;
            PG8_LDB(B1, 1, 1); PG8_STAGE(PG8_SB(1, 0), b3, voffB);
            PG8_BAR; PG8_WAIT_L(0); PG8_MMA(0, 1, At, B1); PG8_BAR;
            PG8_LDA(At, 1, 1); PG8_STAGE(PG8_SA(1, 0), a3, voffA);
            PG8_BAR; PG8_WAIT_L(0); PG8_MMA(1, 0, At, B0); PG8_BAR; PG8_SCHED;
            PG8_STAGE(PG8_SB(1, 1), b3 + hstep, voffB);
            PG8_WAIT_V(6); PG8_BAR; PG8_MMA(1, 1, At, B1); PG8_BAR;
            }
        }
        if constexpr (ALIGN_EPI) { if (wr == 0) PG8_BAR; }
        if constexpr (!Epi::AFTER_DRAIN) { E(acc, cur, wr, wc, fr, fq); S.done(cur); }
        if (!has_next) break;
#pragma unroll
        for (int a = 0; a < 2; ++a)
#pragma unroll
            for (int b = 0; b < 2; ++b)
#pragma unroll
                for (int m = 0; m < 4; ++m)
#pragma unroll
                    for (int n = 0; n < 2; ++n) acc[a][b][m][n] = (f32x4){0.f, 0.f, 0.f, 0.f};
        cur = nxt; cA = nA; cB = nB; ++ui;
        if constexpr (ALIGN_EPI) { if (wr == 1) PG8_BAR; }
    }
    PG8_WAIT_V(0);
    if constexpr (!ALIGN_EPI) { if (wr == 0) PG8_BAR; }
    PG8_BAR;
    if constexpr (Epi::AFTER_DRAIN) { E.fused(acc, cur, wr, wc, fr, fq, lds, wid, lane); S.done(cur); }
#undef PG8_SA
#undef PG8_SB
#undef PG8_STAGE
#undef PG8_LDA
#undef PG8_LDB
#undef PG8_MMA
#undef PG8_WAIT_V
#undef PG8_WAIT_L
#undef PG8_BAR
#undef PG8_SCHED
}
}

namespace att {
using bf16x8 = __attribute__((ext_vector_type(8))) short;
using s16x4  = __attribute__((ext_vector_type(4))) short;
using f32x16 = __attribute__((ext_vector_type(16))) float;
using u32x4  = __attribute__((ext_vector_type(4))) unsigned;
constexpr int NW = 8, QBLK = 32, KVBLK = 64, DV = 128;
#define ATT_SBAR() __builtin_amdgcn_sched_barrier(0)
__device__ __forceinline__ int crow(int r, int hi) { return (r & 3) + 8 * (r >> 2) + 4 * hi; }
__device__ __forceinline__ unsigned cvtpk(float lo, float hi) { unsigned r; asm volatile("v_cvt_pk_bf16_f32 %0, %1, %2" : "=v"(r) : "v"(lo), "v"(hi)); return r; }
template <int DQK> __device__ __forceinline__ int kswz(int row, int colB) { return row * (DQK * 2) + (colB ^ ((row & 7) << 4)); }
constexpr float THR = 8.f;

template <int DQK> struct Cfg {
    static constexpr int SHM_V = KVBLK * DV * 2, SHM_K = KVBLK * DQK * 2;
    static constexpr int OFF_V = 0, OFF_K = 2 * SHM_V, OFF_WS = OFF_K + 2 * SHM_K, OFF_BIAS = OFF_WS + NW * 64 * 4, LDS_BYTES = OFF_BIAS + 10240;
    static constexpr int KCH = DQK / 8;
    static constexpr int KLD = (64 * KCH) / 512;
};

struct Job {
    const bf16_t* Q;
    const bf16_t* K;
    const bf16_t* V;
    bf16_t* O;
    int nt;
    int seg0_tiles, row_seg0, row_seg1;
    int R0; int rlo;
};

__device__ __forceinline__ int tile_row(const Job& J, int j) {
    if (j < J.seg0_tiles) return J.row_seg0 + 64 * j;
    int jj = j - J.seg0_tiles; if (jj > 3) jj = 0; return J.row_seg1 + 64 * jj;
}

__device__ __forceinline__ void partialSM(f32x16& p0, f32x16& p1, float& m_reg, float& mn, float& alpha, float C, float thr_raw) {
    float pmax = p0[0];
#pragma unroll
    for (int r = 1; r < 16; ++r) pmax = fmaxf(pmax, p0[r]);
#pragma unroll
    for (int r = 0; r < 16; ++r) pmax = fmaxf(pmax, p1[r]);
    { auto rr = __builtin_amdgcn_permlane32_swap(__float_as_uint(pmax), __float_as_uint(pmax), false, false);
      pmax = fmaxf(__uint_as_float(rr[0]), __uint_as_float(rr[1])); }
    if (__builtin_expect(__all(pmax - m_reg <= thr_raw), 1)) { mn = m_reg; alpha = 1.f; }
    else { mn = fmaxf(m_reg, pmax); alpha = __builtin_amdgcn_exp2f((m_reg - mn) * C); m_reg = mn; }
    const float mnC = -mn * C;
#pragma unroll
    for (int r = 0; r < 16; ++r) p0[r] = fmaf(p0[r], C, mnC);
#pragma unroll
    for (int r = 0; r < 16; ++r) p1[r] = fmaf(p1[r], C, mnC);
#pragma unroll
    for (int r = 0; r < 16; ++r) p0[r] = __builtin_amdgcn_exp2f(p0[r]);
}
__device__ __forceinline__ void finishSM(f32x16& p0, f32x16& p1, float alpha, float& l_reg, bf16x8& pa0, bf16x8& pa1, bf16x8& pa2, bf16x8& pa3) {
#pragma unroll
    for (int r = 0; r < 16; ++r) p1[r] = __builtin_amdgcn_exp2f(p1[r]);
    float ps = 0;
#pragma unroll
    for (int r = 0; r < 16; ++r) ps += p0[r];
#pragma unroll
    for (int r = 0; r < 16; ++r) ps += p1[r];
    { auto rr = __builtin_amdgcn_permlane32_swap(__float_as_uint(ps), __float_as_uint(ps), false, false);
      ps = __uint_as_float(rr[0]) + __uint_as_float(rr[1]); }
    l_reg = l_reg * alpha + ps;
#define ATT_PK4(P, BASE, OUT) do { unsigned a0 = cvtpk(P[BASE + 0], P[BASE + 1]), a1 = cvtpk(P[BASE + 2], P[BASE + 3]);   \
    unsigned b0 = cvtpk(P[BASE + 4], P[BASE + 5]), b1 = cvtpk(P[BASE + 6], P[BASE + 7]);                              \
    auto r0 = __builtin_amdgcn_permlane32_swap(a0, b0, false, false); auto r1 = __builtin_amdgcn_permlane32_swap(a1, b1, false, false); \
    u32x4 w = {r0[0], r1[0], r0[1], r1[1]}; OUT = *reinterpret_cast<bf16x8*>(&w); } while (0)
    ATT_PK4(p0, 0, pa0); ATT_PK4(p0, 8, pa1); ATT_PK4(p1, 0, pa2); ATT_PK4(p1, 8, pa3);
#undef ATT_PK4
}
template <int DQK> __device__ __forceinline__ void qkt(f32x16& p0, f32x16& p1, const char* Ks, const bf16x8* qr, int r32, int hi) {
    p0 = f32x16{}; p1 = f32x16{};
#pragma unroll
    for (int d0 = 0; d0 < DQK / 16; ++d0) { const int cb = (d0 * 16 + hi * 8) * 2;
        const bf16x8 b0 = *reinterpret_cast<const bf16x8*>(Ks + kswz<DQK>(r32, cb));
        const bf16x8 b1 = *reinterpret_cast<const bf16x8*>(Ks + kswz<DQK>(32 + r32, cb));
        p0 = __builtin_amdgcn_mfma_f32_32x32x16_bf16(b0, qr[d0], p0, 0, 0, 0);
        p1 = __builtin_amdgcn_mfma_f32_32x32x16_bf16(b1, qr[d0], p1, 0, 0, 0); }
}
__device__ __forceinline__ int v_st(int k, int c) { const int kk = (k & ~0xC) | ((k & 4) << 1) | ((k & 8) >> 1); return ((kk >> 3) * 4 + (c >> 5)) * 512 + ((kk & 7) * 32 + (c & 31)) * 2; }
__device__ __forceinline__ int v_rd_base(int lane) { return ((lane & 3) << 3) | (((lane >> 2) & 3) << 6) | (((lane >> 4) & 1) << 5) | (((lane >> 5) & 1) << 8); }
constexpr int v_rd_off(int d0, int ks, int half) { return d0 * 512 + ks * 4096 + half * 2048; }
template <int OFF> __device__ __forceinline__ s16x4 tr_read(int vb) { s16x4 r; asm volatile("ds_read_b64_tr_b16 %0, %1 offset:%2" : "=&v"(r) : "v"(vb), "i"(OFF) : "memory"); return r; }
template <int D0> __device__ __forceinline__ void pv_one(f32x16& od, int vb, bf16x8 pa0, bf16x8 pa1, bf16x8 pa2, bf16x8 pa3) {
    const s16x4 l0 = tr_read<v_rd_off(D0, 0, 0)>(vb), h0 = tr_read<v_rd_off(D0, 0, 1)>(vb), l1 = tr_read<v_rd_off(D0, 1, 0)>(vb), h1 = tr_read<v_rd_off(D0, 1, 1)>(vb);
    const s16x4 l2 = tr_read<v_rd_off(D0, 2, 0)>(vb), h2 = tr_read<v_rd_off(D0, 2, 1)>(vb), l3 = tr_read<v_rd_off(D0, 3, 0)>(vb), h3 = tr_read<v_rd_off(D0, 3, 1)>(vb);
    asm volatile("s_waitcnt lgkmcnt(0)" ::: "memory"); ATT_SBAR();
#define ATT_PK(L, H) (bf16x8){L[0], L[1], L[2], L[3], H[0], H[1], H[2], H[3]}
    od = __builtin_amdgcn_mfma_f32_32x32x16_bf16(pa0, ATT_PK(l0, h0), od, 0, 0, 0);
    od = __builtin_amdgcn_mfma_f32_32x32x16_bf16(pa1, ATT_PK(l1, h1), od, 0, 0, 0);
    od = __builtin_amdgcn_mfma_f32_32x32x16_bf16(pa2, ATT_PK(l2, h2), od, 0, 0, 0);
    od = __builtin_amdgcn_mfma_f32_32x32x16_bf16(pa3, ATT_PK(l3, h3), od, 0, 0, 0);
#undef ATT_PK
}
__device__ __forceinline__ void pv_d0(f32x16* o, int vb, bf16x8 pa0, bf16x8 pa1, bf16x8 pa2, bf16x8 pa3) {
    pv_one<0>(o[0], vb, pa0, pa1, pa2, pa3); pv_one<1>(o[1], vb, pa0, pa1, pa2, pa3); pv_one<2>(o[2], vb, pa0, pa1, pa2, pa3); pv_one<3>(o[3], vb, pa0, pa1, pa2, pa3);
}
constexpr int NA_BROW = 160, NA_BORG = 64 + (NA_KW - 1);
__device__ __forceinline__ void na_bias(f32x16& p0, f32x16& p1, const Job& J, int j, int R, int c, int hi, const float* biasq) {
    const int nloc = J.seg0_tiles;
    if (j >= nloc && j < nloc + 4) return;
    const int rr = J.rlo + j; int r0 = R - NA_KH / 2; r0 = r0 < 0 ? 0 : (r0 > ROWS - NA_KH ? ROWS - NA_KH : r0);
    const bool rowok = (j < nloc) && rr >= r0 && rr < r0 + NA_KH;
    if (!rowok) {
#pragma unroll
        for (int r = 0; r < 16; ++r) { p0[r] = -1e30f; p1[r] = -1e30f; }
        return; }
    int c0 = c - NA_KW / 2; c0 = c0 < 0 ? 0 : (c0 > GRID_W - NA_KW ? GRID_W - NA_KW : c0);
    const int dr = rr - R + (NA_KH - 1);
    const float* bl = biasq + dr * NA_BROW + NA_BORG + 4 * hi - c;
    const int vb = 4 * hi - c0;
#pragma unroll
    for (int r = 0; r < 16; ++r) { const int cc = (r & 3) + 8 * (r >> 2);
        p0[r] = ((unsigned)(cc + vb) < (unsigned)NA_KW) ? p0[r] + bl[cc] : -1e30f;
        p1[r] = ((unsigned)(cc + 32 + vb) < (unsigned)NA_KW) ? p1[r] + bl[cc + 32] : -1e30f; }
}

template <int DQK, bool NA, int LDQ, int LDK, int LDV, int LDO>
__device__ __forceinline__ void attn_unit(const Job& J, char* lds, const float scale) {
    using C_ = Cfg<DQK>;
    const int tid = threadIdx.x, wid = tid >> 6, lane = tid & 63, r32 = lane & 31, hi = lane >> 5;
    char* V_lds = lds + C_::OFF_V; char* K_lds = lds + C_::OFF_K;
    float* wsf = (float*)(lds + C_::OFF_WS) + wid * 64; float* li_l = wsf; float* al_l = wsf + 32;
    const float* biasq = (const float*)(lds + C_::OFF_BIAS);
    const float Cc = scale * 1.4426950408889634f, thr_raw = THR / scale;
    float m_reg = -1e5f, l_reg = 0; f32x16 o[4] = {}; bf16x8 qr[DQK / 16];
    const bf16_t* Qw = J.Q + (long)(wid * QBLK + r32) * LDQ + hi * 8;
#pragma unroll
    for (int d0 = 0; d0 < DQK / 16; ++d0) qr[d0] = *reinterpret_cast<const bf16x8*>(Qw + d0 * 16);
    const int naR = J.R0 + (wid >> 1), nac = (wid & 1) * 32 + r32;
    const int sr = tid >> 4, sc = (tid & 15) * 8, vst0 = v_st(sr, sc), vst1 = v_st(32 + sr, sc);
    const int vb0 = (int)(uintptr_t)V_lds + v_rd_base(lane);
    const unsigned voffV = (unsigned)(sr * LDV + sc) * 2u;
    unsigned koff[C_::KLD]; int kst[C_::KLD];
#pragma unroll
    for (int i = 0; i < C_::KLD; ++i) { const int id = tid + 512 * i, kr = id / C_::KCH, kc = id % C_::KCH; koff[i] = (unsigned)(kr * LDK + kc * 8) * 2u; kst[i] = kswz<DQK>(kr, kc * 16); }
    bf16x8 vs0, vs1, ks[C_::KLD];
#define ATT_SLOAD(j) do { const int row0_ = tile_row(J, (j)); const char* vp_ = (const char*)(J.V + (size_t)row0_ * LDV); const char* kp_ = (const char*)(J.K + (size_t)row0_ * LDK); \
        vs0 = *reinterpret_cast<const bf16x8*>(vp_ + voffV); vs1 = *reinterpret_cast<const bf16x8*>(vp_ + voffV + (unsigned)(64 * LDV)); \
        _Pragma("unroll") for (int i_ = 0; i_ < C_::KLD; ++i_) ks[i_] = *reinterpret_cast<const bf16x8*>(kp_ + koff[i_]); } while (0)
#define ATT_SWRITE(b) do { *(bf16x8*)(V_lds + (b) * C_::SHM_V + vst0) = vs0; *(bf16x8*)(V_lds + (b) * C_::SHM_V + vst1) = vs1; \
        _Pragma("unroll") for (int i_ = 0; i_ < C_::KLD; ++i_) *(bf16x8*)(K_lds + (b) * C_::SHM_K + kst[i_]) = ks[i_]; } while (0)
    const int NT = J.nt;
    __syncthreads();
    ATT_SLOAD(0); asm volatile("s_waitcnt vmcnt(0)" ::: "memory"); ATT_SWRITE(0); __syncthreads();
    for (int j = 0; j < NT; ++j) {
        const int buf = j & 1;
        if (j + 1 < NT) ATT_SLOAD(j + 1);
        f32x16 p0, p1; float mn, al; bf16x8 pa0, pa1, pa2, pa3;
        qkt<DQK>(p0, p1, K_lds + buf * C_::SHM_K, qr, r32, hi);
        if (NA) na_bias(p0, p1, J, j, naR, nac, hi, biasq);
        partialSM(p0, p1, m_reg, mn, al, Cc, thr_raw);
        finishSM(p0, p1, al, l_reg, pa0, pa1, pa2, pa3);
        if (__any(al < 1.f)) { if (hi == 0) al_l[r32] = al; asm volatile("s_waitcnt lgkmcnt(0)" ::: "memory");
#pragma unroll
            for (int d = 0; d < 4; ++d)
#pragma unroll
                for (int r = 0; r < 16; ++r) o[d][r] *= al_l[crow(r, hi)]; }
        ATT_SBAR();
        pv_d0(o, vb0 + buf * C_::SHM_V, pa0, pa1, pa2, pa3);
        if (j + 1 < NT) { asm volatile("s_waitcnt vmcnt(0)" ::: "memory"); ATT_SWRITE(buf ^ 1); }
        __syncthreads();
    }
    if (hi == 0) li_l[r32] = l_reg; asm volatile("s_waitcnt lgkmcnt(0)" ::: "memory");
    float rli[16];
#pragma unroll
    for (int r = 0; r < 16; ++r) rli[r] = __builtin_amdgcn_rcpf(li_l[crow(r, hi)]);
    bf16_t* Ow = J.O + (long)(wid * QBLK) * LDO;
#pragma unroll
    for (int r = 0; r < 16; ++r) { const int orow = crow(r, hi);
#pragma unroll
        for (int d0 = 0; d0 < 4; ++d0) Ow[(long)orow * LDO + d0 * 32 + r32] = f2bf(o[d0][r] * rli[r]); }
#undef ATT_SLOAD
#undef ATT_SWRITE
}
}


struct Inputs {
    const float *x, *c, *ctx, *c_ctx, *ada_w, *ada_b, *norm_mix_g, *norm_ffn_g, *w_in, *w_out,
        *lru_conv_w, *lru_conv_b, *lru_wa, *lru_ba, *lru_wx, *lru_bx, *lru_lam,
        *mla_qa_g, *mla_w_uq, *mla_kva_g, *mla_w_ukv, *mla_qn_g, *mla_kn_g,
        *gdn_conv_w, *gdn_a_log, *gdn_dt_bias, *gdn_norm_g, *na_qn_g, *na_kn_g, *na_rpb,
        *ffn_w_up, *ffn_conv_w, *ffn_conv_b, *ffn_w_down;
};
static inline Inputs make_inputs(void* const* d_in) { Inputs I; const float** p = (const float**)&I; for (int i = 0; i < 34; ++i) p[i] = (const float*)d_in[i]; return I; }

constexpr int NQ_MLA = NH * MLA_QK, NKV_MLA = NH * (MLA_NOPE + MLA_V);
struct WS {
    unsigned* ctl;
    float *SC, *MOD, *H;
    bf16_t *U, *Y;
    bf16_t *WIN, *WOUT, *WUP, *WDOWN, *WUQ, *WUKV;
    bf16_t* P; float *LU, *LA, *LB; bf16_t *CQN, *CKVN; float *QR, *KVR; bf16_t *QM, *KM, *VM; float *GC, *GG, *GBt, *GO; bf16_t *NQ, *NK;
    bf16_t *UP, *ACT;
    size_t total;
};
constexpr size_t SZ_WIN = (size_t)NP * D_MODEL, SZ_WOUT = (size_t)D_MODEL * D_MODEL, SZ_WUP = (size_t)2 * D_FF * D_MODEL, SZ_WDOWN = (size_t)D_MODEL * D_FF,
                 SZ_WUQ = (size_t)NQ_MLA * MLA_Q_LORA, SZ_WUKV = (size_t)NKV_MLA * MLA_KV_LORA;
static inline WS ws_carve(void* base) {
    WS w; size_t off = 0; char* b = (char*)base;
    auto take = [&](size_t bytes) { char* p = b + off; off += (bytes + 255) & ~(size_t)255; return p; };
    w.ctl = (unsigned*)take(1 << 20);
    w.SC = (float*)take(sizeof(float) * (BATCH + 1) * D_MODEL);
    w.MOD = (float*)take(sizeof(float) * (size_t)DEPTH * (BATCH + 1) * NMODV);
    w.H = (float*)take(sizeof(float) * (size_t)M_ALL * D_MODEL);
    w.U = (bf16_t*)take(2 * (size_t)M_ALL * D_MODEL);
    w.Y = (bf16_t*)take(2 * (size_t)M_ALL * D_MODEL);
    w.WIN = (bf16_t*)take(2 * SZ_WIN * DEPTH); w.WOUT = (bf16_t*)take(2 * SZ_WOUT * DEPTH); w.WUP = (bf16_t*)take(2 * SZ_WUP * DEPTH); w.WDOWN = (bf16_t*)take(2 * SZ_WDOWN * DEPTH);
    w.WUQ = (bf16_t*)take(2 * SZ_WUQ * DEPTH); w.WUKV = (bf16_t*)take(2 * SZ_WUKV * DEPTH);
    const size_t r0 = off;
    w.P = (bf16_t*)take(2 * (size_t)M_ALL * NP);
    w.LU = (float*)take(4 * (size_t)M_ALL * LRU_W); w.LA = (float*)take(4 * (size_t)2 * M_ALL * LRU_W); w.LB = (float*)take(4 * (size_t)2 * M_ALL * LRU_W);
    w.CQN = (bf16_t*)take(2 * (size_t)M_ALL * MLA_Q_LORA); w.CKVN = (bf16_t*)take(2 * (size_t)M_ALL * MLA_KV_LORA);
    w.QR = (float*)take(4 * (size_t)M_ALL * NQ_MLA); w.KVR = (float*)take(4 * (size_t)M_ALL * NKV_MLA);
    w.QM = (bf16_t*)take(2 * (size_t)M_ALL * NQ_MLA); w.KM = (bf16_t*)take(2 * (size_t)M_ALL * NQ_MLA); w.VM = (bf16_t*)take(2 * (size_t)M_ALL * NH * MLA_V);
    w.GC = (float*)take(4 * (size_t)M_ALL * 3 * GROUP_W); w.GG = (float*)take(4 * (size_t)2 * M_ALL * NH); w.GBt = (float*)take(4 * (size_t)2 * M_ALL * NH);
    w.GO = (float*)take(4 * (size_t)2 * M_ALL * GROUP_W);
    w.NQ = (bf16_t*)take(2 * (size_t)M_ALL * GROUP_W); w.NK = (bf16_t*)take(2 * (size_t)M_ALL * GROUP_W);
    const size_t r1 = off;
    off = r0;
    w.UP = (bf16_t*)take(2 * (size_t)M_ALL * 2 * D_FF); w.ACT = (bf16_t*)take(2 * (size_t)M_ALL * D_FF);
    const size_t f1 = off;
    w.total = r1 > f1 ? r1 : f1;
    return w;
}

void gemm_bf16out(STREAM_T st, const bf16_t* A, const bf16_t* Bt, int M, int N, int K, bf16_t* O, int ldc);
void gemm_f32out(STREAM_T st, const bf16_t* A, const bf16_t* Bt, int M, int N, int K, float* C, int ldc);
void gemm_gate_res(STREAM_T st, const bf16_t* A, const bf16_t* Bt, int M, int N, int K, const float* base, float* out, int ldc, const float* gate  );

#ifdef FAST_ATTN
void fast_attention(STREAM_T st, const WS& w, const float* rpb, bool want_ctx);
#endif
static inline int cdiv(long a, long b) { return (int)((a + b - 1) / b); }
#define L1D(k, total, ...) LAUNCH(k, cdiv((total), 256), 256, st, __VA_ARGS__)

static void run_forward(const Inputs& I, float* d_out, const WS& w, STREAM_T st) {
    L1D(k_silu_c, (long)(BATCH + 1) * D_MODEL, I.c, I.c_ctx, w.SC);
    L1D(k_ada, (long)DEPTH * NMODV, w.SC, I.ada_w, I.ada_b, w.MOD);
    L1D(k_init_h, (long)M_ALL * D_MODEL, I.x, I.ctx, w.H);
    for (int l = 0; l < DEPTH; ++l) {
        L1D(k_convert_w, (long)NP * D_MODEL / 8, I.w_in + (size_t)l * D_MODEL * IN_COLS, w.WIN + l * SZ_WIN, D_MODEL, IN_COLS, NP);
        L1D(k_convert_w, (long)D_MODEL * D_MODEL / 8, I.w_out + (size_t)l * D_MODEL * D_MODEL, w.WOUT + l * SZ_WOUT, D_MODEL, D_MODEL, D_MODEL);
        L1D(k_convert_w, (long)2 * D_FF * D_MODEL / 8, I.ffn_w_up + (size_t)l * D_MODEL * 2 * D_FF, w.WUP + l * SZ_WUP, D_MODEL, 2 * D_FF, 2 * D_FF);
        L1D(k_convert_w, (long)D_MODEL * D_FF / 8, I.ffn_w_down + (size_t)l * D_FF * D_MODEL, w.WDOWN + l * SZ_WDOWN, D_FF, D_MODEL, D_MODEL);
        L1D(k_convert_w, (long)NQ_MLA * MLA_Q_LORA / 8, I.mla_w_uq + (size_t)l * MLA_Q_LORA * NQ_MLA, w.WUQ + l * SZ_WUQ, MLA_Q_LORA, NQ_MLA, NQ_MLA);
        L1D(k_convert_w, (long)NKV_MLA * MLA_KV_LORA / 8, I.mla_w_ukv + (size_t)l * MLA_KV_LORA * NKV_MLA, w.WUKV + l * SZ_WUKV, MLA_KV_LORA, NKV_MLA, NKV_MLA);
    }
    for (int l = 0; l < DEPTH; ++l) {
        const bool want_ctx = l < DEPTH - 1; const int Mo = want_ctx ? M_ALL : M_LAT;
        const float* MODl = w.MOD + (size_t)l * (BATCH + 1) * NMODV;
        L1D(k_norm_mod, M_ALL, w.H, I.norm_mix_g + (size_t)l * D_MODEL, MODl, 0, w.U, M_ALL);
        gemm_bf16out(st, w.U, w.WIN + l * SZ_WIN, M_ALL, NP, D_MODEL, w.P, NP);
        L1D(k_lru_conv, (long)M_ALL * LRU_W, w.P, I.lru_conv_w + (size_t)l * 4 * LRU_W, I.lru_conv_b + (size_t)l * LRU_W, w.LU);
        L1D(k_lru_coef, (long)2 * M_ALL * LRU_W, w.LU, I.lru_wa + (size_t)l * 2 * NH * LRU_BW * LRU_BW, I.lru_ba + (size_t)l * 2 * LRU_W,
            I.lru_wx + (size_t)l * 2 * NH * LRU_BW * LRU_BW, I.lru_bx + (size_t)l * 2 * LRU_W, I.lru_lam + (size_t)l * 2 * LRU_W, w.LA, w.LB);
        L1D(k_lru_scan, (long)BATCH * 2 * LRU_W, w.LA, w.LB);
        L1D(k_lru_fin, (long)M_ALL * LRU_W, w.LB, w.P, w.Y);
        L1D(k_mla_norm1, M_ALL, w.P, I.mla_qa_g + (size_t)l * MLA_Q_LORA, I.mla_kva_g + (size_t)l * MLA_KV_LORA, w.CQN, w.CKVN);
        gemm_f32out(st, w.CQN, w.WUQ + l * SZ_WUQ, M_ALL, NQ_MLA, MLA_Q_LORA, w.QR, NQ_MLA);
        gemm_f32out(st, w.CKVN, w.WUKV + l * SZ_WUKV, M_ALL, NKV_MLA, MLA_KV_LORA, w.KVR, NKV_MLA);
        L1D(k_mla_qkv, (long)M_ALL * NH, w.QR, w.KVR, w.P, I.mla_qn_g + (size_t)l * MLA_QK, I.mla_kn_g + (size_t)l * MLA_QK, w.QM, w.KM, w.VM);
#ifndef FAST_ATTN
        { const float sc = 1.0f / sqrtf((float)MLA_QK);
          LAUNCH((k_attn_dense<MLA_QK, MLA_V>), BATCH * NH * cdiv(SEQ, 128), 256, st, w.QM, w.KM, w.VM, NQ_MLA, NQ_MLA, NH * MLA_V, sc, w.Y, GROUP_W, 0);
          if (want_ctx) LAUNCH((k_attn_dense<MLA_QK, MLA_V>), BATCH * NH * cdiv(CTX_LEN, 128), 256, st, w.QM, w.KM, w.VM, NQ_MLA, NQ_MLA, NH * MLA_V, sc, w.Y, GROUP_W, 1); }
#endif
        L1D(k_gdn_conv, (long)M_ALL * 3 * GROUP_W, w.P, I.gdn_conv_w + (size_t)l * 4 * 3 * GROUP_W, w.GC);
        L1D(k_gdn_norm, (long)M_ALL * NH, w.GC);
        L1D(k_gdn_gates, (long)2 * M_ALL * NH, w.P, I.gdn_a_log + (size_t)l * 2 * NH, I.gdn_dt_bias + (size_t)l * 2 * NH, w.GG, w.GBt);
        LAUNCH(k_gdn_seq, BATCH * NH * 2, HD, st, w.GC, w.GG, w.GBt, w.GO);
        L1D(k_gdn_fin, (long)M_ALL * NH, w.GO, w.P, I.gdn_norm_g + (size_t)l * HD, w.Y);
        L1D(k_na_norm, (long)M_ALL * NH, w.P, I.na_qn_g + (size_t)l * HD, I.na_kn_g + (size_t)l * HD, w.NQ, w.NK);
#ifndef FAST_ATTN
        LAUNCH(k_na_attn, BATCH * NH * (SEQ / 128), 256, st, w.NQ, w.NK, w.P, I.na_rpb + (size_t)l * NH * (2 * NA_KH - 1) * (2 * NA_KW - 1), w.Y);
        if (want_ctx) LAUNCH((k_attn_dense<HD, HD>), BATCH * NH * cdiv(CTX_LEN, 128), 256, st, w.NQ, w.NK, w.P + C_NV, GROUP_W, GROUP_W, NP, 1.0f / sqrtf((float)HD), w.Y, 3 * GROUP_W, 1);
#else
        fast_attention(st, w, I.na_rpb + (size_t)l * NH * (2 * NA_KH - 1) * (2 * NA_KW - 1), want_ctx);
#endif
        gemm_gate_res(st, w.Y, w.WOUT + l * SZ_WOUT, Mo, D_MODEL, D_MODEL, w.H, w.H, D_MODEL, MODl + 2 * D_MODEL);
        L1D(k_norm_mod, Mo, w.H, I.norm_ffn_g + (size_t)l * D_MODEL, MODl, 3, w.U, Mo);
        gemm_bf16out(st, w.U, w.WUP + l * SZ_WUP, Mo, 2 * D_FF, D_MODEL, w.UP, 2 * D_FF);
        L1D(k_ffn_act, (long)Mo * D_FF, w.UP, I.ffn_conv_w + (size_t)l * 3 * 2 * D_FF, I.ffn_conv_b + (size_t)l * 2 * D_FF, w.ACT, Mo);
        gemm_gate_res(st, w.ACT, w.WDOWN + l * SZ_WDOWN, Mo, D_MODEL, D_FF, w.H, want_ctx ? w.H : d_out, D_MODEL, MODl + 5 * D_MODEL);
    }
}

struct AttnArgs { const bf16_t *QM, *KM, *VM, *NQ, *NK, *P; bf16_t* Y; const float* rpb; int want_ctx; int pad; };
__device__ __forceinline__ void attention_phase(const AttnArgs& A, char* lds, int G, int wg) {
    static_assert(GRID_W == 64 && SEQ % 256 == 0 && CTX_LEN == 256 && HD == 128, "attention phase geometry");
    constexpr int NQB = SEQ / 256;
    constexpr float sc_mla = 0.07216878364870323f, sc_na = 0.08838834764831845f;
    static_assert(MLA_QK == 192 && HD == 128, "softmax scales");
    for (int u = wg; u < BATCH * NH * NQB; u += G) {
        const int bh = u % (BATCH * NH), qb = u / (BATCH * NH), b = bh / NH, h = bh % NH;
        att::Job J{};
        J.Q = A.QM + (size_t)(b * SEQ + qb * 256) * NQ_MLA + h * MLA_QK; J.K = A.KM + h * MLA_QK; J.V = A.VM + h * MLA_V;
        J.O = A.Y + (size_t)(b * SEQ + qb * 256) * D_MODEL + GROUP_W + h * MLA_V;
        J.nt = SEQ / 64 + CTX_LEN / 64; J.seg0_tiles = SEQ / 64; J.row_seg0 = b * SEQ; J.row_seg1 = M_LAT + b * CTX_LEN;
        att::attn_unit<MLA_QK, false, NQ_MLA, NQ_MLA, NH * MLA_V, D_MODEL>(J, lds, sc_mla);
    }
    for (int u = wg; u < BATCH * NH * NQB; u += G) {
        const int bh = u % (BATCH * NH), qb = u / (BATCH * NH), b = bh / NH, h = bh % NH, R0 = qb * 4;
        __syncthreads();
        { float* bq = (float*)(lds + att::Cfg<HD>::OFF_BIAS); const float* src = A.rpb + (size_t)h * (2 * NA_KH - 1) * (2 * NA_KW - 1);
          for (int i = threadIdx.x; i < (2 * NA_KH - 1) * att::NA_BROW; i += 512) { const int dr = i / att::NA_BROW; int dc = i % att::NA_BROW - att::NA_BORG + (NA_KW - 1); dc = dc < 0 ? 0 : (dc > 2 * NA_KW - 2 ? 2 * NA_KW - 2 : dc);
              bq[i] = src[dr * (2 * NA_KW - 1) + dc] * 11.313708498984761f; } }
        int rlo = R0 - NA_KH / 2; rlo = rlo < 0 ? 0 : (rlo > ROWS - NA_KH ? ROWS - NA_KH : rlo);
        int rhi = R0 + 3 - NA_KH / 2; rhi = (rhi < 0 ? 0 : (rhi > ROWS - NA_KH ? ROWS - NA_KH : rhi)) + NA_KH - 1;
        const int nloc = rhi - rlo + 1;
        att::Job J{};
        J.Q = A.NQ + (size_t)(b * SEQ + R0 * 64) * GROUP_W + h * HD; J.K = A.NK + h * HD; J.V = A.P + C_NV + h * HD;
        J.O = A.Y + (size_t)(b * SEQ + R0 * 64) * D_MODEL + 3 * GROUP_W + h * HD;
        J.nt = (nloc + 4 + 1) & ~1; J.seg0_tiles = nloc; J.row_seg0 = b * SEQ + rlo * 64; J.row_seg1 = M_LAT + b * CTX_LEN;  J.R0 = R0; J.rlo = rlo;
        att::attn_unit<HD, true, GROUP_W, GROUP_W, NP, D_MODEL>(J, lds, sc_na);
    }
    if (A.want_ctx) {
        for (int u = wg; u < BATCH * NH; u += G) {
            const int b = u / NH, h = u % NH; const int crow0 = M_LAT + b * CTX_LEN;
            att::Job J{}; J.nt = CTX_LEN / 64; J.seg0_tiles = 0; J.row_seg0 = crow0; J.row_seg1 = crow0;
            J.Q = A.QM + (size_t)crow0 * NQ_MLA + h * MLA_QK; J.K = A.KM + h * MLA_QK; J.V = A.VM + h * MLA_V;
            J.O = A.Y + (size_t)crow0 * D_MODEL + GROUP_W + h * MLA_V; att::attn_unit<MLA_QK, false, NQ_MLA, NQ_MLA, NH * MLA_V, D_MODEL>(J, lds, sc_mla);
        }
        for (int u = wg - BATCH * NH; u >= 0 && u < BATCH * NH; u += G) {
            const int b = u / NH, h = u % NH; const int crow0 = M_LAT + b * CTX_LEN;
            att::Job J{}; J.nt = CTX_LEN / 64; J.seg0_tiles = 0; J.row_seg0 = crow0; J.row_seg1 = crow0;
            J.Q = A.NQ + (size_t)crow0 * GROUP_W + h * HD; J.K = A.NK + h * HD; J.V = A.P + C_NV + h * HD;
            J.O = A.Y + (size_t)crow0 * D_MODEL + 3 * GROUP_W + h * HD; att::attn_unit<HD, false, GROUP_W, GROUP_W, NP, D_MODEL>(J, lds, sc_na);
        }
    }
}

template <class Epi> __global__ void __launch_bounds__(512, 2) k_gemm(pg8::Gemm g, Epi E) {
    extern __shared__ __attribute__((aligned(16))) unsigned char shm[];
    pg8::StaticOrder S; S.init(g.M, g.N, (int)gridDim.x, (int)blockIdx.x);
    pg8::gemm_phase<Epi, pg8::StaticOrder, true, true>((PG8_LAS unsigned char*)shm, g, S, E);
}
constexpr int GEMM_LDS = pg8::STAGE_BYTES;
static int g_grid = 0;
template <class Epi> static void gemm_launch(hipStream_t st, const bf16_t* A, const bf16_t* Bt, int M, int N, int K, const Epi& E) {
    static bool attr_done = false;
    if (!attr_done) { (void)hipFuncSetAttribute((const void*)k_gemm<Epi>, hipFuncAttributeMaxDynamicSharedMemorySize, GEMM_LDS); attr_done = true; }
    pg8::Gemm g; memset(&g, 0, sizeof(g)); g.A = A; g.Bt = Bt; g.M = M; g.N = N; g.K = K;
    hipLaunchKernelGGL(k_gemm<Epi>, dim3(g_grid), dim3(512), GEMM_LDS, st, g, E);
}
void gemm_bf16out(STREAM_T st, const bf16_t* A, const bf16_t* Bt, int M, int N, int K, bf16_t* O, int ldc) {
    pg8::EpiBf16<0> E; memset(&E, 0, sizeof(E)); E.O = O; E.ldc = ldc; E.bias = nullptr; E.split_cols = 0; E.split_stride = 0; E.scale0 = 1.0f; gemm_launch(st, A, Bt, M, N, K, E); }
void gemm_f32out(STREAM_T st, const bf16_t* A, const bf16_t* Bt, int M, int N, int K, float* C, int ldc) {
    pg8::EpiF32 E; memset(&E, 0, sizeof(E)); E.C = C; E.ldc = ldc; gemm_launch(st, A, Bt, M, N, K, E); }
void gemm_gate_res(STREAM_T st, const bf16_t* A, const bf16_t* Bt, int M, int N, int K, const float* base, float* out, int ldc, const float* gate) {
    pg8::EpiGateRes E; memset(&E, 0, sizeof(E)); E.base = base; E.out = out; E.ldc = ldc; E.gate = gate; E.set_stride = NMODV; E.rows_per_set = SEQ; E.nsets_lat = BATCH; E.lat_rows = M_LAT; gemm_launch(st, A, Bt, M, N, K, E); }


#ifdef FAST_ATTN
__global__ void __launch_bounds__(512, 2) k_attn_phase(AttnArgs A) {
    extern __shared__ __attribute__((aligned(16))) unsigned char shm[];
    attention_phase(A, (char*)shm, (int)gridDim.x, (int)blockIdx.x);
}
void fast_attention(STREAM_T st, const WS& w, const float* rpb, bool want_ctx) {
    static bool attr_done = false; constexpr int LDSB = att::Cfg<MLA_QK>::LDS_BYTES;
    if (!attr_done) { (void)hipFuncSetAttribute((const void*)k_attn_phase, hipFuncAttributeMaxDynamicSharedMemorySize, LDSB); attr_done = true; }
    AttnArgs A; memset(&A, 0, sizeof(A)); A.QM = w.QM; A.KM = w.KM; A.VM = w.VM; A.NQ = w.NQ; A.NK = w.NK; A.P = w.P; A.Y = w.Y; A.rpb = rpb; A.want_ctx = want_ctx ? 1 : 0;
    hipLaunchKernelGGL(k_attn_phase, dim3(g_grid), dim3(512), LDSB, st, A);
}
#endif

extern "C" void kernel_launch(void* const* d_in, const int* in_sizes, int n_in, void* d_out, int out_size, void* d_ws, size_t ws_size, hipStream_t stream) {
    if (g_grid == 0) { int dev = 0, cus = 0; (void)hipGetDevice(&dev); (void)hipDeviceGetAttribute(&cus, hipDeviceAttributeMultiprocessorCount, dev); g_grid = cus > 0 ? cus : 256; }
    const WS w = ws_carve(d_ws);
    if (n_in != 34 || w.total > ws_size) { fprintf(stderr, "kernel_launch: bad inputs / workspace (need %zu, have %zu)\n", w.total, ws_size); return; }
    const Inputs I = make_inputs(d_in);
    run_forward(I, (float*)d_out, w, stream);
}
```

```cpp
#include <hip/hip_runtime.h>
#include <cstdio>
#include <cstdint>
#include <cstring>
typedef hipStream_t STREAM_T;
#define LAUNCH(k, grid, block, st, ...) hipLaunchKernelGGL(k, dim3(grid), dim3(block), 0, st, __VA_ARGS__)
#define FAST_ATTN 1
#define FAST_GDN 1
#include <math.h>
#include <stdint.h>

#ifdef CFG_SMALL
constexpr int D_MODEL = 256, BATCH = 2, SEQ = 512, DEPTH = 2, CTX_LEN = 64, GRID_W = 32, HEAD_DIM = 16;
#else
constexpr int D_MODEL = 2048, BATCH = 2, SEQ = 8192, DEPTH = 4, CTX_LEN = 256, GRID_W = 64, HEAD_DIM = 128;
#endif
constexpr int GROUP_W = D_MODEL / 4, NH = GROUP_W / HEAD_DIM;
constexpr int HD = HEAD_DIM;
constexpr int N_MOD = 6;
constexpr float EPS = 1e-6f;
constexpr int LRU_W = GROUP_W, LRU_BW = LRU_W / NH;
constexpr float LRU_C = 8.0f;
constexpr int MLA_Q_LORA = 3 * D_MODEL / 16, MLA_KV_LORA = D_MODEL / 8, MLA_NOPE = HD, MLA_ROPE = HD / 2, MLA_V = HD, MLA_QK = MLA_NOPE + MLA_ROPE;
constexpr int GDN_CHUNK = 64;
constexpr int NA_KH = 8, NA_KW = 16;
constexpr int D_FF = 5 * D_MODEL / 2;
constexpr int ROWS = SEQ / GRID_W;
constexpr int C_LRU_X = 0, C_LRU_G = C_LRU_X + LRU_W, C_CQ = C_LRU_G + LRU_W, C_CKV = C_CQ + MLA_Q_LORA, C_KR = C_CKV + MLA_KV_LORA,
              C_GQ = C_KR + MLA_ROPE, C_GK = C_GQ + GROUP_W, C_GV = C_GK + GROUP_W, C_GG = C_GV + GROUP_W, C_GB = C_GG + GROUP_W,
              C_GA = C_GB + 2 * NH, C_NQ = C_GA + 2 * NH, C_NK = C_NQ + GROUP_W, C_NV = C_NK + GROUP_W, IN_COLS = C_NV + GROUP_W;
constexpr int NP = (IN_COLS + 255) / 256 * 256;
constexpr int M_LAT = BATCH * SEQ, M_CTX = BATCH * CTX_LEN, M_ALL = M_LAT + M_CTX;
constexpr int NMODV = N_MOD * D_MODEL;

typedef unsigned short bf16_t;
__host__ __device__ __forceinline__ bf16_t f2bf(float f) { union { float f; unsigned u; } v; v.f = f; unsigned u = v.u; u += 0x7fffu + ((u >> 16) & 1u); return (bf16_t)(u >> 16); }
__host__ __device__ __forceinline__ float bf2f(bf16_t b) { union { float f; unsigned u; } v; v.u = ((unsigned)b) << 16; return v.f; }
__host__ __device__ __forceinline__ float sigmoidf_(float x) { return 1.0f / (1.0f + expf(-x)); }
__host__ __device__ __forceinline__ float siluf_(float x) { return x / (1.0f + expf(-x)); }
__host__ __device__ __forceinline__ float softplusf_(float x) { return fmaxf(x, 0.0f) + log1pf(expf(-fabsf(x))); }
__host__ __device__ __forceinline__ float geluf_(float x) { return 0.5f * x * (1.0f + tanhf(0.7978845608028654f * (x + 0.044715f * x * x * x))); }

struct RowInfo { int b, t, T, base, set; };
__host__ __device__ __forceinline__ RowInfo row_info(int r) {
    RowInfo i;
    if (r < M_LAT) { i.b = r / SEQ; i.t = r % SEQ; i.T = SEQ; i.base = i.b * SEQ; i.set = i.b; }
    else { const int rr = r - M_LAT; i.b = rr / CTX_LEN; i.t = rr % CTX_LEN; i.T = CTX_LEN; i.base = M_LAT + i.b * CTX_LEN; i.set = BATCH; }
    return i;
}

#define GID() ((long)blockIdx.x * blockDim.x + threadIdx.x)

__global__ void k_silu_c(const float* c, const float* c_ctx, float* SC) {
    const long i = GID(); if (i >= (long)(BATCH + 1) * D_MODEL) return;
    const int s = (int)(i / D_MODEL), k = (int)(i % D_MODEL);
    const float v = s < BATCH ? c[s * D_MODEL + k] : c_ctx[k];
    SC[i] = siluf_(v);
}
__global__ void k_ada(const float* SC, const float* ada_w, const float* ada_b, float* MOD) {
    const long i = GID(); if (i >= (long)DEPTH * NMODV) return;
    const int l = (int)(i / NMODV), j = (int)(i % NMODV);
    float acc[BATCH + 1];
    for (int s = 0; s <= BATCH; ++s) acc[s] = 0.f;
    const float* w = ada_w + (size_t)l * D_MODEL * NMODV + j;
    for (int k = 0; k < D_MODEL; ++k) { const float wv = w[(size_t)k * NMODV];
        for (int s = 0; s <= BATCH; ++s) acc[s] += SC[s * D_MODEL + k] * wv; }
    for (int s = 0; s <= BATCH; ++s) MOD[((size_t)l * (BATCH + 1) + s) * NMODV + j] = acc[s] + ada_b[(size_t)l * NMODV + j];
}
__global__ void k_convert_w(const float* W, bf16_t* Wt, int K, int N, int Npad) {
    const long i = GID(); const int K8 = K / 8; if (i >= (long)Npad * K8) return;
    const int k8 = (int)(i / Npad), n = (int)(i % Npad);
    for (int j = 0; j < 8; ++j) { const int k = k8 * 8 + j; Wt[(size_t)n * K + k] = n < N ? f2bf(W[(size_t)k * N + n]) : (bf16_t)0; }
}
__global__ void k_init_h(const float* x, const float* ctx, float* H) {
    const long i = GID(); if (i >= (long)M_ALL * D_MODEL) return;
    H[i] = i < (long)M_LAT * D_MODEL ? x[i] : ctx[i - (long)M_LAT * D_MODEL];
}

__global__ void k_norm_mod(const float* H, const float* g, const float* MODl, int sh_idx, bf16_t* U, int nrows) {
    const long r = GID(); if (r >= nrows) return;
    const RowInfo ri = row_info((int)r);
    const float* h = H + (size_t)r * D_MODEL;
    float ss = 0.f; for (int k = 0; k < D_MODEL; ++k) ss += h[k] * h[k];
    const float rstd = 1.0f / sqrtf(ss / D_MODEL + EPS);
    const float* shift = MODl + (size_t)ri.set * NMODV + (size_t)sh_idx * D_MODEL; const float* scale = shift + D_MODEL;
    for (int k = 0; k < D_MODEL; ++k) U[(size_t)r * D_MODEL + k] = f2bf(h[k] * rstd * g[k] * (1.0f + scale[k]) + shift[k]);
}

__global__ void k_lru_conv(const bf16_t* P, const float* cw, const float* cb, float* LU) {
    const long i = GID(); if (i >= (long)M_ALL * LRU_W) return;
    const int r = (int)(i / LRU_W), ch = (int)(i % LRU_W); const RowInfo ri = row_info(r);
    float acc = cb[ch];
    for (int j = 0; j < 4; ++j) { const int tt = ri.t + j - 1; if (tt >= 0 && tt < ri.T) acc += cw[j * LRU_W + ch] * bf2f(P[(size_t)(ri.base + tt) * NP + C_LRU_X + ch]); }
    LU[i] = acc;
}
__global__ void k_lru_coef(const float* LU, const float* wa, const float* ba, const float* wx, const float* bx, const float* lam, float* LA, float* LB) {
    const long i = GID(); if (i >= (long)2 * M_ALL * LRU_W) return;
    const int d = (int)(i / ((long)M_ALL * LRU_W)); const long rem = i % ((long)M_ALL * LRU_W);
    const int r = (int)(rem / LRU_W), ch = (int)(rem % LRU_W), nb = ch / LRU_BW, e = ch % LRU_BW;
    const float* u = LU + (size_t)r * LRU_W + nb * LRU_BW;
    const float* wap = wa + ((size_t)(d * NH + nb) * LRU_BW) * LRU_BW + e; const float* wxp = wx + ((size_t)(d * NH + nb) * LRU_BW) * LRU_BW + e;
    float za = ba[d * LRU_W + ch], zx = bx[d * LRU_W + ch];
    for (int k = 0; k < LRU_BW; ++k) { const float uv = u[k]; za += uv * wap[(size_t)k * LRU_BW]; zx += uv * wxp[(size_t)k * LRU_BW]; }
    const float rr = sigmoidf_(za), ii = sigmoidf_(zx);
    const float log_a = -LRU_C * rr * softplusf_(-lam[d * LRU_W + ch]);
    LA[i] = expf(log_a);
    LB[i] = sqrtf(-expm1f(2.0f * log_a)) * ii * LU[(size_t)r * LRU_W + ch];
}
__global__ void k_lru_scan(const float* LA, float* LB) {
    const long i = GID(); if (i >= (long)BATCH * 2 * LRU_W) return;
    const int ch = (int)(i % LRU_W), d = (int)((i / LRU_W) % 2), b = (int)(i / (2 * LRU_W));
    float h = 0.f;
    for (int seg = 0; seg < 2; ++seg) {
        const int T = seg == 0 ? CTX_LEN : SEQ, base = seg == 0 ? M_LAT + b * CTX_LEN : b * SEQ;
        for (int s = 0; s < T; ++s) { const int t = d == 0 ? s : T - 1 - s; const size_t idx = ((size_t)d * M_ALL + base + t) * LRU_W + ch;
            h = LA[idx] * h + LB[idx]; LB[idx] = h; }
    }
}
__global__ void k_lru_fin(const float* LB, const bf16_t* P, bf16_t* Y) {
    const long i = GID(); if (i >= (long)M_ALL * LRU_W) return;
    const int r = (int)(i / LRU_W), ch = (int)(i % LRU_W);
    const float h = LB[i] + LB[(size_t)M_ALL * LRU_W + i];
    Y[(size_t)r * D_MODEL + ch] = f2bf(h * geluf_(bf2f(P[(size_t)r * NP + C_LRU_G + ch])));
}

__global__ void k_mla_norm1(const bf16_t* P, const float* qa_g, const float* kva_g, bf16_t* CQN, bf16_t* CKVN) {
    const long r = GID(); if (r >= M_ALL) return;
    const bf16_t* p = P + (size_t)r * NP;
    float ss = 0.f; for (int k = 0; k < MLA_Q_LORA; ++k) { const float v = bf2f(p[C_CQ + k]); ss += v * v; }
    float rstd = 1.0f / sqrtf(ss / MLA_Q_LORA + EPS);
    for (int k = 0; k < MLA_Q_LORA; ++k) CQN[(size_t)r * MLA_Q_LORA + k] = f2bf(bf2f(p[C_CQ + k]) * rstd * qa_g[k]);
    ss = 0.f; for (int k = 0; k < MLA_KV_LORA; ++k) { const float v = bf2f(p[C_CKV + k]); ss += v * v; }
    rstd = 1.0f / sqrtf(ss / MLA_KV_LORA + EPS);
    for (int k = 0; k < MLA_KV_LORA; ++k) CKVN[(size_t)r * MLA_KV_LORA + k] = f2bf(bf2f(p[C_CKV + k]) * rstd * kva_g[k]);
}
__host__ __device__ __forceinline__ void rope_angle(int t, int i, float& cs, float& sn) {
    constexpr int NF = MLA_ROPE / 4;
    const int j = i < NF ? i : i - NF; const float pos = i < NF ? (float)(t / GRID_W) : (float)(t % GRID_W);
    const float inv = powf(10000.0f, -(float)j / (float)NF); const float ang = pos * inv; cs = cosf(ang); sn = sinf(ang);
}
__global__ void k_mla_qkv(const float* QR, const float* KVR, const bf16_t* P, const float* qn_g, const float* kn_g, bf16_t* QM, bf16_t* KM, bf16_t* VM) {
    const long i = GID(); if (i >= (long)M_ALL * NH) return;
    const int r = (int)(i / NH), h = (int)(i % NH); const RowInfo ri = row_info(r); const bool lat = r < M_LAT;
    constexpr int HR = MLA_ROPE / 2;
    for (int which = 0; which < 2; ++which) {
        const float* g = which == 0 ? qn_g : kn_g; bf16_t* O = (which == 0 ? QM : KM) + ((size_t)r * NH + h) * MLA_QK;
        const float* src = which == 0 ? QR + (size_t)r * (NH * MLA_QK) + h * MLA_QK : KVR + (size_t)r * (NH * (MLA_NOPE + MLA_V)) + h * (MLA_NOPE + MLA_V);
        const bf16_t* kr = P + (size_t)r * NP + C_KR;
        float ss = 0.f;
        for (int dd = 0; dd < MLA_QK; ++dd) { const float v = (which == 0 || dd < MLA_NOPE) ? src[dd] : bf2f(kr[dd - MLA_NOPE]); ss += v * v; }
        const float rstd = 1.0f / sqrtf(ss / MLA_QK + EPS);
        for (int dd = 0; dd < MLA_NOPE; ++dd) O[dd] = f2bf(src[dd] * rstd * g[dd]);
        for (int p2 = 0; p2 < HR; ++p2) {
            const int d1 = MLA_NOPE + p2, d2 = MLA_NOPE + HR + p2;
            float x1 = (which == 0 ? src[d1] : bf2f(kr[p2])) * rstd * g[d1], x2 = (which == 0 ? src[d2] : bf2f(kr[HR + p2])) * rstd * g[d2];
            if (lat) { float cs, sn; rope_angle(ri.t, p2, cs, sn); const float y1 = x1 * cs - x2 * sn, y2 = x1 * sn + x2 * cs; x1 = y1; x2 = y2; }
            O[d1] = f2bf(x1); O[d2] = f2bf(x2);
        }
    }
    const float* vs = KVR + (size_t)r * (NH * (MLA_NOPE + MLA_V)) + h * (MLA_NOPE + MLA_V) + MLA_NOPE;
    for (int dd = 0; dd < MLA_V; ++dd) VM[((size_t)r * NH + h) * MLA_V + dd] = f2bf(vs[dd]);
}
__host__ __device__ __forceinline__ float bflo(unsigned w) { union { float f; unsigned u; } v; v.u = w << 16; return v.f; }
__host__ __device__ __forceinline__ float bfhi(unsigned w) { union { float f; unsigned u; } v; v.u = w & 0xffff0000u; return v.f; }
template <int DQ, int DV>
__global__ void __launch_bounds__(256) k_attn_dense(const bf16_t* Q, const bf16_t* K, const bf16_t* V, int ldq, int ldk, int ldv, float scale, bf16_t* Y, int ycol0, int seg) {
    const int Tq = seg == 0 ? SEQ : CTX_LEN; const int nqb = (Tq + 127) / 128;
    const int blk = blockIdx.x, qb = blk % nqb, h = (blk / nqb) % NH, b = blk / (nqb * NH);
    const int ql = threadIdx.x >> 1, half = threadIdx.x & 1; const int tq = qb * 128 + ql; if (tq >= Tq) return;
    const int qrow = seg == 0 ? b * SEQ + tq : M_LAT + b * CTX_LEN + tq;
    constexpr int DH = DV / 2;
    unsigned q[DQ / 2]; { const unsigned* qp = (const unsigned*)(Q + (size_t)qrow * ldq + h * DQ); for (int d = 0; d < DQ / 2; ++d) q[d] = qp[d]; }
    float o[DH]; for (int d = 0; d < DH; ++d) o[d] = 0.f;
    float m = -INFINITY, l = 0.f;
    for (int ks = (seg == 0 ? 0 : 1); ks < 2; ++ks) {
        const int Tk = ks == 0 ? SEQ : CTX_LEN, kbase = ks == 0 ? b * SEQ : M_LAT + b * CTX_LEN;
        for (int j = 0; j < Tk; ++j) {
            const unsigned* kp = (const unsigned*)(K + (size_t)(kbase + j) * ldk + h * DQ); float s = 0.f;
            for (int d = 0; d < DQ / 2; ++d) { const unsigned kw = kp[d]; s += bflo(q[d]) * bflo(kw) + bfhi(q[d]) * bfhi(kw); }
            s *= scale;
            const float mn = fmaxf(m, s), corr = expf(m - mn), p = expf(s - mn);
            l = l * corr + p; const unsigned* vp = (const unsigned*)(V + (size_t)(kbase + j) * ldv + h * DV + half * DH);
            for (int d = 0; d < DH / 2; ++d) { const unsigned vw = vp[d]; o[2 * d] = o[2 * d] * corr + p * bflo(vw); o[2 * d + 1] = o[2 * d + 1] * corr + p * bfhi(vw); }
            m = mn;
        }
    }
    const float il = 1.0f / l;
    for (int d = 0; d < DH; ++d) Y[(size_t)qrow * D_MODEL + ycol0 + h * DV + half * DH + d] = f2bf(o[d] * il);
}

__global__ void k_gdn_conv(const bf16_t* P, const float* cw, float* GC) {
    const long i = GID(); if (i >= (long)M_ALL * 3 * GROUP_W) return;
    const int r = (int)(i / (3 * GROUP_W)), c = (int)(i % (3 * GROUP_W)); const RowInfo ri = row_info(r);
    float acc = 0.f;
    for (int j = 0; j < 4; ++j) { const int tt = ri.t + j - 1; if (tt >= 0 && tt < ri.T) acc += cw[j * 3 * GROUP_W + c] * bf2f(P[(size_t)(ri.base + tt) * NP + C_GQ + c]); }
    GC[i] = siluf_(acc);
}
__global__ void k_gdn_norm(float* GC) {
    const long i = GID(); if (i >= (long)M_ALL * NH) return;
    const int r = (int)(i / NH), h = (int)(i % NH);
    for (int which = 0; which < 2; ++which) { float* p = GC + (size_t)r * 3 * GROUP_W + which * GROUP_W + h * HD;
        float ss = 0.f; for (int d = 0; d < HD; ++d) ss += p[d] * p[d];
        const float sc = (1.0f / sqrtf(ss + EPS)) * (which == 0 ? 1.0f / sqrtf((float)HD) : 1.0f);
        for (int d = 0; d < HD; ++d) p[d] *= sc; }
}
__global__ void k_gdn_gates(const bf16_t* P, const float* a_log, const float* dt_bias, float* GG, float* GBt) {
    const long i = GID(); if (i >= (long)2 * M_ALL * NH) return;
    const int d = (int)(i / ((long)M_ALL * NH)); const long rem = i % ((long)M_ALL * NH); const int r = (int)(rem / NH), h = (int)(rem % NH);
    GBt[i] = sigmoidf_(bf2f(P[(size_t)r * NP + C_GB + d * NH + h]));
    GG[i] = -expf(a_log[d * NH + h]) * softplusf_(bf2f(P[(size_t)r * NP + C_GA + d * NH + h]) + dt_bias[d * NH + h]);
}
__global__ void __launch_bounds__(HD) k_gdn_seq(const float* GC, const float* GG, const float* GBt, float* GO) {
    const int blk = blockIdx.x, d = blk % 2, h = (blk / 2) % NH, b = blk / (2 * NH), vc = threadIdx.x;
    float S[HD]; for (int k = 0; k < HD; ++k) S[k] = 0.f;
    for (int seg = 0; seg < 2; ++seg) {
        const int T = seg == 0 ? CTX_LEN : SEQ, base = seg == 0 ? M_LAT + b * CTX_LEN : b * SEQ;
        for (int s = 0; s < T; ++s) { const int t = d == 0 ? s : T - 1 - s, r = base + t;
            const float* qp = GC + (size_t)r * 3 * GROUP_W + h * HD; const float* kp = qp + GROUP_W; const float v = qp[2 * GROUP_W + vc];
            const float g = GG[((size_t)d * M_ALL + r) * NH + h], beta = GBt[((size_t)d * M_ALL + r) * NH + h];
            const float eg = expf(g); float kS = 0.f;
            for (int k = 0; k < HD; ++k) { S[k] *= eg; kS += kp[k] * S[k]; }
            const float vn = beta * (v - kS); float o = 0.f;
            for (int k = 0; k < HD; ++k) { S[k] += kp[k] * vn; o += qp[k] * S[k]; }
            GO[((size_t)d * M_ALL + r) * GROUP_W + h * HD + vc] = o; }
    }
}
__global__ void k_gdn_fin(const float* GO, const bf16_t* P, const float* norm_g, bf16_t* Y) {
    const long i = GID(); if (i >= (long)M_ALL * NH) return;
    const int r = (int)(i / NH), h = (int)(i % NH);
    const float* o0 = GO + (size_t)r * GROUP_W + h * HD; const float* o1 = o0 + (size_t)M_ALL * GROUP_W;
    float ss = 0.f; for (int v = 0; v < HD; ++v) { const float o = o0[v] + o1[v]; ss += o * o; }
    const float rstd = 1.0f / sqrtf(ss / HD + EPS);
    for (int v = 0; v < HD; ++v) Y[(size_t)r * D_MODEL + 2 * GROUP_W + h * HD + v] = f2bf((o0[v] + o1[v]) * rstd * norm_g[v] * siluf_(bf2f(P[(size_t)r * NP + C_GG + h * HD + v])));
}

__global__ void k_na_norm(const bf16_t* P, const float* qn_g, const float* kn_g, bf16_t* NQ, bf16_t* NK) {
    const long i = GID(); if (i >= (long)M_ALL * NH) return;
    const int r = (int)(i / NH), h = (int)(i % NH);
    for (int which = 0; which < 2; ++which) { const bf16_t* p = P + (size_t)r * NP + (which == 0 ? C_NQ : C_NK) + h * HD; const float* g = which == 0 ? qn_g : kn_g;
        bf16_t* O = (which == 0 ? NQ : NK) + (size_t)r * GROUP_W + h * HD;
        float ss = 0.f; for (int d = 0; d < HD; ++d) { const float v = bf2f(p[d]); ss += v * v; }
        const float rstd = 1.0f / sqrtf(ss / HD + EPS);
        for (int d = 0; d < HD; ++d) O[d] = f2bf(bf2f(p[d]) * rstd * g[d]); }
}
__global__ void __launch_bounds__(256) k_na_attn(const bf16_t* NQ, const bf16_t* NK, const bf16_t* P, const float* rpb, bf16_t* Y) {
    const int nqb = SEQ / 128; const int blk = blockIdx.x, qb = blk % nqb, h = (blk / nqb) % NH, b = blk / (nqb * NH);
    const int ql = threadIdx.x >> 1, half = threadIdx.x & 1, tq = qb * 128 + ql, qrow = b * SEQ + tq;
    constexpr int DH = HD / 2; const float scale = 1.0f / sqrtf((float)HD);
    unsigned q[HD / 2]; { const unsigned* qp = (const unsigned*)(NQ + (size_t)qrow * GROUP_W + h * HD); for (int d = 0; d < HD / 2; ++d) q[d] = qp[d]; }
    float o[DH]; for (int d = 0; d < DH; ++d) o[d] = 0.f;
    float m = -INFINITY, l = 0.f;
    const int r = tq / GRID_W, c = tq % GRID_W; constexpr int kh = NA_KH < ROWS ? NA_KH : ROWS;
    int r0 = r - kh / 2; r0 = r0 < 0 ? 0 : (r0 > ROWS - kh ? ROWS - kh : r0);
    int c0 = c - NA_KW / 2; c0 = c0 < 0 ? 0 : (c0 > GRID_W - NA_KW ? GRID_W - NA_KW : c0);
    const int nloc = kh * NA_KW;
    for (int j = 0; j < nloc + CTX_LEN; ++j) {
        int krow; float bias = 0.f;
        if (j < nloc) { const int rr = r0 + j / NA_KW, cc = c0 + j % NA_KW; krow = b * SEQ + rr * GRID_W + cc;
            const int dr = rr - r + (NA_KH - 1); int dc = cc - c + (NA_KW - 1); dc = dc < 0 ? 0 : (dc > 2 * NA_KW - 2 ? 2 * NA_KW - 2 : dc);
            bias = rpb[((size_t)h * (2 * NA_KH - 1) + dr) * (2 * NA_KW - 1) + dc]; }
        else krow = M_LAT + b * CTX_LEN + (j - nloc);
        const unsigned* kp = (const unsigned*)(NK + (size_t)krow * GROUP_W + h * HD); float s = 0.f;
        for (int d = 0; d < HD / 2; ++d) { const unsigned kw = kp[d]; s += bflo(q[d]) * bflo(kw) + bfhi(q[d]) * bfhi(kw); }
        s = s * scale + bias;
        const float mn = fmaxf(m, s), corr = expf(m - mn), p = expf(s - mn);
        l = l * corr + p; const unsigned* vp = (const unsigned*)(P + (size_t)krow * NP + C_NV + h * HD + half * DH);
        for (int d = 0; d < DH / 2; ++d) { const unsigned vw = vp[d]; o[2 * d] = o[2 * d] * corr + p * bflo(vw); o[2 * d + 1] = o[2 * d + 1] * corr + p * bfhi(vw); }
        m = mn; }
    const float il = 1.0f / l;
    for (int d = 0; d < DH; ++d) Y[(size_t)qrow * D_MODEL + 3 * GROUP_W + h * HD + half * DH + d] = f2bf(o[d] * il);
}

__global__ void k_ffn_act(const bf16_t* UP, const float* cw, const float* cb, bf16_t* ACT, int nrows) {
    const long i = GID(); if (i >= (long)nrows * D_FF) return;
    const int r = (int)(i / D_FF), j = (int)(i % D_FF); const RowInfo ri = row_info(r);
    float a = cb[j], g = cb[D_FF + j];
    for (int k = 0; k < 3; ++k) { const int tt = ri.t + k - 1; if (tt >= 0 && tt < ri.T) { const bf16_t* u = UP + (size_t)(ri.base + tt) * (2 * D_FF);
        a += cw[k * 2 * D_FF + j] * bf2f(u[j]); g += cw[k * 2 * D_FF + D_FF + j] * bf2f(u[D_FF + j]); } }
    ACT[i] = f2bf(a * siluf_(g));
}

namespace pg8 {
#define PG8_LAS __attribute__((address_space(3)))
typedef unsigned short bf16_t;
typedef short bf16x8 __attribute__((ext_vector_type(8)));
typedef float f32x4 __attribute__((ext_vector_type(4)));
typedef unsigned u32x4 __attribute__((ext_vector_type(4)));
constexpr int BM = 256, BK = 64, HALF = 128, HTB = HALF * BK * 2  , STAGE_BYTES = 8 * HTB, NXCD = 8, WGM = 8;

__host__ __device__ __forceinline__ int lds_byte(int r, int c) { const int st = (r >> 4) * 2 + (c >> 5), rr = r & 15, cc = c & 31, ob = rr * 64 + cc * 2; return st * 1024 + (ob ^ (((ob >> 9) & 1) << 5)); }
__host__ __device__ __forceinline__ void stage_rc(int b, int& R, int& C) { const int st = b / 1024, sb = b % 1024, swz = sb ^ (((sb >> 9) & 1) << 5); R = (st >> 1) * 16 + swz / 64; C = (st & 1) * 32 + (swz % 64) / 2; }
__host__ __device__ __forceinline__ int perm32(int rho) { const int n = rho >> 4, i = rho & 15; return 8 * (i >> 2) + 4 * n + (i & 3); }

struct Unit { int pm, pn; };
struct Gemm { const bf16_t* A; const bf16_t* Bt; int M, N, K; };

struct StaticOrder {
    int nM, nN, nwg, G, c;
    __host__ __device__ void init(int M, int N, int G_, int c_) { nM = M / BM; nN = N / BM; nwg = nM * nN; G = G_; c = c_; }
    __host__ __device__ bool next(int i, Unit& u) const {
        const long L = (long)i * G + c; if (L >= nwg) return false;
        int wgid = (int)L; { const int q = nwg / NXCD, r = nwg % NXCD, xcd = wgid % NXCD, off = wgid / NXCD; wgid = (xcd < r ? xcd * (q + 1) : r * (q + 1) + (xcd - r) * q) + off; }
        const int nig = WGM * nN, gid = wgid / nig, fm = gid * WGM, gsz = (nM - fm) < WGM ? (nM - fm) : WGM;
        u.pm = fm + ((wgid % nig) % gsz); u.pn = (wgid % nig) / gsz; return true;
    }
    __device__ __forceinline__ void a_ready(const Unit&) const {}
    __device__ __forceinline__ void done(const Unit&) const {}
};
__device__ __forceinline__ unsigned cvt_pk_bf16(float lo, float hi) { unsigned r; asm volatile("v_cvt_pk_bf16_f32 %0, %1, %2" : "=v"(r) : "v"(lo), "v"(hi)); return r; }
typedef float f32x2 __attribute__((ext_vector_type(2)));
__device__ __forceinline__ f32x2 gelu_pk(f32x2 v) {
    const f32x2 av = __builtin_elementwise_abs(v), d = av * 0.2316418882f + 1.0f;
    f32x2 t; t.x = __builtin_amdgcn_rcpf(d.x); t.y = __builtin_amdgcn_rcpf(d.y);
    f32x2 q = t * 0.5307027145f + (-0.7265760135f); q = q * t + 0.7107068705f; q = q * t + (-0.142248368f); q = q * t + 0.127414796f; q = q * t;
    const f32x2 s = (v * v) * (-0.72134752044f);
    f32x2 e; e.x = __builtin_amdgcn_exp2f(s.x); e.y = __builtin_amdgcn_exp2f(s.y);
    const f32x2 m = v * (q * e), r = v - m;
    f32x2 o; o.x = v.x < 0.f ? m.x : r.x; o.y = v.y < 0.f ? m.y : r.y; return o;
}

template <int ACT  > struct EpiBf16 {
    static constexpr bool PERM = true, AFTER_DRAIN = false; static_assert(ACT == 0 || ACT == 1, "EpiBf16: ACT is 0 (none) or 1 (gelu_pk)");
    bf16_t* O; int ldc; const float* bias; int split_cols; size_t split_stride; float scale0;
    __device__ __forceinline__ void operator()(const f32x4 (&acc)[2][2][4][2], const Unit& u, int wr, int wc, int fr, int fq) const {
        const int row0 = u.pm * BM + wr * 64 + fr; int colt = u.pn * BM; bf16_t* base = O;
        float sc = 1.f; if (split_cols) { const int t = colt / split_cols; base += (size_t)t * split_stride; colt -= t * split_cols; if (t == 0) sc = scale0; }
        const int col0 = colt + wc * 32 + 8 * fq, bcol0 = u.pn * BM + wc * 32 + 8 * fq;
        f32x4 bv[2][2];
#pragma unroll
        for (int bj = 0; bj < 2; ++bj)
#pragma unroll
            for (int n = 0; n < 2; ++n) bv[bj][n] = bias ? *(const f32x4*)(bias + bcol0 + bj * HALF + 4 * n) : (f32x4){0.f, 0.f, 0.f, 0.f};
#pragma unroll
        for (int ai = 0; ai < 2; ++ai)
#pragma unroll
            for (int m = 0; m < 4; ++m) { bf16_t* rowp = base + (size_t)(row0 + ai * HALF + m * 16) * ldc + col0;
#pragma unroll
                for (int bj = 0; bj < 2; ++bj) { f32x4 v0 = acc[ai][bj][m][0] + bv[bj][0], v1 = acc[ai][bj][m][1] + bv[bj][1];
                    if (ACT == 1) { f32x2 a = gelu_pk((f32x2){v0[0], v0[1]}), b = gelu_pk((f32x2){v0[2], v0[3]}), c = gelu_pk((f32x2){v1[0], v1[1]}), d = gelu_pk((f32x2){v1[2], v1[3]});
                        v0 = (f32x4){a.x, a.y, b.x, b.y}; v1 = (f32x4){c.x, c.y, d.x, d.y}; }
                    v0 = v0 * sc; v1 = v1 * sc; u32x4 w; w.x = cvt_pk_bf16(v0[0], v0[1]); w.y = cvt_pk_bf16(v0[2], v0[3]); w.z = cvt_pk_bf16(v1[0], v1[1]); w.w = cvt_pk_bf16(v1[2], v1[3]);
                    *(u32x4*)(rowp + bj * HALF) = w; } }
    }
};

struct EpiF32 {
    static constexpr bool PERM = false, AFTER_DRAIN = false;
    float* C; int ldc;
    __device__ __forceinline__ void operator()(const f32x4 (&acc)[2][2][4][2], const Unit& u, int wr, int wc, int fr, int fq) const {
        const int row0 = u.pm * BM + wr * 64 + fr, col0 = u.pn * BM + wc * 32 + 4 * fq;
#pragma unroll
        for (int ai = 0; ai < 2; ++ai)
#pragma unroll
            for (int m = 0; m < 4; ++m) { float* rowp = C + (size_t)(row0 + ai * HALF + m * 16) * ldc + col0;
#pragma unroll
                for (int bj = 0; bj < 2; ++bj)
#pragma unroll
                    for (int n = 0; n < 2; ++n) *(f32x4*)(rowp + bj * HALF + n * 16) = acc[ai][bj][m][n]; }
    }
};
struct EpiGateRes {
    static constexpr bool PERM = false, AFTER_DRAIN = false;
    const float* base; float* out; int ldc; const float* gate; int set_stride; int rows_per_set; int nsets_lat; int lat_rows;
    __device__ __forceinline__ void operator()(const f32x4 (&acc)[2][2][4][2], const Unit& u, int wr, int wc, int fr, int fq) const {
        const int row0 = u.pm * BM + wr * 64 + fr, col0 = u.pn * BM + wc * 32 + 4 * fq;
        const int set = (u.pm * BM >= lat_rows) ? nsets_lat : (u.pm * BM) / rows_per_set;
        const float* gp = gate + (size_t)set * set_stride + col0;
        f32x4 gv[2][2];
#pragma unroll
        for (int bj = 0; bj < 2; ++bj)
#pragma unroll
            for (int n = 0; n < 2; ++n) gv[bj][n] = *(const f32x4*)(gp + bj * HALF + n * 16);
#pragma unroll
        for (int ai = 0; ai < 2; ++ai)
#pragma unroll
            for (int m = 0; m < 4; ++m) { const size_t off = (size_t)(row0 + ai * HALF + m * 16) * ldc + col0;
#pragma unroll
                for (int bj = 0; bj < 2; ++bj)
#pragma unroll
                    for (int n = 0; n < 2; ++n) { const f32x4 b = *(const f32x4*)(base + off + bj * HALF + n * 16); *(f32x4*)(out + off + bj * HALF + n * 16) = b + gv[bj][n] * acc[ai][bj][m][n]; } }
    }
};

template <class Epi, class Sched, bool ALIGN_EPI = false, bool SP2 = false>
__device__ __forceinline__ void gemm_phase(PG8_LAS unsigned char* lds, const Gemm g, const Sched& S, const Epi& E) {
    const int tid = threadIdx.x, wid = __builtin_amdgcn_readfirstlane(tid >> 6), lane = tid & 63, wr = wid >> 2, wc = wid & 3, fr = lane & 15, fq = lane >> 4;
    const int K = g.K, nt = K / BK;
    unsigned voffA[2], voffB[2];
#pragma unroll
    for (int i = 0; i < 2; ++i) { int R, C; stage_rc(tid * 16 + i * 8192, R, C); const int Rb = Epi::PERM ? ((R & ~31) + perm32(R & 31)) : R;
        voffA[i] = (unsigned)(R * K + C) * 2u; voffB[i] = (unsigned)(Rb * K + C) * 2u; }
    const size_t kstep = (size_t)(BK * 2);
    const size_t hstep = (size_t)HALF * K * 2;
    const size_t tstep = 2 * hstep;
    const unsigned ldsw = (unsigned)wid * 1024u;
    const int aoff = lds_byte(wr * 64 + fr, fq * 8), boff = lds_byte(wc * 32 + fr, fq * 8);
#define PG8_SA(b, h) (((b) * 2 + (h)) * HTB)
#define PG8_SB(b, h) ((4 + (b) * 2 + (h)) * HTB)
#define PG8_STAGE(bufoff, gbase, voff) do { _Pragma("unroll") for (int _i = 0; _i < 2; ++_i) \
        __builtin_amdgcn_global_load_lds((const unsigned*)((const char*)(gbase) + (voff)[_i]), (PG8_LAS unsigned*)(lds + (bufoff) + ldsw + _i * 8192), 16, 0, 0); } while (0)
#define PG8_LDA(dst, b, h) do { _Pragma("unroll") for (int m = 0; m < 4; ++m) _Pragma("unroll") for (int k = 0; k < 2; ++k) dst[m][k] = *(const PG8_LAS bf16x8*)(lds + PG8_SA(b, h) + aoff + m * 2048 + k * 1024); } while (0)
#define PG8_LDB(dst, b, h) do { _Pragma("unroll") for (int n = 0; n < 2; ++n) _Pragma("unroll") for (int k = 0; k < 2; ++k) dst[n][k] = *(const PG8_LAS bf16x8*)(lds + PG8_SB(b, h) + boff + n * 2048 + k * 1024); } while (0)
#define PG8_MMA(ai, bj, At, Bt) do { __builtin_amdgcn_s_setprio(1); _Pragma("unroll") for (int m = 0; m < 4; ++m) _Pragma("unroll") for (int n = 0; n < 2; ++n) _Pragma("unroll") for (int k = 0; k < 2; ++k) \
        acc[ai][bj][m][n] = __builtin_amdgcn_mfma_f32_16x16x32_bf16(Bt[n][k], At[m][k], acc[ai][bj][m][n], 0, 0, 0); __builtin_amdgcn_s_setprio(0); } while (0)
#define PG8_WAIT_V(n) asm volatile("s_waitcnt vmcnt(" #n ")" ::: "memory")
#define PG8_WAIT_L(n) asm volatile("s_waitcnt lgkmcnt(" #n ")" ::: "memory")
#define PG8_BAR __builtin_amdgcn_s_barrier()
#define PG8_SCHED __builtin_amdgcn_sched_barrier(0)
    Unit cur, nxt; int ui = 0;
    if (!S.next(0, cur)) return;
    f32x4 acc[2][2][4][2];
#pragma unroll
    for (int a = 0; a < 2; ++a)
#pragma unroll
        for (int b = 0; b < 2; ++b)
#pragma unroll
            for (int m = 0; m < 4; ++m)
#pragma unroll
                for (int n = 0; n < 2; ++n) acc[a][b][m][n] = (f32x4){0.f, 0.f, 0.f, 0.f};
    bf16x8 At[4][2], B0[2][2], B1[2][2];
    const char* cA = (const char*)g.A + (size_t)cur.pm * tstep; const char* cB = (const char*)g.Bt + (size_t)cur.pn * tstep;
    S.a_ready(cur);
    if constexpr (SP2) {
        PG8_STAGE(PG8_SB(0, 0), cB, voffB); PG8_STAGE(PG8_SB(0, 1), cB + hstep, voffB); PG8_STAGE(PG8_SA(0, 0), cA, voffA); PG8_STAGE(PG8_SA(0, 1), cA + hstep, voffA);
        if (wr == 1) PG8_BAR;
        PG8_WAIT_V(2); PG8_BAR;
        PG8_STAGE(PG8_SB(1, 0), cB + kstep, voffB); PG8_STAGE(PG8_SA(1, 0), cA + kstep, voffA); PG8_STAGE(PG8_SB(1, 1), cB + hstep + kstep, voffB);
        PG8_WAIT_V(6); PG8_BAR;
    } else {
        PG8_STAGE(PG8_SB(0, 0), cB, voffB); PG8_STAGE(PG8_SA(0, 0), cA, voffA); PG8_STAGE(PG8_SB(0, 1), cB + hstep, voffB); PG8_STAGE(PG8_SA(0, 1), cA + hstep, voffA);
        if (wr == 1) PG8_BAR;
        PG8_WAIT_V(4); PG8_BAR;
        PG8_STAGE(PG8_SB(1, 0), cB + kstep, voffB); PG8_STAGE(PG8_SA(1, 0), cA + kstep, voffA); PG8_STAGE(PG8_SB(1, 1), cB + hstep + kstep, voffB);
        PG8_WAIT_V(6); PG8_BAR;
    }
    for (;;) {
        const bool has_next = S.next(ui + 1, nxt);
        const char* nA = has_next ? (const char*)g.A + (size_t)nxt.pm * tstep : cA; const char* nB = has_next ? (const char*)g.Bt + (size_t)nxt.pn * tstep : cB;
        for (int t = 0; t < nt; t += 2) {
            const bool last = (t == nt - 2);
            const char* a1 = cA + (size_t)(t + 1) * kstep;
            const char* a2 = last ? nA : cA + (size_t)(t + 2) * kstep; const char* b2 = last ? nB : cB + (size_t)(t + 2) * kstep;
            const char* a3 = a2 + kstep; const char* b3 = b2 + kstep;
            if (last && has_next) S.a_ready(nxt);
            if constexpr (SP2) {
            PG8_LDB(B0, 0, 0); PG8_LDB(B1, 0, 1); PG8_SCHED; PG8_LDA(At, 0, 0); PG8_STAGE(PG8_SA(1, 1), a1 + hstep, voffA);
            PG8_WAIT_V(8); PG8_WAIT_L(0); PG8_BAR; PG8_MMA(0, 0, At, B0); PG8_MMA(0, 1, At, B1); PG8_BAR; PG8_SCHED;
            PG8_LDA(At, 0, 1); PG8_STAGE(PG8_SB(0, 0), b2, voffB); PG8_STAGE(PG8_SB(0, 1), b2 + hstep, voffB); PG8_STAGE(PG8_SA(0, 0), a2, voffA);
            PG8_WAIT_V(8); PG8_WAIT_L(0); PG8_BAR; PG8_MMA(1, 0, At, B0); PG8_MMA(1, 1, At, B1); PG8_BAR; PG8_SCHED;
            PG8_LDB(B0, 1, 0); PG8_LDB(B1, 1, 1); PG8_SCHED; PG8_LDA(At, 1, 0); PG8_STAGE(PG8_SA(0, 1), a2 + hstep, voffA);
            PG8_WAIT_V(8); PG8_WAIT_L(0); PG8_BAR; PG8_MMA(0, 0, At, B0); PG8_MMA(0, 1, At, B1); PG8_BAR; PG8_SCHED;
            PG8_LDA(At, 1, 1); PG8_STAGE(PG8_SB(1, 0), b3, voffB); PG8_STAGE(PG8_SB(1, 1), b3 + hstep, voffB); PG8_STAGE(PG8_SA(1, 0), a3, voffA);
            PG8_WAIT_V(8); PG8_WAIT_L(0); PG8_BAR; PG8_MMA(1, 0, At, B0); PG8_MMA(1, 1, At, B1); PG8_BAR; PG8_SCHED;
            } else {
            PG8_LDB(B0, 0, 0); PG8_SCHED; PG8_LDA(At, 0, 0); PG8_STAGE(PG8_SA(1, 1), a1 + hstep, voffA);
            PG8_WAIT_L(8); PG8_BAR; PG8_WAIT_L(0); PG8_MMA(0, 0, At, B0); PG8_BAR; PG8_SCHED;
            PG8_LDB(B1, 0, 1); PG8_STAGE(PG8_SB(0, 0), b2, voffB);
            PG8_BAR; PG8_WAIT_L(0); PG8_MMA(0, 1, At, B1); PG8_BAR;
            PG8_LDA(At, 0, 1); PG8_STAGE(PG8_SA(0, 0), a2, voffA);
            PG8_BAR; PG8_WAIT_L(0); PG8_MMA(1, 0, At, B0); PG8_BAR; PG8_SCHED;
            PG8_STAGE(PG8_SB(0, 1), b2 + hstep, voffB);
            PG8_WAIT_V(6); PG8_BAR; PG8_MMA(1, 1, At, B1); PG8_BAR;
            PG8_LDB(B0, 1, 0); PG8_SCHED; PG8_LDA(At, 1, 0); PG8_STAGE(PG8_SA(0, 1), a2 + hstep, voffA);
            PG8_WAIT_L(8); PG8_BAR; PG8_WAIT_L(0); PG8_MMA(0, 0, At, B0); PG8_BAR; PG8_SCHED;
            PG8_LDB(B1, 1, 1); PG8_STAGE(PG8_SB(1, 0), b3, voffB);
            PG8_BAR; PG8_WAIT_L(0); PG8_MMA(0, 1, At, B1); PG8_BAR;
            PG8_LDA(At, 1, 1); PG8_STAGE(PG8_SA(1, 0), a3, voffA);
            PG8_BAR; PG8_WAIT_L(0); PG8_MMA(1, 0, At, B0); PG8_BAR; PG8_SCHED;
            PG8_STAGE(PG8_SB(1, 1), b3 + hstep, voffB);
            PG8_WAIT_V(6); PG8_BAR; PG8_MMA(1, 1, At, B1); PG8_BAR;
            }
        }
        if constexpr (ALIGN_EPI) { if (wr == 0) PG8_BAR; }
        if constexpr (!Epi::AFTER_DRAIN) { E(acc, cur, wr, wc, fr, fq); S.done(cur); }
        if (!has_next) break;
#pragma unroll
        for (int a = 0; a < 2; ++a)
#pragma unroll
            for (int b = 0; b < 2; ++b)
#pragma unroll
                for (int m = 0; m < 4; ++m)
#pragma unroll
                    for (int n = 0; n < 2; ++n) acc[a][b][m][n] = (f32x4){0.f, 0.f, 0.f, 0.f};
        cur = nxt; cA = nA; cB = nB; ++ui;
        if constexpr (ALIGN_EPI) { if (wr == 1) PG8_BAR; }
    }
    PG8_WAIT_V(0);
    if constexpr (!ALIGN_EPI) { if (wr == 0) PG8_BAR; }
    PG8_BAR;
    if constexpr (Epi::AFTER_DRAIN) { E.fused(acc, cur, wr, wc, fr, fq, lds, wid, lane); S.done(cur); }
#undef PG8_SA
#undef PG8_SB
#undef PG8_STAGE
#undef PG8_LDA
#undef PG8_LDB
#undef PG8_MMA
#undef PG8_WAIT_V
#undef PG8_WAIT_L
#undef PG8_BAR
#undef PG8_SCHED
}
}

namespace att {
using bf16x8 = __attribute__((ext_vector_type(8))) short;
using s16x4  = __attribute__((ext_vector_type(4))) short;
using f32x16 = __attribute__((ext_vector_type(16))) float;
using u32x4  = __attribute__((ext_vector_type(4))) unsigned;
constexpr int NW = 8, QBLK = 32, KVBLK = 64, DV = 128;
#define ATT_SBAR() __builtin_amdgcn_sched_barrier(0)
__device__ __forceinline__ int crow(int r, int hi) { return (r & 3) + 8 * (r >> 2) + 4 * hi; }
__device__ __forceinline__ unsigned cvtpk(float lo, float hi) { unsigned r; asm volatile("v_cvt_pk_bf16_f32 %0, %1, %2" : "=v"(r) : "v"(lo), "v"(hi)); return r; }
template <int DQK> __device__ __forceinline__ int kswz(int row, int colB) { return row * (DQK * 2) + (colB ^ ((row & 7) << 4)); }
constexpr float THR = 8.f;

template <int DQK> struct Cfg {
    static constexpr int SHM_V = KVBLK * DV * 2, SHM_K = KVBLK * DQK * 2;
    static constexpr int OFF_V = 0, OFF_K = 2 * SHM_V, OFF_WS = OFF_K + 2 * SHM_K, OFF_BIAS = OFF_WS + NW * 64 * 4, LDS_BYTES = OFF_BIAS + 10240;
    static constexpr int KCH = DQK / 8;
    static constexpr int KLD = (64 * KCH) / 512;
};

struct Job {
    const bf16_t* Q;
    const bf16_t* K;
    const bf16_t* V;
    bf16_t* O;
    int nt;
    int seg0_tiles, row_seg0, row_seg1;
    int R0; int rlo;
};

__device__ __forceinline__ int tile_row(const Job& J, int j) {
    if (j < J.seg0_tiles) return J.row_seg0 + 64 * j;
    int jj = j - J.seg0_tiles; if (jj > 3) jj = 0; return J.row_seg1 + 64 * jj;
}

__device__ __forceinline__ void partialSM(f32x16& p0, f32x16& p1, float& m_reg, float& mn, float& alpha, float C, float thr_raw) {
    float pmax = p0[0];
#pragma unroll
    for (int r = 1; r < 16; ++r) pmax = fmaxf(pmax, p0[r]);
#pragma unroll
    for (int r = 0; r < 16; ++r) pmax = fmaxf(pmax, p1[r]);
    { auto rr = __builtin_amdgcn_permlane32_swap(__float_as_uint(pmax), __float_as_uint(pmax), false, false);
      pmax = fmaxf(__uint_as_float(rr[0]), __uint_as_float(rr[1])); }
    if (__builtin_expect(__all(pmax - m_reg <= thr_raw), 1)) { mn = m_reg; alpha = 1.f; }
    else { mn = fmaxf(m_reg, pmax); alpha = __builtin_amdgcn_exp2f((m_reg - mn) * C); m_reg = mn; }
    const float mnC = -mn * C;
#pragma unroll
    for (int r = 0; r < 16; ++r) p0[r] = fmaf(p0[r], C, mnC);
#pragma unroll
    for (int r = 0; r < 16; ++r) p1[r] = fmaf(p1[r], C, mnC);
#pragma unroll
    for (int r = 0; r < 16; ++r) p0[r] = __builtin_amdgcn_exp2f(p0[r]);
}
__device__ __forceinline__ void finishSM(f32x16& p0, f32x16& p1, float alpha, float& l_reg, bf16x8& pa0, bf16x8& pa1, bf16x8& pa2, bf16x8& pa3) {
#pragma unroll
    for (int r = 0; r < 16; ++r) p1[r] = __builtin_amdgcn_exp2f(p1[r]);
    float ps = 0;
#pragma unroll
    for (int r = 0; r < 16; ++r) ps += p0[r];
#pragma unroll
    for (int r = 0; r < 16; ++r) ps += p1[r];
    { auto rr = __builtin_amdgcn_permlane32_swap(__float_as_uint(ps), __float_as_uint(ps), false, false);
      ps = __uint_as_float(rr[0]) + __uint_as_float(rr[1]); }
    l_reg = l_reg * alpha + ps;
#define ATT_PK4(P, BASE, OUT) do { unsigned a0 = cvtpk(P[BASE + 0], P[BASE + 1]), a1 = cvtpk(P[BASE + 2], P[BASE + 3]);   \
    unsigned b0 = cvtpk(P[BASE + 4], P[BASE + 5]), b1 = cvtpk(P[BASE + 6], P[BASE + 7]);                              \
    auto r0 = __builtin_amdgcn_permlane32_swap(a0, b0, false, false); auto r1 = __builtin_amdgcn_permlane32_swap(a1, b1, false, false); \
    u32x4 w = {r0[0], r1[0], r0[1], r1[1]}; OUT = *reinterpret_cast<bf16x8*>(&w); } while (0)
    ATT_PK4(p0, 0, pa0); ATT_PK4(p0, 8, pa1); ATT_PK4(p1, 0, pa2); ATT_PK4(p1, 8, pa3);
#undef ATT_PK4
}
template <int DQK> __device__ __forceinline__ void qkt(f32x16& p0, f32x16& p1, const char* Ks, const bf16x8* qr, int r32, int hi) {
    p0 = f32x16{}; p1 = f32x16{};
#pragma unroll
    for (int d0 = 0; d0 < DQK / 16; ++d0) { const int cb = (d0 * 16 + hi * 8) * 2;
        const bf16x8 b0 = *reinterpret_cast<const bf16x8*>(Ks + kswz<DQK>(r32, cb));
        const bf16x8 b1 = *reinterpret_cast<const bf16x8*>(Ks + kswz<DQK>(32 + r32, cb));
        p0 = __builtin_amdgcn_mfma_f32_32x32x16_bf16(b0, qr[d0], p0, 0, 0, 0);
        p1 = __builtin_amdgcn_mfma_f32_32x32x16_bf16(b1, qr[d0], p1, 0, 0, 0); }
}
__device__ __forceinline__ int v_st(int k, int c) { const int kk = (k & ~0xC) | ((k & 4) << 1) | ((k & 8) >> 1); return ((kk >> 3) * 4 + (c >> 5)) * 512 + ((kk & 7) * 32 + (c & 31)) * 2; }
__device__ __forceinline__ int v_rd_base(int lane) { return ((lane & 3) << 3) | (((lane >> 2) & 3) << 6) | (((lane >> 4) & 1) << 5) | (((lane >> 5) & 1) << 8); }
constexpr int v_rd_off(int d0, int ks, int half) { return d0 * 512 + ks * 4096 + half * 2048; }
template <int OFF> __device__ __forceinline__ s16x4 tr_read(int vb) { s16x4 r; asm volatile("ds_read_b64_tr_b16 %0, %1 offset:%2" : "=&v"(r) : "v"(vb), "i"(OFF) : "memory"); return r; }
template <int D0> __device__ __forceinline__ void pv_one(f32x16& od, int vb, bf16x8 pa0, bf16x8 pa1, bf16x8 pa2, bf16x8 pa3) {
    const s16x4 l0 = tr_read<v_rd_off(D0, 0, 0)>(vb), h0 = tr_read<v_rd_off(D0, 0, 1)>(vb), l1 = tr_read<v_rd_off(D0, 1, 0)>(vb), h1 = tr_read<v_rd_off(D0, 1, 1)>(vb);
    const s16x4 l2 = tr_read<v_rd_off(D0, 2, 0)>(vb), h2 = tr_read<v_rd_off(D0, 2, 1)>(vb), l3 = tr_read<v_rd_off(D0, 3, 0)>(vb), h3 = tr_read<v_rd_off(D0, 3, 1)>(vb);
    asm volatile("s_waitcnt lgkmcnt(0)" ::: "memory"); ATT_SBAR();
#define ATT_PK(L, H) (bf16x8){L[0], L[1], L[2], L[3], H[0], H[1], H[2], H[3]}
    od = __builtin_amdgcn_mfma_f32_32x32x16_bf16(pa0, ATT_PK(l0, h0), od, 0, 0, 0);
    od = __builtin_amdgcn_mfma_f32_32x32x16_bf16(pa1, ATT_PK(l1, h1), od, 0, 0, 0);
    od = __builtin_amdgcn_mfma_f32_32x32x16_bf16(pa2, ATT_PK(l2, h2), od, 0, 0, 0);
    od = __builtin_amdgcn_mfma_f32_32x32x16_bf16(pa3, ATT_PK(l3, h3), od, 0, 0, 0);
#undef ATT_PK
}
__device__ __forceinline__ void pv_d0(f32x16* o, int vb, bf16x8 pa0, bf16x8 pa1, bf16x8 pa2, bf16x8 pa3) {
    pv_one<0>(o[0], vb, pa0, pa1, pa2, pa3); pv_one<1>(o[1], vb, pa0, pa1, pa2, pa3); pv_one<2>(o[2], vb, pa0, pa1, pa2, pa3); pv_one<3>(o[3], vb, pa0, pa1, pa2, pa3);
}
constexpr int NA_BROW = 160, NA_BORG = 64 + (NA_KW - 1);
__device__ __forceinline__ void na_bias(f32x16& p0, f32x16& p1, const Job& J, int j, int R, int c, int hi, const float* biasq) {
    const int nloc = J.seg0_tiles;
    if (j >= nloc && j < nloc + 4) return;
    const int rr = J.rlo + j; int r0 = R - NA_KH / 2; r0 = r0 < 0 ? 0 : (r0 > ROWS - NA_KH ? ROWS - NA_KH : r0);
    const bool rowok = (j < nloc) && rr >= r0 && rr < r0 + NA_KH;
    if (!rowok) {
#pragma unroll
        for (int r = 0; r < 16; ++r) { p0[r] = -1e30f; p1[r] = -1e30f; }
        return; }
    int c0 = c - NA_KW / 2; c0 = c0 < 0 ? 0 : (c0 > GRID_W - NA_KW ? GRID_W - NA_KW : c0);
    const int dr = rr - R + (NA_KH - 1);
    const float* bl = biasq + dr * NA_BROW + NA_BORG + 4 * hi - c;
    const int vb = 4 * hi - c0;
#pragma unroll
    for (int r = 0; r < 16; ++r) { const int cc = (r & 3) + 8 * (r >> 2);
        p0[r] = ((unsigned)(cc + vb) < (unsigned)NA_KW) ? p0[r] + bl[cc] : -1e30f;
        p1[r] = ((unsigned)(cc + 32 + vb) < (unsigned)NA_KW) ? p1[r] + bl[cc + 32] : -1e30f; }
}

template <int DQK, bool NA, int LDQ, int LDK, int LDV, int LDO>
__device__ __forceinline__ void attn_unit(const Job& J, char* lds, const float scale) {
    using C_ = Cfg<DQK>;
    const int tid = threadIdx.x, wid = tid >> 6, lane = tid & 63, r32 = lane & 31, hi = lane >> 5;
    char* V_lds = lds + C_::OFF_V; char* K_lds = lds + C_::OFF_K;
    float* wsf = (float*)(lds + C_::OFF_WS) + wid * 64; float* li_l = wsf; float* al_l = wsf + 32;
    const float* biasq = (const float*)(lds + C_::OFF_BIAS);
    const float Cc = scale * 1.4426950408889634f, thr_raw = THR / scale;
    float m_reg = -1e5f, l_reg = 0; f32x16 o[4] = {}; bf16x8 qr[DQK / 16];
    const bf16_t* Qw = J.Q + (long)(wid * QBLK + r32) * LDQ + hi * 8;
#pragma unroll
    for (int d0 = 0; d0 < DQK / 16; ++d0) qr[d0] = *reinterpret_cast<const bf16x8*>(Qw + d0 * 16);
    const int naR = J.R0 + (wid >> 1), nac = (wid & 1) * 32 + r32;
    const int sr = tid >> 4, sc = (tid & 15) * 8, vst0 = v_st(sr, sc), vst1 = v_st(32 + sr, sc);
    const int vb0 = (int)(uintptr_t)V_lds + v_rd_base(lane);
    const unsigned voffV = (unsigned)(sr * LDV + sc) * 2u;
    unsigned koff[C_::KLD]; int kst[C_::KLD];
#pragma unroll
    for (int i = 0; i < C_::KLD; ++i) { const int id = tid + 512 * i, kr = id / C_::KCH, kc = id % C_::KCH; koff[i] = (unsigned)(kr * LDK + kc * 8) * 2u; kst[i] = kswz<DQK>(kr, kc * 16); }
    bf16x8 vs0, vs1, ks[C_::KLD];
#define ATT_SLOAD(j) do { const int row0_ = tile_row(J, (j)); const char* vp_ = (const char*)(J.V + (size_t)row0_ * LDV); const char* kp_ = (const char*)(J.K + (size_t)row0_ * LDK); \
        vs0 = *reinterpret_cast<const bf16x8*>(vp_ + voffV); vs1 = *reinterpret_cast<const bf16x8*>(vp_ + voffV + (unsigned)(64 * LDV)); \
        _Pragma("unroll") for (int i_ = 0; i_ < C_::KLD; ++i_) ks[i_] = *reinterpret_cast<const bf16x8*>(kp_ + koff[i_]); } while (0)
#define ATT_SWRITE(b) do { *(bf16x8*)(V_lds + (b) * C_::SHM_V + vst0) = vs0; *(bf16x8*)(V_lds + (b) * C_::SHM_V + vst1) = vs1; \
        _Pragma("unroll") for (int i_ = 0; i_ < C_::KLD; ++i_) *(bf16x8*)(K_lds + (b) * C_::SHM_K + kst[i_]) = ks[i_]; } while (0)
    const int NT = J.nt;
    __syncthreads();
    ATT_SLOAD(0); asm volatile("s_waitcnt vmcnt(0)" ::: "memory"); ATT_SWRITE(0); __syncthreads();
    for (int j = 0; j < NT; ++j) {
        const int buf = j & 1;
        if (j + 1 < NT) ATT_SLOAD(j + 1);
        f32x16 p0, p1; float mn, al; bf16x8 pa0, pa1, pa2, pa3;
        qkt<DQK>(p0, p1, K_lds + buf * C_::SHM_K, qr, r32, hi);
        if (NA) na_bias(p0, p1, J, j, naR, nac, hi, biasq);
        partialSM(p0, p1, m_reg, mn, al, Cc, thr_raw);
        finishSM(p0, p1, al, l_reg, pa0, pa1, pa2, pa3);
        if (__any(al < 1.f)) { if (hi == 0) al_l[r32] = al; asm volatile("s_waitcnt lgkmcnt(0)" ::: "memory");
#pragma unroll
            for (int d = 0; d < 4; ++d)
#pragma unroll
                for (int r = 0; r < 16; ++r) o[d][r] *= al_l[crow(r, hi)]; }
        ATT_SBAR();
        pv_d0(o, vb0 + buf * C_::SHM_V, pa0, pa1, pa2, pa3);
        if (j + 1 < NT) { asm volatile("s_waitcnt vmcnt(0)" ::: "memory"); ATT_SWRITE(buf ^ 1); }
        __syncthreads();
    }
    if (hi == 0) li_l[r32] = l_reg; asm volatile("s_waitcnt lgkmcnt(0)" ::: "memory");
    float rli[16];
#pragma unroll
    for (int r = 0; r < 16; ++r) rli[r] = __builtin_amdgcn_rcpf(li_l[crow(r, hi)]);
    bf16_t* Ow = J.O + (long)(wid * QBLK) * LDO;
#pragma unroll
    for (int r = 0; r < 16; ++r) { const int orow = crow(r, hi);
#pragma unroll
        for (int d0 = 0; d0 < 4; ++d0) Ow[(long)orow * LDO + d0 * 32 + r32] = f2bf(o[d0][r] * rli[r]); }
#undef ATT_SLOAD
#undef ATT_SWRITE
}
}

namespace gdn {
typedef short bf16x8 __attribute__((ext_vector_type(8)));
typedef float f32x4 __attribute__((ext_vector_type(4)));
typedef float f32x16 __attribute__((ext_vector_type(16)));
typedef unsigned u32x2 __attribute__((ext_vector_type(2)));
typedef unsigned u32x4 __attribute__((ext_vector_type(4)));
constexpr int CH = 64, NCHUNK = M_ALL / CH;
constexpr int NTASK = NCHUNK * NH * 2;
constexpr size_t SZ_UT = 128 * 64, SZ_WP = 64 * 128, SZ_KDT = 128 * 64, SZ_QD = 64 * 128, SZ_QK = 64 * 64, SZ_SIT = 128 * 128, SZ_VNT = 128 * 64;
struct Bufs { bf16_t *UT, *WP, *KDT, *QD, *QK, *SIT, *VNT; float* GT; };
__device__ __forceinline__ int perm32(int o) { return (o & ~31) | (((o & 15) >> 2) * 8 + ((o >> 4) & 1) * 4 + (o & 3)); }
__device__ __forceinline__ unsigned pk2(float lo, float hi) { return (unsigned)f2bf(lo) | ((unsigned)f2bf(hi) << 16); }

constexpr int QS = 132;
constexpr int AS = 68;
constexpr int G1_OFF_Q = 0, G1_OFF_K = G1_OFF_Q + CH * QS * 4, G1_OFF_V = G1_OFF_K + CH * QS * 4, G1_OFF_AA = G1_OFF_V + CH * QS * 4, G1_OFF_SM = G1_OFF_AA + 2 * CH * AS * 4,
              G1_LDS = G1_OFF_SM + 8 * 64 * 4;
struct G1Args { const bf16_t* P; const float* conv_w; const float* a_log; const float* dt_bias; Bufs B; };

__device__ __forceinline__ void g1_task(const G1Args& A, char* lds, int cix, int h) {
    int tid_ = threadIdx.x; asm volatile("" : "+v"(tid_));
    const int tid = tid_, wid = __builtin_amdgcn_readfirstlane(tid >> 6), lane = tid & 63;
    float* Qs = (float*)(lds + G1_OFF_Q); float* Ks = (float*)(lds + G1_OFF_K); float* Vs = (float*)(lds + G1_OFF_V); float* AA = (float*)(lds + G1_OFF_AA);
    float* sm = (float*)(lds + G1_OFF_SM); float* g_s = sm;   float* beta_s = sm + 128;   float* gc_s = sm + 256;
    const int row0 = cix * CH; const RowInfo r0i = row_info(row0);
    __syncthreads();
    for (int e = tid; e < CH * 3 * HD; e += 512) {
        const int i = e / (3 * HD), c = e % (3 * HD), which = c / HD, cc = c % HD, ch = which * GROUP_W + h * HD + cc;
        float acc = 0.f;
#pragma unroll
        for (int j = 0; j < 4; ++j) { const int tt = r0i.t + i + j - 1; if (tt >= 0 && tt < r0i.T) acc += A.conv_w[j * 3 * GROUP_W + ch] * bf2f(A.P[(size_t)(r0i.base + tt) * NP + C_GQ + ch]); }
        const float y = acc / (1.0f + __expf(-acc));
        (which == 0 ? Qs : which == 1 ? Ks : Vs)[i * QS + cc] = y;
    }
    if (tid < 128) { const int d = tid >> 6, i = tid & 63; const size_t r = (size_t)(row0 + i) * NP;
        beta_s[d * 64 + i] = 1.0f / (1.0f + __expf(-bf2f(A.P[r + C_GB + d * NH + h])));
        g_s[d * 64 + i] = -__expf(A.a_log[d * NH + h]) * softplusf_(bf2f(A.P[r + C_GA + d * NH + h]) + A.dt_bias[d * NH + h]); }
    __syncthreads();
    for (int rr = wid; rr < 2 * CH; rr += 8) { float* rowp = (rr < CH ? Qs : Ks) + (rr & 63) * QS;
        const float a = rowp[lane], b = rowp[lane + 64]; float ss = a * a + b * b;
#pragma unroll
        for (int o = 1; o < 64; o <<= 1) ss += __shfl_xor(ss, o);
        const float scl = (1.0f / sqrtf(ss + EPS)) * (rr < CH ? 0.08838834764831845f : 1.0f);
        rowp[lane] = a * scl; rowp[lane + 64] = b * scl; }
    if (wid < 2) { const int d = wid, i = d == 0 ? lane : 63 - lane; float v = g_s[d * 64 + i];
#pragma unroll
        for (int o = 1; o < 64; o <<= 1) { const float t = __shfl_up(v, o); if (lane >= o) v += t; }
        gc_s[d * 64 + i] = v; }
    __syncthreads();
    {
        const int which = wid >> 2, I = (wid >> 1) & 1, J = wid & 1, r32 = lane & 31, hi = lane >> 5;
        const float* X = (which ? Qs : Ks) + (32 * I + r32) * QS + 4 * hi; const float* Yp = Ks + (32 * J + r32) * QS + 4 * hi;
        f32x16 acc = {};
#pragma unroll
        for (int s = 0; s < 16; ++s) { const f32x4 a4 = *(const f32x4*)(X + 8 * s), b4 = *(const f32x4*)(Yp + 8 * s);
#pragma unroll
            for (int e = 0; e < 4; ++e) acc = __builtin_amdgcn_mfma_f32_32x32x2f32(a4[e], b4[e], acc, 0, 0, 0); }
        const int j = 32 * J + r32;
        const size_t t0 = ((size_t)cix * NH + h) * 2;
        if (which == 0) {
            const float b1j = beta_s[64 + j], g0j = gc_s[j], g1j = gc_s[64 + j];
#pragma unroll
            for (int r = 0; r < 16; ++r) { const int i = 32 * I + (r & 3) + 8 * (r >> 2) + 4 * hi;
                if (i > j) { const float kk = acc[r];
                    AA[(63 - j) * AS + (63 - i)] = beta_s[i] * kk * __expf(gc_s[i] - g0j);
                    AA[CH * AS + i * AS + j] = b1j * kk * __expf(g1j - gc_s[64 + i]); } }
        } else {
            bf16_t* q0 = A.B.QK + (t0 + 0) * SZ_QK; bf16_t* q1 = A.B.QK + (t0 + 1) * SZ_QK;
            const float g0j = gc_s[j], g1j = gc_s[64 + j];
#pragma unroll
            for (int r = 0; r < 16; ++r) { const int i = 32 * I + (r & 3) + 8 * (r >> 2) + 4 * hi; const float qk = acc[r];
                q0[i * 64 + j] = f2bf(i >= j ? qk * __expf(gc_s[i] - g0j) : 0.f);
                q1[(63 - i) * 64 + (63 - j)] = f2bf(i <= j ? qk * __expf(gc_s[64 + i] - g1j) : 0.f); }
        }
    }
    __syncthreads();
    {
        const size_t t0 = ((size_t)cix * NH + h) * 2;
        const int d = tid >> 8, k = tid & 127, ph = (tid >> 7) & 1;
        bf16_t* qd = A.B.QD + (t0 + d) * SZ_QD; bf16_t* kdt = A.B.KDT + (t0 + d) * SZ_KDT + (size_t)k * 64;
        const float glast = d == 0 ? gc_s[63] : gc_s[64 + 0];
#pragma unroll 8
        for (int pp = 0; pp < 32; ++pp) { const int p = ph * 32 + pp, i = d == 0 ? p : 63 - p; const float gci = gc_s[d * 64 + i];
            qd[p * 128 + k] = f2bf(Qs[i * QS + k] * __expf(gci));
            kdt[perm32(p)] = f2bf(Ks[i * QS + k] * __expf(glast - gci)); }
        if (tid == 0) { A.B.GT[t0] = __expf(gc_s[63]); A.B.GT[t0 + 1] = __expf(gc_s[64]); }
    }
    __syncthreads();
    {
        int tidv = tid; asm volatile("" : "+v"(tidv));
        const int d = tidv >> 8, c = tidv & 255; const bool isw = c >= 128; const int cc = c & 127;
        const float* src = isw ? Ks : Vs;
        int lz; asm volatile("v_mov_b32 %0, 0" : "=v"(lz));
        const float* AAv = AA + lz + d * (CH * AS);
        float x[CH];
#pragma unroll
        for (int p = 0; p < CH; ++p) { const int i = d == 0 ? p : 63 - p; float f = beta_s[d * 64 + i]; if (isw) f *= __expf(gc_s[d * 64 + i]); x[p] = f * src[i * QS + cc]; }
        {
#pragma unroll
            for (int p = 0; p < CH - 1; ++p) { const float xp = x[p]; const float* rowp = AAv + (63 - p) * AS;
#pragma unroll
                for (int m = 0; m <= (62 - p) / 4; ++m) { const f32x4 a4 = *(const f32x4*)(rowp + 4 * m);
#pragma unroll
                    for (int e = 0; e < 4; ++e) { const int col = 4 * m + e; if (col <= 62 - p) x[63 - col] -= a4[e] * xp; } } }
        }
        const size_t t = ((size_t)cix * NH + h) * 2 + d;
        if (!isw) { u32x4* dst = (u32x4*)(A.B.UT + t * SZ_UT + (size_t)cc * 64);
#pragma unroll
            for (int m = 0; m < 8; ++m) { u32x4 w4; w4.x = pk2(x[8 * m], x[8 * m + 1]); w4.y = pk2(x[8 * m + 2], x[8 * m + 3]); w4.z = pk2(x[8 * m + 4], x[8 * m + 5]); w4.w = pk2(x[8 * m + 6], x[8 * m + 7]); dst[m] = w4; }
        } else { bf16_t* dst = A.B.WP + t * SZ_WP + perm32(cc);
#pragma unroll
            for (int p = 0; p < CH; ++p) dst[p * 128] = f2bf(x[p]); }
    }
}
__device__ __forceinline__ void g1_phase(const G1Args& A, char* lds, int G, int wg) {
    for (int t = wg; t < NCHUNK * NH; t += G) g1_task(A, lds, t / NH, t % NH);
}

constexpr int WPS = 272, KDS = 144;
constexpr int G2_BUF = 64 * WPS + 128 * KDS, G2_LDS = 2 * G2_BUF;
__device__ __forceinline__ int g2_task_index(int b, int h, int d, int step) {
    constexpr int NC = CTX_LEN / CH, NL = SEQ / CH; int cix;
    if (step < NC) { const int n = d ? NC - 1 - step : step; cix = M_LAT / CH + b * NC + n; }
    else { const int s2 = step - NC, n = d ? NL - 1 - s2 : s2; cix = b * NL + n; }
    return (cix * NH + h) * 2 + d;
}
__device__ __forceinline__ void g2_chain(const Bufs& B, char* lds, int chain) {
    const int tid = threadIdx.x, wid = tid >> 6, lane = tid & 63, q = lane >> 4, vl = lane & 15;
    const int d = chain & 1, h = (chain >> 1) % NH, b = chain / (2 * NH);
    constexpr int NSTEP = CTX_LEN / CH + SEQ / CH;
    f32x4 S[8];
#pragma unroll
    for (int kb = 0; kb < 8; ++kb) S[kb] = (f32x4){0.f, 0.f, 0.f, 0.f};
    u32x4 stw[2], stk[2];
#define G2_LOAD(ti) do { const u32x4* wp_ = (const u32x4*)(B.WP + (size_t)(ti) * SZ_WP); const u32x4* kp_ = (const u32x4*)(B.KDT + (size_t)(ti) * SZ_KDT); \
        stw[0] = wp_[tid]; stw[1] = wp_[tid + 512]; stk[0] = kp_[tid]; stk[1] = kp_[tid + 512]; } while (0)
#define G2_WRITE(buf) do { char* base_ = lds + (buf) * G2_BUF; \
        _Pragma("unroll") for (int i_ = 0; i_ < 2; ++i_) { const int id_ = tid + 512 * i_; \
            *(u32x4*)(base_ + (id_ >> 4) * WPS + (id_ & 15) * 16) = stw[i_]; *(u32x4*)(base_ + 64 * WPS + (id_ >> 3) * KDS + (id_ & 7) * 16) = stk[i_]; } } while (0)
    __syncthreads();
    { const int ti0 = g2_task_index(b, h, d, 0); G2_LOAD(ti0); G2_WRITE(0); }
    __syncthreads();
    for (int step = 0; step < NSTEP; ++step) {
        const int ti = g2_task_index(b, h, d, step), buf = step & 1;
        if (step + 1 < NSTEP) { const int tn = g2_task_index(b, h, d, step + 1); G2_LOAD(tn); }
        const char* wl = lds + buf * G2_BUF; const char* kl = wl + 64 * WPS;
        const bf16_t* ut = B.UT + (size_t)ti * SZ_UT + (size_t)(16 * wid + vl) * 64 + 4 * q;
        u32x2 uu[4];
#pragma unroll
        for (int rb = 0; rb < 4; ++rb) uu[rb] = *(const u32x2*)(ut + 16 * rb);
        const float gt = B.GT[ti];
        bf16_t* sit = B.SIT + (size_t)ti * SZ_SIT + (size_t)(16 * wid + vl) * 128 + 4 * q;
        bf16x8 sf[4];
#pragma unroll
        for (int s = 0; s < 4; ++s) { u32x4 w4; w4.x = pk2(S[2 * s][0], S[2 * s][1]); w4.y = pk2(S[2 * s][2], S[2 * s][3]); w4.z = pk2(S[2 * s + 1][0], S[2 * s + 1][1]); w4.w = pk2(S[2 * s + 1][2], S[2 * s + 1][3]);
            sf[s] = __builtin_bit_cast(bf16x8, w4);
            *(u32x2*)(sit + 32 * s) = (u32x2){w4.x, w4.y}; *(u32x2*)(sit + 32 * s + 16) = (u32x2){w4.z, w4.w}; }
        f32x4 vn[4];
#pragma unroll
        for (int rb = 0; rb < 4; ++rb) { f32x4 acc = {0.f, 0.f, 0.f, 0.f};
#pragma unroll
            for (int s = 0; s < 4; ++s) { const bf16x8 a = *(const bf16x8*)(wl + (16 * rb + vl) * WPS + s * 64 + q * 16);
                acc = __builtin_amdgcn_mfma_f32_16x16x32_bf16(a, sf[s], acc, 0, 0, 0); }
            vn[rb][0] = bflo(uu[rb].x) - acc[0]; vn[rb][1] = bfhi(uu[rb].x) - acc[1]; vn[rb][2] = bflo(uu[rb].y) - acc[2]; vn[rb][3] = bfhi(uu[rb].y) - acc[3]; }
        bf16_t* vnt = B.VNT + (size_t)ti * SZ_VNT + (size_t)(16 * wid + vl) * 64 + 4 * q;
        bf16x8 vf[2];
#pragma unroll
        for (int s = 0; s < 2; ++s) { u32x4 w4; w4.x = pk2(vn[2 * s][0], vn[2 * s][1]); w4.y = pk2(vn[2 * s][2], vn[2 * s][3]); w4.z = pk2(vn[2 * s + 1][0], vn[2 * s + 1][1]); w4.w = pk2(vn[2 * s + 1][2], vn[2 * s + 1][3]);
            vf[s] = __builtin_bit_cast(bf16x8, w4);
            *(u32x2*)(vnt + 32 * s) = (u32x2){w4.x, w4.y}; *(u32x2*)(vnt + 32 * s + 16) = (u32x2){w4.z, w4.w}; }
#pragma unroll
        for (int kb = 0; kb < 8; ++kb) { f32x4 acc = S[kb] * gt;
#pragma unroll
            for (int s = 0; s < 2; ++s) { const bf16x8 a = *(const bf16x8*)(kl + (16 * kb + vl) * KDS + s * 64 + q * 16);
                acc = __builtin_amdgcn_mfma_f32_16x16x32_bf16(a, vf[s], acc, 0, 0, 0); }
            S[kb] = acc; }
        if (step + 1 < NSTEP) G2_WRITE(buf ^ 1);
        __syncthreads();
    }
#undef G2_LOAD
#undef G2_WRITE
}

constexpr int G3_LDS = 8 * 64 * 4 * 2;
struct G3Args { Bufs B; const bf16_t* P; const float* norm_g; bf16_t* Y; };
__device__ __forceinline__ void g3_task(const G3Args& A, char* lds, int cix, int h) {
    const int tid = threadIdx.x, wid = tid >> 6, lane = tid & 63, q = lane >> 4, vl = lane & 15;
    float* part = (float*)lds;
    f32x4 o[2][4];
#pragma unroll
    for (int d = 0; d < 2; ++d) {
        const size_t t = ((size_t)cix * NH + h) * 2 + d;
        const bf16_t* sit = A.B.SIT + t * SZ_SIT + (size_t)(16 * wid + vl) * 128 + 8 * q;
        const bf16_t* vnt = A.B.VNT + t * SZ_VNT + (size_t)(16 * wid + vl) * 64 + 8 * q;
        const bf16_t* qd = A.B.QD + t * SZ_QD + (size_t)vl * 128 + 8 * q;
        const bf16_t* qk = A.B.QK + t * SZ_QK + (size_t)vl * 64 + 8 * q;
        bf16x8 sf[4], vf[2];
#pragma unroll
        for (int s = 0; s < 4; ++s) sf[s] = *(const bf16x8*)(sit + 32 * s);
#pragma unroll
        for (int s = 0; s < 2; ++s) vf[s] = *(const bf16x8*)(vnt + 32 * s);
#pragma unroll
        for (int rb = 0; rb < 4; ++rb) { f32x4 acc = {0.f, 0.f, 0.f, 0.f};
#pragma unroll
            for (int s = 0; s < 4; ++s) acc = __builtin_amdgcn_mfma_f32_16x16x32_bf16(*(const bf16x8*)(qd + (size_t)rb * 16 * 128 + 32 * s), sf[s], acc, 0, 0, 0);
#pragma unroll
            for (int s = 0; s < 2; ++s) acc = __builtin_amdgcn_mfma_f32_16x16x32_bf16(*(const bf16x8*)(qk + (size_t)rb * 16 * 64 + 32 * s), vf[s], acc, 0, 0, 0);
            o[d][rb] = acc; }
    }
    f32x4 ot[4];
#pragma unroll
    for (int rb = 0; rb < 4; ++rb)
#pragma unroll
        for (int r = 0; r < 4; ++r) ot[rb][r] = o[0][rb][r] + __shfl_xor(o[1][3 - rb][3 - r], 48);
    __syncthreads();
#pragma unroll
    for (int rb = 0; rb < 4; ++rb)
#pragma unroll
        for (int r = 0; r < 4; ++r) { float ss = ot[rb][r] * ot[rb][r];
#pragma unroll
            for (int of = 1; of < 16; of <<= 1) ss += __shfl_xor(ss, of);
            if (vl == 0) part[wid * 64 + 16 * rb + 4 * q + r] = ss; }
    __syncthreads();
    const int v = 16 * wid + vl; const float ng = A.norm_g[v];
#pragma unroll
    for (int rb = 0; rb < 4; ++rb)
#pragma unroll
        for (int r = 0; r < 4; ++r) { const int tok = 16 * rb + 4 * q + r; float ss = 0.f;
#pragma unroll
            for (int w8 = 0; w8 < 8; ++w8) ss += part[w8 * 64 + tok];
            const float rstd = 1.0f / sqrtf(ss * (1.0f / HD) + EPS);
            const size_t row = (size_t)cix * CH + tok; const float gate = bf2f(A.P[row * NP + C_GG + h * HD + v]);
            A.Y[row * D_MODEL + 2 * GROUP_W + h * HD + v] = f2bf(ot[rb][r] * rstd * ng * (gate / (1.0f + __expf(-gate)))); }
}
__device__ __forceinline__ void g3_phase(const G3Args& A, char* lds, int G, int wg) {
    for (int t = wg; t < NCHUNK * NH; t += G) g3_task(A, lds, t / NH, t % NH);
}
}


struct Inputs {
    const float *x, *c, *ctx, *c_ctx, *ada_w, *ada_b, *norm_mix_g, *norm_ffn_g, *w_in, *w_out,
        *lru_conv_w, *lru_conv_b, *lru_wa, *lru_ba, *lru_wx, *lru_bx, *lru_lam,
        *mla_qa_g, *mla_w_uq, *mla_kva_g, *mla_w_ukv, *mla_qn_g, *mla_kn_g,
        *gdn_conv_w, *gdn_a_log, *gdn_dt_bias, *gdn_norm_g, *na_qn_g, *na_kn_g, *na_rpb,
        *ffn_w_up, *ffn_conv_w, *ffn_conv_b, *ffn_w_down;
};
static inline Inputs make_inputs(void* const* d_in) { Inputs I; const float** p = (const float**)&I; for (int i = 0; i < 34; ++i) p[i] = (const float*)d_in[i]; return I; }

constexpr int NQ_MLA = NH * MLA_QK, NKV_MLA = NH * (MLA_NOPE + MLA_V);
struct WS {
    unsigned* ctl;
    float *SC, *MOD, *H;
    bf16_t *U, *Y;
    bf16_t *WIN, *WOUT, *WUP, *WDOWN, *WUQ, *WUKV;
    bf16_t* P; float *LU, *LA, *LB; bf16_t *CQN, *CKVN; float *QR, *KVR; bf16_t *QM, *KM, *VM; float *GC, *GG, *GBt, *GO; bf16_t *NQ, *NK;
    bf16_t *UP, *ACT;
#ifdef FAST_GDN
    bf16_t *gUT, *gWP, *gKDT, *gQD, *gQK, *gSIT, *gVNT; float* gGT;
#endif
    size_t total;
};
constexpr size_t SZ_WIN = (size_t)NP * D_MODEL, SZ_WOUT = (size_t)D_MODEL * D_MODEL, SZ_WUP = (size_t)2 * D_FF * D_MODEL, SZ_WDOWN = (size_t)D_MODEL * D_FF,
                 SZ_WUQ = (size_t)NQ_MLA * MLA_Q_LORA, SZ_WUKV = (size_t)NKV_MLA * MLA_KV_LORA;
static inline WS ws_carve(void* base) {
    WS w; size_t off = 0; char* b = (char*)base;
    auto take = [&](size_t bytes) { char* p = b + off; off += (bytes + 255) & ~(size_t)255; return p; };
    w.ctl = (unsigned*)take(1 << 20);
    w.SC = (float*)take(sizeof(float) * (BATCH + 1) * D_MODEL);
    w.MOD = (float*)take(sizeof(float) * (size_t)DEPTH * (BATCH + 1) * NMODV);
    w.H = (float*)take(sizeof(float) * (size_t)M_ALL * D_MODEL);
    w.U = (bf16_t*)take(2 * (size_t)M_ALL * D_MODEL);
    w.Y = (bf16_t*)take(2 * (size_t)M_ALL * D_MODEL);
    w.WIN = (bf16_t*)take(2 * SZ_WIN * DEPTH); w.WOUT = (bf16_t*)take(2 * SZ_WOUT * DEPTH); w.WUP = (bf16_t*)take(2 * SZ_WUP * DEPTH); w.WDOWN = (bf16_t*)take(2 * SZ_WDOWN * DEPTH);
    w.WUQ = (bf16_t*)take(2 * SZ_WUQ * DEPTH); w.WUKV = (bf16_t*)take(2 * SZ_WUKV * DEPTH);
    const size_t r0 = off;
    w.P = (bf16_t*)take(2 * (size_t)M_ALL * NP);
    w.LU = (float*)take(4 * (size_t)M_ALL * LRU_W); w.LA = (float*)take(4 * (size_t)2 * M_ALL * LRU_W); w.LB = (float*)take(4 * (size_t)2 * M_ALL * LRU_W);
    w.CQN = (bf16_t*)take(2 * (size_t)M_ALL * MLA_Q_LORA); w.CKVN = (bf16_t*)take(2 * (size_t)M_ALL * MLA_KV_LORA);
    w.QR = (float*)take(4 * (size_t)M_ALL * NQ_MLA); w.KVR = (float*)take(4 * (size_t)M_ALL * NKV_MLA);
    w.QM = (bf16_t*)take(2 * (size_t)M_ALL * NQ_MLA); w.KM = (bf16_t*)take(2 * (size_t)M_ALL * NQ_MLA); w.VM = (bf16_t*)take(2 * (size_t)M_ALL * NH * MLA_V);
#ifdef FAST_GDN
    { constexpr size_t NT_ = (size_t)(M_ALL / 64) * NH * 2;
      w.gUT = (bf16_t*)take(2 * NT_ * 128 * 64); w.gWP = (bf16_t*)take(2 * NT_ * 64 * 128); w.gKDT = (bf16_t*)take(2 * NT_ * 128 * 64); w.gQD = (bf16_t*)take(2 * NT_ * 64 * 128);
      w.gQK = (bf16_t*)take(2 * NT_ * 64 * 64); w.gSIT = (bf16_t*)take(2 * NT_ * 128 * 128); w.gVNT = (bf16_t*)take(2 * NT_ * 128 * 64); w.gGT = (float*)take(4 * NT_);
      w.GC = nullptr; w.GG = nullptr; w.GBt = nullptr; w.GO = nullptr; }
#else
    w.GC = (float*)take(4 * (size_t)M_ALL * 3 * GROUP_W); w.GG = (float*)take(4 * (size_t)2 * M_ALL * NH); w.GBt = (float*)take(4 * (size_t)2 * M_ALL * NH);
    w.GO = (float*)take(4 * (size_t)2 * M_ALL * GROUP_W);
#endif
    w.NQ = (bf16_t*)take(2 * (size_t)M_ALL * GROUP_W); w.NK = (bf16_t*)take(2 * (size_t)M_ALL * GROUP_W);
    const size_t r1 = off;
    off = r0;
    w.UP = (bf16_t*)take(2 * (size_t)M_ALL * 2 * D_FF); w.ACT = (bf16_t*)take(2 * (size_t)M_ALL * D_FF);
    const size_t f1 = off;
    w.total = r1 > f1 ? r1 : f1;
    return w;
}

void gemm_bf16out(STREAM_T st, const bf16_t* A, const bf16_t* Bt, int M, int N, int K, bf16_t* O, int ldc);
void gemm_f32out(STREAM_T st, const bf16_t* A, const bf16_t* Bt, int M, int N, int K, float* C, int ldc);
void gemm_gate_res(STREAM_T st, const bf16_t* A, const bf16_t* Bt, int M, int N, int K, const float* base, float* out, int ldc, const float* gate  );

#ifdef FAST_GDN
void fast_gdn(STREAM_T st, const WS& w, const float* conv_w, const float* a_log, const float* dt_bias, const float* norm_g);
#endif
#ifdef FAST_ATTN
void fast_attention(STREAM_T st, const WS& w, const float* rpb, bool want_ctx);
#endif
static inline int cdiv(long a, long b) { return (int)((a + b - 1) / b); }
#define L1D(k, total, ...) LAUNCH(k, cdiv((total), 256), 256, st, __VA_ARGS__)

static void run_forward(const Inputs& I, float* d_out, const WS& w, STREAM_T st) {
    L1D(k_silu_c, (long)(BATCH + 1) * D_MODEL, I.c, I.c_ctx, w.SC);
    L1D(k_ada, (long)DEPTH * NMODV, w.SC, I.ada_w, I.ada_b, w.MOD);
    L1D(k_init_h, (long)M_ALL * D_MODEL, I.x, I.ctx, w.H);
    for (int l = 0; l < DEPTH; ++l) {
        L1D(k_convert_w, (long)NP * D_MODEL / 8, I.w_in + (size_t)l * D_MODEL * IN_COLS, w.WIN + l * SZ_WIN, D_MODEL, IN_COLS, NP);
        L1D(k_convert_w, (long)D_MODEL * D_MODEL / 8, I.w_out + (size_t)l * D_MODEL * D_MODEL, w.WOUT + l * SZ_WOUT, D_MODEL, D_MODEL, D_MODEL);
        L1D(k_convert_w, (long)2 * D_FF * D_MODEL / 8, I.ffn_w_up + (size_t)l * D_MODEL * 2 * D_FF, w.WUP + l * SZ_WUP, D_MODEL, 2 * D_FF, 2 * D_FF);
        L1D(k_convert_w, (long)D_MODEL * D_FF / 8, I.ffn_w_down + (size_t)l * D_FF * D_MODEL, w.WDOWN + l * SZ_WDOWN, D_FF, D_MODEL, D_MODEL);
        L1D(k_convert_w, (long)NQ_MLA * MLA_Q_LORA / 8, I.mla_w_uq + (size_t)l * MLA_Q_LORA * NQ_MLA, w.WUQ + l * SZ_WUQ, MLA_Q_LORA, NQ_MLA, NQ_MLA);
        L1D(k_convert_w, (long)NKV_MLA * MLA_KV_LORA / 8, I.mla_w_ukv + (size_t)l * MLA_KV_LORA * NKV_MLA, w.WUKV + l * SZ_WUKV, MLA_KV_LORA, NKV_MLA, NKV_MLA);
    }
    for (int l = 0; l < DEPTH; ++l) {
        const bool want_ctx = l < DEPTH - 1; const int Mo = want_ctx ? M_ALL : M_LAT;
        const float* MODl = w.MOD + (size_t)l * (BATCH + 1) * NMODV;
        L1D(k_norm_mod, M_ALL, w.H, I.norm_mix_g + (size_t)l * D_MODEL, MODl, 0, w.U, M_ALL);
        gemm_bf16out(st, w.U, w.WIN + l * SZ_WIN, M_ALL, NP, D_MODEL, w.P, NP);
        L1D(k_lru_conv, (long)M_ALL * LRU_W, w.P, I.lru_conv_w + (size_t)l * 4 * LRU_W, I.lru_conv_b + (size_t)l * LRU_W, w.LU);
        L1D(k_lru_coef, (long)2 * M_ALL * LRU_W, w.LU, I.lru_wa + (size_t)l * 2 * NH * LRU_BW * LRU_BW, I.lru_ba + (size_t)l * 2 * LRU_W,
            I.lru_wx + (size_t)l * 2 * NH * LRU_BW * LRU_BW, I.lru_bx + (size_t)l * 2 * LRU_W, I.lru_lam + (size_t)l * 2 * LRU_W, w.LA, w.LB);
        L1D(k_lru_scan, (long)BATCH * 2 * LRU_W, w.LA, w.LB);
        L1D(k_lru_fin, (long)M_ALL * LRU_W, w.LB, w.P, w.Y);
        L1D(k_mla_norm1, M_ALL, w.P, I.mla_qa_g + (size_t)l * MLA_Q_LORA, I.mla_kva_g + (size_t)l * MLA_KV_LORA, w.CQN, w.CKVN);
        gemm_f32out(st, w.CQN, w.WUQ + l * SZ_WUQ, M_ALL, NQ_MLA, MLA_Q_LORA, w.QR, NQ_MLA);
        gemm_f32out(st, w.CKVN, w.WUKV + l * SZ_WUKV, M_ALL, NKV_MLA, MLA_KV_LORA, w.KVR, NKV_MLA);
        L1D(k_mla_qkv, (long)M_ALL * NH, w.QR, w.KVR, w.P, I.mla_qn_g + (size_t)l * MLA_QK, I.mla_kn_g + (size_t)l * MLA_QK, w.QM, w.KM, w.VM);
#ifndef FAST_ATTN
        { const float sc = 1.0f / sqrtf((float)MLA_QK);
          LAUNCH((k_attn_dense<MLA_QK, MLA_V>), BATCH * NH * cdiv(SEQ, 128), 256, st, w.QM, w.KM, w.VM, NQ_MLA, NQ_MLA, NH * MLA_V, sc, w.Y, GROUP_W, 0);
          if (want_ctx) LAUNCH((k_attn_dense<MLA_QK, MLA_V>), BATCH * NH * cdiv(CTX_LEN, 128), 256, st, w.QM, w.KM, w.VM, NQ_MLA, NQ_MLA, NH * MLA_V, sc, w.Y, GROUP_W, 1); }
#endif
#ifndef FAST_GDN
        L1D(k_gdn_conv, (long)M_ALL * 3 * GROUP_W, w.P, I.gdn_conv_w + (size_t)l * 4 * 3 * GROUP_W, w.GC);
        L1D(k_gdn_norm, (long)M_ALL * NH, w.GC);
        L1D(k_gdn_gates, (long)2 * M_ALL * NH, w.P, I.gdn_a_log + (size_t)l * 2 * NH, I.gdn_dt_bias + (size_t)l * 2 * NH, w.GG, w.GBt);
        LAUNCH(k_gdn_seq, BATCH * NH * 2, HD, st, w.GC, w.GG, w.GBt, w.GO);
        L1D(k_gdn_fin, (long)M_ALL * NH, w.GO, w.P, I.gdn_norm_g + (size_t)l * HD, w.Y);
#else
        fast_gdn(st, w, I.gdn_conv_w + (size_t)l * 4 * 3 * GROUP_W, I.gdn_a_log + (size_t)l * 2 * NH, I.gdn_dt_bias + (size_t)l * 2 * NH, I.gdn_norm_g + (size_t)l * HD);
#endif
        L1D(k_na_norm, (long)M_ALL * NH, w.P, I.na_qn_g + (size_t)l * HD, I.na_kn_g + (size_t)l * HD, w.NQ, w.NK);
#ifndef FAST_ATTN
        LAUNCH(k_na_attn, BATCH * NH * (SEQ / 128), 256, st, w.NQ, w.NK, w.P, I.na_rpb + (size_t)l * NH * (2 * NA_KH - 1) * (2 * NA_KW - 1), w.Y);
        if (want_ctx) LAUNCH((k_attn_dense<HD, HD>), BATCH * NH * cdiv(CTX_LEN, 128), 256, st, w.NQ, w.NK, w.P + C_NV, GROUP_W, GROUP_W, NP, 1.0f / sqrtf((float)HD), w.Y, 3 * GROUP_W, 1);
#else
        fast_attention(st, w, I.na_rpb + (size_t)l * NH * (2 * NA_KH - 1) * (2 * NA_KW - 1), want_ctx);
#endif
        gemm_gate_res(st, w.Y, w.WOUT + l * SZ_WOUT, Mo, D_MODEL, D_MODEL, w.H, w.H, D_MODEL, MODl + 2 * D_MODEL);
        L1D(k_norm_mod, Mo, w.H, I.norm_ffn_g + (size_t)l * D_MODEL, MODl, 3, w.U, Mo);
        gemm_bf16out(st, w.U, w.WUP + l * SZ_WUP, Mo, 2 * D_FF, D_MODEL, w.UP, 2 * D_FF);
        L1D(k_ffn_act, (long)Mo * D_FF, w.UP, I.ffn_conv_w + (size_t)l * 3 * 2 * D_FF, I.ffn_conv_b + (size_t)l * 2 * D_FF, w.ACT, Mo);
        gemm_gate_res(st, w.ACT, w.WDOWN + l * SZ_WDOWN, Mo, D_MODEL, D_FF, w.H, want_ctx ? w.H : d_out, D_MODEL, MODl + 5 * D_MODEL);
    }
}

struct AttnArgs { const bf16_t *QM, *KM, *VM, *NQ, *NK, *P; bf16_t* Y; const float* rpb; int want_ctx; int pad; };
__device__ __forceinline__ void attention_phase(const AttnArgs& A, char* lds, int G, int wg) {
    static_assert(GRID_W == 64 && SEQ % 256 == 0 && CTX_LEN == 256 && HD == 128, "attention phase geometry");
    constexpr int NQB = SEQ / 256;
    constexpr float sc_mla = 0.07216878364870323f, sc_na = 0.08838834764831845f;
    static_assert(MLA_QK == 192 && HD == 128, "softmax scales");
    for (int u = wg; u < BATCH * NH * NQB; u += G) {
        const int bh = u % (BATCH * NH), qb = u / (BATCH * NH), b = bh / NH, h = bh % NH;
        att::Job J{};
        J.Q = A.QM + (size_t)(b * SEQ + qb * 256) * NQ_MLA + h * MLA_QK; J.K = A.KM + h * MLA_QK; J.V = A.VM + h * MLA_V;
        J.O = A.Y + (size_t)(b * SEQ + qb * 256) * D_MODEL + GROUP_W + h * MLA_V;
        J.nt = SEQ / 64 + CTX_LEN / 64; J.seg0_tiles = SEQ / 64; J.row_seg0 = b * SEQ; J.row_seg1 = M_LAT + b * CTX_LEN;
        att::attn_unit<MLA_QK, false, NQ_MLA, NQ_MLA, NH * MLA_V, D_MODEL>(J, lds, sc_mla);
    }
    for (int u = wg; u < BATCH * NH * NQB; u += G) {
        const int bh = u % (BATCH * NH), qb = u / (BATCH * NH), b = bh / NH, h = bh % NH, R0 = qb * 4;
        __syncthreads();
        { float* bq = (float*)(lds + att::Cfg<HD>::OFF_BIAS); const float* src = A.rpb + (size_t)h * (2 * NA_KH - 1) * (2 * NA_KW - 1);
          for (int i = threadIdx.x; i < (2 * NA_KH - 1) * att::NA_BROW; i += 512) { const int dr = i / att::NA_BROW; int dc = i % att::NA_BROW - att::NA_BORG + (NA_KW - 1); dc = dc < 0 ? 0 : (dc > 2 * NA_KW - 2 ? 2 * NA_KW - 2 : dc);
              bq[i] = src[dr * (2 * NA_KW - 1) + dc] * 11.313708498984761f; } }
        int rlo = R0 - NA_KH / 2; rlo = rlo < 0 ? 0 : (rlo > ROWS - NA_KH ? ROWS - NA_KH : rlo);
        int rhi = R0 + 3 - NA_KH / 2; rhi = (rhi < 0 ? 0 : (rhi > ROWS - NA_KH ? ROWS - NA_KH : rhi)) + NA_KH - 1;
        const int nloc = rhi - rlo + 1;
        att::Job J{};
        J.Q = A.NQ + (size_t)(b * SEQ + R0 * 64) * GROUP_W + h * HD; J.K = A.NK + h * HD; J.V = A.P + C_NV + h * HD;
        J.O = A.Y + (size_t)(b * SEQ + R0 * 64) * D_MODEL + 3 * GROUP_W + h * HD;
        J.nt = (nloc + 4 + 1) & ~1; J.seg0_tiles = nloc; J.row_seg0 = b * SEQ + rlo * 64; J.row_seg1 = M_LAT + b * CTX_LEN;  J.R0 = R0; J.rlo = rlo;
        att::attn_unit<HD, true, GROUP_W, GROUP_W, NP, D_MODEL>(J, lds, sc_na);
    }
    if (A.want_ctx) {
        for (int u = wg; u < BATCH * NH; u += G) {
            const int b = u / NH, h = u % NH; const int crow0 = M_LAT + b * CTX_LEN;
            att::Job J{}; J.nt = CTX_LEN / 64; J.seg0_tiles = 0; J.row_seg0 = crow0; J.row_seg1 = crow0;
            J.Q = A.QM + (size_t)crow0 * NQ_MLA + h * MLA_QK; J.K = A.KM + h * MLA_QK; J.V = A.VM + h * MLA_V;
            J.O = A.Y + (size_t)crow0 * D_MODEL + GROUP_W + h * MLA_V; att::attn_unit<MLA_QK, false, NQ_MLA, NQ_MLA, NH * MLA_V, D_MODEL>(J, lds, sc_mla);
        }
        for (int u = wg - BATCH * NH; u >= 0 && u < BATCH * NH; u += G) {
            const int b = u / NH, h = u % NH; const int crow0 = M_LAT + b * CTX_LEN;
            att::Job J{}; J.nt = CTX_LEN / 64; J.seg0_tiles = 0; J.row_seg0 = crow0; J.row_seg1 = crow0;
            J.Q = A.NQ + (size_t)crow0 * GROUP_W + h * HD; J.K = A.NK + h * HD; J.V = A.P + C_NV + h * HD;
            J.O = A.Y + (size_t)crow0 * D_MODEL + 3 * GROUP_W + h * HD; att::attn_unit<HD, false, GROUP_W, GROUP_W, NP, D_MODEL>(J, lds, sc_na);
        }
    }
}

template <class Epi> __global__ void __launch_bounds__(512, 2) k_gemm(pg8::Gemm g, Epi E) {
    extern __shared__ __attribute__((aligned(16))) unsigned char shm[];
    pg8::StaticOrder S; S.init(g.M, g.N, (int)gridDim.x, (int)blockIdx.x);
    pg8::gemm_phase<Epi, pg8::StaticOrder, true, true>((PG8_LAS unsigned char*)shm, g, S, E);
}
constexpr int GEMM_LDS = pg8::STAGE_BYTES;
static int g_grid = 0;
template <class Epi> static void gemm_launch(hipStream_t st, const bf16_t* A, const bf16_t* Bt, int M, int N, int K, const Epi& E) {
    static bool attr_done = false;
    if (!attr_done) { (void)hipFuncSetAttribute((const void*)k_gemm<Epi>, hipFuncAttributeMaxDynamicSharedMemorySize, GEMM_LDS); attr_done = true; }
    pg8::Gemm g; memset(&g, 0, sizeof(g)); g.A = A; g.Bt = Bt; g.M = M; g.N = N; g.K = K;
    hipLaunchKernelGGL(k_gemm<Epi>, dim3(g_grid), dim3(512), GEMM_LDS, st, g, E);
}
void gemm_bf16out(STREAM_T st, const bf16_t* A, const bf16_t* Bt, int M, int N, int K, bf16_t* O, int ldc) {
    pg8::EpiBf16<0> E; memset(&E, 0, sizeof(E)); E.O = O; E.ldc = ldc; E.bias = nullptr; E.split_cols = 0; E.split_stride = 0; E.scale0 = 1.0f; gemm_launch(st, A, Bt, M, N, K, E); }
void gemm_f32out(STREAM_T st, const bf16_t* A, const bf16_t* Bt, int M, int N, int K, float* C, int ldc) {
    pg8::EpiF32 E; memset(&E, 0, sizeof(E)); E.C = C; E.ldc = ldc; gemm_launch(st, A, Bt, M, N, K, E); }
void gemm_gate_res(STREAM_T st, const bf16_t* A, const bf16_t* Bt, int M, int N, int K, const float* base, float* out, int ldc, const float* gate) {
    pg8::EpiGateRes E; memset(&E, 0, sizeof(E)); E.base = base; E.out = out; E.ldc = ldc; E.gate = gate; E.set_stride = NMODV; E.rows_per_set = SEQ; E.nsets_lat = BATCH; E.lat_rows = M_LAT; gemm_launch(st, A, Bt, M, N, K, E); }


#ifdef FAST_ATTN
__global__ void __launch_bounds__(512, 2) k_attn_phase(AttnArgs A) {
    extern __shared__ __attribute__((aligned(16))) unsigned char shm[];
    attention_phase(A, (char*)shm, (int)gridDim.x, (int)blockIdx.x);
}
void fast_attention(STREAM_T st, const WS& w, const float* rpb, bool want_ctx) {
    static bool attr_done = false; constexpr int LDSB = att::Cfg<MLA_QK>::LDS_BYTES;
    if (!attr_done) { (void)hipFuncSetAttribute((const void*)k_attn_phase, hipFuncAttributeMaxDynamicSharedMemorySize, LDSB); attr_done = true; }
    AttnArgs A; memset(&A, 0, sizeof(A)); A.QM = w.QM; A.KM = w.KM; A.VM = w.VM; A.NQ = w.NQ; A.NK = w.NK; A.P = w.P; A.Y = w.Y; A.rpb = rpb; A.want_ctx = want_ctx ? 1 : 0;
    hipLaunchKernelGGL(k_attn_phase, dim3(g_grid), dim3(512), LDSB, st, A);
}
#endif

#ifdef FAST_GDN
__global__ void __launch_bounds__(512, 2) k_g1(gdn::G1Args A) { extern __shared__ __attribute__((aligned(16))) unsigned char shm[]; gdn::g1_phase(A, (char*)shm, (int)gridDim.x, (int)blockIdx.x); }
__global__ void __launch_bounds__(512, 2) k_g2(gdn::Bufs B) { extern __shared__ __attribute__((aligned(16))) unsigned char shm[]; gdn::g2_chain(B, (char*)shm, (int)blockIdx.x); }
__global__ void __launch_bounds__(512, 2) k_g3(gdn::G3Args A) { extern __shared__ __attribute__((aligned(16))) unsigned char shm[]; gdn::g3_phase(A, (char*)shm, (int)gridDim.x, (int)blockIdx.x); }
void fast_gdn(STREAM_T st, const WS& w, const float* conv_w, const float* a_log, const float* dt_bias, const float* norm_g) {
    static bool attr_done = false;
    if (!attr_done) { (void)hipFuncSetAttribute((const void*)k_g1, hipFuncAttributeMaxDynamicSharedMemorySize, gdn::G1_LDS); (void)hipFuncSetAttribute((const void*)k_g2, hipFuncAttributeMaxDynamicSharedMemorySize, gdn::G2_LDS); attr_done = true; }
    gdn::Bufs B; memset(&B, 0, sizeof(B)); B.UT = w.gUT; B.WP = w.gWP; B.KDT = w.gKDT; B.QD = w.gQD; B.QK = w.gQK; B.SIT = w.gSIT; B.VNT = w.gVNT; B.GT = w.gGT;
    gdn::G1Args A1; memset(&A1, 0, sizeof(A1)); A1.P = w.P; A1.conv_w = conv_w; A1.a_log = a_log; A1.dt_bias = dt_bias; A1.B = B;
    hipLaunchKernelGGL(k_g1, dim3(g_grid), dim3(512), gdn::G1_LDS, st, A1);
    hipLaunchKernelGGL(k_g2, dim3(BATCH * NH * 2), dim3(512), gdn::G2_LDS, st, B);
    gdn::G3Args A3; memset(&A3, 0, sizeof(A3)); A3.B = B; A3.P = w.P; A3.norm_g = norm_g; A3.Y = w.Y;
    hipLaunchKernelGGL(k_g3, dim3(g_grid), dim3(512), gdn::G3_LDS, st, A3);
}
#endif

extern "C" void kernel_launch(void* const* d_in, const int* in_sizes, int n_in, void* d_out, int out_size, void* d_ws, size_t ws_size, hipStream_t stream) {
    if (g_grid == 0) { int dev = 0, cus = 0; (void)hipGetDevice(&dev); (void)hipDeviceGetAttribute(&cus, hipDeviceAttributeMultiprocessorCount, dev); g_grid = cus > 0 ? cus : 256; }
    const WS w = ws_carve(d_ws);
    if (n_in != 34 || w.total > ws_size) { fprintf(stderr, "kernel_launch: bad inputs / workspace (need %zu, have %zu)\n", w.total, ws_size); return; }
    const Inputs I = make_inputs(d_in);
    run_forward(I, (float*)d_out, w, stream);
}
```

```cpp
#include <hip/hip_runtime.h>
#include <cstdio>
#include <cstdint>
#include <cstring>
#include <math.h>
#include <stdint.h>

#ifdef CFG_SMALL
constexpr int D_MODEL = 256, BATCH = 2, SEQ = 512, DEPTH = 2, CTX_LEN = 64, GRID_W = 32, HEAD_DIM = 16;
#else
constexpr int D_MODEL = 2048, BATCH = 2, SEQ = 8192, DEPTH = 4, CTX_LEN = 256, GRID_W = 64, HEAD_DIM = 128;
#endif
constexpr int GROUP_W = D_MODEL / 4, NH = GROUP_W / HEAD_DIM;
constexpr int HD = HEAD_DIM;
constexpr int N_MOD = 6;
constexpr float EPS = 1e-6f;
constexpr int LRU_W = GROUP_W, LRU_BW = LRU_W / NH;
constexpr float LRU_C = 8.0f;
constexpr int MLA_Q_LORA = 3 * D_MODEL / 16, MLA_KV_LORA = D_MODEL / 8, MLA_NOPE = HD, MLA_ROPE = HD / 2, MLA_V = HD, MLA_QK = MLA_NOPE + MLA_ROPE;
constexpr int GDN_CHUNK = 64;
constexpr int NA_KH = 8, NA_KW = 16;
constexpr int D_FF = 5 * D_MODEL / 2;
constexpr int ROWS = SEQ / GRID_W;
constexpr int C_LRU_X = 0, C_LRU_G = C_LRU_X + LRU_W, C_CQ = C_LRU_G + LRU_W, C_CKV = C_CQ + MLA_Q_LORA, C_KR = C_CKV + MLA_KV_LORA,
              C_GQ = C_KR + MLA_ROPE, C_GK = C_GQ + GROUP_W, C_GV = C_GK + GROUP_W, C_GG = C_GV + GROUP_W, C_GB = C_GG + GROUP_W,
              C_GA = C_GB + 2 * NH, C_NQ = C_GA + 2 * NH, C_NK = C_NQ + GROUP_W, C_NV = C_NK + GROUP_W, IN_COLS = C_NV + GROUP_W;
constexpr int NP = (IN_COLS + 255) / 256 * 256;
constexpr int M_LAT = BATCH * SEQ, M_CTX = BATCH * CTX_LEN, M_ALL = M_LAT + M_CTX;
constexpr int NMODV = N_MOD * D_MODEL;

typedef unsigned short bf16_t;
__host__ __device__ __forceinline__ bf16_t f2bf(float f) { union { float f; unsigned u; } v; v.f = f; unsigned u = v.u; u += 0x7fffu + ((u >> 16) & 1u); return (bf16_t)(u >> 16); }
__host__ __device__ __forceinline__ float bf2f(bf16_t b) { union { float f; unsigned u; } v; v.u = ((unsigned)b) << 16; return v.f; }
__host__ __device__ __forceinline__ float sigmoidf_(float x) { return 1.0f / (1.0f + expf(-x)); }
__host__ __device__ __forceinline__ float siluf_(float x) { return x / (1.0f + expf(-x)); }
__host__ __device__ __forceinline__ float softplusf_(float x) { return fmaxf(x, 0.0f) + log1pf(expf(-fabsf(x))); }
__host__ __device__ __forceinline__ float geluf_(float x) { return 0.5f * x * (1.0f + tanhf(0.7978845608028654f * (x + 0.044715f * x * x * x))); }

struct RowInfo { int b, t, T, base, set; };
__host__ __device__ __forceinline__ RowInfo row_info(int r) {
    RowInfo i;
    if (r < M_LAT) { i.b = r / SEQ; i.t = r % SEQ; i.T = SEQ; i.base = i.b * SEQ; i.set = i.b; }
    else { const int rr = r - M_LAT; i.b = rr / CTX_LEN; i.t = rr % CTX_LEN; i.T = CTX_LEN; i.base = M_LAT + i.b * CTX_LEN; i.set = BATCH; }
    return i;
}


__host__ __device__ __forceinline__ float bflo(unsigned w) { union { float f; unsigned u; } v; v.u = w << 16; return v.f; }
__host__ __device__ __forceinline__ float bfhi(unsigned w) { union { float f; unsigned u; } v; v.u = w & 0xffff0000u; return v.f; }
__device__ __forceinline__ float lane_xor(float v, int mask, int lane) { return __int_as_float(__builtin_amdgcn_ds_bpermute((lane ^ mask) << 2, __float_as_int(v))); }
__device__ __forceinline__ float lane_get(float v, int src_lane) { return __int_as_float(__builtin_amdgcn_ds_bpermute(src_lane << 2, __float_as_int(v))); }
struct Inputs {
    const float *x, *c, *ctx, *c_ctx, *ada_w, *ada_b, *norm_mix_g, *norm_ffn_g, *w_in, *w_out,
        *lru_conv_w, *lru_conv_b, *lru_wa, *lru_ba, *lru_wx, *lru_bx, *lru_lam,
        *mla_qa_g, *mla_w_uq, *mla_kva_g, *mla_w_ukv, *mla_qn_g, *mla_kn_g,
        *gdn_conv_w, *gdn_a_log, *gdn_dt_bias, *gdn_norm_g, *na_qn_g, *na_kn_g, *na_rpb,
        *ffn_w_up, *ffn_conv_w, *ffn_conv_b, *ffn_w_down;
};
constexpr int NQ_MLA = NH * MLA_QK, NKV_MLA = NH * (MLA_NOPE + MLA_V);
constexpr size_t SZ_WIN = (size_t)NP * D_MODEL, SZ_WOUT = (size_t)D_MODEL * D_MODEL, SZ_WUP = (size_t)2 * D_FF * D_MODEL, SZ_WDOWN = (size_t)D_MODEL * D_FF,
                 SZ_WUQ = (size_t)NQ_MLA * MLA_Q_LORA, SZ_WUKV = (size_t)NKV_MLA * MLA_KV_LORA, SZ_WLRU = (size_t)16 * LRU_BW * LRU_BW;
struct WS {
    unsigned* ctl; float *MOD, *H; bf16_t *U, *Y;
    bf16_t *WIN, *WOUT, *WUP, *WDOWN, *WUQ, *WUKV, *WLRU;
    bf16_t* P; bf16_t *CQN, *CKVN; float *QR, *KVR; bf16_t *QM, *KM, *VM, *NQ, *NK;
    bf16_t *gUT, *gWP, *gKDT, *gQD, *gQK, *gSIT, *gVNT; float* gGT;
    bf16_t *lHLOC, *lACUM; float *lLSUM, *lHIN;
    bf16_t *UP, *ACT;
    size_t total;
};
__host__ __device__ inline WS ws_carve(void* base) {
    WS w; size_t off = 0; char* b = (char*)base;
#define WS_TAKE(T, field, bytes) do { w.field = (T*)(b + off); off += (((size_t)(bytes)) + 255) & ~(size_t)255; } while (0)
    WS_TAKE(unsigned, ctl, 1 << 20);
    WS_TAKE(float, MOD, sizeof(float) * (size_t)DEPTH * (BATCH + 1) * NMODV);
    WS_TAKE(float, H, sizeof(float) * (size_t)M_ALL * D_MODEL);
    WS_TAKE(bf16_t, U, 2 * (size_t)M_ALL * D_MODEL);
    WS_TAKE(bf16_t, Y, 2 * (size_t)M_ALL * D_MODEL);
    WS_TAKE(bf16_t, WIN, 2 * SZ_WIN * DEPTH); WS_TAKE(bf16_t, WOUT, 2 * SZ_WOUT * DEPTH); WS_TAKE(bf16_t, WUP, 2 * SZ_WUP * DEPTH); WS_TAKE(bf16_t, WDOWN, 2 * SZ_WDOWN * DEPTH);
    WS_TAKE(bf16_t, WUQ, 2 * SZ_WUQ * DEPTH); WS_TAKE(bf16_t, WUKV, 2 * SZ_WUKV * DEPTH); WS_TAKE(bf16_t, WLRU, 2 * SZ_WLRU * DEPTH);
    const size_t r0 = off;
    WS_TAKE(bf16_t, P, 2 * (size_t)M_ALL * NP);
    WS_TAKE(bf16_t, CQN, 2 * (size_t)M_ALL * MLA_Q_LORA); WS_TAKE(bf16_t, CKVN, 2 * (size_t)M_ALL * MLA_KV_LORA);
    WS_TAKE(float, QR, 4 * (size_t)M_ALL * NQ_MLA); WS_TAKE(float, KVR, 4 * (size_t)M_ALL * NKV_MLA);
    WS_TAKE(bf16_t, QM, 2 * (size_t)M_ALL * NQ_MLA); WS_TAKE(bf16_t, KM, 2 * (size_t)M_ALL * NQ_MLA); WS_TAKE(bf16_t, VM, 2 * (size_t)M_ALL * NH * MLA_V);
    WS_TAKE(bf16_t, NQ, 2 * (size_t)M_ALL * GROUP_W); WS_TAKE(bf16_t, NK, 2 * (size_t)M_ALL * GROUP_W);
    { constexpr size_t NT_ = (size_t)(M_ALL / 64) * NH * 2;
      WS_TAKE(bf16_t, gUT, 2 * NT_ * 128 * 64); WS_TAKE(bf16_t, gWP, 2 * NT_ * 64 * 128); WS_TAKE(bf16_t, gKDT, 2 * NT_ * 128 * 64); WS_TAKE(bf16_t, gQD, 2 * NT_ * 64 * 128);
      WS_TAKE(bf16_t, gQK, 2 * NT_ * 64 * 64); WS_TAKE(bf16_t, gSIT, 2 * NT_ * 128 * 128); WS_TAKE(bf16_t, gVNT, 2 * NT_ * 128 * 64); WS_TAKE(float, gGT, 4 * NT_); }
    WS_TAKE(bf16_t, lHLOC, 2 * (size_t)2 * M_ALL * LRU_W); WS_TAKE(bf16_t, lACUM, 2 * (size_t)2 * M_ALL * LRU_W);
    WS_TAKE(float, lLSUM, 4 * (size_t)(M_ALL / 64) * 2 * 2 * LRU_W); WS_TAKE(float, lHIN, 4 * (size_t)(M_ALL / 64) * 2 * LRU_W);
    const size_t r1 = off;
    off = r0;
    WS_TAKE(bf16_t, UP, 2 * (size_t)M_ALL * 2 * D_FF); WS_TAKE(bf16_t, ACT, 2 * (size_t)M_ALL * D_FF);
    const size_t f1 = off;
#undef WS_TAKE
    w.total = r1 > f1 ? r1 : f1;
    return w;
}

namespace pg8 {
#define PG8_LAS __attribute__((address_space(3)))
typedef unsigned short bf16_t;
typedef short bf16x8 __attribute__((ext_vector_type(8)));
typedef float f32x4 __attribute__((ext_vector_type(4)));
typedef unsigned u32x4 __attribute__((ext_vector_type(4)));
constexpr int BM = 256, BK = 64, HALF = 128, HTB = HALF * BK * 2  , STAGE_BYTES = 8 * HTB, NXCD = 8, WGM = 8;

__host__ __device__ __forceinline__ int lds_byte(int r, int c) { const int st = (r >> 4) * 2 + (c >> 5), rr = r & 15, cc = c & 31, ob = rr * 64 + cc * 2; return st * 1024 + (ob ^ (((ob >> 9) & 1) << 5)); }
__host__ __device__ __forceinline__ void stage_rc(int b, int& R, int& C) { const int st = b / 1024, sb = b % 1024, swz = sb ^ (((sb >> 9) & 1) << 5); R = (st >> 1) * 16 + swz / 64; C = (st & 1) * 32 + (swz % 64) / 2; }
__host__ __device__ __forceinline__ int perm32(int rho) { const int n = rho >> 4, i = rho & 15; return 8 * (i >> 2) + 4 * n + (i & 3); }

struct Unit { int pm, pn; };
struct Gemm { const bf16_t* A; const bf16_t* Bt; int M, N, K; };

struct StaticOrder {
    int nM, nN, nwg, G, c;
    __host__ __device__ void init(int M, int N, int G_, int c_) { nM = M / BM; nN = N / BM; nwg = nM * nN; G = G_; c = c_; }
    __host__ __device__ bool next(int i, Unit& u) const {
        const long L = (long)i * G + c; if (L >= nwg) return false;
        int wgid = (int)L; { const int q = nwg / NXCD, r = nwg % NXCD, xcd = wgid % NXCD, off = wgid / NXCD; wgid = (xcd < r ? xcd * (q + 1) : r * (q + 1) + (xcd - r) * q) + off; }
        const int nig = WGM * nN, gid = wgid / nig, fm = gid * WGM, gsz = (nM - fm) < WGM ? (nM - fm) : WGM;
        u.pm = fm + ((wgid % nig) % gsz); u.pn = (wgid % nig) / gsz; return true;
    }
    __device__ __forceinline__ void a_ready(const Unit&) const {}
    __device__ __forceinline__ void done(const Unit&) const {}
};
__device__ __forceinline__ unsigned cvt_pk_bf16(float lo, float hi) { unsigned r; asm volatile("v_cvt_pk_bf16_f32 %0, %1, %2" : "=v"(r) : "v"(lo), "v"(hi)); return r; }
typedef float f32x2 __attribute__((ext_vector_type(2)));
__device__ __forceinline__ f32x2 gelu_pk(f32x2 v) {
    const f32x2 av = __builtin_elementwise_abs(v), d = av * 0.2316418882f + 1.0f;
    f32x2 t; t.x = __builtin_amdgcn_rcpf(d.x); t.y = __builtin_amdgcn_rcpf(d.y);
    f32x2 q = t * 0.5307027145f + (-0.7265760135f); q = q * t + 0.7107068705f; q = q * t + (-0.142248368f); q = q * t + 0.127414796f; q = q * t;
    const f32x2 s = (v * v) * (-0.72134752044f);
    f32x2 e; e.x = __builtin_amdgcn_exp2f(s.x); e.y = __builtin_amdgcn_exp2f(s.y);
    const f32x2 m = v * (q * e), r = v - m;
    f32x2 o; o.x = v.x < 0.f ? m.x : r.x; o.y = v.y < 0.f ? m.y : r.y; return o;
}

template <int ACT  > struct EpiBf16 {
    static constexpr bool PERM = true, AFTER_DRAIN = false; static_assert(ACT == 0 || ACT == 1, "EpiBf16: ACT is 0 (none) or 1 (gelu_pk)");
    bf16_t* O; int ldc; const float* bias; int split_cols; size_t split_stride; float scale0;
    __device__ __forceinline__ void operator()(const f32x4 (&acc)[2][2][4][2], const Unit& u, int wr, int wc, int fr, int fq) const {
        const int row0 = u.pm * BM + wr * 64 + fr; int colt = u.pn * BM; bf16_t* base = O;
        float sc = 1.f; if (split_cols) { const int t = colt / split_cols; base += (size_t)t * split_stride; colt -= t * split_cols; if (t == 0) sc = scale0; }
        const int col0 = colt + wc * 32 + 8 * fq, bcol0 = u.pn * BM + wc * 32 + 8 * fq;
        f32x4 bv[2][2];
#pragma unroll
        for (int bj = 0; bj < 2; ++bj)
#pragma unroll
            for (int n = 0; n < 2; ++n) bv[bj][n] = bias ? *(const f32x4*)(bias + bcol0 + bj * HALF + 4 * n) : (f32x4){0.f, 0.f, 0.f, 0.f};
#pragma unroll
        for (int ai = 0; ai < 2; ++ai)
#pragma unroll
            for (int m = 0; m < 4; ++m) { bf16_t* rowp = base + (size_t)(row0 + ai * HALF + m * 16) * ldc + col0;
#pragma unroll
                for (int bj = 0; bj < 2; ++bj) { f32x4 v0 = acc[ai][bj][m][0] + bv[bj][0], v1 = acc[ai][bj][m][1] + bv[bj][1];
                    if (ACT == 1) { f32x2 a = gelu_pk((f32x2){v0[0], v0[1]}), b = gelu_pk((f32x2){v0[2], v0[3]}), c = gelu_pk((f32x2){v1[0], v1[1]}), d = gelu_pk((f32x2){v1[2], v1[3]});
                        v0 = (f32x4){a.x, a.y, b.x, b.y}; v1 = (f32x4){c.x, c.y, d.x, d.y}; }
                    v0 = v0 * sc; v1 = v1 * sc; u32x4 w; w.x = cvt_pk_bf16(v0[0], v0[1]); w.y = cvt_pk_bf16(v0[2], v0[3]); w.z = cvt_pk_bf16(v1[0], v1[1]); w.w = cvt_pk_bf16(v1[2], v1[3]);
                    *(u32x4*)(rowp + bj * HALF) = w; } }
    }
};

struct EpiF32 {
    static constexpr bool PERM = false, AFTER_DRAIN = false;
    float* C; int ldc;
    __device__ __forceinline__ void operator()(const f32x4 (&acc)[2][2][4][2], const Unit& u, int wr, int wc, int fr, int fq) const {
        const int row0 = u.pm * BM + wr * 64 + fr, col0 = u.pn * BM + wc * 32 + 4 * fq;
#pragma unroll
        for (int ai = 0; ai < 2; ++ai)
#pragma unroll
            for (int m = 0; m < 4; ++m) { float* rowp = C + (size_t)(row0 + ai * HALF + m * 16) * ldc + col0;
#pragma unroll
                for (int bj = 0; bj < 2; ++bj)
#pragma unroll
                    for (int n = 0; n < 2; ++n) *(f32x4*)(rowp + bj * HALF + n * 16) = acc[ai][bj][m][n]; }
    }
};
struct EpiGateRes {
    static constexpr bool PERM = false, AFTER_DRAIN = false;
    const float* base; float* out; int ldc; const float* gate; int set_stride; int rows_per_set; int nsets_lat; int lat_rows;
    __device__ __forceinline__ void operator()(const f32x4 (&acc)[2][2][4][2], const Unit& u, int wr, int wc, int fr, int fq) const {
        const int row0 = u.pm * BM + wr * 64 + fr, col0 = u.pn * BM + wc * 32 + 4 * fq;
        const int set = (u.pm * BM >= lat_rows) ? nsets_lat : (u.pm * BM) / rows_per_set;
        const float* gp = gate + (size_t)set * set_stride + col0;
        f32x4 gv[2][2];
#pragma unroll
        for (int bj = 0; bj < 2; ++bj)
#pragma unroll
            for (int n = 0; n < 2; ++n) gv[bj][n] = *(const f32x4*)(gp + bj * HALF + n * 16);
#pragma unroll
        for (int ai = 0; ai < 2; ++ai)
#pragma unroll
            for (int m = 0; m < 4; ++m) { const size_t off = (size_t)(row0 + ai * HALF + m * 16) * ldc + col0;
#pragma unroll
                for (int bj = 0; bj < 2; ++bj)
#pragma unroll
                    for (int n = 0; n < 2; ++n) { const f32x4 b = *(const f32x4*)(base + off + bj * HALF + n * 16); *(f32x4*)(out + off + bj * HALF + n * 16) = b + gv[bj][n] * acc[ai][bj][m][n]; } }
    }
};

template <class Epi, class Sched, bool ALIGN_EPI = false, bool SP2 = false>
__device__ __forceinline__ void gemm_phase(PG8_LAS unsigned char* lds, const Gemm g, const Sched& S, const Epi& E, const int tid_in) {
    int tid_ = tid_in; asm volatile("" : "+v"(tid_));
    const int tid = tid_, wid = __builtin_amdgcn_readfirstlane(tid >> 6), lane = tid & 63, wr = wid >> 2, wc = wid & 3, fr = lane & 15, fq = lane >> 4;
    const int K = g.K, nt = K / BK;
    unsigned voffA[2], voffB[2];
#pragma unroll
    for (int i = 0; i < 2; ++i) { int R, C; stage_rc(tid * 16 + i * 8192, R, C); const int Rb = Epi::PERM ? ((R & ~31) + perm32(R & 31)) : R;
        voffA[i] = (unsigned)(R * K + C) * 2u; voffB[i] = (unsigned)(Rb * K + C) * 2u; }
    const size_t kstep = (size_t)(BK * 2);
    const size_t hstep = (size_t)HALF * K * 2;
    const size_t tstep = 2 * hstep;
    const unsigned ldsw = (unsigned)wid * 1024u;
    const int aoff = lds_byte(wr * 64 + fr, fq * 8), boff = lds_byte(wc * 32 + fr, fq * 8);
#define PG8_SA(b, h) (((b) * 2 + (h)) * HTB)
#define PG8_SB(b, h) ((4 + (b) * 2 + (h)) * HTB)
#define PG8_STAGE(bufoff, gbase, voff) do { _Pragma("unroll") for (int _i = 0; _i < 2; ++_i) \
        __builtin_amdgcn_global_load_lds((const unsigned*)((const char*)(gbase) + (voff)[_i]), (PG8_LAS unsigned*)(lds + (bufoff) + ldsw + _i * 8192), 16, 0, 0); } while (0)
#define PG8_LDA(dst, b, h) do { _Pragma("unroll") for (int m = 0; m < 4; ++m) _Pragma("unroll") for (int k = 0; k < 2; ++k) dst[m][k] = *(const PG8_LAS bf16x8*)(lds + PG8_SA(b, h) + aoff + m * 2048 + k * 1024); } while (0)
#define PG8_LDB(dst, b, h) do { _Pragma("unroll") for (int n = 0; n < 2; ++n) _Pragma("unroll") for (int k = 0; k < 2; ++k) dst[n][k] = *(const PG8_LAS bf16x8*)(lds + PG8_SB(b, h) + boff + n * 2048 + k * 1024); } while (0)
#define PG8_MMA(ai, bj, At, Bt) do { __builtin_amdgcn_s_setprio(1); _Pragma("unroll") for (int m = 0; m < 4; ++m) _Pragma("unroll") for (int n = 0; n < 2; ++n) _Pragma("unroll") for (int k = 0; k < 2; ++k) \
        acc[ai][bj][m][n] = __builtin_amdgcn_mfma_f32_16x16x32_bf16(Bt[n][k], At[m][k], acc[ai][bj][m][n], 0, 0, 0); __builtin_amdgcn_s_setprio(0); } while (0)
#define PG8_WAIT_V(n) asm volatile("s_waitcnt vmcnt(" #n ")" ::: "memory")
#define PG8_WAIT_L(n) asm volatile("s_waitcnt lgkmcnt(" #n ")" ::: "memory")
#define PG8_BAR __builtin_amdgcn_s_barrier()
#define PG8_SCHED __builtin_amdgcn_sched_barrier(0)
    Unit cur, nxt; int ui = 0;
    if (!S.next(0, cur)) return;
    f32x4 acc[2][2][4][2];
#pragma unroll
    for (int a = 0; a < 2; ++a)
#pragma unroll
        for (int b = 0; b < 2; ++b)
#pragma unroll
            for (int m = 0; m < 4; ++m)
#pragma unroll
                for (int n = 0; n < 2; ++n) acc[a][b][m][n] = (f32x4){0.f, 0.f, 0.f, 0.f};
    bf16x8 At[4][2], B0[2][2], B1[2][2];
    const char* cA = (const char*)g.A + (size_t)cur.pm * tstep; const char* cB = (const char*)g.Bt + (size_t)cur.pn * tstep;
    S.a_ready(cur);
    if constexpr (SP2) {
        PG8_STAGE(PG8_SB(0, 0), cB, voffB); PG8_STAGE(PG8_SB(0, 1), cB + hstep, voffB); PG8_STAGE(PG8_SA(0, 0), cA, voffA); PG8_STAGE(PG8_SA(0, 1), cA + hstep, voffA);
        if (wr == 1) PG8_BAR;
        PG8_WAIT_V(2); PG8_BAR;
        PG8_STAGE(PG8_SB(1, 0), cB + kstep, voffB); PG8_STAGE(PG8_SA(1, 0), cA + kstep, voffA); PG8_STAGE(PG8_SB(1, 1), cB + hstep + kstep, voffB);
        PG8_WAIT_V(6); PG8_BAR;
    } else {
        PG8_STAGE(PG8_SB(0, 0), cB, voffB); PG8_STAGE(PG8_SA(0, 0), cA, voffA); PG8_STAGE(PG8_SB(0, 1), cB + hstep, voffB); PG8_STAGE(PG8_SA(0, 1), cA + hstep, voffA);
        if (wr == 1) PG8_BAR;
        PG8_WAIT_V(4); PG8_BAR;
        PG8_STAGE(PG8_SB(1, 0), cB + kstep, voffB); PG8_STAGE(PG8_SA(1, 0), cA + kstep, voffA); PG8_STAGE(PG8_SB(1, 1), cB + hstep + kstep, voffB);
        PG8_WAIT_V(6); PG8_BAR;
    }
    for (;;) {
        const bool has_next = S.next(ui + 1, nxt);
        const char* nA = has_next ? (const char*)g.A + (size_t)nxt.pm * tstep : cA; const char* nB = has_next ? (const char*)g.Bt + (size_t)nxt.pn * tstep : cB;
        for (int t = 0; t < nt; t += 2) {
            const bool last = (t == nt - 2);
            const char* a1 = cA + (size_t)(t + 1) * kstep;
            const char* a2 = last ? nA : cA + (size_t)(t + 2) * kstep; const char* b2 = last ? nB : cB + (size_t)(t + 2) * kstep;
            const char* a3 = a2 + kstep; const char* b3 = b2 + kstep;
            if (last && has_next) S.a_ready(nxt);
            if constexpr (SP2) {
            PG8_LDB(B0, 0, 0); PG8_LDB(B1, 0, 1); PG8_SCHED; PG8_LDA(At, 0, 0); PG8_STAGE(PG8_SA(1, 1), a1 + hstep, voffA);
            PG8_WAIT_V(8); PG8_WAIT_L(0); PG8_BAR; PG8_MMA(0, 0, At, B0); PG8_MMA(0, 1, At, B1); PG8_BAR; PG8_SCHED;
            PG8_LDA(At, 0, 1); PG8_STAGE(PG8_SB(0, 0), b2, voffB); PG8_STAGE(PG8_SB(0, 1), b2 + hstep, voffB); PG8_STAGE(PG8_SA(0, 0), a2, voffA);
            PG8_WAIT_V(8); PG8_WAIT_L(0); PG8_BAR; PG8_MMA(1, 0, At, B0); PG8_MMA(1, 1, At, B1); PG8_BAR; PG8_SCHED;
            PG8_LDB(B0, 1, 0); PG8_LDB(B1, 1, 1); PG8_SCHED; PG8_LDA(At, 1, 0); PG8_STAGE(PG8_SA(0, 1), a2 + hstep, voffA);
            PG8_WAIT_V(8); PG8_WAIT_L(0); PG8_BAR; PG8_MMA(0, 0, At, B0); PG8_MMA(0, 1, At, B1); PG8_BAR; PG8_SCHED;
            PG8_LDA(At, 1, 1); PG8_STAGE(PG8_SB(1, 0), b3, voffB); PG8_STAGE(PG8_SB(1, 1), b3 + hstep, voffB); PG8_STAGE(PG8_SA(1, 0), a3, voffA);
            PG8_WAIT_V(8); PG8_WAIT_L(0); PG8_BAR; PG8_MMA(1, 0, At, B0); PG8_MMA(1, 1, At, B1); PG8_BAR; PG8_SCHED;
            } else {
            PG8_LDB(B0, 0, 0); PG8_SCHED; PG8_LDA(At, 0, 0); PG8_STAGE(PG8_SA(1, 1), a1 + hstep, voffA);
            PG8_WAIT_L(8); PG8_BAR; PG8_WAIT_L(0); PG8_MMA(0, 0, At, B0); PG8_BAR; PG8_SCHED;
            PG8_LDB(B1, 0, 1); PG8_STAGE(PG8_SB(0, 0), b2, voffB);
            PG8_BAR; PG8_WAIT_L(0); PG8_MMA(0, 1, At, B1); PG8_BAR;
            PG8_LDA(At, 0, 1); PG8_STAGE(PG8_SA(0, 0), a2, voffA);
            PG8_BAR; PG8_WAIT_L(0); PG8_MMA(1, 0, At, B0); PG8_BAR; PG8_SCHED;
            PG8_STAGE(PG8_SB(0, 1), b2 + hstep, voffB);
            PG8_WAIT_V(6); PG8_BAR; PG8_MMA(1, 1, At, B1); PG8_BAR;
            PG8_LDB(B0, 1, 0); PG8_SCHED; PG8_LDA(At, 1, 0); PG8_STAGE(PG8_SA(0, 1), a2 + hstep, voffA);
            PG8_WAIT_L(8); PG8_BAR; PG8_WAIT_L(0); PG8_MMA(0, 0, At, B0); PG8_BAR; PG8_SCHED;
            PG8_LDB(B1, 1, 1); PG8_STAGE(PG8_SB(1, 0), b3, voffB);
            PG8_BAR; PG8_WAIT_L(0); PG8_MMA(0, 1, At, B1); PG8_BAR;
            PG8_LDA(At, 1, 1); PG8_STAGE(PG8_SA(1, 0), a3, voffA);
            PG8_BAR; PG8_WAIT_L(0); PG8_MMA(1, 0, At, B0); PG8_BAR; PG8_SCHED;
            PG8_STAGE(PG8_SB(1, 1), b3 + hstep, voffB);
            PG8_WAIT_V(6); PG8_BAR; PG8_MMA(1, 1, At, B1); PG8_BAR;
            }
        }
        if constexpr (ALIGN_EPI) { if (wr == 0) PG8_BAR; }
        if constexpr (!Epi::AFTER_DRAIN) { E(acc, cur, wr, wc, fr, fq); S.done(cur); }
        if (!has_next) break;
#pragma unroll
        for (int a = 0; a < 2; ++a)
#pragma unroll
            for (int b = 0; b < 2; ++b)
#pragma unroll
                for (int m = 0; m < 4; ++m)
#pragma unroll
                    for (int n = 0; n < 2; ++n) acc[a][b][m][n] = (f32x4){0.f, 0.f, 0.f, 0.f};
        cur = nxt; cA = nA; cB = nB; ++ui;
        if constexpr (ALIGN_EPI) { if (wr == 1) PG8_BAR; }
    }
    PG8_WAIT_V(0);
    if constexpr (!ALIGN_EPI) { if (wr == 0) PG8_BAR; }
    PG8_BAR;
    if constexpr (Epi::AFTER_DRAIN) { E.fused(acc, cur, wr, wc, fr, fq, lds, wid, lane); S.done(cur); }
#undef PG8_SA
#undef PG8_SB
#undef PG8_STAGE
#undef PG8_LDA
#undef PG8_LDB
#undef PG8_MMA
#undef PG8_WAIT_V
#undef PG8_WAIT_L
#undef PG8_BAR
#undef PG8_SCHED
}
}

namespace att {
using bf16x8 = __attribute__((ext_vector_type(8))) short;
using s16x4  = __attribute__((ext_vector_type(4))) short;
using f32x16 = __attribute__((ext_vector_type(16))) float;
using u32x4  = __attribute__((ext_vector_type(4))) unsigned;
constexpr int NW = 8, QBLK = 32, KVBLK = 64, DV = 128;
#define ATT_SBAR() __builtin_amdgcn_sched_barrier(0)
__device__ __forceinline__ int crow(int r, int hi) { return (r & 3) + 8 * (r >> 2) + 4 * hi; }
__device__ __forceinline__ unsigned cvtpk(float lo, float hi) { unsigned r; asm volatile("v_cvt_pk_bf16_f32 %0, %1, %2" : "=v"(r) : "v"(lo), "v"(hi)); return r; }
template <int DQK> __device__ __forceinline__ int kswz(int row, int colB) { return row * (DQK * 2) + (colB ^ ((row & 7) << 4)); }
constexpr float THR = 8.f;

template <int DQK> struct Cfg {
    static constexpr int SHM_V = KVBLK * DV * 2, SHM_K = KVBLK * DQK * 2;
    static constexpr int OFF_V = 0, OFF_K = 2 * SHM_V, OFF_WS = OFF_K + 2 * SHM_K, OFF_BIAS = OFF_WS + NW * 64 * 4, LDS_BYTES = OFF_BIAS + 10240;
    static constexpr int KCH = DQK / 8;
    static constexpr int KLD = (64 * KCH) / 512;
};

struct Job {
    const bf16_t* Q;
    const bf16_t* K;
    const bf16_t* V;
    bf16_t* O;
    int nt;
    int seg0_tiles, row_seg0, row_seg1;
    int R0; int rlo;
};

__device__ __forceinline__ int tile_row(const Job& J, int j) {
    if (j < J.seg0_tiles) return J.row_seg0 + 64 * j;
    int jj = j - J.seg0_tiles; if (jj > 3) jj = 0; return J.row_seg1 + 64 * jj;
}

__device__ __forceinline__ void partialSM(f32x16& p0, f32x16& p1, float& m_reg, float& mn, float& alpha, float C, float thr_raw) {
    float pmax = p0[0];
#pragma unroll
    for (int r = 1; r < 16; ++r) pmax = fmaxf(pmax, p0[r]);
#pragma unroll
    for (int r = 0; r < 16; ++r) pmax = fmaxf(pmax, p1[r]);
    { auto rr = __builtin_amdgcn_permlane32_swap(__float_as_uint(pmax), __float_as_uint(pmax), false, false);
      pmax = fmaxf(__uint_as_float(rr[0]), __uint_as_float(rr[1])); }
    if (__builtin_expect(__all(pmax - m_reg <= thr_raw), 1)) { mn = m_reg; alpha = 1.f; }
    else { mn = fmaxf(m_reg, pmax); alpha = __builtin_amdgcn_exp2f((m_reg - mn) * C); m_reg = mn; }
    const float mnC = -mn * C;
#pragma unroll
    for (int r = 0; r < 16; ++r) p0[r] = fmaf(p0[r], C, mnC);
#pragma unroll
    for (int r = 0; r < 16; ++r) p1[r] = fmaf(p1[r], C, mnC);
#pragma unroll
    for (int r = 0; r < 16; ++r) p0[r] = __builtin_amdgcn_exp2f(p0[r]);
}
__device__ __forceinline__ void finishSM(f32x16& p0, f32x16& p1, float alpha, float& l_reg, bf16x8& pa0, bf16x8& pa1, bf16x8& pa2, bf16x8& pa3) {
#pragma unroll
    for (int r = 0; r < 16; ++r) p1[r] = __builtin_amdgcn_exp2f(p1[r]);
    float ps = 0;
#pragma unroll
    for (int r = 0; r < 16; ++r) ps += p0[r];
#pragma unroll
    for (int r = 0; r < 16; ++r) ps += p1[r];
    { auto rr = __builtin_amdgcn_permlane32_swap(__float_as_uint(ps), __float_as_uint(ps), false, false);
      ps = __uint_as_float(rr[0]) + __uint_as_float(rr[1]); }
    l_reg = l_reg * alpha + ps;
#define ATT_PK4(P, BASE, OUT) do { unsigned a0 = cvtpk(P[BASE + 0], P[BASE + 1]), a1 = cvtpk(P[BASE + 2], P[BASE + 3]);   \
    unsigned b0 = cvtpk(P[BASE + 4], P[BASE + 5]), b1 = cvtpk(P[BASE + 6], P[BASE + 7]);                              \
    auto r0 = __builtin_amdgcn_permlane32_swap(a0, b0, false, false); auto r1 = __builtin_amdgcn_permlane32_swap(a1, b1, false, false); \
    u32x4 w = {r0[0], r1[0], r0[1], r1[1]}; OUT = *reinterpret_cast<bf16x8*>(&w); } while (0)
    ATT_PK4(p0, 0, pa0); ATT_PK4(p0, 8, pa1); ATT_PK4(p1, 0, pa2); ATT_PK4(p1, 8, pa3);
#undef ATT_PK4
}
template <int DQK> __device__ __forceinline__ void qkt(f32x16& p0, f32x16& p1, const char* Ks, const bf16x8* qr, int r32, int hi) {
    p0 = f32x16{}; p1 = f32x16{};
#pragma unroll
    for (int d0 = 0; d0 < DQK / 16; ++d0) { const int cb = (d0 * 16 + hi * 8) * 2;
        const bf16x8 b0 = *reinterpret_cast<const bf16x8*>(Ks + kswz<DQK>(r32, cb));
        const bf16x8 b1 = *reinterpret_cast<const bf16x8*>(Ks + kswz<DQK>(32 + r32, cb));
        p0 = __builtin_amdgcn_mfma_f32_32x32x16_bf16(b0, qr[d0], p0, 0, 0, 0);
        p1 = __builtin_amdgcn_mfma_f32_32x32x16_bf16(b1, qr[d0], p1, 0, 0, 0); }
}
__device__ __forceinline__ int v_st(int k, int c) { const int kk = (k & ~0xC) | ((k & 4) << 1) | ((k & 8) >> 1); return ((kk >> 3) * 4 + (c >> 5)) * 512 + ((kk & 7) * 32 + (c & 31)) * 2; }
__device__ __forceinline__ int v_rd_base(int lane) { return ((lane & 3) << 3) | (((lane >> 2) & 3) << 6) | (((lane >> 4) & 1) << 5) | (((lane >> 5) & 1) << 8); }
constexpr int v_rd_off(int d0, int ks, int half) { return d0 * 512 + ks * 4096 + half * 2048; }
template <int OFF> __device__ __forceinline__ s16x4 tr_read(int vb) { s16x4 r; asm volatile("ds_read_b64_tr_b16 %0, %1 offset:%2" : "=&v"(r) : "v"(vb), "i"(OFF) : "memory"); return r; }
template <int D0> __device__ __forceinline__ void pv_one(f32x16& od, int vb, bf16x8 pa0, bf16x8 pa1, bf16x8 pa2, bf16x8 pa3) {
    const s16x4 l0 = tr_read<v_rd_off(D0, 0, 0)>(vb), h0 = tr_read<v_rd_off(D0, 0, 1)>(vb), l1 = tr_read<v_rd_off(D0, 1, 0)>(vb), h1 = tr_read<v_rd_off(D0, 1, 1)>(vb);
    const s16x4 l2 = tr_read<v_rd_off(D0, 2, 0)>(vb), h2 = tr_read<v_rd_off(D0, 2, 1)>(vb), l3 = tr_read<v_rd_off(D0, 3, 0)>(vb), h3 = tr_read<v_rd_off(D0, 3, 1)>(vb);
    asm volatile("s_waitcnt lgkmcnt(0)" ::: "memory"); ATT_SBAR();
#define ATT_PK(L, H) (bf16x8){L[0], L[1], L[2], L[3], H[0], H[1], H[2], H[3]}
    od = __builtin_amdgcn_mfma_f32_32x32x16_bf16(pa0, ATT_PK(l0, h0), od, 0, 0, 0);
    od = __builtin_amdgcn_mfma_f32_32x32x16_bf16(pa1, ATT_PK(l1, h1), od, 0, 0, 0);
    od = __builtin_amdgcn_mfma_f32_32x32x16_bf16(pa2, ATT_PK(l2, h2), od, 0, 0, 0);
    od = __builtin_amdgcn_mfma_f32_32x32x16_bf16(pa3, ATT_PK(l3, h3), od, 0, 0, 0);
#undef ATT_PK
}
__device__ __forceinline__ void pv_d0(f32x16* o, int vb, bf16x8 pa0, bf16x8 pa1, bf16x8 pa2, bf16x8 pa3) {
    pv_one<0>(o[0], vb, pa0, pa1, pa2, pa3); pv_one<1>(o[1], vb, pa0, pa1, pa2, pa3); pv_one<2>(o[2], vb, pa0, pa1, pa2, pa3); pv_one<3>(o[3], vb, pa0, pa1, pa2, pa3);
}
constexpr int NA_BROW = 160, NA_BORG = 64 + (NA_KW - 1);
__device__ __forceinline__ void na_bias(f32x16& p0, f32x16& p1, const Job& J, int j, int R, int c, int hi, const float* biasq) {
    const int nloc = J.seg0_tiles;
    if (j >= nloc && j < nloc + 4) return;
    const int rr = J.rlo + j; int r0 = R - NA_KH / 2; r0 = r0 < 0 ? 0 : (r0 > ROWS - NA_KH ? ROWS - NA_KH : r0);
    const bool rowok = (j < nloc) && rr >= r0 && rr < r0 + NA_KH;
    if (!rowok) {
#pragma unroll
        for (int r = 0; r < 16; ++r) { p0[r] = -1e30f; p1[r] = -1e30f; }
        return; }
    int c0 = c - NA_KW / 2; c0 = c0 < 0 ? 0 : (c0 > GRID_W - NA_KW ? GRID_W - NA_KW : c0);
    const int dr = rr - R + (NA_KH - 1);
    const float* bl = biasq + dr * NA_BROW + NA_BORG + 4 * hi - c;
    const int vb = 4 * hi - c0;
#pragma unroll
    for (int r = 0; r < 16; ++r) { const int cc = (r & 3) + 8 * (r >> 2);
        p0[r] = ((unsigned)(cc + vb) < (unsigned)NA_KW) ? p0[r] + bl[cc] : -1e30f;
        p1[r] = ((unsigned)(cc + 32 + vb) < (unsigned)NA_KW) ? p1[r] + bl[cc + 32] : -1e30f; }
}

#define ATT_LAS __attribute__((address_space(3)))
template <int DQK, bool NA, int LDQ, int LDK, int LDV, int LDO>
__device__ __forceinline__ void attn_unit(const Job& J, char* lds, const float scale, const int tid_in) {
    using C_ = Cfg<DQK>;
    int tid_ = tid_in; asm volatile("" : "+v"(tid_));
    const int tid = tid_, wid = __builtin_amdgcn_readfirstlane(tid >> 6), lane = tid & 63, r32 = lane & 31, hi = lane >> 5;
    char* V_lds = lds + C_::OFF_V; char* K_lds = lds + C_::OFF_K;
    const unsigned ldsb = (unsigned)(uintptr_t)lds;
    float* wsf = (float*)(lds + C_::OFF_WS) + wid * 64; float* li_l = wsf; float* al_l = wsf + 32;
    const float* biasq = (const float*)(lds + C_::OFF_BIAS);
    const float Cc = scale * 1.4426950408889634f, thr_raw = THR / scale;
    float m_reg = -1e5f, l_reg = 0; f32x16 o[4] = {}; bf16x8 qr[DQK / 16];
    const bf16_t* Qw = J.Q + (long)(wid * QBLK + r32) * LDQ + hi * 8;
#pragma unroll
    for (int d0 = 0; d0 < DQK / 16; ++d0) qr[d0] = *reinterpret_cast<const bf16x8*>(Qw + d0 * 16);
    const int naR = J.R0 + (wid >> 1), nac = (wid & 1) * 32 + r32;
    const int vb0 = (int)(uintptr_t)V_lds + v_rd_base(lane);
    unsigned koff[C_::KLD], voff[2];
#pragma unroll
    for (int i = 0; i < C_::KLD; ++i) { const int sl = 512 * i + tid, row = sl / C_::KCH, cs = sl % C_::KCH, chunk = (cs & ~7) | ((cs & 7) ^ (row & 7)); koff[i] = (unsigned)(row * LDK * 2 + chunk * 16); }
#pragma unroll
    for (int i = 0; i < 2; ++i) { const int sl = 512 * i + tid, sub = sl >> 5, wi = sl & 31, kk = (sub >> 2) * 8 + (wi >> 2), k = (kk & ~0xC) | ((kk & 4) << 1) | ((kk & 8) >> 1), c = (sub & 3) * 32 + (wi & 3) * 8;
        voff[i] = (unsigned)(k * LDV * 2 + c * 2); }
#define ATT_STAGE(j, b) do { const int row0_ = tile_row(J, (j)); const char* vp_ = (const char*)(J.V + (size_t)row0_ * LDV); const char* kp_ = (const char*)(J.K + (size_t)row0_ * LDK); \
        _Pragma("unroll") for (int i_ = 0; i_ < C_::KLD; ++i_) __builtin_amdgcn_global_load_lds((const unsigned*)(kp_ + koff[i_]), (ATT_LAS unsigned*)(ldsb + C_::OFF_K + (b) * C_::SHM_K + (512 * i_ + 64 * wid) * 16), 16, 0, 0); \
        _Pragma("unroll") for (int i_ = 0; i_ < 2; ++i_) __builtin_amdgcn_global_load_lds((const unsigned*)(vp_ + voff[i_]), (ATT_LAS unsigned*)(ldsb + C_::OFF_V + (b) * C_::SHM_V + (512 * i_ + 64 * wid) * 16), 16, 0, 0); } while (0)
    const int NT = J.nt;
    __syncthreads();
    ATT_STAGE(0, 0); asm volatile("s_waitcnt vmcnt(0)" ::: "memory"); __syncthreads();
    for (int j = 0; j < NT; ++j) {
        const int buf = j & 1;
        if (j + 1 < NT) ATT_STAGE(j + 1, buf ^ 1);
        f32x16 p0, p1; float mn, al; bf16x8 pa0, pa1, pa2, pa3;
        qkt<DQK>(p0, p1, K_lds + buf * C_::SHM_K, qr, r32, hi);
        if (NA) na_bias(p0, p1, J, j, naR, nac, hi, biasq);
        partialSM(p0, p1, m_reg, mn, al, Cc, thr_raw);
        finishSM(p0, p1, al, l_reg, pa0, pa1, pa2, pa3);
        if (__any(al < 1.f)) { if (hi == 0) al_l[r32] = al; asm volatile("s_waitcnt lgkmcnt(0)" ::: "memory");
#pragma unroll
            for (int d = 0; d < 4; ++d)
#pragma unroll
                for (int r = 0; r < 16; ++r) o[d][r] *= al_l[crow(r, hi)]; }
        ATT_SBAR();
        pv_d0(o, vb0 + buf * C_::SHM_V, pa0, pa1, pa2, pa3);
        asm volatile("s_waitcnt vmcnt(0)" ::: "memory");
        __syncthreads();
    }
    if (hi == 0) li_l[r32] = l_reg; asm volatile("s_waitcnt lgkmcnt(0)" ::: "memory");
    float rli[16];
#pragma unroll
    for (int r = 0; r < 16; ++r) rli[r] = __builtin_amdgcn_rcpf(li_l[crow(r, hi)]);
    bf16_t* Ow = J.O + (long)(wid * QBLK) * LDO;
#pragma unroll
    for (int r = 0; r < 16; ++r) { const int orow = crow(r, hi);
#pragma unroll
        for (int d0 = 0; d0 < 4; ++d0) Ow[(long)orow * LDO + d0 * 32 + r32] = f2bf(o[d0][r] * rli[r]); }
#undef ATT_STAGE
}
}

struct AttnArgs { const bf16_t *QM, *KM, *VM, *NQ, *NK, *P; bf16_t* Y; const float* rpb; int want_ctx; int pad; };
__device__ __forceinline__ void attention_phase(const AttnArgs& A, char* lds, int G, int wg, const int tid) {
    static_assert(GRID_W == 64 && SEQ % 256 == 0 && CTX_LEN == 256 && HD == 128, "attention phase geometry");
    constexpr int NQB = SEQ / 256;
    constexpr float sc_mla = 0.07216878364870323f, sc_na = 0.08838834764831845f;
    static_assert(MLA_QK == 192 && HD == 128, "softmax scales");
    for (int u = wg; u < BATCH * NH * NQB; u += G) {
        const int bh = u % (BATCH * NH), qb = u / (BATCH * NH), b = bh / NH, h = bh % NH;
        att::Job J{};
        J.Q = A.QM + (size_t)(b * SEQ + qb * 256) * NQ_MLA + h * MLA_QK; J.K = A.KM + h * MLA_QK; J.V = A.VM + h * MLA_V;
        J.O = A.Y + (size_t)(b * SEQ + qb * 256) * D_MODEL + GROUP_W + h * MLA_V;
        J.nt = SEQ / 64 + CTX_LEN / 64; J.seg0_tiles = SEQ / 64; J.row_seg0 = b * SEQ; J.row_seg1 = M_LAT + b * CTX_LEN;
        att::attn_unit<MLA_QK, false, NQ_MLA, NQ_MLA, NH * MLA_V, D_MODEL>(J, lds, sc_mla, tid);
    }
    for (int u = wg; u < BATCH * NH * NQB; u += G) {
        const int bh = u % (BATCH * NH), qb = u / (BATCH * NH), b = bh / NH, h = bh % NH, R0 = qb * 4;
        __syncthreads();
        { float* bq = (float*)(lds + att::Cfg<HD>::OFF_BIAS); const float* src = A.rpb + (size_t)h * (2 * NA_KH - 1) * (2 * NA_KW - 1);
          for (int i = tid; i < (2 * NA_KH - 1) * att::NA_BROW; i += 512) { const int dr = i / att::NA_BROW; int dc = i % att::NA_BROW - att::NA_BORG + (NA_KW - 1); dc = dc < 0 ? 0 : (dc > 2 * NA_KW - 2 ? 2 * NA_KW - 2 : dc);
              bq[i] = src[dr * (2 * NA_KW - 1) + dc] * 11.313708498984761f; } }
        int rlo = R0 - NA_KH / 2; rlo = rlo < 0 ? 0 : (rlo > ROWS - NA_KH ? ROWS - NA_KH : rlo);
        int rhi = R0 + 3 - NA_KH / 2; rhi = (rhi < 0 ? 0 : (rhi > ROWS - NA_KH ? ROWS - NA_KH : rhi)) + NA_KH - 1;
        const int nloc = rhi - rlo + 1;
        att::Job J{};
        J.Q = A.NQ + (size_t)(b * SEQ + R0 * 64) * GROUP_W + h * HD; J.K = A.NK + h * HD; J.V = A.P + C_NV + h * HD;
        J.O = A.Y + (size_t)(b * SEQ + R0 * 64) * D_MODEL + 3 * GROUP_W + h * HD;
        J.nt = (nloc + 4 + 1) & ~1; J.seg0_tiles = nloc; J.row_seg0 = b * SEQ + rlo * 64; J.row_seg1 = M_LAT + b * CTX_LEN;  J.R0 = R0; J.rlo = rlo;
        att::attn_unit<HD, true, GROUP_W, GROUP_W, NP, D_MODEL>(J, lds, sc_na, tid);
    }
    if (A.want_ctx) {
        for (int u = wg; u < BATCH * NH; u += G) {
            const int b = u / NH, h = u % NH; const int crow0 = M_LAT + b * CTX_LEN;
            att::Job J{}; J.nt = CTX_LEN / 64; J.seg0_tiles = 0; J.row_seg0 = crow0; J.row_seg1 = crow0;
            J.Q = A.QM + (size_t)crow0 * NQ_MLA + h * MLA_QK; J.K = A.KM + h * MLA_QK; J.V = A.VM + h * MLA_V;
            J.O = A.Y + (size_t)crow0 * D_MODEL + GROUP_W + h * MLA_V; att::attn_unit<MLA_QK, false, NQ_MLA, NQ_MLA, NH * MLA_V, D_MODEL>(J, lds, sc_mla, tid);
        }
        for (int u = wg - BATCH * NH; u >= 0 && u < BATCH * NH; u += G) {
            const int b = u / NH, h = u % NH; const int crow0 = M_LAT + b * CTX_LEN;
            att::Job J{}; J.nt = CTX_LEN / 64; J.seg0_tiles = 0; J.row_seg0 = crow0; J.row_seg1 = crow0;
            J.Q = A.NQ + (size_t)crow0 * GROUP_W + h * HD; J.K = A.NK + h * HD; J.V = A.P + C_NV + h * HD;
            J.O = A.Y + (size_t)crow0 * D_MODEL + 3 * GROUP_W + h * HD; att::attn_unit<HD, false, GROUP_W, GROUP_W, NP, D_MODEL>(J, lds, sc_na, tid);
        }
    }
}

namespace gdn {
typedef short bf16x8 __attribute__((ext_vector_type(8)));
typedef float f32x4 __attribute__((ext_vector_type(4)));
typedef float f32x16 __attribute__((ext_vector_type(16)));
typedef unsigned u32x2 __attribute__((ext_vector_type(2)));
typedef unsigned u32x4 __attribute__((ext_vector_type(4)));
constexpr int CH = 64, NCHUNK = M_ALL / CH;
constexpr int NTASK = NCHUNK * NH * 2;
constexpr size_t SZ_UT = 128 * 64, SZ_WP = 64 * 128, SZ_KDT = 128 * 64, SZ_QD = 64 * 128, SZ_QK = 64 * 64, SZ_SIT = 128 * 128, SZ_VNT = 128 * 64;
struct Bufs { bf16_t *UT, *WP, *KDT, *QD, *QK, *SIT, *VNT; float* GT; };
__device__ __forceinline__ int perm32(int o) { return (o & ~31) | (((o & 15) >> 2) * 8 + ((o >> 4) & 1) * 4 + (o & 3)); }
__device__ __forceinline__ unsigned pk2(float lo, float hi) { return (unsigned)f2bf(lo) | ((unsigned)f2bf(hi) << 16); }

constexpr int QS = 132;
constexpr int AS = 68;
constexpr int G1_OFF_Q = 0, G1_OFF_K = G1_OFF_Q + CH * QS * 4, G1_OFF_V = G1_OFF_K + CH * QS * 4, G1_OFF_AA = G1_OFF_V + CH * QS * 4, G1_OFF_SM = G1_OFF_AA + 2 * CH * AS * 4,
              G1_LDS = G1_OFF_SM + 8 * 64 * 4;
struct G1Args { const bf16_t* P; const float* conv_w; const float* a_log; const float* dt_bias; Bufs B; };

__device__ __forceinline__ void g1_task(const G1Args& A, char* lds, int cix, int h, const int tid_in) {
    int tid_ = tid_in; asm volatile("" : "+v"(tid_));
    const int tid = tid_, wid = __builtin_amdgcn_readfirstlane(tid >> 6), lane = tid & 63;
    float* Qs = (float*)(lds + G1_OFF_Q); float* Ks = (float*)(lds + G1_OFF_K); float* Vs = (float*)(lds + G1_OFF_V); float* AA = (float*)(lds + G1_OFF_AA);
    float* sm = (float*)(lds + G1_OFF_SM); float* g_s = sm;   float* beta_s = sm + 128;   float* gc_s = sm + 256;
    const int row0 = cix * CH; const RowInfo r0i = row_info(row0);
    __syncthreads();
    for (int e = tid; e < CH * 3 * HD; e += 512) {
        const int i = e / (3 * HD), c = e % (3 * HD), which = c / HD, cc = c % HD, ch = which * GROUP_W + h * HD + cc;
        float acc = 0.f;
#pragma unroll
        for (int j = 0; j < 4; ++j) { const int tt = r0i.t + i + j - 1; if (tt >= 0 && tt < r0i.T) acc += A.conv_w[j * 3 * GROUP_W + ch] * bf2f(A.P[(size_t)(r0i.base + tt) * NP + C_GQ + ch]); }
        const float y = acc / (1.0f + __expf(-acc));
        (which == 0 ? Qs : which == 1 ? Ks : Vs)[i * QS + cc] = y;
    }
    if (tid < 128) { const int d = tid >> 6, i = tid & 63; const size_t r = (size_t)(row0 + i) * NP;
        beta_s[d * 64 + i] = 1.0f / (1.0f + __expf(-bf2f(A.P[r + C_GB + d * NH + h])));
        g_s[d * 64 + i] = -__expf(A.a_log[d * NH + h]) * softplusf_(bf2f(A.P[r + C_GA + d * NH + h]) + A.dt_bias[d * NH + h]); }
    __syncthreads();
    for (int rr = wid; rr < 2 * CH; rr += 8) { float* rowp = (rr < CH ? Qs : Ks) + (rr & 63) * QS;
        const float a = rowp[lane], b = rowp[lane + 64]; float ss = a * a + b * b;
#pragma unroll
        for (int o = 1; o < 64; o <<= 1) ss += lane_xor(ss, o, lane);
        const float scl = (1.0f / sqrtf(ss + EPS)) * (rr < CH ? 0.08838834764831845f : 1.0f);
        rowp[lane] = a * scl; rowp[lane + 64] = b * scl; }
    if (tid < 2) {
        f32x4 gv[16];
#pragma unroll
        for (int m = 0; m < 16; ++m) gv[m] = *(const f32x4*)(g_s + tid * 64 + 4 * m);
        float run = 0.f;
        if (tid == 0) {
#pragma unroll
            for (int m = 0; m < 16; ++m) { f32x4 o4;
#pragma unroll
                for (int e = 0; e < 4; ++e) { run += gv[m][e]; o4[e] = run; }
                *(f32x4*)(gc_s + 4 * m) = o4; }
        } else {
#pragma unroll
            for (int m = 15; m >= 0; --m) { f32x4 o4;
#pragma unroll
                for (int e = 3; e >= 0; --e) { run += gv[m][e]; o4[e] = run; }
                *(f32x4*)(gc_s + 64 + 4 * m) = o4; }
        }
    }
    __syncthreads();
    {
        const int which = wid >> 2, I = (wid >> 1) & 1, J = wid & 1, r32 = lane & 31, hi = lane >> 5;
        const float* X = (which ? Qs : Ks) + (32 * I + r32) * QS + 4 * hi; const float* Yp = Ks + (32 * J + r32) * QS + 4 * hi;
        f32x16 acc = {};
#pragma unroll
        for (int s = 0; s < 16; ++s) { const f32x4 a4 = *(const f32x4*)(X + 8 * s), b4 = *(const f32x4*)(Yp + 8 * s);
#pragma unroll
            for (int e = 0; e < 4; ++e) acc = __builtin_amdgcn_mfma_f32_32x32x2f32(a4[e], b4[e], acc, 0, 0, 0); }
        const int j = 32 * J + r32;
        const size_t t0 = ((size_t)cix * NH + h) * 2;
        if (which == 0) {
            const float b1j = beta_s[64 + j], g0j = gc_s[j], g1j = gc_s[64 + j];
#pragma unroll
            for (int r = 0; r < 16; ++r) { const int i = 32 * I + (r & 3) + 8 * (r >> 2) + 4 * hi;
                if (i > j) { const float kk = acc[r];
                    AA[(63 - j) * AS + (63 - i)] = beta_s[i] * kk * __expf(gc_s[i] - g0j);
                    AA[CH * AS + i * AS + j] = b1j * kk * __expf(g1j - gc_s[64 + i]); } }
        } else {
            bf16_t* q0 = A.B.QK + (t0 + 0) * SZ_QK; bf16_t* q1 = A.B.QK + (t0 + 1) * SZ_QK;
            const float g0j = gc_s[j], g1j = gc_s[64 + j];
#pragma unroll
            for (int r = 0; r < 16; ++r) { const int i = 32 * I + (r & 3) + 8 * (r >> 2) + 4 * hi; const float qk = acc[r];
                q0[i * 64 + j] = f2bf(i >= j ? qk * __expf(gc_s[i] - g0j) : 0.f);
                q1[(63 - i) * 64 + (63 - j)] = f2bf(i <= j ? qk * __expf(gc_s[64 + i] - g1j) : 0.f); }
        }
    }
    __syncthreads();
    {
        const size_t t0 = ((size_t)cix * NH + h) * 2;
        const int d = tid >> 8, k = tid & 127, ph = (tid >> 7) & 1;
        bf16_t* qd = A.B.QD + (t0 + d) * SZ_QD; bf16_t* kdt = A.B.KDT + (t0 + d) * SZ_KDT + (size_t)k * 64;
        const float glast = d == 0 ? gc_s[63] : gc_s[64 + 0];
#pragma unroll 8
        for (int pp = 0; pp < 32; ++pp) { const int p = ph * 32 + pp, i = d == 0 ? p : 63 - p; const float gci = gc_s[d * 64 + i];
            qd[p * 128 + k] = f2bf(Qs[i * QS + k] * __expf(gci));
            kdt[perm32(p)] = f2bf(Ks[i * QS + k] * __expf(glast - gci)); }
        if (tid == 0) { A.B.GT[t0] = __expf(gc_s[63]); A.B.GT[t0 + 1] = __expf(gc_s[64]); }
    }
    __syncthreads();
    {
        int tidv = tid; asm volatile("" : "+v"(tidv));
        const int d = tidv >> 8, c = tidv & 255; const bool isw = c >= 128; const int cc = c & 127;
        const float* src = isw ? Ks : Vs;
        int lz; asm volatile("v_mov_b32 %0, 0" : "=v"(lz));
        const float* AAv = AA + lz + d * (CH * AS);
        float x[CH];
#pragma unroll
        for (int p = 0; p < CH; ++p) { const int i = d == 0 ? p : 63 - p; float f = beta_s[d * 64 + i]; if (isw) f *= __expf(gc_s[d * 64 + i]); x[p] = f * src[i * QS + cc]; }
        {
#pragma unroll
            for (int p = 0; p < CH - 1; ++p) { const float xp = x[p]; const float* rowp = AAv + (63 - p) * AS;
#pragma unroll
                for (int m = 0; m <= (62 - p) / 4; ++m) { const f32x4 a4 = *(const f32x4*)(rowp + 4 * m);
#pragma unroll
                    for (int e = 0; e < 4; ++e) { const int col = 4 * m + e; if (col <= 62 - p) x[63 - col] -= a4[e] * xp; } } }
        }
        const size_t t = ((size_t)cix * NH + h) * 2 + d;
        if (!isw) { u32x4* dst = (u32x4*)(A.B.UT + t * SZ_UT + (size_t)cc * 64);
#pragma unroll
            for (int m = 0; m < 8; ++m) { u32x4 w4; w4.x = pk2(x[8 * m], x[8 * m + 1]); w4.y = pk2(x[8 * m + 2], x[8 * m + 3]); w4.z = pk2(x[8 * m + 4], x[8 * m + 5]); w4.w = pk2(x[8 * m + 6], x[8 * m + 7]); dst[m] = w4; }
        } else { bf16_t* dst = A.B.WP + t * SZ_WP + perm32(cc);
#pragma unroll
            for (int p = 0; p < CH; ++p) dst[p * 128] = f2bf(x[p]); }
    }
}
__device__ __forceinline__ void g1_phase(const G1Args& A, char* lds, int G, int wg, const int tid) {
    for (int t = wg; t < NCHUNK * NH; t += G) g1_task(A, lds, t / NH, t % NH, tid);
}

constexpr int WPS = 272, KDS = 144;
constexpr int G2_BUF = 64 * WPS + 128 * KDS, G2_LDS = 2 * G2_BUF;
__device__ __forceinline__ int g2_task_index(int b, int h, int d, int step) {
    constexpr int NC = CTX_LEN / CH, NL = SEQ / CH; int cix;
    if (step < NC) { const int n = d ? NC - 1 - step : step; cix = M_LAT / CH + b * NC + n; }
    else { const int s2 = step - NC, n = d ? NL - 1 - s2 : s2; cix = b * NL + n; }
    return (cix * NH + h) * 2 + d;
}
__device__ __forceinline__ void g2_chain(const Bufs& B, char* lds, int chain, const int tid_in) {
    int tid_ = tid_in; asm volatile("" : "+v"(tid_));
    const int tid = tid_, wid = __builtin_amdgcn_readfirstlane(tid >> 6), lane = tid & 63, q = lane >> 4, vl = lane & 15;
    const int d = chain & 1, h = (chain >> 1) % NH, b = chain / (2 * NH);
    constexpr int NSTEP = CTX_LEN / CH + SEQ / CH;
    f32x4 S[8];
#pragma unroll
    for (int kb = 0; kb < 8; ++kb) S[kb] = (f32x4){0.f, 0.f, 0.f, 0.f};
    u32x4 stw[2], stk[2];
#define G2_LOAD(ti) do { const u32x4* wp_ = (const u32x4*)(B.WP + (size_t)(ti) * SZ_WP); const u32x4* kp_ = (const u32x4*)(B.KDT + (size_t)(ti) * SZ_KDT); \
        stw[0] = wp_[tid]; stw[1] = wp_[tid + 512]; stk[0] = kp_[tid]; stk[1] = kp_[tid + 512]; } while (0)
#define G2_WRITE(buf) do { char* base_ = lds + (buf) * G2_BUF; \
        _Pragma("unroll") for (int i_ = 0; i_ < 2; ++i_) { const int id_ = tid + 512 * i_; \
            *(u32x4*)(base_ + (id_ >> 4) * WPS + (id_ & 15) * 16) = stw[i_]; *(u32x4*)(base_ + 64 * WPS + (id_ >> 3) * KDS + (id_ & 7) * 16) = stk[i_]; } } while (0)
    __syncthreads();
    { const int ti0 = g2_task_index(b, h, d, 0); G2_LOAD(ti0); G2_WRITE(0); }
    __syncthreads();
    for (int step = 0; step < NSTEP; ++step) {
        const int ti = g2_task_index(b, h, d, step), buf = step & 1;
        if (step + 1 < NSTEP) { const int tn = g2_task_index(b, h, d, step + 1); G2_LOAD(tn); }
        const char* wl = lds + buf * G2_BUF; const char* kl = wl + 64 * WPS;
        const bf16_t* ut = B.UT + (size_t)ti * SZ_UT + (size_t)(16 * wid + vl) * 64 + 4 * q;
        u32x2 uu[4];
#pragma unroll
        for (int rb = 0; rb < 4; ++rb) uu[rb] = *(const u32x2*)(ut + 16 * rb);
        const float gt = B.GT[ti];
        bf16_t* sit = B.SIT + (size_t)ti * SZ_SIT + (size_t)(16 * wid + vl) * 128 + 4 * q;
        bf16x8 sf[4];
#pragma unroll
        for (int s = 0; s < 4; ++s) { u32x4 w4; w4.x = pk2(S[2 * s][0], S[2 * s][1]); w4.y = pk2(S[2 * s][2], S[2 * s][3]); w4.z = pk2(S[2 * s + 1][0], S[2 * s + 1][1]); w4.w = pk2(S[2 * s + 1][2], S[2 * s + 1][3]);
            sf[s] = __builtin_bit_cast(bf16x8, w4);
            *(u32x2*)(sit + 32 * s) = (u32x2){w4.x, w4.y}; *(u32x2*)(sit + 32 * s + 16) = (u32x2){w4.z, w4.w}; }
        f32x4 vn[4];
#pragma unroll
        for (int rb = 0; rb < 4; ++rb) { f32x4 acc = {0.f, 0.f, 0.f, 0.f};
#pragma unroll
            for (int s = 0; s < 4; ++s) { const bf16x8 a = *(const bf16x8*)(wl + (16 * rb + vl) * WPS + s * 64 + q * 16);
                acc = __builtin_amdgcn_mfma_f32_16x16x32_bf16(a, sf[s], acc, 0, 0, 0); }
            vn[rb][0] = bflo(uu[rb].x) - acc[0]; vn[rb][1] = bfhi(uu[rb].x) - acc[1]; vn[rb][2] = bflo(uu[rb].y) - acc[2]; vn[rb][3] = bfhi(uu[rb].y) - acc[3]; }
        bf16_t* vnt = B.VNT + (size_t)ti * SZ_VNT + (size_t)(16 * wid + vl) * 64 + 4 * q;
        bf16x8 vf[2];
#pragma unroll
        for (int s = 0; s < 2; ++s) { u32x4 w4; w4.x = pk2(vn[2 * s][0], vn[2 * s][1]); w4.y = pk2(vn[2 * s][2], vn[2 * s][3]); w4.z = pk2(vn[2 * s + 1][0], vn[2 * s + 1][1]); w4.w = pk2(vn[2 * s + 1][2], vn[2 * s + 1][3]);
            vf[s] = __builtin_bit_cast(bf16x8, w4);
            *(u32x2*)(vnt + 32 * s) = (u32x2){w4.x, w4.y}; *(u32x2*)(vnt + 32 * s + 16) = (u32x2){w4.z, w4.w}; }
#pragma unroll
        for (int kb = 0; kb < 8; ++kb) { f32x4 acc = S[kb] * gt;
#pragma unroll
            for (int s = 0; s < 2; ++s) { const bf16x8 a = *(const bf16x8*)(kl + (16 * kb + vl) * KDS + s * 64 + q * 16);
                acc = __builtin_amdgcn_mfma_f32_16x16x32_bf16(a, vf[s], acc, 0, 0, 0); }
            S[kb] = acc; }
        if (step + 1 < NSTEP) G2_WRITE(buf ^ 1);
        __syncthreads();
    }
#undef G2_LOAD
#undef G2_WRITE
}

constexpr int G3_LDS = 8 * 64 * 4 * 2;
struct G3Args { Bufs B; const bf16_t* P; const float* norm_g; bf16_t* Y; };
__device__ __forceinline__ void g3_task(const G3Args& A, char* lds, int cix, int h, const int tid_in) {
    int tid_ = tid_in; asm volatile("" : "+v"(tid_));
    const int tid = tid_, wid = __builtin_amdgcn_readfirstlane(tid >> 6), lane = tid & 63, q = lane >> 4, vl = lane & 15;
    float* part = (float*)lds;
    f32x4 o[2][4];
#pragma unroll
    for (int d = 0; d < 2; ++d) {
        const size_t t = ((size_t)cix * NH + h) * 2 + d;
        const bf16_t* sit = A.B.SIT + t * SZ_SIT + (size_t)(16 * wid + vl) * 128 + 8 * q;
        const bf16_t* vnt = A.B.VNT + t * SZ_VNT + (size_t)(16 * wid + vl) * 64 + 8 * q;
        const bf16_t* qd = A.B.QD + t * SZ_QD + (size_t)vl * 128 + 8 * q;
        const bf16_t* qk = A.B.QK + t * SZ_QK + (size_t)vl * 64 + 8 * q;
        bf16x8 sf[4], vf[2];
#pragma unroll
        for (int s = 0; s < 4; ++s) sf[s] = *(const bf16x8*)(sit + 32 * s);
#pragma unroll
        for (int s = 0; s < 2; ++s) vf[s] = *(const bf16x8*)(vnt + 32 * s);
#pragma unroll
        for (int rb = 0; rb < 4; ++rb) { f32x4 acc = {0.f, 0.f, 0.f, 0.f};
#pragma unroll
            for (int s = 0; s < 4; ++s) acc = __builtin_amdgcn_mfma_f32_16x16x32_bf16(*(const bf16x8*)(qd + (size_t)rb * 16 * 128 + 32 * s), sf[s], acc, 0, 0, 0);
#pragma unroll
            for (int s = 0; s < 2; ++s) acc = __builtin_amdgcn_mfma_f32_16x16x32_bf16(*(const bf16x8*)(qk + (size_t)rb * 16 * 64 + 32 * s), vf[s], acc, 0, 0, 0);
            o[d][rb] = acc; }
    }
    f32x4 ot[4];
#pragma unroll
    for (int rb = 0; rb < 4; ++rb)
#pragma unroll
        for (int r = 0; r < 4; ++r) ot[rb][r] = o[0][rb][r] + lane_xor(o[1][3 - rb][3 - r], 48, lane);
    __syncthreads();
#pragma unroll
    for (int rb = 0; rb < 4; ++rb)
#pragma unroll
        for (int r = 0; r < 4; ++r) { float ss = ot[rb][r] * ot[rb][r];
#pragma unroll
            for (int of = 1; of < 16; of <<= 1) ss += lane_xor(ss, of, lane);
            if (vl == 0) part[wid * 64 + 16 * rb + 4 * q + r] = ss; }
    __syncthreads();
    const int v = 16 * wid + vl; const float ng = A.norm_g[v];
#pragma unroll
    for (int rb = 0; rb < 4; ++rb)
#pragma unroll
        for (int r = 0; r < 4; ++r) { const int tok = 16 * rb + 4 * q + r; float ss = 0.f;
#pragma unroll
            for (int w8 = 0; w8 < 8; ++w8) ss += part[w8 * 64 + tok];
            const float rstd = 1.0f / sqrtf(ss * (1.0f / HD) + EPS);
            const size_t row = (size_t)cix * CH + tok; const float gate = bf2f(A.P[row * NP + C_GG + h * HD + v]);
            A.Y[row * D_MODEL + 2 * GROUP_W + h * HD + v] = f2bf(ot[rb][r] * rstd * ng * (gate / (1.0f + __expf(-gate)))); }
}
__device__ __forceinline__ void g3_phase(const G3Args& A, char* lds, int G, int wg, const int tid) {
    for (int t = wg; t < NCHUNK * NH; t += G) g3_task(A, lds, t / NH, t % NH, tid);
}
}

namespace lru {
typedef short bf16x8 __attribute__((ext_vector_type(8)));
typedef float f32x4 __attribute__((ext_vector_type(4)));
typedef unsigned u32x2 __attribute__((ext_vector_type(2)));
typedef unsigned u32x4 __attribute__((ext_vector_type(4)));
constexpr int CH = 64, NCHUNK = M_ALL / CH;
constexpr int US = 129;
constexpr int UBS = 272;
constexpr int L_OFF_U = 0, L_OFF_UB = CH * US * 4, L_LDS = L_OFF_UB + CH * UBS;
constexpr size_t SZ_WBLK = (size_t)LRU_BW * LRU_BW;
struct Bufs { bf16_t* HLOC; bf16_t* ACUM; float* LSUM; float* HIN; };
struct LocalArgs { const bf16_t* P; const float* conv_w; const float* conv_b; const bf16_t* WG;   const float* ba; const float* bx; const float* lam; Bufs B; };

__device__ __forceinline__ unsigned pk2(float lo, float hi) { return (unsigned)f2bf(lo) | ((unsigned)f2bf(hi) << 16); }

__device__ __forceinline__ void local_task(const LocalArgs& A, char* lds, int cix, int nb, const int tid_in) {
    int tid_ = tid_in; asm volatile("" : "+v"(tid_));
    const int tid = tid_, wid = __builtin_amdgcn_readfirstlane(tid >> 6), lane = tid & 63, q = lane >> 4, tl = lane & 15;
    float* Us = (float*)(lds + L_OFF_U); char* Ub = lds + L_OFF_UB;
    const int row0 = cix * CH; const RowInfo r0i = row_info(row0);
    __syncthreads();
    for (int e = tid; e < CH * LRU_BW; e += 512) { const int i = e >> 7, c = e & 127, ch = nb * LRU_BW + c;
        float acc = A.conv_b[ch];
#pragma unroll
        for (int j = 0; j < 4; ++j) { const int tt = r0i.t + i + j - 1; if (tt >= 0 && tt < r0i.T) acc += A.conv_w[j * LRU_W + ch] * bf2f(A.P[(size_t)(r0i.base + tt) * NP + C_LRU_X + ch]); }
        Us[i * US + c] = acc; *(bf16_t*)(Ub + i * UBS + c * 2) = f2bf(acc); }
    __syncthreads();
    f32x4 acc[2][2][4];
#pragma unroll
    for (int d = 0; d < 2; ++d)
#pragma unroll
        for (int wh = 0; wh < 2; ++wh)
#pragma unroll
            for (int tb = 0; tb < 4; ++tb) acc[d][wh][tb] = (f32x4){0.f, 0.f, 0.f, 0.f};
#pragma unroll
    for (int s = 0; s < 4; ++s) {
        bf16x8 bfr[4];
#pragma unroll
        for (int tb = 0; tb < 4; ++tb) bfr[tb] = *(const bf16x8*)(Ub + (16 * tb + tl) * UBS + (32 * s + 8 * q) * 2);
#pragma unroll
        for (int d = 0; d < 2; ++d)
#pragma unroll
            for (int wh = 0; wh < 2; ++wh) { const bf16x8 a = *(const bf16x8*)(A.WG + ((size_t)((d * 2 + wh) * NH + nb)) * SZ_WBLK + (size_t)(16 * wid + tl) * LRU_BW + 32 * s + 8 * q);
#pragma unroll
                for (int tb = 0; tb < 4; ++tb) acc[d][wh][tb] = __builtin_amdgcn_mfma_f32_16x16x32_bf16(a, bfr[tb], acc[d][wh][tb], 0, 0, 0); }
    }
    const int chb = nb * LRU_BW + 16 * wid + 4 * q;
#pragma unroll
    for (int d = 0; d < 2; ++d) {
        float sp[4], bav[4], bxv[4];
#pragma unroll
        for (int r = 0; r < 4; ++r) { sp[r] = -LRU_C * softplusf_(-A.lam[d * LRU_W + chb + r]); bav[r] = A.ba[d * LRU_W + chb + r]; bxv[r] = A.bx[d * LRU_W + chb + r]; }
        float Ac[4], Bc[4];
#pragma unroll
        for (int r = 0; r < 4; ++r) { Ac[r] = 1.f; Bc[r] = 0.f; }
#pragma unroll
        for (int tbi = 0; tbi < 4; ++tbi) { const int tb = d == 0 ? tbi : 3 - tbi; const int tok = 16 * tb + tl;
            float a[4], b[4];
#pragma unroll
            for (int r = 0; r < 4; ++r) { const float rr = 1.0f / (1.0f + __expf(-(acc[d][0][tb][r] + bav[r]))), ii = 1.0f / (1.0f + __expf(-(acc[d][1][tb][r] + bxv[r])));
                const float log_a = sp[r] * rr; a[r] = __expf(log_a); b[r] = sqrtf(-expm1f(2.0f * log_a)) * ii * Us[tok * US + 16 * wid + 4 * q + r]; }
#pragma unroll
            for (int off = 1; off < 16; off <<= 1) {
#pragma unroll
                for (int r = 0; r < 4; ++r) { const int src = d == 0 ? tl - off : tl + off; const bool ok = d == 0 ? (tl >= off) : (tl + off < 16);
                    const int sl = (lane & ~15) | (src & 15); const float ap = lane_get(a[r], sl), bp = lane_get(b[r], sl);
                    if (ok) { b[r] = a[r] * bp + b[r]; a[r] = a[r] * ap; } } }
#pragma unroll
            for (int r = 0; r < 4; ++r) { b[r] = a[r] * Bc[r] + b[r]; a[r] = a[r] * Ac[r]; }
            { const size_t o = ((size_t)d * M_ALL + row0 + tok) * LRU_W + chb;
              *(u32x2*)(A.B.HLOC + o) = (u32x2){pk2(b[0], b[1]), pk2(b[2], b[3])}; *(u32x2*)(A.B.ACUM + o) = (u32x2){pk2(a[0], a[1]), pk2(a[2], a[3])}; }
#pragma unroll
            for (int r = 0; r < 4; ++r) { const int sl = (lane & ~15) | (d == 0 ? 15 : 0); Ac[r] = lane_get(a[r], sl); Bc[r] = lane_get(b[r], sl); }
        }
        if (tl == 0) { float* ls = A.B.LSUM + (((size_t)cix * 2 + d) * 2) * LRU_W + chb;
            *(f32x4*)ls = (f32x4){Ac[0], Ac[1], Ac[2], Ac[3]}; *(f32x4*)(ls + LRU_W) = (f32x4){Bc[0], Bc[1], Bc[2], Bc[3]}; }
    }
}
__device__ __forceinline__ void local_phase(const LocalArgs& A, char* lds, int G, int wg, const int tid) {
    for (int t = wg; t < NCHUNK * NH; t += G) local_task(A, lds, t / NH, t % NH, tid);
}
__device__ __forceinline__ void carry_phase(const Bufs& B, int gtid, int gthreads) {
    constexpr int NC = CTX_LEN / CH, NL = SEQ / CH;
    for (int i = gtid; i < BATCH * 2 * LRU_W; i += gthreads) { const int ch = i % LRU_W, d = (i / LRU_W) & 1, b = i / (2 * LRU_W);
        float h = 0.f;
        for (int s0 = 0; s0 < NC + NL; s0 += 12) {
            float av[12], bv[12]; int cx[12];
#pragma unroll
            for (int u = 0; u < 12; ++u) { const int step = s0 + u; int cix = 0;
                if (step < NC) { const int n = d ? NC - 1 - step : step; cix = M_LAT / CH + b * NC + n; }
                else if (step < NC + NL) { const int s2 = step - NC, n = d ? NL - 1 - s2 : s2; cix = b * NL + n; }
                cx[u] = cix; const float* ls = B.LSUM + (((size_t)cix * 2 + d) * 2) * LRU_W + ch; av[u] = ls[0]; bv[u] = ls[LRU_W]; }
#pragma unroll
            for (int u = 0; u < 12; ++u) if (s0 + u < NC + NL) { B.HIN[((size_t)cx[u] * 2 + d) * LRU_W + ch] = h; h = av[u] * h + bv[u]; }
        }
    }
}
__device__ __forceinline__ void finish_phase(const Bufs& B, const bf16_t* P, bf16_t* Y, int gtid, int gthreads) {
    for (int it = gtid; it < M_ALL * (LRU_W / 8); it += gthreads) { const int row = it / (LRU_W / 8), c0 = (it % (LRU_W / 8)) * 8, cix = row / CH;
        const u32x4 h0 = *(const u32x4*)(B.HLOC + (size_t)row * LRU_W + c0), a0 = *(const u32x4*)(B.ACUM + (size_t)row * LRU_W + c0);
        const u32x4 h1 = *(const u32x4*)(B.HLOC + ((size_t)M_ALL + row) * LRU_W + c0), a1 = *(const u32x4*)(B.ACUM + ((size_t)M_ALL + row) * LRU_W + c0);
        const u32x4 gt = *(const u32x4*)(P + (size_t)row * NP + C_LRU_G + c0);
        const float* i0 = B.HIN + ((size_t)cix * 2 + 0) * LRU_W + c0; const float* i1 = B.HIN + ((size_t)cix * 2 + 1) * LRU_W + c0;
        const f32x4 i0a = *(const f32x4*)i0, i0b = *(const f32x4*)(i0 + 4), i1a = *(const f32x4*)i1, i1b = *(const f32x4*)(i1 + 4);
        float y[8];
#pragma unroll
        for (int j = 0; j < 4; ++j) { const unsigned hw0 = h0[j], aw0 = a0[j], hw1 = h1[j], aw1 = a1[j], gw = gt[j];
            const float in0l = j < 2 ? i0a[2 * j] : i0b[2 * j - 4], in0h = j < 2 ? i0a[2 * j + 1] : i0b[2 * j - 3], in1l = j < 2 ? i1a[2 * j] : i1b[2 * j - 4], in1h = j < 2 ? i1a[2 * j + 1] : i1b[2 * j - 3];
            y[2 * j] = (bflo(hw0) + bflo(aw0) * in0l + bflo(hw1) + bflo(aw1) * in1l) * geluf_(bflo(gw));
            y[2 * j + 1] = (bfhi(hw0) + bfhi(aw0) * in0h + bfhi(hw1) + bfhi(aw1) * in1h) * geluf_(bfhi(gw)); }
        *(u32x4*)(Y + (size_t)row * D_MODEL + c0) = (u32x4){pk2(y[0], y[1]), pk2(y[2], y[3]), pk2(y[4], y[5]), pk2(y[6], y[7])};
    }
}
}

namespace misc {
typedef float f32x4 __attribute__((ext_vector_type(4)));
typedef unsigned u32x2 __attribute__((ext_vector_type(2)));
typedef unsigned u32x4 __attribute__((ext_vector_type(4)));
__device__ __forceinline__ unsigned pk2(float lo, float hi) { return (unsigned)f2bf(lo) | ((unsigned)f2bf(hi) << 16); }
__device__ __forceinline__ float wave_sum(float v, int lane) {
#pragma unroll
    for (int o = 1; o < 64; o <<= 1) v += lane_xor(v, o, lane);
    return v;
}
__device__ __forceinline__ float sum16(float v, int lane) {
#pragma unroll
    for (int o = 1; o < 16; o <<= 1) v += lane_xor(v, o, lane);
    return v;
}
__device__ __forceinline__ void norm_phase(const float* H, const float* g, const float* MODl, int sh_idx, bf16_t* U, int nrows, int gwave, int nwaves, int lane) {
    static_assert(D_MODEL == 2048, "norm_phase geometry");
    for (int r = gwave; r < nrows; r += nwaves) {
        const int set = r < M_LAT ? r / SEQ : BATCH;
        const f32x4* hr = (const f32x4*)(H + (size_t)r * D_MODEL) + lane;
        f32x4 v[8]; float ss = 0.f;
#pragma unroll
        for (int j = 0; j < 8; ++j) { v[j] = hr[64 * j]; ss += (v[j][0] * v[j][0] + v[j][1] * v[j][1]) + (v[j][2] * v[j][2] + v[j][3] * v[j][3]); }
        const float rstd = 1.0f / sqrtf(wave_sum(ss, lane) * (1.0f / D_MODEL) + EPS);
        const f32x4* gp = (const f32x4*)g + lane; const f32x4* shp = (const f32x4*)(MODl + (size_t)set * NMODV + (size_t)sh_idx * D_MODEL) + lane; const f32x4* scp = shp + D_MODEL / 4;
        u32x2* o = (u32x2*)(U + (size_t)r * D_MODEL) + lane;
#pragma unroll
        for (int j = 0; j < 8; ++j) { const f32x4 gg = gp[64 * j], sh = shp[64 * j], sc = scp[64 * j]; f32x4 y;
#pragma unroll
            for (int e = 0; e < 4; ++e) y[e] = v[j][e] * rstd * gg[e] * (1.0f + sc[e]) + sh[e];
            o[64 * j] = (u32x2){pk2(y[0], y[1]), pk2(y[2], y[3])}; }
    }
}
struct RowNormArgs { const bf16_t* P; const float *qa_g, *kva_g, *na_qn_g, *na_kn_g; bf16_t *CQN, *CKVN, *NQ, *NK; };
__device__ __forceinline__ void rownorm_phase(const RowNormArgs& A, int gwave, int nwaves, int lane) {
    static_assert(MLA_Q_LORA == 384 && MLA_KV_LORA == 256 && GROUP_W == 512 && HD == 128, "rownorm geometry");
    for (int r = gwave; r < M_ALL; r += nwaves) { const bf16_t* p = A.P + (size_t)r * NP;
        { float x[6], ss = 0.f;
#pragma unroll
          for (int j = 0; j < 3; ++j) { const unsigned w = *(const unsigned*)(p + C_CQ + 2 * lane + 128 * j); x[2 * j] = bflo(w); x[2 * j + 1] = bfhi(w); ss += x[2 * j] * x[2 * j] + x[2 * j + 1] * x[2 * j + 1]; }
          const float rstd = 1.0f / sqrtf(wave_sum(ss, lane) * (1.0f / MLA_Q_LORA) + EPS);
#pragma unroll
          for (int j = 0; j < 3; ++j) { const int c = 2 * lane + 128 * j; *(unsigned*)(A.CQN + (size_t)r * MLA_Q_LORA + c) = pk2(x[2 * j] * rstd * A.qa_g[c], x[2 * j + 1] * rstd * A.qa_g[c + 1]); } }
        { float x[4], ss = 0.f;
#pragma unroll
          for (int j = 0; j < 2; ++j) { const unsigned w = *(const unsigned*)(p + C_CKV + 2 * lane + 128 * j); x[2 * j] = bflo(w); x[2 * j + 1] = bfhi(w); ss += x[2 * j] * x[2 * j] + x[2 * j + 1] * x[2 * j + 1]; }
          const float rstd = 1.0f / sqrtf(wave_sum(ss, lane) * (1.0f / MLA_KV_LORA) + EPS);
#pragma unroll
          for (int j = 0; j < 2; ++j) { const int c = 2 * lane + 128 * j; *(unsigned*)(A.CKVN + (size_t)r * MLA_KV_LORA + c) = pk2(x[2 * j] * rstd * A.kva_g[c], x[2 * j + 1] * rstd * A.kva_g[c + 1]); } }
#pragma unroll
        for (int which = 0; which < 2; ++which) {
            const int hh = lane >> 4, d0 = (lane & 15) * 8; const u32x4 w = *(const u32x4*)(p + (which == 0 ? C_NQ : C_NK) + hh * HD + d0);
            float x[8]; float ss = 0.f;
#pragma unroll
            for (int j = 0; j < 4; ++j) { x[2 * j] = bflo(w[j]); x[2 * j + 1] = bfhi(w[j]); ss += x[2 * j] * x[2 * j] + x[2 * j + 1] * x[2 * j + 1]; }
            const float rstd = 1.0f / sqrtf(sum16(ss, lane) * (1.0f / HD) + EPS); const float* g = (which == 0 ? A.na_qn_g : A.na_kn_g) + d0;
            *(u32x4*)((which == 0 ? A.NQ : A.NK) + (size_t)r * GROUP_W + hh * HD + d0) =
                (u32x4){pk2(x[0] * rstd * g[0], x[1] * rstd * g[1]), pk2(x[2] * rstd * g[2], x[3] * rstd * g[3]), pk2(x[4] * rstd * g[4], x[5] * rstd * g[5]), pk2(x[6] * rstd * g[6], x[7] * rstd * g[7])};
        }
    }
}
struct MlaQkvArgs { const float* QR; const float* KVR; const bf16_t* P; const float *qn_g, *kn_g; bf16_t *QM, *KM, *VM; };
__device__ __forceinline__ void mlaqkv_phase(const MlaQkvArgs& A, int gwave, int nwaves, int lane) {
    static_assert(MLA_QK == 192 && MLA_NOPE == 128 && MLA_ROPE == 64 && NH == 4, "mla qkv geometry");
    const int hh = lane >> 4, g = lane & 15;
    const float inv = powf(10000.0f, -(float)g / 16.0f);
    for (int r = gwave; r < M_ALL; r += nwaves) {
        const bool lat = r < M_LAT; const int t = lat ? r % SEQ : 0;
        float cr = 1.f, sr = 0.f, cc = 1.f, sc = 0.f;
        if (lat) { sincosf((float)(t / GRID_W) * inv, &sr, &cr); sincosf((float)(t % GRID_W) * inv, &sc, &cc); }
#pragma unroll
        for (int which = 0; which < 2; ++which) {
            float x[12]; float ss = 0.f;
            if (which == 0) { const float* src = A.QR + (size_t)r * NQ_MLA + hh * MLA_QK + g;
#pragma unroll
                for (int i = 0; i < 12; ++i) x[i] = src[16 * i]; }
            else { const float* src = A.KVR + (size_t)r * NKV_MLA + hh * (MLA_NOPE + MLA_V) + g; const bf16_t* kr = A.P + (size_t)r * NP + C_KR + g;
#pragma unroll
                for (int i = 0; i < 8; ++i) x[i] = src[16 * i];
#pragma unroll
                for (int i = 0; i < 4; ++i) x[8 + i] = bf2f(kr[16 * i]); }
#pragma unroll
            for (int i = 0; i < 12; ++i) ss += x[i] * x[i];
            const float rstd = 1.0f / sqrtf(sum16(ss, lane) * (1.0f / MLA_QK) + EPS); const float* gn = (which == 0 ? A.qn_g : A.kn_g) + g;
#pragma unroll
            for (int i = 0; i < 12; ++i) x[i] = x[i] * rstd * gn[16 * i];
            { const float a0 = x[8], b0 = x[10]; x[8] = a0 * cr - b0 * sr; x[10] = a0 * sr + b0 * cr;
              const float a1 = x[9], b1 = x[11]; x[9] = a1 * cc - b1 * sc; x[11] = a1 * sc + b1 * cc; }
            bf16_t* O = (which == 0 ? A.QM : A.KM) + (size_t)r * NQ_MLA + hh * MLA_QK + g;
#pragma unroll
            for (int i = 0; i < 12; ++i) O[16 * i] = f2bf(x[i]);
        }
        { const float* vs = A.KVR + (size_t)r * NKV_MLA + hh * (MLA_NOPE + MLA_V) + MLA_NOPE + g; bf16_t* O = A.VM + (size_t)r * (NH * MLA_V) + hh * MLA_V + g;
#pragma unroll
          for (int i = 0; i < 8; ++i) O[16 * i] = f2bf(vs[16 * i]); }
    }
}
__device__ __forceinline__ void act_phase(const bf16_t* UP, const float* cw, const float* cb, bf16_t* ACT, int nrows, int gtid, int gthreads) {
    constexpr int NC8 = D_FF / 8;
    for (long it = gtid; it < (long)nrows * NC8; it += gthreads) { const int r = (int)(it / NC8), j0 = (int)(it % NC8) * 8; const RowInfo ri = row_info(r);
        float a[8], g[8];
#pragma unroll
        for (int e = 0; e < 8; ++e) { a[e] = cb[j0 + e]; g[e] = cb[D_FF + j0 + e]; }
#pragma unroll
        for (int k = 0; k < 3; ++k) { const int tt = ri.t + k - 1; if (tt >= 0 && tt < ri.T) { const bf16_t* u = UP + (size_t)(ri.base + tt) * (2 * D_FF) + j0;
            const u32x4 ua = *(const u32x4*)u, ug = *(const u32x4*)(u + D_FF); const float* wa = cw + (size_t)k * 2 * D_FF + j0; const float* wg = wa + D_FF;
#pragma unroll
            for (int e = 0; e < 4; ++e) { a[2 * e] += wa[2 * e] * bflo(ua[e]); a[2 * e + 1] += wa[2 * e + 1] * bfhi(ua[e]); g[2 * e] += wg[2 * e] * bflo(ug[e]); g[2 * e + 1] += wg[2 * e + 1] * bfhi(ug[e]); } } }
        float y[8];
#pragma unroll
        for (int e = 0; e < 8; ++e) y[e] = a[e] * (g[e] / (1.0f + __expf(-g[e])));
        *(u32x4*)(ACT + (size_t)r * D_FF + j0) = (u32x4){pk2(y[0], y[1]), pk2(y[2], y[3]), pk2(y[4], y[5]), pk2(y[6], y[7])};
    }
}
__device__ __forceinline__ void transpose_item(const float* W, int K, int N, int Npad, bf16_t* WT, float* scr, int item, int lane) {
    const int nblk = Npad / 32, kb = item / nblk, nb = item % nblk, k0 = 64 * kb, n0 = 32 * nb; const int n = n0 + (lane & 31); const bool ok = n < N;
#pragma unroll 8
    for (int i = 0; i < 32; ++i) { const int kk = 2 * i + (lane >> 5); scr[kk * 33 + (lane & 31)] = ok ? W[(size_t)(k0 + kk) * N + n] : 0.f; }
    asm volatile("s_waitcnt lgkmcnt(0)" ::: "memory");
    const int c = lane & 7;
#pragma unroll
    for (int j = 0; j < 4; ++j) { const int nn = (lane >> 3) + 8 * j; const float* s = scr + (8 * c) * 33 + nn;
        u32x4 o; o.x = pk2(s[0 * 33], s[1 * 33]); o.y = pk2(s[2 * 33], s[3 * 33]); o.z = pk2(s[4 * 33], s[5 * 33]); o.w = pk2(s[6 * 33], s[7 * 33]);
        *(u32x4*)(WT + (size_t)(n0 + nn) * K + k0 + 8 * c) = o; }
    asm volatile("s_waitcnt lgkmcnt(0)" ::: "memory");
}
}

__device__ __forceinline__ gdn::Bufs gdn_bufs(const WS& w) { gdn::Bufs B; B.UT = w.gUT; B.WP = w.gWP; B.KDT = w.gKDT; B.QD = w.gQD; B.QK = w.gQK; B.SIT = w.gSIT; B.VNT = w.gVNT; B.GT = w.gGT; return B; }
__device__ __forceinline__ lru::Bufs lru_bufs(const WS& w) { lru::Bufs B; B.HLOC = w.lHLOC; B.ACUM = w.lACUM; B.LSUM = w.lLSUM; B.HIN = w.lHIN; return B; }

#define LAS __attribute__((address_space(3)))
#define XB_TMO      128
#define XB_XCNT(j)  (256  + 64 * (j))
#define XB_XSUB(j)  (1280 + 64 * (j))
#define XB_XGEN(j)  (2304 + 64 * (j))
#define XB_TOP      3328
#define XB_TOPGEN   3392
#define XCD_BAR_WORDS 3456
#define XB_SPIN_CAP (1u << 18)
__device__ __forceinline__ unsigned xb_ld(unsigned* p)              { return __hip_atomic_load(p, __ATOMIC_RELAXED, __HIP_MEMORY_SCOPE_AGENT); }
__device__ __forceinline__ unsigned xb_add(unsigned* p, unsigned v) { return __hip_atomic_fetch_add(p, v, __ATOMIC_RELAXED, __HIP_MEMORY_SCOPE_AGENT); }
__device__ __forceinline__ unsigned xb_xcc_id() { return (unsigned)__builtin_amdgcn_s_getreg((3 << 11) | 20) & 0xFu; }
#define XB_SPIN(cond, bar) do { unsigned _sp = 0; while (cond) { __builtin_amdgcn_s_sleep(1); \
    if ((++_sp & 255u) == 0u) { if (xb_ld(&(bar)[XB_TMO])) break; if (_sp > XB_SPIN_CAP) { atomicAdd(&(bar)[XB_TMO], 1u); break; } } } } while (0)
struct XcdBarrier { unsigned* bar; unsigned x; volatile LAS unsigned* st; };
__device__ __forceinline__ XcdBarrier xcd_barrier_post(unsigned* bar, volatile LAS unsigned* st, const bool leader) {
    XcdBarrier b; b.bar = bar; b.x = xb_xcc_id(); b.st = st;
    if (leader) (void)xb_add(&bar[XB_XCNT(b.x)], 1u);
    return b;
}
__device__ __forceinline__ void xcd_barrier_complete(unsigned* bar, unsigned x, unsigned& nloc, unsigned& nx) {
    const unsigned G = gridDim.x * gridDim.y * gridDim.z;
    unsigned sum, cnt, mine, sp = 0u;
    for (;;) {
        sum = 0u; cnt = 0u; mine = 0u;
#pragma unroll
        for (unsigned j = 0; j < 16; ++j) { const unsigned c = xb_ld(&bar[XB_XCNT(j)]); sum += c; cnt += (c > 0u) ? 1u : 0u; mine = (j == x) ? c : mine; }
        if (sum == G) break;
        __builtin_amdgcn_s_sleep(1);
        if ((++sp & 255u) == 0u) { if (xb_ld(&bar[XB_TMO])) break; if (sp > XB_SPIN_CAP) { atomicAdd(&bar[XB_TMO], 1u); break; } }
    }
    nloc = mine > 0u ? mine : 1u; nx = cnt > 0u ? cnt : 1u;
}
__device__ __forceinline__ void xcd_barrier(const XcdBarrier& b, const bool leader) {
    asm volatile("s_waitcnt vmcnt(0)" ::: "memory");
    __syncthreads();
    if (leader) {
        unsigned* bar = b.bar;
        __builtin_amdgcn_s_waitcnt(0);
        unsigned nloc = b.st[0], nx = b.st[1];
        if (nloc == 0u) { xcd_barrier_complete(bar, b.x, nloc, nx); b.st[0] = nloc; b.st[1] = nx; }
        const unsigned old = xb_add(&bar[XB_XSUB(b.x)], 1u);
        const unsigned gen = old / nloc;
        if (old + 1u == (gen + 1u) * nloc) {
            __builtin_amdgcn_fence(__ATOMIC_RELEASE, "agent");
            asm volatile("s_waitcnt vmcnt(0)" ::: "memory");
            const unsigned og = xb_add(&bar[XB_TOP], 1u);
            const unsigned tg = og / nx;
            if (og + 1u == (tg + 1u) * nx) xb_add(&bar[XB_TOPGEN], 1u);
            else XB_SPIN(xb_ld(&bar[XB_TOPGEN]) == tg, bar);
            __builtin_amdgcn_fence(__ATOMIC_ACQUIRE, "agent");
            xb_add(&bar[XB_XGEN(b.x)], 1u);
            asm volatile("s_waitcnt vmcnt(0)" ::: "memory");
        } else {
            XB_SPIN(xb_ld(&bar[XB_XGEN(b.x)]) == gen, bar);
            __builtin_amdgcn_fence(__ATOMIC_ACQUIRE, "agent");
            asm volatile("s_waitcnt vmcnt(0)" ::: "memory");
        }
    }
    __syncthreads();
}

constexpr int NWAVES = 8, NTHR = 512;
constexpr int LDS_MISC = 143360, LDS_BYTES = 147456;
static_assert(sizeof(Inputs) == 34 * 8, "Inputs mirrors Params::in");
static_assert(gdn::G1_LDS <= LDS_MISC && pg8::STAGE_BYTES <= LDS_MISC && att::Cfg<MLA_QK>::LDS_BYTES <= LDS_MISC && gdn::G2_LDS <= LDS_MISC, "LDS map");
constexpr int CW_BAR = 4096;
constexpr int PH_PRO = 0, PH_PER_LAYER = 12, NPH = 1 + PH_PER_LAYER * DEPTH;
struct Params { const float* in[34]; float* out; unsigned char* ws; int ph_lo, ph_hi, li, pad; };

struct SpanOrder {
    int nN, lo, hi, G, g0;
    __device__ __forceinline__ void init(int N, int lo_, int hi_, int G_, int c) { nN = N / pg8::BM; lo = lo_; hi = hi_; G = G_; int i0 = 0; if (c < lo_) i0 = (lo_ - c + G_ - 1) / G_; g0 = c + i0 * G_; }
    __device__ __forceinline__ bool next(int i, pg8::Unit& u) const { const int g = g0 + i * G; if (g >= hi) return false; const int loc = g - lo; u.pm = loc / nN; u.pn = loc % nN; return true; }
    __device__ __forceinline__ void a_ready(const pg8::Unit&) const {}
    __device__ __forceinline__ void done(const pg8::Unit&) const {}
};

#define AS4 __attribute__((address_space(4)))
#define PHASE_WS const AS4 Params* pp = (const AS4 Params*)__builtin_amdgcn_kernarg_segment_ptr(); asm volatile("" : "+s"(pp)); const AS4 Inputs* I = (const AS4 Inputs*)pp; (void)I; unsigned char* wsb_ = pp->ws; const WS w = ws_carve(wsb_)
#define PHASE_IDS int tid = C_wave0 * 64 + (int)__builtin_amdgcn_mbcnt_hi(~0u, __builtin_amdgcn_mbcnt_lo(~0u, 0u)); asm volatile("" : "+v"(tid)); const int lane = tid & 63, wave = __builtin_amdgcn_readfirstlane(tid >> 6), gwave = wg * NWAVES + wave, gtid = wg * NTHR + tid; (void)lane; (void)gwave; (void)gtid
#ifndef DBG_MASK
#define DBG_MASK 0xFFFFFF
#endif
#define IN(k) (lo <= (k) && (k) < hi)
#define ON(j) (((DBG_MASK) >> (j)) & 1)
#define SEAM(k) do { if (IN(k) && IN((k) + 1)) xcd_barrier(bar, C_wave0 == 0 && __builtin_amdgcn_mbcnt_hi(~0u, __builtin_amdgcn_mbcnt_lo(~0u, 0u)) == 0u); } while (0)

struct LayerCtx { int lo, hi, G, wg, nwaves, gthreads, wave0; XcdBarrier bar; char* lds; unsigned char* lds_raw; };
template <int l> __device__ __forceinline__ void layer_body(const LayerCtx& C) {
    const int lo = C.lo, hi = C.hi, G = C.G, wg = C.wg, nwaves = C.nwaves, gthreads = C.gthreads, C_wave0 = C.wave0; const XcdBarrier& bar = C.bar; char* lds = C.lds; unsigned char* lds_raw = C.lds_raw;
    (void)G; (void)nwaves; (void)gthreads;
        const int pb = 1 + PH_PER_LAYER * l;
        const bool want_ctx = l < DEPTH - 1; const int Mo = want_ctx ? M_ALL : M_LAT;
        if (ON(0) && IN(pb + 0)) { PHASE_WS; PHASE_IDS; const float* MODl = w.MOD + (size_t)l * (BATCH + 1) * NMODV; (void)MODl; misc::norm_phase(w.H, I->norm_mix_g + (size_t)l * D_MODEL, MODl, 0, w.U, M_ALL, gwave, nwaves, lane); }
        SEAM(pb + 0);
        if (ON(1) && IN(pb + 1)) { PHASE_WS; PHASE_IDS; const float* MODl = w.MOD + (size_t)l * (BATCH + 1) * NMODV; (void)MODl; pg8::Gemm g{w.U, w.WIN + l * SZ_WIN, M_ALL, NP, D_MODEL}; pg8::StaticOrder S; S.init(M_ALL, NP, G, wg);
            pg8::EpiBf16<0> E{w.P, NP, nullptr, 0, 0, 1.0f};
            pg8::gemm_phase<pg8::EpiBf16<0>, pg8::StaticOrder, true, true>((PG8_LAS unsigned char*)lds_raw, g, S, E, tid); }
        SEAM(pb + 1);
        if (ON(2) && IN(pb + 2)) { PHASE_WS; PHASE_IDS; const float* MODl = w.MOD + (size_t)l * (BATCH + 1) * NMODV; (void)MODl;
            { gdn::G1Args A; A.P = w.P; A.conv_w = I->gdn_conv_w + (size_t)l * 4 * 3 * GROUP_W; A.a_log = I->gdn_a_log + (size_t)l * 2 * NH; A.dt_bias = I->gdn_dt_bias + (size_t)l * 2 * NH; A.B = gdn_bufs(w);
              gdn::g1_phase(A, lds, G, wg, tid); }
            { lru::LocalArgs A; A.P = w.P; A.conv_w = I->lru_conv_w + (size_t)l * 4 * LRU_W; A.conv_b = I->lru_conv_b + (size_t)l * LRU_W; A.WG = w.WLRU + (size_t)l * 16 * lru::SZ_WBLK;
              A.ba = I->lru_ba + (size_t)l * 2 * LRU_W; A.bx = I->lru_bx + (size_t)l * 2 * LRU_W; A.lam = I->lru_lam + (size_t)l * 2 * LRU_W; A.B = lru_bufs(w);
              lru::local_phase(A, lds, G, wg, tid); }
            { misc::RowNormArgs A; A.P = w.P; A.qa_g = I->mla_qa_g + (size_t)l * MLA_Q_LORA; A.kva_g = I->mla_kva_g + (size_t)l * MLA_KV_LORA; A.na_qn_g = I->na_qn_g + (size_t)l * HD; A.na_kn_g = I->na_kn_g + (size_t)l * HD;
              A.CQN = w.CQN; A.CKVN = w.CKVN; A.NQ = w.NQ; A.NK = w.NK; misc::rownorm_phase(A, gwave, nwaves, lane); }
        }
        SEAM(pb + 2);
        if (ON(3) && IN(pb + 3)) { PHASE_WS; PHASE_IDS; const float* MODl = w.MOD + (size_t)l * (BATCH + 1) * NMODV; (void)MODl;
            constexpr int UQ = (M_ALL / 256) * (NQ_MLA / 256), UKV = (M_ALL / 256) * (NKV_MLA / 256);
            { pg8::Gemm g{w.CQN, w.WUQ + l * SZ_WUQ, M_ALL, NQ_MLA, MLA_Q_LORA}; SpanOrder S; S.init(NQ_MLA, 0, UQ, G, wg); pg8::EpiF32 E{w.QR, NQ_MLA};
              pg8::gemm_phase<pg8::EpiF32, SpanOrder, true, true>((PG8_LAS unsigned char*)lds_raw, g, S, E, tid); }
            { pg8::Gemm g{w.CKVN, w.WUKV + l * SZ_WUKV, M_ALL, NKV_MLA, MLA_KV_LORA}; SpanOrder S; S.init(NKV_MLA, UQ, UQ + UKV, G, wg); pg8::EpiF32 E{w.KVR, NKV_MLA};
              pg8::gemm_phase<pg8::EpiF32, SpanOrder, true, true>((PG8_LAS unsigned char*)lds_raw, g, S, E, tid); }
        }
        SEAM(pb + 3);
        if (ON(4) && IN(pb + 4)) { PHASE_WS; PHASE_IDS; const float* MODl = w.MOD + (size_t)l * (BATCH + 1) * NMODV; (void)MODl;
            { misc::MlaQkvArgs A; A.QR = w.QR; A.KVR = w.KVR; A.P = w.P; A.qn_g = I->mla_qn_g + (size_t)l * MLA_QK; A.kn_g = I->mla_kn_g + (size_t)l * MLA_QK; A.QM = w.QM; A.KM = w.KM; A.VM = w.VM;
              misc::mlaqkv_phase(A, gwave, nwaves, lane); }
            lru::carry_phase(lru_bufs(w), gtid, gthreads);
        }
        SEAM(pb + 4);
        if (ON(5) && IN(pb + 5)) { PHASE_WS; PHASE_IDS; const float* MODl = w.MOD + (size_t)l * (BATCH + 1) * NMODV; (void)MODl;
            if (wg < BATCH * NH * 2) gdn::g2_chain(gdn_bufs(w), lds, wg, tid);
            AttnArgs A; A.QM = w.QM; A.KM = w.KM; A.VM = w.VM; A.NQ = w.NQ; A.NK = w.NK; A.P = w.P; A.Y = w.Y; A.rpb = I->na_rpb + (size_t)l * NH * (2 * NA_KH - 1) * (2 * NA_KW - 1); A.want_ctx = want_ctx ? 1 : 0; A.pad = 0;
            attention_phase(A, lds, G, wg, tid);
        }
        SEAM(pb + 5);
        if (ON(6) && IN(pb + 6)) { PHASE_WS; PHASE_IDS; const float* MODl = w.MOD + (size_t)l * (BATCH + 1) * NMODV; (void)MODl;
            { gdn::G3Args A; A.B = gdn_bufs(w); A.P = w.P; A.norm_g = I->gdn_norm_g + (size_t)l * HD; A.Y = w.Y; gdn::g3_phase(A, lds, G, wg, tid); }
            lru::finish_phase(lru_bufs(w), w.P, w.Y, gtid, gthreads);
        }
        SEAM(pb + 6);
        if (ON(7) && IN(pb + 7)) { PHASE_WS; PHASE_IDS; const float* MODl = w.MOD + (size_t)l * (BATCH + 1) * NMODV; (void)MODl; pg8::Gemm g{w.Y, w.WOUT + l * SZ_WOUT, Mo, D_MODEL, D_MODEL}; pg8::StaticOrder S; S.init(Mo, D_MODEL, G, wg);
            pg8::EpiGateRes E{w.H, w.H, D_MODEL, MODl + 2 * D_MODEL, NMODV, SEQ, BATCH, M_LAT};
            pg8::gemm_phase<pg8::EpiGateRes, pg8::StaticOrder, true, true>((PG8_LAS unsigned char*)lds_raw, g, S, E, tid); }
        SEAM(pb + 7);
        if (ON(8) && IN(pb + 8)) { PHASE_WS; PHASE_IDS; const float* MODl = w.MOD + (size_t)l * (BATCH + 1) * NMODV; (void)MODl; misc::norm_phase(w.H, I->norm_ffn_g + (size_t)l * D_MODEL, MODl, 3, w.U, Mo, gwave, nwaves, lane); }
        SEAM(pb + 8);
        if (ON(9) && IN(pb + 9)) { PHASE_WS; PHASE_IDS; const float* MODl = w.MOD + (size_t)l * (BATCH + 1) * NMODV; (void)MODl; pg8::Gemm g{w.U, w.WUP + l * SZ_WUP, Mo, 2 * D_FF, D_MODEL}; pg8::StaticOrder S; S.init(Mo, 2 * D_FF, G, wg);
            pg8::EpiBf16<0> E{w.UP, 2 * D_FF, nullptr, 0, 0, 1.0f};
            pg8::gemm_phase<pg8::EpiBf16<0>, pg8::StaticOrder, true, true>((PG8_LAS unsigned char*)lds_raw, g, S, E, tid); }
        SEAM(pb + 9);
        if (ON(10) && IN(pb + 10)) { PHASE_WS; PHASE_IDS; const float* MODl = w.MOD + (size_t)l * (BATCH + 1) * NMODV; (void)MODl; misc::act_phase(w.UP, I->ffn_conv_w + (size_t)l * 3 * 2 * D_FF, I->ffn_conv_b + (size_t)l * 2 * D_FF, w.ACT, Mo, gtid, gthreads); }
        SEAM(pb + 10);
        if (ON(11) && IN(pb + 11)) { PHASE_WS; PHASE_IDS; const float* MODl = w.MOD + (size_t)l * (BATCH + 1) * NMODV; (void)MODl; pg8::Gemm g{w.ACT, w.WDOWN + l * SZ_WDOWN, Mo, D_MODEL, D_FF}; pg8::StaticOrder S; S.init(Mo, D_MODEL, G, wg);
            pg8::EpiGateRes E{w.H, want_ctx ? w.H : pp->out, D_MODEL, MODl + 5 * D_MODEL, NMODV, SEQ, BATCH, M_LAT};
            pg8::gemm_phase<pg8::EpiGateRes, pg8::StaticOrder, true, true>((PG8_LAS unsigned char*)lds_raw, g, S, E, tid); }
        SEAM(pb + 11);

}
__global__ void __launch_bounds__(NTHR, 2) fwd(Params p) {
    extern __shared__ __attribute__((aligned(16))) unsigned char lds_raw[];
    char* lds = (char*)lds_raw;
    const int G = (int)gridDim.x, wg = (int)blockIdx.x, nwaves = G * NWAVES, gthreads = G * NTHR;
    const int C_wave0 = __builtin_amdgcn_readfirstlane((int)threadIdx.x >> 6);
    volatile LAS unsigned* MISC = (volatile LAS unsigned*)(lds_raw + LDS_MISC);
    if (threadIdx.x < 32) MISC[threadIdx.x] = 0u;
    __syncthreads();
    const int lo = p.ph_lo, hi = p.ph_hi;
    unsigned* const barw = (unsigned*)p.ws + CW_BAR + (size_t)p.li * XCD_BAR_WORDS;
    XcdBarrier bar; bar.bar = barw; bar.x = 0; bar.st = MISC + 8;
    if (hi - lo > 1) bar = xcd_barrier_post(barw, MISC + 8, threadIdx.x == 0);

    if (ON(12) && IN(PH_PRO)) { PHASE_WS; PHASE_IDS;
        {
            float* SCs = (float*)lds;
            float* red = (float*)(lds + 3 * D_MODEL * 4);
            constexpr int NT = DEPTH * NMODV / 256;
            if (wg < NT) {
                for (int i = tid; i < (BATCH + 1) * D_MODEL; i += NTHR) { const int s = i / D_MODEL, k = i % D_MODEL; const float v = s < BATCH ? I->c[s * D_MODEL + k] : I->c_ctx[k]; SCs[i] = v / (1.0f + __expf(-v)); }
                __syncthreads();
            }
            for (int t = wg; t < NT; t += G) { const int l = t / (NMODV / 256), j0 = (t % (NMODV / 256)) * 256;
                misc::f32x4 acc[3] = {{0.f, 0.f, 0.f, 0.f}, {0.f, 0.f, 0.f, 0.f}, {0.f, 0.f, 0.f, 0.f}};
                const float* wp = I->ada_w + (size_t)l * D_MODEL * NMODV + (size_t)(256 * wave) * NMODV + j0 + 4 * lane;
#pragma unroll 8
                for (int k = 0; k < 256; ++k) { const misc::f32x4 wv = *(const misc::f32x4*)(wp + (size_t)k * NMODV); const int kk = 256 * wave + k;
                    acc[0] += wv * SCs[kk]; acc[1] += wv * SCs[D_MODEL + kk]; acc[2] += wv * SCs[2 * D_MODEL + kk]; }
                __syncthreads();
#pragma unroll
                for (int s = 0; s < 3; ++s) *(misc::f32x4*)(red + (wave * 3 + s) * 256 + 4 * lane) = acc[s];
                __syncthreads();
                for (int i = tid; i < 3 * 256; i += NTHR) { const int s = i / 256, c = i % 256; float sum = I->ada_b[(size_t)l * NMODV + j0 + c];
#pragma unroll
                    for (int w8 = 0; w8 < 8; ++w8) sum += red[(w8 * 3 + s) * 256 + c];
                    w.MOD[((size_t)l * (BATCH + 1) + s) * NMODV + j0 + c] = sum; }
            }
            __syncthreads();
        }
        {
            float* scr = (float*)(lds + wave * 8448);
            constexpr int I_IN = (D_MODEL / 64) * (NP / 32), I_OUT = (D_MODEL / 64) * (D_MODEL / 32), I_UP = (D_MODEL / 64) * (2 * D_FF / 32), I_DN = (D_FF / 64) * (D_MODEL / 32),
                          I_UQ = (MLA_Q_LORA / 64) * (NQ_MLA / 32), I_UKV = (MLA_KV_LORA / 64) * (NKV_MLA / 32), I_LB = (LRU_BW / 64) * (LRU_BW / 32), I_LRU = 2 * 2 * NH * I_LB;
            constexpr int I_LAYER = I_IN + I_OUT + I_UP + I_DN + I_UQ + I_UKV + I_LRU;
            for (int it = gwave; it < DEPTH * I_LAYER; it += nwaves) { const int l = it / I_LAYER; int r = it % I_LAYER;
                if (r < I_IN) { misc::transpose_item(I->w_in + (size_t)l * D_MODEL * IN_COLS, D_MODEL, IN_COLS, NP, w.WIN + l * SZ_WIN, scr, r, lane); continue; } r -= I_IN;
                if (r < I_OUT) { misc::transpose_item(I->w_out + (size_t)l * D_MODEL * D_MODEL, D_MODEL, D_MODEL, D_MODEL, w.WOUT + l * SZ_WOUT, scr, r, lane); continue; } r -= I_OUT;
                if (r < I_UP) { misc::transpose_item(I->ffn_w_up + (size_t)l * D_MODEL * 2 * D_FF, D_MODEL, 2 * D_FF, 2 * D_FF, w.WUP + l * SZ_WUP, scr, r, lane); continue; } r -= I_UP;
                if (r < I_DN) { misc::transpose_item(I->ffn_w_down + (size_t)l * D_FF * D_MODEL, D_FF, D_MODEL, D_MODEL, w.WDOWN + l * SZ_WDOWN, scr, r, lane); continue; } r -= I_DN;
                if (r < I_UQ) { misc::transpose_item(I->mla_w_uq + (size_t)l * MLA_Q_LORA * NQ_MLA, MLA_Q_LORA, NQ_MLA, NQ_MLA, w.WUQ + l * SZ_WUQ, scr, r, lane); continue; } r -= I_UQ;
                if (r < I_UKV) { misc::transpose_item(I->mla_w_ukv + (size_t)l * MLA_KV_LORA * NKV_MLA, MLA_KV_LORA, NKV_MLA, NKV_MLA, w.WUKV + l * SZ_WUKV, scr, r, lane); continue; } r -= I_UKV;
                { const int blk = r / I_LB, item = r % I_LB, d = blk / (2 * NH), wh = (blk / NH) & 1, nb = blk % NH;
                  const float* src = (wh == 0 ? I->lru_wa : I->lru_wx) + ((size_t)(l * 2 + d) * NH + nb) * lru::SZ_WBLK;
                  misc::transpose_item(src, LRU_BW, LRU_BW, LRU_BW, w.WLRU + ((size_t)l * 16 + blk) * lru::SZ_WBLK, scr, item, lane); }
            }
        }
        for (long i = gtid; i < (long)M_ALL * D_MODEL / 4; i += gthreads) { const long e = i * 4;
            ((misc::f32x4*)w.H)[i] = e < (long)M_LAT * D_MODEL ? *(const misc::f32x4*)(I->x + e) : *(const misc::f32x4*)(I->ctx + (e - (long)M_LAT * D_MODEL)); }
    }
    SEAM(PH_PRO);

    { LayerCtx C; C.lo = lo; C.hi = hi; C.G = G; C.wg = wg; C.nwaves = nwaves; C.gthreads = gthreads; C.wave0 = C_wave0; C.bar = bar; C.lds = lds; C.lds_raw = lds_raw;
      static_assert(DEPTH == 4, "layer calls are written out (a real layer loop lets LICM park loop-invariant values in registers across every phase: spills)");
      layer_body<0>(C); layer_body<1>(C); layer_body<2>(C); layer_body<3>(C); }
#undef IN
#undef SEAM
}

#ifndef MK_PHASES_PER_LAUNCH
#define MK_PHASES_PER_LAUNCH NPH
#endif
extern "C" void kernel_launch(void* const* d_in, const int* in_sizes, int n_in, void* d_out, int out_size, void* d_ws, size_t ws_size, hipStream_t stream) {
    static int grid = 0;
    if (grid == 0) {
        int dev = 0, cus = 0;
        if (hipGetDevice(&dev) != hipSuccess || hipDeviceGetAttribute(&cus, hipDeviceAttributeMultiprocessorCount, dev) != hipSuccess || cus <= 0) { fprintf(stderr, "kernel_launch: no device\n"); grid = -1; return; }
        if (hipFuncSetAttribute((const void*)fwd, hipFuncAttributeMaxDynamicSharedMemorySize, LDS_BYTES) != hipSuccess) { fprintf(stderr, "kernel_launch: hipFuncSetAttribute failed\n"); grid = -1; return; }
        int per_cu = 0; if (hipOccupancyMaxActiveBlocksPerMultiprocessor(&per_cu, (const void*)fwd, NTHR, LDS_BYTES) != hipSuccess || per_cu < 1) fprintf(stderr, "kernel_launch: occupancy query says %d blocks per CU\n", per_cu);
        (void)hipGetLastError();
        grid = cus;
        const WS w0 = ws_carve(nullptr);
        if (n_in != 34 || w0.total > ws_size) { fprintf(stderr, "kernel_launch: bad inputs / workspace (need %zu, have %zu)\n", w0.total, ws_size); grid = -1; return; }
    }
    if (grid < 0) return;
    (void)hipMemsetAsync(d_ws, 0, 1 << 20, stream);
    Params p; memset(&p, 0, sizeof(p));
    for (int i = 0; i < 34; ++i) p.in[i] = (const float*)d_in[i];
    p.out = (float*)d_out; p.ws = (unsigned char*)d_ws;
    int li = 0;
    for (int lo = 0; lo < NPH; lo += MK_PHASES_PER_LAUNCH, ++li) {
        p.ph_lo = lo; p.ph_hi = lo + MK_PHASES_PER_LAUNCH < NPH ? lo + MK_PHASES_PER_LAUNCH : NPH; p.li = li;
        hipLaunchKernelGGL(fwd, dim3(grid), dim3(NTHR), LDS_BYTES, stream, p);
    }
}
```

```cpp
#include <hip/hip_runtime.h>
#include <cstdio>
#include <cstdint>
#include <cstring>
#include <math.h>
#include <stdint.h>

#ifdef CFG_SMALL
constexpr int D_MODEL = 256, BATCH = 2, SEQ = 512, DEPTH = 2, CTX_LEN = 64, GRID_W = 32, HEAD_DIM = 16;
#else
constexpr int D_MODEL = 2048, BATCH = 2, SEQ = 8192, DEPTH = 4, CTX_LEN = 256, GRID_W = 64, HEAD_DIM = 128;
#endif
constexpr int GROUP_W = D_MODEL / 4, NH = GROUP_W / HEAD_DIM;
constexpr int HD = HEAD_DIM;
constexpr int N_MOD = 6;
constexpr float EPS = 1e-6f;
constexpr int LRU_W = GROUP_W, LRU_BW = LRU_W / NH;
constexpr float LRU_C = 8.0f;
constexpr int MLA_Q_LORA = 3 * D_MODEL / 16, MLA_KV_LORA = D_MODEL / 8, MLA_NOPE = HD, MLA_ROPE = HD / 2, MLA_V = HD, MLA_QK = MLA_NOPE + MLA_ROPE;
constexpr int GDN_CHUNK = 64;
constexpr int NA_KH = 8, NA_KW = 16;
constexpr int D_FF = 5 * D_MODEL / 2;
constexpr int ROWS = SEQ / GRID_W;
constexpr int C_LRU_X = 0, C_LRU_G = C_LRU_X + LRU_W, C_CQ = C_LRU_G + LRU_W, C_CKV = C_CQ + MLA_Q_LORA, C_KR = C_CKV + MLA_KV_LORA,
              C_GQ = C_KR + MLA_ROPE, C_GK = C_GQ + GROUP_W, C_GV = C_GK + GROUP_W, C_GG = C_GV + GROUP_W, C_GB = C_GG + GROUP_W,
              C_GA = C_GB + 2 * NH, C_NQ = C_GA + 2 * NH, C_NK = C_NQ + GROUP_W, C_NV = C_NK + GROUP_W, IN_COLS = C_NV + GROUP_W;
constexpr int NP = (IN_COLS + 255) / 256 * 256;
constexpr int M_LAT = BATCH * SEQ, M_CTX = BATCH * CTX_LEN, M_ALL = M_LAT + M_CTX;
constexpr int NMODV = N_MOD * D_MODEL;

typedef unsigned short bf16_t;
__host__ __device__ __forceinline__ bf16_t f2bf(float f) { union { float f; unsigned u; } v; v.f = f; unsigned u = v.u; u += 0x7fffu + ((u >> 16) & 1u); return (bf16_t)(u >> 16); }
__host__ __device__ __forceinline__ float bf2f(bf16_t b) { union { float f; unsigned u; } v; v.u = ((unsigned)b) << 16; return v.f; }
__host__ __device__ __forceinline__ float sigmoidf_(float x) { return 1.0f / (1.0f + expf(-x)); }
__host__ __device__ __forceinline__ float siluf_(float x) { return x / (1.0f + expf(-x)); }
__host__ __device__ __forceinline__ float softplusf_(float x) { return fmaxf(x, 0.0f) + log1pf(expf(-fabsf(x))); }
__host__ __device__ __forceinline__ float geluf_(float x) { return 0.5f * x * (1.0f + tanhf(0.7978845608028654f * (x + 0.044715f * x * x * x))); }

struct RowInfo { int b, t, T, base, set; };
__host__ __device__ __forceinline__ RowInfo row_info(int r) {
    RowInfo i;
    if (r < M_LAT) { i.b = r / SEQ; i.t = r % SEQ; i.T = SEQ; i.base = i.b * SEQ; i.set = i.b; }
    else { const int rr = r - M_LAT; i.b = rr / CTX_LEN; i.t = rr % CTX_LEN; i.T = CTX_LEN; i.base = M_LAT + i.b * CTX_LEN; i.set = BATCH; }
    return i;
}


__host__ __device__ __forceinline__ float bflo(unsigned w) { union { float f; unsigned u; } v; v.u = w << 16; return v.f; }
__host__ __device__ __forceinline__ float bfhi(unsigned w) { union { float f; unsigned u; } v; v.u = w & 0xffff0000u; return v.f; }
__device__ __forceinline__ float lane_xor(float v, int mask, int lane) { return __int_as_float(__builtin_amdgcn_ds_bpermute((lane ^ mask) << 2, __float_as_int(v))); }
__device__ __forceinline__ float lane_get(float v, int src_lane) { return __int_as_float(__builtin_amdgcn_ds_bpermute(src_lane << 2, __float_as_int(v))); }
struct Inputs {
    const float *x, *c, *ctx, *c_ctx, *ada_w, *ada_b, *norm_mix_g, *norm_ffn_g, *w_in, *w_out,
        *lru_conv_w, *lru_conv_b, *lru_wa, *lru_ba, *lru_wx, *lru_bx, *lru_lam,
        *mla_qa_g, *mla_w_uq, *mla_kva_g, *mla_w_ukv, *mla_qn_g, *mla_kn_g,
        *gdn_conv_w, *gdn_a_log, *gdn_dt_bias, *gdn_norm_g, *na_qn_g, *na_kn_g, *na_rpb,
        *ffn_w_up, *ffn_conv_w, *ffn_conv_b, *ffn_w_down;
};
constexpr int NQ_MLA = NH * MLA_QK, NKV_MLA = NH * (MLA_NOPE + MLA_V);
constexpr size_t SZ_WIN = (size_t)NP * D_MODEL, SZ_WOUT = (size_t)D_MODEL * D_MODEL, SZ_WUP = (size_t)2 * D_FF * D_MODEL, SZ_WDOWN = (size_t)D_MODEL * D_FF,
                 SZ_WUQ = (size_t)NQ_MLA * MLA_Q_LORA, SZ_WUKV = (size_t)NKV_MLA * MLA_KV_LORA, SZ_WLRU = (size_t)16 * LRU_BW * LRU_BW;
struct WS {
    unsigned* ctl; float *MOD, *H; bf16_t *U, *Y;
    bf16_t *WIN, *WOUT, *WUP, *WDOWN, *WUQ, *WUKV, *WLRU;
    bf16_t* P; bf16_t *CQN, *CKVN; float *QR, *KVR; bf16_t *QM, *KM, *VM, *NQ, *NK;
    bf16_t *gUT, *gWP, *gKDT, *gQD, *gQK, *gSIT, *gVNT; float* gGT;
    bf16_t *lHLOC, *lACUM; float *lLSUM, *lHIN;
    bf16_t *UP, *ACT;
    size_t total;
};
__host__ __device__ inline WS ws_carve(void* base) {
    WS w; size_t off = 0; char* b = (char*)base;
#define WS_TAKE(T, field, bytes) do { w.field = (T*)(b + off); off += (((size_t)(bytes)) + 255) & ~(size_t)255; } while (0)
    WS_TAKE(unsigned, ctl, 1 << 20);
    WS_TAKE(float, MOD, sizeof(float) * (size_t)DEPTH * (BATCH + 1) * NMODV);
    WS_TAKE(float, H, sizeof(float) * (size_t)M_ALL * D_MODEL);
    WS_TAKE(bf16_t, U, 2 * (size_t)M_ALL * D_MODEL);
    WS_TAKE(bf16_t, Y, 2 * (size_t)M_ALL * D_MODEL);
    WS_TAKE(bf16_t, WIN, 2 * SZ_WIN * DEPTH); WS_TAKE(bf16_t, WOUT, 2 * SZ_WOUT * DEPTH); WS_TAKE(bf16_t, WUP, 2 * SZ_WUP * DEPTH); WS_TAKE(bf16_t, WDOWN, 2 * SZ_WDOWN * DEPTH);
    WS_TAKE(bf16_t, WUQ, 2 * SZ_WUQ * DEPTH); WS_TAKE(bf16_t, WUKV, 2 * SZ_WUKV * DEPTH); WS_TAKE(bf16_t, WLRU, 2 * SZ_WLRU * DEPTH);
    const size_t r0 = off;
    WS_TAKE(bf16_t, P, 2 * (size_t)M_ALL * NP);
    WS_TAKE(bf16_t, CQN, 2 * (size_t)M_ALL * MLA_Q_LORA); WS_TAKE(bf16_t, CKVN, 2 * (size_t)M_ALL * MLA_KV_LORA);
    WS_TAKE(float, QR, 4 * (size_t)M_ALL * NQ_MLA); WS_TAKE(float, KVR, 4 * (size_t)M_ALL * NKV_MLA);
    WS_TAKE(bf16_t, QM, 2 * (size_t)M_ALL * NQ_MLA); WS_TAKE(bf16_t, KM, 2 * (size_t)M_ALL * NQ_MLA); WS_TAKE(bf16_t, VM, 2 * (size_t)M_ALL * NH * MLA_V);
    WS_TAKE(bf16_t, NQ, 2 * (size_t)M_ALL * GROUP_W); WS_TAKE(bf16_t, NK, 2 * (size_t)M_ALL * GROUP_W);
    { constexpr size_t NT_ = (size_t)(M_ALL / 64) * NH * 2;
      WS_TAKE(bf16_t, gUT, 2 * NT_ * 128 * 64); WS_TAKE(bf16_t, gWP, 2 * NT_ * 64 * 128); WS_TAKE(bf16_t, gKDT, 2 * NT_ * 128 * 64); WS_TAKE(bf16_t, gQD, 2 * NT_ * 64 * 128);
      WS_TAKE(bf16_t, gQK, 2 * NT_ * 64 * 64); WS_TAKE(bf16_t, gSIT, 2 * NT_ * 128 * 128); WS_TAKE(bf16_t, gVNT, 2 * NT_ * 128 * 64); WS_TAKE(float, gGT, 4 * NT_); }
    WS_TAKE(bf16_t, lHLOC, 2 * (size_t)2 * M_ALL * LRU_W); WS_TAKE(bf16_t, lACUM, 2 * (size_t)2 * M_ALL * LRU_W);
    WS_TAKE(float, lLSUM, 4 * (size_t)(M_ALL / 64) * 2 * 2 * LRU_W); WS_TAKE(float, lHIN, 4 * (size_t)(M_ALL / 64) * 2 * LRU_W);
    const size_t r1 = off;
    off = r0;
    WS_TAKE(bf16_t, UP, 2 * (size_t)M_ALL * 2 * D_FF); WS_TAKE(bf16_t, ACT, 2 * (size_t)M_ALL * D_FF);
    const size_t f1 = off;
#undef WS_TAKE
    w.total = r1 > f1 ? r1 : f1;
    return w;
}

namespace pg8 {
#define PG8_LAS __attribute__((address_space(3)))
typedef unsigned short bf16_t;
typedef short bf16x8 __attribute__((ext_vector_type(8)));
typedef float f32x4 __attribute__((ext_vector_type(4)));
typedef unsigned u32x4 __attribute__((ext_vector_type(4)));
constexpr int BM = 256, BK = 64, HALF = 128, HTB = HALF * BK * 2  , STAGE_BYTES = 8 * HTB, NXCD = 8, WGM = 8;

__host__ __device__ __forceinline__ int lds_byte(int r, int c) { const int st = (r >> 4) * 2 + (c >> 5), rr = r & 15, cc = c & 31, ob = rr * 64 + cc * 2; return st * 1024 + (ob ^ (((ob >> 9) & 1) << 5)); }
__host__ __device__ __forceinline__ void stage_rc(int b, int& R, int& C) { const int st = b / 1024, sb = b % 1024, swz = sb ^ (((sb >> 9) & 1) << 5); R = (st >> 1) * 16 + swz / 64; C = (st & 1) * 32 + (swz % 64) / 2; }
__host__ __device__ __forceinline__ int perm32(int rho) { const int n = rho >> 4, i = rho & 15; return 8 * (i >> 2) + 4 * n + (i & 3); }

struct Unit { int pm, pn; };
struct Gemm { const bf16_t* A; const bf16_t* Bt; int M, N, K; };

struct StaticOrder {
    int nM, nN, nwg, G, c;
    __host__ __device__ void init(int M, int N, int G_, int c_) { nM = M / BM; nN = N / BM; nwg = nM * nN; G = G_; c = c_; }
    __host__ __device__ bool next(int i, Unit& u) const {
        const long L = (long)i * G + c; if (L >= nwg) return false;
        int wgid = (int)L; { const int q = nwg / NXCD, r = nwg % NXCD, xcd = wgid % NXCD, off = wgid / NXCD; wgid = (xcd < r ? xcd * (q + 1) : r * (q + 1) + (xcd - r) * q) + off; }
        const int nig = WGM * nN, gid = wgid / nig, fm = gid * WGM, gsz = (nM - fm) < WGM ? (nM - fm) : WGM;
        u.pm = fm + ((wgid % nig) % gsz); u.pn = (wgid % nig) / gsz; return true;
    }
    __device__ __forceinline__ void a_ready(const Unit&) const {}
    __device__ __forceinline__ void done(const Unit&) const {}
};
__device__ __forceinline__ unsigned cvt_pk_bf16(float lo, float hi) { unsigned r; asm volatile("v_cvt_pk_bf16_f32 %0, %1, %2" : "=v"(r) : "v"(lo), "v"(hi)); return r; }
typedef float f32x2 __attribute__((ext_vector_type(2)));
__device__ __forceinline__ f32x2 gelu_pk(f32x2 v) {
    const f32x2 av = __builtin_elementwise_abs(v), d = av * 0.2316418882f + 1.0f;
    f32x2 t; t.x = __builtin_amdgcn_rcpf(d.x); t.y = __builtin_amdgcn_rcpf(d.y);
    f32x2 q = t * 0.5307027145f + (-0.7265760135f); q = q * t + 0.7107068705f; q = q * t + (-0.142248368f); q = q * t + 0.127414796f; q = q * t;
    const f32x2 s = (v * v) * (-0.72134752044f);
    f32x2 e; e.x = __builtin_amdgcn_exp2f(s.x); e.y = __builtin_amdgcn_exp2f(s.y);
    const f32x2 m = v * (q * e), r = v - m;
    f32x2 o; o.x = v.x < 0.f ? m.x : r.x; o.y = v.y < 0.f ? m.y : r.y; return o;
}

template <int ACT  > struct EpiBf16 {
    static constexpr bool PERM = true, AFTER_DRAIN = false; static_assert(ACT == 0 || ACT == 1, "EpiBf16: ACT is 0 (none) or 1 (gelu_pk)");
    bf16_t* O; int ldc; const float* bias; int split_cols; size_t split_stride; float scale0;
    __device__ __forceinline__ void operator()(const f32x4 (&acc)[2][2][4][2], const Unit& u, int wr, int wc, int fr, int fq) const {
        const int row0 = u.pm * BM + wr * 64 + fr; int colt = u.pn * BM; bf16_t* base = O;
        float sc = 1.f; if (split_cols) { const int t = colt / split_cols; base += (size_t)t * split_stride; colt -= t * split_cols; if (t == 0) sc = scale0; }
        const int col0 = colt + wc * 32 + 8 * fq, bcol0 = u.pn * BM + wc * 32 + 8 * fq;
        f32x4 bv[2][2];
#pragma unroll
        for (int bj = 0; bj < 2; ++bj)
#pragma unroll
            for (int n = 0; n < 2; ++n) bv[bj][n] = bias ? *(const f32x4*)(bias + bcol0 + bj * HALF + 4 * n) : (f32x4){0.f, 0.f, 0.f, 0.f};
#pragma unroll
        for (int ai = 0; ai < 2; ++ai)
#pragma unroll
            for (int m = 0; m < 4; ++m) { bf16_t* rowp = base + (size_t)(row0 + ai * HALF + m * 16) * ldc + col0;
#pragma unroll
                for (int bj = 0; bj < 2; ++bj) { f32x4 v0 = acc[ai][bj][m][0] + bv[bj][0], v1 = acc[ai][bj][m][1] + bv[bj][1];
                    if (ACT == 1) { f32x2 a = gelu_pk((f32x2){v0[0], v0[1]}), b = gelu_pk((f32x2){v0[2], v0[3]}), c = gelu_pk((f32x2){v1[0], v1[1]}), d = gelu_pk((f32x2){v1[2], v1[3]});
                        v0 = (f32x4){a.x, a.y, b.x, b.y}; v1 = (f32x4){c.x, c.y, d.x, d.y}; }
                    v0 = v0 * sc; v1 = v1 * sc; u32x4 w; w.x = cvt_pk_bf16(v0[0], v0[1]); w.y = cvt_pk_bf16(v0[2], v0[3]); w.z = cvt_pk_bf16(v1[0], v1[1]); w.w = cvt_pk_bf16(v1[2], v1[3]);
                    *(u32x4*)(rowp + bj * HALF) = w; } }
    }
};

struct EpiF32 {
    static constexpr bool PERM = false, AFTER_DRAIN = false;
    float* C; int ldc;
    __device__ __forceinline__ void operator()(const f32x4 (&acc)[2][2][4][2], const Unit& u, int wr, int wc, int fr, int fq) const {
        const int row0 = u.pm * BM + wr * 64 + fr, col0 = u.pn * BM + wc * 32 + 4 * fq;
#pragma unroll
        for (int ai = 0; ai < 2; ++ai)
#pragma unroll
            for (int m = 0; m < 4; ++m) { float* rowp = C + (size_t)(row0 + ai * HALF + m * 16) * ldc + col0;
#pragma unroll
                for (int bj = 0; bj < 2; ++bj)
#pragma unroll
                    for (int n = 0; n < 2; ++n) *(f32x4*)(rowp + bj * HALF + n * 16) = acc[ai][bj][m][n]; }
    }
};
struct EpiGateRes {
    static constexpr bool PERM = false, AFTER_DRAIN = false;
    const float* base; float* out; int ldc; const float* gate; int set_stride; int rows_per_set; int nsets_lat; int lat_rows;
    __device__ __forceinline__ void operator()(const f32x4 (&acc)[2][2][4][2], const Unit& u, int wr, int wc, int fr, int fq) const {
        const int row0 = u.pm * BM + wr * 64 + fr, col0 = u.pn * BM + wc * 32 + 4 * fq;
        const int set = (u.pm * BM >= lat_rows) ? nsets_lat : (u.pm * BM) / rows_per_set;
        const float* gp = gate + (size_t)set * set_stride + col0;
        f32x4 gv[2][2];
#pragma unroll
        for (int bj = 0; bj < 2; ++bj)
#pragma unroll
            for (int n = 0; n < 2; ++n) gv[bj][n] = *(const f32x4*)(gp + bj * HALF + n * 16);
#pragma unroll
        for (int ai = 0; ai < 2; ++ai)
#pragma unroll
            for (int m = 0; m < 4; ++m) { const size_t off = (size_t)(row0 + ai * HALF + m * 16) * ldc + col0;
#pragma unroll
                for (int bj = 0; bj < 2; ++bj)
#pragma unroll
                    for (int n = 0; n < 2; ++n) { const f32x4 b = *(const f32x4*)(base + off + bj * HALF + n * 16); *(f32x4*)(out + off + bj * HALF + n * 16) = b + gv[bj][n] * acc[ai][bj][m][n]; } }
    }
};

template <class Epi, class Sched, bool ALIGN_EPI = false, bool SP2 = false>
__device__ __forceinline__ void gemm_phase(PG8_LAS unsigned char* lds, const Gemm g, const Sched& S, const Epi& E, const int tid_in) {
    int tid_ = tid_in; asm volatile("" : "+v"(tid_));
    const int tid = tid_, wid = __builtin_amdgcn_readfirstlane(tid >> 6), lane = tid & 63, wr = wid >> 2, wc = wid & 3, fr = lane & 15, fq = lane >> 4;
    const int K = g.K, nt = K / BK;
    unsigned voffA[2], voffB[2];
#pragma unroll
    for (int i = 0; i < 2; ++i) { int R, C; stage_rc(tid * 16 + i * 8192, R, C); const int Rb = Epi::PERM ? ((R & ~31) + perm32(R & 31)) : R;
        voffA[i] = (unsigned)(R * K + C) * 2u; voffB[i] = (unsigned)(Rb * K + C) * 2u; }
    const size_t kstep = (size_t)(BK * 2);
    const size_t hstep = (size_t)HALF * K * 2;
    const size_t tstep = 2 * hstep;
    const unsigned ldsw = (unsigned)wid * 1024u;
    const int aoff = lds_byte(wr * 64 + fr, fq * 8), boff = lds_byte(wc * 32 + fr, fq * 8);
#define PG8_SA(b, h) (((b) * 2 + (h)) * HTB)
#define PG8_SB(b, h) ((4 + (b) * 2 + (h)) * HTB)
#define PG8_STAGE(bufoff, gbase, voff) do { _Pragma("unroll") for (int _i = 0; _i < 2; ++_i) \
        __builtin_amdgcn_global_load_lds((const unsigned*)((const char*)(gbase) + (voff)[_i]), (PG8_LAS unsigned*)(lds + (bufoff) + ldsw + _i * 8192), 16, 0, 0); } while (0)
#define PG8_LDA(dst, b, h) do { _Pragma("unroll") for (int m = 0; m < 4; ++m) _Pragma("unroll") for (int k = 0; k < 2; ++k) dst[m][k] = *(const PG8_LAS bf16x8*)(lds + PG8_SA(b, h) + aoff + m * 2048 + k * 1024); } while (0)
#define PG8_LDB(dst, b, h) do { _Pragma("unroll") for (int n = 0; n < 2; ++n) _Pragma("unroll") for (int k = 0; k < 2; ++k) dst[n][k] = *(const PG8_LAS bf16x8*)(lds + PG8_SB(b, h) + boff + n * 2048 + k * 1024); } while (0)
#define PG8_MMA(ai, bj, At, Bt) do { __builtin_amdgcn_s_setprio(1); _Pragma("unroll") for (int m = 0; m < 4; ++m) _Pragma("unroll") for (int n = 0; n < 2; ++n) _Pragma("unroll") for (int k = 0; k < 2; ++k) \
        acc[ai][bj][m][n] = __builtin_amdgcn_mfma_f32_16x16x32_bf16(Bt[n][k], At[m][k], acc[ai][bj][m][n], 0, 0, 0); __builtin_amdgcn_s_setprio(0); } while (0)
#define PG8_WAIT_V(n) asm volatile("s_waitcnt vmcnt(" #n ")" ::: "memory")
#define PG8_WAIT_L(n) asm volatile("s_waitcnt lgkmcnt(" #n ")" ::: "memory")
#define PG8_BAR __builtin_amdgcn_s_barrier()
#define PG8_SCHED __builtin_amdgcn_sched_barrier(0)
    Unit cur, nxt; int ui = 0;
    if (!S.next(0, cur)) return;
    f32x4 acc[2][2][4][2];
#pragma unroll
    for (int a = 0; a < 2; ++a)
#pragma unroll
        for (int b = 0; b < 2; ++b)
#pragma unroll
            for (int m = 0; m < 4; ++m)
#pragma unroll
                for (int n = 0; n < 2; ++n) acc[a][b][m][n] = (f32x4){0.f, 0.f, 0.f, 0.f};
    bf16x8 At[4][2], B0[2][2], B1[2][2];
    const char* cA = (const char*)g.A + (size_t)cur.pm * tstep; const char* cB = (const char*)g.Bt + (size_t)cur.pn * tstep;
    S.a_ready(cur);
    if constexpr (SP2) {
        PG8_STAGE(PG8_SB(0, 0), cB, voffB); PG8_STAGE(PG8_SB(0, 1), cB + hstep, voffB); PG8_STAGE(PG8_SA(0, 0), cA, voffA); PG8_STAGE(PG8_SA(0, 1), cA + hstep, voffA);
        if (wr == 1) PG8_BAR;
        PG8_WAIT_V(2); PG8_BAR;
        PG8_STAGE(PG8_SB(1, 0), cB + kstep, voffB); PG8_STAGE(PG8_SA(1, 0), cA + kstep, voffA); PG8_STAGE(PG8_SB(1, 1), cB + hstep + kstep, voffB);
        PG8_WAIT_V(6); PG8_BAR;
    } else {
        PG8_STAGE(PG8_SB(0, 0), cB, voffB); PG8_STAGE(PG8_SA(0, 0), cA, voffA); PG8_STAGE(PG8_SB(0, 1), cB + hstep, voffB); PG8_STAGE(PG8_SA(0, 1), cA + hstep, voffA);
        if (wr == 1) PG8_BAR;
        PG8_WAIT_V(4); PG8_BAR;
        PG8_STAGE(PG8_SB(1, 0), cB + kstep, voffB); PG8_STAGE(PG8_SA(1, 0), cA + kstep, voffA); PG8_STAGE(PG8_SB(1, 1), cB + hstep + kstep, voffB);
        PG8_WAIT_V(6); PG8_BAR;
    }
    for (;;) {
        const bool has_next = S.next(ui + 1, nxt);
        const char* nA = has_next ? (const char*)g.A + (size_t)nxt.pm * tstep : cA; const char* nB = has_next ? (const char*)g.Bt + (size_t)nxt.pn * tstep : cB;
        for (int t = 0; t < nt; t += 2) {
            const bool last = (t == nt - 2);
            const char* a1 = cA + (size_t)(t + 1) * kstep;
            const char* a2 = last ? nA : cA + (size_t)(t + 2) * kstep; const char* b2 = last ? nB : cB + (size_t)(t + 2) * kstep;
            const char* a3 = a2 + kstep; const char* b3 = b2 + kstep;
            if (last && has_next) S.a_ready(nxt);
            if constexpr (SP2) {
            PG8_LDB(B0, 0, 0); PG8_LDB(B1, 0, 1); PG8_SCHED; PG8_LDA(At, 0, 0); PG8_STAGE(PG8_SA(1, 1), a1 + hstep, voffA);
            PG8_WAIT_V(8); PG8_WAIT_L(0); PG8_BAR; PG8_MMA(0, 0, At, B0); PG8_MMA(0, 1, At, B1); PG8_BAR; PG8_SCHED;
            PG8_LDA(At, 0, 1); PG8_STAGE(PG8_SB(0, 0), b2, voffB); PG8_STAGE(PG8_SB(0, 1), b2 + hstep, voffB); PG8_STAGE(PG8_SA(0, 0), a2, voffA);
            PG8_WAIT_V(8); PG8_WAIT_L(0); PG8_BAR; PG8_MMA(1, 0, At, B0); PG8_MMA(1, 1, At, B1); PG8_BAR; PG8_SCHED;
            PG8_LDB(B0, 1, 0); PG8_LDB(B1, 1, 1); PG8_SCHED; PG8_LDA(At, 1, 0); PG8_STAGE(PG8_SA(0, 1), a2 + hstep, voffA);
            PG8_WAIT_V(8); PG8_WAIT_L(0); PG8_BAR; PG8_MMA(0, 0, At, B0); PG8_MMA(0, 1, At, B1); PG8_BAR; PG8_SCHED;
            PG8_LDA(At, 1, 1); PG8_STAGE(PG8_SB(1, 0), b3, voffB); PG8_STAGE(PG8_SB(1, 1), b3 + hstep, voffB); PG8_STAGE(PG8_SA(1, 0), a3, voffA);
            PG8_WAIT_V(8); PG8_WAIT_L(0); PG8_BAR; PG8_MMA(1, 0, At, B0); PG8_MMA(1, 1, At, B1); PG8_BAR; PG8_SCHED;
            } else {
            PG8_LDB(B0, 0, 0); PG8_SCHED; PG8_LDA(At, 0, 0); PG8_STAGE(PG8_SA(1, 1), a1 + hstep, voffA);
            PG8_WAIT_L(8); PG8_BAR; PG8_WAIT_L(0); PG8_MMA(0, 0, At, B0); PG8_BAR; PG8_SCHED;
            PG8_LDB(B1, 0, 1); PG8_STAGE(PG8_SB(0, 0), b2, voffB);
            PG8_BAR; PG8_WAIT_L(0); PG8_MMA(0, 1, At, B1); PG8_BAR;
            PG8_LDA(At, 0, 1); PG8_STAGE(PG8_SA(0, 0), a2, voffA);
            PG8_BAR; PG8_WAIT_L(0); PG8_MMA(1, 0, At, B0); PG8_BAR; PG8_SCHED;
            PG8_STAGE(PG8_SB(0, 1), b2 + hstep, voffB);
            PG8_WAIT_V(6); PG8_BAR; PG8_MMA(1, 1, At, B1); PG8_BAR;
            PG8_LDB(B0, 1, 0); PG8_SCHED; PG8_LDA(At, 1, 0); PG8_STAGE(PG8_SA(0, 1), a2 + hstep, voffA);
            PG8_WAIT_L(8); PG8_BAR; PG8_WAIT_L(0); PG8_MMA(0, 0, At, B0); PG8_BAR; PG8_SCHED;
            PG8_LDB(B1, 1, 1); PG8_STAGE(PG8_SB(1, 0), b3, voffB);
            PG8_BAR; PG8_WAIT_L(0); PG8_MMA(0, 1, At, B1); PG8_BAR;
            PG8_LDA(At, 1, 1); PG8_STAGE(PG8_SA(1, 0), a3, voffA);
            PG8_BAR; PG8_WAIT_L(0); PG8_MMA(1, 0, At, B0); PG8_BAR; PG8_SCHED;
            PG8_STAGE(PG8_SB(1, 1), b3 + hstep, voffB);
            PG8_WAIT_V(6); PG8_BAR; PG8_MMA(1, 1, At, B1); PG8_BAR;
            }
        }
        if constexpr (ALIGN_EPI) { if (wr == 0) PG8_BAR; }
        if constexpr (!Epi::AFTER_DRAIN) { E(acc, cur, wr, wc, fr, fq); S.done(cur); }
        if (!has_next) break;
#pragma unroll
        for (int a = 0; a < 2; ++a)
#pragma unroll
            for (int b = 0; b < 2; ++b)
#pragma unroll
                for (int m = 0; m < 4; ++m)
#pragma unroll
                    for (int n = 0; n < 2; ++n) acc[a][b][m][n] = (f32x4){0.f, 0.f, 0.f, 0.f};
        cur = nxt; cA = nA; cB = nB; ++ui;
        if constexpr (ALIGN_EPI) { if (wr == 1) PG8_BAR; }
    }
    PG8_WAIT_V(0);
    if constexpr (!ALIGN_EPI) { if (wr == 0) PG8_BAR; }
    PG8_BAR;
    if constexpr (Epi::AFTER_DRAIN) { E.fused(acc, cur, wr, wc, fr, fq, lds, wid, lane); S.done(cur); }
#undef PG8_SA
#undef PG8_SB
#undef PG8_STAGE
#undef PG8_LDA
#undef PG8_LDB
#undef PG8_MMA
#undef PG8_WAIT_V
#undef PG8_WAIT_L
#undef PG8_BAR
#undef PG8_SCHED
}
}

namespace att {
using bf16x8 = __attribute__((ext_vector_type(8))) short;
using s16x4  = __attribute__((ext_vector_type(4))) short;
using f32x16 = __attribute__((ext_vector_type(16))) float;
using u32x4  = __attribute__((ext_vector_type(4))) unsigned;
constexpr int NW = 8, QBLK = 32, KVBLK = 64, DV = 128;
#define ATT_SBAR() __builtin_amdgcn_sched_barrier(0)
__device__ __forceinline__ int crow(int r, int hi) { return (r & 3) + 8 * (r >> 2) + 4 * hi; }
__device__ __forceinline__ unsigned cvtpk(float lo, float hi) { unsigned r; asm volatile("v_cvt_pk_bf16_f32 %0, %1, %2" : "=v"(r) : "v"(lo), "v"(hi)); return r; }
template <int DQK> __device__ __forceinline__ int kswz(int row, int colB) { return row * (DQK * 2) + (colB ^ ((row & 7) << 4)); }
constexpr float THR = 8.f;

template <int DQK> struct Cfg {
    static constexpr int SHM_V = KVBLK * DV * 2, SHM_K = KVBLK * DQK * 2;
    static constexpr int OFF_V = 0, OFF_K = 2 * SHM_V, OFF_WS = OFF_K + 2 * SHM_K, OFF_BIAS = OFF_WS + NW * 64 * 4, LDS_BYTES = OFF_BIAS + 10240;
    static constexpr int KCH = DQK / 8;
    static constexpr int KLD = (64 * KCH) / 512;
};

struct Job {
    const bf16_t* Q;
    const bf16_t* K;
    const bf16_t* V;
    bf16_t* O;
    int nt;
    int seg0_tiles, row_seg0, row_seg1;
    int R0; int rlo;
};

__device__ __forceinline__ int tile_row(const Job& J, int j) {
    if (j < J.seg0_tiles) return J.row_seg0 + 64 * j;
    int jj = j - J.seg0_tiles; if (jj > 3) jj = 0; return J.row_seg1 + 64 * jj;
}

__device__ __forceinline__ void partialSM(f32x16& p0, f32x16& p1, float& m_reg, float& mn, float& alpha, float C, float thr_raw) {
    float pmax = p0[0];
#pragma unroll
    for (int r = 1; r < 16; ++r) pmax = fmaxf(pmax, p0[r]);
#pragma unroll
    for (int r = 0; r < 16; ++r) pmax = fmaxf(pmax, p1[r]);
    { auto rr = __builtin_amdgcn_permlane32_swap(__float_as_uint(pmax), __float_as_uint(pmax), false, false);
      pmax = fmaxf(__uint_as_float(rr[0]), __uint_as_float(rr[1])); }
    if (__builtin_expect(__all(pmax - m_reg <= thr_raw), 1)) { mn = m_reg; alpha = 1.f; }
    else { mn = fmaxf(m_reg, pmax); alpha = __builtin_amdgcn_exp2f((m_reg - mn) * C); m_reg = mn; }
    const float mnC = -mn * C;
#pragma unroll
    for (int r = 0; r < 16; ++r) p0[r] = fmaf(p0[r], C, mnC);
#pragma unroll
    for (int r = 0; r < 16; ++r) p1[r] = fmaf(p1[r], C, mnC);
#pragma unroll
    for (int r = 0; r < 16; ++r) p0[r] = __builtin_amdgcn_exp2f(p0[r]);
}
__device__ __forceinline__ void finishSM(f32x16& p0, f32x16& p1, float alpha, float& l_reg, bf16x8& pa0, bf16x8& pa1, bf16x8& pa2, bf16x8& pa3) {
#pragma unroll
    for (int r = 0; r < 16; ++r) p1[r] = __builtin_amdgcn_exp2f(p1[r]);
    float ps = 0;
#pragma unroll
    for (int r = 0; r < 16; ++r) ps += p0[r];
#pragma unroll
    for (int r = 0; r < 16; ++r) ps += p1[r];
    { auto rr = __builtin_amdgcn_permlane32_swap(__float_as_uint(ps), __float_as_uint(ps), false, false);
      ps = __uint_as_float(rr[0]) + __uint_as_float(rr[1]); }
    l_reg = l_reg * alpha + ps;
#define ATT_PK4(P, BASE, OUT) do { unsigned a0 = cvtpk(P[BASE + 0], P[BASE + 1]), a1 = cvtpk(P[BASE + 2], P[BASE + 3]);   \
    unsigned b0 = cvtpk(P[BASE + 4], P[BASE + 5]), b1 = cvtpk(P[BASE + 6], P[BASE + 7]);                              \
    auto r0 = __builtin_amdgcn_permlane32_swap(a0, b0, false, false); auto r1 = __builtin_amdgcn_permlane32_swap(a1, b1, false, false); \
    u32x4 w = {r0[0], r1[0], r0[1], r1[1]}; OUT = *reinterpret_cast<bf16x8*>(&w); } while (0)
    ATT_PK4(p0, 0, pa0); ATT_PK4(p0, 8, pa1); ATT_PK4(p1, 0, pa2); ATT_PK4(p1, 8, pa3);
#undef ATT_PK4
}
template <int DQK> __device__ __forceinline__ void qkt(f32x16& p0, f32x16& p1, const char* Ks, const bf16x8* qr, int r32, int hi) {
    p0 = f32x16{}; p1 = f32x16{};
#pragma unroll
    for (int d0 = 0; d0 < DQK / 16; ++d0) { const int cb = (d0 * 16 + hi * 8) * 2;
        const bf16x8 b0 = *reinterpret_cast<const bf16x8*>(Ks + kswz<DQK>(r32, cb));
        const bf16x8 b1 = *reinterpret_cast<const bf16x8*>(Ks + kswz<DQK>(32 + r32, cb));
        p0 = __builtin_amdgcn_mfma_f32_32x32x16_bf16(b0, qr[d0], p0, 0, 0, 0);
        p1 = __builtin_amdgcn_mfma_f32_32x32x16_bf16(b1, qr[d0], p1, 0, 0, 0); }
}
__device__ __forceinline__ int v_st(int k, int c) { const int kk = (k & ~0xC) | ((k & 4) << 1) | ((k & 8) >> 1); return ((kk >> 3) * 4 + (c >> 5)) * 512 + ((kk & 7) * 32 + (c & 31)) * 2; }
__device__ __forceinline__ int v_rd_base(int lane) { return ((lane & 3) << 3) | (((lane >> 2) & 3) << 6) | (((lane >> 4) & 1) << 5) | (((lane >> 5) & 1) << 8); }
constexpr int v_rd_off(int d0, int ks, int half) { return d0 * 512 + ks * 4096 + half * 2048; }
template <int OFF> __device__ __forceinline__ s16x4 tr_read(int vb) { s16x4 r; asm volatile("ds_read_b64_tr_b16 %0, %1 offset:%2" : "=&v"(r) : "v"(vb), "i"(OFF) : "memory"); return r; }
template <int D0> __device__ __forceinline__ void pv_one(f32x16& od, int vb, bf16x8 pa0, bf16x8 pa1, bf16x8 pa2, bf16x8 pa3) {
    const s16x4 l0 = tr_read<v_rd_off(D0, 0, 0)>(vb), h0 = tr_read<v_rd_off(D0, 0, 1)>(vb), l1 = tr_read<v_rd_off(D0, 1, 0)>(vb), h1 = tr_read<v_rd_off(D0, 1, 1)>(vb);
    const s16x4 l2 = tr_read<v_rd_off(D0, 2, 0)>(vb), h2 = tr_read<v_rd_off(D0, 2, 1)>(vb), l3 = tr_read<v_rd_off(D0, 3, 0)>(vb), h3 = tr_read<v_rd_off(D0, 3, 1)>(vb);
    asm volatile("s_waitcnt lgkmcnt(0)" ::: "memory"); ATT_SBAR();
#define ATT_PK(L, H) (bf16x8){L[0], L[1], L[2], L[3], H[0], H[1], H[2], H[3]}
    od = __builtin_amdgcn_mfma_f32_32x32x16_bf16(pa0, ATT_PK(l0, h0), od, 0, 0, 0);
    od = __builtin_amdgcn_mfma_f32_32x32x16_bf16(pa1, ATT_PK(l1, h1), od, 0, 0, 0);
    od = __builtin_amdgcn_mfma_f32_32x32x16_bf16(pa2, ATT_PK(l2, h2), od, 0, 0, 0);
    od = __builtin_amdgcn_mfma_f32_32x32x16_bf16(pa3, ATT_PK(l3, h3), od, 0, 0, 0);
#undef ATT_PK
}
__device__ __forceinline__ void pv_d0(f32x16* o, int vb, bf16x8 pa0, bf16x8 pa1, bf16x8 pa2, bf16x8 pa3) {
    pv_one<0>(o[0], vb, pa0, pa1, pa2, pa3); pv_one<1>(o[1], vb, pa0, pa1, pa2, pa3); pv_one<2>(o[2], vb, pa0, pa1, pa2, pa3); pv_one<3>(o[3], vb, pa0, pa1, pa2, pa3);
}
constexpr int NA_BROW = 160, NA_BORG = 64 + (NA_KW - 1);
__device__ __forceinline__ void na_bias(f32x16& p0, f32x16& p1, const Job& J, int j, int R, int c, int hi, const float* biasq) {
    const int nloc = J.seg0_tiles;
    if (j >= nloc && j < nloc + 4) return;
    const int rr = J.rlo + j; int r0 = R - NA_KH / 2; r0 = r0 < 0 ? 0 : (r0 > ROWS - NA_KH ? ROWS - NA_KH : r0);
    const bool rowok = (j < nloc) && rr >= r0 && rr < r0 + NA_KH;
    if (!rowok) {
#pragma unroll
        for (int r = 0; r < 16; ++r) { p0[r] = -1e30f; p1[r] = -1e30f; }
        return; }
    int c0 = c - NA_KW / 2; c0 = c0 < 0 ? 0 : (c0 > GRID_W - NA_KW ? GRID_W - NA_KW : c0);
    const int dr = rr - R + (NA_KH - 1);
    const float* bl = biasq + dr * NA_BROW + NA_BORG + 4 * hi - c;
    const int vb = 4 * hi - c0;
#pragma unroll
    for (int r = 0; r < 16; ++r) { const int cc = (r & 3) + 8 * (r >> 2);
        p0[r] = ((unsigned)(cc + vb) < (unsigned)NA_KW) ? p0[r] + bl[cc] : -1e30f;
        p1[r] = ((unsigned)(cc + 32 + vb) < (unsigned)NA_KW) ? p1[r] + bl[cc + 32] : -1e30f; }
}

#define ATT_LAS __attribute__((address_space(3)))
template <int DQK, bool NA, int LDQ, int LDK, int LDV, int LDO>
__device__ __forceinline__ void attn_unit(const Job& J, char* lds, const float scale, const int tid_in) {
    using C_ = Cfg<DQK>;
    int tid_ = tid_in; asm volatile("" : "+v"(tid_));
    const int tid = tid_, wid = __builtin_amdgcn_readfirstlane(tid >> 6), lane = tid & 63, r32 = lane & 31, hi = lane >> 5;
    char* V_lds = lds + C_::OFF_V; char* K_lds = lds + C_::OFF_K;
    const unsigned ldsb = (unsigned)(uintptr_t)lds;
    float* wsf = (float*)(lds + C_::OFF_WS) + wid * 64; float* li_l = wsf; float* al_l = wsf + 32;
    const float* biasq = (const float*)(lds + C_::OFF_BIAS);
    const float Cc = scale * 1.4426950408889634f, thr_raw = THR / scale;
    float m_reg = -1e5f, l_reg = 0; f32x16 o[4] = {}; bf16x8 qr[DQK / 16];
    const bf16_t* Qw = J.Q + (long)(wid * QBLK + r32) * LDQ + hi * 8;
#pragma unroll
    for (int d0 = 0; d0 < DQK / 16; ++d0) qr[d0] = *reinterpret_cast<const bf16x8*>(Qw + d0 * 16);
    const int naR = J.R0 + (wid >> 1), nac = (wid & 1) * 32 + r32;
    const int vb0 = (int)(uintptr_t)V_lds + v_rd_base(lane);
    unsigned koff[C_::KLD], voff[2];
#pragma unroll
    for (int i = 0; i < C_::KLD; ++i) { const int sl = 512 * i + tid, row = sl / C_::KCH, cs = sl % C_::KCH, chunk = (cs & ~7) | ((cs & 7) ^ (row & 7)); koff[i] = (unsigned)(row * LDK * 2 + chunk * 16); }
#pragma unroll
    for (int i = 0; i < 2; ++i) { const int sl = 512 * i + tid, sub = sl >> 5, wi = sl & 31, kk = (sub >> 2) * 8 + (wi >> 2), k = (kk & ~0xC) | ((kk & 4) << 1) | ((kk & 8) >> 1), c = (sub & 3) * 32 + (wi & 3) * 8;
        voff[i] = (unsigned)(k * LDV * 2 + c * 2); }
#define ATT_STAGE(j, b) do { const int row0_ = tile_row(J, (j)); const char* vp_ = (const char*)(J.V + (size_t)row0_ * LDV); const char* kp_ = (const char*)(J.K + (size_t)row0_ * LDK); \
        _Pragma("unroll") for (int i_ = 0; i_ < C_::KLD; ++i_) __builtin_amdgcn_global_load_lds((const unsigned*)(kp_ + koff[i_]), (ATT_LAS unsigned*)(ldsb + C_::OFF_K + (b) * C_::SHM_K + (512 * i_ + 64 * wid) * 16), 16, 0, 0); \
        _Pragma("unroll") for (int i_ = 0; i_ < 2; ++i_) __builtin_amdgcn_global_load_lds((const unsigned*)(vp_ + voff[i_]), (ATT_LAS unsigned*)(ldsb + C_::OFF_V + (b) * C_::SHM_V + (512 * i_ + 64 * wid) * 16), 16, 0, 0); } while (0)
    const int NT = J.nt;
    __syncthreads();
    ATT_STAGE(0, 0); asm volatile("s_waitcnt vmcnt(0)" ::: "memory"); __syncthreads();
    for (int j = 0; j < NT; ++j) {
        const int buf = j & 1;
        if (j + 1 < NT) ATT_STAGE(j + 1, buf ^ 1);
        f32x16 p0, p1; float mn, al; bf16x8 pa0, pa1, pa2, pa3;
        qkt<DQK>(p0, p1, K_lds + buf * C_::SHM_K, qr, r32, hi);
        if (NA) na_bias(p0, p1, J, j, naR, nac, hi, biasq);
        partialSM(p0, p1, m_reg, mn, al, Cc, thr_raw);
        finishSM(p0, p1, al, l_reg, pa0, pa1, pa2, pa3);
        if (__any(al < 1.f)) { if (hi == 0) al_l[r32] = al; asm volatile("s_waitcnt lgkmcnt(0)" ::: "memory");
#pragma unroll
            for (int d = 0; d < 4; ++d)
#pragma unroll
                for (int r = 0; r < 16; ++r) o[d][r] *= al_l[crow(r, hi)]; }
        ATT_SBAR();
        pv_d0(o, vb0 + buf * C_::SHM_V, pa0, pa1, pa2, pa3);
        asm volatile("s_waitcnt vmcnt(0)" ::: "memory");
        __syncthreads();
    }
    if (hi == 0) li_l[r32] = l_reg; asm volatile("s_waitcnt lgkmcnt(0)" ::: "memory");
    float rli[16];
#pragma unroll
    for (int r = 0; r < 16; ++r) rli[r] = __builtin_amdgcn_rcpf(li_l[crow(r, hi)]);
    bf16_t* Ow = J.O + (long)(wid * QBLK) * LDO;
#pragma unroll
    for (int r = 0; r < 16; ++r) { const int orow = crow(r, hi);
#pragma unroll
        for (int d0 = 0; d0 < 4; ++d0) Ow[(long)orow * LDO + d0 * 32 + r32] = f2bf(o[d0][r] * rli[r]); }
#undef ATT_STAGE
}
}

struct AttnArgs { const bf16_t *QM, *KM, *VM, *NQ, *NK, *P; bf16_t* Y; const float* rpb; int want_ctx; int pad; };
__device__ __forceinline__ void attention_phase(const AttnArgs& A, char* lds, int G, int wg, const int tid) {
    static_assert(GRID_W == 64 && SEQ % 256 == 0 && CTX_LEN == 256 && HD == 128, "attention phase geometry");
    constexpr int NQB = SEQ / 256;
    constexpr float sc_mla = 0.07216878364870323f, sc_na = 0.08838834764831845f;
    static_assert(MLA_QK == 192 && HD == 128, "softmax scales");
    if (!(A.pad & 2)) for (int u = wg; u < BATCH * NH * NQB; u += G) {
        const int bh = u % (BATCH * NH), qb = u / (BATCH * NH), b = bh / NH, h = bh % NH;
        att::Job J{};
        J.Q = A.QM + (size_t)(b * SEQ + qb * 256) * NQ_MLA + h * MLA_QK; J.K = A.KM + h * MLA_QK; J.V = A.VM + h * MLA_V;
        J.O = A.Y + (size_t)(b * SEQ + qb * 256) * D_MODEL + GROUP_W + h * MLA_V;
        J.nt = SEQ / 64 + CTX_LEN / 64; J.seg0_tiles = SEQ / 64; J.row_seg0 = b * SEQ; J.row_seg1 = M_LAT + b * CTX_LEN;
        att::attn_unit<MLA_QK, false, NQ_MLA, NQ_MLA, NH * MLA_V, D_MODEL>(J, lds, sc_mla, tid);
    }
    if (!(A.pad & 4)) for (int u = wg; u < BATCH * NH * NQB; u += G) {
        const int bh = u % (BATCH * NH), qb = u / (BATCH * NH), b = bh / NH, h = bh % NH, R0 = qb * 4;
        __syncthreads();
        { float* bq = (float*)(lds + att::Cfg<HD>::OFF_BIAS); const float* src = A.rpb + (size_t)h * (2 * NA_KH - 1) * (2 * NA_KW - 1);
          for (int i = tid; i < (2 * NA_KH - 1) * att::NA_BROW; i += 512) { const int dr = i / att::NA_BROW; int dc = i % att::NA_BROW - att::NA_BORG + (NA_KW - 1); dc = dc < 0 ? 0 : (dc > 2 * NA_KW - 2 ? 2 * NA_KW - 2 : dc);
              bq[i] = src[dr * (2 * NA_KW - 1) + dc] * 11.313708498984761f; } }
        int rlo = R0 - NA_KH / 2; rlo = rlo < 0 ? 0 : (rlo > ROWS - NA_KH ? ROWS - NA_KH : rlo);
        int rhi = R0 + 3 - NA_KH / 2; rhi = (rhi < 0 ? 0 : (rhi > ROWS - NA_KH ? ROWS - NA_KH : rhi)) + NA_KH - 1;
        const int nloc = rhi - rlo + 1;
        att::Job J{};
        J.Q = A.NQ + (size_t)(b * SEQ + R0 * 64) * GROUP_W + h * HD; J.K = A.NK + h * HD; J.V = A.P + C_NV + h * HD;
        J.O = A.Y + (size_t)(b * SEQ + R0 * 64) * D_MODEL + 3 * GROUP_W + h * HD;
        J.nt = (nloc + 4 + 1) & ~1; J.seg0_tiles = nloc; J.row_seg0 = b * SEQ + rlo * 64; J.row_seg1 = M_LAT + b * CTX_LEN;  J.R0 = R0; J.rlo = rlo;
        att::attn_unit<HD, true, GROUP_W, GROUP_W, NP, D_MODEL>(J, lds, sc_na, tid);
    }
    if (A.want_ctx && !(A.pad & 8)) {
        for (int u = wg; u < BATCH * NH; u += G) {
            const int b = u / NH, h = u % NH; const int crow0 = M_LAT + b * CTX_LEN;
            att::Job J{}; J.nt = CTX_LEN / 64; J.seg0_tiles = 0; J.row_seg0 = crow0; J.row_seg1 = crow0;
            J.Q = A.QM + (size_t)crow0 * NQ_MLA + h * MLA_QK; J.K = A.KM + h * MLA_QK; J.V = A.VM + h * MLA_V;
            J.O = A.Y + (size_t)crow0 * D_MODEL + GROUP_W + h * MLA_V; att::attn_unit<MLA_QK, false, NQ_MLA, NQ_MLA, NH * MLA_V, D_MODEL>(J, lds, sc_mla, tid);
        }
        for (int u = wg - BATCH * NH; u >= 0 && u < BATCH * NH; u += G) {
            const int b = u / NH, h = u % NH; const int crow0 = M_LAT + b * CTX_LEN;
            att::Job J{}; J.nt = CTX_LEN / 64; J.seg0_tiles = 0; J.row_seg0 = crow0; J.row_seg1 = crow0;
            J.Q = A.NQ + (size_t)crow0 * GROUP_W + h * HD; J.K = A.NK + h * HD; J.V = A.P + C_NV + h * HD;
            J.O = A.Y + (size_t)crow0 * D_MODEL + 3 * GROUP_W + h * HD; att::attn_unit<HD, false, GROUP_W, GROUP_W, NP, D_MODEL>(J, lds, sc_na, tid);
        }
    }
}

namespace gdn {
typedef short bf16x8 __attribute__((ext_vector_type(8)));
typedef float f32x4 __attribute__((ext_vector_type(4)));
typedef float f32x16 __attribute__((ext_vector_type(16)));
typedef unsigned u32x2 __attribute__((ext_vector_type(2)));
typedef unsigned u32x4 __attribute__((ext_vector_type(4)));
constexpr int CH = 64, NCHUNK = M_ALL / CH;
constexpr int NTASK = NCHUNK * NH * 2;
constexpr size_t SZ_UT = 128 * 64, SZ_WP = 64 * 128, SZ_KDT = 128 * 64, SZ_QD = 64 * 128, SZ_QK = 64 * 64, SZ_SIT = 128 * 128, SZ_VNT = 128 * 64;
struct Bufs { bf16_t *UT, *WP, *KDT, *QD, *QK, *SIT, *VNT; float* GT; };
__device__ __forceinline__ int perm32(int o) { return (o & ~31) | (((o & 15) >> 2) * 8 + ((o >> 4) & 1) * 4 + (o & 3)); }
__device__ __forceinline__ unsigned pk2(float lo, float hi) { return (unsigned)f2bf(lo) | ((unsigned)f2bf(hi) << 16); }

constexpr int QS = 132;
constexpr int AS = 68;
constexpr int G1_OFF_Q = 0, G1_OFF_K = G1_OFF_Q + CH * QS * 4, G1_OFF_V = G1_OFF_K + CH * QS * 4, G1_OFF_AA = G1_OFF_V + CH * QS * 4, G1_OFF_SM = G1_OFF_AA + 2 * CH * AS * 4,
              G1_LDS = G1_OFF_SM + 8 * 64 * 4;
struct G1Args { const bf16_t* P; const float* conv_w; const float* a_log; const float* dt_bias; Bufs B; };

__device__ __forceinline__ void g1_task(const G1Args& A, char* lds, int cix, int h, const int tid_in) {
    int tid_ = tid_in; asm volatile("" : "+v"(tid_));
    const int tid = tid_, wid = __builtin_amdgcn_readfirstlane(tid >> 6), lane = tid & 63;
    float* Qs = (float*)(lds + G1_OFF_Q); float* Ks = (float*)(lds + G1_OFF_K); float* Vs = (float*)(lds + G1_OFF_V); float* AA = (float*)(lds + G1_OFF_AA);
    float* sm = (float*)(lds + G1_OFF_SM); float* g_s = sm;   float* beta_s = sm + 128;   float* gc_s = sm + 256;
    const int row0 = cix * CH; const RowInfo r0i = row_info(row0);
    __syncthreads();
    if (tid < 48 * 8) {
        const int grp = tid % 48, ts = tid / 48, which = grp >> 4, cc0 = (grp & 15) * 8, ch0 = which * GROUP_W + h * HD + cc0;
        float wgt[4][8];
#pragma unroll
        for (int j = 0; j < 4; ++j) { const f32x4 w0 = *(const f32x4*)(A.conv_w + j * 3 * GROUP_W + ch0), w1 = *(const f32x4*)(A.conv_w + j * 3 * GROUP_W + ch0 + 4);
#pragma unroll
            for (int e = 0; e < 4; ++e) { wgt[j][e] = w0[e]; wgt[j][4 + e] = w1[e]; } }
        u32x4 xr[11];
#pragma unroll
        for (int k = 0; k < 11; ++k) { const int tt = r0i.t + 8 * ts + k - 1;
            xr[k] = (tt >= 0 && tt < r0i.T) ? *(const u32x4*)(A.P + (size_t)(r0i.base + tt) * NP + C_GQ + ch0) : (u32x4){0u, 0u, 0u, 0u}; }
        float* dstp = (which == 0 ? Qs : which == 1 ? Ks : Vs) + cc0;
#pragma unroll
        for (int i = 0; i < 8; ++i) { float acc[8];
#pragma unroll
            for (int e = 0; e < 8; ++e) acc[e] = 0.f;
#pragma unroll
            for (int j = 0; j < 4; ++j) { const u32x4 xv = xr[i + j];
#pragma unroll
                for (int e = 0; e < 4; ++e) { acc[2 * e] += wgt[j][2 * e] * bflo(xv[e]); acc[2 * e + 1] += wgt[j][2 * e + 1] * bfhi(xv[e]); } }
            f32x4 y0, y1;
#pragma unroll
            for (int e = 0; e < 4; ++e) { y0[e] = acc[e] / (1.0f + __expf(-acc[e])); y1[e] = acc[4 + e] / (1.0f + __expf(-acc[4 + e])); }
            *(f32x4*)(dstp + (8 * ts + i) * QS) = y0; *(f32x4*)(dstp + (8 * ts + i) * QS + 4) = y1; }
    }
    if (tid < 128) { const int d = tid >> 6, i = tid & 63; const size_t r = (size_t)(row0 + i) * NP;
        beta_s[d * 64 + i] = 1.0f / (1.0f + __expf(-bf2f(A.P[r + C_GB + d * NH + h])));
        g_s[d * 64 + i] = -__expf(A.a_log[d * NH + h]) * softplusf_(bf2f(A.P[r + C_GA + d * NH + h]) + A.dt_bias[d * NH + h]); }
    __syncthreads();
    for (int rr = wid; rr < 2 * CH; rr += 8) { float* rowp = (rr < CH ? Qs : Ks) + (rr & 63) * QS;
        const float a = rowp[lane], b = rowp[lane + 64]; float ss = a * a + b * b;
#pragma unroll
        for (int o = 1; o < 64; o <<= 1) ss += lane_xor(ss, o, lane);
        const float scl = (1.0f / sqrtf(ss + EPS)) * (rr < CH ? 0.08838834764831845f : 1.0f);
        rowp[lane] = a * scl; rowp[lane + 64] = b * scl; }
    if (tid < 2) {
        f32x4 gv[16];
#pragma unroll
        for (int m = 0; m < 16; ++m) gv[m] = *(const f32x4*)(g_s + tid * 64 + 4 * m);
        float run = 0.f;
        if (tid == 0) {
#pragma unroll
            for (int m = 0; m < 16; ++m) { f32x4 o4;
#pragma unroll
                for (int e = 0; e < 4; ++e) { run += gv[m][e]; o4[e] = run; }
                *(f32x4*)(gc_s + 4 * m) = o4; }
        } else {
#pragma unroll
            for (int m = 15; m >= 0; --m) { f32x4 o4;
#pragma unroll
                for (int e = 3; e >= 0; --e) { run += gv[m][e]; o4[e] = run; }
                *(f32x4*)(gc_s + 64 + 4 * m) = o4; }
        }
    }
    __syncthreads();
    {
        const int which = wid >> 2, I = (wid >> 1) & 1, J = wid & 1, r32 = lane & 31, hi = lane >> 5;
        const float* X = (which ? Qs : Ks) + (32 * I + r32) * QS + 4 * hi; const float* Yp = Ks + (32 * J + r32) * QS + 4 * hi;
        f32x16 acc = {};
#pragma unroll
        for (int s = 0; s < 16; ++s) { const f32x4 a4 = *(const f32x4*)(X + 8 * s), b4 = *(const f32x4*)(Yp + 8 * s);
#pragma unroll
            for (int e = 0; e < 4; ++e) acc = __builtin_amdgcn_mfma_f32_32x32x2f32(a4[e], b4[e], acc, 0, 0, 0); }
        const int j = 32 * J + r32;
        const size_t t0 = ((size_t)cix * NH + h) * 2;
        if (which == 0) {
            const float b1j = beta_s[64 + j], g0j = gc_s[j], g1j = gc_s[64 + j];
#pragma unroll
            for (int r = 0; r < 16; ++r) { const int i = 32 * I + (r & 3) + 8 * (r >> 2) + 4 * hi;
                if (i > j) { const float kk = acc[r];
                    AA[(63 - j) * AS + (63 - i)] = beta_s[i] * kk * __expf(gc_s[i] - g0j);
                    AA[CH * AS + i * AS + j] = b1j * kk * __expf(g1j - gc_s[64 + i]); } }
        } else {
            bf16_t* q0 = A.B.QK + (t0 + 0) * SZ_QK; bf16_t* q1 = A.B.QK + (t0 + 1) * SZ_QK;
            const float g0j = gc_s[j], g1j = gc_s[64 + j];
#pragma unroll
            for (int r = 0; r < 16; ++r) { const int i = 32 * I + (r & 3) + 8 * (r >> 2) + 4 * hi; const float qk = acc[r];
                q0[i * 64 + j] = f2bf(i >= j ? qk * __expf(gc_s[i] - g0j) : 0.f);
                q1[(63 - i) * 64 + (63 - j)] = f2bf(i <= j ? qk * __expf(gc_s[64 + i] - g1j) : 0.f); }
        }
    }
    __syncthreads();
    {
        const size_t t0 = ((size_t)cix * NH + h) * 2;
        const int d = tid >> 8, k = tid & 127, ph = (tid >> 7) & 1;
        bf16_t* qd = A.B.QD + (t0 + d) * SZ_QD; bf16_t* kdt = A.B.KDT + (t0 + d) * SZ_KDT + (size_t)k * 64;
        const float glast = d == 0 ? gc_s[63] : gc_s[64 + 0];
#pragma unroll 8
        for (int pp = 0; pp < 32; ++pp) { const int p = ph * 32 + pp, i = d == 0 ? p : 63 - p; const float gci = gc_s[d * 64 + i];
            qd[p * 128 + k] = f2bf(Qs[i * QS + k] * __expf(gci));
            kdt[perm32(p)] = f2bf(Ks[i * QS + k] * __expf(glast - gci)); }
        if (tid == 0) { A.B.GT[t0] = __expf(gc_s[63]); A.B.GT[t0 + 1] = __expf(gc_s[64]); }
    }
    __syncthreads();
    {
        int tidv = tid; asm volatile("" : "+v"(tidv));
        const int d = tidv >> 8, c = tidv & 255; const bool isw = c >= 128; const int cc = c & 127;
        const float* src = isw ? Ks : Vs;
        int lz; asm volatile("v_mov_b32 %0, 0" : "=v"(lz));
        const float* AAv = AA + lz + d * (CH * AS);
        float x[CH];
#pragma unroll
        for (int p = 0; p < CH; ++p) { const int i = d == 0 ? p : 63 - p; float f = beta_s[d * 64 + i]; if (isw) f *= __expf(gc_s[d * 64 + i]); x[p] = f * src[i * QS + cc]; }
        {
#pragma unroll
            for (int p = 0; p < CH - 1; ++p) { const float xp = x[p]; const float* rowp = AAv + (63 - p) * AS;
#pragma unroll
                for (int m = 0; m <= (62 - p) / 4; ++m) { const f32x4 a4 = *(const f32x4*)(rowp + 4 * m);
#pragma unroll
                    for (int e = 0; e < 4; ++e) { const int col = 4 * m + e; if (col <= 62 - p) x[63 - col] -= a4[e] * xp; } } }
        }
        const size_t t = ((size_t)cix * NH + h) * 2 + d;
        if (!isw) { u32x4* dst = (u32x4*)(A.B.UT + t * SZ_UT + (size_t)cc * 64);
#pragma unroll
            for (int m = 0; m < 8; ++m) { u32x4 w4; w4.x = pk2(x[8 * m], x[8 * m + 1]); w4.y = pk2(x[8 * m + 2], x[8 * m + 3]); w4.z = pk2(x[8 * m + 4], x[8 * m + 5]); w4.w = pk2(x[8 * m + 6], x[8 * m + 7]); dst[m] = w4; }
        } else { bf16_t* dst = A.B.WP + t * SZ_WP + perm32(cc);
#pragma unroll
            for (int p = 0; p < CH; ++p) dst[p * 128] = f2bf(x[p]); }
    }
}
__device__ __forceinline__ void g1_phase(const G1Args& A, char* lds, int G, int wg, const int tid) {
    for (int t = wg; t < NCHUNK * NH; t += G) g1_task(A, lds, t / NH, t % NH, tid);
}

constexpr int WPS = 272, KDS = 144;
constexpr int G2_BUF = 64 * WPS + 128 * KDS, G2_LDS = 2 * G2_BUF;
__device__ __forceinline__ int g2_task_index(int b, int h, int d, int step) {
    constexpr int NC = CTX_LEN / CH, NL = SEQ / CH; int cix;
    if (step < NC) { const int n = d ? NC - 1 - step : step; cix = M_LAT / CH + b * NC + n; }
    else { const int s2 = step - NC, n = d ? NL - 1 - s2 : s2; cix = b * NL + n; }
    return (cix * NH + h) * 2 + d;
}
__device__ __forceinline__ void g2_chain(const Bufs& B, char* lds, int chain, const int tid_in) {
    int tid_ = tid_in; asm volatile("" : "+v"(tid_));
    const int tid = tid_, wid = __builtin_amdgcn_readfirstlane(tid >> 6), lane = tid & 63, q = lane >> 4, vl = lane & 15;
    const int d = chain & 1, h = (chain >> 1) % NH, b = chain / (2 * NH);
    constexpr int NSTEP = CTX_LEN / CH + SEQ / CH;
    f32x4 S[8];
#pragma unroll
    for (int kb = 0; kb < 8; ++kb) S[kb] = (f32x4){0.f, 0.f, 0.f, 0.f};
    u32x4 stw[2], stk[2];
#define G2_LOAD(ti) do { const u32x4* wp_ = (const u32x4*)(B.WP + (size_t)(ti) * SZ_WP); const u32x4* kp_ = (const u32x4*)(B.KDT + (size_t)(ti) * SZ_KDT); \
        stw[0] = wp_[tid]; stw[1] = wp_[tid + 512]; stk[0] = kp_[tid]; stk[1] = kp_[tid + 512]; } while (0)
#define G2_WRITE(buf) do { char* base_ = lds + (buf) * G2_BUF; \
        _Pragma("unroll") for (int i_ = 0; i_ < 2; ++i_) { const int id_ = tid + 512 * i_; \
            *(u32x4*)(base_ + (id_ >> 4) * WPS + (id_ & 15) * 16) = stw[i_]; *(u32x4*)(base_ + 64 * WPS + (id_ >> 3) * KDS + (id_ & 7) * 16) = stk[i_]; } } while (0)
#define G2_UADDR(ti) (B.UT + (size_t)(ti) * SZ_UT + (size_t)(16 * wid + vl) * 64 + 4 * q)
    __syncthreads();
    u32x2 uu[4]; float gt;
    { const int ti0 = g2_task_index(b, h, d, 0); G2_LOAD(ti0); const bf16_t* ut0 = G2_UADDR(ti0);
#pragma unroll
      for (int rb = 0; rb < 4; ++rb) uu[rb] = *(const u32x2*)(ut0 + 16 * rb);
      gt = B.GT[ti0]; G2_WRITE(0); }
    __syncthreads();
    for (int step = 0; step < NSTEP; ++step) {
        const int ti = g2_task_index(b, h, d, step), buf = step & 1;
        const int tn = g2_task_index(b, h, d, step + 1 < NSTEP ? step + 1 : step);
        G2_LOAD(tn);
        u32x2 un[4]; const bf16_t* utn = G2_UADDR(tn);
#pragma unroll
        for (int rb = 0; rb < 4; ++rb) un[rb] = *(const u32x2*)(utn + 16 * rb);
        const float gtn = B.GT[tn];
        __builtin_amdgcn_sched_barrier(0);
        const char* wl = lds + buf * G2_BUF; const char* kl = wl + 64 * WPS;
        bf16x8 aw[16], ak[16];
#pragma unroll
        for (int rb = 0; rb < 4; ++rb)
#pragma unroll
            for (int s = 0; s < 4; ++s) aw[rb * 4 + s] = *(const bf16x8*)(wl + (16 * rb + vl) * WPS + s * 64 + q * 16);
#pragma unroll
        for (int kb = 0; kb < 8; ++kb)
#pragma unroll
            for (int s = 0; s < 2; ++s) ak[kb * 2 + s] = *(const bf16x8*)(kl + (16 * kb + vl) * KDS + s * 64 + q * 16);
        bf16_t* sit = B.SIT + (size_t)ti * SZ_SIT + (size_t)(16 * wid + vl) * 128 + 4 * q;
        bf16x8 sf[4];
#pragma unroll
        for (int s = 0; s < 4; ++s) { u32x4 w4; w4.x = pk2(S[2 * s][0], S[2 * s][1]); w4.y = pk2(S[2 * s][2], S[2 * s][3]); w4.z = pk2(S[2 * s + 1][0], S[2 * s + 1][1]); w4.w = pk2(S[2 * s + 1][2], S[2 * s + 1][3]);
            sf[s] = __builtin_bit_cast(bf16x8, w4);
            *(u32x2*)(sit + 32 * s) = (u32x2){w4.x, w4.y}; *(u32x2*)(sit + 32 * s + 16) = (u32x2){w4.z, w4.w}; }
        __builtin_amdgcn_sched_barrier(0);
        f32x4 vn[4];
#pragma unroll
        for (int rb = 0; rb < 4; ++rb) vn[rb] = (f32x4){0.f, 0.f, 0.f, 0.f};
#pragma unroll
        for (int s = 0; s < 4; ++s)
#pragma unroll
            for (int rb = 0; rb < 4; ++rb) vn[rb] = __builtin_amdgcn_mfma_f32_16x16x32_bf16(aw[rb * 4 + s], sf[s], vn[rb], 0, 0, 0);
#pragma unroll
        for (int rb = 0; rb < 4; ++rb) { const f32x4 acc = vn[rb];
            vn[rb][0] = bflo(uu[rb].x) - acc[0]; vn[rb][1] = bfhi(uu[rb].x) - acc[1]; vn[rb][2] = bflo(uu[rb].y) - acc[2]; vn[rb][3] = bfhi(uu[rb].y) - acc[3]; }
        bf16_t* vnt = B.VNT + (size_t)ti * SZ_VNT + (size_t)(16 * wid + vl) * 64 + 4 * q;
        bf16x8 vf[2];
#pragma unroll
        for (int s = 0; s < 2; ++s) { u32x4 w4; w4.x = pk2(vn[2 * s][0], vn[2 * s][1]); w4.y = pk2(vn[2 * s][2], vn[2 * s][3]); w4.z = pk2(vn[2 * s + 1][0], vn[2 * s + 1][1]); w4.w = pk2(vn[2 * s + 1][2], vn[2 * s + 1][3]);
            vf[s] = __builtin_bit_cast(bf16x8, w4);
            *(u32x2*)(vnt + 32 * s) = (u32x2){w4.x, w4.y}; *(u32x2*)(vnt + 32 * s + 16) = (u32x2){w4.z, w4.w}; }
#pragma unroll
        for (int kb = 0; kb < 8; ++kb) S[kb] = S[kb] * gt;
#pragma unroll
        for (int s = 0; s < 2; ++s)
#pragma unroll
            for (int kb = 0; kb < 8; ++kb) S[kb] = __builtin_amdgcn_mfma_f32_16x16x32_bf16(ak[kb * 2 + s], vf[s], S[kb], 0, 0, 0);
        __builtin_amdgcn_sched_barrier(0);
        G2_WRITE(buf ^ 1);
#pragma unroll
        for (int rb = 0; rb < 4; ++rb) uu[rb] = un[rb];
        gt = gtn;
        asm volatile("s_waitcnt lgkmcnt(0)\n\ts_barrier" ::: "memory");
    }
    asm volatile("s_waitcnt vmcnt(0)" ::: "memory");
    __syncthreads();
#undef G2_UADDR
#undef G2_LOAD
#undef G2_WRITE
}

constexpr int G3_LDS = 8 * 64 * 4 * 2;
struct G3Args { Bufs B; const bf16_t* P; const float* norm_g; bf16_t* Y; };
__device__ __forceinline__ void g3_task(const G3Args& A, char* lds, int cix, int h, const int tid_in) {
    int tid_ = tid_in; asm volatile("" : "+v"(tid_));
    const int tid = tid_, wid = __builtin_amdgcn_readfirstlane(tid >> 6), lane = tid & 63, q = lane >> 4, vl = lane & 15;
    float* part = (float*)lds;
    f32x4 o[2][4];
#pragma unroll
    for (int d = 0; d < 2; ++d) {
        const size_t t = ((size_t)cix * NH + h) * 2 + d;
        const bf16_t* sit = A.B.SIT + t * SZ_SIT + (size_t)(16 * wid + vl) * 128 + 8 * q;
        const bf16_t* vnt = A.B.VNT + t * SZ_VNT + (size_t)(16 * wid + vl) * 64 + 8 * q;
        const bf16_t* qd = A.B.QD + t * SZ_QD + (size_t)vl * 128 + 8 * q;
        const bf16_t* qk = A.B.QK + t * SZ_QK + (size_t)vl * 64 + 8 * q;
        bf16x8 sf[4], vf[2];
#pragma unroll
        for (int s = 0; s < 4; ++s) sf[s] = *(const bf16x8*)(sit + 32 * s);
#pragma unroll
        for (int s = 0; s < 2; ++s) vf[s] = *(const bf16x8*)(vnt + 32 * s);
#pragma unroll
        for (int rb = 0; rb < 4; ++rb) { f32x4 acc = {0.f, 0.f, 0.f, 0.f};
#pragma unroll
            for (int s = 0; s < 4; ++s) acc = __builtin_amdgcn_mfma_f32_16x16x32_bf16(*(const bf16x8*)(qd + (size_t)rb * 16 * 128 + 32 * s), sf[s], acc, 0, 0, 0);
#pragma unroll
            for (int s = 0; s < 2; ++s) acc = __builtin_amdgcn_mfma_f32_16x16x32_bf16(*(const bf16x8*)(qk + (size_t)rb * 16 * 64 + 32 * s), vf[s], acc, 0, 0, 0);
            o[d][rb] = acc; }
    }
    f32x4 ot[4];
#pragma unroll
    for (int rb = 0; rb < 4; ++rb)
#pragma unroll
        for (int r = 0; r < 4; ++r) ot[rb][r] = o[0][rb][r] + lane_xor(o[1][3 - rb][3 - r], 48, lane);
    __syncthreads();
#pragma unroll
    for (int rb = 0; rb < 4; ++rb)
#pragma unroll
        for (int r = 0; r < 4; ++r) { float ss = ot[rb][r] * ot[rb][r];
#pragma unroll
            for (int of = 1; of < 16; of <<= 1) ss += lane_xor(ss, of, lane);
            if (vl == 0) part[wid * 64 + 16 * rb + 4 * q + r] = ss; }
    __syncthreads();
    const int v = 16 * wid + vl; const float ng = A.norm_g[v];
#pragma unroll
    for (int rb = 0; rb < 4; ++rb)
#pragma unroll
        for (int r = 0; r < 4; ++r) { const int tok = 16 * rb + 4 * q + r; float ss = 0.f;
#pragma unroll
            for (int w8 = 0; w8 < 8; ++w8) ss += part[w8 * 64 + tok];
            const float rstd = 1.0f / sqrtf(ss * (1.0f / HD) + EPS);
            const size_t row = (size_t)cix * CH + tok; const float gate = bf2f(A.P[row * NP + C_GG + h * HD + v]);
            A.Y[row * D_MODEL + 2 * GROUP_W + h * HD + v] = f2bf(ot[rb][r] * rstd * ng * (gate / (1.0f + __expf(-gate)))); }
}
__device__ __forceinline__ void g3_phase(const G3Args& A, char* lds, int G, int wg, const int tid) {
    for (int t = wg; t < NCHUNK * NH; t += G) g3_task(A, lds, t / NH, t % NH, tid);
}
}

namespace lru {
typedef short bf16x8 __attribute__((ext_vector_type(8)));
typedef float f32x4 __attribute__((ext_vector_type(4)));
typedef unsigned u32x2 __attribute__((ext_vector_type(2)));
typedef unsigned u32x4 __attribute__((ext_vector_type(4)));
constexpr int CH = 64, NCHUNK = M_ALL / CH;
constexpr int US = 129;
constexpr int UBS = 272;
constexpr int L_OFF_U = 0, L_OFF_UB = CH * US * 4, L_LDS = L_OFF_UB + CH * UBS;
constexpr size_t SZ_WBLK = (size_t)LRU_BW * LRU_BW;
struct Bufs { bf16_t* HLOC; bf16_t* ACUM; float* LSUM; float* HIN; };
struct LocalArgs { const bf16_t* P; const float* conv_w; const float* conv_b; const bf16_t* WG;   const float* ba; const float* bx; const float* lam; Bufs B; };

__device__ __forceinline__ unsigned pk2(float lo, float hi) { return (unsigned)f2bf(lo) | ((unsigned)f2bf(hi) << 16); }

__device__ __forceinline__ void local_task(const LocalArgs& A, char* lds, int cix, int nb, const int tid_in) {
    int tid_ = tid_in; asm volatile("" : "+v"(tid_));
    const int tid = tid_, wid = __builtin_amdgcn_readfirstlane(tid >> 6), lane = tid & 63, q = lane >> 4, tl = lane & 15;
    float* Us = (float*)(lds + L_OFF_U); char* Ub = lds + L_OFF_UB;
    const int row0 = cix * CH; const RowInfo r0i = row_info(row0);
    __syncthreads();
    {
        const int grp = tid & 15, t2 = tid >> 4, c0 = grp * 8, ch0 = nb * LRU_BW + c0;
        float wgt[4][8], bia[8];
#pragma unroll
        for (int j = 0; j < 4; ++j) { const f32x4 w0 = *(const f32x4*)(A.conv_w + j * LRU_W + ch0), w1 = *(const f32x4*)(A.conv_w + j * LRU_W + ch0 + 4);
#pragma unroll
            for (int e = 0; e < 4; ++e) { wgt[j][e] = w0[e]; wgt[j][4 + e] = w1[e]; } }
        { const f32x4 b0 = *(const f32x4*)(A.conv_b + ch0), b1 = *(const f32x4*)(A.conv_b + ch0 + 4);
#pragma unroll
          for (int e = 0; e < 4; ++e) { bia[e] = b0[e]; bia[4 + e] = b1[e]; } }
        u32x4 xr[5];
#pragma unroll
        for (int k = 0; k < 5; ++k) { const int tt = r0i.t + 2 * t2 + k - 1;
            xr[k] = (tt >= 0 && tt < r0i.T) ? *(const u32x4*)(A.P + (size_t)(r0i.base + tt) * NP + C_LRU_X + ch0) : (u32x4){0u, 0u, 0u, 0u}; }
#pragma unroll
        for (int i = 0; i < 2; ++i) { float acc[8];
#pragma unroll
            for (int e = 0; e < 8; ++e) acc[e] = bia[e];
#pragma unroll
            for (int j = 0; j < 4; ++j) { const u32x4 xv = xr[i + j];
#pragma unroll
                for (int e = 0; e < 4; ++e) { acc[2 * e] += wgt[j][2 * e] * bflo(xv[e]); acc[2 * e + 1] += wgt[j][2 * e + 1] * bfhi(xv[e]); } }
            const int tok = 2 * t2 + i;
#pragma unroll
            for (int e = 0; e < 8; ++e) Us[tok * US + c0 + e] = acc[e];
            *(u32x4*)(Ub + tok * UBS + c0 * 2) = (u32x4){pk2(acc[0], acc[1]), pk2(acc[2], acc[3]), pk2(acc[4], acc[5]), pk2(acc[6], acc[7])}; }
    }
    __syncthreads();
    f32x4 acc[2][2][4];
#pragma unroll
    for (int d = 0; d < 2; ++d)
#pragma unroll
        for (int wh = 0; wh < 2; ++wh)
#pragma unroll
            for (int tb = 0; tb < 4; ++tb) acc[d][wh][tb] = (f32x4){0.f, 0.f, 0.f, 0.f};
#pragma unroll
    for (int s = 0; s < 4; ++s) {
        bf16x8 bfr[4];
#pragma unroll
        for (int tb = 0; tb < 4; ++tb) bfr[tb] = *(const bf16x8*)(Ub + (16 * tb + tl) * UBS + (32 * s + 8 * q) * 2);
#pragma unroll
        for (int d = 0; d < 2; ++d)
#pragma unroll
            for (int wh = 0; wh < 2; ++wh) { const bf16x8 a = *(const bf16x8*)(A.WG + ((size_t)((d * 2 + wh) * NH + nb)) * SZ_WBLK + (size_t)(16 * wid + tl) * LRU_BW + 32 * s + 8 * q);
#pragma unroll
                for (int tb = 0; tb < 4; ++tb) acc[d][wh][tb] = __builtin_amdgcn_mfma_f32_16x16x32_bf16(a, bfr[tb], acc[d][wh][tb], 0, 0, 0); }
    }
    const int chb = nb * LRU_BW + 16 * wid + 4 * q;
#pragma unroll
    for (int d = 0; d < 2; ++d) {
        float sp[4], bav[4], bxv[4];
#pragma unroll
        for (int r = 0; r < 4; ++r) { sp[r] = -LRU_C * softplusf_(-A.lam[d * LRU_W + chb + r]); bav[r] = A.ba[d * LRU_W + chb + r]; bxv[r] = A.bx[d * LRU_W + chb + r]; }
        float Ac[4], Bc[4];
#pragma unroll
        for (int r = 0; r < 4; ++r) { Ac[r] = 1.f; Bc[r] = 0.f; }
#pragma unroll
        for (int tbi = 0; tbi < 4; ++tbi) { const int tb = d == 0 ? tbi : 3 - tbi; const int tok = 16 * tb + tl;
            float a[4], b[4];
#pragma unroll
            for (int r = 0; r < 4; ++r) { const float rr = 1.0f / (1.0f + __expf(-(acc[d][0][tb][r] + bav[r]))), ii = 1.0f / (1.0f + __expf(-(acc[d][1][tb][r] + bxv[r])));
                const float log_a = sp[r] * rr; a[r] = __expf(log_a); b[r] = sqrtf(-expm1f(2.0f * log_a)) * ii * Us[tok * US + 16 * wid + 4 * q + r]; }
#pragma unroll
            for (int off = 1; off < 16; off <<= 1) {
#pragma unroll
                for (int r = 0; r < 4; ++r) { const int src = d == 0 ? tl - off : tl + off; const bool ok = d == 0 ? (tl >= off) : (tl + off < 16);
                    const int sl = (lane & ~15) | (src & 15); const float ap = lane_get(a[r], sl), bp = lane_get(b[r], sl);
                    if (ok) { b[r] = a[r] * bp + b[r]; a[r] = a[r] * ap; } } }
#pragma unroll
            for (int r = 0; r < 4; ++r) { b[r] = a[r] * Bc[r] + b[r]; a[r] = a[r] * Ac[r]; }
            { const size_t o = ((size_t)d * M_ALL + row0 + tok) * LRU_W + chb;
              *(u32x2*)(A.B.HLOC + o) = (u32x2){pk2(b[0], b[1]), pk2(b[2], b[3])}; *(u32x2*)(A.B.ACUM + o) = (u32x2){pk2(a[0], a[1]), pk2(a[2], a[3])}; }
#pragma unroll
            for (int r = 0; r < 4; ++r) { const int sl = (lane & ~15) | (d == 0 ? 15 : 0); Ac[r] = lane_get(a[r], sl); Bc[r] = lane_get(b[r], sl); }
        }
        if (tl == 0) { float* ls = A.B.LSUM + (((size_t)cix * 2 + d) * 2) * LRU_W + chb;
            *(f32x4*)ls = (f32x4){Ac[0], Ac[1], Ac[2], Ac[3]}; *(f32x4*)(ls + LRU_W) = (f32x4){Bc[0], Bc[1], Bc[2], Bc[3]}; }
    }
}
__device__ __forceinline__ void local_phase(const LocalArgs& A, char* lds, int G, int wg, const int tid) {
    for (int t = wg; t < NCHUNK * NH; t += G) local_task(A, lds, t / NH, t % NH, tid);
}
__device__ __forceinline__ void carry_phase(const Bufs& B, int gtid, int gthreads) {
    constexpr int NC = CTX_LEN / CH, NL = SEQ / CH;
    for (int i = gtid; i < BATCH * 2 * LRU_W; i += gthreads) { const int ch = i % LRU_W, d = (i / LRU_W) & 1, b = i / (2 * LRU_W);
        float h = 0.f;
        for (int s0 = 0; s0 < NC + NL; s0 += 12) {
            float av[12], bv[12]; int cx[12];
#pragma unroll
            for (int u = 0; u < 12; ++u) { const int step = s0 + u; int cix = 0;
                if (step < NC) { const int n = d ? NC - 1 - step : step; cix = M_LAT / CH + b * NC + n; }
                else if (step < NC + NL) { const int s2 = step - NC, n = d ? NL - 1 - s2 : s2; cix = b * NL + n; }
                cx[u] = cix; const float* ls = B.LSUM + (((size_t)cix * 2 + d) * 2) * LRU_W + ch; av[u] = ls[0]; bv[u] = ls[LRU_W]; }
#pragma unroll
            for (int u = 0; u < 12; ++u) if (s0 + u < NC + NL) { B.HIN[((size_t)cx[u] * 2 + d) * LRU_W + ch] = h; h = av[u] * h + bv[u]; }
        }
    }
}
__device__ __forceinline__ void finish_phase(const Bufs& B, const bf16_t* P, bf16_t* Y, int gtid, int gthreads) {
    for (int it = gtid; it < M_ALL * (LRU_W / 8); it += gthreads) { const int row = it / (LRU_W / 8), c0 = (it % (LRU_W / 8)) * 8, cix = row / CH;
        const u32x4 h0 = *(const u32x4*)(B.HLOC + (size_t)row * LRU_W + c0), a0 = *(const u32x4*)(B.ACUM + (size_t)row * LRU_W + c0);
        const u32x4 h1 = *(const u32x4*)(B.HLOC + ((size_t)M_ALL + row) * LRU_W + c0), a1 = *(const u32x4*)(B.ACUM + ((size_t)M_ALL + row) * LRU_W + c0);
        const u32x4 gt = *(const u32x4*)(P + (size_t)row * NP + C_LRU_G + c0);
        const float* i0 = B.HIN + ((size_t)cix * 2 + 0) * LRU_W + c0; const float* i1 = B.HIN + ((size_t)cix * 2 + 1) * LRU_W + c0;
        const f32x4 i0a = *(const f32x4*)i0, i0b = *(const f32x4*)(i0 + 4), i1a = *(const f32x4*)i1, i1b = *(const f32x4*)(i1 + 4);
        float y[8];
#pragma unroll
        for (int j = 0; j < 4; ++j) { const unsigned hw0 = h0[j], aw0 = a0[j], hw1 = h1[j], aw1 = a1[j], gw = gt[j];
            const float in0l = j < 2 ? i0a[2 * j] : i0b[2 * j - 4], in0h = j < 2 ? i0a[2 * j + 1] : i0b[2 * j - 3], in1l = j < 2 ? i1a[2 * j] : i1b[2 * j - 4], in1h = j < 2 ? i1a[2 * j + 1] : i1b[2 * j - 3];
            y[2 * j] = (bflo(hw0) + bflo(aw0) * in0l + bflo(hw1) + bflo(aw1) * in1l) * geluf_(bflo(gw));
            y[2 * j + 1] = (bfhi(hw0) + bfhi(aw0) * in0h + bfhi(hw1) + bfhi(aw1) * in1h) * geluf_(bfhi(gw)); }
        *(u32x4*)(Y + (size_t)row * D_MODEL + c0) = (u32x4){pk2(y[0], y[1]), pk2(y[2], y[3]), pk2(y[4], y[5]), pk2(y[6], y[7])};
    }
}
}

namespace misc {
typedef float f32x4 __attribute__((ext_vector_type(4)));
typedef unsigned u32x2 __attribute__((ext_vector_type(2)));
typedef unsigned u32x4 __attribute__((ext_vector_type(4)));
__device__ __forceinline__ unsigned pk2(float lo, float hi) { return (unsigned)f2bf(lo) | ((unsigned)f2bf(hi) << 16); }
__device__ __forceinline__ float wave_sum(float v, int lane) {
#pragma unroll
    for (int o = 1; o < 64; o <<= 1) v += lane_xor(v, o, lane);
    return v;
}
__device__ __forceinline__ float sum16(float v, int lane) {
#pragma unroll
    for (int o = 1; o < 16; o <<= 1) v += lane_xor(v, o, lane);
    return v;
}
__device__ __forceinline__ void norm_phase(const float* H, const float* g, const float* MODl, int sh_idx, bf16_t* U, int nrows, int gwave, int nwaves, int lane) {
    static_assert(D_MODEL == 2048, "norm_phase geometry");
    for (int r = gwave; r < nrows; r += nwaves) {
        const int set = r < M_LAT ? r / SEQ : BATCH;
        const f32x4* hr = (const f32x4*)(H + (size_t)r * D_MODEL) + lane;
        f32x4 v[8]; float ss = 0.f;
#pragma unroll
        for (int j = 0; j < 8; ++j) { v[j] = hr[64 * j]; ss += (v[j][0] * v[j][0] + v[j][1] * v[j][1]) + (v[j][2] * v[j][2] + v[j][3] * v[j][3]); }
        const float rstd = 1.0f / sqrtf(wave_sum(ss, lane) * (1.0f / D_MODEL) + EPS);
        const f32x4* gp = (const f32x4*)g + lane; const f32x4* shp = (const f32x4*)(MODl + (size_t)set * NMODV + (size_t)sh_idx * D_MODEL) + lane; const f32x4* scp = shp + D_MODEL / 4;
        u32x2* o = (u32x2*)(U + (size_t)r * D_MODEL) + lane;
#pragma unroll
        for (int j = 0; j < 8; ++j) { const f32x4 gg = gp[64 * j], sh = shp[64 * j], sc = scp[64 * j]; f32x4 y;
#pragma unroll
            for (int e = 0; e < 4; ++e) y[e] = v[j][e] * rstd * gg[e] * (1.0f + sc[e]) + sh[e];
            o[64 * j] = (u32x2){pk2(y[0], y[1]), pk2(y[2], y[3])}; }
    }
}
struct RowNormArgs { const bf16_t* P; const float *qa_g, *kva_g, *na_qn_g, *na_kn_g; bf16_t *CQN, *CKVN, *NQ, *NK; };
__device__ __forceinline__ void rownorm_phase(const RowNormArgs& A, int gwave, int nwaves, int lane) {
    static_assert(MLA_Q_LORA == 384 && MLA_KV_LORA == 256 && GROUP_W == 512 && HD == 128, "rownorm geometry");
    for (int r = gwave; r < M_ALL; r += nwaves) { const bf16_t* p = A.P + (size_t)r * NP;
        { float x[6], ss = 0.f;
#pragma unroll
          for (int j = 0; j < 3; ++j) { const unsigned w = *(const unsigned*)(p + C_CQ + 2 * lane + 128 * j); x[2 * j] = bflo(w); x[2 * j + 1] = bfhi(w); ss += x[2 * j] * x[2 * j] + x[2 * j + 1] * x[2 * j + 1]; }
          const float rstd = 1.0f / sqrtf(wave_sum(ss, lane) * (1.0f / MLA_Q_LORA) + EPS);
#pragma unroll
          for (int j = 0; j < 3; ++j) { const int c = 2 * lane + 128 * j; *(unsigned*)(A.CQN + (size_t)r * MLA_Q_LORA + c) = pk2(x[2 * j] * rstd * A.qa_g[c], x[2 * j + 1] * rstd * A.qa_g[c + 1]); } }
        { float x[4], ss = 0.f;
#pragma unroll
          for (int j = 0; j < 2; ++j) { const unsigned w = *(const unsigned*)(p + C_CKV + 2 * lane + 128 * j); x[2 * j] = bflo(w); x[2 * j + 1] = bfhi(w); ss += x[2 * j] * x[2 * j] + x[2 * j + 1] * x[2 * j + 1]; }
          const float rstd = 1.0f / sqrtf(wave_sum(ss, lane) * (1.0f / MLA_KV_LORA) + EPS);
#pragma unroll
          for (int j = 0; j < 2; ++j) { const int c = 2 * lane + 128 * j; *(unsigned*)(A.CKVN + (size_t)r * MLA_KV_LORA + c) = pk2(x[2 * j] * rstd * A.kva_g[c], x[2 * j + 1] * rstd * A.kva_g[c + 1]); } }
#pragma unroll
        for (int which = 0; which < 2; ++which) {
            const int hh = lane >> 4, d0 = (lane & 15) * 8; const u32x4 w = *(const u32x4*)(p + (which == 0 ? C_NQ : C_NK) + hh * HD + d0);
            float x[8]; float ss = 0.f;
#pragma unroll
            for (int j = 0; j < 4; ++j) { x[2 * j] = bflo(w[j]); x[2 * j + 1] = bfhi(w[j]); ss += x[2 * j] * x[2 * j] + x[2 * j + 1] * x[2 * j + 1]; }
            const float rstd = 1.0f / sqrtf(sum16(ss, lane) * (1.0f / HD) + EPS); const float* g = (which == 0 ? A.na_qn_g : A.na_kn_g) + d0;
            *(u32x4*)((which == 0 ? A.NQ : A.NK) + (size_t)r * GROUP_W + hh * HD + d0) =
                (u32x4){pk2(x[0] * rstd * g[0], x[1] * rstd * g[1]), pk2(x[2] * rstd * g[2], x[3] * rstd * g[3]), pk2(x[4] * rstd * g[4], x[5] * rstd * g[5]), pk2(x[6] * rstd * g[6], x[7] * rstd * g[7])};
        }
    }
}
struct MlaQkvArgs { const float* QR; const float* KVR; const bf16_t* P; const float *qn_g, *kn_g; bf16_t *QM, *KM, *VM; };
__device__ __forceinline__ void mlaqkv_phase(const MlaQkvArgs& A, int gwave, int nwaves, int lane) {
    static_assert(MLA_QK == 192 && MLA_NOPE == 128 && MLA_ROPE == 64 && NH == 4, "mla qkv geometry");
    const int hh = lane >> 4, g = lane & 15;
    const float inv = powf(10000.0f, -(float)g / 16.0f);
    for (int r = gwave; r < M_ALL; r += nwaves) {
        const bool lat = r < M_LAT; const int t = lat ? r % SEQ : 0;
        float cr = 1.f, sr = 0.f, cc = 1.f, sc = 0.f;
        if (lat) { sincosf((float)(t / GRID_W) * inv, &sr, &cr); sincosf((float)(t % GRID_W) * inv, &sc, &cc); }
#pragma unroll
        for (int which = 0; which < 2; ++which) {
            float x[12]; float ss = 0.f;
            if (which == 0) { const float* src = A.QR + (size_t)r * NQ_MLA + hh * MLA_QK + g;
#pragma unroll
                for (int i = 0; i < 12; ++i) x[i] = src[16 * i]; }
            else { const float* src = A.KVR + (size_t)r * NKV_MLA + hh * (MLA_NOPE + MLA_V) + g; const bf16_t* kr = A.P + (size_t)r * NP + C_KR + g;
#pragma unroll
                for (int i = 0; i < 8; ++i) x[i] = src[16 * i];
#pragma unroll
                for (int i = 0; i < 4; ++i) x[8 + i] = bf2f(kr[16 * i]); }
#pragma unroll
            for (int i = 0; i < 12; ++i) ss += x[i] * x[i];
            const float rstd = 1.0f / sqrtf(sum16(ss, lane) * (1.0f / MLA_QK) + EPS); const float* gn = (which == 0 ? A.qn_g : A.kn_g) + g;
#pragma unroll
            for (int i = 0; i < 12; ++i) x[i] = x[i] * rstd * gn[16 * i];
            { const float a0 = x[8], b0 = x[10]; x[8] = a0 * cr - b0 * sr; x[10] = a0 * sr + b0 * cr;
              const float a1 = x[9], b1 = x[11]; x[9] = a1 * cc - b1 * sc; x[11] = a1 * sc + b1 * cc; }
            bf16_t* O = (which == 0 ? A.QM : A.KM) + (size_t)r * NQ_MLA + hh * MLA_QK + g;
#pragma unroll
            for (int i = 0; i < 12; ++i) O[16 * i] = f2bf(x[i]);
        }
        { const float* vs = A.KVR + (size_t)r * NKV_MLA + hh * (MLA_NOPE + MLA_V) + MLA_NOPE + g; bf16_t* O = A.VM + (size_t)r * (NH * MLA_V) + hh * MLA_V + g;
#pragma unroll
          for (int i = 0; i < 8; ++i) O[16 * i] = f2bf(vs[16 * i]); }
    }
}
constexpr int ACT_RUN = 32;
__device__ __forceinline__ void act_phase(const bf16_t* UP, const float* cw, const float* cb, bf16_t* ACT, int nrows, int gtid, int gthreads) {
    constexpr int NC8 = D_FF / 8; static_assert(SEQ % ACT_RUN == 0 && CTX_LEN % ACT_RUN == 0, "row runs stay inside one sequence");
    const int nruns = nrows / ACT_RUN;
    for (long it = gtid; it < (long)nruns * NC8; it += gthreads) { const int run = (int)(it / NC8), j0 = (int)(it % NC8) * 8, r0 = run * ACT_RUN; const RowInfo ri = row_info(r0);
        float wa[3][8], wg[3][8], ba[8], bg[8];
#pragma unroll
        for (int k = 0; k < 3; ++k) { const float* p = cw + (size_t)k * 2 * D_FF + j0; const f32x4 a0 = *(const f32x4*)p, a1 = *(const f32x4*)(p + 4), g0 = *(const f32x4*)(p + D_FF), g1 = *(const f32x4*)(p + D_FF + 4);
#pragma unroll
            for (int e = 0; e < 4; ++e) { wa[k][e] = a0[e]; wa[k][4 + e] = a1[e]; wg[k][e] = g0[e]; wg[k][4 + e] = g1[e]; } }
        { const f32x4 a0 = *(const f32x4*)(cb + j0), a1 = *(const f32x4*)(cb + j0 + 4), g0 = *(const f32x4*)(cb + D_FF + j0), g1 = *(const f32x4*)(cb + D_FF + j0 + 4);
#pragma unroll
          for (int e = 0; e < 4; ++e) { ba[e] = a0[e]; ba[4 + e] = a1[e]; bg[e] = g0[e]; bg[4 + e] = g1[e]; } }
        const u32x4 zero = {0u, 0u, 0u, 0u};
        const bf16_t* ub = UP + (size_t)ri.base * (2 * D_FF) + j0;
        u32x4 am, ac, gm, gc;
        { const int t = ri.t; am = t > 0 ? *(const u32x4*)(ub + (size_t)(t - 1) * (2 * D_FF)) : zero; gm = t > 0 ? *(const u32x4*)(ub + (size_t)(t - 1) * (2 * D_FF) + D_FF) : zero;
          ac = *(const u32x4*)(ub + (size_t)t * (2 * D_FF)); gc = *(const u32x4*)(ub + (size_t)t * (2 * D_FF) + D_FF); }
#pragma unroll 4
        for (int i = 0; i < ACT_RUN; ++i) { const int t = ri.t + i;
            const u32x4 ap = t + 1 < ri.T ? *(const u32x4*)(ub + (size_t)(t + 1) * (2 * D_FF)) : zero, gp = t + 1 < ri.T ? *(const u32x4*)(ub + (size_t)(t + 1) * (2 * D_FF) + D_FF) : zero;
            float y[8];
#pragma unroll
            for (int e = 0; e < 4; ++e) {
                const float a0 = ba[2 * e] + wa[0][2 * e] * bflo(am[e]) + wa[1][2 * e] * bflo(ac[e]) + wa[2][2 * e] * bflo(ap[e]);
                const float a1 = ba[2 * e + 1] + wa[0][2 * e + 1] * bfhi(am[e]) + wa[1][2 * e + 1] * bfhi(ac[e]) + wa[2][2 * e + 1] * bfhi(ap[e]);
                const float g0 = bg[2 * e] + wg[0][2 * e] * bflo(gm[e]) + wg[1][2 * e] * bflo(gc[e]) + wg[2][2 * e] * bflo(gp[e]);
                const float g1 = bg[2 * e + 1] + wg[0][2 * e + 1] * bfhi(gm[e]) + wg[1][2 * e + 1] * bfhi(gc[e]) + wg[2][2 * e + 1] * bfhi(gp[e]);
                y[2 * e] = a0 * (g0 / (1.0f + __expf(-g0))); y[2 * e + 1] = a1 * (g1 / (1.0f + __expf(-g1))); }
            *(u32x4*)(ACT + (size_t)(r0 + i) * D_FF + j0) = (u32x4){pk2(y[0], y[1]), pk2(y[2], y[3]), pk2(y[4], y[5]), pk2(y[6], y[7])};
            am = ac; ac = ap; gm = gc; gc = gp; }
    }
}
__device__ __forceinline__ void transpose_item(const float* W, int K, int N, int Npad, bf16_t* WT, float* scr, int item, int lane) {
    const int nblk = Npad / 32, kb = item / nblk, nb = item % nblk, k0 = 64 * kb, n0 = 32 * nb; const int n = n0 + (lane & 31); const bool ok = n < N;
#pragma unroll 8
    for (int i = 0; i < 32; ++i) { const int kk = 2 * i + (lane >> 5); scr[kk * 33 + (lane & 31)] = ok ? W[(size_t)(k0 + kk) * N + n] : 0.f; }
    asm volatile("s_waitcnt lgkmcnt(0)" ::: "memory");
    const int c = lane & 7;
#pragma unroll
    for (int j = 0; j < 4; ++j) { const int nn = (lane >> 3) + 8 * j; const float* s = scr + (8 * c) * 33 + nn;
        u32x4 o; o.x = pk2(s[0 * 33], s[1 * 33]); o.y = pk2(s[2 * 33], s[3 * 33]); o.z = pk2(s[4 * 33], s[5 * 33]); o.w = pk2(s[6 * 33], s[7 * 33]);
        *(u32x4*)(WT + (size_t)(n0 + nn) * K + k0 + 8 * c) = o; }
    asm volatile("s_waitcnt lgkmcnt(0)" ::: "memory");
}
}

__device__ __forceinline__ gdn::Bufs gdn_bufs(const WS& w) { gdn::Bufs B; B.UT = w.gUT; B.WP = w.gWP; B.KDT = w.gKDT; B.QD = w.gQD; B.QK = w.gQK; B.SIT = w.gSIT; B.VNT = w.gVNT; B.GT = w.gGT; return B; }
__device__ __forceinline__ lru::Bufs lru_bufs(const WS& w) { lru::Bufs B; B.HLOC = w.lHLOC; B.ACUM = w.lACUM; B.LSUM = w.lLSUM; B.HIN = w.lHIN; return B; }

#define LAS __attribute__((address_space(3)))
#define XB_TMO      128
#define XB_XCNT(j)  (256  + 64 * (j))
#define XB_XSUB(j)  (1280 + 64 * (j))
#define XB_XGEN(j)  (2304 + 64 * (j))
#define XB_TOP      3328
#define XB_TOPGEN   3392
#define XCD_BAR_WORDS 3456
#define XB_SPIN_CAP (1u << 18)
__device__ __forceinline__ unsigned xb_ld(unsigned* p)              { return __hip_atomic_load(p, __ATOMIC_RELAXED, __HIP_MEMORY_SCOPE_AGENT); }
__device__ __forceinline__ unsigned xb_add(unsigned* p, unsigned v) { return __hip_atomic_fetch_add(p, v, __ATOMIC_RELAXED, __HIP_MEMORY_SCOPE_AGENT); }
__device__ __forceinline__ unsigned xb_xcc_id() { return (unsigned)__builtin_amdgcn_s_getreg((3 << 11) | 20) & 0xFu; }
#define XB_SPIN(cond, bar) do { unsigned _sp = 0; while (cond) { __builtin_amdgcn_s_sleep(1); \
    if ((++_sp & 255u) == 0u) { if (xb_ld(&(bar)[XB_TMO])) break; if (_sp > XB_SPIN_CAP) { atomicAdd(&(bar)[XB_TMO], 1u); break; } } } } while (0)
struct XcdBarrier { unsigned* bar; unsigned x; volatile LAS unsigned* st; };
__device__ __forceinline__ XcdBarrier xcd_barrier_post(unsigned* bar, volatile LAS unsigned* st, const bool leader) {
    XcdBarrier b; b.bar = bar; b.x = xb_xcc_id(); b.st = st;
    if (leader) (void)xb_add(&bar[XB_XCNT(b.x)], 1u);
    return b;
}
__device__ __forceinline__ void xcd_barrier_complete(unsigned* bar, unsigned x, unsigned& nloc, unsigned& nx) {
    const unsigned G = gridDim.x * gridDim.y * gridDim.z;
    unsigned sum, cnt, mine, sp = 0u;
    for (;;) {
        sum = 0u; cnt = 0u; mine = 0u;
#pragma unroll
        for (unsigned j = 0; j < 16; ++j) { const unsigned c = xb_ld(&bar[XB_XCNT(j)]); sum += c; cnt += (c > 0u) ? 1u : 0u; mine = (j == x) ? c : mine; }
        if (sum == G) break;
        __builtin_amdgcn_s_sleep(1);
        if ((++sp & 255u) == 0u) { if (xb_ld(&bar[XB_TMO])) break; if (sp > XB_SPIN_CAP) { atomicAdd(&bar[XB_TMO], 1u); break; } }
    }
    nloc = mine > 0u ? mine : 1u; nx = cnt > 0u ? cnt : 1u;
}
__device__ __forceinline__ void xcd_barrier(const XcdBarrier& b, const bool leader) {
    asm volatile("s_waitcnt vmcnt(0)" ::: "memory");
    __syncthreads();
    if (leader) {
        unsigned* bar = b.bar;
        __builtin_amdgcn_s_waitcnt(0);
        unsigned nloc = b.st[0], nx = b.st[1];
        if (nloc == 0u) { xcd_barrier_complete(bar, b.x, nloc, nx); b.st[0] = nloc; b.st[1] = nx; }
        const unsigned old = xb_add(&bar[XB_XSUB(b.x)], 1u);
        const unsigned gen = old / nloc;
        if (old + 1u == (gen + 1u) * nloc) {
            __builtin_amdgcn_fence(__ATOMIC_RELEASE, "agent");
            asm volatile("s_waitcnt vmcnt(0)" ::: "memory");
            const unsigned og = xb_add(&bar[XB_TOP], 1u);
            const unsigned tg = og / nx;
            if (og + 1u == (tg + 1u) * nx) xb_add(&bar[XB_TOPGEN], 1u);
            else XB_SPIN(xb_ld(&bar[XB_TOPGEN]) == tg, bar);
            __builtin_amdgcn_fence(__ATOMIC_ACQUIRE, "agent");
            xb_add(&bar[XB_XGEN(b.x)], 1u);
            asm volatile("s_waitcnt vmcnt(0)" ::: "memory");
        } else {
            XB_SPIN(xb_ld(&bar[XB_XGEN(b.x)]) == gen, bar);
            __builtin_amdgcn_fence(__ATOMIC_ACQUIRE, "agent");
            asm volatile("s_waitcnt vmcnt(0)" ::: "memory");
        }
    }
    __syncthreads();
}

constexpr int NWAVES = 8, NTHR = 512;
constexpr int LDS_MISC = 143360, LDS_BYTES = 147456;
static_assert(sizeof(Inputs) == 34 * 8, "Inputs mirrors Params::in");
static_assert(gdn::G1_LDS <= LDS_MISC && pg8::STAGE_BYTES <= LDS_MISC && att::Cfg<MLA_QK>::LDS_BYTES <= LDS_MISC && gdn::G2_LDS <= LDS_MISC, "LDS map");
constexpr int CW_BAR = 4096;
constexpr int PH_PRO = 0, PH_PER_LAYER = 12, NPH = 1 + PH_PER_LAYER * DEPTH;
struct Params { const float* in[34]; float* out; unsigned char* ws; int ph_lo, ph_hi, li, pad; };

struct SpanOrder {
    int nN, lo, hi, G, g0;
    __device__ __forceinline__ void init(int N, int lo_, int hi_, int G_, int c) { nN = N / pg8::BM; lo = lo_; hi = hi_; G = G_; int i0 = 0; if (c < lo_) i0 = (lo_ - c + G_ - 1) / G_; g0 = c + i0 * G_; }
    __device__ __forceinline__ bool next(int i, pg8::Unit& u) const { const int g = g0 + i * G; if (g >= hi) return false; const int loc = g - lo; u.pm = loc / nN; u.pn = loc % nN; return true; }
    __device__ __forceinline__ void a_ready(const pg8::Unit&) const {}
    __device__ __forceinline__ void done(const pg8::Unit&) const {}
};

#define AS4 __attribute__((address_space(4)))
#define PHASE_WS const AS4 Params* pp = (const AS4 Params*)__builtin_amdgcn_kernarg_segment_ptr(); asm volatile("" : "+s"(pp)); const AS4 Inputs* I = (const AS4 Inputs*)pp; (void)I; unsigned char* wsb_ = pp->ws; const WS w = ws_carve(wsb_)
#define PHASE_IDS int tid = C_wave0 * 64 + (int)__builtin_amdgcn_mbcnt_hi(~0u, __builtin_amdgcn_mbcnt_lo(~0u, 0u)); asm volatile("" : "+v"(tid)); const int lane = tid & 63, wave = __builtin_amdgcn_readfirstlane(tid >> 6), gwave = wg * NWAVES + wave, gtid = wg * NTHR + tid; (void)lane; (void)gwave; (void)gtid
#ifndef DBG_MASK
#define DBG_MASK 0xFFFFFF
#endif
#define IN(k) (lo <= (k) && (k) < hi)
#define ON(j) (((DBG_MASK) >> (j)) & 1)
#define SEAM(k) do { if (IN(k) && IN((k) + 1)) xcd_barrier(bar, C_wave0 == 0 && __builtin_amdgcn_mbcnt_hi(~0u, __builtin_amdgcn_mbcnt_lo(~0u, 0u)) == 0u); } while (0)

struct LayerCtx { int lo, hi, G, wg, nwaves, gthreads, wave0; XcdBarrier bar; char* lds; unsigned char* lds_raw; };
template <int l> __device__ __forceinline__ void layer_body(const LayerCtx& C) {
    const int lo = C.lo, hi = C.hi, G = C.G, wg = C.wg, nwaves = C.nwaves, gthreads = C.gthreads, C_wave0 = C.wave0; const XcdBarrier& bar = C.bar; char* lds = C.lds; unsigned char* lds_raw = C.lds_raw;
    (void)G; (void)nwaves; (void)gthreads;
        const int pb = 1 + PH_PER_LAYER * l;
        const bool want_ctx = l < DEPTH - 1; const int Mo = want_ctx ? M_ALL : M_LAT;
        if (ON(0) && IN(pb + 0)) { PHASE_WS; PHASE_IDS; const float* MODl = w.MOD + (size_t)l * (BATCH + 1) * NMODV; (void)MODl; misc::norm_phase(w.H, I->norm_mix_g + (size_t)l * D_MODEL, MODl, 0, w.U, M_ALL, gwave, nwaves, lane); }
        SEAM(pb + 0);
        if (ON(1) && IN(pb + 1)) { PHASE_WS; PHASE_IDS; const float* MODl = w.MOD + (size_t)l * (BATCH + 1) * NMODV; (void)MODl; pg8::Gemm g{w.U, w.WIN + l * SZ_WIN, M_ALL, NP, D_MODEL}; pg8::StaticOrder S; S.init(M_ALL, NP, G, wg);
            pg8::EpiBf16<0> E{w.P, NP, nullptr, 0, 0, 1.0f};
            pg8::gemm_phase<pg8::EpiBf16<0>, pg8::StaticOrder, true, true>((PG8_LAS unsigned char*)lds_raw, g, S, E, tid); }
        SEAM(pb + 1);
        if (ON(2) && IN(pb + 2)) { PHASE_WS; PHASE_IDS; const float* MODl = w.MOD + (size_t)l * (BATCH + 1) * NMODV; (void)MODl;
            { gdn::G1Args A; A.P = w.P; A.conv_w = I->gdn_conv_w + (size_t)l * 4 * 3 * GROUP_W; A.a_log = I->gdn_a_log + (size_t)l * 2 * NH; A.dt_bias = I->gdn_dt_bias + (size_t)l * 2 * NH; A.B = gdn_bufs(w);
              gdn::g1_phase(A, lds, G, wg, tid); }
            { lru::LocalArgs A; A.P = w.P; A.conv_w = I->lru_conv_w + (size_t)l * 4 * LRU_W; A.conv_b = I->lru_conv_b + (size_t)l * LRU_W; A.WG = w.WLRU + (size_t)l * 16 * lru::SZ_WBLK;
              A.ba = I->lru_ba + (size_t)l * 2 * LRU_W; A.bx = I->lru_bx + (size_t)l * 2 * LRU_W; A.lam = I->lru_lam + (size_t)l * 2 * LRU_W; A.B = lru_bufs(w);
              lru::local_phase(A, lds, G, wg, tid); }
            { misc::RowNormArgs A; A.P = w.P; A.qa_g = I->mla_qa_g + (size_t)l * MLA_Q_LORA; A.kva_g = I->mla_kva_g + (size_t)l * MLA_KV_LORA; A.na_qn_g = I->na_qn_g + (size_t)l * HD; A.na_kn_g = I->na_kn_g + (size_t)l * HD;
              A.CQN = w.CQN; A.CKVN = w.CKVN; A.NQ = w.NQ; A.NK = w.NK; misc::rownorm_phase(A, gwave, nwaves, lane); }
        }
        SEAM(pb + 2);
        if (ON(3) && IN(pb + 3)) { PHASE_WS; PHASE_IDS; const float* MODl = w.MOD + (size_t)l * (BATCH + 1) * NMODV; (void)MODl;
            constexpr int UQ = (M_ALL / 256) * (NQ_MLA / 256), UKV = (M_ALL / 256) * (NKV_MLA / 256);
            { pg8::Gemm g{w.CQN, w.WUQ + l * SZ_WUQ, M_ALL, NQ_MLA, MLA_Q_LORA}; SpanOrder S; S.init(NQ_MLA, 0, UQ, G, wg); pg8::EpiF32 E{w.QR, NQ_MLA};
              pg8::gemm_phase<pg8::EpiF32, SpanOrder, true, true>((PG8_LAS unsigned char*)lds_raw, g, S, E, tid); }
            { pg8::Gemm g{w.CKVN, w.WUKV + l * SZ_WUKV, M_ALL, NKV_MLA, MLA_KV_LORA}; SpanOrder S; S.init(NKV_MLA, UQ, UQ + UKV, G, wg); pg8::EpiF32 E{w.KVR, NKV_MLA};
              pg8::gemm_phase<pg8::EpiF32, SpanOrder, true, true>((PG8_LAS unsigned char*)lds_raw, g, S, E, tid); }
        }
        SEAM(pb + 3);
        if (ON(4) && IN(pb + 4)) { PHASE_WS; PHASE_IDS; const float* MODl = w.MOD + (size_t)l * (BATCH + 1) * NMODV; (void)MODl;
            { misc::MlaQkvArgs A; A.QR = w.QR; A.KVR = w.KVR; A.P = w.P; A.qn_g = I->mla_qn_g + (size_t)l * MLA_QK; A.kn_g = I->mla_kn_g + (size_t)l * MLA_QK; A.QM = w.QM; A.KM = w.KM; A.VM = w.VM;
              misc::mlaqkv_phase(A, gwave, nwaves, lane); }
            lru::carry_phase(lru_bufs(w), gtid, gthreads);
        }
        SEAM(pb + 4);
        if (ON(5) && IN(pb + 5)) { PHASE_WS; PHASE_IDS; const float* MODl = w.MOD + (size_t)l * (BATCH + 1) * NMODV; (void)MODl;
            const int pflags = pp->pad;
            if (wg < BATCH * NH * 2 && !(pflags & 1)) gdn::g2_chain(gdn_bufs(w), lds, wg, tid);
            AttnArgs A; A.QM = w.QM; A.KM = w.KM; A.VM = w.VM; A.NQ = w.NQ; A.NK = w.NK; A.P = w.P; A.Y = w.Y; A.rpb = I->na_rpb + (size_t)l * NH * (2 * NA_KH - 1) * (2 * NA_KW - 1); A.want_ctx = want_ctx ? 1 : 0; A.pad = pflags;
            attention_phase(A, lds, G, wg, tid);
        }
        SEAM(pb + 5);
        if (ON(6) && IN(pb + 6)) { PHASE_WS; PHASE_IDS; const float* MODl = w.MOD + (size_t)l * (BATCH + 1) * NMODV; (void)MODl;
            { gdn::G3Args A; A.B = gdn_bufs(w); A.P = w.P; A.norm_g = I->gdn_norm_g + (size_t)l * HD; A.Y = w.Y; gdn::g3_phase(A, lds, G, wg, tid); }
            lru::finish_phase(lru_bufs(w), w.P, w.Y, gtid, gthreads);
        }
        SEAM(pb + 6);
        if (ON(7) && IN(pb + 7)) { PHASE_WS; PHASE_IDS; const float* MODl = w.MOD + (size_t)l * (BATCH + 1) * NMODV; (void)MODl; pg8::Gemm g{w.Y, w.WOUT + l * SZ_WOUT, Mo, D_MODEL, D_MODEL}; pg8::StaticOrder S; S.init(Mo, D_MODEL, G, wg);
            pg8::EpiGateRes E{w.H, w.H, D_MODEL, MODl + 2 * D_MODEL, NMODV, SEQ, BATCH, M_LAT};
            pg8::gemm_phase<pg8::EpiGateRes, pg8::StaticOrder, true, true>((PG8_LAS unsigned char*)lds_raw, g, S, E, tid); }
        SEAM(pb + 7);
        if (ON(8) && IN(pb + 8)) { PHASE_WS; PHASE_IDS; const float* MODl = w.MOD + (size_t)l * (BATCH + 1) * NMODV; (void)MODl; misc::norm_phase(w.H, I->norm_ffn_g + (size_t)l * D_MODEL, MODl, 3, w.U, Mo, gwave, nwaves, lane); }
        SEAM(pb + 8);
        if (ON(9) && IN(pb + 9)) { PHASE_WS; PHASE_IDS; const float* MODl = w.MOD + (size_t)l * (BATCH + 1) * NMODV; (void)MODl; pg8::Gemm g{w.U, w.WUP + l * SZ_WUP, Mo, 2 * D_FF, D_MODEL}; pg8::StaticOrder S; S.init(Mo, 2 * D_FF, G, wg);
            pg8::EpiBf16<0> E{w.UP, 2 * D_FF, nullptr, 0, 0, 1.0f};
            pg8::gemm_phase<pg8::EpiBf16<0>, pg8::StaticOrder, true, true>((PG8_LAS unsigned char*)lds_raw, g, S, E, tid); }
        SEAM(pb + 9);
        if (ON(10) && IN(pb + 10)) { PHASE_WS; PHASE_IDS; const float* MODl = w.MOD + (size_t)l * (BATCH + 1) * NMODV; (void)MODl; misc::act_phase(w.UP, I->ffn_conv_w + (size_t)l * 3 * 2 * D_FF, I->ffn_conv_b + (size_t)l * 2 * D_FF, w.ACT, Mo, gtid, gthreads); }
        SEAM(pb + 10);
        if (ON(11) && IN(pb + 11)) { PHASE_WS; PHASE_IDS; const float* MODl = w.MOD + (size_t)l * (BATCH + 1) * NMODV; (void)MODl; pg8::Gemm g{w.ACT, w.WDOWN + l * SZ_WDOWN, Mo, D_MODEL, D_FF}; pg8::StaticOrder S; S.init(Mo, D_MODEL, G, wg);
            pg8::EpiGateRes E{w.H, want_ctx ? w.H : pp->out, D_MODEL, MODl + 5 * D_MODEL, NMODV, SEQ, BATCH, M_LAT};
            pg8::gemm_phase<pg8::EpiGateRes, pg8::StaticOrder, true, true>((PG8_LAS unsigned char*)lds_raw, g, S, E, tid); }
        SEAM(pb + 11);

}
__global__ void __launch_bounds__(NTHR, 2) fwd(Params p) {
    extern __shared__ __attribute__((aligned(16))) unsigned char lds_raw[];
    char* lds = (char*)lds_raw;
    const int G = (int)gridDim.x, wg = (int)blockIdx.x, nwaves = G * NWAVES, gthreads = G * NTHR;
    const int C_wave0 = __builtin_amdgcn_readfirstlane((int)threadIdx.x >> 6);
    volatile LAS unsigned* MISC = (volatile LAS unsigned*)(lds_raw + LDS_MISC);
    if (threadIdx.x < 32) MISC[threadIdx.x] = 0u;
    __syncthreads();
    const int lo = p.ph_lo, hi = p.ph_hi;
    unsigned* const barw = (unsigned*)p.ws + CW_BAR + (size_t)p.li * XCD_BAR_WORDS;
    XcdBarrier bar; bar.bar = barw; bar.x = 0; bar.st = MISC + 8;
    if (hi - lo > 1) bar = xcd_barrier_post(barw, MISC + 8, threadIdx.x == 0);

    if (ON(12) && IN(PH_PRO)) { PHASE_WS; PHASE_IDS;
        {
            float* SCs = (float*)lds;
            float* red = (float*)(lds + 3 * D_MODEL * 4);
            constexpr int NT = DEPTH * NMODV / 256;
            if (wg < NT) {
                for (int i = tid; i < (BATCH + 1) * D_MODEL; i += NTHR) { const int s = i / D_MODEL, k = i % D_MODEL; const float v = s < BATCH ? I->c[s * D_MODEL + k] : I->c_ctx[k]; SCs[i] = v / (1.0f + __expf(-v)); }
                __syncthreads();
            }
            for (int t = wg; t < NT; t += G) { const int l = t / (NMODV / 256), j0 = (t % (NMODV / 256)) * 256;
                misc::f32x4 acc[3] = {{0.f, 0.f, 0.f, 0.f}, {0.f, 0.f, 0.f, 0.f}, {0.f, 0.f, 0.f, 0.f}};
                const float* wp = I->ada_w + (size_t)l * D_MODEL * NMODV + (size_t)(256 * wave) * NMODV + j0 + 4 * lane;
#pragma unroll 8
                for (int k = 0; k < 256; ++k) { const misc::f32x4 wv = *(const misc::f32x4*)(wp + (size_t)k * NMODV); const int kk = 256 * wave + k;
                    acc[0] += wv * SCs[kk]; acc[1] += wv * SCs[D_MODEL + kk]; acc[2] += wv * SCs[2 * D_MODEL + kk]; }
                __syncthreads();
#pragma unroll
                for (int s = 0; s < 3; ++s) *(misc::f32x4*)(red + (wave * 3 + s) * 256 + 4 * lane) = acc[s];
                __syncthreads();
                for (int i = tid; i < 3 * 256; i += NTHR) { const int s = i / 256, c = i % 256; float sum = I->ada_b[(size_t)l * NMODV + j0 + c];
#pragma unroll
                    for (int w8 = 0; w8 < 8; ++w8) sum += red[(w8 * 3 + s) * 256 + c];
                    w.MOD[((size_t)l * (BATCH + 1) + s) * NMODV + j0 + c] = sum; }
            }
            __syncthreads();
        }
        {
            float* scr = (float*)(lds + wave * 8448);
            constexpr int I_IN = (D_MODEL / 64) * (NP / 32), I_OUT = (D_MODEL / 64) * (D_MODEL / 32), I_UP = (D_MODEL / 64) * (2 * D_FF / 32), I_DN = (D_FF / 64) * (D_MODEL / 32),
                          I_UQ = (MLA_Q_LORA / 64) * (NQ_MLA / 32), I_UKV = (MLA_KV_LORA / 64) * (NKV_MLA / 32), I_LB = (LRU_BW / 64) * (LRU_BW / 32), I_LRU = 2 * 2 * NH * I_LB;
            constexpr int I_LAYER = I_IN + I_OUT + I_UP + I_DN + I_UQ + I_UKV + I_LRU;
            for (int it = gwave; it < DEPTH * I_LAYER; it += nwaves) { const int l = it / I_LAYER; int r = it % I_LAYER;
                if (r < I_IN) { misc::transpose_item(I->w_in + (size_t)l * D_MODEL * IN_COLS, D_MODEL, IN_COLS, NP, w.WIN + l * SZ_WIN, scr, r, lane); continue; } r -= I_IN;
                if (r < I_OUT) { misc::transpose_item(I->w_out + (size_t)l * D_MODEL * D_MODEL, D_MODEL, D_MODEL, D_MODEL, w.WOUT + l * SZ_WOUT, scr, r, lane); continue; } r -= I_OUT;
                if (r < I_UP) { misc::transpose_item(I->ffn_w_up + (size_t)l * D_MODEL * 2 * D_FF, D_MODEL, 2 * D_FF, 2 * D_FF, w.WUP + l * SZ_WUP, scr, r, lane); continue; } r -= I_UP;
                if (r < I_DN) { misc::transpose_item(I->ffn_w_down + (size_t)l * D_FF * D_MODEL, D_FF, D_MODEL, D_MODEL, w.WDOWN + l * SZ_WDOWN, scr, r, lane); continue; } r -= I_DN;
                if (r < I_UQ) { misc::transpose_item(I->mla_w_uq + (size_t)l * MLA_Q_LORA * NQ_MLA, MLA_Q_LORA, NQ_MLA, NQ_MLA, w.WUQ + l * SZ_WUQ, scr, r, lane); continue; } r -= I_UQ;
                if (r < I_UKV) { misc::transpose_item(I->mla_w_ukv + (size_t)l * MLA_KV_LORA * NKV_MLA, MLA_KV_LORA, NKV_MLA, NKV_MLA, w.WUKV + l * SZ_WUKV, scr, r, lane); continue; } r -= I_UKV;
                { const int blk = r / I_LB, item = r % I_LB, d = blk / (2 * NH), wh = (blk / NH) & 1, nb = blk % NH;
                  const float* src = (wh == 0 ? I->lru_wa : I->lru_wx) + ((size_t)(l * 2 + d) * NH + nb) * lru::SZ_WBLK;
                  misc::transpose_item(src, LRU_BW, LRU_BW, LRU_BW, w.WLRU + ((size_t)l * 16 + blk) * lru::SZ_WBLK, scr, item, lane); }
            }
        }
        for (long i = gtid; i < (long)M_ALL * D_MODEL / 4; i += gthreads) { const long e = i * 4;
            ((misc::f32x4*)w.H)[i] = e < (long)M_LAT * D_MODEL ? *(const misc::f32x4*)(I->x + e) : *(const misc::f32x4*)(I->ctx + (e - (long)M_LAT * D_MODEL)); }
    }
    SEAM(PH_PRO);

    { LayerCtx C; C.lo = lo; C.hi = hi; C.G = G; C.wg = wg; C.nwaves = nwaves; C.gthreads = gthreads; C.wave0 = C_wave0; C.bar = bar; C.lds = lds; C.lds_raw = lds_raw;
      static_assert(DEPTH == 4, "layer calls are written out (a real layer loop lets LICM park loop-invariant values in registers across every phase: spills)");
      layer_body<0>(C); layer_body<1>(C); layer_body<2>(C); layer_body<3>(C); }
#undef IN
#undef SEAM
}

#ifndef MK_PHASES_PER_LAUNCH
#define MK_PHASES_PER_LAUNCH NPH
#endif
extern "C" void kernel_launch(void* const* d_in, const int* in_sizes, int n_in, void* d_out, int out_size, void* d_ws, size_t ws_size, hipStream_t stream) {
    static int grid = 0;
    if (grid == 0) {
        int dev = 0, cus = 0;
        if (hipGetDevice(&dev) != hipSuccess || hipDeviceGetAttribute(&cus, hipDeviceAttributeMultiprocessorCount, dev) != hipSuccess || cus <= 0) { fprintf(stderr, "kernel_launch: no device\n"); grid = -1; return; }
        if (hipFuncSetAttribute((const void*)fwd, hipFuncAttributeMaxDynamicSharedMemorySize, LDS_BYTES) != hipSuccess) { fprintf(stderr, "kernel_launch: hipFuncSetAttribute failed\n"); grid = -1; return; }
        int per_cu = 0; if (hipOccupancyMaxActiveBlocksPerMultiprocessor(&per_cu, (const void*)fwd, NTHR, LDS_BYTES) != hipSuccess || per_cu < 1) fprintf(stderr, "kernel_launch: occupancy query says %d blocks per CU\n", per_cu);
        (void)hipGetLastError();
        grid = cus;
        const WS w0 = ws_carve(nullptr);
        if (n_in != 34 || w0.total > ws_size) { fprintf(stderr, "kernel_launch: bad inputs / workspace (need %zu, have %zu)\n", w0.total, ws_size); grid = -1; return; }
    }
    if (grid < 0) return;
    (void)hipMemsetAsync(d_ws, 0, 1 << 20, stream);
    Params p; memset(&p, 0, sizeof(p));
    for (int i = 0; i < 34; ++i) p.in[i] = (const float*)d_in[i];
    p.out = (float*)d_out; p.ws = (unsigned char*)d_ws;
    int li = 0;
    for (int lo = 0; lo < NPH; lo += MK_PHASES_PER_LAUNCH, ++li) {
        p.ph_lo = lo; p.ph_hi = lo + MK_PHASES_PER_LAUNCH < NPH ? lo + MK_PHASES_PER_LAUNCH : NPH; p.li = li;
        hipLaunchKernelGGL(fwd, dim3(grid), dim3(NTHR), LDS_BYTES, stream, p);
#if defined(PROBE_MASK)
        if (MK_PHASES_PER_LAUNCH == 1 && ((((PROBE_MASK) >> 12) & 1 && lo == 0) || (lo > 0 && (((PROBE_MASK) >> ((lo - 1) % PH_PER_LAYER)) & 1))))
            { Params q = p;
#if defined(PROBE_FLAGS)
              q.pad = PROBE_FLAGS;
#endif
              for (int r = 0; r < PROBE_REPS; ++r) hipLaunchKernelGGL(fwd, dim3(grid), dim3(NTHR), LDS_BYTES, stream, q); }
#endif
    }
}
```

```cpp
#include <hip/hip_runtime.h>
#include <cstdio>
#include <cstdint>
#include <cstring>
#include <math.h>
#include <stdint.h>

#ifdef CFG_SMALL
constexpr int D_MODEL = 256, BATCH = 2, SEQ = 512, DEPTH = 2, CTX_LEN = 64, GRID_W = 32, HEAD_DIM = 16;
#else
constexpr int D_MODEL = 2048, BATCH = 2, SEQ = 8192, DEPTH = 4, CTX_LEN = 256, GRID_W = 64, HEAD_DIM = 128;
#endif
constexpr int GROUP_W = D_MODEL / 4, NH = GROUP_W / HEAD_DIM;
constexpr int HD = HEAD_DIM;
constexpr int N_MOD = 6;
constexpr float EPS = 1e-6f;
constexpr int LRU_W = GROUP_W, LRU_BW = LRU_W / NH;
constexpr float LRU_C = 8.0f;
constexpr int MLA_Q_LORA = 3 * D_MODEL / 16, MLA_KV_LORA = D_MODEL / 8, MLA_NOPE = HD, MLA_ROPE = HD / 2, MLA_V = HD, MLA_QK = MLA_NOPE + MLA_ROPE;
constexpr int GDN_CHUNK = 64;
constexpr int NA_KH = 8, NA_KW = 16;
constexpr int D_FF = 5 * D_MODEL / 2;
constexpr int ROWS = SEQ / GRID_W;
constexpr int C_LRU_X = 0, C_LRU_G = C_LRU_X + LRU_W, C_CQ = C_LRU_G + LRU_W, C_CKV = C_CQ + MLA_Q_LORA, C_KR = C_CKV + MLA_KV_LORA,
              C_GQ = C_KR + MLA_ROPE, C_GK = C_GQ + GROUP_W, C_GV = C_GK + GROUP_W, C_GG = C_GV + GROUP_W, C_GB = C_GG + GROUP_W,
              C_GA = C_GB + 2 * NH, C_NQ = C_GA + 2 * NH, C_NK = C_NQ + GROUP_W, C_NV = C_NK + GROUP_W, IN_COLS = C_NV + GROUP_W;
constexpr int NP = (IN_COLS + 255) / 256 * 256;
constexpr int M_LAT = BATCH * SEQ, M_CTX = BATCH * CTX_LEN, M_ALL = M_LAT + M_CTX;
constexpr int NMODV = N_MOD * D_MODEL;

typedef unsigned short bf16_t;
__host__ __device__ __forceinline__ bf16_t f2bf(float f) { union { float f; unsigned u; } v; v.f = f; unsigned u = v.u; u += 0x7fffu + ((u >> 16) & 1u); return (bf16_t)(u >> 16); }
__host__ __device__ __forceinline__ float bf2f(bf16_t b) { union { float f; unsigned u; } v; v.u = ((unsigned)b) << 16; return v.f; }
__host__ __device__ __forceinline__ float sigmoidf_(float x) { return 1.0f / (1.0f + expf(-x)); }
__host__ __device__ __forceinline__ float siluf_(float x) { return x / (1.0f + expf(-x)); }
__host__ __device__ __forceinline__ float softplusf_(float x) { return fmaxf(x, 0.0f) + log1pf(expf(-fabsf(x))); }
__host__ __device__ __forceinline__ float geluf_(float x) { return 0.5f * x * (1.0f + tanhf(0.7978845608028654f * (x + 0.044715f * x * x * x))); }

struct RowInfo { int b, t, T, base, set; };
__host__ __device__ __forceinline__ RowInfo row_info(int r) {
    RowInfo i;
    if (r < M_LAT) { i.b = r / SEQ; i.t = r % SEQ; i.T = SEQ; i.base = i.b * SEQ; i.set = i.b; }
    else { const int rr = r - M_LAT; i.b = rr / CTX_LEN; i.t = rr % CTX_LEN; i.T = CTX_LEN; i.base = M_LAT + i.b * CTX_LEN; i.set = BATCH; }
    return i;
}


__host__ __device__ __forceinline__ float bflo(unsigned w) { union { float f; unsigned u; } v; v.u = w << 16; return v.f; }
__host__ __device__ __forceinline__ float bfhi(unsigned w) { union { float f; unsigned u; } v; v.u = w & 0xffff0000u; return v.f; }
__device__ __forceinline__ float lane_xor(float v, int mask, int lane) { return __int_as_float(__builtin_amdgcn_ds_bpermute((lane ^ mask) << 2, __float_as_int(v))); }
__device__ __forceinline__ float lane_get(float v, int src_lane) { return __int_as_float(__builtin_amdgcn_ds_bpermute(src_lane << 2, __float_as_int(v))); }
struct Inputs {
    const float *x, *c, *ctx, *c_ctx, *ada_w, *ada_b, *norm_mix_g, *norm_ffn_g, *w_in, *w_out,
        *lru_conv_w, *lru_conv_b, *lru_wa, *lru_ba, *lru_wx, *lru_bx, *lru_lam,
        *mla_qa_g, *mla_w_uq, *mla_kva_g, *mla_w_ukv, *mla_qn_g, *mla_kn_g,
        *gdn_conv_w, *gdn_a_log, *gdn_dt_bias, *gdn_norm_g, *na_qn_g, *na_kn_g, *na_rpb,
        *ffn_w_up, *ffn_conv_w, *ffn_conv_b, *ffn_w_down;
};
constexpr int NQ_MLA = NH * MLA_QK, NKV_MLA = NH * (MLA_NOPE + MLA_V);
constexpr size_t SZ_WIN = (size_t)NP * D_MODEL, SZ_WOUT = (size_t)D_MODEL * D_MODEL, SZ_WUP = (size_t)2 * D_FF * D_MODEL, SZ_WDOWN = (size_t)D_MODEL * D_FF,
                 SZ_WUQ = (size_t)NQ_MLA * MLA_Q_LORA, SZ_WUKV = (size_t)NKV_MLA * MLA_KV_LORA, SZ_WLRU = (size_t)16 * LRU_BW * LRU_BW;
struct WS {
    unsigned* ctl; float *MOD, *H; bf16_t *U, *Y;
    bf16_t *WIN, *WOUT, *WUP, *WDOWN, *WUQ, *WUKV, *WLRU;
    bf16_t* P; bf16_t *CQN, *CKVN; float *QR, *KVR; bf16_t *QM, *KM, *VM, *NQ, *NK;
    bf16_t *gUT, *gWP, *gKDT, *gQD, *gQK, *gSIT, *gVNT; float* gGT;
    bf16_t *lHLOC, *lACUM; float *lLSUM, *lHIN;
    bf16_t *UP, *ACT;
    size_t total;
};
__host__ __device__ inline WS ws_carve(void* base) {
    WS w; size_t off = 0; char* b = (char*)base;
#define WS_TAKE(T, field, bytes) do { w.field = (T*)(b + off); off += (((size_t)(bytes)) + 255) & ~(size_t)255; } while (0)
    WS_TAKE(unsigned, ctl, 1 << 20);
    WS_TAKE(float, MOD, sizeof(float) * (size_t)DEPTH * (BATCH + 1) * NMODV);
    WS_TAKE(float, H, sizeof(float) * (size_t)M_ALL * D_MODEL);
    WS_TAKE(bf16_t, U, 2 * (size_t)M_ALL * D_MODEL);
    WS_TAKE(bf16_t, Y, 2 * (size_t)M_ALL * D_MODEL);
    WS_TAKE(bf16_t, WIN, 2 * SZ_WIN * DEPTH); WS_TAKE(bf16_t, WOUT, 2 * SZ_WOUT * DEPTH); WS_TAKE(bf16_t, WUP, 2 * SZ_WUP * DEPTH); WS_TAKE(bf16_t, WDOWN, 2 * SZ_WDOWN * DEPTH);
    WS_TAKE(bf16_t, WUQ, 2 * SZ_WUQ * DEPTH); WS_TAKE(bf16_t, WUKV, 2 * SZ_WUKV * DEPTH); WS_TAKE(bf16_t, WLRU, 2 * SZ_WLRU * DEPTH);
    const size_t r0 = off;
    WS_TAKE(bf16_t, P, 2 * (size_t)M_ALL * NP);
    WS_TAKE(bf16_t, CQN, 2 * (size_t)M_ALL * MLA_Q_LORA); WS_TAKE(bf16_t, CKVN, 2 * (size_t)M_ALL * MLA_KV_LORA);
    WS_TAKE(float, QR, 4 * (size_t)M_ALL * NQ_MLA); WS_TAKE(float, KVR, 4 * (size_t)M_ALL * NKV_MLA);
    WS_TAKE(bf16_t, QM, 2 * (size_t)M_ALL * NQ_MLA); WS_TAKE(bf16_t, KM, 2 * (size_t)M_ALL * NQ_MLA); WS_TAKE(bf16_t, VM, 2 * (size_t)M_ALL * NH * MLA_V);
    WS_TAKE(bf16_t, NQ, 2 * (size_t)M_ALL * GROUP_W); WS_TAKE(bf16_t, NK, 2 * (size_t)M_ALL * GROUP_W);
    { constexpr size_t NT_ = (size_t)(M_ALL / 64) * NH * 2;
      WS_TAKE(bf16_t, gUT, 2 * NT_ * 128 * 64); WS_TAKE(bf16_t, gWP, 2 * NT_ * 64 * 128); WS_TAKE(bf16_t, gKDT, 2 * NT_ * 128 * 64); WS_TAKE(bf16_t, gQD, 2 * NT_ * 64 * 128);
      WS_TAKE(bf16_t, gQK, 2 * NT_ * 64 * 64); WS_TAKE(bf16_t, gSIT, 2 * NT_ * 128 * 128); WS_TAKE(bf16_t, gVNT, 2 * NT_ * 128 * 64); WS_TAKE(float, gGT, 4 * NT_ * DEPTH); }
    WS_TAKE(bf16_t, lHLOC, 2 * (size_t)2 * M_ALL * LRU_W); WS_TAKE(bf16_t, lACUM, 2 * (size_t)2 * M_ALL * LRU_W);
    WS_TAKE(float, lLSUM, 4 * (size_t)(M_ALL / 64) * 2 * 2 * LRU_W); WS_TAKE(float, lHIN, 4 * (size_t)(M_ALL / 64) * 2 * LRU_W);
    const size_t r1 = off;
    off = r0;
    WS_TAKE(bf16_t, UP, 2 * (size_t)M_ALL * 2 * D_FF); WS_TAKE(bf16_t, ACT, 2 * (size_t)M_ALL * D_FF);
    const size_t f1 = off;
#undef WS_TAKE
    w.total = r1 > f1 ? r1 : f1;
    return w;
}

namespace pg8 {
#define PG8_LAS __attribute__((address_space(3)))
typedef unsigned short bf16_t;
typedef short bf16x8 __attribute__((ext_vector_type(8)));
typedef float f32x4 __attribute__((ext_vector_type(4)));
typedef unsigned u32x4 __attribute__((ext_vector_type(4)));
constexpr int BM = 256, BK = 64, HALF = 128, HTB = HALF * BK * 2  , STAGE_BYTES = 8 * HTB, NXCD = 8, WGM = 8;

__host__ __device__ __forceinline__ int lds_byte(int r, int c) { const int st = (r >> 4) * 2 + (c >> 5), rr = r & 15, cc = c & 31, ob = rr * 64 + cc * 2; return st * 1024 + (ob ^ (((ob >> 9) & 1) << 5)); }
__host__ __device__ __forceinline__ void stage_rc(int b, int& R, int& C) { const int st = b / 1024, sb = b % 1024, swz = sb ^ (((sb >> 9) & 1) << 5); R = (st >> 1) * 16 + swz / 64; C = (st & 1) * 32 + (swz % 64) / 2; }
__host__ __device__ __forceinline__ int perm32(int rho) { const int n = rho >> 4, i = rho & 15; return 8 * (i >> 2) + 4 * n + (i & 3); }

struct Unit { int pm, pn; };
struct Gemm { const bf16_t* A; const bf16_t* Bt; int M, N, K; };

struct StaticOrder {
    int nM, nN, nwg, G, c;
    __host__ __device__ void init(int M, int N, int G_, int c_) { nM = M / BM; nN = N / BM; nwg = nM * nN; G = G_; c = c_; }
    __host__ __device__ bool next(int i, Unit& u) const {
        const long L = (long)i * G + c; if (L >= nwg) return false;
        int wgid = (int)L; { const int q = nwg / NXCD, r = nwg % NXCD, xcd = wgid % NXCD, off = wgid / NXCD; wgid = (xcd < r ? xcd * (q + 1) : r * (q + 1) + (xcd - r) * q) + off; }
        const int nig = WGM * nN, gid = wgid / nig, fm = gid * WGM, gsz = (nM - fm) < WGM ? (nM - fm) : WGM;
        u.pm = fm + ((wgid % nig) % gsz); u.pn = (wgid % nig) / gsz; return true;
    }
    __device__ __forceinline__ void a_ready(const Unit&) const {}
    __device__ __forceinline__ void done(const Unit&) const {}
};
__device__ __forceinline__ unsigned cvt_pk_bf16(float lo, float hi) { unsigned r; asm volatile("v_cvt_pk_bf16_f32 %0, %1, %2" : "=v"(r) : "v"(lo), "v"(hi)); return r; }
typedef float f32x2 __attribute__((ext_vector_type(2)));
__device__ __forceinline__ f32x2 gelu_pk(f32x2 v) {
    const f32x2 av = __builtin_elementwise_abs(v), d = av * 0.2316418882f + 1.0f;
    f32x2 t; t.x = __builtin_amdgcn_rcpf(d.x); t.y = __builtin_amdgcn_rcpf(d.y);
    f32x2 q = t * 0.5307027145f + (-0.7265760135f); q = q * t + 0.7107068705f; q = q * t + (-0.142248368f); q = q * t + 0.127414796f; q = q * t;
    const f32x2 s = (v * v) * (-0.72134752044f);
    f32x2 e; e.x = __builtin_amdgcn_exp2f(s.x); e.y = __builtin_amdgcn_exp2f(s.y);
    const f32x2 m = v * (q * e), r = v - m;
    f32x2 o; o.x = v.x < 0.f ? m.x : r.x; o.y = v.y < 0.f ? m.y : r.y; return o;
}

template <int ACT  > struct EpiBf16 {
    static constexpr bool PERM = true, AFTER_DRAIN = false; static_assert(ACT == 0 || ACT == 1, "EpiBf16: ACT is 0 (none) or 1 (gelu_pk)");
    bf16_t* O; int ldc; const float* bias; int split_cols; size_t split_stride; float scale0;
    __device__ __forceinline__ void operator()(const f32x4 (&acc)[2][2][4][2], const Unit& u, int wr, int wc, int fr, int fq) const {
        const int row0 = u.pm * BM + wr * 64 + fr; int colt = u.pn * BM; bf16_t* base = O;
        float sc = 1.f; if (split_cols) { const int t = colt / split_cols; base += (size_t)t * split_stride; colt -= t * split_cols; if (t == 0) sc = scale0; }
        const int col0 = colt + wc * 32 + 8 * fq, bcol0 = u.pn * BM + wc * 32 + 8 * fq;
        f32x4 bv[2][2];
#pragma unroll
        for (int bj = 0; bj < 2; ++bj)
#pragma unroll
            for (int n = 0; n < 2; ++n) bv[bj][n] = bias ? *(const f32x4*)(bias + bcol0 + bj * HALF + 4 * n) : (f32x4){0.f, 0.f, 0.f, 0.f};
#pragma unroll
        for (int ai = 0; ai < 2; ++ai)
#pragma unroll
            for (int m = 0; m < 4; ++m) { bf16_t* rowp = base + (size_t)(row0 + ai * HALF + m * 16) * ldc + col0;
#pragma unroll
                for (int bj = 0; bj < 2; ++bj) { f32x4 v0 = acc[ai][bj][m][0] + bv[bj][0], v1 = acc[ai][bj][m][1] + bv[bj][1];
                    if (ACT == 1) { f32x2 a = gelu_pk((f32x2){v0[0], v0[1]}), b = gelu_pk((f32x2){v0[2], v0[3]}), c = gelu_pk((f32x2){v1[0], v1[1]}), d = gelu_pk((f32x2){v1[2], v1[3]});
                        v0 = (f32x4){a.x, a.y, b.x, b.y}; v1 = (f32x4){c.x, c.y, d.x, d.y}; }
                    v0 = v0 * sc; v1 = v1 * sc; u32x4 w; w.x = cvt_pk_bf16(v0[0], v0[1]); w.y = cvt_pk_bf16(v0[2], v0[3]); w.z = cvt_pk_bf16(v1[0], v1[1]); w.w = cvt_pk_bf16(v1[2], v1[3]);
                    *(u32x4*)(rowp + bj * HALF) = w; } }
    }
};

struct EpiF32 {
    static constexpr bool PERM = false, AFTER_DRAIN = false;
    float* C; int ldc;
    __device__ __forceinline__ void operator()(const f32x4 (&acc)[2][2][4][2], const Unit& u, int wr, int wc, int fr, int fq) const {
        const int row0 = u.pm * BM + wr * 64 + fr, col0 = u.pn * BM + wc * 32 + 4 * fq;
#pragma unroll
        for (int ai = 0; ai < 2; ++ai)
#pragma unroll
            for (int m = 0; m < 4; ++m) { float* rowp = C + (size_t)(row0 + ai * HALF + m * 16) * ldc + col0;
#pragma unroll
                for (int bj = 0; bj < 2; ++bj)
#pragma unroll
                    for (int n = 0; n < 2; ++n) *(f32x4*)(rowp + bj * HALF + n * 16) = acc[ai][bj][m][n]; }
    }
};
struct EpiGateRes {
    static constexpr bool PERM = false, AFTER_DRAIN = false;
    const float* base; float* out; int ldc; const float* gate; int set_stride; int rows_per_set; int nsets_lat; int lat_rows;
    __device__ __forceinline__ void operator()(const f32x4 (&acc)[2][2][4][2], const Unit& u, int wr, int wc, int fr, int fq) const {
        const int row0 = u.pm * BM + wr * 64 + fr, col0 = u.pn * BM + wc * 32 + 4 * fq;
        const int set = (u.pm * BM >= lat_rows) ? nsets_lat : (u.pm * BM) / rows_per_set;
        const float* gp = gate + (size_t)set * set_stride + col0;
        f32x4 gv[2][2];
#pragma unroll
        for (int bj = 0; bj < 2; ++bj)
#pragma unroll
            for (int n = 0; n < 2; ++n) gv[bj][n] = *(const f32x4*)(gp + bj * HALF + n * 16);
#pragma unroll
        for (int ai = 0; ai < 2; ++ai)
#pragma unroll
            for (int m = 0; m < 4; ++m) { const size_t off = (size_t)(row0 + ai * HALF + m * 16) * ldc + col0;
#pragma unroll
                for (int bj = 0; bj < 2; ++bj)
#pragma unroll
                    for (int n = 0; n < 2; ++n) { const f32x4 b = *(const f32x4*)(base + off + bj * HALF + n * 16); *(f32x4*)(out + off + bj * HALF + n * 16) = b + gv[bj][n] * acc[ai][bj][m][n]; } }
    }
};

template <class Epi, class Sched, bool ALIGN_EPI = false, bool SP2 = false>
__device__ __forceinline__ void gemm_phase(PG8_LAS unsigned char* lds, const Gemm g, const Sched& S, const Epi& E, const int tid_in) {
    int tid_ = tid_in; asm volatile("" : "+v"(tid_));
    const int tid = tid_, wid = __builtin_amdgcn_readfirstlane(tid >> 6), lane = tid & 63, wr = wid >> 2, wc = wid & 3, fr = lane & 15, fq = lane >> 4;
    const int K = g.K, nt = K / BK;
    unsigned voffA[2], voffB[2];
#pragma unroll
    for (int i = 0; i < 2; ++i) { int R, C; stage_rc(tid * 16 + i * 8192, R, C); const int Rb = Epi::PERM ? ((R & ~31) + perm32(R & 31)) : R;
        voffA[i] = (unsigned)(R * K + C) * 2u; voffB[i] = (unsigned)(Rb * K + C) * 2u; }
    const size_t kstep = (size_t)(BK * 2);
    const size_t hstep = (size_t)HALF * K * 2;
    const size_t tstep = 2 * hstep;
    const unsigned ldsw = (unsigned)wid * 1024u;
    const int aoff = lds_byte(wr * 64 + fr, fq * 8), boff = lds_byte(wc * 32 + fr, fq * 8);
#define PG8_SA(b, h) (((b) * 2 + (h)) * HTB)
#define PG8_SB(b, h) ((4 + (b) * 2 + (h)) * HTB)
#define PG8_STAGE(bufoff, gbase, voff) do { _Pragma("unroll") for (int _i = 0; _i < 2; ++_i) \
        __builtin_amdgcn_global_load_lds((const unsigned*)((const char*)(gbase) + (voff)[_i]), (PG8_LAS unsigned*)(lds + (bufoff) + ldsw + _i * 8192), 16, 0, 0); } while (0)
#define PG8_LDA(dst, b, h) do { _Pragma("unroll") for (int m = 0; m < 4; ++m) _Pragma("unroll") for (int k = 0; k < 2; ++k) dst[m][k] = *(const PG8_LAS bf16x8*)(lds + PG8_SA(b, h) + aoff + m * 2048 + k * 1024); } while (0)
#define PG8_LDB(dst, b, h) do { _Pragma("unroll") for (int n = 0; n < 2; ++n) _Pragma("unroll") for (int k = 0; k < 2; ++k) dst[n][k] = *(const PG8_LAS bf16x8*)(lds + PG8_SB(b, h) + boff + n * 2048 + k * 1024); } while (0)
#define PG8_MMA(ai, bj, At, Bt) do { __builtin_amdgcn_s_setprio(1); _Pragma("unroll") for (int m = 0; m < 4; ++m) _Pragma("unroll") for (int n = 0; n < 2; ++n) _Pragma("unroll") for (int k = 0; k < 2; ++k) \
        acc[ai][bj][m][n] = __builtin_amdgcn_mfma_f32_16x16x32_bf16(Bt[n][k], At[m][k], acc[ai][bj][m][n], 0, 0, 0); __builtin_amdgcn_s_setprio(0); } while (0)
#define PG8_WAIT_V(n) asm volatile("s_waitcnt vmcnt(" #n ")" ::: "memory")
#define PG8_WAIT_L(n) asm volatile("s_waitcnt lgkmcnt(" #n ")" ::: "memory")
#define PG8_BAR __builtin_amdgcn_s_barrier()
#define PG8_SCHED __builtin_amdgcn_sched_barrier(0)
    Unit cur, nxt; int ui = 0;
    if (!S.next(0, cur)) return;
    f32x4 acc[2][2][4][2];
#pragma unroll
    for (int a = 0; a < 2; ++a)
#pragma unroll
        for (int b = 0; b < 2; ++b)
#pragma unroll
            for (int m = 0; m < 4; ++m)
#pragma unroll
                for (int n = 0; n < 2; ++n) acc[a][b][m][n] = (f32x4){0.f, 0.f, 0.f, 0.f};
    bf16x8 At[4][2], B0[2][2], B1[2][2];
    const char* cA = (const char*)g.A + (size_t)cur.pm * tstep; const char* cB = (const char*)g.Bt + (size_t)cur.pn * tstep;
    S.a_ready(cur);
    if constexpr (SP2) {
        PG8_STAGE(PG8_SB(0, 0), cB, voffB); PG8_STAGE(PG8_SB(0, 1), cB + hstep, voffB); PG8_STAGE(PG8_SA(0, 0), cA, voffA); PG8_STAGE(PG8_SA(0, 1), cA + hstep, voffA);
        if (wr == 1) PG8_BAR;
        PG8_WAIT_V(2); PG8_BAR;
        PG8_STAGE(PG8_SB(1, 0), cB + kstep, voffB); PG8_STAGE(PG8_SA(1, 0), cA + kstep, voffA); PG8_STAGE(PG8_SB(1, 1), cB + hstep + kstep, voffB);
        PG8_WAIT_V(6); PG8_BAR;
    } else {
        PG8_STAGE(PG8_SB(0, 0), cB, voffB); PG8_STAGE(PG8_SA(0, 0), cA, voffA); PG8_STAGE(PG8_SB(0, 1), cB + hstep, voffB); PG8_STAGE(PG8_SA(0, 1), cA + hstep, voffA);
        if (wr == 1) PG8_BAR;
        PG8_WAIT_V(4); PG8_BAR;
        PG8_STAGE(PG8_SB(1, 0), cB + kstep, voffB); PG8_STAGE(PG8_SA(1, 0), cA + kstep, voffA); PG8_STAGE(PG8_SB(1, 1), cB + hstep + kstep, voffB);
        PG8_WAIT_V(6); PG8_BAR;
    }
    for (;;) {
        const bool has_next = S.next(ui + 1, nxt);
        const char* nA = has_next ? (const char*)g.A + (size_t)nxt.pm * tstep : cA; const char* nB = has_next ? (const char*)g.Bt + (size_t)nxt.pn * tstep : cB;
        for (int t = 0; t < nt; t += 2) {
            const bool last = (t == nt - 2);
            const char* a1 = cA + (size_t)(t + 1) * kstep;
            const char* a2 = last ? nA : cA + (size_t)(t + 2) * kstep; const char* b2 = last ? nB : cB + (size_t)(t + 2) * kstep;
            const char* a3 = a2 + kstep; const char* b3 = b2 + kstep;
            if (last && has_next) S.a_ready(nxt);
            if constexpr (SP2) {
            PG8_LDB(B0, 0, 0); PG8_LDB(B1, 0, 1); PG8_SCHED; PG8_LDA(At, 0, 0); PG8_STAGE(PG8_SA(1, 1), a1 + hstep, voffA);
            PG8_WAIT_V(8); PG8_WAIT_L(0); PG8_BAR; PG8_MMA(0, 0, At, B0); PG8_MMA(0, 1, At, B1); PG8_BAR; PG8_SCHED;
            PG8_LDA(At, 0, 1); PG8_STAGE(PG8_SB(0, 0), b2, voffB); PG8_STAGE(PG8_SB(0, 1), b2 + hstep, voffB); PG8_STAGE(PG8_SA(0, 0), a2, voffA);
            PG8_WAIT_V(8); PG8_WAIT_L(0); PG8_BAR; PG8_MMA(1, 0, At, B0); PG8_MMA(1, 1, At, B1); PG8_BAR; PG8_SCHED;
            PG8_LDB(B0, 1, 0); PG8_LDB(B1, 1, 1); PG8_SCHED; PG8_LDA(At, 1, 0); PG8_STAGE(PG8_SA(0, 1), a2 + hstep, voffA);
            PG8_WAIT_V(8); PG8_WAIT_L(0); PG8_BAR; PG8_MMA(0, 0, At, B0); PG8_MMA(0, 1, At, B1); PG8_BAR; PG8_SCHED;
            PG8_LDA(At, 1, 1); PG8_STAGE(PG8_SB(1, 0), b3, voffB); PG8_STAGE(PG8_SB(1, 1), b3 + hstep, voffB); PG8_STAGE(PG8_SA(1, 0), a3, voffA);
            PG8_WAIT_V(8); PG8_WAIT_L(0); PG8_BAR; PG8_MMA(1, 0, At, B0); PG8_MMA(1, 1, At, B1); PG8_BAR; PG8_SCHED;
            } else {
            PG8_LDB(B0, 0, 0); PG8_SCHED; PG8_LDA(At, 0, 0); PG8_STAGE(PG8_SA(1, 1), a1 + hstep, voffA);
            PG8_WAIT_L(8); PG8_BAR; PG8_WAIT_L(0); PG8_MMA(0, 0, At, B0); PG8_BAR; PG8_SCHED;
            PG8_LDB(B1, 0, 1); PG8_STAGE(PG8_SB(0, 0), b2, voffB);
            PG8_BAR; PG8_WAIT_L(0); PG8_MMA(0, 1, At, B1); PG8_BAR;
            PG8_LDA(At, 0, 1); PG8_STAGE(PG8_SA(0, 0), a2, voffA);
            PG8_BAR; PG8_WAIT_L(0); PG8_MMA(1, 0, At, B0); PG8_BAR; PG8_SCHED;
            PG8_STAGE(PG8_SB(0, 1), b2 + hstep, voffB);
            PG8_WAIT_V(6); PG8_BAR; PG8_MMA(1, 1, At, B1); PG8_BAR;
            PG8_LDB(B0, 1, 0); PG8_SCHED; PG8_LDA(At, 1, 0); PG8_STAGE(PG8_SA(0, 1), a2 + hstep, voffA);
            PG8_WAIT_L(8); PG8_BAR; PG8_WAIT_L(0); PG8_MMA(0, 0, At, B0); PG8_BAR; PG8_SCHED;
            PG8_LDB(B1, 1, 1); PG8_STAGE(PG8_SB(1, 0), b3, voffB);
            PG8_BAR; PG8_WAIT_L(0); PG8_MMA(0, 1, At, B1); PG8_BAR;
            PG8_LDA(At, 1, 1); PG8_STAGE(PG8_SA(1, 0), a3, voffA);
            PG8_BAR; PG8_WAIT_L(0); PG8_MMA(1, 0, At, B0); PG8_BAR; PG8_SCHED;
            PG8_STAGE(PG8_SB(1, 1), b3 + hstep, voffB);
            PG8_WAIT_V(6); PG8_BAR; PG8_MMA(1, 1, At, B1); PG8_BAR;
            }
        }
        if constexpr (ALIGN_EPI) { if (wr == 0) PG8_BAR; }
        if constexpr (!Epi::AFTER_DRAIN) { E(acc, cur, wr, wc, fr, fq); S.done(cur); }
        if (!has_next) break;
#pragma unroll
        for (int a = 0; a < 2; ++a)
#pragma unroll
            for (int b = 0; b < 2; ++b)
#pragma unroll
                for (int m = 0; m < 4; ++m)
#pragma unroll
                    for (int n = 0; n < 2; ++n) acc[a][b][m][n] = (f32x4){0.f, 0.f, 0.f, 0.f};
        cur = nxt; cA = nA; cB = nB; ++ui;
        if constexpr (ALIGN_EPI) { if (wr == 1) PG8_BAR; }
    }
    PG8_WAIT_V(0);
    if constexpr (!ALIGN_EPI) { if (wr == 0) PG8_BAR; }
    PG8_BAR;
    if constexpr (Epi::AFTER_DRAIN) { E.fused(acc, cur, wr, wc, fr, fq, lds, wid, lane); S.done(cur); }
#undef PG8_SA
#undef PG8_SB
#undef PG8_STAGE
#undef PG8_LDA
#undef PG8_LDB
#undef PG8_MMA
#undef PG8_WAIT_V
#undef PG8_WAIT_L
#undef PG8_BAR
#undef PG8_SCHED
}
}

namespace att {
using bf16x8 = __attribute__((ext_vector_type(8))) short;
using s16x4  = __attribute__((ext_vector_type(4))) short;
using f32x16 = __attribute__((ext_vector_type(16))) float;
using u32x4  = __attribute__((ext_vector_type(4))) unsigned;
constexpr int NW = 8, QBLK = 32, KVBLK = 64, DV = 128;
#define ATT_SBAR() __builtin_amdgcn_sched_barrier(0)
__device__ __forceinline__ int crow(int r, int hi) { return (r & 3) + 8 * (r >> 2) + 4 * hi; }
__device__ __forceinline__ unsigned cvtpk(float lo, float hi) { unsigned r; asm volatile("v_cvt_pk_bf16_f32 %0, %1, %2" : "=v"(r) : "v"(lo), "v"(hi)); return r; }
template <int DQK> __device__ __forceinline__ int kswz(int row, int colB) { return row * (DQK * 2) + (colB ^ ((row & 7) << 4)); }
constexpr float THR = 8.f;

template <int DQK> struct Cfg {
    static constexpr int SHM_V = KVBLK * DV * 2, SHM_K = KVBLK * DQK * 2;
    static constexpr int OFF_V = 0, OFF_K = 2 * SHM_V, OFF_WS = OFF_K + 2 * SHM_K, OFF_BIAS = OFF_WS + NW * 64 * 4, LDS_BYTES = OFF_BIAS + 10240;
    static constexpr int KCH = DQK / 8;
    static constexpr int KLD = (64 * KCH) / 512;
};

struct Job {
    const bf16_t* Q;
    const bf16_t* K;
    const bf16_t* V;
    bf16_t* O;
    int nt;
    int seg0_tiles, row_seg0, row_seg1;
    int R0; int rlo;
};

__device__ __forceinline__ int tile_row(const Job& J, int j) {
    if (j < J.seg0_tiles) return J.row_seg0 + 64 * j;
    int jj = j - J.seg0_tiles; if (jj > 3) jj = 0; return J.row_seg1 + 64 * jj;
}

__device__ __forceinline__ void partialSM(f32x16& p0, f32x16& p1, float& m_reg, float& mn, float& alpha, float C, float thr_raw) {
    float pmax = p0[0];
#pragma unroll
    for (int r = 1; r < 16; ++r) pmax = fmaxf(pmax, p0[r]);
#pragma unroll
    for (int r = 0; r < 16; ++r) pmax = fmaxf(pmax, p1[r]);
    { auto rr = __builtin_amdgcn_permlane32_swap(__float_as_uint(pmax), __float_as_uint(pmax), false, false);
      pmax = fmaxf(__uint_as_float(rr[0]), __uint_as_float(rr[1])); }
    if (__builtin_expect(__all(pmax - m_reg <= thr_raw), 1)) { mn = m_reg; alpha = 1.f; }
    else { mn = fmaxf(m_reg, pmax); alpha = __builtin_amdgcn_exp2f((m_reg - mn) * C); m_reg = mn; }
    const float mnC = -mn * C;
#pragma unroll
    for (int r = 0; r < 16; ++r) p0[r] = fmaf(p0[r], C, mnC);
#pragma unroll
    for (int r = 0; r < 16; ++r) p1[r] = fmaf(p1[r], C, mnC);
#pragma unroll
    for (int r = 0; r < 16; ++r) p0[r] = __builtin_amdgcn_exp2f(p0[r]);
}
__device__ __forceinline__ void finishSM(f32x16& p0, f32x16& p1, float alpha, float& l_reg, bf16x8& pa0, bf16x8& pa1, bf16x8& pa2, bf16x8& pa3) {
#pragma unroll
    for (int r = 0; r < 16; ++r) p1[r] = __builtin_amdgcn_exp2f(p1[r]);
    float ps = 0;
#pragma unroll
    for (int r = 0; r < 16; ++r) ps += p0[r];
#pragma unroll
    for (int r = 0; r < 16; ++r) ps += p1[r];
    { auto rr = __builtin_amdgcn_permlane32_swap(__float_as_uint(ps), __float_as_uint(ps), false, false);
      ps = __uint_as_float(rr[0]) + __uint_as_float(rr[1]); }
    l_reg = l_reg * alpha + ps;
#define ATT_PK4(P, BASE, OUT) do { unsigned a0 = cvtpk(P[BASE + 0], P[BASE + 1]), a1 = cvtpk(P[BASE + 2], P[BASE + 3]);   \
    unsigned b0 = cvtpk(P[BASE + 4], P[BASE + 5]), b1 = cvtpk(P[BASE + 6], P[BASE + 7]);                              \
    auto r0 = __builtin_amdgcn_permlane32_swap(a0, b0, false, false); auto r1 = __builtin_amdgcn_permlane32_swap(a1, b1, false, false); \
    u32x4 w = {r0[0], r1[0], r0[1], r1[1]}; OUT = *reinterpret_cast<bf16x8*>(&w); } while (0)
    ATT_PK4(p0, 0, pa0); ATT_PK4(p0, 8, pa1); ATT_PK4(p1, 0, pa2); ATT_PK4(p1, 8, pa3);
#undef ATT_PK4
}
template <int DQK> __device__ __forceinline__ void qkt(f32x16& p0, f32x16& p1, const char* Ks, const bf16x8* qr, int r32, int hi) {
    p0 = f32x16{}; p1 = f32x16{};
#pragma unroll
    for (int d0 = 0; d0 < DQK / 16; ++d0) { const int cb = (d0 * 16 + hi * 8) * 2;
        const bf16x8 b0 = *reinterpret_cast<const bf16x8*>(Ks + kswz<DQK>(r32, cb));
        const bf16x8 b1 = *reinterpret_cast<const bf16x8*>(Ks + kswz<DQK>(32 + r32, cb));
        p0 = __builtin_amdgcn_mfma_f32_32x32x16_bf16(b0, qr[d0], p0, 0, 0, 0);
        p1 = __builtin_amdgcn_mfma_f32_32x32x16_bf16(b1, qr[d0], p1, 0, 0, 0); }
}
__device__ __forceinline__ int v_st(int k, int c) { const int kk = (k & ~0xC) | ((k & 4) << 1) | ((k & 8) >> 1); return ((kk >> 3) * 4 + (c >> 5)) * 512 + ((kk & 7) * 32 + (c & 31)) * 2; }
__device__ __forceinline__ int v_rd_base(int lane) { return ((lane & 3) << 3) | (((lane >> 2) & 3) << 6) | (((lane >> 4) & 1) << 5) | (((lane >> 5) & 1) << 8); }
constexpr int v_rd_off(int d0, int ks, int half) { return d0 * 512 + ks * 4096 + half * 2048; }
template <int OFF> __device__ __forceinline__ s16x4 tr_read(int vb) { s16x4 r; asm volatile("ds_read_b64_tr_b16 %0, %1 offset:%2" : "=&v"(r) : "v"(vb), "i"(OFF) : "memory"); return r; }
template <int D0> __device__ __forceinline__ void pv_one(f32x16& od, int vb, bf16x8 pa0, bf16x8 pa1, bf16x8 pa2, bf16x8 pa3) {
    const s16x4 l0 = tr_read<v_rd_off(D0, 0, 0)>(vb), h0 = tr_read<v_rd_off(D0, 0, 1)>(vb), l1 = tr_read<v_rd_off(D0, 1, 0)>(vb), h1 = tr_read<v_rd_off(D0, 1, 1)>(vb);
    const s16x4 l2 = tr_read<v_rd_off(D0, 2, 0)>(vb), h2 = tr_read<v_rd_off(D0, 2, 1)>(vb), l3 = tr_read<v_rd_off(D0, 3, 0)>(vb), h3 = tr_read<v_rd_off(D0, 3, 1)>(vb);
    asm volatile("s_waitcnt lgkmcnt(0)" ::: "memory"); ATT_SBAR();
#define ATT_PK(L, H) (bf16x8){L[0], L[1], L[2], L[3], H[0], H[1], H[2], H[3]}
    od = __builtin_amdgcn_mfma_f32_32x32x16_bf16(pa0, ATT_PK(l0, h0), od, 0, 0, 0);
    od = __builtin_amdgcn_mfma_f32_32x32x16_bf16(pa1, ATT_PK(l1, h1), od, 0, 0, 0);
    od = __builtin_amdgcn_mfma_f32_32x32x16_bf16(pa2, ATT_PK(l2, h2), od, 0, 0, 0);
    od = __builtin_amdgcn_mfma_f32_32x32x16_bf16(pa3, ATT_PK(l3, h3), od, 0, 0, 0);
#undef ATT_PK
}
__device__ __forceinline__ void pv_d0(f32x16* o, int vb, bf16x8 pa0, bf16x8 pa1, bf16x8 pa2, bf16x8 pa3) {
    pv_one<0>(o[0], vb, pa0, pa1, pa2, pa3); pv_one<1>(o[1], vb, pa0, pa1, pa2, pa3); pv_one<2>(o[2], vb, pa0, pa1, pa2, pa3); pv_one<3>(o[3], vb, pa0, pa1, pa2, pa3);
}
constexpr int NA_BROW = 160, NA_BORG = 64 + (NA_KW - 1);
__device__ __forceinline__ void na_bias(f32x16& p0, f32x16& p1, const Job& J, int j, int R, int c, int hi, const float* biasq) {
    const int nloc = J.seg0_tiles;
    if (j >= nloc && j < nloc + 4) return;
    const int rr = J.rlo + j; int r0 = R - NA_KH / 2; r0 = r0 < 0 ? 0 : (r0 > ROWS - NA_KH ? ROWS - NA_KH : r0);
    const bool rowok = (j < nloc) && rr >= r0 && rr < r0 + NA_KH;
    if (!rowok) {
#pragma unroll
        for (int r = 0; r < 16; ++r) { p0[r] = -1e30f; p1[r] = -1e30f; }
        return; }
    int c0 = c - NA_KW / 2; c0 = c0 < 0 ? 0 : (c0 > GRID_W - NA_KW ? GRID_W - NA_KW : c0);
    const int dr = rr - R + (NA_KH - 1);
    const float* bl = biasq + dr * NA_BROW + NA_BORG + 4 * hi - c;
    const int vb = 4 * hi - c0;
#pragma unroll
    for (int r = 0; r < 16; ++r) { const int cc = (r & 3) + 8 * (r >> 2);
        p0[r] = ((unsigned)(cc + vb) < (unsigned)NA_KW) ? p0[r] + bl[cc] : -1e30f;
        p1[r] = ((unsigned)(cc + 32 + vb) < (unsigned)NA_KW) ? p1[r] + bl[cc + 32] : -1e30f; }
}

#define ATT_LAS __attribute__((address_space(3)))
template <int DQK, bool NA, int LDQ, int LDK, int LDV, int LDO>
__device__ __forceinline__ void attn_unit(const Job& J, char* lds, const float scale, const int tid_in) {
    using C_ = Cfg<DQK>;
    int tid_ = tid_in; asm volatile("" : "+v"(tid_));
    const int tid = tid_, wid = __builtin_amdgcn_readfirstlane(tid >> 6), lane = tid & 63, r32 = lane & 31, hi = lane >> 5;
    char* V_lds = lds + C_::OFF_V; char* K_lds = lds + C_::OFF_K;
    const unsigned ldsb = (unsigned)(uintptr_t)lds;
    float* wsf = (float*)(lds + C_::OFF_WS) + wid * 64; float* li_l = wsf; float* al_l = wsf + 32;
    const float* biasq = (const float*)(lds + C_::OFF_BIAS);
    const float Cc = scale * 1.4426950408889634f, thr_raw = THR / scale;
    float m_reg = -1e5f, l_reg = 0; f32x16 o[4] = {}; bf16x8 qr[DQK / 16];
    const bf16_t* Qw = J.Q + (long)(wid * QBLK + r32) * LDQ + hi * 8;
#pragma unroll
    for (int d0 = 0; d0 < DQK / 16; ++d0) qr[d0] = *reinterpret_cast<const bf16x8*>(Qw + d0 * 16);
    const int naR = J.R0 + (wid >> 1), nac = (wid & 1) * 32 + r32;
    const int vb0 = (int)(uintptr_t)V_lds + v_rd_base(lane);
    unsigned koff[C_::KLD], voff[2];
#pragma unroll
    for (int i = 0; i < C_::KLD; ++i) { const int sl = 512 * i + tid, row = sl / C_::KCH, cs = sl % C_::KCH, chunk = (cs & ~7) | ((cs & 7) ^ (row & 7)); koff[i] = (unsigned)(row * LDK * 2 + chunk * 16); }
#pragma unroll
    for (int i = 0; i < 2; ++i) { const int sl = 512 * i + tid, sub = sl >> 5, wi = sl & 31, kk = (sub >> 2) * 8 + (wi >> 2), k = (kk & ~0xC) | ((kk & 4) << 1) | ((kk & 8) >> 1), c = (sub & 3) * 32 + (wi & 3) * 8;
        voff[i] = (unsigned)(k * LDV * 2 + c * 2); }
#define ATT_STAGE(j, b) do { const int row0_ = tile_row(J, (j)); const char* vp_ = (const char*)(J.V + (size_t)row0_ * LDV); const char* kp_ = (const char*)(J.K + (size_t)row0_ * LDK); \
        _Pragma("unroll") for (int i_ = 0; i_ < C_::KLD; ++i_) __builtin_amdgcn_global_load_lds((const unsigned*)(kp_ + koff[i_]), (ATT_LAS unsigned*)(ldsb + C_::OFF_K + (b) * C_::SHM_K + (512 * i_ + 64 * wid) * 16), 16, 0, 0); \
        _Pragma("unroll") for (int i_ = 0; i_ < 2; ++i_) __builtin_amdgcn_global_load_lds((const unsigned*)(vp_ + voff[i_]), (ATT_LAS unsigned*)(ldsb + C_::OFF_V + (b) * C_::SHM_V + (512 * i_ + 64 * wid) * 16), 16, 0, 0); } while (0)
    const int NT = J.nt;
    __syncthreads();
    ATT_STAGE(0, 0); asm volatile("s_waitcnt vmcnt(0)" ::: "memory"); __syncthreads();
    for (int j = 0; j < NT; ++j) {
        const int buf = j & 1;
        if (j + 1 < NT) ATT_STAGE(j + 1, buf ^ 1);
        f32x16 p0, p1; float mn, al; bf16x8 pa0, pa1, pa2, pa3;
        qkt<DQK>(p0, p1, K_lds + buf * C_::SHM_K, qr, r32, hi);
        if (NA) na_bias(p0, p1, J, j, naR, nac, hi, biasq);
        partialSM(p0, p1, m_reg, mn, al, Cc, thr_raw);
        finishSM(p0, p1, al, l_reg, pa0, pa1, pa2, pa3);
        if (__any(al < 1.f)) { if (hi == 0) al_l[r32] = al; asm volatile("s_waitcnt lgkmcnt(0)" ::: "memory");
#pragma unroll
            for (int d = 0; d < 4; ++d)
#pragma unroll
                for (int r = 0; r < 16; ++r) o[d][r] *= al_l[crow(r, hi)]; }
        ATT_SBAR();
        pv_d0(o, vb0 + buf * C_::SHM_V, pa0, pa1, pa2, pa3);
        asm volatile("s_waitcnt vmcnt(0)" ::: "memory");
        __syncthreads();
    }
    if (hi == 0) li_l[r32] = l_reg; asm volatile("s_waitcnt lgkmcnt(0)" ::: "memory");
    float rli[16];
#pragma unroll
    for (int r = 0; r < 16; ++r) rli[r] = __builtin_amdgcn_rcpf(li_l[crow(r, hi)]);
    bf16_t* Ow = J.O + (long)(wid * QBLK) * LDO;
#pragma unroll
    for (int r = 0; r < 16; ++r) { const int orow = crow(r, hi);
#pragma unroll
        for (int d0 = 0; d0 < 4; ++d0) Ow[(long)orow * LDO + d0 * 32 + r32] = f2bf(o[d0][r] * rli[r]); }
#undef ATT_STAGE
}
}

struct AttnArgs { const bf16_t *QM, *KM, *VM, *NQ, *NK, *P; bf16_t* Y; const float* rpb; int want_ctx; int pad; };
__device__ __forceinline__ void attention_phase(const AttnArgs& A, char* lds, int G, int wg, const int tid) {
    static_assert(GRID_W == 64 && SEQ % 256 == 0 && CTX_LEN == 256 && HD == 128, "attention phase geometry");
    constexpr int NQB = SEQ / 256;
    constexpr float sc_mla = 0.07216878364870323f, sc_na = 0.08838834764831845f;
    static_assert(MLA_QK == 192 && HD == 128, "softmax scales");
    if (!(A.pad & 2)) for (int u = wg; u < BATCH * NH * NQB; u += G) {
        const int bh = u % (BATCH * NH), qb = u / (BATCH * NH), b = bh / NH, h = bh % NH;
        att::Job J{};
        J.Q = A.QM + (size_t)(b * SEQ + qb * 256) * NQ_MLA + h * MLA_QK; J.K = A.KM + h * MLA_QK; J.V = A.VM + h * MLA_V;
        J.O = A.Y + (size_t)(b * SEQ + qb * 256) * D_MODEL + GROUP_W + h * MLA_V;
        J.nt = SEQ / 64 + CTX_LEN / 64; J.seg0_tiles = SEQ / 64; J.row_seg0 = b * SEQ; J.row_seg1 = M_LAT + b * CTX_LEN;
        att::attn_unit<MLA_QK, false, NQ_MLA, NQ_MLA, NH * MLA_V, D_MODEL>(J, lds, sc_mla, tid);
    }
    if (!(A.pad & 4)) for (int u = wg; u < BATCH * NH * NQB; u += G) {
        const int bh = u % (BATCH * NH), qb = u / (BATCH * NH), b = bh / NH, h = bh % NH, R0 = qb * 4;
        __syncthreads();
        { float* bq = (float*)(lds + att::Cfg<HD>::OFF_BIAS); const float* src = A.rpb + (size_t)h * (2 * NA_KH - 1) * (2 * NA_KW - 1);
          for (int i = tid; i < (2 * NA_KH - 1) * att::NA_BROW; i += 512) { const int dr = i / att::NA_BROW; int dc = i % att::NA_BROW - att::NA_BORG + (NA_KW - 1); dc = dc < 0 ? 0 : (dc > 2 * NA_KW - 2 ? 2 * NA_KW - 2 : dc);
              bq[i] = src[dr * (2 * NA_KW - 1) + dc] * 11.313708498984761f; } }
        int rlo = R0 - NA_KH / 2; rlo = rlo < 0 ? 0 : (rlo > ROWS - NA_KH ? ROWS - NA_KH : rlo);
        int rhi = R0 + 3 - NA_KH / 2; rhi = (rhi < 0 ? 0 : (rhi > ROWS - NA_KH ? ROWS - NA_KH : rhi)) + NA_KH - 1;
        const int nloc = rhi - rlo + 1;
        att::Job J{};
        J.Q = A.NQ + (size_t)(b * SEQ + R0 * 64) * GROUP_W + h * HD; J.K = A.NK + h * HD; J.V = A.P + C_NV + h * HD;
        J.O = A.Y + (size_t)(b * SEQ + R0 * 64) * D_MODEL + 3 * GROUP_W + h * HD;
        J.nt = (nloc + 4 + 1) & ~1; J.seg0_tiles = nloc; J.row_seg0 = b * SEQ + rlo * 64; J.row_seg1 = M_LAT + b * CTX_LEN;  J.R0 = R0; J.rlo = rlo;
        att::attn_unit<HD, true, GROUP_W, GROUP_W, NP, D_MODEL>(J, lds, sc_na, tid);
    }
    if (A.want_ctx && !(A.pad & 8)) {
        for (int u = wg; u < BATCH * NH; u += G) {
            const int b = u / NH, h = u % NH; const int crow0 = M_LAT + b * CTX_LEN;
            att::Job J{}; J.nt = CTX_LEN / 64; J.seg0_tiles = 0; J.row_seg0 = crow0; J.row_seg1 = crow0;
            J.Q = A.QM + (size_t)crow0 * NQ_MLA + h * MLA_QK; J.K = A.KM + h * MLA_QK; J.V = A.VM + h * MLA_V;
            J.O = A.Y + (size_t)crow0 * D_MODEL + GROUP_W + h * MLA_V; att::attn_unit<MLA_QK, false, NQ_MLA, NQ_MLA, NH * MLA_V, D_MODEL>(J, lds, sc_mla, tid);
        }
        for (int u = wg - BATCH * NH; u >= 0 && u < BATCH * NH; u += G) {
            const int b = u / NH, h = u % NH; const int crow0 = M_LAT + b * CTX_LEN;
            att::Job J{}; J.nt = CTX_LEN / 64; J.seg0_tiles = 0; J.row_seg0 = crow0; J.row_seg1 = crow0;
            J.Q = A.NQ + (size_t)crow0 * GROUP_W + h * HD; J.K = A.NK + h * HD; J.V = A.P + C_NV + h * HD;
            J.O = A.Y + (size_t)crow0 * D_MODEL + 3 * GROUP_W + h * HD; att::attn_unit<HD, false, GROUP_W, GROUP_W, NP, D_MODEL>(J, lds, sc_na, tid);
        }
    }
}

namespace gdn {
typedef short bf16x8 __attribute__((ext_vector_type(8)));
typedef float f32x4 __attribute__((ext_vector_type(4)));
typedef float f32x16 __attribute__((ext_vector_type(16)));
typedef unsigned u32x2 __attribute__((ext_vector_type(2)));
typedef unsigned u32x4 __attribute__((ext_vector_type(4)));
constexpr int CH = 64, NCHUNK = M_ALL / CH;
constexpr int NTASK = NCHUNK * NH * 2;
constexpr size_t SZ_UT = 128 * 64, SZ_WP = 64 * 128, SZ_KDT = 128 * 64, SZ_QD = 64 * 128, SZ_QK = 64 * 64, SZ_SIT = 128 * 128, SZ_VNT = 128 * 64;
struct Bufs { bf16_t *UT, *WP, *KDT, *QD, *QK, *SIT, *VNT; float* GT; };
__device__ __forceinline__ int perm32(int o) { return (o & ~31) | (((o & 15) >> 2) * 8 + ((o >> 4) & 1) * 4 + (o & 3)); }
__device__ __forceinline__ unsigned pk2(float lo, float hi) { return (unsigned)f2bf(lo) | ((unsigned)f2bf(hi) << 16); }

constexpr int QS = 132;
constexpr int AS = 68;
constexpr int G1_OFF_Q = 0, G1_OFF_K = G1_OFF_Q + CH * QS * 4, G1_OFF_V = G1_OFF_K + CH * QS * 4, G1_OFF_AA = G1_OFF_V + CH * QS * 4, G1_OFF_SM = G1_OFF_AA + 2 * CH * AS * 4,
              G1_LDS = G1_OFF_SM + 8 * 64 * 4;
struct G1Args { const bf16_t* P; const float* conv_w; const float* a_log; const float* dt_bias; Bufs B; };

__device__ __forceinline__ void g1_task(const G1Args& A, char* lds, int cix, int h, const int tid_in) {
    int tid_ = tid_in; asm volatile("" : "+v"(tid_));
    const int tid = tid_, wid = __builtin_amdgcn_readfirstlane(tid >> 6), lane = tid & 63;
    float* Qs = (float*)(lds + G1_OFF_Q); float* Ks = (float*)(lds + G1_OFF_K); float* Vs = (float*)(lds + G1_OFF_V); float* AA = (float*)(lds + G1_OFF_AA);
    float* sm = (float*)(lds + G1_OFF_SM); float* g_s = sm;   float* beta_s = sm + 128;   float* gc_s = sm + 256;
    const int row0 = cix * CH; const RowInfo r0i = row_info(row0);
    __syncthreads();
    if (tid < 48 * 8) {
        const int grp = tid % 48, ts = tid / 48, which = grp >> 4, cc0 = (grp & 15) * 8, ch0 = which * GROUP_W + h * HD + cc0;
        float wgt[4][8];
#pragma unroll
        for (int j = 0; j < 4; ++j) { const f32x4 w0 = *(const f32x4*)(A.conv_w + j * 3 * GROUP_W + ch0), w1 = *(const f32x4*)(A.conv_w + j * 3 * GROUP_W + ch0 + 4);
#pragma unroll
            for (int e = 0; e < 4; ++e) { wgt[j][e] = w0[e]; wgt[j][4 + e] = w1[e]; } }
        u32x4 xr[11];
#pragma unroll
        for (int k = 0; k < 11; ++k) { const int tt = r0i.t + 8 * ts + k - 1;
            xr[k] = (tt >= 0 && tt < r0i.T) ? *(const u32x4*)(A.P + (size_t)(r0i.base + tt) * NP + C_GQ + ch0) : (u32x4){0u, 0u, 0u, 0u}; }
        float* dstp = (which == 0 ? Qs : which == 1 ? Ks : Vs) + cc0;
#pragma unroll
        for (int i = 0; i < 8; ++i) { float acc[8];
#pragma unroll
            for (int e = 0; e < 8; ++e) acc[e] = 0.f;
#pragma unroll
            for (int j = 0; j < 4; ++j) { const u32x4 xv = xr[i + j];
#pragma unroll
                for (int e = 0; e < 4; ++e) { acc[2 * e] += wgt[j][2 * e] * bflo(xv[e]); acc[2 * e + 1] += wgt[j][2 * e + 1] * bfhi(xv[e]); } }
            f32x4 y0, y1;
#pragma unroll
            for (int e = 0; e < 4; ++e) { y0[e] = acc[e] / (1.0f + __expf(-acc[e])); y1[e] = acc[4 + e] / (1.0f + __expf(-acc[4 + e])); }
            *(f32x4*)(dstp + (8 * ts + i) * QS) = y0; *(f32x4*)(dstp + (8 * ts + i) * QS + 4) = y1; }
    }
    if (tid < 128) { const int d = tid >> 6, i = tid & 63; const size_t r = (size_t)(row0 + i) * NP;
        beta_s[d * 64 + i] = 1.0f / (1.0f + __expf(-bf2f(A.P[r + C_GB + d * NH + h])));
        g_s[d * 64 + i] = -__expf(A.a_log[d * NH + h]) * softplusf_(bf2f(A.P[r + C_GA + d * NH + h]) + A.dt_bias[d * NH + h]); }
    __syncthreads();
    for (int rr = wid; rr < 2 * CH; rr += 8) { float* rowp = (rr < CH ? Qs : Ks) + (rr & 63) * QS;
        const float a = rowp[lane], b = rowp[lane + 64]; float ss = a * a + b * b;
#pragma unroll
        for (int o = 1; o < 64; o <<= 1) ss += lane_xor(ss, o, lane);
        const float scl = (1.0f / sqrtf(ss + EPS)) * (rr < CH ? 0.08838834764831845f : 1.0f);
        rowp[lane] = a * scl; rowp[lane + 64] = b * scl; }
    if (tid < 2) {
        f32x4 gv[16];
#pragma unroll
        for (int m = 0; m < 16; ++m) gv[m] = *(const f32x4*)(g_s + tid * 64 + 4 * m);
        float run = 0.f;
        if (tid == 0) {
#pragma unroll
            for (int m = 0; m < 16; ++m) { f32x4 o4;
#pragma unroll
                for (int e = 0; e < 4; ++e) { run += gv[m][e]; o4[e] = run; }
                *(f32x4*)(gc_s + 4 * m) = o4; }
        } else {
#pragma unroll
            for (int m = 15; m >= 0; --m) { f32x4 o4;
#pragma unroll
                for (int e = 3; e >= 0; --e) { run += gv[m][e]; o4[e] = run; }
                *(f32x4*)(gc_s + 64 + 4 * m) = o4; }
        }
    }
    __syncthreads();
    {
        const int which = wid >> 2, I = (wid >> 1) & 1, J = wid & 1, r32 = lane & 31, hi = lane >> 5;
        const float* X = (which ? Qs : Ks) + (32 * I + r32) * QS + 4 * hi; const float* Yp = Ks + (32 * J + r32) * QS + 4 * hi;
        f32x16 acc = {};
#pragma unroll
        for (int s = 0; s < 16; ++s) { const f32x4 a4 = *(const f32x4*)(X + 8 * s), b4 = *(const f32x4*)(Yp + 8 * s);
#pragma unroll
            for (int e = 0; e < 4; ++e) acc = __builtin_amdgcn_mfma_f32_32x32x2f32(a4[e], b4[e], acc, 0, 0, 0); }
        const int j = 32 * J + r32;
        const size_t t0 = ((size_t)cix * NH + h) * 2;
        if (which == 0) {
            const float b1j = beta_s[64 + j], g0j = gc_s[j], g1j = gc_s[64 + j];
#pragma unroll
            for (int r = 0; r < 16; ++r) { const int i = 32 * I + (r & 3) + 8 * (r >> 2) + 4 * hi;
                if (i > j) { const float kk = acc[r];
                    AA[(63 - j) * AS + (63 - i)] = beta_s[i] * kk * __expf(gc_s[i] - g0j);
                    AA[CH * AS + i * AS + j] = b1j * kk * __expf(g1j - gc_s[64 + i]); } }
        } else {
            bf16_t* q0 = A.B.QK + (t0 + 0) * SZ_QK; bf16_t* q1 = A.B.QK + (t0 + 1) * SZ_QK;
            const float g0j = gc_s[j], g1j = gc_s[64 + j];
#pragma unroll
            for (int r = 0; r < 16; ++r) { const int i = 32 * I + (r & 3) + 8 * (r >> 2) + 4 * hi; const float qk = acc[r];
                q0[i * 64 + perm32(j)] = f2bf(i >= j ? qk * __expf(gc_s[i] - g0j) : 0.f);
                q1[(63 - i) * 64 + perm32(63 - j)] = f2bf(i <= j ? qk * __expf(gc_s[64 + i] - g1j) : 0.f); }
        }
    }
    __syncthreads();
    {
        const size_t t0 = ((size_t)cix * NH + h) * 2;
        const int d = tid >> 8, k = tid & 127, ph = (tid >> 7) & 1;
        bf16_t* qd = A.B.QD + (t0 + d) * SZ_QD; bf16_t* kdt = A.B.KDT + (t0 + d) * SZ_KDT + (size_t)k * 64;
        const float glast = d == 0 ? gc_s[63] : gc_s[64 + 0];
#pragma unroll 8
        for (int pp = 0; pp < 32; ++pp) { const int p = ph * 32 + pp, i = d == 0 ? p : 63 - p; const float gci = gc_s[d * 64 + i];
            qd[p * 128 + perm32(k)] = f2bf(Qs[i * QS + k] * __expf(gci));
            kdt[perm32(p)] = f2bf(Ks[i * QS + k] * __expf(glast - gci)); }
        if (tid == 0) { A.B.GT[t0] = __expf(gc_s[63]); A.B.GT[t0 + 1] = __expf(gc_s[64]); }
    }
    __syncthreads();
    {
        int tidv = tid; asm volatile("" : "+v"(tidv));
        const int d = tidv >> 8, c = tidv & 255; const bool isw = c >= 128; const int cc = c & 127;
        const float* src = isw ? Ks : Vs;
        int lz; asm volatile("v_mov_b32 %0, 0" : "=v"(lz));
        const float* AAv = AA + lz + d * (CH * AS);
        float x[CH];
#pragma unroll
        for (int p = 0; p < CH; ++p) { const int i = d == 0 ? p : 63 - p; float f = beta_s[d * 64 + i]; if (isw) f *= __expf(gc_s[d * 64 + i]); x[p] = f * src[i * QS + cc]; }
        {
#pragma unroll
            for (int p = 0; p < CH - 1; ++p) { const float xp = x[p]; const float* rowp = AAv + (63 - p) * AS;
#pragma unroll
                for (int m = 0; m <= (62 - p) / 4; ++m) { const f32x4 a4 = *(const f32x4*)(rowp + 4 * m);
#pragma unroll
                    for (int e = 0; e < 4; ++e) { const int col = 4 * m + e; if (col <= 62 - p) x[63 - col] -= a4[e] * xp; } } }
        }
        const size_t t = ((size_t)cix * NH + h) * 2 + d;
        if (!isw) { bf16_t* dst = A.B.UT + t * SZ_UT + (size_t)((cc >> 4) * 2 * 64 + (cc & 15)) * 8;
#pragma unroll
            for (int s = 0; s < 2; ++s)
#pragma unroll
                for (int qq = 0; qq < 4; ++qq) { const int p0 = 32 * s + 4 * qq; u32x4 w4; w4.x = pk2(x[p0], x[p0 + 1]); w4.y = pk2(x[p0 + 2], x[p0 + 3]); w4.z = pk2(x[p0 + 16], x[p0 + 17]); w4.w = pk2(x[p0 + 18], x[p0 + 19]);
                    *(u32x4*)(dst + (size_t)(s * 64 + qq * 16) * 8) = w4; }
        } else { bf16_t* dst = A.B.WP + t * SZ_WP + perm32(cc);
#pragma unroll
            for (int p = 0; p < CH; ++p) dst[p * 128] = f2bf(x[p]); }
    }
}
__device__ __forceinline__ void g1_phase(const G1Args& A, char* lds, int G, int wg, const int tid) {
    for (int t = wg; t < NCHUNK * NH; t += G) g1_task(A, lds, t / NH, t % NH, tid);
}

constexpr int G2_SPLIT = 4, G2_NACT = 8 / G2_SPLIT;
constexpr int G2_USL = G2_NACT * 2 * 64 * 16;
constexpr int G2_BUF = 16384 + 16384 + G2_USL, G2_NB = 4, G2_LDS = G2_NB * G2_BUF;
static_assert(G2_SPLIT == 4 && G2_USL == 4096, "G2 staging map below assumes 4 KB of u per step");
__device__ __forceinline__ int g2_task_index(int b, int h, int d, int step) {
    constexpr int NC = CTX_LEN / CH, NL = SEQ / CH; int cix;
    if (step < NC) { const int n = d ? NC - 1 - step : step; cix = M_LAT / CH + b * NC + n; }
    else { const int s2 = step - NC, n = d ? NL - 1 - s2 : s2; cix = b * NL + n; }
    return (cix * NH + h) * 2 + d;
}
__device__ __forceinline__ void g2_chain(const Bufs& B, char* lds, int chain_part, const int tid_in) {
    int tid_ = tid_in; asm volatile("" : "+v"(tid_));
    const int tid = tid_, wid = __builtin_amdgcn_readfirstlane(tid >> 6), lane = tid & 63, q = lane >> 4, vl = lane & 15;
    const int chain = chain_part / G2_SPLIT, part = chain_part % G2_SPLIT;
    const bool active = wid < G2_NACT; const int vt = part * G2_NACT + (active ? wid : 0);
    const int d = chain & 1, h = (chain >> 1) % NH, b = chain / (2 * NH);
    constexpr int NSTEP = CTX_LEN / CH + SEQ / CH;
    const unsigned ldsb = (unsigned)(uintptr_t)lds;
    f32x4 S[8];
#pragma unroll
    for (int kb = 0; kb < 8; ++kb) S[kb] = (f32x4){0.f, 0.f, 0.f, 0.f};
    unsigned offw[2], offk[2], offu;
#pragma unroll
    for (int i = 0; i < 2; ++i) { const int sl = 128 * wid + 64 * i + lane;
        { const int row = sl >> 4, pc = sl & 15, c = pc ^ (row & 15); offw[i] = (unsigned)(row * 256 + c * 16); }
        { const int row = sl >> 3, pc = sl & 7, c = pc ^ ((row >> 1) & 7); offk[i] = (unsigned)(row * 128 + c * 16); } }
    offu = (unsigned)((part * G2_NACT * 2 * 64 + (wid & 3) * 64 + lane) * 16);
#define G2_DMA(ti, slot) do { const char* wp_ = (const char*)(B.WP + (size_t)(ti) * SZ_WP); const char* kp_ = (const char*)(B.KDT + (size_t)(ti) * SZ_KDT); const unsigned base_ = ldsb + (unsigned)(slot) * G2_BUF; \
        _Pragma("unroll") for (int i_ = 0; i_ < 2; ++i_) { \
            __builtin_amdgcn_global_load_lds((const unsigned*)(wp_ + offw[i_]), (ATT_LAS unsigned*)(base_ + (128 * wid + 64 * i_) * 16), 16, 0, 0); \
            __builtin_amdgcn_global_load_lds((const unsigned*)(kp_ + offk[i_]), (ATT_LAS unsigned*)(base_ + 16384 + (128 * wid + 64 * i_) * 16), 16, 0, 0); } \
        if (wid >= 4) __builtin_amdgcn_global_load_lds((const unsigned*)((const char*)(B.UT + (size_t)(ti) * SZ_UT) + offu), (ATT_LAS unsigned*)(base_ + 32768 + ((wid & 3) * 64) * 16), 16, 0, 0); } while (0)
#define G2_TI(step) g2_task_index(b, h, d, (step) < NSTEP ? (step) : NSTEP - 1)
    __syncthreads();
    G2_DMA(G2_TI(0), 0); G2_DMA(G2_TI(1), 1); G2_DMA(G2_TI(2), 2);
    asm volatile("s_waitcnt vmcnt(0)" ::: "memory");
    __syncthreads();
    for (int step = 0; step < NSTEP; ++step) {
        const int ti = G2_TI(step), slot = step & 3;
        G2_DMA(G2_TI(step + 3), (step + 3) & 3);
        unsigned gtb; { const float* gp = B.GT + ti; asm volatile("s_load_dword %0, %1, 0x0" : "=s"(gtb) : "s"(gp)); }
        const char* wl = lds + slot * G2_BUF; const char* kl = wl + 16384; const char* ul = kl + 16384;
        if (active) {
            bf16x8 aw[16], ak[16];
#pragma unroll
            for (int rb = 0; rb < 4; ++rb)
#pragma unroll
                for (int s = 0; s < 4; ++s) aw[rb * 4 + s] = *(const bf16x8*)(wl + (16 * rb + vl) * 256 + (((4 * s + q) ^ vl) << 4));
#pragma unroll
            for (int kb = 0; kb < 8; ++kb)
#pragma unroll
                for (int s = 0; s < 2; ++s) ak[kb * 2 + s] = *(const bf16x8*)(kl + (16 * kb + vl) * 128 + (((4 * s + q) ^ ((vl >> 1) & 7)) << 4));
            u32x4 uu[2];
#pragma unroll
            for (int s = 0; s < 2; ++s) uu[s] = *(const u32x4*)(ul + ((wid * 2 + s) * 64 + lane) * 16);
            bf16_t* sit = B.SIT + (size_t)ti * SZ_SIT + (size_t)(vt * 4 * 64 + lane) * 8;
            bf16x8 sf[4];
#pragma unroll
            for (int s = 0; s < 4; ++s) { u32x4 w4; w4.x = pk2(S[2 * s][0], S[2 * s][1]); w4.y = pk2(S[2 * s][2], S[2 * s][3]); w4.z = pk2(S[2 * s + 1][0], S[2 * s + 1][1]); w4.w = pk2(S[2 * s + 1][2], S[2 * s + 1][3]);
                sf[s] = __builtin_bit_cast(bf16x8, w4); *(u32x4*)(sit + (size_t)s * 64 * 8) = w4; }
            __builtin_amdgcn_sched_barrier(0);
            f32x4 vn[4];
#pragma unroll
            for (int rb = 0; rb < 4; ++rb) vn[rb] = (f32x4){0.f, 0.f, 0.f, 0.f};
#pragma unroll
            for (int s = 0; s < 4; ++s)
#pragma unroll
                for (int rb = 0; rb < 4; ++rb) vn[rb] = __builtin_amdgcn_mfma_f32_16x16x32_bf16(aw[rb * 4 + s], sf[s], vn[rb], 0, 0, 0);
#pragma unroll
            for (int s = 0; s < 2; ++s) { const f32x4 a0 = vn[2 * s], a1 = vn[2 * s + 1];
                vn[2 * s][0] = bflo(uu[s].x) - a0[0]; vn[2 * s][1] = bfhi(uu[s].x) - a0[1]; vn[2 * s][2] = bflo(uu[s].y) - a0[2]; vn[2 * s][3] = bfhi(uu[s].y) - a0[3];
                vn[2 * s + 1][0] = bflo(uu[s].z) - a1[0]; vn[2 * s + 1][1] = bfhi(uu[s].z) - a1[1]; vn[2 * s + 1][2] = bflo(uu[s].w) - a1[2]; vn[2 * s + 1][3] = bfhi(uu[s].w) - a1[3]; }
            bf16_t* vnt = B.VNT + (size_t)ti * SZ_VNT + (size_t)(vt * 2 * 64 + lane) * 8;
            bf16x8 vf[2];
#pragma unroll
            for (int s = 0; s < 2; ++s) { u32x4 w4; w4.x = pk2(vn[2 * s][0], vn[2 * s][1]); w4.y = pk2(vn[2 * s][2], vn[2 * s][3]); w4.z = pk2(vn[2 * s + 1][0], vn[2 * s + 1][1]); w4.w = pk2(vn[2 * s + 1][2], vn[2 * s + 1][3]);
                vf[s] = __builtin_bit_cast(bf16x8, w4); *(u32x4*)(vnt + (size_t)s * 64 * 8) = w4; }
            asm volatile("s_waitcnt lgkmcnt(0)" ::: "memory");
            const float gt = __uint_as_float(gtb);
#pragma unroll
            for (int kb = 0; kb < 8; ++kb) S[kb] = S[kb] * gt;
#pragma unroll
            for (int s = 0; s < 2; ++s)
#pragma unroll
                for (int kb = 0; kb < 8; ++kb) S[kb] = __builtin_amdgcn_mfma_f32_16x16x32_bf16(ak[kb * 2 + s], vf[s], S[kb], 0, 0, 0);
            __builtin_amdgcn_sched_barrier(0);
            asm volatile("s_waitcnt vmcnt(26) lgkmcnt(0)\n\ts_barrier" ::: "memory");
        } else if (wid >= 4) {
            asm volatile("s_waitcnt vmcnt(10) lgkmcnt(0)\n\ts_barrier" ::: "memory");
        } else {
            asm volatile("s_waitcnt vmcnt(8) lgkmcnt(0)\n\ts_barrier" ::: "memory");
        }
    }
    asm volatile("s_waitcnt vmcnt(0)" ::: "memory");
    __syncthreads();
#undef G2_DMA
#undef G2_TI
}

constexpr int G3_LDS = 8 * 64 * 4 * 2;
struct G3Args { Bufs B; const bf16_t* P; const float* norm_g; bf16_t* Y; };
__device__ __forceinline__ void g3_task(const G3Args& A, char* lds, int cix, int h, const int tid_in) {
    int tid_ = tid_in; asm volatile("" : "+v"(tid_));
    const int tid = tid_, wid = __builtin_amdgcn_readfirstlane(tid >> 6), lane = tid & 63, q = lane >> 4, vl = lane & 15;
    float* part = (float*)lds;
    f32x4 o[2][4];
#pragma unroll
    for (int d = 0; d < 2; ++d) {
        const size_t t = ((size_t)cix * NH + h) * 2 + d;
        const bf16_t* sit = A.B.SIT + t * SZ_SIT + (size_t)(wid * 4 * 64 + lane) * 8;
        const bf16_t* vnt = A.B.VNT + t * SZ_VNT + (size_t)(wid * 2 * 64 + lane) * 8;
        const bf16_t* qd = A.B.QD + t * SZ_QD + (size_t)vl * 128 + 8 * q;
        const bf16_t* qk = A.B.QK + t * SZ_QK + (size_t)vl * 64 + 8 * q;
        bf16x8 sf[4], vf[2];
#pragma unroll
        for (int s = 0; s < 4; ++s) sf[s] = *(const bf16x8*)(sit + (size_t)s * 64 * 8);
#pragma unroll
        for (int s = 0; s < 2; ++s) vf[s] = *(const bf16x8*)(vnt + (size_t)s * 64 * 8);
#pragma unroll
        for (int rb = 0; rb < 4; ++rb) { f32x4 acc = {0.f, 0.f, 0.f, 0.f};
#pragma unroll
            for (int s = 0; s < 4; ++s) acc = __builtin_amdgcn_mfma_f32_16x16x32_bf16(*(const bf16x8*)(qd + (size_t)rb * 16 * 128 + 32 * s), sf[s], acc, 0, 0, 0);
#pragma unroll
            for (int s = 0; s < 2; ++s) acc = __builtin_amdgcn_mfma_f32_16x16x32_bf16(*(const bf16x8*)(qk + (size_t)rb * 16 * 64 + 32 * s), vf[s], acc, 0, 0, 0);
            o[d][rb] = acc; }
    }
    f32x4 ot[4];
#pragma unroll
    for (int rb = 0; rb < 4; ++rb)
#pragma unroll
        for (int r = 0; r < 4; ++r) ot[rb][r] = o[0][rb][r] + lane_xor(o[1][3 - rb][3 - r], 48, lane);
    __syncthreads();
#pragma unroll
    for (int rb = 0; rb < 4; ++rb)
#pragma unroll
        for (int r = 0; r < 4; ++r) { float ss = ot[rb][r] * ot[rb][r];
#pragma unroll
            for (int of = 1; of < 16; of <<= 1) ss += lane_xor(ss, of, lane);
            if (vl == 0) part[wid * 64 + 16 * rb + 4 * q + r] = ss; }
    __syncthreads();
    const int v = 16 * wid + vl; const float ng = A.norm_g[v];
#pragma unroll
    for (int rb = 0; rb < 4; ++rb)
#pragma unroll
        for (int r = 0; r < 4; ++r) { const int tok = 16 * rb + 4 * q + r; float ss = 0.f;
#pragma unroll
            for (int w8 = 0; w8 < 8; ++w8) ss += part[w8 * 64 + tok];
            const float rstd = 1.0f / sqrtf(ss * (1.0f / HD) + EPS);
            const size_t row = (size_t)cix * CH + tok; const float gate = bf2f(A.P[row * NP + C_GG + h * HD + v]);
            A.Y[row * D_MODEL + 2 * GROUP_W + h * HD + v] = f2bf(ot[rb][r] * rstd * ng * (gate / (1.0f + __expf(-gate)))); }
}
__device__ __forceinline__ void g3_phase(const G3Args& A, char* lds, int G, int wg, const int tid) {
    for (int t = wg; t < NCHUNK * NH; t += G) g3_task(A, lds, t / NH, t % NH, tid);
}
}

namespace lru {
typedef short bf16x8 __attribute__((ext_vector_type(8)));
typedef float f32x4 __attribute__((ext_vector_type(4)));
typedef unsigned u32x2 __attribute__((ext_vector_type(2)));
typedef unsigned u32x4 __attribute__((ext_vector_type(4)));
constexpr int CH = 64, NCHUNK = M_ALL / CH;
constexpr int US = 129;
constexpr int UBS = 272;
constexpr int L_OFF_U = 0, L_OFF_UB = CH * US * 4, L_LDS = L_OFF_UB + CH * UBS;
constexpr size_t SZ_WBLK = (size_t)LRU_BW * LRU_BW;
struct Bufs { bf16_t* HLOC; bf16_t* ACUM; float* LSUM; float* HIN; };
struct LocalArgs { const bf16_t* P; const float* conv_w; const float* conv_b; const bf16_t* WG;   const float* ba; const float* bx; const float* lam; Bufs B; };

__device__ __forceinline__ unsigned pk2(float lo, float hi) { return (unsigned)f2bf(lo) | ((unsigned)f2bf(hi) << 16); }

__device__ __forceinline__ void local_task(const LocalArgs& A, char* lds, int cix, int nb, const int tid_in) {
    int tid_ = tid_in; asm volatile("" : "+v"(tid_));
    const int tid = tid_, wid = __builtin_amdgcn_readfirstlane(tid >> 6), lane = tid & 63, q = lane >> 4, tl = lane & 15;
    float* Us = (float*)(lds + L_OFF_U); char* Ub = lds + L_OFF_UB;
    const int row0 = cix * CH; const RowInfo r0i = row_info(row0);
    __syncthreads();
    {
        const int grp = tid & 15, t2 = tid >> 4, c0 = grp * 8, ch0 = nb * LRU_BW + c0;
        float wgt[4][8], bia[8];
#pragma unroll
        for (int j = 0; j < 4; ++j) { const f32x4 w0 = *(const f32x4*)(A.conv_w + j * LRU_W + ch0), w1 = *(const f32x4*)(A.conv_w + j * LRU_W + ch0 + 4);
#pragma unroll
            for (int e = 0; e < 4; ++e) { wgt[j][e] = w0[e]; wgt[j][4 + e] = w1[e]; } }
        { const f32x4 b0 = *(const f32x4*)(A.conv_b + ch0), b1 = *(const f32x4*)(A.conv_b + ch0 + 4);
#pragma unroll
          for (int e = 0; e < 4; ++e) { bia[e] = b0[e]; bia[4 + e] = b1[e]; } }
        u32x4 xr[5];
#pragma unroll
        for (int k = 0; k < 5; ++k) { const int tt = r0i.t + 2 * t2 + k - 1;
            xr[k] = (tt >= 0 && tt < r0i.T) ? *(const u32x4*)(A.P + (size_t)(r0i.base + tt) * NP + C_LRU_X + ch0) : (u32x4){0u, 0u, 0u, 0u}; }
#pragma unroll
        for (int i = 0; i < 2; ++i) { float acc[8];
#pragma unroll
            for (int e = 0; e < 8; ++e) acc[e] = bia[e];
#pragma unroll
            for (int j = 0; j < 4; ++j) { const u32x4 xv = xr[i + j];
#pragma unroll
                for (int e = 0; e < 4; ++e) { acc[2 * e] += wgt[j][2 * e] * bflo(xv[e]); acc[2 * e + 1] += wgt[j][2 * e + 1] * bfhi(xv[e]); } }
            const int tok = 2 * t2 + i;
#pragma unroll
            for (int e = 0; e < 8; ++e) Us[tok * US + c0 + e] = acc[e];
            *(u32x4*)(Ub + tok * UBS + c0 * 2) = (u32x4){pk2(acc[0], acc[1]), pk2(acc[2], acc[3]), pk2(acc[4], acc[5]), pk2(acc[6], acc[7])}; }
    }
    __syncthreads();
    f32x4 acc[2][2][4];
#pragma unroll
    for (int d = 0; d < 2; ++d)
#pragma unroll
        for (int wh = 0; wh < 2; ++wh)
#pragma unroll
            for (int tb = 0; tb < 4; ++tb) acc[d][wh][tb] = (f32x4){0.f, 0.f, 0.f, 0.f};
#pragma unroll
    for (int s = 0; s < 4; ++s) {
        bf16x8 bfr[4];
#pragma unroll
        for (int tb = 0; tb < 4; ++tb) bfr[tb] = *(const bf16x8*)(Ub + (16 * tb + tl) * UBS + (32 * s + 8 * q) * 2);
#pragma unroll
        for (int d = 0; d < 2; ++d)
#pragma unroll
            for (int wh = 0; wh < 2; ++wh) { const bf16x8 a = *(const bf16x8*)(A.WG + ((size_t)((d * 2 + wh) * NH + nb)) * SZ_WBLK + (size_t)(16 * wid + tl) * LRU_BW + 32 * s + 8 * q);
#pragma unroll
                for (int tb = 0; tb < 4; ++tb) acc[d][wh][tb] = __builtin_amdgcn_mfma_f32_16x16x32_bf16(a, bfr[tb], acc[d][wh][tb], 0, 0, 0); }
    }
    const int chb = nb * LRU_BW + 16 * wid + 4 * q;
#pragma unroll
    for (int d = 0; d < 2; ++d) {
        float sp[4], bav[4], bxv[4];
#pragma unroll
        for (int r = 0; r < 4; ++r) { sp[r] = -LRU_C * softplusf_(-A.lam[d * LRU_W + chb + r]); bav[r] = A.ba[d * LRU_W + chb + r]; bxv[r] = A.bx[d * LRU_W + chb + r]; }
        float Ac[4], Bc[4];
#pragma unroll
        for (int r = 0; r < 4; ++r) { Ac[r] = 1.f; Bc[r] = 0.f; }
#pragma unroll
        for (int tbi = 0; tbi < 4; ++tbi) { const int tb = d == 0 ? tbi : 3 - tbi; const int tok = 16 * tb + tl;
            float a[4], b[4];
#pragma unroll
            for (int r = 0; r < 4; ++r) { const float rr = 1.0f / (1.0f + __expf(-(acc[d][0][tb][r] + bav[r]))), ii = 1.0f / (1.0f + __expf(-(acc[d][1][tb][r] + bxv[r])));
                const float log_a = sp[r] * rr; a[r] = __expf(log_a); b[r] = sqrtf(-expm1f(2.0f * log_a)) * ii * Us[tok * US + 16 * wid + 4 * q + r]; }
#pragma unroll
            for (int off = 1; off < 16; off <<= 1) {
#pragma unroll
                for (int r = 0; r < 4; ++r) { const int src = d == 0 ? tl - off : tl + off; const bool ok = d == 0 ? (tl >= off) : (tl + off < 16);
                    const int sl = (lane & ~15) | (src & 15); const float ap = lane_get(a[r], sl), bp = lane_get(b[r], sl);
                    if (ok) { b[r] = a[r] * bp + b[r]; a[r] = a[r] * ap; } } }
#pragma unroll
            for (int r = 0; r < 4; ++r) { b[r] = a[r] * Bc[r] + b[r]; a[r] = a[r] * Ac[r]; }
            { const size_t o = ((size_t)d * M_ALL + row0 + tok) * LRU_W + chb;
              *(u32x2*)(A.B.HLOC + o) = (u32x2){pk2(b[0], b[1]), pk2(b[2], b[3])}; *(u32x2*)(A.B.ACUM + o) = (u32x2){pk2(a[0], a[1]), pk2(a[2], a[3])}; }
#pragma unroll
            for (int r = 0; r < 4; ++r) { const int sl = (lane & ~15) | (d == 0 ? 15 : 0); Ac[r] = lane_get(a[r], sl); Bc[r] = lane_get(b[r], sl); }
        }
        if (tl == 0) { float* ls = A.B.LSUM + (((size_t)cix * 2 + d) * 2) * LRU_W + chb;
            *(f32x4*)ls = (f32x4){Ac[0], Ac[1], Ac[2], Ac[3]}; *(f32x4*)(ls + LRU_W) = (f32x4){Bc[0], Bc[1], Bc[2], Bc[3]}; }
    }
}
__device__ __forceinline__ void local_phase(const LocalArgs& A, char* lds, int G, int wg, const int tid) {
    for (int t = wg; t < NCHUNK * NH; t += G) local_task(A, lds, t / NH, t % NH, tid);
}
__device__ __forceinline__ void carry_phase(const Bufs& B, int gtid, int gthreads) {
    constexpr int NC = CTX_LEN / CH, NL = SEQ / CH;
    for (int i = gtid; i < BATCH * 2 * LRU_W; i += gthreads) { const int ch = i % LRU_W, d = (i / LRU_W) & 1, b = i / (2 * LRU_W);
        float h = 0.f;
        for (int s0 = 0; s0 < NC + NL; s0 += 12) {
            float av[12], bv[12]; int cx[12];
#pragma unroll
            for (int u = 0; u < 12; ++u) { const int step = s0 + u; int cix = 0;
                if (step < NC) { const int n = d ? NC - 1 - step : step; cix = M_LAT / CH + b * NC + n; }
                else if (step < NC + NL) { const int s2 = step - NC, n = d ? NL - 1 - s2 : s2; cix = b * NL + n; }
                cx[u] = cix; const float* ls = B.LSUM + (((size_t)cix * 2 + d) * 2) * LRU_W + ch; av[u] = ls[0]; bv[u] = ls[LRU_W]; }
#pragma unroll
            for (int u = 0; u < 12; ++u) if (s0 + u < NC + NL) { B.HIN[((size_t)cx[u] * 2 + d) * LRU_W + ch] = h; h = av[u] * h + bv[u]; }
        }
    }
}
__device__ __forceinline__ void finish_phase(const Bufs& B, const bf16_t* P, bf16_t* Y, int gtid, int gthreads) {
    for (int it = gtid; it < M_ALL * (LRU_W / 8); it += gthreads) { const int row = it / (LRU_W / 8), c0 = (it % (LRU_W / 8)) * 8, cix = row / CH;
        const u32x4 h0 = *(const u32x4*)(B.HLOC + (size_t)row * LRU_W + c0), a0 = *(const u32x4*)(B.ACUM + (size_t)row * LRU_W + c0);
        const u32x4 h1 = *(const u32x4*)(B.HLOC + ((size_t)M_ALL + row) * LRU_W + c0), a1 = *(const u32x4*)(B.ACUM + ((size_t)M_ALL + row) * LRU_W + c0);
        const u32x4 gt = *(const u32x4*)(P + (size_t)row * NP + C_LRU_G + c0);
        const float* i0 = B.HIN + ((size_t)cix * 2 + 0) * LRU_W + c0; const float* i1 = B.HIN + ((size_t)cix * 2 + 1) * LRU_W + c0;
        const f32x4 i0a = *(const f32x4*)i0, i0b = *(const f32x4*)(i0 + 4), i1a = *(const f32x4*)i1, i1b = *(const f32x4*)(i1 + 4);
        float y[8];
#pragma unroll
        for (int j = 0; j < 4; ++j) { const unsigned hw0 = h0[j], aw0 = a0[j], hw1 = h1[j], aw1 = a1[j], gw = gt[j];
            const float in0l = j < 2 ? i0a[2 * j] : i0b[2 * j - 4], in0h = j < 2 ? i0a[2 * j + 1] : i0b[2 * j - 3], in1l = j < 2 ? i1a[2 * j] : i1b[2 * j - 4], in1h = j < 2 ? i1a[2 * j + 1] : i1b[2 * j - 3];
            y[2 * j] = (bflo(hw0) + bflo(aw0) * in0l + bflo(hw1) + bflo(aw1) * in1l) * geluf_(bflo(gw));
            y[2 * j + 1] = (bfhi(hw0) + bfhi(aw0) * in0h + bfhi(hw1) + bfhi(aw1) * in1h) * geluf_(bfhi(gw)); }
        *(u32x4*)(Y + (size_t)row * D_MODEL + c0) = (u32x4){pk2(y[0], y[1]), pk2(y[2], y[3]), pk2(y[4], y[5]), pk2(y[6], y[7])};
    }
}
}

namespace misc {
typedef float f32x4 __attribute__((ext_vector_type(4)));
typedef unsigned u32x2 __attribute__((ext_vector_type(2)));
typedef unsigned u32x4 __attribute__((ext_vector_type(4)));
__device__ __forceinline__ unsigned pk2(float lo, float hi) { return (unsigned)f2bf(lo) | ((unsigned)f2bf(hi) << 16); }
__device__ __forceinline__ float wave_sum(float v, int lane) {
#pragma unroll
    for (int o = 1; o < 64; o <<= 1) v += lane_xor(v, o, lane);
    return v;
}
__device__ __forceinline__ float sum16(float v, int lane) {
#pragma unroll
    for (int o = 1; o < 16; o <<= 1) v += lane_xor(v, o, lane);
    return v;
}
__device__ __forceinline__ void norm_phase(const float* H, const float* g, const float* MODl, int sh_idx, bf16_t* U, int nrows, int gwave, int nwaves, int lane) {
    static_assert(D_MODEL == 2048, "norm_phase geometry");
    for (int r = gwave; r < nrows; r += nwaves) {
        const int set = r < M_LAT ? r / SEQ : BATCH;
        const f32x4* hr = (const f32x4*)(H + (size_t)r * D_MODEL) + lane;
        f32x4 v[8]; float ss = 0.f;
#pragma unroll
        for (int j = 0; j < 8; ++j) { v[j] = hr[64 * j]; ss += (v[j][0] * v[j][0] + v[j][1] * v[j][1]) + (v[j][2] * v[j][2] + v[j][3] * v[j][3]); }
        const float rstd = 1.0f / sqrtf(wave_sum(ss, lane) * (1.0f / D_MODEL) + EPS);
        const f32x4* gp = (const f32x4*)g + lane; const f32x4* shp = (const f32x4*)(MODl + (size_t)set * NMODV + (size_t)sh_idx * D_MODEL) + lane; const f32x4* scp = shp + D_MODEL / 4;
        u32x2* o = (u32x2*)(U + (size_t)r * D_MODEL) + lane;
#pragma unroll
        for (int j = 0; j < 8; ++j) { const f32x4 gg = gp[64 * j], sh = shp[64 * j], sc = scp[64 * j]; f32x4 y;
#pragma unroll
            for (int e = 0; e < 4; ++e) y[e] = v[j][e] * rstd * gg[e] * (1.0f + sc[e]) + sh[e];
            o[64 * j] = (u32x2){pk2(y[0], y[1]), pk2(y[2], y[3])}; }
    }
}
struct RowNormArgs { const bf16_t* P; const float *qa_g, *kva_g, *na_qn_g, *na_kn_g; bf16_t *CQN, *CKVN, *NQ, *NK; };
__device__ __forceinline__ void rownorm_phase(const RowNormArgs& A, int gwave, int nwaves, int lane) {
    static_assert(MLA_Q_LORA == 384 && MLA_KV_LORA == 256 && GROUP_W == 512 && HD == 128, "rownorm geometry");
    for (int r = gwave; r < M_ALL; r += nwaves) { const bf16_t* p = A.P + (size_t)r * NP;
        { float x[6], ss = 0.f;
#pragma unroll
          for (int j = 0; j < 3; ++j) { const unsigned w = *(const unsigned*)(p + C_CQ + 2 * lane + 128 * j); x[2 * j] = bflo(w); x[2 * j + 1] = bfhi(w); ss += x[2 * j] * x[2 * j] + x[2 * j + 1] * x[2 * j + 1]; }
          const float rstd = 1.0f / sqrtf(wave_sum(ss, lane) * (1.0f / MLA_Q_LORA) + EPS);
#pragma unroll
          for (int j = 0; j < 3; ++j) { const int c = 2 * lane + 128 * j; *(unsigned*)(A.CQN + (size_t)r * MLA_Q_LORA + c) = pk2(x[2 * j] * rstd * A.qa_g[c], x[2 * j + 1] * rstd * A.qa_g[c + 1]); } }
        { float x[4], ss = 0.f;
#pragma unroll
          for (int j = 0; j < 2; ++j) { const unsigned w = *(const unsigned*)(p + C_CKV + 2 * lane + 128 * j); x[2 * j] = bflo(w); x[2 * j + 1] = bfhi(w); ss += x[2 * j] * x[2 * j] + x[2 * j + 1] * x[2 * j + 1]; }
          const float rstd = 1.0f / sqrtf(wave_sum(ss, lane) * (1.0f / MLA_KV_LORA) + EPS);
#pragma unroll
          for (int j = 0; j < 2; ++j) { const int c = 2 * lane + 128 * j; *(unsigned*)(A.CKVN + (size_t)r * MLA_KV_LORA + c) = pk2(x[2 * j] * rstd * A.kva_g[c], x[2 * j + 1] * rstd * A.kva_g[c + 1]); } }
#pragma unroll
        for (int which = 0; which < 2; ++which) {
            const int hh = lane >> 4, d0 = (lane & 15) * 8; const u32x4 w = *(const u32x4*)(p + (which == 0 ? C_NQ : C_NK) + hh * HD + d0);
            float x[8]; float ss = 0.f;
#pragma unroll
            for (int j = 0; j < 4; ++j) { x[2 * j] = bflo(w[j]); x[2 * j + 1] = bfhi(w[j]); ss += x[2 * j] * x[2 * j] + x[2 * j + 1] * x[2 * j + 1]; }
            const float rstd = 1.0f / sqrtf(sum16(ss, lane) * (1.0f / HD) + EPS); const float* g = (which == 0 ? A.na_qn_g : A.na_kn_g) + d0;
            *(u32x4*)((which == 0 ? A.NQ : A.NK) + (size_t)r * GROUP_W + hh * HD + d0) =
                (u32x4){pk2(x[0] * rstd * g[0], x[1] * rstd * g[1]), pk2(x[2] * rstd * g[2], x[3] * rstd * g[3]), pk2(x[4] * rstd * g[4], x[5] * rstd * g[5]), pk2(x[6] * rstd * g[6], x[7] * rstd * g[7])};
        }
    }
}
struct MlaQkvArgs { const float* QR; const float* KVR; const bf16_t* P; const float *qn_g, *kn_g; bf16_t *QM, *KM, *VM; };
__device__ __forceinline__ void mlaqkv_phase(const MlaQkvArgs& A, int gwave, int nwaves, int lane) {
    static_assert(MLA_QK == 192 && MLA_NOPE == 128 && MLA_ROPE == 64 && NH == 4, "mla qkv geometry");
    const int hh = lane >> 4, g = lane & 15;
    const float inv = powf(10000.0f, -(float)g / 16.0f);
    for (int r = gwave; r < M_ALL; r += nwaves) {
        const bool lat = r < M_LAT; const int t = lat ? r % SEQ : 0;
        float cr = 1.f, sr = 0.f, cc = 1.f, sc = 0.f;
        if (lat) { sincosf((float)(t / GRID_W) * inv, &sr, &cr); sincosf((float)(t % GRID_W) * inv, &sc, &cc); }
#pragma unroll
        for (int which = 0; which < 2; ++which) {
            float x[12]; float ss = 0.f;
            if (which == 0) { const float* src = A.QR + (size_t)r * NQ_MLA + hh * MLA_QK + g;
#pragma unroll
                for (int i = 0; i < 12; ++i) x[i] = src[16 * i]; }
            else { const float* src = A.KVR + (size_t)r * NKV_MLA + hh * (MLA_NOPE + MLA_V) + g; const bf16_t* kr = A.P + (size_t)r * NP + C_KR + g;
#pragma unroll
                for (int i = 0; i < 8; ++i) x[i] = src[16 * i];
#pragma unroll
                for (int i = 0; i < 4; ++i) x[8 + i] = bf2f(kr[16 * i]); }
#pragma unroll
            for (int i = 0; i < 12; ++i) ss += x[i] * x[i];
            const float rstd = 1.0f / sqrtf(sum16(ss, lane) * (1.0f / MLA_QK) + EPS); const float* gn = (which == 0 ? A.qn_g : A.kn_g) + g;
#pragma unroll
            for (int i = 0; i < 12; ++i) x[i] = x[i] * rstd * gn[16 * i];
            { const float a0 = x[8], b0 = x[10]; x[8] = a0 * cr - b0 * sr; x[10] = a0 * sr + b0 * cr;
              const float a1 = x[9], b1 = x[11]; x[9] = a1 * cc - b1 * sc; x[11] = a1 * sc + b1 * cc; }
            bf16_t* O = (which == 0 ? A.QM : A.KM) + (size_t)r * NQ_MLA + hh * MLA_QK + g;
#pragma unroll
            for (int i = 0; i < 12; ++i) O[16 * i] = f2bf(x[i]);
        }
        { const float* vs = A.KVR + (size_t)r * NKV_MLA + hh * (MLA_NOPE + MLA_V) + MLA_NOPE + g; bf16_t* O = A.VM + (size_t)r * (NH * MLA_V) + hh * MLA_V + g;
#pragma unroll
          for (int i = 0; i < 8; ++i) O[16 * i] = f2bf(vs[16 * i]); }
    }
}
constexpr int ACT_RUN = 32;
__device__ __forceinline__ void act_phase(const bf16_t* UP, const float* cw, const float* cb, bf16_t* ACT, int nrows, int gtid, int gthreads) {
    constexpr int NC8 = D_FF / 8; static_assert(SEQ % ACT_RUN == 0 && CTX_LEN % ACT_RUN == 0, "row runs stay inside one sequence");
    const int nruns = nrows / ACT_RUN;
    for (long it = gtid; it < (long)nruns * NC8; it += gthreads) { const int run = (int)(it / NC8), j0 = (int)(it % NC8) * 8, r0 = run * ACT_RUN; const RowInfo ri = row_info(r0);
        float wa[3][8], wg[3][8], ba[8], bg[8];
#pragma unroll
        for (int k = 0; k < 3; ++k) { const float* p = cw + (size_t)k * 2 * D_FF + j0; const f32x4 a0 = *(const f32x4*)p, a1 = *(const f32x4*)(p + 4), g0 = *(const f32x4*)(p + D_FF), g1 = *(const f32x4*)(p + D_FF + 4);
#pragma unroll
            for (int e = 0; e < 4; ++e) { wa[k][e] = a0[e]; wa[k][4 + e] = a1[e]; wg[k][e] = g0[e]; wg[k][4 + e] = g1[e]; } }
        { const f32x4 a0 = *(const f32x4*)(cb + j0), a1 = *(const f32x4*)(cb + j0 + 4), g0 = *(const f32x4*)(cb + D_FF + j0), g1 = *(const f32x4*)(cb + D_FF + j0 + 4);
#pragma unroll
          for (int e = 0; e < 4; ++e) { ba[e] = a0[e]; ba[4 + e] = a1[e]; bg[e] = g0[e]; bg[4 + e] = g1[e]; } }
        const u32x4 zero = {0u, 0u, 0u, 0u};
        const bf16_t* ub = UP + (size_t)ri.base * (2 * D_FF) + j0;
        u32x4 am, ac, gm, gc;
        { const int t = ri.t; am = t > 0 ? *(const u32x4*)(ub + (size_t)(t - 1) * (2 * D_FF)) : zero; gm = t > 0 ? *(const u32x4*)(ub + (size_t)(t - 1) * (2 * D_FF) + D_FF) : zero;
          ac = *(const u32x4*)(ub + (size_t)t * (2 * D_FF)); gc = *(const u32x4*)(ub + (size_t)t * (2 * D_FF) + D_FF); }
#pragma unroll 4
        for (int i = 0; i < ACT_RUN; ++i) { const int t = ri.t + i;
            const u32x4 ap = t + 1 < ri.T ? *(const u32x4*)(ub + (size_t)(t + 1) * (2 * D_FF)) : zero, gp = t + 1 < ri.T ? *(const u32x4*)(ub + (size_t)(t + 1) * (2 * D_FF) + D_FF) : zero;
            float y[8];
#pragma unroll
            for (int e = 0; e < 4; ++e) {
                const float a0 = ba[2 * e] + wa[0][2 * e] * bflo(am[e]) + wa[1][2 * e] * bflo(ac[e]) + wa[2][2 * e] * bflo(ap[e]);
                const float a1 = ba[2 * e + 1] + wa[0][2 * e + 1] * bfhi(am[e]) + wa[1][2 * e + 1] * bfhi(ac[e]) + wa[2][2 * e + 1] * bfhi(ap[e]);
                const float g0 = bg[2 * e] + wg[0][2 * e] * bflo(gm[e]) + wg[1][2 * e] * bflo(gc[e]) + wg[2][2 * e] * bflo(gp[e]);
                const float g1 = bg[2 * e + 1] + wg[0][2 * e + 1] * bfhi(gm[e]) + wg[1][2 * e + 1] * bfhi(gc[e]) + wg[2][2 * e + 1] * bfhi(gp[e]);
                y[2 * e] = a0 * (g0 / (1.0f + __expf(-g0))); y[2 * e + 1] = a1 * (g1 / (1.0f + __expf(-g1))); }
            *(u32x4*)(ACT + (size_t)(r0 + i) * D_FF + j0) = (u32x4){pk2(y[0], y[1]), pk2(y[2], y[3]), pk2(y[4], y[5]), pk2(y[6], y[7])};
            am = ac; ac = ap; gm = gc; gc = gp; }
    }
}
__device__ __forceinline__ void transpose_item(const float* W, int K, int N, int Npad, bf16_t* WT, float* scr, int item, int lane) {
    const int nblk = Npad / 32, kb = item / nblk, nb = item % nblk, k0 = 64 * kb, n0 = 32 * nb; const int n = n0 + (lane & 31); const bool ok = n < N;
#pragma unroll 8
    for (int i = 0; i < 32; ++i) { const int kk = 2 * i + (lane >> 5); scr[kk * 33 + (lane & 31)] = ok ? W[(size_t)(k0 + kk) * N + n] : 0.f; }
    asm volatile("s_waitcnt lgkmcnt(0)" ::: "memory");
    const int c = lane & 7;
#pragma unroll
    for (int j = 0; j < 4; ++j) { const int nn = (lane >> 3) + 8 * j; const float* s = scr + (8 * c) * 33 + nn;
        u32x4 o; o.x = pk2(s[0 * 33], s[1 * 33]); o.y = pk2(s[2 * 33], s[3 * 33]); o.z = pk2(s[4 * 33], s[5 * 33]); o.w = pk2(s[6 * 33], s[7 * 33]);
        *(u32x4*)(WT + (size_t)(n0 + nn) * K + k0 + 8 * c) = o; }
    asm volatile("s_waitcnt lgkmcnt(0)" ::: "memory");
}
}

__device__ __forceinline__ gdn::Bufs gdn_bufs(const WS& w, int l) { gdn::Bufs B; B.UT = w.gUT; B.WP = w.gWP; B.KDT = w.gKDT; B.QD = w.gQD; B.QK = w.gQK; B.SIT = w.gSIT; B.VNT = w.gVNT; B.GT = w.gGT + (size_t)l * gdn::NTASK; return B; }
__device__ __forceinline__ lru::Bufs lru_bufs(const WS& w) { lru::Bufs B; B.HLOC = w.lHLOC; B.ACUM = w.lACUM; B.LSUM = w.lLSUM; B.HIN = w.lHIN; return B; }

#define LAS __attribute__((address_space(3)))
#define XB_TMO      128
#define XB_XCNT(j)  (256  + 64 * (j))
#define XB_XSUB(j)  (1280 + 64 * (j))
#define XB_XGEN(j)  (2304 + 64 * (j))
#define XB_TOP      3328
#define XB_TOPGEN   3392
#define XCD_BAR_WORDS 3456
#define XB_SPIN_CAP (1u << 18)
__device__ __forceinline__ unsigned xb_ld(unsigned* p)              { return __hip_atomic_load(p, __ATOMIC_RELAXED, __HIP_MEMORY_SCOPE_AGENT); }
__device__ __forceinline__ unsigned xb_add(unsigned* p, unsigned v) { return __hip_atomic_fetch_add(p, v, __ATOMIC_RELAXED, __HIP_MEMORY_SCOPE_AGENT); }
__device__ __forceinline__ unsigned xb_xcc_id() { return (unsigned)__builtin_amdgcn_s_getreg((3 << 11) | 20) & 0xFu; }
#define XB_SPIN(cond, bar) do { unsigned _sp = 0; while (cond) { __builtin_amdgcn_s_sleep(1); \
    if ((++_sp & 255u) == 0u) { if (xb_ld(&(bar)[XB_TMO])) break; if (_sp > XB_SPIN_CAP) { atomicAdd(&(bar)[XB_TMO], 1u); break; } } } } while (0)
struct XcdBarrier { unsigned* bar; unsigned x; volatile LAS unsigned* st; };
__device__ __forceinline__ XcdBarrier xcd_barrier_post(unsigned* bar, volatile LAS unsigned* st, const bool leader) {
    XcdBarrier b; b.bar = bar; b.x = xb_xcc_id(); b.st = st;
    if (leader) (void)xb_add(&bar[XB_XCNT(b.x)], 1u);
    return b;
}
__device__ __forceinline__ void xcd_barrier_complete(unsigned* bar, unsigned x, unsigned& nloc, unsigned& nx) {
    const unsigned G = gridDim.x * gridDim.y * gridDim.z;
    unsigned sum, cnt, mine, sp = 0u;
    for (;;) {
        sum = 0u; cnt = 0u; mine = 0u;
#pragma unroll
        for (unsigned j = 0; j < 16; ++j) { const unsigned c = xb_ld(&bar[XB_XCNT(j)]); sum += c; cnt += (c > 0u) ? 1u : 0u; mine = (j == x) ? c : mine; }
        if (sum == G) break;
        __builtin_amdgcn_s_sleep(1);
        if ((++sp & 255u) == 0u) { if (xb_ld(&bar[XB_TMO])) break; if (sp > XB_SPIN_CAP) { atomicAdd(&bar[XB_TMO], 1u); break; } }
    }
    nloc = mine > 0u ? mine : 1u; nx = cnt > 0u ? cnt : 1u;
}
__device__ __forceinline__ void xcd_barrier(const XcdBarrier& b, const bool leader) {
    asm volatile("s_waitcnt vmcnt(0)" ::: "memory");
    __syncthreads();
    if (leader) {
        unsigned* bar = b.bar;
        __builtin_amdgcn_s_waitcnt(0);
        unsigned nloc = b.st[0], nx = b.st[1];
        if (nloc == 0u) { xcd_barrier_complete(bar, b.x, nloc, nx); b.st[0] = nloc; b.st[1] = nx; }
        const unsigned old = xb_add(&bar[XB_XSUB(b.x)], 1u);
        const unsigned gen = old / nloc;
        if (old + 1u == (gen + 1u) * nloc) {
            __builtin_amdgcn_fence(__ATOMIC_RELEASE, "agent");
            asm volatile("s_waitcnt vmcnt(0)" ::: "memory");
            const unsigned og = xb_add(&bar[XB_TOP], 1u);
            const unsigned tg = og / nx;
            if (og + 1u == (tg + 1u) * nx) xb_add(&bar[XB_TOPGEN], 1u);
            else XB_SPIN(xb_ld(&bar[XB_TOPGEN]) == tg, bar);
            __builtin_amdgcn_fence(__ATOMIC_ACQUIRE, "agent");
            xb_add(&bar[XB_XGEN(b.x)], 1u);
            asm volatile("s_waitcnt vmcnt(0)" ::: "memory");
        } else {
            XB_SPIN(xb_ld(&bar[XB_XGEN(b.x)]) == gen, bar);
            __builtin_amdgcn_fence(__ATOMIC_ACQUIRE, "agent");
            asm volatile("s_waitcnt vmcnt(0)" ::: "memory");
        }
    }
    __syncthreads();
}

constexpr int NWAVES = 8, NTHR = 512;
constexpr int LDS_MISC = 147456, LDS_BYTES = 148480;
static_assert(sizeof(Inputs) == 34 * 8, "Inputs mirrors Params::in");
static_assert(gdn::G1_LDS <= LDS_MISC && pg8::STAGE_BYTES <= LDS_MISC && att::Cfg<MLA_QK>::LDS_BYTES <= LDS_MISC && gdn::G2_LDS <= LDS_MISC, "LDS map");
constexpr int CW_BAR = 4096;
constexpr int PH_PRO = 0, PH_PER_LAYER = 12, NPH = 1 + PH_PER_LAYER * DEPTH;
struct Params { const float* in[34]; float* out; unsigned char* ws; int ph_lo, ph_hi, li, pad; };

struct SpanOrder {
    int nN, lo, hi, G, g0;
    __device__ __forceinline__ void init(int N, int lo_, int hi_, int G_, int c) { nN = N / pg8::BM; lo = lo_; hi = hi_; G = G_; int i0 = 0; if (c < lo_) i0 = (lo_ - c + G_ - 1) / G_; g0 = c + i0 * G_; }
    __device__ __forceinline__ bool next(int i, pg8::Unit& u) const { const int g = g0 + i * G; if (g >= hi) return false; const int loc = g - lo; u.pm = loc / nN; u.pn = loc % nN; return true; }
    __device__ __forceinline__ void a_ready(const pg8::Unit&) const {}
    __device__ __forceinline__ void done(const pg8::Unit&) const {}
};

#define AS4 __attribute__((address_space(4)))
#define PHASE_WS const AS4 Params* pp = (const AS4 Params*)__builtin_amdgcn_kernarg_segment_ptr(); asm volatile("" : "+s"(pp)); const AS4 Inputs* I = (const AS4 Inputs*)pp; (void)I; unsigned char* wsb_ = pp->ws; const WS w = ws_carve(wsb_)
#define PHASE_IDS int tid = C_wave0 * 64 + (int)__builtin_amdgcn_mbcnt_hi(~0u, __builtin_amdgcn_mbcnt_lo(~0u, 0u)); asm volatile("" : "+v"(tid)); const int lane = tid & 63, wave = __builtin_amdgcn_readfirstlane(tid >> 6), gwave = wg * NWAVES + wave, gtid = wg * NTHR + tid; (void)lane; (void)gwave; (void)gtid
#ifndef DBG_MASK
#define DBG_MASK 0xFFFFFF
#endif
#define IN(k) (lo <= (k) && (k) < hi)
#define ON(j) (((DBG_MASK) >> (j)) & 1)
#define SEAM(k) do { if (IN(k) && IN((k) + 1)) xcd_barrier(bar, C_wave0 == 0 && __builtin_amdgcn_mbcnt_hi(~0u, __builtin_amdgcn_mbcnt_lo(~0u, 0u)) == 0u); } while (0)

struct LayerCtx { int lo, hi, G, wg, nwaves, gthreads, wave0; XcdBarrier bar; char* lds; unsigned char* lds_raw; };
template <int l> __device__ __forceinline__ void layer_body(const LayerCtx& C) {
    const int lo = C.lo, hi = C.hi, G = C.G, wg = C.wg, nwaves = C.nwaves, gthreads = C.gthreads, C_wave0 = C.wave0; const XcdBarrier& bar = C.bar; char* lds = C.lds; unsigned char* lds_raw = C.lds_raw;
    (void)G; (void)nwaves; (void)gthreads;
        const int pb = 1 + PH_PER_LAYER * l;
        const bool want_ctx = l < DEPTH - 1; const int Mo = want_ctx ? M_ALL : M_LAT;
        if (ON(0) && IN(pb + 0)) { PHASE_WS; PHASE_IDS; const float* MODl = w.MOD + (size_t)l * (BATCH + 1) * NMODV; (void)MODl; misc::norm_phase(w.H, I->norm_mix_g + (size_t)l * D_MODEL, MODl, 0, w.U, M_ALL, gwave, nwaves, lane); }
        SEAM(pb + 0);
        if (ON(1) && IN(pb + 1)) { PHASE_WS; PHASE_IDS; const float* MODl = w.MOD + (size_t)l * (BATCH + 1) * NMODV; (void)MODl; pg8::Gemm g{w.U, w.WIN + l * SZ_WIN, M_ALL, NP, D_MODEL}; pg8::StaticOrder S; S.init(M_ALL, NP, G, wg);
            pg8::EpiBf16<0> E{w.P, NP, nullptr, 0, 0, 1.0f};
            pg8::gemm_phase<pg8::EpiBf16<0>, pg8::StaticOrder, true, true>((PG8_LAS unsigned char*)lds_raw, g, S, E, tid); }
        SEAM(pb + 1);
        if (ON(2) && IN(pb + 2)) { PHASE_WS; PHASE_IDS; const float* MODl = w.MOD + (size_t)l * (BATCH + 1) * NMODV; (void)MODl;
            const int pflags = pp->pad;
            if (!(pflags & 16)) { gdn::G1Args A; A.P = w.P; A.conv_w = I->gdn_conv_w + (size_t)l * 4 * 3 * GROUP_W; A.a_log = I->gdn_a_log + (size_t)l * 2 * NH; A.dt_bias = I->gdn_dt_bias + (size_t)l * 2 * NH; A.B = gdn_bufs(w, l);
              gdn::g1_phase(A, lds, G, wg, tid); }
            if (!(pflags & 32)) { lru::LocalArgs A; A.P = w.P; A.conv_w = I->lru_conv_w + (size_t)l * 4 * LRU_W; A.conv_b = I->lru_conv_b + (size_t)l * LRU_W; A.WG = w.WLRU + (size_t)l * 16 * lru::SZ_WBLK;
              A.ba = I->lru_ba + (size_t)l * 2 * LRU_W; A.bx = I->lru_bx + (size_t)l * 2 * LRU_W; A.lam = I->lru_lam + (size_t)l * 2 * LRU_W; A.B = lru_bufs(w);
              lru::local_phase(A, lds, G, wg, tid); }
            if (!(pflags & 64)) { misc::RowNormArgs A; A.P = w.P; A.qa_g = I->mla_qa_g + (size_t)l * MLA_Q_LORA; A.kva_g = I->mla_kva_g + (size_t)l * MLA_KV_LORA; A.na_qn_g = I->na_qn_g + (size_t)l * HD; A.na_kn_g = I->na_kn_g + (size_t)l * HD;
              A.CQN = w.CQN; A.CKVN = w.CKVN; A.NQ = w.NQ; A.NK = w.NK; misc::rownorm_phase(A, gwave, nwaves, lane); }
        }
        SEAM(pb + 2);
        if (ON(3) && IN(pb + 3)) { PHASE_WS; PHASE_IDS; const float* MODl = w.MOD + (size_t)l * (BATCH + 1) * NMODV; (void)MODl;
            constexpr int UQ = (M_ALL / 256) * (NQ_MLA / 256), UKV = (M_ALL / 256) * (NKV_MLA / 256);
            { pg8::Gemm g{w.CQN, w.WUQ + l * SZ_WUQ, M_ALL, NQ_MLA, MLA_Q_LORA}; SpanOrder S; S.init(NQ_MLA, 0, UQ, G, wg); pg8::EpiF32 E{w.QR, NQ_MLA};
              pg8::gemm_phase<pg8::EpiF32, SpanOrder, true, true>((PG8_LAS unsigned char*)lds_raw, g, S, E, tid); }
            { pg8::Gemm g{w.CKVN, w.WUKV + l * SZ_WUKV, M_ALL, NKV_MLA, MLA_KV_LORA}; SpanOrder S; S.init(NKV_MLA, UQ, UQ + UKV, G, wg); pg8::EpiF32 E{w.KVR, NKV_MLA};
              pg8::gemm_phase<pg8::EpiF32, SpanOrder, true, true>((PG8_LAS unsigned char*)lds_raw, g, S, E, tid); }
        }
        SEAM(pb + 3);
        if (ON(4) && IN(pb + 4)) { PHASE_WS; PHASE_IDS; const float* MODl = w.MOD + (size_t)l * (BATCH + 1) * NMODV; (void)MODl;
            { misc::MlaQkvArgs A; A.QR = w.QR; A.KVR = w.KVR; A.P = w.P; A.qn_g = I->mla_qn_g + (size_t)l * MLA_QK; A.kn_g = I->mla_kn_g + (size_t)l * MLA_QK; A.QM = w.QM; A.KM = w.KM; A.VM = w.VM;
              misc::mlaqkv_phase(A, gwave, nwaves, lane); }
            lru::carry_phase(lru_bufs(w), gtid, gthreads);
        }
        SEAM(pb + 4);
        if (ON(5) && IN(pb + 5)) { PHASE_WS; PHASE_IDS; const float* MODl = w.MOD + (size_t)l * (BATCH + 1) * NMODV; (void)MODl;
            const int pflags = pp->pad;
            if (wg < BATCH * NH * 2 * gdn::G2_SPLIT && !(pflags & 1)) gdn::g2_chain(gdn_bufs(w, l), lds, wg, tid);
            AttnArgs A; A.QM = w.QM; A.KM = w.KM; A.VM = w.VM; A.NQ = w.NQ; A.NK = w.NK; A.P = w.P; A.Y = w.Y; A.rpb = I->na_rpb + (size_t)l * NH * (2 * NA_KH - 1) * (2 * NA_KW - 1); A.want_ctx = want_ctx ? 1 : 0; A.pad = pflags;
            attention_phase(A, lds, G, wg, tid);
        }
        SEAM(pb + 5);
        if (ON(6) && IN(pb + 6)) { PHASE_WS; PHASE_IDS; const float* MODl = w.MOD + (size_t)l * (BATCH + 1) * NMODV; (void)MODl;
            const int pflags = pp->pad;
            if (!(pflags & 128)) { gdn::G3Args A; A.B = gdn_bufs(w, l); A.P = w.P; A.norm_g = I->gdn_norm_g + (size_t)l * HD; A.Y = w.Y; gdn::g3_phase(A, lds, G, wg, tid); }
            if (!(pflags & 256)) lru::finish_phase(lru_bufs(w), w.P, w.Y, gtid, gthreads);
        }
        SEAM(pb + 6);
        if (ON(7) && IN(pb + 7)) { PHASE_WS; PHASE_IDS; const float* MODl = w.MOD + (size_t)l * (BATCH + 1) * NMODV; (void)MODl; pg8::Gemm g{w.Y, w.WOUT + l * SZ_WOUT, Mo, D_MODEL, D_MODEL}; pg8::StaticOrder S; S.init(Mo, D_MODEL, G, wg);
            pg8::EpiGateRes E{w.H, w.H, D_MODEL, MODl + 2 * D_MODEL, NMODV, SEQ, BATCH, M_LAT};
            pg8::gemm_phase<pg8::EpiGateRes, pg8::StaticOrder, true, true>((PG8_LAS unsigned char*)lds_raw, g, S, E, tid); }
        SEAM(pb + 7);
        if (ON(8) && IN(pb + 8)) { PHASE_WS; PHASE_IDS; const float* MODl = w.MOD + (size_t)l * (BATCH + 1) * NMODV; (void)MODl; misc::norm_phase(w.H, I->norm_ffn_g + (size_t)l * D_MODEL, MODl, 3, w.U, Mo, gwave, nwaves, lane); }
        SEAM(pb + 8);
        if (ON(9) && IN(pb + 9)) { PHASE_WS; PHASE_IDS; const float* MODl = w.MOD + (size_t)l * (BATCH + 1) * NMODV; (void)MODl; pg8::Gemm g{w.U, w.WUP + l * SZ_WUP, Mo, 2 * D_FF, D_MODEL}; pg8::StaticOrder S; S.init(Mo, 2 * D_FF, G, wg);
            pg8::EpiBf16<0> E{w.UP, 2 * D_FF, nullptr, 0, 0, 1.0f};
            pg8::gemm_phase<pg8::EpiBf16<0>, pg8::StaticOrder, true, true>((PG8_LAS unsigned char*)lds_raw, g, S, E, tid); }
        SEAM(pb + 9);
        if (ON(10) && IN(pb + 10)) { PHASE_WS; PHASE_IDS; const float* MODl = w.MOD + (size_t)l * (BATCH + 1) * NMODV; (void)MODl; misc::act_phase(w.UP, I->ffn_conv_w + (size_t)l * 3 * 2 * D_FF, I->ffn_conv_b + (size_t)l * 2 * D_FF, w.ACT, Mo, gtid, gthreads); }
        SEAM(pb + 10);
        if (ON(11) && IN(pb + 11)) { PHASE_WS; PHASE_IDS; const float* MODl = w.MOD + (size_t)l * (BATCH + 1) * NMODV; (void)MODl; pg8::Gemm g{w.ACT, w.WDOWN + l * SZ_WDOWN, Mo, D_MODEL, D_FF}; pg8::StaticOrder S; S.init(Mo, D_MODEL, G, wg);
            pg8::EpiGateRes E{w.H, want_ctx ? w.H : pp->out, D_MODEL, MODl + 5 * D_MODEL, NMODV, SEQ, BATCH, M_LAT};
            pg8::gemm_phase<pg8::EpiGateRes, pg8::StaticOrder, true, true>((PG8_LAS unsigned char*)lds_raw, g, S, E, tid); }
        SEAM(pb + 11);

}
__global__ void __launch_bounds__(NTHR, 2) fwd(Params p) {
    extern __shared__ __attribute__((aligned(16))) unsigned char lds_raw[];
    char* lds = (char*)lds_raw;
    const int G = (int)gridDim.x, wg = (int)blockIdx.x, nwaves = G * NWAVES, gthreads = G * NTHR;
    const int C_wave0 = __builtin_amdgcn_readfirstlane((int)threadIdx.x >> 6);
    volatile LAS unsigned* MISC = (volatile LAS unsigned*)(lds_raw + LDS_MISC);
    if (threadIdx.x < 32) MISC[threadIdx.x] = 0u;
    __syncthreads();
    const int lo = p.ph_lo, hi = p.ph_hi;
    unsigned* const barw = (unsigned*)p.ws + CW_BAR + (size_t)p.li * XCD_BAR_WORDS;
    XcdBarrier bar; bar.bar = barw; bar.x = 0; bar.st = MISC + 8;
    if (hi - lo > 1) bar = xcd_barrier_post(barw, MISC + 8, threadIdx.x == 0);

    if (ON(12) && IN(PH_PRO)) { PHASE_WS; PHASE_IDS;
        {
            float* SCs = (float*)lds;
            float* red = (float*)(lds + 3 * D_MODEL * 4);
            constexpr int NT = DEPTH * NMODV / 256;
            if (wg < NT) {
                for (int i = tid; i < (BATCH + 1) * D_MODEL; i += NTHR) { const int s = i / D_MODEL, k = i % D_MODEL; const float v = s < BATCH ? I->c[s * D_MODEL + k] : I->c_ctx[k]; SCs[i] = v / (1.0f + __expf(-v)); }
                __syncthreads();
            }
            for (int t = wg; t < NT; t += G) { const int l = t / (NMODV / 256), j0 = (t % (NMODV / 256)) * 256;
                misc::f32x4 acc[3] = {{0.f, 0.f, 0.f, 0.f}, {0.f, 0.f, 0.f, 0.f}, {0.f, 0.f, 0.f, 0.f}};
                const float* wp = I->ada_w + (size_t)l * D_MODEL * NMODV + (size_t)(256 * wave) * NMODV + j0 + 4 * lane;
#pragma unroll 8
                for (int k = 0; k < 256; ++k) { const misc::f32x4 wv = *(const misc::f32x4*)(wp + (size_t)k * NMODV); const int kk = 256 * wave + k;
                    acc[0] += wv * SCs[kk]; acc[1] += wv * SCs[D_MODEL + kk]; acc[2] += wv * SCs[2 * D_MODEL + kk]; }
                __syncthreads();
#pragma unroll
                for (int s = 0; s < 3; ++s) *(misc::f32x4*)(red + (wave * 3 + s) * 256 + 4 * lane) = acc[s];
                __syncthreads();
                for (int i = tid; i < 3 * 256; i += NTHR) { const int s = i / 256, c = i % 256; float sum = I->ada_b[(size_t)l * NMODV + j0 + c];
#pragma unroll
                    for (int w8 = 0; w8 < 8; ++w8) sum += red[(w8 * 3 + s) * 256 + c];
                    w.MOD[((size_t)l * (BATCH + 1) + s) * NMODV + j0 + c] = sum; }
            }
            __syncthreads();
        }
        {
            float* scr = (float*)(lds + wave * 8448);
            constexpr int I_IN = (D_MODEL / 64) * (NP / 32), I_OUT = (D_MODEL / 64) * (D_MODEL / 32), I_UP = (D_MODEL / 64) * (2 * D_FF / 32), I_DN = (D_FF / 64) * (D_MODEL / 32),
                          I_UQ = (MLA_Q_LORA / 64) * (NQ_MLA / 32), I_UKV = (MLA_KV_LORA / 64) * (NKV_MLA / 32), I_LB = (LRU_BW / 64) * (LRU_BW / 32), I_LRU = 2 * 2 * NH * I_LB;
            constexpr int I_LAYER = I_IN + I_OUT + I_UP + I_DN + I_UQ + I_UKV + I_LRU;
            for (int it = gwave; it < DEPTH * I_LAYER; it += nwaves) { const int l = it / I_LAYER; int r = it % I_LAYER;
                if (r < I_IN) { misc::transpose_item(I->w_in + (size_t)l * D_MODEL * IN_COLS, D_MODEL, IN_COLS, NP, w.WIN + l * SZ_WIN, scr, r, lane); continue; } r -= I_IN;
                if (r < I_OUT) { misc::transpose_item(I->w_out + (size_t)l * D_MODEL * D_MODEL, D_MODEL, D_MODEL, D_MODEL, w.WOUT + l * SZ_WOUT, scr, r, lane); continue; } r -= I_OUT;
                if (r < I_UP) { misc::transpose_item(I->ffn_w_up + (size_t)l * D_MODEL * 2 * D_FF, D_MODEL, 2 * D_FF, 2 * D_FF, w.WUP + l * SZ_WUP, scr, r, lane); continue; } r -= I_UP;
                if (r < I_DN) { misc::transpose_item(I->ffn_w_down + (size_t)l * D_FF * D_MODEL, D_FF, D_MODEL, D_MODEL, w.WDOWN + l * SZ_WDOWN, scr, r, lane); continue; } r -= I_DN;
                if (r < I_UQ) { misc::transpose_item(I->mla_w_uq + (size_t)l * MLA_Q_LORA * NQ_MLA, MLA_Q_LORA, NQ_MLA, NQ_MLA, w.WUQ + l * SZ_WUQ, scr, r, lane); continue; } r -= I_UQ;
                if (r < I_UKV) { misc::transpose_item(I->mla_w_ukv + (size_t)l * MLA_KV_LORA * NKV_MLA, MLA_KV_LORA, NKV_MLA, NKV_MLA, w.WUKV + l * SZ_WUKV, scr, r, lane); continue; } r -= I_UKV;
                { const int blk = r / I_LB, item = r % I_LB, d = blk / (2 * NH), wh = (blk / NH) & 1, nb = blk % NH;
                  const float* src = (wh == 0 ? I->lru_wa : I->lru_wx) + ((size_t)(l * 2 + d) * NH + nb) * lru::SZ_WBLK;
                  misc::transpose_item(src, LRU_BW, LRU_BW, LRU_BW, w.WLRU + ((size_t)l * 16 + blk) * lru::SZ_WBLK, scr, item, lane); }
            }
        }
        for (long i = gtid; i < (long)M_ALL * D_MODEL / 4; i += gthreads) { const long e = i * 4;
            ((misc::f32x4*)w.H)[i] = e < (long)M_LAT * D_MODEL ? *(const misc::f32x4*)(I->x + e) : *(const misc::f32x4*)(I->ctx + (e - (long)M_LAT * D_MODEL)); }
    }
    SEAM(PH_PRO);

    { LayerCtx C; C.lo = lo; C.hi = hi; C.G = G; C.wg = wg; C.nwaves = nwaves; C.gthreads = gthreads; C.wave0 = C_wave0; C.bar = bar; C.lds = lds; C.lds_raw = lds_raw;
      static_assert(DEPTH == 4, "layer calls are written out (a real layer loop lets LICM park loop-invariant values in registers across every phase: spills)");
      layer_body<0>(C); layer_body<1>(C); layer_body<2>(C); layer_body<3>(C); }
#undef IN
#undef SEAM
}

#ifndef MK_PHASES_PER_LAUNCH
#define MK_PHASES_PER_LAUNCH NPH
#endif
extern "C" void kernel_launch(void* const* d_in, const int* in_sizes, int n_in, void* d_out, int out_size, void* d_ws, size_t ws_size, hipStream_t stream) {
    static int grid = 0;
    if (grid == 0) {
        int dev = 0, cus = 0;
        if (hipGetDevice(&dev) != hipSuccess || hipDeviceGetAttribute(&cus, hipDeviceAttributeMultiprocessorCount, dev) != hipSuccess || cus <= 0) { fprintf(stderr, "kernel_launch: no device\n"); grid = -1; return; }
        if (hipFuncSetAttribute((const void*)fwd, hipFuncAttributeMaxDynamicSharedMemorySize, LDS_BYTES) != hipSuccess) { fprintf(stderr, "kernel_launch: hipFuncSetAttribute failed\n"); grid = -1; return; }
        int per_cu = 0; if (hipOccupancyMaxActiveBlocksPerMultiprocessor(&per_cu, (const void*)fwd, NTHR, LDS_BYTES) != hipSuccess || per_cu < 1) fprintf(stderr, "kernel_launch: occupancy query says %d blocks per CU\n", per_cu);
        (void)hipGetLastError();
        grid = cus;
        const WS w0 = ws_carve(nullptr);
        if (n_in != 34 || w0.total > ws_size) { fprintf(stderr, "kernel_launch: bad inputs / workspace (need %zu, have %zu)\n", w0.total, ws_size); grid = -1; return; }
    }
    if (grid < 0) return;
    (void)hipMemsetAsync(d_ws, 0, 1 << 20, stream);
    Params p; memset(&p, 0, sizeof(p));
    for (int i = 0; i < 34; ++i) p.in[i] = (const float*)d_in[i];
    p.out = (float*)d_out; p.ws = (unsigned char*)d_ws;
    int li = 0;
    for (int lo = 0; lo < NPH; lo += MK_PHASES_PER_LAUNCH, ++li) {
        p.ph_lo = lo; p.ph_hi = lo + MK_PHASES_PER_LAUNCH < NPH ? lo + MK_PHASES_PER_LAUNCH : NPH; p.li = li;
        hipLaunchKernelGGL(fwd, dim3(grid), dim3(NTHR), LDS_BYTES, stream, p);
#if defined(PROBE_MASK)
        if (MK_PHASES_PER_LAUNCH == 1 && ((((PROBE_MASK) >> 12) & 1 && lo == 0) || (lo > 0 && (((PROBE_MASK) >> ((lo - 1) % PH_PER_LAYER)) & 1))))
            { Params q = p;
#if defined(PROBE_FLAGS)
              q.pad = PROBE_FLAGS;
#endif
              for (int r = 0; r < PROBE_REPS; ++r) hipLaunchKernelGGL(fwd, dim3(grid), dim3(NTHR), LDS_BYTES, stream, q); }
#endif
    }
}
```

```cpp
#include <hip/hip_runtime.h>
#include <cstdio>
#include <cstdint>
#include <cstring>
#include <math.h>
#include <stdint.h>

#ifdef CFG_SMALL
constexpr int D_MODEL = 256, BATCH = 2, SEQ = 512, DEPTH = 2, CTX_LEN = 64, GRID_W = 32, HEAD_DIM = 16;
#else
constexpr int D_MODEL = 2048, BATCH = 2, SEQ = 8192, DEPTH = 4, CTX_LEN = 256, GRID_W = 64, HEAD_DIM = 128;
#endif
constexpr int GROUP_W = D_MODEL / 4, NH = GROUP_W / HEAD_DIM;
constexpr int HD = HEAD_DIM;
constexpr int N_MOD = 6;
constexpr float EPS = 1e-6f;
constexpr int LRU_W = GROUP_W, LRU_BW = LRU_W / NH;
constexpr float LRU_C = 8.0f;
constexpr int MLA_Q_LORA = 3 * D_MODEL / 16, MLA_KV_LORA = D_MODEL / 8, MLA_NOPE = HD, MLA_ROPE = HD / 2, MLA_V = HD, MLA_QK = MLA_NOPE + MLA_ROPE;
constexpr int GDN_CHUNK = 64;
constexpr int NA_KH = 8, NA_KW = 16;
constexpr int D_FF = 5 * D_MODEL / 2;
constexpr int ROWS = SEQ / GRID_W;
constexpr int C_LRU_X = 0, C_LRU_G = C_LRU_X + LRU_W, C_CQ = C_LRU_G + LRU_W, C_CKV = C_CQ + MLA_Q_LORA, C_KR = C_CKV + MLA_KV_LORA,
              C_GQ = C_KR + MLA_ROPE, C_GK = C_GQ + GROUP_W, C_GV = C_GK + GROUP_W, C_GG = C_GV + GROUP_W, C_GB = C_GG + GROUP_W,
              C_GA = C_GB + 2 * NH, C_NQ = C_GA + 2 * NH, C_NK = C_NQ + GROUP_W, C_NV = C_NK + GROUP_W, IN_COLS = C_NV + GROUP_W;
constexpr int NP = (IN_COLS + 255) / 256 * 256;
constexpr int M_LAT = BATCH * SEQ, M_CTX = BATCH * CTX_LEN, M_ALL = M_LAT + M_CTX;
constexpr int NMODV = N_MOD * D_MODEL;

typedef unsigned short bf16_t;
__host__ __device__ __forceinline__ bf16_t f2bf(float f) { union { float f; unsigned u; } v; v.f = f; unsigned u = v.u; u += 0x7fffu + ((u >> 16) & 1u); return (bf16_t)(u >> 16); }
__host__ __device__ __forceinline__ float bf2f(bf16_t b) { union { float f; unsigned u; } v; v.u = ((unsigned)b) << 16; return v.f; }
__host__ __device__ __forceinline__ float sigmoidf_(float x) { return 1.0f / (1.0f + expf(-x)); }
__host__ __device__ __forceinline__ float siluf_(float x) { return x / (1.0f + expf(-x)); }
__host__ __device__ __forceinline__ float softplusf_(float x) { return fmaxf(x, 0.0f) + log1pf(expf(-fabsf(x))); }
__host__ __device__ __forceinline__ float geluf_(float x) { return 0.5f * x * (1.0f + tanhf(0.7978845608028654f * (x + 0.044715f * x * x * x))); }

struct RowInfo { int b, t, T, base, set; };
__host__ __device__ __forceinline__ RowInfo row_info(int r) {
    RowInfo i;
    if (r < M_LAT) { i.b = r / SEQ; i.t = r % SEQ; i.T = SEQ; i.base = i.b * SEQ; i.set = i.b; }
    else { const int rr = r - M_LAT; i.b = rr / CTX_LEN; i.t = rr % CTX_LEN; i.T = CTX_LEN; i.base = M_LAT + i.b * CTX_LEN; i.set = BATCH; }
    return i;
}


__host__ __device__ __forceinline__ float bflo(unsigned w) { union { float f; unsigned u; } v; v.u = w << 16; return v.f; }
__host__ __device__ __forceinline__ float bfhi(unsigned w) { union { float f; unsigned u; } v; v.u = w & 0xffff0000u; return v.f; }
#define LDS_BARRIER() asm volatile("s_waitcnt lgkmcnt(0)\n\ts_barrier" ::: "memory")
__device__ __forceinline__ float lane_xor(float v, int mask, int lane) { return __int_as_float(__builtin_amdgcn_ds_bpermute((lane ^ mask) << 2, __float_as_int(v))); }
__device__ __forceinline__ float lane_get(float v, int src_lane) { return __int_as_float(__builtin_amdgcn_ds_bpermute(src_lane << 2, __float_as_int(v))); }
struct Inputs {
    const float *x, *c, *ctx, *c_ctx, *ada_w, *ada_b, *norm_mix_g, *norm_ffn_g, *w_in, *w_out,
        *lru_conv_w, *lru_conv_b, *lru_wa, *lru_ba, *lru_wx, *lru_bx, *lru_lam,
        *mla_qa_g, *mla_w_uq, *mla_kva_g, *mla_w_ukv, *mla_qn_g, *mla_kn_g,
        *gdn_conv_w, *gdn_a_log, *gdn_dt_bias, *gdn_norm_g, *na_qn_g, *na_kn_g, *na_rpb,
        *ffn_w_up, *ffn_conv_w, *ffn_conv_b, *ffn_w_down;
};
constexpr int NQ_MLA = NH * MLA_QK, NKV_MLA = NH * (MLA_NOPE + MLA_V);
constexpr size_t SZ_WIN = (size_t)NP * D_MODEL, SZ_WOUT = (size_t)D_MODEL * D_MODEL, SZ_WUP = (size_t)2 * D_FF * D_MODEL, SZ_WDOWN = (size_t)D_MODEL * D_FF,
                 SZ_WUQ = (size_t)NQ_MLA * MLA_Q_LORA, SZ_WUKV = (size_t)NKV_MLA * MLA_KV_LORA, SZ_WLRU = (size_t)16 * LRU_BW * LRU_BW;
struct WS {
    unsigned* ctl; float *MOD, *H; bf16_t *U, *Y;
    bf16_t *WIN, *WOUT, *WUP, *WDOWN, *WUQ, *WUKV, *WLRU;
    bf16_t* P; bf16_t *CQN, *CKVN; float *QR, *KVR; bf16_t *QM, *KM, *VM, *NQ, *NK;
    bf16_t *gUT, *gWP, *gKDT, *gQD, *gQK, *gSIT, *gVNT; float* gGT;
    bf16_t *lHLOC, *lACUM; float *lLSUM, *lHIN;
    bf16_t *UP, *ACT;
    size_t total;
};
__host__ __device__ inline WS ws_carve(void* base) {
    WS w; size_t off = 0; char* b = (char*)base;
#define WS_TAKE(T, field, bytes) do { w.field = (T*)(b + off); off += (((size_t)(bytes)) + 255) & ~(size_t)255; } while (0)
    WS_TAKE(unsigned, ctl, 1 << 20);
    WS_TAKE(float, MOD, sizeof(float) * (size_t)DEPTH * (BATCH + 1) * NMODV);
    WS_TAKE(float, H, sizeof(float) * (size_t)M_ALL * D_MODEL);
    WS_TAKE(bf16_t, U, 2 * (size_t)M_ALL * D_MODEL);
    WS_TAKE(bf16_t, Y, 2 * (size_t)M_ALL * D_MODEL);
    WS_TAKE(bf16_t, WIN, 2 * SZ_WIN * DEPTH); WS_TAKE(bf16_t, WOUT, 2 * SZ_WOUT * DEPTH); WS_TAKE(bf16_t, WUP, 2 * SZ_WUP * DEPTH); WS_TAKE(bf16_t, WDOWN, 2 * SZ_WDOWN * DEPTH);
    WS_TAKE(bf16_t, WUQ, 2 * SZ_WUQ * DEPTH); WS_TAKE(bf16_t, WUKV, 2 * SZ_WUKV * DEPTH); WS_TAKE(bf16_t, WLRU, 2 * SZ_WLRU * DEPTH);
    const size_t r0 = off;
    WS_TAKE(bf16_t, P, 2 * (size_t)M_ALL * NP);
    WS_TAKE(bf16_t, CQN, 2 * (size_t)M_ALL * MLA_Q_LORA); WS_TAKE(bf16_t, CKVN, 2 * (size_t)M_ALL * MLA_KV_LORA);
    WS_TAKE(float, QR, 4 * (size_t)M_ALL * NQ_MLA); WS_TAKE(float, KVR, 4 * (size_t)M_ALL * NKV_MLA);
    WS_TAKE(bf16_t, QM, 2 * (size_t)M_ALL * NQ_MLA); WS_TAKE(bf16_t, KM, 2 * (size_t)M_ALL * NQ_MLA); WS_TAKE(bf16_t, VM, 2 * (size_t)M_ALL * NH * MLA_V);
    WS_TAKE(bf16_t, NQ, 2 * (size_t)M_ALL * GROUP_W); WS_TAKE(bf16_t, NK, 2 * (size_t)M_ALL * GROUP_W);
    { constexpr size_t NT_ = (size_t)(M_ALL / 64) * NH * 2;
      WS_TAKE(bf16_t, gUT, 2 * NT_ * 128 * 64); WS_TAKE(bf16_t, gWP, 2 * NT_ * 64 * 128); WS_TAKE(bf16_t, gKDT, 2 * NT_ * 128 * 64); WS_TAKE(bf16_t, gQD, 2 * NT_ * 64 * 128);
      WS_TAKE(bf16_t, gQK, 2 * NT_ * 64 * 64); WS_TAKE(bf16_t, gSIT, 2 * NT_ * 128 * 128); WS_TAKE(bf16_t, gVNT, 2 * NT_ * 128 * 64); WS_TAKE(float, gGT, 4 * NT_ * DEPTH); }
    WS_TAKE(bf16_t, lHLOC, 2 * (size_t)2 * M_ALL * LRU_W); WS_TAKE(bf16_t, lACUM, 2 * (size_t)2 * M_ALL * LRU_W);
    WS_TAKE(float, lLSUM, 4 * (size_t)(M_ALL / 64) * 2 * 2 * LRU_W); WS_TAKE(float, lHIN, 4 * (size_t)(M_ALL / 64) * 2 * LRU_W);
    const size_t r1 = off;
    off = r0;
    WS_TAKE(bf16_t, UP, 2 * (size_t)M_ALL * 2 * D_FF); WS_TAKE(bf16_t, ACT, 2 * (size_t)M_ALL * D_FF);
    const size_t f1 = off;
#undef WS_TAKE
    w.total = r1 > f1 ? r1 : f1;
    return w;
}

namespace pg8 {
#define PG8_LAS __attribute__((address_space(3)))
typedef unsigned short bf16_t;
typedef short bf16x8 __attribute__((ext_vector_type(8)));
typedef float f32x4 __attribute__((ext_vector_type(4)));
typedef unsigned u32x4 __attribute__((ext_vector_type(4)));
constexpr int BM = 256, BK = 64, HALF = 128, HTB = HALF * BK * 2  , STAGE_BYTES = 8 * HTB, NXCD = 8, WGM = 8;

__host__ __device__ __forceinline__ int lds_byte(int r, int c) { const int st = (r >> 4) * 2 + (c >> 5), rr = r & 15, cc = c & 31, ob = rr * 64 + cc * 2; return st * 1024 + (ob ^ (((ob >> 9) & 1) << 5)); }
__host__ __device__ __forceinline__ void stage_rc(int b, int& R, int& C) { const int st = b / 1024, sb = b % 1024, swz = sb ^ (((sb >> 9) & 1) << 5); R = (st >> 1) * 16 + swz / 64; C = (st & 1) * 32 + (swz % 64) / 2; }
__host__ __device__ __forceinline__ int perm32(int rho) { const int n = rho >> 4, i = rho & 15; return 8 * (i >> 2) + 4 * n + (i & 3); }

struct Unit { int pm, pn; };
struct Gemm { const bf16_t* A; const bf16_t* Bt; int M, N, K; };

struct StaticOrder {
    int nM, nN, nwg, G, c;
    __host__ __device__ void init(int M, int N, int G_, int c_) { nM = M / BM; nN = N / BM; nwg = nM * nN; G = G_; c = c_; }
    __host__ __device__ bool next(int i, Unit& u) const {
        const long L = (long)i * G + c; if (L >= nwg) return false;
        int wgid = (int)L; { const int q = nwg / NXCD, r = nwg % NXCD, xcd = wgid % NXCD, off = wgid / NXCD; wgid = (xcd < r ? xcd * (q + 1) : r * (q + 1) + (xcd - r) * q) + off; }
        const int nig = WGM * nN, gid = wgid / nig, fm = gid * WGM, gsz = (nM - fm) < WGM ? (nM - fm) : WGM;
        u.pm = fm + ((wgid % nig) % gsz); u.pn = (wgid % nig) / gsz; return true;
    }
    __device__ __forceinline__ void a_ready(const Unit&) const {}
    __device__ __forceinline__ void done(const Unit&) const {}
};
__device__ __forceinline__ unsigned cvt_pk_bf16(float lo, float hi) { unsigned r; asm volatile("v_cvt_pk_bf16_f32 %0, %1, %2" : "=v"(r) : "v"(lo), "v"(hi)); return r; }
typedef float f32x2 __attribute__((ext_vector_type(2)));
__device__ __forceinline__ f32x2 gelu_pk(f32x2 v) {
    const f32x2 av = __builtin_elementwise_abs(v), d = av * 0.2316418882f + 1.0f;
    f32x2 t; t.x = __builtin_amdgcn_rcpf(d.x); t.y = __builtin_amdgcn_rcpf(d.y);
    f32x2 q = t * 0.5307027145f + (-0.7265760135f); q = q * t + 0.7107068705f; q = q * t + (-0.142248368f); q = q * t + 0.127414796f; q = q * t;
    const f32x2 s = (v * v) * (-0.72134752044f);
    f32x2 e; e.x = __builtin_amdgcn_exp2f(s.x); e.y = __builtin_amdgcn_exp2f(s.y);
    const f32x2 m = v * (q * e), r = v - m;
    f32x2 o; o.x = v.x < 0.f ? m.x : r.x; o.y = v.y < 0.f ? m.y : r.y; return o;
}

template <int ACT  > struct EpiBf16 {
    static constexpr bool PERM = true, AFTER_DRAIN = false; static_assert(ACT == 0 || ACT == 1, "EpiBf16: ACT is 0 (none) or 1 (gelu_pk)");
    bf16_t* O; int ldc; const float* bias; int split_cols; size_t split_stride; float scale0;
    __device__ __forceinline__ void operator()(const f32x4 (&acc)[2][2][4][2], const Unit& u, int wr, int wc, int fr, int fq) const {
        const int row0 = u.pm * BM + wr * 64 + fr; int colt = u.pn * BM; bf16_t* base = O;
        float sc = 1.f; if (split_cols) { const int t = colt / split_cols; base += (size_t)t * split_stride; colt -= t * split_cols; if (t == 0) sc = scale0; }
        const int col0 = colt + wc * 32 + 8 * fq, bcol0 = u.pn * BM + wc * 32 + 8 * fq;
        f32x4 bv[2][2];
#pragma unroll
        for (int bj = 0; bj < 2; ++bj)
#pragma unroll
            for (int n = 0; n < 2; ++n) bv[bj][n] = bias ? *(const f32x4*)(bias + bcol0 + bj * HALF + 4 * n) : (f32x4){0.f, 0.f, 0.f, 0.f};
#pragma unroll
        for (int ai = 0; ai < 2; ++ai)
#pragma unroll
            for (int m = 0; m < 4; ++m) { bf16_t* rowp = base + (size_t)(row0 + ai * HALF + m * 16) * ldc + col0;
#pragma unroll
                for (int bj = 0; bj < 2; ++bj) { f32x4 v0 = acc[ai][bj][m][0] + bv[bj][0], v1 = acc[ai][bj][m][1] + bv[bj][1];
                    if (ACT == 1) { f32x2 a = gelu_pk((f32x2){v0[0], v0[1]}), b = gelu_pk((f32x2){v0[2], v0[3]}), c = gelu_pk((f32x2){v1[0], v1[1]}), d = gelu_pk((f32x2){v1[2], v1[3]});
                        v0 = (f32x4){a.x, a.y, b.x, b.y}; v1 = (f32x4){c.x, c.y, d.x, d.y}; }
                    v0 = v0 * sc; v1 = v1 * sc; u32x4 w; w.x = cvt_pk_bf16(v0[0], v0[1]); w.y = cvt_pk_bf16(v0[2], v0[3]); w.z = cvt_pk_bf16(v1[0], v1[1]); w.w = cvt_pk_bf16(v1[2], v1[3]);
                    *(u32x4*)(rowp + bj * HALF) = w; } }
    }
};

struct EpiF32 {
    static constexpr bool PERM = false, AFTER_DRAIN = false;
    float* C; int ldc;
    __device__ __forceinline__ void operator()(const f32x4 (&acc)[2][2][4][2], const Unit& u, int wr, int wc, int fr, int fq) const {
        const int row0 = u.pm * BM + wr * 64 + fr, col0 = u.pn * BM + wc * 32 + 4 * fq;
#pragma unroll
        for (int ai = 0; ai < 2; ++ai)
#pragma unroll
            for (int m = 0; m < 4; ++m) { float* rowp = C + (size_t)(row0 + ai * HALF + m * 16) * ldc + col0;
#pragma unroll
                for (int bj = 0; bj < 2; ++bj)
#pragma unroll
                    for (int n = 0; n < 2; ++n) *(f32x4*)(rowp + bj * HALF + n * 16) = acc[ai][bj][m][n]; }
    }
};
struct EpiGateRes {
    static constexpr bool PERM = false, AFTER_DRAIN = false;
    const float* base; float* out; int ldc; const float* gate; int set_stride; int rows_per_set; int nsets_lat; int lat_rows;
    __device__ __forceinline__ void operator()(const f32x4 (&acc)[2][2][4][2], const Unit& u, int wr, int wc, int fr, int fq) const {
        const int row0 = u.pm * BM + wr * 64 + fr, col0 = u.pn * BM + wc * 32 + 4 * fq;
        const int set = (u.pm * BM >= lat_rows) ? nsets_lat : (u.pm * BM) / rows_per_set;
        const float* gp = gate + (size_t)set * set_stride + col0;
        f32x4 gv[2][2];
#pragma unroll
        for (int bj = 0; bj < 2; ++bj)
#pragma unroll
            for (int n = 0; n < 2; ++n) gv[bj][n] = *(const f32x4*)(gp + bj * HALF + n * 16);
#pragma unroll
        for (int ai = 0; ai < 2; ++ai)
#pragma unroll
            for (int m = 0; m < 4; ++m) { const size_t off = (size_t)(row0 + ai * HALF + m * 16) * ldc + col0;
#pragma unroll
                for (int bj = 0; bj < 2; ++bj)
#pragma unroll
                    for (int n = 0; n < 2; ++n) { const f32x4 b = *(const f32x4*)(base + off + bj * HALF + n * 16); *(f32x4*)(out + off + bj * HALF + n * 16) = b + gv[bj][n] * acc[ai][bj][m][n]; } }
    }
};

template <class Epi, class Sched, bool ALIGN_EPI = false, bool SP2 = false>
__device__ __forceinline__ void gemm_phase(PG8_LAS unsigned char* lds, const Gemm g, const Sched& S, const Epi& E, const int tid_in) {
    int tid_ = tid_in; asm volatile("" : "+v"(tid_));
    const int tid = tid_, wid = __builtin_amdgcn_readfirstlane(tid >> 6), lane = tid & 63, wr = wid >> 2, wc = wid & 3, fr = lane & 15, fq = lane >> 4;
    const int K = g.K, nt = K / BK;
    unsigned voffA[2], voffB[2];
#pragma unroll
    for (int i = 0; i < 2; ++i) { int R, C; stage_rc(tid * 16 + i * 8192, R, C); const int Rb = Epi::PERM ? ((R & ~31) + perm32(R & 31)) : R;
        voffA[i] = (unsigned)(R * K + C) * 2u; voffB[i] = (unsigned)(Rb * K + C) * 2u; }
    const size_t kstep = (size_t)(BK * 2);
    const size_t hstep = (size_t)HALF * K * 2;
    const size_t tstep = 2 * hstep;
    const unsigned ldsw = (unsigned)wid * 1024u;
    const int aoff = lds_byte(wr * 64 + fr, fq * 8), boff = lds_byte(wc * 32 + fr, fq * 8);
#define PG8_SA(b, h) (((b) * 2 + (h)) * HTB)
#define PG8_SB(b, h) ((4 + (b) * 2 + (h)) * HTB)
#define PG8_STAGE(bufoff, gbase, voff) do { _Pragma("unroll") for (int _i = 0; _i < 2; ++_i) \
        __builtin_amdgcn_global_load_lds((const unsigned*)((const char*)(gbase) + (voff)[_i]), (PG8_LAS unsigned*)(lds + (bufoff) + ldsw + _i * 8192), 16, 0, 0); } while (0)
#define PG8_LDA(dst, b, h) do { _Pragma("unroll") for (int m = 0; m < 4; ++m) _Pragma("unroll") for (int k = 0; k < 2; ++k) dst[m][k] = *(const PG8_LAS bf16x8*)(lds + PG8_SA(b, h) + aoff + m * 2048 + k * 1024); } while (0)
#define PG8_LDB(dst, b, h) do { _Pragma("unroll") for (int n = 0; n < 2; ++n) _Pragma("unroll") for (int k = 0; k < 2; ++k) dst[n][k] = *(const PG8_LAS bf16x8*)(lds + PG8_SB(b, h) + boff + n * 2048 + k * 1024); } while (0)
#define PG8_MMA(ai, bj, At, Bt) do { __builtin_amdgcn_s_setprio(1); _Pragma("unroll") for (int m = 0; m < 4; ++m) _Pragma("unroll") for (int n = 0; n < 2; ++n) _Pragma("unroll") for (int k = 0; k < 2; ++k) \
        acc[ai][bj][m][n] = __builtin_amdgcn_mfma_f32_16x16x32_bf16(Bt[n][k], At[m][k], acc[ai][bj][m][n], 0, 0, 0); __builtin_amdgcn_s_setprio(0); } while (0)
#define PG8_WAIT_V(n) asm volatile("s_waitcnt vmcnt(" #n ")" ::: "memory")
#define PG8_WAIT_L(n) asm volatile("s_waitcnt lgkmcnt(" #n ")" ::: "memory")
#define PG8_BAR __builtin_amdgcn_s_barrier()
#define PG8_SCHED __builtin_amdgcn_sched_barrier(0)
    Unit cur, nxt; int ui = 0;
    if (!S.next(0, cur)) return;
    f32x4 acc[2][2][4][2];
#pragma unroll
    for (int a = 0; a < 2; ++a)
#pragma unroll
        for (int b = 0; b < 2; ++b)
#pragma unroll
            for (int m = 0; m < 4; ++m)
#pragma unroll
                for (int n = 0; n < 2; ++n) acc[a][b][m][n] = (f32x4){0.f, 0.f, 0.f, 0.f};
    bf16x8 At[4][2], B0[2][2], B1[2][2];
    const char* cA = (const char*)g.A + (size_t)cur.pm * tstep; const char* cB = (const char*)g.Bt + (size_t)cur.pn * tstep;
    S.a_ready(cur);
    if constexpr (SP2) {
        PG8_STAGE(PG8_SB(0, 0), cB, voffB); PG8_STAGE(PG8_SB(0, 1), cB + hstep, voffB); PG8_STAGE(PG8_SA(0, 0), cA, voffA); PG8_STAGE(PG8_SA(0, 1), cA + hstep, voffA);
        if (wr == 1) PG8_BAR;
        PG8_WAIT_V(2); PG8_BAR;
        PG8_STAGE(PG8_SB(1, 0), cB + kstep, voffB); PG8_STAGE(PG8_SA(1, 0), cA + kstep, voffA); PG8_STAGE(PG8_SB(1, 1), cB + hstep + kstep, voffB);
        PG8_WAIT_V(6); PG8_BAR;
    } else {
        PG8_STAGE(PG8_SB(0, 0), cB, voffB); PG8_STAGE(PG8_SA(0, 0), cA, voffA); PG8_STAGE(PG8_SB(0, 1), cB + hstep, voffB); PG8_STAGE(PG8_SA(0, 1), cA + hstep, voffA);
        if (wr == 1) PG8_BAR;
        PG8_WAIT_V(4); PG8_BAR;
        PG8_STAGE(PG8_SB(1, 0), cB + kstep, voffB); PG8_STAGE(PG8_SA(1, 0), cA + kstep, voffA); PG8_STAGE(PG8_SB(1, 1), cB + hstep + kstep, voffB);
        PG8_WAIT_V(6); PG8_BAR;
    }
    for (;;) {
        const bool has_next = S.next(ui + 1, nxt);
        const char* nA = has_next ? (const char*)g.A + (size_t)nxt.pm * tstep : cA; const char* nB = has_next ? (const char*)g.Bt + (size_t)nxt.pn * tstep : cB;
        for (int t = 0; t < nt; t += 2) {
            const bool last = (t == nt - 2);
            const char* a1 = cA + (size_t)(t + 1) * kstep;
            const char* a2 = last ? nA : cA + (size_t)(t + 2) * kstep; const char* b2 = last ? nB : cB + (size_t)(t + 2) * kstep;
            const char* a3 = a2 + kstep; const char* b3 = b2 + kstep;
            if (last && has_next) S.a_ready(nxt);
            if constexpr (SP2) {
            PG8_LDB(B0, 0, 0); PG8_LDB(B1, 0, 1); PG8_SCHED; PG8_LDA(At, 0, 0); PG8_STAGE(PG8_SA(1, 1), a1 + hstep, voffA);
            PG8_WAIT_V(8); PG8_WAIT_L(0); PG8_BAR; PG8_MMA(0, 0, At, B0); PG8_MMA(0, 1, At, B1); PG8_BAR; PG8_SCHED;
            PG8_LDA(At, 0, 1); PG8_STAGE(PG8_SB(0, 0), b2, voffB); PG8_STAGE(PG8_SB(0, 1), b2 + hstep, voffB); PG8_STAGE(PG8_SA(0, 0), a2, voffA);
            PG8_WAIT_V(8); PG8_WAIT_L(0); PG8_BAR; PG8_MMA(1, 0, At, B0); PG8_MMA(1, 1, At, B1); PG8_BAR; PG8_SCHED;
            PG8_LDB(B0, 1, 0); PG8_LDB(B1, 1, 1); PG8_SCHED; PG8_LDA(At, 1, 0); PG8_STAGE(PG8_SA(0, 1), a2 + hstep, voffA);
            PG8_WAIT_V(8); PG8_WAIT_L(0); PG8_BAR; PG8_MMA(0, 0, At, B0); PG8_MMA(0, 1, At, B1); PG8_BAR; PG8_SCHED;
            PG8_LDA(At, 1, 1); PG8_STAGE(PG8_SB(1, 0), b3, voffB); PG8_STAGE(PG8_SB(1, 1), b3 + hstep, voffB); PG8_STAGE(PG8_SA(1, 0), a3, voffA);
            PG8_WAIT_V(8); PG8_WAIT_L(0); PG8_BAR; PG8_MMA(1, 0, At, B0); PG8_MMA(1, 1, At, B1); PG8_BAR; PG8_SCHED;
            } else {
            PG8_LDB(B0, 0, 0); PG8_SCHED; PG8_LDA(At, 0, 0); PG8_STAGE(PG8_SA(1, 1), a1 + hstep, voffA);
            PG8_WAIT_L(8); PG8_BAR; PG8_WAIT_L(0); PG8_MMA(0, 0, At, B0); PG8_BAR; PG8_SCHED;
            PG8_LDB(B1, 0, 1); PG8_STAGE(PG8_SB(0, 0), b2, voffB);
            PG8_BAR; PG8_WAIT_L(0); PG8_MMA(0, 1, At, B1); PG8_BAR;
            PG8_LDA(At, 0, 1); PG8_STAGE(PG8_SA(0, 0), a2, voffA);
            PG8_BAR; PG8_WAIT_L(0); PG8_MMA(1, 0, At, B0); PG8_BAR; PG8_SCHED;
            PG8_STAGE(PG8_SB(0, 1), b2 + hstep, voffB);
            PG8_WAIT_V(6); PG8_BAR; PG8_MMA(1, 1, At, B1); PG8_BAR;
            PG8_LDB(B0, 1, 0); PG8_SCHED; PG8_LDA(At, 1, 0); PG8_STAGE(PG8_SA(0, 1), a2 + hstep, voffA);
            PG8_WAIT_L(8); PG8_BAR; PG8_WAIT_L(0); PG8_MMA(0, 0, At, B0); PG8_BAR; PG8_SCHED;
            PG8_LDB(B1, 1, 1); PG8_STAGE(PG8_SB(1, 0), b3, voffB);
            PG8_BAR; PG8_WAIT_L(0); PG8_MMA(0, 1, At, B1); PG8_BAR;
            PG8_LDA(At, 1, 1); PG8_STAGE(PG8_SA(1, 0), a3, voffA);
            PG8_BAR; PG8_WAIT_L(0); PG8_MMA(1, 0, At, B0); PG8_BAR; PG8_SCHED;
            PG8_STAGE(PG8_SB(1, 1), b3 + hstep, voffB);
            PG8_WAIT_V(6); PG8_BAR; PG8_MMA(1, 1, At, B1); PG8_BAR;
            }
        }
        if constexpr (ALIGN_EPI) { if (wr == 0) PG8_BAR; }
        if constexpr (!Epi::AFTER_DRAIN) { E(acc, cur, wr, wc, fr, fq); S.done(cur); }
        if (!has_next) break;
#pragma unroll
        for (int a = 0; a < 2; ++a)
#pragma unroll
            for (int b = 0; b < 2; ++b)
#pragma unroll
                for (int m = 0; m < 4; ++m)
#pragma unroll
                    for (int n = 0; n < 2; ++n) acc[a][b][m][n] = (f32x4){0.f, 0.f, 0.f, 0.f};
        cur = nxt; cA = nA; cB = nB; ++ui;
        if constexpr (ALIGN_EPI) { if (wr == 1) PG8_BAR; }
    }
    PG8_WAIT_V(0);
    if constexpr (!ALIGN_EPI) { if (wr == 0) PG8_BAR; }
    PG8_BAR;
    if constexpr (Epi::AFTER_DRAIN) { E.fused(acc, cur, wr, wc, fr, fq, lds, wid, lane); S.done(cur); }
#undef PG8_SA
#undef PG8_SB
#undef PG8_STAGE
#undef PG8_LDA
#undef PG8_LDB
#undef PG8_MMA
#undef PG8_WAIT_V
#undef PG8_WAIT_L
#undef PG8_BAR
#undef PG8_SCHED
}
}

namespace att {
using bf16x8 = __attribute__((ext_vector_type(8))) short;
using s16x4  = __attribute__((ext_vector_type(4))) short;
using f32x16 = __attribute__((ext_vector_type(16))) float;
using u32x4  = __attribute__((ext_vector_type(4))) unsigned;
constexpr int NW = 8, QBLK = 32, KVBLK = 64, DV = 128;
#define ATT_SBAR() __builtin_amdgcn_sched_barrier(0)
__device__ __forceinline__ int crow(int r, int hi) { return (r & 3) + 8 * (r >> 2) + 4 * hi; }
__device__ __forceinline__ unsigned cvtpk(float lo, float hi) { unsigned r; asm volatile("v_cvt_pk_bf16_f32 %0, %1, %2" : "=v"(r) : "v"(lo), "v"(hi)); return r; }
template <int DQK> __device__ __forceinline__ int kswz(int row, int colB) { return row * (DQK * 2) + (colB ^ ((row & 7) << 4)); }
constexpr float THR = 8.f;

template <int DQK> struct Cfg {
    static constexpr int SHM_V = KVBLK * DV * 2, SHM_K = KVBLK * DQK * 2;
    static constexpr int OFF_V = 0, OFF_K = 2 * SHM_V, OFF_WS = OFF_K + 2 * SHM_K, OFF_BIAS = OFF_WS + NW * 64 * 4, LDS_BYTES = OFF_BIAS + 10240;
    static constexpr int KCH = DQK / 8;
    static constexpr int KLD = (64 * KCH) / 512;
};

struct Job {
    const bf16_t* Q;
    const bf16_t* K;
    const bf16_t* V;
    bf16_t* O;
    int nt;
    int seg0_tiles, row_seg0, row_seg1;
    int R0; int rlo;
};

__device__ __forceinline__ int tile_row(const Job& J, int j) {
    if (j < J.seg0_tiles) return J.row_seg0 + 64 * j;
    int jj = j - J.seg0_tiles; if (jj > 3) jj = 0; return J.row_seg1 + 64 * jj;
}

__device__ __forceinline__ void partialSM(f32x16& p0, f32x16& p1, float& m_reg, float& mn, float& alpha, float C, float thr_raw) {
    float pmax = p0[0];
#pragma unroll
    for (int r = 1; r < 16; ++r) pmax = fmaxf(pmax, p0[r]);
#pragma unroll
    for (int r = 0; r < 16; ++r) pmax = fmaxf(pmax, p1[r]);
    { auto rr = __builtin_amdgcn_permlane32_swap(__float_as_uint(pmax), __float_as_uint(pmax), false, false);
      pmax = fmaxf(__uint_as_float(rr[0]), __uint_as_float(rr[1])); }
    if (__builtin_expect(__all(pmax - m_reg <= thr_raw), 1)) { mn = m_reg; alpha = 1.f; }
    else { mn = fmaxf(m_reg, pmax); alpha = __builtin_amdgcn_exp2f((m_reg - mn) * C); m_reg = mn; }
    const float mnC = -mn * C;
#pragma unroll
    for (int r = 0; r < 16; ++r) p0[r] = fmaf(p0[r], C, mnC);
#pragma unroll
    for (int r = 0; r < 16; ++r) p1[r] = fmaf(p1[r], C, mnC);
#pragma unroll
    for (int r = 0; r < 16; ++r) p0[r] = __builtin_amdgcn_exp2f(p0[r]);
}
__device__ __forceinline__ void finishSM(f32x16& p0, f32x16& p1, float alpha, float& l_reg, bf16x8& pa0, bf16x8& pa1, bf16x8& pa2, bf16x8& pa3) {
#pragma unroll
    for (int r = 0; r < 16; ++r) p1[r] = __builtin_amdgcn_exp2f(p1[r]);
    float ps = 0;
#pragma unroll
    for (int r = 0; r < 16; ++r) ps += p0[r];
#pragma unroll
    for (int r = 0; r < 16; ++r) ps += p1[r];
    { auto rr = __builtin_amdgcn_permlane32_swap(__float_as_uint(ps), __float_as_uint(ps), false, false);
      ps = __uint_as_float(rr[0]) + __uint_as_float(rr[1]); }
    l_reg = l_reg * alpha + ps;
#define ATT_PK4(P, BASE, OUT) do { unsigned a0 = cvtpk(P[BASE + 0], P[BASE + 1]), a1 = cvtpk(P[BASE + 2], P[BASE + 3]);   \
    unsigned b0 = cvtpk(P[BASE + 4], P[BASE + 5]), b1 = cvtpk(P[BASE + 6], P[BASE + 7]);                              \
    auto r0 = __builtin_amdgcn_permlane32_swap(a0, b0, false, false); auto r1 = __builtin_amdgcn_permlane32_swap(a1, b1, false, false); \
    u32x4 w = {r0[0], r1[0], r0[1], r1[1]}; OUT = *reinterpret_cast<bf16x8*>(&w); } while (0)
    ATT_PK4(p0, 0, pa0); ATT_PK4(p0, 8, pa1); ATT_PK4(p1, 0, pa2); ATT_PK4(p1, 8, pa3);
#undef ATT_PK4
}
template <int DQK> __device__ __forceinline__ void qkt(f32x16& p0, f32x16& p1, const char* Ks, const bf16x8* qr, int r32, int hi) {
    p0 = f32x16{}; p1 = f32x16{};
#pragma unroll
    for (int d0 = 0; d0 < DQK / 16; ++d0) { const int cb = (d0 * 16 + hi * 8) * 2;
        const bf16x8 b0 = *reinterpret_cast<const bf16x8*>(Ks + kswz<DQK>(r32, cb));
        const bf16x8 b1 = *reinterpret_cast<const bf16x8*>(Ks + kswz<DQK>(32 + r32, cb));
        p0 = __builtin_amdgcn_mfma_f32_32x32x16_bf16(b0, qr[d0], p0, 0, 0, 0);
        p1 = __builtin_amdgcn_mfma_f32_32x32x16_bf16(b1, qr[d0], p1, 0, 0, 0); }
}
__device__ __forceinline__ int v_st(int k, int c) { const int kk = (k & ~0xC) | ((k & 4) << 1) | ((k & 8) >> 1); return ((kk >> 3) * 4 + (c >> 5)) * 512 + ((kk & 7) * 32 + (c & 31)) * 2; }
__device__ __forceinline__ int v_rd_base(int lane) { return ((lane & 3) << 3) | (((lane >> 2) & 3) << 6) | (((lane >> 4) & 1) << 5) | (((lane >> 5) & 1) << 8); }
constexpr int v_rd_off(int d0, int ks, int half) { return d0 * 512 + ks * 4096 + half * 2048; }
template <int OFF> __device__ __forceinline__ s16x4 tr_read(int vb) { s16x4 r; asm volatile("ds_read_b64_tr_b16 %0, %1 offset:%2" : "=&v"(r) : "v"(vb), "i"(OFF) : "memory"); return r; }
template <int D0> __device__ __forceinline__ void pv_one(f32x16& od, int vb, bf16x8 pa0, bf16x8 pa1, bf16x8 pa2, bf16x8 pa3) {
    const s16x4 l0 = tr_read<v_rd_off(D0, 0, 0)>(vb), h0 = tr_read<v_rd_off(D0, 0, 1)>(vb), l1 = tr_read<v_rd_off(D0, 1, 0)>(vb), h1 = tr_read<v_rd_off(D0, 1, 1)>(vb);
    const s16x4 l2 = tr_read<v_rd_off(D0, 2, 0)>(vb), h2 = tr_read<v_rd_off(D0, 2, 1)>(vb), l3 = tr_read<v_rd_off(D0, 3, 0)>(vb), h3 = tr_read<v_rd_off(D0, 3, 1)>(vb);
    asm volatile("s_waitcnt lgkmcnt(0)" ::: "memory"); ATT_SBAR();
#define ATT_PK(L, H) (bf16x8){L[0], L[1], L[2], L[3], H[0], H[1], H[2], H[3]}
    od = __builtin_amdgcn_mfma_f32_32x32x16_bf16(pa0, ATT_PK(l0, h0), od, 0, 0, 0);
    od = __builtin_amdgcn_mfma_f32_32x32x16_bf16(pa1, ATT_PK(l1, h1), od, 0, 0, 0);
    od = __builtin_amdgcn_mfma_f32_32x32x16_bf16(pa2, ATT_PK(l2, h2), od, 0, 0, 0);
    od = __builtin_amdgcn_mfma_f32_32x32x16_bf16(pa3, ATT_PK(l3, h3), od, 0, 0, 0);
#undef ATT_PK
}
__device__ __forceinline__ void pv_d0(f32x16* o, int vb, bf16x8 pa0, bf16x8 pa1, bf16x8 pa2, bf16x8 pa3) {
    pv_one<0>(o[0], vb, pa0, pa1, pa2, pa3); pv_one<1>(o[1], vb, pa0, pa1, pa2, pa3); pv_one<2>(o[2], vb, pa0, pa1, pa2, pa3); pv_one<3>(o[3], vb, pa0, pa1, pa2, pa3);
}
constexpr int NA_BROW = 160, NA_BORG = 64 + (NA_KW - 1);
__device__ __forceinline__ void na_bias(f32x16& p0, f32x16& p1, const Job& J, int j, int R, int c, int hi, const float* biasq) {
    const int nloc = J.seg0_tiles;
    if (j >= nloc && j < nloc + 4) return;
    const int rr = J.rlo + j; int r0 = R - NA_KH / 2; r0 = r0 < 0 ? 0 : (r0 > ROWS - NA_KH ? ROWS - NA_KH : r0);
    const bool rowok = (j < nloc) && rr >= r0 && rr < r0 + NA_KH;
    if (!rowok) {
#pragma unroll
        for (int r = 0; r < 16; ++r) { p0[r] = -1e30f; p1[r] = -1e30f; }
        return; }
    int c0 = c - NA_KW / 2; c0 = c0 < 0 ? 0 : (c0 > GRID_W - NA_KW ? GRID_W - NA_KW : c0);
    const int dr = rr - R + (NA_KH - 1);
    const float* bl = biasq + dr * NA_BROW + NA_BORG + 4 * hi - c;
    const int vb = 4 * hi - c0;
#pragma unroll
    for (int r = 0; r < 16; ++r) { const int cc = (r & 3) + 8 * (r >> 2);
        p0[r] = ((unsigned)(cc + vb) < (unsigned)NA_KW) ? p0[r] + bl[cc] : -1e30f;
        p1[r] = ((unsigned)(cc + 32 + vb) < (unsigned)NA_KW) ? p1[r] + bl[cc + 32] : -1e30f; }
}

#define ATT_LAS __attribute__((address_space(3)))
template <int DQK, bool NA, int LDQ, int LDK, int LDV, int LDO>
__device__ __forceinline__ void attn_unit(const Job& J, char* lds, const float scale, const int tid_in) {
    using C_ = Cfg<DQK>;
    int tid_ = tid_in; asm volatile("" : "+v"(tid_));
    const int tid = tid_, wid = __builtin_amdgcn_readfirstlane(tid >> 6), lane = tid & 63, r32 = lane & 31, hi = lane >> 5;
    char* V_lds = lds + C_::OFF_V; char* K_lds = lds + C_::OFF_K;
    const unsigned ldsb = (unsigned)(uintptr_t)lds;
    float* wsf = (float*)(lds + C_::OFF_WS) + wid * 64; float* li_l = wsf; float* al_l = wsf + 32;
    const float* biasq = (const float*)(lds + C_::OFF_BIAS);
    const float Cc = scale * 1.4426950408889634f, thr_raw = THR / scale;
    float m_reg = -1e5f, l_reg = 0; f32x16 o[4] = {}; bf16x8 qr[DQK / 16];
    const bf16_t* Qw = J.Q + (long)(wid * QBLK + r32) * LDQ + hi * 8;
#pragma unroll
    for (int d0 = 0; d0 < DQK / 16; ++d0) qr[d0] = *reinterpret_cast<const bf16x8*>(Qw + d0 * 16);
    const int naR = J.R0 + (wid >> 1), nac = (wid & 1) * 32 + r32;
    const int vb0 = (int)(uintptr_t)V_lds + v_rd_base(lane);
    unsigned koff[C_::KLD], voff[2];
#pragma unroll
    for (int i = 0; i < C_::KLD; ++i) { const int sl = 512 * i + tid, row = sl / C_::KCH, cs = sl % C_::KCH, chunk = (cs & ~7) | ((cs & 7) ^ (row & 7)); koff[i] = (unsigned)(row * LDK * 2 + chunk * 16); }
#pragma unroll
    for (int i = 0; i < 2; ++i) { const int sl = 512 * i + tid, sub = sl >> 5, wi = sl & 31, kk = (sub >> 2) * 8 + (wi >> 2), k = (kk & ~0xC) | ((kk & 4) << 1) | ((kk & 8) >> 1), c = (sub & 3) * 32 + (wi & 3) * 8;
        voff[i] = (unsigned)(k * LDV * 2 + c * 2); }
#define ATT_STAGE(j, b) do { const int row0_ = tile_row(J, (j)); const char* vp_ = (const char*)(J.V + (size_t)row0_ * LDV); const char* kp_ = (const char*)(J.K + (size_t)row0_ * LDK); \
        _Pragma("unroll") for (int i_ = 0; i_ < C_::KLD; ++i_) __builtin_amdgcn_global_load_lds((const unsigned*)(kp_ + koff[i_]), (ATT_LAS unsigned*)(ldsb + C_::OFF_K + (b) * C_::SHM_K + (512 * i_ + 64 * wid) * 16), 16, 0, 0); \
        _Pragma("unroll") for (int i_ = 0; i_ < 2; ++i_) __builtin_amdgcn_global_load_lds((const unsigned*)(vp_ + voff[i_]), (ATT_LAS unsigned*)(ldsb + C_::OFF_V + (b) * C_::SHM_V + (512 * i_ + 64 * wid) * 16), 16, 0, 0); } while (0)
    const int NT = J.nt;
    __syncthreads();
    ATT_STAGE(0, 0); asm volatile("s_waitcnt vmcnt(0)" ::: "memory"); __syncthreads();
    for (int j = 0; j < NT; ++j) {
        const int buf = j & 1;
        if (j + 1 < NT) ATT_STAGE(j + 1, buf ^ 1);
        f32x16 p0, p1; float mn, al; bf16x8 pa0, pa1, pa2, pa3;
        qkt<DQK>(p0, p1, K_lds + buf * C_::SHM_K, qr, r32, hi);
        if (NA) na_bias(p0, p1, J, j, naR, nac, hi, biasq);
        partialSM(p0, p1, m_reg, mn, al, Cc, thr_raw);
        finishSM(p0, p1, al, l_reg, pa0, pa1, pa2, pa3);
        if (__any(al < 1.f)) { if (hi == 0) al_l[r32] = al; asm volatile("s_waitcnt lgkmcnt(0)" ::: "memory");
#pragma unroll
            for (int d = 0; d < 4; ++d)
#pragma unroll
                for (int r = 0; r < 16; ++r) o[d][r] *= al_l[crow(r, hi)]; }
        ATT_SBAR();
        pv_d0(o, vb0 + buf * C_::SHM_V, pa0, pa1, pa2, pa3);
        asm volatile("s_waitcnt vmcnt(0)" ::: "memory");
        __syncthreads();
    }
    if (hi == 0) li_l[r32] = l_reg; asm volatile("s_waitcnt lgkmcnt(0)" ::: "memory");
    float rli[16];
#pragma unroll
    for (int r = 0; r < 16; ++r) rli[r] = __builtin_amdgcn_rcpf(li_l[crow(r, hi)]);
    bf16_t* Ow = J.O + (long)(wid * QBLK) * LDO;
#pragma unroll
    for (int r = 0; r < 16; ++r) { const int orow = crow(r, hi);
#pragma unroll
        for (int d0 = 0; d0 < 4; ++d0) Ow[(long)orow * LDO + d0 * 32 + r32] = f2bf(o[d0][r] * rli[r]); }
#undef ATT_STAGE
}
}

struct AttnArgs { const bf16_t *QM, *KM, *VM, *NQ, *NK, *P; bf16_t* Y; const float* rpb; int want_ctx; int pad; };
__device__ __forceinline__ void attention_phase(const AttnArgs& A, char* lds, int G, int wg, const int tid) {
    static_assert(GRID_W == 64 && SEQ % 256 == 0 && CTX_LEN == 256 && HD == 128, "attention phase geometry");
    constexpr int NQB = SEQ / 256;
    constexpr float sc_mla = 0.07216878364870323f, sc_na = 0.08838834764831845f;
    static_assert(MLA_QK == 192 && HD == 128, "softmax scales");
    if (!(A.pad & 2)) for (int u = wg; u < BATCH * NH * NQB; u += G) {
        const int bh = u % (BATCH * NH), qb = u / (BATCH * NH), b = bh / NH, h = bh % NH;
        att::Job J{};
        J.Q = A.QM + (size_t)(b * SEQ + qb * 256) * NQ_MLA + h * MLA_QK; J.K = A.KM + h * MLA_QK; J.V = A.VM + h * MLA_V;
        J.O = A.Y + (size_t)(b * SEQ + qb * 256) * D_MODEL + GROUP_W + h * MLA_V;
        J.nt = SEQ / 64 + CTX_LEN / 64; J.seg0_tiles = SEQ / 64; J.row_seg0 = b * SEQ; J.row_seg1 = M_LAT + b * CTX_LEN;
        att::attn_unit<MLA_QK, false, NQ_MLA, NQ_MLA, NH * MLA_V, D_MODEL>(J, lds, sc_mla, tid);
    }
    if (!(A.pad & 4)) for (int u = wg; u < BATCH * NH * NQB; u += G) {
        const int bh = u % (BATCH * NH), qb = u / (BATCH * NH), b = bh / NH, h = bh % NH, R0 = qb * 4;
        __syncthreads();
        { float* bq = (float*)(lds + att::Cfg<HD>::OFF_BIAS); const float* src = A.rpb + (size_t)h * (2 * NA_KH - 1) * (2 * NA_KW - 1);
          for (int i = tid; i < (2 * NA_KH - 1) * att::NA_BROW; i += 512) { const int dr = i / att::NA_BROW; int dc = i % att::NA_BROW - att::NA_BORG + (NA_KW - 1); dc = dc < 0 ? 0 : (dc > 2 * NA_KW - 2 ? 2 * NA_KW - 2 : dc);
              bq[i] = src[dr * (2 * NA_KW - 1) + dc] * 11.313708498984761f; } }
        int rlo = R0 - NA_KH / 2; rlo = rlo < 0 ? 0 : (rlo > ROWS - NA_KH ? ROWS - NA_KH : rlo);
        int rhi = R0 + 3 - NA_KH / 2; rhi = (rhi < 0 ? 0 : (rhi > ROWS - NA_KH ? ROWS - NA_KH : rhi)) + NA_KH - 1;
        const int nloc = rhi - rlo + 1;
        att::Job J{};
        J.Q = A.NQ + (size_t)(b * SEQ + R0 * 64) * GROUP_W + h * HD; J.K = A.NK + h * HD; J.V = A.P + C_NV + h * HD;
        J.O = A.Y + (size_t)(b * SEQ + R0 * 64) * D_MODEL + 3 * GROUP_W + h * HD;
        J.nt = (nloc + 4 + 1) & ~1; J.seg0_tiles = nloc; J.row_seg0 = b * SEQ + rlo * 64; J.row_seg1 = M_LAT + b * CTX_LEN;  J.R0 = R0; J.rlo = rlo;
        att::attn_unit<HD, true, GROUP_W, GROUP_W, NP, D_MODEL>(J, lds, sc_na, tid);
    }
    if (A.want_ctx && !(A.pad & 8)) {
        for (int u = wg; u < BATCH * NH; u += G) {
            const int b = u / NH, h = u % NH; const int crow0 = M_LAT + b * CTX_LEN;
            att::Job J{}; J.nt = CTX_LEN / 64; J.seg0_tiles = 0; J.row_seg0 = crow0; J.row_seg1 = crow0;
            J.Q = A.QM + (size_t)crow0 * NQ_MLA + h * MLA_QK; J.K = A.KM + h * MLA_QK; J.V = A.VM + h * MLA_V;
            J.O = A.Y + (size_t)crow0 * D_MODEL + GROUP_W + h * MLA_V; att::attn_unit<MLA_QK, false, NQ_MLA, NQ_MLA, NH * MLA_V, D_MODEL>(J, lds, sc_mla, tid);
        }
        for (int u = wg - BATCH * NH; u >= 0 && u < BATCH * NH; u += G) {
            const int b = u / NH, h = u % NH; const int crow0 = M_LAT + b * CTX_LEN;
            att::Job J{}; J.nt = CTX_LEN / 64; J.seg0_tiles = 0; J.row_seg0 = crow0; J.row_seg1 = crow0;
            J.Q = A.NQ + (size_t)crow0 * GROUP_W + h * HD; J.K = A.NK + h * HD; J.V = A.P + C_NV + h * HD;
            J.O = A.Y + (size_t)crow0 * D_MODEL + 3 * GROUP_W + h * HD; att::attn_unit<HD, false, GROUP_W, GROUP_W, NP, D_MODEL>(J, lds, sc_na, tid);
        }
    }
}

namespace gdn {
typedef short bf16x8 __attribute__((ext_vector_type(8)));
typedef float f32x4 __attribute__((ext_vector_type(4)));
typedef float f32x16 __attribute__((ext_vector_type(16)));
typedef unsigned u32x2 __attribute__((ext_vector_type(2)));
typedef unsigned u32x4 __attribute__((ext_vector_type(4)));
constexpr int CH = 64, NCHUNK = M_ALL / CH;
constexpr int NTASK = NCHUNK * NH * 2;
constexpr size_t SZ_UT = 128 * 64, SZ_WP = 64 * 128, SZ_KDT = 128 * 64, SZ_QD = 64 * 128, SZ_QK = 64 * 64, SZ_SIT = 128 * 128, SZ_VNT = 128 * 64;
struct Bufs { bf16_t *UT, *WP, *KDT, *QD, *QK, *SIT, *VNT; float* GT; };
__device__ __forceinline__ int perm32(int o) { return (o & ~31) | (((o & 15) >> 2) * 8 + ((o >> 4) & 1) * 4 + (o & 3)); }
__device__ __forceinline__ unsigned pk2(float lo, float hi) { return (unsigned)f2bf(lo) | ((unsigned)f2bf(hi) << 16); }

constexpr int QS = 132;
constexpr int AS = 68;
constexpr int G1_OFF_Q = 0, G1_OFF_K = G1_OFF_Q + CH * QS * 4, G1_OFF_V = G1_OFF_K + CH * QS * 4, G1_OFF_AA = G1_OFF_V + CH * QS * 4, G1_OFF_SM = G1_OFF_AA + 2 * CH * AS * 4,
              G1_LDS = G1_OFF_SM + 12 * 64 * 4;
struct G1Args { const bf16_t* P; const float* conv_w; const float* a_log; const float* dt_bias; Bufs B; int pflags; };

__device__ __forceinline__ void g1_task(const G1Args& A, char* lds, int cix, int h, const int tid_in) {
    int tid_ = tid_in; asm volatile("" : "+v"(tid_));
    const int tid = tid_, wid = __builtin_amdgcn_readfirstlane(tid >> 6), lane = tid & 63;
    float* Qs = (float*)(lds + G1_OFF_Q); float* Ks = (float*)(lds + G1_OFF_K); float* Vs = (float*)(lds + G1_OFF_V); float* AA = (float*)(lds + G1_OFF_AA);
    float* sm = (float*)(lds + G1_OFF_SM); float* g_s = sm;   float* beta_s = sm + 128;   float* gc_s = sm + 256;
    const int row0 = cix * CH; const RowInfo r0i = row_info(row0);
    LDS_BARRIER();
    if (tid < 48 * 8) {
        const int grp = tid % 48, ts = tid / 48, which = grp >> 4, cc0 = (grp & 15) * 8, ch0 = which * GROUP_W + h * HD + cc0;
        float wgt[4][8];
#pragma unroll
        for (int j = 0; j < 4; ++j) { const f32x4 w0 = *(const f32x4*)(A.conv_w + j * 3 * GROUP_W + ch0), w1 = *(const f32x4*)(A.conv_w + j * 3 * GROUP_W + ch0 + 4);
#pragma unroll
            for (int e = 0; e < 4; ++e) { wgt[j][e] = w0[e]; wgt[j][4 + e] = w1[e]; } }
        u32x4 xr[11];
#pragma unroll
        for (int k = 0; k < 11; ++k) { const int tt = r0i.t + 8 * ts + k - 1;
            xr[k] = (tt >= 0 && tt < r0i.T) ? *(const u32x4*)(A.P + (size_t)(r0i.base + tt) * NP + C_GQ + ch0) : (u32x4){0u, 0u, 0u, 0u}; }
        float* dstp = (which == 0 ? Qs : which == 1 ? Ks : Vs) + cc0;
#pragma unroll
        for (int i = 0; i < 8; ++i) { float acc[8];
#pragma unroll
            for (int e = 0; e < 8; ++e) acc[e] = 0.f;
#pragma unroll
            for (int j = 0; j < 4; ++j) { const u32x4 xv = xr[i + j];
#pragma unroll
                for (int e = 0; e < 4; ++e) { acc[2 * e] += wgt[j][2 * e] * bflo(xv[e]); acc[2 * e + 1] += wgt[j][2 * e + 1] * bfhi(xv[e]); } }
            f32x4 y0, y1;
#pragma unroll
            for (int e = 0; e < 4; ++e) { y0[e] = acc[e] / (1.0f + __expf(-acc[e])); y1[e] = acc[4 + e] / (1.0f + __expf(-acc[4 + e])); }
            *(f32x4*)(dstp + (8 * ts + i) * QS) = y0; *(f32x4*)(dstp + (8 * ts + i) * QS + 4) = y1; }
    }
    if (tid < 128) { const int d = tid >> 6, i = tid & 63; const size_t r = (size_t)(row0 + i) * NP;
        beta_s[d * 64 + i] = 1.0f / (1.0f + __expf(-bf2f(A.P[r + C_GB + d * NH + h])));
        g_s[d * 64 + i] = -__expf(A.a_log[d * NH + h]) * softplusf_(bf2f(A.P[r + C_GA + d * NH + h]) + A.dt_bias[d * NH + h]); }
    LDS_BARRIER();
    for (int rr = wid; rr < 2 * CH; rr += 8) { float* rowp = (rr < CH ? Qs : Ks) + (rr & 63) * QS;
        const float a = rowp[lane], b = rowp[lane + 64]; float ss = a * a + b * b;
#pragma unroll
        for (int o = 1; o < 64; o <<= 1) ss += lane_xor(ss, o, lane);
        const float scl = (1.0f / sqrtf(ss + EPS)) * (rr < CH ? 0.08838834764831845f : 1.0f);
        rowp[lane] = a * scl; rowp[lane + 64] = b * scl; }
    if (tid < 2) {
        f32x4 gv[16];
#pragma unroll
        for (int m = 0; m < 16; ++m) gv[m] = *(const f32x4*)(g_s + tid * 64 + 4 * m);
        float run = 0.f;
        if (tid == 0) {
#pragma unroll
            for (int m = 0; m < 16; ++m) { f32x4 o4;
#pragma unroll
                for (int e = 0; e < 4; ++e) { run += gv[m][e]; o4[e] = run; }
                *(f32x4*)(gc_s + 4 * m) = o4; }
        } else {
#pragma unroll
            for (int m = 15; m >= 0; --m) { f32x4 o4;
#pragma unroll
                for (int e = 3; e >= 0; --e) { run += gv[m][e]; o4[e] = run; }
                *(f32x4*)(gc_s + 64 + 4 * m) = o4; }
        }
    }
    LDS_BARRIER();
    float* eq_s = sm + 384; float* ek_s = sm + 512;
    if (tid < 128) { const int d = tid >> 6, i = tid & 63; const float gci = gc_s[d * 64 + i], glast = d == 0 ? gc_s[63] : gc_s[64];
        eq_s[tid] = __expf(gci); ek_s[tid] = __expf(glast - gci); }
    const int gwhich = wid >> 2, gI = (wid >> 1) & 1, gJ = wid & 1, r32 = lane & 31, hi = lane >> 5;
    f32x16 acc = {};
    {
        const float* X = (gwhich ? Qs : Ks) + (32 * gI + r32) * QS + 4 * hi; const float* Yp = Ks + (32 * gJ + r32) * QS + 4 * hi;
#pragma unroll
        for (int s = 0; s < 16; ++s) { const f32x4 a4 = *(const f32x4*)(X + 8 * s), b4 = *(const f32x4*)(Yp + 8 * s);
#pragma unroll
            for (int e = 0; e < 4; ++e) acc = __builtin_amdgcn_mfma_f32_32x32x2f32(a4[e], b4[e], acc, 0, 0, 0); }
        const int j = 32 * gJ + r32;
        if (gwhich == 0) {
            const float b1j = beta_s[64 + j], g0j = gc_s[j], g1j = gc_s[64 + j];
#pragma unroll
            for (int r = 0; r < 16; ++r) { const int i = 32 * gI + (r & 3) + 8 * (r >> 2) + 4 * hi;
                if (i > j) { const float kk = acc[r];
                    AA[(63 - j) * AS + (63 - i)] = beta_s[i] * kk * __expf(gc_s[i] - g0j);
                    AA[CH * AS + i * AS + j] = b1j * kk * __expf(g1j - gc_s[64 + i]); } }
        }
    }
    LDS_BARRIER();
    const size_t t0 = ((size_t)cix * NH + h) * 2;
    {
#pragma unroll
        for (int n = 0; n < 4; ++n) { const int it = tid + 512 * n, d = it >> 10, p = (it >> 4) & 63, m = it & 15, i = d == 0 ? p : 63 - p, k0 = 32 * (m >> 2) + 4 * (m & 3);
            const float e = eq_s[d * 64 + i]; const f32x4 lo = *(const f32x4*)(Qs + i * QS + k0), hi4 = *(const f32x4*)(Qs + i * QS + k0 + 16);
            *(u32x4*)(A.B.QD + (t0 + d) * SZ_QD + (size_t)p * 128 + m * 8) = (u32x4){pk2(lo[0] * e, lo[1] * e), pk2(lo[2] * e, lo[3] * e), pk2(hi4[0] * e, hi4[1] * e), pk2(hi4[2] * e, hi4[3] * e)}; }
#pragma unroll
        for (int n = 0; n < 4; ++n) { const int it = tid + 512 * n, k = it & 127, d = (it >> 7) & 1, m = it >> 8, p0 = 32 * (m >> 2) + 4 * (m & 3);
            float v[8];
#pragma unroll
            for (int jj = 0; jj < 8; ++jj) { const int p = p0 + (jj < 4 ? jj : 12 + jj), i = d == 0 ? p : 63 - p; v[jj] = Ks[i * QS + k] * ek_s[d * 64 + i]; }
            *(u32x4*)(A.B.KDT + (t0 + d) * SZ_KDT + (size_t)k * 64 + m * 8) = (u32x4){pk2(v[0], v[1]), pk2(v[2], v[3]), pk2(v[4], v[5]), pk2(v[6], v[7])}; }
        if (tid == 0) { A.B.GT[t0] = __expf(gc_s[63]); A.B.GT[t0 + 1] = __expf(gc_s[64]); }
    }
    LDS_BARRIER();
    bf16_t* stg = (bf16_t*)Qs;
    if (gwhich == 1) { const int j = 32 * gJ + r32; const float g0j = gc_s[j], g1j = gc_s[64 + j];
#pragma unroll
        for (int r = 0; r < 16; ++r) { const int i = 32 * gI + (r & 3) + 8 * (r >> 2) + 4 * hi; const float qk = acc[r];
            stg[i * 64 + perm32(j)] = f2bf(i >= j ? qk * __expf(gc_s[i] - g0j) : 0.f);
            stg[4096 + (63 - i) * 64 + perm32(63 - j)] = f2bf(i <= j ? qk * __expf(gc_s[64 + i] - g1j) : 0.f); } }
    LDS_BARRIER();
#pragma unroll
    for (int n = 0; n < 2; ++n) { const int c16 = tid + 512 * n; *(u32x4*)(A.B.QK + t0 * SZ_QK + (size_t)c16 * 8) = *(const u32x4*)(stg + c16 * 8); }
    {
        int tidv = tid; asm volatile("" : "+v"(tidv));
        const int d = tidv >> 8, c = tidv & 255; const bool isw = c >= 128; const int cc = c & 127;
        const float* src = isw ? Ks : Vs;
        int lz; asm volatile("v_mov_b32 %0, 0" : "=v"(lz));
        const float* AAv = AA + lz + d * (CH * AS);
        float x[CH];
#pragma unroll
        for (int p = 0; p < CH; ++p) { const int i = d == 0 ? p : 63 - p; float f = beta_s[d * 64 + i]; if (isw) f *= eq_s[d * 64 + i]; x[p] = f * src[i * QS + cc]; }
        {
#pragma unroll
            for (int p = 0; p < CH - 1; ++p) { const float xp = x[p]; const float* rowp = AAv + (63 - p) * AS;
#pragma unroll
                for (int m = 0; m <= (62 - p) / 4; ++m) { const f32x4 a4 = *(const f32x4*)(rowp + 4 * m);
#pragma unroll
                    for (int e = 0; e < 4; ++e) { const int col = 4 * m + e; if (col <= 62 - p) x[63 - col] -= a4[e] * xp; } } }
        }
        LDS_BARRIER();
        if (!isw) { bf16_t* dst = A.B.UT + (t0 + d) * SZ_UT + (size_t)((cc >> 4) * 2 * 64 + (cc & 15)) * 8;
#pragma unroll
            for (int s = 0; s < 2; ++s)
#pragma unroll
                for (int qq = 0; qq < 4; ++qq) { const int p0 = 32 * s + 4 * qq; u32x4 w4; w4.x = pk2(x[p0], x[p0 + 1]); w4.y = pk2(x[p0 + 2], x[p0 + 3]); w4.z = pk2(x[p0 + 16], x[p0 + 17]); w4.w = pk2(x[p0 + 18], x[p0 + 19]);
                    *(u32x4*)(dst + (size_t)(s * 64 + qq * 16) * 8) = w4; }
        } else { bf16_t* dst = stg + d * 8192 + perm32(cc);
#pragma unroll
            for (int p = 0; p < CH; ++p) dst[p * 128] = f2bf(x[p]); }
    }
    LDS_BARRIER();
#pragma unroll
    for (int n = 0; n < 4; ++n) { const int c16 = tid + 512 * n; *(u32x4*)(A.B.WP + t0 * SZ_WP + (size_t)c16 * 8) = *(const u32x4*)(stg + c16 * 8); }
}
__device__ __forceinline__ void g1_phase(const G1Args& A, char* lds, int G, int wg, const int tid) {
    for (int t = wg; t < NCHUNK * NH; t += G) g1_task(A, lds, t / NH, t % NH, tid);
}

constexpr int G2_SPLIT = 4, G2_NACT = 8 / G2_SPLIT;
constexpr int G2_USL = G2_NACT * 2 * 64 * 16;
constexpr int G2_BUF = 16384 + 16384 + G2_USL, G2_NB = 4, G2_LDS = G2_NB * G2_BUF;
static_assert(G2_SPLIT == 4 && G2_USL == 4096, "G2 staging map below assumes 4 KB of u per step");
__device__ __forceinline__ int g2_task_index(int b, int h, int d, int step) {
    constexpr int NC = CTX_LEN / CH, NL = SEQ / CH; int cix;
    if (step < NC) { const int n = d ? NC - 1 - step : step; cix = M_LAT / CH + b * NC + n; }
    else { const int s2 = step - NC, n = d ? NL - 1 - s2 : s2; cix = b * NL + n; }
    return (cix * NH + h) * 2 + d;
}
__device__ __forceinline__ void g2_chain(const Bufs& B, char* lds, int chain_part, const int tid_in) {
    int tid_ = tid_in; asm volatile("" : "+v"(tid_));
    const int tid = tid_, wid = __builtin_amdgcn_readfirstlane(tid >> 6), lane = tid & 63, q = lane >> 4, vl = lane & 15;
    const int chain = chain_part / G2_SPLIT, part = chain_part % G2_SPLIT;
    const bool active = wid < G2_NACT; const int vt = part * G2_NACT + (active ? wid : 0);
    const int d = chain & 1, h = (chain >> 1) % NH, b = chain / (2 * NH);
    constexpr int NSTEP = CTX_LEN / CH + SEQ / CH;
    const unsigned ldsb = (unsigned)(uintptr_t)lds;
    f32x4 S[8];
#pragma unroll
    for (int kb = 0; kb < 8; ++kb) S[kb] = (f32x4){0.f, 0.f, 0.f, 0.f};
    unsigned offw[2], offk[2], offu;
#pragma unroll
    for (int i = 0; i < 2; ++i) { const int sl = 128 * wid + 64 * i + lane;
        { const int row = sl >> 4, pc = sl & 15, c = pc ^ (row & 15); offw[i] = (unsigned)(row * 256 + c * 16); }
        { const int row = sl >> 3, pc = sl & 7, c = pc ^ ((row >> 1) & 7); offk[i] = (unsigned)(row * 128 + c * 16); } }
    offu = (unsigned)((part * G2_NACT * 2 * 64 + (wid & 3) * 64 + lane) * 16);
#define G2_DMA(ti, slot) do { const char* wp_ = (const char*)(B.WP + (size_t)(ti) * SZ_WP); const char* kp_ = (const char*)(B.KDT + (size_t)(ti) * SZ_KDT); const unsigned base_ = ldsb + (unsigned)(slot) * G2_BUF; \
        _Pragma("unroll") for (int i_ = 0; i_ < 2; ++i_) { \
            __builtin_amdgcn_global_load_lds((const unsigned*)(wp_ + offw[i_]), (ATT_LAS unsigned*)(base_ + (128 * wid + 64 * i_) * 16), 16, 0, 0); \
            __builtin_amdgcn_global_load_lds((const unsigned*)(kp_ + offk[i_]), (ATT_LAS unsigned*)(base_ + 16384 + (128 * wid + 64 * i_) * 16), 16, 0, 0); } \
        if (wid >= 4) __builtin_amdgcn_global_load_lds((const unsigned*)((const char*)(B.UT + (size_t)(ti) * SZ_UT) + offu), (ATT_LAS unsigned*)(base_ + 32768 + ((wid & 3) * 64) * 16), 16, 0, 0); } while (0)
#define G2_TI(step) g2_task_index(b, h, d, (step) < NSTEP ? (step) : NSTEP - 1)
    __syncthreads();
    G2_DMA(G2_TI(0), 0); G2_DMA(G2_TI(1), 1); G2_DMA(G2_TI(2), 2);
    asm volatile("s_waitcnt vmcnt(0)" ::: "memory");
    __syncthreads();
    for (int step = 0; step < NSTEP; ++step) {
        const int ti = G2_TI(step), slot = step & 3;
        G2_DMA(G2_TI(step + 3), (step + 3) & 3);
        unsigned gtb; { const float* gp = B.GT + ti; asm volatile("s_load_dword %0, %1, 0x0" : "=s"(gtb) : "s"(gp)); }
        const char* wl = lds + slot * G2_BUF; const char* kl = wl + 16384; const char* ul = kl + 16384;
        if (active) {
            bf16x8 aw[16], ak[16];
#pragma unroll
            for (int rb = 0; rb < 4; ++rb)
#pragma unroll
                for (int s = 0; s < 4; ++s) aw[rb * 4 + s] = *(const bf16x8*)(wl + (16 * rb + vl) * 256 + (((4 * s + q) ^ vl) << 4));
#pragma unroll
            for (int kb = 0; kb < 8; ++kb)
#pragma unroll
                for (int s = 0; s < 2; ++s) ak[kb * 2 + s] = *(const bf16x8*)(kl + (16 * kb + vl) * 128 + (((4 * s + q) ^ ((vl >> 1) & 7)) << 4));
            u32x4 uu[2];
#pragma unroll
            for (int s = 0; s < 2; ++s) uu[s] = *(const u32x4*)(ul + ((wid * 2 + s) * 64 + lane) * 16);
            bf16_t* sit = B.SIT + (size_t)ti * SZ_SIT + (size_t)(vt * 4 * 64 + lane) * 8;
            bf16x8 sf[4];
#pragma unroll
            for (int s = 0; s < 4; ++s) { u32x4 w4; w4.x = pk2(S[2 * s][0], S[2 * s][1]); w4.y = pk2(S[2 * s][2], S[2 * s][3]); w4.z = pk2(S[2 * s + 1][0], S[2 * s + 1][1]); w4.w = pk2(S[2 * s + 1][2], S[2 * s + 1][3]);
                sf[s] = __builtin_bit_cast(bf16x8, w4); *(u32x4*)(sit + (size_t)s * 64 * 8) = w4; }
            __builtin_amdgcn_sched_barrier(0);
            f32x4 vn[4];
#pragma unroll
            for (int rb = 0; rb < 4; ++rb) vn[rb] = (f32x4){0.f, 0.f, 0.f, 0.f};
#pragma unroll
            for (int s = 0; s < 4; ++s)
#pragma unroll
                for (int rb = 0; rb < 4; ++rb) vn[rb] = __builtin_amdgcn_mfma_f32_16x16x32_bf16(aw[rb * 4 + s], sf[s], vn[rb], 0, 0, 0);
#pragma unroll
            for (int s = 0; s < 2; ++s) { const f32x4 a0 = vn[2 * s], a1 = vn[2 * s + 1];
                vn[2 * s][0] = bflo(uu[s].x) - a0[0]; vn[2 * s][1] = bfhi(uu[s].x) - a0[1]; vn[2 * s][2] = bflo(uu[s].y) - a0[2]; vn[2 * s][3] = bfhi(uu[s].y) - a0[3];
                vn[2 * s + 1][0] = bflo(uu[s].z) - a1[0]; vn[2 * s + 1][1] = bfhi(uu[s].z) - a1[1]; vn[2 * s + 1][2] = bflo(uu[s].w) - a1[2]; vn[2 * s + 1][3] = bfhi(uu[s].w) - a1[3]; }
            bf16_t* vnt = B.VNT + (size_t)ti * SZ_VNT + (size_t)(vt * 2 * 64 + lane) * 8;
            bf16x8 vf[2];
#pragma unroll
            for (int s = 0; s < 2; ++s) { u32x4 w4; w4.x = pk2(vn[2 * s][0], vn[2 * s][1]); w4.y = pk2(vn[2 * s][2], vn[2 * s][3]); w4.z = pk2(vn[2 * s + 1][0], vn[2 * s + 1][1]); w4.w = pk2(vn[2 * s + 1][2], vn[2 * s + 1][3]);
                vf[s] = __builtin_bit_cast(bf16x8, w4); *(u32x4*)(vnt + (size_t)s * 64 * 8) = w4; }
            asm volatile("s_waitcnt lgkmcnt(0)" ::: "memory");
            const float gt = __uint_as_float(gtb);
#pragma unroll
            for (int kb = 0; kb < 8; ++kb) S[kb] = S[kb] * gt;
#pragma unroll
            for (int s = 0; s < 2; ++s)
#pragma unroll
                for (int kb = 0; kb < 8; ++kb) S[kb] = __builtin_amdgcn_mfma_f32_16x16x32_bf16(ak[kb * 2 + s], vf[s], S[kb], 0, 0, 0);
            __builtin_amdgcn_sched_barrier(0);
            asm volatile("s_waitcnt vmcnt(26) lgkmcnt(0)\n\ts_barrier" ::: "memory");
        } else if (wid >= 4) {
            asm volatile("s_waitcnt vmcnt(10) lgkmcnt(0)\n\ts_barrier" ::: "memory");
        } else {
            asm volatile("s_waitcnt vmcnt(8) lgkmcnt(0)\n\ts_barrier" ::: "memory");
        }
    }
    asm volatile("s_waitcnt vmcnt(0)" ::: "memory");
    __syncthreads();
#undef G2_DMA
#undef G2_TI
}

constexpr int G3_LDS = 8 * 64 * 4 * 2;
struct G3Args { Bufs B; const bf16_t* P; const float* norm_g; bf16_t* Y; };
__device__ __forceinline__ void g3_task(const G3Args& A, char* lds, int cix, int h, const int tid_in) {
    int tid_ = tid_in; asm volatile("" : "+v"(tid_));
    const int tid = tid_, wid = __builtin_amdgcn_readfirstlane(tid >> 6), lane = tid & 63, q = lane >> 4, vl = lane & 15;
    float* part = (float*)lds;
    f32x4 o[2][4];
#pragma unroll
    for (int d = 0; d < 2; ++d) {
        const size_t t = ((size_t)cix * NH + h) * 2 + d;
        const bf16_t* sit = A.B.SIT + t * SZ_SIT + (size_t)(wid * 4 * 64 + lane) * 8;
        const bf16_t* vnt = A.B.VNT + t * SZ_VNT + (size_t)(wid * 2 * 64 + lane) * 8;
        const bf16_t* qd = A.B.QD + t * SZ_QD + (size_t)vl * 128 + 8 * q;
        const bf16_t* qk = A.B.QK + t * SZ_QK + (size_t)vl * 64 + 8 * q;
        bf16x8 sf[4], vf[2];
#pragma unroll
        for (int s = 0; s < 4; ++s) sf[s] = *(const bf16x8*)(sit + (size_t)s * 64 * 8);
#pragma unroll
        for (int s = 0; s < 2; ++s) vf[s] = *(const bf16x8*)(vnt + (size_t)s * 64 * 8);
#pragma unroll
        for (int rb = 0; rb < 4; ++rb) { f32x4 acc = {0.f, 0.f, 0.f, 0.f};
#pragma unroll
            for (int s = 0; s < 4; ++s) acc = __builtin_amdgcn_mfma_f32_16x16x32_bf16(*(const bf16x8*)(qd + (size_t)rb * 16 * 128 + 32 * s), sf[s], acc, 0, 0, 0);
#pragma unroll
            for (int s = 0; s < 2; ++s) acc = __builtin_amdgcn_mfma_f32_16x16x32_bf16(*(const bf16x8*)(qk + (size_t)rb * 16 * 64 + 32 * s), vf[s], acc, 0, 0, 0);
            o[d][rb] = acc; }
    }
    f32x4 ot[4];
#pragma unroll
    for (int rb = 0; rb < 4; ++rb)
#pragma unroll
        for (int r = 0; r < 4; ++r) ot[rb][r] = o[0][rb][r] + lane_xor(o[1][3 - rb][3 - r], 48, lane);
    LDS_BARRIER();
#pragma unroll
    for (int rb = 0; rb < 4; ++rb)
#pragma unroll
        for (int r = 0; r < 4; ++r) { float ss = ot[rb][r] * ot[rb][r];
#pragma unroll
            for (int of = 1; of < 16; of <<= 1) ss += lane_xor(ss, of, lane);
            if (vl == 0) part[wid * 64 + 16 * rb + 4 * q + r] = ss; }
    LDS_BARRIER();
    const int v = 16 * wid + vl; const float ng = A.norm_g[v];
#pragma unroll
    for (int rb = 0; rb < 4; ++rb)
#pragma unroll
        for (int r = 0; r < 4; ++r) { const int tok = 16 * rb + 4 * q + r; float ss = 0.f;
#pragma unroll
            for (int w8 = 0; w8 < 8; ++w8) ss += part[w8 * 64 + tok];
            const float rstd = 1.0f / sqrtf(ss * (1.0f / HD) + EPS);
            const size_t row = (size_t)cix * CH + tok; const float gate = bf2f(A.P[row * NP + C_GG + h * HD + v]);
            A.Y[row * D_MODEL + 2 * GROUP_W + h * HD + v] = f2bf(ot[rb][r] * rstd * ng * (gate / (1.0f + __expf(-gate)))); }
}
__device__ __forceinline__ void g3_phase(const G3Args& A, char* lds, int G, int wg, const int tid) {
    for (int t = wg; t < NCHUNK * NH; t += G) g3_task(A, lds, t / NH, t % NH, tid);
}
}

namespace lru {
typedef short bf16x8 __attribute__((ext_vector_type(8)));
typedef float f32x4 __attribute__((ext_vector_type(4)));
typedef unsigned u32x2 __attribute__((ext_vector_type(2)));
typedef unsigned u32x4 __attribute__((ext_vector_type(4)));
constexpr int CH = 64, NCHUNK = M_ALL / CH;
constexpr int US = 129;
constexpr int UBS = 272;
constexpr int L_OFF_U = 0, L_OFF_UB = CH * US * 4, L_LDS = L_OFF_UB + CH * UBS;
constexpr size_t SZ_WBLK = (size_t)LRU_BW * LRU_BW;
struct Bufs { bf16_t* HLOC; bf16_t* ACUM; float* LSUM; float* HIN; };
struct LocalArgs { const bf16_t* P; const float* conv_w; const float* conv_b; const bf16_t* WG;   const float* ba; const float* bx; const float* lam; Bufs B; };

__device__ __forceinline__ unsigned pk2(float lo, float hi) { return (unsigned)f2bf(lo) | ((unsigned)f2bf(hi) << 16); }

__device__ __forceinline__ void local_task(const LocalArgs& A, char* lds, int cix, int nb, const int tid_in) {
    int tid_ = tid_in; asm volatile("" : "+v"(tid_));
    const int tid = tid_, wid = __builtin_amdgcn_readfirstlane(tid >> 6), lane = tid & 63, q = lane >> 4, tl = lane & 15;
    float* Us = (float*)(lds + L_OFF_U); char* Ub = lds + L_OFF_UB;
    const int row0 = cix * CH; const RowInfo r0i = row_info(row0);
    LDS_BARRIER();
    {
        const int grp = tid & 15, t2 = tid >> 4, c0 = grp * 8, ch0 = nb * LRU_BW + c0;
        float wgt[4][8], bia[8];
#pragma unroll
        for (int j = 0; j < 4; ++j) { const f32x4 w0 = *(const f32x4*)(A.conv_w + j * LRU_W + ch0), w1 = *(const f32x4*)(A.conv_w + j * LRU_W + ch0 + 4);
#pragma unroll
            for (int e = 0; e < 4; ++e) { wgt[j][e] = w0[e]; wgt[j][4 + e] = w1[e]; } }
        { const f32x4 b0 = *(const f32x4*)(A.conv_b + ch0), b1 = *(const f32x4*)(A.conv_b + ch0 + 4);
#pragma unroll
          for (int e = 0; e < 4; ++e) { bia[e] = b0[e]; bia[4 + e] = b1[e]; } }
        u32x4 xr[5];
#pragma unroll
        for (int k = 0; k < 5; ++k) { const int tt = r0i.t + 2 * t2 + k - 1;
            xr[k] = (tt >= 0 && tt < r0i.T) ? *(const u32x4*)(A.P + (size_t)(r0i.base + tt) * NP + C_LRU_X + ch0) : (u32x4){0u, 0u, 0u, 0u}; }
#pragma unroll
        for (int i = 0; i < 2; ++i) { float acc[8];
#pragma unroll
            for (int e = 0; e < 8; ++e) acc[e] = bia[e];
#pragma unroll
            for (int j = 0; j < 4; ++j) { const u32x4 xv = xr[i + j];
#pragma unroll
                for (int e = 0; e < 4; ++e) { acc[2 * e] += wgt[j][2 * e] * bflo(xv[e]); acc[2 * e + 1] += wgt[j][2 * e + 1] * bfhi(xv[e]); } }
            const int tok = 2 * t2 + i;
#pragma unroll
            for (int e = 0; e < 8; ++e) Us[tok * US + c0 + e] = acc[e];
            *(u32x4*)(Ub + tok * UBS + c0 * 2) = (u32x4){pk2(acc[0], acc[1]), pk2(acc[2], acc[3]), pk2(acc[4], acc[5]), pk2(acc[6], acc[7])}; }
    }
    LDS_BARRIER();
    f32x4 acc[2][2][4];
#pragma unroll
    for (int d = 0; d < 2; ++d)
#pragma unroll
        for (int wh = 0; wh < 2; ++wh)
#pragma unroll
            for (int tb = 0; tb < 4; ++tb) acc[d][wh][tb] = (f32x4){0.f, 0.f, 0.f, 0.f};
#pragma unroll
    for (int s = 0; s < 4; ++s) {
        bf16x8 bfr[4];
#pragma unroll
        for (int tb = 0; tb < 4; ++tb) bfr[tb] = *(const bf16x8*)(Ub + (16 * tb + tl) * UBS + (32 * s + 8 * q) * 2);
#pragma unroll
        for (int d = 0; d < 2; ++d)
#pragma unroll
            for (int wh = 0; wh < 2; ++wh) { const bf16x8 a = *(const bf16x8*)(A.WG + ((size_t)((d * 2 + wh) * NH + nb)) * SZ_WBLK + (size_t)(16 * wid + tl) * LRU_BW + 32 * s + 8 * q);
#pragma unroll
                for (int tb = 0; tb < 4; ++tb) acc[d][wh][tb] = __builtin_amdgcn_mfma_f32_16x16x32_bf16(a, bfr[tb], acc[d][wh][tb], 0, 0, 0); }
    }
    const int chb = nb * LRU_BW + 16 * wid + 4 * q;
#pragma unroll
    for (int d = 0; d < 2; ++d) {
        float sp[4], bav[4], bxv[4];
#pragma unroll
        for (int r = 0; r < 4; ++r) { sp[r] = -LRU_C * softplusf_(-A.lam[d * LRU_W + chb + r]); bav[r] = A.ba[d * LRU_W + chb + r]; bxv[r] = A.bx[d * LRU_W + chb + r]; }
        float Ac[4], Bc[4];
#pragma unroll
        for (int r = 0; r < 4; ++r) { Ac[r] = 1.f; Bc[r] = 0.f; }
#pragma unroll
        for (int tbi = 0; tbi < 4; ++tbi) { const int tb = d == 0 ? tbi : 3 - tbi; const int tok = 16 * tb + tl;
            float a[4], b[4];
#pragma unroll
            for (int r = 0; r < 4; ++r) { const float rr = 1.0f / (1.0f + __expf(-(acc[d][0][tb][r] + bav[r]))), ii = 1.0f / (1.0f + __expf(-(acc[d][1][tb][r] + bxv[r])));
                const float log_a = sp[r] * rr; a[r] = __expf(log_a); b[r] = sqrtf(-expm1f(2.0f * log_a)) * ii * Us[tok * US + 16 * wid + 4 * q + r]; }
#pragma unroll
            for (int off = 1; off < 16; off <<= 1) {
#pragma unroll
                for (int r = 0; r < 4; ++r) { const int src = d == 0 ? tl - off : tl + off; const bool ok = d == 0 ? (tl >= off) : (tl + off < 16);
                    const int sl = (lane & ~15) | (src & 15); const float ap = lane_get(a[r], sl), bp = lane_get(b[r], sl);
                    if (ok) { b[r] = a[r] * bp + b[r]; a[r] = a[r] * ap; } } }
#pragma unroll
            for (int r = 0; r < 4; ++r) { b[r] = a[r] * Bc[r] + b[r]; a[r] = a[r] * Ac[r]; }
            { const size_t o = ((size_t)d * M_ALL + row0 + tok) * LRU_W + chb;
              *(u32x2*)(A.B.HLOC + o) = (u32x2){pk2(b[0], b[1]), pk2(b[2], b[3])}; *(u32x2*)(A.B.ACUM + o) = (u32x2){pk2(a[0], a[1]), pk2(a[2], a[3])}; }
#pragma unroll
            for (int r = 0; r < 4; ++r) { const int sl = (lane & ~15) | (d == 0 ? 15 : 0); Ac[r] = lane_get(a[r], sl); Bc[r] = lane_get(b[r], sl); }
        }
        if (tl == 0) { float* ls = A.B.LSUM + (((size_t)cix * 2 + d) * 2) * LRU_W + chb;
            *(f32x4*)ls = (f32x4){Ac[0], Ac[1], Ac[2], Ac[3]}; *(f32x4*)(ls + LRU_W) = (f32x4){Bc[0], Bc[1], Bc[2], Bc[3]}; }
    }
}
__device__ __forceinline__ void local_phase(const LocalArgs& A, char* lds, int G, int wg, const int tid) {
    for (int t = wg; t < NCHUNK * NH; t += G) local_task(A, lds, t / NH, t % NH, tid);
}
__device__ __forceinline__ void carry_phase(const Bufs& B, int gtid, int gthreads) {
    constexpr int NC = CTX_LEN / CH, NL = SEQ / CH;
    for (int i = gtid; i < BATCH * 2 * LRU_W; i += gthreads) { const int ch = i % LRU_W, d = (i / LRU_W) & 1, b = i / (2 * LRU_W);
        float h = 0.f;
        for (int s0 = 0; s0 < NC + NL; s0 += 12) {
            float av[12], bv[12]; int cx[12];
#pragma unroll
            for (int u = 0; u < 12; ++u) { const int step = s0 + u; int cix = 0;
                if (step < NC) { const int n = d ? NC - 1 - step : step; cix = M_LAT / CH + b * NC + n; }
                else if (step < NC + NL) { const int s2 = step - NC, n = d ? NL - 1 - s2 : s2; cix = b * NL + n; }
                cx[u] = cix; const float* ls = B.LSUM + (((size_t)cix * 2 + d) * 2) * LRU_W + ch; av[u] = ls[0]; bv[u] = ls[LRU_W]; }
#pragma unroll
            for (int u = 0; u < 12; ++u) if (s0 + u < NC + NL) { B.HIN[((size_t)cx[u] * 2 + d) * LRU_W + ch] = h; h = av[u] * h + bv[u]; }
        }
    }
}
__device__ __forceinline__ void finish_phase(const Bufs& B, const bf16_t* P, bf16_t* Y, int gtid, int gthreads) {
    for (int it = gtid; it < M_ALL * (LRU_W / 8); it += gthreads) { const int row = it / (LRU_W / 8), c0 = (it % (LRU_W / 8)) * 8, cix = row / CH;
        const u32x4 h0 = *(const u32x4*)(B.HLOC + (size_t)row * LRU_W + c0), a0 = *(const u32x4*)(B.ACUM + (size_t)row * LRU_W + c0);
        const u32x4 h1 = *(const u32x4*)(B.HLOC + ((size_t)M_ALL + row) * LRU_W + c0), a1 = *(const u32x4*)(B.ACUM + ((size_t)M_ALL + row) * LRU_W + c0);
        const u32x4 gt = *(const u32x4*)(P + (size_t)row * NP + C_LRU_G + c0);
        const float* i0 = B.HIN + ((size_t)cix * 2 + 0) * LRU_W + c0; const float* i1 = B.HIN + ((size_t)cix * 2 + 1) * LRU_W + c0;
        const f32x4 i0a = *(const f32x4*)i0, i0b = *(const f32x4*)(i0 + 4), i1a = *(const f32x4*)i1, i1b = *(const f32x4*)(i1 + 4);
        float y[8];
#pragma unroll
        for (int j = 0; j < 4; ++j) { const unsigned hw0 = h0[j], aw0 = a0[j], hw1 = h1[j], aw1 = a1[j], gw = gt[j];
            const float in0l = j < 2 ? i0a[2 * j] : i0b[2 * j - 4], in0h = j < 2 ? i0a[2 * j + 1] : i0b[2 * j - 3], in1l = j < 2 ? i1a[2 * j] : i1b[2 * j - 4], in1h = j < 2 ? i1a[2 * j + 1] : i1b[2 * j - 3];
            y[2 * j] = (bflo(hw0) + bflo(aw0) * in0l + bflo(hw1) + bflo(aw1) * in1l) * geluf_(bflo(gw));
            y[2 * j + 1] = (bfhi(hw0) + bfhi(aw0) * in0h + bfhi(hw1) + bfhi(aw1) * in1h) * geluf_(bfhi(gw)); }
        *(u32x4*)(Y + (size_t)row * D_MODEL + c0) = (u32x4){pk2(y[0], y[1]), pk2(y[2], y[3]), pk2(y[4], y[5]), pk2(y[6], y[7])};
    }
}
}

namespace misc {
typedef float f32x4 __attribute__((ext_vector_type(4)));
typedef unsigned u32x2 __attribute__((ext_vector_type(2)));
typedef unsigned u32x4 __attribute__((ext_vector_type(4)));
__device__ __forceinline__ unsigned pk2(float lo, float hi) { return (unsigned)f2bf(lo) | ((unsigned)f2bf(hi) << 16); }
__device__ __forceinline__ float wave_sum(float v, int lane) {
#pragma unroll
    for (int o = 1; o < 64; o <<= 1) v += lane_xor(v, o, lane);
    return v;
}
__device__ __forceinline__ float sum16(float v, int lane) {
#pragma unroll
    for (int o = 1; o < 16; o <<= 1) v += lane_xor(v, o, lane);
    return v;
}
__device__ __forceinline__ void norm_phase(const float* H, const float* g, const float* MODl, int sh_idx, bf16_t* U, int nrows, int gwave, int nwaves, int lane) {
    static_assert(D_MODEL == 2048, "norm_phase geometry");
    for (int r = gwave; r < nrows; r += nwaves) {
        const int set = r < M_LAT ? r / SEQ : BATCH;
        const f32x4* hr = (const f32x4*)(H + (size_t)r * D_MODEL) + lane;
        f32x4 v[8]; float ss = 0.f;
#pragma unroll
        for (int j = 0; j < 8; ++j) { v[j] = hr[64 * j]; ss += (v[j][0] * v[j][0] + v[j][1] * v[j][1]) + (v[j][2] * v[j][2] + v[j][3] * v[j][3]); }
        const float rstd = 1.0f / sqrtf(wave_sum(ss, lane) * (1.0f / D_MODEL) + EPS);
        const f32x4* gp = (const f32x4*)g + lane; const f32x4* shp = (const f32x4*)(MODl + (size_t)set * NMODV + (size_t)sh_idx * D_MODEL) + lane; const f32x4* scp = shp + D_MODEL / 4;
        u32x2* o = (u32x2*)(U + (size_t)r * D_MODEL) + lane;
#pragma unroll
        for (int j = 0; j < 8; ++j) { const f32x4 gg = gp[64 * j], sh = shp[64 * j], sc = scp[64 * j]; f32x4 y;
#pragma unroll
            for (int e = 0; e < 4; ++e) y[e] = v[j][e] * rstd * gg[e] * (1.0f + sc[e]) + sh[e];
            o[64 * j] = (u32x2){pk2(y[0], y[1]), pk2(y[2], y[3])}; }
    }
}
struct RowNormArgs { const bf16_t* P; const float *qa_g, *kva_g, *na_qn_g, *na_kn_g; bf16_t *CQN, *CKVN, *NQ, *NK; };
__device__ __forceinline__ void rownorm_phase(const RowNormArgs& A, int gwave, int nwaves, int lane) {
    static_assert(MLA_Q_LORA == 384 && MLA_KV_LORA == 256 && GROUP_W == 512 && HD == 128, "rownorm geometry");
    for (int r = gwave; r < M_ALL; r += nwaves) { const bf16_t* p = A.P + (size_t)r * NP;
        { float x[6], ss = 0.f;
#pragma unroll
          for (int j = 0; j < 3; ++j) { const unsigned w = *(const unsigned*)(p + C_CQ + 2 * lane + 128 * j); x[2 * j] = bflo(w); x[2 * j + 1] = bfhi(w); ss += x[2 * j] * x[2 * j] + x[2 * j + 1] * x[2 * j + 1]; }
          const float rstd = 1.0f / sqrtf(wave_sum(ss, lane) * (1.0f / MLA_Q_LORA) + EPS);
#pragma unroll
          for (int j = 0; j < 3; ++j) { const int c = 2 * lane + 128 * j; *(unsigned*)(A.CQN + (size_t)r * MLA_Q_LORA + c) = pk2(x[2 * j] * rstd * A.qa_g[c], x[2 * j + 1] * rstd * A.qa_g[c + 1]); } }
        { float x[4], ss = 0.f;
#pragma unroll
          for (int j = 0; j < 2; ++j) { const unsigned w = *(const unsigned*)(p + C_CKV + 2 * lane + 128 * j); x[2 * j] = bflo(w); x[2 * j + 1] = bfhi(w); ss += x[2 * j] * x[2 * j] + x[2 * j + 1] * x[2 * j + 1]; }
          const float rstd = 1.0f / sqrtf(wave_sum(ss, lane) * (1.0f / MLA_KV_LORA) + EPS);
#pragma unroll
          for (int j = 0; j < 2; ++j) { const int c = 2 * lane + 128 * j; *(unsigned*)(A.CKVN + (size_t)r * MLA_KV_LORA + c) = pk2(x[2 * j] * rstd * A.kva_g[c], x[2 * j + 1] * rstd * A.kva_g[c + 1]); } }
#pragma unroll
        for (int which = 0; which < 2; ++which) {
            const int hh = lane >> 4, d0 = (lane & 15) * 8; const u32x4 w = *(const u32x4*)(p + (which == 0 ? C_NQ : C_NK) + hh * HD + d0);
            float x[8]; float ss = 0.f;
#pragma unroll
            for (int j = 0; j < 4; ++j) { x[2 * j] = bflo(w[j]); x[2 * j + 1] = bfhi(w[j]); ss += x[2 * j] * x[2 * j] + x[2 * j + 1] * x[2 * j + 1]; }
            const float rstd = 1.0f / sqrtf(sum16(ss, lane) * (1.0f / HD) + EPS); const float* g = (which == 0 ? A.na_qn_g : A.na_kn_g) + d0;
            *(u32x4*)((which == 0 ? A.NQ : A.NK) + (size_t)r * GROUP_W + hh * HD + d0) =
                (u32x4){pk2(x[0] * rstd * g[0], x[1] * rstd * g[1]), pk2(x[2] * rstd * g[2], x[3] * rstd * g[3]), pk2(x[4] * rstd * g[4], x[5] * rstd * g[5]), pk2(x[6] * rstd * g[6], x[7] * rstd * g[7])};
        }
    }
}
struct MlaQkvArgs { const float* QR; const float* KVR; const bf16_t* P; const float *qn_g, *kn_g; bf16_t *QM, *KM, *VM; };
__device__ __forceinline__ void mlaqkv_phase(const MlaQkvArgs& A, int gwave, int nwaves, int lane) {
    static_assert(MLA_QK == 192 && MLA_NOPE == 128 && MLA_ROPE == 64 && NH == 4, "mla qkv geometry");
    const int hh = lane >> 4, g = lane & 15;
    const float inv = powf(10000.0f, -(float)g / 16.0f);
    for (int r = gwave; r < M_ALL; r += nwaves) {
        const bool lat = r < M_LAT; const int t = lat ? r % SEQ : 0;
        float cr = 1.f, sr = 0.f, cc = 1.f, sc = 0.f;
        if (lat) { sincosf((float)(t / GRID_W) * inv, &sr, &cr); sincosf((float)(t % GRID_W) * inv, &sc, &cc); }
#pragma unroll
        for (int which = 0; which < 2; ++which) {
            float x[12]; float ss = 0.f;
            if (which == 0) { const float* src = A.QR + (size_t)r * NQ_MLA + hh * MLA_QK + g;
#pragma unroll
                for (int i = 0; i < 12; ++i) x[i] = src[16 * i]; }
            else { const float* src = A.KVR + (size_t)r * NKV_MLA + hh * (MLA_NOPE + MLA_V) + g; const bf16_t* kr = A.P + (size_t)r * NP + C_KR + g;
#pragma unroll
                for (int i = 0; i < 8; ++i) x[i] = src[16 * i];
#pragma unroll
                for (int i = 0; i < 4; ++i) x[8 + i] = bf2f(kr[16 * i]); }
#pragma unroll
            for (int i = 0; i < 12; ++i) ss += x[i] * x[i];
            const float rstd = 1.0f / sqrtf(sum16(ss, lane) * (1.0f / MLA_QK) + EPS); const float* gn = (which == 0 ? A.qn_g : A.kn_g) + g;
#pragma unroll
            for (int i = 0; i < 12; ++i) x[i] = x[i] * rstd * gn[16 * i];
            { const float a0 = x[8], b0 = x[10]; x[8] = a0 * cr - b0 * sr; x[10] = a0 * sr + b0 * cr;
              const float a1 = x[9], b1 = x[11]; x[9] = a1 * cc - b1 * sc; x[11] = a1 * sc + b1 * cc; }
            bf16_t* O = (which == 0 ? A.QM : A.KM) + (size_t)r * NQ_MLA + hh * MLA_QK + g;
#pragma unroll
            for (int i = 0; i < 12; ++i) O[16 * i] = f2bf(x[i]);
        }
        { const float* vs = A.KVR + (size_t)r * NKV_MLA + hh * (MLA_NOPE + MLA_V) + MLA_NOPE + g; bf16_t* O = A.VM + (size_t)r * (NH * MLA_V) + hh * MLA_V + g;
#pragma unroll
          for (int i = 0; i < 8; ++i) O[16 * i] = f2bf(vs[16 * i]); }
    }
}
constexpr int ACT_RUN = 32;
__device__ __forceinline__ void act_phase(const bf16_t* UP, const float* cw, const float* cb, bf16_t* ACT, int nrows, int gtid, int gthreads) {
    constexpr int NC8 = D_FF / 8; static_assert(SEQ % ACT_RUN == 0 && CTX_LEN % ACT_RUN == 0, "row runs stay inside one sequence");
    const int nruns = nrows / ACT_RUN;
    for (long it = gtid; it < (long)nruns * NC8; it += gthreads) { const int run = (int)(it / NC8), j0 = (int)(it % NC8) * 8, r0 = run * ACT_RUN; const RowInfo ri = row_info(r0);
        float wa[3][8], wg[3][8], ba[8], bg[8];
#pragma unroll
        for (int k = 0; k < 3; ++k) { const float* p = cw + (size_t)k * 2 * D_FF + j0; const f32x4 a0 = *(const f32x4*)p, a1 = *(const f32x4*)(p + 4), g0 = *(const f32x4*)(p + D_FF), g1 = *(const f32x4*)(p + D_FF + 4);
#pragma unroll
            for (int e = 0; e < 4; ++e) { wa[k][e] = a0[e]; wa[k][4 + e] = a1[e]; wg[k][e] = g0[e]; wg[k][4 + e] = g1[e]; } }
        { const f32x4 a0 = *(const f32x4*)(cb + j0), a1 = *(const f32x4*)(cb + j0 + 4), g0 = *(const f32x4*)(cb + D_FF + j0), g1 = *(const f32x4*)(cb + D_FF + j0 + 4);
#pragma unroll
          for (int e = 0; e < 4; ++e) { ba[e] = a0[e]; ba[4 + e] = a1[e]; bg[e] = g0[e]; bg[4 + e] = g1[e]; } }
        const u32x4 zero = {0u, 0u, 0u, 0u};
        const bf16_t* ub = UP + (size_t)ri.base * (2 * D_FF) + j0;
        u32x4 am, ac, gm, gc;
        { const int t = ri.t; am = t > 0 ? *(const u32x4*)(ub + (size_t)(t - 1) * (2 * D_FF)) : zero; gm = t > 0 ? *(const u32x4*)(ub + (size_t)(t - 1) * (2 * D_FF) + D_FF) : zero;
          ac = *(const u32x4*)(ub + (size_t)t * (2 * D_FF)); gc = *(const u32x4*)(ub + (size_t)t * (2 * D_FF) + D_FF); }
#pragma unroll 4
        for (int i = 0; i < ACT_RUN; ++i) { const int t = ri.t + i;
            const u32x4 ap = t + 1 < ri.T ? *(const u32x4*)(ub + (size_t)(t + 1) * (2 * D_FF)) : zero, gp = t + 1 < ri.T ? *(const u32x4*)(ub + (size_t)(t + 1) * (2 * D_FF) + D_FF) : zero;
            float y[8];
#pragma unroll
            for (int e = 0; e < 4; ++e) {
                const float a0 = ba[2 * e] + wa[0][2 * e] * bflo(am[e]) + wa[1][2 * e] * bflo(ac[e]) + wa[2][2 * e] * bflo(ap[e]);
                const float a1 = ba[2 * e + 1] + wa[0][2 * e + 1] * bfhi(am[e]) + wa[1][2 * e + 1] * bfhi(ac[e]) + wa[2][2 * e + 1] * bfhi(ap[e]);
                const float g0 = bg[2 * e] + wg[0][2 * e] * bflo(gm[e]) + wg[1][2 * e] * bflo(gc[e]) + wg[2][2 * e] * bflo(gp[e]);
                const float g1 = bg[2 * e + 1] + wg[0][2 * e + 1] * bfhi(gm[e]) + wg[1][2 * e + 1] * bfhi(gc[e]) + wg[2][2 * e + 1] * bfhi(gp[e]);
                y[2 * e] = a0 * (g0 / (1.0f + __expf(-g0))); y[2 * e + 1] = a1 * (g1 / (1.0f + __expf(-g1))); }
            *(u32x4*)(ACT + (size_t)(r0 + i) * D_FF + j0) = (u32x4){pk2(y[0], y[1]), pk2(y[2], y[3]), pk2(y[4], y[5]), pk2(y[6], y[7])};
            am = ac; ac = ap; gm = gc; gc = gp; }
    }
}
__device__ __forceinline__ void transpose_item(const float* W, int K, int N, int Npad, bf16_t* WT, float* scr, int item, int lane) {
    const int nblk = Npad / 32, kb = item / nblk, nb = item % nblk, k0 = 64 * kb, n0 = 32 * nb; const int n = n0 + (lane & 31); const bool ok = n < N;
#pragma unroll 8
    for (int i = 0; i < 32; ++i) { const int kk = 2 * i + (lane >> 5); scr[kk * 33 + (lane & 31)] = ok ? W[(size_t)(k0 + kk) * N + n] : 0.f; }
    asm volatile("s_waitcnt lgkmcnt(0)" ::: "memory");
    const int c = lane & 7;
#pragma unroll
    for (int j = 0; j < 4; ++j) { const int nn = (lane >> 3) + 8 * j; const float* s = scr + (8 * c) * 33 + nn;
        u32x4 o; o.x = pk2(s[0 * 33], s[1 * 33]); o.y = pk2(s[2 * 33], s[3 * 33]); o.z = pk2(s[4 * 33], s[5 * 33]); o.w = pk2(s[6 * 33], s[7 * 33]);
        *(u32x4*)(WT + (size_t)(n0 + nn) * K + k0 + 8 * c) = o; }
    asm volatile("s_waitcnt lgkmcnt(0)" ::: "memory");
}
}

__device__ __forceinline__ gdn::Bufs gdn_bufs(const WS& w, int l) { gdn::Bufs B; B.UT = w.gUT; B.WP = w.gWP; B.KDT = w.gKDT; B.QD = w.gQD; B.QK = w.gQK; B.SIT = w.gSIT; B.VNT = w.gVNT; B.GT = w.gGT + (size_t)l * gdn::NTASK; return B; }
__device__ __forceinline__ lru::Bufs lru_bufs(const WS& w) { lru::Bufs B; B.HLOC = w.lHLOC; B.ACUM = w.lACUM; B.LSUM = w.lLSUM; B.HIN = w.lHIN; return B; }

#define LAS __attribute__((address_space(3)))
#define XB_TMO      128
#define XB_XCNT(j)  (256  + 64 * (j))
#define XB_XSUB(j)  (1280 + 64 * (j))
#define XB_XGEN(j)  (2304 + 64 * (j))
#define XB_TOP      3328
#define XB_TOPGEN   3392
#define XCD_BAR_WORDS 3456
#define XB_SPIN_CAP (1u << 18)
__device__ __forceinline__ unsigned xb_ld(unsigned* p)              { return __hip_atomic_load(p, __ATOMIC_RELAXED, __HIP_MEMORY_SCOPE_AGENT); }
__device__ __forceinline__ unsigned xb_add(unsigned* p, unsigned v) { return __hip_atomic_fetch_add(p, v, __ATOMIC_RELAXED, __HIP_MEMORY_SCOPE_AGENT); }
__device__ __forceinline__ unsigned xb_xcc_id() { return (unsigned)__builtin_amdgcn_s_getreg((3 << 11) | 20) & 0xFu; }
#define XB_SPIN(cond, bar) do { unsigned _sp = 0; while (cond) { __builtin_amdgcn_s_sleep(1); \
    if ((++_sp & 255u) == 0u) { if (xb_ld(&(bar)[XB_TMO])) break; if (_sp > XB_SPIN_CAP) { atomicAdd(&(bar)[XB_TMO], 1u); break; } } } } while (0)
struct XcdBarrier { unsigned* bar; unsigned x; volatile LAS unsigned* st; };
__device__ __forceinline__ XcdBarrier xcd_barrier_post(unsigned* bar, volatile LAS unsigned* st, const bool leader) {
    XcdBarrier b; b.bar = bar; b.x = xb_xcc_id(); b.st = st;
    if (leader) (void)xb_add(&bar[XB_XCNT(b.x)], 1u);
    return b;
}
__device__ __forceinline__ void xcd_barrier_complete(unsigned* bar, unsigned x, unsigned& nloc, unsigned& nx) {
    const unsigned G = gridDim.x * gridDim.y * gridDim.z;
    unsigned sum, cnt, mine, sp = 0u;
    for (;;) {
        sum = 0u; cnt = 0u; mine = 0u;
#pragma unroll
        for (unsigned j = 0; j < 16; ++j) { const unsigned c = xb_ld(&bar[XB_XCNT(j)]); sum += c; cnt += (c > 0u) ? 1u : 0u; mine = (j == x) ? c : mine; }
        if (sum == G) break;
        __builtin_amdgcn_s_sleep(1);
        if ((++sp & 255u) == 0u) { if (xb_ld(&bar[XB_TMO])) break; if (sp > XB_SPIN_CAP) { atomicAdd(&bar[XB_TMO], 1u); break; } }
    }
    nloc = mine > 0u ? mine : 1u; nx = cnt > 0u ? cnt : 1u;
}
__device__ __forceinline__ void xcd_barrier(const XcdBarrier& b, const bool leader) {
    asm volatile("s_waitcnt vmcnt(0)" ::: "memory");
    __syncthreads();
    if (leader) {
        unsigned* bar = b.bar;
        __builtin_amdgcn_s_waitcnt(0);
        unsigned nloc = b.st[0], nx = b.st[1];
        if (nloc == 0u) { xcd_barrier_complete(bar, b.x, nloc, nx); b.st[0] = nloc; b.st[1] = nx; }
        const unsigned old = xb_add(&bar[XB_XSUB(b.x)], 1u);
        const unsigned gen = old / nloc;
        if (old + 1u == (gen + 1u) * nloc) {
            __builtin_amdgcn_fence(__ATOMIC_RELEASE, "agent");
            asm volatile("s_waitcnt vmcnt(0)" ::: "memory");
            const unsigned og = xb_add(&bar[XB_TOP], 1u);
            const unsigned tg = og / nx;
            if (og + 1u == (tg + 1u) * nx) xb_add(&bar[XB_TOPGEN], 1u);
            else XB_SPIN(xb_ld(&bar[XB_TOPGEN]) == tg, bar);
            __builtin_amdgcn_fence(__ATOMIC_ACQUIRE, "agent");
            xb_add(&bar[XB_XGEN(b.x)], 1u);
            asm volatile("s_waitcnt vmcnt(0)" ::: "memory");
        } else {
            XB_SPIN(xb_ld(&bar[XB_XGEN(b.x)]) == gen, bar);
            __builtin_amdgcn_fence(__ATOMIC_ACQUIRE, "agent");
            asm volatile("s_waitcnt vmcnt(0)" ::: "memory");
        }
    }
    __syncthreads();
}

constexpr int NWAVES = 8, NTHR = 512;
constexpr int LDS_MISC = 147456, LDS_BYTES = 148480;
static_assert(sizeof(Inputs) == 34 * 8, "Inputs mirrors Params::in");
static_assert(gdn::G1_LDS <= LDS_MISC && pg8::STAGE_BYTES <= LDS_MISC && att::Cfg<MLA_QK>::LDS_BYTES <= LDS_MISC && gdn::G2_LDS <= LDS_MISC, "LDS map");
constexpr int CW_BAR = 4096;
constexpr int PH_PRO = 0, PH_PER_LAYER = 12, NPH = 1 + PH_PER_LAYER * DEPTH;
struct Params { const float* in[34]; float* out; unsigned char* ws; int ph_lo, ph_hi, li, pad; };

struct SpanOrder {
    int nN, lo, hi, G, g0;
    __device__ __forceinline__ void init(int N, int lo_, int hi_, int G_, int c) { nN = N / pg8::BM; lo = lo_; hi = hi_; G = G_; int i0 = 0; if (c < lo_) i0 = (lo_ - c + G_ - 1) / G_; g0 = c + i0 * G_; }
    __device__ __forceinline__ bool next(int i, pg8::Unit& u) const { const int g = g0 + i * G; if (g >= hi) return false; const int loc = g - lo; u.pm = loc / nN; u.pn = loc % nN; return true; }
    __device__ __forceinline__ void a_ready(const pg8::Unit&) const {}
    __device__ __forceinline__ void done(const pg8::Unit&) const {}
};

#define AS4 __attribute__((address_space(4)))
#define PHASE_WS const AS4 Params* pp = (const AS4 Params*)__builtin_amdgcn_kernarg_segment_ptr(); asm volatile("" : "+s"(pp)); const AS4 Inputs* I = (const AS4 Inputs*)pp; (void)I; unsigned char* wsb_ = pp->ws; const WS w = ws_carve(wsb_)
#define PHASE_IDS int tid = C_wave0 * 64 + (int)__builtin_amdgcn_mbcnt_hi(~0u, __builtin_amdgcn_mbcnt_lo(~0u, 0u)); asm volatile("" : "+v"(tid)); const int lane = tid & 63, wave = __builtin_amdgcn_readfirstlane(tid >> 6), gwave = wg * NWAVES + wave, gtid = wg * NTHR + tid; (void)lane; (void)gwave; (void)gtid
#ifndef DBG_MASK
#define DBG_MASK 0xFFFFFF
#endif
#define IN(k) (lo <= (k) && (k) < hi)
#define ON(j) (((DBG_MASK) >> (j)) & 1)
#define SEAM(k) do { if (IN(k) && IN((k) + 1)) xcd_barrier(bar, C_wave0 == 0 && __builtin_amdgcn_mbcnt_hi(~0u, __builtin_amdgcn_mbcnt_lo(~0u, 0u)) == 0u); } while (0)

struct LayerCtx { int lo, hi, G, wg, nwaves, gthreads, wave0; XcdBarrier bar; char* lds; unsigned char* lds_raw; };
template <int l> __device__ __forceinline__ void layer_body(const LayerCtx& C) {
    const int lo = C.lo, hi = C.hi, G = C.G, wg = C.wg, nwaves = C.nwaves, gthreads = C.gthreads, C_wave0 = C.wave0; const XcdBarrier& bar = C.bar; char* lds = C.lds; unsigned char* lds_raw = C.lds_raw;
    (void)G; (void)nwaves; (void)gthreads;
        const int pb = 1 + PH_PER_LAYER * l;
        const bool want_ctx = l < DEPTH - 1; const int Mo = want_ctx ? M_ALL : M_LAT;
        if (ON(0) && IN(pb + 0)) { PHASE_WS; PHASE_IDS; const float* MODl = w.MOD + (size_t)l * (BATCH + 1) * NMODV; (void)MODl; misc::norm_phase(w.H, I->norm_mix_g + (size_t)l * D_MODEL, MODl, 0, w.U, M_ALL, gwave, nwaves, lane); }
        SEAM(pb + 0);
        if (ON(1) && IN(pb + 1)) { PHASE_WS; PHASE_IDS; const float* MODl = w.MOD + (size_t)l * (BATCH + 1) * NMODV; (void)MODl; pg8::Gemm g{w.U, w.WIN + l * SZ_WIN, M_ALL, NP, D_MODEL}; pg8::StaticOrder S; S.init(M_ALL, NP, G, wg);
            pg8::EpiBf16<0> E{w.P, NP, nullptr, 0, 0, 1.0f};
            pg8::gemm_phase<pg8::EpiBf16<0>, pg8::StaticOrder, true, true>((PG8_LAS unsigned char*)lds_raw, g, S, E, tid); }
        SEAM(pb + 1);
        if (ON(2) && IN(pb + 2)) { PHASE_WS; PHASE_IDS; const float* MODl = w.MOD + (size_t)l * (BATCH + 1) * NMODV; (void)MODl;
            const int pflags = pp->pad;
            if (!(pflags & 16)) { gdn::G1Args A; A.P = w.P; A.conv_w = I->gdn_conv_w + (size_t)l * 4 * 3 * GROUP_W; A.a_log = I->gdn_a_log + (size_t)l * 2 * NH; A.dt_bias = I->gdn_dt_bias + (size_t)l * 2 * NH; A.B = gdn_bufs(w, l); A.pflags = pflags;
              gdn::g1_phase(A, lds, G, wg, tid); }
            if (!(pflags & 32)) { lru::LocalArgs A; A.P = w.P; A.conv_w = I->lru_conv_w + (size_t)l * 4 * LRU_W; A.conv_b = I->lru_conv_b + (size_t)l * LRU_W; A.WG = w.WLRU + (size_t)l * 16 * lru::SZ_WBLK;
              A.ba = I->lru_ba + (size_t)l * 2 * LRU_W; A.bx = I->lru_bx + (size_t)l * 2 * LRU_W; A.lam = I->lru_lam + (size_t)l * 2 * LRU_W; A.B = lru_bufs(w);
              lru::local_phase(A, lds, G, wg, tid); }
            if (!(pflags & 64)) { misc::RowNormArgs A; A.P = w.P; A.qa_g = I->mla_qa_g + (size_t)l * MLA_Q_LORA; A.kva_g = I->mla_kva_g + (size_t)l * MLA_KV_LORA; A.na_qn_g = I->na_qn_g + (size_t)l * HD; A.na_kn_g = I->na_kn_g + (size_t)l * HD;
              A.CQN = w.CQN; A.CKVN = w.CKVN; A.NQ = w.NQ; A.NK = w.NK; misc::rownorm_phase(A, gwave, nwaves, lane); }
        }
        SEAM(pb + 2);
        if (ON(3) && IN(pb + 3)) { PHASE_WS; PHASE_IDS; const float* MODl = w.MOD + (size_t)l * (BATCH + 1) * NMODV; (void)MODl;
            constexpr int UQ = (M_ALL / 256) * (NQ_MLA / 256), UKV = (M_ALL / 256) * (NKV_MLA / 256);
            { pg8::Gemm g{w.CQN, w.WUQ + l * SZ_WUQ, M_ALL, NQ_MLA, MLA_Q_LORA}; SpanOrder S; S.init(NQ_MLA, 0, UQ, G, wg); pg8::EpiF32 E{w.QR, NQ_MLA};
              pg8::gemm_phase<pg8::EpiF32, SpanOrder, true, true>((PG8_LAS unsigned char*)lds_raw, g, S, E, tid); }
            { pg8::Gemm g{w.CKVN, w.WUKV + l * SZ_WUKV, M_ALL, NKV_MLA, MLA_KV_LORA}; SpanOrder S; S.init(NKV_MLA, UQ, UQ + UKV, G, wg); pg8::EpiF32 E{w.KVR, NKV_MLA};
              pg8::gemm_phase<pg8::EpiF32, SpanOrder, true, true>((PG8_LAS unsigned char*)lds_raw, g, S, E, tid); }
        }
        SEAM(pb + 3);
        if (ON(4) && IN(pb + 4)) { PHASE_WS; PHASE_IDS; const float* MODl = w.MOD + (size_t)l * (BATCH + 1) * NMODV; (void)MODl;
            { misc::MlaQkvArgs A; A.QR = w.QR; A.KVR = w.KVR; A.P = w.P; A.qn_g = I->mla_qn_g + (size_t)l * MLA_QK; A.kn_g = I->mla_kn_g + (size_t)l * MLA_QK; A.QM = w.QM; A.KM = w.KM; A.VM = w.VM;
              misc::mlaqkv_phase(A, gwave, nwaves, lane); }
            lru::carry_phase(lru_bufs(w), gtid, gthreads);
        }
        SEAM(pb + 4);
        if (ON(5) && IN(pb + 5)) { PHASE_WS; PHASE_IDS; const float* MODl = w.MOD + (size_t)l * (BATCH + 1) * NMODV; (void)MODl;
            const int pflags = pp->pad;
            if (wg < BATCH * NH * 2 * gdn::G2_SPLIT && !(pflags & 1)) gdn::g2_chain(gdn_bufs(w, l), lds, wg, tid);
            AttnArgs A; A.QM = w.QM; A.KM = w.KM; A.VM = w.VM; A.NQ = w.NQ; A.NK = w.NK; A.P = w.P; A.Y = w.Y; A.rpb = I->na_rpb + (size_t)l * NH * (2 * NA_KH - 1) * (2 * NA_KW - 1); A.want_ctx = want_ctx ? 1 : 0; A.pad = pflags;
            attention_phase(A, lds, G, wg, tid);
        }
        SEAM(pb + 5);
        if (ON(6) && IN(pb + 6)) { PHASE_WS; PHASE_IDS; const float* MODl = w.MOD + (size_t)l * (BATCH + 1) * NMODV; (void)MODl;
            const int pflags = pp->pad;
            if (!(pflags & 128)) { gdn::G3Args A; A.B = gdn_bufs(w, l); A.P = w.P; A.norm_g = I->gdn_norm_g + (size_t)l * HD; A.Y = w.Y; gdn::g3_phase(A, lds, G, wg, tid); }
            if (!(pflags & 256)) lru::finish_phase(lru_bufs(w), w.P, w.Y, gtid, gthreads);
        }
        SEAM(pb + 6);
        if (ON(7) && IN(pb + 7)) { PHASE_WS; PHASE_IDS; const float* MODl = w.MOD + (size_t)l * (BATCH + 1) * NMODV; (void)MODl; pg8::Gemm g{w.Y, w.WOUT + l * SZ_WOUT, Mo, D_MODEL, D_MODEL}; pg8::StaticOrder S; S.init(Mo, D_MODEL, G, wg);
            pg8::EpiGateRes E{w.H, w.H, D_MODEL, MODl + 2 * D_MODEL, NMODV, SEQ, BATCH, M_LAT};
            pg8::gemm_phase<pg8::EpiGateRes, pg8::StaticOrder, true, true>((PG8_LAS unsigned char*)lds_raw, g, S, E, tid); }
        SEAM(pb + 7);
        if (ON(8) && IN(pb + 8)) { PHASE_WS; PHASE_IDS; const float* MODl = w.MOD + (size_t)l * (BATCH + 1) * NMODV; (void)MODl; misc::norm_phase(w.H, I->norm_ffn_g + (size_t)l * D_MODEL, MODl, 3, w.U, Mo, gwave, nwaves, lane); }
        SEAM(pb + 8);
        if (ON(9) && IN(pb + 9)) { PHASE_WS; PHASE_IDS; const float* MODl = w.MOD + (size_t)l * (BATCH + 1) * NMODV; (void)MODl; pg8::Gemm g{w.U, w.WUP + l * SZ_WUP, Mo, 2 * D_FF, D_MODEL}; pg8::StaticOrder S; S.init(Mo, 2 * D_FF, G, wg);
            pg8::EpiBf16<0> E{w.UP, 2 * D_FF, nullptr, 0, 0, 1.0f};
            pg8::gemm_phase<pg8::EpiBf16<0>, pg8::StaticOrder, true, true>((PG8_LAS unsigned char*)lds_raw, g, S, E, tid); }
        SEAM(pb + 9);
        if (ON(10) && IN(pb + 10)) { PHASE_WS; PHASE_IDS; const float* MODl = w.MOD + (size_t)l * (BATCH + 1) * NMODV; (void)MODl; misc::act_phase(w.UP, I->ffn_conv_w + (size_t)l * 3 * 2 * D_FF, I->ffn_conv_b + (size_t)l * 2 * D_FF, w.ACT, Mo, gtid, gthreads); }
        SEAM(pb + 10);
        if (ON(11) && IN(pb + 11)) { PHASE_WS; PHASE_IDS; const float* MODl = w.MOD + (size_t)l * (BATCH + 1) * NMODV; (void)MODl; pg8::Gemm g{w.ACT, w.WDOWN + l * SZ_WDOWN, Mo, D_MODEL, D_FF}; pg8::StaticOrder S; S.init(Mo, D_MODEL, G, wg);
            pg8::EpiGateRes E{w.H, want_ctx ? w.H : pp->out, D_MODEL, MODl + 5 * D_MODEL, NMODV, SEQ, BATCH, M_LAT};
            pg8::gemm_phase<pg8::EpiGateRes, pg8::StaticOrder, true, true>((PG8_LAS unsigned char*)lds_raw, g, S, E, tid); }
        SEAM(pb + 11);

}
__global__ void __launch_bounds__(NTHR, 2) fwd(Params p) {
    extern __shared__ __attribute__((aligned(16))) unsigned char lds_raw[];
    char* lds = (char*)lds_raw;
    const int G = (int)gridDim.x, wg = (int)blockIdx.x, nwaves = G * NWAVES, gthreads = G * NTHR;
    const int C_wave0 = __builtin_amdgcn_readfirstlane((int)threadIdx.x >> 6);
    volatile LAS unsigned* MISC = (volatile LAS unsigned*)(lds_raw + LDS_MISC);
    if (threadIdx.x < 32) MISC[threadIdx.x] = 0u;
    __syncthreads();
    const int lo = p.ph_lo, hi = p.ph_hi;
    unsigned* const barw = (unsigned*)p.ws + CW_BAR + (size_t)p.li * XCD_BAR_WORDS;
    XcdBarrier bar; bar.bar = barw; bar.x = 0; bar.st = MISC + 8;
    if (hi - lo > 1) bar = xcd_barrier_post(barw, MISC + 8, threadIdx.x == 0);

    if (ON(12) && IN(PH_PRO)) { PHASE_WS; PHASE_IDS;
        {
            float* SCs = (float*)lds;
            float* red = (float*)(lds + 3 * D_MODEL * 4);
            constexpr int NT = DEPTH * NMODV / 256;
            if (wg < NT) {
                for (int i = tid; i < (BATCH + 1) * D_MODEL; i += NTHR) { const int s = i / D_MODEL, k = i % D_MODEL; const float v = s < BATCH ? I->c[s * D_MODEL + k] : I->c_ctx[k]; SCs[i] = v / (1.0f + __expf(-v)); }
                __syncthreads();
            }
            for (int t = wg; t < NT; t += G) { const int l = t / (NMODV / 256), j0 = (t % (NMODV / 256)) * 256;
                misc::f32x4 acc[3] = {{0.f, 0.f, 0.f, 0.f}, {0.f, 0.f, 0.f, 0.f}, {0.f, 0.f, 0.f, 0.f}};
                const float* wp = I->ada_w + (size_t)l * D_MODEL * NMODV + (size_t)(256 * wave) * NMODV + j0 + 4 * lane;
#pragma unroll 8
                for (int k = 0; k < 256; ++k) { const misc::f32x4 wv = *(const misc::f32x4*)(wp + (size_t)k * NMODV); const int kk = 256 * wave + k;
                    acc[0] += wv * SCs[kk]; acc[1] += wv * SCs[D_MODEL + kk]; acc[2] += wv * SCs[2 * D_MODEL + kk]; }
                __syncthreads();
#pragma unroll
                for (int s = 0; s < 3; ++s) *(misc::f32x4*)(red + (wave * 3 + s) * 256 + 4 * lane) = acc[s];
                __syncthreads();
                for (int i = tid; i < 3 * 256; i += NTHR) { const int s = i / 256, c = i % 256; float sum = I->ada_b[(size_t)l * NMODV + j0 + c];
#pragma unroll
                    for (int w8 = 0; w8 < 8; ++w8) sum += red[(w8 * 3 + s) * 256 + c];
                    w.MOD[((size_t)l * (BATCH + 1) + s) * NMODV + j0 + c] = sum; }
            }
            __syncthreads();
        }
        {
            float* scr = (float*)(lds + wave * 8448);
            constexpr int I_IN = (D_MODEL / 64) * (NP / 32), I_OUT = (D_MODEL / 64) * (D_MODEL / 32), I_UP = (D_MODEL / 64) * (2 * D_FF / 32), I_DN = (D_FF / 64) * (D_MODEL / 32),
                          I_UQ = (MLA_Q_LORA / 64) * (NQ_MLA / 32), I_UKV = (MLA_KV_LORA / 64) * (NKV_MLA / 32), I_LB = (LRU_BW / 64) * (LRU_BW / 32), I_LRU = 2 * 2 * NH * I_LB;
            constexpr int I_LAYER = I_IN + I_OUT + I_UP + I_DN + I_UQ + I_UKV + I_LRU;
            for (int it = gwave; it < DEPTH * I_LAYER; it += nwaves) { const int l = it / I_LAYER; int r = it % I_LAYER;
                if (r < I_IN) { misc::transpose_item(I->w_in + (size_t)l * D_MODEL * IN_COLS, D_MODEL, IN_COLS, NP, w.WIN + l * SZ_WIN, scr, r, lane); continue; } r -= I_IN;
                if (r < I_OUT) { misc::transpose_item(I->w_out + (size_t)l * D_MODEL * D_MODEL, D_MODEL, D_MODEL, D_MODEL, w.WOUT + l * SZ_WOUT, scr, r, lane); continue; } r -= I_OUT;
                if (r < I_UP) { misc::transpose_item(I->ffn_w_up + (size_t)l * D_MODEL * 2 * D_FF, D_MODEL, 2 * D_FF, 2 * D_FF, w.WUP + l * SZ_WUP, scr, r, lane); continue; } r -= I_UP;
                if (r < I_DN) { misc::transpose_item(I->ffn_w_down + (size_t)l * D_FF * D_MODEL, D_FF, D_MODEL, D_MODEL, w.WDOWN + l * SZ_WDOWN, scr, r, lane); continue; } r -= I_DN;
                if (r < I_UQ) { misc::transpose_item(I->mla_w_uq + (size_t)l * MLA_Q_LORA * NQ_MLA, MLA_Q_LORA, NQ_MLA, NQ_MLA, w.WUQ + l * SZ_WUQ, scr, r, lane); continue; } r -= I_UQ;
                if (r < I_UKV) { misc::transpose_item(I->mla_w_ukv + (size_t)l * MLA_KV_LORA * NKV_MLA, MLA_KV_LORA, NKV_MLA, NKV_MLA, w.WUKV + l * SZ_WUKV, scr, r, lane); continue; } r -= I_UKV;
                { const int blk = r / I_LB, item = r % I_LB, d = blk / (2 * NH), wh = (blk / NH) & 1, nb = blk % NH;
                  const float* src = (wh == 0 ? I->lru_wa : I->lru_wx) + ((size_t)(l * 2 + d) * NH + nb) * lru::SZ_WBLK;
                  misc::transpose_item(src, LRU_BW, LRU_BW, LRU_BW, w.WLRU + ((size_t)l * 16 + blk) * lru::SZ_WBLK, scr, item, lane); }
            }
        }
        for (long i = gtid; i < (long)M_ALL * D_MODEL / 4; i += gthreads) { const long e = i * 4;
            ((misc::f32x4*)w.H)[i] = e < (long)M_LAT * D_MODEL ? *(const misc::f32x4*)(I->x + e) : *(const misc::f32x4*)(I->ctx + (e - (long)M_LAT * D_MODEL)); }
    }
    SEAM(PH_PRO);

    { LayerCtx C; C.lo = lo; C.hi = hi; C.G = G; C.wg = wg; C.nwaves = nwaves; C.gthreads = gthreads; C.wave0 = C_wave0; C.bar = bar; C.lds = lds; C.lds_raw = lds_raw;
      static_assert(DEPTH == 4, "layer calls are written out (a real layer loop lets LICM park loop-invariant values in registers across every phase: spills)");
      layer_body<0>(C); layer_body<1>(C); layer_body<2>(C); layer_body<3>(C); }
#undef IN
#undef SEAM
}

#ifndef MK_PHASES_PER_LAUNCH
#define MK_PHASES_PER_LAUNCH NPH
#endif
extern "C" void kernel_launch(void* const* d_in, const int* in_sizes, int n_in, void* d_out, int out_size, void* d_ws, size_t ws_size, hipStream_t stream) {
    static int grid = 0;
    if (grid == 0) {
        int dev = 0, cus = 0;
        if (hipGetDevice(&dev) != hipSuccess || hipDeviceGetAttribute(&cus, hipDeviceAttributeMultiprocessorCount, dev) != hipSuccess || cus <= 0) { fprintf(stderr, "kernel_launch: no device\n"); grid = -1; return; }
        if (hipFuncSetAttribute((const void*)fwd, hipFuncAttributeMaxDynamicSharedMemorySize, LDS_BYTES) != hipSuccess) { fprintf(stderr, "kernel_launch: hipFuncSetAttribute failed\n"); grid = -1; return; }
        int per_cu = 0; if (hipOccupancyMaxActiveBlocksPerMultiprocessor(&per_cu, (const void*)fwd, NTHR, LDS_BYTES) != hipSuccess || per_cu < 1) fprintf(stderr, "kernel_launch: occupancy query says %d blocks per CU\n", per_cu);
        (void)hipGetLastError();
        grid = cus;
        const WS w0 = ws_carve(nullptr);
        if (n_in != 34 || w0.total > ws_size) { fprintf(stderr, "kernel_launch: bad inputs / workspace (need %zu, have %zu)\n", w0.total, ws_size); grid = -1; return; }
    }
    if (grid < 0) return;
    (void)hipMemsetAsync(d_ws, 0, 1 << 20, stream);
    Params p; memset(&p, 0, sizeof(p));
    for (int i = 0; i < 34; ++i) p.in[i] = (const float*)d_in[i];
    p.out = (float*)d_out; p.ws = (unsigned char*)d_ws;
    int li = 0;
    for (int lo = 0; lo < NPH; lo += MK_PHASES_PER_LAUNCH, ++li) {
        p.ph_lo = lo; p.ph_hi = lo + MK_PHASES_PER_LAUNCH < NPH ? lo + MK_PHASES_PER_LAUNCH : NPH; p.li = li;
#if defined(PROBE_MASK)
        if (MK_PHASES_PER_LAUNCH == 1 && ((((PROBE_MASK) >> 12) & 1 && lo == 0) || (lo > 0 && (((PROBE_MASK) >> ((lo - 1) % PH_PER_LAYER)) & 1))))
            { Params q = p;
#if defined(PROBE_FLAGS)
              q.pad = PROBE_FLAGS;
#endif
              for (int r = 0; r < PROBE_REPS; ++r) hipLaunchKernelGGL(fwd, dim3(grid), dim3(NTHR), LDS_BYTES, stream, q); }
#endif
        hipLaunchKernelGGL(fwd, dim3(grid), dim3(NTHR), LDS_BYTES, stream, p);
    }
}
```

```cpp
#include <hip/hip_runtime.h>
#include <cstdio>
#include <cstdint>
#include <cstring>
#include <math.h>
#include <stdint.h>

#ifdef CFG_SMALL
constexpr int D_MODEL = 256, BATCH = 2, SEQ = 512, DEPTH = 2, CTX_LEN = 64, GRID_W = 32, HEAD_DIM = 16;
#else
constexpr int D_MODEL = 2048, BATCH = 2, SEQ = 8192, DEPTH = 4, CTX_LEN = 256, GRID_W = 64, HEAD_DIM = 128;
#endif
constexpr int GROUP_W = D_MODEL / 4, NH = GROUP_W / HEAD_DIM;
constexpr int HD = HEAD_DIM;
constexpr int N_MOD = 6;
constexpr float EPS = 1e-6f;
constexpr int LRU_W = GROUP_W, LRU_BW = LRU_W / NH;
constexpr float LRU_C = 8.0f;
constexpr int MLA_Q_LORA = 3 * D_MODEL / 16, MLA_KV_LORA = D_MODEL / 8, MLA_NOPE = HD, MLA_ROPE = HD / 2, MLA_V = HD, MLA_QK = MLA_NOPE + MLA_ROPE;
constexpr int GDN_CHUNK = 64;
constexpr int NA_KH = 8, NA_KW = 16;
constexpr int D_FF = 5 * D_MODEL / 2;
constexpr int ROWS = SEQ / GRID_W;
constexpr int C_LRU_X = 0, C_LRU_G = C_LRU_X + LRU_W, C_CQ = C_LRU_G + LRU_W, C_CKV = C_CQ + MLA_Q_LORA, C_KR = C_CKV + MLA_KV_LORA,
              C_GQ = C_KR + MLA_ROPE, C_GK = C_GQ + GROUP_W, C_GV = C_GK + GROUP_W, C_GG = C_GV + GROUP_W, C_GB = C_GG + GROUP_W,
              C_GA = C_GB + 2 * NH, C_NQ = C_GA + 2 * NH, C_NK = C_NQ + GROUP_W, C_NV = C_NK + GROUP_W, IN_COLS = C_NV + GROUP_W;
constexpr int NP = (IN_COLS + 255) / 256 * 256;
constexpr int M_LAT = BATCH * SEQ, M_CTX = BATCH * CTX_LEN, M_ALL = M_LAT + M_CTX;
constexpr int NMODV = N_MOD * D_MODEL;

typedef unsigned short bf16_t;
__host__ __device__ __forceinline__ bf16_t f2bf(float f) { union { float f; unsigned u; } v; v.f = f; unsigned u = v.u; u += 0x7fffu + ((u >> 16) & 1u); return (bf16_t)(u >> 16); }
__host__ __device__ __forceinline__ float bf2f(bf16_t b) { union { float f; unsigned u; } v; v.u = ((unsigned)b) << 16; return v.f; }
__host__ __device__ __forceinline__ float sigmoidf_(float x) { return 1.0f / (1.0f + expf(-x)); }
__host__ __device__ __forceinline__ float siluf_(float x) { return x / (1.0f + expf(-x)); }
__host__ __device__ __forceinline__ float softplusf_(float x) { return fmaxf(x, 0.0f) + log1pf(expf(-fabsf(x))); }
__host__ __device__ __forceinline__ float geluf_(float x) { return 0.5f * x * (1.0f + tanhf(0.7978845608028654f * (x + 0.044715f * x * x * x))); }

struct RowInfo { int b, t, T, base, set; };
__host__ __device__ __forceinline__ RowInfo row_info(int r) {
    RowInfo i;
    if (r < M_LAT) { i.b = r / SEQ; i.t = r % SEQ; i.T = SEQ; i.base = i.b * SEQ; i.set = i.b; }
    else { const int rr = r - M_LAT; i.b = rr / CTX_LEN; i.t = rr % CTX_LEN; i.T = CTX_LEN; i.base = M_LAT + i.b * CTX_LEN; i.set = BATCH; }
    return i;
}


__host__ __device__ __forceinline__ float bflo(unsigned w) { union { float f; unsigned u; } v; v.u = w << 16; return v.f; }
__host__ __device__ __forceinline__ float bfhi(unsigned w) { union { float f; unsigned u; } v; v.u = w & 0xffff0000u; return v.f; }
#define LDS_BARRIER() asm volatile("s_waitcnt lgkmcnt(0)\n\ts_barrier" ::: "memory")
__device__ __forceinline__ float lane_xor(float v, int mask, int lane) { return __int_as_float(__builtin_amdgcn_ds_bpermute((lane ^ mask) << 2, __float_as_int(v))); }
__device__ __forceinline__ float lane_get(float v, int src_lane) { return __int_as_float(__builtin_amdgcn_ds_bpermute(src_lane << 2, __float_as_int(v))); }
struct Inputs {
    const float *x, *c, *ctx, *c_ctx, *ada_w, *ada_b, *norm_mix_g, *norm_ffn_g, *w_in, *w_out,
        *lru_conv_w, *lru_conv_b, *lru_wa, *lru_ba, *lru_wx, *lru_bx, *lru_lam,
        *mla_qa_g, *mla_w_uq, *mla_kva_g, *mla_w_ukv, *mla_qn_g, *mla_kn_g,
        *gdn_conv_w, *gdn_a_log, *gdn_dt_bias, *gdn_norm_g, *na_qn_g, *na_kn_g, *na_rpb,
        *ffn_w_up, *ffn_conv_w, *ffn_conv_b, *ffn_w_down;
};
constexpr int NQ_MLA = NH * MLA_QK, NKV_MLA = NH * (MLA_NOPE + MLA_V);
constexpr size_t SZ_WIN = (size_t)NP * D_MODEL, SZ_WOUT = (size_t)D_MODEL * D_MODEL, SZ_WUP = (size_t)2 * D_FF * D_MODEL, SZ_WDOWN = (size_t)D_MODEL * D_FF,
                 SZ_WUQ = (size_t)NQ_MLA * MLA_Q_LORA, SZ_WUKV = (size_t)NKV_MLA * MLA_KV_LORA, SZ_WLRU = (size_t)16 * LRU_BW * LRU_BW;
struct WS {
    unsigned* ctl; float *MOD, *H, *PART; bf16_t *U, *Y;
    bf16_t *WIN, *WOUT, *WUP, *WDOWN, *WUQ, *WUKV, *WLRU;
    bf16_t* P; bf16_t *CQN, *CKVN; float *QR, *KVR; bf16_t *QM, *KM, *VM, *NQ, *NK;
    bf16_t *gUT, *gWP, *gKDT, *gQD, *gQK, *gSIT, *gVNT; float* gGT;
    bf16_t *lHLOC, *lACUM; float *lLSUM, *lHIN;
    bf16_t *UP, *ACT;
    size_t total;
};
__host__ __device__ inline WS ws_carve(void* base) {
    WS w; size_t off = 0; char* b = (char*)base;
#define WS_TAKE(T, field, bytes) do { w.field = (T*)(b + off); off += (((size_t)(bytes)) + 255) & ~(size_t)255; } while (0)
    WS_TAKE(unsigned, ctl, 1 << 20);
    WS_TAKE(float, MOD, sizeof(float) * (size_t)DEPTH * (BATCH + 1) * NMODV);
    WS_TAKE(float, H, sizeof(float) * (size_t)M_ALL * D_MODEL);
    WS_TAKE(float, PART, sizeof(float) * (size_t)5 * M_CTX * D_MODEL);
    WS_TAKE(bf16_t, U, 2 * (size_t)M_ALL * D_MODEL);
    WS_TAKE(bf16_t, Y, 2 * (size_t)M_ALL * D_MODEL);
    WS_TAKE(bf16_t, WIN, 2 * SZ_WIN * DEPTH); WS_TAKE(bf16_t, WOUT, 2 * SZ_WOUT * DEPTH); WS_TAKE(bf16_t, WUP, 2 * SZ_WUP * DEPTH); WS_TAKE(bf16_t, WDOWN, 2 * SZ_WDOWN * DEPTH);
    WS_TAKE(bf16_t, WUQ, 2 * SZ_WUQ * DEPTH); WS_TAKE(bf16_t, WUKV, 2 * SZ_WUKV * DEPTH); WS_TAKE(bf16_t, WLRU, 2 * SZ_WLRU * DEPTH);
    const size_t r0 = off;
    WS_TAKE(bf16_t, P, 2 * (size_t)M_ALL * NP);
    WS_TAKE(bf16_t, CQN, 2 * (size_t)M_ALL * MLA_Q_LORA); WS_TAKE(bf16_t, CKVN, 2 * (size_t)M_ALL * MLA_KV_LORA);
    WS_TAKE(float, QR, 4 * (size_t)M_ALL * NQ_MLA); WS_TAKE(float, KVR, 4 * (size_t)M_ALL * NKV_MLA);
    WS_TAKE(bf16_t, QM, 2 * (size_t)M_ALL * NQ_MLA); WS_TAKE(bf16_t, KM, 2 * (size_t)M_ALL * NQ_MLA); WS_TAKE(bf16_t, VM, 2 * (size_t)M_ALL * NH * MLA_V);
    WS_TAKE(bf16_t, NQ, 2 * (size_t)M_ALL * GROUP_W); WS_TAKE(bf16_t, NK, 2 * (size_t)M_ALL * GROUP_W);
    { constexpr size_t NT_ = (size_t)(M_ALL / 64) * NH * 2;
      WS_TAKE(bf16_t, gUT, 2 * NT_ * 128 * 64); WS_TAKE(bf16_t, gWP, 2 * NT_ * 64 * 128); WS_TAKE(bf16_t, gKDT, 2 * NT_ * 128 * 64); WS_TAKE(bf16_t, gQD, 2 * NT_ * 64 * 128);
      WS_TAKE(bf16_t, gQK, 2 * NT_ * 64 * 64); WS_TAKE(bf16_t, gSIT, 2 * NT_ * 128 * 128); WS_TAKE(bf16_t, gVNT, 2 * NT_ * 128 * 64); WS_TAKE(float, gGT, 4 * NT_ * DEPTH); }
    WS_TAKE(bf16_t, lHLOC, 2 * (size_t)2 * M_ALL * LRU_W); WS_TAKE(bf16_t, lACUM, 2 * (size_t)2 * M_ALL * LRU_W);
    WS_TAKE(float, lLSUM, 4 * (size_t)(M_ALL / 64) * 2 * 2 * LRU_W); WS_TAKE(float, lHIN, 4 * (size_t)(M_ALL / 64) * 2 * LRU_W);
    const size_t r1 = off;
    off = r0;
    WS_TAKE(bf16_t, UP, 2 * (size_t)M_ALL * 2 * D_FF); WS_TAKE(bf16_t, ACT, 2 * (size_t)M_ALL * D_FF);
    const size_t f1 = off;
#undef WS_TAKE
    w.total = r1 > f1 ? r1 : f1;
    return w;
}

namespace pg8 {
#define PG8_LAS __attribute__((address_space(3)))
typedef unsigned short bf16_t;
typedef short bf16x8 __attribute__((ext_vector_type(8)));
typedef float f32x4 __attribute__((ext_vector_type(4)));
typedef unsigned u32x4 __attribute__((ext_vector_type(4)));
constexpr int BM = 256, BK = 64, HALF = 128, HTB = HALF * BK * 2  , STAGE_BYTES = 8 * HTB, NXCD = 8, WGM = 8;

__host__ __device__ __forceinline__ int lds_byte(int r, int c) { const int st = (r >> 4) * 2 + (c >> 5), rr = r & 15, cc = c & 31, ob = rr * 64 + cc * 2; return st * 1024 + (ob ^ (((ob >> 9) & 1) << 5)); }
__host__ __device__ __forceinline__ void stage_rc(int b, int& R, int& C) { const int st = b / 1024, sb = b % 1024, swz = sb ^ (((sb >> 9) & 1) << 5); R = (st >> 1) * 16 + swz / 64; C = (st & 1) * 32 + (swz % 64) / 2; }
__host__ __device__ __forceinline__ int perm32(int rho) { const int n = rho >> 4, i = rho & 15; return 8 * (i >> 2) + 4 * n + (i & 3); }

struct Unit { int pm, pn, ks; };
struct Gemm { const bf16_t* A; const bf16_t* Bt; int M, N, K, ld; };

struct StaticOrder {
    int nM, nN, nwg, G, c;
    __host__ __device__ void init(int M, int N, int G_, int c_) { nM = M / BM; nN = N / BM; nwg = nM * nN; G = G_; c = c_; }
    __host__ __device__ bool next(int i, Unit& u) const {
        const long L = (long)i * G + c; if (L >= nwg) return false;
        int wgid = (int)L; { const int q = nwg / NXCD, r = nwg % NXCD, xcd = wgid % NXCD, off = wgid / NXCD; wgid = (xcd < r ? xcd * (q + 1) : r * (q + 1) + (xcd - r) * q) + off; }
        const int nig = WGM * nN, gid = wgid / nig, fm = gid * WGM, gsz = (nM - fm) < WGM ? (nM - fm) : WGM;
        u.pm = fm + ((wgid % nig) % gsz); u.pn = (wgid % nig) / gsz; u.ks = 0; return true;
    }
    __device__ __forceinline__ void a_ready(const Unit&) const {}
    __device__ __forceinline__ void done(const Unit&) const {}
};
__device__ __forceinline__ unsigned cvt_pk_bf16(float lo, float hi) { unsigned r; asm volatile("v_cvt_pk_bf16_f32 %0, %1, %2" : "=v"(r) : "v"(lo), "v"(hi)); return r; }
typedef float f32x2 __attribute__((ext_vector_type(2)));
__device__ __forceinline__ f32x2 gelu_pk(f32x2 v) {
    const f32x2 av = __builtin_elementwise_abs(v), d = av * 0.2316418882f + 1.0f;
    f32x2 t; t.x = __builtin_amdgcn_rcpf(d.x); t.y = __builtin_amdgcn_rcpf(d.y);
    f32x2 q = t * 0.5307027145f + (-0.7265760135f); q = q * t + 0.7107068705f; q = q * t + (-0.142248368f); q = q * t + 0.127414796f; q = q * t;
    const f32x2 s = (v * v) * (-0.72134752044f);
    f32x2 e; e.x = __builtin_amdgcn_exp2f(s.x); e.y = __builtin_amdgcn_exp2f(s.y);
    const f32x2 m = v * (q * e), r = v - m;
    f32x2 o; o.x = v.x < 0.f ? m.x : r.x; o.y = v.y < 0.f ? m.y : r.y; return o;
}

template <int ACT  > struct EpiBf16 {
    static constexpr bool PERM = true, AFTER_DRAIN = false; static_assert(ACT == 0 || ACT == 1, "EpiBf16: ACT is 0 (none) or 1 (gelu_pk)");
    bf16_t* O; int ldc; const float* bias; int split_cols; size_t split_stride; float scale0;
    __device__ __forceinline__ void operator()(const f32x4 (&acc)[2][2][4][2], const Unit& u, int wr, int wc, int fr, int fq) const {
        const int row0 = u.pm * BM + wr * 64 + fr; int colt = u.pn * BM; bf16_t* base = O;
        float sc = 1.f; if (split_cols) { const int t = colt / split_cols; base += (size_t)t * split_stride; colt -= t * split_cols; if (t == 0) sc = scale0; }
        const int col0 = colt + wc * 32 + 8 * fq, bcol0 = u.pn * BM + wc * 32 + 8 * fq;
        f32x4 bv[2][2];
#pragma unroll
        for (int bj = 0; bj < 2; ++bj)
#pragma unroll
            for (int n = 0; n < 2; ++n) bv[bj][n] = bias ? *(const f32x4*)(bias + bcol0 + bj * HALF + 4 * n) : (f32x4){0.f, 0.f, 0.f, 0.f};
#pragma unroll
        for (int ai = 0; ai < 2; ++ai)
#pragma unroll
            for (int m = 0; m < 4; ++m) { bf16_t* rowp = base + (size_t)(row0 + ai * HALF + m * 16) * ldc + col0;
#pragma unroll
                for (int bj = 0; bj < 2; ++bj) { f32x4 v0 = acc[ai][bj][m][0] + bv[bj][0], v1 = acc[ai][bj][m][1] + bv[bj][1];
                    if (ACT == 1) { f32x2 a = gelu_pk((f32x2){v0[0], v0[1]}), b = gelu_pk((f32x2){v0[2], v0[3]}), c = gelu_pk((f32x2){v1[0], v1[1]}), d = gelu_pk((f32x2){v1[2], v1[3]});
                        v0 = (f32x4){a.x, a.y, b.x, b.y}; v1 = (f32x4){c.x, c.y, d.x, d.y}; }
                    v0 = v0 * sc; v1 = v1 * sc; u32x4 w; w.x = cvt_pk_bf16(v0[0], v0[1]); w.y = cvt_pk_bf16(v0[2], v0[3]); w.z = cvt_pk_bf16(v1[0], v1[1]); w.w = cvt_pk_bf16(v1[2], v1[3]);
                    *(u32x4*)(rowp + bj * HALF) = w; } }
    }
};

struct EpiF32 {
    static constexpr bool PERM = false, AFTER_DRAIN = false;
    float* C; int ldc;
    __device__ __forceinline__ void operator()(const f32x4 (&acc)[2][2][4][2], const Unit& u, int wr, int wc, int fr, int fq) const {
        const int row0 = u.pm * BM + wr * 64 + fr, col0 = u.pn * BM + wc * 32 + 4 * fq;
#pragma unroll
        for (int ai = 0; ai < 2; ++ai)
#pragma unroll
            for (int m = 0; m < 4; ++m) { float* rowp = C + (size_t)(row0 + ai * HALF + m * 16) * ldc + col0;
#pragma unroll
                for (int bj = 0; bj < 2; ++bj)
#pragma unroll
                    for (int n = 0; n < 2; ++n) *(f32x4*)(rowp + bj * HALF + n * 16) = acc[ai][bj][m][n]; }
    }
};
struct EpiGateRes {
    static constexpr bool PERM = false, AFTER_DRAIN = false;
    const float* base; float* out; int ldc; const float* gate; int set_stride; int rows_per_set; int nsets_lat; int lat_rows;
    __device__ __forceinline__ void operator()(const f32x4 (&acc)[2][2][4][2], const Unit& u, int wr, int wc, int fr, int fq) const {
        const int row0 = u.pm * BM + wr * 64 + fr, col0 = u.pn * BM + wc * 32 + 4 * fq;
        const int set = (u.pm * BM >= lat_rows) ? nsets_lat : (u.pm * BM) / rows_per_set;
        const float* gp = gate + (size_t)set * set_stride + col0;
        f32x4 gv[2][2];
#pragma unroll
        for (int bj = 0; bj < 2; ++bj)
#pragma unroll
            for (int n = 0; n < 2; ++n) gv[bj][n] = *(const f32x4*)(gp + bj * HALF + n * 16);
#pragma unroll
        for (int ai = 0; ai < 2; ++ai)
#pragma unroll
            for (int m = 0; m < 4; ++m) { const size_t off = (size_t)(row0 + ai * HALF + m * 16) * ldc + col0;
#pragma unroll
                for (int bj = 0; bj < 2; ++bj)
#pragma unroll
                    for (int n = 0; n < 2; ++n) { const f32x4 b = *(const f32x4*)(base + off + bj * HALF + n * 16); *(f32x4*)(out + off + bj * HALF + n * 16) = b + gv[bj][n] * acc[ai][bj][m][n]; } }
    }
};

struct EpiPart {
    static constexpr bool PERM = false, AFTER_DRAIN = false;
    float* C; int ldc; size_t ks_stride;
    __device__ __forceinline__ void operator()(const f32x4 (&acc)[2][2][4][2], const Unit& u, int wr, int wc, int fr, int fq) const {
        const int row0 = u.pm * BM + wr * 64 + fr, col0 = u.pn * BM + wc * 32 + 4 * fq; float* Cb = C + (size_t)u.ks * ks_stride;
#pragma unroll
        for (int ai = 0; ai < 2; ++ai)
#pragma unroll
            for (int m = 0; m < 4; ++m) { float* rowp = Cb + (size_t)(row0 + ai * HALF + m * 16) * ldc + col0;
#pragma unroll
                for (int bj = 0; bj < 2; ++bj)
#pragma unroll
                    for (int n = 0; n < 2; ++n) *(f32x4*)(rowp + bj * HALF + n * 16) = acc[ai][bj][m][n]; }
    }
};

template <class Epi, class Sched, bool ALIGN_EPI = false, bool SP2 = false>
__device__ __forceinline__ void gemm_phase(PG8_LAS unsigned char* lds, const Gemm g, const Sched& S, const Epi& E, const int tid_in) {
    int tid_ = tid_in; asm volatile("" : "+v"(tid_));
    const int tid = tid_, wid = __builtin_amdgcn_readfirstlane(tid >> 6), lane = tid & 63, wr = wid >> 2, wc = wid & 3, fr = lane & 15, fq = lane >> 4;
    const int K = g.K, nt = K / BK;
    unsigned voffA[2], voffB[2];
#pragma unroll
    for (int i = 0; i < 2; ++i) { int R, C; stage_rc(tid * 16 + i * 8192, R, C); const int Rb = Epi::PERM ? ((R & ~31) + perm32(R & 31)) : R;
        voffA[i] = (unsigned)(R * g.ld + C) * 2u; voffB[i] = (unsigned)(Rb * g.ld + C) * 2u; }
    const size_t kstep = (size_t)(BK * 2);
    const size_t hstep = (size_t)HALF * g.ld * 2;
    const size_t tstep = 2 * hstep;
    const unsigned ldsw = (unsigned)wid * 1024u;
    const int aoff = lds_byte(wr * 64 + fr, fq * 8), boff = lds_byte(wc * 32 + fr, fq * 8);
#define PG8_SA(b, h) (((b) * 2 + (h)) * HTB)
#define PG8_SB(b, h) ((4 + (b) * 2 + (h)) * HTB)
#define PG8_STAGE(bufoff, gbase, voff) do { _Pragma("unroll") for (int _i = 0; _i < 2; ++_i) \
        __builtin_amdgcn_global_load_lds((const unsigned*)((const char*)(gbase) + (voff)[_i]), (PG8_LAS unsigned*)(lds + (bufoff) + ldsw + _i * 8192), 16, 0, 0); } while (0)
#define PG8_LDA(dst, b, h) do { _Pragma("unroll") for (int m = 0; m < 4; ++m) _Pragma("unroll") for (int k = 0; k < 2; ++k) dst[m][k] = *(const PG8_LAS bf16x8*)(lds + PG8_SA(b, h) + aoff + m * 2048 + k * 1024); } while (0)
#define PG8_LDB(dst, b, h) do { _Pragma("unroll") for (int n = 0; n < 2; ++n) _Pragma("unroll") for (int k = 0; k < 2; ++k) dst[n][k] = *(const PG8_LAS bf16x8*)(lds + PG8_SB(b, h) + boff + n * 2048 + k * 1024); } while (0)
#define PG8_MMA(ai, bj, At, Bt) do { __builtin_amdgcn_s_setprio(1); _Pragma("unroll") for (int m = 0; m < 4; ++m) _Pragma("unroll") for (int n = 0; n < 2; ++n) _Pragma("unroll") for (int k = 0; k < 2; ++k) \
        acc[ai][bj][m][n] = __builtin_amdgcn_mfma_f32_16x16x32_bf16(Bt[n][k], At[m][k], acc[ai][bj][m][n], 0, 0, 0); __builtin_amdgcn_s_setprio(0); } while (0)
#define PG8_WAIT_V(n) asm volatile("s_waitcnt vmcnt(" #n ")" ::: "memory")
#define PG8_WAIT_L(n) asm volatile("s_waitcnt lgkmcnt(" #n ")" ::: "memory")
#define PG8_BAR __builtin_amdgcn_s_barrier()
#define PG8_SCHED __builtin_amdgcn_sched_barrier(0)
    Unit cur, nxt; int ui = 0;
    if (!S.next(0, cur)) return;
    f32x4 acc[2][2][4][2];
#pragma unroll
    for (int a = 0; a < 2; ++a)
#pragma unroll
        for (int b = 0; b < 2; ++b)
#pragma unroll
            for (int m = 0; m < 4; ++m)
#pragma unroll
                for (int n = 0; n < 2; ++n) acc[a][b][m][n] = (f32x4){0.f, 0.f, 0.f, 0.f};
    bf16x8 At[4][2], B0[2][2], B1[2][2];
    const size_t ksb = (size_t)K * 2;
    const char* cA = (const char*)g.A + (size_t)cur.pm * tstep + (size_t)cur.ks * ksb; const char* cB = (const char*)g.Bt + (size_t)cur.pn * tstep + (size_t)cur.ks * ksb;
    S.a_ready(cur);
    if constexpr (SP2) {
        PG8_STAGE(PG8_SB(0, 0), cB, voffB); PG8_STAGE(PG8_SB(0, 1), cB + hstep, voffB); PG8_STAGE(PG8_SA(0, 0), cA, voffA); PG8_STAGE(PG8_SA(0, 1), cA + hstep, voffA);
        if (wr == 1) PG8_BAR;
        PG8_WAIT_V(2); PG8_BAR;
        PG8_STAGE(PG8_SB(1, 0), cB + kstep, voffB); PG8_STAGE(PG8_SA(1, 0), cA + kstep, voffA); PG8_STAGE(PG8_SB(1, 1), cB + hstep + kstep, voffB);
        PG8_WAIT_V(6); PG8_BAR;
    } else {
        PG8_STAGE(PG8_SB(0, 0), cB, voffB); PG8_STAGE(PG8_SA(0, 0), cA, voffA); PG8_STAGE(PG8_SB(0, 1), cB + hstep, voffB); PG8_STAGE(PG8_SA(0, 1), cA + hstep, voffA);
        if (wr == 1) PG8_BAR;
        PG8_WAIT_V(4); PG8_BAR;
        PG8_STAGE(PG8_SB(1, 0), cB + kstep, voffB); PG8_STAGE(PG8_SA(1, 0), cA + kstep, voffA); PG8_STAGE(PG8_SB(1, 1), cB + hstep + kstep, voffB);
        PG8_WAIT_V(6); PG8_BAR;
    }
    for (;;) {
        const bool has_next = S.next(ui + 1, nxt);
        const char* nA = has_next ? (const char*)g.A + (size_t)nxt.pm * tstep + (size_t)nxt.ks * ksb : cA; const char* nB = has_next ? (const char*)g.Bt + (size_t)nxt.pn * tstep + (size_t)nxt.ks * ksb : cB;
        for (int t = 0; t < nt; t += 2) {
            const bool last = (t == nt - 2);
            const char* a1 = cA + (size_t)(t + 1) * kstep;
            const char* a2 = last ? nA : cA + (size_t)(t + 2) * kstep; const char* b2 = last ? nB : cB + (size_t)(t + 2) * kstep;
            const char* a3 = a2 + kstep; const char* b3 = b2 + kstep;
            if (last && has_next) S.a_ready(nxt);
            if constexpr (SP2) {
            PG8_LDB(B0, 0, 0); PG8_LDB(B1, 0, 1); PG8_SCHED; PG8_LDA(At, 0, 0); PG8_STAGE(PG8_SA(1, 1), a1 + hstep, voffA);
            PG8_WAIT_V(8); PG8_WAIT_L(0); PG8_BAR; PG8_MMA(0, 0, At, B0); PG8_MMA(0, 1, At, B1); PG8_BAR; PG8_SCHED;
            PG8_LDA(At, 0, 1); PG8_STAGE(PG8_SB(0, 0), b2, voffB); PG8_STAGE(PG8_SB(0, 1), b2 + hstep, voffB); PG8_STAGE(PG8_SA(0, 0), a2, voffA);
            PG8_WAIT_V(8); PG8_WAIT_L(0); PG8_BAR; PG8_MMA(1, 0, At, B0); PG8_MMA(1, 1, At, B1); PG8_BAR; PG8_SCHED;
            PG8_LDB(B0, 1, 0); PG8_LDB(B1, 1, 1); PG8_SCHED; PG8_LDA(At, 1, 0); PG8_STAGE(PG8_SA(0, 1), a2 + hstep, voffA);
            PG8_WAIT_V(8); PG8_WAIT_L(0); PG8_BAR; PG8_MMA(0, 0, At, B0); PG8_MMA(0, 1, At, B1); PG8_BAR; PG8_SCHED;
            PG8_LDA(At, 1, 1); PG8_STAGE(PG8_SB(1, 0), b3, voffB); PG8_STAGE(PG8_SB(1, 1), b3 + hstep, voffB); PG8_STAGE(PG8_SA(1, 0), a3, voffA);
            PG8_WAIT_V(8); PG8_WAIT_L(0); PG8_BAR; PG8_MMA(1, 0, At, B0); PG8_MMA(1, 1, At, B1); PG8_BAR; PG8_SCHED;
            } else {
            PG8_LDB(B0, 0, 0); PG8_SCHED; PG8_LDA(At, 0, 0); PG8_STAGE(PG8_SA(1, 1), a1 + hstep, voffA);
            PG8_WAIT_L(8); PG8_BAR; PG8_WAIT_L(0); PG8_MMA(0, 0, At, B0); PG8_BAR; PG8_SCHED;
            PG8_LDB(B1, 0, 1); PG8_STAGE(PG8_SB(0, 0), b2, voffB);
            PG8_BAR; PG8_WAIT_L(0); PG8_MMA(0, 1, At, B1); PG8_BAR;
            PG8_LDA(At, 0, 1); PG8_STAGE(PG8_SA(0, 0), a2, voffA);
            PG8_BAR; PG8_WAIT_L(0); PG8_MMA(1, 0, At, B0); PG8_BAR; PG8_SCHED;
            PG8_STAGE(PG8_SB(0, 1), b2 + hstep, voffB);
            PG8_WAIT_V(6); PG8_BAR; PG8_MMA(1, 1, At, B1); PG8_BAR;
            PG8_LDB(B0, 1, 0); PG8_SCHED; PG8_LDA(At, 1, 0); PG8_STAGE(PG8_SA(0, 1), a2 + hstep, voffA);
            PG8_WAIT_L(8); PG8_BAR; PG8_WAIT_L(0); PG8_MMA(0, 0, At, B0); PG8_BAR; PG8_SCHED;
            PG8_LDB(B1, 1, 1); PG8_STAGE(PG8_SB(1, 0), b3, voffB);
            PG8_BAR; PG8_WAIT_L(0); PG8_MMA(0, 1, At, B1); PG8_BAR;
            PG8_LDA(At, 1, 1); PG8_STAGE(PG8_SA(1, 0), a3, voffA);
            PG8_BAR; PG8_WAIT_L(0); PG8_MMA(1, 0, At, B0); PG8_BAR; PG8_SCHED;
            PG8_STAGE(PG8_SB(1, 1), b3 + hstep, voffB);
            PG8_WAIT_V(6); PG8_BAR; PG8_MMA(1, 1, At, B1); PG8_BAR;
            }
        }
        if constexpr (ALIGN_EPI) { if (wr == 0) PG8_BAR; }
        if constexpr (!Epi::AFTER_DRAIN) { E(acc, cur, wr, wc, fr, fq); S.done(cur); }
        if (!has_next) break;
#pragma unroll
        for (int a = 0; a < 2; ++a)
#pragma unroll
            for (int b = 0; b < 2; ++b)
#pragma unroll
                for (int m = 0; m < 4; ++m)
#pragma unroll
                    for (int n = 0; n < 2; ++n) acc[a][b][m][n] = (f32x4){0.f, 0.f, 0.f, 0.f};
        cur = nxt; cA = nA; cB = nB; ++ui;
        if constexpr (ALIGN_EPI) { if (wr == 1) PG8_BAR; }
    }
    PG8_WAIT_V(0);
    if constexpr (!ALIGN_EPI) { if (wr == 0) PG8_BAR; }
    PG8_BAR;
    if constexpr (Epi::AFTER_DRAIN) { E.fused(acc, cur, wr, wc, fr, fq, lds, wid, lane); S.done(cur); }
#undef PG8_SA
#undef PG8_SB
#undef PG8_STAGE
#undef PG8_LDA
#undef PG8_LDB
#undef PG8_MMA
#undef PG8_WAIT_V
#undef PG8_WAIT_L
#undef PG8_BAR
#undef PG8_SCHED
}
}

namespace att {
using bf16x8 = __attribute__((ext_vector_type(8))) short;
using s16x4  = __attribute__((ext_vector_type(4))) short;
using f32x16 = __attribute__((ext_vector_type(16))) float;
using u32x4  = __attribute__((ext_vector_type(4))) unsigned;
constexpr int NW = 8, QBLK = 32, KVBLK = 64, DV = 128;
#define ATT_SBAR() __builtin_amdgcn_sched_barrier(0)
__device__ __forceinline__ int crow(int r, int hi) { return (r & 3) + 8 * (r >> 2) + 4 * hi; }
__device__ __forceinline__ unsigned cvtpk(float lo, float hi) { unsigned r; asm volatile("v_cvt_pk_bf16_f32 %0, %1, %2" : "=v"(r) : "v"(lo), "v"(hi)); return r; }
template <int DQK> __device__ __forceinline__ int kswz(int row, int colB) { return row * (DQK * 2) + (colB ^ ((row & 7) << 4)); }
constexpr float THR = 8.f;

template <int DQK> struct Cfg {
    static constexpr int SHM_V = KVBLK * DV * 2, SHM_K = KVBLK * DQK * 2;
    static constexpr int OFF_V = 0, OFF_K = 2 * SHM_V, OFF_WS = OFF_K + 2 * SHM_K, OFF_BIAS = OFF_WS + NW * 64 * 4, LDS_BYTES = OFF_BIAS + 10240;
    static constexpr int KCH = DQK / 8;
    static constexpr int KLD = (64 * KCH) / 512;
};

struct Job {
    const bf16_t* Q;
    const bf16_t* K;
    const bf16_t* V;
    bf16_t* O;
    int nt;
    int seg0_tiles, row_seg0, row_seg1;
    int R0; int rlo;
};

__device__ __forceinline__ int tile_row(const Job& J, int j) {
    if (j < J.seg0_tiles) return J.row_seg0 + 64 * j;
    int jj = j - J.seg0_tiles; if (jj > 3) jj = 0; return J.row_seg1 + 64 * jj;
}

__device__ __forceinline__ void partialSM(f32x16& p0, f32x16& p1, float& m_reg, float& mn, float& alpha, float C, float thr_raw) {
    float pmax = p0[0];
#pragma unroll
    for (int r = 1; r < 16; ++r) pmax = fmaxf(pmax, p0[r]);
#pragma unroll
    for (int r = 0; r < 16; ++r) pmax = fmaxf(pmax, p1[r]);
    { auto rr = __builtin_amdgcn_permlane32_swap(__float_as_uint(pmax), __float_as_uint(pmax), false, false);
      pmax = fmaxf(__uint_as_float(rr[0]), __uint_as_float(rr[1])); }
    if (__builtin_expect(__all(pmax - m_reg <= thr_raw), 1)) { mn = m_reg; alpha = 1.f; }
    else { mn = fmaxf(m_reg, pmax); alpha = __builtin_amdgcn_exp2f((m_reg - mn) * C); m_reg = mn; }
    const float mnC = -mn * C;
#pragma unroll
    for (int r = 0; r < 16; ++r) p0[r] = fmaf(p0[r], C, mnC);
#pragma unroll
    for (int r = 0; r < 16; ++r) p1[r] = fmaf(p1[r], C, mnC);
#pragma unroll
    for (int r = 0; r < 16; ++r) p0[r] = __builtin_amdgcn_exp2f(p0[r]);
}
__device__ __forceinline__ void finishSM(f32x16& p0, f32x16& p1, float alpha, float& l_reg, bf16x8& pa0, bf16x8& pa1, bf16x8& pa2, bf16x8& pa3) {
#pragma unroll
    for (int r = 0; r < 16; ++r) p1[r] = __builtin_amdgcn_exp2f(p1[r]);
    float ps = 0;
#pragma unroll
    for (int r = 0; r < 16; ++r) ps += p0[r];
#pragma unroll
    for (int r = 0; r < 16; ++r) ps += p1[r];
    { auto rr = __builtin_amdgcn_permlane32_swap(__float_as_uint(ps), __float_as_uint(ps), false, false);
      ps = __uint_as_float(rr[0]) + __uint_as_float(rr[1]); }
    l_reg = l_reg * alpha + ps;
#define ATT_PK4(P, BASE, OUT) do { unsigned a0 = cvtpk(P[BASE + 0], P[BASE + 1]), a1 = cvtpk(P[BASE + 2], P[BASE + 3]);   \
    unsigned b0 = cvtpk(P[BASE + 4], P[BASE + 5]), b1 = cvtpk(P[BASE + 6], P[BASE + 7]);                              \
    auto r0 = __builtin_amdgcn_permlane32_swap(a0, b0, false, false); auto r1 = __builtin_amdgcn_permlane32_swap(a1, b1, false, false); \
    u32x4 w = {r0[0], r1[0], r0[1], r1[1]}; OUT = *reinterpret_cast<bf16x8*>(&w); } while (0)
    ATT_PK4(p0, 0, pa0); ATT_PK4(p0, 8, pa1); ATT_PK4(p1, 0, pa2); ATT_PK4(p1, 8, pa3);
#undef ATT_PK4
}
template <int DQK> __device__ __forceinline__ void qkt(f32x16& p0, f32x16& p1, const char* Ks, const bf16x8* qr, int r32, int hi) {
    p0 = f32x16{}; p1 = f32x16{};
#pragma unroll
    for (int d0 = 0; d0 < DQK / 16; ++d0) { const int cb = (d0 * 16 + hi * 8) * 2;
        const bf16x8 b0 = *reinterpret_cast<const bf16x8*>(Ks + kswz<DQK>(r32, cb));
        const bf16x8 b1 = *reinterpret_cast<const bf16x8*>(Ks + kswz<DQK>(32 + r32, cb));
        p0 = __builtin_amdgcn_mfma_f32_32x32x16_bf16(b0, qr[d0], p0, 0, 0, 0);
        p1 = __builtin_amdgcn_mfma_f32_32x32x16_bf16(b1, qr[d0], p1, 0, 0, 0); }
}
__device__ __forceinline__ int v_st(int k, int c) { const int kk = (k & ~0xC) | ((k & 4) << 1) | ((k & 8) >> 1); return ((kk >> 3) * 4 + (c >> 5)) * 512 + ((kk & 7) * 32 + (c & 31)) * 2; }
__device__ __forceinline__ int v_rd_base(int lane) { return ((lane & 3) << 3) | (((lane >> 2) & 3) << 6) | (((lane >> 4) & 1) << 5) | (((lane >> 5) & 1) << 8); }
constexpr int v_rd_off(int d0, int ks, int half) { return d0 * 512 + ks * 4096 + half * 2048; }
template <int OFF> __device__ __forceinline__ s16x4 tr_read(int vb) { s16x4 r; asm volatile("ds_read_b64_tr_b16 %0, %1 offset:%2" : "=&v"(r) : "v"(vb), "i"(OFF) : "memory"); return r; }
template <int D0> __device__ __forceinline__ void pv_one(f32x16& od, int vb, bf16x8 pa0, bf16x8 pa1, bf16x8 pa2, bf16x8 pa3) {
    const s16x4 l0 = tr_read<v_rd_off(D0, 0, 0)>(vb), h0 = tr_read<v_rd_off(D0, 0, 1)>(vb), l1 = tr_read<v_rd_off(D0, 1, 0)>(vb), h1 = tr_read<v_rd_off(D0, 1, 1)>(vb);
    const s16x4 l2 = tr_read<v_rd_off(D0, 2, 0)>(vb), h2 = tr_read<v_rd_off(D0, 2, 1)>(vb), l3 = tr_read<v_rd_off(D0, 3, 0)>(vb), h3 = tr_read<v_rd_off(D0, 3, 1)>(vb);
    asm volatile("s_waitcnt lgkmcnt(0)" ::: "memory"); ATT_SBAR();
#define ATT_PK(L, H) (bf16x8){L[0], L[1], L[2], L[3], H[0], H[1], H[2], H[3]}
    od = __builtin_amdgcn_mfma_f32_32x32x16_bf16(pa0, ATT_PK(l0, h0), od, 0, 0, 0);
    od = __builtin_amdgcn_mfma_f32_32x32x16_bf16(pa1, ATT_PK(l1, h1), od, 0, 0, 0);
    od = __builtin_amdgcn_mfma_f32_32x32x16_bf16(pa2, ATT_PK(l2, h2), od, 0, 0, 0);
    od = __builtin_amdgcn_mfma_f32_32x32x16_bf16(pa3, ATT_PK(l3, h3), od, 0, 0, 0);
#undef ATT_PK
}
__device__ __forceinline__ void pv_d0(f32x16* o, int vb, bf16x8 pa0, bf16x8 pa1, bf16x8 pa2, bf16x8 pa3) {
    pv_one<0>(o[0], vb, pa0, pa1, pa2, pa3); pv_one<1>(o[1], vb, pa0, pa1, pa2, pa3); pv_one<2>(o[2], vb, pa0, pa1, pa2, pa3); pv_one<3>(o[3], vb, pa0, pa1, pa2, pa3);
}
constexpr int NA_BROW = 160, NA_BORG = 64 + (NA_KW - 1);
__device__ __forceinline__ void na_bias(f32x16& p0, f32x16& p1, const Job& J, int j, int R, int c, int hi, const float* biasq) {
    const int nloc = J.seg0_tiles;
    if (j >= nloc && j < nloc + 4) return;
    const int rr = J.rlo + j; int r0 = R - NA_KH / 2; r0 = r0 < 0 ? 0 : (r0 > ROWS - NA_KH ? ROWS - NA_KH : r0);
    const bool rowok = (j < nloc) && rr >= r0 && rr < r0 + NA_KH;
    if (!rowok) {
#pragma unroll
        for (int r = 0; r < 16; ++r) { p0[r] = -1e30f; p1[r] = -1e30f; }
        return; }
    int c0 = c - NA_KW / 2; c0 = c0 < 0 ? 0 : (c0 > GRID_W - NA_KW ? GRID_W - NA_KW : c0);
    const int dr = rr - R + (NA_KH - 1);
    const float* bl = biasq + dr * NA_BROW + NA_BORG + 4 * hi - c;
    const int vb = 4 * hi - c0;
#pragma unroll
    for (int r = 0; r < 16; ++r) { const int cc = (r & 3) + 8 * (r >> 2);
        p0[r] = ((unsigned)(cc + vb) < (unsigned)NA_KW) ? p0[r] + bl[cc] : -1e30f;
        p1[r] = ((unsigned)(cc + 32 + vb) < (unsigned)NA_KW) ? p1[r] + bl[cc + 32] : -1e30f; }
}

#define ATT_LAS __attribute__((address_space(3)))
template <int DQK, bool NA, int LDQ, int LDK, int LDV, int LDO>
__device__ __forceinline__ void attn_unit(const Job& J, char* lds, const float scale, const int tid_in) {
    using C_ = Cfg<DQK>;
    int tid_ = tid_in; asm volatile("" : "+v"(tid_));
    const int tid = tid_, wid = __builtin_amdgcn_readfirstlane(tid >> 6), lane = tid & 63, r32 = lane & 31, hi = lane >> 5;
    char* V_lds = lds + C_::OFF_V; char* K_lds = lds + C_::OFF_K;
    const unsigned ldsb = (unsigned)(uintptr_t)lds;
    float* wsf = (float*)(lds + C_::OFF_WS) + wid * 64; float* li_l = wsf; float* al_l = wsf + 32;
    const float* biasq = (const float*)(lds + C_::OFF_BIAS);
    const float Cc = scale * 1.4426950408889634f, thr_raw = THR / scale;
    float m_reg = -1e5f, l_reg = 0; f32x16 o[4] = {}; bf16x8 qr[DQK / 16];
    const bf16_t* Qw = J.Q + (long)(wid * QBLK + r32) * LDQ + hi * 8;
#pragma unroll
    for (int d0 = 0; d0 < DQK / 16; ++d0) qr[d0] = *reinterpret_cast<const bf16x8*>(Qw + d0 * 16);
    const int naR = J.R0 + (wid >> 1), nac = (wid & 1) * 32 + r32;
    const int vb0 = (int)(uintptr_t)V_lds + v_rd_base(lane);
    unsigned koff[C_::KLD], voff[2];
#pragma unroll
    for (int i = 0; i < C_::KLD; ++i) { const int sl = 512 * i + tid, row = sl / C_::KCH, cs = sl % C_::KCH, chunk = (cs & ~7) | ((cs & 7) ^ (row & 7)); koff[i] = (unsigned)(row * LDK * 2 + chunk * 16); }
#pragma unroll
    for (int i = 0; i < 2; ++i) { const int sl = 512 * i + tid, sub = sl >> 5, wi = sl & 31, kk = (sub >> 2) * 8 + (wi >> 2), k = (kk & ~0xC) | ((kk & 4) << 1) | ((kk & 8) >> 1), c = (sub & 3) * 32 + (wi & 3) * 8;
        voff[i] = (unsigned)(k * LDV * 2 + c * 2); }
#define ATT_STAGE(j, b) do { const int row0_ = tile_row(J, (j)); const char* vp_ = (const char*)(J.V + (size_t)row0_ * LDV); const char* kp_ = (const char*)(J.K + (size_t)row0_ * LDK); \
        _Pragma("unroll") for (int i_ = 0; i_ < C_::KLD; ++i_) __builtin_amdgcn_global_load_lds((const unsigned*)(kp_ + koff[i_]), (ATT_LAS unsigned*)(ldsb + C_::OFF_K + (b) * C_::SHM_K + (512 * i_ + 64 * wid) * 16), 16, 0, 0); \
        _Pragma("unroll") for (int i_ = 0; i_ < 2; ++i_) __builtin_amdgcn_global_load_lds((const unsigned*)(vp_ + voff[i_]), (ATT_LAS unsigned*)(ldsb + C_::OFF_V + (b) * C_::SHM_V + (512 * i_ + 64 * wid) * 16), 16, 0, 0); } while (0)
    const int NT = J.nt;
    __syncthreads();
    ATT_STAGE(0, 0); asm volatile("s_waitcnt vmcnt(0)" ::: "memory"); __syncthreads();
    for (int j = 0; j < NT; ++j) {
        const int buf = j & 1;
        if (j + 1 < NT) ATT_STAGE(j + 1, buf ^ 1);
        f32x16 p0, p1; float mn, al; bf16x8 pa0, pa1, pa2, pa3;
        qkt<DQK>(p0, p1, K_lds + buf * C_::SHM_K, qr, r32, hi);
        if (NA) na_bias(p0, p1, J, j, naR, nac, hi, biasq);
        partialSM(p0, p1, m_reg, mn, al, Cc, thr_raw);
        finishSM(p0, p1, al, l_reg, pa0, pa1, pa2, pa3);
        if (__any(al < 1.f)) { if (hi == 0) al_l[r32] = al; asm volatile("s_waitcnt lgkmcnt(0)" ::: "memory");
#pragma unroll
            for (int d = 0; d < 4; ++d)
#pragma unroll
                for (int r = 0; r < 16; ++r) o[d][r] *= al_l[crow(r, hi)]; }
        ATT_SBAR();
        pv_d0(o, vb0 + buf * C_::SHM_V, pa0, pa1, pa2, pa3);
        asm volatile("s_waitcnt vmcnt(0)" ::: "memory");
        __syncthreads();
    }
    if (hi == 0) li_l[r32] = l_reg; asm volatile("s_waitcnt lgkmcnt(0)" ::: "memory");
    float rli[16];
#pragma unroll
    for (int r = 0; r < 16; ++r) rli[r] = __builtin_amdgcn_rcpf(li_l[crow(r, hi)]);
    bf16_t* Ow = J.O + (long)(wid * QBLK) * LDO;
#pragma unroll
    for (int r = 0; r < 16; ++r) { const int orow = crow(r, hi);
#pragma unroll
        for (int d0 = 0; d0 < 4; ++d0) Ow[(long)orow * LDO + d0 * 32 + r32] = f2bf(o[d0][r] * rli[r]); }
#undef ATT_STAGE
}
}

struct AttnArgs { const bf16_t *QM, *KM, *VM, *NQ, *NK, *P; bf16_t* Y; const float* rpb; int want_ctx; int pad; };
__device__ __forceinline__ void attention_phase(const AttnArgs& A, char* lds, int G, int wg, const int tid) {
    static_assert(GRID_W == 64 && SEQ % 256 == 0 && CTX_LEN == 256 && HD == 128, "attention phase geometry");
    constexpr int NQB = SEQ / 256;
    constexpr float sc_mla = 0.07216878364870323f, sc_na = 0.08838834764831845f;
    static_assert(MLA_QK == 192 && HD == 128, "softmax scales");
    if (!(A.pad & 2)) for (int u = wg; u < BATCH * NH * NQB; u += G) {
        const int bh = u % (BATCH * NH), qb = u / (BATCH * NH), b = bh / NH, h = bh % NH;
        att::Job J{};
        J.Q = A.QM + (size_t)(b * SEQ + qb * 256) * NQ_MLA + h * MLA_QK; J.K = A.KM + h * MLA_QK; J.V = A.VM + h * MLA_V;
        J.O = A.Y + (size_t)(b * SEQ + qb * 256) * D_MODEL + GROUP_W + h * MLA_V;
        J.nt = SEQ / 64 + CTX_LEN / 64; J.seg0_tiles = SEQ / 64; J.row_seg0 = b * SEQ; J.row_seg1 = M_LAT + b * CTX_LEN;
        att::attn_unit<MLA_QK, false, NQ_MLA, NQ_MLA, NH * MLA_V, D_MODEL>(J, lds, sc_mla, tid);
    }
    if (!(A.pad & 4)) for (int u = wg; u < BATCH * NH * NQB; u += G) {
        const int bh = u % (BATCH * NH), qb = u / (BATCH * NH), b = bh / NH, h = bh % NH, R0 = qb * 4;
        __syncthreads();
        { float* bq = (float*)(lds + att::Cfg<HD>::OFF_BIAS); const float* src = A.rpb + (size_t)h * (2 * NA_KH - 1) * (2 * NA_KW - 1);
          for (int i = tid; i < (2 * NA_KH - 1) * att::NA_BROW; i += 512) { const int dr = i / att::NA_BROW; int dc = i % att::NA_BROW - att::NA_BORG + (NA_KW - 1); dc = dc < 0 ? 0 : (dc > 2 * NA_KW - 2 ? 2 * NA_KW - 2 : dc);
              bq[i] = src[dr * (2 * NA_KW - 1) + dc] * 11.313708498984761f; } }
        int rlo = R0 - NA_KH / 2; rlo = rlo < 0 ? 0 : (rlo > ROWS - NA_KH ? ROWS - NA_KH : rlo);
        int rhi = R0 + 3 - NA_KH / 2; rhi = (rhi < 0 ? 0 : (rhi > ROWS - NA_KH ? ROWS - NA_KH : rhi)) + NA_KH - 1;
        const int nloc = rhi - rlo + 1;
        att::Job J{};
        J.Q = A.NQ + (size_t)(b * SEQ + R0 * 64) * GROUP_W + h * HD; J.K = A.NK + h * HD; J.V = A.P + C_NV + h * HD;
        J.O = A.Y + (size_t)(b * SEQ + R0 * 64) * D_MODEL + 3 * GROUP_W + h * HD;
        J.nt = (nloc + 4 + 1) & ~1; J.seg0_tiles = nloc; J.row_seg0 = b * SEQ + rlo * 64; J.row_seg1 = M_LAT + b * CTX_LEN;  J.R0 = R0; J.rlo = rlo;
        att::attn_unit<HD, true, GROUP_W, GROUP_W, NP, D_MODEL>(J, lds, sc_na, tid);
    }
    if (A.want_ctx && !(A.pad & 8)) {
        for (int u = wg; u < BATCH * NH; u += G) {
            const int b = u / NH, h = u % NH; const int crow0 = M_LAT + b * CTX_LEN;
            att::Job J{}; J.nt = CTX_LEN / 64; J.seg0_tiles = 0; J.row_seg0 = crow0; J.row_seg1 = crow0;
            J.Q = A.QM + (size_t)crow0 * NQ_MLA + h * MLA_QK; J.K = A.KM + h * MLA_QK; J.V = A.VM + h * MLA_V;
            J.O = A.Y + (size_t)crow0 * D_MODEL + GROUP_W + h * MLA_V; att::attn_unit<MLA_QK, false, NQ_MLA, NQ_MLA, NH * MLA_V, D_MODEL>(J, lds, sc_mla, tid);
        }
        for (int u = wg - BATCH * NH; u >= 0 && u < BATCH * NH; u += G) {
            const int b = u / NH, h = u % NH; const int crow0 = M_LAT + b * CTX_LEN;
            att::Job J{}; J.nt = CTX_LEN / 64; J.seg0_tiles = 0; J.row_seg0 = crow0; J.row_seg1 = crow0;
            J.Q = A.NQ + (size_t)crow0 * GROUP_W + h * HD; J.K = A.NK + h * HD; J.V = A.P + C_NV + h * HD;
            J.O = A.Y + (size_t)crow0 * D_MODEL + 3 * GROUP_W + h * HD; att::attn_unit<HD, false, GROUP_W, GROUP_W, NP, D_MODEL>(J, lds, sc_na, tid);
        }
    }
}

namespace gdn {
typedef short bf16x8 __attribute__((ext_vector_type(8)));
typedef float f32x4 __attribute__((ext_vector_type(4)));
typedef float f32x16 __attribute__((ext_vector_type(16)));
typedef unsigned u32x2 __attribute__((ext_vector_type(2)));
typedef unsigned u32x4 __attribute__((ext_vector_type(4)));
constexpr int CH = 64, NCHUNK = M_ALL / CH;
constexpr int NTASK = NCHUNK * NH * 2;
constexpr size_t SZ_UT = 128 * 64, SZ_WP = 64 * 128, SZ_KDT = 128 * 64, SZ_QD = 64 * 128, SZ_QK = 64 * 64, SZ_SIT = 128 * 128, SZ_VNT = 128 * 64;
struct Bufs { bf16_t *UT, *WP, *KDT, *QD, *QK, *SIT, *VNT; float* GT; };
__device__ __forceinline__ int perm32(int o) { return (o & ~31) | (((o & 15) >> 2) * 8 + ((o >> 4) & 1) * 4 + (o & 3)); }
__device__ __forceinline__ unsigned pk2(float lo, float hi) { return (unsigned)f2bf(lo) | ((unsigned)f2bf(hi) << 16); }

constexpr int QS = 132;
constexpr int AS = 68;
constexpr int G1_OFF_Q = 0, G1_OFF_K = G1_OFF_Q + CH * QS * 4, G1_OFF_V = G1_OFF_K + CH * QS * 4, G1_OFF_AA = G1_OFF_V + CH * QS * 4, G1_OFF_SM = G1_OFF_AA + 2 * CH * AS * 4,
              G1_LDS = G1_OFF_SM + 12 * 64 * 4;
struct G1Args { const bf16_t* P; const float* conv_w; const float* a_log; const float* dt_bias; Bufs B; int pflags; };

__device__ __forceinline__ void g1_task(const G1Args& A, char* lds, int cix, int h, const int tid_in) {
    int tid_ = tid_in; asm volatile("" : "+v"(tid_));
    const int tid = tid_, wid = __builtin_amdgcn_readfirstlane(tid >> 6), lane = tid & 63;
    float* Qs = (float*)(lds + G1_OFF_Q); float* Ks = (float*)(lds + G1_OFF_K); float* Vs = (float*)(lds + G1_OFF_V); float* AA = (float*)(lds + G1_OFF_AA);
    float* sm = (float*)(lds + G1_OFF_SM); float* g_s = sm;   float* beta_s = sm + 128;   float* gc_s = sm + 256;
    const int row0 = cix * CH; const RowInfo r0i = row_info(row0);
    LDS_BARRIER();
    if (tid < 48 * 8) {
        const int grp = tid % 48, ts = tid / 48, which = grp >> 4, cc0 = (grp & 15) * 8, ch0 = which * GROUP_W + h * HD + cc0;
        float wgt[4][8];
#pragma unroll
        for (int j = 0; j < 4; ++j) { const f32x4 w0 = *(const f32x4*)(A.conv_w + j * 3 * GROUP_W + ch0), w1 = *(const f32x4*)(A.conv_w + j * 3 * GROUP_W + ch0 + 4);
#pragma unroll
            for (int e = 0; e < 4; ++e) { wgt[j][e] = w0[e]; wgt[j][4 + e] = w1[e]; } }
        u32x4 xr[11];
#pragma unroll
        for (int k = 0; k < 11; ++k) { const int tt = r0i.t + 8 * ts + k - 1;
            xr[k] = (tt >= 0 && tt < r0i.T && !(A.pflags & 4096)) ? *(const u32x4*)(A.P + (size_t)(r0i.base + tt) * NP + C_GQ + ch0) : (u32x4){0u, 0u, 0u, 0u}; }
        float* dstp = (which == 0 ? Qs : which == 1 ? Ks : Vs) + cc0;
#pragma unroll
        for (int i = 0; i < 8; ++i) { float acc[8];
#pragma unroll
            for (int e = 0; e < 8; ++e) acc[e] = 0.f;
#pragma unroll
            for (int j = 0; j < 4; ++j) { const u32x4 xv = xr[i + j];
#pragma unroll
                for (int e = 0; e < 4; ++e) { acc[2 * e] += wgt[j][2 * e] * bflo(xv[e]); acc[2 * e + 1] += wgt[j][2 * e + 1] * bfhi(xv[e]); } }
            f32x4 y0, y1;
#pragma unroll
            for (int e = 0; e < 4; ++e) { y0[e] = acc[e] / (1.0f + __expf(-acc[e])); y1[e] = acc[4 + e] / (1.0f + __expf(-acc[4 + e])); }
            *(f32x4*)(dstp + (8 * ts + i) * QS) = y0; *(f32x4*)(dstp + (8 * ts + i) * QS + 4) = y1; }
    }
    if (tid < 128) { const int d = tid >> 6, i = tid & 63; const size_t r = (size_t)(row0 + i) * NP;
        beta_s[d * 64 + i] = 1.0f / (1.0f + __expf(-bf2f(A.P[r + C_GB + d * NH + h])));
        g_s[d * 64 + i] = -__expf(A.a_log[d * NH + h]) * softplusf_(bf2f(A.P[r + C_GA + d * NH + h]) + A.dt_bias[d * NH + h]); }
    LDS_BARRIER();
    for (int rr = wid; rr < 2 * CH; rr += 8) { float* rowp = (rr < CH ? Qs : Ks) + (rr & 63) * QS;
        const float a = rowp[lane], b = rowp[lane + 64]; float ss = a * a + b * b;
#pragma unroll
        for (int o = 1; o < 64; o <<= 1) ss += lane_xor(ss, o, lane);
        const float scl = (1.0f / sqrtf(ss + EPS)) * (rr < CH ? 0.08838834764831845f : 1.0f);
        rowp[lane] = a * scl; rowp[lane + 64] = b * scl; }
    if (tid < 2) {
        f32x4 gv[16];
#pragma unroll
        for (int m = 0; m < 16; ++m) gv[m] = *(const f32x4*)(g_s + tid * 64 + 4 * m);
        float run = 0.f;
        if (tid == 0) {
#pragma unroll
            for (int m = 0; m < 16; ++m) { f32x4 o4;
#pragma unroll
                for (int e = 0; e < 4; ++e) { run += gv[m][e]; o4[e] = run; }
                *(f32x4*)(gc_s + 4 * m) = o4; }
        } else {
#pragma unroll
            for (int m = 15; m >= 0; --m) { f32x4 o4;
#pragma unroll
                for (int e = 3; e >= 0; --e) { run += gv[m][e]; o4[e] = run; }
                *(f32x4*)(gc_s + 64 + 4 * m) = o4; }
        }
    }
    LDS_BARRIER();
    float* eq_s = sm + 384; float* ek_s = sm + 512;
    if (tid < 128) { const int d = tid >> 6, i = tid & 63; const float gci = gc_s[d * 64 + i], glast = d == 0 ? gc_s[63] : gc_s[64];
        eq_s[tid] = __expf(gci); ek_s[tid] = __expf(glast - gci); }
    const int gwhich = wid >> 2, gI = (wid >> 1) & 1, gJ = wid & 1, r32 = lane & 31, hi = lane >> 5;
    f32x16 acc = {};
    if (!(A.pflags & 1024)) {
        const float* X = (gwhich ? Qs : Ks) + (32 * gI + r32) * QS + 4 * hi; const float* Yp = Ks + (32 * gJ + r32) * QS + 4 * hi;
#pragma unroll
        for (int s = 0; s < 16; ++s) { const f32x4 a4 = *(const f32x4*)(X + 8 * s), b4 = *(const f32x4*)(Yp + 8 * s);
#pragma unroll
            for (int e = 0; e < 4; ++e) acc = __builtin_amdgcn_mfma_f32_32x32x2f32(a4[e], b4[e], acc, 0, 0, 0); }
        const int j = 32 * gJ + r32;
        if (gwhich == 0) {
            const float b1j = beta_s[64 + j], g0j = gc_s[j], g1j = gc_s[64 + j];
#pragma unroll
            for (int r = 0; r < 16; ++r) { const int i = 32 * gI + (r & 3) + 8 * (r >> 2) + 4 * hi;
                if (i > j) { const float kk = acc[r];
                    AA[(63 - j) * AS + (63 - i)] = beta_s[i] * kk * __expf(gc_s[i] - g0j);
                    AA[CH * AS + i * AS + j] = b1j * kk * __expf(g1j - gc_s[64 + i]); } }
        }
    }
    LDS_BARRIER();
    const size_t t0 = ((size_t)cix * NH + h) * 2;
    if (!(A.pflags & 2048)) {
#pragma unroll
        for (int n = 0; n < 4; ++n) { const int it = tid + 512 * n, d = it >> 10, p = (it >> 4) & 63, m = it & 15, i = d == 0 ? p : 63 - p, k0 = 32 * (m >> 2) + 4 * (m & 3);
            const float e = eq_s[d * 64 + i]; const f32x4 lo = *(const f32x4*)(Qs + i * QS + k0), hi4 = *(const f32x4*)(Qs + i * QS + k0 + 16);
            *(u32x4*)(A.B.QD + (t0 + d) * SZ_QD + (size_t)p * 128 + m * 8) = (u32x4){pk2(lo[0] * e, lo[1] * e), pk2(lo[2] * e, lo[3] * e), pk2(hi4[0] * e, hi4[1] * e), pk2(hi4[2] * e, hi4[3] * e)}; }
#pragma unroll
        for (int n = 0; n < 4; ++n) { const int it = tid + 512 * n, k = it & 127, d = (it >> 7) & 1, m = it >> 8, p0 = 32 * (m >> 2) + 4 * (m & 3);
            float v[8];
#pragma unroll
            for (int jj = 0; jj < 8; ++jj) { const int p = p0 + (jj < 4 ? jj : 12 + jj), i = d == 0 ? p : 63 - p; v[jj] = Ks[i * QS + k] * ek_s[d * 64 + i]; }
            *(u32x4*)(A.B.KDT + (t0 + d) * SZ_KDT + (size_t)k * 64 + m * 8) = (u32x4){pk2(v[0], v[1]), pk2(v[2], v[3]), pk2(v[4], v[5]), pk2(v[6], v[7])}; }
        if (tid == 0) { A.B.GT[t0] = __expf(gc_s[63]); A.B.GT[t0 + 1] = __expf(gc_s[64]); }
    }
    LDS_BARRIER();
    bf16_t* stg = (bf16_t*)Qs;
    if (gwhich == 1) { const int j = 32 * gJ + r32; const float g0j = gc_s[j], g1j = gc_s[64 + j];
#pragma unroll
        for (int r = 0; r < 16; ++r) { const int i = 32 * gI + (r & 3) + 8 * (r >> 2) + 4 * hi; const float qk = acc[r];
            stg[i * 64 + perm32(j)] = f2bf(i >= j ? qk * __expf(gc_s[i] - g0j) : 0.f);
            stg[4096 + (63 - i) * 64 + perm32(63 - j)] = f2bf(i <= j ? qk * __expf(gc_s[64 + i] - g1j) : 0.f); } }
    LDS_BARRIER();
#pragma unroll
    for (int n = 0; n < 2; ++n) { const int c16 = tid + 512 * n; *(u32x4*)(A.B.QK + t0 * SZ_QK + (size_t)c16 * 8) = *(const u32x4*)(stg + c16 * 8); }
    if (!(A.pflags & 512)) {
        int tidv = tid; asm volatile("" : "+v"(tidv));
        const int d = tidv >> 8, c = tidv & 255; const bool isw = c >= 128; const int cc = c & 127;
        const float* src = isw ? Ks : Vs;
        int lz; asm volatile("v_mov_b32 %0, 0" : "=v"(lz));
        const float* AAv = AA + lz + d * (CH * AS);
        float x[CH];
#pragma unroll
        for (int p = 0; p < CH; ++p) { const int i = d == 0 ? p : 63 - p; float f = beta_s[d * 64 + i]; if (isw) f *= eq_s[d * 64 + i]; x[p] = f * src[i * QS + cc]; }
        {
#pragma unroll
            for (int p = 0; p < CH - 1; ++p) { const float xp = x[p]; const float* rowp = AAv + (63 - p) * AS;
#pragma unroll
                for (int m = 0; m <= (62 - p) / 4; ++m) { const f32x4 a4 = *(const f32x4*)(rowp + 4 * m);
#pragma unroll
                    for (int e = 0; e < 4; ++e) { const int col = 4 * m + e; if (col <= 62 - p) x[63 - col] -= a4[e] * xp; } } }
        }
        LDS_BARRIER();
        if (!isw) { bf16_t* dst = A.B.UT + (t0 + d) * SZ_UT + (size_t)((cc >> 4) * 2 * 64 + (cc & 15)) * 8;
#pragma unroll
            for (int s = 0; s < 2; ++s)
#pragma unroll
                for (int qq = 0; qq < 4; ++qq) { const int p0 = 32 * s + 4 * qq; u32x4 w4; w4.x = pk2(x[p0], x[p0 + 1]); w4.y = pk2(x[p0 + 2], x[p0 + 3]); w4.z = pk2(x[p0 + 16], x[p0 + 17]); w4.w = pk2(x[p0 + 18], x[p0 + 19]);
                    *(u32x4*)(dst + (size_t)(s * 64 + qq * 16) * 8) = w4; }
        } else { bf16_t* dst = stg + d * 8192 + perm32(cc);
#pragma unroll
            for (int p = 0; p < CH; ++p) dst[p * 128] = f2bf(x[p]); }
    }
    LDS_BARRIER();
#pragma unroll
    for (int n = 0; n < 4; ++n) { const int c16 = tid + 512 * n; *(u32x4*)(A.B.WP + t0 * SZ_WP + (size_t)c16 * 8) = *(const u32x4*)(stg + c16 * 8); }
}
__device__ __forceinline__ void g1_phase(const G1Args& A, char* lds, int G, int wg, const int tid) {
    for (int t = wg; t < NCHUNK * NH; t += G) g1_task(A, lds, t / NH, t % NH, tid);
}

constexpr int G2_SPLIT = 4, G2_NACT = 8 / G2_SPLIT;
constexpr int G2_USL = G2_NACT * 2 * 64 * 16;
constexpr int G2_BUF = 16384 + 16384 + G2_USL, G2_NB = 4, G2_LDS = G2_NB * G2_BUF;
static_assert(G2_SPLIT == 4 && G2_USL == 4096, "G2 staging map below assumes 4 KB of u per step");
__device__ __forceinline__ int g2_task_index(int b, int h, int d, int step) {
    constexpr int NC = CTX_LEN / CH, NL = SEQ / CH; int cix;
    if (step < NC) { const int n = d ? NC - 1 - step : step; cix = M_LAT / CH + b * NC + n; }
    else { const int s2 = step - NC, n = d ? NL - 1 - s2 : s2; cix = b * NL + n; }
    return (cix * NH + h) * 2 + d;
}
__device__ __forceinline__ void g2_chain(const Bufs& B, char* lds, int chain_part, const int tid_in) {
    int tid_ = tid_in; asm volatile("" : "+v"(tid_));
    const int tid = tid_, wid = __builtin_amdgcn_readfirstlane(tid >> 6), lane = tid & 63, q = lane >> 4, vl = lane & 15;
    const int chain = chain_part / G2_SPLIT, part = chain_part % G2_SPLIT;
    const bool active = wid < G2_NACT; const int vt = part * G2_NACT + (active ? wid : 0);
    const int d = chain & 1, h = (chain >> 1) % NH, b = chain / (2 * NH);
    constexpr int NSTEP = CTX_LEN / CH + SEQ / CH;
    const unsigned ldsb = (unsigned)(uintptr_t)lds;
    f32x4 S[8];
#pragma unroll
    for (int kb = 0; kb < 8; ++kb) S[kb] = (f32x4){0.f, 0.f, 0.f, 0.f};
    unsigned offw[2], offk[2], offu;
#pragma unroll
    for (int i = 0; i < 2; ++i) { const int sl = 128 * wid + 64 * i + lane;
        { const int row = sl >> 4, pc = sl & 15, c = pc ^ (row & 15); offw[i] = (unsigned)(row * 256 + c * 16); }
        { const int row = sl >> 3, pc = sl & 7, c = pc ^ ((row >> 1) & 7); offk[i] = (unsigned)(row * 128 + c * 16); } }
    offu = (unsigned)((part * G2_NACT * 2 * 64 + (wid & 3) * 64 + lane) * 16);
#define G2_DMA(ti, slot) do { const char* wp_ = (const char*)(B.WP + (size_t)(ti) * SZ_WP); const char* kp_ = (const char*)(B.KDT + (size_t)(ti) * SZ_KDT); const unsigned base_ = ldsb + (unsigned)(slot) * G2_BUF; \
        _Pragma("unroll") for (int i_ = 0; i_ < 2; ++i_) { \
            __builtin_amdgcn_global_load_lds((const unsigned*)(wp_ + offw[i_]), (ATT_LAS unsigned*)(base_ + (128 * wid + 64 * i_) * 16), 16, 0, 0); \
            __builtin_amdgcn_global_load_lds((const unsigned*)(kp_ + offk[i_]), (ATT_LAS unsigned*)(base_ + 16384 + (128 * wid + 64 * i_) * 16), 16, 0, 0); } \
        if (wid >= 4) __builtin_amdgcn_global_load_lds((const unsigned*)((const char*)(B.UT + (size_t)(ti) * SZ_UT) + offu), (ATT_LAS unsigned*)(base_ + 32768 + ((wid & 3) * 64) * 16), 16, 0, 0); } while (0)
#define G2_TI(step) g2_task_index(b, h, d, (step) < NSTEP ? (step) : NSTEP - 1)
    __syncthreads();
    G2_DMA(G2_TI(0), 0); G2_DMA(G2_TI(1), 1); G2_DMA(G2_TI(2), 2);
    asm volatile("s_waitcnt vmcnt(0)" ::: "memory");
    __syncthreads();
    for (int step = 0; step < NSTEP; ++step) {
        const int ti = G2_TI(step), slot = step & 3;
        G2_DMA(G2_TI(step + 3), (step + 3) & 3);
        unsigned gtb; { const float* gp = B.GT + ti; asm volatile("s_load_dword %0, %1, 0x0" : "=s"(gtb) : "s"(gp)); }
        const char* wl = lds + slot * G2_BUF; const char* kl = wl + 16384; const char* ul = kl + 16384;
        if (active) {
            bf16x8 aw[16], ak[16];
#pragma unroll
            for (int rb = 0; rb < 4; ++rb)
#pragma unroll
                for (int s = 0; s < 4; ++s) aw[rb * 4 + s] = *(const bf16x8*)(wl + (16 * rb + vl) * 256 + (((4 * s + q) ^ vl) << 4));
#pragma unroll
            for (int kb = 0; kb < 8; ++kb)
#pragma unroll
                for (int s = 0; s < 2; ++s) ak[kb * 2 + s] = *(const bf16x8*)(kl + (16 * kb + vl) * 128 + (((4 * s + q) ^ ((vl >> 1) & 7)) << 4));
            u32x4 uu[2];
#pragma unroll
            for (int s = 0; s < 2; ++s) uu[s] = *(const u32x4*)(ul + ((wid * 2 + s) * 64 + lane) * 16);
            bf16_t* sit = B.SIT + (size_t)ti * SZ_SIT + (size_t)(vt * 4 * 64 + lane) * 8;
            bf16x8 sf[4];
#pragma unroll
            for (int s = 0; s < 4; ++s) { u32x4 w4; w4.x = pk2(S[2 * s][0], S[2 * s][1]); w4.y = pk2(S[2 * s][2], S[2 * s][3]); w4.z = pk2(S[2 * s + 1][0], S[2 * s + 1][1]); w4.w = pk2(S[2 * s + 1][2], S[2 * s + 1][3]);
                sf[s] = __builtin_bit_cast(bf16x8, w4); *(u32x4*)(sit + (size_t)s * 64 * 8) = w4; }
            __builtin_amdgcn_sched_barrier(0);
            f32x4 vn[4];
#pragma unroll
            for (int rb = 0; rb < 4; ++rb) vn[rb] = (f32x4){0.f, 0.f, 0.f, 0.f};
#pragma unroll
            for (int s = 0; s < 4; ++s)
#pragma unroll
                for (int rb = 0; rb < 4; ++rb) vn[rb] = __builtin_amdgcn_mfma_f32_16x16x32_bf16(aw[rb * 4 + s], sf[s], vn[rb], 0, 0, 0);
#pragma unroll
            for (int s = 0; s < 2; ++s) { const f32x4 a0 = vn[2 * s], a1 = vn[2 * s + 1];
                vn[2 * s][0] = bflo(uu[s].x) - a0[0]; vn[2 * s][1] = bfhi(uu[s].x) - a0[1]; vn[2 * s][2] = bflo(uu[s].y) - a0[2]; vn[2 * s][3] = bfhi(uu[s].y) - a0[3];
                vn[2 * s + 1][0] = bflo(uu[s].z) - a1[0]; vn[2 * s + 1][1] = bfhi(uu[s].z) - a1[1]; vn[2 * s + 1][2] = bflo(uu[s].w) - a1[2]; vn[2 * s + 1][3] = bfhi(uu[s].w) - a1[3]; }
            bf16_t* vnt = B.VNT + (size_t)ti * SZ_VNT + (size_t)(vt * 2 * 64 + lane) * 8;
            bf16x8 vf[2];
#pragma unroll
            for (int s = 0; s < 2; ++s) { u32x4 w4; w4.x = pk2(vn[2 * s][0], vn[2 * s][1]); w4.y = pk2(vn[2 * s][2], vn[2 * s][3]); w4.z = pk2(vn[2 * s + 1][0], vn[2 * s + 1][1]); w4.w = pk2(vn[2 * s + 1][2], vn[2 * s + 1][3]);
                vf[s] = __builtin_bit_cast(bf16x8, w4); *(u32x4*)(vnt + (size_t)s * 64 * 8) = w4; }
            asm volatile("s_waitcnt lgkmcnt(0)" ::: "memory");
            const float gt = __uint_as_float(gtb);
#pragma unroll
            for (int kb = 0; kb < 8; ++kb) S[kb] = S[kb] * gt;
#pragma unroll
            for (int s = 0; s < 2; ++s)
#pragma unroll
                for (int kb = 0; kb < 8; ++kb) S[kb] = __builtin_amdgcn_mfma_f32_16x16x32_bf16(ak[kb * 2 + s], vf[s], S[kb], 0, 0, 0);
            __builtin_amdgcn_sched_barrier(0);
            asm volatile("s_waitcnt vmcnt(26) lgkmcnt(0)\n\ts_barrier" ::: "memory");
        } else if (wid >= 4) {
            asm volatile("s_waitcnt vmcnt(10) lgkmcnt(0)\n\ts_barrier" ::: "memory");
        } else {
            asm volatile("s_waitcnt vmcnt(8) lgkmcnt(0)\n\ts_barrier" ::: "memory");
        }
    }
    asm volatile("s_waitcnt vmcnt(0)" ::: "memory");
    __syncthreads();
#undef G2_DMA
#undef G2_TI
}

constexpr int G3_LDS = 8 * 64 * 4 * 2;
struct G3Args { Bufs B; const bf16_t* P; const float* norm_g; bf16_t* Y; };
__device__ __forceinline__ void g3_task(const G3Args& A, char* lds, int cix, int h, const int tid_in) {
    int tid_ = tid_in; asm volatile("" : "+v"(tid_));
    const int tid = tid_, wid = __builtin_amdgcn_readfirstlane(tid >> 6), lane = tid & 63, q = lane >> 4, vl = lane & 15;
    float* part = (float*)lds;
    f32x4 o[2][4];
#pragma unroll
    for (int d = 0; d < 2; ++d) {
        const size_t t = ((size_t)cix * NH + h) * 2 + d;
        const bf16_t* sit = A.B.SIT + t * SZ_SIT + (size_t)(wid * 4 * 64 + lane) * 8;
        const bf16_t* vnt = A.B.VNT + t * SZ_VNT + (size_t)(wid * 2 * 64 + lane) * 8;
        const bf16_t* qd = A.B.QD + t * SZ_QD + (size_t)vl * 128 + 8 * q;
        const bf16_t* qk = A.B.QK + t * SZ_QK + (size_t)vl * 64 + 8 * q;
        bf16x8 sf[4], vf[2];
#pragma unroll
        for (int s = 0; s < 4; ++s) sf[s] = *(const bf16x8*)(sit + (size_t)s * 64 * 8);
#pragma unroll
        for (int s = 0; s < 2; ++s) vf[s] = *(const bf16x8*)(vnt + (size_t)s * 64 * 8);
#pragma unroll
        for (int rb = 0; rb < 4; ++rb) { f32x4 acc = {0.f, 0.f, 0.f, 0.f};
#pragma unroll
            for (int s = 0; s < 4; ++s) acc = __builtin_amdgcn_mfma_f32_16x16x32_bf16(*(const bf16x8*)(qd + (size_t)rb * 16 * 128 + 32 * s), sf[s], acc, 0, 0, 0);
#pragma unroll
            for (int s = 0; s < 2; ++s) acc = __builtin_amdgcn_mfma_f32_16x16x32_bf16(*(const bf16x8*)(qk + (size_t)rb * 16 * 64 + 32 * s), vf[s], acc, 0, 0, 0);
            o[d][rb] = acc; }
    }
    f32x4 ot[4];
#pragma unroll
    for (int rb = 0; rb < 4; ++rb)
#pragma unroll
        for (int r = 0; r < 4; ++r) ot[rb][r] = o[0][rb][r] + lane_xor(o[1][3 - rb][3 - r], 48, lane);
    LDS_BARRIER();
#pragma unroll
    for (int rb = 0; rb < 4; ++rb)
#pragma unroll
        for (int r = 0; r < 4; ++r) { float ss = ot[rb][r] * ot[rb][r];
#pragma unroll
            for (int of = 1; of < 16; of <<= 1) ss += lane_xor(ss, of, lane);
            if (vl == 0) part[wid * 64 + 16 * rb + 4 * q + r] = ss; }
    LDS_BARRIER();
    const int v = 16 * wid + vl; const float ng = A.norm_g[v];
#pragma unroll
    for (int rb = 0; rb < 4; ++rb)
#pragma unroll
        for (int r = 0; r < 4; ++r) { const int tok = 16 * rb + 4 * q + r; float ss = 0.f;
#pragma unroll
            for (int w8 = 0; w8 < 8; ++w8) ss += part[w8 * 64 + tok];
            const float rstd = 1.0f / sqrtf(ss * (1.0f / HD) + EPS);
            const size_t row = (size_t)cix * CH + tok; const float gate = bf2f(A.P[row * NP + C_GG + h * HD + v]);
            A.Y[row * D_MODEL + 2 * GROUP_W + h * HD + v] = f2bf(ot[rb][r] * rstd * ng * (gate / (1.0f + __expf(-gate)))); }
}
__device__ __forceinline__ void g3_phase(const G3Args& A, char* lds, int G, int wg, const int tid) {
    for (int t = wg; t < NCHUNK * NH; t += G) g3_task(A, lds, t / NH, t % NH, tid);
}
}

namespace lru {
typedef short bf16x8 __attribute__((ext_vector_type(8)));
typedef float f32x4 __attribute__((ext_vector_type(4)));
typedef unsigned u32x2 __attribute__((ext_vector_type(2)));
typedef unsigned u32x4 __attribute__((ext_vector_type(4)));
constexpr int CH = 64, NCHUNK = M_ALL / CH;
constexpr int US = 129;
constexpr int UBS = 272;
constexpr int L_OFF_U = 0, L_OFF_UB = CH * US * 4, L_LDS = L_OFF_UB + CH * UBS;
constexpr size_t SZ_WBLK = (size_t)LRU_BW * LRU_BW;
struct Bufs { bf16_t* HLOC; bf16_t* ACUM; float* LSUM; float* HIN; };
struct LocalArgs { const bf16_t* P; const float* conv_w; const float* conv_b; const bf16_t* WG;   const float* ba; const float* bx; const float* lam; Bufs B; };

__device__ __forceinline__ unsigned pk2(float lo, float hi) { return (unsigned)f2bf(lo) | ((unsigned)f2bf(hi) << 16); }

__device__ __forceinline__ void local_task(const LocalArgs& A, char* lds, int cix, int nb, const int tid_in) {
    int tid_ = tid_in; asm volatile("" : "+v"(tid_));
    const int tid = tid_, wid = __builtin_amdgcn_readfirstlane(tid >> 6), lane = tid & 63, q = lane >> 4, tl = lane & 15;
    float* Us = (float*)(lds + L_OFF_U); char* Ub = lds + L_OFF_UB;
    const int row0 = cix * CH; const RowInfo r0i = row_info(row0);
    LDS_BARRIER();
    {
        const int grp = tid & 15, t2 = tid >> 4, c0 = grp * 8, ch0 = nb * LRU_BW + c0;
        float wgt[4][8], bia[8];
#pragma unroll
        for (int j = 0; j < 4; ++j) { const f32x4 w0 = *(const f32x4*)(A.conv_w + j * LRU_W + ch0), w1 = *(const f32x4*)(A.conv_w + j * LRU_W + ch0 + 4);
#pragma unroll
            for (int e = 0; e < 4; ++e) { wgt[j][e] = w0[e]; wgt[j][4 + e] = w1[e]; } }
        { const f32x4 b0 = *(const f32x4*)(A.conv_b + ch0), b1 = *(const f32x4*)(A.conv_b + ch0 + 4);
#pragma unroll
          for (int e = 0; e < 4; ++e) { bia[e] = b0[e]; bia[4 + e] = b1[e]; } }
        u32x4 xr[5];
#pragma unroll
        for (int k = 0; k < 5; ++k) { const int tt = r0i.t + 2 * t2 + k - 1;
            xr[k] = (tt >= 0 && tt < r0i.T) ? *(const u32x4*)(A.P + (size_t)(r0i.base + tt) * NP + C_LRU_X + ch0) : (u32x4){0u, 0u, 0u, 0u}; }
#pragma unroll
        for (int i = 0; i < 2; ++i) { float acc[8];
#pragma unroll
            for (int e = 0; e < 8; ++e) acc[e] = bia[e];
#pragma unroll
            for (int j = 0; j < 4; ++j) { const u32x4 xv = xr[i + j];
#pragma unroll
                for (int e = 0; e < 4; ++e) { acc[2 * e] += wgt[j][2 * e] * bflo(xv[e]); acc[2 * e + 1] += wgt[j][2 * e + 1] * bfhi(xv[e]); } }
            const int tok = 2 * t2 + i;
#pragma unroll
            for (int e = 0; e < 8; ++e) Us[tok * US + c0 + e] = acc[e];
            *(u32x4*)(Ub + tok * UBS + c0 * 2) = (u32x4){pk2(acc[0], acc[1]), pk2(acc[2], acc[3]), pk2(acc[4], acc[5]), pk2(acc[6], acc[7])}; }
    }
    LDS_BARRIER();
    f32x4 acc[2][2][4];
#pragma unroll
    for (int d = 0; d < 2; ++d)
#pragma unroll
        for (int wh = 0; wh < 2; ++wh)
#pragma unroll
            for (int tb = 0; tb < 4; ++tb) acc[d][wh][tb] = (f32x4){0.f, 0.f, 0.f, 0.f};
#pragma unroll
    for (int s = 0; s < 4; ++s) {
        bf16x8 bfr[4];
#pragma unroll
        for (int tb = 0; tb < 4; ++tb) bfr[tb] = *(const bf16x8*)(Ub + (16 * tb + tl) * UBS + (32 * s + 8 * q) * 2);
#pragma unroll
        for (int d = 0; d < 2; ++d)
#pragma unroll
            for (int wh = 0; wh < 2; ++wh) { const bf16x8 a = *(const bf16x8*)(A.WG + ((size_t)((d * 2 + wh) * NH + nb)) * SZ_WBLK + (size_t)(16 * wid + tl) * LRU_BW + 32 * s + 8 * q);
#pragma unroll
                for (int tb = 0; tb < 4; ++tb) acc[d][wh][tb] = __builtin_amdgcn_mfma_f32_16x16x32_bf16(a, bfr[tb], acc[d][wh][tb], 0, 0, 0); }
    }
    const int chb = nb * LRU_BW + 16 * wid + 4 * q;
#pragma unroll
    for (int d = 0; d < 2; ++d) {
        float sp[4], bav[4], bxv[4];
#pragma unroll
        for (int r = 0; r < 4; ++r) { sp[r] = -LRU_C * softplusf_(-A.lam[d * LRU_W + chb + r]); bav[r] = A.ba[d * LRU_W + chb + r]; bxv[r] = A.bx[d * LRU_W + chb + r]; }
        float Ac[4], Bc[4];
#pragma unroll
        for (int r = 0; r < 4; ++r) { Ac[r] = 1.f; Bc[r] = 0.f; }
#pragma unroll
        for (int tbi = 0; tbi < 4; ++tbi) { const int tb = d == 0 ? tbi : 3 - tbi; const int tok = 16 * tb + tl;
            float a[4], b[4];
#pragma unroll
            for (int r = 0; r < 4; ++r) { const float rr = 1.0f / (1.0f + __expf(-(acc[d][0][tb][r] + bav[r]))), ii = 1.0f / (1.0f + __expf(-(acc[d][1][tb][r] + bxv[r])));
                const float log_a = sp[r] * rr; a[r] = __expf(log_a); b[r] = sqrtf(-expm1f(2.0f * log_a)) * ii * Us[tok * US + 16 * wid + 4 * q + r]; }
#pragma unroll
            for (int off = 1; off < 16; off <<= 1) {
#pragma unroll
                for (int r = 0; r < 4; ++r) { const int src = d == 0 ? tl - off : tl + off; const bool ok = d == 0 ? (tl >= off) : (tl + off < 16);
                    const int sl = (lane & ~15) | (src & 15); const float ap = lane_get(a[r], sl), bp = lane_get(b[r], sl);
                    if (ok) { b[r] = a[r] * bp + b[r]; a[r] = a[r] * ap; } } }
#pragma unroll
            for (int r = 0; r < 4; ++r) { b[r] = a[r] * Bc[r] + b[r]; a[r] = a[r] * Ac[r]; }
            { const size_t o = ((size_t)d * M_ALL + row0 + tok) * LRU_W + chb;
              *(u32x2*)(A.B.HLOC + o) = (u32x2){pk2(b[0], b[1]), pk2(b[2], b[3])}; *(u32x2*)(A.B.ACUM + o) = (u32x2){pk2(a[0], a[1]), pk2(a[2], a[3])}; }
#pragma unroll
            for (int r = 0; r < 4; ++r) { const int sl = (lane & ~15) | (d == 0 ? 15 : 0); Ac[r] = lane_get(a[r], sl); Bc[r] = lane_get(b[r], sl); }
        }
        if (tl == 0) { float* ls = A.B.LSUM + (((size_t)cix * 2 + d) * 2) * LRU_W + chb;
            *(f32x4*)ls = (f32x4){Ac[0], Ac[1], Ac[2], Ac[3]}; *(f32x4*)(ls + LRU_W) = (f32x4){Bc[0], Bc[1], Bc[2], Bc[3]}; }
    }
}
__device__ __forceinline__ void local_phase(const LocalArgs& A, char* lds, int G, int wg, const int tid) {
    for (int t = wg; t < NCHUNK * NH; t += G) local_task(A, lds, t / NH, t % NH, tid);
}
__device__ __forceinline__ void carry_phase(const Bufs& B, int gtid, int gthreads) {
    constexpr int NC = CTX_LEN / CH, NL = SEQ / CH;
    for (int i = gtid; i < BATCH * 2 * LRU_W; i += gthreads) { const int ch = i % LRU_W, d = (i / LRU_W) & 1, b = i / (2 * LRU_W);
        float h = 0.f;
        for (int s0 = 0; s0 < NC + NL; s0 += 12) {
            float av[12], bv[12]; int cx[12];
#pragma unroll
            for (int u = 0; u < 12; ++u) { const int step = s0 + u; int cix = 0;
                if (step < NC) { const int n = d ? NC - 1 - step : step; cix = M_LAT / CH + b * NC + n; }
                else if (step < NC + NL) { const int s2 = step - NC, n = d ? NL - 1 - s2 : s2; cix = b * NL + n; }
                cx[u] = cix; const float* ls = B.LSUM + (((size_t)cix * 2 + d) * 2) * LRU_W + ch; av[u] = ls[0]; bv[u] = ls[LRU_W]; }
#pragma unroll
            for (int u = 0; u < 12; ++u) if (s0 + u < NC + NL) { B.HIN[((size_t)cx[u] * 2 + d) * LRU_W + ch] = h; h = av[u] * h + bv[u]; }
        }
    }
}
__device__ __forceinline__ void finish_phase(const Bufs& B, const bf16_t* P, bf16_t* Y, int gtid, int gthreads) {
    for (int it = gtid; it < M_ALL * (LRU_W / 8); it += gthreads) { const int row = it / (LRU_W / 8), c0 = (it % (LRU_W / 8)) * 8, cix = row / CH;
        const u32x4 h0 = *(const u32x4*)(B.HLOC + (size_t)row * LRU_W + c0), a0 = *(const u32x4*)(B.ACUM + (size_t)row * LRU_W + c0);
        const u32x4 h1 = *(const u32x4*)(B.HLOC + ((size_t)M_ALL + row) * LRU_W + c0), a1 = *(const u32x4*)(B.ACUM + ((size_t)M_ALL + row) * LRU_W + c0);
        const u32x4 gt = *(const u32x4*)(P + (size_t)row * NP + C_LRU_G + c0);
        const float* i0 = B.HIN + ((size_t)cix * 2 + 0) * LRU_W + c0; const float* i1 = B.HIN + ((size_t)cix * 2 + 1) * LRU_W + c0;
        const f32x4 i0a = *(const f32x4*)i0, i0b = *(const f32x4*)(i0 + 4), i1a = *(const f32x4*)i1, i1b = *(const f32x4*)(i1 + 4);
        float y[8];
#pragma unroll
        for (int j = 0; j < 4; ++j) { const unsigned hw0 = h0[j], aw0 = a0[j], hw1 = h1[j], aw1 = a1[j], gw = gt[j];
            const float in0l = j < 2 ? i0a[2 * j] : i0b[2 * j - 4], in0h = j < 2 ? i0a[2 * j + 1] : i0b[2 * j - 3], in1l = j < 2 ? i1a[2 * j] : i1b[2 * j - 4], in1h = j < 2 ? i1a[2 * j + 1] : i1b[2 * j - 3];
            y[2 * j] = (bflo(hw0) + bflo(aw0) * in0l + bflo(hw1) + bflo(aw1) * in1l) * geluf_(bflo(gw));
            y[2 * j + 1] = (bfhi(hw0) + bfhi(aw0) * in0h + bfhi(hw1) + bfhi(aw1) * in1h) * geluf_(bfhi(gw)); }
        *(u32x4*)(Y + (size_t)row * D_MODEL + c0) = (u32x4){pk2(y[0], y[1]), pk2(y[2], y[3]), pk2(y[4], y[5]), pk2(y[6], y[7])};
    }
}
}

namespace misc {
typedef float f32x4 __attribute__((ext_vector_type(4)));
typedef unsigned u32x2 __attribute__((ext_vector_type(2)));
typedef unsigned u32x4 __attribute__((ext_vector_type(4)));
__device__ __forceinline__ unsigned pk2(float lo, float hi) { return (unsigned)f2bf(lo) | ((unsigned)f2bf(hi) << 16); }
__device__ __forceinline__ float wave_sum(float v, int lane) {
#pragma unroll
    for (int o = 1; o < 64; o <<= 1) v += lane_xor(v, o, lane);
    return v;
}
__device__ __forceinline__ float sum16(float v, int lane) {
#pragma unroll
    for (int o = 1; o < 16; o <<= 1) v += lane_xor(v, o, lane);
    return v;
}
__device__ __forceinline__ void norm_phase(float* H, const float* g, const float* MODl, int sh_idx, bf16_t* U, int nrows, int gwave, int nwaves, int lane,
                                           const float* PART, int nparts, const float* pgate) {
    static_assert(D_MODEL == 2048, "norm_phase geometry");
    for (int r = gwave; r < nrows; r += nwaves) {
        const int set = r < M_LAT ? r / SEQ : BATCH;
        f32x4* hr = (f32x4*)(H + (size_t)r * D_MODEL) + lane;
        f32x4 v[8]; float ss = 0.f;
#pragma unroll
        for (int j = 0; j < 8; ++j) v[j] = hr[64 * j];
        if (PART != nullptr && r >= M_LAT) {
            const f32x4* gp = (const f32x4*)pgate + lane;
#pragma unroll
            for (int j = 0; j < 8; ++j) { f32x4 acc = {0.f, 0.f, 0.f, 0.f};
                for (int s = 0; s < nparts; ++s) acc += *((const f32x4*)(PART + ((size_t)s * M_CTX + (r - M_LAT)) * D_MODEL) + lane + 64 * j);
                v[j] += gp[64 * j] * acc; hr[64 * j] = v[j]; }
        }
#pragma unroll
        for (int j = 0; j < 8; ++j) ss += (v[j][0] * v[j][0] + v[j][1] * v[j][1]) + (v[j][2] * v[j][2] + v[j][3] * v[j][3]);
        const float rstd = 1.0f / sqrtf(wave_sum(ss, lane) * (1.0f / D_MODEL) + EPS);
        const f32x4* gp = (const f32x4*)g + lane; const f32x4* shp = (const f32x4*)(MODl + (size_t)set * NMODV + (size_t)sh_idx * D_MODEL) + lane; const f32x4* scp = shp + D_MODEL / 4;
        u32x2* o = (u32x2*)(U + (size_t)r * D_MODEL) + lane;
#pragma unroll
        for (int j = 0; j < 8; ++j) { const f32x4 gg = gp[64 * j], sh = shp[64 * j], sc = scp[64 * j]; f32x4 y;
#pragma unroll
            for (int e = 0; e < 4; ++e) y[e] = v[j][e] * rstd * gg[e] * (1.0f + sc[e]) + sh[e];
            o[64 * j] = (u32x2){pk2(y[0], y[1]), pk2(y[2], y[3])}; }
    }
}
struct RowNormArgs { const bf16_t* P; const float *qa_g, *kva_g, *na_qn_g, *na_kn_g; bf16_t *CQN, *CKVN, *NQ, *NK; };
__device__ __forceinline__ void rownorm_phase(const RowNormArgs& A, int gwave, int nwaves, int lane) {
    static_assert(MLA_Q_LORA == 384 && MLA_KV_LORA == 256 && GROUP_W == 512 && HD == 128, "rownorm geometry");
    for (int r = gwave; r < M_ALL; r += nwaves) { const bf16_t* p = A.P + (size_t)r * NP;
        { float x[6], ss = 0.f;
#pragma unroll
          for (int j = 0; j < 3; ++j) { const unsigned w = *(const unsigned*)(p + C_CQ + 2 * lane + 128 * j); x[2 * j] = bflo(w); x[2 * j + 1] = bfhi(w); ss += x[2 * j] * x[2 * j] + x[2 * j + 1] * x[2 * j + 1]; }
          const float rstd = 1.0f / sqrtf(wave_sum(ss, lane) * (1.0f / MLA_Q_LORA) + EPS);
#pragma unroll
          for (int j = 0; j < 3; ++j) { const int c = 2 * lane + 128 * j; *(unsigned*)(A.CQN + (size_t)r * MLA_Q_LORA + c) = pk2(x[2 * j] * rstd * A.qa_g[c], x[2 * j + 1] * rstd * A.qa_g[c + 1]); } }
        { float x[4], ss = 0.f;
#pragma unroll
          for (int j = 0; j < 2; ++j) { const unsigned w = *(const unsigned*)(p + C_CKV + 2 * lane + 128 * j); x[2 * j] = bflo(w); x[2 * j + 1] = bfhi(w); ss += x[2 * j] * x[2 * j] + x[2 * j + 1] * x[2 * j + 1]; }
          const float rstd = 1.0f / sqrtf(wave_sum(ss, lane) * (1.0f / MLA_KV_LORA) + EPS);
#pragma unroll
          for (int j = 0; j < 2; ++j) { const int c = 2 * lane + 128 * j; *(unsigned*)(A.CKVN + (size_t)r * MLA_KV_LORA + c) = pk2(x[2 * j] * rstd * A.kva_g[c], x[2 * j + 1] * rstd * A.kva_g[c + 1]); } }
#pragma unroll
        for (int which = 0; which < 2; ++which) {
            const int hh = lane >> 4, d0 = (lane & 15) * 8; const u32x4 w = *(const u32x4*)(p + (which == 0 ? C_NQ : C_NK) + hh * HD + d0);
            float x[8]; float ss = 0.f;
#pragma unroll
            for (int j = 0; j < 4; ++j) { x[2 * j] = bflo(w[j]); x[2 * j + 1] = bfhi(w[j]); ss += x[2 * j] * x[2 * j] + x[2 * j + 1] * x[2 * j + 1]; }
            const float rstd = 1.0f / sqrtf(sum16(ss, lane) * (1.0f / HD) + EPS); const float* g = (which == 0 ? A.na_qn_g : A.na_kn_g) + d0;
            *(u32x4*)((which == 0 ? A.NQ : A.NK) + (size_t)r * GROUP_W + hh * HD + d0) =
                (u32x4){pk2(x[0] * rstd * g[0], x[1] * rstd * g[1]), pk2(x[2] * rstd * g[2], x[3] * rstd * g[3]), pk2(x[4] * rstd * g[4], x[5] * rstd * g[5]), pk2(x[6] * rstd * g[6], x[7] * rstd * g[7])};
        }
    }
}
struct MlaQkvArgs { const float* QR; const float* KVR; const bf16_t* P; const float *qn_g, *kn_g; bf16_t *QM, *KM, *VM; };
__device__ __forceinline__ void mlaqkv_phase(const MlaQkvArgs& A, int gwave, int nwaves, int lane) {
    static_assert(MLA_QK == 192 && MLA_NOPE == 128 && MLA_ROPE == 64 && NH == 4, "mla qkv geometry");
    const int hh = lane >> 4, g = lane & 15;
    const float inv = powf(10000.0f, -(float)g / 16.0f);
    for (int r = gwave; r < M_ALL; r += nwaves) {
        const bool lat = r < M_LAT; const int t = lat ? r % SEQ : 0;
        float cr = 1.f, sr = 0.f, cc = 1.f, sc = 0.f;
        if (lat) { sincosf((float)(t / GRID_W) * inv, &sr, &cr); sincosf((float)(t % GRID_W) * inv, &sc, &cc); }
#pragma unroll
        for (int which = 0; which < 2; ++which) {
            float x[12]; float ss = 0.f;
            if (which == 0) { const float* src = A.QR + (size_t)r * NQ_MLA + hh * MLA_QK + g;
#pragma unroll
                for (int i = 0; i < 12; ++i) x[i] = src[16 * i]; }
            else { const float* src = A.KVR + (size_t)r * NKV_MLA + hh * (MLA_NOPE + MLA_V) + g; const bf16_t* kr = A.P + (size_t)r * NP + C_KR + g;
#pragma unroll
                for (int i = 0; i < 8; ++i) x[i] = src[16 * i];
#pragma unroll
                for (int i = 0; i < 4; ++i) x[8 + i] = bf2f(kr[16 * i]); }
#pragma unroll
            for (int i = 0; i < 12; ++i) ss += x[i] * x[i];
            const float rstd = 1.0f / sqrtf(sum16(ss, lane) * (1.0f / MLA_QK) + EPS); const float* gn = (which == 0 ? A.qn_g : A.kn_g) + g;
#pragma unroll
            for (int i = 0; i < 12; ++i) x[i] = x[i] * rstd * gn[16 * i];
            { const float a0 = x[8], b0 = x[10]; x[8] = a0 * cr - b0 * sr; x[10] = a0 * sr + b0 * cr;
              const float a1 = x[9], b1 = x[11]; x[9] = a1 * cc - b1 * sc; x[11] = a1 * sc + b1 * cc; }
            bf16_t* O = (which == 0 ? A.QM : A.KM) + (size_t)r * NQ_MLA + hh * MLA_QK + g;
#pragma unroll
            for (int i = 0; i < 12; ++i) O[16 * i] = f2bf(x[i]);
        }
        { const float* vs = A.KVR + (size_t)r * NKV_MLA + hh * (MLA_NOPE + MLA_V) + MLA_NOPE + g; bf16_t* O = A.VM + (size_t)r * (NH * MLA_V) + hh * MLA_V + g;
#pragma unroll
          for (int i = 0; i < 8; ++i) O[16 * i] = f2bf(vs[16 * i]); }
    }
}
constexpr int ACT_RUN = 32;
__device__ __forceinline__ void act_phase(const bf16_t* UP, const float* cw, const float* cb, bf16_t* ACT, int nrows, int gtid, int gthreads) {
    constexpr int NC8 = D_FF / 8; static_assert(SEQ % ACT_RUN == 0 && CTX_LEN % ACT_RUN == 0, "row runs stay inside one sequence");
    const int nruns = nrows / ACT_RUN;
    for (long it = gtid; it < (long)nruns * NC8; it += gthreads) { const int run = (int)(it / NC8), j0 = (int)(it % NC8) * 8, r0 = run * ACT_RUN; const RowInfo ri = row_info(r0);
        float wa[3][8], wg[3][8], ba[8], bg[8];
#pragma unroll
        for (int k = 0; k < 3; ++k) { const float* p = cw + (size_t)k * 2 * D_FF + j0; const f32x4 a0 = *(const f32x4*)p, a1 = *(const f32x4*)(p + 4), g0 = *(const f32x4*)(p + D_FF), g1 = *(const f32x4*)(p + D_FF + 4);
#pragma unroll
            for (int e = 0; e < 4; ++e) { wa[k][e] = a0[e]; wa[k][4 + e] = a1[e]; wg[k][e] = g0[e]; wg[k][4 + e] = g1[e]; } }
        { const f32x4 a0 = *(const f32x4*)(cb + j0), a1 = *(const f32x4*)(cb + j0 + 4), g0 = *(const f32x4*)(cb + D_FF + j0), g1 = *(const f32x4*)(cb + D_FF + j0 + 4);
#pragma unroll
          for (int e = 0; e < 4; ++e) { ba[e] = a0[e]; ba[4 + e] = a1[e]; bg[e] = g0[e]; bg[4 + e] = g1[e]; } }
        const u32x4 zero = {0u, 0u, 0u, 0u};
        const bf16_t* ub = UP + (size_t)ri.base * (2 * D_FF) + j0;
        u32x4 am, ac, gm, gc;
        { const int t = ri.t; am = t > 0 ? *(const u32x4*)(ub + (size_t)(t - 1) * (2 * D_FF)) : zero; gm = t > 0 ? *(const u32x4*)(ub + (size_t)(t - 1) * (2 * D_FF) + D_FF) : zero;
          ac = *(const u32x4*)(ub + (size_t)t * (2 * D_FF)); gc = *(const u32x4*)(ub + (size_t)t * (2 * D_FF) + D_FF); }
#pragma unroll 4
        for (int i = 0; i < ACT_RUN; ++i) { const int t = ri.t + i;
            const u32x4 ap = t + 1 < ri.T ? *(const u32x4*)(ub + (size_t)(t + 1) * (2 * D_FF)) : zero, gp = t + 1 < ri.T ? *(const u32x4*)(ub + (size_t)(t + 1) * (2 * D_FF) + D_FF) : zero;
            float y[8];
#pragma unroll
            for (int e = 0; e < 4; ++e) {
                const float a0 = ba[2 * e] + wa[0][2 * e] * bflo(am[e]) + wa[1][2 * e] * bflo(ac[e]) + wa[2][2 * e] * bflo(ap[e]);
                const float a1 = ba[2 * e + 1] + wa[0][2 * e + 1] * bfhi(am[e]) + wa[1][2 * e + 1] * bfhi(ac[e]) + wa[2][2 * e + 1] * bfhi(ap[e]);
                const float g0 = bg[2 * e] + wg[0][2 * e] * bflo(gm[e]) + wg[1][2 * e] * bflo(gc[e]) + wg[2][2 * e] * bflo(gp[e]);
                const float g1 = bg[2 * e + 1] + wg[0][2 * e + 1] * bfhi(gm[e]) + wg[1][2 * e + 1] * bfhi(gc[e]) + wg[2][2 * e + 1] * bfhi(gp[e]);
                y[2 * e] = a0 * (g0 / (1.0f + __expf(-g0))); y[2 * e + 1] = a1 * (g1 / (1.0f + __expf(-g1))); }
            *(u32x4*)(ACT + (size_t)(r0 + i) * D_FF + j0) = (u32x4){pk2(y[0], y[1]), pk2(y[2], y[3]), pk2(y[4], y[5]), pk2(y[6], y[7])};
            am = ac; ac = ap; gm = gc; gc = gp; }
    }
}
__device__ __forceinline__ void transpose_item(const float* W, int K, int N, int Npad, bf16_t* WT, float* scr, int item, int lane) {
    const int nblk = Npad / 32, kb = item / nblk, nb = item % nblk, k0 = 64 * kb, n0 = 32 * nb; const int n = n0 + (lane & 31); const bool ok = n < N;
#pragma unroll 8
    for (int i = 0; i < 32; ++i) { const int kk = 2 * i + (lane >> 5); scr[kk * 33 + (lane & 31)] = ok ? W[(size_t)(k0 + kk) * N + n] : 0.f; }
    asm volatile("s_waitcnt lgkmcnt(0)" ::: "memory");
    const int c = lane & 7;
#pragma unroll
    for (int j = 0; j < 4; ++j) { const int nn = (lane >> 3) + 8 * j; const float* s = scr + (8 * c) * 33 + nn;
        u32x4 o; o.x = pk2(s[0 * 33], s[1 * 33]); o.y = pk2(s[2 * 33], s[3 * 33]); o.z = pk2(s[4 * 33], s[5 * 33]); o.w = pk2(s[6 * 33], s[7 * 33]);
        *(u32x4*)(WT + (size_t)(n0 + nn) * K + k0 + 8 * c) = o; }
    asm volatile("s_waitcnt lgkmcnt(0)" ::: "memory");
}
}

__device__ __forceinline__ gdn::Bufs gdn_bufs(const WS& w, int l) { gdn::Bufs B; B.UT = w.gUT; B.WP = w.gWP; B.KDT = w.gKDT; B.QD = w.gQD; B.QK = w.gQK; B.SIT = w.gSIT; B.VNT = w.gVNT; B.GT = w.gGT + (size_t)l * gdn::NTASK; return B; }
__device__ __forceinline__ lru::Bufs lru_bufs(const WS& w) { lru::Bufs B; B.HLOC = w.lHLOC; B.ACUM = w.lACUM; B.LSUM = w.lLSUM; B.HIN = w.lHIN; return B; }

#define LAS __attribute__((address_space(3)))
#define XB_TMO      128
#define XB_XCNT(j)  (256  + 64 * (j))
#define XB_XSUB(j)  (1280 + 64 * (j))
#define XB_XGEN(j)  (2304 + 64 * (j))
#define XB_TOP      3328
#define XB_TOPGEN   3392
#define XCD_BAR_WORDS 3456
#define XB_SPIN_CAP (1u << 18)
__device__ __forceinline__ unsigned xb_ld(unsigned* p)              { return __hip_atomic_load(p, __ATOMIC_RELAXED, __HIP_MEMORY_SCOPE_AGENT); }
__device__ __forceinline__ unsigned xb_add(unsigned* p, unsigned v) { return __hip_atomic_fetch_add(p, v, __ATOMIC_RELAXED, __HIP_MEMORY_SCOPE_AGENT); }
__device__ __forceinline__ unsigned xb_xcc_id() { return (unsigned)__builtin_amdgcn_s_getreg((3 << 11) | 20) & 0xFu; }
#define XB_SPIN(cond, bar) do { unsigned _sp = 0; while (cond) { __builtin_amdgcn_s_sleep(1); \
    if ((++_sp & 255u) == 0u) { if (xb_ld(&(bar)[XB_TMO])) break; if (_sp > XB_SPIN_CAP) { atomicAdd(&(bar)[XB_TMO], 1u); break; } } } } while (0)
struct XcdBarrier { unsigned* bar; unsigned x; volatile LAS unsigned* st; };
__device__ __forceinline__ XcdBarrier xcd_barrier_post(unsigned* bar, volatile LAS unsigned* st, const bool leader) {
    XcdBarrier b; b.bar = bar; b.x = xb_xcc_id(); b.st = st;
    if (leader) (void)xb_add(&bar[XB_XCNT(b.x)], 1u);
    return b;
}
__device__ __forceinline__ void xcd_barrier_complete(unsigned* bar, unsigned x, unsigned& nloc, unsigned& nx) {
    const unsigned G = gridDim.x * gridDim.y * gridDim.z;
    unsigned sum, cnt, mine, sp = 0u;
    for (;;) {
        sum = 0u; cnt = 0u; mine = 0u;
#pragma unroll
        for (unsigned j = 0; j < 16; ++j) { const unsigned c = xb_ld(&bar[XB_XCNT(j)]); sum += c; cnt += (c > 0u) ? 1u : 0u; mine = (j == x) ? c : mine; }
        if (sum == G) break;
        __builtin_amdgcn_s_sleep(1);
        if ((++sp & 255u) == 0u) { if (xb_ld(&bar[XB_TMO])) break; if (sp > XB_SPIN_CAP) { atomicAdd(&bar[XB_TMO], 1u); break; } }
    }
    nloc = mine > 0u ? mine : 1u; nx = cnt > 0u ? cnt : 1u;
}
__device__ __forceinline__ void xcd_barrier(const XcdBarrier& b, const bool leader) {
    asm volatile("s_waitcnt vmcnt(0)" ::: "memory");
    __syncthreads();
    if (leader) {
        unsigned* bar = b.bar;
        __builtin_amdgcn_s_waitcnt(0);
        unsigned nloc = b.st[0], nx = b.st[1];
        if (nloc == 0u) { xcd_barrier_complete(bar, b.x, nloc, nx); b.st[0] = nloc; b.st[1] = nx; }
        const unsigned old = xb_add(&bar[XB_XSUB(b.x)], 1u);
        const unsigned gen = old / nloc;
        if (old + 1u == (gen + 1u) * nloc) {
            __builtin_amdgcn_fence(__ATOMIC_RELEASE, "agent");
            asm volatile("s_waitcnt vmcnt(0)" ::: "memory");
            const unsigned og = xb_add(&bar[XB_TOP], 1u);
            const unsigned tg = og / nx;
            if (og + 1u == (tg + 1u) * nx) xb_add(&bar[XB_TOPGEN], 1u);
            else XB_SPIN(xb_ld(&bar[XB_TOPGEN]) == tg, bar);
            __builtin_amdgcn_fence(__ATOMIC_ACQUIRE, "agent");
            xb_add(&bar[XB_XGEN(b.x)], 1u);
            asm volatile("s_waitcnt vmcnt(0)" ::: "memory");
        } else {
            XB_SPIN(xb_ld(&bar[XB_XGEN(b.x)]) == gen, bar);
            __builtin_amdgcn_fence(__ATOMIC_ACQUIRE, "agent");
            asm volatile("s_waitcnt vmcnt(0)" ::: "memory");
        }
    }
    __syncthreads();
}

constexpr int NWAVES = 8, NTHR = 512;
constexpr int LDS_MISC = 147456, LDS_BYTES = 148480;
static_assert(sizeof(Inputs) == 34 * 8, "Inputs mirrors Params::in");
static_assert(gdn::G1_LDS <= LDS_MISC && pg8::STAGE_BYTES <= LDS_MISC && att::Cfg<MLA_QK>::LDS_BYTES <= LDS_MISC && gdn::G2_LDS <= LDS_MISC, "LDS map");
constexpr int CW_BAR = 4096;
constexpr int SK_OUT = 4, SK_DOWN = 5;
constexpr int PH_PRO = 0, PH_PER_LAYER = 12, NPH = 1 + PH_PER_LAYER * DEPTH;
struct Params { const float* in[34]; float* out; unsigned char* ws; int ph_lo, ph_hi, li, pad; };

struct SplitOrder {
    int nN, nM, S, G, c;
    __device__ __forceinline__ void init(int M, int N, int S_, int G_, int c_) { nM = M / pg8::BM; nN = N / pg8::BM; S = S_; G = G_; c = c_; }
    __device__ __forceinline__ bool next(int i, pg8::Unit& u) const { const int g = c + i * G; if (g >= nM * nN * S) return false; u.ks = g / (nM * nN); const int loc = g % (nM * nN); u.pm = loc / nN; u.pn = loc % nN; return true; }
    __device__ __forceinline__ void a_ready(const pg8::Unit&) const {}
    __device__ __forceinline__ void done(const pg8::Unit&) const {}
};
struct SpanOrder {
    int nN, lo, hi, G, g0;
    __device__ __forceinline__ void init(int N, int lo_, int hi_, int G_, int c) { nN = N / pg8::BM; lo = lo_; hi = hi_; G = G_; int i0 = 0; if (c < lo_) i0 = (lo_ - c + G_ - 1) / G_; g0 = c + i0 * G_; }
    __device__ __forceinline__ bool next(int i, pg8::Unit& u) const { const int g = g0 + i * G; if (g >= hi) return false; const int loc = g - lo; u.pm = loc / nN; u.pn = loc % nN; u.ks = 0; return true; }
    __device__ __forceinline__ void a_ready(const pg8::Unit&) const {}
    __device__ __forceinline__ void done(const pg8::Unit&) const {}
};

#define AS4 __attribute__((address_space(4)))
#define PHASE_WS const AS4 Params* pp = (const AS4 Params*)__builtin_amdgcn_kernarg_segment_ptr(); asm volatile("" : "+s"(pp)); const AS4 Inputs* I = (const AS4 Inputs*)pp; (void)I; unsigned char* wsb_ = pp->ws; const WS w = ws_carve(wsb_)
#define PHASE_IDS int tid = C_wave0 * 64 + (int)__builtin_amdgcn_mbcnt_hi(~0u, __builtin_amdgcn_mbcnt_lo(~0u, 0u)); asm volatile("" : "+v"(tid)); const int lane = tid & 63, wave = __builtin_amdgcn_readfirstlane(tid >> 6), gwave = wg * NWAVES + wave, gtid = wg * NTHR + tid; (void)lane; (void)gwave; (void)gtid
#ifndef DBG_MASK
#define DBG_MASK 0xFFFFFF
#endif
#define IN(k) (lo <= (k) && (k) < hi)
#define ON(j) (((DBG_MASK) >> (j)) & 1)
#define SEAM(k) do { if (IN(k) && IN((k) + 1)) xcd_barrier(bar, C_wave0 == 0 && __builtin_amdgcn_mbcnt_hi(~0u, __builtin_amdgcn_mbcnt_lo(~0u, 0u)) == 0u); } while (0)

struct LayerCtx { int lo, hi, G, wg, nwaves, gthreads, wave0; XcdBarrier bar; char* lds; unsigned char* lds_raw; };
template <int l> __device__ __forceinline__ void layer_body(const LayerCtx& C) {
    const int lo = C.lo, hi = C.hi, G = C.G, wg = C.wg, nwaves = C.nwaves, gthreads = C.gthreads, C_wave0 = C.wave0; const XcdBarrier& bar = C.bar; char* lds = C.lds; unsigned char* lds_raw = C.lds_raw;
    (void)G; (void)nwaves; (void)gthreads;
        const int pb = 1 + PH_PER_LAYER * l;
        const bool want_ctx = l < DEPTH - 1; const int Mo = want_ctx ? M_ALL : M_LAT;
        if (ON(0) && IN(pb + 0)) { PHASE_WS; PHASE_IDS; const float* MODl = w.MOD + (size_t)l * (BATCH + 1) * NMODV; (void)MODl; misc::norm_phase(w.H, I->norm_mix_g + (size_t)l * D_MODEL, MODl, 0, w.U, M_ALL, gwave, nwaves, lane, l > 0 ? w.PART : nullptr, SK_DOWN, MODl - (size_t)(BATCH + 1) * NMODV + (size_t)BATCH * NMODV + 5 * D_MODEL); }
        SEAM(pb + 0);
        if (ON(1) && IN(pb + 1)) { PHASE_WS; PHASE_IDS; const float* MODl = w.MOD + (size_t)l * (BATCH + 1) * NMODV; (void)MODl; pg8::Gemm g{w.U, w.WIN + l * SZ_WIN, M_ALL, NP, D_MODEL, D_MODEL}; pg8::StaticOrder S; S.init(M_ALL, NP, G, wg);
            pg8::EpiBf16<0> E{w.P, NP, nullptr, 0, 0, 1.0f};
            pg8::gemm_phase<pg8::EpiBf16<0>, pg8::StaticOrder, true, true>((PG8_LAS unsigned char*)lds_raw, g, S, E, tid); }
        SEAM(pb + 1);
        if (ON(2) && IN(pb + 2)) { PHASE_WS; PHASE_IDS; const float* MODl = w.MOD + (size_t)l * (BATCH + 1) * NMODV; (void)MODl;
            const int pflags = pp->pad;
            if (!(pflags & 16)) { gdn::G1Args A; A.P = w.P; A.conv_w = I->gdn_conv_w + (size_t)l * 4 * 3 * GROUP_W; A.a_log = I->gdn_a_log + (size_t)l * 2 * NH; A.dt_bias = I->gdn_dt_bias + (size_t)l * 2 * NH; A.B = gdn_bufs(w, l); A.pflags = pflags;
              gdn::g1_phase(A, lds, G, wg, tid); }
            if (!(pflags & 32)) { lru::LocalArgs A; A.P = w.P; A.conv_w = I->lru_conv_w + (size_t)l * 4 * LRU_W; A.conv_b = I->lru_conv_b + (size_t)l * LRU_W; A.WG = w.WLRU + (size_t)l * 16 * lru::SZ_WBLK;
              A.ba = I->lru_ba + (size_t)l * 2 * LRU_W; A.bx = I->lru_bx + (size_t)l * 2 * LRU_W; A.lam = I->lru_lam + (size_t)l * 2 * LRU_W; A.B = lru_bufs(w);
              lru::local_phase(A, lds, G, wg, tid); }
            if (!(pflags & 64)) { misc::RowNormArgs A; A.P = w.P; A.qa_g = I->mla_qa_g + (size_t)l * MLA_Q_LORA; A.kva_g = I->mla_kva_g + (size_t)l * MLA_KV_LORA; A.na_qn_g = I->na_qn_g + (size_t)l * HD; A.na_kn_g = I->na_kn_g + (size_t)l * HD;
              A.CQN = w.CQN; A.CKVN = w.CKVN; A.NQ = w.NQ; A.NK = w.NK; misc::rownorm_phase(A, gwave, nwaves, lane); }
        }
        SEAM(pb + 2);
        if (ON(3) && IN(pb + 3)) { PHASE_WS; PHASE_IDS; const float* MODl = w.MOD + (size_t)l * (BATCH + 1) * NMODV; (void)MODl;
            constexpr int UQ = (M_ALL / 256) * (NQ_MLA / 256), UKV = (M_ALL / 256) * (NKV_MLA / 256);
            { pg8::Gemm g{w.CQN, w.WUQ + l * SZ_WUQ, M_ALL, NQ_MLA, MLA_Q_LORA, MLA_Q_LORA}; SpanOrder S; S.init(NQ_MLA, 0, UQ, G, wg); pg8::EpiF32 E{w.QR, NQ_MLA};
              pg8::gemm_phase<pg8::EpiF32, SpanOrder, true, true>((PG8_LAS unsigned char*)lds_raw, g, S, E, tid); }
            { pg8::Gemm g{w.CKVN, w.WUKV + l * SZ_WUKV, M_ALL, NKV_MLA, MLA_KV_LORA, MLA_KV_LORA}; SpanOrder S; S.init(NKV_MLA, UQ, UQ + UKV, G, wg); pg8::EpiF32 E{w.KVR, NKV_MLA};
              pg8::gemm_phase<pg8::EpiF32, SpanOrder, true, true>((PG8_LAS unsigned char*)lds_raw, g, S, E, tid); }
        }
        SEAM(pb + 3);
        if (ON(4) && IN(pb + 4)) { PHASE_WS; PHASE_IDS; const float* MODl = w.MOD + (size_t)l * (BATCH + 1) * NMODV; (void)MODl;
            { misc::MlaQkvArgs A; A.QR = w.QR; A.KVR = w.KVR; A.P = w.P; A.qn_g = I->mla_qn_g + (size_t)l * MLA_QK; A.kn_g = I->mla_kn_g + (size_t)l * MLA_QK; A.QM = w.QM; A.KM = w.KM; A.VM = w.VM;
              misc::mlaqkv_phase(A, gwave, nwaves, lane); }
            lru::carry_phase(lru_bufs(w), gtid, gthreads);
        }
        SEAM(pb + 4);
        if (ON(5) && IN(pb + 5)) { PHASE_WS; PHASE_IDS; const float* MODl = w.MOD + (size_t)l * (BATCH + 1) * NMODV; (void)MODl;
            const int pflags = pp->pad;
            if (wg < BATCH * NH * 2 * gdn::G2_SPLIT && !(pflags & 1)) gdn::g2_chain(gdn_bufs(w, l), lds, wg, tid);
            AttnArgs A; A.QM = w.QM; A.KM = w.KM; A.VM = w.VM; A.NQ = w.NQ; A.NK = w.NK; A.P = w.P; A.Y = w.Y; A.rpb = I->na_rpb + (size_t)l * NH * (2 * NA_KH - 1) * (2 * NA_KW - 1); A.want_ctx = want_ctx ? 1 : 0; A.pad = pflags;
            attention_phase(A, lds, G, wg, tid);
        }
        SEAM(pb + 5);
        if (ON(6) && IN(pb + 6)) { PHASE_WS; PHASE_IDS; const float* MODl = w.MOD + (size_t)l * (BATCH + 1) * NMODV; (void)MODl;
            const int pflags = pp->pad;
            if (!(pflags & 128)) { gdn::G3Args A; A.B = gdn_bufs(w, l); A.P = w.P; A.norm_g = I->gdn_norm_g + (size_t)l * HD; A.Y = w.Y; gdn::g3_phase(A, lds, G, wg, tid); }
            if (!(pflags & 256)) lru::finish_phase(lru_bufs(w), w.P, w.Y, gtid, gthreads);
        }
        SEAM(pb + 6);
        if (ON(7) && IN(pb + 7)) { PHASE_WS; PHASE_IDS; const float* MODl = w.MOD + (size_t)l * (BATCH + 1) * NMODV; (void)MODl;
            { pg8::Gemm g{w.Y, w.WOUT + l * SZ_WOUT, M_LAT, D_MODEL, D_MODEL, D_MODEL}; pg8::StaticOrder S; S.init(M_LAT, D_MODEL, G, wg);
              pg8::EpiGateRes E{w.H, w.H, D_MODEL, MODl + 2 * D_MODEL, NMODV, SEQ, BATCH, M_LAT};
              pg8::gemm_phase<pg8::EpiGateRes, pg8::StaticOrder, true, true>((PG8_LAS unsigned char*)lds_raw, g, S, E, tid); }
            if (want_ctx) { constexpr int SK = SK_OUT;
              pg8::Gemm g{w.Y + (size_t)M_LAT * D_MODEL, w.WOUT + l * SZ_WOUT, M_CTX, D_MODEL, D_MODEL / SK, D_MODEL}; SplitOrder S; S.init(M_CTX, D_MODEL, SK, G, (wg + G / 2) % G);
              pg8::EpiPart E{w.PART, D_MODEL, (size_t)M_CTX * D_MODEL};
              pg8::gemm_phase<pg8::EpiPart, SplitOrder, true, true>((PG8_LAS unsigned char*)lds_raw, g, S, E, tid); } }
        SEAM(pb + 7);
        if (ON(8) && IN(pb + 8)) { PHASE_WS; PHASE_IDS; const float* MODl = w.MOD + (size_t)l * (BATCH + 1) * NMODV; (void)MODl; misc::norm_phase(w.H, I->norm_ffn_g + (size_t)l * D_MODEL, MODl, 3, w.U, Mo, gwave, nwaves, lane, want_ctx ? w.PART : nullptr, SK_OUT, MODl + (size_t)BATCH * NMODV + 2 * D_MODEL); }
        SEAM(pb + 8);
        if (ON(9) && IN(pb + 9)) { PHASE_WS; PHASE_IDS; const float* MODl = w.MOD + (size_t)l * (BATCH + 1) * NMODV; (void)MODl; pg8::Gemm g{w.U, w.WUP + l * SZ_WUP, Mo, 2 * D_FF, D_MODEL, D_MODEL}; pg8::StaticOrder S; S.init(Mo, 2 * D_FF, G, wg);
            pg8::EpiBf16<0> E{w.UP, 2 * D_FF, nullptr, 0, 0, 1.0f};
            pg8::gemm_phase<pg8::EpiBf16<0>, pg8::StaticOrder, true, true>((PG8_LAS unsigned char*)lds_raw, g, S, E, tid); }
        SEAM(pb + 9);
        if (ON(10) && IN(pb + 10)) { PHASE_WS; PHASE_IDS; const float* MODl = w.MOD + (size_t)l * (BATCH + 1) * NMODV; (void)MODl; misc::act_phase(w.UP, I->ffn_conv_w + (size_t)l * 3 * 2 * D_FF, I->ffn_conv_b + (size_t)l * 2 * D_FF, w.ACT, Mo, gtid, gthreads); }
        SEAM(pb + 10);
        if (ON(11) && IN(pb + 11)) { PHASE_WS; PHASE_IDS; const float* MODl = w.MOD + (size_t)l * (BATCH + 1) * NMODV; (void)MODl;
            { pg8::Gemm g{w.ACT, w.WDOWN + l * SZ_WDOWN, M_LAT, D_MODEL, D_FF, D_FF}; pg8::StaticOrder S; S.init(M_LAT, D_MODEL, G, wg);
              pg8::EpiGateRes E{w.H, want_ctx ? w.H : pp->out, D_MODEL, MODl + 5 * D_MODEL, NMODV, SEQ, BATCH, M_LAT};
              pg8::gemm_phase<pg8::EpiGateRes, pg8::StaticOrder, true, true>((PG8_LAS unsigned char*)lds_raw, g, S, E, tid); }
            if (want_ctx) { constexpr int SK = SK_DOWN;
              pg8::Gemm g{w.ACT + (size_t)M_LAT * D_FF, w.WDOWN + l * SZ_WDOWN, M_CTX, D_MODEL, D_FF / SK, D_FF}; SplitOrder S; S.init(M_CTX, D_MODEL, SK, G, (wg + G / 2) % G);
              pg8::EpiPart E{w.PART, D_MODEL, (size_t)M_CTX * D_MODEL};
              pg8::gemm_phase<pg8::EpiPart, SplitOrder, true, true>((PG8_LAS unsigned char*)lds_raw, g, S, E, tid); } }
        SEAM(pb + 11);

}
__global__ void __launch_bounds__(NTHR, 2) fwd(Params p) {
    extern __shared__ __attribute__((aligned(16))) unsigned char lds_raw[];
    char* lds = (char*)lds_raw;
    const int G = (int)gridDim.x, wg = (int)blockIdx.x, nwaves = G * NWAVES, gthreads = G * NTHR;
    const int C_wave0 = __builtin_amdgcn_readfirstlane((int)threadIdx.x >> 6);
    volatile LAS unsigned* MISC = (volatile LAS unsigned*)(lds_raw + LDS_MISC);
    if (threadIdx.x < 32) MISC[threadIdx.x] = 0u;
    __syncthreads();
    const int lo = p.ph_lo, hi = p.ph_hi;
    unsigned* const barw = (unsigned*)p.ws + CW_BAR + (size_t)p.li * XCD_BAR_WORDS;
    XcdBarrier bar; bar.bar = barw; bar.x = 0; bar.st = MISC + 8;
    if (hi - lo > 1) bar = xcd_barrier_post(barw, MISC + 8, threadIdx.x == 0);

    if (ON(12) && IN(PH_PRO)) { PHASE_WS; PHASE_IDS;
        {
            float* SCs = (float*)lds;
            float* red = (float*)(lds + 3 * D_MODEL * 4);
            constexpr int NT = DEPTH * NMODV / 256;
            if (wg < NT) {
                for (int i = tid; i < (BATCH + 1) * D_MODEL; i += NTHR) { const int s = i / D_MODEL, k = i % D_MODEL; const float v = s < BATCH ? I->c[s * D_MODEL + k] : I->c_ctx[k]; SCs[i] = v / (1.0f + __expf(-v)); }
                __syncthreads();
            }
            for (int t = wg; t < NT; t += G) { const int l = t / (NMODV / 256), j0 = (t % (NMODV / 256)) * 256;
                misc::f32x4 acc[3] = {{0.f, 0.f, 0.f, 0.f}, {0.f, 0.f, 0.f, 0.f}, {0.f, 0.f, 0.f, 0.f}};
                const float* wp = I->ada_w + (size_t)l * D_MODEL * NMODV + (size_t)(256 * wave) * NMODV + j0 + 4 * lane;
#pragma unroll 8
                for (int k = 0; k < 256; ++k) { const misc::f32x4 wv = *(const misc::f32x4*)(wp + (size_t)k * NMODV); const int kk = 256 * wave + k;
                    acc[0] += wv * SCs[kk]; acc[1] += wv * SCs[D_MODEL + kk]; acc[2] += wv * SCs[2 * D_MODEL + kk]; }
                __syncthreads();
#pragma unroll
                for (int s = 0; s < 3; ++s) *(misc::f32x4*)(red + (wave * 3 + s) * 256 + 4 * lane) = acc[s];
                __syncthreads();
                for (int i = tid; i < 3 * 256; i += NTHR) { const int s = i / 256, c = i % 256; float sum = I->ada_b[(size_t)l * NMODV + j0 + c];
#pragma unroll
                    for (int w8 = 0; w8 < 8; ++w8) sum += red[(w8 * 3 + s) * 256 + c];
                    w.MOD[((size_t)l * (BATCH + 1) + s) * NMODV + j0 + c] = sum; }
            }
            __syncthreads();
        }
        {
            float* scr = (float*)(lds + wave * 8448);
            constexpr int I_IN = (D_MODEL / 64) * (NP / 32), I_OUT = (D_MODEL / 64) * (D_MODEL / 32), I_UP = (D_MODEL / 64) * (2 * D_FF / 32), I_DN = (D_FF / 64) * (D_MODEL / 32),
                          I_UQ = (MLA_Q_LORA / 64) * (NQ_MLA / 32), I_UKV = (MLA_KV_LORA / 64) * (NKV_MLA / 32), I_LB = (LRU_BW / 64) * (LRU_BW / 32), I_LRU = 2 * 2 * NH * I_LB;
            constexpr int I_LAYER = I_IN + I_OUT + I_UP + I_DN + I_UQ + I_UKV + I_LRU;
            for (int it = gwave; it < DEPTH * I_LAYER; it += nwaves) { const int l = it / I_LAYER; int r = it % I_LAYER;
                if (r < I_IN) { misc::transpose_item(I->w_in + (size_t)l * D_MODEL * IN_COLS, D_MODEL, IN_COLS, NP, w.WIN + l * SZ_WIN, scr, r, lane); continue; } r -= I_IN;
                if (r < I_OUT) { misc::transpose_item(I->w_out + (size_t)l * D_MODEL * D_MODEL, D_MODEL, D_MODEL, D_MODEL, w.WOUT + l * SZ_WOUT, scr, r, lane); continue; } r -= I_OUT;
                if (r < I_UP) { misc::transpose_item(I->ffn_w_up + (size_t)l * D_MODEL * 2 * D_FF, D_MODEL, 2 * D_FF, 2 * D_FF, w.WUP + l * SZ_WUP, scr, r, lane); continue; } r -= I_UP;
                if (r < I_DN) { misc::transpose_item(I->ffn_w_down + (size_t)l * D_FF * D_MODEL, D_FF, D_MODEL, D_MODEL, w.WDOWN + l * SZ_WDOWN, scr, r, lane); continue; } r -= I_DN;
                if (r < I_UQ) { misc::transpose_item(I->mla_w_uq + (size_t)l * MLA_Q_LORA * NQ_MLA, MLA_Q_LORA, NQ_MLA, NQ_MLA, w.WUQ + l * SZ_WUQ, scr, r, lane); continue; } r -= I_UQ;
                if (r < I_UKV) { misc::transpose_item(I->mla_w_ukv + (size_t)l * MLA_KV_LORA * NKV_MLA, MLA_KV_LORA, NKV_MLA, NKV_MLA, w.WUKV + l * SZ_WUKV, scr, r, lane); continue; } r -= I_UKV;
                { const int blk = r / I_LB, item = r % I_LB, d = blk / (2 * NH), wh = (blk / NH) & 1, nb = blk % NH;
                  const float* src = (wh == 0 ? I->lru_wa : I->lru_wx) + ((size_t)(l * 2 + d) * NH + nb) * lru::SZ_WBLK;
                  misc::transpose_item(src, LRU_BW, LRU_BW, LRU_BW, w.WLRU + ((size_t)l * 16 + blk) * lru::SZ_WBLK, scr, item, lane); }
            }
        }
        for (long i = gtid; i < (long)M_ALL * D_MODEL / 4; i += gthreads) { const long e = i * 4;
            ((misc::f32x4*)w.H)[i] = e < (long)M_LAT * D_MODEL ? *(const misc::f32x4*)(I->x + e) : *(const misc::f32x4*)(I->ctx + (e - (long)M_LAT * D_MODEL)); }
    }
    SEAM(PH_PRO);

    { LayerCtx C; C.lo = lo; C.hi = hi; C.G = G; C.wg = wg; C.nwaves = nwaves; C.gthreads = gthreads; C.wave0 = C_wave0; C.bar = bar; C.lds = lds; C.lds_raw = lds_raw;
      static_assert(DEPTH == 4, "layer calls are written out (a real layer loop lets LICM park loop-invariant values in registers across every phase: spills)");
      layer_body<0>(C); layer_body<1>(C); layer_body<2>(C); layer_body<3>(C); }
#undef IN
#undef SEAM
}

#ifndef MK_PHASES_PER_LAUNCH
#define MK_PHASES_PER_LAUNCH NPH
#endif
extern "C" void kernel_launch(void* const* d_in, const int* in_sizes, int n_in, void* d_out, int out_size, void* d_ws, size_t ws_size, hipStream_t stream) {
    static int grid = 0;
    if (grid == 0) {
        int dev = 0, cus = 0;
        if (hipGetDevice(&dev) != hipSuccess || hipDeviceGetAttribute(&cus, hipDeviceAttributeMultiprocessorCount, dev) != hipSuccess || cus <= 0) { fprintf(stderr, "kernel_launch: no device\n"); grid = -1; return; }
        if (hipFuncSetAttribute((const void*)fwd, hipFuncAttributeMaxDynamicSharedMemorySize, LDS_BYTES) != hipSuccess) { fprintf(stderr, "kernel_launch: hipFuncSetAttribute failed\n"); grid = -1; return; }
        int per_cu = 0; if (hipOccupancyMaxActiveBlocksPerMultiprocessor(&per_cu, (const void*)fwd, NTHR, LDS_BYTES) != hipSuccess || per_cu < 1) fprintf(stderr, "kernel_launch: occupancy query says %d blocks per CU\n", per_cu);
        (void)hipGetLastError();
        grid = cus;
        const WS w0 = ws_carve(nullptr);
        if (n_in != 34 || w0.total > ws_size) { fprintf(stderr, "kernel_launch: bad inputs / workspace (need %zu, have %zu)\n", w0.total, ws_size); grid = -1; return; }
    }
    if (grid < 0) return;
    (void)hipMemsetAsync(d_ws, 0, 1 << 20, stream);
    Params p; memset(&p, 0, sizeof(p));
    for (int i = 0; i < 34; ++i) p.in[i] = (const float*)d_in[i];
    p.out = (float*)d_out; p.ws = (unsigned char*)d_ws;
    int li = 0;
    for (int lo = 0; lo < NPH; lo += MK_PHASES_PER_LAUNCH, ++li) {
        p.ph_lo = lo; p.ph_hi = lo + MK_PHASES_PER_LAUNCH < NPH ? lo + MK_PHASES_PER_LAUNCH : NPH; p.li = li;
#if defined(PROBE_MASK)
        if (MK_PHASES_PER_LAUNCH == 1 && ((((PROBE_MASK) >> 12) & 1 && lo == 0) || (lo > 0 && (((PROBE_MASK) >> ((lo - 1) % PH_PER_LAYER)) & 1))))
            { Params q = p;
#if defined(PROBE_FLAGS)
              q.pad = PROBE_FLAGS;
#endif
              for (int r = 0; r < PROBE_REPS; ++r) hipLaunchKernelGGL(fwd, dim3(grid), dim3(NTHR), LDS_BYTES, stream, q); }
#endif
        hipLaunchKernelGGL(fwd, dim3(grid), dim3(NTHR), LDS_BYTES, stream, p);
    }
}
```

```cpp
#include <hip/hip_runtime.h>
#include <cstdio>
#include <cstdint>
#include <cstring>
#include <math.h>
#include <stdint.h>

#ifdef CFG_SMALL
constexpr int D_MODEL = 256, BATCH = 2, SEQ = 512, DEPTH = 2, CTX_LEN = 64, GRID_W = 32, HEAD_DIM = 16;
#else
constexpr int D_MODEL = 2048, BATCH = 2, SEQ = 8192, DEPTH = 4, CTX_LEN = 256, GRID_W = 64, HEAD_DIM = 128;
#endif
constexpr int GROUP_W = D_MODEL / 4, NH = GROUP_W / HEAD_DIM;
constexpr int HD = HEAD_DIM;
constexpr int N_MOD = 6;
constexpr float EPS = 1e-6f;
constexpr int LRU_W = GROUP_W, LRU_BW = LRU_W / NH;
constexpr float LRU_C = 8.0f;
constexpr int MLA_Q_LORA = 3 * D_MODEL / 16, MLA_KV_LORA = D_MODEL / 8, MLA_NOPE = HD, MLA_ROPE = HD / 2, MLA_V = HD, MLA_QK = MLA_NOPE + MLA_ROPE;
constexpr int GDN_CHUNK = 64;
constexpr int NA_KH = 8, NA_KW = 16;
constexpr int D_FF = 5 * D_MODEL / 2;
constexpr int ROWS = SEQ / GRID_W;
constexpr int C_LRU_X = 0, C_LRU_G = C_LRU_X + LRU_W, C_CQ = C_LRU_G + LRU_W, C_CKV = C_CQ + MLA_Q_LORA, C_KR = C_CKV + MLA_KV_LORA,
              C_GQ = C_KR + MLA_ROPE, C_GK = C_GQ + GROUP_W, C_GV = C_GK + GROUP_W, C_GG = C_GV + GROUP_W, C_GB = C_GG + GROUP_W,
              C_GA = C_GB + 2 * NH, C_NQ = C_GA + 2 * NH, C_NK = C_NQ + GROUP_W, C_NV = C_NK + GROUP_W, IN_COLS = C_NV + GROUP_W;
constexpr int NP = (IN_COLS + 255) / 256 * 256;
constexpr int M_LAT = BATCH * SEQ, M_CTX = BATCH * CTX_LEN, M_ALL = M_LAT + M_CTX;
constexpr int NMODV = N_MOD * D_MODEL;

typedef unsigned short bf16_t;
__host__ __device__ __forceinline__ bf16_t f2bf(float f) { union { float f; unsigned u; } v; v.f = f; unsigned u = v.u; u += 0x7fffu + ((u >> 16) & 1u); return (bf16_t)(u >> 16); }
__host__ __device__ __forceinline__ float bf2f(bf16_t b) { union { float f; unsigned u; } v; v.u = ((unsigned)b) << 16; return v.f; }
__host__ __device__ __forceinline__ float sigmoidf_(float x) { return 1.0f / (1.0f + expf(-x)); }
__host__ __device__ __forceinline__ float siluf_(float x) { return x / (1.0f + expf(-x)); }
__host__ __device__ __forceinline__ float softplusf_(float x) { return fmaxf(x, 0.0f) + log1pf(expf(-fabsf(x))); }
__host__ __device__ __forceinline__ float geluf_(float x) { return 0.5f * x * (1.0f + tanhf(0.7978845608028654f * (x + 0.044715f * x * x * x))); }

struct RowInfo { int b, t, T, base, set; };
__host__ __device__ __forceinline__ RowInfo row_info(int r) {
    RowInfo i;
    if (r < M_LAT) { i.b = r / SEQ; i.t = r % SEQ; i.T = SEQ; i.base = i.b * SEQ; i.set = i.b; }
    else { const int rr = r - M_LAT; i.b = rr / CTX_LEN; i.t = rr % CTX_LEN; i.T = CTX_LEN; i.base = M_LAT + i.b * CTX_LEN; i.set = BATCH; }
    return i;
}


__host__ __device__ __forceinline__ float bflo(unsigned w) { union { float f; unsigned u; } v; v.u = w << 16; return v.f; }
__host__ __device__ __forceinline__ float bfhi(unsigned w) { union { float f; unsigned u; } v; v.u = w & 0xffff0000u; return v.f; }
#define LDS_BARRIER() asm volatile("s_waitcnt lgkmcnt(0)\n\ts_barrier" ::: "memory")
__device__ __forceinline__ float lane_xor(float v, int mask, int lane) { return __int_as_float(__builtin_amdgcn_ds_bpermute((lane ^ mask) << 2, __float_as_int(v))); }
__device__ __forceinline__ float lane_get(float v, int src_lane) { return __int_as_float(__builtin_amdgcn_ds_bpermute(src_lane << 2, __float_as_int(v))); }
struct Inputs {
    const float *x, *c, *ctx, *c_ctx, *ada_w, *ada_b, *norm_mix_g, *norm_ffn_g, *w_in, *w_out,
        *lru_conv_w, *lru_conv_b, *lru_wa, *lru_ba, *lru_wx, *lru_bx, *lru_lam,
        *mla_qa_g, *mla_w_uq, *mla_kva_g, *mla_w_ukv, *mla_qn_g, *mla_kn_g,
        *gdn_conv_w, *gdn_a_log, *gdn_dt_bias, *gdn_norm_g, *na_qn_g, *na_kn_g, *na_rpb,
        *ffn_w_up, *ffn_conv_w, *ffn_conv_b, *ffn_w_down;
};
constexpr int NQ_MLA = NH * MLA_QK, NKV_MLA = NH * (MLA_NOPE + MLA_V);
constexpr size_t SZ_WIN = (size_t)NP * D_MODEL, SZ_WOUT = (size_t)D_MODEL * D_MODEL, SZ_WUP = (size_t)2 * D_FF * D_MODEL, SZ_WDOWN = (size_t)D_MODEL * D_FF,
                 SZ_WUQ = (size_t)NQ_MLA * MLA_Q_LORA, SZ_WUKV = (size_t)NKV_MLA * MLA_KV_LORA, SZ_WLRU = (size_t)16 * LRU_BW * LRU_BW;
struct WS {
    unsigned* ctl; float *MOD, *H, *PART; bf16_t *U, *Y;
    bf16_t *WIN, *WOUT, *WUP, *WDOWN, *WUQ, *WUKV, *WLRU;
    bf16_t* P; bf16_t *CQN, *CKVN; float *QR, *KVR; bf16_t *QM, *KM, *VM, *NQ, *NK;
    bf16_t *gUT, *gWP, *gKDT, *gQD, *gQK, *gSIT, *gVNT; float *gGT, *gSS;
    bf16_t *lHLOC, *lACUM; float *lLSUM, *lHIN;
    bf16_t *UP, *ACT;
    size_t total;
};
__host__ __device__ inline WS ws_carve(void* base) {
    WS w; size_t off = 0; char* b = (char*)base;
#define WS_TAKE(T, field, bytes) do { w.field = (T*)(b + off); off += (((size_t)(bytes)) + 255) & ~(size_t)255; } while (0)
    WS_TAKE(unsigned, ctl, 1 << 20);
    WS_TAKE(float, MOD, sizeof(float) * (size_t)DEPTH * (BATCH + 1) * NMODV);
    WS_TAKE(float, H, sizeof(float) * (size_t)M_ALL * D_MODEL);
    WS_TAKE(float, PART, sizeof(float) * (size_t)5 * M_CTX * D_MODEL);
    WS_TAKE(bf16_t, U, 2 * (size_t)M_ALL * D_MODEL);
    WS_TAKE(bf16_t, Y, 2 * (size_t)M_ALL * D_MODEL);
    WS_TAKE(bf16_t, WIN, 2 * SZ_WIN * DEPTH); WS_TAKE(bf16_t, WOUT, 2 * SZ_WOUT * DEPTH); WS_TAKE(bf16_t, WUP, 2 * SZ_WUP * DEPTH); WS_TAKE(bf16_t, WDOWN, 2 * SZ_WDOWN * DEPTH);
    WS_TAKE(bf16_t, WUQ, 2 * SZ_WUQ * DEPTH); WS_TAKE(bf16_t, WUKV, 2 * SZ_WUKV * DEPTH); WS_TAKE(bf16_t, WLRU, 2 * SZ_WLRU * DEPTH);
    const size_t r0 = off;
    WS_TAKE(bf16_t, P, 2 * (size_t)M_ALL * NP);
    WS_TAKE(bf16_t, CQN, 2 * (size_t)M_ALL * MLA_Q_LORA); WS_TAKE(bf16_t, CKVN, 2 * (size_t)M_ALL * MLA_KV_LORA);
    WS_TAKE(float, QR, 4 * (size_t)M_ALL * NQ_MLA); WS_TAKE(float, KVR, 4 * (size_t)M_ALL * NKV_MLA);
    WS_TAKE(bf16_t, QM, 2 * (size_t)M_ALL * NQ_MLA); WS_TAKE(bf16_t, KM, 2 * (size_t)M_ALL * NQ_MLA); WS_TAKE(bf16_t, VM, 2 * (size_t)M_ALL * NH * MLA_V);
    WS_TAKE(bf16_t, NQ, 2 * (size_t)M_ALL * GROUP_W); WS_TAKE(bf16_t, NK, 2 * (size_t)M_ALL * GROUP_W);
    { constexpr size_t NT_ = (size_t)(M_ALL / 64) * NH * 2;
      WS_TAKE(bf16_t, gUT, 2 * NT_ * 128 * 64); WS_TAKE(bf16_t, gWP, 2 * NT_ * 64 * 128); WS_TAKE(bf16_t, gKDT, 2 * NT_ * 128 * 64); WS_TAKE(bf16_t, gQD, 2 * NT_ * 64 * 128);
      WS_TAKE(bf16_t, gQK, 2 * NT_ * 64 * 64); WS_TAKE(bf16_t, gSIT, 2 * NT_ * 128 * 128); WS_TAKE(bf16_t, gVNT, 2 * NT_ * 128 * 64); WS_TAKE(float, gGT, 4 * NT_ * DEPTH); WS_TAKE(float, gSS, 4 * (size_t)BATCH * NH * 2 * HD * HD); }
    WS_TAKE(bf16_t, lHLOC, 2 * (size_t)2 * M_ALL * LRU_W); WS_TAKE(bf16_t, lACUM, 2 * (size_t)2 * M_ALL * LRU_W);
    WS_TAKE(float, lLSUM, 4 * (size_t)(M_ALL / 64) * 2 * 2 * LRU_W); WS_TAKE(float, lHIN, 4 * (size_t)(M_ALL / 64) * 2 * LRU_W);
    const size_t r1 = off;
    off = r0;
    WS_TAKE(bf16_t, UP, 2 * (size_t)M_ALL * 2 * D_FF); WS_TAKE(bf16_t, ACT, 2 * (size_t)M_ALL * D_FF);
    const size_t f1 = off;
#undef WS_TAKE
    w.total = r1 > f1 ? r1 : f1;
    return w;
}

namespace pg8 {
#define PG8_LAS __attribute__((address_space(3)))
typedef unsigned short bf16_t;
typedef short bf16x8 __attribute__((ext_vector_type(8)));
typedef float f32x4 __attribute__((ext_vector_type(4)));
typedef unsigned u32x4 __attribute__((ext_vector_type(4)));
constexpr int BM = 256, BK = 64, HALF = 128, HTB = HALF * BK * 2  , STAGE_BYTES = 8 * HTB, NXCD = 8, WGM = 8;

__host__ __device__ __forceinline__ int lds_byte(int r, int c) { const int st = (r >> 4) * 2 + (c >> 5), rr = r & 15, cc = c & 31, ob = rr * 64 + cc * 2; return st * 1024 + (ob ^ (((ob >> 9) & 1) << 5)); }
__host__ __device__ __forceinline__ void stage_rc(int b, int& R, int& C) { const int st = b / 1024, sb = b % 1024, swz = sb ^ (((sb >> 9) & 1) << 5); R = (st >> 1) * 16 + swz / 64; C = (st & 1) * 32 + (swz % 64) / 2; }
__host__ __device__ __forceinline__ int perm32(int rho) { const int n = rho >> 4, i = rho & 15; return 8 * (i >> 2) + 4 * n + (i & 3); }

struct Unit { int pm, pn, ks; };
struct Gemm { const bf16_t* A; const bf16_t* Bt; int M, N, K, ld; };

struct StaticOrder {
    int nM, nN, nwg, G, c;
    __host__ __device__ void init(int M, int N, int G_, int c_) { nM = M / BM; nN = N / BM; nwg = nM * nN; G = G_; c = c_; }
    __host__ __device__ bool next(int i, Unit& u) const {
        const long L = (long)i * G + c; if (L >= nwg) return false;
        int wgid = (int)L; { const int q = nwg / NXCD, r = nwg % NXCD, xcd = wgid % NXCD, off = wgid / NXCD; wgid = (xcd < r ? xcd * (q + 1) : r * (q + 1) + (xcd - r) * q) + off; }
        const int nig = WGM * nN, gid = wgid / nig, fm = gid * WGM, gsz = (nM - fm) < WGM ? (nM - fm) : WGM;
        u.pm = fm + ((wgid % nig) % gsz); u.pn = (wgid % nig) / gsz; u.ks = 0; return true;
    }
    __device__ __forceinline__ void a_ready(const Unit&) const {}
    __device__ __forceinline__ void done(const Unit&) const {}
};
__device__ __forceinline__ unsigned cvt_pk_bf16(float lo, float hi) { unsigned r; asm volatile("v_cvt_pk_bf16_f32 %0, %1, %2" : "=v"(r) : "v"(lo), "v"(hi)); return r; }
typedef float f32x2 __attribute__((ext_vector_type(2)));
__device__ __forceinline__ f32x2 gelu_pk(f32x2 v) {
    const f32x2 av = __builtin_elementwise_abs(v), d = av * 0.2316418882f + 1.0f;
    f32x2 t; t.x = __builtin_amdgcn_rcpf(d.x); t.y = __builtin_amdgcn_rcpf(d.y);
    f32x2 q = t * 0.5307027145f + (-0.7265760135f); q = q * t + 0.7107068705f; q = q * t + (-0.142248368f); q = q * t + 0.127414796f; q = q * t;
    const f32x2 s = (v * v) * (-0.72134752044f);
    f32x2 e; e.x = __builtin_amdgcn_exp2f(s.x); e.y = __builtin_amdgcn_exp2f(s.y);
    const f32x2 m = v * (q * e), r = v - m;
    f32x2 o; o.x = v.x < 0.f ? m.x : r.x; o.y = v.y < 0.f ? m.y : r.y; return o;
}

template <int ACT  > struct EpiBf16 {
    static constexpr bool PERM = true, AFTER_DRAIN = false; static_assert(ACT == 0 || ACT == 1, "EpiBf16: ACT is 0 (none) or 1 (gelu_pk)");
    bf16_t* O; int ldc; const float* bias; int split_cols; size_t split_stride; float scale0;
    __device__ __forceinline__ void operator()(const f32x4 (&acc)[2][2][4][2], const Unit& u, int wr, int wc, int fr, int fq) const {
        const int row0 = u.pm * BM + wr * 64 + fr; int colt = u.pn * BM; bf16_t* base = O;
        float sc = 1.f; if (split_cols) { const int t = colt / split_cols; base += (size_t)t * split_stride; colt -= t * split_cols; if (t == 0) sc = scale0; }
        const int col0 = colt + wc * 32 + 8 * fq, bcol0 = u.pn * BM + wc * 32 + 8 * fq;
        f32x4 bv[2][2];
#pragma unroll
        for (int bj = 0; bj < 2; ++bj)
#pragma unroll
            for (int n = 0; n < 2; ++n) bv[bj][n] = bias ? *(const f32x4*)(bias + bcol0 + bj * HALF + 4 * n) : (f32x4){0.f, 0.f, 0.f, 0.f};
#pragma unroll
        for (int ai = 0; ai < 2; ++ai)
#pragma unroll
            for (int m = 0; m < 4; ++m) { bf16_t* rowp = base + (size_t)(row0 + ai * HALF + m * 16) * ldc + col0;
#pragma unroll
                for (int bj = 0; bj < 2; ++bj) { f32x4 v0 = acc[ai][bj][m][0] + bv[bj][0], v1 = acc[ai][bj][m][1] + bv[bj][1];
                    if (ACT == 1) { f32x2 a = gelu_pk((f32x2){v0[0], v0[1]}), b = gelu_pk((f32x2){v0[2], v0[3]}), c = gelu_pk((f32x2){v1[0], v1[1]}), d = gelu_pk((f32x2){v1[2], v1[3]});
                        v0 = (f32x4){a.x, a.y, b.x, b.y}; v1 = (f32x4){c.x, c.y, d.x, d.y}; }
                    v0 = v0 * sc; v1 = v1 * sc; u32x4 w; w.x = cvt_pk_bf16(v0[0], v0[1]); w.y = cvt_pk_bf16(v0[2], v0[3]); w.z = cvt_pk_bf16(v1[0], v1[1]); w.w = cvt_pk_bf16(v1[2], v1[3]);
                    *(u32x4*)(rowp + bj * HALF) = w; } }
    }
};

struct EpiF32 {
    static constexpr bool PERM = false, AFTER_DRAIN = false;
    float* C; int ldc;
    __device__ __forceinline__ void operator()(const f32x4 (&acc)[2][2][4][2], const Unit& u, int wr, int wc, int fr, int fq) const {
        const int row0 = u.pm * BM + wr * 64 + fr, col0 = u.pn * BM + wc * 32 + 4 * fq;
#pragma unroll
        for (int ai = 0; ai < 2; ++ai)
#pragma unroll
            for (int m = 0; m < 4; ++m) { float* rowp = C + (size_t)(row0 + ai * HALF + m * 16) * ldc + col0;
#pragma unroll
                for (int bj = 0; bj < 2; ++bj)
#pragma unroll
                    for (int n = 0; n < 2; ++n) *(f32x4*)(rowp + bj * HALF + n * 16) = acc[ai][bj][m][n]; }
    }
};
struct EpiGateRes {
    static constexpr bool PERM = false, AFTER_DRAIN = false;
    const float* base; float* out; int ldc; const float* gate; int set_stride; int rows_per_set; int nsets_lat; int lat_rows;
    __device__ __forceinline__ void operator()(const f32x4 (&acc)[2][2][4][2], const Unit& u, int wr, int wc, int fr, int fq) const {
        const int row0 = u.pm * BM + wr * 64 + fr, col0 = u.pn * BM + wc * 32 + 4 * fq;
        const int set = (u.pm * BM >= lat_rows) ? nsets_lat : (u.pm * BM) / rows_per_set;
        const float* gp = gate + (size_t)set * set_stride + col0;
        f32x4 gv[2][2];
#pragma unroll
        for (int bj = 0; bj < 2; ++bj)
#pragma unroll
            for (int n = 0; n < 2; ++n) gv[bj][n] = *(const f32x4*)(gp + bj * HALF + n * 16);
#pragma unroll
        for (int ai = 0; ai < 2; ++ai)
#pragma unroll
            for (int m = 0; m < 4; ++m) { const size_t off = (size_t)(row0 + ai * HALF + m * 16) * ldc + col0;
#pragma unroll
                for (int bj = 0; bj < 2; ++bj)
#pragma unroll
                    for (int n = 0; n < 2; ++n) { const f32x4 b = *(const f32x4*)(base + off + bj * HALF + n * 16); *(f32x4*)(out + off + bj * HALF + n * 16) = b + gv[bj][n] * acc[ai][bj][m][n]; } }
    }
};

struct EpiPart {
    static constexpr bool PERM = false, AFTER_DRAIN = false;
    float* C; int ldc; size_t ks_stride;
    __device__ __forceinline__ void operator()(const f32x4 (&acc)[2][2][4][2], const Unit& u, int wr, int wc, int fr, int fq) const {
        const int row0 = u.pm * BM + wr * 64 + fr, col0 = u.pn * BM + wc * 32 + 4 * fq; float* Cb = C + (size_t)u.ks * ks_stride;
#pragma unroll
        for (int ai = 0; ai < 2; ++ai)
#pragma unroll
            for (int m = 0; m < 4; ++m) { float* rowp = Cb + (size_t)(row0 + ai * HALF + m * 16) * ldc + col0;
#pragma unroll
                for (int bj = 0; bj < 2; ++bj)
#pragma unroll
                    for (int n = 0; n < 2; ++n) *(f32x4*)(rowp + bj * HALF + n * 16) = acc[ai][bj][m][n]; }
    }
};

template <class Epi, class Sched, bool ALIGN_EPI = false, bool SP2 = false>
__device__ __forceinline__ void gemm_phase(PG8_LAS unsigned char* lds, const Gemm g, const Sched& S, const Epi& E, const int tid_in) {
    int tid_ = tid_in; asm volatile("" : "+v"(tid_));
    const int tid = tid_, wid = __builtin_amdgcn_readfirstlane(tid >> 6), lane = tid & 63, wr = wid >> 2, wc = wid & 3, fr = lane & 15, fq = lane >> 4;
    const int K = g.K, nt = K / BK;
    unsigned voffA[2], voffB[2];
#pragma unroll
    for (int i = 0; i < 2; ++i) { int R, C; stage_rc(tid * 16 + i * 8192, R, C); const int Rb = Epi::PERM ? ((R & ~31) + perm32(R & 31)) : R;
        voffA[i] = (unsigned)(R * g.ld + C) * 2u; voffB[i] = (unsigned)(Rb * g.ld + C) * 2u; }
    const size_t kstep = (size_t)(BK * 2);
    const size_t hstep = (size_t)HALF * g.ld * 2;
    const size_t tstep = 2 * hstep;
    const unsigned ldsw = (unsigned)wid * 1024u;
    const int aoff = lds_byte(wr * 64 + fr, fq * 8), boff = lds_byte(wc * 32 + fr, fq * 8);
#define PG8_SA(b, h) (((b) * 2 + (h)) * HTB)
#define PG8_SB(b, h) ((4 + (b) * 2 + (h)) * HTB)
#define PG8_STAGE(bufoff, gbase, voff) do { _Pragma("unroll") for (int _i = 0; _i < 2; ++_i) \
        __builtin_amdgcn_global_load_lds((const unsigned*)((const char*)(gbase) + (voff)[_i]), (PG8_LAS unsigned*)(lds + (bufoff) + ldsw + _i * 8192), 16, 0, 0); } while (0)
#define PG8_LDA(dst, b, h) do { _Pragma("unroll") for (int m = 0; m < 4; ++m) _Pragma("unroll") for (int k = 0; k < 2; ++k) dst[m][k] = *(const PG8_LAS bf16x8*)(lds + PG8_SA(b, h) + aoff + m * 2048 + k * 1024); } while (0)
#define PG8_LDB(dst, b, h) do { _Pragma("unroll") for (int n = 0; n < 2; ++n) _Pragma("unroll") for (int k = 0; k < 2; ++k) dst[n][k] = *(const PG8_LAS bf16x8*)(lds + PG8_SB(b, h) + boff + n * 2048 + k * 1024); } while (0)
#define PG8_MMA(ai, bj, At, Bt) do { __builtin_amdgcn_s_setprio(1); _Pragma("unroll") for (int m = 0; m < 4; ++m) _Pragma("unroll") for (int n = 0; n < 2; ++n) _Pragma("unroll") for (int k = 0; k < 2; ++k) \
        acc[ai][bj][m][n] = __builtin_amdgcn_mfma_f32_16x16x32_bf16(Bt[n][k], At[m][k], acc[ai][bj][m][n], 0, 0, 0); __builtin_amdgcn_s_setprio(0); } while (0)
#define PG8_WAIT_V(n) asm volatile("s_waitcnt vmcnt(" #n ")" ::: "memory")
#define PG8_WAIT_L(n) asm volatile("s_waitcnt lgkmcnt(" #n ")" ::: "memory")
#define PG8_BAR __builtin_amdgcn_s_barrier()
#define PG8_SCHED __builtin_amdgcn_sched_barrier(0)
    Unit cur, nxt; int ui = 0;
    if (!S.next(0, cur)) return;
    f32x4 acc[2][2][4][2];
#pragma unroll
    for (int a = 0; a < 2; ++a)
#pragma unroll
        for (int b = 0; b < 2; ++b)
#pragma unroll
            for (int m = 0; m < 4; ++m)
#pragma unroll
                for (int n = 0; n < 2; ++n) acc[a][b][m][n] = (f32x4){0.f, 0.f, 0.f, 0.f};
    bf16x8 At[4][2], B0[2][2], B1[2][2];
    const size_t ksb = (size_t)K * 2;
    const char* cA = (const char*)g.A + (size_t)cur.pm * tstep + (size_t)cur.ks * ksb; const char* cB = (const char*)g.Bt + (size_t)cur.pn * tstep + (size_t)cur.ks * ksb;
    S.a_ready(cur);
    if constexpr (SP2) {
        PG8_STAGE(PG8_SB(0, 0), cB, voffB); PG8_STAGE(PG8_SB(0, 1), cB + hstep, voffB); PG8_STAGE(PG8_SA(0, 0), cA, voffA); PG8_STAGE(PG8_SA(0, 1), cA + hstep, voffA);
        if (wr == 1) PG8_BAR;
        PG8_WAIT_V(2); PG8_BAR;
        PG8_STAGE(PG8_SB(1, 0), cB + kstep, voffB); PG8_STAGE(PG8_SA(1, 0), cA + kstep, voffA); PG8_STAGE(PG8_SB(1, 1), cB + hstep + kstep, voffB);
        PG8_WAIT_V(6); PG8_BAR;
    } else {
        PG8_STAGE(PG8_SB(0, 0), cB, voffB); PG8_STAGE(PG8_SA(0, 0), cA, voffA); PG8_STAGE(PG8_SB(0, 1), cB + hstep, voffB); PG8_STAGE(PG8_SA(0, 1), cA + hstep, voffA);
        if (wr == 1) PG8_BAR;
        PG8_WAIT_V(4); PG8_BAR;
        PG8_STAGE(PG8_SB(1, 0), cB + kstep, voffB); PG8_STAGE(PG8_SA(1, 0), cA + kstep, voffA); PG8_STAGE(PG8_SB(1, 1), cB + hstep + kstep, voffB);
        PG8_WAIT_V(6); PG8_BAR;
    }
    for (;;) {
        const bool has_next = S.next(ui + 1, nxt);
        const char* nA = has_next ? (const char*)g.A + (size_t)nxt.pm * tstep + (size_t)nxt.ks * ksb : cA; const char* nB = has_next ? (const char*)g.Bt + (size_t)nxt.pn * tstep + (size_t)nxt.ks * ksb : cB;
        for (int t = 0; t < nt; t += 2) {
            const bool last = (t == nt - 2);
            const char* a1 = cA + (size_t)(t + 1) * kstep;
            const char* a2 = last ? nA : cA + (size_t)(t + 2) * kstep; const char* b2 = last ? nB : cB + (size_t)(t + 2) * kstep;
            const char* a3 = a2 + kstep; const char* b3 = b2 + kstep;
            if (last && has_next) S.a_ready(nxt);
            if constexpr (SP2) {
            PG8_LDB(B0, 0, 0); PG8_LDB(B1, 0, 1); PG8_SCHED; PG8_LDA(At, 0, 0); PG8_STAGE(PG8_SA(1, 1), a1 + hstep, voffA);
            PG8_WAIT_V(8); PG8_WAIT_L(0); PG8_BAR; PG8_MMA(0, 0, At, B0); PG8_MMA(0, 1, At, B1); PG8_BAR; PG8_SCHED;
            PG8_LDA(At, 0, 1); PG8_STAGE(PG8_SB(0, 0), b2, voffB); PG8_STAGE(PG8_SB(0, 1), b2 + hstep, voffB); PG8_STAGE(PG8_SA(0, 0), a2, voffA);
            PG8_WAIT_V(8); PG8_WAIT_L(0); PG8_BAR; PG8_MMA(1, 0, At, B0); PG8_MMA(1, 1, At, B1); PG8_BAR; PG8_SCHED;
            PG8_LDB(B0, 1, 0); PG8_LDB(B1, 1, 1); PG8_SCHED; PG8_LDA(At, 1, 0); PG8_STAGE(PG8_SA(0, 1), a2 + hstep, voffA);
            PG8_WAIT_V(8); PG8_WAIT_L(0); PG8_BAR; PG8_MMA(0, 0, At, B0); PG8_MMA(0, 1, At, B1); PG8_BAR; PG8_SCHED;
            PG8_LDA(At, 1, 1); PG8_STAGE(PG8_SB(1, 0), b3, voffB); PG8_STAGE(PG8_SB(1, 1), b3 + hstep, voffB); PG8_STAGE(PG8_SA(1, 0), a3, voffA);
            PG8_WAIT_V(8); PG8_WAIT_L(0); PG8_BAR; PG8_MMA(1, 0, At, B0); PG8_MMA(1, 1, At, B1); PG8_BAR; PG8_SCHED;
            } else {
            PG8_LDB(B0, 0, 0); PG8_SCHED; PG8_LDA(At, 0, 0); PG8_STAGE(PG8_SA(1, 1), a1 + hstep, voffA);
            PG8_WAIT_L(8); PG8_BAR; PG8_WAIT_L(0); PG8_MMA(0, 0, At, B0); PG8_BAR; PG8_SCHED;
            PG8_LDB(B1, 0, 1); PG8_STAGE(PG8_SB(0, 0), b2, voffB);
            PG8_BAR; PG8_WAIT_L(0); PG8_MMA(0, 1, At, B1); PG8_BAR;
            PG8_LDA(At, 0, 1); PG8_STAGE(PG8_SA(0, 0), a2, voffA);
            PG8_BAR; PG8_WAIT_L(0); PG8_MMA(1, 0, At, B0); PG8_BAR; PG8_SCHED;
            PG8_STAGE(PG8_SB(0, 1), b2 + hstep, voffB);
            PG8_WAIT_V(6); PG8_BAR; PG8_MMA(1, 1, At, B1); PG8_BAR;
            PG8_LDB(B0, 1, 0); PG8_SCHED; PG8_LDA(At, 1, 0); PG8_STAGE(PG8_SA(0, 1), a2 + hstep, voffA);
            PG8_WAIT_L(8); PG8_BAR; PG8_WAIT_L(0); PG8_MMA(0, 0, At, B0); PG8_BAR; PG8_SCHED;
            PG8_LDB(B1, 1, 1); PG8_STAGE(PG8_SB(1, 0), b3, voffB);
            PG8_BAR; PG8_WAIT_L(0); PG8_MMA(0, 1, At, B1); PG8_BAR;
            PG8_LDA(At, 1, 1); PG8_STAGE(PG8_SA(1, 0), a3, voffA);
            PG8_BAR; PG8_WAIT_L(0); PG8_MMA(1, 0, At, B0); PG8_BAR; PG8_SCHED;
            PG8_STAGE(PG8_SB(1, 1), b3 + hstep, voffB);
            PG8_WAIT_V(6); PG8_BAR; PG8_MMA(1, 1, At, B1); PG8_BAR;
            }
        }
        if constexpr (ALIGN_EPI) { if (wr == 0) PG8_BAR; }
        if constexpr (!Epi::AFTER_DRAIN) { E(acc, cur, wr, wc, fr, fq); S.done(cur); }
        if (!has_next) break;
#pragma unroll
        for (int a = 0; a < 2; ++a)
#pragma unroll
            for (int b = 0; b < 2; ++b)
#pragma unroll
                for (int m = 0; m < 4; ++m)
#pragma unroll
                    for (int n = 0; n < 2; ++n) acc[a][b][m][n] = (f32x4){0.f, 0.f, 0.f, 0.f};
        cur = nxt; cA = nA; cB = nB; ++ui;
        if constexpr (ALIGN_EPI) { if (wr == 1) PG8_BAR; }
    }
    PG8_WAIT_V(0);
    if constexpr (!ALIGN_EPI) { if (wr == 0) PG8_BAR; }
    PG8_BAR;
    if constexpr (Epi::AFTER_DRAIN) { E.fused(acc, cur, wr, wc, fr, fq, lds, wid, lane); S.done(cur); }
#undef PG8_SA
#undef PG8_SB
#undef PG8_STAGE
#undef PG8_LDA
#undef PG8_LDB
#undef PG8_MMA
#undef PG8_WAIT_V
#undef PG8_WAIT_L
#undef PG8_BAR
#undef PG8_SCHED
}
}

namespace att {
using bf16x8 = __attribute__((ext_vector_type(8))) short;
using s16x4  = __attribute__((ext_vector_type(4))) short;
using f32x16 = __attribute__((ext_vector_type(16))) float;
using u32x4  = __attribute__((ext_vector_type(4))) unsigned;
constexpr int NW = 8, QBLK = 32, KVBLK = 64, DV = 128;
#define ATT_SBAR() __builtin_amdgcn_sched_barrier(0)
__device__ __forceinline__ int crow(int r, int hi) { return (r & 3) + 8 * (r >> 2) + 4 * hi; }
__device__ __forceinline__ unsigned cvtpk(float lo, float hi) { unsigned r; asm volatile("v_cvt_pk_bf16_f32 %0, %1, %2" : "=v"(r) : "v"(lo), "v"(hi)); return r; }
template <int DQK> __device__ __forceinline__ int kswz(int row, int colB) { return row * (DQK * 2) + (colB ^ ((row & 7) << 4)); }
constexpr float THR = 8.f;

template <int DQK> struct Cfg {
    static constexpr int SHM_V = KVBLK * DV * 2, SHM_K = KVBLK * DQK * 2;
    static constexpr int OFF_V = 0, OFF_K = 2 * SHM_V, OFF_WS = OFF_K + 2 * SHM_K, OFF_BIAS = OFF_WS + NW * 64 * 4, LDS_BYTES = OFF_BIAS + 10240;
    static constexpr int KCH = DQK / 8;
    static constexpr int KLD = (64 * KCH) / 512;
};

struct Job {
    const bf16_t* Q;
    const bf16_t* K;
    const bf16_t* V;
    bf16_t* O;
    int nt;
    int seg0_tiles, row_seg0, row_seg1;
    int R0; int rlo;
};

__device__ __forceinline__ int tile_row(const Job& J, int j) {
    if (j < J.seg0_tiles) return J.row_seg0 + 64 * j;
    int jj = j - J.seg0_tiles; if (jj > 3) jj = 0; return J.row_seg1 + 64 * jj;
}

__device__ __forceinline__ void partialSM(f32x16& p0, f32x16& p1, float& m_reg, float& mn, float& alpha, float C, float thr_raw) {
    float pmax = p0[0];
#pragma unroll
    for (int r = 1; r < 16; ++r) pmax = fmaxf(pmax, p0[r]);
#pragma unroll
    for (int r = 0; r < 16; ++r) pmax = fmaxf(pmax, p1[r]);
    { auto rr = __builtin_amdgcn_permlane32_swap(__float_as_uint(pmax), __float_as_uint(pmax), false, false);
      pmax = fmaxf(__uint_as_float(rr[0]), __uint_as_float(rr[1])); }
    if (__builtin_expect(__all(pmax - m_reg <= thr_raw), 1)) { mn = m_reg; alpha = 1.f; }
    else { mn = fmaxf(m_reg, pmax); alpha = __builtin_amdgcn_exp2f((m_reg - mn) * C); m_reg = mn; }
    const float mnC = -mn * C;
#pragma unroll
    for (int r = 0; r < 16; ++r) p0[r] = fmaf(p0[r], C, mnC);
#pragma unroll
    for (int r = 0; r < 16; ++r) p1[r] = fmaf(p1[r], C, mnC);
#pragma unroll
    for (int r = 0; r < 16; ++r) p0[r] = __builtin_amdgcn_exp2f(p0[r]);
}
__device__ __forceinline__ void finishSM(f32x16& p0, f32x16& p1, float alpha, float& l_reg, bf16x8& pa0, bf16x8& pa1, bf16x8& pa2, bf16x8& pa3) {
#pragma unroll
    for (int r = 0; r < 16; ++r) p1[r] = __builtin_amdgcn_exp2f(p1[r]);
    float ps = 0;
#pragma unroll
    for (int r = 0; r < 16; ++r) ps += p0[r];
#pragma unroll
    for (int r = 0; r < 16; ++r) ps += p1[r];
    { auto rr = __builtin_amdgcn_permlane32_swap(__float_as_uint(ps), __float_as_uint(ps), false, false);
      ps = __uint_as_float(rr[0]) + __uint_as_float(rr[1]); }
    l_reg = l_reg * alpha + ps;
#define ATT_PK4(P, BASE, OUT) do { unsigned a0 = cvtpk(P[BASE + 0], P[BASE + 1]), a1 = cvtpk(P[BASE + 2], P[BASE + 3]);   \
    unsigned b0 = cvtpk(P[BASE + 4], P[BASE + 5]), b1 = cvtpk(P[BASE + 6], P[BASE + 7]);                              \
    auto r0 = __builtin_amdgcn_permlane32_swap(a0, b0, false, false); auto r1 = __builtin_amdgcn_permlane32_swap(a1, b1, false, false); \
    u32x4 w = {r0[0], r1[0], r0[1], r1[1]}; OUT = *reinterpret_cast<bf16x8*>(&w); } while (0)
    ATT_PK4(p0, 0, pa0); ATT_PK4(p0, 8, pa1); ATT_PK4(p1, 0, pa2); ATT_PK4(p1, 8, pa3);
#undef ATT_PK4
}
template <int DQK> __device__ __forceinline__ void qkt(f32x16& p0, f32x16& p1, const char* Ks, const bf16x8* qr, int r32, int hi) {
    p0 = f32x16{}; p1 = f32x16{};
#pragma unroll
    for (int d0 = 0; d0 < DQK / 16; ++d0) { const int cb = (d0 * 16 + hi * 8) * 2;
        const bf16x8 b0 = *reinterpret_cast<const bf16x8*>(Ks + kswz<DQK>(r32, cb));
        const bf16x8 b1 = *reinterpret_cast<const bf16x8*>(Ks + kswz<DQK>(32 + r32, cb));
        p0 = __builtin_amdgcn_mfma_f32_32x32x16_bf16(b0, qr[d0], p0, 0, 0, 0);
        p1 = __builtin_amdgcn_mfma_f32_32x32x16_bf16(b1, qr[d0], p1, 0, 0, 0); }
}
__device__ __forceinline__ int v_st(int k, int c) { const int kk = (k & ~0xC) | ((k & 4) << 1) | ((k & 8) >> 1); return ((kk >> 3) * 4 + (c >> 5)) * 512 + ((kk & 7) * 32 + (c & 31)) * 2; }
__device__ __forceinline__ int v_rd_base(int lane) { return ((lane & 3) << 3) | (((lane >> 2) & 3) << 6) | (((lane >> 4) & 1) << 5) | (((lane >> 5) & 1) << 8); }
constexpr int v_rd_off(int d0, int ks, int half) { return d0 * 512 + ks * 4096 + half * 2048; }
template <int OFF> __device__ __forceinline__ s16x4 tr_read(int vb) { s16x4 r; asm volatile("ds_read_b64_tr_b16 %0, %1 offset:%2" : "=&v"(r) : "v"(vb), "i"(OFF) : "memory"); return r; }
template <int D0> __device__ __forceinline__ void pv_one(f32x16& od, int vb, bf16x8 pa0, bf16x8 pa1, bf16x8 pa2, bf16x8 pa3) {
    const s16x4 l0 = tr_read<v_rd_off(D0, 0, 0)>(vb), h0 = tr_read<v_rd_off(D0, 0, 1)>(vb), l1 = tr_read<v_rd_off(D0, 1, 0)>(vb), h1 = tr_read<v_rd_off(D0, 1, 1)>(vb);
    const s16x4 l2 = tr_read<v_rd_off(D0, 2, 0)>(vb), h2 = tr_read<v_rd_off(D0, 2, 1)>(vb), l3 = tr_read<v_rd_off(D0, 3, 0)>(vb), h3 = tr_read<v_rd_off(D0, 3, 1)>(vb);
    asm volatile("s_waitcnt lgkmcnt(0)" ::: "memory"); ATT_SBAR();
#define ATT_PK(L, H) (bf16x8){L[0], L[1], L[2], L[3], H[0], H[1], H[2], H[3]}
    od = __builtin_amdgcn_mfma_f32_32x32x16_bf16(pa0, ATT_PK(l0, h0), od, 0, 0, 0);
    od = __builtin_amdgcn_mfma_f32_32x32x16_bf16(pa1, ATT_PK(l1, h1), od, 0, 0, 0);
    od = __builtin_amdgcn_mfma_f32_32x32x16_bf16(pa2, ATT_PK(l2, h2), od, 0, 0, 0);
    od = __builtin_amdgcn_mfma_f32_32x32x16_bf16(pa3, ATT_PK(l3, h3), od, 0, 0, 0);
#undef ATT_PK
}
__device__ __forceinline__ void pv_d0(f32x16* o, int vb, bf16x8 pa0, bf16x8 pa1, bf16x8 pa2, bf16x8 pa3) {
    pv_one<0>(o[0], vb, pa0, pa1, pa2, pa3); pv_one<1>(o[1], vb, pa0, pa1, pa2, pa3); pv_one<2>(o[2], vb, pa0, pa1, pa2, pa3); pv_one<3>(o[3], vb, pa0, pa1, pa2, pa3);
}
constexpr int NA_BROW = 160, NA_BORG = 64 + (NA_KW - 1);
__device__ __forceinline__ void na_bias(f32x16& p0, f32x16& p1, const Job& J, int j, int R, int c, int hi, const float* biasq) {
    const int nloc = J.seg0_tiles;
    if (j >= nloc && j < nloc + 4) return;
    const int rr = J.rlo + j; int r0 = R - NA_KH / 2; r0 = r0 < 0 ? 0 : (r0 > ROWS - NA_KH ? ROWS - NA_KH : r0);
    const bool rowok = (j < nloc) && rr >= r0 && rr < r0 + NA_KH;
    if (!rowok) {
#pragma unroll
        for (int r = 0; r < 16; ++r) { p0[r] = -1e30f; p1[r] = -1e30f; }
        return; }
    int c0 = c - NA_KW / 2; c0 = c0 < 0 ? 0 : (c0 > GRID_W - NA_KW ? GRID_W - NA_KW : c0);
    const int dr = rr - R + (NA_KH - 1);
    const float* bl = biasq + dr * NA_BROW + NA_BORG + 4 * hi - c;
    const int vb = 4 * hi - c0;
#pragma unroll
    for (int r = 0; r < 16; ++r) { const int cc = (r & 3) + 8 * (r >> 2);
        p0[r] = ((unsigned)(cc + vb) < (unsigned)NA_KW) ? p0[r] + bl[cc] : -1e30f;
        p1[r] = ((unsigned)(cc + 32 + vb) < (unsigned)NA_KW) ? p1[r] + bl[cc + 32] : -1e30f; }
}

#define ATT_LAS __attribute__((address_space(3)))
template <int DQK, bool NA, int LDQ, int LDK, int LDV, int LDO>
__device__ __forceinline__ void attn_unit(const Job& J, char* lds, const float scale, const int tid_in) {
    using C_ = Cfg<DQK>;
    int tid_ = tid_in; asm volatile("" : "+v"(tid_));
    const int tid = tid_, wid = __builtin_amdgcn_readfirstlane(tid >> 6), lane = tid & 63, r32 = lane & 31, hi = lane >> 5;
    char* V_lds = lds + C_::OFF_V; char* K_lds = lds + C_::OFF_K;
    const unsigned ldsb = (unsigned)(uintptr_t)lds;
    float* wsf = (float*)(lds + C_::OFF_WS) + wid * 64; float* li_l = wsf; float* al_l = wsf + 32;
    const float* biasq = (const float*)(lds + C_::OFF_BIAS);
    const float Cc = scale * 1.4426950408889634f, thr_raw = THR / scale;
    float m_reg = -1e5f, l_reg = 0; f32x16 o[4] = {}; bf16x8 qr[DQK / 16];
    const bf16_t* Qw = J.Q + (long)(wid * QBLK + r32) * LDQ + hi * 8;
#pragma unroll
    for (int d0 = 0; d0 < DQK / 16; ++d0) qr[d0] = *reinterpret_cast<const bf16x8*>(Qw + d0 * 16);
    const int naR = J.R0 + (wid >> 1), nac = (wid & 1) * 32 + r32;
    const int vb0 = (int)(uintptr_t)V_lds + v_rd_base(lane);
    unsigned koff[C_::KLD], voff[2];
#pragma unroll
    for (int i = 0; i < C_::KLD; ++i) { const int sl = 512 * i + tid, row = sl / C_::KCH, cs = sl % C_::KCH, chunk = (cs & ~7) | ((cs & 7) ^ (row & 7)); koff[i] = (unsigned)(row * LDK * 2 + chunk * 16); }
#pragma unroll
    for (int i = 0; i < 2; ++i) { const int sl = 512 * i + tid, sub = sl >> 5, wi = sl & 31, kk = (sub >> 2) * 8 + (wi >> 2), k = (kk & ~0xC) | ((kk & 4) << 1) | ((kk & 8) >> 1), c = (sub & 3) * 32 + (wi & 3) * 8;
        voff[i] = (unsigned)(k * LDV * 2 + c * 2); }
#define ATT_STAGE(j, b) do { const int row0_ = tile_row(J, (j)); const char* vp_ = (const char*)(J.V + (size_t)row0_ * LDV); const char* kp_ = (const char*)(J.K + (size_t)row0_ * LDK); \
        _Pragma("unroll") for (int i_ = 0; i_ < C_::KLD; ++i_) __builtin_amdgcn_global_load_lds((const unsigned*)(kp_ + koff[i_]), (ATT_LAS unsigned*)(ldsb + C_::OFF_K + (b) * C_::SHM_K + (512 * i_ + 64 * wid) * 16), 16, 0, 0); \
        _Pragma("unroll") for (int i_ = 0; i_ < 2; ++i_) __builtin_amdgcn_global_load_lds((const unsigned*)(vp_ + voff[i_]), (ATT_LAS unsigned*)(ldsb + C_::OFF_V + (b) * C_::SHM_V + (512 * i_ + 64 * wid) * 16), 16, 0, 0); } while (0)
    const int NT = J.nt;
    __syncthreads();
    ATT_STAGE(0, 0); asm volatile("s_waitcnt vmcnt(0)" ::: "memory"); __syncthreads();
    for (int j = 0; j < NT; ++j) {
        const int buf = j & 1;
        if (j + 1 < NT) ATT_STAGE(j + 1, buf ^ 1);
        f32x16 p0, p1; float mn, al; bf16x8 pa0, pa1, pa2, pa3;
        qkt<DQK>(p0, p1, K_lds + buf * C_::SHM_K, qr, r32, hi);
        if (NA) na_bias(p0, p1, J, j, naR, nac, hi, biasq);
        partialSM(p0, p1, m_reg, mn, al, Cc, thr_raw);
        finishSM(p0, p1, al, l_reg, pa0, pa1, pa2, pa3);
        if (__any(al < 1.f)) { if (hi == 0) al_l[r32] = al; asm volatile("s_waitcnt lgkmcnt(0)" ::: "memory");
#pragma unroll
            for (int d = 0; d < 4; ++d)
#pragma unroll
                for (int r = 0; r < 16; ++r) o[d][r] *= al_l[crow(r, hi)]; }
        ATT_SBAR();
        pv_d0(o, vb0 + buf * C_::SHM_V, pa0, pa1, pa2, pa3);
        asm volatile("s_waitcnt vmcnt(0)" ::: "memory");
        __syncthreads();
    }
    if (hi == 0) li_l[r32] = l_reg; asm volatile("s_waitcnt lgkmcnt(0)" ::: "memory");
    float rli[16];
#pragma unroll
    for (int r = 0; r < 16; ++r) rli[r] = __builtin_amdgcn_rcpf(li_l[crow(r, hi)]);
    bf16_t* Ow = J.O + (long)(wid * QBLK) * LDO;
#pragma unroll
    for (int r = 0; r < 16; ++r) { const int orow = crow(r, hi);
#pragma unroll
        for (int d0 = 0; d0 < 4; ++d0) Ow[(long)orow * LDO + d0 * 32 + r32] = f2bf(o[d0][r] * rli[r]); }
#undef ATT_STAGE
}
}

struct AttnArgs { const bf16_t *QM, *KM, *VM, *NQ, *NK, *P; bf16_t* Y; const float* rpb; int want_ctx; int pad; };
__device__ __forceinline__ void attention_phase(const AttnArgs& A, char* lds, int G, int wg, const int tid) {
    static_assert(GRID_W == 64 && SEQ % 256 == 0 && CTX_LEN == 256 && HD == 128, "attention phase geometry");
    constexpr int NQB = SEQ / 256;
    constexpr float sc_mla = 0.07216878364870323f, sc_na = 0.08838834764831845f;
    static_assert(MLA_QK == 192 && HD == 128, "softmax scales");
    if (!(A.pad & 2)) for (int u = wg; u < BATCH * NH * NQB; u += G) {
        const int bh = u % (BATCH * NH), qb = u / (BATCH * NH), b = bh / NH, h = bh % NH;
        att::Job J{};
        J.Q = A.QM + (size_t)(b * SEQ + qb * 256) * NQ_MLA + h * MLA_QK; J.K = A.KM + h * MLA_QK; J.V = A.VM + h * MLA_V;
        J.O = A.Y + (size_t)(b * SEQ + qb * 256) * D_MODEL + GROUP_W + h * MLA_V;
        J.nt = SEQ / 64 + CTX_LEN / 64; J.seg0_tiles = SEQ / 64; J.row_seg0 = b * SEQ; J.row_seg1 = M_LAT + b * CTX_LEN;
        att::attn_unit<MLA_QK, false, NQ_MLA, NQ_MLA, NH * MLA_V, D_MODEL>(J, lds, sc_mla, tid);
    }
    if (!(A.pad & 4)) for (int u = wg; u < BATCH * NH * NQB; u += G) {
        const int bh = u % (BATCH * NH), qb = u / (BATCH * NH), b = bh / NH, h = bh % NH, R0 = qb * 4;
        __syncthreads();
        { float* bq = (float*)(lds + att::Cfg<HD>::OFF_BIAS); const float* src = A.rpb + (size_t)h * (2 * NA_KH - 1) * (2 * NA_KW - 1);
          for (int i = tid; i < (2 * NA_KH - 1) * att::NA_BROW; i += 512) { const int dr = i / att::NA_BROW; int dc = i % att::NA_BROW - att::NA_BORG + (NA_KW - 1); dc = dc < 0 ? 0 : (dc > 2 * NA_KW - 2 ? 2 * NA_KW - 2 : dc);
              bq[i] = src[dr * (2 * NA_KW - 1) + dc] * 11.313708498984761f; } }
        int rlo = R0 - NA_KH / 2; rlo = rlo < 0 ? 0 : (rlo > ROWS - NA_KH ? ROWS - NA_KH : rlo);
        int rhi = R0 + 3 - NA_KH / 2; rhi = (rhi < 0 ? 0 : (rhi > ROWS - NA_KH ? ROWS - NA_KH : rhi)) + NA_KH - 1;
        const int nloc = rhi - rlo + 1;
        att::Job J{};
        J.Q = A.NQ + (size_t)(b * SEQ + R0 * 64) * GROUP_W + h * HD; J.K = A.NK + h * HD; J.V = A.P + C_NV + h * HD;
        J.O = A.Y + (size_t)(b * SEQ + R0 * 64) * D_MODEL + 3 * GROUP_W + h * HD;
        J.nt = (nloc + 4 + 1) & ~1; J.seg0_tiles = nloc; J.row_seg0 = b * SEQ + rlo * 64; J.row_seg1 = M_LAT + b * CTX_LEN;  J.R0 = R0; J.rlo = rlo;
        att::attn_unit<HD, true, GROUP_W, GROUP_W, NP, D_MODEL>(J, lds, sc_na, tid);
    }
    if (A.want_ctx && !(A.pad & 8)) {
        for (int u = wg; u < BATCH * NH; u += G) {
            const int b = u / NH, h = u % NH; const int crow0 = M_LAT + b * CTX_LEN;
            att::Job J{}; J.nt = CTX_LEN / 64; J.seg0_tiles = 0; J.row_seg0 = crow0; J.row_seg1 = crow0;
            J.Q = A.QM + (size_t)crow0 * NQ_MLA + h * MLA_QK; J.K = A.KM + h * MLA_QK; J.V = A.VM + h * MLA_V;
            J.O = A.Y + (size_t)crow0 * D_MODEL + GROUP_W + h * MLA_V; att::attn_unit<MLA_QK, false, NQ_MLA, NQ_MLA, NH * MLA_V, D_MODEL>(J, lds, sc_mla, tid);
        }
        for (int u = wg - BATCH * NH; u >= 0 && u < BATCH * NH; u += G) {
            const int b = u / NH, h = u % NH; const int crow0 = M_LAT + b * CTX_LEN;
            att::Job J{}; J.nt = CTX_LEN / 64; J.seg0_tiles = 0; J.row_seg0 = crow0; J.row_seg1 = crow0;
            J.Q = A.NQ + (size_t)crow0 * GROUP_W + h * HD; J.K = A.NK + h * HD; J.V = A.P + C_NV + h * HD;
            J.O = A.Y + (size_t)crow0 * D_MODEL + 3 * GROUP_W + h * HD; att::attn_unit<HD, false, GROUP_W, GROUP_W, NP, D_MODEL>(J, lds, sc_na, tid);
        }
    }
}

namespace gdn {
typedef short bf16x8 __attribute__((ext_vector_type(8)));
typedef float f32x4 __attribute__((ext_vector_type(4)));
typedef float f32x16 __attribute__((ext_vector_type(16)));
typedef unsigned u32x2 __attribute__((ext_vector_type(2)));
typedef unsigned u32x4 __attribute__((ext_vector_type(4)));
constexpr int CH = 64, NCHUNK = M_ALL / CH;
constexpr int NTASK = NCHUNK * NH * 2;
constexpr size_t SZ_UT = 128 * 64, SZ_WP = 64 * 128, SZ_KDT = 128 * 64, SZ_QD = 64 * 128, SZ_QK = 64 * 64, SZ_SIT = 128 * 128, SZ_VNT = 128 * 64;
struct Bufs { bf16_t *UT, *WP, *KDT, *QD, *QK, *SIT, *VNT; float* GT; };
__device__ __forceinline__ int perm32(int o) { return (o & ~31) | (((o & 15) >> 2) * 8 + ((o >> 4) & 1) * 4 + (o & 3)); }
__device__ __forceinline__ unsigned pk2(float lo, float hi) { return (unsigned)f2bf(lo) | ((unsigned)f2bf(hi) << 16); }

constexpr int QS = 132;
constexpr int AS = 68;
constexpr int G1_OFF_Q = 0, G1_OFF_K = G1_OFF_Q + CH * QS * 4, G1_OFF_V = G1_OFF_K + CH * QS * 4, G1_OFF_AA = G1_OFF_V + CH * QS * 4, G1_OFF_SM = G1_OFF_AA + 2 * CH * AS * 4,
              G1_LDS = G1_OFF_SM + 12 * 64 * 4;
struct G1Args { const bf16_t* P; const float* conv_w; const float* a_log; const float* dt_bias; Bufs B; int pflags; };

__device__ __forceinline__ void g1_task(const G1Args& A, char* lds, int cix, int h, const int tid_in) {
    int tid_ = tid_in; asm volatile("" : "+v"(tid_));
    const int tid = tid_, wid = __builtin_amdgcn_readfirstlane(tid >> 6), lane = tid & 63;
    float* Qs = (float*)(lds + G1_OFF_Q); float* Ks = (float*)(lds + G1_OFF_K); float* Vs = (float*)(lds + G1_OFF_V); float* AA = (float*)(lds + G1_OFF_AA);
    float* sm = (float*)(lds + G1_OFF_SM); float* g_s = sm;   float* beta_s = sm + 128;   float* gc_s = sm + 256;
    const int row0 = cix * CH; const RowInfo r0i = row_info(row0);
    LDS_BARRIER();
    if (tid < 48 * 8) {
        const int grp = tid % 48, ts = tid / 48, which = grp >> 4, cc0 = (grp & 15) * 8, ch0 = which * GROUP_W + h * HD + cc0;
        float wgt[4][8];
#pragma unroll
        for (int j = 0; j < 4; ++j) { const f32x4 w0 = *(const f32x4*)(A.conv_w + j * 3 * GROUP_W + ch0), w1 = *(const f32x4*)(A.conv_w + j * 3 * GROUP_W + ch0 + 4);
#pragma unroll
            for (int e = 0; e < 4; ++e) { wgt[j][e] = w0[e]; wgt[j][4 + e] = w1[e]; } }
        u32x4 xr[11];
#pragma unroll
        for (int k = 0; k < 11; ++k) { const int tt = r0i.t + 8 * ts + k - 1;
            xr[k] = (tt >= 0 && tt < r0i.T && !(A.pflags & 4096)) ? *(const u32x4*)(A.P + (size_t)(r0i.base + tt) * NP + C_GQ + ch0) : (u32x4){0u, 0u, 0u, 0u}; }
        float* dstp = (which == 0 ? Qs : which == 1 ? Ks : Vs) + cc0;
#pragma unroll
        for (int i = 0; i < 8; ++i) { float acc[8];
#pragma unroll
            for (int e = 0; e < 8; ++e) acc[e] = 0.f;
#pragma unroll
            for (int j = 0; j < 4; ++j) { const u32x4 xv = xr[i + j];
#pragma unroll
                for (int e = 0; e < 4; ++e) { acc[2 * e] += wgt[j][2 * e] * bflo(xv[e]); acc[2 * e + 1] += wgt[j][2 * e + 1] * bfhi(xv[e]); } }
            f32x4 y0, y1;
#pragma unroll
            for (int e = 0; e < 4; ++e) { y0[e] = acc[e] / (1.0f + __expf(-acc[e])); y1[e] = acc[4 + e] / (1.0f + __expf(-acc[4 + e])); }
            *(f32x4*)(dstp + (8 * ts + i) * QS) = y0; *(f32x4*)(dstp + (8 * ts + i) * QS + 4) = y1; }
    }
    if (tid < 128) { const int d = tid >> 6, i = tid & 63; const size_t r = (size_t)(row0 + i) * NP;
        beta_s[d * 64 + i] = 1.0f / (1.0f + __expf(-bf2f(A.P[r + C_GB + d * NH + h])));
        g_s[d * 64 + i] = -__expf(A.a_log[d * NH + h]) * softplusf_(bf2f(A.P[r + C_GA + d * NH + h]) + A.dt_bias[d * NH + h]); }
    LDS_BARRIER();
    for (int rr = wid; rr < 2 * CH; rr += 8) { float* rowp = (rr < CH ? Qs : Ks) + (rr & 63) * QS;
        const float a = rowp[lane], b = rowp[lane + 64]; float ss = a * a + b * b;
#pragma unroll
        for (int o = 1; o < 64; o <<= 1) ss += lane_xor(ss, o, lane);
        const float scl = (1.0f / sqrtf(ss + EPS)) * (rr < CH ? 0.08838834764831845f : 1.0f);
        rowp[lane] = a * scl; rowp[lane + 64] = b * scl; }
    if (tid < 2) {
        f32x4 gv[16];
#pragma unroll
        for (int m = 0; m < 16; ++m) gv[m] = *(const f32x4*)(g_s + tid * 64 + 4 * m);
        float run = 0.f;
        if (tid == 0) {
#pragma unroll
            for (int m = 0; m < 16; ++m) { f32x4 o4;
#pragma unroll
                for (int e = 0; e < 4; ++e) { run += gv[m][e]; o4[e] = run; }
                *(f32x4*)(gc_s + 4 * m) = o4; }
        } else {
#pragma unroll
            for (int m = 15; m >= 0; --m) { f32x4 o4;
#pragma unroll
                for (int e = 3; e >= 0; --e) { run += gv[m][e]; o4[e] = run; }
                *(f32x4*)(gc_s + 64 + 4 * m) = o4; }
        }
    }
    LDS_BARRIER();
    float* eq_s = sm + 384; float* ek_s = sm + 512;
    if (tid < 128) { const int d = tid >> 6, i = tid & 63; const float gci = gc_s[d * 64 + i], glast = d == 0 ? gc_s[63] : gc_s[64];
        eq_s[tid] = __expf(gci); ek_s[tid] = __expf(glast - gci); }
    const int gwhich = wid >> 2, gI = (wid >> 1) & 1, gJ = wid & 1, r32 = lane & 31, hi = lane >> 5;
    f32x16 acc = {};
    if (!(A.pflags & 1024)) {
        const float* X = (gwhich ? Qs : Ks) + (32 * gI + r32) * QS + 4 * hi; const float* Yp = Ks + (32 * gJ + r32) * QS + 4 * hi;
#pragma unroll
        for (int s = 0; s < 16; ++s) { const f32x4 a4 = *(const f32x4*)(X + 8 * s), b4 = *(const f32x4*)(Yp + 8 * s);
#pragma unroll
            for (int e = 0; e < 4; ++e) acc = __builtin_amdgcn_mfma_f32_32x32x2f32(a4[e], b4[e], acc, 0, 0, 0); }
        const int j = 32 * gJ + r32;
        if (gwhich == 0) {
            const float b1j = beta_s[64 + j], g0j = gc_s[j], g1j = gc_s[64 + j];
#pragma unroll
            for (int r = 0; r < 16; ++r) { const int i = 32 * gI + (r & 3) + 8 * (r >> 2) + 4 * hi;
                if (i > j) { const float kk = acc[r];
                    AA[(63 - j) * AS + (63 - i)] = beta_s[i] * kk * __expf(gc_s[i] - g0j);
                    AA[CH * AS + i * AS + j] = b1j * kk * __expf(g1j - gc_s[64 + i]); } }
        }
    }
    LDS_BARRIER();
    const size_t t0 = ((size_t)cix * NH + h) * 2;
    if (!(A.pflags & 2048)) {
#pragma unroll
        for (int n = 0; n < 4; ++n) { const int it = tid + 512 * n, d = it >> 10, p = (it >> 4) & 63, m = it & 15, i = d == 0 ? p : 63 - p, k0 = 32 * (m >> 2) + 4 * (m & 3);
            const float e = eq_s[d * 64 + i]; const f32x4 lo = *(const f32x4*)(Qs + i * QS + k0), hi4 = *(const f32x4*)(Qs + i * QS + k0 + 16);
            *(u32x4*)(A.B.QD + (t0 + d) * SZ_QD + (size_t)p * 128 + m * 8) = (u32x4){pk2(lo[0] * e, lo[1] * e), pk2(lo[2] * e, lo[3] * e), pk2(hi4[0] * e, hi4[1] * e), pk2(hi4[2] * e, hi4[3] * e)}; }
#pragma unroll
        for (int n = 0; n < 4; ++n) { const int it = tid + 512 * n, k = it & 127, d = (it >> 7) & 1, m = it >> 8, p0 = 32 * (m >> 2) + 4 * (m & 3);
            float v[8];
#pragma unroll
            for (int jj = 0; jj < 8; ++jj) { const int p = p0 + (jj < 4 ? jj : 12 + jj), i = d == 0 ? p : 63 - p; v[jj] = Ks[i * QS + k] * ek_s[d * 64 + i]; }
            *(u32x4*)(A.B.KDT + (t0 + d) * SZ_KDT + (size_t)k * 64 + m * 8) = (u32x4){pk2(v[0], v[1]), pk2(v[2], v[3]), pk2(v[4], v[5]), pk2(v[6], v[7])}; }
        if (tid == 0) { A.B.GT[t0] = __expf(gc_s[63]); A.B.GT[t0 + 1] = __expf(gc_s[64]); }
    }
    LDS_BARRIER();
    bf16_t* stg = (bf16_t*)Qs;
    if (gwhich == 1) { const int j = 32 * gJ + r32; const float g0j = gc_s[j], g1j = gc_s[64 + j];
#pragma unroll
        for (int r = 0; r < 16; ++r) { const int i = 32 * gI + (r & 3) + 8 * (r >> 2) + 4 * hi; const float qk = acc[r];
            stg[i * 64 + perm32(j)] = f2bf(i >= j ? qk * __expf(gc_s[i] - g0j) : 0.f);
            stg[4096 + (63 - i) * 64 + perm32(63 - j)] = f2bf(i <= j ? qk * __expf(gc_s[64 + i] - g1j) : 0.f); } }
    LDS_BARRIER();
#pragma unroll
    for (int n = 0; n < 2; ++n) { const int c16 = tid + 512 * n; *(u32x4*)(A.B.QK + t0 * SZ_QK + (size_t)c16 * 8) = *(const u32x4*)(stg + c16 * 8); }
    if (!(A.pflags & 512)) {
        int tidv = tid; asm volatile("" : "+v"(tidv));
        const int d = tidv >> 8, c = tidv & 255; const bool isw = c >= 128; const int cc = c & 127;
        const float* src = isw ? Ks : Vs;
        int lz; asm volatile("v_mov_b32 %0, 0" : "=v"(lz));
        const float* AAv = AA + lz + d * (CH * AS);
        float x[CH];
#pragma unroll
        for (int p = 0; p < CH; ++p) { const int i = d == 0 ? p : 63 - p; float f = beta_s[d * 64 + i]; if (isw) f *= eq_s[d * 64 + i]; x[p] = f * src[i * QS + cc]; }
        {
#pragma unroll
            for (int p = 0; p < CH - 1; ++p) { const float xp = x[p]; const float* rowp = AAv + (63 - p) * AS;
#pragma unroll
                for (int m = 0; m <= (62 - p) / 4; ++m) { const f32x4 a4 = *(const f32x4*)(rowp + 4 * m);
#pragma unroll
                    for (int e = 0; e < 4; ++e) { const int col = 4 * m + e; if (col <= 62 - p) x[63 - col] -= a4[e] * xp; } } }
        }
        LDS_BARRIER();
        if (!isw) { bf16_t* dst = A.B.UT + (t0 + d) * SZ_UT + (size_t)((cc >> 4) * 2 * 64 + (cc & 15)) * 8;
#pragma unroll
            for (int s = 0; s < 2; ++s)
#pragma unroll
                for (int qq = 0; qq < 4; ++qq) { const int p0 = 32 * s + 4 * qq; u32x4 w4; w4.x = pk2(x[p0], x[p0 + 1]); w4.y = pk2(x[p0 + 2], x[p0 + 3]); w4.z = pk2(x[p0 + 16], x[p0 + 17]); w4.w = pk2(x[p0 + 18], x[p0 + 19]);
                    *(u32x4*)(dst + (size_t)(s * 64 + qq * 16) * 8) = w4; }
        } else { bf16_t* dst = stg + d * 8192 + perm32(cc);
#pragma unroll
            for (int p = 0; p < CH; ++p) dst[p * 128] = f2bf(x[p]); }
    }
    LDS_BARRIER();
#pragma unroll
    for (int n = 0; n < 4; ++n) { const int c16 = tid + 512 * n; *(u32x4*)(A.B.WP + t0 * SZ_WP + (size_t)c16 * 8) = *(const u32x4*)(stg + c16 * 8); }
}
__device__ __forceinline__ void g1_phase(const G1Args& A, char* lds, int G, int wg, const int tid) {
    for (int t = wg; t < NCHUNK * NH; t += G) g1_task(A, lds, t / NH, t % NH, tid);
}

constexpr int G2_SPLIT = 4, G2_NACT = 8 / G2_SPLIT, G2_NSTEP = CTX_LEN / CH + SEQ / CH, G2_WGS = BATCH * NH * 2 * G2_SPLIT;
constexpr int G2_USL = G2_NACT * 2 * 64 * 16;
constexpr int G2_BUF = 16384 + 16384 + G2_USL, G2_NB = 4, G2_LDS = G2_NB * G2_BUF;
static_assert(G2_SPLIT == 4 && G2_USL == 4096, "G2 staging map below assumes 4 KB of u per step");
__device__ __forceinline__ int g2_task_index(int b, int h, int d, int step) {
    constexpr int NC = CTX_LEN / CH, NL = SEQ / CH; int cix;
    if (step < NC) { const int n = d ? NC - 1 - step : step; cix = M_LAT / CH + b * NC + n; }
    else { const int s2 = step - NC, n = d ? NL - 1 - s2 : s2; cix = b * NL + n; }
    return (cix * NH + h) * 2 + d;
}
__device__ __forceinline__ void g2_chain(const Bufs& B, char* lds, int chain_part, const int tid_in, const int step_lo, const int step_hi, float* Ssave) {
    int tid_ = tid_in; asm volatile("" : "+v"(tid_));
    const int tid = tid_, wid = __builtin_amdgcn_readfirstlane(tid >> 6), lane = tid & 63, q = lane >> 4, vl = lane & 15;
    const int chain = chain_part / G2_SPLIT, part = chain_part % G2_SPLIT;
    const bool active = wid < G2_NACT; const int vt = part * G2_NACT + (active ? wid : 0);
    const int d = chain & 1, h = (chain >> 1) % NH, b = chain / (2 * NH);
    constexpr int NSTEP = CTX_LEN / CH + SEQ / CH;
    const unsigned ldsb = (unsigned)(uintptr_t)lds;
    f32x4 S[8];
    f32x4* sv = (f32x4*)Ssave + ((size_t)chain_part * G2_NACT + (active ? wid : 0)) * 8 * 64 + lane;
#pragma unroll
    for (int kb = 0; kb < 8; ++kb) S[kb] = (step_lo > 0 && active) ? sv[kb * 64] : (f32x4){0.f, 0.f, 0.f, 0.f};
    unsigned offw[2], offk[2], offu;
#pragma unroll
    for (int i = 0; i < 2; ++i) { const int sl = 128 * wid + 64 * i + lane;
        { const int row = sl >> 4, pc = sl & 15, c = pc ^ (row & 15); offw[i] = (unsigned)(row * 256 + c * 16); }
        { const int row = sl >> 3, pc = sl & 7, c = pc ^ ((row >> 1) & 7); offk[i] = (unsigned)(row * 128 + c * 16); } }
    offu = (unsigned)((part * G2_NACT * 2 * 64 + (wid & 3) * 64 + lane) * 16);
#define G2_DMA(ti, slot) do { const char* wp_ = (const char*)(B.WP + (size_t)(ti) * SZ_WP); const char* kp_ = (const char*)(B.KDT + (size_t)(ti) * SZ_KDT); const unsigned base_ = ldsb + (unsigned)(slot) * G2_BUF; \
        _Pragma("unroll") for (int i_ = 0; i_ < 2; ++i_) { \
            __builtin_amdgcn_global_load_lds((const unsigned*)(wp_ + offw[i_]), (ATT_LAS unsigned*)(base_ + (128 * wid + 64 * i_) * 16), 16, 0, 0); \
            __builtin_amdgcn_global_load_lds((const unsigned*)(kp_ + offk[i_]), (ATT_LAS unsigned*)(base_ + 16384 + (128 * wid + 64 * i_) * 16), 16, 0, 0); } \
        if (wid >= 4) __builtin_amdgcn_global_load_lds((const unsigned*)((const char*)(B.UT + (size_t)(ti) * SZ_UT) + offu), (ATT_LAS unsigned*)(base_ + 32768 + ((wid & 3) * 64) * 16), 16, 0, 0); } while (0)
#define G2_TI(step) g2_task_index(b, h, d, (step) < NSTEP ? (step) : NSTEP - 1)
    __syncthreads();
    G2_DMA(G2_TI(step_lo), step_lo & 3); G2_DMA(G2_TI(step_lo + 1), (step_lo + 1) & 3); G2_DMA(G2_TI(step_lo + 2), (step_lo + 2) & 3);
    asm volatile("s_waitcnt vmcnt(0)" ::: "memory");
    __syncthreads();
    for (int step = step_lo; step < step_hi; ++step) {
        const int ti = G2_TI(step), slot = step & 3;
        G2_DMA(G2_TI(step + 3), (step + 3) & 3);
        unsigned gtb; { const float* gp = B.GT + ti; asm volatile("s_load_dword %0, %1, 0x0" : "=s"(gtb) : "s"(gp)); }
        const char* wl = lds + slot * G2_BUF; const char* kl = wl + 16384; const char* ul = kl + 16384;
        if (active) {
            bf16x8 aw[16], ak[16];
#pragma unroll
            for (int rb = 0; rb < 4; ++rb)
#pragma unroll
                for (int s = 0; s < 4; ++s) aw[rb * 4 + s] = *(const bf16x8*)(wl + (16 * rb + vl) * 256 + (((4 * s + q) ^ vl) << 4));
#pragma unroll
            for (int kb = 0; kb < 8; ++kb)
#pragma unroll
                for (int s = 0; s < 2; ++s) ak[kb * 2 + s] = *(const bf16x8*)(kl + (16 * kb + vl) * 128 + (((4 * s + q) ^ ((vl >> 1) & 7)) << 4));
            u32x4 uu[2];
#pragma unroll
            for (int s = 0; s < 2; ++s) uu[s] = *(const u32x4*)(ul + ((wid * 2 + s) * 64 + lane) * 16);
            bf16_t* sit = B.SIT + (size_t)ti * SZ_SIT + (size_t)(vt * 4 * 64 + lane) * 8;
            bf16x8 sf[4];
#pragma unroll
            for (int s = 0; s < 4; ++s) { u32x4 w4; w4.x = pk2(S[2 * s][0], S[2 * s][1]); w4.y = pk2(S[2 * s][2], S[2 * s][3]); w4.z = pk2(S[2 * s + 1][0], S[2 * s + 1][1]); w4.w = pk2(S[2 * s + 1][2], S[2 * s + 1][3]);
                sf[s] = __builtin_bit_cast(bf16x8, w4); *(u32x4*)(sit + (size_t)s * 64 * 8) = w4; }
            __builtin_amdgcn_sched_barrier(0);
            f32x4 vn[4];
#pragma unroll
            for (int rb = 0; rb < 4; ++rb) vn[rb] = (f32x4){0.f, 0.f, 0.f, 0.f};
#pragma unroll
            for (int s = 0; s < 4; ++s)
#pragma unroll
                for (int rb = 0; rb < 4; ++rb) vn[rb] = __builtin_amdgcn_mfma_f32_16x16x32_bf16(aw[rb * 4 + s], sf[s], vn[rb], 0, 0, 0);
#pragma unroll
            for (int s = 0; s < 2; ++s) { const f32x4 a0 = vn[2 * s], a1 = vn[2 * s + 1];
                vn[2 * s][0] = bflo(uu[s].x) - a0[0]; vn[2 * s][1] = bfhi(uu[s].x) - a0[1]; vn[2 * s][2] = bflo(uu[s].y) - a0[2]; vn[2 * s][3] = bfhi(uu[s].y) - a0[3];
                vn[2 * s + 1][0] = bflo(uu[s].z) - a1[0]; vn[2 * s + 1][1] = bfhi(uu[s].z) - a1[1]; vn[2 * s + 1][2] = bflo(uu[s].w) - a1[2]; vn[2 * s + 1][3] = bfhi(uu[s].w) - a1[3]; }
            bf16_t* vnt = B.VNT + (size_t)ti * SZ_VNT + (size_t)(vt * 2 * 64 + lane) * 8;
            bf16x8 vf[2];
#pragma unroll
            for (int s = 0; s < 2; ++s) { u32x4 w4; w4.x = pk2(vn[2 * s][0], vn[2 * s][1]); w4.y = pk2(vn[2 * s][2], vn[2 * s][3]); w4.z = pk2(vn[2 * s + 1][0], vn[2 * s + 1][1]); w4.w = pk2(vn[2 * s + 1][2], vn[2 * s + 1][3]);
                vf[s] = __builtin_bit_cast(bf16x8, w4); *(u32x4*)(vnt + (size_t)s * 64 * 8) = w4; }
            asm volatile("s_waitcnt lgkmcnt(0)" ::: "memory");
            const float gt = __uint_as_float(gtb);
#pragma unroll
            for (int kb = 0; kb < 8; ++kb) S[kb] = S[kb] * gt;
#pragma unroll
            for (int s = 0; s < 2; ++s)
#pragma unroll
                for (int kb = 0; kb < 8; ++kb) S[kb] = __builtin_amdgcn_mfma_f32_16x16x32_bf16(ak[kb * 2 + s], vf[s], S[kb], 0, 0, 0);
            __builtin_amdgcn_sched_barrier(0);
            asm volatile("s_waitcnt vmcnt(26) lgkmcnt(0)\n\ts_barrier" ::: "memory");
        } else if (wid >= 4) {
            asm volatile("s_waitcnt vmcnt(10) lgkmcnt(0)\n\ts_barrier" ::: "memory");
        } else {
            asm volatile("s_waitcnt vmcnt(8) lgkmcnt(0)\n\ts_barrier" ::: "memory");
        }
    }
    if (step_hi < NSTEP && active) {
#pragma unroll
        for (int kb = 0; kb < 8; ++kb) sv[kb * 64] = S[kb]; }
    asm volatile("s_waitcnt vmcnt(0)" ::: "memory");
    __syncthreads();
#undef G2_DMA
#undef G2_TI
}

constexpr int G3_LDS = 8 * 64 * 4 * 2;
struct G3Args { Bufs B; const bf16_t* P; const float* norm_g; bf16_t* Y; };
__device__ __forceinline__ void g3_task(const G3Args& A, char* lds, int cix, int h, const int tid_in) {
    int tid_ = tid_in; asm volatile("" : "+v"(tid_));
    const int tid = tid_, wid = __builtin_amdgcn_readfirstlane(tid >> 6), lane = tid & 63, q = lane >> 4, vl = lane & 15;
    float* part = (float*)lds;
    f32x4 o[2][4];
#pragma unroll
    for (int d = 0; d < 2; ++d) {
        const size_t t = ((size_t)cix * NH + h) * 2 + d;
        const bf16_t* sit = A.B.SIT + t * SZ_SIT + (size_t)(wid * 4 * 64 + lane) * 8;
        const bf16_t* vnt = A.B.VNT + t * SZ_VNT + (size_t)(wid * 2 * 64 + lane) * 8;
        const bf16_t* qd = A.B.QD + t * SZ_QD + (size_t)vl * 128 + 8 * q;
        const bf16_t* qk = A.B.QK + t * SZ_QK + (size_t)vl * 64 + 8 * q;
        bf16x8 sf[4], vf[2];
#pragma unroll
        for (int s = 0; s < 4; ++s) sf[s] = *(const bf16x8*)(sit + (size_t)s * 64 * 8);
#pragma unroll
        for (int s = 0; s < 2; ++s) vf[s] = *(const bf16x8*)(vnt + (size_t)s * 64 * 8);
#pragma unroll
        for (int rb = 0; rb < 4; ++rb) { f32x4 acc = {0.f, 0.f, 0.f, 0.f};
#pragma unroll
            for (int s = 0; s < 4; ++s) acc = __builtin_amdgcn_mfma_f32_16x16x32_bf16(*(const bf16x8*)(qd + (size_t)rb * 16 * 128 + 32 * s), sf[s], acc, 0, 0, 0);
#pragma unroll
            for (int s = 0; s < 2; ++s) acc = __builtin_amdgcn_mfma_f32_16x16x32_bf16(*(const bf16x8*)(qk + (size_t)rb * 16 * 64 + 32 * s), vf[s], acc, 0, 0, 0);
            o[d][rb] = acc; }
    }
    f32x4 ot[4];
#pragma unroll
    for (int rb = 0; rb < 4; ++rb)
#pragma unroll
        for (int r = 0; r < 4; ++r) ot[rb][r] = o[0][rb][r] + lane_xor(o[1][3 - rb][3 - r], 48, lane);
    LDS_BARRIER();
#pragma unroll
    for (int rb = 0; rb < 4; ++rb)
#pragma unroll
        for (int r = 0; r < 4; ++r) { float ss = ot[rb][r] * ot[rb][r];
#pragma unroll
            for (int of = 1; of < 16; of <<= 1) ss += lane_xor(ss, of, lane);
            if (vl == 0) part[wid * 64 + 16 * rb + 4 * q + r] = ss; }
    LDS_BARRIER();
    const int v = 16 * wid + vl; const float ng = A.norm_g[v];
#pragma unroll
    for (int rb = 0; rb < 4; ++rb)
#pragma unroll
        for (int r = 0; r < 4; ++r) { const int tok = 16 * rb + 4 * q + r; float ss = 0.f;
#pragma unroll
            for (int w8 = 0; w8 < 8; ++w8) ss += part[w8 * 64 + tok];
            const float rstd = 1.0f / sqrtf(ss * (1.0f / HD) + EPS);
            const size_t row = (size_t)cix * CH + tok; const float gate = bf2f(A.P[row * NP + C_GG + h * HD + v]);
            A.Y[row * D_MODEL + 2 * GROUP_W + h * HD + v] = f2bf(ot[rb][r] * rstd * ng * (gate / (1.0f + __expf(-gate)))); }
}
__device__ __forceinline__ void g3_phase(const G3Args& A, char* lds, int G, int wg, const int tid) {
    for (int t = wg; t < NCHUNK * NH; t += G) g3_task(A, lds, t / NH, t % NH, tid);
}
}

namespace lru {
typedef short bf16x8 __attribute__((ext_vector_type(8)));
typedef float f32x4 __attribute__((ext_vector_type(4)));
typedef unsigned u32x2 __attribute__((ext_vector_type(2)));
typedef unsigned u32x4 __attribute__((ext_vector_type(4)));
constexpr int CH = 64, NCHUNK = M_ALL / CH;
constexpr int US = 129;
constexpr int UBS = 272;
constexpr int L_OFF_U = 0, L_OFF_UB = CH * US * 4, L_LDS = L_OFF_UB + CH * UBS;
constexpr size_t SZ_WBLK = (size_t)LRU_BW * LRU_BW;
struct Bufs { bf16_t* HLOC; bf16_t* ACUM; float* LSUM; float* HIN; };
struct LocalArgs { const bf16_t* P; const float* conv_w; const float* conv_b; const bf16_t* WG;   const float* ba; const float* bx; const float* lam; Bufs B; };

__device__ __forceinline__ unsigned pk2(float lo, float hi) { return (unsigned)f2bf(lo) | ((unsigned)f2bf(hi) << 16); }

__device__ __forceinline__ void local_task(const LocalArgs& A, char* lds, int cix, int nb, const int tid_in) {
    int tid_ = tid_in; asm volatile("" : "+v"(tid_));
    const int tid = tid_, wid = __builtin_amdgcn_readfirstlane(tid >> 6), lane = tid & 63, q = lane >> 4, tl = lane & 15;
    float* Us = (float*)(lds + L_OFF_U); char* Ub = lds + L_OFF_UB;
    const int row0 = cix * CH; const RowInfo r0i = row_info(row0);
    LDS_BARRIER();
    {
        const int grp = tid & 15, t2 = tid >> 4, c0 = grp * 8, ch0 = nb * LRU_BW + c0;
        float wgt[4][8], bia[8];
#pragma unroll
        for (int j = 0; j < 4; ++j) { const f32x4 w0 = *(const f32x4*)(A.conv_w + j * LRU_W + ch0), w1 = *(const f32x4*)(A.conv_w + j * LRU_W + ch0 + 4);
#pragma unroll
            for (int e = 0; e < 4; ++e) { wgt[j][e] = w0[e]; wgt[j][4 + e] = w1[e]; } }
        { const f32x4 b0 = *(const f32x4*)(A.conv_b + ch0), b1 = *(const f32x4*)(A.conv_b + ch0 + 4);
#pragma unroll
          for (int e = 0; e < 4; ++e) { bia[e] = b0[e]; bia[4 + e] = b1[e]; } }
        u32x4 xr[5];
#pragma unroll
        for (int k = 0; k < 5; ++k) { const int tt = r0i.t + 2 * t2 + k - 1;
            xr[k] = (tt >= 0 && tt < r0i.T) ? *(const u32x4*)(A.P + (size_t)(r0i.base + tt) * NP + C_LRU_X + ch0) : (u32x4){0u, 0u, 0u, 0u}; }
#pragma unroll
        for (int i = 0; i < 2; ++i) { float acc[8];
#pragma unroll
            for (int e = 0; e < 8; ++e) acc[e] = bia[e];
#pragma unroll
            for (int j = 0; j < 4; ++j) { const u32x4 xv = xr[i + j];
#pragma unroll
                for (int e = 0; e < 4; ++e) { acc[2 * e] += wgt[j][2 * e] * bflo(xv[e]); acc[2 * e + 1] += wgt[j][2 * e + 1] * bfhi(xv[e]); } }
            const int tok = 2 * t2 + i;
#pragma unroll
            for (int e = 0; e < 8; ++e) Us[tok * US + c0 + e] = acc[e];
            *(u32x4*)(Ub + tok * UBS + c0 * 2) = (u32x4){pk2(acc[0], acc[1]), pk2(acc[2], acc[3]), pk2(acc[4], acc[5]), pk2(acc[6], acc[7])}; }
    }
    LDS_BARRIER();
    f32x4 acc[2][2][4];
#pragma unroll
    for (int d = 0; d < 2; ++d)
#pragma unroll
        for (int wh = 0; wh < 2; ++wh)
#pragma unroll
            for (int tb = 0; tb < 4; ++tb) acc[d][wh][tb] = (f32x4){0.f, 0.f, 0.f, 0.f};
#pragma unroll
    for (int s = 0; s < 4; ++s) {
        bf16x8 bfr[4];
#pragma unroll
        for (int tb = 0; tb < 4; ++tb) bfr[tb] = *(const bf16x8*)(Ub + (16 * tb + tl) * UBS + (32 * s + 8 * q) * 2);
#pragma unroll
        for (int d = 0; d < 2; ++d)
#pragma unroll
            for (int wh = 0; wh < 2; ++wh) { const bf16x8 a = *(const bf16x8*)(A.WG + ((size_t)((d * 2 + wh) * NH + nb)) * SZ_WBLK + (size_t)(16 * wid + tl) * LRU_BW + 32 * s + 8 * q);
#pragma unroll
                for (int tb = 0; tb < 4; ++tb) acc[d][wh][tb] = __builtin_amdgcn_mfma_f32_16x16x32_bf16(a, bfr[tb], acc[d][wh][tb], 0, 0, 0); }
    }
    const int chb = nb * LRU_BW + 16 * wid + 4 * q;
#pragma unroll
    for (int d = 0; d < 2; ++d) {
        float sp[4], bav[4], bxv[4];
#pragma unroll
        for (int r = 0; r < 4; ++r) { sp[r] = -LRU_C * softplusf_(-A.lam[d * LRU_W + chb + r]); bav[r] = A.ba[d * LRU_W + chb + r]; bxv[r] = A.bx[d * LRU_W + chb + r]; }
        float Ac[4], Bc[4];
#pragma unroll
        for (int r = 0; r < 4; ++r) { Ac[r] = 1.f; Bc[r] = 0.f; }
#pragma unroll
        for (int tbi = 0; tbi < 4; ++tbi) { const int tb = d == 0 ? tbi : 3 - tbi; const int tok = 16 * tb + tl;
            float a[4], b[4];
#pragma unroll
            for (int r = 0; r < 4; ++r) { const float rr = 1.0f / (1.0f + __expf(-(acc[d][0][tb][r] + bav[r]))), ii = 1.0f / (1.0f + __expf(-(acc[d][1][tb][r] + bxv[r])));
                const float log_a = sp[r] * rr; a[r] = __expf(log_a); b[r] = sqrtf(-expm1f(2.0f * log_a)) * ii * Us[tok * US + 16 * wid + 4 * q + r]; }
#pragma unroll
            for (int off = 1; off < 16; off <<= 1) {
#pragma unroll
                for (int r = 0; r < 4; ++r) { const int src = d == 0 ? tl - off : tl + off; const bool ok = d == 0 ? (tl >= off) : (tl + off < 16);
                    const int sl = (lane & ~15) | (src & 15); const float ap = lane_get(a[r], sl), bp = lane_get(b[r], sl);
                    if (ok) { b[r] = a[r] * bp + b[r]; a[r] = a[r] * ap; } } }
#pragma unroll
            for (int r = 0; r < 4; ++r) { b[r] = a[r] * Bc[r] + b[r]; a[r] = a[r] * Ac[r]; }
            { const size_t o = ((size_t)d * M_ALL + row0 + tok) * LRU_W + chb;
              *(u32x2*)(A.B.HLOC + o) = (u32x2){pk2(b[0], b[1]), pk2(b[2], b[3])}; *(u32x2*)(A.B.ACUM + o) = (u32x2){pk2(a[0], a[1]), pk2(a[2], a[3])}; }
#pragma unroll
            for (int r = 0; r < 4; ++r) { const int sl = (lane & ~15) | (d == 0 ? 15 : 0); Ac[r] = lane_get(a[r], sl); Bc[r] = lane_get(b[r], sl); }
        }
        if (tl == 0) { float* ls = A.B.LSUM + (((size_t)cix * 2 + d) * 2) * LRU_W + chb;
            *(f32x4*)ls = (f32x4){Ac[0], Ac[1], Ac[2], Ac[3]}; *(f32x4*)(ls + LRU_W) = (f32x4){Bc[0], Bc[1], Bc[2], Bc[3]}; }
    }
}
__device__ __forceinline__ void local_phase(const LocalArgs& A, char* lds, int G, int wg, const int tid) {
    for (int j = wg; j < 2 * NCHUNK * NH; j += G) if (j >= NCHUNK * NH) { const int t = j - NCHUNK * NH; local_task(A, lds, t / NH, t % NH, tid); }
}
__device__ __forceinline__ void carry_phase(const Bufs& B, int gtid, int gthreads) {
    constexpr int NC = CTX_LEN / CH, NL = SEQ / CH;
    for (int i = gtid; i < BATCH * 2 * LRU_W; i += gthreads) { const int ch = i % LRU_W, d = (i / LRU_W) & 1, b = i / (2 * LRU_W);
        float h = 0.f;
        for (int s0 = 0; s0 < NC + NL; s0 += 12) {
            float av[12], bv[12]; int cx[12];
#pragma unroll
            for (int u = 0; u < 12; ++u) { const int step = s0 + u; int cix = 0;
                if (step < NC) { const int n = d ? NC - 1 - step : step; cix = M_LAT / CH + b * NC + n; }
                else if (step < NC + NL) { const int s2 = step - NC, n = d ? NL - 1 - s2 : s2; cix = b * NL + n; }
                cx[u] = cix; const float* ls = B.LSUM + (((size_t)cix * 2 + d) * 2) * LRU_W + ch; av[u] = ls[0]; bv[u] = ls[LRU_W]; }
#pragma unroll
            for (int u = 0; u < 12; ++u) if (s0 + u < NC + NL) { B.HIN[((size_t)cx[u] * 2 + d) * LRU_W + ch] = h; h = av[u] * h + bv[u]; }
        }
    }
}
__device__ __forceinline__ void finish_phase(const Bufs& B, const bf16_t* P, bf16_t* Y, int gtid, int gthreads) {
    for (int it = gtid; it < M_ALL * (LRU_W / 8); it += gthreads) { const int row = it / (LRU_W / 8), c0 = (it % (LRU_W / 8)) * 8, cix = row / CH;
        const u32x4 h0 = *(const u32x4*)(B.HLOC + (size_t)row * LRU_W + c0), a0 = *(const u32x4*)(B.ACUM + (size_t)row * LRU_W + c0);
        const u32x4 h1 = *(const u32x4*)(B.HLOC + ((size_t)M_ALL + row) * LRU_W + c0), a1 = *(const u32x4*)(B.ACUM + ((size_t)M_ALL + row) * LRU_W + c0);
        const u32x4 gt = *(const u32x4*)(P + (size_t)row * NP + C_LRU_G + c0);
        const float* i0 = B.HIN + ((size_t)cix * 2 + 0) * LRU_W + c0; const float* i1 = B.HIN + ((size_t)cix * 2 + 1) * LRU_W + c0;
        const f32x4 i0a = *(const f32x4*)i0, i0b = *(const f32x4*)(i0 + 4), i1a = *(const f32x4*)i1, i1b = *(const f32x4*)(i1 + 4);
        float y[8];
#pragma unroll
        for (int j = 0; j < 4; ++j) { const unsigned hw0 = h0[j], aw0 = a0[j], hw1 = h1[j], aw1 = a1[j], gw = gt[j];
            const float in0l = j < 2 ? i0a[2 * j] : i0b[2 * j - 4], in0h = j < 2 ? i0a[2 * j + 1] : i0b[2 * j - 3], in1l = j < 2 ? i1a[2 * j] : i1b[2 * j - 4], in1h = j < 2 ? i1a[2 * j + 1] : i1b[2 * j - 3];
            y[2 * j] = (bflo(hw0) + bflo(aw0) * in0l + bflo(hw1) + bflo(aw1) * in1l) * geluf_(bflo(gw));
            y[2 * j + 1] = (bfhi(hw0) + bfhi(aw0) * in0h + bfhi(hw1) + bfhi(aw1) * in1h) * geluf_(bfhi(gw)); }
        *(u32x4*)(Y + (size_t)row * D_MODEL + c0) = (u32x4){pk2(y[0], y[1]), pk2(y[2], y[3]), pk2(y[4], y[5]), pk2(y[6], y[7])};
    }
}
}

namespace misc {
typedef float f32x4 __attribute__((ext_vector_type(4)));
typedef unsigned u32x2 __attribute__((ext_vector_type(2)));
typedef unsigned u32x4 __attribute__((ext_vector_type(4)));
__device__ __forceinline__ unsigned pk2(float lo, float hi) { return (unsigned)f2bf(lo) | ((unsigned)f2bf(hi) << 16); }
__device__ __forceinline__ float wave_sum(float v, int lane) {
#pragma unroll
    for (int o = 1; o < 64; o <<= 1) v += lane_xor(v, o, lane);
    return v;
}
__device__ __forceinline__ float sum16(float v, int lane) {
#pragma unroll
    for (int o = 1; o < 16; o <<= 1) v += lane_xor(v, o, lane);
    return v;
}
__device__ __forceinline__ void norm_phase(float* H, const float* g, const float* MODl, int sh_idx, bf16_t* U, int nrows, int gwave, int nwaves, int lane,
                                           const float* PART, int nparts, const float* pgate) {
    static_assert(D_MODEL == 2048, "norm_phase geometry");
    for (int r = gwave; r < nrows; r += nwaves) {
        const int set = r < M_LAT ? r / SEQ : BATCH;
        f32x4* hr = (f32x4*)(H + (size_t)r * D_MODEL) + lane;
        f32x4 v[8]; float ss = 0.f;
#pragma unroll
        for (int j = 0; j < 8; ++j) v[j] = hr[64 * j];
        if (PART != nullptr && r >= M_LAT) {
            const f32x4* gp = (const f32x4*)pgate + lane;
#pragma unroll
            for (int j = 0; j < 8; ++j) { f32x4 acc = {0.f, 0.f, 0.f, 0.f};
                for (int s = 0; s < nparts; ++s) acc += *((const f32x4*)(PART + ((size_t)s * M_CTX + (r - M_LAT)) * D_MODEL) + lane + 64 * j);
                v[j] += gp[64 * j] * acc; hr[64 * j] = v[j]; }
        }
#pragma unroll
        for (int j = 0; j < 8; ++j) ss += (v[j][0] * v[j][0] + v[j][1] * v[j][1]) + (v[j][2] * v[j][2] + v[j][3] * v[j][3]);
        const float rstd = 1.0f / sqrtf(wave_sum(ss, lane) * (1.0f / D_MODEL) + EPS);
        const f32x4* gp = (const f32x4*)g + lane; const f32x4* shp = (const f32x4*)(MODl + (size_t)set * NMODV + (size_t)sh_idx * D_MODEL) + lane; const f32x4* scp = shp + D_MODEL / 4;
        u32x2* o = (u32x2*)(U + (size_t)r * D_MODEL) + lane;
#pragma unroll
        for (int j = 0; j < 8; ++j) { const f32x4 gg = gp[64 * j], sh = shp[64 * j], sc = scp[64 * j]; f32x4 y;
#pragma unroll
            for (int e = 0; e < 4; ++e) y[e] = v[j][e] * rstd * gg[e] * (1.0f + sc[e]) + sh[e];
            o[64 * j] = (u32x2){pk2(y[0], y[1]), pk2(y[2], y[3])}; }
    }
}
struct RowNormArgs { const bf16_t* P; const float *qa_g, *kva_g, *na_qn_g, *na_kn_g; bf16_t *CQN, *CKVN, *NQ, *NK; };
__device__ __forceinline__ void rownorm_phase(const RowNormArgs& A, int gwave, int nwaves, int lane) {
    static_assert(MLA_Q_LORA == 384 && MLA_KV_LORA == 256 && GROUP_W == 512 && HD == 128, "rownorm geometry");
    for (int r = gwave; r < M_ALL; r += nwaves) { const bf16_t* p = A.P + (size_t)r * NP;
        { float x[6], ss = 0.f;
#pragma unroll
          for (int j = 0; j < 3; ++j) { const unsigned w = *(const unsigned*)(p + C_CQ + 2 * lane + 128 * j); x[2 * j] = bflo(w); x[2 * j + 1] = bfhi(w); ss += x[2 * j] * x[2 * j] + x[2 * j + 1] * x[2 * j + 1]; }
          const float rstd = 1.0f / sqrtf(wave_sum(ss, lane) * (1.0f / MLA_Q_LORA) + EPS);
#pragma unroll
          for (int j = 0; j < 3; ++j) { const int c = 2 * lane + 128 * j; *(unsigned*)(A.CQN + (size_t)r * MLA_Q_LORA + c) = pk2(x[2 * j] * rstd * A.qa_g[c], x[2 * j + 1] * rstd * A.qa_g[c + 1]); } }
        { float x[4], ss = 0.f;
#pragma unroll
          for (int j = 0; j < 2; ++j) { const unsigned w = *(const unsigned*)(p + C_CKV + 2 * lane + 128 * j); x[2 * j] = bflo(w); x[2 * j + 1] = bfhi(w); ss += x[2 * j] * x[2 * j] + x[2 * j + 1] * x[2 * j + 1]; }
          const float rstd = 1.0f / sqrtf(wave_sum(ss, lane) * (1.0f / MLA_KV_LORA) + EPS);
#pragma unroll
          for (int j = 0; j < 2; ++j) { const int c = 2 * lane + 128 * j; *(unsigned*)(A.CKVN + (size_t)r * MLA_KV_LORA + c) = pk2(x[2 * j] * rstd * A.kva_g[c], x[2 * j + 1] * rstd * A.kva_g[c + 1]); } }
#pragma unroll
        for (int which = 0; which < 2; ++which) {
            const int hh = lane >> 4, d0 = (lane & 15) * 8; const u32x4 w = *(const u32x4*)(p + (which == 0 ? C_NQ : C_NK) + hh * HD + d0);
            float x[8]; float ss = 0.f;
#pragma unroll
            for (int j = 0; j < 4; ++j) { x[2 * j] = bflo(w[j]); x[2 * j + 1] = bfhi(w[j]); ss += x[2 * j] * x[2 * j] + x[2 * j + 1] * x[2 * j + 1]; }
            const float rstd = 1.0f / sqrtf(sum16(ss, lane) * (1.0f / HD) + EPS); const float* g = (which == 0 ? A.na_qn_g : A.na_kn_g) + d0;
            *(u32x4*)((which == 0 ? A.NQ : A.NK) + (size_t)r * GROUP_W + hh * HD + d0) =
                (u32x4){pk2(x[0] * rstd * g[0], x[1] * rstd * g[1]), pk2(x[2] * rstd * g[2], x[3] * rstd * g[3]), pk2(x[4] * rstd * g[4], x[5] * rstd * g[5]), pk2(x[6] * rstd * g[6], x[7] * rstd * g[7])};
        }
    }
}
struct MlaQkvArgs { const float* QR; const float* KVR; const bf16_t* P; const float *qn_g, *kn_g; bf16_t *QM, *KM, *VM; };
__device__ __forceinline__ void mlaqkv_phase(const MlaQkvArgs& A, int gwave, int nwaves, int lane) {
    static_assert(MLA_QK == 192 && MLA_NOPE == 128 && MLA_ROPE == 64 && NH == 4, "mla qkv geometry");
    const int hh = lane >> 4, g = lane & 15;
    const float inv = powf(10000.0f, -(float)g / 16.0f);
    for (int r = gwave; r < M_ALL; r += nwaves) {
        const bool lat = r < M_LAT; const int t = lat ? r % SEQ : 0;
        float cr = 1.f, sr = 0.f, cc = 1.f, sc = 0.f;
        if (lat) { sincosf((float)(t / GRID_W) * inv, &sr, &cr); sincosf((float)(t % GRID_W) * inv, &sc, &cc); }
#pragma unroll
        for (int which = 0; which < 2; ++which) {
            float x[12]; float ss = 0.f;
            if (which == 0) { const float* src = A.QR + (size_t)r * NQ_MLA + hh * MLA_QK + g;
#pragma unroll
                for (int i = 0; i < 12; ++i) x[i] = src[16 * i]; }
            else { const float* src = A.KVR + (size_t)r * NKV_MLA + hh * (MLA_NOPE + MLA_V) + g; const bf16_t* kr = A.P + (size_t)r * NP + C_KR + g;
#pragma unroll
                for (int i = 0; i < 8; ++i) x[i] = src[16 * i];
#pragma unroll
                for (int i = 0; i < 4; ++i) x[8 + i] = bf2f(kr[16 * i]); }
#pragma unroll
            for (int i = 0; i < 12; ++i) ss += x[i] * x[i];
            const float rstd = 1.0f / sqrtf(sum16(ss, lane) * (1.0f / MLA_QK) + EPS); const float* gn = (which == 0 ? A.qn_g : A.kn_g) + g;
#pragma unroll
            for (int i = 0; i < 12; ++i) x[i] = x[i] * rstd * gn[16 * i];
            { const float a0 = x[8], b0 = x[10]; x[8] = a0 * cr - b0 * sr; x[10] = a0 * sr + b0 * cr;
              const float a1 = x[9], b1 = x[11]; x[9] = a1 * cc - b1 * sc; x[11] = a1 * sc + b1 * cc; }
            bf16_t* O = (which == 0 ? A.QM : A.KM) + (size_t)r * NQ_MLA + hh * MLA_QK + g;
#pragma unroll
            for (int i = 0; i < 12; ++i) O[16 * i] = f2bf(x[i]);
        }
        { const float* vs = A.KVR + (size_t)r * NKV_MLA + hh * (MLA_NOPE + MLA_V) + MLA_NOPE + g; bf16_t* O = A.VM + (size_t)r * (NH * MLA_V) + hh * MLA_V + g;
#pragma unroll
          for (int i = 0; i < 8; ++i) O[16 * i] = f2bf(vs[16 * i]); }
    }
}
constexpr int ACT_RUN = 32;
__device__ __forceinline__ void act_phase(const bf16_t* UP, const float* cw, const float* cb, bf16_t* ACT, int nrows, int gtid, int gthreads) {
    constexpr int NC8 = D_FF / 8; static_assert(SEQ % ACT_RUN == 0 && CTX_LEN % ACT_RUN == 0, "row runs stay inside one sequence");
    const int nruns = nrows / ACT_RUN;
    for (long it = gtid; it < (long)nruns * NC8; it += gthreads) { const int run = (int)(it / NC8), j0 = (int)(it % NC8) * 8, r0 = run * ACT_RUN; const RowInfo ri = row_info(r0);
        float wa[3][8], wg[3][8], ba[8], bg[8];
#pragma unroll
        for (int k = 0; k < 3; ++k) { const float* p = cw + (size_t)k * 2 * D_FF + j0; const f32x4 a0 = *(const f32x4*)p, a1 = *(const f32x4*)(p + 4), g0 = *(const f32x4*)(p + D_FF), g1 = *(const f32x4*)(p + D_FF + 4);
#pragma unroll
            for (int e = 0; e < 4; ++e) { wa[k][e] = a0[e]; wa[k][4 + e] = a1[e]; wg[k][e] = g0[e]; wg[k][4 + e] = g1[e]; } }
        { const f32x4 a0 = *(const f32x4*)(cb + j0), a1 = *(const f32x4*)(cb + j0 + 4), g0 = *(const f32x4*)(cb + D_FF + j0), g1 = *(const f32x4*)(cb + D_FF + j0 + 4);
#pragma unroll
          for (int e = 0; e < 4; ++e) { ba[e] = a0[e]; ba[4 + e] = a1[e]; bg[e] = g0[e]; bg[4 + e] = g1[e]; } }
        const u32x4 zero = {0u, 0u, 0u, 0u};
        const bf16_t* ub = UP + (size_t)ri.base * (2 * D_FF) + j0;
        u32x4 am, ac, gm, gc;
        { const int t = ri.t; am = t > 0 ? *(const u32x4*)(ub + (size_t)(t - 1) * (2 * D_FF)) : zero; gm = t > 0 ? *(const u32x4*)(ub + (size_t)(t - 1) * (2 * D_FF) + D_FF) : zero;
          ac = *(const u32x4*)(ub + (size_t)t * (2 * D_FF)); gc = *(const u32x4*)(ub + (size_t)t * (2 * D_FF) + D_FF); }
#pragma unroll 4
        for (int i = 0; i < ACT_RUN; ++i) { const int t = ri.t + i;
            const u32x4 ap = t + 1 < ri.T ? *(const u32x4*)(ub + (size_t)(t + 1) * (2 * D_FF)) : zero, gp = t + 1 < ri.T ? *(const u32x4*)(ub + (size_t)(t + 1) * (2 * D_FF) + D_FF) : zero;
            float y[8];
#pragma unroll
            for (int e = 0; e < 4; ++e) {
                const float a0 = ba[2 * e] + wa[0][2 * e] * bflo(am[e]) + wa[1][2 * e] * bflo(ac[e]) + wa[2][2 * e] * bflo(ap[e]);
                const float a1 = ba[2 * e + 1] + wa[0][2 * e + 1] * bfhi(am[e]) + wa[1][2 * e + 1] * bfhi(ac[e]) + wa[2][2 * e + 1] * bfhi(ap[e]);
                const float g0 = bg[2 * e] + wg[0][2 * e] * bflo(gm[e]) + wg[1][2 * e] * bflo(gc[e]) + wg[2][2 * e] * bflo(gp[e]);
                const float g1 = bg[2 * e + 1] + wg[0][2 * e + 1] * bfhi(gm[e]) + wg[1][2 * e + 1] * bfhi(gc[e]) + wg[2][2 * e + 1] * bfhi(gp[e]);
                y[2 * e] = a0 * (g0 / (1.0f + __expf(-g0))); y[2 * e + 1] = a1 * (g1 / (1.0f + __expf(-g1))); }
            *(u32x4*)(ACT + (size_t)(r0 + i) * D_FF + j0) = (u32x4){pk2(y[0], y[1]), pk2(y[2], y[3]), pk2(y[4], y[5]), pk2(y[6], y[7])};
            am = ac; ac = ap; gm = gc; gc = gp; }
    }
}
__device__ __forceinline__ void transpose_item(const float* W, int K, int N, int Npad, bf16_t* WT, float* scr, int item, int lane) {
    const int nblk = Npad / 32, kb = item / nblk, nb = item % nblk, k0 = 64 * kb, n0 = 32 * nb; const int n = n0 + (lane & 31); const bool ok = n < N;
#pragma unroll 8
    for (int i = 0; i < 32; ++i) { const int kk = 2 * i + (lane >> 5); scr[kk * 33 + (lane & 31)] = ok ? W[(size_t)(k0 + kk) * N + n] : 0.f; }
    asm volatile("s_waitcnt lgkmcnt(0)" ::: "memory");
    const int c = lane & 7;
#pragma unroll
    for (int j = 0; j < 4; ++j) { const int nn = (lane >> 3) + 8 * j; const float* s = scr + (8 * c) * 33 + nn;
        u32x4 o; o.x = pk2(s[0 * 33], s[1 * 33]); o.y = pk2(s[2 * 33], s[3 * 33]); o.z = pk2(s[4 * 33], s[5 * 33]); o.w = pk2(s[6 * 33], s[7 * 33]);
        *(u32x4*)(WT + (size_t)(n0 + nn) * K + k0 + 8 * c) = o; }
    asm volatile("s_waitcnt lgkmcnt(0)" ::: "memory");
}
}

__device__ __forceinline__ gdn::Bufs gdn_bufs(const WS& w, int l) { gdn::Bufs B; B.UT = w.gUT; B.WP = w.gWP; B.KDT = w.gKDT; B.QD = w.gQD; B.QK = w.gQK; B.SIT = w.gSIT; B.VNT = w.gVNT; B.GT = w.gGT + (size_t)l * gdn::NTASK; return B; }
__device__ __forceinline__ lru::Bufs lru_bufs(const WS& w) { lru::Bufs B; B.HLOC = w.lHLOC; B.ACUM = w.lACUM; B.LSUM = w.lLSUM; B.HIN = w.lHIN; return B; }

#define LAS __attribute__((address_space(3)))
#define XB_TMO      128
#define XB_XCNT(j)  (256  + 64 * (j))
#define XB_XSUB(j)  (1280 + 64 * (j))
#define XB_XGEN(j)  (2304 + 64 * (j))
#define XB_TOP      3328
#define XB_TOPGEN   3392
#define XCD_BAR_WORDS 3456
#define XB_SPIN_CAP (1u << 18)
__device__ __forceinline__ unsigned xb_ld(unsigned* p)              { return __hip_atomic_load(p, __ATOMIC_RELAXED, __HIP_MEMORY_SCOPE_AGENT); }
__device__ __forceinline__ unsigned xb_add(unsigned* p, unsigned v) { return __hip_atomic_fetch_add(p, v, __ATOMIC_RELAXED, __HIP_MEMORY_SCOPE_AGENT); }
__device__ __forceinline__ unsigned xb_xcc_id() { return (unsigned)__builtin_amdgcn_s_getreg((3 << 11) | 20) & 0xFu; }
#define XB_SPIN(cond, bar) do { unsigned _sp = 0; while (cond) { __builtin_amdgcn_s_sleep(1); \
    if ((++_sp & 255u) == 0u) { if (xb_ld(&(bar)[XB_TMO])) break; if (_sp > XB_SPIN_CAP) { atomicAdd(&(bar)[XB_TMO], 1u); break; } } } } while (0)
struct XcdBarrier { unsigned* bar; unsigned x; volatile LAS unsigned* st; };
__device__ __forceinline__ XcdBarrier xcd_barrier_post(unsigned* bar, volatile LAS unsigned* st, const bool leader) {
    XcdBarrier b; b.bar = bar; b.x = xb_xcc_id(); b.st = st;
    if (leader) (void)xb_add(&bar[XB_XCNT(b.x)], 1u);
    return b;
}
__device__ __forceinline__ void xcd_barrier_complete(unsigned* bar, unsigned x, unsigned& nloc, unsigned& nx) {
    const unsigned G = gridDim.x * gridDim.y * gridDim.z;
    unsigned sum, cnt, mine, sp = 0u;
    for (;;) {
        sum = 0u; cnt = 0u; mine = 0u;
#pragma unroll
        for (unsigned j = 0; j < 16; ++j) { const unsigned c = xb_ld(&bar[XB_XCNT(j)]); sum += c; cnt += (c > 0u) ? 1u : 0u; mine = (j == x) ? c : mine; }
        if (sum == G) break;
        __builtin_amdgcn_s_sleep(1);
        if ((++sp & 255u) == 0u) { if (xb_ld(&bar[XB_TMO])) break; if (sp > XB_SPIN_CAP) { atomicAdd(&bar[XB_TMO], 1u); break; } }
    }
    nloc = mine > 0u ? mine : 1u; nx = cnt > 0u ? cnt : 1u;
}
__device__ __forceinline__ void xcd_barrier(const XcdBarrier& b, const bool leader) {
    asm volatile("s_waitcnt vmcnt(0)" ::: "memory");
    __syncthreads();
    if (leader) {
        unsigned* bar = b.bar;
        __builtin_amdgcn_s_waitcnt(0);
        unsigned nloc = b.st[0], nx = b.st[1];
        if (nloc == 0u) { xcd_barrier_complete(bar, b.x, nloc, nx); b.st[0] = nloc; b.st[1] = nx; }
        const unsigned old = xb_add(&bar[XB_XSUB(b.x)], 1u);
        const unsigned gen = old / nloc;
        if (old + 1u == (gen + 1u) * nloc) {
            __builtin_amdgcn_fence(__ATOMIC_RELEASE, "agent");
            asm volatile("s_waitcnt vmcnt(0)" ::: "memory");
            const unsigned og = xb_add(&bar[XB_TOP], 1u);
            const unsigned tg = og / nx;
            if (og + 1u == (tg + 1u) * nx) xb_add(&bar[XB_TOPGEN], 1u);
            else XB_SPIN(xb_ld(&bar[XB_TOPGEN]) == tg, bar);
            __builtin_amdgcn_fence(__ATOMIC_ACQUIRE, "agent");
            xb_add(&bar[XB_XGEN(b.x)], 1u);
            asm volatile("s_waitcnt vmcnt(0)" ::: "memory");
        } else {
            XB_SPIN(xb_ld(&bar[XB_XGEN(b.x)]) == gen, bar);
            __builtin_amdgcn_fence(__ATOMIC_ACQUIRE, "agent");
            asm volatile("s_waitcnt vmcnt(0)" ::: "memory");
        }
    }
    __syncthreads();
}

constexpr int NWAVES = 8, NTHR = 512;
constexpr int LDS_MISC = 147456, LDS_BYTES = 148480;
static_assert(sizeof(Inputs) == 34 * 8, "Inputs mirrors Params::in");
static_assert(gdn::G1_LDS <= LDS_MISC && pg8::STAGE_BYTES <= LDS_MISC && att::Cfg<MLA_QK>::LDS_BYTES <= LDS_MISC && gdn::G2_LDS <= LDS_MISC, "LDS map");
constexpr int CW_BAR = 4096;
constexpr int G2_CUT1 = 52, G2_CUT2 = 52;
constexpr int SK_OUT = 4, SK_DOWN = 5;
constexpr int PH_PRO = 0, PH_PER_LAYER = 12, NPH = 1 + PH_PER_LAYER * DEPTH;
struct Params { const float* in[34]; float* out; unsigned char* ws; int ph_lo, ph_hi, li, pad; };

struct SplitOrder {
    int nN, nM, S, G, c;
    __device__ __forceinline__ void init(int M, int N, int S_, int G_, int c_) { nM = M / pg8::BM; nN = N / pg8::BM; S = S_; G = G_; c = c_; }
    __device__ __forceinline__ bool next(int i, pg8::Unit& u) const { const int g = c + i * G; if (g >= nM * nN * S) return false; u.ks = g / (nM * nN); const int loc = g % (nM * nN); u.pm = loc / nN; u.pn = loc % nN; return true; }
    __device__ __forceinline__ void a_ready(const pg8::Unit&) const {}
    __device__ __forceinline__ void done(const pg8::Unit&) const {}
};
struct SpanOrder {
    int nN, lo, hi, G, g0;
    __device__ __forceinline__ void init(int N, int lo_, int hi_, int G_, int c) { nN = N / pg8::BM; lo = lo_; hi = hi_; G = G_; int i0 = 0; if (c < lo_) i0 = (lo_ - c + G_ - 1) / G_; g0 = c + i0 * G_; }
    __device__ __forceinline__ bool next(int i, pg8::Unit& u) const { const int g = g0 + i * G; if (g >= hi) return false; const int loc = g - lo; u.pm = loc / nN; u.pn = loc % nN; u.ks = 0; return true; }
    __device__ __forceinline__ void a_ready(const pg8::Unit&) const {}
    __device__ __forceinline__ void done(const pg8::Unit&) const {}
};

#define AS4 __attribute__((address_space(4)))
#define PHASE_WS const AS4 Params* pp = (const AS4 Params*)__builtin_amdgcn_kernarg_segment_ptr(); asm volatile("" : "+s"(pp)); const AS4 Inputs* I = (const AS4 Inputs*)pp; (void)I; unsigned char* wsb_ = pp->ws; const WS w = ws_carve(wsb_)
#define PHASE_IDS int tid = C_wave0 * 64 + (int)__builtin_amdgcn_mbcnt_hi(~0u, __builtin_amdgcn_mbcnt_lo(~0u, 0u)); asm volatile("" : "+v"(tid)); const int lane = tid & 63, wave = __builtin_amdgcn_readfirstlane(tid >> 6), gwave = wg * NWAVES + wave, gtid = wg * NTHR + tid; (void)lane; (void)gwave; (void)gtid
#ifndef DBG_MASK
#define DBG_MASK 0xFFFFFF
#endif
#define IN(k) (lo <= (k) && (k) < hi)
#define ON(j) (((DBG_MASK) >> (j)) & 1)
#define SEAM(k) do { if (IN(k) && IN((k) + 1)) xcd_barrier(bar, C_wave0 == 0 && __builtin_amdgcn_mbcnt_hi(~0u, __builtin_amdgcn_mbcnt_lo(~0u, 0u)) == 0u); } while (0)

struct LayerCtx { int lo, hi, G, wg, nwaves, gthreads, wave0; XcdBarrier bar; char* lds; unsigned char* lds_raw; };
template <int l> __device__ __forceinline__ void layer_body(const LayerCtx& C) {
    const int lo = C.lo, hi = C.hi, G = C.G, wg = C.wg, nwaves = C.nwaves, gthreads = C.gthreads, C_wave0 = C.wave0; const XcdBarrier& bar = C.bar; char* lds = C.lds; unsigned char* lds_raw = C.lds_raw;
    (void)G; (void)nwaves; (void)gthreads;
        const int pb = 1 + PH_PER_LAYER * l;
        const bool want_ctx = l < DEPTH - 1; const int Mo = want_ctx ? M_ALL : M_LAT;
        if (ON(0) && IN(pb + 0)) { PHASE_WS; PHASE_IDS; const float* MODl = w.MOD + (size_t)l * (BATCH + 1) * NMODV; (void)MODl; misc::norm_phase(w.H, I->norm_mix_g + (size_t)l * D_MODEL, MODl, 0, w.U, M_ALL, gwave, nwaves, lane, l > 0 ? w.PART : nullptr, SK_DOWN, MODl - (size_t)(BATCH + 1) * NMODV + (size_t)BATCH * NMODV + 5 * D_MODEL); }
        SEAM(pb + 0);
        if (ON(1) && IN(pb + 1)) { PHASE_WS; PHASE_IDS; const float* MODl = w.MOD + (size_t)l * (BATCH + 1) * NMODV; (void)MODl; pg8::Gemm g{w.U, w.WIN + l * SZ_WIN, M_ALL, NP, D_MODEL, D_MODEL}; pg8::StaticOrder S; S.init(M_ALL, NP, G, wg);
            pg8::EpiBf16<0> E{w.P, NP, nullptr, 0, 0, 1.0f};
            pg8::gemm_phase<pg8::EpiBf16<0>, pg8::StaticOrder, true, true>((PG8_LAS unsigned char*)lds_raw, g, S, E, tid); }
        SEAM(pb + 1);
        if (ON(2) && IN(pb + 2)) { PHASE_WS; PHASE_IDS; const float* MODl = w.MOD + (size_t)l * (BATCH + 1) * NMODV; (void)MODl;
            const int pflags = pp->pad;
            if (!(pflags & 16)) { gdn::G1Args A; A.P = w.P; A.conv_w = I->gdn_conv_w + (size_t)l * 4 * 3 * GROUP_W; A.a_log = I->gdn_a_log + (size_t)l * 2 * NH; A.dt_bias = I->gdn_dt_bias + (size_t)l * 2 * NH; A.B = gdn_bufs(w, l); A.pflags = pflags;
              gdn::g1_phase(A, lds, G, wg, tid); }
            if (!(pflags & 32)) { lru::LocalArgs A; A.P = w.P; A.conv_w = I->lru_conv_w + (size_t)l * 4 * LRU_W; A.conv_b = I->lru_conv_b + (size_t)l * LRU_W; A.WG = w.WLRU + (size_t)l * 16 * lru::SZ_WBLK;
              A.ba = I->lru_ba + (size_t)l * 2 * LRU_W; A.bx = I->lru_bx + (size_t)l * 2 * LRU_W; A.lam = I->lru_lam + (size_t)l * 2 * LRU_W; A.B = lru_bufs(w);
              lru::local_phase(A, lds, G, wg, tid); }
            if (!(pflags & 64)) { misc::RowNormArgs A; A.P = w.P; A.qa_g = I->mla_qa_g + (size_t)l * MLA_Q_LORA; A.kva_g = I->mla_kva_g + (size_t)l * MLA_KV_LORA; A.na_qn_g = I->na_qn_g + (size_t)l * HD; A.na_kn_g = I->na_kn_g + (size_t)l * HD;
              A.CQN = w.CQN; A.CKVN = w.CKVN; A.NQ = w.NQ; A.NK = w.NK; misc::rownorm_phase(A, gwave, nwaves, lane); }
        }
        SEAM(pb + 2);
        if (ON(3) && IN(pb + 3)) { PHASE_WS; PHASE_IDS; const float* MODl = w.MOD + (size_t)l * (BATCH + 1) * NMODV; (void)MODl;
            if (wg < gdn::G2_WGS) gdn::g2_chain(gdn_bufs(w, l), lds, wg, tid, 0, G2_CUT1, w.gSS);
            else {
            constexpr int UQ = (M_ALL / 256) * (NQ_MLA / 256), UKV = (M_ALL / 256) * (NKV_MLA / 256); const int G2n = G - gdn::G2_WGS, c2 = wg - gdn::G2_WGS;
            { pg8::Gemm g{w.CQN, w.WUQ + l * SZ_WUQ, M_ALL, NQ_MLA, MLA_Q_LORA, MLA_Q_LORA}; SpanOrder S; S.init(NQ_MLA, 0, UQ, G2n, c2); pg8::EpiF32 E{w.QR, NQ_MLA};
              pg8::gemm_phase<pg8::EpiF32, SpanOrder, true, true>((PG8_LAS unsigned char*)lds_raw, g, S, E, tid); }
            { pg8::Gemm g{w.CKVN, w.WUKV + l * SZ_WUKV, M_ALL, NKV_MLA, MLA_KV_LORA, MLA_KV_LORA}; SpanOrder S; S.init(NKV_MLA, UQ, UQ + UKV, G2n, c2); pg8::EpiF32 E{w.KVR, NKV_MLA};
              pg8::gemm_phase<pg8::EpiF32, SpanOrder, true, true>((PG8_LAS unsigned char*)lds_raw, g, S, E, tid); }
            }
        }
        SEAM(pb + 3);
        if (ON(4) && IN(pb + 4)) { PHASE_WS; PHASE_IDS; const float* MODl = w.MOD + (size_t)l * (BATCH + 1) * NMODV; (void)MODl;
            { misc::MlaQkvArgs A; A.QR = w.QR; A.KVR = w.KVR; A.P = w.P; A.qn_g = I->mla_qn_g + (size_t)l * MLA_QK; A.kn_g = I->mla_kn_g + (size_t)l * MLA_QK; A.QM = w.QM; A.KM = w.KM; A.VM = w.VM;
              misc::mlaqkv_phase(A, gwave, nwaves, lane); }
            lru::carry_phase(lru_bufs(w), gtid, gthreads);
        }
        SEAM(pb + 4);
        if (ON(5) && IN(pb + 5)) { PHASE_WS; PHASE_IDS; const float* MODl = w.MOD + (size_t)l * (BATCH + 1) * NMODV; (void)MODl;
            const int pflags = pp->pad;
            if (wg < gdn::G2_WGS && !(pflags & 1)) gdn::g2_chain(gdn_bufs(w, l), lds, wg, tid, G2_CUT2, gdn::G2_NSTEP, w.gSS);
            AttnArgs A; A.QM = w.QM; A.KM = w.KM; A.VM = w.VM; A.NQ = w.NQ; A.NK = w.NK; A.P = w.P; A.Y = w.Y; A.rpb = I->na_rpb + (size_t)l * NH * (2 * NA_KH - 1) * (2 * NA_KW - 1); A.want_ctx = want_ctx ? 1 : 0; A.pad = pflags;
            attention_phase(A, lds, G, wg, tid);
        }
        SEAM(pb + 5);
        if (ON(6) && IN(pb + 6)) { PHASE_WS; PHASE_IDS; const float* MODl = w.MOD + (size_t)l * (BATCH + 1) * NMODV; (void)MODl;
            const int pflags = pp->pad;
            if (!(pflags & 128)) { gdn::G3Args A; A.B = gdn_bufs(w, l); A.P = w.P; A.norm_g = I->gdn_norm_g + (size_t)l * HD; A.Y = w.Y; gdn::g3_phase(A, lds, G, wg, tid); }
            if (!(pflags & 256)) lru::finish_phase(lru_bufs(w), w.P, w.Y, gtid, gthreads);
        }
        SEAM(pb + 6);
        if (ON(7) && IN(pb + 7)) { PHASE_WS; PHASE_IDS; const float* MODl = w.MOD + (size_t)l * (BATCH + 1) * NMODV; (void)MODl;
            { pg8::Gemm g{w.Y, w.WOUT + l * SZ_WOUT, M_LAT, D_MODEL, D_MODEL, D_MODEL}; pg8::StaticOrder S; S.init(M_LAT, D_MODEL, G, wg);
              pg8::EpiGateRes E{w.H, w.H, D_MODEL, MODl + 2 * D_MODEL, NMODV, SEQ, BATCH, M_LAT};
              pg8::gemm_phase<pg8::EpiGateRes, pg8::StaticOrder, true, true>((PG8_LAS unsigned char*)lds_raw, g, S, E, tid); }
            if (want_ctx) { constexpr int SK = SK_OUT;
              pg8::Gemm g{w.Y + (size_t)M_LAT * D_MODEL, w.WOUT + l * SZ_WOUT, M_CTX, D_MODEL, D_MODEL / SK, D_MODEL}; SplitOrder S; S.init(M_CTX, D_MODEL, SK, G, (wg + G / 2) % G);
              pg8::EpiPart E{w.PART, D_MODEL, (size_t)M_CTX * D_MODEL};
              pg8::gemm_phase<pg8::EpiPart, SplitOrder, true, true>((PG8_LAS unsigned char*)lds_raw, g, S, E, tid); } }
        SEAM(pb + 7);
        if (ON(8) && IN(pb + 8)) { PHASE_WS; PHASE_IDS; const float* MODl = w.MOD + (size_t)l * (BATCH + 1) * NMODV; (void)MODl; misc::norm_phase(w.H, I->norm_ffn_g + (size_t)l * D_MODEL, MODl, 3, w.U, Mo, gwave, nwaves, lane, want_ctx ? w.PART : nullptr, SK_OUT, MODl + (size_t)BATCH * NMODV + 2 * D_MODEL); }
        SEAM(pb + 8);
        if (ON(9) && IN(pb + 9)) { PHASE_WS; PHASE_IDS; const float* MODl = w.MOD + (size_t)l * (BATCH + 1) * NMODV; (void)MODl; pg8::Gemm g{w.U, w.WUP + l * SZ_WUP, Mo, 2 * D_FF, D_MODEL, D_MODEL}; pg8::StaticOrder S; S.init(Mo, 2 * D_FF, G, wg);
            pg8::EpiBf16<0> E{w.UP, 2 * D_FF, nullptr, 0, 0, 1.0f};
            pg8::gemm_phase<pg8::EpiBf16<0>, pg8::StaticOrder, true, true>((PG8_LAS unsigned char*)lds_raw, g, S, E, tid); }
        SEAM(pb + 9);
        if (ON(10) && IN(pb + 10)) { PHASE_WS; PHASE_IDS; const float* MODl = w.MOD + (size_t)l * (BATCH + 1) * NMODV; (void)MODl; misc::act_phase(w.UP, I->ffn_conv_w + (size_t)l * 3 * 2 * D_FF, I->ffn_conv_b + (size_t)l * 2 * D_FF, w.ACT, Mo, gtid, gthreads); }
        SEAM(pb + 10);
        if (ON(11) && IN(pb + 11)) { PHASE_WS; PHASE_IDS; const float* MODl = w.MOD + (size_t)l * (BATCH + 1) * NMODV; (void)MODl;
            { pg8::Gemm g{w.ACT, w.WDOWN + l * SZ_WDOWN, M_LAT, D_MODEL, D_FF, D_FF}; pg8::StaticOrder S; S.init(M_LAT, D_MODEL, G, wg);
              pg8::EpiGateRes E{w.H, want_ctx ? w.H : pp->out, D_MODEL, MODl + 5 * D_MODEL, NMODV, SEQ, BATCH, M_LAT};
              pg8::gemm_phase<pg8::EpiGateRes, pg8::StaticOrder, true, true>((PG8_LAS unsigned char*)lds_raw, g, S, E, tid); }
            if (want_ctx) { constexpr int SK = SK_DOWN;
              pg8::Gemm g{w.ACT + (size_t)M_LAT * D_FF, w.WDOWN + l * SZ_WDOWN, M_CTX, D_MODEL, D_FF / SK, D_FF}; SplitOrder S; S.init(M_CTX, D_MODEL, SK, G, (wg + G / 2) % G);
              pg8::EpiPart E{w.PART, D_MODEL, (size_t)M_CTX * D_MODEL};
              pg8::gemm_phase<pg8::EpiPart, SplitOrder, true, true>((PG8_LAS unsigned char*)lds_raw, g, S, E, tid); } }
        SEAM(pb + 11);

}
__global__ void __launch_bounds__(NTHR, 2) fwd(Params p) {
    extern __shared__ __attribute__((aligned(16))) unsigned char lds_raw[];
    char* lds = (char*)lds_raw;
    const int G = (int)gridDim.x, wg = (int)blockIdx.x, nwaves = G * NWAVES, gthreads = G * NTHR;
    const int C_wave0 = __builtin_amdgcn_readfirstlane((int)threadIdx.x >> 6);
    volatile LAS unsigned* MISC = (volatile LAS unsigned*)(lds_raw + LDS_MISC);
    if (threadIdx.x < 32) MISC[threadIdx.x] = 0u;
    __syncthreads();
    const int lo = p.ph_lo, hi = p.ph_hi;
    unsigned* const barw = (unsigned*)p.ws + CW_BAR + (size_t)p.li * XCD_BAR_WORDS;
    XcdBarrier bar; bar.bar = barw; bar.x = 0; bar.st = MISC + 8;
    if (hi - lo > 1) bar = xcd_barrier_post(barw, MISC + 8, threadIdx.x == 0);

    if (ON(12) && IN(PH_PRO)) { PHASE_WS; PHASE_IDS;
        {
            float* SCs = (float*)lds;
            float* red = (float*)(lds + 3 * D_MODEL * 4);
            constexpr int NT = DEPTH * NMODV / 256;
            if (wg < NT) {
                for (int i = tid; i < (BATCH + 1) * D_MODEL; i += NTHR) { const int s = i / D_MODEL, k = i % D_MODEL; const float v = s < BATCH ? I->c[s * D_MODEL + k] : I->c_ctx[k]; SCs[i] = v / (1.0f + __expf(-v)); }
                __syncthreads();
            }
            for (int t = wg; t < NT; t += G) { const int l = t / (NMODV / 256), j0 = (t % (NMODV / 256)) * 256;
                misc::f32x4 acc[3] = {{0.f, 0.f, 0.f, 0.f}, {0.f, 0.f, 0.f, 0.f}, {0.f, 0.f, 0.f, 0.f}};
                const float* wp = I->ada_w + (size_t)l * D_MODEL * NMODV + (size_t)(256 * wave) * NMODV + j0 + 4 * lane;
#pragma unroll 8
                for (int k = 0; k < 256; ++k) { const misc::f32x4 wv = *(const misc::f32x4*)(wp + (size_t)k * NMODV); const int kk = 256 * wave + k;
                    acc[0] += wv * SCs[kk]; acc[1] += wv * SCs[D_MODEL + kk]; acc[2] += wv * SCs[2 * D_MODEL + kk]; }
                __syncthreads();
#pragma unroll
                for (int s = 0; s < 3; ++s) *(misc::f32x4*)(red + (wave * 3 + s) * 256 + 4 * lane) = acc[s];
                __syncthreads();
                for (int i = tid; i < 3 * 256; i += NTHR) { const int s = i / 256, c = i % 256; float sum = I->ada_b[(size_t)l * NMODV + j0 + c];
#pragma unroll
                    for (int w8 = 0; w8 < 8; ++w8) sum += red[(w8 * 3 + s) * 256 + c];
                    w.MOD[((size_t)l * (BATCH + 1) + s) * NMODV + j0 + c] = sum; }
            }
            __syncthreads();
        }
        {
            float* scr = (float*)(lds + wave * 8448);
            constexpr int I_IN = (D_MODEL / 64) * (NP / 32), I_OUT = (D_MODEL / 64) * (D_MODEL / 32), I_UP = (D_MODEL / 64) * (2 * D_FF / 32), I_DN = (D_FF / 64) * (D_MODEL / 32),
                          I_UQ = (MLA_Q_LORA / 64) * (NQ_MLA / 32), I_UKV = (MLA_KV_LORA / 64) * (NKV_MLA / 32), I_LB = (LRU_BW / 64) * (LRU_BW / 32), I_LRU = 2 * 2 * NH * I_LB;
            constexpr int I_LAYER = I_IN + I_OUT + I_UP + I_DN + I_UQ + I_UKV + I_LRU;
            for (int it = gwave; it < DEPTH * I_LAYER; it += nwaves) { const int l = it / I_LAYER; int r = it % I_LAYER;
                if (r < I_IN) { misc::transpose_item(I->w_in + (size_t)l * D_MODEL * IN_COLS, D_MODEL, IN_COLS, NP, w.WIN + l * SZ_WIN, scr, r, lane); continue; } r -= I_IN;
                if (r < I_OUT) { misc::transpose_item(I->w_out + (size_t)l * D_MODEL * D_MODEL, D_MODEL, D_MODEL, D_MODEL, w.WOUT + l * SZ_WOUT, scr, r, lane); continue; } r -= I_OUT;
                if (r < I_UP) { misc::transpose_item(I->ffn_w_up + (size_t)l * D_MODEL * 2 * D_FF, D_MODEL, 2 * D_FF, 2 * D_FF, w.WUP + l * SZ_WUP, scr, r, lane); continue; } r -= I_UP;
                if (r < I_DN) { misc::transpose_item(I->ffn_w_down + (size_t)l * D_FF * D_MODEL, D_FF, D_MODEL, D_MODEL, w.WDOWN + l * SZ_WDOWN, scr, r, lane); continue; } r -= I_DN;
                if (r < I_UQ) { misc::transpose_item(I->mla_w_uq + (size_t)l * MLA_Q_LORA * NQ_MLA, MLA_Q_LORA, NQ_MLA, NQ_MLA, w.WUQ + l * SZ_WUQ, scr, r, lane); continue; } r -= I_UQ;
                if (r < I_UKV) { misc::transpose_item(I->mla_w_ukv + (size_t)l * MLA_KV_LORA * NKV_MLA, MLA_KV_LORA, NKV_MLA, NKV_MLA, w.WUKV + l * SZ_WUKV, scr, r, lane); continue; } r -= I_UKV;
                { const int blk = r / I_LB, item = r % I_LB, d = blk / (2 * NH), wh = (blk / NH) & 1, nb = blk % NH;
                  const float* src = (wh == 0 ? I->lru_wa : I->lru_wx) + ((size_t)(l * 2 + d) * NH + nb) * lru::SZ_WBLK;
                  misc::transpose_item(src, LRU_BW, LRU_BW, LRU_BW, w.WLRU + ((size_t)l * 16 + blk) * lru::SZ_WBLK, scr, item, lane); }
            }
        }
        for (long i = gtid; i < (long)M_ALL * D_MODEL / 4; i += gthreads) { const long e = i * 4;
            ((misc::f32x4*)w.H)[i] = e < (long)M_LAT * D_MODEL ? *(const misc::f32x4*)(I->x + e) : *(const misc::f32x4*)(I->ctx + (e - (long)M_LAT * D_MODEL)); }
    }
    SEAM(PH_PRO);

    { LayerCtx C; C.lo = lo; C.hi = hi; C.G = G; C.wg = wg; C.nwaves = nwaves; C.gthreads = gthreads; C.wave0 = C_wave0; C.bar = bar; C.lds = lds; C.lds_raw = lds_raw;
      static_assert(DEPTH == 4, "layer calls are written out (a real layer loop lets LICM park loop-invariant values in registers across every phase: spills)");
      layer_body<0>(C); layer_body<1>(C); layer_body<2>(C); layer_body<3>(C); }
#undef IN
#undef SEAM
}

#ifndef MK_PHASES_PER_LAUNCH
#define MK_PHASES_PER_LAUNCH NPH
#endif
extern "C" void kernel_launch(void* const* d_in, const int* in_sizes, int n_in, void* d_out, int out_size, void* d_ws, size_t ws_size, hipStream_t stream) {
    static int grid = 0;
    if (grid == 0) {
        int dev = 0, cus = 0;
        if (hipGetDevice(&dev) != hipSuccess || hipDeviceGetAttribute(&cus, hipDeviceAttributeMultiprocessorCount, dev) != hipSuccess || cus <= 0) { fprintf(stderr, "kernel_launch: no device\n"); grid = -1; return; }
        if (hipFuncSetAttribute((const void*)fwd, hipFuncAttributeMaxDynamicSharedMemorySize, LDS_BYTES) != hipSuccess) { fprintf(stderr, "kernel_launch: hipFuncSetAttribute failed\n"); grid = -1; return; }
        int per_cu = 0; if (hipOccupancyMaxActiveBlocksPerMultiprocessor(&per_cu, (const void*)fwd, NTHR, LDS_BYTES) != hipSuccess || per_cu < 1) fprintf(stderr, "kernel_launch: occupancy query says %d blocks per CU\n", per_cu);
        (void)hipGetLastError();
        grid = cus;
        const WS w0 = ws_carve(nullptr);
        if (n_in != 34 || w0.total > ws_size) { fprintf(stderr, "kernel_launch: bad inputs / workspace (need %zu, have %zu)\n", w0.total, ws_size); grid = -1; return; }
    }
    if (grid < 0) return;
    (void)hipMemsetAsync(d_ws, 0, 1 << 20, stream);
    Params p; memset(&p, 0, sizeof(p));
    for (int i = 0; i < 34; ++i) p.in[i] = (const float*)d_in[i];
    p.out = (float*)d_out; p.ws = (unsigned char*)d_ws;
    int li = 0;
    for (int lo = 0; lo < NPH; lo += MK_PHASES_PER_LAUNCH, ++li) {
        p.ph_lo = lo; p.ph_hi = lo + MK_PHASES_PER_LAUNCH < NPH ? lo + MK_PHASES_PER_LAUNCH : NPH; p.li = li;
#if defined(PROBE_MASK)
        if (MK_PHASES_PER_LAUNCH == 1 && ((((PROBE_MASK) >> 12) & 1 && lo == 0) || (lo > 0 && (((PROBE_MASK) >> ((lo - 1) % PH_PER_LAYER)) & 1))))
            { Params q = p;
#if defined(PROBE_FLAGS)
              q.pad = PROBE_FLAGS;
#endif
              for (int r = 0; r < PROBE_REPS; ++r) hipLaunchKernelGGL(fwd, dim3(grid), dim3(NTHR), LDS_BYTES, stream, q); }
#endif
        hipLaunchKernelGGL(fwd, dim3(grid), dim3(NTHR), LDS_BYTES, stream, p);
    }
}
```

```cpp
#include <hip/hip_runtime.h>
#include <cstdio>
#include <cstdint>
#include <cstring>
#include <math.h>
#include <stdint.h>

#ifdef CFG_SMALL
constexpr int D_MODEL = 256, BATCH = 2, SEQ = 512, DEPTH = 2, CTX_LEN = 64, GRID_W = 32, HEAD_DIM = 16;
#else
constexpr int D_MODEL = 2048, BATCH = 2, SEQ = 8192, DEPTH = 4, CTX_LEN = 256, GRID_W = 64, HEAD_DIM = 128;
#endif
constexpr int GROUP_W = D_MODEL / 4, NH = GROUP_W / HEAD_DIM;
constexpr int HD = HEAD_DIM;
constexpr int N_MOD = 6;
constexpr float EPS = 1e-6f;
constexpr int LRU_W = GROUP_W, LRU_BW = LRU_W / NH;
constexpr float LRU_C = 8.0f;
constexpr int MLA_Q_LORA = 3 * D_MODEL / 16, MLA_KV_LORA = D_MODEL / 8, MLA_NOPE = HD, MLA_ROPE = HD / 2, MLA_V = HD, MLA_QK = MLA_NOPE + MLA_ROPE;
constexpr int GDN_CHUNK = 64;
constexpr int NA_KH = 8, NA_KW = 16;
constexpr int D_FF = 5 * D_MODEL / 2;
constexpr int ROWS = SEQ / GRID_W;
constexpr int C_LRU_X = 0, C_LRU_G = C_LRU_X + LRU_W, C_CQ = C_LRU_G + LRU_W, C_CKV = C_CQ + MLA_Q_LORA, C_KR = C_CKV + MLA_KV_LORA,
              C_GQ = C_KR + MLA_ROPE, C_GK = C_GQ + GROUP_W, C_GV = C_GK + GROUP_W, C_GG = C_GV + GROUP_W, C_GB = C_GG + GROUP_W,
              C_GA = C_GB + 2 * NH, C_NQ = C_GA + 2 * NH, C_NK = C_NQ + GROUP_W, C_NV = C_NK + GROUP_W, IN_COLS = C_NV + GROUP_W;
constexpr int NP = (IN_COLS + 255) / 256 * 256;
constexpr int M_LAT = BATCH * SEQ, M_CTX = BATCH * CTX_LEN, M_ALL = M_LAT + M_CTX;
constexpr int NMODV = N_MOD * D_MODEL;

typedef unsigned short bf16_t;
__host__ __device__ __forceinline__ bf16_t f2bf(float f) { union { float f; unsigned u; } v; v.f = f; unsigned u = v.u; u += 0x7fffu + ((u >> 16) & 1u); return (bf16_t)(u >> 16); }
__host__ __device__ __forceinline__ float bf2f(bf16_t b) { union { float f; unsigned u; } v; v.u = ((unsigned)b) << 16; return v.f; }
__host__ __device__ __forceinline__ float sigmoidf_(float x) { return 1.0f / (1.0f + expf(-x)); }
__host__ __device__ __forceinline__ float siluf_(float x) { return x / (1.0f + expf(-x)); }
__host__ __device__ __forceinline__ float softplusf_(float x) { return fmaxf(x, 0.0f) + log1pf(expf(-fabsf(x))); }
__host__ __device__ __forceinline__ float geluf_(float x) { return 0.5f * x * (1.0f + tanhf(0.7978845608028654f * (x + 0.044715f * x * x * x))); }

struct RowInfo { int b, t, T, base, set; };
__host__ __device__ __forceinline__ RowInfo row_info(int r) {
    RowInfo i;
    if (r < M_LAT) { i.b = r / SEQ; i.t = r % SEQ; i.T = SEQ; i.base = i.b * SEQ; i.set = i.b; }
    else { const int rr = r - M_LAT; i.b = rr / CTX_LEN; i.t = rr % CTX_LEN; i.T = CTX_LEN; i.base = M_LAT + i.b * CTX_LEN; i.set = BATCH; }
    return i;
}


__host__ __device__ __forceinline__ float bflo(unsigned w) { union { float f; unsigned u; } v; v.u = w << 16; return v.f; }
__host__ __device__ __forceinline__ float bfhi(unsigned w) { union { float f; unsigned u; } v; v.u = w & 0xffff0000u; return v.f; }
#define LDS_BARRIER() asm volatile("s_waitcnt lgkmcnt(0)\n\ts_barrier" ::: "memory")
__device__ __forceinline__ float lane_xor(float v, int mask, int lane) { return __int_as_float(__builtin_amdgcn_ds_bpermute((lane ^ mask) << 2, __float_as_int(v))); }
__device__ __forceinline__ float lane_get(float v, int src_lane) { return __int_as_float(__builtin_amdgcn_ds_bpermute(src_lane << 2, __float_as_int(v))); }
struct Inputs {
    const float *x, *c, *ctx, *c_ctx, *ada_w, *ada_b, *norm_mix_g, *norm_ffn_g, *w_in, *w_out,
        *lru_conv_w, *lru_conv_b, *lru_wa, *lru_ba, *lru_wx, *lru_bx, *lru_lam,
        *mla_qa_g, *mla_w_uq, *mla_kva_g, *mla_w_ukv, *mla_qn_g, *mla_kn_g,
        *gdn_conv_w, *gdn_a_log, *gdn_dt_bias, *gdn_norm_g, *na_qn_g, *na_kn_g, *na_rpb,
        *ffn_w_up, *ffn_conv_w, *ffn_conv_b, *ffn_w_down;
};
constexpr int NQ_MLA = NH * MLA_QK, NKV_MLA = NH * (MLA_NOPE + MLA_V);
constexpr size_t SZ_WIN = (size_t)NP * D_MODEL, SZ_WOUT = (size_t)D_MODEL * D_MODEL, SZ_WUP = (size_t)2 * D_FF * D_MODEL, SZ_WDOWN = (size_t)D_MODEL * D_FF,
                 SZ_WUQ = (size_t)NQ_MLA * MLA_Q_LORA, SZ_WUKV = (size_t)NKV_MLA * MLA_KV_LORA, SZ_WLRU = (size_t)16 * LRU_BW * LRU_BW;
struct WS {
    unsigned* ctl; float *MOD, *H, *PART; bf16_t *U, *Y;
    bf16_t *WIN, *WOUT, *WUP, *WDOWN, *WUQ, *WUKV, *WLRU;
    bf16_t* P; bf16_t *CQN, *CKVN, *QR, *KVR, *QM, *KM, *VM, *NQ, *NK;
    bf16_t *gUT, *gWP, *gKDT, *gQD, *gQK, *gSIT, *gVNT; float *gGT, *gSS;
    bf16_t *lHLOC, *lACUM; float *lLSUM, *lHIN;
    bf16_t *UP, *ACT;
    size_t total;
};
__host__ __device__ inline WS ws_carve(void* base) {
    WS w; size_t off = 0; char* b = (char*)base;
#define WS_TAKE(T, field, bytes) do { w.field = (T*)(b + off); off += (((size_t)(bytes)) + 255) & ~(size_t)255; } while (0)
    WS_TAKE(unsigned, ctl, 1 << 20);
    WS_TAKE(float, MOD, sizeof(float) * (size_t)DEPTH * (BATCH + 1) * NMODV);
    WS_TAKE(float, H, sizeof(float) * (size_t)M_ALL * D_MODEL);
    WS_TAKE(float, PART, sizeof(float) * (size_t)5 * M_CTX * D_MODEL);
    WS_TAKE(bf16_t, U, 2 * (size_t)M_ALL * D_MODEL);
    WS_TAKE(bf16_t, Y, 2 * (size_t)M_ALL * D_MODEL);
    WS_TAKE(bf16_t, WIN, 2 * SZ_WIN * DEPTH); WS_TAKE(bf16_t, WOUT, 2 * SZ_WOUT * DEPTH); WS_TAKE(bf16_t, WUP, 2 * SZ_WUP * DEPTH); WS_TAKE(bf16_t, WDOWN, 2 * SZ_WDOWN * DEPTH);
    WS_TAKE(bf16_t, WUQ, 2 * SZ_WUQ * DEPTH); WS_TAKE(bf16_t, WUKV, 2 * SZ_WUKV * DEPTH); WS_TAKE(bf16_t, WLRU, 2 * SZ_WLRU * DEPTH);
    const size_t r0 = off;
    WS_TAKE(bf16_t, P, 2 * (size_t)M_ALL * NP);
    WS_TAKE(bf16_t, CQN, 2 * (size_t)M_ALL * MLA_Q_LORA); WS_TAKE(bf16_t, CKVN, 2 * (size_t)M_ALL * MLA_KV_LORA);
    WS_TAKE(bf16_t, QR, 2 * (size_t)M_ALL * NQ_MLA); WS_TAKE(bf16_t, KVR, 2 * (size_t)M_ALL * NKV_MLA);
    WS_TAKE(bf16_t, QM, 2 * (size_t)M_ALL * NQ_MLA); WS_TAKE(bf16_t, KM, 2 * (size_t)M_ALL * NQ_MLA); WS_TAKE(bf16_t, VM, 2 * (size_t)M_ALL * NH * MLA_V);
    WS_TAKE(bf16_t, NQ, 2 * (size_t)M_ALL * GROUP_W); WS_TAKE(bf16_t, NK, 2 * (size_t)M_ALL * GROUP_W);
    { constexpr size_t NT_ = (size_t)(M_ALL / 64) * NH * 2;
      WS_TAKE(bf16_t, gUT, 2 * NT_ * 128 * 64); WS_TAKE(bf16_t, gWP, 2 * NT_ * 64 * 128); WS_TAKE(bf16_t, gKDT, 2 * NT_ * 128 * 64); WS_TAKE(bf16_t, gQD, 2 * NT_ * 64 * 128);
      WS_TAKE(bf16_t, gQK, 2 * NT_ * 64 * 64); WS_TAKE(bf16_t, gSIT, 2 * NT_ * 128 * 128); WS_TAKE(bf16_t, gVNT, 2 * NT_ * 128 * 64); WS_TAKE(float, gGT, 4 * NT_ * DEPTH); WS_TAKE(float, gSS, 4 * (size_t)BATCH * NH * 2 * HD * HD); }
    WS_TAKE(bf16_t, lHLOC, 2 * (size_t)2 * M_ALL * LRU_W); WS_TAKE(bf16_t, lACUM, 2 * (size_t)2 * M_ALL * LRU_W);
    WS_TAKE(float, lLSUM, 4 * (size_t)(M_ALL / 64) * 2 * 2 * LRU_W); WS_TAKE(float, lHIN, 4 * (size_t)(M_ALL / 64) * 2 * LRU_W);
    const size_t r1 = off;
    off = r0;
    WS_TAKE(bf16_t, UP, 2 * (size_t)M_ALL * 2 * D_FF); WS_TAKE(bf16_t, ACT, 2 * (size_t)M_ALL * D_FF);
    const size_t f1 = off;
#undef WS_TAKE
    w.total = r1 > f1 ? r1 : f1;
    return w;
}

namespace pg8 {
#define PG8_LAS __attribute__((address_space(3)))
typedef unsigned short bf16_t;
typedef short bf16x8 __attribute__((ext_vector_type(8)));
typedef float f32x4 __attribute__((ext_vector_type(4)));
typedef unsigned u32x4 __attribute__((ext_vector_type(4)));
constexpr int BM = 256, BK = 64, HALF = 128, HTB = HALF * BK * 2  , STAGE_BYTES = 8 * HTB, NXCD = 8, WGM = 8;

__host__ __device__ __forceinline__ int lds_byte(int r, int c) { const int st = (r >> 4) * 2 + (c >> 5), rr = r & 15, cc = c & 31, ob = rr * 64 + cc * 2; return st * 1024 + (ob ^ (((ob >> 9) & 1) << 5)); }
__host__ __device__ __forceinline__ void stage_rc(int b, int& R, int& C) { const int st = b / 1024, sb = b % 1024, swz = sb ^ (((sb >> 9) & 1) << 5); R = (st >> 1) * 16 + swz / 64; C = (st & 1) * 32 + (swz % 64) / 2; }
__host__ __device__ __forceinline__ int perm32(int rho) { const int n = rho >> 4, i = rho & 15; return 8 * (i >> 2) + 4 * n + (i & 3); }

struct Unit { int pm, pn, ks; };
struct Gemm { const bf16_t* A; const bf16_t* Bt; int M, N, K, ld; };

struct StaticOrder {
    int nM, nN, nwg, G, c;
    __host__ __device__ void init(int M, int N, int G_, int c_) { nM = M / BM; nN = N / BM; nwg = nM * nN; G = G_; c = c_; }
    __host__ __device__ bool next(int i, Unit& u) const {
        const long L = (long)i * G + c; if (L >= nwg) return false;
        int wgid = (int)L; { const int q = nwg / NXCD, r = nwg % NXCD, xcd = wgid % NXCD, off = wgid / NXCD; wgid = (xcd < r ? xcd * (q + 1) : r * (q + 1) + (xcd - r) * q) + off; }
        const int nig = WGM * nN, gid = wgid / nig, fm = gid * WGM, gsz = (nM - fm) < WGM ? (nM - fm) : WGM;
        u.pm = fm + ((wgid % nig) % gsz); u.pn = (wgid % nig) / gsz; u.ks = 0; return true;
    }
    __device__ __forceinline__ void a_ready(const Unit&) const {}
    __device__ __forceinline__ void done(const Unit&) const {}
};
__device__ __forceinline__ unsigned cvt_pk_bf16(float lo, float hi) { unsigned r; asm volatile("v_cvt_pk_bf16_f32 %0, %1, %2" : "=v"(r) : "v"(lo), "v"(hi)); return r; }
typedef float f32x2 __attribute__((ext_vector_type(2)));
__device__ __forceinline__ f32x2 gelu_pk(f32x2 v) {
    const f32x2 av = __builtin_elementwise_abs(v), d = av * 0.2316418882f + 1.0f;
    f32x2 t; t.x = __builtin_amdgcn_rcpf(d.x); t.y = __builtin_amdgcn_rcpf(d.y);
    f32x2 q = t * 0.5307027145f + (-0.7265760135f); q = q * t + 0.7107068705f; q = q * t + (-0.142248368f); q = q * t + 0.127414796f; q = q * t;
    const f32x2 s = (v * v) * (-0.72134752044f);
    f32x2 e; e.x = __builtin_amdgcn_exp2f(s.x); e.y = __builtin_amdgcn_exp2f(s.y);
    const f32x2 m = v * (q * e), r = v - m;
    f32x2 o; o.x = v.x < 0.f ? m.x : r.x; o.y = v.y < 0.f ? m.y : r.y; return o;
}

template <int ACT  > struct EpiBf16 {
    static constexpr bool PERM = true, AFTER_DRAIN = false; static_assert(ACT == 0 || ACT == 1, "EpiBf16: ACT is 0 (none) or 1 (gelu_pk)");
    bf16_t* O; int ldc; const float* bias; int split_cols; size_t split_stride; float scale0;
    __device__ __forceinline__ void operator()(const f32x4 (&acc)[2][2][4][2], const Unit& u, int wr, int wc, int fr, int fq) const {
        const int row0 = u.pm * BM + wr * 64 + fr; int colt = u.pn * BM; bf16_t* base = O;
        float sc = 1.f; if (split_cols) { const int t = colt / split_cols; base += (size_t)t * split_stride; colt -= t * split_cols; if (t == 0) sc = scale0; }
        const int col0 = colt + wc * 32 + 8 * fq, bcol0 = u.pn * BM + wc * 32 + 8 * fq;
        f32x4 bv[2][2];
#pragma unroll
        for (int bj = 0; bj < 2; ++bj)
#pragma unroll
            for (int n = 0; n < 2; ++n) bv[bj][n] = bias ? *(const f32x4*)(bias + bcol0 + bj * HALF + 4 * n) : (f32x4){0.f, 0.f, 0.f, 0.f};
#pragma unroll
        for (int ai = 0; ai < 2; ++ai)
#pragma unroll
            for (int m = 0; m < 4; ++m) { bf16_t* rowp = base + (size_t)(row0 + ai * HALF + m * 16) * ldc + col0;
#pragma unroll
                for (int bj = 0; bj < 2; ++bj) { f32x4 v0 = acc[ai][bj][m][0] + bv[bj][0], v1 = acc[ai][bj][m][1] + bv[bj][1];
                    if (ACT == 1) { f32x2 a = gelu_pk((f32x2){v0[0], v0[1]}), b = gelu_pk((f32x2){v0[2], v0[3]}), c = gelu_pk((f32x2){v1[0], v1[1]}), d = gelu_pk((f32x2){v1[2], v1[3]});
                        v0 = (f32x4){a.x, a.y, b.x, b.y}; v1 = (f32x4){c.x, c.y, d.x, d.y}; }
                    v0 = v0 * sc; v1 = v1 * sc; u32x4 w; w.x = cvt_pk_bf16(v0[0], v0[1]); w.y = cvt_pk_bf16(v0[2], v0[3]); w.z = cvt_pk_bf16(v1[0], v1[1]); w.w = cvt_pk_bf16(v1[2], v1[3]);
                    *(u32x4*)(rowp + bj * HALF) = w; } }
    }
};

struct EpiF32 {
    static constexpr bool PERM = false, AFTER_DRAIN = false;
    float* C; int ldc;
    __device__ __forceinline__ void operator()(const f32x4 (&acc)[2][2][4][2], const Unit& u, int wr, int wc, int fr, int fq) const {
        const int row0 = u.pm * BM + wr * 64 + fr, col0 = u.pn * BM + wc * 32 + 4 * fq;
#pragma unroll
        for (int ai = 0; ai < 2; ++ai)
#pragma unroll
            for (int m = 0; m < 4; ++m) { float* rowp = C + (size_t)(row0 + ai * HALF + m * 16) * ldc + col0;
#pragma unroll
                for (int bj = 0; bj < 2; ++bj)
#pragma unroll
                    for (int n = 0; n < 2; ++n) *(f32x4*)(rowp + bj * HALF + n * 16) = acc[ai][bj][m][n]; }
    }
};
struct EpiGateRes {
    static constexpr bool PERM = false, AFTER_DRAIN = false;
    const float* base; float* out; int ldc; const float* gate; int set_stride; int rows_per_set; int nsets_lat; int lat_rows;
    __device__ __forceinline__ void operator()(const f32x4 (&acc)[2][2][4][2], const Unit& u, int wr, int wc, int fr, int fq) const {
        const int row0 = u.pm * BM + wr * 64 + fr, col0 = u.pn * BM + wc * 32 + 4 * fq;
        const int set = (u.pm * BM >= lat_rows) ? nsets_lat : (u.pm * BM) / rows_per_set;
        const float* gp = gate + (size_t)set * set_stride + col0;
        f32x4 gv[2][2];
#pragma unroll
        for (int bj = 0; bj < 2; ++bj)
#pragma unroll
            for (int n = 0; n < 2; ++n) gv[bj][n] = *(const f32x4*)(gp + bj * HALF + n * 16);
#pragma unroll
        for (int ai = 0; ai < 2; ++ai)
#pragma unroll
            for (int m = 0; m < 4; ++m) { const size_t off = (size_t)(row0 + ai * HALF + m * 16) * ldc + col0;
#pragma unroll
                for (int bj = 0; bj < 2; ++bj)
#pragma unroll
                    for (int n = 0; n < 2; ++n) { const f32x4 b = *(const f32x4*)(base + off + bj * HALF + n * 16); *(f32x4*)(out + off + bj * HALF + n * 16) = b + gv[bj][n] * acc[ai][bj][m][n]; } }
    }
};

struct EpiPart {
    static constexpr bool PERM = false, AFTER_DRAIN = false;
    float* C; int ldc; size_t ks_stride;
    __device__ __forceinline__ void operator()(const f32x4 (&acc)[2][2][4][2], const Unit& u, int wr, int wc, int fr, int fq) const {
        const int row0 = u.pm * BM + wr * 64 + fr, col0 = u.pn * BM + wc * 32 + 4 * fq; float* Cb = C + (size_t)u.ks * ks_stride;
#pragma unroll
        for (int ai = 0; ai < 2; ++ai)
#pragma unroll
            for (int m = 0; m < 4; ++m) { float* rowp = Cb + (size_t)(row0 + ai * HALF + m * 16) * ldc + col0;
#pragma unroll
                for (int bj = 0; bj < 2; ++bj)
#pragma unroll
                    for (int n = 0; n < 2; ++n) *(f32x4*)(rowp + bj * HALF + n * 16) = acc[ai][bj][m][n]; }
    }
};

template <class Epi, class Sched, bool ALIGN_EPI = false, bool SP2 = false>
__device__ __forceinline__ void gemm_phase(PG8_LAS unsigned char* lds, const Gemm g, const Sched& S, const Epi& E, const int tid_in) {
    int tid_ = tid_in; asm volatile("" : "+v"(tid_));
    const int tid = tid_, wid = __builtin_amdgcn_readfirstlane(tid >> 6), lane = tid & 63, wr = wid >> 2, wc = wid & 3, fr = lane & 15, fq = lane >> 4;
    const int K = g.K, nt = K / BK;
    unsigned voffA[2], voffB[2];
#pragma unroll
    for (int i = 0; i < 2; ++i) { int R, C; stage_rc(tid * 16 + i * 8192, R, C); const int Rb = Epi::PERM ? ((R & ~31) + perm32(R & 31)) : R;
        voffA[i] = (unsigned)(R * g.ld + C) * 2u; voffB[i] = (unsigned)(Rb * g.ld + C) * 2u; }
    const size_t kstep = (size_t)(BK * 2);
    const size_t hstep = (size_t)HALF * g.ld * 2;
    const size_t tstep = 2 * hstep;
    const unsigned ldsw = (unsigned)wid * 1024u;
    const int aoff = lds_byte(wr * 64 + fr, fq * 8), boff = lds_byte(wc * 32 + fr, fq * 8);
#define PG8_SA(b, h) (((b) * 2 + (h)) * HTB)
#define PG8_SB(b, h) ((4 + (b) * 2 + (h)) * HTB)
#define PG8_STAGE(bufoff, gbase, voff) do { _Pragma("unroll") for (int _i = 0; _i < 2; ++_i) \
        __builtin_amdgcn_global_load_lds((const unsigned*)((const char*)(gbase) + (voff)[_i]), (PG8_LAS unsigned*)(lds + (bufoff) + ldsw + _i * 8192), 16, 0, 0); } while (0)
#define PG8_LDA(dst, b, h) do { _Pragma("unroll") for (int m = 0; m < 4; ++m) _Pragma("unroll") for (int k = 0; k < 2; ++k) dst[m][k] = *(const PG8_LAS bf16x8*)(lds + PG8_SA(b, h) + aoff + m * 2048 + k * 1024); } while (0)
#define PG8_LDB(dst, b, h) do { _Pragma("unroll") for (int n = 0; n < 2; ++n) _Pragma("unroll") for (int k = 0; k < 2; ++k) dst[n][k] = *(const PG8_LAS bf16x8*)(lds + PG8_SB(b, h) + boff + n * 2048 + k * 1024); } while (0)
#define PG8_MMA(ai, bj, At, Bt) do { __builtin_amdgcn_s_setprio(1); _Pragma("unroll") for (int m = 0; m < 4; ++m) _Pragma("unroll") for (int n = 0; n < 2; ++n) _Pragma("unroll") for (int k = 0; k < 2; ++k) \
        acc[ai][bj][m][n] = __builtin_amdgcn_mfma_f32_16x16x32_bf16(Bt[n][k], At[m][k], acc[ai][bj][m][n], 0, 0, 0); __builtin_amdgcn_s_setprio(0); } while (0)
#define PG8_WAIT_V(n) asm volatile("s_waitcnt vmcnt(" #n ")" ::: "memory")
#define PG8_WAIT_L(n) asm volatile("s_waitcnt lgkmcnt(" #n ")" ::: "memory")
#define PG8_BAR __builtin_amdgcn_s_barrier()
#define PG8_SCHED __builtin_amdgcn_sched_barrier(0)
    Unit cur, nxt; int ui = 0;
    if (!S.next(0, cur)) return;
    f32x4 acc[2][2][4][2];
#pragma unroll
    for (int a = 0; a < 2; ++a)
#pragma unroll
        for (int b = 0; b < 2; ++b)
#pragma unroll
            for (int m = 0; m < 4; ++m)
#pragma unroll
                for (int n = 0; n < 2; ++n) acc[a][b][m][n] = (f32x4){0.f, 0.f, 0.f, 0.f};
    bf16x8 At[4][2], B0[2][2], B1[2][2];
    const size_t ksb = (size_t)K * 2;
    const char* cA = (const char*)g.A + (size_t)cur.pm * tstep + (size_t)cur.ks * ksb; const char* cB = (const char*)g.Bt + (size_t)cur.pn * tstep + (size_t)cur.ks * ksb;
    S.a_ready(cur);
    if constexpr (SP2) {
        PG8_STAGE(PG8_SB(0, 0), cB, voffB); PG8_STAGE(PG8_SB(0, 1), cB + hstep, voffB); PG8_STAGE(PG8_SA(0, 0), cA, voffA); PG8_STAGE(PG8_SA(0, 1), cA + hstep, voffA);
        if (wr == 1) PG8_BAR;
        PG8_WAIT_V(2); PG8_BAR;
        PG8_STAGE(PG8_SB(1, 0), cB + kstep, voffB); PG8_STAGE(PG8_SA(1, 0), cA + kstep, voffA); PG8_STAGE(PG8_SB(1, 1), cB + hstep + kstep, voffB);
        PG8_WAIT_V(6); PG8_BAR;
    } else {
        PG8_STAGE(PG8_SB(0, 0), cB, voffB); PG8_STAGE(PG8_SA(0, 0), cA, voffA); PG8_STAGE(PG8_SB(0, 1), cB + hstep, voffB); PG8_STAGE(PG8_SA(0, 1), cA + hstep, voffA);
        if (wr == 1) PG8_BAR;
        PG8_WAIT_V(4); PG8_BAR;
        PG8_STAGE(PG8_SB(1, 0), cB + kstep, voffB); PG8_STAGE(PG8_SA(1, 0), cA + kstep, voffA); PG8_STAGE(PG8_SB(1, 1), cB + hstep + kstep, voffB);
        PG8_WAIT_V(6); PG8_BAR;
    }
    for (;;) {
        const bool has_next = S.next(ui + 1, nxt);
        const char* nA = has_next ? (const char*)g.A + (size_t)nxt.pm * tstep + (size_t)nxt.ks * ksb : cA; const char* nB = has_next ? (const char*)g.Bt + (size_t)nxt.pn * tstep + (size_t)nxt.ks * ksb : cB;
        for (int t = 0; t < nt; t += 2) {
            const bool last = (t == nt - 2);
            const char* a1 = cA + (size_t)(t + 1) * kstep;
            const char* a2 = last ? nA : cA + (size_t)(t + 2) * kstep; const char* b2 = last ? nB : cB + (size_t)(t + 2) * kstep;
            const char* a3 = a2 + kstep; const char* b3 = b2 + kstep;
            if (last && has_next) S.a_ready(nxt);
            if constexpr (SP2) {
            PG8_LDB(B0, 0, 0); PG8_LDB(B1, 0, 1); PG8_SCHED; PG8_LDA(At, 0, 0); PG8_STAGE(PG8_SA(1, 1), a1 + hstep, voffA);
            PG8_WAIT_V(8); PG8_WAIT_L(0); PG8_BAR; PG8_MMA(0, 0, At, B0); PG8_MMA(0, 1, At, B1); PG8_BAR; PG8_SCHED;
            PG8_LDA(At, 0, 1); PG8_STAGE(PG8_SB(0, 0), b2, voffB); PG8_STAGE(PG8_SB(0, 1), b2 + hstep, voffB); PG8_STAGE(PG8_SA(0, 0), a2, voffA);
            PG8_WAIT_V(8); PG8_WAIT_L(0); PG8_BAR; PG8_MMA(1, 0, At, B0); PG8_MMA(1, 1, At, B1); PG8_BAR; PG8_SCHED;
            PG8_LDB(B0, 1, 0); PG8_LDB(B1, 1, 1); PG8_SCHED; PG8_LDA(At, 1, 0); PG8_STAGE(PG8_SA(0, 1), a2 + hstep, voffA);
            PG8_WAIT_V(8); PG8_WAIT_L(0); PG8_BAR; PG8_MMA(0, 0, At, B0); PG8_MMA(0, 1, At, B1); PG8_BAR; PG8_SCHED;
            PG8_LDA(At, 1, 1); PG8_STAGE(PG8_SB(1, 0), b3, voffB); PG8_STAGE(PG8_SB(1, 1), b3 + hstep, voffB); PG8_STAGE(PG8_SA(1, 0), a3, voffA);
            PG8_WAIT_V(8); PG8_WAIT_L(0); PG8_BAR; PG8_MMA(1, 0, At, B0); PG8_MMA(1, 1, At, B1); PG8_BAR; PG8_SCHED;
            } else {
            PG8_LDB(B0, 0, 0); PG8_SCHED; PG8_LDA(At, 0, 0); PG8_STAGE(PG8_SA(1, 1), a1 + hstep, voffA);
            PG8_WAIT_L(8); PG8_BAR; PG8_WAIT_L(0); PG8_MMA(0, 0, At, B0); PG8_BAR; PG8_SCHED;
            PG8_LDB(B1, 0, 1); PG8_STAGE(PG8_SB(0, 0), b2, voffB);
            PG8_BAR; PG8_WAIT_L(0); PG8_MMA(0, 1, At, B1); PG8_BAR;
            PG8_LDA(At, 0, 1); PG8_STAGE(PG8_SA(0, 0), a2, voffA);
            PG8_BAR; PG8_WAIT_L(0); PG8_MMA(1, 0, At, B0); PG8_BAR; PG8_SCHED;
            PG8_STAGE(PG8_SB(0, 1), b2 + hstep, voffB);
            PG8_WAIT_V(6); PG8_BAR; PG8_MMA(1, 1, At, B1); PG8_BAR;
            PG8_LDB(B0, 1, 0); PG8_SCHED; PG8_LDA(At, 1, 0); PG8_STAGE(PG8_SA(0, 1), a2 + hstep, voffA);
            PG8_WAIT_L(8); PG8_BAR; PG8_WAIT_L(0); PG8_MMA(0, 0, At, B0); PG8_BAR; PG8_SCHED;
            PG8_LDB(B1, 1, 1); PG8_STAGE(PG8_SB(1, 0), b3, voffB);
            PG8_BAR; PG8_WAIT_L(0); PG8_MMA(0, 1, At, B1); PG8_BAR;
            PG8_LDA(At, 1, 1); PG8_STAGE(PG8_SA(1, 0), a3, voffA);
            PG8_BAR; PG8_WAIT_L(0); PG8_MMA(1, 0, At, B0); PG8_BAR; PG8_SCHED;
            PG8_STAGE(PG8_SB(1, 1), b3 + hstep, voffB);
            PG8_WAIT_V(6); PG8_BAR; PG8_MMA(1, 1, At, B1); PG8_BAR;
            }
        }
        if constexpr (ALIGN_EPI) { if (wr == 0) PG8_BAR; }
        if constexpr (!Epi::AFTER_DRAIN) { E(acc, cur, wr, wc, fr, fq); S.done(cur); }
        if (!has_next) break;
#pragma unroll
        for (int a = 0; a < 2; ++a)
#pragma unroll
            for (int b = 0; b < 2; ++b)
#pragma unroll
                for (int m = 0; m < 4; ++m)
#pragma unroll
                    for (int n = 0; n < 2; ++n) acc[a][b][m][n] = (f32x4){0.f, 0.f, 0.f, 0.f};
        cur = nxt; cA = nA; cB = nB; ++ui;
        if constexpr (ALIGN_EPI) { if (wr == 1) PG8_BAR; }
    }
    PG8_WAIT_V(0);
    if constexpr (!ALIGN_EPI) { if (wr == 0) PG8_BAR; }
    PG8_BAR;
    if constexpr (Epi::AFTER_DRAIN) { E.fused(acc, cur, wr, wc, fr, fq, lds, wid, lane); S.done(cur); }
#undef PG8_SA
#undef PG8_SB
#undef PG8_STAGE
#undef PG8_LDA
#undef PG8_LDB
#undef PG8_MMA
#undef PG8_WAIT_V
#undef PG8_WAIT_L
#undef PG8_BAR
#undef PG8_SCHED
}
}

namespace att {
using bf16x8 = __attribute__((ext_vector_type(8))) short;
using s16x4  = __attribute__((ext_vector_type(4))) short;
using f32x16 = __attribute__((ext_vector_type(16))) float;
using u32x4  = __attribute__((ext_vector_type(4))) unsigned;
constexpr int NW = 8, QBLK = 32, KVBLK = 64, DV = 128;
#define ATT_SBAR() __builtin_amdgcn_sched_barrier(0)
__device__ __forceinline__ int crow(int r, int hi) { return (r & 3) + 8 * (r >> 2) + 4 * hi; }
__device__ __forceinline__ unsigned cvtpk(float lo, float hi) { unsigned r; asm volatile("v_cvt_pk_bf16_f32 %0, %1, %2" : "=v"(r) : "v"(lo), "v"(hi)); return r; }
template <int DQK> __device__ __forceinline__ int kswz(int row, int colB) { return row * (DQK * 2) + (colB ^ ((row & 7) << 4)); }
constexpr float THR = 8.f;

template <int DQK> struct Cfg {
    static constexpr int SHM_V = KVBLK * DV * 2, SHM_K = KVBLK * DQK * 2;
    static constexpr int OFF_V = 0, OFF_K = 2 * SHM_V, OFF_WS = OFF_K + 2 * SHM_K, OFF_BIAS = OFF_WS + NW * 64 * 4, LDS_BYTES = OFF_BIAS + 10240;
    static constexpr int KCH = DQK / 8;
    static constexpr int KLD = (64 * KCH) / 512;
};

struct Job {
    const bf16_t* Q;
    const bf16_t* K;
    const bf16_t* V;
    bf16_t* O;
    int nt;
    int seg0_tiles, row_seg0, row_seg1;
    int R0; int rlo;
};

__device__ __forceinline__ int tile_row(const Job& J, int j) {
    if (j < J.seg0_tiles) return J.row_seg0 + 64 * j;
    int jj = j - J.seg0_tiles; if (jj > 3) jj = 0; return J.row_seg1 + 64 * jj;
}

__device__ __forceinline__ void partialSM(f32x16& p0, f32x16& p1, float& m_reg, float& mn, float& alpha, float C, float thr_raw) {
    float pmax = p0[0];
#pragma unroll
    for (int r = 1; r < 16; ++r) pmax = fmaxf(pmax, p0[r]);
#pragma unroll
    for (int r = 0; r < 16; ++r) pmax = fmaxf(pmax, p1[r]);
    { auto rr = __builtin_amdgcn_permlane32_swap(__float_as_uint(pmax), __float_as_uint(pmax), false, false);
      pmax = fmaxf(__uint_as_float(rr[0]), __uint_as_float(rr[1])); }
    if (__builtin_expect(__all(pmax - m_reg <= thr_raw), 1)) { mn = m_reg; alpha = 1.f; }
    else { mn = fmaxf(m_reg, pmax); alpha = __builtin_amdgcn_exp2f((m_reg - mn) * C); m_reg = mn; }
    const float mnC = -mn * C;
#pragma unroll
    for (int r = 0; r < 16; ++r) p0[r] = fmaf(p0[r], C, mnC);
#pragma unroll
    for (int r = 0; r < 16; ++r) p1[r] = fmaf(p1[r], C, mnC);
#pragma unroll
    for (int r = 0; r < 16; ++r) p0[r] = __builtin_amdgcn_exp2f(p0[r]);
}
__device__ __forceinline__ void finishSM(f32x16& p0, f32x16& p1, float alpha, float& l_reg, bf16x8& pa0, bf16x8& pa1, bf16x8& pa2, bf16x8& pa3) {
#pragma unroll
    for (int r = 0; r < 16; ++r) p1[r] = __builtin_amdgcn_exp2f(p1[r]);
    float ps = 0;
#pragma unroll
    for (int r = 0; r < 16; ++r) ps += p0[r];
#pragma unroll
    for (int r = 0; r < 16; ++r) ps += p1[r];
    { auto rr = __builtin_amdgcn_permlane32_swap(__float_as_uint(ps), __float_as_uint(ps), false, false);
      ps = __uint_as_float(rr[0]) + __uint_as_float(rr[1]); }
    l_reg = l_reg * alpha + ps;
#define ATT_PK4(P, BASE, OUT) do { unsigned a0 = cvtpk(P[BASE + 0], P[BASE + 1]), a1 = cvtpk(P[BASE + 2], P[BASE + 3]);   \
    unsigned b0 = cvtpk(P[BASE + 4], P[BASE + 5]), b1 = cvtpk(P[BASE + 6], P[BASE + 7]);                              \
    auto r0 = __builtin_amdgcn_permlane32_swap(a0, b0, false, false); auto r1 = __builtin_amdgcn_permlane32_swap(a1, b1, false, false); \
    u32x4 w = {r0[0], r1[0], r0[1], r1[1]}; OUT = *reinterpret_cast<bf16x8*>(&w); } while (0)
    ATT_PK4(p0, 0, pa0); ATT_PK4(p0, 8, pa1); ATT_PK4(p1, 0, pa2); ATT_PK4(p1, 8, pa3);
#undef ATT_PK4
}
template <int DQK> __device__ __forceinline__ void qkt(f32x16& p0, f32x16& p1, const char* Ks, const bf16x8* qr, int r32, int hi) {
    p0 = f32x16{}; p1 = f32x16{};
#pragma unroll
    for (int d0 = 0; d0 < DQK / 16; ++d0) { const int cb = (d0 * 16 + hi * 8) * 2;
        const bf16x8 b0 = *reinterpret_cast<const bf16x8*>(Ks + kswz<DQK>(r32, cb));
        const bf16x8 b1 = *reinterpret_cast<const bf16x8*>(Ks + kswz<DQK>(32 + r32, cb));
        p0 = __builtin_amdgcn_mfma_f32_32x32x16_bf16(b0, qr[d0], p0, 0, 0, 0);
        p1 = __builtin_amdgcn_mfma_f32_32x32x16_bf16(b1, qr[d0], p1, 0, 0, 0); }
}
__device__ __forceinline__ int v_st(int k, int c) { const int kk = (k & ~0xC) | ((k & 4) << 1) | ((k & 8) >> 1); return ((kk >> 3) * 4 + (c >> 5)) * 512 + ((kk & 7) * 32 + (c & 31)) * 2; }
__device__ __forceinline__ int v_rd_base(int lane) { return ((lane & 3) << 3) | (((lane >> 2) & 3) << 6) | (((lane >> 4) & 1) << 5) | (((lane >> 5) & 1) << 8); }
constexpr int v_rd_off(int d0, int ks, int half) { return d0 * 512 + ks * 4096 + half * 2048; }
template <int OFF> __device__ __forceinline__ s16x4 tr_read(int vb) { s16x4 r; asm volatile("ds_read_b64_tr_b16 %0, %1 offset:%2" : "=&v"(r) : "v"(vb), "i"(OFF) : "memory"); return r; }
template <int D0> __device__ __forceinline__ void pv_one(f32x16& od, int vb, bf16x8 pa0, bf16x8 pa1, bf16x8 pa2, bf16x8 pa3) {
    const s16x4 l0 = tr_read<v_rd_off(D0, 0, 0)>(vb), h0 = tr_read<v_rd_off(D0, 0, 1)>(vb), l1 = tr_read<v_rd_off(D0, 1, 0)>(vb), h1 = tr_read<v_rd_off(D0, 1, 1)>(vb);
    const s16x4 l2 = tr_read<v_rd_off(D0, 2, 0)>(vb), h2 = tr_read<v_rd_off(D0, 2, 1)>(vb), l3 = tr_read<v_rd_off(D0, 3, 0)>(vb), h3 = tr_read<v_rd_off(D0, 3, 1)>(vb);
    asm volatile("s_waitcnt lgkmcnt(0)" ::: "memory"); ATT_SBAR();
#define ATT_PK(L, H) (bf16x8){L[0], L[1], L[2], L[3], H[0], H[1], H[2], H[3]}
    od = __builtin_amdgcn_mfma_f32_32x32x16_bf16(pa0, ATT_PK(l0, h0), od, 0, 0, 0);
    od = __builtin_amdgcn_mfma_f32_32x32x16_bf16(pa1, ATT_PK(l1, h1), od, 0, 0, 0);
    od = __builtin_amdgcn_mfma_f32_32x32x16_bf16(pa2, ATT_PK(l2, h2), od, 0, 0, 0);
    od = __builtin_amdgcn_mfma_f32_32x32x16_bf16(pa3, ATT_PK(l3, h3), od, 0, 0, 0);
#undef ATT_PK
}
__device__ __forceinline__ void pv_d0(f32x16* o, int vb, bf16x8 pa0, bf16x8 pa1, bf16x8 pa2, bf16x8 pa3) {
    pv_one<0>(o[0], vb, pa0, pa1, pa2, pa3); pv_one<1>(o[1], vb, pa0, pa1, pa2, pa3); pv_one<2>(o[2], vb, pa0, pa1, pa2, pa3); pv_one<3>(o[3], vb, pa0, pa1, pa2, pa3);
}
constexpr int NA_BROW = 160, NA_BORG = 64 + (NA_KW - 1);
__device__ __forceinline__ void na_bias(f32x16& p0, f32x16& p1, const Job& J, int j, int R, int c, int hi, const float* biasq) {
    const int nloc = J.seg0_tiles;
    if (j >= nloc && j < nloc + 4) return;
    const int rr = J.rlo + j; int r0 = R - NA_KH / 2; r0 = r0 < 0 ? 0 : (r0 > ROWS - NA_KH ? ROWS - NA_KH : r0);
    const bool rowok = (j < nloc) && rr >= r0 && rr < r0 + NA_KH;
    if (!rowok) {
#pragma unroll
        for (int r = 0; r < 16; ++r) { p0[r] = -1e30f; p1[r] = -1e30f; }
        return; }
    int c0 = c - NA_KW / 2; c0 = c0 < 0 ? 0 : (c0 > GRID_W - NA_KW ? GRID_W - NA_KW : c0);
    const int dr = rr - R + (NA_KH - 1);
    const float* bl = biasq + dr * NA_BROW + NA_BORG + 4 * hi - c;
    const int vb = 4 * hi - c0;
#pragma unroll
    for (int r = 0; r < 16; ++r) { const int cc = (r & 3) + 8 * (r >> 2);
        p0[r] = ((unsigned)(cc + vb) < (unsigned)NA_KW) ? p0[r] + bl[cc] : -1e30f;
        p1[r] = ((unsigned)(cc + 32 + vb) < (unsigned)NA_KW) ? p1[r] + bl[cc + 32] : -1e30f; }
}

#define ATT_LAS __attribute__((address_space(3)))
template <int DQK, bool NA, int LDQ, int LDK, int LDV, int LDO>
__device__ __forceinline__ void attn_unit(const Job& J, char* lds, const float scale, const int tid_in) {
    using C_ = Cfg<DQK>;
    int tid_ = tid_in; asm volatile("" : "+v"(tid_));
    const int tid = tid_, wid = __builtin_amdgcn_readfirstlane(tid >> 6), lane = tid & 63, r32 = lane & 31, hi = lane >> 5;
    char* V_lds = lds + C_::OFF_V; char* K_lds = lds + C_::OFF_K;
    const unsigned ldsb = (unsigned)(uintptr_t)lds;
    float* wsf = (float*)(lds + C_::OFF_WS) + wid * 64; float* li_l = wsf; float* al_l = wsf + 32;
    const float* biasq = (const float*)(lds + C_::OFF_BIAS);
    const float Cc = scale * 1.4426950408889634f, thr_raw = THR / scale;
    float m_reg = -1e5f, l_reg = 0; f32x16 o[4] = {}; bf16x8 qr[DQK / 16];
    const bf16_t* Qw = J.Q + (long)(wid * QBLK + r32) * LDQ + hi * 8;
#pragma unroll
    for (int d0 = 0; d0 < DQK / 16; ++d0) qr[d0] = *reinterpret_cast<const bf16x8*>(Qw + d0 * 16);
    const int naR = J.R0 + (wid >> 1), nac = (wid & 1) * 32 + r32;
    const int vb0 = (int)(uintptr_t)V_lds + v_rd_base(lane);
    unsigned koff[C_::KLD], voff[2];
#pragma unroll
    for (int i = 0; i < C_::KLD; ++i) { const int sl = 512 * i + tid, row = sl / C_::KCH, cs = sl % C_::KCH, chunk = (cs & ~7) | ((cs & 7) ^ (row & 7)); koff[i] = (unsigned)(row * LDK * 2 + chunk * 16); }
#pragma unroll
    for (int i = 0; i < 2; ++i) { const int sl = 512 * i + tid, sub = sl >> 5, wi = sl & 31, kk = (sub >> 2) * 8 + (wi >> 2), k = (kk & ~0xC) | ((kk & 4) << 1) | ((kk & 8) >> 1), c = (sub & 3) * 32 + (wi & 3) * 8;
        voff[i] = (unsigned)(k * LDV * 2 + c * 2); }
#define ATT_STAGE(j, b) do { const int row0_ = tile_row(J, (j)); const char* vp_ = (const char*)(J.V + (size_t)row0_ * LDV); const char* kp_ = (const char*)(J.K + (size_t)row0_ * LDK); \
        _Pragma("unroll") for (int i_ = 0; i_ < C_::KLD; ++i_) __builtin_amdgcn_global_load_lds((const unsigned*)(kp_ + koff[i_]), (ATT_LAS unsigned*)(ldsb + C_::OFF_K + (b) * C_::SHM_K + (512 * i_ + 64 * wid) * 16), 16, 0, 0); \
        _Pragma("unroll") for (int i_ = 0; i_ < 2; ++i_) __builtin_amdgcn_global_load_lds((const unsigned*)(vp_ + voff[i_]), (ATT_LAS unsigned*)(ldsb + C_::OFF_V + (b) * C_::SHM_V + (512 * i_ + 64 * wid) * 16), 16, 0, 0); } while (0)
    const int NT = J.nt;
    __syncthreads();
    ATT_STAGE(0, 0); asm volatile("s_waitcnt vmcnt(0)" ::: "memory"); __syncthreads();
    for (int j = 0; j < NT; ++j) {
        const int buf = j & 1;
        if (j + 1 < NT) ATT_STAGE(j + 1, buf ^ 1);
        f32x16 p0, p1; float mn, al; bf16x8 pa0, pa1, pa2, pa3;
        qkt<DQK>(p0, p1, K_lds + buf * C_::SHM_K, qr, r32, hi);
        if (NA) na_bias(p0, p1, J, j, naR, nac, hi, biasq);
        partialSM(p0, p1, m_reg, mn, al, Cc, thr_raw);
        finishSM(p0, p1, al, l_reg, pa0, pa1, pa2, pa3);
        if (__any(al < 1.f)) { if (hi == 0) al_l[r32] = al; asm volatile("s_waitcnt lgkmcnt(0)" ::: "memory");
#pragma unroll
            for (int d = 0; d < 4; ++d)
#pragma unroll
                for (int r = 0; r < 16; ++r) o[d][r] *= al_l[crow(r, hi)]; }
        ATT_SBAR();
        pv_d0(o, vb0 + buf * C_::SHM_V, pa0, pa1, pa2, pa3);
        asm volatile("s_waitcnt vmcnt(0)" ::: "memory");
        __syncthreads();
    }
    if (hi == 0) li_l[r32] = l_reg; asm volatile("s_waitcnt lgkmcnt(0)" ::: "memory");
    float rli[16];
#pragma unroll
    for (int r = 0; r < 16; ++r) rli[r] = __builtin_amdgcn_rcpf(li_l[crow(r, hi)]);
    bf16_t* Ow = J.O + (long)(wid * QBLK) * LDO;
#pragma unroll
    for (int r = 0; r < 16; ++r) { const int orow = crow(r, hi);
#pragma unroll
        for (int d0 = 0; d0 < 4; ++d0) Ow[(long)orow * LDO + d0 * 32 + r32] = f2bf(o[d0][r] * rli[r]); }
#undef ATT_STAGE
}
}

struct AttnArgs { const bf16_t *QM, *KM, *VM, *NQ, *NK, *P; bf16_t* Y; const float* rpb; int want_ctx; int pad; };
__device__ __forceinline__ void attention_phase(const AttnArgs& A, char* lds, int G, int wg, const int tid, const int nskip) {
    static_assert(GRID_W == 64 && SEQ % 256 == 0 && CTX_LEN == 256 && HD == 128, "attention phase geometry");
    constexpr int NQB = SEQ / 256;
    constexpr float sc_mla = 0.07216878364870323f, sc_na = 0.08838834764831845f;
    static_assert(MLA_QK == 192 && HD == 128, "softmax scales");
    if (!(A.pad & 2)) for (int u = wg; u < BATCH * NH * NQB; u += G) {
        const int bh = u % (BATCH * NH), qb = u / (BATCH * NH), b = bh / NH, h = bh % NH;
        att::Job J{};
        J.Q = A.QM + (size_t)(b * SEQ + qb * 256) * NQ_MLA + h * MLA_QK; J.K = A.KM + h * MLA_QK; J.V = A.VM + h * MLA_V;
        J.O = A.Y + (size_t)(b * SEQ + qb * 256) * D_MODEL + GROUP_W + h * MLA_V;
        J.nt = SEQ / 64 + CTX_LEN / 64; J.seg0_tiles = SEQ / 64; J.row_seg0 = b * SEQ; J.row_seg1 = M_LAT + b * CTX_LEN;
        att::attn_unit<MLA_QK, false, NQ_MLA, NQ_MLA, NH * MLA_V, D_MODEL>(J, lds, sc_mla, tid);
    }
    const int G2n = G - nskip, c2 = wg - nskip;
    if (!(A.pad & 4) && c2 >= 0) for (int u = c2; u < BATCH * NH * NQB; u += G2n) {
        const int bh = u % (BATCH * NH), qb = u / (BATCH * NH), b = bh / NH, h = bh % NH, R0 = qb * 4;
        __syncthreads();
        { float* bq = (float*)(lds + att::Cfg<HD>::OFF_BIAS); const float* src = A.rpb + (size_t)h * (2 * NA_KH - 1) * (2 * NA_KW - 1);
          for (int i = tid; i < (2 * NA_KH - 1) * att::NA_BROW; i += 512) { const int dr = i / att::NA_BROW; int dc = i % att::NA_BROW - att::NA_BORG + (NA_KW - 1); dc = dc < 0 ? 0 : (dc > 2 * NA_KW - 2 ? 2 * NA_KW - 2 : dc);
              bq[i] = src[dr * (2 * NA_KW - 1) + dc] * 11.313708498984761f; } }
        int rlo = R0 - NA_KH / 2; rlo = rlo < 0 ? 0 : (rlo > ROWS - NA_KH ? ROWS - NA_KH : rlo);
        int rhi = R0 + 3 - NA_KH / 2; rhi = (rhi < 0 ? 0 : (rhi > ROWS - NA_KH ? ROWS - NA_KH : rhi)) + NA_KH - 1;
        const int nloc = rhi - rlo + 1;
        att::Job J{};
        J.Q = A.NQ + (size_t)(b * SEQ + R0 * 64) * GROUP_W + h * HD; J.K = A.NK + h * HD; J.V = A.P + C_NV + h * HD;
        J.O = A.Y + (size_t)(b * SEQ + R0 * 64) * D_MODEL + 3 * GROUP_W + h * HD;
        J.nt = (nloc + 4 + 1) & ~1; J.seg0_tiles = nloc; J.row_seg0 = b * SEQ + rlo * 64; J.row_seg1 = M_LAT + b * CTX_LEN;  J.R0 = R0; J.rlo = rlo;
        att::attn_unit<HD, true, GROUP_W, GROUP_W, NP, D_MODEL>(J, lds, sc_na, tid);
    }
    if (A.want_ctx && !(A.pad & 8)) {
        for (int u = c2 - 64; u >= 0 && u < BATCH * NH; u += G) {
            const int b = u / NH, h = u % NH; const int crow0 = M_LAT + b * CTX_LEN;
            att::Job J{}; J.nt = CTX_LEN / 64; J.seg0_tiles = 0; J.row_seg0 = crow0; J.row_seg1 = crow0;
            J.Q = A.QM + (size_t)crow0 * NQ_MLA + h * MLA_QK; J.K = A.KM + h * MLA_QK; J.V = A.VM + h * MLA_V;
            J.O = A.Y + (size_t)crow0 * D_MODEL + GROUP_W + h * MLA_V; att::attn_unit<MLA_QK, false, NQ_MLA, NQ_MLA, NH * MLA_V, D_MODEL>(J, lds, sc_mla, tid);
        }
        for (int u = c2 - 64 - BATCH * NH; u >= 0 && u < BATCH * NH; u += G) {
            const int b = u / NH, h = u % NH; const int crow0 = M_LAT + b * CTX_LEN;
            att::Job J{}; J.nt = CTX_LEN / 64; J.seg0_tiles = 0; J.row_seg0 = crow0; J.row_seg1 = crow0;
            J.Q = A.NQ + (size_t)crow0 * GROUP_W + h * HD; J.K = A.NK + h * HD; J.V = A.P + C_NV + h * HD;
            J.O = A.Y + (size_t)crow0 * D_MODEL + 3 * GROUP_W + h * HD; att::attn_unit<HD, false, GROUP_W, GROUP_W, NP, D_MODEL>(J, lds, sc_na, tid);
        }
    }
}

namespace gdn {
typedef short bf16x8 __attribute__((ext_vector_type(8)));
typedef float f32x4 __attribute__((ext_vector_type(4)));
typedef float f32x16 __attribute__((ext_vector_type(16)));
typedef unsigned u32x2 __attribute__((ext_vector_type(2)));
typedef unsigned u32x4 __attribute__((ext_vector_type(4)));
constexpr int CH = 64, NCHUNK = M_ALL / CH;
constexpr int NTASK = NCHUNK * NH * 2;
constexpr size_t SZ_UT = 128 * 64, SZ_WP = 64 * 128, SZ_KDT = 128 * 64, SZ_QD = 64 * 128, SZ_QK = 64 * 64, SZ_SIT = 128 * 128, SZ_VNT = 128 * 64;
struct Bufs { bf16_t *UT, *WP, *KDT, *QD, *QK, *SIT, *VNT; float* GT; };
__device__ __forceinline__ int perm32(int o) { return (o & ~31) | (((o & 15) >> 2) * 8 + ((o >> 4) & 1) * 4 + (o & 3)); }
__device__ __forceinline__ unsigned pk2(float lo, float hi) { return (unsigned)f2bf(lo) | ((unsigned)f2bf(hi) << 16); }

constexpr int QS = 132;
constexpr int AS = 68;
constexpr int G1_OFF_Q = 0, G1_OFF_K = G1_OFF_Q + CH * QS * 4, G1_OFF_V = G1_OFF_K + CH * QS * 4, G1_OFF_AA = G1_OFF_V + CH * QS * 4, G1_OFF_SM = G1_OFF_AA + 2 * CH * AS * 4,
              G1_LDS = G1_OFF_SM + 12 * 64 * 4;
struct G1Args { const bf16_t* P; const float* conv_w; const float* a_log; const float* dt_bias; Bufs B; int pflags; };

__device__ __forceinline__ void g1_task(const G1Args& A, char* lds, int cix, int h, const int tid_in) {
    int tid_ = tid_in; asm volatile("" : "+v"(tid_));
    const int tid = tid_, wid = __builtin_amdgcn_readfirstlane(tid >> 6), lane = tid & 63;
    float* Qs = (float*)(lds + G1_OFF_Q); float* Ks = (float*)(lds + G1_OFF_K); float* Vs = (float*)(lds + G1_OFF_V); float* AA = (float*)(lds + G1_OFF_AA);
    float* sm = (float*)(lds + G1_OFF_SM); float* g_s = sm;   float* beta_s = sm + 128;   float* gc_s = sm + 256;
    const int row0 = cix * CH; const RowInfo r0i = row_info(row0);
    LDS_BARRIER();
    if (tid < 48 * 8) {
        const int grp = tid % 48, ts = tid / 48, which = grp >> 4, cc0 = (grp & 15) * 8, ch0 = which * GROUP_W + h * HD + cc0;
        float wgt[4][8];
#pragma unroll
        for (int j = 0; j < 4; ++j) { const f32x4 w0 = *(const f32x4*)(A.conv_w + j * 3 * GROUP_W + ch0), w1 = *(const f32x4*)(A.conv_w + j * 3 * GROUP_W + ch0 + 4);
#pragma unroll
            for (int e = 0; e < 4; ++e) { wgt[j][e] = w0[e]; wgt[j][4 + e] = w1[e]; } }
        u32x4 xr[11];
#pragma unroll
        for (int k = 0; k < 11; ++k) { const int tt = r0i.t + 8 * ts + k - 1;
            xr[k] = (tt >= 0 && tt < r0i.T && !(A.pflags & 4096)) ? *(const u32x4*)(A.P + (size_t)(r0i.base + tt) * NP + C_GQ + ch0) : (u32x4){0u, 0u, 0u, 0u}; }
        float* dstp = (which == 0 ? Qs : which == 1 ? Ks : Vs) + cc0;
#pragma unroll
        for (int i = 0; i < 8; ++i) { float acc[8];
#pragma unroll
            for (int e = 0; e < 8; ++e) acc[e] = 0.f;
#pragma unroll
            for (int j = 0; j < 4; ++j) { const u32x4 xv = xr[i + j];
#pragma unroll
                for (int e = 0; e < 4; ++e) { acc[2 * e] += wgt[j][2 * e] * bflo(xv[e]); acc[2 * e + 1] += wgt[j][2 * e + 1] * bfhi(xv[e]); } }
            f32x4 y0, y1;
#pragma unroll
            for (int e = 0; e < 4; ++e) { y0[e] = acc[e] / (1.0f + __expf(-acc[e])); y1[e] = acc[4 + e] / (1.0f + __expf(-acc[4 + e])); }
            *(f32x4*)(dstp + (8 * ts + i) * QS) = y0; *(f32x4*)(dstp + (8 * ts + i) * QS + 4) = y1; }
    }
    if (tid < 128) { const int d = tid >> 6, i = tid & 63; const size_t r = (size_t)(row0 + i) * NP;
        beta_s[d * 64 + i] = 1.0f / (1.0f + __expf(-bf2f(A.P[r + C_GB + d * NH + h])));
        g_s[d * 64 + i] = -__expf(A.a_log[d * NH + h]) * softplusf_(bf2f(A.P[r + C_GA + d * NH + h]) + A.dt_bias[d * NH + h]); }
    LDS_BARRIER();
    for (int rr = wid; rr < 2 * CH; rr += 8) { float* rowp = (rr < CH ? Qs : Ks) + (rr & 63) * QS;
        const float a = rowp[lane], b = rowp[lane + 64]; float ss = a * a + b * b;
#pragma unroll
        for (int o = 1; o < 64; o <<= 1) ss += lane_xor(ss, o, lane);
        const float scl = (1.0f / sqrtf(ss + EPS)) * (rr < CH ? 0.08838834764831845f : 1.0f);
        rowp[lane] = a * scl; rowp[lane + 64] = b * scl; }
    if (tid < 2) {
        f32x4 gv[16];
#pragma unroll
        for (int m = 0; m < 16; ++m) gv[m] = *(const f32x4*)(g_s + tid * 64 + 4 * m);
        float run = 0.f;
        if (tid == 0) {
#pragma unroll
            for (int m = 0; m < 16; ++m) { f32x4 o4;
#pragma unroll
                for (int e = 0; e < 4; ++e) { run += gv[m][e]; o4[e] = run; }
                *(f32x4*)(gc_s + 4 * m) = o4; }
        } else {
#pragma unroll
            for (int m = 15; m >= 0; --m) { f32x4 o4;
#pragma unroll
                for (int e = 3; e >= 0; --e) { run += gv[m][e]; o4[e] = run; }
                *(f32x4*)(gc_s + 64 + 4 * m) = o4; }
        }
    }
    LDS_BARRIER();
    float* eq_s = sm + 384; float* ek_s = sm + 512;
    if (tid < 128) { const int d = tid >> 6, i = tid & 63; const float gci = gc_s[d * 64 + i], glast = d == 0 ? gc_s[63] : gc_s[64];
        eq_s[tid] = __expf(gci); ek_s[tid] = __expf(glast - gci); }
    const int gwhich = wid >> 2, gI = (wid >> 1) & 1, gJ = wid & 1, r32 = lane & 31, hi = lane >> 5;
    f32x16 acc = {};
    if (!(A.pflags & 1024)) {
        const float* X = (gwhich ? Qs : Ks) + (32 * gI + r32) * QS + 4 * hi; const float* Yp = Ks + (32 * gJ + r32) * QS + 4 * hi;
#pragma unroll
        for (int s = 0; s < 16; ++s) { const f32x4 a4 = *(const f32x4*)(X + 8 * s), b4 = *(const f32x4*)(Yp + 8 * s);
#pragma unroll
            for (int e = 0; e < 4; ++e) acc = __builtin_amdgcn_mfma_f32_32x32x2f32(a4[e], b4[e], acc, 0, 0, 0); }
        const int j = 32 * gJ + r32;
        if (gwhich == 0) {
            const float b1j = beta_s[64 + j], g0j = gc_s[j], g1j = gc_s[64 + j];
#pragma unroll
            for (int r = 0; r < 16; ++r) { const int i = 32 * gI + (r & 3) + 8 * (r >> 2) + 4 * hi;
                if (i > j) { const float kk = acc[r];
                    AA[(63 - j) * AS + (63 - i)] = beta_s[i] * kk * __expf(gc_s[i] - g0j);
                    AA[CH * AS + i * AS + j] = b1j * kk * __expf(g1j - gc_s[64 + i]); } }
        }
    }
    LDS_BARRIER();
    const size_t t0 = ((size_t)cix * NH + h) * 2;
    if (!(A.pflags & 2048)) {
#pragma unroll
        for (int n = 0; n < 4; ++n) { const int it = tid + 512 * n, d = it >> 10, p = (it >> 4) & 63, m = it & 15, i = d == 0 ? p : 63 - p, k0 = 32 * (m >> 2) + 4 * (m & 3);
            const float e = eq_s[d * 64 + i]; const f32x4 lo = *(const f32x4*)(Qs + i * QS + k0), hi4 = *(const f32x4*)(Qs + i * QS + k0 + 16);
            *(u32x4*)(A.B.QD + (t0 + d) * SZ_QD + (size_t)p * 128 + m * 8) = (u32x4){pk2(lo[0] * e, lo[1] * e), pk2(lo[2] * e, lo[3] * e), pk2(hi4[0] * e, hi4[1] * e), pk2(hi4[2] * e, hi4[3] * e)}; }
#pragma unroll
        for (int n = 0; n < 4; ++n) { const int it = tid + 512 * n, k = it & 127, d = (it >> 7) & 1, m = it >> 8, p0 = 32 * (m >> 2) + 4 * (m & 3);
            float v[8];
#pragma unroll
            for (int jj = 0; jj < 8; ++jj) { const int p = p0 + (jj < 4 ? jj : 12 + jj), i = d == 0 ? p : 63 - p; v[jj] = Ks[i * QS + k] * ek_s[d * 64 + i]; }
            *(u32x4*)(A.B.KDT + (t0 + d) * SZ_KDT + (size_t)k * 64 + m * 8) = (u32x4){pk2(v[0], v[1]), pk2(v[2], v[3]), pk2(v[4], v[5]), pk2(v[6], v[7])}; }
        if (tid == 0) { A.B.GT[t0] = __expf(gc_s[63]); A.B.GT[t0 + 1] = __expf(gc_s[64]); }
    }
    LDS_BARRIER();
    bf16_t* stg = (bf16_t*)Qs;
    if (gwhich == 1) { const int j = 32 * gJ + r32; const float g0j = gc_s[j], g1j = gc_s[64 + j];
#pragma unroll
        for (int r = 0; r < 16; ++r) { const int i = 32 * gI + (r & 3) + 8 * (r >> 2) + 4 * hi; const float qk = acc[r];
            stg[i * 64 + perm32(j)] = f2bf(i >= j ? qk * __expf(gc_s[i] - g0j) : 0.f);
            stg[4096 + (63 - i) * 64 + perm32(63 - j)] = f2bf(i <= j ? qk * __expf(gc_s[64 + i] - g1j) : 0.f); } }
    LDS_BARRIER();
#pragma unroll
    for (int n = 0; n < 2; ++n) { const int c16 = tid + 512 * n; *(u32x4*)(A.B.QK + t0 * SZ_QK + (size_t)c16 * 8) = *(const u32x4*)(stg + c16 * 8); }
    if (!(A.pflags & 512)) {
        int tidv = tid; asm volatile("" : "+v"(tidv));
        const int d = tidv >> 8, c = tidv & 255; const bool isw = c >= 128; const int cc = c & 127;
        const float* src = isw ? Ks : Vs;
        int lz; asm volatile("v_mov_b32 %0, 0" : "=v"(lz));
        const float* AAv = AA + lz + d * (CH * AS);
        float x[CH];
#pragma unroll
        for (int p = 0; p < CH; ++p) { const int i = d == 0 ? p : 63 - p; float f = beta_s[d * 64 + i]; if (isw) f *= eq_s[d * 64 + i]; x[p] = f * src[i * QS + cc]; }
        {
#pragma unroll
            for (int p = 0; p < CH - 1; ++p) { const float xp = x[p]; const float* rowp = AAv + (63 - p) * AS;
#pragma unroll
                for (int m = 0; m <= (62 - p) / 4; ++m) { const f32x4 a4 = *(const f32x4*)(rowp + 4 * m);
#pragma unroll
                    for (int e = 0; e < 4; ++e) { const int col = 4 * m + e; if (col <= 62 - p) x[63 - col] -= a4[e] * xp; } } }
        }
        LDS_BARRIER();
        if (!isw) { bf16_t* dst = A.B.UT + (t0 + d) * SZ_UT + (size_t)((cc >> 4) * 2 * 64 + (cc & 15)) * 8;
#pragma unroll
            for (int s = 0; s < 2; ++s)
#pragma unroll
                for (int qq = 0; qq < 4; ++qq) { const int p0 = 32 * s + 4 * qq; u32x4 w4; w4.x = pk2(x[p0], x[p0 + 1]); w4.y = pk2(x[p0 + 2], x[p0 + 3]); w4.z = pk2(x[p0 + 16], x[p0 + 17]); w4.w = pk2(x[p0 + 18], x[p0 + 19]);
                    *(u32x4*)(dst + (size_t)(s * 64 + qq * 16) * 8) = w4; }
        } else { bf16_t* dst = stg + d * 8192 + perm32(cc);
#pragma unroll
            for (int p = 0; p < CH; ++p) dst[p * 128] = f2bf(x[p]); }
    }
    LDS_BARRIER();
#pragma unroll
    for (int n = 0; n < 4; ++n) { const int c16 = tid + 512 * n; *(u32x4*)(A.B.WP + t0 * SZ_WP + (size_t)c16 * 8) = *(const u32x4*)(stg + c16 * 8); }
}
__device__ __forceinline__ void g1_phase(const G1Args& A, char* lds, int G, int wg, const int tid) {
    for (int t = wg; t < NCHUNK * NH; t += G) g1_task(A, lds, t / NH, t % NH, tid);
}

constexpr int G2_SPLIT = 4, G2_NACT = 8 / G2_SPLIT, G2_NSTEP = CTX_LEN / CH + SEQ / CH, G2_WGS = BATCH * NH * 2 * G2_SPLIT;
constexpr int G2_USL = G2_NACT * 2 * 64 * 16;
constexpr int G2_BUF = 16384 + 16384 + G2_USL, G2_NB = 4, G2_LDS = G2_NB * G2_BUF;
static_assert(G2_SPLIT == 4 && G2_USL == 4096, "G2 staging map below assumes 4 KB of u per step");
__device__ __forceinline__ int g2_task_index(int b, int h, int d, int step) {
    constexpr int NC = CTX_LEN / CH, NL = SEQ / CH; int cix;
    if (step < NC) { const int n = d ? NC - 1 - step : step; cix = M_LAT / CH + b * NC + n; }
    else { const int s2 = step - NC, n = d ? NL - 1 - s2 : s2; cix = b * NL + n; }
    return (cix * NH + h) * 2 + d;
}
__device__ __forceinline__ void g2_chain(const Bufs& B, char* lds, int chain_part, const int tid_in, const int step_lo, const int step_hi, float* Ssave) {
    int tid_ = tid_in; asm volatile("" : "+v"(tid_));
    const int tid = tid_, wid = __builtin_amdgcn_readfirstlane(tid >> 6), lane = tid & 63, q = lane >> 4, vl = lane & 15;
    const int chain = chain_part / G2_SPLIT, part = chain_part % G2_SPLIT;
    const bool active = wid < G2_NACT; const int vt = part * G2_NACT + (active ? wid : 0);
    const int d = chain & 1, h = (chain >> 1) % NH, b = chain / (2 * NH);
    constexpr int NSTEP = CTX_LEN / CH + SEQ / CH;
    const unsigned ldsb = (unsigned)(uintptr_t)lds;
    f32x4 S[8];
    f32x4* sv = (f32x4*)Ssave + ((size_t)chain_part * G2_NACT + (active ? wid : 0)) * 8 * 64 + lane;
#pragma unroll
    for (int kb = 0; kb < 8; ++kb) S[kb] = (step_lo > 0 && active) ? sv[kb * 64] : (f32x4){0.f, 0.f, 0.f, 0.f};
    unsigned offw[2], offk[2], offu;
#pragma unroll
    for (int i = 0; i < 2; ++i) { const int sl = 128 * wid + 64 * i + lane;
        { const int row = sl >> 4, pc = sl & 15, c = pc ^ (row & 15); offw[i] = (unsigned)(row * 256 + c * 16); }
        { const int row = sl >> 3, pc = sl & 7, c = pc ^ ((row >> 1) & 7); offk[i] = (unsigned)(row * 128 + c * 16); } }
    offu = (unsigned)((part * G2_NACT * 2 * 64 + (wid & 3) * 64 + lane) * 16);
#define G2_DMA(ti, slot) do { const char* wp_ = (const char*)(B.WP + (size_t)(ti) * SZ_WP); const char* kp_ = (const char*)(B.KDT + (size_t)(ti) * SZ_KDT); const unsigned base_ = ldsb + (unsigned)(slot) * G2_BUF; \
        _Pragma("unroll") for (int i_ = 0; i_ < 2; ++i_) { \
            __builtin_amdgcn_global_load_lds((const unsigned*)(wp_ + offw[i_]), (ATT_LAS unsigned*)(base_ + (128 * wid + 64 * i_) * 16), 16, 0, 0); \
            __builtin_amdgcn_global_load_lds((const unsigned*)(kp_ + offk[i_]), (ATT_LAS unsigned*)(base_ + 16384 + (128 * wid + 64 * i_) * 16), 16, 0, 0); } \
        if (wid >= 4) __builtin_amdgcn_global_load_lds((const unsigned*)((const char*)(B.UT + (size_t)(ti) * SZ_UT) + offu), (ATT_LAS unsigned*)(base_ + 32768 + ((wid & 3) * 64) * 16), 16, 0, 0); } while (0)
#define G2_TI(step) g2_task_index(b, h, d, (step) < NSTEP ? (step) : NSTEP - 1)
    __syncthreads();
    G2_DMA(G2_TI(step_lo), step_lo & 3); G2_DMA(G2_TI(step_lo + 1), (step_lo + 1) & 3); G2_DMA(G2_TI(step_lo + 2), (step_lo + 2) & 3);
    asm volatile("s_waitcnt vmcnt(0)" ::: "memory");
    __syncthreads();
    for (int step = step_lo; step < step_hi; ++step) {
        const int ti = G2_TI(step), slot = step & 3;
        G2_DMA(G2_TI(step + 3), (step + 3) & 3);
        unsigned gtb; { const float* gp = B.GT + ti; asm volatile("s_load_dword %0, %1, 0x0" : "=s"(gtb) : "s"(gp)); }
        const char* wl = lds + slot * G2_BUF; const char* kl = wl + 16384; const char* ul = kl + 16384;
        if (active) {
            bf16x8 aw[16], ak[16];
#pragma unroll
            for (int rb = 0; rb < 4; ++rb)
#pragma unroll
                for (int s = 0; s < 4; ++s) aw[rb * 4 + s] = *(const bf16x8*)(wl + (16 * rb + vl) * 256 + (((4 * s + q) ^ vl) << 4));
#pragma unroll
            for (int kb = 0; kb < 8; ++kb)
#pragma unroll
                for (int s = 0; s < 2; ++s) ak[kb * 2 + s] = *(const bf16x8*)(kl + (16 * kb + vl) * 128 + (((4 * s + q) ^ ((vl >> 1) & 7)) << 4));
            u32x4 uu[2];
#pragma unroll
            for (int s = 0; s < 2; ++s) uu[s] = *(const u32x4*)(ul + ((wid * 2 + s) * 64 + lane) * 16);
            bf16_t* sit = B.SIT + (size_t)ti * SZ_SIT + (size_t)(vt * 4 * 64 + lane) * 8;
            bf16x8 sf[4];
#pragma unroll
            for (int s = 0; s < 4; ++s) { u32x4 w4; w4.x = pk2(S[2 * s][0], S[2 * s][1]); w4.y = pk2(S[2 * s][2], S[2 * s][3]); w4.z = pk2(S[2 * s + 1][0], S[2 * s + 1][1]); w4.w = pk2(S[2 * s + 1][2], S[2 * s + 1][3]);
                sf[s] = __builtin_bit_cast(bf16x8, w4); *(u32x4*)(sit + (size_t)s * 64 * 8) = w4; }
            __builtin_amdgcn_sched_barrier(0);
            f32x4 vn[4];
#pragma unroll
            for (int rb = 0; rb < 4; ++rb) vn[rb] = (f32x4){0.f, 0.f, 0.f, 0.f};
#pragma unroll
            for (int s = 0; s < 4; ++s)
#pragma unroll
                for (int rb = 0; rb < 4; ++rb) vn[rb] = __builtin_amdgcn_mfma_f32_16x16x32_bf16(aw[rb * 4 + s], sf[s], vn[rb], 0, 0, 0);
#pragma unroll
            for (int s = 0; s < 2; ++s) { const f32x4 a0 = vn[2 * s], a1 = vn[2 * s + 1];
                vn[2 * s][0] = bflo(uu[s].x) - a0[0]; vn[2 * s][1] = bfhi(uu[s].x) - a0[1]; vn[2 * s][2] = bflo(uu[s].y) - a0[2]; vn[2 * s][3] = bfhi(uu[s].y) - a0[3];
                vn[2 * s + 1][0] = bflo(uu[s].z) - a1[0]; vn[2 * s + 1][1] = bfhi(uu[s].z) - a1[1]; vn[2 * s + 1][2] = bflo(uu[s].w) - a1[2]; vn[2 * s + 1][3] = bfhi(uu[s].w) - a1[3]; }
            bf16_t* vnt = B.VNT + (size_t)ti * SZ_VNT + (size_t)(vt * 2 * 64 + lane) * 8;
            bf16x8 vf[2];
#pragma unroll
            for (int s = 0; s < 2; ++s) { u32x4 w4; w4.x = pk2(vn[2 * s][0], vn[2 * s][1]); w4.y = pk2(vn[2 * s][2], vn[2 * s][3]); w4.z = pk2(vn[2 * s + 1][0], vn[2 * s + 1][1]); w4.w = pk2(vn[2 * s + 1][2], vn[2 * s + 1][3]);
                vf[s] = __builtin_bit_cast(bf16x8, w4); *(u32x4*)(vnt + (size_t)s * 64 * 8) = w4; }
            asm volatile("s_waitcnt lgkmcnt(0)" ::: "memory");
            const float gt = __uint_as_float(gtb);
#pragma unroll
            for (int kb = 0; kb < 8; ++kb) S[kb] = S[kb] * gt;
#pragma unroll
            for (int s = 0; s < 2; ++s)
#pragma unroll
                for (int kb = 0; kb < 8; ++kb) S[kb] = __builtin_amdgcn_mfma_f32_16x16x32_bf16(ak[kb * 2 + s], vf[s], S[kb], 0, 0, 0);
            __builtin_amdgcn_sched_barrier(0);
            asm volatile("s_waitcnt vmcnt(26) lgkmcnt(0)\n\ts_barrier" ::: "memory");
        } else if (wid >= 4) {
            asm volatile("s_waitcnt vmcnt(10) lgkmcnt(0)\n\ts_barrier" ::: "memory");
        } else {
            asm volatile("s_waitcnt vmcnt(8) lgkmcnt(0)\n\ts_barrier" ::: "memory");
        }
    }
    if (step_hi < NSTEP && active) {
#pragma unroll
        for (int kb = 0; kb < 8; ++kb) sv[kb * 64] = S[kb]; }
    asm volatile("s_waitcnt vmcnt(0)" ::: "memory");
    __syncthreads();
#undef G2_DMA
#undef G2_TI
}

constexpr int G3_LDS = 8 * 64 * 4 * 2;
struct G3Args { Bufs B; const bf16_t* P; const float* norm_g; bf16_t* Y; };
__device__ __forceinline__ void g3_task(const G3Args& A, char* lds, int cix, int h, const int tid_in) {
    int tid_ = tid_in; asm volatile("" : "+v"(tid_));
    const int tid = tid_, wid = __builtin_amdgcn_readfirstlane(tid >> 6), lane = tid & 63, q = lane >> 4, vl = lane & 15;
    float* part = (float*)lds;
    f32x4 o[2][4];
#pragma unroll
    for (int d = 0; d < 2; ++d) {
        const size_t t = ((size_t)cix * NH + h) * 2 + d;
        const bf16_t* sit = A.B.SIT + t * SZ_SIT + (size_t)(wid * 4 * 64 + lane) * 8;
        const bf16_t* vnt = A.B.VNT + t * SZ_VNT + (size_t)(wid * 2 * 64 + lane) * 8;
        const bf16_t* qd = A.B.QD + t * SZ_QD + (size_t)vl * 128 + 8 * q;
        const bf16_t* qk = A.B.QK + t * SZ_QK + (size_t)vl * 64 + 8 * q;
        bf16x8 sf[4], vf[2];
#pragma unroll
        for (int s = 0; s < 4; ++s) sf[s] = *(const bf16x8*)(sit + (size_t)s * 64 * 8);
#pragma unroll
        for (int s = 0; s < 2; ++s) vf[s] = *(const bf16x8*)(vnt + (size_t)s * 64 * 8);
#pragma unroll
        for (int rb = 0; rb < 4; ++rb) { f32x4 acc = {0.f, 0.f, 0.f, 0.f};
#pragma unroll
            for (int s = 0; s < 4; ++s) acc = __builtin_amdgcn_mfma_f32_16x16x32_bf16(*(const bf16x8*)(qd + (size_t)rb * 16 * 128 + 32 * s), sf[s], acc, 0, 0, 0);
#pragma unroll
            for (int s = 0; s < 2; ++s) acc = __builtin_amdgcn_mfma_f32_16x16x32_bf16(*(const bf16x8*)(qk + (size_t)rb * 16 * 64 + 32 * s), vf[s], acc, 0, 0, 0);
            o[d][rb] = acc; }
    }
    f32x4 ot[4];
#pragma unroll
    for (int rb = 0; rb < 4; ++rb)
#pragma unroll
        for (int r = 0; r < 4; ++r) ot[rb][r] = o[0][rb][r] + lane_xor(o[1][3 - rb][3 - r], 48, lane);
    LDS_BARRIER();
#pragma unroll
    for (int rb = 0; rb < 4; ++rb)
#pragma unroll
        for (int r = 0; r < 4; ++r) { float ss = ot[rb][r] * ot[rb][r];
#pragma unroll
            for (int of = 1; of < 16; of <<= 1) ss += lane_xor(ss, of, lane);
            if (vl == 0) part[wid * 64 + 16 * rb + 4 * q + r] = ss; }
    LDS_BARRIER();
    const int v = 16 * wid + vl; const float ng = A.norm_g[v];
#pragma unroll
    for (int rb = 0; rb < 4; ++rb)
#pragma unroll
        for (int r = 0; r < 4; ++r) { const int tok = 16 * rb + 4 * q + r; float ss = 0.f;
#pragma unroll
            for (int w8 = 0; w8 < 8; ++w8) ss += part[w8 * 64 + tok];
            const float rstd = 1.0f / sqrtf(ss * (1.0f / HD) + EPS);
            const size_t row = (size_t)cix * CH + tok; const float gate = bf2f(A.P[row * NP + C_GG + h * HD + v]);
            A.Y[row * D_MODEL + 2 * GROUP_W + h * HD + v] = f2bf(ot[rb][r] * rstd * ng * (gate / (1.0f + __expf(-gate)))); }
}
__device__ __forceinline__ void g3_phase(const G3Args& A, char* lds, int G, int wg, const int tid) {
    for (int t = wg; t < NCHUNK * NH; t += G) g3_task(A, lds, t / NH, t % NH, tid);
}
}

namespace lru {
typedef short bf16x8 __attribute__((ext_vector_type(8)));
typedef float f32x4 __attribute__((ext_vector_type(4)));
typedef unsigned u32x2 __attribute__((ext_vector_type(2)));
typedef unsigned u32x4 __attribute__((ext_vector_type(4)));
constexpr int CH = 64, NCHUNK = M_ALL / CH;
constexpr int US = 129;
constexpr int UBS = 272;
constexpr int L_OFF_U = 0, L_OFF_UB = CH * US * 4, L_LDS = L_OFF_UB + CH * UBS;
constexpr size_t SZ_WBLK = (size_t)LRU_BW * LRU_BW;
struct Bufs { bf16_t* HLOC; bf16_t* ACUM; float* LSUM; float* HIN; };
struct LocalArgs { const bf16_t* P; const float* conv_w; const float* conv_b; const bf16_t* WG;   const float* ba; const float* bx; const float* lam; Bufs B; };

__device__ __forceinline__ unsigned pk2(float lo, float hi) { return (unsigned)f2bf(lo) | ((unsigned)f2bf(hi) << 16); }

__device__ __forceinline__ void local_task(const LocalArgs& A, char* lds, int cix, int nb, const int tid_in) {
    int tid_ = tid_in; asm volatile("" : "+v"(tid_));
    const int tid = tid_, wid = __builtin_amdgcn_readfirstlane(tid >> 6), lane = tid & 63, q = lane >> 4, tl = lane & 15;
    float* Us = (float*)(lds + L_OFF_U); char* Ub = lds + L_OFF_UB;
    const int row0 = cix * CH; const RowInfo r0i = row_info(row0);
    LDS_BARRIER();
    {
        const int grp = tid & 15, t2 = tid >> 4, c0 = grp * 8, ch0 = nb * LRU_BW + c0;
        float wgt[4][8], bia[8];
#pragma unroll
        for (int j = 0; j < 4; ++j) { const f32x4 w0 = *(const f32x4*)(A.conv_w + j * LRU_W + ch0), w1 = *(const f32x4*)(A.conv_w + j * LRU_W + ch0 + 4);
#pragma unroll
            for (int e = 0; e < 4; ++e) { wgt[j][e] = w0[e]; wgt[j][4 + e] = w1[e]; } }
        { const f32x4 b0 = *(const f32x4*)(A.conv_b + ch0), b1 = *(const f32x4*)(A.conv_b + ch0 + 4);
#pragma unroll
          for (int e = 0; e < 4; ++e) { bia[e] = b0[e]; bia[4 + e] = b1[e]; } }
        u32x4 xr[5];
#pragma unroll
        for (int k = 0; k < 5; ++k) { const int tt = r0i.t + 2 * t2 + k - 1;
            xr[k] = (tt >= 0 && tt < r0i.T) ? *(const u32x4*)(A.P + (size_t)(r0i.base + tt) * NP + C_LRU_X + ch0) : (u32x4){0u, 0u, 0u, 0u}; }
#pragma unroll
        for (int i = 0; i < 2; ++i) { float acc[8];
#pragma unroll
            for (int e = 0; e < 8; ++e) acc[e] = bia[e];
#pragma unroll
            for (int j = 0; j < 4; ++j) { const u32x4 xv = xr[i + j];
#pragma unroll
                for (int e = 0; e < 4; ++e) { acc[2 * e] += wgt[j][2 * e] * bflo(xv[e]); acc[2 * e + 1] += wgt[j][2 * e + 1] * bfhi(xv[e]); } }
            const int tok = 2 * t2 + i;
#pragma unroll
            for (int e = 0; e < 8; ++e) Us[tok * US + c0 + e] = acc[e];
            *(u32x4*)(Ub + tok * UBS + c0 * 2) = (u32x4){pk2(acc[0], acc[1]), pk2(acc[2], acc[3]), pk2(acc[4], acc[5]), pk2(acc[6], acc[7])}; }
    }
    LDS_BARRIER();
    f32x4 acc[2][2][4];
#pragma unroll
    for (int d = 0; d < 2; ++d)
#pragma unroll
        for (int wh = 0; wh < 2; ++wh)
#pragma unroll
            for (int tb = 0; tb < 4; ++tb) acc[d][wh][tb] = (f32x4){0.f, 0.f, 0.f, 0.f};
#pragma unroll
    for (int s = 0; s < 4; ++s) {
        bf16x8 bfr[4];
#pragma unroll
        for (int tb = 0; tb < 4; ++tb) bfr[tb] = *(const bf16x8*)(Ub + (16 * tb + tl) * UBS + (32 * s + 8 * q) * 2);
#pragma unroll
        for (int d = 0; d < 2; ++d)
#pragma unroll
            for (int wh = 0; wh < 2; ++wh) { const bf16x8 a = *(const bf16x8*)(A.WG + ((size_t)((d * 2 + wh) * NH + nb)) * SZ_WBLK + (size_t)(16 * wid + tl) * LRU_BW + 32 * s + 8 * q);
#pragma unroll
                for (int tb = 0; tb < 4; ++tb) acc[d][wh][tb] = __builtin_amdgcn_mfma_f32_16x16x32_bf16(a, bfr[tb], acc[d][wh][tb], 0, 0, 0); }
    }
    const int chb = nb * LRU_BW + 16 * wid + 4 * q;
#pragma unroll
    for (int d = 0; d < 2; ++d) {
        float sp[4], bav[4], bxv[4];
#pragma unroll
        for (int r = 0; r < 4; ++r) { sp[r] = -LRU_C * softplusf_(-A.lam[d * LRU_W + chb + r]); bav[r] = A.ba[d * LRU_W + chb + r]; bxv[r] = A.bx[d * LRU_W + chb + r]; }
        float Ac[4], Bc[4];
#pragma unroll
        for (int r = 0; r < 4; ++r) { Ac[r] = 1.f; Bc[r] = 0.f; }
#pragma unroll
        for (int tbi = 0; tbi < 4; ++tbi) { const int tb = d == 0 ? tbi : 3 - tbi; const int tok = 16 * tb + tl;
            float a[4], b[4];
#pragma unroll
            for (int r = 0; r < 4; ++r) { const float rr = __builtin_amdgcn_rcpf(1.0f + __expf(-(acc[d][0][tb][r] + bav[r]))), ii = __builtin_amdgcn_rcpf(1.0f + __expf(-(acc[d][1][tb][r] + bxv[r])));
                const float log_a = sp[r] * rr, x2 = 2.0f * log_a; a[r] = __expf(log_a);
                float em = 1.0f + x2 * (1.0f / 6.0f); em = 1.0f + x2 * 0.2f * em; em = 1.0f + x2 * 0.25f * em; em = 1.0f + x2 * (1.0f / 3.0f) * em; em = 1.0f + x2 * 0.5f * em; em = -x2 * em;
                if (__builtin_expect(x2 < -0.25f, 0)) em = -expm1f(x2);
                b[r] = __builtin_amdgcn_sqrtf(em) * ii * Us[tok * US + 16 * wid + 4 * q + r]; }
#define LRU_SCAN_STEP(CTRL) do { _Pragma("unroll") for (int r = 0; r < 4; ++r) { \
                const float ap = __int_as_float(__builtin_amdgcn_update_dpp(0x3f800000, __float_as_int(a[r]), (CTRL), 0xf, 0xf, false)); \
                const float bp = __int_as_float(__builtin_amdgcn_update_dpp(0, __float_as_int(b[r]), (CTRL), 0xf, 0xf, false)); \
                b[r] = a[r] * bp + b[r]; a[r] = a[r] * ap; } } while (0)
            if (d == 0) { LRU_SCAN_STEP(0x111); LRU_SCAN_STEP(0x112); LRU_SCAN_STEP(0x114); LRU_SCAN_STEP(0x118); }
            else        { LRU_SCAN_STEP(0x101); LRU_SCAN_STEP(0x102); LRU_SCAN_STEP(0x104); LRU_SCAN_STEP(0x108); }
#undef LRU_SCAN_STEP
#pragma unroll
            for (int r = 0; r < 4; ++r) { b[r] = a[r] * Bc[r] + b[r]; a[r] = a[r] * Ac[r]; }
            { const size_t o = ((size_t)d * M_ALL + row0 + tok) * LRU_W + chb;
              *(u32x2*)(A.B.HLOC + o) = (u32x2){pk2(b[0], b[1]), pk2(b[2], b[3])}; *(u32x2*)(A.B.ACUM + o) = (u32x2){pk2(a[0], a[1]), pk2(a[2], a[3])}; }
#pragma unroll
            for (int r = 0; r < 4; ++r) { const int sl = (lane & ~15) | (d == 0 ? 15 : 0); Ac[r] = lane_get(a[r], sl); Bc[r] = lane_get(b[r], sl); }
        }
        if (tl == 0) { float* ls = A.B.LSUM + (((size_t)cix * 2 + d) * 2) * LRU_W + chb;
            *(f32x4*)ls = (f32x4){Ac[0], Ac[1], Ac[2], Ac[3]}; *(f32x4*)(ls + LRU_W) = (f32x4){Bc[0], Bc[1], Bc[2], Bc[3]}; }
    }
}
__device__ __forceinline__ void local_phase(const LocalArgs& A, char* lds, int G, int wg, const int tid) {
    for (int j = wg; j < 2 * NCHUNK * NH; j += G) if (j >= NCHUNK * NH) { const int t = j - NCHUNK * NH; local_task(A, lds, t / NH, t % NH, tid); }
}
__device__ __forceinline__ void carry_phase(const Bufs& B, int gtid, int gthreads) {
    constexpr int NC = CTX_LEN / CH, NL = SEQ / CH;
    for (int i = gtid; i < BATCH * 2 * LRU_W; i += gthreads) { const int ch = i % LRU_W, d = (i / LRU_W) & 1, b = i / (2 * LRU_W);
        float h = 0.f;
        for (int s0 = 0; s0 < NC + NL; s0 += 12) {
            float av[12], bv[12]; int cx[12];
#pragma unroll
            for (int u = 0; u < 12; ++u) { const int step = s0 + u; int cix = 0;
                if (step < NC) { const int n = d ? NC - 1 - step : step; cix = M_LAT / CH + b * NC + n; }
                else if (step < NC + NL) { const int s2 = step - NC, n = d ? NL - 1 - s2 : s2; cix = b * NL + n; }
                cx[u] = cix; const float* ls = B.LSUM + (((size_t)cix * 2 + d) * 2) * LRU_W + ch; av[u] = ls[0]; bv[u] = ls[LRU_W]; }
#pragma unroll
            for (int u = 0; u < 12; ++u) if (s0 + u < NC + NL) { B.HIN[((size_t)cx[u] * 2 + d) * LRU_W + ch] = h; h = av[u] * h + bv[u]; }
        }
    }
}
__device__ __forceinline__ void finish_phase(const Bufs& B, const bf16_t* P, bf16_t* Y, int gtid, int gthreads) {
    for (int it = gtid; it < M_ALL * (LRU_W / 8); it += gthreads) { const int row = it / (LRU_W / 8), c0 = (it % (LRU_W / 8)) * 8, cix = row / CH;
        const u32x4 h0 = *(const u32x4*)(B.HLOC + (size_t)row * LRU_W + c0), a0 = *(const u32x4*)(B.ACUM + (size_t)row * LRU_W + c0);
        const u32x4 h1 = *(const u32x4*)(B.HLOC + ((size_t)M_ALL + row) * LRU_W + c0), a1 = *(const u32x4*)(B.ACUM + ((size_t)M_ALL + row) * LRU_W + c0);
        const u32x4 gt = *(const u32x4*)(P + (size_t)row * NP + C_LRU_G + c0);
        const float* i0 = B.HIN + ((size_t)cix * 2 + 0) * LRU_W + c0; const float* i1 = B.HIN + ((size_t)cix * 2 + 1) * LRU_W + c0;
        const f32x4 i0a = *(const f32x4*)i0, i0b = *(const f32x4*)(i0 + 4), i1a = *(const f32x4*)i1, i1b = *(const f32x4*)(i1 + 4);
        float y[8];
#pragma unroll
        for (int j = 0; j < 4; ++j) { const unsigned hw0 = h0[j], aw0 = a0[j], hw1 = h1[j], aw1 = a1[j], gw = gt[j];
            const float in0l = j < 2 ? i0a[2 * j] : i0b[2 * j - 4], in0h = j < 2 ? i0a[2 * j + 1] : i0b[2 * j - 3], in1l = j < 2 ? i1a[2 * j] : i1b[2 * j - 4], in1h = j < 2 ? i1a[2 * j + 1] : i1b[2 * j - 3];
            y[2 * j] = (bflo(hw0) + bflo(aw0) * in0l + bflo(hw1) + bflo(aw1) * in1l) * geluf_(bflo(gw));
            y[2 * j + 1] = (bfhi(hw0) + bfhi(aw0) * in0h + bfhi(hw1) + bfhi(aw1) * in1h) * geluf_(bfhi(gw)); }
        *(u32x4*)(Y + (size_t)row * D_MODEL + c0) = (u32x4){pk2(y[0], y[1]), pk2(y[2], y[3]), pk2(y[4], y[5]), pk2(y[6], y[7])};
    }
}
}

namespace misc {
typedef float f32x4 __attribute__((ext_vector_type(4)));
typedef unsigned u32x2 __attribute__((ext_vector_type(2)));
typedef unsigned u32x4 __attribute__((ext_vector_type(4)));
__device__ __forceinline__ unsigned pk2(float lo, float hi) { return (unsigned)f2bf(lo) | ((unsigned)f2bf(hi) << 16); }
__device__ __forceinline__ float wave_sum(float v, int lane) {
#pragma unroll
    for (int o = 1; o < 64; o <<= 1) v += lane_xor(v, o, lane);
    return v;
}
__device__ __forceinline__ float sum16(float v, int lane) {
#pragma unroll
    for (int o = 1; o < 16; o <<= 1) v += lane_xor(v, o, lane);
    return v;
}
__device__ __forceinline__ void norm_phase(float* H, const float* g, const float* MODl, int sh_idx, bf16_t* U, int nrows, int gwave, int nwaves, int lane,
                                           const float* PART, int nparts, const float* pgate) {
    static_assert(D_MODEL == 2048, "norm_phase geometry");
    for (int r = gwave; r < nrows; r += nwaves) {
        const int set = r < M_LAT ? r / SEQ : BATCH;
        f32x4* hr = (f32x4*)(H + (size_t)r * D_MODEL) + lane;
        f32x4 v[8]; float ss = 0.f;
#pragma unroll
        for (int j = 0; j < 8; ++j) v[j] = hr[64 * j];
        if (PART != nullptr && r >= M_LAT) {
            const f32x4* gp = (const f32x4*)pgate + lane;
#pragma unroll
            for (int j = 0; j < 8; ++j) { f32x4 acc = {0.f, 0.f, 0.f, 0.f};
                for (int s = 0; s < nparts; ++s) acc += *((const f32x4*)(PART + ((size_t)s * M_CTX + (r - M_LAT)) * D_MODEL) + lane + 64 * j);
                v[j] += gp[64 * j] * acc; hr[64 * j] = v[j]; }
        }
#pragma unroll
        for (int j = 0; j < 8; ++j) ss += (v[j][0] * v[j][0] + v[j][1] * v[j][1]) + (v[j][2] * v[j][2] + v[j][3] * v[j][3]);
        const float rstd = 1.0f / sqrtf(wave_sum(ss, lane) * (1.0f / D_MODEL) + EPS);
        const f32x4* gp = (const f32x4*)g + lane; const f32x4* shp = (const f32x4*)(MODl + (size_t)set * NMODV + (size_t)sh_idx * D_MODEL) + lane; const f32x4* scp = shp + D_MODEL / 4;
        u32x2* o = (u32x2*)(U + (size_t)r * D_MODEL) + lane;
#pragma unroll
        for (int j = 0; j < 8; ++j) { const f32x4 gg = gp[64 * j], sh = shp[64 * j], sc = scp[64 * j]; f32x4 y;
#pragma unroll
            for (int e = 0; e < 4; ++e) y[e] = v[j][e] * rstd * gg[e] * (1.0f + sc[e]) + sh[e];
            o[64 * j] = (u32x2){pk2(y[0], y[1]), pk2(y[2], y[3])}; }
    }
}
struct RowNormArgs { const bf16_t* P; const float *qa_g, *kva_g, *na_qn_g, *na_kn_g; bf16_t *CQN, *CKVN, *NQ, *NK; };
__device__ __forceinline__ void rownorm_phase(const RowNormArgs& A, int gwave, int nwaves, int lane) {
    static_assert(MLA_Q_LORA == 384 && MLA_KV_LORA == 256 && GROUP_W == 512 && HD == 128, "rownorm geometry");
    for (int r = gwave; r < M_ALL; r += nwaves) { const bf16_t* p = A.P + (size_t)r * NP;
        { float x[6], ss = 0.f;
#pragma unroll
          for (int j = 0; j < 3; ++j) { const unsigned w = *(const unsigned*)(p + C_CQ + 2 * lane + 128 * j); x[2 * j] = bflo(w); x[2 * j + 1] = bfhi(w); ss += x[2 * j] * x[2 * j] + x[2 * j + 1] * x[2 * j + 1]; }
          const float rstd = 1.0f / sqrtf(wave_sum(ss, lane) * (1.0f / MLA_Q_LORA) + EPS);
#pragma unroll
          for (int j = 0; j < 3; ++j) { const int c = 2 * lane + 128 * j; *(unsigned*)(A.CQN + (size_t)r * MLA_Q_LORA + c) = pk2(x[2 * j] * rstd * A.qa_g[c], x[2 * j + 1] * rstd * A.qa_g[c + 1]); } }
        { float x[4], ss = 0.f;
#pragma unroll
          for (int j = 0; j < 2; ++j) { const unsigned w = *(const unsigned*)(p + C_CKV + 2 * lane + 128 * j); x[2 * j] = bflo(w); x[2 * j + 1] = bfhi(w); ss += x[2 * j] * x[2 * j] + x[2 * j + 1] * x[2 * j + 1]; }
          const float rstd = 1.0f / sqrtf(wave_sum(ss, lane) * (1.0f / MLA_KV_LORA) + EPS);
#pragma unroll
          for (int j = 0; j < 2; ++j) { const int c = 2 * lane + 128 * j; *(unsigned*)(A.CKVN + (size_t)r * MLA_KV_LORA + c) = pk2(x[2 * j] * rstd * A.kva_g[c], x[2 * j + 1] * rstd * A.kva_g[c + 1]); } }
#pragma unroll
        for (int which = 0; which < 2; ++which) {
            const int hh = lane >> 4, d0 = (lane & 15) * 8; const u32x4 w = *(const u32x4*)(p + (which == 0 ? C_NQ : C_NK) + hh * HD + d0);
            float x[8]; float ss = 0.f;
#pragma unroll
            for (int j = 0; j < 4; ++j) { x[2 * j] = bflo(w[j]); x[2 * j + 1] = bfhi(w[j]); ss += x[2 * j] * x[2 * j] + x[2 * j + 1] * x[2 * j + 1]; }
            const float rstd = 1.0f / sqrtf(sum16(ss, lane) * (1.0f / HD) + EPS); const float* g = (which == 0 ? A.na_qn_g : A.na_kn_g) + d0;
            *(u32x4*)((which == 0 ? A.NQ : A.NK) + (size_t)r * GROUP_W + hh * HD + d0) =
                (u32x4){pk2(x[0] * rstd * g[0], x[1] * rstd * g[1]), pk2(x[2] * rstd * g[2], x[3] * rstd * g[3]), pk2(x[4] * rstd * g[4], x[5] * rstd * g[5]), pk2(x[6] * rstd * g[6], x[7] * rstd * g[7])};
        }
    }
}
struct MlaQkvArgs { const bf16_t* QR; const bf16_t* KVR; const bf16_t* P; const float *qn_g, *kn_g; bf16_t *QM, *KM, *VM; };
__device__ __forceinline__ void mlaqkv_phase(const MlaQkvArgs& A, int gwave, int nwaves, int lane) {
    static_assert(MLA_QK == 192 && MLA_NOPE == 128 && MLA_ROPE == 64 && NH == 4, "mla qkv geometry");
    const int hh = lane >> 4, g = lane & 15;
    const float inv = powf(10000.0f, -(float)g / 16.0f);
    for (int r = gwave; r < M_ALL; r += nwaves) {
        const bool lat = r < M_LAT; const int t = lat ? r % SEQ : 0;
        float cr = 1.f, sr = 0.f, cc = 1.f, sc = 0.f;
        if (lat) { sincosf((float)(t / GRID_W) * inv, &sr, &cr); sincosf((float)(t % GRID_W) * inv, &sc, &cc); }
#pragma unroll
        for (int which = 0; which < 2; ++which) {
            float x[12]; float ss = 0.f;
            if (which == 0) { const bf16_t* src = A.QR + (size_t)r * NQ_MLA + hh * MLA_QK + g;
#pragma unroll
                for (int i = 0; i < 12; ++i) x[i] = bf2f(src[16 * i]); }
            else { const bf16_t* src = A.KVR + (size_t)r * NKV_MLA + hh * (MLA_NOPE + MLA_V) + g; const bf16_t* kr = A.P + (size_t)r * NP + C_KR + g;
#pragma unroll
                for (int i = 0; i < 8; ++i) x[i] = bf2f(src[16 * i]);
#pragma unroll
                for (int i = 0; i < 4; ++i) x[8 + i] = bf2f(kr[16 * i]); }
#pragma unroll
            for (int i = 0; i < 12; ++i) ss += x[i] * x[i];
            const float rstd = 1.0f / sqrtf(sum16(ss, lane) * (1.0f / MLA_QK) + EPS); const float* gn = (which == 0 ? A.qn_g : A.kn_g) + g;
#pragma unroll
            for (int i = 0; i < 12; ++i) x[i] = x[i] * rstd * gn[16 * i];
            { const float a0 = x[8], b0 = x[10]; x[8] = a0 * cr - b0 * sr; x[10] = a0 * sr + b0 * cr;
              const float a1 = x[9], b1 = x[11]; x[9] = a1 * cc - b1 * sc; x[11] = a1 * sc + b1 * cc; }
            bf16_t* O = (which == 0 ? A.QM : A.KM) + (size_t)r * NQ_MLA + hh * MLA_QK + g;
#pragma unroll
            for (int i = 0; i < 12; ++i) O[16 * i] = f2bf(x[i]);
        }
        { const bf16_t* vs = A.KVR + (size_t)r * NKV_MLA + hh * (MLA_NOPE + MLA_V) + MLA_NOPE + g; bf16_t* O = A.VM + (size_t)r * (NH * MLA_V) + hh * MLA_V + g;
#pragma unroll
          for (int i = 0; i < 8; ++i) O[16 * i] = vs[16 * i]; }
    }
}
constexpr int ACT_RUN = 32;
__device__ __forceinline__ void act_phase(const bf16_t* UP, const float* cw, const float* cb, bf16_t* ACT, int nrows, int gtid, int gthreads) {
    constexpr int NC8 = D_FF / 8; static_assert(SEQ % ACT_RUN == 0 && CTX_LEN % ACT_RUN == 0, "row runs stay inside one sequence");
    const int nruns = nrows / ACT_RUN;
    for (long it = gtid; it < (long)nruns * NC8; it += gthreads) { const int run = (int)(it / NC8), j0 = (int)(it % NC8) * 8, r0 = run * ACT_RUN; const RowInfo ri = row_info(r0);
        float wa[3][8], wg[3][8], ba[8], bg[8];
#pragma unroll
        for (int k = 0; k < 3; ++k) { const float* p = cw + (size_t)k * 2 * D_FF + j0; const f32x4 a0 = *(const f32x4*)p, a1 = *(const f32x4*)(p + 4), g0 = *(const f32x4*)(p + D_FF), g1 = *(const f32x4*)(p + D_FF + 4);
#pragma unroll
            for (int e = 0; e < 4; ++e) { wa[k][e] = a0[e]; wa[k][4 + e] = a1[e]; wg[k][e] = g0[e]; wg[k][4 + e] = g1[e]; } }
        { const f32x4 a0 = *(const f32x4*)(cb + j0), a1 = *(const f32x4*)(cb + j0 + 4), g0 = *(const f32x4*)(cb + D_FF + j0), g1 = *(const f32x4*)(cb + D_FF + j0 + 4);
#pragma unroll
          for (int e = 0; e < 4; ++e) { ba[e] = a0[e]; ba[4 + e] = a1[e]; bg[e] = g0[e]; bg[4 + e] = g1[e]; } }
        const u32x4 zero = {0u, 0u, 0u, 0u};
        const bf16_t* ub = UP + (size_t)ri.base * (2 * D_FF) + j0;
        u32x4 am, ac, gm, gc;
        { const int t = ri.t; am = t > 0 ? *(const u32x4*)(ub + (size_t)(t - 1) * (2 * D_FF)) : zero; gm = t > 0 ? *(const u32x4*)(ub + (size_t)(t - 1) * (2 * D_FF) + D_FF) : zero;
          ac = *(const u32x4*)(ub + (size_t)t * (2 * D_FF)); gc = *(const u32x4*)(ub + (size_t)t * (2 * D_FF) + D_FF); }
#pragma unroll 4
        for (int i = 0; i < ACT_RUN; ++i) { const int t = ri.t + i;
            const u32x4 ap = t + 1 < ri.T ? *(const u32x4*)(ub + (size_t)(t + 1) * (2 * D_FF)) : zero, gp = t + 1 < ri.T ? *(const u32x4*)(ub + (size_t)(t + 1) * (2 * D_FF) + D_FF) : zero;
            float y[8];
#pragma unroll
            for (int e = 0; e < 4; ++e) {
                const float a0 = ba[2 * e] + wa[0][2 * e] * bflo(am[e]) + wa[1][2 * e] * bflo(ac[e]) + wa[2][2 * e] * bflo(ap[e]);
                const float a1 = ba[2 * e + 1] + wa[0][2 * e + 1] * bfhi(am[e]) + wa[1][2 * e + 1] * bfhi(ac[e]) + wa[2][2 * e + 1] * bfhi(ap[e]);
                const float g0 = bg[2 * e] + wg[0][2 * e] * bflo(gm[e]) + wg[1][2 * e] * bflo(gc[e]) + wg[2][2 * e] * bflo(gp[e]);
                const float g1 = bg[2 * e + 1] + wg[0][2 * e + 1] * bfhi(gm[e]) + wg[1][2 * e + 1] * bfhi(gc[e]) + wg[2][2 * e + 1] * bfhi(gp[e]);
                y[2 * e] = a0 * (g0 / (1.0f + __expf(-g0))); y[2 * e + 1] = a1 * (g1 / (1.0f + __expf(-g1))); }
            *(u32x4*)(ACT + (size_t)(r0 + i) * D_FF + j0) = (u32x4){pk2(y[0], y[1]), pk2(y[2], y[3]), pk2(y[4], y[5]), pk2(y[6], y[7])};
            am = ac; ac = ap; gm = gc; gc = gp; }
    }
}
__device__ __forceinline__ void transpose_item(const float* W, int K, int N, int Npad, bf16_t* WT, float* scr, int item, int lane) {
    const int nblk = Npad / 32, kb = item / nblk, nb = item % nblk, k0 = 64 * kb, n0 = 32 * nb; const int n = n0 + (lane & 31); const bool ok = n < N;
#pragma unroll 8
    for (int i = 0; i < 32; ++i) { const int kk = 2 * i + (lane >> 5); scr[kk * 33 + (lane & 31)] = ok ? W[(size_t)(k0 + kk) * N + n] : 0.f; }
    asm volatile("s_waitcnt lgkmcnt(0)" ::: "memory");
    const int c = lane & 7;
#pragma unroll
    for (int j = 0; j < 4; ++j) { const int nn = (lane >> 3) + 8 * j; const float* s = scr + (8 * c) * 33 + nn;
        u32x4 o; o.x = pk2(s[0 * 33], s[1 * 33]); o.y = pk2(s[2 * 33], s[3 * 33]); o.z = pk2(s[4 * 33], s[5 * 33]); o.w = pk2(s[6 * 33], s[7 * 33]);
        *(u32x4*)(WT + (size_t)(n0 + nn) * K + k0 + 8 * c) = o; }
    asm volatile("s_waitcnt lgkmcnt(0)" ::: "memory");
}
}

__device__ __forceinline__ gdn::Bufs gdn_bufs(const WS& w, int l) { gdn::Bufs B; B.UT = w.gUT; B.WP = w.gWP; B.KDT = w.gKDT; B.QD = w.gQD; B.QK = w.gQK; B.SIT = w.gSIT; B.VNT = w.gVNT; B.GT = w.gGT + (size_t)l * gdn::NTASK; return B; }
__device__ __forceinline__ lru::Bufs lru_bufs(const WS& w) { lru::Bufs B; B.HLOC = w.lHLOC; B.ACUM = w.lACUM; B.LSUM = w.lLSUM; B.HIN = w.lHIN; return B; }

#define LAS __attribute__((address_space(3)))
#define XB_TMO      128
#define XB_XCNT(j)  (256  + 64 * (j))
#define XB_XSUB(j)  (1280 + 64 * (j))
#define XB_XGEN(j)  (2304 + 64 * (j))
#define XB_TOP      3328
#define XB_TOPGEN   3392
#define XCD_BAR_WORDS 3456
#define XB_SPIN_CAP (1u << 18)
__device__ __forceinline__ unsigned xb_ld(unsigned* p)              { return __hip_atomic_load(p, __ATOMIC_RELAXED, __HIP_MEMORY_SCOPE_AGENT); }
__device__ __forceinline__ unsigned xb_add(unsigned* p, unsigned v) { return __hip_atomic_fetch_add(p, v, __ATOMIC_RELAXED, __HIP_MEMORY_SCOPE_AGENT); }
__device__ __forceinline__ unsigned xb_xcc_id() { return (unsigned)__builtin_amdgcn_s_getreg((3 << 11) | 20) & 0xFu; }
#define XB_SPIN(cond, bar) do { unsigned _sp = 0; while (cond) { __builtin_amdgcn_s_sleep(1); \
    if ((++_sp & 255u) == 0u) { if (xb_ld(&(bar)[XB_TMO])) break; if (_sp > XB_SPIN_CAP) { atomicAdd(&(bar)[XB_TMO], 1u); break; } } } } while (0)
struct XcdBarrier { unsigned* bar; unsigned x; volatile LAS unsigned* st; };
__device__ __forceinline__ XcdBarrier xcd_barrier_post(unsigned* bar, volatile LAS unsigned* st, const bool leader) {
    XcdBarrier b; b.bar = bar; b.x = xb_xcc_id(); b.st = st;
    if (leader) (void)xb_add(&bar[XB_XCNT(b.x)], 1u);
    return b;
}
__device__ __forceinline__ void xcd_barrier_complete(unsigned* bar, unsigned x, unsigned& nloc, unsigned& nx) {
    const unsigned G = gridDim.x * gridDim.y * gridDim.z;
    unsigned sum, cnt, mine, sp = 0u;
    for (;;) {
        sum = 0u; cnt = 0u; mine = 0u;
#pragma unroll
        for (unsigned j = 0; j < 16; ++j) { const unsigned c = xb_ld(&bar[XB_XCNT(j)]); sum += c; cnt += (c > 0u) ? 1u : 0u; mine = (j == x) ? c : mine; }
        if (sum == G) break;
        __builtin_amdgcn_s_sleep(1);
        if ((++sp & 255u) == 0u) { if (xb_ld(&bar[XB_TMO])) break; if (sp > XB_SPIN_CAP) { atomicAdd(&bar[XB_TMO], 1u); break; } }
    }
    nloc = mine > 0u ? mine : 1u; nx = cnt > 0u ? cnt : 1u;
}
__device__ __forceinline__ void xcd_barrier(const XcdBarrier& b, const bool leader) {
    asm volatile("s_waitcnt vmcnt(0)" ::: "memory");
    __syncthreads();
    if (leader) {
        unsigned* bar = b.bar;
        __builtin_amdgcn_s_waitcnt(0);
        unsigned nloc = b.st[0], nx = b.st[1];
        if (nloc == 0u) { xcd_barrier_complete(bar, b.x, nloc, nx); b.st[0] = nloc; b.st[1] = nx; }
        const unsigned old = xb_add(&bar[XB_XSUB(b.x)], 1u);
        const unsigned gen = old / nloc;
        if (old + 1u == (gen + 1u) * nloc) {
            __builtin_amdgcn_fence(__ATOMIC_RELEASE, "agent");
            asm volatile("s_waitcnt vmcnt(0)" ::: "memory");
            const unsigned og = xb_add(&bar[XB_TOP], 1u);
            const unsigned tg = og / nx;
            if (og + 1u == (tg + 1u) * nx) xb_add(&bar[XB_TOPGEN], 1u);
            else XB_SPIN(xb_ld(&bar[XB_TOPGEN]) == tg, bar);
            __builtin_amdgcn_fence(__ATOMIC_ACQUIRE, "agent");
            xb_add(&bar[XB_XGEN(b.x)], 1u);
            asm volatile("s_waitcnt vmcnt(0)" ::: "memory");
        } else {
            XB_SPIN(xb_ld(&bar[XB_XGEN(b.x)]) == gen, bar);
            __builtin_amdgcn_fence(__ATOMIC_ACQUIRE, "agent");
            asm volatile("s_waitcnt vmcnt(0)" ::: "memory");
        }
    }
    __syncthreads();
}

constexpr int NWAVES = 8, NTHR = 512;
constexpr int LDS_MISC = 147456, LDS_BYTES = 148480;
static_assert(sizeof(Inputs) == 34 * 8, "Inputs mirrors Params::in");
static_assert(gdn::G1_LDS <= LDS_MISC && pg8::STAGE_BYTES <= LDS_MISC && att::Cfg<MLA_QK>::LDS_BYTES <= LDS_MISC && gdn::G2_LDS <= LDS_MISC, "LDS map");
constexpr int CW_BAR = 4096;
constexpr int G2_CUT1 = 52, G2_CUT2 = 52;
constexpr int SK_OUT = 4, SK_DOWN = 5;
constexpr int PH_PRO = 0, PH_PER_LAYER = 12, NPH = 1 + PH_PER_LAYER * DEPTH;
struct Params { const float* in[34]; float* out; unsigned char* ws; int ph_lo, ph_hi, li, pad; };

struct SplitOrder {
    int nN, nM, S, G, c;
    __device__ __forceinline__ void init(int M, int N, int S_, int G_, int c_) { nM = M / pg8::BM; nN = N / pg8::BM; S = S_; G = G_; c = c_; }
    __device__ __forceinline__ bool next(int i, pg8::Unit& u) const { const int g = c + i * G; if (g >= nM * nN * S) return false; u.ks = g / (nM * nN); const int loc = g % (nM * nN); u.pm = loc / nN; u.pn = loc % nN; return true; }
    __device__ __forceinline__ void a_ready(const pg8::Unit&) const {}
    __device__ __forceinline__ void done(const pg8::Unit&) const {}
};
struct SpanOrder {
    int nN, lo, hi, G, g0;
    __device__ __forceinline__ void init(int N, int lo_, int hi_, int G_, int c) { nN = N / pg8::BM; lo = lo_; hi = hi_; G = G_; int i0 = 0; if (c < lo_) i0 = (lo_ - c + G_ - 1) / G_; g0 = c + i0 * G_; }
    __device__ __forceinline__ bool next(int i, pg8::Unit& u) const { const int g = g0 + i * G; if (g >= hi) return false; const int loc = g - lo; u.pm = loc / nN; u.pn = loc % nN; u.ks = 0; return true; }
    __device__ __forceinline__ void a_ready(const pg8::Unit&) const {}
    __device__ __forceinline__ void done(const pg8::Unit&) const {}
};

#define AS4 __attribute__((address_space(4)))
#define PHASE_WS const AS4 Params* pp = (const AS4 Params*)__builtin_amdgcn_kernarg_segment_ptr(); asm volatile("" : "+s"(pp)); const AS4 Inputs* I = (const AS4 Inputs*)pp; (void)I; unsigned char* wsb_ = pp->ws; const WS w = ws_carve(wsb_)
#define PHASE_IDS int tid = C_wave0 * 64 + (int)__builtin_amdgcn_mbcnt_hi(~0u, __builtin_amdgcn_mbcnt_lo(~0u, 0u)); asm volatile("" : "+v"(tid)); const int lane = tid & 63, wave = __builtin_amdgcn_readfirstlane(tid >> 6), gwave = wg * NWAVES + wave, gtid = wg * NTHR + tid; (void)lane; (void)gwave; (void)gtid
#ifndef DBG_MASK
#define DBG_MASK 0xFFFFFF
#endif
#define IN(k) (lo <= (k) && (k) < hi)
#define ON(j) (((DBG_MASK) >> (j)) & 1)
#define SEAM(k) do { if (IN(k) && IN((k) + 1)) xcd_barrier(bar, C_wave0 == 0 && __builtin_amdgcn_mbcnt_hi(~0u, __builtin_amdgcn_mbcnt_lo(~0u, 0u)) == 0u); } while (0)

struct LayerCtx { int lo, hi, G, wg, nwaves, gthreads, wave0; XcdBarrier bar; char* lds; unsigned char* lds_raw; };
template <int l> __device__ __forceinline__ void layer_body(const LayerCtx& C) {
    const int lo = C.lo, hi = C.hi, G = C.G, wg = C.wg, nwaves = C.nwaves, gthreads = C.gthreads, C_wave0 = C.wave0; const XcdBarrier& bar = C.bar; char* lds = C.lds; unsigned char* lds_raw = C.lds_raw;
    (void)G; (void)nwaves; (void)gthreads;
        const int pb = 1 + PH_PER_LAYER * l;
        const bool want_ctx = l < DEPTH - 1; const int Mo = want_ctx ? M_ALL : M_LAT;
        if (ON(0) && IN(pb + 0)) { PHASE_WS; PHASE_IDS; const float* MODl = w.MOD + (size_t)l * (BATCH + 1) * NMODV; (void)MODl; misc::norm_phase(w.H, I->norm_mix_g + (size_t)l * D_MODEL, MODl, 0, w.U, M_ALL, gwave, nwaves, lane, l > 0 ? w.PART : nullptr, SK_DOWN, MODl - (size_t)(BATCH + 1) * NMODV + (size_t)BATCH * NMODV + 5 * D_MODEL); }
        SEAM(pb + 0);
        if (ON(1) && IN(pb + 1)) { PHASE_WS; PHASE_IDS; const float* MODl = w.MOD + (size_t)l * (BATCH + 1) * NMODV; (void)MODl; pg8::Gemm g{w.U, w.WIN + l * SZ_WIN, M_ALL, NP, D_MODEL, D_MODEL}; pg8::StaticOrder S; S.init(M_ALL, NP, G, wg);
            pg8::EpiBf16<0> E{w.P, NP, nullptr, 0, 0, 1.0f};
            pg8::gemm_phase<pg8::EpiBf16<0>, pg8::StaticOrder, true, true>((PG8_LAS unsigned char*)lds_raw, g, S, E, tid); }
        SEAM(pb + 1);
        if (ON(2) && IN(pb + 2)) { PHASE_WS; PHASE_IDS; const float* MODl = w.MOD + (size_t)l * (BATCH + 1) * NMODV; (void)MODl;
            const int pflags = pp->pad;
            if (!(pflags & 16)) { gdn::G1Args A; A.P = w.P; A.conv_w = I->gdn_conv_w + (size_t)l * 4 * 3 * GROUP_W; A.a_log = I->gdn_a_log + (size_t)l * 2 * NH; A.dt_bias = I->gdn_dt_bias + (size_t)l * 2 * NH; A.B = gdn_bufs(w, l); A.pflags = pflags;
              gdn::g1_phase(A, lds, G, wg, tid); }
            if (!(pflags & 32)) { lru::LocalArgs A; A.P = w.P; A.conv_w = I->lru_conv_w + (size_t)l * 4 * LRU_W; A.conv_b = I->lru_conv_b + (size_t)l * LRU_W; A.WG = w.WLRU + (size_t)l * 16 * lru::SZ_WBLK;
              A.ba = I->lru_ba + (size_t)l * 2 * LRU_W; A.bx = I->lru_bx + (size_t)l * 2 * LRU_W; A.lam = I->lru_lam + (size_t)l * 2 * LRU_W; A.B = lru_bufs(w);
              lru::local_phase(A, lds, G, wg, tid); }
            if (!(pflags & 64)) { misc::RowNormArgs A; A.P = w.P; A.qa_g = I->mla_qa_g + (size_t)l * MLA_Q_LORA; A.kva_g = I->mla_kva_g + (size_t)l * MLA_KV_LORA; A.na_qn_g = I->na_qn_g + (size_t)l * HD; A.na_kn_g = I->na_kn_g + (size_t)l * HD;
              A.CQN = w.CQN; A.CKVN = w.CKVN; A.NQ = w.NQ; A.NK = w.NK; misc::rownorm_phase(A, gwave, nwaves, lane); }
        }
        SEAM(pb + 2);
        if (ON(3) && IN(pb + 3)) { PHASE_WS; PHASE_IDS; const float* MODl = w.MOD + (size_t)l * (BATCH + 1) * NMODV; (void)MODl;
            if (wg < gdn::G2_WGS) gdn::g2_chain(gdn_bufs(w, l), lds, wg, tid, 0, G2_CUT1, w.gSS);
            else {
            constexpr int UQ = (M_ALL / 256) * (NQ_MLA / 256), UKV = (M_ALL / 256) * (NKV_MLA / 256); const int G2n = G - gdn::G2_WGS, c2 = wg - gdn::G2_WGS;
            { pg8::Gemm g{w.CQN, w.WUQ + l * SZ_WUQ, M_ALL, NQ_MLA, MLA_Q_LORA, MLA_Q_LORA}; SpanOrder S; S.init(NQ_MLA, 0, UQ, G2n, c2); pg8::EpiBf16<0> E{w.QR, NQ_MLA, nullptr, 0, 0, 1.0f};
              pg8::gemm_phase<pg8::EpiBf16<0>, SpanOrder, true, true>((PG8_LAS unsigned char*)lds_raw, g, S, E, tid); }
            { pg8::Gemm g{w.CKVN, w.WUKV + l * SZ_WUKV, M_ALL, NKV_MLA, MLA_KV_LORA, MLA_KV_LORA}; SpanOrder S; S.init(NKV_MLA, UQ, UQ + UKV, G2n, c2); pg8::EpiBf16<0> E{w.KVR, NKV_MLA, nullptr, 0, 0, 1.0f};
              pg8::gemm_phase<pg8::EpiBf16<0>, SpanOrder, true, true>((PG8_LAS unsigned char*)lds_raw, g, S, E, tid); }
            }
        }
        SEAM(pb + 3);
        if (ON(4) && IN(pb + 4)) { PHASE_WS; PHASE_IDS; const float* MODl = w.MOD + (size_t)l * (BATCH + 1) * NMODV; (void)MODl;
            { misc::MlaQkvArgs A; A.QR = w.QR; A.KVR = w.KVR; A.P = w.P; A.qn_g = I->mla_qn_g + (size_t)l * MLA_QK; A.kn_g = I->mla_kn_g + (size_t)l * MLA_QK; A.QM = w.QM; A.KM = w.KM; A.VM = w.VM;
              misc::mlaqkv_phase(A, gwave, nwaves, lane); }
            lru::carry_phase(lru_bufs(w), gtid, gthreads);
        }
        SEAM(pb + 4);
        if (ON(5) && IN(pb + 5)) { PHASE_WS; PHASE_IDS; const float* MODl = w.MOD + (size_t)l * (BATCH + 1) * NMODV; (void)MODl;
            const int pflags = pp->pad;
            if (wg < gdn::G2_WGS && !(pflags & 1)) gdn::g2_chain(gdn_bufs(w, l), lds, wg, tid, G2_CUT2, gdn::G2_NSTEP, w.gSS);
            AttnArgs A; A.QM = w.QM; A.KM = w.KM; A.VM = w.VM; A.NQ = w.NQ; A.NK = w.NK; A.P = w.P; A.Y = w.Y; A.rpb = I->na_rpb + (size_t)l * NH * (2 * NA_KH - 1) * (2 * NA_KW - 1); A.want_ctx = want_ctx ? 1 : 0; A.pad = pflags;
            attention_phase(A, lds, G, wg, tid, gdn::G2_WGS);
        }
        SEAM(pb + 5);
        if (ON(6) && IN(pb + 6)) { PHASE_WS; PHASE_IDS; const float* MODl = w.MOD + (size_t)l * (BATCH + 1) * NMODV; (void)MODl;
            const int pflags = pp->pad;
            if (!(pflags & 128)) { gdn::G3Args A; A.B = gdn_bufs(w, l); A.P = w.P; A.norm_g = I->gdn_norm_g + (size_t)l * HD; A.Y = w.Y; gdn::g3_phase(A, lds, G, wg, tid); }
            if (!(pflags & 256)) lru::finish_phase(lru_bufs(w), w.P, w.Y, gtid, gthreads);
        }
        SEAM(pb + 6);
        if (ON(7) && IN(pb + 7)) { PHASE_WS; PHASE_IDS; const float* MODl = w.MOD + (size_t)l * (BATCH + 1) * NMODV; (void)MODl;
            { pg8::Gemm g{w.Y, w.WOUT + l * SZ_WOUT, M_LAT, D_MODEL, D_MODEL, D_MODEL}; pg8::StaticOrder S; S.init(M_LAT, D_MODEL, G, wg);
              pg8::EpiGateRes E{w.H, w.H, D_MODEL, MODl + 2 * D_MODEL, NMODV, SEQ, BATCH, M_LAT};
              pg8::gemm_phase<pg8::EpiGateRes, pg8::StaticOrder, true, true>((PG8_LAS unsigned char*)lds_raw, g, S, E, tid); }
            if (want_ctx) { constexpr int SK = SK_OUT;
              pg8::Gemm g{w.Y + (size_t)M_LAT * D_MODEL, w.WOUT + l * SZ_WOUT, M_CTX, D_MODEL, D_MODEL / SK, D_MODEL}; SplitOrder S; S.init(M_CTX, D_MODEL, SK, G, (wg + G / 2) % G);
              pg8::EpiPart E{w.PART, D_MODEL, (size_t)M_CTX * D_MODEL};
              pg8::gemm_phase<pg8::EpiPart, SplitOrder, true, true>((PG8_LAS unsigned char*)lds_raw, g, S, E, tid); } }
        SEAM(pb + 7);
        if (ON(8) && IN(pb + 8)) { PHASE_WS; PHASE_IDS; const float* MODl = w.MOD + (size_t)l * (BATCH + 1) * NMODV; (void)MODl; misc::norm_phase(w.H, I->norm_ffn_g + (size_t)l * D_MODEL, MODl, 3, w.U, Mo, gwave, nwaves, lane, want_ctx ? w.PART : nullptr, SK_OUT, MODl + (size_t)BATCH * NMODV + 2 * D_MODEL); }
        SEAM(pb + 8);
        if (ON(9) && IN(pb + 9)) { PHASE_WS; PHASE_IDS; const float* MODl = w.MOD + (size_t)l * (BATCH + 1) * NMODV; (void)MODl; pg8::Gemm g{w.U, w.WUP + l * SZ_WUP, Mo, 2 * D_FF, D_MODEL, D_MODEL}; pg8::StaticOrder S; S.init(Mo, 2 * D_FF, G, wg);
            pg8::EpiBf16<0> E{w.UP, 2 * D_FF, nullptr, 0, 0, 1.0f};
            pg8::gemm_phase<pg8::EpiBf16<0>, pg8::StaticOrder, true, true>((PG8_LAS unsigned char*)lds_raw, g, S, E, tid); }
        SEAM(pb + 9);
        if (ON(10) && IN(pb + 10)) { PHASE_WS; PHASE_IDS; const float* MODl = w.MOD + (size_t)l * (BATCH + 1) * NMODV; (void)MODl; misc::act_phase(w.UP, I->ffn_conv_w + (size_t)l * 3 * 2 * D_FF, I->ffn_conv_b + (size_t)l * 2 * D_FF, w.ACT, Mo, gtid, gthreads); }
        SEAM(pb + 10);
        if (ON(11) && IN(pb + 11)) { PHASE_WS; PHASE_IDS; const float* MODl = w.MOD + (size_t)l * (BATCH + 1) * NMODV; (void)MODl;
            { pg8::Gemm g{w.ACT, w.WDOWN + l * SZ_WDOWN, M_LAT, D_MODEL, D_FF, D_FF}; pg8::StaticOrder S; S.init(M_LAT, D_MODEL, G, wg);
              pg8::EpiGateRes E{w.H, want_ctx ? w.H : pp->out, D_MODEL, MODl + 5 * D_MODEL, NMODV, SEQ, BATCH, M_LAT};
              pg8::gemm_phase<pg8::EpiGateRes, pg8::StaticOrder, true, true>((PG8_LAS unsigned char*)lds_raw, g, S, E, tid); }
            if (want_ctx) { constexpr int SK = SK_DOWN;
              pg8::Gemm g{w.ACT + (size_t)M_LAT * D_FF, w.WDOWN + l * SZ_WDOWN, M_CTX, D_MODEL, D_FF / SK, D_FF}; SplitOrder S; S.init(M_CTX, D_MODEL, SK, G, (wg + G / 2) % G);
              pg8::EpiPart E{w.PART, D_MODEL, (size_t)M_CTX * D_MODEL};
              pg8::gemm_phase<pg8::EpiPart, SplitOrder, true, true>((PG8_LAS unsigned char*)lds_raw, g, S, E, tid); } }
        SEAM(pb + 11);

}
__global__ void __launch_bounds__(NTHR, 2) fwd(Params p) {
    extern __shared__ __attribute__((aligned(16))) unsigned char lds_raw[];
    char* lds = (char*)lds_raw;
    const int G = (int)gridDim.x, wg = (int)blockIdx.x, nwaves = G * NWAVES, gthreads = G * NTHR;
    const int C_wave0 = __builtin_amdgcn_readfirstlane((int)threadIdx.x >> 6);
    volatile LAS unsigned* MISC = (volatile LAS unsigned*)(lds_raw + LDS_MISC);
    if (threadIdx.x < 32) MISC[threadIdx.x] = 0u;
    __syncthreads();
    const int lo = p.ph_lo, hi = p.ph_hi;
    unsigned* const barw = (unsigned*)p.ws + CW_BAR + (size_t)p.li * XCD_BAR_WORDS;
    XcdBarrier bar; bar.bar = barw; bar.x = 0; bar.st = MISC + 8;
    if (hi - lo > 1) bar = xcd_barrier_post(barw, MISC + 8, threadIdx.x == 0);

    if (ON(12) && IN(PH_PRO)) { PHASE_WS; PHASE_IDS;
        {
            float* SCs = (float*)lds;
            float* red = (float*)(lds + 3 * D_MODEL * 4);
            constexpr int NT = DEPTH * NMODV / 256;
            if (wg < NT) {
                for (int i = tid; i < (BATCH + 1) * D_MODEL; i += NTHR) { const int s = i / D_MODEL, k = i % D_MODEL; const float v = s < BATCH ? I->c[s * D_MODEL + k] : I->c_ctx[k]; SCs[i] = v / (1.0f + __expf(-v)); }
                __syncthreads();
            }
            for (int t = wg; t < NT; t += G) { const int l = t / (NMODV / 256), j0 = (t % (NMODV / 256)) * 256;
                misc::f32x4 acc[3] = {{0.f, 0.f, 0.f, 0.f}, {0.f, 0.f, 0.f, 0.f}, {0.f, 0.f, 0.f, 0.f}};
                const float* wp = I->ada_w + (size_t)l * D_MODEL * NMODV + (size_t)(256 * wave) * NMODV + j0 + 4 * lane;
#pragma unroll 8
                for (int k = 0; k < 256; ++k) { const misc::f32x4 wv = *(const misc::f32x4*)(wp + (size_t)k * NMODV); const int kk = 256 * wave + k;
                    acc[0] += wv * SCs[kk]; acc[1] += wv * SCs[D_MODEL + kk]; acc[2] += wv * SCs[2 * D_MODEL + kk]; }
                __syncthreads();
#pragma unroll
                for (int s = 0; s < 3; ++s) *(misc::f32x4*)(red + (wave * 3 + s) * 256 + 4 * lane) = acc[s];
                __syncthreads();
                for (int i = tid; i < 3 * 256; i += NTHR) { const int s = i / 256, c = i % 256; float sum = I->ada_b[(size_t)l * NMODV + j0 + c];
#pragma unroll
                    for (int w8 = 0; w8 < 8; ++w8) sum += red[(w8 * 3 + s) * 256 + c];
                    w.MOD[((size_t)l * (BATCH + 1) + s) * NMODV + j0 + c] = sum; }
            }
            __syncthreads();
        }
        {
            float* scr = (float*)(lds + wave * 8448);
            constexpr int I_IN = (D_MODEL / 64) * (NP / 32), I_OUT = (D_MODEL / 64) * (D_MODEL / 32), I_UP = (D_MODEL / 64) * (2 * D_FF / 32), I_DN = (D_FF / 64) * (D_MODEL / 32),
                          I_UQ = (MLA_Q_LORA / 64) * (NQ_MLA / 32), I_UKV = (MLA_KV_LORA / 64) * (NKV_MLA / 32), I_LB = (LRU_BW / 64) * (LRU_BW / 32), I_LRU = 2 * 2 * NH * I_LB;
            constexpr int I_LAYER = I_IN + I_OUT + I_UP + I_DN + I_UQ + I_UKV + I_LRU;
            for (int it = gwave; it < DEPTH * I_LAYER; it += nwaves) { const int l = it / I_LAYER; int r = it % I_LAYER;
                if (r < I_IN) { misc::transpose_item(I->w_in + (size_t)l * D_MODEL * IN_COLS, D_MODEL, IN_COLS, NP, w.WIN + l * SZ_WIN, scr, r, lane); continue; } r -= I_IN;
                if (r < I_OUT) { misc::transpose_item(I->w_out + (size_t)l * D_MODEL * D_MODEL, D_MODEL, D_MODEL, D_MODEL, w.WOUT + l * SZ_WOUT, scr, r, lane); continue; } r -= I_OUT;
                if (r < I_UP) { misc::transpose_item(I->ffn_w_up + (size_t)l * D_MODEL * 2 * D_FF, D_MODEL, 2 * D_FF, 2 * D_FF, w.WUP + l * SZ_WUP, scr, r, lane); continue; } r -= I_UP;
                if (r < I_DN) { misc::transpose_item(I->ffn_w_down + (size_t)l * D_FF * D_MODEL, D_FF, D_MODEL, D_MODEL, w.WDOWN + l * SZ_WDOWN, scr, r, lane); continue; } r -= I_DN;
                if (r < I_UQ) { misc::transpose_item(I->mla_w_uq + (size_t)l * MLA_Q_LORA * NQ_MLA, MLA_Q_LORA, NQ_MLA, NQ_MLA, w.WUQ + l * SZ_WUQ, scr, r, lane); continue; } r -= I_UQ;
                if (r < I_UKV) { misc::transpose_item(I->mla_w_ukv + (size_t)l * MLA_KV_LORA * NKV_MLA, MLA_KV_LORA, NKV_MLA, NKV_MLA, w.WUKV + l * SZ_WUKV, scr, r, lane); continue; } r -= I_UKV;
                { const int blk = r / I_LB, item = r % I_LB, d = blk / (2 * NH), wh = (blk / NH) & 1, nb = blk % NH;
                  const float* src = (wh == 0 ? I->lru_wa : I->lru_wx) + ((size_t)(l * 2 + d) * NH + nb) * lru::SZ_WBLK;
                  misc::transpose_item(src, LRU_BW, LRU_BW, LRU_BW, w.WLRU + ((size_t)l * 16 + blk) * lru::SZ_WBLK, scr, item, lane); }
            }
        }
        for (long i = gtid; i < (long)M_ALL * D_MODEL / 4; i += gthreads) { const long e = i * 4;
            ((misc::f32x4*)w.H)[i] = e < (long)M_LAT * D_MODEL ? *(const misc::f32x4*)(I->x + e) : *(const misc::f32x4*)(I->ctx + (e - (long)M_LAT * D_MODEL)); }
    }
    SEAM(PH_PRO);

    { LayerCtx C; C.lo = lo; C.hi = hi; C.G = G; C.wg = wg; C.nwaves = nwaves; C.gthreads = gthreads; C.wave0 = C_wave0; C.bar = bar; C.lds = lds; C.lds_raw = lds_raw;
      static_assert(DEPTH == 4, "layer calls are written out (a real layer loop lets LICM park loop-invariant values in registers across every phase: spills)");
      layer_body<0>(C); layer_body<1>(C); layer_body<2>(C); layer_body<3>(C); }
#undef IN
#undef SEAM
}

#ifndef MK_PHASES_PER_LAUNCH
#define MK_PHASES_PER_LAUNCH NPH
#endif
extern "C" void kernel_launch(void* const* d_in, const int* in_sizes, int n_in, void* d_out, int out_size, void* d_ws, size_t ws_size, hipStream_t stream) {
    static int grid = 0;
    if (grid == 0) {
        int dev = 0, cus = 0;
        if (hipGetDevice(&dev) != hipSuccess || hipDeviceGetAttribute(&cus, hipDeviceAttributeMultiprocessorCount, dev) != hipSuccess || cus <= 0) { fprintf(stderr, "kernel_launch: no device\n"); grid = -1; return; }
        if (hipFuncSetAttribute((const void*)fwd, hipFuncAttributeMaxDynamicSharedMemorySize, LDS_BYTES) != hipSuccess) { fprintf(stderr, "kernel_launch: hipFuncSetAttribute failed\n"); grid = -1; return; }
        int per_cu = 0; if (hipOccupancyMaxActiveBlocksPerMultiprocessor(&per_cu, (const void*)fwd, NTHR, LDS_BYTES) != hipSuccess || per_cu < 1) fprintf(stderr, "kernel_launch: occupancy query says %d blocks per CU\n", per_cu);
        (void)hipGetLastError();
        grid = cus;
        const WS w0 = ws_carve(nullptr);
        if (n_in != 34 || w0.total > ws_size) { fprintf(stderr, "kernel_launch: bad inputs / workspace (need %zu, have %zu)\n", w0.total, ws_size); grid = -1; return; }
    }
    if (grid < 0) return;
    (void)hipMemsetAsync(d_ws, 0, 1 << 20, stream);
    Params p; memset(&p, 0, sizeof(p));
    for (int i = 0; i < 34; ++i) p.in[i] = (const float*)d_in[i];
    p.out = (float*)d_out; p.ws = (unsigned char*)d_ws;
    int li = 0;
    for (int lo = 0; lo < NPH; lo += MK_PHASES_PER_LAUNCH, ++li) {
        p.ph_lo = lo; p.ph_hi = lo + MK_PHASES_PER_LAUNCH < NPH ? lo + MK_PHASES_PER_LAUNCH : NPH; p.li = li;
#if defined(PROBE_MASK)
        if (MK_PHASES_PER_LAUNCH == 1 && ((((PROBE_MASK) >> 12) & 1 && lo == 0) || (lo > 0 && (((PROBE_MASK) >> ((lo - 1) % PH_PER_LAYER)) & 1))))
            { Params q = p;
#if defined(PROBE_FLAGS)
              q.pad = PROBE_FLAGS;
#endif
              for (int r = 0; r < PROBE_REPS; ++r) hipLaunchKernelGGL(fwd, dim3(grid), dim3(NTHR), LDS_BYTES, stream, q); }
#endif
        hipLaunchKernelGGL(fwd, dim3(grid), dim3(NTHR), LDS_BYTES, stream, p);
    }
}
```

```cpp
#include <hip/hip_runtime.h>
#include <cstdio>
#include <cstdint>
#include <cstring>
#include <math.h>
#include <stdint.h>

#ifdef CFG_SMALL
constexpr int D_MODEL = 256, BATCH = 2, SEQ = 512, DEPTH = 2, CTX_LEN = 64, GRID_W = 32, HEAD_DIM = 16;
#else
constexpr int D_MODEL = 2048, BATCH = 2, SEQ = 8192, DEPTH = 4, CTX_LEN = 256, GRID_W = 64, HEAD_DIM = 128;
#endif
constexpr int GROUP_W = D_MODEL / 4, NH = GROUP_W / HEAD_DIM;
constexpr int HD = HEAD_DIM;
constexpr int N_MOD = 6;
constexpr float EPS = 1e-6f;
constexpr int LRU_W = GROUP_W, LRU_BW = LRU_W / NH;
constexpr float LRU_C = 8.0f;
constexpr int MLA_Q_LORA = 3 * D_MODEL / 16, MLA_KV_LORA = D_MODEL / 8, MLA_NOPE = HD, MLA_ROPE = HD / 2, MLA_V = HD, MLA_QK = MLA_NOPE + MLA_ROPE;
constexpr int GDN_CHUNK = 64;
constexpr int NA_KH = 8, NA_KW = 16;
constexpr int D_FF = 5 * D_MODEL / 2;
constexpr int ROWS = SEQ / GRID_W;
constexpr int C_LRU_X = 0, C_LRU_G = C_LRU_X + LRU_W, C_CQ = C_LRU_G + LRU_W, C_CKV = C_CQ + MLA_Q_LORA, C_KR = C_CKV + MLA_KV_LORA,
              C_GQ = C_KR + MLA_ROPE, C_GK = C_GQ + GROUP_W, C_GV = C_GK + GROUP_W, C_GG = C_GV + GROUP_W, C_GB = C_GG + GROUP_W,
              C_GA = C_GB + 2 * NH, C_NQ = C_GA + 2 * NH, C_NK = C_NQ + GROUP_W, C_NV = C_NK + GROUP_W, IN_COLS = C_NV + GROUP_W;
constexpr int NP = (IN_COLS + 255) / 256 * 256;
constexpr int M_LAT = BATCH * SEQ, M_CTX = BATCH * CTX_LEN, M_ALL = M_LAT + M_CTX;
constexpr int NMODV = N_MOD * D_MODEL;

typedef unsigned short bf16_t;
__host__ __device__ __forceinline__ bf16_t f2bf(float f) { union { float f; unsigned u; } v; v.f = f; unsigned u = v.u; u += 0x7fffu + ((u >> 16) & 1u); return (bf16_t)(u >> 16); }
__host__ __device__ __forceinline__ float bf2f(bf16_t b) { union { float f; unsigned u; } v; v.u = ((unsigned)b) << 16; return v.f; }
__host__ __device__ __forceinline__ float sigmoidf_(float x) { return 1.0f / (1.0f + expf(-x)); }
__host__ __device__ __forceinline__ float siluf_(float x) { return x / (1.0f + expf(-x)); }
__host__ __device__ __forceinline__ float softplusf_(float x) { return fmaxf(x, 0.0f) + log1pf(expf(-fabsf(x))); }
__host__ __device__ __forceinline__ float geluf_(float x) { return 0.5f * x * (1.0f + tanhf(0.7978845608028654f * (x + 0.044715f * x * x * x))); }

struct RowInfo { int b, t, T, base, set; };
__host__ __device__ __forceinline__ RowInfo row_info(int r) {
    RowInfo i;
    if (r < M_LAT) { i.b = r / SEQ; i.t = r % SEQ; i.T = SEQ; i.base = i.b * SEQ; i.set = i.b; }
    else { const int rr = r - M_LAT; i.b = rr / CTX_LEN; i.t = rr % CTX_LEN; i.T = CTX_LEN; i.base = M_LAT + i.b * CTX_LEN; i.set = BATCH; }
    return i;
}


__host__ __device__ __forceinline__ float bflo(unsigned w) { union { float f; unsigned u; } v; v.u = w << 16; return v.f; }
__host__ __device__ __forceinline__ float bfhi(unsigned w) { union { float f; unsigned u; } v; v.u = w & 0xffff0000u; return v.f; }
#define LDS_BARRIER() asm volatile("s_waitcnt lgkmcnt(0)\n\ts_barrier" ::: "memory")
__device__ __forceinline__ float lane_xor(float v, int mask, int lane) { return __int_as_float(__builtin_amdgcn_ds_bpermute((lane ^ mask) << 2, __float_as_int(v))); }
__device__ __forceinline__ float lane_get(float v, int src_lane) { return __int_as_float(__builtin_amdgcn_ds_bpermute(src_lane << 2, __float_as_int(v))); }
struct Inputs {
    const float *x, *c, *ctx, *c_ctx, *ada_w, *ada_b, *norm_mix_g, *norm_ffn_g, *w_in, *w_out,
        *lru_conv_w, *lru_conv_b, *lru_wa, *lru_ba, *lru_wx, *lru_bx, *lru_lam,
        *mla_qa_g, *mla_w_uq, *mla_kva_g, *mla_w_ukv, *mla_qn_g, *mla_kn_g,
        *gdn_conv_w, *gdn_a_log, *gdn_dt_bias, *gdn_norm_g, *na_qn_g, *na_kn_g, *na_rpb,
        *ffn_w_up, *ffn_conv_w, *ffn_conv_b, *ffn_w_down;
};
constexpr int NQ_MLA = NH * MLA_QK, NKV_MLA = NH * (MLA_NOPE + MLA_V);
constexpr size_t SZ_WIN = (size_t)NP * D_MODEL, SZ_WOUT = (size_t)D_MODEL * D_MODEL, SZ_WUP = (size_t)2 * D_FF * D_MODEL, SZ_WDOWN = (size_t)D_MODEL * D_FF,
                 SZ_WUQ = (size_t)NQ_MLA * MLA_Q_LORA, SZ_WUKV = (size_t)NKV_MLA * MLA_KV_LORA, SZ_WLRU = (size_t)16 * LRU_BW * LRU_BW;
struct WS {
    unsigned* ctl; float *MOD, *H, *PART; bf16_t *U, *Y;
    bf16_t *WIN, *WOUT, *WUP, *WDOWN, *WUQ, *WUKV, *WLRU;
    bf16_t* P; bf16_t *CQN, *CKVN, *QR, *KVR, *QM, *KM, *VM, *NQ, *NK;
    bf16_t *gUT, *gWP, *gKDT, *gQD, *gQK, *gSIT, *gVNT; float *gGT, *gSS;
    bf16_t *lHLOC, *lACUM; float *lLSUM, *lHIN;
    bf16_t *UP, *ACT;
    size_t total;
};
__host__ __device__ inline WS ws_carve(void* base) {
    WS w; size_t off = 0; char* b = (char*)base;
#define WS_TAKE(T, field, bytes) do { w.field = (T*)(b + off); off += (((size_t)(bytes)) + 255) & ~(size_t)255; } while (0)
    WS_TAKE(unsigned, ctl, 1 << 20);
    WS_TAKE(float, MOD, sizeof(float) * (size_t)DEPTH * (BATCH + 1) * NMODV);
    WS_TAKE(float, H, sizeof(float) * (size_t)M_ALL * D_MODEL);
    WS_TAKE(float, PART, sizeof(float) * (size_t)5 * M_CTX * D_MODEL);
    WS_TAKE(bf16_t, U, 2 * (size_t)M_ALL * D_MODEL);
    WS_TAKE(bf16_t, Y, 2 * (size_t)M_ALL * D_MODEL);
    WS_TAKE(bf16_t, WIN, 2 * SZ_WIN * DEPTH); WS_TAKE(bf16_t, WOUT, 2 * SZ_WOUT * DEPTH); WS_TAKE(bf16_t, WUP, 2 * SZ_WUP * DEPTH); WS_TAKE(bf16_t, WDOWN, 2 * SZ_WDOWN * DEPTH);
    WS_TAKE(bf16_t, WUQ, 2 * SZ_WUQ * DEPTH); WS_TAKE(bf16_t, WUKV, 2 * SZ_WUKV * DEPTH); WS_TAKE(bf16_t, WLRU, 2 * SZ_WLRU * DEPTH);
    const size_t r0 = off;
    WS_TAKE(bf16_t, P, 2 * (size_t)M_ALL * NP);
    WS_TAKE(bf16_t, CQN, 2 * (size_t)M_ALL * MLA_Q_LORA); WS_TAKE(bf16_t, CKVN, 2 * (size_t)M_ALL * MLA_KV_LORA);
    WS_TAKE(bf16_t, QR, 2 * (size_t)M_ALL * NQ_MLA); WS_TAKE(bf16_t, KVR, 2 * (size_t)M_ALL * NKV_MLA);
    WS_TAKE(bf16_t, QM, 2 * (size_t)M_ALL * NQ_MLA); WS_TAKE(bf16_t, KM, 2 * (size_t)M_ALL * NQ_MLA); WS_TAKE(bf16_t, VM, 2 * (size_t)M_ALL * NH * MLA_V);
    WS_TAKE(bf16_t, NQ, 2 * (size_t)M_ALL * GROUP_W); WS_TAKE(bf16_t, NK, 2 * (size_t)M_ALL * GROUP_W);
    { constexpr size_t NT_ = (size_t)(M_ALL / 64) * NH * 2;
      WS_TAKE(bf16_t, gUT, 2 * NT_ * 128 * 64); WS_TAKE(bf16_t, gWP, 2 * NT_ * 64 * 128); WS_TAKE(bf16_t, gKDT, 2 * NT_ * 128 * 64); WS_TAKE(bf16_t, gQD, 2 * NT_ * 64 * 128);
      WS_TAKE(bf16_t, gQK, 2 * NT_ * 64 * 64); WS_TAKE(bf16_t, gSIT, 2 * NT_ * 128 * 128); WS_TAKE(bf16_t, gVNT, 2 * NT_ * 128 * 64); WS_TAKE(float, gGT, 4 * NT_ * DEPTH); WS_TAKE(float, gSS, 4 * (size_t)BATCH * NH * 2 * HD * HD); }
    WS_TAKE(bf16_t, lHLOC, 2 * (size_t)2 * M_ALL * LRU_W); WS_TAKE(bf16_t, lACUM, 2 * (size_t)2 * M_ALL * LRU_W);
    WS_TAKE(float, lLSUM, 4 * (size_t)(M_ALL / 64) * 2 * 2 * LRU_W); WS_TAKE(float, lHIN, 4 * (size_t)(M_ALL / 64) * 2 * LRU_W);
    const size_t r1 = off;
    off = r0;
    WS_TAKE(bf16_t, UP, 2 * (size_t)M_ALL * 2 * D_FF); WS_TAKE(bf16_t, ACT, 2 * (size_t)M_ALL * D_FF);
    const size_t f1 = off;
#undef WS_TAKE
    w.total = r1 > f1 ? r1 : f1;
    return w;
}

namespace pg8 {
#define PG8_LAS __attribute__((address_space(3)))
typedef unsigned short bf16_t;
typedef short bf16x8 __attribute__((ext_vector_type(8)));
typedef float f32x4 __attribute__((ext_vector_type(4)));
typedef unsigned u32x4 __attribute__((ext_vector_type(4)));
constexpr int BM = 256, BK = 64, HALF = 128, HTB = HALF * BK * 2  , STAGE_BYTES = 8 * HTB, NXCD = 8, WGM = 8;

__host__ __device__ __forceinline__ int lds_byte(int r, int c) { const int st = (r >> 4) * 2 + (c >> 5), rr = r & 15, cc = c & 31, ob = rr * 64 + cc * 2; return st * 1024 + (ob ^ (((ob >> 9) & 1) << 5)); }
__host__ __device__ __forceinline__ void stage_rc(int b, int& R, int& C) { const int st = b / 1024, sb = b % 1024, swz = sb ^ (((sb >> 9) & 1) << 5); R = (st >> 1) * 16 + swz / 64; C = (st & 1) * 32 + (swz % 64) / 2; }
__host__ __device__ __forceinline__ int perm32(int rho) { const int n = rho >> 4, i = rho & 15; return 8 * (i >> 2) + 4 * n + (i & 3); }

struct Unit { int pm, pn, ks; };
struct Gemm { const bf16_t* A; const bf16_t* Bt; int M, N, K, ld; };

struct StaticOrder {
    int nM, nN, nwg, G, c;
    __host__ __device__ void init(int M, int N, int G_, int c_) { nM = M / BM; nN = N / BM; nwg = nM * nN; G = G_; c = c_; }
    __host__ __device__ bool next(int i, Unit& u) const {
        const long L = (long)i * G + c; if (L >= nwg) return false;
        int wgid = (int)L; { const int q = nwg / NXCD, r = nwg % NXCD, xcd = wgid % NXCD, off = wgid / NXCD; wgid = (xcd < r ? xcd * (q + 1) : r * (q + 1) + (xcd - r) * q) + off; }
        const int nig = WGM * nN, gid = wgid / nig, fm = gid * WGM, gsz = (nM - fm) < WGM ? (nM - fm) : WGM;
        u.pm = fm + ((wgid % nig) % gsz); u.pn = (wgid % nig) / gsz; u.ks = 0; return true;
    }
    __device__ __forceinline__ void a_ready(const Unit&) const {}
    __device__ __forceinline__ void done(const Unit&) const {}
};
__device__ __forceinline__ unsigned cvt_pk_bf16(float lo, float hi) { unsigned r; asm volatile("v_cvt_pk_bf16_f32 %0, %1, %2" : "=v"(r) : "v"(lo), "v"(hi)); return r; }
typedef float f32x2 __attribute__((ext_vector_type(2)));
__device__ __forceinline__ f32x2 gelu_pk(f32x2 v) {
    const f32x2 av = __builtin_elementwise_abs(v), d = av * 0.2316418882f + 1.0f;
    f32x2 t; t.x = __builtin_amdgcn_rcpf(d.x); t.y = __builtin_amdgcn_rcpf(d.y);
    f32x2 q = t * 0.5307027145f + (-0.7265760135f); q = q * t + 0.7107068705f; q = q * t + (-0.142248368f); q = q * t + 0.127414796f; q = q * t;
    const f32x2 s = (v * v) * (-0.72134752044f);
    f32x2 e; e.x = __builtin_amdgcn_exp2f(s.x); e.y = __builtin_amdgcn_exp2f(s.y);
    const f32x2 m = v * (q * e), r = v - m;
    f32x2 o; o.x = v.x < 0.f ? m.x : r.x; o.y = v.y < 0.f ? m.y : r.y; return o;
}

template <int ACT  > struct EpiBf16 {
    static constexpr bool PERM = true, AFTER_DRAIN = false; static_assert(ACT == 0 || ACT == 1, "EpiBf16: ACT is 0 (none) or 1 (gelu_pk)");
    bf16_t* O; int ldc; const float* bias; int split_cols; size_t split_stride; float scale0;
    __device__ __forceinline__ void operator()(const f32x4 (&acc)[2][2][4][2], const Unit& u, int wr, int wc, int fr, int fq) const {
        const int row0 = u.pm * BM + wr * 64 + fr; int colt = u.pn * BM; bf16_t* base = O;
        float sc = 1.f; if (split_cols) { const int t = colt / split_cols; base += (size_t)t * split_stride; colt -= t * split_cols; if (t == 0) sc = scale0; }
        const int col0 = colt + wc * 32 + 8 * fq, bcol0 = u.pn * BM + wc * 32 + 8 * fq;
        f32x4 bv[2][2];
#pragma unroll
        for (int bj = 0; bj < 2; ++bj)
#pragma unroll
            for (int n = 0; n < 2; ++n) bv[bj][n] = bias ? *(const f32x4*)(bias + bcol0 + bj * HALF + 4 * n) : (f32x4){0.f, 0.f, 0.f, 0.f};
#pragma unroll
        for (int ai = 0; ai < 2; ++ai)
#pragma unroll
            for (int m = 0; m < 4; ++m) { bf16_t* rowp = base + (size_t)(row0 + ai * HALF + m * 16) * ldc + col0;
#pragma unroll
                for (int bj = 0; bj < 2; ++bj) { f32x4 v0 = acc[ai][bj][m][0] + bv[bj][0], v1 = acc[ai][bj][m][1] + bv[bj][1];
                    if (ACT == 1) { f32x2 a = gelu_pk((f32x2){v0[0], v0[1]}), b = gelu_pk((f32x2){v0[2], v0[3]}), c = gelu_pk((f32x2){v1[0], v1[1]}), d = gelu_pk((f32x2){v1[2], v1[3]});
                        v0 = (f32x4){a.x, a.y, b.x, b.y}; v1 = (f32x4){c.x, c.y, d.x, d.y}; }
                    v0 = v0 * sc; v1 = v1 * sc; u32x4 w; w.x = cvt_pk_bf16(v0[0], v0[1]); w.y = cvt_pk_bf16(v0[2], v0[3]); w.z = cvt_pk_bf16(v1[0], v1[1]); w.w = cvt_pk_bf16(v1[2], v1[3]);
                    *(u32x4*)(rowp + bj * HALF) = w; } }
    }
};

struct EpiF32 {
    static constexpr bool PERM = false, AFTER_DRAIN = false;
    float* C; int ldc;
    __device__ __forceinline__ void operator()(const f32x4 (&acc)[2][2][4][2], const Unit& u, int wr, int wc, int fr, int fq) const {
        const int row0 = u.pm * BM + wr * 64 + fr, col0 = u.pn * BM + wc * 32 + 4 * fq;
#pragma unroll
        for (int ai = 0; ai < 2; ++ai)
#pragma unroll
            for (int m = 0; m < 4; ++m) { float* rowp = C + (size_t)(row0 + ai * HALF + m * 16) * ldc + col0;
#pragma unroll
                for (int bj = 0; bj < 2; ++bj)
#pragma unroll
                    for (int n = 0; n < 2; ++n) *(f32x4*)(rowp + bj * HALF + n * 16) = acc[ai][bj][m][n]; }
    }
};
struct EpiGateRes {
    static constexpr bool PERM = false, AFTER_DRAIN = false;
    const float* base; float* out; int ldc; const float* gate; int set_stride; int rows_per_set; int nsets_lat; int lat_rows;
    __device__ __forceinline__ void operator()(const f32x4 (&acc)[2][2][4][2], const Unit& u, int wr, int wc, int fr, int fq) const {
        const int row0 = u.pm * BM + wr * 64 + fr, col0 = u.pn * BM + wc * 32 + 4 * fq;
        const int set = (u.pm * BM >= lat_rows) ? nsets_lat : (u.pm * BM) / rows_per_set;
        const float* gp = gate + (size_t)set * set_stride + col0;
        f32x4 gv[2][2];
#pragma unroll
        for (int bj = 0; bj < 2; ++bj)
#pragma unroll
            for (int n = 0; n < 2; ++n) gv[bj][n] = *(const f32x4*)(gp + bj * HALF + n * 16);
#pragma unroll
        for (int ai = 0; ai < 2; ++ai)
#pragma unroll
            for (int m = 0; m < 4; ++m) { const size_t off = (size_t)(row0 + ai * HALF + m * 16) * ldc + col0;
#pragma unroll
                for (int bj = 0; bj < 2; ++bj)
#pragma unroll
                    for (int n = 0; n < 2; ++n) { const f32x4 b = *(const f32x4*)(base + off + bj * HALF + n * 16); *(f32x4*)(out + off + bj * HALF + n * 16) = b + gv[bj][n] * acc[ai][bj][m][n]; } }
    }
};

struct EpiPart {
    static constexpr bool PERM = false, AFTER_DRAIN = false;
    float* C; int ldc; size_t ks_stride;
    __device__ __forceinline__ void operator()(const f32x4 (&acc)[2][2][4][2], const Unit& u, int wr, int wc, int fr, int fq) const {
        const int row0 = u.pm * BM + wr * 64 + fr, col0 = u.pn * BM + wc * 32 + 4 * fq; float* Cb = C + (size_t)u.ks * ks_stride;
#pragma unroll
        for (int ai = 0; ai < 2; ++ai)
#pragma unroll
            for (int m = 0; m < 4; ++m) { float* rowp = Cb + (size_t)(row0 + ai * HALF + m * 16) * ldc + col0;
#pragma unroll
                for (int bj = 0; bj < 2; ++bj)
#pragma unroll
                    for (int n = 0; n < 2; ++n) *(f32x4*)(rowp + bj * HALF + n * 16) = acc[ai][bj][m][n]; }
    }
};

template <class Epi, class Sched, bool ALIGN_EPI = false, bool SP2 = false>
__device__ __forceinline__ void gemm_phase(PG8_LAS unsigned char* lds, const Gemm g, const Sched& S, const Epi& E, const int tid_in) {
    int tid_ = tid_in; asm volatile("" : "+v"(tid_));
    const int tid = tid_, wid = __builtin_amdgcn_readfirstlane(tid >> 6), lane = tid & 63, wr = wid >> 2, wc = wid & 3, fr = lane & 15, fq = lane >> 4;
    const int K = g.K, nt = K / BK;
    unsigned voffA[2], voffB[2];
#pragma unroll
    for (int i = 0; i < 2; ++i) { int R, C; stage_rc(tid * 16 + i * 8192, R, C); const int Rb = Epi::PERM ? ((R & ~31) + perm32(R & 31)) : R;
        voffA[i] = (unsigned)(R * g.ld + C) * 2u; voffB[i] = (unsigned)(Rb * g.ld + C) * 2u; }
    const size_t kstep = (size_t)(BK * 2);
    const size_t hstep = (size_t)HALF * g.ld * 2;
    const size_t tstep = 2 * hstep;
    const unsigned ldsw = (unsigned)wid * 1024u;
    const int aoff = lds_byte(wr * 64 + fr, fq * 8), boff = lds_byte(wc * 32 + fr, fq * 8);
#define PG8_SA(b, h) (((b) * 2 + (h)) * HTB)
#define PG8_SB(b, h) ((4 + (b) * 2 + (h)) * HTB)
#define PG8_STAGE(bufoff, gbase, voff) do { _Pragma("unroll") for (int _i = 0; _i < 2; ++_i) \
        __builtin_amdgcn_global_load_lds((const unsigned*)((const char*)(gbase) + (voff)[_i]), (PG8_LAS unsigned*)(lds + (bufoff) + ldsw + _i * 8192), 16, 0, 0); } while (0)
#define PG8_LDA(dst, b, h) do { _Pragma("unroll") for (int m = 0; m < 4; ++m) _Pragma("unroll") for (int k = 0; k < 2; ++k) dst[m][k] = *(const PG8_LAS bf16x8*)(lds + PG8_SA(b, h) + aoff + m * 2048 + k * 1024); } while (0)
#define PG8_LDB(dst, b, h) do { _Pragma("unroll") for (int n = 0; n < 2; ++n) _Pragma("unroll") for (int k = 0; k < 2; ++k) dst[n][k] = *(const PG8_LAS bf16x8*)(lds + PG8_SB(b, h) + boff + n * 2048 + k * 1024); } while (0)
#define PG8_MMA(ai, bj, At, Bt) do { __builtin_amdgcn_s_setprio(1); _Pragma("unroll") for (int m = 0; m < 4; ++m) _Pragma("unroll") for (int n = 0; n < 2; ++n) _Pragma("unroll") for (int k = 0; k < 2; ++k) \
        acc[ai][bj][m][n] = __builtin_amdgcn_mfma_f32_16x16x32_bf16(Bt[n][k], At[m][k], acc[ai][bj][m][n], 0, 0, 0); __builtin_amdgcn_s_setprio(0); } while (0)
#define PG8_WAIT_V(n) asm volatile("s_waitcnt vmcnt(" #n ")" ::: "memory")
#define PG8_WAIT_L(n) asm volatile("s_waitcnt lgkmcnt(" #n ")" ::: "memory")
#define PG8_BAR __builtin_amdgcn_s_barrier()
#define PG8_SCHED __builtin_amdgcn_sched_barrier(0)
    Unit cur, nxt; int ui = 0;
    if (!S.next(0, cur)) return;
    f32x4 acc[2][2][4][2];
#pragma unroll
    for (int a = 0; a < 2; ++a)
#pragma unroll
        for (int b = 0; b < 2; ++b)
#pragma unroll
            for (int m = 0; m < 4; ++m)
#pragma unroll
                for (int n = 0; n < 2; ++n) acc[a][b][m][n] = (f32x4){0.f, 0.f, 0.f, 0.f};
    bf16x8 At[4][2], B0[2][2], B1[2][2];
    const size_t ksb = (size_t)K * 2;
    const char* cA = (const char*)g.A + (size_t)cur.pm * tstep + (size_t)cur.ks * ksb; const char* cB = (const char*)g.Bt + (size_t)cur.pn * tstep + (size_t)cur.ks * ksb;
    S.a_ready(cur);
    if constexpr (SP2) {
        PG8_STAGE(PG8_SB(0, 0), cB, voffB); PG8_STAGE(PG8_SB(0, 1), cB + hstep, voffB); PG8_STAGE(PG8_SA(0, 0), cA, voffA); PG8_STAGE(PG8_SA(0, 1), cA + hstep, voffA);
        if (wr == 1) PG8_BAR;
        PG8_WAIT_V(2); PG8_BAR;
        PG8_STAGE(PG8_SB(1, 0), cB + kstep, voffB); PG8_STAGE(PG8_SA(1, 0), cA + kstep, voffA); PG8_STAGE(PG8_SB(1, 1), cB + hstep + kstep, voffB);
        PG8_WAIT_V(6); PG8_BAR;
    } else {
        PG8_STAGE(PG8_SB(0, 0), cB, voffB); PG8_STAGE(PG8_SA(0, 0), cA, voffA); PG8_STAGE(PG8_SB(0, 1), cB + hstep, voffB); PG8_STAGE(PG8_SA(0, 1), cA + hstep, voffA);
        if (wr == 1) PG8_BAR;
        PG8_WAIT_V(4); PG8_BAR;
        PG8_STAGE(PG8_SB(1, 0), cB + kstep, voffB); PG8_STAGE(PG8_SA(1, 0), cA + kstep, voffA); PG8_STAGE(PG8_SB(1, 1), cB + hstep + kstep, voffB);
        PG8_WAIT_V(6); PG8_BAR;
    }
    for (;;) {
        const bool has_next = S.next(ui + 1, nxt);
        const char* nA = has_next ? (const char*)g.A + (size_t)nxt.pm * tstep + (size_t)nxt.ks * ksb : cA; const char* nB = has_next ? (const char*)g.Bt + (size_t)nxt.pn * tstep + (size_t)nxt.ks * ksb : cB;
        for (int t = 0; t < nt; t += 2) {
            const bool last = (t == nt - 2);
            const char* a1 = cA + (size_t)(t + 1) * kstep;
            const char* a2 = last ? nA : cA + (size_t)(t + 2) * kstep; const char* b2 = last ? nB : cB + (size_t)(t + 2) * kstep;
            const char* a3 = a2 + kstep; const char* b3 = b2 + kstep;
            if (last && has_next) S.a_ready(nxt);
            if constexpr (SP2) {
            PG8_LDB(B0, 0, 0); PG8_LDB(B1, 0, 1); PG8_SCHED; PG8_LDA(At, 0, 0); PG8_STAGE(PG8_SA(1, 1), a1 + hstep, voffA);
            PG8_WAIT_V(8); PG8_WAIT_L(0); PG8_BAR; PG8_MMA(0, 0, At, B0); PG8_MMA(0, 1, At, B1); PG8_BAR; PG8_SCHED;
            PG8_LDA(At, 0, 1); PG8_STAGE(PG8_SB(0, 0), b2, voffB); PG8_STAGE(PG8_SB(0, 1), b2 + hstep, voffB); PG8_STAGE(PG8_SA(0, 0), a2, voffA);
            PG8_WAIT_V(8); PG8_WAIT_L(0); PG8_BAR; PG8_MMA(1, 0, At, B0); PG8_MMA(1, 1, At, B1); PG8_BAR; PG8_SCHED;
            PG8_LDB(B0, 1, 0); PG8_LDB(B1, 1, 1); PG8_SCHED; PG8_LDA(At, 1, 0); PG8_STAGE(PG8_SA(0, 1), a2 + hstep, voffA);
            PG8_WAIT_V(8); PG8_WAIT_L(0); PG8_BAR; PG8_MMA(0, 0, At, B0); PG8_MMA(0, 1, At, B1); PG8_BAR; PG8_SCHED;
            PG8_LDA(At, 1, 1); PG8_STAGE(PG8_SB(1, 0), b3, voffB); PG8_STAGE(PG8_SB(1, 1), b3 + hstep, voffB); PG8_STAGE(PG8_SA(1, 0), a3, voffA);
            PG8_WAIT_V(8); PG8_WAIT_L(0); PG8_BAR; PG8_MMA(1, 0, At, B0); PG8_MMA(1, 1, At, B1); PG8_BAR; PG8_SCHED;
            } else {
            PG8_LDB(B0, 0, 0); PG8_SCHED; PG8_LDA(At, 0, 0); PG8_STAGE(PG8_SA(1, 1), a1 + hstep, voffA);
            PG8_WAIT_L(8); PG8_BAR; PG8_WAIT_L(0); PG8_MMA(0, 0, At, B0); PG8_BAR; PG8_SCHED;
            PG8_LDB(B1, 0, 1); PG8_STAGE(PG8_SB(0, 0), b2, voffB);
            PG8_BAR; PG8_WAIT_L(0); PG8_MMA(0, 1, At, B1); PG8_BAR;
            PG8_LDA(At, 0, 1); PG8_STAGE(PG8_SA(0, 0), a2, voffA);
            PG8_BAR; PG8_WAIT_L(0); PG8_MMA(1, 0, At, B0); PG8_BAR; PG8_SCHED;
            PG8_STAGE(PG8_SB(0, 1), b2 + hstep, voffB);
            PG8_WAIT_V(6); PG8_BAR; PG8_MMA(1, 1, At, B1); PG8_BAR;
            PG8_LDB(B0, 1, 0); PG8_SCHED; PG8_LDA(At, 1, 0); PG8_STAGE(PG8_SA(0, 1), a2 + hstep, voffA);
            PG8_WAIT_L(8); PG8_BAR; PG8_WAIT_L(0); PG8_MMA(0, 0, At, B0); PG8_BAR; PG8_SCHED;
            PG8_LDB(B1, 1, 1); PG8_STAGE(PG8_SB(1, 0), b3, voffB);
            PG8_BAR; PG8_WAIT_L(0); PG8_MMA(0, 1, At, B1); PG8_BAR;
            PG8_LDA(At, 1, 1); PG8_STAGE(PG8_SA(1, 0), a3, voffA);
            PG8_BAR; PG8_WAIT_L(0); PG8_MMA(1, 0, At, B0); PG8_BAR; PG8_SCHED;
            PG8_STAGE(PG8_SB(1, 1), b3 + hstep, voffB);
            PG8_WAIT_V(6); PG8_BAR; PG8_MMA(1, 1, At, B1); PG8_BAR;
            }
        }
        if constexpr (ALIGN_EPI) { if (wr == 0) PG8_BAR; }
        if constexpr (!Epi::AFTER_DRAIN) { E(acc, cur, wr, wc, fr, fq); S.done(cur); }
        if (!has_next) break;
#pragma unroll
        for (int a = 0; a < 2; ++a)
#pragma unroll
            for (int b = 0; b < 2; ++b)
#pragma unroll
                for (int m = 0; m < 4; ++m)
#pragma unroll
                    for (int n = 0; n < 2; ++n) acc[a][b][m][n] = (f32x4){0.f, 0.f, 0.f, 0.f};
        cur = nxt; cA = nA; cB = nB; ++ui;
        if constexpr (ALIGN_EPI) { if (wr == 1) PG8_BAR; }
    }
    PG8_WAIT_V(0);
    if constexpr (!ALIGN_EPI) { if (wr == 0) PG8_BAR; }
    PG8_BAR;
    if constexpr (Epi::AFTER_DRAIN) { E.fused(acc, cur, wr, wc, fr, fq, lds, wid, lane); S.done(cur); }
#undef PG8_SA
#undef PG8_SB
#undef PG8_STAGE
#undef PG8_LDA
#undef PG8_LDB
#undef PG8_MMA
#undef PG8_WAIT_V
#undef PG8_WAIT_L
#undef PG8_BAR
#undef PG8_SCHED
}
}

namespace att {
using bf16x8 = __attribute__((ext_vector_type(8))) short;
using s16x4  = __attribute__((ext_vector_type(4))) short;
using f32x16 = __attribute__((ext_vector_type(16))) float;
using u32x4  = __attribute__((ext_vector_type(4))) unsigned;
constexpr int NW = 8, QBLK = 32, KVBLK = 64, DV = 128;
#define ATT_SBAR() __builtin_amdgcn_sched_barrier(0)
__device__ __forceinline__ int crow(int r, int hi) { return (r & 3) + 8 * (r >> 2) + 4 * hi; }
__device__ __forceinline__ unsigned cvtpk(float lo, float hi) { unsigned r; asm volatile("v_cvt_pk_bf16_f32 %0, %1, %2" : "=v"(r) : "v"(lo), "v"(hi)); return r; }
template <int DQK> __device__ __forceinline__ int kswz(int row, int colB) { return row * (DQK * 2) + (colB ^ ((row & 7) << 4)); }
constexpr float THR = 8.f;

template <int DQK> struct Cfg {
    static constexpr int SHM_V = KVBLK * DV * 2, SHM_K = KVBLK * DQK * 2;
    static constexpr int OFF_V = 0, OFF_K = 2 * SHM_V, OFF_WS = OFF_K + 2 * SHM_K, OFF_BIAS = OFF_WS + NW * 64 * 4, LDS_BYTES = OFF_BIAS + 10240;
    static constexpr int KCH = DQK / 8;
    static constexpr int KLD = (64 * KCH) / 512;
};

struct Job {
    const bf16_t* Q;
    const bf16_t* K;
    const bf16_t* V;
    bf16_t* O;
    int nt;
    int seg0_tiles, row_seg0, row_seg1;
    int R0; int rlo;
};

__device__ __forceinline__ int tile_row(const Job& J, int j) {
    if (j < J.seg0_tiles) return J.row_seg0 + 64 * j;
    int jj = j - J.seg0_tiles; if (jj > 3) jj = 0; return J.row_seg1 + 64 * jj;
}

__device__ __forceinline__ void partialSM(f32x16& p0, f32x16& p1, float& m_reg, float& mn, float& alpha, float C, float thr_raw) {
    float pmax = p0[0];
#pragma unroll
    for (int r = 1; r < 16; ++r) pmax = fmaxf(pmax, p0[r]);
#pragma unroll
    for (int r = 0; r < 16; ++r) pmax = fmaxf(pmax, p1[r]);
    { auto rr = __builtin_amdgcn_permlane32_swap(__float_as_uint(pmax), __float_as_uint(pmax), false, false);
      pmax = fmaxf(__uint_as_float(rr[0]), __uint_as_float(rr[1])); }
    if (__builtin_expect(__all(pmax - m_reg <= thr_raw), 1)) { mn = m_reg; alpha = 1.f; }
    else { mn = fmaxf(m_reg, pmax); alpha = __builtin_amdgcn_exp2f((m_reg - mn) * C); m_reg = mn; }
    const float mnC = -mn * C;
#pragma unroll
    for (int r = 0; r < 16; ++r) p0[r] = fmaf(p0[r], C, mnC);
#pragma unroll
    for (int r = 0; r < 16; ++r) p1[r] = fmaf(p1[r], C, mnC);
#pragma unroll
    for (int r = 0; r < 16; ++r) p0[r] = __builtin_amdgcn_exp2f(p0[r]);
}
__device__ __forceinline__ void finishSM(f32x16& p0, f32x16& p1, float alpha, float& l_reg, bf16x8& pa0, bf16x8& pa1, bf16x8& pa2, bf16x8& pa3) {
#pragma unroll
    for (int r = 0; r < 16; ++r) p1[r] = __builtin_amdgcn_exp2f(p1[r]);
    float ps = 0;
#pragma unroll
    for (int r = 0; r < 16; ++r) ps += p0[r];
#pragma unroll
    for (int r = 0; r < 16; ++r) ps += p1[r];
    { auto rr = __builtin_amdgcn_permlane32_swap(__float_as_uint(ps), __float_as_uint(ps), false, false);
      ps = __uint_as_float(rr[0]) + __uint_as_float(rr[1]); }
    l_reg = l_reg * alpha + ps;
#define ATT_PK4(P, BASE, OUT) do { unsigned a0 = cvtpk(P[BASE + 0], P[BASE + 1]), a1 = cvtpk(P[BASE + 2], P[BASE + 3]);   \
    unsigned b0 = cvtpk(P[BASE + 4], P[BASE + 5]), b1 = cvtpk(P[BASE + 6], P[BASE + 7]);                              \
    auto r0 = __builtin_amdgcn_permlane32_swap(a0, b0, false, false); auto r1 = __builtin_amdgcn_permlane32_swap(a1, b1, false, false); \
    u32x4 w = {r0[0], r1[0], r0[1], r1[1]}; OUT = *reinterpret_cast<bf16x8*>(&w); } while (0)
    ATT_PK4(p0, 0, pa0); ATT_PK4(p0, 8, pa1); ATT_PK4(p1, 0, pa2); ATT_PK4(p1, 8, pa3);
#undef ATT_PK4
}
template <int DQK> __device__ __forceinline__ void qkt(f32x16& p0, f32x16& p1, const char* Ks, const bf16x8* qr, int r32, int hi) {
    p0 = f32x16{}; p1 = f32x16{};
#pragma unroll
    for (int d0 = 0; d0 < DQK / 16; ++d0) { const int cb = (d0 * 16 + hi * 8) * 2;
        const bf16x8 b0 = *reinterpret_cast<const bf16x8*>(Ks + kswz<DQK>(r32, cb));
        const bf16x8 b1 = *reinterpret_cast<const bf16x8*>(Ks + kswz<DQK>(32 + r32, cb));
        p0 = __builtin_amdgcn_mfma_f32_32x32x16_bf16(b0, qr[d0], p0, 0, 0, 0);
        p1 = __builtin_amdgcn_mfma_f32_32x32x16_bf16(b1, qr[d0], p1, 0, 0, 0); }
}
__device__ __forceinline__ int v_st(int k, int c) { const int kk = (k & ~0xC) | ((k & 4) << 1) | ((k & 8) >> 1); return ((kk >> 3) * 4 + (c >> 5)) * 512 + ((kk & 7) * 32 + (c & 31)) * 2; }
__device__ __forceinline__ int v_rd_base(int lane) { return ((lane & 3) << 3) | (((lane >> 2) & 3) << 6) | (((lane >> 4) & 1) << 5) | (((lane >> 5) & 1) << 8); }
constexpr int v_rd_off(int d0, int ks, int half) { return d0 * 512 + ks * 4096 + half * 2048; }
template <int OFF> __device__ __forceinline__ s16x4 tr_read(int vb) { s16x4 r; asm volatile("ds_read_b64_tr_b16 %0, %1 offset:%2" : "=&v"(r) : "v"(vb), "i"(OFF) : "memory"); return r; }
template <int D0> __device__ __forceinline__ void pv_one(f32x16& od, int vb, bf16x8 pa0, bf16x8 pa1, bf16x8 pa2, bf16x8 pa3) {
    const s16x4 l0 = tr_read<v_rd_off(D0, 0, 0)>(vb), h0 = tr_read<v_rd_off(D0, 0, 1)>(vb), l1 = tr_read<v_rd_off(D0, 1, 0)>(vb), h1 = tr_read<v_rd_off(D0, 1, 1)>(vb);
    const s16x4 l2 = tr_read<v_rd_off(D0, 2, 0)>(vb), h2 = tr_read<v_rd_off(D0, 2, 1)>(vb), l3 = tr_read<v_rd_off(D0, 3, 0)>(vb), h3 = tr_read<v_rd_off(D0, 3, 1)>(vb);
    asm volatile("s_waitcnt lgkmcnt(0)" ::: "memory"); ATT_SBAR();
#define ATT_PK(L, H) (bf16x8){L[0], L[1], L[2], L[3], H[0], H[1], H[2], H[3]}
    od = __builtin_amdgcn_mfma_f32_32x32x16_bf16(pa0, ATT_PK(l0, h0), od, 0, 0, 0);
    od = __builtin_amdgcn_mfma_f32_32x32x16_bf16(pa1, ATT_PK(l1, h1), od, 0, 0, 0);
    od = __builtin_amdgcn_mfma_f32_32x32x16_bf16(pa2, ATT_PK(l2, h2), od, 0, 0, 0);
    od = __builtin_amdgcn_mfma_f32_32x32x16_bf16(pa3, ATT_PK(l3, h3), od, 0, 0, 0);
#undef ATT_PK
}
__device__ __forceinline__ void pv_d0(f32x16* o, int vb, bf16x8 pa0, bf16x8 pa1, bf16x8 pa2, bf16x8 pa3) {
    pv_one<0>(o[0], vb, pa0, pa1, pa2, pa3); pv_one<1>(o[1], vb, pa0, pa1, pa2, pa3); pv_one<2>(o[2], vb, pa0, pa1, pa2, pa3); pv_one<3>(o[3], vb, pa0, pa1, pa2, pa3);
}
constexpr int NA_BROW = 160, NA_BORG = 64 + (NA_KW - 1);
__device__ __forceinline__ void na_bias(f32x16& p0, f32x16& p1, const Job& J, int j, int R, int c, int hi, const float* biasq) {
    const int nloc = J.seg0_tiles;
    if (j >= nloc && j < nloc + 4) return;
    const int rr = J.rlo + j; int r0 = R - NA_KH / 2; r0 = r0 < 0 ? 0 : (r0 > ROWS - NA_KH ? ROWS - NA_KH : r0);
    const bool rowok = (j < nloc) && rr >= r0 && rr < r0 + NA_KH;
    if (!rowok) {
#pragma unroll
        for (int r = 0; r < 16; ++r) { p0[r] = -1e30f; p1[r] = -1e30f; }
        return; }
    int c0 = c - NA_KW / 2; c0 = c0 < 0 ? 0 : (c0 > GRID_W - NA_KW ? GRID_W - NA_KW : c0);
    const int dr = rr - R + (NA_KH - 1);
    const float* bl = biasq + dr * NA_BROW + NA_BORG + 4 * hi - c;
    const int vb = 4 * hi - c0;
#pragma unroll
    for (int r = 0; r < 16; ++r) { const int cc = (r & 3) + 8 * (r >> 2);
        p0[r] = ((unsigned)(cc + vb) < (unsigned)NA_KW) ? p0[r] + bl[cc] : -1e30f;
        p1[r] = ((unsigned)(cc + 32 + vb) < (unsigned)NA_KW) ? p1[r] + bl[cc + 32] : -1e30f; }
}

#define ATT_LAS __attribute__((address_space(3)))
template <int DQK, bool NA, int LDQ, int LDK, int LDV, int LDO>
__device__ __forceinline__ void attn_unit(const Job& J, char* lds, const float scale, const int tid_in) {
    using C_ = Cfg<DQK>;
    int tid_ = tid_in; asm volatile("" : "+v"(tid_));
    const int tid = tid_, wid = __builtin_amdgcn_readfirstlane(tid >> 6), lane = tid & 63, r32 = lane & 31, hi = lane >> 5;
    char* V_lds = lds + C_::OFF_V; char* K_lds = lds + C_::OFF_K;
    const unsigned ldsb = (unsigned)(uintptr_t)lds;
    float* wsf = (float*)(lds + C_::OFF_WS) + wid * 64; float* li_l = wsf; float* al_l = wsf + 32;
    const float* biasq = (const float*)(lds + C_::OFF_BIAS);
    const float Cc = scale * 1.4426950408889634f, thr_raw = THR / scale;
    float m_reg = -1e5f, l_reg = 0; f32x16 o[4] = {}; bf16x8 qr[DQK / 16];
    const bf16_t* Qw = J.Q + (long)(wid * QBLK + r32) * LDQ + hi * 8;
#pragma unroll
    for (int d0 = 0; d0 < DQK / 16; ++d0) qr[d0] = *reinterpret_cast<const bf16x8*>(Qw + d0 * 16);
    const int naR = J.R0 + (wid >> 1), nac = (wid & 1) * 32 + r32;
    const int vb0 = (int)(uintptr_t)V_lds + v_rd_base(lane);
    unsigned koff[C_::KLD], voff[2];
#pragma unroll
    for (int i = 0; i < C_::KLD; ++i) { const int sl = 512 * i + tid, row = sl / C_::KCH, cs = sl % C_::KCH, chunk = (cs & ~7) | ((cs & 7) ^ (row & 7)); koff[i] = (unsigned)(row * LDK * 2 + chunk * 16); }
#pragma unroll
    for (int i = 0; i < 2; ++i) { const int sl = 512 * i + tid, sub = sl >> 5, wi = sl & 31, kk = (sub >> 2) * 8 + (wi >> 2), k = (kk & ~0xC) | ((kk & 4) << 1) | ((kk & 8) >> 1), c = (sub & 3) * 32 + (wi & 3) * 8;
        voff[i] = (unsigned)(k * LDV * 2 + c * 2); }
#define ATT_STAGE(j, b) do { const int row0_ = tile_row(J, (j)); const char* vp_ = (const char*)(J.V + (size_t)row0_ * LDV); const char* kp_ = (const char*)(J.K + (size_t)row0_ * LDK); \
        _Pragma("unroll") for (int i_ = 0; i_ < C_::KLD; ++i_) __builtin_amdgcn_global_load_lds((const unsigned*)(kp_ + koff[i_]), (ATT_LAS unsigned*)(ldsb + C_::OFF_K + (b) * C_::SHM_K + (512 * i_ + 64 * wid) * 16), 16, 0, 0); \
        _Pragma("unroll") for (int i_ = 0; i_ < 2; ++i_) __builtin_amdgcn_global_load_lds((const unsigned*)(vp_ + voff[i_]), (ATT_LAS unsigned*)(ldsb + C_::OFF_V + (b) * C_::SHM_V + (512 * i_ + 64 * wid) * 16), 16, 0, 0); } while (0)
    const int NT = J.nt;
    __syncthreads();
    ATT_STAGE(0, 0); asm volatile("s_waitcnt vmcnt(0)" ::: "memory"); __syncthreads();
    for (int j = 0; j < NT; ++j) {
        const int buf = j & 1;
        if (j + 1 < NT) ATT_STAGE(j + 1, buf ^ 1);
        f32x16 p0, p1; float mn, al; bf16x8 pa0, pa1, pa2, pa3;
        qkt<DQK>(p0, p1, K_lds + buf * C_::SHM_K, qr, r32, hi);
        if (NA) na_bias(p0, p1, J, j, naR, nac, hi, biasq);
        partialSM(p0, p1, m_reg, mn, al, Cc, thr_raw);
        finishSM(p0, p1, al, l_reg, pa0, pa1, pa2, pa3);
        if (__any(al < 1.f)) { if (hi == 0) al_l[r32] = al; asm volatile("s_waitcnt lgkmcnt(0)" ::: "memory");
#pragma unroll
            for (int d = 0; d < 4; ++d)
#pragma unroll
                for (int r = 0; r < 16; ++r) o[d][r] *= al_l[crow(r, hi)]; }
        ATT_SBAR();
        pv_d0(o, vb0 + buf * C_::SHM_V, pa0, pa1, pa2, pa3);
        asm volatile("s_waitcnt vmcnt(0)" ::: "memory");
        __syncthreads();
    }
    if (hi == 0) li_l[r32] = l_reg; asm volatile("s_waitcnt lgkmcnt(0)" ::: "memory");
    float rli[16];
#pragma unroll
    for (int r = 0; r < 16; ++r) rli[r] = __builtin_amdgcn_rcpf(li_l[crow(r, hi)]);
    bf16_t* Ow = J.O + (long)(wid * QBLK) * LDO;
#pragma unroll
    for (int r = 0; r < 16; ++r) { const int orow = crow(r, hi);
#pragma unroll
        for (int d0 = 0; d0 < 4; ++d0) Ow[(long)orow * LDO + d0 * 32 + r32] = f2bf(o[d0][r] * rli[r]); }
#undef ATT_STAGE
}
}

struct AttnArgs { const bf16_t *QM, *KM, *VM, *NQ, *NK, *P; bf16_t* Y; const float* rpb; int want_ctx; int pad; };
__device__ __forceinline__ void attention_phase(const AttnArgs& A, char* lds, int G, int wg, const int tid, const int nskip) {
    static_assert(GRID_W == 64 && SEQ % 256 == 0 && CTX_LEN == 256 && HD == 128, "attention phase geometry");
    constexpr int NQB = SEQ / 256;
    constexpr float sc_mla = 0.07216878364870323f, sc_na = 0.08838834764831845f;
    static_assert(MLA_QK == 192 && HD == 128, "softmax scales");
    if (!(A.pad & 2)) for (int u = wg; u < BATCH * NH * NQB; u += G) {
        const int bh = u % (BATCH * NH), qb = u / (BATCH * NH), b = bh / NH, h = bh % NH;
        att::Job J{};
        J.Q = A.QM + (size_t)(b * SEQ + qb * 256) * NQ_MLA + h * MLA_QK; J.K = A.KM + h * MLA_QK; J.V = A.VM + h * MLA_V;
        J.O = A.Y + (size_t)(b * SEQ + qb * 256) * D_MODEL + GROUP_W + h * MLA_V;
        J.nt = SEQ / 64 + CTX_LEN / 64; J.seg0_tiles = SEQ / 64; J.row_seg0 = b * SEQ; J.row_seg1 = M_LAT + b * CTX_LEN;
        att::attn_unit<MLA_QK, false, NQ_MLA, NQ_MLA, NH * MLA_V, D_MODEL>(J, lds, sc_mla, tid);
    }
    const int G2n = G - nskip, c2 = wg - nskip;
    if (!(A.pad & 4) && c2 >= 0) for (int u = c2; u < BATCH * NH * NQB; u += G2n) {
        const int bh = u % (BATCH * NH), qb = u / (BATCH * NH), b = bh / NH, h = bh % NH, R0 = qb * 4;
        __syncthreads();
        { float* bq = (float*)(lds + att::Cfg<HD>::OFF_BIAS); const float* src = A.rpb + (size_t)h * (2 * NA_KH - 1) * (2 * NA_KW - 1);
          for (int i = tid; i < (2 * NA_KH - 1) * att::NA_BROW; i += 512) { const int dr = i / att::NA_BROW; int dc = i % att::NA_BROW - att::NA_BORG + (NA_KW - 1); dc = dc < 0 ? 0 : (dc > 2 * NA_KW - 2 ? 2 * NA_KW - 2 : dc);
              bq[i] = src[dr * (2 * NA_KW - 1) + dc] * 11.313708498984761f; } }
        int rlo = R0 - NA_KH / 2; rlo = rlo < 0 ? 0 : (rlo > ROWS - NA_KH ? ROWS - NA_KH : rlo);
        int rhi = R0 + 3 - NA_KH / 2; rhi = (rhi < 0 ? 0 : (rhi > ROWS - NA_KH ? ROWS - NA_KH : rhi)) + NA_KH - 1;
        const int nloc = rhi - rlo + 1;
        att::Job J{};
        J.Q = A.NQ + (size_t)(b * SEQ + R0 * 64) * GROUP_W + h * HD; J.K = A.NK + h * HD; J.V = A.P + C_NV + h * HD;
        J.O = A.Y + (size_t)(b * SEQ + R0 * 64) * D_MODEL + 3 * GROUP_W + h * HD;
        J.nt = (nloc + 4 + 1) & ~1; J.seg0_tiles = nloc; J.row_seg0 = b * SEQ + rlo * 64; J.row_seg1 = M_LAT + b * CTX_LEN;  J.R0 = R0; J.rlo = rlo;
        att::attn_unit<HD, true, GROUP_W, GROUP_W, NP, D_MODEL>(J, lds, sc_na, tid);
    }
    if (A.want_ctx && !(A.pad & 8)) {
        for (int u = c2 - 64; u >= 0 && u < BATCH * NH; u += G) {
            const int b = u / NH, h = u % NH; const int crow0 = M_LAT + b * CTX_LEN;
            att::Job J{}; J.nt = CTX_LEN / 64; J.seg0_tiles = 0; J.row_seg0 = crow0; J.row_seg1 = crow0;
            J.Q = A.QM + (size_t)crow0 * NQ_MLA + h * MLA_QK; J.K = A.KM + h * MLA_QK; J.V = A.VM + h * MLA_V;
            J.O = A.Y + (size_t)crow0 * D_MODEL + GROUP_W + h * MLA_V; att::attn_unit<MLA_QK, false, NQ_MLA, NQ_MLA, NH * MLA_V, D_MODEL>(J, lds, sc_mla, tid);
        }
        for (int u = c2 - 64 - BATCH * NH; u >= 0 && u < BATCH * NH; u += G) {
            const int b = u / NH, h = u % NH; const int crow0 = M_LAT + b * CTX_LEN;
            att::Job J{}; J.nt = CTX_LEN / 64; J.seg0_tiles = 0; J.row_seg0 = crow0; J.row_seg1 = crow0;
            J.Q = A.NQ + (size_t)crow0 * GROUP_W + h * HD; J.K = A.NK + h * HD; J.V = A.P + C_NV + h * HD;
            J.O = A.Y + (size_t)crow0 * D_MODEL + 3 * GROUP_W + h * HD; att::attn_unit<HD, false, GROUP_W, GROUP_W, NP, D_MODEL>(J, lds, sc_na, tid);
        }
    }
}

namespace gdn {
typedef short bf16x8 __attribute__((ext_vector_type(8)));
typedef float f32x4 __attribute__((ext_vector_type(4)));
typedef float f32x16 __attribute__((ext_vector_type(16)));
typedef unsigned u32x2 __attribute__((ext_vector_type(2)));
typedef unsigned u32x4 __attribute__((ext_vector_type(4)));
constexpr int CH = 64, NCHUNK = M_ALL / CH;
constexpr int NTASK = NCHUNK * NH * 2;
constexpr size_t SZ_UT = 128 * 64, SZ_WP = 64 * 128, SZ_KDT = 128 * 64, SZ_QD = 64 * 128, SZ_QK = 64 * 64, SZ_SIT = 128 * 128, SZ_VNT = 128 * 64;
struct Bufs { bf16_t *UT, *WP, *KDT, *QD, *QK, *SIT, *VNT; float* GT; };
__device__ __forceinline__ int perm32(int o) { return (o & ~31) | (((o & 15) >> 2) * 8 + ((o >> 4) & 1) * 4 + (o & 3)); }
__device__ __forceinline__ unsigned pk2(float lo, float hi) { return (unsigned)f2bf(lo) | ((unsigned)f2bf(hi) << 16); }

constexpr int QS = 132;
constexpr int AS = 68;
constexpr int G1_OFF_Q = 0, G1_OFF_K = G1_OFF_Q + CH * QS * 4, G1_OFF_V = G1_OFF_K + CH * QS * 4, G1_OFF_AA = G1_OFF_V + CH * QS * 4, G1_OFF_SM = G1_OFF_AA + 2 * CH * AS * 4,
              G1_LDS = G1_OFF_SM + 12 * 64 * 4;
struct G1Args { const bf16_t* P; const float* conv_w; const float* a_log; const float* dt_bias; Bufs B; int pflags; };

__device__ __forceinline__ void g1_task(const G1Args& A, char* lds, int cix, int h, const int tid_in) {
    int tid_ = tid_in; asm volatile("" : "+v"(tid_));
    const int tid = tid_, wid = __builtin_amdgcn_readfirstlane(tid >> 6), lane = tid & 63;
    float* Qs = (float*)(lds + G1_OFF_Q); float* Ks = (float*)(lds + G1_OFF_K); float* Vs = (float*)(lds + G1_OFF_V); float* AA = (float*)(lds + G1_OFF_AA);
    float* sm = (float*)(lds + G1_OFF_SM); float* g_s = sm;   float* beta_s = sm + 128;   float* gc_s = sm + 256;
    const int row0 = cix * CH; const RowInfo r0i = row_info(row0);
    LDS_BARRIER();
    if (tid < 48 * 8) {
        const int grp = tid % 48, ts = tid / 48, which = grp >> 4, cc0 = (grp & 15) * 8, ch0 = which * GROUP_W + h * HD + cc0;
        float wgt[4][8];
#pragma unroll
        for (int j = 0; j < 4; ++j) { const f32x4 w0 = *(const f32x4*)(A.conv_w + j * 3 * GROUP_W + ch0), w1 = *(const f32x4*)(A.conv_w + j * 3 * GROUP_W + ch0 + 4);
#pragma unroll
            for (int e = 0; e < 4; ++e) { wgt[j][e] = w0[e]; wgt[j][4 + e] = w1[e]; } }
        u32x4 xr[11];
#pragma unroll
        for (int k = 0; k < 11; ++k) { const int tt = r0i.t + 8 * ts + k - 1;
            xr[k] = (tt >= 0 && tt < r0i.T && !(A.pflags & 4096)) ? *(const u32x4*)(A.P + (size_t)(r0i.base + tt) * NP + C_GQ + ch0) : (u32x4){0u, 0u, 0u, 0u}; }
        float* dstp = (which == 0 ? Qs : which == 1 ? Ks : Vs) + cc0;
#pragma unroll
        for (int i = 0; i < 8; ++i) { float acc[8];
#pragma unroll
            for (int e = 0; e < 8; ++e) acc[e] = 0.f;
#pragma unroll
            for (int j = 0; j < 4; ++j) { const u32x4 xv = xr[i + j];
#pragma unroll
                for (int e = 0; e < 4; ++e) { acc[2 * e] += wgt[j][2 * e] * bflo(xv[e]); acc[2 * e + 1] += wgt[j][2 * e + 1] * bfhi(xv[e]); } }
            f32x4 y0, y1;
#pragma unroll
            for (int e = 0; e < 4; ++e) { y0[e] = acc[e] * __builtin_amdgcn_rcpf(1.0f + __expf(-acc[e])); y1[e] = acc[4 + e] * __builtin_amdgcn_rcpf(1.0f + __expf(-acc[4 + e])); }
            *(f32x4*)(dstp + (8 * ts + i) * QS) = y0; *(f32x4*)(dstp + (8 * ts + i) * QS + 4) = y1; }
    }
    if (tid < 128) { const int d = tid >> 6, i = tid & 63; const size_t r = (size_t)(row0 + i) * NP;
        beta_s[d * 64 + i] = 1.0f / (1.0f + __expf(-bf2f(A.P[r + C_GB + d * NH + h])));
        g_s[d * 64 + i] = -__expf(A.a_log[d * NH + h]) * softplusf_(bf2f(A.P[r + C_GA + d * NH + h]) + A.dt_bias[d * NH + h]); }
    LDS_BARRIER();
    for (int rr = wid * 4 + (lane >> 4); rr < 2 * CH; rr += 32) { float* rowp = (rr < CH ? Qs : Ks) + (rr & 63) * QS + (lane & 15) * 8;
        f32x4 a = *(const f32x4*)rowp, b = *(const f32x4*)(rowp + 4); float ss = (a[0] * a[0] + a[1] * a[1]) + (a[2] * a[2] + a[3] * a[3]) + (b[0] * b[0] + b[1] * b[1]) + (b[2] * b[2] + b[3] * b[3]);
#pragma unroll
        for (int o = 1; o < 16; o <<= 1) ss += lane_xor(ss, o, lane);
        const float scl = __builtin_amdgcn_rsqf(ss + EPS) * (rr < CH ? 0.08838834764831845f : 1.0f);
        *(f32x4*)rowp = a * scl; *(f32x4*)(rowp + 4) = b * scl; }
    if (tid < 2) {
        f32x4 gv[16];
#pragma unroll
        for (int m = 0; m < 16; ++m) gv[m] = *(const f32x4*)(g_s + tid * 64 + 4 * m);
        float run = 0.f;
        if (tid == 0) {
#pragma unroll
            for (int m = 0; m < 16; ++m) { f32x4 o4;
#pragma unroll
                for (int e = 0; e < 4; ++e) { run += gv[m][e]; o4[e] = run; }
                *(f32x4*)(gc_s + 4 * m) = o4; }
        } else {
#pragma unroll
            for (int m = 15; m >= 0; --m) { f32x4 o4;
#pragma unroll
                for (int e = 3; e >= 0; --e) { run += gv[m][e]; o4[e] = run; }
                *(f32x4*)(gc_s + 64 + 4 * m) = o4; }
        }
    }
    LDS_BARRIER();
    float* eq_s = sm + 384; float* ek_s = sm + 512;
    if (tid < 128) { const int d = tid >> 6, i = tid & 63; const float gci = gc_s[d * 64 + i], glast = d == 0 ? gc_s[63] : gc_s[64];
        eq_s[tid] = __expf(gci); ek_s[tid] = __expf(glast - gci); }
    const int gwhich = wid >> 2, gI = (wid >> 1) & 1, gJ = wid & 1, r32 = lane & 31, hi = lane >> 5;
    f32x16 acc = {};
    if (!(A.pflags & 1024)) {
        const float* X = (gwhich ? Qs : Ks) + (32 * gI + r32) * QS + 4 * hi; const float* Yp = Ks + (32 * gJ + r32) * QS + 4 * hi;
#pragma unroll
        for (int s = 0; s < 16; ++s) { const f32x4 a4 = *(const f32x4*)(X + 8 * s), b4 = *(const f32x4*)(Yp + 8 * s);
#pragma unroll
            for (int e = 0; e < 4; ++e) acc = __builtin_amdgcn_mfma_f32_32x32x2f32(a4[e], b4[e], acc, 0, 0, 0); }
        const int j = 32 * gJ + r32;
        if (gwhich == 0) {
            const float b1j = beta_s[64 + j], g0j = gc_s[j], g1j = gc_s[64 + j];
#pragma unroll
            for (int r = 0; r < 16; ++r) { const int i = 32 * gI + (r & 3) + 8 * (r >> 2) + 4 * hi;
                if (i > j) { const float kk = acc[r];
                    AA[(63 - j) * AS + (63 - i)] = beta_s[i] * kk * __expf(gc_s[i] - g0j);
                    AA[CH * AS + i * AS + j] = b1j * kk * __expf(g1j - gc_s[64 + i]); } }
        }
    }
    LDS_BARRIER();
    const size_t t0 = ((size_t)cix * NH + h) * 2;
    if (!(A.pflags & 2048)) {
#pragma unroll
        for (int n = 0; n < 4; ++n) { const int it = tid + 512 * n, d = it >> 10, p = (it >> 4) & 63, m = it & 15, i = d == 0 ? p : 63 - p, k0 = 32 * (m >> 2) + 4 * (m & 3);
            const float e = eq_s[d * 64 + i]; const f32x4 lo = *(const f32x4*)(Qs + i * QS + k0), hi4 = *(const f32x4*)(Qs + i * QS + k0 + 16);
            *(u32x4*)(A.B.QD + (t0 + d) * SZ_QD + (size_t)p * 128 + m * 8) = (u32x4){pk2(lo[0] * e, lo[1] * e), pk2(lo[2] * e, lo[3] * e), pk2(hi4[0] * e, hi4[1] * e), pk2(hi4[2] * e, hi4[3] * e)}; }
#pragma unroll
        for (int n = 0; n < 4; ++n) { const int it = tid + 512 * n, k = it & 127, d = (it >> 7) & 1, m = it >> 8, p0 = 32 * (m >> 2) + 4 * (m & 3);
            float v[8];
#pragma unroll
            for (int jj = 0; jj < 8; ++jj) { const int p = p0 + (jj < 4 ? jj : 12 + jj), i = d == 0 ? p : 63 - p; v[jj] = Ks[i * QS + k] * ek_s[d * 64 + i]; }
            *(u32x4*)(A.B.KDT + (t0 + d) * SZ_KDT + (size_t)k * 64 + m * 8) = (u32x4){pk2(v[0], v[1]), pk2(v[2], v[3]), pk2(v[4], v[5]), pk2(v[6], v[7])}; }
        if (tid == 0) { A.B.GT[t0] = __expf(gc_s[63]); A.B.GT[t0 + 1] = __expf(gc_s[64]); }
    }
    LDS_BARRIER();
    bf16_t* stg = (bf16_t*)Qs;
    if (gwhich == 1) { const int j = 32 * gJ + r32; const float g0j = gc_s[j], g1j = gc_s[64 + j];
#pragma unroll
        for (int r = 0; r < 16; ++r) { const int i = 32 * gI + (r & 3) + 8 * (r >> 2) + 4 * hi; const float qk = acc[r];
            stg[i * 64 + perm32(j)] = f2bf(i >= j ? qk * __expf(gc_s[i] - g0j) : 0.f);
            stg[4096 + (63 - i) * 64 + perm32(63 - j)] = f2bf(i <= j ? qk * __expf(gc_s[64 + i] - g1j) : 0.f); } }
    LDS_BARRIER();
#pragma unroll
    for (int n = 0; n < 2; ++n) { const int c16 = tid + 512 * n; *(u32x4*)(A.B.QK + t0 * SZ_QK + (size_t)c16 * 8) = *(const u32x4*)(stg + c16 * 8); }
    if (!(A.pflags & 512)) {
        int tidv = tid; asm volatile("" : "+v"(tidv));
        const int d = tidv >> 8, c = tidv & 255; const bool isw = c >= 128; const int cc = c & 127;
        const float* src = isw ? Ks : Vs;
        int lz; asm volatile("v_mov_b32 %0, 0" : "=v"(lz));
        const float* AAv = AA + lz + d * (CH * AS);
        float x[CH];
#pragma unroll
        for (int p = 0; p < CH; ++p) { const int i = d == 0 ? p : 63 - p; float f = beta_s[d * 64 + i]; if (isw) f *= eq_s[d * 64 + i]; x[p] = f * src[i * QS + cc]; }
        {
#pragma unroll
            for (int p = 0; p < CH - 1; ++p) { const float xp = x[p]; const float* rowp = AAv + (63 - p) * AS;
#pragma unroll
                for (int m = 0; m <= (62 - p) / 4; ++m) { const f32x4 a4 = *(const f32x4*)(rowp + 4 * m);
#pragma unroll
                    for (int e = 0; e < 4; ++e) { const int col = 4 * m + e; if (col <= 62 - p) x[63 - col] -= a4[e] * xp; } } }
        }
        LDS_BARRIER();
        if (!isw) { bf16_t* dst = A.B.UT + (t0 + d) * SZ_UT + (size_t)((cc >> 4) * 2 * 64 + (cc & 15)) * 8;
#pragma unroll
            for (int s = 0; s < 2; ++s)
#pragma unroll
                for (int qq = 0; qq < 4; ++qq) { const int p0 = 32 * s + 4 * qq; u32x4 w4; w4.x = pk2(x[p0], x[p0 + 1]); w4.y = pk2(x[p0 + 2], x[p0 + 3]); w4.z = pk2(x[p0 + 16], x[p0 + 17]); w4.w = pk2(x[p0 + 18], x[p0 + 19]);
                    *(u32x4*)(dst + (size_t)(s * 64 + qq * 16) * 8) = w4; }
        } else { bf16_t* dst = stg + d * 8192 + perm32(cc);
#pragma unroll
            for (int p = 0; p < CH; ++p) dst[p * 128] = f2bf(x[p]); }
    }
    LDS_BARRIER();
#pragma unroll
    for (int n = 0; n < 4; ++n) { const int c16 = tid + 512 * n; *(u32x4*)(A.B.WP + t0 * SZ_WP + (size_t)c16 * 8) = *(const u32x4*)(stg + c16 * 8); }
}
__device__ __forceinline__ void g1_phase(const G1Args& A, char* lds, int G, int wg, const int tid) {
    for (int t = wg; t < NCHUNK * NH; t += G) g1_task(A, lds, t / NH, t % NH, tid);
}

constexpr int G2_SPLIT = 4, G2_NACT = 8 / G2_SPLIT, G2_NSTEP = CTX_LEN / CH + SEQ / CH, G2_WGS = BATCH * NH * 2 * G2_SPLIT;
constexpr int G2_USL = G2_NACT * 2 * 64 * 16;
constexpr int G2_BUF = 16384 + 16384 + G2_USL, G2_NB = 4, G2_LDS = G2_NB * G2_BUF;
static_assert(G2_SPLIT == 4 && G2_USL == 4096, "G2 staging map below assumes 4 KB of u per step");
__device__ __forceinline__ int g2_task_index(int b, int h, int d, int step) {
    constexpr int NC = CTX_LEN / CH, NL = SEQ / CH; int cix;
    if (step < NC) { const int n = d ? NC - 1 - step : step; cix = M_LAT / CH + b * NC + n; }
    else { const int s2 = step - NC, n = d ? NL - 1 - s2 : s2; cix = b * NL + n; }
    return (cix * NH + h) * 2 + d;
}
__device__ __forceinline__ void g2_chain(const Bufs& B, char* lds, int chain_part, const int tid_in, const int step_lo, const int step_hi, float* Ssave) {
    int tid_ = tid_in; asm volatile("" : "+v"(tid_));
    const int tid = tid_, wid = __builtin_amdgcn_readfirstlane(tid >> 6), lane = tid & 63, q = lane >> 4, vl = lane & 15;
    const int chain = chain_part / G2_SPLIT, part = chain_part % G2_SPLIT;
    const bool active = wid < G2_NACT; const int vt = part * G2_NACT + (active ? wid : 0);
    const int d = chain & 1, h = (chain >> 1) % NH, b = chain / (2 * NH);
    constexpr int NSTEP = CTX_LEN / CH + SEQ / CH;
    const unsigned ldsb = (unsigned)(uintptr_t)lds;
    f32x4 S[8];
    f32x4* sv = (f32x4*)Ssave + ((size_t)chain_part * G2_NACT + (active ? wid : 0)) * 8 * 64 + lane;
#pragma unroll
    for (int kb = 0; kb < 8; ++kb) S[kb] = (step_lo > 0 && active) ? sv[kb * 64] : (f32x4){0.f, 0.f, 0.f, 0.f};
    unsigned offw[2], offk[2], offu;
#pragma unroll
    for (int i = 0; i < 2; ++i) { const int sl = 128 * wid + 64 * i + lane;
        { const int row = sl >> 4, pc = sl & 15, c = pc ^ (row & 15); offw[i] = (unsigned)(row * 256 + c * 16); }
        { const int row = sl >> 3, pc = sl & 7, c = pc ^ ((row >> 1) & 7); offk[i] = (unsigned)(row * 128 + c * 16); } }
    offu = (unsigned)((part * G2_NACT * 2 * 64 + (wid & 3) * 64 + lane) * 16);
#define G2_DMA(ti, slot) do { const char* wp_ = (const char*)(B.WP + (size_t)(ti) * SZ_WP); const char* kp_ = (const char*)(B.KDT + (size_t)(ti) * SZ_KDT); const unsigned base_ = ldsb + (unsigned)(slot) * G2_BUF; \
        _Pragma("unroll") for (int i_ = 0; i_ < 2; ++i_) { \
            __builtin_amdgcn_global_load_lds((const unsigned*)(wp_ + offw[i_]), (ATT_LAS unsigned*)(base_ + (128 * wid + 64 * i_) * 16), 16, 0, 0); \
            __builtin_amdgcn_global_load_lds((const unsigned*)(kp_ + offk[i_]), (ATT_LAS unsigned*)(base_ + 16384 + (128 * wid + 64 * i_) * 16), 16, 0, 0); } \
        if (wid >= 4) __builtin_amdgcn_global_load_lds((const unsigned*)((const char*)(B.UT + (size_t)(ti) * SZ_UT) + offu), (ATT_LAS unsigned*)(base_ + 32768 + ((wid & 3) * 64) * 16), 16, 0, 0); } while (0)
#define G2_TI(step) g2_task_index(b, h, d, (step) < NSTEP ? (step) : NSTEP - 1)
    __syncthreads();
    G2_DMA(G2_TI(step_lo), step_lo & 3); G2_DMA(G2_TI(step_lo + 1), (step_lo + 1) & 3); G2_DMA(G2_TI(step_lo + 2), (step_lo + 2) & 3);
    asm volatile("s_waitcnt vmcnt(0)" ::: "memory");
    __syncthreads();
    for (int step = step_lo; step < step_hi; ++step) {
        const int ti = G2_TI(step), slot = step & 3;
        G2_DMA(G2_TI(step + 3), (step + 3) & 3);
        unsigned gtb; { const float* gp = B.GT + ti; asm volatile("s_load_dword %0, %1, 0x0" : "=s"(gtb) : "s"(gp)); }
        const char* wl = lds + slot * G2_BUF; const char* kl = wl + 16384; const char* ul = kl + 16384;
        if (active) {
            bf16x8 aw[16], ak[16];
#pragma unroll
            for (int rb = 0; rb < 4; ++rb)
#pragma unroll
                for (int s = 0; s < 4; ++s) aw[rb * 4 + s] = *(const bf16x8*)(wl + (16 * rb + vl) * 256 + (((4 * s + q) ^ vl) << 4));
#pragma unroll
            for (int kb = 0; kb < 8; ++kb)
#pragma unroll
                for (int s = 0; s < 2; ++s) ak[kb * 2 + s] = *(const bf16x8*)(kl + (16 * kb + vl) * 128 + (((4 * s + q) ^ ((vl >> 1) & 7)) << 4));
            u32x4 uu[2];
#pragma unroll
            for (int s = 0; s < 2; ++s) uu[s] = *(const u32x4*)(ul + ((wid * 2 + s) * 64 + lane) * 16);
            bf16_t* sit = B.SIT + (size_t)ti * SZ_SIT + (size_t)(vt * 4 * 64 + lane) * 8;
            bf16x8 sf[4];
#pragma unroll
            for (int s = 0; s < 4; ++s) { u32x4 w4; w4.x = pk2(S[2 * s][0], S[2 * s][1]); w4.y = pk2(S[2 * s][2], S[2 * s][3]); w4.z = pk2(S[2 * s + 1][0], S[2 * s + 1][1]); w4.w = pk2(S[2 * s + 1][2], S[2 * s + 1][3]);
                sf[s] = __builtin_bit_cast(bf16x8, w4); *(u32x4*)(sit + (size_t)s * 64 * 8) = w4; }
            __builtin_amdgcn_sched_barrier(0);
            f32x4 vn[4];
#pragma unroll
            for (int rb = 0; rb < 4; ++rb) vn[rb] = (f32x4){0.f, 0.f, 0.f, 0.f};
#pragma unroll
            for (int s = 0; s < 4; ++s)
#pragma unroll
                for (int rb = 0; rb < 4; ++rb) vn[rb] = __builtin_amdgcn_mfma_f32_16x16x32_bf16(aw[rb * 4 + s], sf[s], vn[rb], 0, 0, 0);
#pragma unroll
            for (int s = 0; s < 2; ++s) { const f32x4 a0 = vn[2 * s], a1 = vn[2 * s + 1];
                vn[2 * s][0] = bflo(uu[s].x) - a0[0]; vn[2 * s][1] = bfhi(uu[s].x) - a0[1]; vn[2 * s][2] = bflo(uu[s].y) - a0[2]; vn[2 * s][3] = bfhi(uu[s].y) - a0[3];
                vn[2 * s + 1][0] = bflo(uu[s].z) - a1[0]; vn[2 * s + 1][1] = bfhi(uu[s].z) - a1[1]; vn[2 * s + 1][2] = bflo(uu[s].w) - a1[2]; vn[2 * s + 1][3] = bfhi(uu[s].w) - a1[3]; }
            bf16_t* vnt = B.VNT + (size_t)ti * SZ_VNT + (size_t)(vt * 2 * 64 + lane) * 8;
            bf16x8 vf[2];
#pragma unroll
            for (int s = 0; s < 2; ++s) { u32x4 w4; w4.x = pk2(vn[2 * s][0], vn[2 * s][1]); w4.y = pk2(vn[2 * s][2], vn[2 * s][3]); w4.z = pk2(vn[2 * s + 1][0], vn[2 * s + 1][1]); w4.w = pk2(vn[2 * s + 1][2], vn[2 * s + 1][3]);
                vf[s] = __builtin_bit_cast(bf16x8, w4); *(u32x4*)(vnt + (size_t)s * 64 * 8) = w4; }
            asm volatile("s_waitcnt lgkmcnt(0)" ::: "memory");
            const float gt = __uint_as_float(gtb);
#pragma unroll
            for (int kb = 0; kb < 8; ++kb) S[kb] = S[kb] * gt;
#pragma unroll
            for (int s = 0; s < 2; ++s)
#pragma unroll
                for (int kb = 0; kb < 8; ++kb) S[kb] = __builtin_amdgcn_mfma_f32_16x16x32_bf16(ak[kb * 2 + s], vf[s], S[kb], 0, 0, 0);
            __builtin_amdgcn_sched_barrier(0);
            asm volatile("s_waitcnt vmcnt(26) lgkmcnt(0)\n\ts_barrier" ::: "memory");
        } else if (wid >= 4) {
            asm volatile("s_waitcnt vmcnt(10) lgkmcnt(0)\n\ts_barrier" ::: "memory");
        } else {
            asm volatile("s_waitcnt vmcnt(8) lgkmcnt(0)\n\ts_barrier" ::: "memory");
        }
    }
    if (step_hi < NSTEP && active) {
#pragma unroll
        for (int kb = 0; kb < 8; ++kb) sv[kb * 64] = S[kb]; }
    asm volatile("s_waitcnt vmcnt(0)" ::: "memory");
    __syncthreads();
#undef G2_DMA
#undef G2_TI
}

constexpr int G3_OS = 132, G3_LDS = 64 * G3_OS * 4;
struct G3Args { Bufs B; const bf16_t* P; const float* norm_g; bf16_t* Y; };
__device__ __forceinline__ void g3_task(const G3Args& A, char* lds, int cix, int h, const int tid_in) {
    int tid_ = tid_in; asm volatile("" : "+v"(tid_));
    const int tid = tid_, wid = __builtin_amdgcn_readfirstlane(tid >> 6), lane = tid & 63, q = lane >> 4, vl = lane & 15;
    f32x4 o[2][4];
#pragma unroll
    for (int d = 0; d < 2; ++d) {
        const size_t t = ((size_t)cix * NH + h) * 2 + d;
        const bf16_t* sit = A.B.SIT + t * SZ_SIT + (size_t)(wid * 4 * 64 + lane) * 8;
        const bf16_t* vnt = A.B.VNT + t * SZ_VNT + (size_t)(wid * 2 * 64 + lane) * 8;
        const bf16_t* qd = A.B.QD + t * SZ_QD + (size_t)vl * 128 + 8 * q;
        const bf16_t* qk = A.B.QK + t * SZ_QK + (size_t)vl * 64 + 8 * q;
        bf16x8 sf[4], vf[2];
#pragma unroll
        for (int s = 0; s < 4; ++s) sf[s] = *(const bf16x8*)(sit + (size_t)s * 64 * 8);
#pragma unroll
        for (int s = 0; s < 2; ++s) vf[s] = *(const bf16x8*)(vnt + (size_t)s * 64 * 8);
#pragma unroll
        for (int rb = 0; rb < 4; ++rb) { f32x4 acc = {0.f, 0.f, 0.f, 0.f};
#pragma unroll
            for (int s = 0; s < 4; ++s) acc = __builtin_amdgcn_mfma_f32_16x16x32_bf16(*(const bf16x8*)(qd + (size_t)rb * 16 * 128 + 32 * s), sf[s], acc, 0, 0, 0);
#pragma unroll
            for (int s = 0; s < 2; ++s) acc = __builtin_amdgcn_mfma_f32_16x16x32_bf16(*(const bf16x8*)(qk + (size_t)rb * 16 * 64 + 32 * s), vf[s], acc, 0, 0, 0);
            o[d][rb] = acc; }
    }
    f32x4 ot[4];
#pragma unroll
    for (int rb = 0; rb < 4; ++rb)
#pragma unroll
        for (int r = 0; r < 4; ++r) ot[rb][r] = o[0][rb][r] + lane_xor(o[1][3 - rb][3 - r], 48, lane);
    float* Ot = (float*)lds;
    LDS_BARRIER();
#pragma unroll
    for (int rb = 0; rb < 4; ++rb)
#pragma unroll
        for (int r = 0; r < 4; ++r) Ot[(16 * rb + 4 * q + r) * G3_OS + 16 * wid + vl] = ot[rb][r];
    LDS_BARRIER();
#pragma unroll
    for (int n = 0; n < 2; ++n) { const int item = tid + 512 * n, tok = item >> 4, c8 = (item & 15) * 8;
        const f32x4 o0 = *(const f32x4*)(Ot + tok * G3_OS + c8), o1 = *(const f32x4*)(Ot + tok * G3_OS + c8 + 4);
        float ss = (o0[0] * o0[0] + o0[1] * o0[1]) + (o0[2] * o0[2] + o0[3] * o0[3]) + (o1[0] * o1[0] + o1[1] * o1[1]) + (o1[2] * o1[2] + o1[3] * o1[3]);
#pragma unroll
        for (int of = 1; of < 16; of <<= 1) ss += lane_xor(ss, of, lane);
        const float rstd = __builtin_amdgcn_rsqf(ss * (1.0f / HD) + EPS);
        const f32x4 g0 = *(const f32x4*)(A.norm_g + c8), g1 = *(const f32x4*)(A.norm_g + c8 + 4);
        const size_t row = (size_t)cix * CH + tok; const u32x4 gw = *(const u32x4*)(A.P + row * NP + C_GG + h * HD + c8);
        float y[8];
#pragma unroll
        for (int e = 0; e < 4; ++e) { const float ga = bflo(gw[e]), gb = bfhi(gw[e]); const float oa = e < 2 ? o0[2 * e] : o1[2 * e - 4], ob = e < 2 ? o0[2 * e + 1] : o1[2 * e - 3];
            const float na = e < 2 ? g0[2 * e] : g1[2 * e - 4], nb = e < 2 ? g0[2 * e + 1] : g1[2 * e - 3];
            y[2 * e] = oa * rstd * na * (ga * __builtin_amdgcn_rcpf(1.0f + __expf(-ga))); y[2 * e + 1] = ob * rstd * nb * (gb * __builtin_amdgcn_rcpf(1.0f + __expf(-gb))); }
        *(u32x4*)(A.Y + row * D_MODEL + 2 * GROUP_W + h * HD + c8) = (u32x4){pk2(y[0], y[1]), pk2(y[2], y[3]), pk2(y[4], y[5]), pk2(y[6], y[7])};
    }
}
__device__ __forceinline__ void g3_phase(const G3Args& A, char* lds, int G, int wg, const int tid) {
    for (int t = wg; t < NCHUNK * NH; t += G) g3_task(A, lds, t / NH, t % NH, tid);
}
}

namespace lru {
typedef short bf16x8 __attribute__((ext_vector_type(8)));
typedef float f32x4 __attribute__((ext_vector_type(4)));
typedef unsigned u32x2 __attribute__((ext_vector_type(2)));
typedef unsigned u32x4 __attribute__((ext_vector_type(4)));
constexpr int CH = 64, NCHUNK = M_ALL / CH;
constexpr int US = 129;
constexpr int UBS = 272;
constexpr int L_OFF_U = 0, L_OFF_UB = CH * US * 4, L_LDS = L_OFF_UB + CH * UBS;
constexpr size_t SZ_WBLK = (size_t)LRU_BW * LRU_BW;
struct Bufs { bf16_t* HLOC; bf16_t* ACUM; float* LSUM; float* HIN; };
struct LocalArgs { const bf16_t* P; const float* conv_w; const float* conv_b; const bf16_t* WG;   const float* ba; const float* bx; const float* lam; Bufs B; };

__device__ __forceinline__ unsigned pk2(float lo, float hi) { return (unsigned)f2bf(lo) | ((unsigned)f2bf(hi) << 16); }

__device__ __forceinline__ void local_task(const LocalArgs& A, char* lds, int cix, int nb, const int tid_in) {
    int tid_ = tid_in; asm volatile("" : "+v"(tid_));
    const int tid = tid_, wid = __builtin_amdgcn_readfirstlane(tid >> 6), lane = tid & 63, q = lane >> 4, tl = lane & 15;
    float* Us = (float*)(lds + L_OFF_U); char* Ub = lds + L_OFF_UB;
    const int row0 = cix * CH; const RowInfo r0i = row_info(row0);
    LDS_BARRIER();
    {
        const int grp = tid & 15, t2 = tid >> 4, c0 = grp * 8, ch0 = nb * LRU_BW + c0;
        float wgt[4][8], bia[8];
#pragma unroll
        for (int j = 0; j < 4; ++j) { const f32x4 w0 = *(const f32x4*)(A.conv_w + j * LRU_W + ch0), w1 = *(const f32x4*)(A.conv_w + j * LRU_W + ch0 + 4);
#pragma unroll
            for (int e = 0; e < 4; ++e) { wgt[j][e] = w0[e]; wgt[j][4 + e] = w1[e]; } }
        { const f32x4 b0 = *(const f32x4*)(A.conv_b + ch0), b1 = *(const f32x4*)(A.conv_b + ch0 + 4);
#pragma unroll
          for (int e = 0; e < 4; ++e) { bia[e] = b0[e]; bia[4 + e] = b1[e]; } }
        u32x4 xr[5];
#pragma unroll
        for (int k = 0; k < 5; ++k) { const int tt = r0i.t + 2 * t2 + k - 1;
            xr[k] = (tt >= 0 && tt < r0i.T) ? *(const u32x4*)(A.P + (size_t)(r0i.base + tt) * NP + C_LRU_X + ch0) : (u32x4){0u, 0u, 0u, 0u}; }
#pragma unroll
        for (int i = 0; i < 2; ++i) { float acc[8];
#pragma unroll
            for (int e = 0; e < 8; ++e) acc[e] = bia[e];
#pragma unroll
            for (int j = 0; j < 4; ++j) { const u32x4 xv = xr[i + j];
#pragma unroll
                for (int e = 0; e < 4; ++e) { acc[2 * e] += wgt[j][2 * e] * bflo(xv[e]); acc[2 * e + 1] += wgt[j][2 * e + 1] * bfhi(xv[e]); } }
            const int tok = 2 * t2 + i;
#pragma unroll
            for (int e = 0; e < 8; ++e) Us[tok * US + c0 + e] = acc[e];
            *(u32x4*)(Ub + tok * UBS + c0 * 2) = (u32x4){pk2(acc[0], acc[1]), pk2(acc[2], acc[3]), pk2(acc[4], acc[5]), pk2(acc[6], acc[7])}; }
    }
    LDS_BARRIER();
    f32x4 acc[2][2][4];
#pragma unroll
    for (int d = 0; d < 2; ++d)
#pragma unroll
        for (int wh = 0; wh < 2; ++wh)
#pragma unroll
            for (int tb = 0; tb < 4; ++tb) acc[d][wh][tb] = (f32x4){0.f, 0.f, 0.f, 0.f};
#pragma unroll
    for (int s = 0; s < 4; ++s) {
        bf16x8 bfr[4];
#pragma unroll
        for (int tb = 0; tb < 4; ++tb) bfr[tb] = *(const bf16x8*)(Ub + (16 * tb + tl) * UBS + (32 * s + 8 * q) * 2);
#pragma unroll
        for (int d = 0; d < 2; ++d)
#pragma unroll
            for (int wh = 0; wh < 2; ++wh) { const bf16x8 a = *(const bf16x8*)(A.WG + ((size_t)((d * 2 + wh) * NH + nb)) * SZ_WBLK + (size_t)(16 * wid + tl) * LRU_BW + 32 * s + 8 * q);
#pragma unroll
                for (int tb = 0; tb < 4; ++tb) acc[d][wh][tb] = __builtin_amdgcn_mfma_f32_16x16x32_bf16(a, bfr[tb], acc[d][wh][tb], 0, 0, 0); }
    }
    const int chb = nb * LRU_BW + 16 * wid + 4 * q;
#pragma unroll
    for (int d = 0; d < 2; ++d) {
        float sp[4], bav[4], bxv[4];
#pragma unroll
        for (int r = 0; r < 4; ++r) { sp[r] = -LRU_C * softplusf_(-A.lam[d * LRU_W + chb + r]); bav[r] = A.ba[d * LRU_W + chb + r]; bxv[r] = A.bx[d * LRU_W + chb + r]; }
        float Ac[4], Bc[4];
#pragma unroll
        for (int r = 0; r < 4; ++r) { Ac[r] = 1.f; Bc[r] = 0.f; }
#pragma unroll
        for (int tbi = 0; tbi < 4; ++tbi) { const int tb = d == 0 ? tbi : 3 - tbi; const int tok = 16 * tb + tl;
            float a[4], b[4];
#pragma unroll
            for (int r = 0; r < 4; ++r) { const float rr = __builtin_amdgcn_rcpf(1.0f + __expf(-(acc[d][0][tb][r] + bav[r]))), ii = __builtin_amdgcn_rcpf(1.0f + __expf(-(acc[d][1][tb][r] + bxv[r])));
                const float log_a = sp[r] * rr, x2 = 2.0f * log_a; a[r] = __expf(log_a);
                float em = 1.0f + x2 * (1.0f / 6.0f); em = 1.0f + x2 * 0.2f * em; em = 1.0f + x2 * 0.25f * em; em = 1.0f + x2 * (1.0f / 3.0f) * em; em = 1.0f + x2 * 0.5f * em; em = -x2 * em;
                if (__builtin_expect(x2 < -0.25f, 0)) em = -expm1f(x2);
                b[r] = __builtin_amdgcn_sqrtf(em) * ii * Us[tok * US + 16 * wid + 4 * q + r]; }
#define LRU_SCAN_STEP(CTRL) do { _Pragma("unroll") for (int r = 0; r < 4; ++r) { \
                const float ap = __int_as_float(__builtin_amdgcn_update_dpp(0x3f800000, __float_as_int(a[r]), (CTRL), 0xf, 0xf, false)); \
                const float bp = __int_as_float(__builtin_amdgcn_update_dpp(0, __float_as_int(b[r]), (CTRL), 0xf, 0xf, false)); \
                b[r] = a[r] * bp + b[r]; a[r] = a[r] * ap; } } while (0)
            if (d == 0) { LRU_SCAN_STEP(0x111); LRU_SCAN_STEP(0x112); LRU_SCAN_STEP(0x114); LRU_SCAN_STEP(0x118); }
            else        { LRU_SCAN_STEP(0x101); LRU_SCAN_STEP(0x102); LRU_SCAN_STEP(0x104); LRU_SCAN_STEP(0x108); }
#undef LRU_SCAN_STEP
#pragma unroll
            for (int r = 0; r < 4; ++r) { b[r] = a[r] * Bc[r] + b[r]; a[r] = a[r] * Ac[r]; }
            { const size_t o = ((size_t)d * M_ALL + row0 + tok) * LRU_W + chb;
              *(u32x2*)(A.B.HLOC + o) = (u32x2){pk2(b[0], b[1]), pk2(b[2], b[3])}; *(u32x2*)(A.B.ACUM + o) = (u32x2){pk2(a[0], a[1]), pk2(a[2], a[3])}; }
#pragma unroll
            for (int r = 0; r < 4; ++r) { const int sl = (lane & ~15) | (d == 0 ? 15 : 0); Ac[r] = lane_get(a[r], sl); Bc[r] = lane_get(b[r], sl); }
        }
        if (tl == 0) { float* ls = A.B.LSUM + (((size_t)cix * 2 + d) * 2) * LRU_W + chb;
            *(f32x4*)ls = (f32x4){Ac[0], Ac[1], Ac[2], Ac[3]}; *(f32x4*)(ls + LRU_W) = (f32x4){Bc[0], Bc[1], Bc[2], Bc[3]}; }
    }
}
__device__ __forceinline__ void local_phase(const LocalArgs& A, char* lds, int G, int wg, const int tid) {
    for (int j = wg; j < 2 * NCHUNK * NH; j += G) if (j >= NCHUNK * NH) { const int t = j - NCHUNK * NH; local_task(A, lds, t / NH, t % NH, tid); }
}
__device__ __forceinline__ void carry_phase(const Bufs& B, int gtid, int gthreads) {
    constexpr int NC = CTX_LEN / CH, NL = SEQ / CH;
    for (int i = gtid; i < BATCH * 2 * LRU_W; i += gthreads) { const int ch = i % LRU_W, d = (i / LRU_W) & 1, b = i / (2 * LRU_W);
        float h = 0.f;
        for (int s0 = 0; s0 < NC + NL; s0 += 12) {
            float av[12], bv[12]; int cx[12];
#pragma unroll
            for (int u = 0; u < 12; ++u) { const int step = s0 + u; int cix = 0;
                if (step < NC) { const int n = d ? NC - 1 - step : step; cix = M_LAT / CH + b * NC + n; }
                else if (step < NC + NL) { const int s2 = step - NC, n = d ? NL - 1 - s2 : s2; cix = b * NL + n; }
                cx[u] = cix; const float* ls = B.LSUM + (((size_t)cix * 2 + d) * 2) * LRU_W + ch; av[u] = ls[0]; bv[u] = ls[LRU_W]; }
#pragma unroll
            for (int u = 0; u < 12; ++u) if (s0 + u < NC + NL) { B.HIN[((size_t)cx[u] * 2 + d) * LRU_W + ch] = h; h = av[u] * h + bv[u]; }
        }
    }
}
__device__ __forceinline__ void finish_phase(const Bufs& B, const bf16_t* P, bf16_t* Y, int gtid, int gthreads) {
    for (int it = gtid; it < M_ALL * (LRU_W / 8); it += gthreads) { const int row = it / (LRU_W / 8), c0 = (it % (LRU_W / 8)) * 8, cix = row / CH;
        const u32x4 h0 = *(const u32x4*)(B.HLOC + (size_t)row * LRU_W + c0), a0 = *(const u32x4*)(B.ACUM + (size_t)row * LRU_W + c0);
        const u32x4 h1 = *(const u32x4*)(B.HLOC + ((size_t)M_ALL + row) * LRU_W + c0), a1 = *(const u32x4*)(B.ACUM + ((size_t)M_ALL + row) * LRU_W + c0);
        const u32x4 gt = *(const u32x4*)(P + (size_t)row * NP + C_LRU_G + c0);
        const float* i0 = B.HIN + ((size_t)cix * 2 + 0) * LRU_W + c0; const float* i1 = B.HIN + ((size_t)cix * 2 + 1) * LRU_W + c0;
        const f32x4 i0a = *(const f32x4*)i0, i0b = *(const f32x4*)(i0 + 4), i1a = *(const f32x4*)i1, i1b = *(const f32x4*)(i1 + 4);
        float y[8];
#pragma unroll
        for (int j = 0; j < 4; ++j) { const unsigned hw0 = h0[j], aw0 = a0[j], hw1 = h1[j], aw1 = a1[j], gw = gt[j];
            const float in0l = j < 2 ? i0a[2 * j] : i0b[2 * j - 4], in0h = j < 2 ? i0a[2 * j + 1] : i0b[2 * j - 3], in1l = j < 2 ? i1a[2 * j] : i1b[2 * j - 4], in1h = j < 2 ? i1a[2 * j + 1] : i1b[2 * j - 3];
            y[2 * j] = (bflo(hw0) + bflo(aw0) * in0l + bflo(hw1) + bflo(aw1) * in1l) * geluf_(bflo(gw));
            y[2 * j + 1] = (bfhi(hw0) + bfhi(aw0) * in0h + bfhi(hw1) + bfhi(aw1) * in1h) * geluf_(bfhi(gw)); }
        *(u32x4*)(Y + (size_t)row * D_MODEL + c0) = (u32x4){pk2(y[0], y[1]), pk2(y[2], y[3]), pk2(y[4], y[5]), pk2(y[6], y[7])};
    }
}
}

namespace misc {
typedef float f32x4 __attribute__((ext_vector_type(4)));
typedef unsigned u32x2 __attribute__((ext_vector_type(2)));
typedef unsigned u32x4 __attribute__((ext_vector_type(4)));
__device__ __forceinline__ unsigned pk2(float lo, float hi) { return (unsigned)f2bf(lo) | ((unsigned)f2bf(hi) << 16); }
__device__ __forceinline__ float wave_sum(float v, int lane) {
#pragma unroll
    for (int o = 1; o < 64; o <<= 1) v += lane_xor(v, o, lane);
    return v;
}
__device__ __forceinline__ float sum16(float v, int lane) {
#pragma unroll
    for (int o = 1; o < 16; o <<= 1) v += lane_xor(v, o, lane);
    return v;
}
__device__ __forceinline__ void norm_phase(float* H, const float* g, const float* MODl, int sh_idx, bf16_t* U, int nrows, int gwave, int nwaves, int lane,
                                           const float* PART, int nparts, const float* pgate) {
    static_assert(D_MODEL == 2048, "norm_phase geometry");
    for (int r = gwave; r < nrows; r += nwaves) {
        const int set = r < M_LAT ? r / SEQ : BATCH;
        f32x4* hr = (f32x4*)(H + (size_t)r * D_MODEL) + lane;
        f32x4 v[8]; float ss = 0.f;
#pragma unroll
        for (int j = 0; j < 8; ++j) v[j] = hr[64 * j];
        if (PART != nullptr && r >= M_LAT) {
            const f32x4* gp = (const f32x4*)pgate + lane;
#pragma unroll
            for (int j = 0; j < 8; ++j) { f32x4 acc = {0.f, 0.f, 0.f, 0.f};
                for (int s = 0; s < nparts; ++s) acc += *((const f32x4*)(PART + ((size_t)s * M_CTX + (r - M_LAT)) * D_MODEL) + lane + 64 * j);
                v[j] += gp[64 * j] * acc; hr[64 * j] = v[j]; }
        }
#pragma unroll
        for (int j = 0; j < 8; ++j) ss += (v[j][0] * v[j][0] + v[j][1] * v[j][1]) + (v[j][2] * v[j][2] + v[j][3] * v[j][3]);
        const float rstd = 1.0f / sqrtf(wave_sum(ss, lane) * (1.0f / D_MODEL) + EPS);
        const f32x4* gp = (const f32x4*)g + lane; const f32x4* shp = (const f32x4*)(MODl + (size_t)set * NMODV + (size_t)sh_idx * D_MODEL) + lane; const f32x4* scp = shp + D_MODEL / 4;
        u32x2* o = (u32x2*)(U + (size_t)r * D_MODEL) + lane;
#pragma unroll
        for (int j = 0; j < 8; ++j) { const f32x4 gg = gp[64 * j], sh = shp[64 * j], sc = scp[64 * j]; f32x4 y;
#pragma unroll
            for (int e = 0; e < 4; ++e) y[e] = v[j][e] * rstd * gg[e] * (1.0f + sc[e]) + sh[e];
            o[64 * j] = (u32x2){pk2(y[0], y[1]), pk2(y[2], y[3])}; }
    }
}
struct RowNormArgs { const bf16_t* P; const float *qa_g, *kva_g, *na_qn_g, *na_kn_g; bf16_t *CQN, *CKVN, *NQ, *NK; };
__device__ __forceinline__ void rownorm_phase(const RowNormArgs& A, int gwave, int nwaves, int lane) {
    static_assert(MLA_Q_LORA == 384 && MLA_KV_LORA == 256 && GROUP_W == 512 && HD == 128, "rownorm geometry");
    for (int r = gwave; r < M_ALL; r += nwaves) { const bf16_t* p = A.P + (size_t)r * NP;
        { float x[6], ss = 0.f;
#pragma unroll
          for (int j = 0; j < 3; ++j) { const unsigned w = *(const unsigned*)(p + C_CQ + 2 * lane + 128 * j); x[2 * j] = bflo(w); x[2 * j + 1] = bfhi(w); ss += x[2 * j] * x[2 * j] + x[2 * j + 1] * x[2 * j + 1]; }
          const float rstd = 1.0f / sqrtf(wave_sum(ss, lane) * (1.0f / MLA_Q_LORA) + EPS);
#pragma unroll
          for (int j = 0; j < 3; ++j) { const int c = 2 * lane + 128 * j; *(unsigned*)(A.CQN + (size_t)r * MLA_Q_LORA + c) = pk2(x[2 * j] * rstd * A.qa_g[c], x[2 * j + 1] * rstd * A.qa_g[c + 1]); } }
        { float x[4], ss = 0.f;
#pragma unroll
          for (int j = 0; j < 2; ++j) { const unsigned w = *(const unsigned*)(p + C_CKV + 2 * lane + 128 * j); x[2 * j] = bflo(w); x[2 * j + 1] = bfhi(w); ss += x[2 * j] * x[2 * j] + x[2 * j + 1] * x[2 * j + 1]; }
          const float rstd = 1.0f / sqrtf(wave_sum(ss, lane) * (1.0f / MLA_KV_LORA) + EPS);
#pragma unroll
          for (int j = 0; j < 2; ++j) { const int c = 2 * lane + 128 * j; *(unsigned*)(A.CKVN + (size_t)r * MLA_KV_LORA + c) = pk2(x[2 * j] * rstd * A.kva_g[c], x[2 * j + 1] * rstd * A.kva_g[c + 1]); } }
#pragma unroll
        for (int which = 0; which < 2; ++which) {
            const int hh = lane >> 4, d0 = (lane & 15) * 8; const u32x4 w = *(const u32x4*)(p + (which == 0 ? C_NQ : C_NK) + hh * HD + d0);
            float x[8]; float ss = 0.f;
#pragma unroll
            for (int j = 0; j < 4; ++j) { x[2 * j] = bflo(w[j]); x[2 * j + 1] = bfhi(w[j]); ss += x[2 * j] * x[2 * j] + x[2 * j + 1] * x[2 * j + 1]; }
            const float rstd = 1.0f / sqrtf(sum16(ss, lane) * (1.0f / HD) + EPS); const float* g = (which == 0 ? A.na_qn_g : A.na_kn_g) + d0;
            *(u32x4*)((which == 0 ? A.NQ : A.NK) + (size_t)r * GROUP_W + hh * HD + d0) =
                (u32x4){pk2(x[0] * rstd * g[0], x[1] * rstd * g[1]), pk2(x[2] * rstd * g[2], x[3] * rstd * g[3]), pk2(x[4] * rstd * g[4], x[5] * rstd * g[5]), pk2(x[6] * rstd * g[6], x[7] * rstd * g[7])};
        }
    }
}
struct MlaQkvArgs { const bf16_t* QR; const bf16_t* KVR; const bf16_t* P; const float *qn_g, *kn_g; bf16_t *QM, *KM, *VM; };
__device__ __forceinline__ void mlaqkv_phase(const MlaQkvArgs& A, int gwave, int nwaves, int lane) {
    static_assert(MLA_QK == 192 && MLA_NOPE == 128 && MLA_ROPE == 64 && NH == 4, "mla qkv geometry");
    const int hh = lane >> 4, g = lane & 15;
    const float inv = powf(10000.0f, -(float)g / 16.0f);
    for (int r = gwave; r < M_ALL; r += nwaves) {
        const bool lat = r < M_LAT; const int t = lat ? r % SEQ : 0;
        float cr = 1.f, sr = 0.f, cc = 1.f, sc = 0.f;
        if (lat) { sincosf((float)(t / GRID_W) * inv, &sr, &cr); sincosf((float)(t % GRID_W) * inv, &sc, &cc); }
#pragma unroll
        for (int which = 0; which < 2; ++which) {
            float x[12]; float ss = 0.f;
            if (which == 0) { const bf16_t* src = A.QR + (size_t)r * NQ_MLA + hh * MLA_QK + g;
#pragma unroll
                for (int i = 0; i < 12; ++i) x[i] = bf2f(src[16 * i]); }
            else { const bf16_t* src = A.KVR + (size_t)r * NKV_MLA + hh * (MLA_NOPE + MLA_V) + g; const bf16_t* kr = A.P + (size_t)r * NP + C_KR + g;
#pragma unroll
                for (int i = 0; i < 8; ++i) x[i] = bf2f(src[16 * i]);
#pragma unroll
                for (int i = 0; i < 4; ++i) x[8 + i] = bf2f(kr[16 * i]); }
#pragma unroll
            for (int i = 0; i < 12; ++i) ss += x[i] * x[i];
            const float rstd = 1.0f / sqrtf(sum16(ss, lane) * (1.0f / MLA_QK) + EPS); const float* gn = (which == 0 ? A.qn_g : A.kn_g) + g;
#pragma unroll
            for (int i = 0; i < 12; ++i) x[i] = x[i] * rstd * gn[16 * i];
            { const float a0 = x[8], b0 = x[10]; x[8] = a0 * cr - b0 * sr; x[10] = a0 * sr + b0 * cr;
              const float a1 = x[9], b1 = x[11]; x[9] = a1 * cc - b1 * sc; x[11] = a1 * sc + b1 * cc; }
            bf16_t* O = (which == 0 ? A.QM : A.KM) + (size_t)r * NQ_MLA + hh * MLA_QK + g;
#pragma unroll
            for (int i = 0; i < 12; ++i) O[16 * i] = f2bf(x[i]);
        }
        { const bf16_t* vs = A.KVR + (size_t)r * NKV_MLA + hh * (MLA_NOPE + MLA_V) + MLA_NOPE + g; bf16_t* O = A.VM + (size_t)r * (NH * MLA_V) + hh * MLA_V + g;
#pragma unroll
          for (int i = 0; i < 8; ++i) O[16 * i] = vs[16 * i]; }
    }
}
constexpr int ACT_RUN = 32;
__device__ __forceinline__ void act_phase(const bf16_t* UP, const float* cw, const float* cb, bf16_t* ACT, int nrows, int gtid, int gthreads) {
    constexpr int NC8 = D_FF / 8; static_assert(SEQ % ACT_RUN == 0 && CTX_LEN % ACT_RUN == 0, "row runs stay inside one sequence");
    const int nruns = nrows / ACT_RUN;
    for (long it = gtid; it < (long)nruns * NC8; it += gthreads) { const int run = (int)(it / NC8), j0 = (int)(it % NC8) * 8, r0 = run * ACT_RUN; const RowInfo ri = row_info(r0);
        float wa[3][8], wg[3][8], ba[8], bg[8];
#pragma unroll
        for (int k = 0; k < 3; ++k) { const float* p = cw + (size_t)k * 2 * D_FF + j0; const f32x4 a0 = *(const f32x4*)p, a1 = *(const f32x4*)(p + 4), g0 = *(const f32x4*)(p + D_FF), g1 = *(const f32x4*)(p + D_FF + 4);
#pragma unroll
            for (int e = 0; e < 4; ++e) { wa[k][e] = a0[e]; wa[k][4 + e] = a1[e]; wg[k][e] = g0[e]; wg[k][4 + e] = g1[e]; } }
        { const f32x4 a0 = *(const f32x4*)(cb + j0), a1 = *(const f32x4*)(cb + j0 + 4), g0 = *(const f32x4*)(cb + D_FF + j0), g1 = *(const f32x4*)(cb + D_FF + j0 + 4);
#pragma unroll
          for (int e = 0; e < 4; ++e) { ba[e] = a0[e]; ba[4 + e] = a1[e]; bg[e] = g0[e]; bg[4 + e] = g1[e]; } }
        const u32x4 zero = {0u, 0u, 0u, 0u};
        const bf16_t* ub = UP + (size_t)ri.base * (2 * D_FF) + j0;
        u32x4 am, ac, gm, gc;
        { const int t = ri.t; am = t > 0 ? *(const u32x4*)(ub + (size_t)(t - 1) * (2 * D_FF)) : zero; gm = t > 0 ? *(const u32x4*)(ub + (size_t)(t - 1) * (2 * D_FF) + D_FF) : zero;
          ac = *(const u32x4*)(ub + (size_t)t * (2 * D_FF)); gc = *(const u32x4*)(ub + (size_t)t * (2 * D_FF) + D_FF); }
#pragma unroll 4
        for (int i = 0; i < ACT_RUN; ++i) { const int t = ri.t + i;
            const u32x4 ap = t + 1 < ri.T ? *(const u32x4*)(ub + (size_t)(t + 1) * (2 * D_FF)) : zero, gp = t + 1 < ri.T ? *(const u32x4*)(ub + (size_t)(t + 1) * (2 * D_FF) + D_FF) : zero;
            float y[8];
#pragma unroll
            for (int e = 0; e < 4; ++e) {
                const float a0 = ba[2 * e] + wa[0][2 * e] * bflo(am[e]) + wa[1][2 * e] * bflo(ac[e]) + wa[2][2 * e] * bflo(ap[e]);
                const float a1 = ba[2 * e + 1] + wa[0][2 * e + 1] * bfhi(am[e]) + wa[1][2 * e + 1] * bfhi(ac[e]) + wa[2][2 * e + 1] * bfhi(ap[e]);
                const float g0 = bg[2 * e] + wg[0][2 * e] * bflo(gm[e]) + wg[1][2 * e] * bflo(gc[e]) + wg[2][2 * e] * bflo(gp[e]);
                const float g1 = bg[2 * e + 1] + wg[0][2 * e + 1] * bfhi(gm[e]) + wg[1][2 * e + 1] * bfhi(gc[e]) + wg[2][2 * e + 1] * bfhi(gp[e]);
                y[2 * e] = a0 * (g0 / (1.0f + __expf(-g0))); y[2 * e + 1] = a1 * (g1 / (1.0f + __expf(-g1))); }
            *(u32x4*)(ACT + (size_t)(r0 + i) * D_FF + j0) = (u32x4){pk2(y[0], y[1]), pk2(y[2], y[3]), pk2(y[4], y[5]), pk2(y[6], y[7])};
            am = ac; ac = ap; gm = gc; gc = gp; }
    }
}
__device__ __forceinline__ void transpose_item(const float* W, int K, int N, int Npad, bf16_t* WT, float* scr, int item, int lane) {
    const int nblk = Npad / 32, kb = item / nblk, nb = item % nblk, k0 = 64 * kb, n0 = 32 * nb; const int n = n0 + (lane & 31); const bool ok = n < N;
#pragma unroll 8
    for (int i = 0; i < 32; ++i) { const int kk = 2 * i + (lane >> 5); scr[kk * 33 + (lane & 31)] = ok ? W[(size_t)(k0 + kk) * N + n] : 0.f; }
    asm volatile("s_waitcnt lgkmcnt(0)" ::: "memory");
    const int c = lane & 7;
#pragma unroll
    for (int j = 0; j < 4; ++j) { const int nn = (lane >> 3) + 8 * j; const float* s = scr + (8 * c) * 33 + nn;
        u32x4 o; o.x = pk2(s[0 * 33], s[1 * 33]); o.y = pk2(s[2 * 33], s[3 * 33]); o.z = pk2(s[4 * 33], s[5 * 33]); o.w = pk2(s[6 * 33], s[7 * 33]);
        *(u32x4*)(WT + (size_t)(n0 + nn) * K + k0 + 8 * c) = o; }
    asm volatile("s_waitcnt lgkmcnt(0)" ::: "memory");
}
}

__device__ __forceinline__ gdn::Bufs gdn_bufs(const WS& w, int l) { gdn::Bufs B; B.UT = w.gUT; B.WP = w.gWP; B.KDT = w.gKDT; B.QD = w.gQD; B.QK = w.gQK; B.SIT = w.gSIT; B.VNT = w.gVNT; B.GT = w.gGT + (size_t)l * gdn::NTASK; return B; }
__device__ __forceinline__ lru::Bufs lru_bufs(const WS& w) { lru::Bufs B; B.HLOC = w.lHLOC; B.ACUM = w.lACUM; B.LSUM = w.lLSUM; B.HIN = w.lHIN; return B; }

#define LAS __attribute__((address_space(3)))
#define XB_TMO      128
#define XB_XCNT(j)  (256  + 64 * (j))
#define XB_XSUB(j)  (1280 + 64 * (j))
#define XB_XGEN(j)  (2304 + 64 * (j))
#define XB_TOP      3328
#define XB_TOPGEN   3392
#define XCD_BAR_WORDS 3456
#define XB_SPIN_CAP (1u << 18)
__device__ __forceinline__ unsigned xb_ld(unsigned* p)              { return __hip_atomic_load(p, __ATOMIC_RELAXED, __HIP_MEMORY_SCOPE_AGENT); }
__device__ __forceinline__ unsigned xb_add(unsigned* p, unsigned v) { return __hip_atomic_fetch_add(p, v, __ATOMIC_RELAXED, __HIP_MEMORY_SCOPE_AGENT); }
__device__ __forceinline__ unsigned xb_xcc_id() { return (unsigned)__builtin_amdgcn_s_getreg((3 << 11) | 20) & 0xFu; }
#define XB_SPIN(cond, bar) do { unsigned _sp = 0; while (cond) { __builtin_amdgcn_s_sleep(1); \
    if ((++_sp & 255u) == 0u) { if (xb_ld(&(bar)[XB_TMO])) break; if (_sp > XB_SPIN_CAP) { atomicAdd(&(bar)[XB_TMO], 1u); break; } } } } while (0)
struct XcdBarrier { unsigned* bar; unsigned x; volatile LAS unsigned* st; };
__device__ __forceinline__ XcdBarrier xcd_barrier_post(unsigned* bar, volatile LAS unsigned* st, const bool leader) {
    XcdBarrier b; b.bar = bar; b.x = xb_xcc_id(); b.st = st;
    if (leader) (void)xb_add(&bar[XB_XCNT(b.x)], 1u);
    return b;
}
__device__ __forceinline__ void xcd_barrier_complete(unsigned* bar, unsigned x, unsigned& nloc, unsigned& nx) {
    const unsigned G = gridDim.x * gridDim.y * gridDim.z;
    unsigned sum, cnt, mine, sp = 0u;
    for (;;) {
        sum = 0u; cnt = 0u; mine = 0u;
#pragma unroll
        for (unsigned j = 0; j < 16; ++j) { const unsigned c = xb_ld(&bar[XB_XCNT(j)]); sum += c; cnt += (c > 0u) ? 1u : 0u; mine = (j == x) ? c : mine; }
        if (sum == G) break;
        __builtin_amdgcn_s_sleep(1);
        if ((++sp & 255u) == 0u) { if (xb_ld(&bar[XB_TMO])) break; if (sp > XB_SPIN_CAP) { atomicAdd(&bar[XB_TMO], 1u); break; } }
    }
    nloc = mine > 0u ? mine : 1u; nx = cnt > 0u ? cnt : 1u;
}
__device__ __forceinline__ void xcd_barrier(const XcdBarrier& b, const bool leader) {
    asm volatile("s_waitcnt vmcnt(0)" ::: "memory");
    __syncthreads();
    if (leader) {
        unsigned* bar = b.bar;
        __builtin_amdgcn_s_waitcnt(0);
        unsigned nloc = b.st[0], nx = b.st[1];
        if (nloc == 0u) { xcd_barrier_complete(bar, b.x, nloc, nx); b.st[0] = nloc; b.st[1] = nx; }
        const unsigned old = xb_add(&bar[XB_XSUB(b.x)], 1u);
        const unsigned gen = old / nloc;
        if (old + 1u == (gen + 1u) * nloc) {
            __builtin_amdgcn_fence(__ATOMIC_RELEASE, "agent");
            asm volatile("s_waitcnt vmcnt(0)" ::: "memory");
            const unsigned og = xb_add(&bar[XB_TOP], 1u);
            const unsigned tg = og / nx;
            if (og + 1u == (tg + 1u) * nx) xb_add(&bar[XB_TOPGEN], 1u);
            else XB_SPIN(xb_ld(&bar[XB_TOPGEN]) == tg, bar);
            __builtin_amdgcn_fence(__ATOMIC_ACQUIRE, "agent");
            xb_add(&bar[XB_XGEN(b.x)], 1u);
            asm volatile("s_waitcnt vmcnt(0)" ::: "memory");
        } else {
            XB_SPIN(xb_ld(&bar[XB_XGEN(b.x)]) == gen, bar);
            __builtin_amdgcn_fence(__ATOMIC_ACQUIRE, "agent");
            asm volatile("s_waitcnt vmcnt(0)" ::: "memory");
        }
    }
    __syncthreads();
}

constexpr int NWAVES = 8, NTHR = 512;
constexpr int LDS_MISC = 147456, LDS_BYTES = 148480;
static_assert(sizeof(Inputs) == 34 * 8, "Inputs mirrors Params::in");
static_assert(gdn::G1_LDS <= LDS_MISC && pg8::STAGE_BYTES <= LDS_MISC && att::Cfg<MLA_QK>::LDS_BYTES <= LDS_MISC && gdn::G2_LDS <= LDS_MISC, "LDS map");
constexpr int CW_BAR = 4096;
constexpr int G2_CUT1 = 52, G2_CUT2 = 52;
constexpr int SK_OUT = 4, SK_DOWN = 5;
constexpr int PH_PRO = 0, PH_PER_LAYER = 12, NPH = 1 + PH_PER_LAYER * DEPTH;
struct Params { const float* in[34]; float* out; unsigned char* ws; int ph_lo, ph_hi, li, pad; };

struct SplitOrder {
    int nN, nM, S, G, c;
    __device__ __forceinline__ void init(int M, int N, int S_, int G_, int c_) { nM = M / pg8::BM; nN = N / pg8::BM; S = S_; G = G_; c = c_; }
    __device__ __forceinline__ bool next(int i, pg8::Unit& u) const { const int g = c + i * G; if (g >= nM * nN * S) return false; u.ks = g / (nM * nN); const int loc = g % (nM * nN); u.pm = loc / nN; u.pn = loc % nN; return true; }
    __device__ __forceinline__ void a_ready(const pg8::Unit&) const {}
    __device__ __forceinline__ void done(const pg8::Unit&) const {}
};
struct SpanOrder {
    int nN, lo, hi, G, g0;
    __device__ __forceinline__ void init(int N, int lo_, int hi_, int G_, int c) { nN = N / pg8::BM; lo = lo_; hi = hi_; G = G_; int i0 = 0; if (c < lo_) i0 = (lo_ - c + G_ - 1) / G_; g0 = c + i0 * G_; }
    __device__ __forceinline__ bool next(int i, pg8::Unit& u) const { const int g = g0 + i * G; if (g >= hi) return false; const int loc = g - lo; u.pm = loc / nN; u.pn = loc % nN; u.ks = 0; return true; }
    __device__ __forceinline__ void a_ready(const pg8::Unit&) const {}
    __device__ __forceinline__ void done(const pg8::Unit&) const {}
};

#define AS4 __attribute__((address_space(4)))
#define PHASE_WS const AS4 Params* pp = (const AS4 Params*)__builtin_amdgcn_kernarg_segment_ptr(); asm volatile("" : "+s"(pp)); const AS4 Inputs* I = (const AS4 Inputs*)pp; (void)I; unsigned char* wsb_ = pp->ws; const WS w = ws_carve(wsb_)
#define PHASE_IDS int tid = C_wave0 * 64 + (int)__builtin_amdgcn_mbcnt_hi(~0u, __builtin_amdgcn_mbcnt_lo(~0u, 0u)); asm volatile("" : "+v"(tid)); const int lane = tid & 63, wave = __builtin_amdgcn_readfirstlane(tid >> 6), gwave = wg * NWAVES + wave, gtid = wg * NTHR + tid; (void)lane; (void)gwave; (void)gtid
#ifndef DBG_MASK
#define DBG_MASK 0xFFFFFF
#endif
#define IN(k) (lo <= (k) && (k) < hi)
#define ON(j) (((DBG_MASK) >> (j)) & 1)
#define SEAM(k) do { if (IN(k) && IN((k) + 1)) xcd_barrier(bar, C_wave0 == 0 && __builtin_amdgcn_mbcnt_hi(~0u, __builtin_amdgcn_mbcnt_lo(~0u, 0u)) == 0u); } while (0)

struct LayerCtx { int lo, hi, G, wg, nwaves, gthreads, wave0; XcdBarrier bar; char* lds; unsigned char* lds_raw; };
template <int l> __device__ __forceinline__ void layer_body(const LayerCtx& C) {
    const int lo = C.lo, hi = C.hi, G = C.G, wg = C.wg, nwaves = C.nwaves, gthreads = C.gthreads, C_wave0 = C.wave0; const XcdBarrier& bar = C.bar; char* lds = C.lds; unsigned char* lds_raw = C.lds_raw;
    (void)G; (void)nwaves; (void)gthreads;
        const int pb = 1 + PH_PER_LAYER * l;
        const bool want_ctx = l < DEPTH - 1; const int Mo = want_ctx ? M_ALL : M_LAT;
        if (ON(0) && IN(pb + 0)) { PHASE_WS; PHASE_IDS; const float* MODl = w.MOD + (size_t)l * (BATCH + 1) * NMODV; (void)MODl; misc::norm_phase(w.H, I->norm_mix_g + (size_t)l * D_MODEL, MODl, 0, w.U, M_ALL, gwave, nwaves, lane, l > 0 ? w.PART : nullptr, SK_DOWN, MODl - (size_t)(BATCH + 1) * NMODV + (size_t)BATCH * NMODV + 5 * D_MODEL); }
        SEAM(pb + 0);
        if (ON(1) && IN(pb + 1)) { PHASE_WS; PHASE_IDS; const float* MODl = w.MOD + (size_t)l * (BATCH + 1) * NMODV; (void)MODl; pg8::Gemm g{w.U, w.WIN + l * SZ_WIN, M_ALL, NP, D_MODEL, D_MODEL}; pg8::StaticOrder S; S.init(M_ALL, NP, G, wg);
            pg8::EpiBf16<0> E{w.P, NP, nullptr, 0, 0, 1.0f};
            pg8::gemm_phase<pg8::EpiBf16<0>, pg8::StaticOrder, true, true>((PG8_LAS unsigned char*)lds_raw, g, S, E, tid); }
        SEAM(pb + 1);
        if (ON(2) && IN(pb + 2)) { PHASE_WS; PHASE_IDS; const float* MODl = w.MOD + (size_t)l * (BATCH + 1) * NMODV; (void)MODl;
            const int pflags = pp->pad;
            if (!(pflags & 16)) { gdn::G1Args A; A.P = w.P; A.conv_w = I->gdn_conv_w + (size_t)l * 4 * 3 * GROUP_W; A.a_log = I->gdn_a_log + (size_t)l * 2 * NH; A.dt_bias = I->gdn_dt_bias + (size_t)l * 2 * NH; A.B = gdn_bufs(w, l); A.pflags = pflags;
              gdn::g1_phase(A, lds, G, wg, tid); }
            if (!(pflags & 32)) { lru::LocalArgs A; A.P = w.P; A.conv_w = I->lru_conv_w + (size_t)l * 4 * LRU_W; A.conv_b = I->lru_conv_b + (size_t)l * LRU_W; A.WG = w.WLRU + (size_t)l * 16 * lru::SZ_WBLK;
              A.ba = I->lru_ba + (size_t)l * 2 * LRU_W; A.bx = I->lru_bx + (size_t)l * 2 * LRU_W; A.lam = I->lru_lam + (size_t)l * 2 * LRU_W; A.B = lru_bufs(w);
              lru::local_phase(A, lds, G, wg, tid); }
            if (!(pflags & 64)) { misc::RowNormArgs A; A.P = w.P; A.qa_g = I->mla_qa_g + (size_t)l * MLA_Q_LORA; A.kva_g = I->mla_kva_g + (size_t)l * MLA_KV_LORA; A.na_qn_g = I->na_qn_g + (size_t)l * HD; A.na_kn_g = I->na_kn_g + (size_t)l * HD;
              A.CQN = w.CQN; A.CKVN = w.CKVN; A.NQ = w.NQ; A.NK = w.NK; misc::rownorm_phase(A, gwave, nwaves, lane); }
        }
        SEAM(pb + 2);
        if (ON(3) && IN(pb + 3)) { PHASE_WS; PHASE_IDS; const float* MODl = w.MOD + (size_t)l * (BATCH + 1) * NMODV; (void)MODl;
            if (wg < gdn::G2_WGS) gdn::g2_chain(gdn_bufs(w, l), lds, wg, tid, 0, G2_CUT1, w.gSS);
            else {
            constexpr int UQ = (M_ALL / 256) * (NQ_MLA / 256), UKV = (M_ALL / 256) * (NKV_MLA / 256); const int G2n = G - gdn::G2_WGS, c2 = wg - gdn::G2_WGS;
            { pg8::Gemm g{w.CQN, w.WUQ + l * SZ_WUQ, M_ALL, NQ_MLA, MLA_Q_LORA, MLA_Q_LORA}; SpanOrder S; S.init(NQ_MLA, 0, UQ, G2n, c2); pg8::EpiBf16<0> E{w.QR, NQ_MLA, nullptr, 0, 0, 1.0f};
              pg8::gemm_phase<pg8::EpiBf16<0>, SpanOrder, true, true>((PG8_LAS unsigned char*)lds_raw, g, S, E, tid); }
            { pg8::Gemm g{w.CKVN, w.WUKV + l * SZ_WUKV, M_ALL, NKV_MLA, MLA_KV_LORA, MLA_KV_LORA}; SpanOrder S; S.init(NKV_MLA, UQ, UQ + UKV, G2n, c2); pg8::EpiBf16<0> E{w.KVR, NKV_MLA, nullptr, 0, 0, 1.0f};
              pg8::gemm_phase<pg8::EpiBf16<0>, SpanOrder, true, true>((PG8_LAS unsigned char*)lds_raw, g, S, E, tid); }
            }
        }
        SEAM(pb + 3);
        if (ON(4) && IN(pb + 4)) { PHASE_WS; PHASE_IDS; const float* MODl = w.MOD + (size_t)l * (BATCH + 1) * NMODV; (void)MODl;
            { misc::MlaQkvArgs A; A.QR = w.QR; A.KVR = w.KVR; A.P = w.P; A.qn_g = I->mla_qn_g + (size_t)l * MLA_QK; A.kn_g = I->mla_kn_g + (size_t)l * MLA_QK; A.QM = w.QM; A.KM = w.KM; A.VM = w.VM;
              misc::mlaqkv_phase(A, gwave, nwaves, lane); }
            lru::carry_phase(lru_bufs(w), gtid, gthreads);
        }
        SEAM(pb + 4);
        if (ON(5) && IN(pb + 5)) { PHASE_WS; PHASE_IDS; const float* MODl = w.MOD + (size_t)l * (BATCH + 1) * NMODV; (void)MODl;
            const int pflags = pp->pad;
            if (wg < gdn::G2_WGS && !(pflags & 1)) gdn::g2_chain(gdn_bufs(w, l), lds, wg, tid, G2_CUT2, gdn::G2_NSTEP, w.gSS);
            AttnArgs A; A.QM = w.QM; A.KM = w.KM; A.VM = w.VM; A.NQ = w.NQ; A.NK = w.NK; A.P = w.P; A.Y = w.Y; A.rpb = I->na_rpb + (size_t)l * NH * (2 * NA_KH - 1) * (2 * NA_KW - 1); A.want_ctx = want_ctx ? 1 : 0; A.pad = pflags;
            attention_phase(A, lds, G, wg, tid, gdn::G2_WGS);
        }
        SEAM(pb + 5);
        if (ON(6) && IN(pb + 6)) { PHASE_WS; PHASE_IDS; const float* MODl = w.MOD + (size_t)l * (BATCH + 1) * NMODV; (void)MODl;
            const int pflags = pp->pad;
            if (!(pflags & 128)) { gdn::G3Args A; A.B = gdn_bufs(w, l); A.P = w.P; A.norm_g = I->gdn_norm_g + (size_t)l * HD; A.Y = w.Y; gdn::g3_phase(A, lds, G, wg, tid); }
            if (!(pflags & 256)) lru::finish_phase(lru_bufs(w), w.P, w.Y, gtid, gthreads);
        }
        SEAM(pb + 6);
        if (ON(7) && IN(pb + 7)) { PHASE_WS; PHASE_IDS; const float* MODl = w.MOD + (size_t)l * (BATCH + 1) * NMODV; (void)MODl;
            { pg8::Gemm g{w.Y, w.WOUT + l * SZ_WOUT, M_LAT, D_MODEL, D_MODEL, D_MODEL}; pg8::StaticOrder S; S.init(M_LAT, D_MODEL, G, wg);
              pg8::EpiGateRes E{w.H, w.H, D_MODEL, MODl + 2 * D_MODEL, NMODV, SEQ, BATCH, M_LAT};
              pg8::gemm_phase<pg8::EpiGateRes, pg8::StaticOrder, true, true>((PG8_LAS unsigned char*)lds_raw, g, S, E, tid); }
            if (want_ctx) { constexpr int SK = SK_OUT;
              pg8::Gemm g{w.Y + (size_t)M_LAT * D_MODEL, w.WOUT + l * SZ_WOUT, M_CTX, D_MODEL, D_MODEL / SK, D_MODEL}; SplitOrder S; S.init(M_CTX, D_MODEL, SK, G, (wg + G / 2) % G);
              pg8::EpiPart E{w.PART, D_MODEL, (size_t)M_CTX * D_MODEL};
              pg8::gemm_phase<pg8::EpiPart, SplitOrder, true, true>((PG8_LAS unsigned char*)lds_raw, g, S, E, tid); } }
        SEAM(pb + 7);
        if (ON(8) && IN(pb + 8)) { PHASE_WS; PHASE_IDS; const float* MODl = w.MOD + (size_t)l * (BATCH + 1) * NMODV; (void)MODl; misc::norm_phase(w.H, I->norm_ffn_g + (size_t)l * D_MODEL, MODl, 3, w.U, Mo, gwave, nwaves, lane, want_ctx ? w.PART : nullptr, SK_OUT, MODl + (size_t)BATCH * NMODV + 2 * D_MODEL); }
        SEAM(pb + 8);
        if (ON(9) && IN(pb + 9)) { PHASE_WS; PHASE_IDS; const float* MODl = w.MOD + (size_t)l * (BATCH + 1) * NMODV; (void)MODl; pg8::Gemm g{w.U, w.WUP + l * SZ_WUP, Mo, 2 * D_FF, D_MODEL, D_MODEL}; pg8::StaticOrder S; S.init(Mo, 2 * D_FF, G, wg);
            pg8::EpiBf16<0> E{w.UP, 2 * D_FF, nullptr, 0, 0, 1.0f};
            pg8::gemm_phase<pg8::EpiBf16<0>, pg8::StaticOrder, true, true>((PG8_LAS unsigned char*)lds_raw, g, S, E, tid); }
        SEAM(pb + 9);
        if (ON(10) && IN(pb + 10)) { PHASE_WS; PHASE_IDS; const float* MODl = w.MOD + (size_t)l * (BATCH + 1) * NMODV; (void)MODl; misc::act_phase(w.UP, I->ffn_conv_w + (size_t)l * 3 * 2 * D_FF, I->ffn_conv_b + (size_t)l * 2 * D_FF, w.ACT, Mo, gtid, gthreads); }
        SEAM(pb + 10);
        if (ON(11) && IN(pb + 11)) { PHASE_WS; PHASE_IDS; const float* MODl = w.MOD + (size_t)l * (BATCH + 1) * NMODV; (void)MODl;
            { pg8::Gemm g{w.ACT, w.WDOWN + l * SZ_WDOWN, M_LAT, D_MODEL, D_FF, D_FF}; pg8::StaticOrder S; S.init(M_LAT, D_MODEL, G, wg);
              pg8::EpiGateRes E{w.H, want_ctx ? w.H : pp->out, D_MODEL, MODl + 5 * D_MODEL, NMODV, SEQ, BATCH, M_LAT};
              pg8::gemm_phase<pg8::EpiGateRes, pg8::StaticOrder, true, true>((PG8_LAS unsigned char*)lds_raw, g, S, E, tid); }
            if (want_ctx) { constexpr int SK = SK_DOWN;
              pg8::Gemm g{w.ACT + (size_t)M_LAT * D_FF, w.WDOWN + l * SZ_WDOWN, M_CTX, D_MODEL, D_FF / SK, D_FF}; SplitOrder S; S.init(M_CTX, D_MODEL, SK, G, (wg + G / 2) % G);
              pg8::EpiPart E{w.PART, D_MODEL, (size_t)M_CTX * D_MODEL};
              pg8::gemm_phase<pg8::EpiPart, SplitOrder, true, true>((PG8_LAS unsigned char*)lds_raw, g, S, E, tid); } }
        SEAM(pb + 11);

}
__global__ void __launch_bounds__(NTHR, 2) fwd(Params p) {
    extern __shared__ __attribute__((aligned(16))) unsigned char lds_raw[];
    char* lds = (char*)lds_raw;
    const int G = (int)gridDim.x, wg = (int)blockIdx.x, nwaves = G * NWAVES, gthreads = G * NTHR;
    const int C_wave0 = __builtin_amdgcn_readfirstlane((int)threadIdx.x >> 6);
    volatile LAS unsigned* MISC = (volatile LAS unsigned*)(lds_raw + LDS_MISC);
    if (threadIdx.x < 32) MISC[threadIdx.x] = 0u;
    __syncthreads();
    const int lo = p.ph_lo, hi = p.ph_hi;
    unsigned* const barw = (unsigned*)p.ws + CW_BAR + (size_t)p.li * XCD_BAR_WORDS;
    XcdBarrier bar; bar.bar = barw; bar.x = 0; bar.st = MISC + 8;
    if (hi - lo > 1) bar = xcd_barrier_post(barw, MISC + 8, threadIdx.x == 0);

    if (ON(12) && IN(PH_PRO)) { PHASE_WS; PHASE_IDS;
        {
            float* SCs = (float*)lds;
            float* red = (float*)(lds + 3 * D_MODEL * 4);
            constexpr int NT = DEPTH * NMODV / 256;
            if (wg < NT) {
                for (int i = tid; i < (BATCH + 1) * D_MODEL; i += NTHR) { const int s = i / D_MODEL, k = i % D_MODEL; const float v = s < BATCH ? I->c[s * D_MODEL + k] : I->c_ctx[k]; SCs[i] = v / (1.0f + __expf(-v)); }
                __syncthreads();
            }
            for (int t = wg; t < NT; t += G) { const int l = t / (NMODV / 256), j0 = (t % (NMODV / 256)) * 256;
                misc::f32x4 acc[3] = {{0.f, 0.f, 0.f, 0.f}, {0.f, 0.f, 0.f, 0.f}, {0.f, 0.f, 0.f, 0.f}};
                const float* wp = I->ada_w + (size_t)l * D_MODEL * NMODV + (size_t)(256 * wave) * NMODV + j0 + 4 * lane;
#pragma unroll 8
                for (int k = 0; k < 256; ++k) { const misc::f32x4 wv = *(const misc::f32x4*)(wp + (size_t)k * NMODV); const int kk = 256 * wave + k;
                    acc[0] += wv * SCs[kk]; acc[1] += wv * SCs[D_MODEL + kk]; acc[2] += wv * SCs[2 * D_MODEL + kk]; }
                __syncthreads();
#pragma unroll
                for (int s = 0; s < 3; ++s) *(misc::f32x4*)(red + (wave * 3 + s) * 256 + 4 * lane) = acc[s];
                __syncthreads();
                for (int i = tid; i < 3 * 256; i += NTHR) { const int s = i / 256, c = i % 256; float sum = I->ada_b[(size_t)l * NMODV + j0 + c];
#pragma unroll
                    for (int w8 = 0; w8 < 8; ++w8) sum += red[(w8 * 3 + s) * 256 + c];
                    w.MOD[((size_t)l * (BATCH + 1) + s) * NMODV + j0 + c] = sum; }
            }
            __syncthreads();
        }
        {
            float* scr = (float*)(lds + wave * 8448);
            constexpr int I_IN = (D_MODEL / 64) * (NP / 32), I_OUT = (D_MODEL / 64) * (D_MODEL / 32), I_UP = (D_MODEL / 64) * (2 * D_FF / 32), I_DN = (D_FF / 64) * (D_MODEL / 32),
                          I_UQ = (MLA_Q_LORA / 64) * (NQ_MLA / 32), I_UKV = (MLA_KV_LORA / 64) * (NKV_MLA / 32), I_LB = (LRU_BW / 64) * (LRU_BW / 32), I_LRU = 2 * 2 * NH * I_LB;
            constexpr int I_LAYER = I_IN + I_OUT + I_UP + I_DN + I_UQ + I_UKV + I_LRU;
            for (int it = gwave; it < DEPTH * I_LAYER; it += nwaves) { const int l = it / I_LAYER; int r = it % I_LAYER;
                if (r < I_IN) { misc::transpose_item(I->w_in + (size_t)l * D_MODEL * IN_COLS, D_MODEL, IN_COLS, NP, w.WIN + l * SZ_WIN, scr, r, lane); continue; } r -= I_IN;
                if (r < I_OUT) { misc::transpose_item(I->w_out + (size_t)l * D_MODEL * D_MODEL, D_MODEL, D_MODEL, D_MODEL, w.WOUT + l * SZ_WOUT, scr, r, lane); continue; } r -= I_OUT;
                if (r < I_UP) { misc::transpose_item(I->ffn_w_up + (size_t)l * D_MODEL * 2 * D_FF, D_MODEL, 2 * D_FF, 2 * D_FF, w.WUP + l * SZ_WUP, scr, r, lane); continue; } r -= I_UP;
                if (r < I_DN) { misc::transpose_item(I->ffn_w_down + (size_t)l * D_FF * D_MODEL, D_FF, D_MODEL, D_MODEL, w.WDOWN + l * SZ_WDOWN, scr, r, lane); continue; } r -= I_DN;
                if (r < I_UQ) { misc::transpose_item(I->mla_w_uq + (size_t)l * MLA_Q_LORA * NQ_MLA, MLA_Q_LORA, NQ_MLA, NQ_MLA, w.WUQ + l * SZ_WUQ, scr, r, lane); continue; } r -= I_UQ;
                if (r < I_UKV) { misc::transpose_item(I->mla_w_ukv + (size_t)l * MLA_KV_LORA * NKV_MLA, MLA_KV_LORA, NKV_MLA, NKV_MLA, w.WUKV + l * SZ_WUKV, scr, r, lane); continue; } r -= I_UKV;
                { const int blk = r / I_LB, item = r % I_LB, d = blk / (2 * NH), wh = (blk / NH) & 1, nb = blk % NH;
                  const float* src = (wh == 0 ? I->lru_wa : I->lru_wx) + ((size_t)(l * 2 + d) * NH + nb) * lru::SZ_WBLK;
                  misc::transpose_item(src, LRU_BW, LRU_BW, LRU_BW, w.WLRU + ((size_t)l * 16 + blk) * lru::SZ_WBLK, scr, item, lane); }
            }
        }
        for (long i = gtid; i < (long)M_ALL * D_MODEL / 4; i += gthreads) { const long e = i * 4;
            ((misc::f32x4*)w.H)[i] = e < (long)M_LAT * D_MODEL ? *(const misc::f32x4*)(I->x + e) : *(const misc::f32x4*)(I->ctx + (e - (long)M_LAT * D_MODEL)); }
    }
    SEAM(PH_PRO);

    { LayerCtx C; C.lo = lo; C.hi = hi; C.G = G; C.wg = wg; C.nwaves = nwaves; C.gthreads = gthreads; C.wave0 = C_wave0; C.bar = bar; C.lds = lds; C.lds_raw = lds_raw;
      static_assert(DEPTH == 4, "layer calls are written out (a real layer loop lets LICM park loop-invariant values in registers across every phase: spills)");
      layer_body<0>(C); layer_body<1>(C); layer_body<2>(C); layer_body<3>(C); }
#undef IN
#undef SEAM
}

#ifndef MK_PHASES_PER_LAUNCH
#define MK_PHASES_PER_LAUNCH NPH
#endif
extern "C" void kernel_launch(void* const* d_in, const int* in_sizes, int n_in, void* d_out, int out_size, void* d_ws, size_t ws_size, hipStream_t stream) {
    static int grid = 0;
    if (grid == 0) {
        int dev = 0, cus = 0;
        if (hipGetDevice(&dev) != hipSuccess || hipDeviceGetAttribute(&cus, hipDeviceAttributeMultiprocessorCount, dev) != hipSuccess || cus <= 0) { fprintf(stderr, "kernel_launch: no device\n"); grid = -1; return; }
        if (hipFuncSetAttribute((const void*)fwd, hipFuncAttributeMaxDynamicSharedMemorySize, LDS_BYTES) != hipSuccess) { fprintf(stderr, "kernel_launch: hipFuncSetAttribute failed\n"); grid = -1; return; }
        int per_cu = 0; if (hipOccupancyMaxActiveBlocksPerMultiprocessor(&per_cu, (const void*)fwd, NTHR, LDS_BYTES) != hipSuccess || per_cu < 1) fprintf(stderr, "kernel_launch: occupancy query says %d blocks per CU\n", per_cu);
        (void)hipGetLastError();
        grid = cus;
        const WS w0 = ws_carve(nullptr);
        if (n_in != 34 || w0.total > ws_size) { fprintf(stderr, "kernel_launch: bad inputs / workspace (need %zu, have %zu)\n", w0.total, ws_size); grid = -1; return; }
    }
    if (grid < 0) return;
    (void)hipMemsetAsync(d_ws, 0, 1 << 20, stream);
    Params p; memset(&p, 0, sizeof(p));
    for (int i = 0; i < 34; ++i) p.in[i] = (const float*)d_in[i];
    p.out = (float*)d_out; p.ws = (unsigned char*)d_ws;
    int li = 0;
    for (int lo = 0; lo < NPH; lo += MK_PHASES_PER_LAUNCH, ++li) {
        p.ph_lo = lo; p.ph_hi = lo + MK_PHASES_PER_LAUNCH < NPH ? lo + MK_PHASES_PER_LAUNCH : NPH; p.li = li;
#if defined(PROBE_MASK)
        if (MK_PHASES_PER_LAUNCH == 1 && ((((PROBE_MASK) >> 12) & 1 && lo == 0) || (lo > 0 && (((PROBE_MASK) >> ((lo - 1) % PH_PER_LAYER)) & 1))))
            { Params q = p;
#if defined(PROBE_FLAGS)
              q.pad = PROBE_FLAGS;
#endif
              for (int r = 0; r < PROBE_REPS; ++r) hipLaunchKernelGGL(fwd, dim3(grid), dim3(NTHR), LDS_BYTES, stream, q); }
#endif
        hipLaunchKernelGGL(fwd, dim3(grid), dim3(NTHR), LDS_BYTES, stream, p);
    }
}
```

```cpp
#include <hip/hip_runtime.h>
#include <cstdio>
#include <cstdint>
#include <cstring>
#include <math.h>
#include <stdint.h>

#ifdef CFG_SMALL
constexpr int D_MODEL = 256, BATCH = 2, SEQ = 512, DEPTH = 2, CTX_LEN = 64, GRID_W = 32, HEAD_DIM = 16;
#else
constexpr int D_MODEL = 2048, BATCH = 2, SEQ = 8192, DEPTH = 4, CTX_LEN = 256, GRID_W = 64, HEAD_DIM = 128;
#endif
constexpr int GROUP_W = D_MODEL / 4, NH = GROUP_W / HEAD_DIM;
constexpr int HD = HEAD_DIM;
constexpr int N_MOD = 6;
constexpr float EPS = 1e-6f;
constexpr int LRU_W = GROUP_W, LRU_BW = LRU_W / NH;
constexpr float LRU_C = 8.0f;
constexpr int MLA_Q_LORA = 3 * D_MODEL / 16, MLA_KV_LORA = D_MODEL / 8, MLA_NOPE = HD, MLA_ROPE = HD / 2, MLA_V = HD, MLA_QK = MLA_NOPE + MLA_ROPE;
constexpr int GDN_CHUNK = 64;
constexpr int NA_KH = 8, NA_KW = 16;
constexpr int D_FF = 5 * D_MODEL / 2;
constexpr int ROWS = SEQ / GRID_W;
constexpr int C_LRU_X = 0, C_LRU_G = C_LRU_X + LRU_W, C_CQ = C_LRU_G + LRU_W, C_CKV = C_CQ + MLA_Q_LORA, C_KR = C_CKV + MLA_KV_LORA,
              C_GQ = C_KR + MLA_ROPE, C_GK = C_GQ + GROUP_W, C_GV = C_GK + GROUP_W, C_GG = C_GV + GROUP_W, C_GB = C_GG + GROUP_W,
              C_GA = C_GB + 2 * NH, C_NQ = C_GA + 2 * NH, C_NK = C_NQ + GROUP_W, C_NV = C_NK + GROUP_W, IN_COLS = C_NV + GROUP_W;
constexpr int NP = (IN_COLS + 255) / 256 * 256;
constexpr int M_LAT = BATCH * SEQ, M_CTX = BATCH * CTX_LEN, M_ALL = M_LAT + M_CTX;
constexpr int NMODV = N_MOD * D_MODEL;

typedef unsigned short bf16_t;
__host__ __device__ __forceinline__ bf16_t f2bf(float f) { union { float f; unsigned u; } v; v.f = f; unsigned u = v.u; u += 0x7fffu + ((u >> 16) & 1u); return (bf16_t)(u >> 16); }
__host__ __device__ __forceinline__ float bf2f(bf16_t b) { union { float f; unsigned u; } v; v.u = ((unsigned)b) << 16; return v.f; }
__host__ __device__ __forceinline__ float sigmoidf_(float x) { return 1.0f / (1.0f + expf(-x)); }
__host__ __device__ __forceinline__ float siluf_(float x) { return x / (1.0f + expf(-x)); }
__host__ __device__ __forceinline__ float softplusf_(float x) { return fmaxf(x, 0.0f) + log1pf(expf(-fabsf(x))); }
__host__ __device__ __forceinline__ float geluf_(float x) { return 0.5f * x * (1.0f + tanhf(0.7978845608028654f * (x + 0.044715f * x * x * x))); }

struct RowInfo { int b, t, T, base, set; };
__host__ __device__ __forceinline__ RowInfo row_info(int r) {
    RowInfo i;
    if (r < M_LAT) { i.b = r / SEQ; i.t = r % SEQ; i.T = SEQ; i.base = i.b * SEQ; i.set = i.b; }
    else { const int rr = r - M_LAT; i.b = rr / CTX_LEN; i.t = rr % CTX_LEN; i.T = CTX_LEN; i.base = M_LAT + i.b * CTX_LEN; i.set = BATCH; }
    return i;
}


__host__ __device__ __forceinline__ float bflo(unsigned w) { union { float f; unsigned u; } v; v.u = w << 16; return v.f; }
__host__ __device__ __forceinline__ float bfhi(unsigned w) { union { float f; unsigned u; } v; v.u = w & 0xffff0000u; return v.f; }
#define LDS_BARRIER() asm volatile("s_waitcnt lgkmcnt(0)\n\ts_barrier" ::: "memory")
__device__ __forceinline__ float lane_xor(float v, int mask, int lane) { return __int_as_float(__builtin_amdgcn_ds_bpermute((lane ^ mask) << 2, __float_as_int(v))); }
__device__ __forceinline__ float lane_get(float v, int src_lane) { return __int_as_float(__builtin_amdgcn_ds_bpermute(src_lane << 2, __float_as_int(v))); }
struct Inputs {
    const float *x, *c, *ctx, *c_ctx, *ada_w, *ada_b, *norm_mix_g, *norm_ffn_g, *w_in, *w_out,
        *lru_conv_w, *lru_conv_b, *lru_wa, *lru_ba, *lru_wx, *lru_bx, *lru_lam,
        *mla_qa_g, *mla_w_uq, *mla_kva_g, *mla_w_ukv, *mla_qn_g, *mla_kn_g,
        *gdn_conv_w, *gdn_a_log, *gdn_dt_bias, *gdn_norm_g, *na_qn_g, *na_kn_g, *na_rpb,
        *ffn_w_up, *ffn_conv_w, *ffn_conv_b, *ffn_w_down;
};
constexpr int NQ_MLA = NH * MLA_QK, NKV_MLA = NH * (MLA_NOPE + MLA_V);
constexpr size_t SZ_WIN = (size_t)NP * D_MODEL, SZ_WOUT = (size_t)D_MODEL * D_MODEL, SZ_WUP = (size_t)2 * D_FF * D_MODEL, SZ_WDOWN = (size_t)D_MODEL * D_FF,
                 SZ_WUQ = (size_t)NQ_MLA * MLA_Q_LORA, SZ_WUKV = (size_t)NKV_MLA * MLA_KV_LORA, SZ_WLRU = (size_t)16 * LRU_BW * LRU_BW;
struct WS {
    unsigned* ctl; float *MOD, *H, *PART; bf16_t *U, *Y;
    bf16_t *WIN, *WOUT, *WUP, *WDOWN, *WUQ, *WUKV, *WLRU;
    bf16_t* P; bf16_t *CQN, *CKVN, *QR, *KVR, *QM, *KM, *VM, *NQ, *NK;
    bf16_t *gUT, *gWP, *gKDT, *gQD, *gQK, *gSIT, *gVNT; float *gGT, *gSS;
    bf16_t *lHLOC, *lACUM; float *lLSUM, *lHIN;
    bf16_t *UP, *ACT;
    size_t total;
};
__host__ __device__ inline WS ws_carve(void* base) {
    WS w; size_t off = 0; char* b = (char*)base;
#define WS_TAKE(T, field, bytes) do { w.field = (T*)(b + off); off += (((size_t)(bytes)) + 255) & ~(size_t)255; } while (0)
    WS_TAKE(unsigned, ctl, 1 << 20);
    WS_TAKE(float, MOD, sizeof(float) * (size_t)DEPTH * (BATCH + 1) * NMODV);
    WS_TAKE(float, H, sizeof(float) * (size_t)M_ALL * D_MODEL);
    WS_TAKE(float, PART, sizeof(float) * (size_t)5 * M_CTX * D_MODEL);
    WS_TAKE(bf16_t, U, 2 * (size_t)M_ALL * D_MODEL);
    WS_TAKE(bf16_t, Y, 2 * (size_t)M_ALL * D_MODEL);
    WS_TAKE(bf16_t, WIN, 2 * SZ_WIN * DEPTH); WS_TAKE(bf16_t, WOUT, 2 * SZ_WOUT * DEPTH); WS_TAKE(bf16_t, WUP, 2 * SZ_WUP * DEPTH); WS_TAKE(bf16_t, WDOWN, 2 * SZ_WDOWN * DEPTH);
    WS_TAKE(bf16_t, WUQ, 2 * SZ_WUQ * DEPTH); WS_TAKE(bf16_t, WUKV, 2 * SZ_WUKV * DEPTH); WS_TAKE(bf16_t, WLRU, 2 * SZ_WLRU * DEPTH);
    const size_t r0 = off;
    WS_TAKE(bf16_t, P, 2 * (size_t)M_ALL * NP);
    WS_TAKE(bf16_t, CQN, 2 * (size_t)M_ALL * MLA_Q_LORA); WS_TAKE(bf16_t, CKVN, 2 * (size_t)M_ALL * MLA_KV_LORA);
    WS_TAKE(bf16_t, QR, 2 * (size_t)M_ALL * NQ_MLA); WS_TAKE(bf16_t, KVR, 2 * (size_t)M_ALL * NKV_MLA);
    WS_TAKE(bf16_t, QM, 2 * (size_t)M_ALL * NQ_MLA); WS_TAKE(bf16_t, KM, 2 * (size_t)M_ALL * NQ_MLA); WS_TAKE(bf16_t, VM, 2 * (size_t)M_ALL * NH * MLA_V);
    WS_TAKE(bf16_t, NQ, 2 * (size_t)M_ALL * GROUP_W); WS_TAKE(bf16_t, NK, 2 * (size_t)M_ALL * GROUP_W);
    { constexpr size_t NT_ = (size_t)(M_ALL / 64) * NH * 2;
      WS_TAKE(bf16_t, gUT, 2 * NT_ * 128 * 64); WS_TAKE(bf16_t, gWP, 2 * NT_ * 64 * 128); WS_TAKE(bf16_t, gKDT, 2 * NT_ * 128 * 64); WS_TAKE(bf16_t, gQD, 2 * NT_ * 64 * 128);
      WS_TAKE(bf16_t, gQK, 2 * NT_ * 64 * 64); WS_TAKE(bf16_t, gSIT, 2 * NT_ * 128 * 128); WS_TAKE(bf16_t, gVNT, 2 * NT_ * 128 * 64); WS_TAKE(float, gGT, 4 * NT_ * DEPTH); WS_TAKE(float, gSS, 4 * (size_t)BATCH * NH * 2 * HD * HD); }
    WS_TAKE(bf16_t, lHLOC, 2 * (size_t)2 * M_ALL * LRU_W); WS_TAKE(bf16_t, lACUM, 2 * (size_t)2 * M_ALL * LRU_W);
    WS_TAKE(float, lLSUM, 4 * (size_t)(M_ALL / 64) * 2 * 2 * LRU_W); WS_TAKE(float, lHIN, 4 * (size_t)(M_ALL / 64) * 2 * LRU_W);
    const size_t r1 = off;
    off = r0;
    WS_TAKE(bf16_t, UP, 2 * (size_t)M_ALL * 2 * D_FF); WS_TAKE(bf16_t, ACT, 2 * (size_t)M_ALL * D_FF);
    const size_t f1 = off;
#undef WS_TAKE
    w.total = r1 > f1 ? r1 : f1;
    return w;
}

namespace pg8 {
#define PG8_LAS __attribute__((address_space(3)))
typedef unsigned short bf16_t;
typedef short bf16x8 __attribute__((ext_vector_type(8)));
typedef float f32x4 __attribute__((ext_vector_type(4)));
typedef unsigned u32x4 __attribute__((ext_vector_type(4)));
constexpr int BM = 256, BK = 64, HALF = 128, HTB = HALF * BK * 2  , STAGE_BYTES = 8 * HTB, NXCD = 8, WGM = 8;

__host__ __device__ __forceinline__ int lds_byte(int r, int c) { const int st = (r >> 4) * 2 + (c >> 5), rr = r & 15, cc = c & 31, ob = rr * 64 + cc * 2; return st * 1024 + (ob ^ (((ob >> 9) & 1) << 5)); }
__host__ __device__ __forceinline__ void stage_rc(int b, int& R, int& C) { const int st = b / 1024, sb = b % 1024, swz = sb ^ (((sb >> 9) & 1) << 5); R = (st >> 1) * 16 + swz / 64; C = (st & 1) * 32 + (swz % 64) / 2; }
__host__ __device__ __forceinline__ int perm32(int rho) { const int n = rho >> 4, i = rho & 15; return 8 * (i >> 2) + 4 * n + (i & 3); }

struct Unit { int pm, pn, ks; };
struct Gemm { const bf16_t* A; const bf16_t* Bt; int M, N, K, ld; };

struct StaticOrder {
    int nM, nN, nwg, G, c;
    __host__ __device__ void init(int M, int N, int G_, int c_) { nM = M / BM; nN = N / BM; nwg = nM * nN; G = G_; c = c_; }
    __host__ __device__ bool next(int i, Unit& u) const {
        const long L = (long)i * G + c; if (L >= nwg) return false;
        int wgid = (int)L; { const int q = nwg / NXCD, r = nwg % NXCD, xcd = wgid % NXCD, off = wgid / NXCD; wgid = (xcd < r ? xcd * (q + 1) : r * (q + 1) + (xcd - r) * q) + off; }
        const int nig = WGM * nN, gid = wgid / nig, fm = gid * WGM, gsz = (nM - fm) < WGM ? (nM - fm) : WGM;
        u.pm = fm + ((wgid % nig) % gsz); u.pn = (wgid % nig) / gsz; u.ks = 0; return true;
    }
    __device__ __forceinline__ void a_ready(const Unit&) const {}
    __device__ __forceinline__ void done(const Unit&) const {}
};
__device__ __forceinline__ unsigned cvt_pk_bf16(float lo, float hi) { unsigned r; asm volatile("v_cvt_pk_bf16_f32 %0, %1, %2" : "=v"(r) : "v"(lo), "v"(hi)); return r; }
typedef float f32x2 __attribute__((ext_vector_type(2)));
__device__ __forceinline__ f32x2 gelu_pk(f32x2 v) {
    const f32x2 av = __builtin_elementwise_abs(v), d = av * 0.2316418882f + 1.0f;
    f32x2 t; t.x = __builtin_amdgcn_rcpf(d.x); t.y = __builtin_amdgcn_rcpf(d.y);
    f32x2 q = t * 0.5307027145f + (-0.7265760135f); q = q * t + 0.7107068705f; q = q * t + (-0.142248368f); q = q * t + 0.127414796f; q = q * t;
    const f32x2 s = (v * v) * (-0.72134752044f);
    f32x2 e; e.x = __builtin_amdgcn_exp2f(s.x); e.y = __builtin_amdgcn_exp2f(s.y);
    const f32x2 m = v * (q * e), r = v - m;
    f32x2 o; o.x = v.x < 0.f ? m.x : r.x; o.y = v.y < 0.f ? m.y : r.y; return o;
}

template <int ACT  > struct EpiBf16 {
    static constexpr bool PERM = true, AFTER_DRAIN = false; static_assert(ACT == 0 || ACT == 1, "EpiBf16: ACT is 0 (none) or 1 (gelu_pk)");
    bf16_t* O; int ldc; const float* bias; int split_cols; size_t split_stride; float scale0;
    __device__ __forceinline__ void operator()(const f32x4 (&acc)[2][2][4][2], const Unit& u, int wr, int wc, int fr, int fq) const {
        const int row0 = u.pm * BM + wr * 64 + fr; int colt = u.pn * BM; bf16_t* base = O;
        float sc = 1.f; if (split_cols) { const int t = colt / split_cols; base += (size_t)t * split_stride; colt -= t * split_cols; if (t == 0) sc = scale0; }
        const int col0 = colt + wc * 32 + 8 * fq, bcol0 = u.pn * BM + wc * 32 + 8 * fq;
        f32x4 bv[2][2];
#pragma unroll
        for (int bj = 0; bj < 2; ++bj)
#pragma unroll
            for (int n = 0; n < 2; ++n) bv[bj][n] = bias ? *(const f32x4*)(bias + bcol0 + bj * HALF + 4 * n) : (f32x4){0.f, 0.f, 0.f, 0.f};
#pragma unroll
        for (int ai = 0; ai < 2; ++ai)
#pragma unroll
            for (int m = 0; m < 4; ++m) { bf16_t* rowp = base + (size_t)(row0 + ai * HALF + m * 16) * ldc + col0;
#pragma unroll
                for (int bj = 0; bj < 2; ++bj) { f32x4 v0 = acc[ai][bj][m][0] + bv[bj][0], v1 = acc[ai][bj][m][1] + bv[bj][1];
                    if (ACT == 1) { f32x2 a = gelu_pk((f32x2){v0[0], v0[1]}), b = gelu_pk((f32x2){v0[2], v0[3]}), c = gelu_pk((f32x2){v1[0], v1[1]}), d = gelu_pk((f32x2){v1[2], v1[3]});
                        v0 = (f32x4){a.x, a.y, b.x, b.y}; v1 = (f32x4){c.x, c.y, d.x, d.y}; }
                    v0 = v0 * sc; v1 = v1 * sc; u32x4 w; w.x = cvt_pk_bf16(v0[0], v0[1]); w.y = cvt_pk_bf16(v0[2], v0[3]); w.z = cvt_pk_bf16(v1[0], v1[1]); w.w = cvt_pk_bf16(v1[2], v1[3]);
                    *(u32x4*)(rowp + bj * HALF) = w; } }
    }
};

struct EpiF32 {
    static constexpr bool PERM = false, AFTER_DRAIN = false;
    float* C; int ldc;
    __device__ __forceinline__ void operator()(const f32x4 (&acc)[2][2][4][2], const Unit& u, int wr, int wc, int fr, int fq) const {
        const int row0 = u.pm * BM + wr * 64 + fr, col0 = u.pn * BM + wc * 32 + 4 * fq;
#pragma unroll
        for (int ai = 0; ai < 2; ++ai)
#pragma unroll
            for (int m = 0; m < 4; ++m) { float* rowp = C + (size_t)(row0 + ai * HALF + m * 16) * ldc + col0;
#pragma unroll
                for (int bj = 0; bj < 2; ++bj)
#pragma unroll
                    for (int n = 0; n < 2; ++n) *(f32x4*)(rowp + bj * HALF + n * 16) = acc[ai][bj][m][n]; }
    }
};
struct EpiGateRes {
    static constexpr bool PERM = false, AFTER_DRAIN = false;
    const float* base; float* out; int ldc; const float* gate; int set_stride; int rows_per_set; int nsets_lat; int lat_rows;
    __device__ __forceinline__ void operator()(const f32x4 (&acc)[2][2][4][2], const Unit& u, int wr, int wc, int fr, int fq) const {
        const int row0 = u.pm * BM + wr * 64 + fr, col0 = u.pn * BM + wc * 32 + 4 * fq;
        const int set = (u.pm * BM >= lat_rows) ? nsets_lat : (u.pm * BM) / rows_per_set;
        const float* gp = gate + (size_t)set * set_stride + col0;
        f32x4 gv[2][2];
#pragma unroll
        for (int bj = 0; bj < 2; ++bj)
#pragma unroll
            for (int n = 0; n < 2; ++n) gv[bj][n] = *(const f32x4*)(gp + bj * HALF + n * 16);
#pragma unroll
        for (int ai = 0; ai < 2; ++ai)
#pragma unroll
            for (int m = 0; m < 4; ++m) { const size_t off = (size_t)(row0 + ai * HALF + m * 16) * ldc + col0;
#pragma unroll
                for (int bj = 0; bj < 2; ++bj)
#pragma unroll
                    for (int n = 0; n < 2; ++n) { const f32x4 b = *(const f32x4*)(base + off + bj * HALF + n * 16); *(f32x4*)(out + off + bj * HALF + n * 16) = b + gv[bj][n] * acc[ai][bj][m][n]; } }
    }
};

struct EpiPart {
    static constexpr bool PERM = false, AFTER_DRAIN = false;
    float* C; int ldc; size_t ks_stride;
    __device__ __forceinline__ void operator()(const f32x4 (&acc)[2][2][4][2], const Unit& u, int wr, int wc, int fr, int fq) const {
        const int row0 = u.pm * BM + wr * 64 + fr, col0 = u.pn * BM + wc * 32 + 4 * fq; float* Cb = C + (size_t)u.ks * ks_stride;
#pragma unroll
        for (int ai = 0; ai < 2; ++ai)
#pragma unroll
            for (int m = 0; m < 4; ++m) { float* rowp = Cb + (size_t)(row0 + ai * HALF + m * 16) * ldc + col0;
#pragma unroll
                for (int bj = 0; bj < 2; ++bj)
#pragma unroll
                    for (int n = 0; n < 2; ++n) *(f32x4*)(rowp + bj * HALF + n * 16) = acc[ai][bj][m][n]; }
    }
};

template <class Epi, class Sched, bool ALIGN_EPI = false, bool SP2 = false>
__device__ __forceinline__ void gemm_phase(PG8_LAS unsigned char* lds, const Gemm g, const Sched& S, const Epi& E, const int tid_in) {
    int tid_ = tid_in; asm volatile("" : "+v"(tid_));
    const int tid = tid_, wid = __builtin_amdgcn_readfirstlane(tid >> 6), lane = tid & 63, wr = wid >> 2, wc = wid & 3, fr = lane & 15, fq = lane >> 4;
    const int K = g.K, nt = K / BK;
    unsigned voffA[2], voffB[2];
#pragma unroll
    for (int i = 0; i < 2; ++i) { int R, C; stage_rc(tid * 16 + i * 8192, R, C); const int Rb = Epi::PERM ? ((R & ~31) + perm32(R & 31)) : R;
        voffA[i] = (unsigned)(R * g.ld + C) * 2u; voffB[i] = (unsigned)(Rb * g.ld + C) * 2u; }
    const size_t kstep = (size_t)(BK * 2);
    const size_t hstep = (size_t)HALF * g.ld * 2;
    const size_t tstep = 2 * hstep;
    const unsigned ldsw = (unsigned)wid * 1024u;
    const int aoff = lds_byte(wr * 64 + fr, fq * 8), boff = lds_byte(wc * 32 + fr, fq * 8);
#define PG8_SA(b, h) (((b) * 2 + (h)) * HTB)
#define PG8_SB(b, h) ((4 + (b) * 2 + (h)) * HTB)
#define PG8_STAGE(bufoff, gbase, voff) do { _Pragma("unroll") for (int _i = 0; _i < 2; ++_i) \
        __builtin_amdgcn_global_load_lds((const unsigned*)((const char*)(gbase) + (voff)[_i]), (PG8_LAS unsigned*)(lds + (bufoff) + ldsw + _i * 8192), 16, 0, 0); } while (0)
#define PG8_LDA(dst, b, h) do { _Pragma("unroll") for (int m = 0; m < 4; ++m) _Pragma("unroll") for (int k = 0; k < 2; ++k) dst[m][k] = *(const PG8_LAS bf16x8*)(lds + PG8_SA(b, h) + aoff + m * 2048 + k * 1024); } while (0)
#define PG8_LDB(dst, b, h) do { _Pragma("unroll") for (int n = 0; n < 2; ++n) _Pragma("unroll") for (int k = 0; k < 2; ++k) dst[n][k] = *(const PG8_LAS bf16x8*)(lds + PG8_SB(b, h) + boff + n * 2048 + k * 1024); } while (0)
#define PG8_MMA(ai, bj, At, Bt) do { __builtin_amdgcn_s_setprio(1); _Pragma("unroll") for (int m = 0; m < 4; ++m) _Pragma("unroll") for (int n = 0; n < 2; ++n) _Pragma("unroll") for (int k = 0; k < 2; ++k) \
        acc[ai][bj][m][n] = __builtin_amdgcn_mfma_f32_16x16x32_bf16(Bt[n][k], At[m][k], acc[ai][bj][m][n], 0, 0, 0); __builtin_amdgcn_s_setprio(0); } while (0)
#define PG8_WAIT_V(n) asm volatile("s_waitcnt vmcnt(" #n ")" ::: "memory")
#define PG8_WAIT_L(n) asm volatile("s_waitcnt lgkmcnt(" #n ")" ::: "memory")
#define PG8_BAR __builtin_amdgcn_s_barrier()
#define PG8_SCHED __builtin_amdgcn_sched_barrier(0)
    Unit cur, nxt; int ui = 0;
    if (!S.next(0, cur)) return;
    f32x4 acc[2][2][4][2];
#pragma unroll
    for (int a = 0; a < 2; ++a)
#pragma unroll
        for (int b = 0; b < 2; ++b)
#pragma unroll
            for (int m = 0; m < 4; ++m)
#pragma unroll
                for (int n = 0; n < 2; ++n) acc[a][b][m][n] = (f32x4){0.f, 0.f, 0.f, 0.f};
    bf16x8 At[4][2], B0[2][2], B1[2][2];
    const size_t ksb = (size_t)K * 2;
    const char* cA = (const char*)g.A + (size_t)cur.pm * tstep + (size_t)cur.ks * ksb; const char* cB = (const char*)g.Bt + (size_t)cur.pn * tstep + (size_t)cur.ks * ksb;
    S.a_ready(cur);
    if constexpr (SP2) {
        PG8_STAGE(PG8_SB(0, 0), cB, voffB); PG8_STAGE(PG8_SB(0, 1), cB + hstep, voffB); PG8_STAGE(PG8_SA(0, 0), cA, voffA); PG8_STAGE(PG8_SA(0, 1), cA + hstep, voffA);
        if (wr == 1) PG8_BAR;
        PG8_WAIT_V(2); PG8_BAR;
        PG8_STAGE(PG8_SB(1, 0), cB + kstep, voffB); PG8_STAGE(PG8_SA(1, 0), cA + kstep, voffA); PG8_STAGE(PG8_SB(1, 1), cB + hstep + kstep, voffB);
        PG8_WAIT_V(6); PG8_BAR;
    } else {
        PG8_STAGE(PG8_SB(0, 0), cB, voffB); PG8_STAGE(PG8_SA(0, 0), cA, voffA); PG8_STAGE(PG8_SB(0, 1), cB + hstep, voffB); PG8_STAGE(PG8_SA(0, 1), cA + hstep, voffA);
        if (wr == 1) PG8_BAR;
        PG8_WAIT_V(4); PG8_BAR;
        PG8_STAGE(PG8_SB(1, 0), cB + kstep, voffB); PG8_STAGE(PG8_SA(1, 0), cA + kstep, voffA); PG8_STAGE(PG8_SB(1, 1), cB + hstep + kstep, voffB);
        PG8_WAIT_V(6); PG8_BAR;
    }
    for (;;) {
        const bool has_next = S.next(ui + 1, nxt);
        const char* nA = has_next ? (const char*)g.A + (size_t)nxt.pm * tstep + (size_t)nxt.ks * ksb : cA; const char* nB = has_next ? (const char*)g.Bt + (size_t)nxt.pn * tstep + (size_t)nxt.ks * ksb : cB;
        for (int t = 0; t < nt; t += 2) {
            const bool last = (t == nt - 2);
            const char* a1 = cA + (size_t)(t + 1) * kstep;
            const char* a2 = last ? nA : cA + (size_t)(t + 2) * kstep; const char* b2 = last ? nB : cB + (size_t)(t + 2) * kstep;
            const char* a3 = a2 + kstep; const char* b3 = b2 + kstep;
            if (last && has_next) S.a_ready(nxt);
            if constexpr (SP2) {
            PG8_LDB(B0, 0, 0); PG8_LDB(B1, 0, 1); PG8_SCHED; PG8_LDA(At, 0, 0); PG8_STAGE(PG8_SA(1, 1), a1 + hstep, voffA);
            PG8_WAIT_V(8); PG8_WAIT_L(0); PG8_BAR; PG8_MMA(0, 0, At, B0); PG8_MMA(0, 1, At, B1); PG8_BAR; PG8_SCHED;
            PG8_LDA(At, 0, 1); PG8_STAGE(PG8_SB(0, 0), b2, voffB); PG8_STAGE(PG8_SB(0, 1), b2 + hstep, voffB); PG8_STAGE(PG8_SA(0, 0), a2, voffA);
            PG8_WAIT_V(8); PG8_WAIT_L(0); PG8_BAR; PG8_MMA(1, 0, At, B0); PG8_MMA(1, 1, At, B1); PG8_BAR; PG8_SCHED;
            PG8_LDB(B0, 1, 0); PG8_LDB(B1, 1, 1); PG8_SCHED; PG8_LDA(At, 1, 0); PG8_STAGE(PG8_SA(0, 1), a2 + hstep, voffA);
            PG8_WAIT_V(8); PG8_WAIT_L(0); PG8_BAR; PG8_MMA(0, 0, At, B0); PG8_MMA(0, 1, At, B1); PG8_BAR; PG8_SCHED;
            PG8_LDA(At, 1, 1); PG8_STAGE(PG8_SB(1, 0), b3, voffB); PG8_STAGE(PG8_SB(1, 1), b3 + hstep, voffB); PG8_STAGE(PG8_SA(1, 0), a3, voffA);
            PG8_WAIT_V(8); PG8_WAIT_L(0); PG8_BAR; PG8_MMA(1, 0, At, B0); PG8_MMA(1, 1, At, B1); PG8_BAR; PG8_SCHED;
            } else {
            PG8_LDB(B0, 0, 0); PG8_SCHED; PG8_LDA(At, 0, 0); PG8_STAGE(PG8_SA(1, 1), a1 + hstep, voffA);
            PG8_WAIT_L(8); PG8_BAR; PG8_WAIT_L(0); PG8_MMA(0, 0, At, B0); PG8_BAR; PG8_SCHED;
            PG8_LDB(B1, 0, 1); PG8_STAGE(PG8_SB(0, 0), b2, voffB);
            PG8_BAR; PG8_WAIT_L(0); PG8_MMA(0, 1, At, B1); PG8_BAR;
            PG8_LDA(At, 0, 1); PG8_STAGE(PG8_SA(0, 0), a2, voffA);
            PG8_BAR; PG8_WAIT_L(0); PG8_MMA(1, 0, At, B0); PG8_BAR; PG8_SCHED;
            PG8_STAGE(PG8_SB(0, 1), b2 + hstep, voffB);
            PG8_WAIT_V(6); PG8_BAR; PG8_MMA(1, 1, At, B1); PG8_BAR;
            PG8_LDB(B0, 1, 0); PG8_SCHED; PG8_LDA(At, 1, 0); PG8_STAGE(PG8_SA(0, 1), a2 + hstep, voffA);
            PG8_WAIT_L(8); PG8_BAR; PG8_WAIT_L(0); PG8_MMA(0, 0, At, B0); PG8_BAR; PG8_SCHED;
            PG8_LDB(B1, 1, 1); PG8_STAGE(PG8_SB(1, 0), b3, voffB);
            PG8_BAR; PG8_WAIT_L(0); PG8_MMA(0, 1, At, B1); PG8_BAR;
            PG8_LDA(At, 1, 1); PG8_STAGE(PG8_SA(1, 0), a3, voffA);
            PG8_BAR; PG8_WAIT_L(0); PG8_MMA(1, 0, At, B0); PG8_BAR; PG8_SCHED;
            PG8_STAGE(PG8_SB(1, 1), b3 + hstep, voffB);
            PG8_WAIT_V(6); PG8_BAR; PG8_MMA(1, 1, At, B1); PG8_BAR;
            }
        }
        if constexpr (ALIGN_EPI) { if (wr == 0) PG8_BAR; }
        if constexpr (!Epi::AFTER_DRAIN) { E(acc, cur, wr, wc, fr, fq); S.done(cur); }
        if (!has_next) break;
#pragma unroll
        for (int a = 0; a < 2; ++a)
#pragma unroll
            for (int b = 0; b < 2; ++b)
#pragma unroll
                for (int m = 0; m < 4; ++m)
#pragma unroll
                    for (int n = 0; n < 2; ++n) acc[a][b][m][n] = (f32x4){0.f, 0.f, 0.f, 0.f};
        cur = nxt; cA = nA; cB = nB; ++ui;
        if constexpr (ALIGN_EPI) { if (wr == 1) PG8_BAR; }
    }
    PG8_WAIT_V(0);
    if constexpr (!ALIGN_EPI) { if (wr == 0) PG8_BAR; }
    PG8_BAR;
    if constexpr (Epi::AFTER_DRAIN) { E.fused(acc, cur, wr, wc, fr, fq, lds, wid, lane); S.done(cur); }
#undef PG8_SA
#undef PG8_SB
#undef PG8_STAGE
#undef PG8_LDA
#undef PG8_LDB
#undef PG8_MMA
#undef PG8_WAIT_V
#undef PG8_WAIT_L
#undef PG8_BAR
#undef PG8_SCHED
}
}

namespace att {
using bf16x8 = __attribute__((ext_vector_type(8))) short;
using s16x4  = __attribute__((ext_vector_type(4))) short;
using f32x16 = __attribute__((ext_vector_type(16))) float;
using u32x4  = __attribute__((ext_vector_type(4))) unsigned;
constexpr int NW = 8, QBLK = 32, KVBLK = 64, DV = 128;
#define ATT_SBAR() __builtin_amdgcn_sched_barrier(0)
__device__ __forceinline__ int crow(int r, int hi) { return (r & 3) + 8 * (r >> 2) + 4 * hi; }
__device__ __forceinline__ unsigned cvtpk(float lo, float hi) { unsigned r; asm volatile("v_cvt_pk_bf16_f32 %0, %1, %2" : "=v"(r) : "v"(lo), "v"(hi)); return r; }
template <int DQK> __device__ __forceinline__ int kswz(int row, int colB) { return row * (DQK * 2) + (colB ^ ((row & 7) << 4)); }
constexpr float THR = 8.f;

template <int DQK> struct Cfg {
    static constexpr int SHM_V = KVBLK * DV * 2, SHM_K = KVBLK * DQK * 2;
    static constexpr int OFF_V = 0, OFF_K = 2 * SHM_V, OFF_WS = OFF_K + 2 * SHM_K, OFF_BIAS = OFF_WS + NW * 64 * 4, LDS_BYTES = OFF_BIAS + 10240;
    static constexpr int KCH = DQK / 8;
    static constexpr int KLD = (64 * KCH) / 512;
};

struct Job {
    const bf16_t* Q;
    const bf16_t* K;
    const bf16_t* V;
    bf16_t* O;
    int nt;
    int seg0_tiles, row_seg0, row_seg1;
    int R0; int rlo;
};

__device__ __forceinline__ int tile_row(const Job& J, int j) {
    if (j < J.seg0_tiles) return J.row_seg0 + 64 * j;
    int jj = j - J.seg0_tiles; if (jj > 3) jj = 0; return J.row_seg1 + 64 * jj;
}

__device__ __forceinline__ void partialSM(f32x16& p0, f32x16& p1, float& m_reg, float& mn, float& alpha, float C, float thr_raw) {
    float pmax = p0[0];
#pragma unroll
    for (int r = 1; r < 16; ++r) pmax = fmaxf(pmax, p0[r]);
#pragma unroll
    for (int r = 0; r < 16; ++r) pmax = fmaxf(pmax, p1[r]);
    { auto rr = __builtin_amdgcn_permlane32_swap(__float_as_uint(pmax), __float_as_uint(pmax), false, false);
      pmax = fmaxf(__uint_as_float(rr[0]), __uint_as_float(rr[1])); }
    if (__builtin_expect(__all(pmax - m_reg <= thr_raw), 1)) { mn = m_reg; alpha = 1.f; }
    else { mn = fmaxf(m_reg, pmax); alpha = __builtin_amdgcn_exp2f((m_reg - mn) * C); m_reg = mn; }
    const float mnC = -mn * C;
#pragma unroll
    for (int r = 0; r < 16; ++r) p0[r] = fmaf(p0[r], C, mnC);
#pragma unroll
    for (int r = 0; r < 16; ++r) p1[r] = fmaf(p1[r], C, mnC);
#pragma unroll
    for (int r = 0; r < 16; ++r) p0[r] = __builtin_amdgcn_exp2f(p0[r]);
}
__device__ __forceinline__ void finishSM(f32x16& p0, f32x16& p1, float alpha, float& l_reg, bf16x8& pa0, bf16x8& pa1, bf16x8& pa2, bf16x8& pa3) {
#pragma unroll
    for (int r = 0; r < 16; ++r) p1[r] = __builtin_amdgcn_exp2f(p1[r]);
    float ps = 0;
#pragma unroll
    for (int r = 0; r < 16; ++r) ps += p0[r];
#pragma unroll
    for (int r = 0; r < 16; ++r) ps += p1[r];
    { auto rr = __builtin_amdgcn_permlane32_swap(__float_as_uint(ps), __float_as_uint(ps), false, false);
      ps = __uint_as_float(rr[0]) + __uint_as_float(rr[1]); }
    l_reg = l_reg * alpha + ps;
#define ATT_PK4(P, BASE, OUT) do { unsigned a0 = cvtpk(P[BASE + 0], P[BASE + 1]), a1 = cvtpk(P[BASE + 2], P[BASE + 3]);   \
    unsigned b0 = cvtpk(P[BASE + 4], P[BASE + 5]), b1 = cvtpk(P[BASE + 6], P[BASE + 7]);                              \
    auto r0 = __builtin_amdgcn_permlane32_swap(a0, b0, false, false); auto r1 = __builtin_amdgcn_permlane32_swap(a1, b1, false, false); \
    u32x4 w = {r0[0], r1[0], r0[1], r1[1]}; OUT = *reinterpret_cast<bf16x8*>(&w); } while (0)
    ATT_PK4(p0, 0, pa0); ATT_PK4(p0, 8, pa1); ATT_PK4(p1, 0, pa2); ATT_PK4(p1, 8, pa3);
#undef ATT_PK4
}
template <int DQK> __device__ __forceinline__ void qkt(f32x16& p0, f32x16& p1, const char* Ks, const bf16x8* qr, int r32, int hi) {
    p0 = f32x16{}; p1 = f32x16{};
#pragma unroll
    for (int d0 = 0; d0 < DQK / 16; ++d0) { const int cb = (d0 * 16 + hi * 8) * 2;
        const bf16x8 b0 = *reinterpret_cast<const bf16x8*>(Ks + kswz<DQK>(r32, cb));
        const bf16x8 b1 = *reinterpret_cast<const bf16x8*>(Ks + kswz<DQK>(32 + r32, cb));
        p0 = __builtin_amdgcn_mfma_f32_32x32x16_bf16(b0, qr[d0], p0, 0, 0, 0);
        p1 = __builtin_amdgcn_mfma_f32_32x32x16_bf16(b1, qr[d0], p1, 0, 0, 0); }
}
__device__ __forceinline__ int v_st(int k, int c) { const int kk = (k & ~0xC) | ((k & 4) << 1) | ((k & 8) >> 1); return ((kk >> 3) * 4 + (c >> 5)) * 512 + ((kk & 7) * 32 + (c & 31)) * 2; }
__device__ __forceinline__ int v_rd_base(int lane) { return ((lane & 3) << 3) | (((lane >> 2) & 3) << 6) | (((lane >> 4) & 1) << 5) | (((lane >> 5) & 1) << 8); }
constexpr int v_rd_off(int d0, int ks, int half) { return d0 * 512 + ks * 4096 + half * 2048; }
template <int OFF> __device__ __forceinline__ s16x4 tr_read(int vb) { s16x4 r; asm volatile("ds_read_b64_tr_b16 %0, %1 offset:%2" : "=&v"(r) : "v"(vb), "i"(OFF) : "memory"); return r; }
template <int D0> __device__ __forceinline__ void pv_one(f32x16& od, int vb, bf16x8 pa0, bf16x8 pa1, bf16x8 pa2, bf16x8 pa3) {
    const s16x4 l0 = tr_read<v_rd_off(D0, 0, 0)>(vb), h0 = tr_read<v_rd_off(D0, 0, 1)>(vb), l1 = tr_read<v_rd_off(D0, 1, 0)>(vb), h1 = tr_read<v_rd_off(D0, 1, 1)>(vb);
    const s16x4 l2 = tr_read<v_rd_off(D0, 2, 0)>(vb), h2 = tr_read<v_rd_off(D0, 2, 1)>(vb), l3 = tr_read<v_rd_off(D0, 3, 0)>(vb), h3 = tr_read<v_rd_off(D0, 3, 1)>(vb);
    asm volatile("s_waitcnt lgkmcnt(0)" ::: "memory"); ATT_SBAR();
#define ATT_PK(L, H) (bf16x8){L[0], L[1], L[2], L[3], H[0], H[1], H[2], H[3]}
    od = __builtin_amdgcn_mfma_f32_32x32x16_bf16(pa0, ATT_PK(l0, h0), od, 0, 0, 0);
    od = __builtin_amdgcn_mfma_f32_32x32x16_bf16(pa1, ATT_PK(l1, h1), od, 0, 0, 0);
    od = __builtin_amdgcn_mfma_f32_32x32x16_bf16(pa2, ATT_PK(l2, h2), od, 0, 0, 0);
    od = __builtin_amdgcn_mfma_f32_32x32x16_bf16(pa3, ATT_PK(l3, h3), od, 0, 0, 0);
#undef ATT_PK
}
__device__ __forceinline__ void pv_d0(f32x16* o, int vb, bf16x8 pa0, bf16x8 pa1, bf16x8 pa2, bf16x8 pa3) {
    pv_one<0>(o[0], vb, pa0, pa1, pa2, pa3); pv_one<1>(o[1], vb, pa0, pa1, pa2, pa3); pv_one<2>(o[2], vb, pa0, pa1, pa2, pa3); pv_one<3>(o[3], vb, pa0, pa1, pa2, pa3);
}
constexpr int NA_BROW = 160, NA_BORG = 64 + (NA_KW - 1);
__device__ __forceinline__ void na_bias(f32x16& p0, f32x16& p1, const Job& J, int j, int R, int c, int hi, const float* biasq) {
    const int nloc = J.seg0_tiles;
    if (j >= nloc && j < nloc + 4) return;
    const int rr = J.rlo + j; int r0 = R - NA_KH / 2; r0 = r0 < 0 ? 0 : (r0 > ROWS - NA_KH ? ROWS - NA_KH : r0);
    const bool rowok = (j < nloc) && rr >= r0 && rr < r0 + NA_KH;
    if (!rowok) {
#pragma unroll
        for (int r = 0; r < 16; ++r) { p0[r] = -1e30f; p1[r] = -1e30f; }
        return; }
    int c0 = c - NA_KW / 2; c0 = c0 < 0 ? 0 : (c0 > GRID_W - NA_KW ? GRID_W - NA_KW : c0);
    const int dr = rr - R + (NA_KH - 1);
    const float* bl = biasq + dr * NA_BROW + NA_BORG + 4 * hi - c;
    const int vb = 4 * hi - c0;
#pragma unroll
    for (int r = 0; r < 16; ++r) { const int cc = (r & 3) + 8 * (r >> 2);
        p0[r] = ((unsigned)(cc + vb) < (unsigned)NA_KW) ? p0[r] + bl[cc] : -1e30f;
        p1[r] = ((unsigned)(cc + 32 + vb) < (unsigned)NA_KW) ? p1[r] + bl[cc + 32] : -1e30f; }
}

#define ATT_LAS __attribute__((address_space(3)))
template <int DQK, bool NA, int LDQ, int LDK, int LDV, int LDO>
__device__ __forceinline__ void attn_unit(const Job& J, char* lds, const float scale, const int tid_in) {
    using C_ = Cfg<DQK>;
    int tid_ = tid_in; asm volatile("" : "+v"(tid_));
    const int tid = tid_, wid = __builtin_amdgcn_readfirstlane(tid >> 6), lane = tid & 63, r32 = lane & 31, hi = lane >> 5;
    char* V_lds = lds + C_::OFF_V; char* K_lds = lds + C_::OFF_K;
    const unsigned ldsb = (unsigned)(uintptr_t)lds;
    float* wsf = (float*)(lds + C_::OFF_WS) + wid * 64; float* li_l = wsf; float* al_l = wsf + 32;
    const float* biasq = (const float*)(lds + C_::OFF_BIAS);
    const float Cc = scale * 1.4426950408889634f, thr_raw = THR / scale;
    float m_reg = -1e5f, l_reg = 0; f32x16 o[4] = {}; bf16x8 qr[DQK / 16];
    const bf16_t* Qw = J.Q + (long)(wid * QBLK + r32) * LDQ + hi * 8;
#pragma unroll
    for (int d0 = 0; d0 < DQK / 16; ++d0) qr[d0] = *reinterpret_cast<const bf16x8*>(Qw + d0 * 16);
    const int naR = J.R0 + (wid >> 1), nac = (wid & 1) * 32 + r32;
    const int vb0 = (int)(uintptr_t)V_lds + v_rd_base(lane);
    unsigned koff[C_::KLD], voff[2];
#pragma unroll
    for (int i = 0; i < C_::KLD; ++i) { const int sl = 512 * i + tid, row = sl / C_::KCH, cs = sl % C_::KCH, chunk = (cs & ~7) | ((cs & 7) ^ (row & 7)); koff[i] = (unsigned)(row * LDK * 2 + chunk * 16); }
#pragma unroll
    for (int i = 0; i < 2; ++i) { const int sl = 512 * i + tid, sub = sl >> 5, wi = sl & 31, kk = (sub >> 2) * 8 + (wi >> 2), k = (kk & ~0xC) | ((kk & 4) << 1) | ((kk & 8) >> 1), c = (sub & 3) * 32 + (wi & 3) * 8;
        voff[i] = (unsigned)(k * LDV * 2 + c * 2); }
#define ATT_STAGE(j, b) do { const int row0_ = tile_row(J, (j)); const char* vp_ = (const char*)(J.V + (size_t)row0_ * LDV); const char* kp_ = (const char*)(J.K + (size_t)row0_ * LDK); \
        _Pragma("unroll") for (int i_ = 0; i_ < C_::KLD; ++i_) __builtin_amdgcn_global_load_lds((const unsigned*)(kp_ + koff[i_]), (ATT_LAS unsigned*)(ldsb + C_::OFF_K + (b) * C_::SHM_K + (512 * i_ + 64 * wid) * 16), 16, 0, 0); \
        _Pragma("unroll") for (int i_ = 0; i_ < 2; ++i_) __builtin_amdgcn_global_load_lds((const unsigned*)(vp_ + voff[i_]), (ATT_LAS unsigned*)(ldsb + C_::OFF_V + (b) * C_::SHM_V + (512 * i_ + 64 * wid) * 16), 16, 0, 0); } while (0)
    const int NT = J.nt;
    __syncthreads();
    ATT_STAGE(0, 0); asm volatile("s_waitcnt vmcnt(0)" ::: "memory"); __syncthreads();
    for (int j = 0; j < NT; ++j) {
        const int buf = j & 1;
        if (j + 1 < NT) ATT_STAGE(j + 1, buf ^ 1);
        f32x16 p0, p1; float mn, al; bf16x8 pa0, pa1, pa2, pa3;
        qkt<DQK>(p0, p1, K_lds + buf * C_::SHM_K, qr, r32, hi);
        if (NA) na_bias(p0, p1, J, j, naR, nac, hi, biasq);
        partialSM(p0, p1, m_reg, mn, al, Cc, thr_raw);
        finishSM(p0, p1, al, l_reg, pa0, pa1, pa2, pa3);
        if (__any(al < 1.f)) { if (hi == 0) al_l[r32] = al; asm volatile("s_waitcnt lgkmcnt(0)" ::: "memory");
#pragma unroll
            for (int d = 0; d < 4; ++d)
#pragma unroll
                for (int r = 0; r < 16; ++r) o[d][r] *= al_l[crow(r, hi)]; }
        ATT_SBAR();
        pv_d0(o, vb0 + buf * C_::SHM_V, pa0, pa1, pa2, pa3);
        asm volatile("s_waitcnt vmcnt(0)" ::: "memory");
        __syncthreads();
    }
    if (hi == 0) li_l[r32] = l_reg; asm volatile("s_waitcnt lgkmcnt(0)" ::: "memory");
    float rli[16];
#pragma unroll
    for (int r = 0; r < 16; ++r) rli[r] = __builtin_amdgcn_rcpf(li_l[crow(r, hi)]);
    bf16_t* Ow = J.O + (long)(wid * QBLK) * LDO;
#pragma unroll
    for (int r = 0; r < 16; ++r) { const int orow = crow(r, hi);
#pragma unroll
        for (int d0 = 0; d0 < 4; ++d0) Ow[(long)orow * LDO + d0 * 32 + r32] = f2bf(o[d0][r] * rli[r]); }
#undef ATT_STAGE
}
}

struct AttnArgs { const bf16_t *QM, *KM, *VM, *NQ, *NK, *P; bf16_t* Y; const float* rpb; int want_ctx; int pad; };
__device__ __forceinline__ void attention_phase(const AttnArgs& A, char* lds, int G, int wg, const int tid, const int nskip) {
    static_assert(GRID_W == 64 && SEQ % 256 == 0 && CTX_LEN == 256 && HD == 128, "attention phase geometry");
    constexpr int NQB = SEQ / 256;
    constexpr float sc_mla = 0.07216878364870323f, sc_na = 0.08838834764831845f;
    static_assert(MLA_QK == 192 && HD == 128, "softmax scales");
    if (!(A.pad & 2)) for (int u = wg; u < BATCH * NH * NQB; u += G) {
        const int bh = u % (BATCH * NH), qb = u / (BATCH * NH), b = bh / NH, h = bh % NH;
        att::Job J{};
        J.Q = A.QM + (size_t)(b * SEQ + qb * 256) * NQ_MLA + h * MLA_QK; J.K = A.KM + h * MLA_QK; J.V = A.VM + h * MLA_V;
        J.O = A.Y + (size_t)(b * SEQ + qb * 256) * D_MODEL + GROUP_W + h * MLA_V;
        J.nt = SEQ / 64 + CTX_LEN / 64; J.seg0_tiles = SEQ / 64; J.row_seg0 = b * SEQ; J.row_seg1 = M_LAT + b * CTX_LEN;
        att::attn_unit<MLA_QK, false, NQ_MLA, NQ_MLA, NH * MLA_V, D_MODEL>(J, lds, sc_mla, tid);
    }
    const int G2n = G - nskip, c2 = wg - nskip;
    if (!(A.pad & 4) && c2 >= 0) for (int u = c2; u < BATCH * NH * NQB; u += G2n) {
        const int bh = u % (BATCH * NH), qb = u / (BATCH * NH), b = bh / NH, h = bh % NH, R0 = qb * 4;
        __syncthreads();
        { float* bq = (float*)(lds + att::Cfg<HD>::OFF_BIAS); const float* src = A.rpb + (size_t)h * (2 * NA_KH - 1) * (2 * NA_KW - 1);
          for (int i = tid; i < (2 * NA_KH - 1) * att::NA_BROW; i += 512) { const int dr = i / att::NA_BROW; int dc = i % att::NA_BROW - att::NA_BORG + (NA_KW - 1); dc = dc < 0 ? 0 : (dc > 2 * NA_KW - 2 ? 2 * NA_KW - 2 : dc);
              bq[i] = src[dr * (2 * NA_KW - 1) + dc] * 11.313708498984761f; } }
        int rlo = R0 - NA_KH / 2; rlo = rlo < 0 ? 0 : (rlo > ROWS - NA_KH ? ROWS - NA_KH : rlo);
        int rhi = R0 + 3 - NA_KH / 2; rhi = (rhi < 0 ? 0 : (rhi > ROWS - NA_KH ? ROWS - NA_KH : rhi)) + NA_KH - 1;
        const int nloc = rhi - rlo + 1;
        att::Job J{};
        J.Q = A.NQ + (size_t)(b * SEQ + R0 * 64) * GROUP_W + h * HD; J.K = A.NK + h * HD; J.V = A.P + C_NV + h * HD;
        J.O = A.Y + (size_t)(b * SEQ + R0 * 64) * D_MODEL + 3 * GROUP_W + h * HD;
        J.nt = (nloc + 4 + 1) & ~1; J.seg0_tiles = nloc; J.row_seg0 = b * SEQ + rlo * 64; J.row_seg1 = M_LAT + b * CTX_LEN;  J.R0 = R0; J.rlo = rlo;
        att::attn_unit<HD, true, GROUP_W, GROUP_W, NP, D_MODEL>(J, lds, sc_na, tid);
    }
    if (A.want_ctx && !(A.pad & 8)) {
        for (int u = c2 - 64; u >= 0 && u < BATCH * NH; u += G) {
            const int b = u / NH, h = u % NH; const int crow0 = M_LAT + b * CTX_LEN;
            att::Job J{}; J.nt = CTX_LEN / 64; J.seg0_tiles = 0; J.row_seg0 = crow0; J.row_seg1 = crow0;
            J.Q = A.QM + (size_t)crow0 * NQ_MLA + h * MLA_QK; J.K = A.KM + h * MLA_QK; J.V = A.VM + h * MLA_V;
            J.O = A.Y + (size_t)crow0 * D_MODEL + GROUP_W + h * MLA_V; att::attn_unit<MLA_QK, false, NQ_MLA, NQ_MLA, NH * MLA_V, D_MODEL>(J, lds, sc_mla, tid);
        }
        for (int u = c2 - 64 - BATCH * NH; u >= 0 && u < BATCH * NH; u += G) {
            const int b = u / NH, h = u % NH; const int crow0 = M_LAT + b * CTX_LEN;
            att::Job J{}; J.nt = CTX_LEN / 64; J.seg0_tiles = 0; J.row_seg0 = crow0; J.row_seg1 = crow0;
            J.Q = A.NQ + (size_t)crow0 * GROUP_W + h * HD; J.K = A.NK + h * HD; J.V = A.P + C_NV + h * HD;
            J.O = A.Y + (size_t)crow0 * D_MODEL + 3 * GROUP_W + h * HD; att::attn_unit<HD, false, GROUP_W, GROUP_W, NP, D_MODEL>(J, lds, sc_na, tid);
        }
    }
}

namespace gdn {
typedef short bf16x8 __attribute__((ext_vector_type(8)));
typedef float f32x4 __attribute__((ext_vector_type(4)));
typedef float f32x16 __attribute__((ext_vector_type(16)));
typedef unsigned u32x2 __attribute__((ext_vector_type(2)));
typedef unsigned u32x4 __attribute__((ext_vector_type(4)));
constexpr int CH = 64, NCHUNK = M_ALL / CH;
constexpr int NTASK = NCHUNK * NH * 2;
constexpr size_t SZ_UT = 128 * 64, SZ_WP = 64 * 128, SZ_KDT = 128 * 64, SZ_QD = 64 * 128, SZ_QK = 64 * 64, SZ_SIT = 128 * 128, SZ_VNT = 128 * 64;
struct Bufs { bf16_t *UT, *WP, *KDT, *QD, *QK, *SIT, *VNT; float* GT; };
__device__ __forceinline__ int perm32(int o) { return (o & ~31) | (((o & 15) >> 2) * 8 + ((o >> 4) & 1) * 4 + (o & 3)); }
__device__ __forceinline__ unsigned pk2(float lo, float hi) { return (unsigned)f2bf(lo) | ((unsigned)f2bf(hi) << 16); }

constexpr int QS = 132;
constexpr int AS = 68;
constexpr int G1_OFF_Q = 0, G1_OFF_K = G1_OFF_Q + CH * QS * 4, G1_OFF_V = G1_OFF_K + CH * QS * 4, G1_OFF_AA = G1_OFF_V + CH * QS * 4, G1_OFF_SM = G1_OFF_AA + 2 * CH * AS * 4,
              G1_LDS = G1_OFF_SM + 12 * 64 * 4;
struct G1Args { const bf16_t* P; const float* conv_w; const float* a_log; const float* dt_bias; Bufs B; int pflags; };

__device__ __forceinline__ void g1_task(const G1Args& A, char* lds, int cix, int h, const int tid_in) {
    int tid_ = tid_in; asm volatile("" : "+v"(tid_));
    const int tid = tid_, wid = __builtin_amdgcn_readfirstlane(tid >> 6), lane = tid & 63;
    float* Qs = (float*)(lds + G1_OFF_Q); float* Ks = (float*)(lds + G1_OFF_K); float* Vs = (float*)(lds + G1_OFF_V); float* AA = (float*)(lds + G1_OFF_AA);
    float* sm = (float*)(lds + G1_OFF_SM); float* g_s = sm;   float* beta_s = sm + 128;   float* gc_s = sm + 256;
    const int row0 = cix * CH; const RowInfo r0i = row_info(row0);
    LDS_BARRIER();
    if (tid < 48 * 8) {
        const int grp = tid % 48, ts = tid / 48, which = grp >> 4, cc0 = (grp & 15) * 8, ch0 = which * GROUP_W + h * HD + cc0;
        float wgt[4][8];
#pragma unroll
        for (int j = 0; j < 4; ++j) { const f32x4 w0 = *(const f32x4*)(A.conv_w + j * 3 * GROUP_W + ch0), w1 = *(const f32x4*)(A.conv_w + j * 3 * GROUP_W + ch0 + 4);
#pragma unroll
            for (int e = 0; e < 4; ++e) { wgt[j][e] = w0[e]; wgt[j][4 + e] = w1[e]; } }
        u32x4 xr[11];
#pragma unroll
        for (int k = 0; k < 11; ++k) { const int tt = r0i.t + 8 * ts + k - 1;
            xr[k] = (tt >= 0 && tt < r0i.T && !(A.pflags & 4096)) ? *(const u32x4*)(A.P + (size_t)(r0i.base + tt) * NP + C_GQ + ch0) : (u32x4){0u, 0u, 0u, 0u}; }
        float* dstp = (which == 0 ? Qs : which == 1 ? Ks : Vs) + cc0;
#pragma unroll
        for (int i = 0; i < 8; ++i) { float acc[8];
#pragma unroll
            for (int e = 0; e < 8; ++e) acc[e] = 0.f;
#pragma unroll
            for (int j = 0; j < 4; ++j) { const u32x4 xv = xr[i + j];
#pragma unroll
                for (int e = 0; e < 4; ++e) { acc[2 * e] += wgt[j][2 * e] * bflo(xv[e]); acc[2 * e + 1] += wgt[j][2 * e + 1] * bfhi(xv[e]); } }
            f32x4 y0, y1;
#pragma unroll
            for (int e = 0; e < 4; ++e) { y0[e] = acc[e] * __builtin_amdgcn_rcpf(1.0f + __expf(-acc[e])); y1[e] = acc[4 + e] * __builtin_amdgcn_rcpf(1.0f + __expf(-acc[4 + e])); }
            *(f32x4*)(dstp + (8 * ts + i) * QS) = y0; *(f32x4*)(dstp + (8 * ts + i) * QS + 4) = y1; }
    }
    if (tid < 128) { const int d = tid >> 6, i = tid & 63; const size_t r = (size_t)(row0 + i) * NP;
        beta_s[d * 64 + i] = 1.0f / (1.0f + __expf(-bf2f(A.P[r + C_GB + d * NH + h])));
        g_s[d * 64 + i] = -__expf(A.a_log[d * NH + h]) * softplusf_(bf2f(A.P[r + C_GA + d * NH + h]) + A.dt_bias[d * NH + h]); }
    LDS_BARRIER();
    for (int rr = wid * 4 + (lane >> 4); rr < 2 * CH; rr += 32) { float* rowp = (rr < CH ? Qs : Ks) + (rr & 63) * QS + (lane & 15) * 8;
        f32x4 a = *(const f32x4*)rowp, b = *(const f32x4*)(rowp + 4); float ss = (a[0] * a[0] + a[1] * a[1]) + (a[2] * a[2] + a[3] * a[3]) + (b[0] * b[0] + b[1] * b[1]) + (b[2] * b[2] + b[3] * b[3]);
#pragma unroll
        for (int o = 1; o < 16; o <<= 1) ss += lane_xor(ss, o, lane);
        const float scl = __builtin_amdgcn_rsqf(ss + EPS) * (rr < CH ? 0.08838834764831845f : 1.0f);
        *(f32x4*)rowp = a * scl; *(f32x4*)(rowp + 4) = b * scl; }
    if (tid < 2) {
        f32x4 gv[16];
#pragma unroll
        for (int m = 0; m < 16; ++m) gv[m] = *(const f32x4*)(g_s + tid * 64 + 4 * m);
        float run = 0.f;
        if (tid == 0) {
#pragma unroll
            for (int m = 0; m < 16; ++m) { f32x4 o4;
#pragma unroll
                for (int e = 0; e < 4; ++e) { run += gv[m][e]; o4[e] = run; }
                *(f32x4*)(gc_s + 4 * m) = o4; }
        } else {
#pragma unroll
            for (int m = 15; m >= 0; --m) { f32x4 o4;
#pragma unroll
                for (int e = 3; e >= 0; --e) { run += gv[m][e]; o4[e] = run; }
                *(f32x4*)(gc_s + 64 + 4 * m) = o4; }
        }
    }
    LDS_BARRIER();
    float* eq_s = sm + 384; float* ek_s = sm + 512;
    if (tid < 128) { const int d = tid >> 6, i = tid & 63; const float gci = gc_s[d * 64 + i], glast = d == 0 ? gc_s[63] : gc_s[64];
        eq_s[tid] = __expf(gci); ek_s[tid] = __expf(glast - gci); }
    const int gwhich = wid >> 2, gI = (wid >> 1) & 1, gJ = wid & 1, r32 = lane & 31, hi = lane >> 5;
    f32x16 acc = {};
    if (!(A.pflags & 1024)) {
        const float* X = (gwhich ? Qs : Ks) + (32 * gI + r32) * QS + 4 * hi; const float* Yp = Ks + (32 * gJ + r32) * QS + 4 * hi;
#pragma unroll
        for (int s = 0; s < 16; ++s) { const f32x4 a4 = *(const f32x4*)(X + 8 * s), b4 = *(const f32x4*)(Yp + 8 * s);
#pragma unroll
            for (int e = 0; e < 4; ++e) acc = __builtin_amdgcn_mfma_f32_32x32x2f32(a4[e], b4[e], acc, 0, 0, 0); }
        const int j = 32 * gJ + r32;
        if (gwhich == 0) {
            const float b1j = beta_s[64 + j], g0j = gc_s[j], g1j = gc_s[64 + j];
#pragma unroll
            for (int r = 0; r < 16; ++r) { const int i = 32 * gI + (r & 3) + 8 * (r >> 2) + 4 * hi;
                if (i > j) { const float kk = acc[r];
                    AA[(63 - j) * AS + (63 - i)] = beta_s[i] * kk * __expf(gc_s[i] - g0j);
                    AA[CH * AS + i * AS + j] = b1j * kk * __expf(g1j - gc_s[64 + i]); } }
        }
    }
    LDS_BARRIER();
    const size_t t0 = ((size_t)cix * NH + h) * 2;
    if (!(A.pflags & 2048)) {
#pragma unroll
        for (int n = 0; n < 4; ++n) { const int it = tid + 512 * n, d = it >> 10, p = (it >> 4) & 63, m = it & 15, i = d == 0 ? p : 63 - p, k0 = 32 * (m >> 2) + 4 * (m & 3);
            const float e = eq_s[d * 64 + i]; const f32x4 lo = *(const f32x4*)(Qs + i * QS + k0), hi4 = *(const f32x4*)(Qs + i * QS + k0 + 16);
            *(u32x4*)(A.B.QD + (t0 + d) * SZ_QD + (size_t)p * 128 + m * 8) = (u32x4){pk2(lo[0] * e, lo[1] * e), pk2(lo[2] * e, lo[3] * e), pk2(hi4[0] * e, hi4[1] * e), pk2(hi4[2] * e, hi4[3] * e)}; }
#pragma unroll
        for (int n = 0; n < 4; ++n) { const int it = tid + 512 * n, k = it & 127, d = (it >> 7) & 1, m = it >> 8, p0 = 32 * (m >> 2) + 4 * (m & 3);
            float v[8];
#pragma unroll
            for (int jj = 0; jj < 8; ++jj) { const int p = p0 + (jj < 4 ? jj : 12 + jj), i = d == 0 ? p : 63 - p; v[jj] = Ks[i * QS + k] * ek_s[d * 64 + i]; }
            *(u32x4*)(A.B.KDT + (t0 + d) * SZ_KDT + (size_t)k * 64 + m * 8) = (u32x4){pk2(v[0], v[1]), pk2(v[2], v[3]), pk2(v[4], v[5]), pk2(v[6], v[7])}; }
        if (tid == 0) { A.B.GT[t0] = __expf(gc_s[63]); A.B.GT[t0 + 1] = __expf(gc_s[64]); }
    }
    LDS_BARRIER();
    bf16_t* stg = (bf16_t*)Qs;
    if (gwhich == 1) { const int j = 32 * gJ + r32; const float g0j = gc_s[j], g1j = gc_s[64 + j];
#pragma unroll
        for (int r = 0; r < 16; ++r) { const int i = 32 * gI + (r & 3) + 8 * (r >> 2) + 4 * hi; const float qk = acc[r];
            stg[i * 64 + perm32(j)] = f2bf(i >= j ? qk * __expf(gc_s[i] - g0j) : 0.f);
            stg[4096 + (63 - i) * 64 + perm32(63 - j)] = f2bf(i <= j ? qk * __expf(gc_s[64 + i] - g1j) : 0.f); } }
    LDS_BARRIER();
#pragma unroll
    for (int n = 0; n < 2; ++n) { const int c16 = tid + 512 * n; *(u32x4*)(A.B.QK + t0 * SZ_QK + (size_t)c16 * 8) = *(const u32x4*)(stg + c16 * 8); }
    if (!(A.pflags & 512)) {
        int tidv = tid; asm volatile("" : "+v"(tidv));
        const int d = tidv >> 8, c = tidv & 255; const bool isw = c >= 128; const int cc = c & 127;
        const float* src = isw ? Ks : Vs;
        int lz; asm volatile("v_mov_b32 %0, 0" : "=v"(lz));
        const float* AAv = AA + lz + d * (CH * AS);
        float x[CH];
#pragma unroll
        for (int p = 0; p < CH; ++p) { const int i = d == 0 ? p : 63 - p; float f = beta_s[d * 64 + i]; if (isw) f *= eq_s[d * 64 + i]; x[p] = f * src[i * QS + cc]; }
        {
#pragma unroll
            for (int p = 0; p < CH - 1; ++p) { const float xp = x[p]; const float* rowp = AAv + (63 - p) * AS;
#pragma unroll
                for (int m = 0; m <= (62 - p) / 4; ++m) { const f32x4 a4 = *(const f32x4*)(rowp + 4 * m);
#pragma unroll
                    for (int e = 0; e < 4; ++e) { const int col = 4 * m + e; if (col <= 62 - p) x[63 - col] -= a4[e] * xp; } } }
        }
        LDS_BARRIER();
        if (!isw) { bf16_t* dst = A.B.UT + (t0 + d) * SZ_UT + (size_t)((cc >> 4) * 2 * 64 + (cc & 15)) * 8;
#pragma unroll
            for (int s = 0; s < 2; ++s)
#pragma unroll
                for (int qq = 0; qq < 4; ++qq) { const int p0 = 32 * s + 4 * qq; u32x4 w4; w4.x = pk2(x[p0], x[p0 + 1]); w4.y = pk2(x[p0 + 2], x[p0 + 3]); w4.z = pk2(x[p0 + 16], x[p0 + 17]); w4.w = pk2(x[p0 + 18], x[p0 + 19]);
                    *(u32x4*)(dst + (size_t)(s * 64 + qq * 16) * 8) = w4; }
        } else { bf16_t* dst = stg + d * 8192 + perm32(cc);
#pragma unroll
            for (int p = 0; p < CH; ++p) dst[p * 128] = f2bf(x[p]); }
    }
    LDS_BARRIER();
#pragma unroll
    for (int n = 0; n < 4; ++n) { const int c16 = tid + 512 * n; *(u32x4*)(A.B.WP + t0 * SZ_WP + (size_t)c16 * 8) = *(const u32x4*)(stg + c16 * 8); }
}
__device__ __forceinline__ void g1_phase(const G1Args& A, char* lds, int G, int wg, const int tid) {
    for (int t = wg; t < NCHUNK * NH; t += G) g1_task(A, lds, t / NH, t % NH, tid);
}

constexpr int G2_SPLIT = 4, G2_NACT = 8 / G2_SPLIT, G2_NSTEP = CTX_LEN / CH + SEQ / CH, G2_WGS = BATCH * NH * 2 * G2_SPLIT;
constexpr int G2_USL = G2_NACT * 2 * 64 * 16;
constexpr int G2_BUF = 16384 + 16384 + G2_USL, G2_NB = 4, G2_LDS = G2_NB * G2_BUF;
static_assert(G2_SPLIT == 4 && G2_USL == 4096, "G2 staging map below assumes 4 KB of u per step");
__device__ __forceinline__ int g2_task_index(int b, int h, int d, int step) {
    constexpr int NC = CTX_LEN / CH, NL = SEQ / CH; int cix;
    if (step < NC) { const int n = d ? NC - 1 - step : step; cix = M_LAT / CH + b * NC + n; }
    else { const int s2 = step - NC, n = d ? NL - 1 - s2 : s2; cix = b * NL + n; }
    return (cix * NH + h) * 2 + d;
}
__device__ __forceinline__ void g2_chain(const Bufs& B, char* lds, int chain_part, const int tid_in, const int step_lo, const int step_hi, float* Ssave) {
    int tid_ = tid_in; asm volatile("" : "+v"(tid_));
    const int tid = tid_, wid = __builtin_amdgcn_readfirstlane(tid >> 6), lane = tid & 63, q = lane >> 4, vl = lane & 15;
    const int chain = chain_part / G2_SPLIT, part = chain_part % G2_SPLIT;
    const bool active = wid < G2_NACT; const int vt = part * G2_NACT + (active ? wid : 0);
    const int d = chain & 1, h = (chain >> 1) % NH, b = chain / (2 * NH);
    constexpr int NSTEP = CTX_LEN / CH + SEQ / CH;
    const unsigned ldsb = (unsigned)(uintptr_t)lds;
    f32x4 S[8];
    f32x4* sv = (f32x4*)Ssave + ((size_t)chain_part * G2_NACT + (active ? wid : 0)) * 8 * 64 + lane;
#pragma unroll
    for (int kb = 0; kb < 8; ++kb) S[kb] = (step_lo > 0 && active) ? sv[kb * 64] : (f32x4){0.f, 0.f, 0.f, 0.f};
    unsigned offw[2], offk[2], offu;
#pragma unroll
    for (int i = 0; i < 2; ++i) { const int sl = 128 * wid + 64 * i + lane;
        { const int row = sl >> 4, pc = sl & 15, c = pc ^ (row & 15); offw[i] = (unsigned)(row * 256 + c * 16); }
        { const int row = sl >> 3, pc = sl & 7, c = pc ^ ((row >> 1) & 7); offk[i] = (unsigned)(row * 128 + c * 16); } }
    offu = (unsigned)((part * G2_NACT * 2 * 64 + (wid & 3) * 64 + lane) * 16);
#define G2_DMA(ti, slot) do { const char* wp_ = (const char*)(B.WP + (size_t)(ti) * SZ_WP); const char* kp_ = (const char*)(B.KDT + (size_t)(ti) * SZ_KDT); const unsigned base_ = ldsb + (unsigned)(slot) * G2_BUF; \
        _Pragma("unroll") for (int i_ = 0; i_ < 2; ++i_) { \
            __builtin_amdgcn_global_load_lds((const unsigned*)(wp_ + offw[i_]), (ATT_LAS unsigned*)(base_ + (128 * wid + 64 * i_) * 16), 16, 0, 0); \
            __builtin_amdgcn_global_load_lds((const unsigned*)(kp_ + offk[i_]), (ATT_LAS unsigned*)(base_ + 16384 + (128 * wid + 64 * i_) * 16), 16, 0, 0); } \
        if (wid >= 4) __builtin_amdgcn_global_load_lds((const unsigned*)((const char*)(B.UT + (size_t)(ti) * SZ_UT) + offu), (ATT_LAS unsigned*)(base_ + 32768 + ((wid & 3) * 64) * 16), 16, 0, 0); } while (0)
#define G2_TI(step) g2_task_index(b, h, d, (step) < NSTEP ? (step) : NSTEP - 1)
    __syncthreads();
    G2_DMA(G2_TI(step_lo), step_lo & 3); G2_DMA(G2_TI(step_lo + 1), (step_lo + 1) & 3); G2_DMA(G2_TI(step_lo + 2), (step_lo + 2) & 3);
    asm volatile("s_waitcnt vmcnt(0)" ::: "memory");
    __syncthreads();
    for (int step = step_lo; step < step_hi; ++step) {
        const int ti = G2_TI(step), slot = step & 3;
        G2_DMA(G2_TI(step + 3), (step + 3) & 3);
        unsigned gtb; { const float* gp = B.GT + ti; asm volatile("s_load_dword %0, %1, 0x0" : "=s"(gtb) : "s"(gp)); }
        const char* wl = lds + slot * G2_BUF; const char* kl = wl + 16384; const char* ul = kl + 16384;
        if (active) {
            bf16x8 aw[16], ak[16];
#pragma unroll
            for (int rb = 0; rb < 4; ++rb)
#pragma unroll
                for (int s = 0; s < 4; ++s) aw[rb * 4 + s] = *(const bf16x8*)(wl + (16 * rb + vl) * 256 + (((4 * s + q) ^ vl) << 4));
#pragma unroll
            for (int kb = 0; kb < 8; ++kb)
#pragma unroll
                for (int s = 0; s < 2; ++s) ak[kb * 2 + s] = *(const bf16x8*)(kl + (16 * kb + vl) * 128 + (((4 * s + q) ^ ((vl >> 1) & 7)) << 4));
            u32x4 uu[2];
#pragma unroll
            for (int s = 0; s < 2; ++s) uu[s] = *(const u32x4*)(ul + ((wid * 2 + s) * 64 + lane) * 16);
            bf16_t* sit = B.SIT + (size_t)ti * SZ_SIT + (size_t)(vt * 4 * 64 + lane) * 8;
            bf16x8 sf[4];
#pragma unroll
            for (int s = 0; s < 4; ++s) { u32x4 w4; w4.x = pk2(S[2 * s][0], S[2 * s][1]); w4.y = pk2(S[2 * s][2], S[2 * s][3]); w4.z = pk2(S[2 * s + 1][0], S[2 * s + 1][1]); w4.w = pk2(S[2 * s + 1][2], S[2 * s + 1][3]);
                sf[s] = __builtin_bit_cast(bf16x8, w4); *(u32x4*)(sit + (size_t)s * 64 * 8) = w4; }
            __builtin_amdgcn_sched_barrier(0);
            f32x4 vn[4];
#pragma unroll
            for (int rb = 0; rb < 4; ++rb) vn[rb] = (f32x4){0.f, 0.f, 0.f, 0.f};
#pragma unroll
            for (int s = 0; s < 4; ++s)
#pragma unroll
                for (int rb = 0; rb < 4; ++rb) vn[rb] = __builtin_amdgcn_mfma_f32_16x16x32_bf16(aw[rb * 4 + s], sf[s], vn[rb], 0, 0, 0);
#pragma unroll
            for (int s = 0; s < 2; ++s) { const f32x4 a0 = vn[2 * s], a1 = vn[2 * s + 1];
                vn[2 * s][0] = bflo(uu[s].x) - a0[0]; vn[2 * s][1] = bfhi(uu[s].x) - a0[1]; vn[2 * s][2] = bflo(uu[s].y) - a0[2]; vn[2 * s][3] = bfhi(uu[s].y) - a0[3];
                vn[2 * s + 1][0] = bflo(uu[s].z) - a1[0]; vn[2 * s + 1][1] = bfhi(uu[s].z) - a1[1]; vn[2 * s + 1][2] = bflo(uu[s].w) - a1[2]; vn[2 * s + 1][3] = bfhi(uu[s].w) - a1[3]; }
            bf16_t* vnt = B.VNT + (size_t)ti * SZ_VNT + (size_t)(vt * 2 * 64 + lane) * 8;
            bf16x8 vf[2];
#pragma unroll
            for (int s = 0; s < 2; ++s) { u32x4 w4; w4.x = pk2(vn[2 * s][0], vn[2 * s][1]); w4.y = pk2(vn[2 * s][2], vn[2 * s][3]); w4.z = pk2(vn[2 * s + 1][0], vn[2 * s + 1][1]); w4.w = pk2(vn[2 * s + 1][2], vn[2 * s + 1][3]);
                vf[s] = __builtin_bit_cast(bf16x8, w4); *(u32x4*)(vnt + (size_t)s * 64 * 8) = w4; }
            asm volatile("s_waitcnt lgkmcnt(0)" ::: "memory");
            const float gt = __uint_as_float(gtb);
#pragma unroll
            for (int kb = 0; kb < 8; ++kb) S[kb] = S[kb] * gt;
#pragma unroll
            for (int s = 0; s < 2; ++s)
#pragma unroll
                for (int kb = 0; kb < 8; ++kb) S[kb] = __builtin_amdgcn_mfma_f32_16x16x32_bf16(ak[kb * 2 + s], vf[s], S[kb], 0, 0, 0);
            __builtin_amdgcn_sched_barrier(0);
            asm volatile("s_waitcnt vmcnt(26) lgkmcnt(0)\n\ts_barrier" ::: "memory");
        } else if (wid >= 4) {
            asm volatile("s_waitcnt vmcnt(10) lgkmcnt(0)\n\ts_barrier" ::: "memory");
        } else {
            asm volatile("s_waitcnt vmcnt(8) lgkmcnt(0)\n\ts_barrier" ::: "memory");
        }
    }
    if (step_hi < NSTEP && active) {
#pragma unroll
        for (int kb = 0; kb < 8; ++kb) sv[kb * 64] = S[kb]; }
    asm volatile("s_waitcnt vmcnt(0)" ::: "memory");
    __syncthreads();
#undef G2_DMA
#undef G2_TI
}

constexpr int G3_OS = 132, G3_LDS = 64 * G3_OS * 4;
struct G3Args { Bufs B; const bf16_t* P; const float* norm_g; bf16_t* Y; };
__device__ __forceinline__ void g3_task(const G3Args& A, char* lds, int cix, int h, const int tid_in) {
    int tid_ = tid_in; asm volatile("" : "+v"(tid_));
    const int tid = tid_, wid = __builtin_amdgcn_readfirstlane(tid >> 6), lane = tid & 63, q = lane >> 4, vl = lane & 15;
    f32x4 o[2][4];
#pragma unroll
    for (int d = 0; d < 2; ++d) {
        const size_t t = ((size_t)cix * NH + h) * 2 + d;
        const bf16_t* sit = A.B.SIT + t * SZ_SIT + (size_t)(wid * 4 * 64 + lane) * 8;
        const bf16_t* vnt = A.B.VNT + t * SZ_VNT + (size_t)(wid * 2 * 64 + lane) * 8;
        const bf16_t* qd = A.B.QD + t * SZ_QD + (size_t)vl * 128 + 8 * q;
        const bf16_t* qk = A.B.QK + t * SZ_QK + (size_t)vl * 64 + 8 * q;
        bf16x8 sf[4], vf[2];
#pragma unroll
        for (int s = 0; s < 4; ++s) sf[s] = *(const bf16x8*)(sit + (size_t)s * 64 * 8);
#pragma unroll
        for (int s = 0; s < 2; ++s) vf[s] = *(const bf16x8*)(vnt + (size_t)s * 64 * 8);
#pragma unroll
        for (int rb = 0; rb < 4; ++rb) { f32x4 acc = {0.f, 0.f, 0.f, 0.f};
#pragma unroll
            for (int s = 0; s < 4; ++s) acc = __builtin_amdgcn_mfma_f32_16x16x32_bf16(*(const bf16x8*)(qd + (size_t)rb * 16 * 128 + 32 * s), sf[s], acc, 0, 0, 0);
#pragma unroll
            for (int s = 0; s < 2; ++s) acc = __builtin_amdgcn_mfma_f32_16x16x32_bf16(*(const bf16x8*)(qk + (size_t)rb * 16 * 64 + 32 * s), vf[s], acc, 0, 0, 0);
            o[d][rb] = acc; }
    }
    f32x4 ot[4];
#pragma unroll
    for (int rb = 0; rb < 4; ++rb)
#pragma unroll
        for (int r = 0; r < 4; ++r) ot[rb][r] = o[0][rb][r] + lane_xor(o[1][3 - rb][3 - r], 48, lane);
    float* Ot = (float*)lds;
    LDS_BARRIER();
#pragma unroll
    for (int rb = 0; rb < 4; ++rb)
#pragma unroll
        for (int r = 0; r < 4; ++r) Ot[(16 * rb + 4 * q + r) * G3_OS + 16 * wid + vl] = ot[rb][r];
    LDS_BARRIER();
#pragma unroll
    for (int n = 0; n < 2; ++n) { const int item = tid + 512 * n, tok = item >> 4, c8 = (item & 15) * 8;
        const f32x4 o0 = *(const f32x4*)(Ot + tok * G3_OS + c8), o1 = *(const f32x4*)(Ot + tok * G3_OS + c8 + 4);
        float ss = (o0[0] * o0[0] + o0[1] * o0[1]) + (o0[2] * o0[2] + o0[3] * o0[3]) + (o1[0] * o1[0] + o1[1] * o1[1]) + (o1[2] * o1[2] + o1[3] * o1[3]);
#pragma unroll
        for (int of = 1; of < 16; of <<= 1) ss += lane_xor(ss, of, lane);
        const float rstd = __builtin_amdgcn_rsqf(ss * (1.0f / HD) + EPS);
        const f32x4 g0 = *(const f32x4*)(A.norm_g + c8), g1 = *(const f32x4*)(A.norm_g + c8 + 4);
        const size_t row = (size_t)cix * CH + tok; const u32x4 gw = *(const u32x4*)(A.P + row * NP + C_GG + h * HD + c8);
        float y[8];
#pragma unroll
        for (int e = 0; e < 4; ++e) { const float ga = bflo(gw[e]), gb = bfhi(gw[e]); const float oa = e < 2 ? o0[2 * e] : o1[2 * e - 4], ob = e < 2 ? o0[2 * e + 1] : o1[2 * e - 3];
            const float na = e < 2 ? g0[2 * e] : g1[2 * e - 4], nb = e < 2 ? g0[2 * e + 1] : g1[2 * e - 3];
            y[2 * e] = oa * rstd * na * (ga * __builtin_amdgcn_rcpf(1.0f + __expf(-ga))); y[2 * e + 1] = ob * rstd * nb * (gb * __builtin_amdgcn_rcpf(1.0f + __expf(-gb))); }
        *(u32x4*)(A.Y + row * D_MODEL + 2 * GROUP_W + h * HD + c8) = (u32x4){pk2(y[0], y[1]), pk2(y[2], y[3]), pk2(y[4], y[5]), pk2(y[6], y[7])};
    }
}
__device__ __forceinline__ void g3_phase(const G3Args& A, char* lds, int G, int wg, const int tid) {
    for (int t = wg; t < NCHUNK * NH; t += G) g3_task(A, lds, t / NH, t % NH, tid);
}
}

namespace lru {
typedef short bf16x8 __attribute__((ext_vector_type(8)));
typedef float f32x4 __attribute__((ext_vector_type(4)));
typedef unsigned u32x2 __attribute__((ext_vector_type(2)));
typedef unsigned u32x4 __attribute__((ext_vector_type(4)));
constexpr int CH = 64, NCHUNK = M_ALL / CH;
constexpr int US = 129;
constexpr int UBS = 272;
constexpr int L_OFF_U = 0, L_OFF_UB = CH * US * 4, L_LDS = L_OFF_UB + CH * UBS;
constexpr size_t SZ_WBLK = (size_t)LRU_BW * LRU_BW;
struct Bufs { bf16_t* HLOC; bf16_t* ACUM; float* LSUM; float* HIN; };
struct LocalArgs { const bf16_t* P; const float* conv_w; const float* conv_b; const bf16_t* WG;   const float* ba; const float* bx; const float* lam; Bufs B; };

__device__ __forceinline__ unsigned pk2(float lo, float hi) { return (unsigned)f2bf(lo) | ((unsigned)f2bf(hi) << 16); }

__device__ __forceinline__ void local_task(const LocalArgs& A, char* lds, int cix, int nb, const int tid_in) {
    int tid_ = tid_in; asm volatile("" : "+v"(tid_));
    const int tid = tid_, wid = __builtin_amdgcn_readfirstlane(tid >> 6), lane = tid & 63, q = lane >> 4, tl = lane & 15;
    float* Us = (float*)(lds + L_OFF_U); char* Ub = lds + L_OFF_UB;
    const int row0 = cix * CH; const RowInfo r0i = row_info(row0);
    LDS_BARRIER();
    {
        const int grp = tid & 15, t2 = tid >> 4, c0 = grp * 8, ch0 = nb * LRU_BW + c0;
        float wgt[4][8], bia[8];
#pragma unroll
        for (int j = 0; j < 4; ++j) { const f32x4 w0 = *(const f32x4*)(A.conv_w + j * LRU_W + ch0), w1 = *(const f32x4*)(A.conv_w + j * LRU_W + ch0 + 4);
#pragma unroll
            for (int e = 0; e < 4; ++e) { wgt[j][e] = w0[e]; wgt[j][4 + e] = w1[e]; } }
        { const f32x4 b0 = *(const f32x4*)(A.conv_b + ch0), b1 = *(const f32x4*)(A.conv_b + ch0 + 4);
#pragma unroll
          for (int e = 0; e < 4; ++e) { bia[e] = b0[e]; bia[4 + e] = b1[e]; } }
        u32x4 xr[5];
#pragma unroll
        for (int k = 0; k < 5; ++k) { const int tt = r0i.t + 2 * t2 + k - 1;
            xr[k] = (tt >= 0 && tt < r0i.T) ? *(const u32x4*)(A.P + (size_t)(r0i.base + tt) * NP + C_LRU_X + ch0) : (u32x4){0u, 0u, 0u, 0u}; }
#pragma unroll
        for (int i = 0; i < 2; ++i) { float acc[8];
#pragma unroll
            for (int e = 0; e < 8; ++e) acc[e] = bia[e];
#pragma unroll
            for (int j = 0; j < 4; ++j) { const u32x4 xv = xr[i + j];
#pragma unroll
                for (int e = 0; e < 4; ++e) { acc[2 * e] += wgt[j][2 * e] * bflo(xv[e]); acc[2 * e + 1] += wgt[j][2 * e + 1] * bfhi(xv[e]); } }
            const int tok = 2 * t2 + i;
#pragma unroll
            for (int e = 0; e < 8; ++e) Us[tok * US + c0 + e] = acc[e];
            *(u32x4*)(Ub + tok * UBS + c0 * 2) = (u32x4){pk2(acc[0], acc[1]), pk2(acc[2], acc[3]), pk2(acc[4], acc[5]), pk2(acc[6], acc[7])}; }
    }
    LDS_BARRIER();
    f32x4 acc[2][2][4];
#pragma unroll
    for (int d = 0; d < 2; ++d)
#pragma unroll
        for (int wh = 0; wh < 2; ++wh)
#pragma unroll
            for (int tb = 0; tb < 4; ++tb) acc[d][wh][tb] = (f32x4){0.f, 0.f, 0.f, 0.f};
#pragma unroll
    for (int s = 0; s < 4; ++s) {
        bf16x8 bfr[4];
#pragma unroll
        for (int tb = 0; tb < 4; ++tb) bfr[tb] = *(const bf16x8*)(Ub + (16 * tb + tl) * UBS + (32 * s + 8 * q) * 2);
#pragma unroll
        for (int d = 0; d < 2; ++d)
#pragma unroll
            for (int wh = 0; wh < 2; ++wh) { const bf16x8 a = *(const bf16x8*)(A.WG + ((size_t)((d * 2 + wh) * NH + nb)) * SZ_WBLK + (size_t)(16 * wid + tl) * LRU_BW + 32 * s + 8 * q);
#pragma unroll
                for (int tb = 0; tb < 4; ++tb) acc[d][wh][tb] = __builtin_amdgcn_mfma_f32_16x16x32_bf16(a, bfr[tb], acc[d][wh][tb], 0, 0, 0); }
    }
    const int chb = nb * LRU_BW + 16 * wid + 4 * q;
#pragma unroll
    for (int d = 0; d < 2; ++d) {
        float sp[4], bav[4], bxv[4];
#pragma unroll
        for (int r = 0; r < 4; ++r) { sp[r] = -LRU_C * softplusf_(-A.lam[d * LRU_W + chb + r]); bav[r] = A.ba[d * LRU_W + chb + r]; bxv[r] = A.bx[d * LRU_W + chb + r]; }
        float Ac[4], Bc[4];
#pragma unroll
        for (int r = 0; r < 4; ++r) { Ac[r] = 1.f; Bc[r] = 0.f; }
#pragma unroll
        for (int tbi = 0; tbi < 4; ++tbi) { const int tb = d == 0 ? tbi : 3 - tbi; const int tok = 16 * tb + tl;
            float a[4], b[4];
#pragma unroll
            for (int r = 0; r < 4; ++r) { const float rr = __builtin_amdgcn_rcpf(1.0f + __expf(-(acc[d][0][tb][r] + bav[r]))), ii = __builtin_amdgcn_rcpf(1.0f + __expf(-(acc[d][1][tb][r] + bxv[r])));
                const float log_a = sp[r] * rr, x2 = 2.0f * log_a; a[r] = __expf(log_a);
                float em = 1.0f + x2 * (1.0f / 6.0f); em = 1.0f + x2 * 0.2f * em; em = 1.0f + x2 * 0.25f * em; em = 1.0f + x2 * (1.0f / 3.0f) * em; em = 1.0f + x2 * 0.5f * em; em = -x2 * em;
                if (__builtin_expect(x2 < -0.25f, 0)) em = -expm1f(x2);
                b[r] = __builtin_amdgcn_sqrtf(em) * ii * Us[tok * US + 16 * wid + 4 * q + r]; }
#define LRU_SCAN_STEP(CTRL) do { _Pragma("unroll") for (int r = 0; r < 4; ++r) { \
                const float ap = __int_as_float(__builtin_amdgcn_update_dpp(0x3f800000, __float_as_int(a[r]), (CTRL), 0xf, 0xf, false)); \
                const float bp = __int_as_float(__builtin_amdgcn_update_dpp(0, __float_as_int(b[r]), (CTRL), 0xf, 0xf, false)); \
                b[r] = a[r] * bp + b[r]; a[r] = a[r] * ap; } } while (0)
            if (d == 0) { LRU_SCAN_STEP(0x111); LRU_SCAN_STEP(0x112); LRU_SCAN_STEP(0x114); LRU_SCAN_STEP(0x118); }
            else        { LRU_SCAN_STEP(0x101); LRU_SCAN_STEP(0x102); LRU_SCAN_STEP(0x104); LRU_SCAN_STEP(0x108); }
#undef LRU_SCAN_STEP
#pragma unroll
            for (int r = 0; r < 4; ++r) { b[r] = a[r] * Bc[r] + b[r]; a[r] = a[r] * Ac[r]; }
            { const size_t o = ((size_t)d * M_ALL + row0 + tok) * LRU_W + chb;
              *(u32x2*)(A.B.HLOC + o) = (u32x2){pk2(b[0], b[1]), pk2(b[2], b[3])}; *(u32x2*)(A.B.ACUM + o) = (u32x2){pk2(a[0], a[1]), pk2(a[2], a[3])}; }
#pragma unroll
            for (int r = 0; r < 4; ++r) { const int sl = (lane & ~15) | (d == 0 ? 15 : 0); Ac[r] = lane_get(a[r], sl); Bc[r] = lane_get(b[r], sl); }
        }
        if (tl == 0) { float* ls = A.B.LSUM + (((size_t)cix * 2 + d) * 2) * LRU_W + chb;
            *(f32x4*)ls = (f32x4){Ac[0], Ac[1], Ac[2], Ac[3]}; *(f32x4*)(ls + LRU_W) = (f32x4){Bc[0], Bc[1], Bc[2], Bc[3]}; }
    }
}
__device__ __forceinline__ void local_phase(const LocalArgs& A, char* lds, int G, int wg, const int tid) {
    for (int j = wg; j < 2 * NCHUNK * NH; j += G) if (j >= NCHUNK * NH) { const int t = j - NCHUNK * NH; local_task(A, lds, t / NH, t % NH, tid); }
}
__device__ __forceinline__ void carry_phase(const Bufs& B, int gtid, int gthreads) {
    constexpr int NC = CTX_LEN / CH, NL = SEQ / CH;
    for (int i = gtid; i < BATCH * 2 * LRU_W; i += gthreads) { const int ch = i % LRU_W, d = (i / LRU_W) & 1, b = i / (2 * LRU_W);
        float h = 0.f;
        for (int s0 = 0; s0 < NC + NL; s0 += 12) {
            float av[12], bv[12]; int cx[12];
#pragma unroll
            for (int u = 0; u < 12; ++u) { const int step = s0 + u; int cix = 0;
                if (step < NC) { const int n = d ? NC - 1 - step : step; cix = M_LAT / CH + b * NC + n; }
                else if (step < NC + NL) { const int s2 = step - NC, n = d ? NL - 1 - s2 : s2; cix = b * NL + n; }
                cx[u] = cix; const float* ls = B.LSUM + (((size_t)cix * 2 + d) * 2) * LRU_W + ch; av[u] = ls[0]; bv[u] = ls[LRU_W]; }
#pragma unroll
            for (int u = 0; u < 12; ++u) if (s0 + u < NC + NL) { B.HIN[((size_t)cx[u] * 2 + d) * LRU_W + ch] = h; h = av[u] * h + bv[u]; }
        }
    }
}
__device__ __forceinline__ void finish_phase(const Bufs& B, const bf16_t* P, bf16_t* Y, int gtid, int gthreads) {
    for (int it = gtid; it < M_ALL * (LRU_W / 8); it += gthreads) { const int row = it / (LRU_W / 8), c0 = (it % (LRU_W / 8)) * 8, cix = row / CH;
        const u32x4 h0 = *(const u32x4*)(B.HLOC + (size_t)row * LRU_W + c0), a0 = *(const u32x4*)(B.ACUM + (size_t)row * LRU_W + c0);
        const u32x4 h1 = *(const u32x4*)(B.HLOC + ((size_t)M_ALL + row) * LRU_W + c0), a1 = *(const u32x4*)(B.ACUM + ((size_t)M_ALL + row) * LRU_W + c0);
        const u32x4 gt = *(const u32x4*)(P + (size_t)row * NP + C_LRU_G + c0);
        const float* i0 = B.HIN + ((size_t)cix * 2 + 0) * LRU_W + c0; const float* i1 = B.HIN + ((size_t)cix * 2 + 1) * LRU_W + c0;
        const f32x4 i0a = *(const f32x4*)i0, i0b = *(const f32x4*)(i0 + 4), i1a = *(const f32x4*)i1, i1b = *(const f32x4*)(i1 + 4);
        float y[8];
#pragma unroll
        for (int j = 0; j < 4; ++j) { const unsigned hw0 = h0[j], aw0 = a0[j], hw1 = h1[j], aw1 = a1[j], gw = gt[j];
            const float in0l = j < 2 ? i0a[2 * j] : i0b[2 * j - 4], in0h = j < 2 ? i0a[2 * j + 1] : i0b[2 * j - 3], in1l = j < 2 ? i1a[2 * j] : i1b[2 * j - 4], in1h = j < 2 ? i1a[2 * j + 1] : i1b[2 * j - 3];
            y[2 * j] = (bflo(hw0) + bflo(aw0) * in0l + bflo(hw1) + bflo(aw1) * in1l) * geluf_(bflo(gw));
            y[2 * j + 1] = (bfhi(hw0) + bfhi(aw0) * in0h + bfhi(hw1) + bfhi(aw1) * in1h) * geluf_(bfhi(gw)); }
        *(u32x4*)(Y + (size_t)row * D_MODEL + c0) = (u32x4){pk2(y[0], y[1]), pk2(y[2], y[3]), pk2(y[4], y[5]), pk2(y[6], y[7])};
    }
}
}

namespace misc {
typedef float f32x4 __attribute__((ext_vector_type(4)));
typedef unsigned u32x2 __attribute__((ext_vector_type(2)));
typedef unsigned u32x4 __attribute__((ext_vector_type(4)));
__device__ __forceinline__ unsigned pk2(float lo, float hi) { return (unsigned)f2bf(lo) | ((unsigned)f2bf(hi) << 16); }
__device__ __forceinline__ float wave_sum(float v, int lane) {
#pragma unroll
    for (int o = 1; o < 64; o <<= 1) v += lane_xor(v, o, lane);
    return v;
}
__device__ __forceinline__ float sum16(float v, int lane) {
#pragma unroll
    for (int o = 1; o < 16; o <<= 1) v += lane_xor(v, o, lane);
    return v;
}
__device__ __forceinline__ void norm_phase(float* H, const float* g, const float* MODl, int sh_idx, bf16_t* U, int nrows, int gwave, int nwaves, int lane,
                                           const float* PART, int nparts, const float* pgate, const float* xin, const float* cin) {
    static_assert(D_MODEL == 2048, "norm_phase geometry");
    for (int r = gwave; r < nrows; r += nwaves) {
        const int set = r < M_LAT ? r / SEQ : BATCH;
        f32x4* hr = (f32x4*)(H + (size_t)r * D_MODEL) + lane;
        const f32x4* src = xin == nullptr ? hr : (r < M_LAT ? (const f32x4*)(xin + (size_t)r * D_MODEL) + lane : (const f32x4*)(cin + (size_t)(r - M_LAT) * D_MODEL) + lane);
        f32x4 v[8]; float ss = 0.f;
#pragma unroll
        for (int j = 0; j < 8; ++j) v[j] = src[64 * j];
        if (xin != nullptr && r >= M_LAT) {
#pragma unroll
            for (int j = 0; j < 8; ++j) hr[64 * j] = v[j]; }
        if (PART != nullptr && r >= M_LAT) {
            const f32x4* gp = (const f32x4*)pgate + lane;
#pragma unroll
            for (int j = 0; j < 8; ++j) { f32x4 acc = {0.f, 0.f, 0.f, 0.f};
                for (int s = 0; s < nparts; ++s) acc += *((const f32x4*)(PART + ((size_t)s * M_CTX + (r - M_LAT)) * D_MODEL) + lane + 64 * j);
                v[j] += gp[64 * j] * acc; hr[64 * j] = v[j]; }
        }
#pragma unroll
        for (int j = 0; j < 8; ++j) ss += (v[j][0] * v[j][0] + v[j][1] * v[j][1]) + (v[j][2] * v[j][2] + v[j][3] * v[j][3]);
        const float rstd = 1.0f / sqrtf(wave_sum(ss, lane) * (1.0f / D_MODEL) + EPS);
        const f32x4* gp = (const f32x4*)g + lane; const f32x4* shp = (const f32x4*)(MODl + (size_t)set * NMODV + (size_t)sh_idx * D_MODEL) + lane; const f32x4* scp = shp + D_MODEL / 4;
        u32x2* o = (u32x2*)(U + (size_t)r * D_MODEL) + lane;
#pragma unroll
        for (int j = 0; j < 8; ++j) { const f32x4 gg = gp[64 * j], sh = shp[64 * j], sc = scp[64 * j]; f32x4 y;
#pragma unroll
            for (int e = 0; e < 4; ++e) y[e] = v[j][e] * rstd * gg[e] * (1.0f + sc[e]) + sh[e];
            o[64 * j] = (u32x2){pk2(y[0], y[1]), pk2(y[2], y[3])}; }
    }
}
struct RowNormArgs { const bf16_t* P; const float *qa_g, *kva_g, *na_qn_g, *na_kn_g; bf16_t *CQN, *CKVN, *NQ, *NK; };
__device__ __forceinline__ void rownorm_phase(const RowNormArgs& A, int gwave, int nwaves, int lane) {
    static_assert(MLA_Q_LORA == 384 && MLA_KV_LORA == 256 && GROUP_W == 512 && HD == 128, "rownorm geometry");
    for (int r = gwave; r < M_ALL; r += nwaves) { const bf16_t* p = A.P + (size_t)r * NP;
        { float x[6], ss = 0.f;
#pragma unroll
          for (int j = 0; j < 3; ++j) { const unsigned w = *(const unsigned*)(p + C_CQ + 2 * lane + 128 * j); x[2 * j] = bflo(w); x[2 * j + 1] = bfhi(w); ss += x[2 * j] * x[2 * j] + x[2 * j + 1] * x[2 * j + 1]; }
          const float rstd = 1.0f / sqrtf(wave_sum(ss, lane) * (1.0f / MLA_Q_LORA) + EPS);
#pragma unroll
          for (int j = 0; j < 3; ++j) { const int c = 2 * lane + 128 * j; *(unsigned*)(A.CQN + (size_t)r * MLA_Q_LORA + c) = pk2(x[2 * j] * rstd * A.qa_g[c], x[2 * j + 1] * rstd * A.qa_g[c + 1]); } }
        { float x[4], ss = 0.f;
#pragma unroll
          for (int j = 0; j < 2; ++j) { const unsigned w = *(const unsigned*)(p + C_CKV + 2 * lane + 128 * j); x[2 * j] = bflo(w); x[2 * j + 1] = bfhi(w); ss += x[2 * j] * x[2 * j] + x[2 * j + 1] * x[2 * j + 1]; }
          const float rstd = 1.0f / sqrtf(wave_sum(ss, lane) * (1.0f / MLA_KV_LORA) + EPS);
#pragma unroll
          for (int j = 0; j < 2; ++j) { const int c = 2 * lane + 128 * j; *(unsigned*)(A.CKVN + (size_t)r * MLA_KV_LORA + c) = pk2(x[2 * j] * rstd * A.kva_g[c], x[2 * j + 1] * rstd * A.kva_g[c + 1]); } }
#pragma unroll
        for (int which = 0; which < 2; ++which) {
            const int hh = lane >> 4, d0 = (lane & 15) * 8; const u32x4 w = *(const u32x4*)(p + (which == 0 ? C_NQ : C_NK) + hh * HD + d0);
            float x[8]; float ss = 0.f;
#pragma unroll
            for (int j = 0; j < 4; ++j) { x[2 * j] = bflo(w[j]); x[2 * j + 1] = bfhi(w[j]); ss += x[2 * j] * x[2 * j] + x[2 * j + 1] * x[2 * j + 1]; }
            const float rstd = 1.0f / sqrtf(sum16(ss, lane) * (1.0f / HD) + EPS); const float* g = (which == 0 ? A.na_qn_g : A.na_kn_g) + d0;
            *(u32x4*)((which == 0 ? A.NQ : A.NK) + (size_t)r * GROUP_W + hh * HD + d0) =
                (u32x4){pk2(x[0] * rstd * g[0], x[1] * rstd * g[1]), pk2(x[2] * rstd * g[2], x[3] * rstd * g[3]), pk2(x[4] * rstd * g[4], x[5] * rstd * g[5]), pk2(x[6] * rstd * g[6], x[7] * rstd * g[7])};
        }
    }
}
struct MlaQkvArgs { const bf16_t* QR; const bf16_t* KVR; const bf16_t* P; const float *qn_g, *kn_g; bf16_t *QM, *KM, *VM; };
__device__ __forceinline__ void mlaqkv_phase(const MlaQkvArgs& A, int gwave, int nwaves, int lane) {
    static_assert(MLA_QK == 192 && MLA_NOPE == 128 && MLA_ROPE == 64 && NH == 4 && GRID_W == 64, "mla qkv geometry");
    const int hh = lane >> 4, g = lane & 15;
    const int f0 = (2 * g) & 15; const float inv0 = powf(10000.0f, -(float)f0 / 16.0f), inv1 = powf(10000.0f, -(float)(f0 + 1) / 16.0f);
    for (int r = gwave; r < M_ALL; r += nwaves) {
        const bool lat = r < M_LAT; const int t = lat ? r % SEQ : 0; const float pos = g < 8 ? (float)(t / GRID_W) : (float)(t % GRID_W);
        float c0 = 1.f, s0 = 0.f, c1 = 1.f, s1 = 0.f;
        if (lat) { sincosf(pos * inv0, &s0, &c0); sincosf(pos * inv1, &s1, &c1); }
#pragma unroll
        for (int which = 0; which < 2; ++which) {
            const bf16_t* nsrc = which == 0 ? A.QR + (size_t)r * NQ_MLA + hh * MLA_QK : A.KVR + (size_t)r * NKV_MLA + hh * (MLA_NOPE + MLA_V);
            const bf16_t* rsrc = which == 0 ? nsrc + MLA_NOPE : A.P + (size_t)r * NP + C_KR;
            const u32x4 nw = *(const u32x4*)(nsrc + 8 * g); const unsigned ra = *(const unsigned*)(rsrc + 2 * g), rb = *(const unsigned*)(rsrc + 32 + 2 * g);
            float x[8], a0 = bflo(ra), a1 = bfhi(ra), b0 = bflo(rb), b1 = bfhi(rb);
            float ss = a0 * a0 + a1 * a1 + b0 * b0 + b1 * b1;
#pragma unroll
            for (int j = 0; j < 4; ++j) { x[2 * j] = bflo(nw[j]); x[2 * j + 1] = bfhi(nw[j]); ss += x[2 * j] * x[2 * j] + x[2 * j + 1] * x[2 * j + 1]; }
            const float rstd = __builtin_amdgcn_rsqf(sum16(ss, lane) * (1.0f / MLA_QK) + EPS); const float* gn = which == 0 ? A.qn_g : A.kn_g;
            const f32x4 g0 = *(const f32x4*)(gn + 8 * g), g1 = *(const f32x4*)(gn + 8 * g + 4);
#pragma unroll
            for (int j = 0; j < 4; ++j) { x[j] *= rstd * g0[j]; x[4 + j] *= rstd * g1[j]; }
            a0 *= rstd * gn[MLA_NOPE + 2 * g]; a1 *= rstd * gn[MLA_NOPE + 2 * g + 1]; b0 *= rstd * gn[MLA_NOPE + 32 + 2 * g]; b1 *= rstd * gn[MLA_NOPE + 32 + 2 * g + 1];
            const float ya0 = a0 * c0 - b0 * s0, yb0 = a0 * s0 + b0 * c0, ya1 = a1 * c1 - b1 * s1, yb1 = a1 * s1 + b1 * c1;
            bf16_t* O = (which == 0 ? A.QM : A.KM) + (size_t)r * NQ_MLA + hh * MLA_QK;
            *(u32x4*)(O + 8 * g) = (u32x4){pk2(x[0], x[1]), pk2(x[2], x[3]), pk2(x[4], x[5]), pk2(x[6], x[7])};
            *(unsigned*)(O + MLA_NOPE + 2 * g) = pk2(ya0, ya1); *(unsigned*)(O + MLA_NOPE + 32 + 2 * g) = pk2(yb0, yb1);
        }
        *(u32x4*)(A.VM + (size_t)r * (NH * MLA_V) + hh * MLA_V + 8 * g) = *(const u32x4*)(A.KVR + (size_t)r * NKV_MLA + hh * (MLA_NOPE + MLA_V) + MLA_NOPE + 8 * g);
    }
}
constexpr int ACT_RUN = 32;
__device__ __forceinline__ void act_phase(const bf16_t* UP, const float* cw, const float* cb, bf16_t* ACT, int nrows, int gtid, int gthreads) {
    constexpr int NC8 = D_FF / 8; static_assert(SEQ % ACT_RUN == 0 && CTX_LEN % ACT_RUN == 0, "row runs stay inside one sequence");
    const int nruns = nrows / ACT_RUN;
    for (long it = gtid; it < (long)nruns * NC8; it += gthreads) { const int run = (int)(it / NC8), j0 = (int)(it % NC8) * 8, r0 = run * ACT_RUN; const RowInfo ri = row_info(r0);
        float wa[3][8], wg[3][8], ba[8], bg[8];
#pragma unroll
        for (int k = 0; k < 3; ++k) { const float* p = cw + (size_t)k * 2 * D_FF + j0; const f32x4 a0 = *(const f32x4*)p, a1 = *(const f32x4*)(p + 4), g0 = *(const f32x4*)(p + D_FF), g1 = *(const f32x4*)(p + D_FF + 4);
#pragma unroll
            for (int e = 0; e < 4; ++e) { wa[k][e] = a0[e]; wa[k][4 + e] = a1[e]; wg[k][e] = g0[e]; wg[k][4 + e] = g1[e]; } }
        { const f32x4 a0 = *(const f32x4*)(cb + j0), a1 = *(const f32x4*)(cb + j0 + 4), g0 = *(const f32x4*)(cb + D_FF + j0), g1 = *(const f32x4*)(cb + D_FF + j0 + 4);
#pragma unroll
          for (int e = 0; e < 4; ++e) { ba[e] = a0[e]; ba[4 + e] = a1[e]; bg[e] = g0[e]; bg[4 + e] = g1[e]; } }
        const u32x4 zero = {0u, 0u, 0u, 0u};
        const bf16_t* ub = UP + (size_t)ri.base * (2 * D_FF) + j0;
        u32x4 am, ac, gm, gc;
        { const int t = ri.t; am = t > 0 ? *(const u32x4*)(ub + (size_t)(t - 1) * (2 * D_FF)) : zero; gm = t > 0 ? *(const u32x4*)(ub + (size_t)(t - 1) * (2 * D_FF) + D_FF) : zero;
          ac = *(const u32x4*)(ub + (size_t)t * (2 * D_FF)); gc = *(const u32x4*)(ub + (size_t)t * (2 * D_FF) + D_FF); }
#pragma unroll 4
        for (int i = 0; i < ACT_RUN; ++i) { const int t = ri.t + i;
            const u32x4 ap = t + 1 < ri.T ? *(const u32x4*)(ub + (size_t)(t + 1) * (2 * D_FF)) : zero, gp = t + 1 < ri.T ? *(const u32x4*)(ub + (size_t)(t + 1) * (2 * D_FF) + D_FF) : zero;
            float y[8];
#pragma unroll
            for (int e = 0; e < 4; ++e) {
                const float a0 = ba[2 * e] + wa[0][2 * e] * bflo(am[e]) + wa[1][2 * e] * bflo(ac[e]) + wa[2][2 * e] * bflo(ap[e]);
                const float a1 = ba[2 * e + 1] + wa[0][2 * e + 1] * bfhi(am[e]) + wa[1][2 * e + 1] * bfhi(ac[e]) + wa[2][2 * e + 1] * bfhi(ap[e]);
                const float g0 = bg[2 * e] + wg[0][2 * e] * bflo(gm[e]) + wg[1][2 * e] * bflo(gc[e]) + wg[2][2 * e] * bflo(gp[e]);
                const float g1 = bg[2 * e + 1] + wg[0][2 * e + 1] * bfhi(gm[e]) + wg[1][2 * e + 1] * bfhi(gc[e]) + wg[2][2 * e + 1] * bfhi(gp[e]);
                y[2 * e] = a0 * (g0 / (1.0f + __expf(-g0))); y[2 * e + 1] = a1 * (g1 / (1.0f + __expf(-g1))); }
            *(u32x4*)(ACT + (size_t)(r0 + i) * D_FF + j0) = (u32x4){pk2(y[0], y[1]), pk2(y[2], y[3]), pk2(y[4], y[5]), pk2(y[6], y[7])};
            am = ac; ac = ap; gm = gc; gc = gp; }
    }
}
__device__ __forceinline__ void transpose_item(const float* W, int K, int N, int Npad, bf16_t* WT, float* scr, int item, int lane) {
    const int nblk = Npad / 32, kb = item / nblk, nb = item % nblk, k0 = 64 * kb, n0 = 32 * nb; const int n = n0 + (lane & 31); const bool ok = n < N;
#pragma unroll 8
    for (int i = 0; i < 32; ++i) { const int kk = 2 * i + (lane >> 5); scr[kk * 33 + (lane & 31)] = ok ? W[(size_t)(k0 + kk) * N + n] : 0.f; }
    asm volatile("s_waitcnt lgkmcnt(0)" ::: "memory");
    const int c = lane & 7;
#pragma unroll
    for (int j = 0; j < 4; ++j) { const int nn = (lane >> 3) + 8 * j; const float* s = scr + (8 * c) * 33 + nn;
        u32x4 o; o.x = pk2(s[0 * 33], s[1 * 33]); o.y = pk2(s[2 * 33], s[3 * 33]); o.z = pk2(s[4 * 33], s[5 * 33]); o.w = pk2(s[6 * 33], s[7 * 33]);
        *(u32x4*)(WT + (size_t)(n0 + nn) * K + k0 + 8 * c) = o; }
    asm volatile("s_waitcnt lgkmcnt(0)" ::: "memory");
}
}

__device__ __forceinline__ gdn::Bufs gdn_bufs(const WS& w, int l) { gdn::Bufs B; B.UT = w.gUT; B.WP = w.gWP; B.KDT = w.gKDT; B.QD = w.gQD; B.QK = w.gQK; B.SIT = w.gSIT; B.VNT = w.gVNT; B.GT = w.gGT + (size_t)l * gdn::NTASK; return B; }
__device__ __forceinline__ lru::Bufs lru_bufs(const WS& w) { lru::Bufs B; B.HLOC = w.lHLOC; B.ACUM = w.lACUM; B.LSUM = w.lLSUM; B.HIN = w.lHIN; return B; }

#define LAS __attribute__((address_space(3)))
#define XB_TMO      128
#define XB_XCNT(j)  (256  + 64 * (j))
#define XB_XSUB(j)  (1280 + 64 * (j))
#define XB_XGEN(j)  (2304 + 64 * (j))
#define XB_TOP      3328
#define XB_TOPGEN   3392
#define XCD_BAR_WORDS 3456
#define XB_SPIN_CAP (1u << 18)
__device__ __forceinline__ unsigned xb_ld(unsigned* p)              { return __hip_atomic_load(p, __ATOMIC_RELAXED, __HIP_MEMORY_SCOPE_AGENT); }
__device__ __forceinline__ unsigned xb_add(unsigned* p, unsigned v) { return __hip_atomic_fetch_add(p, v, __ATOMIC_RELAXED, __HIP_MEMORY_SCOPE_AGENT); }
__device__ __forceinline__ unsigned xb_xcc_id() { return (unsigned)__builtin_amdgcn_s_getreg((3 << 11) | 20) & 0xFu; }
#define XB_SPIN(cond, bar) do { unsigned _sp = 0; while (cond) { __builtin_amdgcn_s_sleep(1); \
    if ((++_sp & 255u) == 0u) { if (xb_ld(&(bar)[XB_TMO])) break; if (_sp > XB_SPIN_CAP) { atomicAdd(&(bar)[XB_TMO], 1u); break; } } } } while (0)
struct XcdBarrier { unsigned* bar; unsigned x; volatile LAS unsigned* st; };
__device__ __forceinline__ XcdBarrier xcd_barrier_post(unsigned* bar, volatile LAS unsigned* st, const bool leader) {
    XcdBarrier b; b.bar = bar; b.x = xb_xcc_id(); b.st = st;
    if (leader) (void)xb_add(&bar[XB_XCNT(b.x)], 1u);
    return b;
}
__device__ __forceinline__ void xcd_barrier_complete(unsigned* bar, unsigned x, unsigned& nloc, unsigned& nx) {
    const unsigned G = gridDim.x * gridDim.y * gridDim.z;
    unsigned sum, cnt, mine, sp = 0u;
    for (;;) {
        sum = 0u; cnt = 0u; mine = 0u;
#pragma unroll
        for (unsigned j = 0; j < 16; ++j) { const unsigned c = xb_ld(&bar[XB_XCNT(j)]); sum += c; cnt += (c > 0u) ? 1u : 0u; mine = (j == x) ? c : mine; }
        if (sum == G) break;
        __builtin_amdgcn_s_sleep(1);
        if ((++sp & 255u) == 0u) { if (xb_ld(&bar[XB_TMO])) break; if (sp > XB_SPIN_CAP) { atomicAdd(&bar[XB_TMO], 1u); break; } }
    }
    nloc = mine > 0u ? mine : 1u; nx = cnt > 0u ? cnt : 1u;
}
__device__ __forceinline__ void xcd_barrier(const XcdBarrier& b, const bool leader) {
    asm volatile("s_waitcnt vmcnt(0)" ::: "memory");
    __syncthreads();
    if (leader) {
        unsigned* bar = b.bar;
        __builtin_amdgcn_s_waitcnt(0);
        unsigned nloc = b.st[0], nx = b.st[1];
        if (nloc == 0u) { xcd_barrier_complete(bar, b.x, nloc, nx); b.st[0] = nloc; b.st[1] = nx; }
        const unsigned old = xb_add(&bar[XB_XSUB(b.x)], 1u);
        const unsigned gen = old / nloc;
        if (old + 1u == (gen + 1u) * nloc) {
            __builtin_amdgcn_fence(__ATOMIC_RELEASE, "agent");
            asm volatile("s_waitcnt vmcnt(0)" ::: "memory");
            const unsigned og = xb_add(&bar[XB_TOP], 1u);
            const unsigned tg = og / nx;
            if (og + 1u == (tg + 1u) * nx) xb_add(&bar[XB_TOPGEN], 1u);
            else XB_SPIN(xb_ld(&bar[XB_TOPGEN]) == tg, bar);
            __builtin_amdgcn_fence(__ATOMIC_ACQUIRE, "agent");
            xb_add(&bar[XB_XGEN(b.x)], 1u);
            asm volatile("s_waitcnt vmcnt(0)" ::: "memory");
        } else {
            XB_SPIN(xb_ld(&bar[XB_XGEN(b.x)]) == gen, bar);
            __builtin_amdgcn_fence(__ATOMIC_ACQUIRE, "agent");
            asm volatile("s_waitcnt vmcnt(0)" ::: "memory");
        }
    }
    __syncthreads();
}

constexpr int NWAVES = 8, NTHR = 512;
constexpr int LDS_MISC = 147456, LDS_BYTES = 148480;
static_assert(sizeof(Inputs) == 34 * 8, "Inputs mirrors Params::in");
static_assert(gdn::G1_LDS <= LDS_MISC && pg8::STAGE_BYTES <= LDS_MISC && att::Cfg<MLA_QK>::LDS_BYTES <= LDS_MISC && gdn::G2_LDS <= LDS_MISC, "LDS map");
constexpr int CW_BAR = 4096;
constexpr int G2_CUT1 = 52, G2_CUT2 = 52;
constexpr int SK_OUT = 4, SK_DOWN = 5;
constexpr int PH_PRO = 0, PH_PER_LAYER = 12, NPH = 1 + PH_PER_LAYER * DEPTH;
struct Params { const float* in[34]; float* out; unsigned char* ws; int ph_lo, ph_hi, li, pad; };

struct SplitOrder {
    int nN, nM, S, G, c;
    __device__ __forceinline__ void init(int M, int N, int S_, int G_, int c_) { nM = M / pg8::BM; nN = N / pg8::BM; S = S_; G = G_; c = c_; }
    __device__ __forceinline__ bool next(int i, pg8::Unit& u) const { const int g = c + i * G; if (g >= nM * nN * S) return false; u.ks = g / (nM * nN); const int loc = g % (nM * nN); u.pm = loc / nN; u.pn = loc % nN; return true; }
    __device__ __forceinline__ void a_ready(const pg8::Unit&) const {}
    __device__ __forceinline__ void done(const pg8::Unit&) const {}
};
struct SpanOrder {
    int nN, lo, hi, G, g0;
    __device__ __forceinline__ void init(int N, int lo_, int hi_, int G_, int c) { nN = N / pg8::BM; lo = lo_; hi = hi_; G = G_; int i0 = 0; if (c < lo_) i0 = (lo_ - c + G_ - 1) / G_; g0 = c + i0 * G_; }
    __device__ __forceinline__ bool next(int i, pg8::Unit& u) const { const int g = g0 + i * G; if (g >= hi) return false; const int loc = g - lo; u.pm = loc / nN; u.pn = loc % nN; u.ks = 0; return true; }
    __device__ __forceinline__ void a_ready(const pg8::Unit&) const {}
    __device__ __forceinline__ void done(const pg8::Unit&) const {}
};

#define AS4 __attribute__((address_space(4)))
#define PHASE_WS const AS4 Params* pp = (const AS4 Params*)__builtin_amdgcn_kernarg_segment_ptr(); asm volatile("" : "+s"(pp)); const AS4 Inputs* I = (const AS4 Inputs*)pp; (void)I; unsigned char* wsb_ = pp->ws; const WS w = ws_carve(wsb_)
#define PHASE_IDS int tid = C_wave0 * 64 + (int)__builtin_amdgcn_mbcnt_hi(~0u, __builtin_amdgcn_mbcnt_lo(~0u, 0u)); asm volatile("" : "+v"(tid)); const int lane = tid & 63, wave = __builtin_amdgcn_readfirstlane(tid >> 6), gwave = wg * NWAVES + wave, gtid = wg * NTHR + tid; (void)lane; (void)gwave; (void)gtid
#ifndef DBG_MASK
#define DBG_MASK 0xFFFFFF
#endif
#define IN(k) (lo <= (k) && (k) < hi)
#define ON(j) (((DBG_MASK) >> (j)) & 1)
#define SEAM(k) do { if (IN(k) && IN((k) + 1)) xcd_barrier(bar, C_wave0 == 0 && __builtin_amdgcn_mbcnt_hi(~0u, __builtin_amdgcn_mbcnt_lo(~0u, 0u)) == 0u); } while (0)

struct LayerCtx { int lo, hi, G, wg, nwaves, gthreads, wave0; XcdBarrier bar; char* lds; unsigned char* lds_raw; };
template <int l> __device__ __forceinline__ void layer_body(const LayerCtx& C) {
    const int lo = C.lo, hi = C.hi, G = C.G, wg = C.wg, nwaves = C.nwaves, gthreads = C.gthreads, C_wave0 = C.wave0; const XcdBarrier& bar = C.bar; char* lds = C.lds; unsigned char* lds_raw = C.lds_raw;
    (void)G; (void)nwaves; (void)gthreads;
        const int pb = 1 + PH_PER_LAYER * l;
        const bool want_ctx = l < DEPTH - 1; const int Mo = want_ctx ? M_ALL : M_LAT;
        if (ON(0) && IN(pb + 0)) { PHASE_WS; PHASE_IDS; const float* MODl = w.MOD + (size_t)l * (BATCH + 1) * NMODV; (void)MODl; misc::norm_phase(w.H, I->norm_mix_g + (size_t)l * D_MODEL, MODl, 0, w.U, M_ALL, gwave, nwaves, lane, l > 0 ? w.PART : nullptr, SK_DOWN, MODl - (size_t)(BATCH + 1) * NMODV + (size_t)BATCH * NMODV + 5 * D_MODEL, l == 0 ? I->x : nullptr, l == 0 ? I->ctx : nullptr); }
        SEAM(pb + 0);
        if (ON(1) && IN(pb + 1)) { PHASE_WS; PHASE_IDS; const float* MODl = w.MOD + (size_t)l * (BATCH + 1) * NMODV; (void)MODl; pg8::Gemm g{w.U, w.WIN + l * SZ_WIN, M_ALL, NP, D_MODEL, D_MODEL}; pg8::StaticOrder S; S.init(M_ALL, NP, G, wg);
            pg8::EpiBf16<0> E{w.P, NP, nullptr, 0, 0, 1.0f};
            pg8::gemm_phase<pg8::EpiBf16<0>, pg8::StaticOrder, true, true>((PG8_LAS unsigned char*)lds_raw, g, S, E, tid); }
        SEAM(pb + 1);
        if (ON(2) && IN(pb + 2)) { PHASE_WS; PHASE_IDS; const float* MODl = w.MOD + (size_t)l * (BATCH + 1) * NMODV; (void)MODl;
            const int pflags = pp->pad;
            if (!(pflags & 16)) { gdn::G1Args A; A.P = w.P; A.conv_w = I->gdn_conv_w + (size_t)l * 4 * 3 * GROUP_W; A.a_log = I->gdn_a_log + (size_t)l * 2 * NH; A.dt_bias = I->gdn_dt_bias + (size_t)l * 2 * NH; A.B = gdn_bufs(w, l); A.pflags = pflags;
              gdn::g1_phase(A, lds, G, wg, tid); }
            if (!(pflags & 32)) { lru::LocalArgs A; A.P = w.P; A.conv_w = I->lru_conv_w + (size_t)l * 4 * LRU_W; A.conv_b = I->lru_conv_b + (size_t)l * LRU_W; A.WG = w.WLRU + (size_t)l * 16 * lru::SZ_WBLK;
              A.ba = I->lru_ba + (size_t)l * 2 * LRU_W; A.bx = I->lru_bx + (size_t)l * 2 * LRU_W; A.lam = I->lru_lam + (size_t)l * 2 * LRU_W; A.B = lru_bufs(w);
              lru::local_phase(A, lds, G, wg, tid); }
            if (!(pflags & 64)) { misc::RowNormArgs A; A.P = w.P; A.qa_g = I->mla_qa_g + (size_t)l * MLA_Q_LORA; A.kva_g = I->mla_kva_g + (size_t)l * MLA_KV_LORA; A.na_qn_g = I->na_qn_g + (size_t)l * HD; A.na_kn_g = I->na_kn_g + (size_t)l * HD;
              A.CQN = w.CQN; A.CKVN = w.CKVN; A.NQ = w.NQ; A.NK = w.NK; misc::rownorm_phase(A, gwave, nwaves, lane); }
        }
        SEAM(pb + 2);
        if (ON(3) && IN(pb + 3)) { PHASE_WS; PHASE_IDS; const float* MODl = w.MOD + (size_t)l * (BATCH + 1) * NMODV; (void)MODl;
            if (wg < gdn::G2_WGS) gdn::g2_chain(gdn_bufs(w, l), lds, wg, tid, 0, G2_CUT1, w.gSS);
            else {
            constexpr int UQ = (M_ALL / 256) * (NQ_MLA / 256), UKV = (M_ALL / 256) * (NKV_MLA / 256); const int G2n = G - gdn::G2_WGS, c2 = wg - gdn::G2_WGS;
            { pg8::Gemm g{w.CQN, w.WUQ + l * SZ_WUQ, M_ALL, NQ_MLA, MLA_Q_LORA, MLA_Q_LORA}; SpanOrder S; S.init(NQ_MLA, 0, UQ, G2n, c2); pg8::EpiBf16<0> E{w.QR, NQ_MLA, nullptr, 0, 0, 1.0f};
              pg8::gemm_phase<pg8::EpiBf16<0>, SpanOrder, true, true>((PG8_LAS unsigned char*)lds_raw, g, S, E, tid); }
            { pg8::Gemm g{w.CKVN, w.WUKV + l * SZ_WUKV, M_ALL, NKV_MLA, MLA_KV_LORA, MLA_KV_LORA}; SpanOrder S; S.init(NKV_MLA, UQ, UQ + UKV, G2n, c2); pg8::EpiBf16<0> E{w.KVR, NKV_MLA, nullptr, 0, 0, 1.0f};
              pg8::gemm_phase<pg8::EpiBf16<0>, SpanOrder, true, true>((PG8_LAS unsigned char*)lds_raw, g, S, E, tid); }
            }
        }
        SEAM(pb + 3);
        if (ON(4) && IN(pb + 4)) { PHASE_WS; PHASE_IDS; const float* MODl = w.MOD + (size_t)l * (BATCH + 1) * NMODV; (void)MODl;
            { misc::MlaQkvArgs A; A.QR = w.QR; A.KVR = w.KVR; A.P = w.P; A.qn_g = I->mla_qn_g + (size_t)l * MLA_QK; A.kn_g = I->mla_kn_g + (size_t)l * MLA_QK; A.QM = w.QM; A.KM = w.KM; A.VM = w.VM;
              misc::mlaqkv_phase(A, gwave, nwaves, lane); }
            lru::carry_phase(lru_bufs(w), gtid, gthreads);
        }
        SEAM(pb + 4);
        if (ON(5) && IN(pb + 5)) { PHASE_WS; PHASE_IDS; const float* MODl = w.MOD + (size_t)l * (BATCH + 1) * NMODV; (void)MODl;
            const int pflags = pp->pad;
            if (wg < gdn::G2_WGS && !(pflags & 1)) gdn::g2_chain(gdn_bufs(w, l), lds, wg, tid, G2_CUT2, gdn::G2_NSTEP, w.gSS);
            AttnArgs A; A.QM = w.QM; A.KM = w.KM; A.VM = w.VM; A.NQ = w.NQ; A.NK = w.NK; A.P = w.P; A.Y = w.Y; A.rpb = I->na_rpb + (size_t)l * NH * (2 * NA_KH - 1) * (2 * NA_KW - 1); A.want_ctx = want_ctx ? 1 : 0; A.pad = pflags;
            attention_phase(A, lds, G, wg, tid, gdn::G2_WGS);
        }
        SEAM(pb + 5);
        if (ON(6) && IN(pb + 6)) { PHASE_WS; PHASE_IDS; const float* MODl = w.MOD + (size_t)l * (BATCH + 1) * NMODV; (void)MODl;
            const int pflags = pp->pad;
            if (!(pflags & 128)) { gdn::G3Args A; A.B = gdn_bufs(w, l); A.P = w.P; A.norm_g = I->gdn_norm_g + (size_t)l * HD; A.Y = w.Y; gdn::g3_phase(A, lds, G, wg, tid); }
            if (!(pflags & 256)) lru::finish_phase(lru_bufs(w), w.P, w.Y, gtid, gthreads);
        }
        SEAM(pb + 6);
        if (ON(7) && IN(pb + 7)) { PHASE_WS; PHASE_IDS; const float* MODl = w.MOD + (size_t)l * (BATCH + 1) * NMODV; (void)MODl;
            { pg8::Gemm g{w.Y, w.WOUT + l * SZ_WOUT, M_LAT, D_MODEL, D_MODEL, D_MODEL}; pg8::StaticOrder S; S.init(M_LAT, D_MODEL, G, wg);
              pg8::EpiGateRes E{l == 0 ? I->x : w.H, w.H, D_MODEL, MODl + 2 * D_MODEL, NMODV, SEQ, BATCH, M_LAT};
              pg8::gemm_phase<pg8::EpiGateRes, pg8::StaticOrder, true, true>((PG8_LAS unsigned char*)lds_raw, g, S, E, tid); }
            if (want_ctx) { constexpr int SK = SK_OUT;
              pg8::Gemm g{w.Y + (size_t)M_LAT * D_MODEL, w.WOUT + l * SZ_WOUT, M_CTX, D_MODEL, D_MODEL / SK, D_MODEL}; SplitOrder S; S.init(M_CTX, D_MODEL, SK, G, (wg + G / 2) % G);
              pg8::EpiPart E{w.PART, D_MODEL, (size_t)M_CTX * D_MODEL};
              pg8::gemm_phase<pg8::EpiPart, SplitOrder, true, true>((PG8_LAS unsigned char*)lds_raw, g, S, E, tid); } }
        SEAM(pb + 7);
        if (ON(8) && IN(pb + 8)) { PHASE_WS; PHASE_IDS; const float* MODl = w.MOD + (size_t)l * (BATCH + 1) * NMODV; (void)MODl; misc::norm_phase(w.H, I->norm_ffn_g + (size_t)l * D_MODEL, MODl, 3, w.U, Mo, gwave, nwaves, lane, want_ctx ? w.PART : nullptr, SK_OUT, MODl + (size_t)BATCH * NMODV + 2 * D_MODEL, nullptr, nullptr); }
        SEAM(pb + 8);
        if (ON(9) && IN(pb + 9)) { PHASE_WS; PHASE_IDS; const float* MODl = w.MOD + (size_t)l * (BATCH + 1) * NMODV; (void)MODl; pg8::Gemm g{w.U, w.WUP + l * SZ_WUP, Mo, 2 * D_FF, D_MODEL, D_MODEL}; pg8::StaticOrder S; S.init(Mo, 2 * D_FF, G, wg);
            pg8::EpiBf16<0> E{w.UP, 2 * D_FF, nullptr, 0, 0, 1.0f};
            pg8::gemm_phase<pg8::EpiBf16<0>, pg8::StaticOrder, true, true>((PG8_LAS unsigned char*)lds_raw, g, S, E, tid); }
        SEAM(pb + 9);
        if (ON(10) && IN(pb + 10)) { PHASE_WS; PHASE_IDS; const float* MODl = w.MOD + (size_t)l * (BATCH + 1) * NMODV; (void)MODl; misc::act_phase(w.UP, I->ffn_conv_w + (size_t)l * 3 * 2 * D_FF, I->ffn_conv_b + (size_t)l * 2 * D_FF, w.ACT, Mo, gtid, gthreads); }
        SEAM(pb + 10);
        if (ON(11) && IN(pb + 11)) { PHASE_WS; PHASE_IDS; const float* MODl = w.MOD + (size_t)l * (BATCH + 1) * NMODV; (void)MODl;
            { pg8::Gemm g{w.ACT, w.WDOWN + l * SZ_WDOWN, M_LAT, D_MODEL, D_FF, D_FF}; pg8::StaticOrder S; S.init(M_LAT, D_MODEL, G, wg);
              pg8::EpiGateRes E{w.H, want_ctx ? w.H : pp->out, D_MODEL, MODl + 5 * D_MODEL, NMODV, SEQ, BATCH, M_LAT};
              pg8::gemm_phase<pg8::EpiGateRes, pg8::StaticOrder, true, true>((PG8_LAS unsigned char*)lds_raw, g, S, E, tid); }
            if (want_ctx) { constexpr int SK = SK_DOWN;
              pg8::Gemm g{w.ACT + (size_t)M_LAT * D_FF, w.WDOWN + l * SZ_WDOWN, M_CTX, D_MODEL, D_FF / SK, D_FF}; SplitOrder S; S.init(M_CTX, D_MODEL, SK, G, (wg + G / 2) % G);
              pg8::EpiPart E{w.PART, D_MODEL, (size_t)M_CTX * D_MODEL};
              pg8::gemm_phase<pg8::EpiPart, SplitOrder, true, true>((PG8_LAS unsigned char*)lds_raw, g, S, E, tid); } }
        SEAM(pb + 11);

}
__global__ void __launch_bounds__(NTHR, 2) fwd(Params p) {
    extern __shared__ __attribute__((aligned(16))) unsigned char lds_raw[];
    char* lds = (char*)lds_raw;
    const int G = (int)gridDim.x, wg = (int)blockIdx.x, nwaves = G * NWAVES, gthreads = G * NTHR;
    const int C_wave0 = __builtin_amdgcn_readfirstlane((int)threadIdx.x >> 6);
    volatile LAS unsigned* MISC = (volatile LAS unsigned*)(lds_raw + LDS_MISC);
    if (threadIdx.x < 32) MISC[threadIdx.x] = 0u;
    __syncthreads();
    const int lo = p.ph_lo, hi = p.ph_hi;
    unsigned* const barw = (unsigned*)p.ws + CW_BAR + (size_t)p.li * XCD_BAR_WORDS;
    XcdBarrier bar; bar.bar = barw; bar.x = 0; bar.st = MISC + 8;
    if (hi - lo > 1) bar = xcd_barrier_post(barw, MISC + 8, threadIdx.x == 0);

    if (ON(12) && IN(PH_PRO)) { PHASE_WS; PHASE_IDS;
        {
            float* SCs = (float*)lds;
            float* red = (float*)(lds + 3 * D_MODEL * 4);
            constexpr int NT = DEPTH * NMODV / 256;
            if (wg < NT) {
                for (int i = tid; i < (BATCH + 1) * D_MODEL; i += NTHR) { const int s = i / D_MODEL, k = i % D_MODEL; const float v = s < BATCH ? I->c[s * D_MODEL + k] : I->c_ctx[k]; SCs[i] = v / (1.0f + __expf(-v)); }
                __syncthreads();
            }
            for (int t = wg; t < NT; t += G) { const int l = t / (NMODV / 256), j0 = (t % (NMODV / 256)) * 256;
                misc::f32x4 acc[3] = {{0.f, 0.f, 0.f, 0.f}, {0.f, 0.f, 0.f, 0.f}, {0.f, 0.f, 0.f, 0.f}};
                const float* wp = I->ada_w + (size_t)l * D_MODEL * NMODV + (size_t)(256 * wave) * NMODV + j0 + 4 * lane;
#pragma unroll 8
                for (int k = 0; k < 256; ++k) { const misc::f32x4 wv = *(const misc::f32x4*)(wp + (size_t)k * NMODV); const int kk = 256 * wave + k;
                    acc[0] += wv * SCs[kk]; acc[1] += wv * SCs[D_MODEL + kk]; acc[2] += wv * SCs[2 * D_MODEL + kk]; }
                __syncthreads();
#pragma unroll
                for (int s = 0; s < 3; ++s) *(misc::f32x4*)(red + (wave * 3 + s) * 256 + 4 * lane) = acc[s];
                __syncthreads();
                for (int i = tid; i < 3 * 256; i += NTHR) { const int s = i / 256, c = i % 256; float sum = I->ada_b[(size_t)l * NMODV + j0 + c];
#pragma unroll
                    for (int w8 = 0; w8 < 8; ++w8) sum += red[(w8 * 3 + s) * 256 + c];
                    w.MOD[((size_t)l * (BATCH + 1) + s) * NMODV + j0 + c] = sum; }
            }
            __syncthreads();
        }
        {
            float* scr = (float*)(lds + wave * 8448);
            constexpr int I_IN = (D_MODEL / 64) * (NP / 32), I_OUT = (D_MODEL / 64) * (D_MODEL / 32), I_UP = (D_MODEL / 64) * (2 * D_FF / 32), I_DN = (D_FF / 64) * (D_MODEL / 32),
                          I_UQ = (MLA_Q_LORA / 64) * (NQ_MLA / 32), I_UKV = (MLA_KV_LORA / 64) * (NKV_MLA / 32), I_LB = (LRU_BW / 64) * (LRU_BW / 32), I_LRU = 2 * 2 * NH * I_LB;
            constexpr int I_LAYER = I_IN + I_OUT + I_UP + I_DN + I_UQ + I_UKV + I_LRU;
            for (int it = gwave; it < DEPTH * I_LAYER; it += nwaves) { const int l = it / I_LAYER; int r = it % I_LAYER;
                if (r < I_IN) { misc::transpose_item(I->w_in + (size_t)l * D_MODEL * IN_COLS, D_MODEL, IN_COLS, NP, w.WIN + l * SZ_WIN, scr, r, lane); continue; } r -= I_IN;
                if (r < I_OUT) { misc::transpose_item(I->w_out + (size_t)l * D_MODEL * D_MODEL, D_MODEL, D_MODEL, D_MODEL, w.WOUT + l * SZ_WOUT, scr, r, lane); continue; } r -= I_OUT;
                if (r < I_UP) { misc::transpose_item(I->ffn_w_up + (size_t)l * D_MODEL * 2 * D_FF, D_MODEL, 2 * D_FF, 2 * D_FF, w.WUP + l * SZ_WUP, scr, r, lane); continue; } r -= I_UP;
                if (r < I_DN) { misc::transpose_item(I->ffn_w_down + (size_t)l * D_FF * D_MODEL, D_FF, D_MODEL, D_MODEL, w.WDOWN + l * SZ_WDOWN, scr, r, lane); continue; } r -= I_DN;
                if (r < I_UQ) { misc::transpose_item(I->mla_w_uq + (size_t)l * MLA_Q_LORA * NQ_MLA, MLA_Q_LORA, NQ_MLA, NQ_MLA, w.WUQ + l * SZ_WUQ, scr, r, lane); continue; } r -= I_UQ;
                if (r < I_UKV) { misc::transpose_item(I->mla_w_ukv + (size_t)l * MLA_KV_LORA * NKV_MLA, MLA_KV_LORA, NKV_MLA, NKV_MLA, w.WUKV + l * SZ_WUKV, scr, r, lane); continue; } r -= I_UKV;
                { const int blk = r / I_LB, item = r % I_LB, d = blk / (2 * NH), wh = (blk / NH) & 1, nb = blk % NH;
                  const float* src = (wh == 0 ? I->lru_wa : I->lru_wx) + ((size_t)(l * 2 + d) * NH + nb) * lru::SZ_WBLK;
                  misc::transpose_item(src, LRU_BW, LRU_BW, LRU_BW, w.WLRU + ((size_t)l * 16 + blk) * lru::SZ_WBLK, scr, item, lane); }
            }
        }
    }
    SEAM(PH_PRO);

    { LayerCtx C; C.lo = lo; C.hi = hi; C.G = G; C.wg = wg; C.nwaves = nwaves; C.gthreads = gthreads; C.wave0 = C_wave0; C.bar = bar; C.lds = lds; C.lds_raw = lds_raw;
      static_assert(DEPTH == 4, "layer calls are written out (a real layer loop lets LICM park loop-invariant values in registers across every phase: spills)");
      layer_body<0>(C); layer_body<1>(C); layer_body<2>(C); layer_body<3>(C); }
#undef IN
#undef SEAM
}

#ifndef MK_PHASES_PER_LAUNCH
#define MK_PHASES_PER_LAUNCH NPH
#endif
extern "C" void kernel_launch(void* const* d_in, const int* in_sizes, int n_in, void* d_out, int out_size, void* d_ws, size_t ws_size, hipStream_t stream) {
    static int grid = 0;
    if (grid == 0) {
        int dev = 0, cus = 0;
        if (hipGetDevice(&dev) != hipSuccess || hipDeviceGetAttribute(&cus, hipDeviceAttributeMultiprocessorCount, dev) != hipSuccess || cus <= 0) { fprintf(stderr, "kernel_launch: no device\n"); grid = -1; return; }
        if (hipFuncSetAttribute((const void*)fwd, hipFuncAttributeMaxDynamicSharedMemorySize, LDS_BYTES) != hipSuccess) { fprintf(stderr, "kernel_launch: hipFuncSetAttribute failed\n"); grid = -1; return; }
        int per_cu = 0; if (hipOccupancyMaxActiveBlocksPerMultiprocessor(&per_cu, (const void*)fwd, NTHR, LDS_BYTES) != hipSuccess || per_cu < 1) fprintf(stderr, "kernel_launch: occupancy query says %d blocks per CU\n", per_cu);
        (void)hipGetLastError();
        grid = cus;
        const WS w0 = ws_carve(nullptr);
        if (n_in != 34 || w0.total > ws_size) { fprintf(stderr, "kernel_launch: bad inputs / workspace (need %zu, have %zu)\n", w0.total, ws_size); grid = -1; return; }
    }
    if (grid < 0) return;
    (void)hipMemsetAsync(d_ws, 0, 1 << 20, stream);
    Params p; memset(&p, 0, sizeof(p));
    for (int i = 0; i < 34; ++i) p.in[i] = (const float*)d_in[i];
    p.out = (float*)d_out; p.ws = (unsigned char*)d_ws;
    int li = 0;
    for (int lo = 0; lo < NPH; lo += MK_PHASES_PER_LAUNCH, ++li) {
        p.ph_lo = lo; p.ph_hi = lo + MK_PHASES_PER_LAUNCH < NPH ? lo + MK_PHASES_PER_LAUNCH : NPH; p.li = li;
#if defined(PROBE_MASK)
        if (MK_PHASES_PER_LAUNCH == 1 && ((((PROBE_MASK) >> 12) & 1 && lo == 0) || (lo > 0 && (((PROBE_MASK) >> ((lo - 1) % PH_PER_LAYER)) & 1))))
            { Params q = p;
#if defined(PROBE_FLAGS)
              q.pad = PROBE_FLAGS;
#endif
              for (int r = 0; r < PROBE_REPS; ++r) hipLaunchKernelGGL(fwd, dim3(grid), dim3(NTHR), LDS_BYTES, stream, q); }
#endif
        hipLaunchKernelGGL(fwd, dim3(grid), dim3(NTHR), LDS_BYTES, stream, p);
    }
}
```

```cpp
#include <hip/hip_runtime.h>
#include <cstdio>
#include <cstdint>
#include <cstring>
#include <math.h>
#include <stdint.h>

#ifdef CFG_SMALL
constexpr int D_MODEL = 256, BATCH = 2, SEQ = 512, DEPTH = 2, CTX_LEN = 64, GRID_W = 32, HEAD_DIM = 16;
#else
constexpr int D_MODEL = 2048, BATCH = 2, SEQ = 8192, DEPTH = 4, CTX_LEN = 256, GRID_W = 64, HEAD_DIM = 128;
#endif
constexpr int GROUP_W = D_MODEL / 4, NH = GROUP_W / HEAD_DIM;
constexpr int HD = HEAD_DIM;
constexpr int N_MOD = 6;
constexpr float EPS = 1e-6f;
constexpr int LRU_W = GROUP_W, LRU_BW = LRU_W / NH;
constexpr float LRU_C = 8.0f;
constexpr int MLA_Q_LORA = 3 * D_MODEL / 16, MLA_KV_LORA = D_MODEL / 8, MLA_NOPE = HD, MLA_ROPE = HD / 2, MLA_V = HD, MLA_QK = MLA_NOPE + MLA_ROPE;
constexpr int GDN_CHUNK = 64;
constexpr int NA_KH = 8, NA_KW = 16;
constexpr int D_FF = 5 * D_MODEL / 2;
constexpr int ROWS = SEQ / GRID_W;
constexpr int C_LRU_X = 0, C_LRU_G = C_LRU_X + LRU_W, C_CQ = C_LRU_G + LRU_W, C_CKV = C_CQ + MLA_Q_LORA, C_KR = C_CKV + MLA_KV_LORA,
              C_GQ = C_KR + MLA_ROPE, C_GK = C_GQ + GROUP_W, C_GV = C_GK + GROUP_W, C_GG = C_GV + GROUP_W, C_GB = C_GG + GROUP_W,
              C_GA = C_GB + 2 * NH, C_NQ = C_GA + 2 * NH, C_NK = C_NQ + GROUP_W, C_NV = C_NK + GROUP_W, IN_COLS = C_NV + GROUP_W;
constexpr int NP = (IN_COLS + 255) / 256 * 256;
constexpr int M_LAT = BATCH * SEQ, M_CTX = BATCH * CTX_LEN, M_ALL = M_LAT + M_CTX;
constexpr int NMODV = N_MOD * D_MODEL;

typedef unsigned short bf16_t;
__host__ __device__ __forceinline__ bf16_t f2bf(float f) { union { float f; unsigned u; } v; v.f = f; unsigned u = v.u; u += 0x7fffu + ((u >> 16) & 1u); return (bf16_t)(u >> 16); }
__host__ __device__ __forceinline__ float bf2f(bf16_t b) { union { float f; unsigned u; } v; v.u = ((unsigned)b) << 16; return v.f; }
__host__ __device__ __forceinline__ float sigmoidf_(float x) { return 1.0f / (1.0f + expf(-x)); }
__host__ __device__ __forceinline__ float siluf_(float x) { return x / (1.0f + expf(-x)); }
__host__ __device__ __forceinline__ float softplusf_(float x) { return fmaxf(x, 0.0f) + log1pf(expf(-fabsf(x))); }
__host__ __device__ __forceinline__ float geluf_(float x) { return 0.5f * x * (1.0f + tanhf(0.7978845608028654f * (x + 0.044715f * x * x * x))); }

struct RowInfo { int b, t, T, base, set; };
__host__ __device__ __forceinline__ RowInfo row_info(int r) {
    RowInfo i;
    if (r < M_LAT) { i.b = r / SEQ; i.t = r % SEQ; i.T = SEQ; i.base = i.b * SEQ; i.set = i.b; }
    else { const int rr = r - M_LAT; i.b = rr / CTX_LEN; i.t = rr % CTX_LEN; i.T = CTX_LEN; i.base = M_LAT + i.b * CTX_LEN; i.set = BATCH; }
    return i;
}


__host__ __device__ __forceinline__ float bflo(unsigned w) { union { float f; unsigned u; } v; v.u = w << 16; return v.f; }
__host__ __device__ __forceinline__ float bfhi(unsigned w) { union { float f; unsigned u; } v; v.u = w & 0xffff0000u; return v.f; }
#define LDS_BARRIER() asm volatile("s_waitcnt lgkmcnt(0)\n\ts_barrier" ::: "memory")
__device__ __forceinline__ float lane_xor(float v, int mask, int lane) { return __int_as_float(__builtin_amdgcn_ds_bpermute((lane ^ mask) << 2, __float_as_int(v))); }
__device__ __forceinline__ float lane_get(float v, int src_lane) { return __int_as_float(__builtin_amdgcn_ds_bpermute(src_lane << 2, __float_as_int(v))); }
struct Inputs {
    const float *x, *c, *ctx, *c_ctx, *ada_w, *ada_b, *norm_mix_g, *norm_ffn_g, *w_in, *w_out,
        *lru_conv_w, *lru_conv_b, *lru_wa, *lru_ba, *lru_wx, *lru_bx, *lru_lam,
        *mla_qa_g, *mla_w_uq, *mla_kva_g, *mla_w_ukv, *mla_qn_g, *mla_kn_g,
        *gdn_conv_w, *gdn_a_log, *gdn_dt_bias, *gdn_norm_g, *na_qn_g, *na_kn_g, *na_rpb,
        *ffn_w_up, *ffn_conv_w, *ffn_conv_b, *ffn_w_down;
};
constexpr int NQ_MLA = NH * MLA_QK, NKV_MLA = NH * (MLA_NOPE + MLA_V);
constexpr size_t SZ_WIN = (size_t)NP * D_MODEL, SZ_WOUT = (size_t)D_MODEL * D_MODEL, SZ_WUP = (size_t)2 * D_FF * D_MODEL, SZ_WDOWN = (size_t)D_MODEL * D_FF,
                 SZ_WUQ = (size_t)NQ_MLA * MLA_Q_LORA, SZ_WUKV = (size_t)NKV_MLA * MLA_KV_LORA, SZ_WLRU = (size_t)16 * LRU_BW * LRU_BW;
struct WS {
    unsigned* ctl; float *MOD, *H, *PART; bf16_t *U, *Y;
    bf16_t *WIN, *WOUT, *WUP, *WDOWN, *WUQ, *WUKV, *WLRU;
    bf16_t* P; bf16_t *CQN, *CKVN, *QR, *KVR, *QM, *KM, *VM, *NQ, *NK;
    bf16_t *gUT, *gWP, *gKDT, *gQD, *gQK, *gSIT, *gVNT; float *gGT, *gSS;
    bf16_t *lHLOC, *lACUM; float *lLSUM, *lHIN;
    bf16_t *HALO, *ACT;
    size_t total;
};
__host__ __device__ inline WS ws_carve(void* base) {
    WS w; size_t off = 0; char* b = (char*)base;
#define WS_TAKE(T, field, bytes) do { w.field = (T*)(b + off); off += (((size_t)(bytes)) + 255) & ~(size_t)255; } while (0)
    WS_TAKE(unsigned, ctl, 1 << 20);
    WS_TAKE(float, MOD, sizeof(float) * (size_t)DEPTH * (BATCH + 1) * NMODV);
    WS_TAKE(float, H, sizeof(float) * (size_t)M_ALL * D_MODEL);
    WS_TAKE(float, PART, sizeof(float) * (size_t)5 * M_CTX * D_MODEL);
    WS_TAKE(bf16_t, U, 2 * (size_t)M_ALL * D_MODEL);
    WS_TAKE(bf16_t, Y, 2 * (size_t)M_ALL * D_MODEL);
    WS_TAKE(bf16_t, WIN, 2 * SZ_WIN * DEPTH); WS_TAKE(bf16_t, WOUT, 2 * SZ_WOUT * DEPTH); WS_TAKE(bf16_t, WUP, 2 * SZ_WUP * DEPTH); WS_TAKE(bf16_t, WDOWN, 2 * SZ_WDOWN * DEPTH);
    WS_TAKE(bf16_t, WUQ, 2 * SZ_WUQ * DEPTH); WS_TAKE(bf16_t, WUKV, 2 * SZ_WUKV * DEPTH); WS_TAKE(bf16_t, WLRU, 2 * SZ_WLRU * DEPTH);
    const size_t r0 = off;
    WS_TAKE(bf16_t, P, 2 * (size_t)M_ALL * NP);
    WS_TAKE(bf16_t, CQN, 2 * (size_t)M_ALL * MLA_Q_LORA); WS_TAKE(bf16_t, CKVN, 2 * (size_t)M_ALL * MLA_KV_LORA);
    WS_TAKE(bf16_t, QR, 2 * (size_t)M_ALL * NQ_MLA); WS_TAKE(bf16_t, KVR, 2 * (size_t)M_ALL * NKV_MLA);
    WS_TAKE(bf16_t, QM, 2 * (size_t)M_ALL * NQ_MLA); WS_TAKE(bf16_t, KM, 2 * (size_t)M_ALL * NQ_MLA); WS_TAKE(bf16_t, VM, 2 * (size_t)M_ALL * NH * MLA_V);
    WS_TAKE(bf16_t, NQ, 2 * (size_t)M_ALL * GROUP_W); WS_TAKE(bf16_t, NK, 2 * (size_t)M_ALL * GROUP_W);
    { constexpr size_t NT_ = (size_t)(M_ALL / 64) * NH * 2;
      WS_TAKE(bf16_t, gUT, 2 * NT_ * 128 * 64); WS_TAKE(bf16_t, gWP, 2 * NT_ * 64 * 128); WS_TAKE(bf16_t, gKDT, 2 * NT_ * 128 * 64); WS_TAKE(bf16_t, gQD, 2 * NT_ * 64 * 128);
      WS_TAKE(bf16_t, gQK, 2 * NT_ * 64 * 64); WS_TAKE(bf16_t, gSIT, 2 * NT_ * 128 * 128); WS_TAKE(bf16_t, gVNT, 2 * NT_ * 128 * 64); WS_TAKE(float, gGT, 4 * NT_ * DEPTH); WS_TAKE(float, gSS, 4 * (size_t)BATCH * NH * 2 * HD * HD); }
    WS_TAKE(bf16_t, lHLOC, 2 * (size_t)2 * M_ALL * LRU_W); WS_TAKE(bf16_t, lACUM, 2 * (size_t)2 * M_ALL * LRU_W);
    WS_TAKE(float, lLSUM, 4 * (size_t)(M_ALL / 64) * 2 * 2 * LRU_W); WS_TAKE(float, lHIN, 4 * (size_t)(M_ALL / 64) * 2 * LRU_W);
    const size_t r1 = off;
    off = r0;
    WS_TAKE(bf16_t, HALO, 2 * (size_t)(M_ALL / 64) * 4 * 2 * D_FF); WS_TAKE(bf16_t, ACT, 2 * (size_t)M_ALL * D_FF);
    const size_t f1 = off;
#undef WS_TAKE
    w.total = r1 > f1 ? r1 : f1;
    return w;
}

namespace pg8 {
#define PG8_LAS __attribute__((address_space(3)))
typedef unsigned short bf16_t;
typedef short bf16x8 __attribute__((ext_vector_type(8)));
typedef float f32x4 __attribute__((ext_vector_type(4)));
typedef unsigned u32x4 __attribute__((ext_vector_type(4)));
constexpr int BM = 256, BK = 64, HALF = 128, HTB = HALF * BK * 2  , STAGE_BYTES = 8 * HTB, NXCD = 8, WGM = 8;

__host__ __device__ __forceinline__ int lds_byte(int r, int c) { const int st = (r >> 4) * 2 + (c >> 5), rr = r & 15, cc = c & 31, ob = rr * 64 + cc * 2; return st * 1024 + (ob ^ (((ob >> 9) & 1) << 5)); }
__host__ __device__ __forceinline__ void stage_rc(int b, int& R, int& C) { const int st = b / 1024, sb = b % 1024, swz = sb ^ (((sb >> 9) & 1) << 5); R = (st >> 1) * 16 + swz / 64; C = (st & 1) * 32 + (swz % 64) / 2; }
__host__ __device__ __forceinline__ int perm32(int rho) { const int n = rho >> 4, i = rho & 15; return 8 * (i >> 2) + 4 * n + (i & 3); }

struct Unit { int pm, pn, ks; };
struct Gemm { const bf16_t* A; const bf16_t* Bt; int M, N, K, ld; };

struct StaticOrder {
    int nM, nN, nwg, G, c;
    __host__ __device__ void init(int M, int N, int G_, int c_) { nM = M / BM; nN = N / BM; nwg = nM * nN; G = G_; c = c_; }
    __host__ __device__ bool next(int i, Unit& u) const {
        const long L = (long)i * G + c; if (L >= nwg) return false;
        int wgid = (int)L; { const int q = nwg / NXCD, r = nwg % NXCD, xcd = wgid % NXCD, off = wgid / NXCD; wgid = (xcd < r ? xcd * (q + 1) : r * (q + 1) + (xcd - r) * q) + off; }
        const int nig = WGM * nN, gid = wgid / nig, fm = gid * WGM, gsz = (nM - fm) < WGM ? (nM - fm) : WGM;
        u.pm = fm + ((wgid % nig) % gsz); u.pn = (wgid % nig) / gsz; u.ks = 0; return true;
    }
    __device__ __forceinline__ void a_ready(const Unit&) const {}
    __device__ __forceinline__ void done(const Unit&) const {}
};
__device__ __forceinline__ unsigned cvt_pk_bf16(float lo, float hi) { unsigned r; asm volatile("v_cvt_pk_bf16_f32 %0, %1, %2" : "=v"(r) : "v"(lo), "v"(hi)); return r; }
typedef float f32x2 __attribute__((ext_vector_type(2)));
__device__ __forceinline__ f32x2 gelu_pk(f32x2 v) {
    const f32x2 av = __builtin_elementwise_abs(v), d = av * 0.2316418882f + 1.0f;
    f32x2 t; t.x = __builtin_amdgcn_rcpf(d.x); t.y = __builtin_amdgcn_rcpf(d.y);
    f32x2 q = t * 0.5307027145f + (-0.7265760135f); q = q * t + 0.7107068705f; q = q * t + (-0.142248368f); q = q * t + 0.127414796f; q = q * t;
    const f32x2 s = (v * v) * (-0.72134752044f);
    f32x2 e; e.x = __builtin_amdgcn_exp2f(s.x); e.y = __builtin_amdgcn_exp2f(s.y);
    const f32x2 m = v * (q * e), r = v - m;
    f32x2 o; o.x = v.x < 0.f ? m.x : r.x; o.y = v.y < 0.f ? m.y : r.y; return o;
}

template <int ACT  > struct EpiBf16 {
    static constexpr bool PERM = true, AFTER_DRAIN = false; static_assert(ACT == 0 || ACT == 1, "EpiBf16: ACT is 0 (none) or 1 (gelu_pk)");
    bf16_t* O; int ldc; const float* bias; int split_cols; size_t split_stride; float scale0;
    __device__ __forceinline__ void operator()(const f32x4 (&acc)[2][2][4][2], const Unit& u, int wr, int wc, int fr, int fq) const {
        const int row0 = u.pm * BM + wr * 64 + fr; int colt = u.pn * BM; bf16_t* base = O;
        float sc = 1.f; if (split_cols) { const int t = colt / split_cols; base += (size_t)t * split_stride; colt -= t * split_cols; if (t == 0) sc = scale0; }
        const int col0 = colt + wc * 32 + 8 * fq, bcol0 = u.pn * BM + wc * 32 + 8 * fq;
        f32x4 bv[2][2];
#pragma unroll
        for (int bj = 0; bj < 2; ++bj)
#pragma unroll
            for (int n = 0; n < 2; ++n) bv[bj][n] = bias ? *(const f32x4*)(bias + bcol0 + bj * HALF + 4 * n) : (f32x4){0.f, 0.f, 0.f, 0.f};
#pragma unroll
        for (int ai = 0; ai < 2; ++ai)
#pragma unroll
            for (int m = 0; m < 4; ++m) { bf16_t* rowp = base + (size_t)(row0 + ai * HALF + m * 16) * ldc + col0;
#pragma unroll
                for (int bj = 0; bj < 2; ++bj) { f32x4 v0 = acc[ai][bj][m][0] + bv[bj][0], v1 = acc[ai][bj][m][1] + bv[bj][1];
                    if (ACT == 1) { f32x2 a = gelu_pk((f32x2){v0[0], v0[1]}), b = gelu_pk((f32x2){v0[2], v0[3]}), c = gelu_pk((f32x2){v1[0], v1[1]}), d = gelu_pk((f32x2){v1[2], v1[3]});
                        v0 = (f32x4){a.x, a.y, b.x, b.y}; v1 = (f32x4){c.x, c.y, d.x, d.y}; }
                    v0 = v0 * sc; v1 = v1 * sc; u32x4 w; w.x = cvt_pk_bf16(v0[0], v0[1]); w.y = cvt_pk_bf16(v0[2], v0[3]); w.z = cvt_pk_bf16(v1[0], v1[1]); w.w = cvt_pk_bf16(v1[2], v1[3]);
                    *(u32x4*)(rowp + bj * HALF) = w; } }
    }
};

struct EpiF32 {
    static constexpr bool PERM = false, AFTER_DRAIN = false;
    float* C; int ldc;
    __device__ __forceinline__ void operator()(const f32x4 (&acc)[2][2][4][2], const Unit& u, int wr, int wc, int fr, int fq) const {
        const int row0 = u.pm * BM + wr * 64 + fr, col0 = u.pn * BM + wc * 32 + 4 * fq;
#pragma unroll
        for (int ai = 0; ai < 2; ++ai)
#pragma unroll
            for (int m = 0; m < 4; ++m) { float* rowp = C + (size_t)(row0 + ai * HALF + m * 16) * ldc + col0;
#pragma unroll
                for (int bj = 0; bj < 2; ++bj)
#pragma unroll
                    for (int n = 0; n < 2; ++n) *(f32x4*)(rowp + bj * HALF + n * 16) = acc[ai][bj][m][n]; }
    }
};
struct EpiGateRes {
    static constexpr bool PERM = false, AFTER_DRAIN = false;
    const float* base; float* out; int ldc; const float* gate; int set_stride; int rows_per_set; int nsets_lat; int lat_rows;
    __device__ __forceinline__ void operator()(const f32x4 (&acc)[2][2][4][2], const Unit& u, int wr, int wc, int fr, int fq) const {
        const int row0 = u.pm * BM + wr * 64 + fr, col0 = u.pn * BM + wc * 32 + 4 * fq;
        const int set = (u.pm * BM >= lat_rows) ? nsets_lat : (u.pm * BM) / rows_per_set;
        const float* gp = gate + (size_t)set * set_stride + col0;
        f32x4 gv[2][2];
#pragma unroll
        for (int bj = 0; bj < 2; ++bj)
#pragma unroll
            for (int n = 0; n < 2; ++n) gv[bj][n] = *(const f32x4*)(gp + bj * HALF + n * 16);
#pragma unroll
        for (int ai = 0; ai < 2; ++ai)
#pragma unroll
            for (int m = 0; m < 4; ++m) { const size_t off = (size_t)(row0 + ai * HALF + m * 16) * ldc + col0;
#pragma unroll
                for (int bj = 0; bj < 2; ++bj)
#pragma unroll
                    for (int n = 0; n < 2; ++n) { const f32x4 b = *(const f32x4*)(base + off + bj * HALF + n * 16); *(f32x4*)(out + off + bj * HALF + n * 16) = b + gv[bj][n] * acc[ai][bj][m][n]; } }
    }
};

struct EpiConvAct {
    static constexpr bool PERM = false, AFTER_DRAIN = false;
    bf16_t* ACT; bf16_t* HALO; const float* cw; const float* cb; int dff;
    __device__ __forceinline__ static float ror1(float v) { return __int_as_float(__builtin_amdgcn_update_dpp(0, __float_as_int(v), 0x121, 0xf, 0xf, false)); }
    __device__ __forceinline__ static float rol1(float v) { return __int_as_float(__builtin_amdgcn_update_dpp(0, __float_as_int(v), 0x12f, 0xf, 0xf, false)); }
    __device__ __forceinline__ void operator()(const f32x4 (&acc)[2][2][4][2], const Unit& u, int wr, int wc, int fr, int fq) const {
        const int rowb = u.pm * BM + wr * 64, chb = u.pn * HALF + wc * 32 + 4 * fq;
        const bool f0 = fr == 0, f15 = fr == 15;
        typedef float f32x2 __attribute__((ext_vector_type(2)));
#pragma unroll
        for (int n = 0; n < 2; ++n)
#pragma unroll
            for (int ep = 0; ep < 2; ++ep) { const int ch = chb + 16 * n + 2 * ep;
                f32x2 wa[3], wg[3], ba, bg;
#pragma unroll
                for (int k = 0; k < 3; ++k) { wa[k] = *(const f32x2*)(cw + (size_t)k * 2 * dff + ch); wg[k] = *(const f32x2*)(cw + (size_t)k * 2 * dff + dff + ch); }
                ba = *(const f32x2*)(cb + ch); bg = *(const f32x2*)(cb + dff + ch);
#pragma unroll
                for (int ai = 0; ai < 2; ++ai) { const int blk = (rowb + ai * HALF) >> 6;
                    float y[4][2];
#pragma unroll
                    for (int eo = 0; eo < 2; ++eo) { const int e = 2 * ep + eo;
                        float Ra[4], La[4], Rg[4], Lg[4];
#pragma unroll
                        for (int m = 0; m < 4; ++m) { Ra[m] = ror1(acc[ai][0][m][n][e]); La[m] = rol1(acc[ai][0][m][n][e]); Rg[m] = ror1(acc[ai][1][m][n][e]); Lg[m] = rol1(acc[ai][1][m][n][e]); }
#pragma unroll
                        for (int m = 0; m < 4; ++m) {
                            const float ap = f0 ? Ra[m > 0 ? m - 1 : 0] : Ra[m], an = f15 ? La[m < 3 ? m + 1 : 3] : La[m];
                            const float gp = f0 ? Rg[m > 0 ? m - 1 : 0] : Rg[m], gn = f15 ? Lg[m < 3 ? m + 1 : 3] : Lg[m];
                            const float a = ba[eo] + wa[0][eo] * ap + wa[1][eo] * acc[ai][0][m][n][e] + wa[2][eo] * an;
                            const float g = bg[eo] + wg[0][eo] * gp + wg[1][eo] * acc[ai][1][m][n][e] + wg[2][eo] * gn;
                            y[m][eo] = a * (g * __builtin_amdgcn_rcpf(1.0f + __expf(-g))); }
                    }
#pragma unroll
                    for (int m = 0; m < 4; ++m) { const int row = rowb + ai * HALF + 16 * m + fr;
                        *(unsigned*)(ACT + (size_t)row * dff + ch) = cvt_pk_bf16(y[m][0], y[m][1]);
                        if ((m == 0 && fr < 2) || (m == 3 && fr >= 14)) { const int slot = m == 0 ? fr : fr - 12; bf16_t* hp = HALO + ((size_t)blk * 4 + slot) * (2 * dff) + ch;
                            *(unsigned*)hp = cvt_pk_bf16(acc[ai][0][m][n][2 * ep], acc[ai][0][m][n][2 * ep + 1]);
                            *(unsigned*)(hp + dff) = cvt_pk_bf16(acc[ai][1][m][n][2 * ep], acc[ai][1][m][n][2 * ep + 1]); }
                    }
                }
            }
    }
};

struct EpiPart {
    static constexpr bool PERM = false, AFTER_DRAIN = false;
    float* C; int ldc; size_t ks_stride;
    __device__ __forceinline__ void operator()(const f32x4 (&acc)[2][2][4][2], const Unit& u, int wr, int wc, int fr, int fq) const {
        const int row0 = u.pm * BM + wr * 64 + fr, col0 = u.pn * BM + wc * 32 + 4 * fq; float* Cb = C + (size_t)u.ks * ks_stride;
#pragma unroll
        for (int ai = 0; ai < 2; ++ai)
#pragma unroll
            for (int m = 0; m < 4; ++m) { float* rowp = Cb + (size_t)(row0 + ai * HALF + m * 16) * ldc + col0;
#pragma unroll
                for (int bj = 0; bj < 2; ++bj)
#pragma unroll
                    for (int n = 0; n < 2; ++n) *(f32x4*)(rowp + bj * HALF + n * 16) = acc[ai][bj][m][n]; }
    }
};

template <class Epi, class Sched, bool ALIGN_EPI = false, bool SP2 = false>
__device__ __forceinline__ void gemm_phase(PG8_LAS unsigned char* lds, const Gemm g, const Sched& S, const Epi& E, const int tid_in) {
    int tid_ = tid_in; asm volatile("" : "+v"(tid_));
    const int tid = tid_, wid = __builtin_amdgcn_readfirstlane(tid >> 6), lane = tid & 63, wr = wid >> 2, wc = wid & 3, fr = lane & 15, fq = lane >> 4;
    const int K = g.K, nt = K / BK;
    unsigned voffA[2], voffB[2];
#pragma unroll
    for (int i = 0; i < 2; ++i) { int R, C; stage_rc(tid * 16 + i * 8192, R, C); const int Rb = Epi::PERM ? ((R & ~31) + perm32(R & 31)) : R;
        voffA[i] = (unsigned)(R * g.ld + C) * 2u; voffB[i] = (unsigned)(Rb * g.ld + C) * 2u; }
    const size_t kstep = (size_t)(BK * 2);
    const size_t hstep = (size_t)HALF * g.ld * 2;
    const size_t tstep = 2 * hstep;
    const unsigned ldsw = (unsigned)wid * 1024u;
    const int aoff = lds_byte(wr * 64 + fr, fq * 8), boff = lds_byte(wc * 32 + fr, fq * 8);
#define PG8_SA(b, h) (((b) * 2 + (h)) * HTB)
#define PG8_SB(b, h) ((4 + (b) * 2 + (h)) * HTB)
#define PG8_STAGE(bufoff, gbase, voff) do { _Pragma("unroll") for (int _i = 0; _i < 2; ++_i) \
        __builtin_amdgcn_global_load_lds((const unsigned*)((const char*)(gbase) + (voff)[_i]), (PG8_LAS unsigned*)(lds + (bufoff) + ldsw + _i * 8192), 16, 0, 0); } while (0)
#define PG8_LDA(dst, b, h) do { _Pragma("unroll") for (int m = 0; m < 4; ++m) _Pragma("unroll") for (int k = 0; k < 2; ++k) dst[m][k] = *(const PG8_LAS bf16x8*)(lds + PG8_SA(b, h) + aoff + m * 2048 + k * 1024); } while (0)
#define PG8_LDB(dst, b, h) do { _Pragma("unroll") for (int n = 0; n < 2; ++n) _Pragma("unroll") for (int k = 0; k < 2; ++k) dst[n][k] = *(const PG8_LAS bf16x8*)(lds + PG8_SB(b, h) + boff + n * 2048 + k * 1024); } while (0)
#define PG8_MMA(ai, bj, At, Bt) do { __builtin_amdgcn_s_setprio(1); _Pragma("unroll") for (int m = 0; m < 4; ++m) _Pragma("unroll") for (int n = 0; n < 2; ++n) _Pragma("unroll") for (int k = 0; k < 2; ++k) \
        acc[ai][bj][m][n] = __builtin_amdgcn_mfma_f32_16x16x32_bf16(Bt[n][k], At[m][k], acc[ai][bj][m][n], 0, 0, 0); __builtin_amdgcn_s_setprio(0); } while (0)
#define PG8_WAIT_V(n) asm volatile("s_waitcnt vmcnt(" #n ")" ::: "memory")
#define PG8_WAIT_L(n) asm volatile("s_waitcnt lgkmcnt(" #n ")" ::: "memory")
#define PG8_BAR __builtin_amdgcn_s_barrier()
#define PG8_SCHED __builtin_amdgcn_sched_barrier(0)
    Unit cur, nxt; int ui = 0;
    if (!S.next(0, cur)) return;
    f32x4 acc[2][2][4][2];
#pragma unroll
    for (int a = 0; a < 2; ++a)
#pragma unroll
        for (int b = 0; b < 2; ++b)
#pragma unroll
            for (int m = 0; m < 4; ++m)
#pragma unroll
                for (int n = 0; n < 2; ++n) acc[a][b][m][n] = (f32x4){0.f, 0.f, 0.f, 0.f};
    bf16x8 At[4][2], B0[2][2], B1[2][2];
    const size_t ksb = (size_t)K * 2;
    const char* cA = (const char*)g.A + (size_t)cur.pm * tstep + (size_t)cur.ks * ksb; const char* cB = (const char*)g.Bt + (size_t)cur.pn * tstep + (size_t)cur.ks * ksb;
    S.a_ready(cur);
    if constexpr (SP2) {
        PG8_STAGE(PG8_SB(0, 0), cB, voffB); PG8_STAGE(PG8_SB(0, 1), cB + hstep, voffB); PG8_STAGE(PG8_SA(0, 0), cA, voffA); PG8_STAGE(PG8_SA(0, 1), cA + hstep, voffA);
        if (wr == 1) PG8_BAR;
        PG8_WAIT_V(2); PG8_BAR;
        PG8_STAGE(PG8_SB(1, 0), cB + kstep, voffB); PG8_STAGE(PG8_SA(1, 0), cA + kstep, voffA); PG8_STAGE(PG8_SB(1, 1), cB + hstep + kstep, voffB);
        PG8_WAIT_V(6); PG8_BAR;
    } else {
        PG8_STAGE(PG8_SB(0, 0), cB, voffB); PG8_STAGE(PG8_SA(0, 0), cA, voffA); PG8_STAGE(PG8_SB(0, 1), cB + hstep, voffB); PG8_STAGE(PG8_SA(0, 1), cA + hstep, voffA);
        if (wr == 1) PG8_BAR;
        PG8_WAIT_V(4); PG8_BAR;
        PG8_STAGE(PG8_SB(1, 0), cB + kstep, voffB); PG8_STAGE(PG8_SA(1, 0), cA + kstep, voffA); PG8_STAGE(PG8_SB(1, 1), cB + hstep + kstep, voffB);
        PG8_WAIT_V(6); PG8_BAR;
    }
    for (;;) {
        const bool has_next = S.next(ui + 1, nxt);
        const char* nA = has_next ? (const char*)g.A + (size_t)nxt.pm * tstep + (size_t)nxt.ks * ksb : cA; const char* nB = has_next ? (const char*)g.Bt + (size_t)nxt.pn * tstep + (size_t)nxt.ks * ksb : cB;
        for (int t = 0; t < nt; t += 2) {
            const bool last = (t == nt - 2);
            const char* a1 = cA + (size_t)(t + 1) * kstep;
            const char* a2 = last ? nA : cA + (size_t)(t + 2) * kstep; const char* b2 = last ? nB : cB + (size_t)(t + 2) * kstep;
            const char* a3 = a2 + kstep; const char* b3 = b2 + kstep;
            if (last && has_next) S.a_ready(nxt);
            if constexpr (SP2) {
            PG8_LDB(B0, 0, 0); PG8_LDB(B1, 0, 1); PG8_SCHED; PG8_LDA(At, 0, 0); PG8_STAGE(PG8_SA(1, 1), a1 + hstep, voffA);
            PG8_WAIT_V(8); PG8_WAIT_L(0); PG8_BAR; PG8_MMA(0, 0, At, B0); PG8_MMA(0, 1, At, B1); PG8_BAR; PG8_SCHED;
            PG8_LDA(At, 0, 1); PG8_STAGE(PG8_SB(0, 0), b2, voffB); PG8_STAGE(PG8_SB(0, 1), b2 + hstep, voffB); PG8_STAGE(PG8_SA(0, 0), a2, voffA);
            PG8_WAIT_V(8); PG8_WAIT_L(0); PG8_BAR; PG8_MMA(1, 0, At, B0); PG8_MMA(1, 1, At, B1); PG8_BAR; PG8_SCHED;
            PG8_LDB(B0, 1, 0); PG8_LDB(B1, 1, 1); PG8_SCHED; PG8_LDA(At, 1, 0); PG8_STAGE(PG8_SA(0, 1), a2 + hstep, voffA);
            PG8_WAIT_V(8); PG8_WAIT_L(0); PG8_BAR; PG8_MMA(0, 0, At, B0); PG8_MMA(0, 1, At, B1); PG8_BAR; PG8_SCHED;
            PG8_LDA(At, 1, 1); PG8_STAGE(PG8_SB(1, 0), b3, voffB); PG8_STAGE(PG8_SB(1, 1), b3 + hstep, voffB); PG8_STAGE(PG8_SA(1, 0), a3, voffA);
            PG8_WAIT_V(8); PG8_WAIT_L(0); PG8_BAR; PG8_MMA(1, 0, At, B0); PG8_MMA(1, 1, At, B1); PG8_BAR; PG8_SCHED;
            } else {
            PG8_LDB(B0, 0, 0); PG8_SCHED; PG8_LDA(At, 0, 0); PG8_STAGE(PG8_SA(1, 1), a1 + hstep, voffA);
            PG8_WAIT_L(8); PG8_BAR; PG8_WAIT_L(0); PG8_MMA(0, 0, At, B0); PG8_BAR; PG8_SCHED;
            PG8_LDB(B1, 0, 1); PG8_STAGE(PG8_SB(0, 0), b2, voffB);
            PG8_BAR; PG8_WAIT_L(0); PG8_MMA(0, 1, At, B1); PG8_BAR;
            PG8_LDA(At, 0, 1); PG8_STAGE(PG8_SA(0, 0), a2, voffA);
            PG8_BAR; PG8_WAIT_L(0); PG8_MMA(1, 0, At, B0); PG8_BAR; PG8_SCHED;
            PG8_STAGE(PG8_SB(0, 1), b2 + hstep, voffB);
            PG8_WAIT_V(6); PG8_BAR; PG8_MMA(1, 1, At, B1); PG8_BAR;
            PG8_LDB(B0, 1, 0); PG8_SCHED; PG8_LDA(At, 1, 0); PG8_STAGE(PG8_SA(0, 1), a2 + hstep, voffA);
            PG8_WAIT_L(8); PG8_BAR; PG8_WAIT_L(0); PG8_MMA(0, 0, At, B0); PG8_BAR; PG8_SCHED;
            PG8_LDB(B1, 1, 1); PG8_STAGE(PG8_SB(1, 0), b3, voffB);
            PG8_BAR; PG8_WAIT_L(0); PG8_MMA(0, 1, At, B1); PG8_BAR;
            PG8_LDA(At, 1, 1); PG8_STAGE(PG8_SA(1, 0), a3, voffA);
            PG8_BAR; PG8_WAIT_L(0); PG8_MMA(1, 0, At, B0); PG8_BAR; PG8_SCHED;
            PG8_STAGE(PG8_SB(1, 1), b3 + hstep, voffB);
            PG8_WAIT_V(6); PG8_BAR; PG8_MMA(1, 1, At, B1); PG8_BAR;
            }
        }
        if constexpr (ALIGN_EPI) { if (wr == 0) PG8_BAR; }
        if constexpr (!Epi::AFTER_DRAIN) { E(acc, cur, wr, wc, fr, fq); S.done(cur); }
        if (!has_next) break;
#pragma unroll
        for (int a = 0; a < 2; ++a)
#pragma unroll
            for (int b = 0; b < 2; ++b)
#pragma unroll
                for (int m = 0; m < 4; ++m)
#pragma unroll
                    for (int n = 0; n < 2; ++n) acc[a][b][m][n] = (f32x4){0.f, 0.f, 0.f, 0.f};
        cur = nxt; cA = nA; cB = nB; ++ui;
        if constexpr (ALIGN_EPI) { if (wr == 1) PG8_BAR; }
    }
    PG8_WAIT_V(0);
    if constexpr (!ALIGN_EPI) { if (wr == 0) PG8_BAR; }
    PG8_BAR;
    if constexpr (Epi::AFTER_DRAIN) { E.fused(acc, cur, wr, wc, fr, fq, lds, wid, lane); S.done(cur); }
#undef PG8_SA
#undef PG8_SB
#undef PG8_STAGE
#undef PG8_LDA
#undef PG8_LDB
#undef PG8_MMA
#undef PG8_WAIT_V
#undef PG8_WAIT_L
#undef PG8_BAR
#undef PG8_SCHED
}
}

namespace att {
using bf16x8 = __attribute__((ext_vector_type(8))) short;
using s16x4  = __attribute__((ext_vector_type(4))) short;
using f32x16 = __attribute__((ext_vector_type(16))) float;
using u32x4  = __attribute__((ext_vector_type(4))) unsigned;
constexpr int NW = 8, QBLK = 32, KVBLK = 64, DV = 128;
#define ATT_SBAR() __builtin_amdgcn_sched_barrier(0)
__device__ __forceinline__ int crow(int r, int hi) { return (r & 3) + 8 * (r >> 2) + 4 * hi; }
__device__ __forceinline__ unsigned cvtpk(float lo, float hi) { unsigned r; asm volatile("v_cvt_pk_bf16_f32 %0, %1, %2" : "=v"(r) : "v"(lo), "v"(hi)); return r; }
template <int DQK> __device__ __forceinline__ int kswz(int row, int colB) { return row * (DQK * 2) + (colB ^ ((row & 7) << 4)); }
constexpr float THR = 8.f;

template <int DQK> struct Cfg {
    static constexpr int SHM_V = KVBLK * DV * 2, SHM_K = KVBLK * DQK * 2;
    static constexpr int OFF_V = 0, OFF_K = 2 * SHM_V, OFF_WS = OFF_K + 2 * SHM_K, OFF_BIAS = OFF_WS + NW * 64 * 4, LDS_BYTES = OFF_BIAS + 10240;
    static constexpr int KCH = DQK / 8;
    static constexpr int KLD = (64 * KCH) / 512;
};

struct Job {
    const bf16_t* Q;
    const bf16_t* K;
    const bf16_t* V;
    bf16_t* O;
    int nt;
    int seg0_tiles, row_seg0, row_seg1;
    int R0; int rlo;
};

__device__ __forceinline__ int tile_row(const Job& J, int j) {
    if (j < J.seg0_tiles) return J.row_seg0 + 64 * j;
    int jj = j - J.seg0_tiles; if (jj > 3) jj = 0; return J.row_seg1 + 64 * jj;
}

__device__ __forceinline__ void partialSM(f32x16& p0, f32x16& p1, float& m_reg, float& mn, float& alpha, float C, float thr_raw) {
    float pmax = p0[0];
#pragma unroll
    for (int r = 1; r < 16; ++r) pmax = fmaxf(pmax, p0[r]);
#pragma unroll
    for (int r = 0; r < 16; ++r) pmax = fmaxf(pmax, p1[r]);
    { auto rr = __builtin_amdgcn_permlane32_swap(__float_as_uint(pmax), __float_as_uint(pmax), false, false);
      pmax = fmaxf(__uint_as_float(rr[0]), __uint_as_float(rr[1])); }
    if (__builtin_expect(__all(pmax - m_reg <= thr_raw), 1)) { mn = m_reg; alpha = 1.f; }
    else { mn = fmaxf(m_reg, pmax); alpha = __builtin_amdgcn_exp2f((m_reg - mn) * C); m_reg = mn; }
    const float mnC = -mn * C;
#pragma unroll
    for (int r = 0; r < 16; ++r) p0[r] = fmaf(p0[r], C, mnC);
#pragma unroll
    for (int r = 0; r < 16; ++r) p1[r] = fmaf(p1[r], C, mnC);
#pragma unroll
    for (int r = 0; r < 16; ++r) p0[r] = __builtin_amdgcn_exp2f(p0[r]);
}
__device__ __forceinline__ void finishSM(f32x16& p0, f32x16& p1, float alpha, float& l_reg, bf16x8& pa0, bf16x8& pa1, bf16x8& pa2, bf16x8& pa3) {
#pragma unroll
    for (int r = 0; r < 16; ++r) p1[r] = __builtin_amdgcn_exp2f(p1[r]);
    float ps = 0;
#pragma unroll
    for (int r = 0; r < 16; ++r) ps += p0[r];
#pragma unroll
    for (int r = 0; r < 16; ++r) ps += p1[r];
    { auto rr = __builtin_amdgcn_permlane32_swap(__float_as_uint(ps), __float_as_uint(ps), false, false);
      ps = __uint_as_float(rr[0]) + __uint_as_float(rr[1]); }
    l_reg = l_reg * alpha + ps;
#define ATT_PK4(P, BASE, OUT) do { unsigned a0 = cvtpk(P[BASE + 0], P[BASE + 1]), a1 = cvtpk(P[BASE + 2], P[BASE + 3]);   \
    unsigned b0 = cvtpk(P[BASE + 4], P[BASE + 5]), b1 = cvtpk(P[BASE + 6], P[BASE + 7]);                              \
    auto r0 = __builtin_amdgcn_permlane32_swap(a0, b0, false, false); auto r1 = __builtin_amdgcn_permlane32_swap(a1, b1, false, false); \
    u32x4 w = {r0[0], r1[0], r0[1], r1[1]}; OUT = *reinterpret_cast<bf16x8*>(&w); } while (0)
    ATT_PK4(p0, 0, pa0); ATT_PK4(p0, 8, pa1); ATT_PK4(p1, 0, pa2); ATT_PK4(p1, 8, pa3);
#undef ATT_PK4
}
template <int DQK> __device__ __forceinline__ void qkt(f32x16& p0, f32x16& p1, const char* Ks, const bf16x8* qr, int r32, int hi) {
    p0 = f32x16{}; p1 = f32x16{};
#pragma unroll
    for (int d0 = 0; d0 < DQK / 16; ++d0) { const int cb = (d0 * 16 + hi * 8) * 2;
        const bf16x8 b0 = *reinterpret_cast<const bf16x8*>(Ks + kswz<DQK>(r32, cb));
        const bf16x8 b1 = *reinterpret_cast<const bf16x8*>(Ks + kswz<DQK>(32 + r32, cb));
        p0 = __builtin_amdgcn_mfma_f32_32x32x16_bf16(b0, qr[d0], p0, 0, 0, 0);
        p1 = __builtin_amdgcn_mfma_f32_32x32x16_bf16(b1, qr[d0], p1, 0, 0, 0); }
}
__device__ __forceinline__ int v_st(int k, int c) { const int kk = (k & ~0xC) | ((k & 4) << 1) | ((k & 8) >> 1); return ((kk >> 3) * 4 + (c >> 5)) * 512 + ((kk & 7) * 32 + (c & 31)) * 2; }
__device__ __forceinline__ int v_rd_base(int lane) { return ((lane & 3) << 3) | (((lane >> 2) & 3) << 6) | (((lane >> 4) & 1) << 5) | (((lane >> 5) & 1) << 8); }
constexpr int v_rd_off(int d0, int ks, int half) { return d0 * 512 + ks * 4096 + half * 2048; }
template <int OFF> __device__ __forceinline__ s16x4 tr_read(int vb) { s16x4 r; asm volatile("ds_read_b64_tr_b16 %0, %1 offset:%2" : "=&v"(r) : "v"(vb), "i"(OFF) : "memory"); return r; }
template <int D0> __device__ __forceinline__ void pv_one(f32x16& od, int vb, bf16x8 pa0, bf16x8 pa1, bf16x8 pa2, bf16x8 pa3) {
    const s16x4 l0 = tr_read<v_rd_off(D0, 0, 0)>(vb), h0 = tr_read<v_rd_off(D0, 0, 1)>(vb), l1 = tr_read<v_rd_off(D0, 1, 0)>(vb), h1 = tr_read<v_rd_off(D0, 1, 1)>(vb);
    const s16x4 l2 = tr_read<v_rd_off(D0, 2, 0)>(vb), h2 = tr_read<v_rd_off(D0, 2, 1)>(vb), l3 = tr_read<v_rd_off(D0, 3, 0)>(vb), h3 = tr_read<v_rd_off(D0, 3, 1)>(vb);
    asm volatile("s_waitcnt lgkmcnt(0)" ::: "memory"); ATT_SBAR();
#define ATT_PK(L, H) (bf16x8){L[0], L[1], L[2], L[3], H[0], H[1], H[2], H[3]}
    od = __builtin_amdgcn_mfma_f32_32x32x16_bf16(pa0, ATT_PK(l0, h0), od, 0, 0, 0);
    od = __builtin_amdgcn_mfma_f32_32x32x16_bf16(pa1, ATT_PK(l1, h1), od, 0, 0, 0);
    od = __builtin_amdgcn_mfma_f32_32x32x16_bf16(pa2, ATT_PK(l2, h2), od, 0, 0, 0);
    od = __builtin_amdgcn_mfma_f32_32x32x16_bf16(pa3, ATT_PK(l3, h3), od, 0, 0, 0);
#undef ATT_PK
}
__device__ __forceinline__ void pv_d0(f32x16* o, int vb, bf16x8 pa0, bf16x8 pa1, bf16x8 pa2, bf16x8 pa3) {
    pv_one<0>(o[0], vb, pa0, pa1, pa2, pa3); pv_one<1>(o[1], vb, pa0, pa1, pa2, pa3); pv_one<2>(o[2], vb, pa0, pa1, pa2, pa3); pv_one<3>(o[3], vb, pa0, pa1, pa2, pa3);
}
constexpr int NA_BROW = 160, NA_BORG = 64 + (NA_KW - 1);
__device__ __forceinline__ void na_bias(f32x16& p0, f32x16& p1, const Job& J, int j, int R, int c, int hi, const float* biasq) {
    const int nloc = J.seg0_tiles;
    if (j >= nloc && j < nloc + 4) return;
    const int rr = J.rlo + j; int r0 = R - NA_KH / 2; r0 = r0 < 0 ? 0 : (r0 > ROWS - NA_KH ? ROWS - NA_KH : r0);
    const bool rowok = (j < nloc) && rr >= r0 && rr < r0 + NA_KH;
    if (!rowok) {
#pragma unroll
        for (int r = 0; r < 16; ++r) { p0[r] = -1e30f; p1[r] = -1e30f; }
        return; }
    int c0 = c - NA_KW / 2; c0 = c0 < 0 ? 0 : (c0 > GRID_W - NA_KW ? GRID_W - NA_KW : c0);
    const int dr = rr - R + (NA_KH - 1);
    const float* bl = biasq + dr * NA_BROW + NA_BORG + 4 * hi - c;
    const int vb = 4 * hi - c0;
#pragma unroll
    for (int r = 0; r < 16; ++r) { const int cc = (r & 3) + 8 * (r >> 2);
        p0[r] = ((unsigned)(cc + vb) < (unsigned)NA_KW) ? p0[r] + bl[cc] : -1e30f;
        p1[r] = ((unsigned)(cc + 32 + vb) < (unsigned)NA_KW) ? p1[r] + bl[cc + 32] : -1e30f; }
}

#define ATT_LAS __attribute__((address_space(3)))
template <int DQK, bool NA, int LDQ, int LDK, int LDV, int LDO>
__device__ __forceinline__ void attn_unit(const Job& J, char* lds, const float scale, const int tid_in) {
    using C_ = Cfg<DQK>;
    int tid_ = tid_in; asm volatile("" : "+v"(tid_));
    const int tid = tid_, wid = __builtin_amdgcn_readfirstlane(tid >> 6), lane = tid & 63, r32 = lane & 31, hi = lane >> 5;
    char* V_lds = lds + C_::OFF_V; char* K_lds = lds + C_::OFF_K;
    const unsigned ldsb = (unsigned)(uintptr_t)lds;
    float* wsf = (float*)(lds + C_::OFF_WS) + wid * 64; float* li_l = wsf; float* al_l = wsf + 32;
    const float* biasq = (const float*)(lds + C_::OFF_BIAS);
    const float Cc = scale * 1.4426950408889634f, thr_raw = THR / scale;
    float m_reg = -1e5f, l_reg = 0; f32x16 o[4] = {}; bf16x8 qr[DQK / 16];
    const bf16_t* Qw = J.Q + (long)(wid * QBLK + r32) * LDQ + hi * 8;
#pragma unroll
    for (int d0 = 0; d0 < DQK / 16; ++d0) qr[d0] = *reinterpret_cast<const bf16x8*>(Qw + d0 * 16);
    const int naR = J.R0 + (wid >> 1), nac = (wid & 1) * 32 + r32;
    const int vb0 = (int)(uintptr_t)V_lds + v_rd_base(lane);
    unsigned koff[C_::KLD], voff[2];
#pragma unroll
    for (int i = 0; i < C_::KLD; ++i) { const int sl = 512 * i + tid, row = sl / C_::KCH, cs = sl % C_::KCH, chunk = (cs & ~7) | ((cs & 7) ^ (row & 7)); koff[i] = (unsigned)(row * LDK * 2 + chunk * 16); }
#pragma unroll
    for (int i = 0; i < 2; ++i) { const int sl = 512 * i + tid, sub = sl >> 5, wi = sl & 31, kk = (sub >> 2) * 8 + (wi >> 2), k = (kk & ~0xC) | ((kk & 4) << 1) | ((kk & 8) >> 1), c = (sub & 3) * 32 + (wi & 3) * 8;
        voff[i] = (unsigned)(k * LDV * 2 + c * 2); }
#define ATT_STAGE(j, b) do { const int row0_ = tile_row(J, (j)); const char* vp_ = (const char*)(J.V + (size_t)row0_ * LDV); const char* kp_ = (const char*)(J.K + (size_t)row0_ * LDK); \
        _Pragma("unroll") for (int i_ = 0; i_ < C_::KLD; ++i_) __builtin_amdgcn_global_load_lds((const unsigned*)(kp_ + koff[i_]), (ATT_LAS unsigned*)(ldsb + C_::OFF_K + (b) * C_::SHM_K + (512 * i_ + 64 * wid) * 16), 16, 0, 0); \
        _Pragma("unroll") for (int i_ = 0; i_ < 2; ++i_) __builtin_amdgcn_global_load_lds((const unsigned*)(vp_ + voff[i_]), (ATT_LAS unsigned*)(ldsb + C_::OFF_V + (b) * C_::SHM_V + (512 * i_ + 64 * wid) * 16), 16, 0, 0); } while (0)
    const int NT = J.nt;
    __syncthreads();
    ATT_STAGE(0, 0); asm volatile("s_waitcnt vmcnt(0)" ::: "memory"); __syncthreads();
    for (int j = 0; j < NT; ++j) {
        const int buf = j & 1;
        if (j + 1 < NT) ATT_STAGE(j + 1, buf ^ 1);
        f32x16 p0, p1; float mn, al; bf16x8 pa0, pa1, pa2, pa3;
        qkt<DQK>(p0, p1, K_lds + buf * C_::SHM_K, qr, r32, hi);
        if (NA) na_bias(p0, p1, J, j, naR, nac, hi, biasq);
        partialSM(p0, p1, m_reg, mn, al, Cc, thr_raw);
        finishSM(p0, p1, al, l_reg, pa0, pa1, pa2, pa3);
        if (__any(al < 1.f)) { if (hi == 0) al_l[r32] = al; asm volatile("s_waitcnt lgkmcnt(0)" ::: "memory");
#pragma unroll
            for (int d = 0; d < 4; ++d)
#pragma unroll
                for (int r = 0; r < 16; ++r) o[d][r] *= al_l[crow(r, hi)]; }
        ATT_SBAR();
        pv_d0(o, vb0 + buf * C_::SHM_V, pa0, pa1, pa2, pa3);
        asm volatile("s_waitcnt vmcnt(0)" ::: "memory");
        __syncthreads();
    }
    if (hi == 0) li_l[r32] = l_reg; asm volatile("s_waitcnt lgkmcnt(0)" ::: "memory");
    float rli[16];
#pragma unroll
    for (int r = 0; r < 16; ++r) rli[r] = __builtin_amdgcn_rcpf(li_l[crow(r, hi)]);
    bf16_t* Ow = J.O + (long)(wid * QBLK) * LDO;
#pragma unroll
    for (int r = 0; r < 16; ++r) { const int orow = crow(r, hi);
#pragma unroll
        for (int d0 = 0; d0 < 4; ++d0) Ow[(long)orow * LDO + d0 * 32 + r32] = f2bf(o[d0][r] * rli[r]); }
#undef ATT_STAGE
}
}

struct AttnArgs { const bf16_t *QM, *KM, *VM, *NQ, *NK, *P; bf16_t* Y; const float* rpb; int want_ctx; int pad; };
__device__ __forceinline__ void attention_phase(const AttnArgs& A, char* lds, int G, int wg, const int tid, const int nskip) {
    static_assert(GRID_W == 64 && SEQ % 256 == 0 && CTX_LEN == 256 && HD == 128, "attention phase geometry");
    constexpr int NQB = SEQ / 256;
    constexpr float sc_mla = 0.07216878364870323f, sc_na = 0.08838834764831845f;
    static_assert(MLA_QK == 192 && HD == 128, "softmax scales");
    if (!(A.pad & 2)) for (int u = wg; u < BATCH * NH * NQB; u += G) {
        const int bh = u % (BATCH * NH), qb = u / (BATCH * NH), b = bh / NH, h = bh % NH;
        att::Job J{};
        J.Q = A.QM + (size_t)(b * SEQ + qb * 256) * NQ_MLA + h * MLA_QK; J.K = A.KM + h * MLA_QK; J.V = A.VM + h * MLA_V;
        J.O = A.Y + (size_t)(b * SEQ + qb * 256) * D_MODEL + GROUP_W + h * MLA_V;
        J.nt = SEQ / 64 + CTX_LEN / 64; J.seg0_tiles = SEQ / 64; J.row_seg0 = b * SEQ; J.row_seg1 = M_LAT + b * CTX_LEN;
        att::attn_unit<MLA_QK, false, NQ_MLA, NQ_MLA, NH * MLA_V, D_MODEL>(J, lds, sc_mla, tid);
    }
    const int G2n = G - nskip, c2 = wg - nskip;
    if (!(A.pad & 4) && c2 >= 0) for (int u = c2; u < BATCH * NH * NQB; u += G2n) {
        const int bh = u % (BATCH * NH), qb = u / (BATCH * NH), b = bh / NH, h = bh % NH, R0 = qb * 4;
        __syncthreads();
        { float* bq = (float*)(lds + att::Cfg<HD>::OFF_BIAS); const float* src = A.rpb + (size_t)h * (2 * NA_KH - 1) * (2 * NA_KW - 1);
          for (int i = tid; i < (2 * NA_KH - 1) * att::NA_BROW; i += 512) { const int dr = i / att::NA_BROW; int dc = i % att::NA_BROW - att::NA_BORG + (NA_KW - 1); dc = dc < 0 ? 0 : (dc > 2 * NA_KW - 2 ? 2 * NA_KW - 2 : dc);
              bq[i] = src[dr * (2 * NA_KW - 1) + dc] * 11.313708498984761f; } }
        int rlo = R0 - NA_KH / 2; rlo = rlo < 0 ? 0 : (rlo > ROWS - NA_KH ? ROWS - NA_KH : rlo);
        int rhi = R0 + 3 - NA_KH / 2; rhi = (rhi < 0 ? 0 : (rhi > ROWS - NA_KH ? ROWS - NA_KH : rhi)) + NA_KH - 1;
        const int nloc = rhi - rlo + 1;
        att::Job J{};
        J.Q = A.NQ + (size_t)(b * SEQ + R0 * 64) * GROUP_W + h * HD; J.K = A.NK + h * HD; J.V = A.P + C_NV + h * HD;
        J.O = A.Y + (size_t)(b * SEQ + R0 * 64) * D_MODEL + 3 * GROUP_W + h * HD;
        J.nt = (nloc + 4 + 1) & ~1; J.seg0_tiles = nloc; J.row_seg0 = b * SEQ + rlo * 64; J.row_seg1 = M_LAT + b * CTX_LEN;  J.R0 = R0; J.rlo = rlo;
        att::attn_unit<HD, true, GROUP_W, GROUP_W, NP, D_MODEL>(J, lds, sc_na, tid);
    }
    if (A.want_ctx && !(A.pad & 8)) {
        for (int u = c2 - 64; u >= 0 && u < BATCH * NH; u += G) {
            const int b = u / NH, h = u % NH; const int crow0 = M_LAT + b * CTX_LEN;
            att::Job J{}; J.nt = CTX_LEN / 64; J.seg0_tiles = 0; J.row_seg0 = crow0; J.row_seg1 = crow0;
            J.Q = A.QM + (size_t)crow0 * NQ_MLA + h * MLA_QK; J.K = A.KM + h * MLA_QK; J.V = A.VM + h * MLA_V;
            J.O = A.Y + (size_t)crow0 * D_MODEL + GROUP_W + h * MLA_V; att::attn_unit<MLA_QK, false, NQ_MLA, NQ_MLA, NH * MLA_V, D_MODEL>(J, lds, sc_mla, tid);
        }
        for (int u = c2 - 64 - BATCH * NH; u >= 0 && u < BATCH * NH; u += G) {
            const int b = u / NH, h = u % NH; const int crow0 = M_LAT + b * CTX_LEN;
            att::Job J{}; J.nt = CTX_LEN / 64; J.seg0_tiles = 0; J.row_seg0 = crow0; J.row_seg1 = crow0;
            J.Q = A.NQ + (size_t)crow0 * GROUP_W + h * HD; J.K = A.NK + h * HD; J.V = A.P + C_NV + h * HD;
            J.O = A.Y + (size_t)crow0 * D_MODEL + 3 * GROUP_W + h * HD; att::attn_unit<HD, false, GROUP_W, GROUP_W, NP, D_MODEL>(J, lds, sc_na, tid);
        }
    }
}

namespace gdn {
typedef short bf16x8 __attribute__((ext_vector_type(8)));
typedef float f32x4 __attribute__((ext_vector_type(4)));
typedef float f32x16 __attribute__((ext_vector_type(16)));
typedef unsigned u32x2 __attribute__((ext_vector_type(2)));
typedef unsigned u32x4 __attribute__((ext_vector_type(4)));
constexpr int CH = 64, NCHUNK = M_ALL / CH;
constexpr int NTASK = NCHUNK * NH * 2;
constexpr size_t SZ_UT = 128 * 64, SZ_WP = 64 * 128, SZ_KDT = 128 * 64, SZ_QD = 64 * 128, SZ_QK = 64 * 64, SZ_SIT = 128 * 128, SZ_VNT = 128 * 64;
struct Bufs { bf16_t *UT, *WP, *KDT, *QD, *QK, *SIT, *VNT; float* GT; };
__device__ __forceinline__ int perm32(int o) { return (o & ~31) | (((o & 15) >> 2) * 8 + ((o >> 4) & 1) * 4 + (o & 3)); }
__device__ __forceinline__ unsigned pk2(float lo, float hi) { return (unsigned)f2bf(lo) | ((unsigned)f2bf(hi) << 16); }

constexpr int QS = 132;
constexpr int AS = 68;
constexpr int G1_OFF_Q = 0, G1_OFF_K = G1_OFF_Q + CH * QS * 4, G1_OFF_V = G1_OFF_K + CH * QS * 4, G1_OFF_AA = G1_OFF_V + CH * QS * 4, G1_OFF_SM = G1_OFF_AA + 2 * CH * AS * 4,
              G1_LDS = G1_OFF_SM + 12 * 64 * 4;
struct G1Args { const bf16_t* P; const float* conv_w; const float* a_log; const float* dt_bias; Bufs B; int pflags; };

__device__ __forceinline__ void g1_task(const G1Args& A, char* lds, int cix, int h, const int tid_in) {
    int tid_ = tid_in; asm volatile("" : "+v"(tid_));
    const int tid = tid_, wid = __builtin_amdgcn_readfirstlane(tid >> 6), lane = tid & 63;
    float* Qs = (float*)(lds + G1_OFF_Q); float* Ks = (float*)(lds + G1_OFF_K); float* Vs = (float*)(lds + G1_OFF_V); float* AA = (float*)(lds + G1_OFF_AA);
    float* sm = (float*)(lds + G1_OFF_SM); float* g_s = sm;   float* beta_s = sm + 128;   float* gc_s = sm + 256;
    const int row0 = cix * CH; const RowInfo r0i = row_info(row0);
    LDS_BARRIER();
    if (tid < 48 * 8) {
        const int grp = tid % 48, ts = tid / 48, which = grp >> 4, cc0 = (grp & 15) * 8, ch0 = which * GROUP_W + h * HD + cc0;
        float wgt[4][8];
#pragma unroll
        for (int j = 0; j < 4; ++j) { const f32x4 w0 = *(const f32x4*)(A.conv_w + j * 3 * GROUP_W + ch0), w1 = *(const f32x4*)(A.conv_w + j * 3 * GROUP_W + ch0 + 4);
#pragma unroll
            for (int e = 0; e < 4; ++e) { wgt[j][e] = w0[e]; wgt[j][4 + e] = w1[e]; } }
        u32x4 xr[11];
#pragma unroll
        for (int k = 0; k < 11; ++k) { const int tt = r0i.t + 8 * ts + k - 1;
            xr[k] = (tt >= 0 && tt < r0i.T && !(A.pflags & 4096)) ? *(const u32x4*)(A.P + (size_t)(r0i.base + tt) * NP + C_GQ + ch0) : (u32x4){0u, 0u, 0u, 0u}; }
        float* dstp = (which == 0 ? Qs : which == 1 ? Ks : Vs) + cc0;
#pragma unroll
        for (int i = 0; i < 8; ++i) { float acc[8];
#pragma unroll
            for (int e = 0; e < 8; ++e) acc[e] = 0.f;
#pragma unroll
            for (int j = 0; j < 4; ++j) { const u32x4 xv = xr[i + j];
#pragma unroll
                for (int e = 0; e < 4; ++e) { acc[2 * e] += wgt[j][2 * e] * bflo(xv[e]); acc[2 * e + 1] += wgt[j][2 * e + 1] * bfhi(xv[e]); } }
            f32x4 y0, y1;
#pragma unroll
            for (int e = 0; e < 4; ++e) { y0[e] = acc[e] * __builtin_amdgcn_rcpf(1.0f + __expf(-acc[e])); y1[e] = acc[4 + e] * __builtin_amdgcn_rcpf(1.0f + __expf(-acc[4 + e])); }
            *(f32x4*)(dstp + (8 * ts + i) * QS) = y0; *(f32x4*)(dstp + (8 * ts + i) * QS + 4) = y1; }
    }
    if (tid < 128) { const int d = tid >> 6, i = tid & 63; const size_t r = (size_t)(row0 + i) * NP;
        beta_s[d * 64 + i] = 1.0f / (1.0f + __expf(-bf2f(A.P[r + C_GB + d * NH + h])));
        g_s[d * 64 + i] = -__expf(A.a_log[d * NH + h]) * softplusf_(bf2f(A.P[r + C_GA + d * NH + h]) + A.dt_bias[d * NH + h]); }
    LDS_BARRIER();
    for (int rr = wid * 4 + (lane >> 4); rr < 2 * CH; rr += 32) { float* rowp = (rr < CH ? Qs : Ks) + (rr & 63) * QS + (lane & 15) * 8;
        f32x4 a = *(const f32x4*)rowp, b = *(const f32x4*)(rowp + 4); float ss = (a[0] * a[0] + a[1] * a[1]) + (a[2] * a[2] + a[3] * a[3]) + (b[0] * b[0] + b[1] * b[1]) + (b[2] * b[2] + b[3] * b[3]);
#pragma unroll
        for (int o = 1; o < 16; o <<= 1) ss += lane_xor(ss, o, lane);
        const float scl = __builtin_amdgcn_rsqf(ss + EPS) * (rr < CH ? 0.08838834764831845f : 1.0f);
        *(f32x4*)rowp = a * scl; *(f32x4*)(rowp + 4) = b * scl; }
    if (tid < 2) {
        f32x4 gv[16];
#pragma unroll
        for (int m = 0; m < 16; ++m) gv[m] = *(const f32x4*)(g_s + tid * 64 + 4 * m);
        float run = 0.f;
        if (tid == 0) {
#pragma unroll
            for (int m = 0; m < 16; ++m) { f32x4 o4;
#pragma unroll
                for (int e = 0; e < 4; ++e) { run += gv[m][e]; o4[e] = run; }
                *(f32x4*)(gc_s + 4 * m) = o4; }
        } else {
#pragma unroll
            for (int m = 15; m >= 0; --m) { f32x4 o4;
#pragma unroll
                for (int e = 3; e >= 0; --e) { run += gv[m][e]; o4[e] = run; }
                *(f32x4*)(gc_s + 64 + 4 * m) = o4; }
        }
    }
    LDS_BARRIER();
    float* eq_s = sm + 384; float* ek_s = sm + 512;
    if (tid < 128) { const int d = tid >> 6, i = tid & 63; const float gci = gc_s[d * 64 + i], glast = d == 0 ? gc_s[63] : gc_s[64];
        eq_s[tid] = __expf(gci); ek_s[tid] = __expf(glast - gci); }
    const int gwhich = wid >> 2, gI = (wid >> 1) & 1, gJ = wid & 1, r32 = lane & 31, hi = lane >> 5;
    f32x16 acc = {};
    if (!(A.pflags & 1024)) {
        const float* X = (gwhich ? Qs : Ks) + (32 * gI + r32) * QS + 4 * hi; const float* Yp = Ks + (32 * gJ + r32) * QS + 4 * hi;
#pragma unroll
        for (int s = 0; s < 16; ++s) { const f32x4 a4 = *(const f32x4*)(X + 8 * s), b4 = *(const f32x4*)(Yp + 8 * s);
#pragma unroll
            for (int e = 0; e < 4; ++e) acc = __builtin_amdgcn_mfma_f32_32x32x2f32(a4[e], b4[e], acc, 0, 0, 0); }
        const int j = 32 * gJ + r32;
        if (gwhich == 0) {
            const float b1j = beta_s[64 + j], g0j = gc_s[j], g1j = gc_s[64 + j];
#pragma unroll
            for (int r = 0; r < 16; ++r) { const int i = 32 * gI + (r & 3) + 8 * (r >> 2) + 4 * hi;
                if (i > j) { const float kk = acc[r];
                    AA[(63 - j) * AS + (63 - i)] = beta_s[i] * kk * __expf(gc_s[i] - g0j);
                    AA[CH * AS + i * AS + j] = b1j * kk * __expf(g1j - gc_s[64 + i]); } }
        }
    }
    LDS_BARRIER();
    const size_t t0 = ((size_t)cix * NH + h) * 2;
    if (!(A.pflags & 2048)) {
#pragma unroll
        for (int n = 0; n < 4; ++n) { const int it = tid + 512 * n, d = it >> 10, p = (it >> 4) & 63, m = it & 15, i = d == 0 ? p : 63 - p, k0 = 32 * (m >> 2) + 4 * (m & 3);
            const float e = eq_s[d * 64 + i]; const f32x4 lo = *(const f32x4*)(Qs + i * QS + k0), hi4 = *(const f32x4*)(Qs + i * QS + k0 + 16);
            *(u32x4*)(A.B.QD + (t0 + d) * SZ_QD + (size_t)p * 128 + m * 8) = (u32x4){pk2(lo[0] * e, lo[1] * e), pk2(lo[2] * e, lo[3] * e), pk2(hi4[0] * e, hi4[1] * e), pk2(hi4[2] * e, hi4[3] * e)}; }
#pragma unroll
        for (int n = 0; n < 4; ++n) { const int it = tid + 512 * n, k = it & 127, d = (it >> 7) & 1, m = it >> 8, p0 = 32 * (m >> 2) + 4 * (m & 3);
            float v[8];
#pragma unroll
            for (int jj = 0; jj < 8; ++jj) { const int p = p0 + (jj < 4 ? jj : 12 + jj), i = d == 0 ? p : 63 - p; v[jj] = Ks[i * QS + k] * ek_s[d * 64 + i]; }
            *(u32x4*)(A.B.KDT + (t0 + d) * SZ_KDT + (size_t)k * 64 + m * 8) = (u32x4){pk2(v[0], v[1]), pk2(v[2], v[3]), pk2(v[4], v[5]), pk2(v[6], v[7])}; }
        if (tid == 0) { A.B.GT[t0] = __expf(gc_s[63]); A.B.GT[t0 + 1] = __expf(gc_s[64]); }
    }
    LDS_BARRIER();
    bf16_t* stg = (bf16_t*)Qs;
    if (gwhich == 1) { const int j = 32 * gJ + r32; const float g0j = gc_s[j], g1j = gc_s[64 + j];
#pragma unroll
        for (int r = 0; r < 16; ++r) { const int i = 32 * gI + (r & 3) + 8 * (r >> 2) + 4 * hi; const float qk = acc[r];
            stg[i * 64 + perm32(j)] = f2bf(i >= j ? qk * __expf(gc_s[i] - g0j) : 0.f);
            stg[4096 + (63 - i) * 64 + perm32(63 - j)] = f2bf(i <= j ? qk * __expf(gc_s[64 + i] - g1j) : 0.f); } }
    LDS_BARRIER();
#pragma unroll
    for (int n = 0; n < 2; ++n) { const int c16 = tid + 512 * n; *(u32x4*)(A.B.QK + t0 * SZ_QK + (size_t)c16 * 8) = *(const u32x4*)(stg + c16 * 8); }
    if (!(A.pflags & 512)) {
        int tidv = tid; asm volatile("" : "+v"(tidv));
        const int d = tidv >> 8, c = tidv & 255; const bool isw = c >= 128; const int cc = c & 127;
        const float* src = isw ? Ks : Vs;
        int lz; asm volatile("v_mov_b32 %0, 0" : "=v"(lz));
        const float* AAv = AA + lz + d * (CH * AS);
        float x[CH];
#pragma unroll
        for (int p = 0; p < CH; ++p) { const int i = d == 0 ? p : 63 - p; float f = beta_s[d * 64 + i]; if (isw) f *= eq_s[d * 64 + i]; x[p] = f * src[i * QS + cc]; }
        {
#pragma unroll
            for (int p = 0; p < CH - 1; ++p) { const float xp = x[p]; const float* rowp = AAv + (63 - p) * AS;
#pragma unroll
                for (int m = 0; m <= (62 - p) / 4; ++m) { const f32x4 a4 = *(const f32x4*)(rowp + 4 * m);
#pragma unroll
                    for (int e = 0; e < 4; ++e) { const int col = 4 * m + e; if (col <= 62 - p) x[63 - col] -= a4[e] * xp; } } }
        }
        LDS_BARRIER();
        if (!isw) { bf16_t* dst = A.B.UT + (t0 + d) * SZ_UT + (size_t)((cc >> 4) * 2 * 64 + (cc & 15)) * 8;
#pragma unroll
            for (int s = 0; s < 2; ++s)
#pragma unroll
                for (int qq = 0; qq < 4; ++qq) { const int p0 = 32 * s + 4 * qq; u32x4 w4; w4.x = pk2(x[p0], x[p0 + 1]); w4.y = pk2(x[p0 + 2], x[p0 + 3]); w4.z = pk2(x[p0 + 16], x[p0 + 17]); w4.w = pk2(x[p0 + 18], x[p0 + 19]);
                    *(u32x4*)(dst + (size_t)(s * 64 + qq * 16) * 8) = w4; }
        } else { bf16_t* dst = stg + d * 8192 + perm32(cc);
#pragma unroll
            for (int p = 0; p < CH; ++p) dst[p * 128] = f2bf(x[p]); }
    }
    LDS_BARRIER();
#pragma unroll
    for (int n = 0; n < 4; ++n) { const int c16 = tid + 512 * n; *(u32x4*)(A.B.WP + t0 * SZ_WP + (size_t)c16 * 8) = *(const u32x4*)(stg + c16 * 8); }
}
__device__ __forceinline__ void g1_phase(const G1Args& A, char* lds, int G, int wg, const int tid) {
    for (int t = wg; t < NCHUNK * NH; t += G) g1_task(A, lds, t / NH, t % NH, tid);
}

constexpr int G2_SPLIT = 4, G2_NACT = 8 / G2_SPLIT, G2_NSTEP = CTX_LEN / CH + SEQ / CH, G2_WGS = BATCH * NH * 2 * G2_SPLIT;
constexpr int G2_USL = G2_NACT * 2 * 64 * 16;
constexpr int G2_BUF = 16384 + 16384 + G2_USL, G2_NB = 4, G2_LDS = G2_NB * G2_BUF;
static_assert(G2_SPLIT == 4 && G2_USL == 4096, "G2 staging map below assumes 4 KB of u per step");
__device__ __forceinline__ int g2_task_index(int b, int h, int d, int step) {
    constexpr int NC = CTX_LEN / CH, NL = SEQ / CH; int cix;
    if (step < NC) { const int n = d ? NC - 1 - step : step; cix = M_LAT / CH + b * NC + n; }
    else { const int s2 = step - NC, n = d ? NL - 1 - s2 : s2; cix = b * NL + n; }
    return (cix * NH + h) * 2 + d;
}
__device__ __forceinline__ void g2_chain(const Bufs& B, char* lds, int chain_part, const int tid_in, const int step_lo, const int step_hi, float* Ssave) {
    int tid_ = tid_in; asm volatile("" : "+v"(tid_));
    const int tid = tid_, wid = __builtin_amdgcn_readfirstlane(tid >> 6), lane = tid & 63, q = lane >> 4, vl = lane & 15;
    const int chain = chain_part / G2_SPLIT, part = chain_part % G2_SPLIT;
    const bool active = wid < G2_NACT; const int vt = part * G2_NACT + (active ? wid : 0);
    const int d = chain & 1, h = (chain >> 1) % NH, b = chain / (2 * NH);
    constexpr int NSTEP = CTX_LEN / CH + SEQ / CH;
    const unsigned ldsb = (unsigned)(uintptr_t)lds;
    f32x4 S[8];
    f32x4* sv = (f32x4*)Ssave + ((size_t)chain_part * G2_NACT + (active ? wid : 0)) * 8 * 64 + lane;
#pragma unroll
    for (int kb = 0; kb < 8; ++kb) S[kb] = (step_lo > 0 && active) ? sv[kb * 64] : (f32x4){0.f, 0.f, 0.f, 0.f};
    unsigned offw[2], offk[2], offu;
#pragma unroll
    for (int i = 0; i < 2; ++i) { const int sl = 128 * wid + 64 * i + lane;
        { const int row = sl >> 4, pc = sl & 15, c = pc ^ (row & 15); offw[i] = (unsigned)(row * 256 + c * 16); }
        { const int row = sl >> 3, pc = sl & 7, c = pc ^ ((row >> 1) & 7); offk[i] = (unsigned)(row * 128 + c * 16); } }
    offu = (unsigned)((part * G2_NACT * 2 * 64 + (wid & 3) * 64 + lane) * 16);
#define G2_DMA(ti, slot) do { const char* wp_ = (const char*)(B.WP + (size_t)(ti) * SZ_WP); const char* kp_ = (const char*)(B.KDT + (size_t)(ti) * SZ_KDT); const unsigned base_ = ldsb + (unsigned)(slot) * G2_BUF; \
        _Pragma("unroll") for (int i_ = 0; i_ < 2; ++i_) { \
            __builtin_amdgcn_global_load_lds((const unsigned*)(wp_ + offw[i_]), (ATT_LAS unsigned*)(base_ + (128 * wid + 64 * i_) * 16), 16, 0, 0); \
            __builtin_amdgcn_global_load_lds((const unsigned*)(kp_ + offk[i_]), (ATT_LAS unsigned*)(base_ + 16384 + (128 * wid + 64 * i_) * 16), 16, 0, 0); } \
        if (wid >= 4) __builtin_amdgcn_global_load_lds((const unsigned*)((const char*)(B.UT + (size_t)(ti) * SZ_UT) + offu), (ATT_LAS unsigned*)(base_ + 32768 + ((wid & 3) * 64) * 16), 16, 0, 0); } while (0)
#define G2_TI(step) g2_task_index(b, h, d, (step) < NSTEP ? (step) : NSTEP - 1)
    __syncthreads();
    G2_DMA(G2_TI(step_lo), step_lo & 3); G2_DMA(G2_TI(step_lo + 1), (step_lo + 1) & 3); G2_DMA(G2_TI(step_lo + 2), (step_lo + 2) & 3);
    asm volatile("s_waitcnt vmcnt(0)" ::: "memory");
    __syncthreads();
    for (int step = step_lo; step < step_hi; ++step) {
        const int ti = G2_TI(step), slot = step & 3;
        G2_DMA(G2_TI(step + 3), (step + 3) & 3);
        unsigned gtb; { const float* gp = B.GT + ti; asm volatile("s_load_dword %0, %1, 0x0" : "=s"(gtb) : "s"(gp)); }
        const char* wl = lds + slot * G2_BUF; const char* kl = wl + 16384; const char* ul = kl + 16384;
        if (active) {
            bf16x8 aw[16], ak[16];
#pragma unroll
            for (int rb = 0; rb < 4; ++rb)
#pragma unroll
                for (int s = 0; s < 4; ++s) aw[rb * 4 + s] = *(const bf16x8*)(wl + (16 * rb + vl) * 256 + (((4 * s + q) ^ vl) << 4));
#pragma unroll
            for (int kb = 0; kb < 8; ++kb)
#pragma unroll
                for (int s = 0; s < 2; ++s) ak[kb * 2 + s] = *(const bf16x8*)(kl + (16 * kb + vl) * 128 + (((4 * s + q) ^ ((vl >> 1) & 7)) << 4));
            u32x4 uu[2];
#pragma unroll
            for (int s = 0; s < 2; ++s) uu[s] = *(const u32x4*)(ul + ((wid * 2 + s) * 64 + lane) * 16);
            bf16_t* sit = B.SIT + (size_t)ti * SZ_SIT + (size_t)(vt * 4 * 64 + lane) * 8;
            bf16x8 sf[4];
#pragma unroll
            for (int s = 0; s < 4; ++s) { u32x4 w4; w4.x = pk2(S[2 * s][0], S[2 * s][1]); w4.y = pk2(S[2 * s][2], S[2 * s][3]); w4.z = pk2(S[2 * s + 1][0], S[2 * s + 1][1]); w4.w = pk2(S[2 * s + 1][2], S[2 * s + 1][3]);
                sf[s] = __builtin_bit_cast(bf16x8, w4); *(u32x4*)(sit + (size_t)s * 64 * 8) = w4; }
            __builtin_amdgcn_sched_barrier(0);
            f32x4 vn[4];
#pragma unroll
            for (int rb = 0; rb < 4; ++rb) vn[rb] = (f32x4){0.f, 0.f, 0.f, 0.f};
#pragma unroll
            for (int s = 0; s < 4; ++s)
#pragma unroll
                for (int rb = 0; rb < 4; ++rb) vn[rb] = __builtin_amdgcn_mfma_f32_16x16x32_bf16(aw[rb * 4 + s], sf[s], vn[rb], 0, 0, 0);
#pragma unroll
            for (int s = 0; s < 2; ++s) { const f32x4 a0 = vn[2 * s], a1 = vn[2 * s + 1];
                vn[2 * s][0] = bflo(uu[s].x) - a0[0]; vn[2 * s][1] = bfhi(uu[s].x) - a0[1]; vn[2 * s][2] = bflo(uu[s].y) - a0[2]; vn[2 * s][3] = bfhi(uu[s].y) - a0[3];
                vn[2 * s + 1][0] = bflo(uu[s].z) - a1[0]; vn[2 * s + 1][1] = bfhi(uu[s].z) - a1[1]; vn[2 * s + 1][2] = bflo(uu[s].w) - a1[2]; vn[2 * s + 1][3] = bfhi(uu[s].w) - a1[3]; }
            bf16_t* vnt = B.VNT + (size_t)ti * SZ_VNT + (size_t)(vt * 2 * 64 + lane) * 8;
            bf16x8 vf[2];
#pragma unroll
            for (int s = 0; s < 2; ++s) { u32x4 w4; w4.x = pk2(vn[2 * s][0], vn[2 * s][1]); w4.y = pk2(vn[2 * s][2], vn[2 * s][3]); w4.z = pk2(vn[2 * s + 1][0], vn[2 * s + 1][1]); w4.w = pk2(vn[2 * s + 1][2], vn[2 * s + 1][3]);
                vf[s] = __builtin_bit_cast(bf16x8, w4); *(u32x4*)(vnt + (size_t)s * 64 * 8) = w4; }
            asm volatile("s_waitcnt lgkmcnt(0)" ::: "memory");
            const float gt = __uint_as_float(gtb);
#pragma unroll
            for (int kb = 0; kb < 8; ++kb) S[kb] = S[kb] * gt;
#pragma unroll
            for (int s = 0; s < 2; ++s)
#pragma unroll
                for (int kb = 0; kb < 8; ++kb) S[kb] = __builtin_amdgcn_mfma_f32_16x16x32_bf16(ak[kb * 2 + s], vf[s], S[kb], 0, 0, 0);
            __builtin_amdgcn_sched_barrier(0);
            asm volatile("s_waitcnt vmcnt(26) lgkmcnt(0)\n\ts_barrier" ::: "memory");
        } else if (wid >= 4) {
            asm volatile("s_waitcnt vmcnt(10) lgkmcnt(0)\n\ts_barrier" ::: "memory");
        } else {
            asm volatile("s_waitcnt vmcnt(8) lgkmcnt(0)\n\ts_barrier" ::: "memory");
        }
    }
    if (step_hi < NSTEP && active) {
#pragma unroll
        for (int kb = 0; kb < 8; ++kb) sv[kb * 64] = S[kb]; }
    asm volatile("s_waitcnt vmcnt(0)" ::: "memory");
    __syncthreads();
#undef G2_DMA
#undef G2_TI
}

constexpr int G3_OS = 132, G3_LDS = 64 * G3_OS * 4;
struct G3Args { Bufs B; const bf16_t* P; const float* norm_g; bf16_t* Y; };
__device__ __forceinline__ void g3_task(const G3Args& A, char* lds, int cix, int h, const int tid_in) {
    int tid_ = tid_in; asm volatile("" : "+v"(tid_));
    const int tid = tid_, wid = __builtin_amdgcn_readfirstlane(tid >> 6), lane = tid & 63, q = lane >> 4, vl = lane & 15;
    f32x4 o[2][4];
#pragma unroll
    for (int d = 0; d < 2; ++d) {
        const size_t t = ((size_t)cix * NH + h) * 2 + d;
        const bf16_t* sit = A.B.SIT + t * SZ_SIT + (size_t)(wid * 4 * 64 + lane) * 8;
        const bf16_t* vnt = A.B.VNT + t * SZ_VNT + (size_t)(wid * 2 * 64 + lane) * 8;
        const bf16_t* qd = A.B.QD + t * SZ_QD + (size_t)vl * 128 + 8 * q;
        const bf16_t* qk = A.B.QK + t * SZ_QK + (size_t)vl * 64 + 8 * q;
        bf16x8 sf[4], vf[2];
#pragma unroll
        for (int s = 0; s < 4; ++s) sf[s] = *(const bf16x8*)(sit + (size_t)s * 64 * 8);
#pragma unroll
        for (int s = 0; s < 2; ++s) vf[s] = *(const bf16x8*)(vnt + (size_t)s * 64 * 8);
#pragma unroll
        for (int rb = 0; rb < 4; ++rb) { f32x4 acc = {0.f, 0.f, 0.f, 0.f};
#pragma unroll
            for (int s = 0; s < 4; ++s) acc = __builtin_amdgcn_mfma_f32_16x16x32_bf16(*(const bf16x8*)(qd + (size_t)rb * 16 * 128 + 32 * s), sf[s], acc, 0, 0, 0);
#pragma unroll
            for (int s = 0; s < 2; ++s) acc = __builtin_amdgcn_mfma_f32_16x16x32_bf16(*(const bf16x8*)(qk + (size_t)rb * 16 * 64 + 32 * s), vf[s], acc, 0, 0, 0);
            o[d][rb] = acc; }
    }
    f32x4 ot[4];
#pragma unroll
    for (int rb = 0; rb < 4; ++rb)
#pragma unroll
        for (int r = 0; r < 4; ++r) ot[rb][r] = o[0][rb][r] + lane_xor(o[1][3 - rb][3 - r], 48, lane);
    float* Ot = (float*)lds;
    LDS_BARRIER();
#pragma unroll
    for (int rb = 0; rb < 4; ++rb)
#pragma unroll
        for (int r = 0; r < 4; ++r) Ot[(16 * rb + 4 * q + r) * G3_OS + 16 * wid + vl] = ot[rb][r];
    LDS_BARRIER();
#pragma unroll
    for (int n = 0; n < 2; ++n) { const int item = tid + 512 * n, tok = item >> 4, c8 = (item & 15) * 8;
        const f32x4 o0 = *(const f32x4*)(Ot + tok * G3_OS + c8), o1 = *(const f32x4*)(Ot + tok * G3_OS + c8 + 4);
        float ss = (o0[0] * o0[0] + o0[1] * o0[1]) + (o0[2] * o0[2] + o0[3] * o0[3]) + (o1[0] * o1[0] + o1[1] * o1[1]) + (o1[2] * o1[2] + o1[3] * o1[3]);
#pragma unroll
        for (int of = 1; of < 16; of <<= 1) ss += lane_xor(ss, of, lane);
        const float rstd = __builtin_amdgcn_rsqf(ss * (1.0f / HD) + EPS);
        const f32x4 g0 = *(const f32x4*)(A.norm_g + c8), g1 = *(const f32x4*)(A.norm_g + c8 + 4);
        const size_t row = (size_t)cix * CH + tok; const u32x4 gw = *(const u32x4*)(A.P + row * NP + C_GG + h * HD + c8);
        float y[8];
#pragma unroll
        for (int e = 0; e < 4; ++e) { const float ga = bflo(gw[e]), gb = bfhi(gw[e]); const float oa = e < 2 ? o0[2 * e] : o1[2 * e - 4], ob = e < 2 ? o0[2 * e + 1] : o1[2 * e - 3];
            const float na = e < 2 ? g0[2 * e] : g1[2 * e - 4], nb = e < 2 ? g0[2 * e + 1] : g1[2 * e - 3];
            y[2 * e] = oa * rstd * na * (ga * __builtin_amdgcn_rcpf(1.0f + __expf(-ga))); y[2 * e + 1] = ob * rstd * nb * (gb * __builtin_amdgcn_rcpf(1.0f + __expf(-gb))); }
        *(u32x4*)(A.Y + row * D_MODEL + 2 * GROUP_W + h * HD + c8) = (u32x4){pk2(y[0], y[1]), pk2(y[2], y[3]), pk2(y[4], y[5]), pk2(y[6], y[7])};
    }
}
__device__ __forceinline__ void g3_phase(const G3Args& A, char* lds, int G, int wg, const int tid) {
    for (int t = wg; t < NCHUNK * NH; t += G) g3_task(A, lds, t / NH, t % NH, tid);
}
}

namespace lru {
typedef short bf16x8 __attribute__((ext_vector_type(8)));
typedef float f32x4 __attribute__((ext_vector_type(4)));
typedef unsigned u32x2 __attribute__((ext_vector_type(2)));
typedef unsigned u32x4 __attribute__((ext_vector_type(4)));
constexpr int CH = 64, NCHUNK = M_ALL / CH;
constexpr int US = 129;
constexpr int UBS = 272;
constexpr int L_OFF_U = 0, L_OFF_UB = CH * US * 4, L_LDS = L_OFF_UB + CH * UBS;
constexpr size_t SZ_WBLK = (size_t)LRU_BW * LRU_BW;
struct Bufs { bf16_t* HLOC; bf16_t* ACUM; float* LSUM; float* HIN; };
struct LocalArgs { const bf16_t* P; const float* conv_w; const float* conv_b; const bf16_t* WG;   const float* ba; const float* bx; const float* lam; Bufs B; };

__device__ __forceinline__ unsigned pk2(float lo, float hi) { return (unsigned)f2bf(lo) | ((unsigned)f2bf(hi) << 16); }

__device__ __forceinline__ void local_task(const LocalArgs& A, char* lds, int cix, int nb, const int tid_in) {
    int tid_ = tid_in; asm volatile("" : "+v"(tid_));
    const int tid = tid_, wid = __builtin_amdgcn_readfirstlane(tid >> 6), lane = tid & 63, q = lane >> 4, tl = lane & 15;
    float* Us = (float*)(lds + L_OFF_U); char* Ub = lds + L_OFF_UB;
    const int row0 = cix * CH; const RowInfo r0i = row_info(row0);
    LDS_BARRIER();
    {
        const int grp = tid & 15, t2 = tid >> 4, c0 = grp * 8, ch0 = nb * LRU_BW + c0;
        float wgt[4][8], bia[8];
#pragma unroll
        for (int j = 0; j < 4; ++j) { const f32x4 w0 = *(const f32x4*)(A.conv_w + j * LRU_W + ch0), w1 = *(const f32x4*)(A.conv_w + j * LRU_W + ch0 + 4);
#pragma unroll
            for (int e = 0; e < 4; ++e) { wgt[j][e] = w0[e]; wgt[j][4 + e] = w1[e]; } }
        { const f32x4 b0 = *(const f32x4*)(A.conv_b + ch0), b1 = *(const f32x4*)(A.conv_b + ch0 + 4);
#pragma unroll
          for (int e = 0; e < 4; ++e) { bia[e] = b0[e]; bia[4 + e] = b1[e]; } }
        u32x4 xr[5];
#pragma unroll
        for (int k = 0; k < 5; ++k) { const int tt = r0i.t + 2 * t2 + k - 1;
            xr[k] = (tt >= 0 && tt < r0i.T) ? *(const u32x4*)(A.P + (size_t)(r0i.base + tt) * NP + C_LRU_X + ch0) : (u32x4){0u, 0u, 0u, 0u}; }
#pragma unroll
        for (int i = 0; i < 2; ++i) { float acc[8];
#pragma unroll
            for (int e = 0; e < 8; ++e) acc[e] = bia[e];
#pragma unroll
            for (int j = 0; j < 4; ++j) { const u32x4 xv = xr[i + j];
#pragma unroll
                for (int e = 0; e < 4; ++e) { acc[2 * e] += wgt[j][2 * e] * bflo(xv[e]); acc[2 * e + 1] += wgt[j][2 * e + 1] * bfhi(xv[e]); } }
            const int tok = 2 * t2 + i;
#pragma unroll
            for (int e = 0; e < 8; ++e) Us[tok * US + c0 + e] = acc[e];
            *(u32x4*)(Ub + tok * UBS + c0 * 2) = (u32x4){pk2(acc[0], acc[1]), pk2(acc[2], acc[3]), pk2(acc[4], acc[5]), pk2(acc[6], acc[7])}; }
    }
    LDS_BARRIER();
    f32x4 acc[2][2][4];
#pragma unroll
    for (int d = 0; d < 2; ++d)
#pragma unroll
        for (int wh = 0; wh < 2; ++wh)
#pragma unroll
            for (int tb = 0; tb < 4; ++tb) acc[d][wh][tb] = (f32x4){0.f, 0.f, 0.f, 0.f};
#pragma unroll
    for (int s = 0; s < 4; ++s) {
        bf16x8 bfr[4];
#pragma unroll
        for (int tb = 0; tb < 4; ++tb) bfr[tb] = *(const bf16x8*)(Ub + (16 * tb + tl) * UBS + (32 * s + 8 * q) * 2);
#pragma unroll
        for (int d = 0; d < 2; ++d)
#pragma unroll
            for (int wh = 0; wh < 2; ++wh) { const bf16x8 a = *(const bf16x8*)(A.WG + ((size_t)((d * 2 + wh) * NH + nb)) * SZ_WBLK + (size_t)(16 * wid + tl) * LRU_BW + 32 * s + 8 * q);
#pragma unroll
                for (int tb = 0; tb < 4; ++tb) acc[d][wh][tb] = __builtin_amdgcn_mfma_f32_16x16x32_bf16(a, bfr[tb], acc[d][wh][tb], 0, 0, 0); }
    }
    const int chb = nb * LRU_BW + 16 * wid + 4 * q;
#pragma unroll
    for (int d = 0; d < 2; ++d) {
        float sp[4], bav[4], bxv[4];
#pragma unroll
        for (int r = 0; r < 4; ++r) { sp[r] = -LRU_C * softplusf_(-A.lam[d * LRU_W + chb + r]); bav[r] = A.ba[d * LRU_W + chb + r]; bxv[r] = A.bx[d * LRU_W + chb + r]; }
        float Ac[4], Bc[4];
#pragma unroll
        for (int r = 0; r < 4; ++r) { Ac[r] = 1.f; Bc[r] = 0.f; }
#pragma unroll
        for (int tbi = 0; tbi < 4; ++tbi) { const int tb = d == 0 ? tbi : 3 - tbi; const int tok = 16 * tb + tl;
            float a[4], b[4];
#pragma unroll
            for (int r = 0; r < 4; ++r) { const float rr = __builtin_amdgcn_rcpf(1.0f + __expf(-(acc[d][0][tb][r] + bav[r]))), ii = __builtin_amdgcn_rcpf(1.0f + __expf(-(acc[d][1][tb][r] + bxv[r])));
                const float log_a = sp[r] * rr, x2 = 2.0f * log_a; a[r] = __expf(log_a);
                float em = 1.0f + x2 * (1.0f / 6.0f); em = 1.0f + x2 * 0.2f * em; em = 1.0f + x2 * 0.25f * em; em = 1.0f + x2 * (1.0f / 3.0f) * em; em = 1.0f + x2 * 0.5f * em; em = -x2 * em;
                if (__builtin_expect(x2 < -0.25f, 0)) em = -expm1f(x2);
                b[r] = __builtin_amdgcn_sqrtf(em) * ii * Us[tok * US + 16 * wid + 4 * q + r]; }
#define LRU_SCAN_STEP(CTRL) do { _Pragma("unroll") for (int r = 0; r < 4; ++r) { \
                const float ap = __int_as_float(__builtin_amdgcn_update_dpp(0x3f800000, __float_as_int(a[r]), (CTRL), 0xf, 0xf, false)); \
                const float bp = __int_as_float(__builtin_amdgcn_update_dpp(0, __float_as_int(b[r]), (CTRL), 0xf, 0xf, false)); \
                b[r] = a[r] * bp + b[r]; a[r] = a[r] * ap; } } while (0)
            if (d == 0) { LRU_SCAN_STEP(0x111); LRU_SCAN_STEP(0x112); LRU_SCAN_STEP(0x114); LRU_SCAN_STEP(0x118); }
            else        { LRU_SCAN_STEP(0x101); LRU_SCAN_STEP(0x102); LRU_SCAN_STEP(0x104); LRU_SCAN_STEP(0x108); }
#undef LRU_SCAN_STEP
#pragma unroll
            for (int r = 0; r < 4; ++r) { b[r] = a[r] * Bc[r] + b[r]; a[r] = a[r] * Ac[r]; }
            { const size_t o = ((size_t)d * M_ALL + row0 + tok) * LRU_W + chb;
              *(u32x2*)(A.B.HLOC + o) = (u32x2){pk2(b[0], b[1]), pk2(b[2], b[3])}; *(u32x2*)(A.B.ACUM + o) = (u32x2){pk2(a[0], a[1]), pk2(a[2], a[3])}; }
#pragma unroll
            for (int r = 0; r < 4; ++r) { const int sl = (lane & ~15) | (d == 0 ? 15 : 0); Ac[r] = lane_get(a[r], sl); Bc[r] = lane_get(b[r], sl); }
        }
        if (tl == 0) { float* ls = A.B.LSUM + (((size_t)cix * 2 + d) * 2) * LRU_W + chb;
            *(f32x4*)ls = (f32x4){Ac[0], Ac[1], Ac[2], Ac[3]}; *(f32x4*)(ls + LRU_W) = (f32x4){Bc[0], Bc[1], Bc[2], Bc[3]}; }
    }
}
__device__ __forceinline__ void local_phase(const LocalArgs& A, char* lds, int G, int wg, const int tid) {
    for (int j = wg; j < 2 * NCHUNK * NH; j += G) if (j >= NCHUNK * NH) { const int t = j - NCHUNK * NH; local_task(A, lds, t / NH, t % NH, tid); }
}
__device__ __forceinline__ void carry_phase(const Bufs& B, int gtid, int gthreads) {
    constexpr int NC = CTX_LEN / CH, NL = SEQ / CH;
    for (int i = gtid; i < BATCH * 2 * LRU_W; i += gthreads) { const int ch = i % LRU_W, d = (i / LRU_W) & 1, b = i / (2 * LRU_W);
        float h = 0.f;
        for (int s0 = 0; s0 < NC + NL; s0 += 12) {
            float av[12], bv[12]; int cx[12];
#pragma unroll
            for (int u = 0; u < 12; ++u) { const int step = s0 + u; int cix = 0;
                if (step < NC) { const int n = d ? NC - 1 - step : step; cix = M_LAT / CH + b * NC + n; }
                else if (step < NC + NL) { const int s2 = step - NC, n = d ? NL - 1 - s2 : s2; cix = b * NL + n; }
                cx[u] = cix; const float* ls = B.LSUM + (((size_t)cix * 2 + d) * 2) * LRU_W + ch; av[u] = ls[0]; bv[u] = ls[LRU_W]; }
#pragma unroll
            for (int u = 0; u < 12; ++u) if (s0 + u < NC + NL) { B.HIN[((size_t)cx[u] * 2 + d) * LRU_W + ch] = h; h = av[u] * h + bv[u]; }
        }
    }
}
__device__ __forceinline__ void finish_phase(const Bufs& B, const bf16_t* P, bf16_t* Y, int gtid, int gthreads) {
    for (int it = gtid; it < M_ALL * (LRU_W / 8); it += gthreads) { const int row = it / (LRU_W / 8), c0 = (it % (LRU_W / 8)) * 8, cix = row / CH;
        const u32x4 h0 = *(const u32x4*)(B.HLOC + (size_t)row * LRU_W + c0), a0 = *(const u32x4*)(B.ACUM + (size_t)row * LRU_W + c0);
        const u32x4 h1 = *(const u32x4*)(B.HLOC + ((size_t)M_ALL + row) * LRU_W + c0), a1 = *(const u32x4*)(B.ACUM + ((size_t)M_ALL + row) * LRU_W + c0);
        const u32x4 gt = *(const u32x4*)(P + (size_t)row * NP + C_LRU_G + c0);
        const float* i0 = B.HIN + ((size_t)cix * 2 + 0) * LRU_W + c0; const float* i1 = B.HIN + ((size_t)cix * 2 + 1) * LRU_W + c0;
        const f32x4 i0a = *(const f32x4*)i0, i0b = *(const f32x4*)(i0 + 4), i1a = *(const f32x4*)i1, i1b = *(const f32x4*)(i1 + 4);
        float y[8];
#pragma unroll
        for (int j = 0; j < 4; ++j) { const unsigned hw0 = h0[j], aw0 = a0[j], hw1 = h1[j], aw1 = a1[j], gw = gt[j];
            const float in0l = j < 2 ? i0a[2 * j] : i0b[2 * j - 4], in0h = j < 2 ? i0a[2 * j + 1] : i0b[2 * j - 3], in1l = j < 2 ? i1a[2 * j] : i1b[2 * j - 4], in1h = j < 2 ? i1a[2 * j + 1] : i1b[2 * j - 3];
            y[2 * j] = (bflo(hw0) + bflo(aw0) * in0l + bflo(hw1) + bflo(aw1) * in1l) * geluf_(bflo(gw));
            y[2 * j + 1] = (bfhi(hw0) + bfhi(aw0) * in0h + bfhi(hw1) + bfhi(aw1) * in1h) * geluf_(bfhi(gw)); }
        *(u32x4*)(Y + (size_t)row * D_MODEL + c0) = (u32x4){pk2(y[0], y[1]), pk2(y[2], y[3]), pk2(y[4], y[5]), pk2(y[6], y[7])};
    }
}
}

namespace misc {
typedef float f32x4 __attribute__((ext_vector_type(4)));
typedef unsigned u32x2 __attribute__((ext_vector_type(2)));
typedef unsigned u32x4 __attribute__((ext_vector_type(4)));
__device__ __forceinline__ unsigned pk2(float lo, float hi) { return (unsigned)f2bf(lo) | ((unsigned)f2bf(hi) << 16); }
__device__ __forceinline__ float wave_sum(float v, int lane) {
#pragma unroll
    for (int o = 1; o < 64; o <<= 1) v += lane_xor(v, o, lane);
    return v;
}
__device__ __forceinline__ float sum16(float v, int lane) {
#pragma unroll
    for (int o = 1; o < 16; o <<= 1) v += lane_xor(v, o, lane);
    return v;
}
__device__ __forceinline__ void norm_phase(float* H, const float* g, const float* MODl, int sh_idx, bf16_t* U, int nrows, int gwave, int nwaves, int lane,
                                           const float* PART, int nparts, const float* pgate, const float* xin, const float* cin) {
    static_assert(D_MODEL == 2048, "norm_phase geometry");
    for (int r = gwave; r < nrows; r += nwaves) {
        const int set = r < M_LAT ? r / SEQ : BATCH;
        f32x4* hr = (f32x4*)(H + (size_t)r * D_MODEL) + lane;
        const f32x4* src = xin == nullptr ? hr : (r < M_LAT ? (const f32x4*)(xin + (size_t)r * D_MODEL) + lane : (const f32x4*)(cin + (size_t)(r - M_LAT) * D_MODEL) + lane);
        f32x4 v[8]; float ss = 0.f;
#pragma unroll
        for (int j = 0; j < 8; ++j) v[j] = src[64 * j];
        if (xin != nullptr && r >= M_LAT) {
#pragma unroll
            for (int j = 0; j < 8; ++j) hr[64 * j] = v[j]; }
        if (PART != nullptr && r >= M_LAT) {
            const f32x4* gp = (const f32x4*)pgate + lane;
#pragma unroll
            for (int j = 0; j < 8; ++j) { f32x4 acc = {0.f, 0.f, 0.f, 0.f};
                for (int s = 0; s < nparts; ++s) acc += *((const f32x4*)(PART + ((size_t)s * M_CTX + (r - M_LAT)) * D_MODEL) + lane + 64 * j);
                v[j] += gp[64 * j] * acc; hr[64 * j] = v[j]; }
        }
#pragma unroll
        for (int j = 0; j < 8; ++j) ss += (v[j][0] * v[j][0] + v[j][1] * v[j][1]) + (v[j][2] * v[j][2] + v[j][3] * v[j][3]);
        const float rstd = 1.0f / sqrtf(wave_sum(ss, lane) * (1.0f / D_MODEL) + EPS);
        const f32x4* gp = (const f32x4*)g + lane; const f32x4* shp = (const f32x4*)(MODl + (size_t)set * NMODV + (size_t)sh_idx * D_MODEL) + lane; const f32x4* scp = shp + D_MODEL / 4;
        u32x2* o = (u32x2*)(U + (size_t)r * D_MODEL) + lane;
#pragma unroll
        for (int j = 0; j < 8; ++j) { const f32x4 gg = gp[64 * j], sh = shp[64 * j], sc = scp[64 * j]; f32x4 y;
#pragma unroll
            for (int e = 0; e < 4; ++e) y[e] = v[j][e] * rstd * gg[e] * (1.0f + sc[e]) + sh[e];
            o[64 * j] = (u32x2){pk2(y[0], y[1]), pk2(y[2], y[3])}; }
    }
}
struct RowNormArgs { const bf16_t* P; const float *qa_g, *kva_g, *na_qn_g, *na_kn_g; bf16_t *CQN, *CKVN, *NQ, *NK; };
__device__ __forceinline__ void rownorm_phase(const RowNormArgs& A, int gwave, int nwaves, int lane) {
    static_assert(MLA_Q_LORA == 384 && MLA_KV_LORA == 256 && GROUP_W == 512 && HD == 128, "rownorm geometry");
    for (int r = gwave; r < M_ALL; r += nwaves) { const bf16_t* p = A.P + (size_t)r * NP;
        { float x[6], ss = 0.f;
#pragma unroll
          for (int j = 0; j < 3; ++j) { const unsigned w = *(const unsigned*)(p + C_CQ + 2 * lane + 128 * j); x[2 * j] = bflo(w); x[2 * j + 1] = bfhi(w); ss += x[2 * j] * x[2 * j] + x[2 * j + 1] * x[2 * j + 1]; }
          const float rstd = 1.0f / sqrtf(wave_sum(ss, lane) * (1.0f / MLA_Q_LORA) + EPS);
#pragma unroll
          for (int j = 0; j < 3; ++j) { const int c = 2 * lane + 128 * j; *(unsigned*)(A.CQN + (size_t)r * MLA_Q_LORA + c) = pk2(x[2 * j] * rstd * A.qa_g[c], x[2 * j + 1] * rstd * A.qa_g[c + 1]); } }
        { float x[4], ss = 0.f;
#pragma unroll
          for (int j = 0; j < 2; ++j) { const unsigned w = *(const unsigned*)(p + C_CKV + 2 * lane + 128 * j); x[2 * j] = bflo(w); x[2 * j + 1] = bfhi(w); ss += x[2 * j] * x[2 * j] + x[2 * j + 1] * x[2 * j + 1]; }
          const float rstd = 1.0f / sqrtf(wave_sum(ss, lane) * (1.0f / MLA_KV_LORA) + EPS);
#pragma unroll
          for (int j = 0; j < 2; ++j) { const int c = 2 * lane + 128 * j; *(unsigned*)(A.CKVN + (size_t)r * MLA_KV_LORA + c) = pk2(x[2 * j] * rstd * A.kva_g[c], x[2 * j + 1] * rstd * A.kva_g[c + 1]); } }
#pragma unroll
        for (int which = 0; which < 2; ++which) {
            const int hh = lane >> 4, d0 = (lane & 15) * 8; const u32x4 w = *(const u32x4*)(p + (which == 0 ? C_NQ : C_NK) + hh * HD + d0);
            float x[8]; float ss = 0.f;
#pragma unroll
            for (int j = 0; j < 4; ++j) { x[2 * j] = bflo(w[j]); x[2 * j + 1] = bfhi(w[j]); ss += x[2 * j] * x[2 * j] + x[2 * j + 1] * x[2 * j + 1]; }
            const float rstd = 1.0f / sqrtf(sum16(ss, lane) * (1.0f / HD) + EPS); const float* g = (which == 0 ? A.na_qn_g : A.na_kn_g) + d0;
            *(u32x4*)((which == 0 ? A.NQ : A.NK) + (size_t)r * GROUP_W + hh * HD + d0) =
                (u32x4){pk2(x[0] * rstd * g[0], x[1] * rstd * g[1]), pk2(x[2] * rstd * g[2], x[3] * rstd * g[3]), pk2(x[4] * rstd * g[4], x[5] * rstd * g[5]), pk2(x[6] * rstd * g[6], x[7] * rstd * g[7])};
        }
    }
}
struct MlaQkvArgs { const bf16_t* QR; const bf16_t* KVR; const bf16_t* P; const float *qn_g, *kn_g; bf16_t *QM, *KM, *VM; };
__device__ __forceinline__ void mlaqkv_phase(const MlaQkvArgs& A, int gwave, int nwaves, int lane) {
    static_assert(MLA_QK == 192 && MLA_NOPE == 128 && MLA_ROPE == 64 && NH == 4 && GRID_W == 64, "mla qkv geometry");
    const int hh = lane >> 4, g = lane & 15;
    const int f0 = (2 * g) & 15; const float inv0 = powf(10000.0f, -(float)f0 / 16.0f), inv1 = powf(10000.0f, -(float)(f0 + 1) / 16.0f);
    for (int r = gwave; r < M_ALL; r += nwaves) {
        const bool lat = r < M_LAT; const int t = lat ? r % SEQ : 0; const float pos = g < 8 ? (float)(t / GRID_W) : (float)(t % GRID_W);
        float c0 = 1.f, s0 = 0.f, c1 = 1.f, s1 = 0.f;
        if (lat) { sincosf(pos * inv0, &s0, &c0); sincosf(pos * inv1, &s1, &c1); }
#pragma unroll
        for (int which = 0; which < 2; ++which) {
            const bf16_t* nsrc = which == 0 ? A.QR + (size_t)r * NQ_MLA + hh * MLA_QK : A.KVR + (size_t)r * NKV_MLA + hh * (MLA_NOPE + MLA_V);
            const bf16_t* rsrc = which == 0 ? nsrc + MLA_NOPE : A.P + (size_t)r * NP + C_KR;
            const u32x4 nw = *(const u32x4*)(nsrc + 8 * g); const unsigned ra = *(const unsigned*)(rsrc + 2 * g), rb = *(const unsigned*)(rsrc + 32 + 2 * g);
            float x[8], a0 = bflo(ra), a1 = bfhi(ra), b0 = bflo(rb), b1 = bfhi(rb);
            float ss = a0 * a0 + a1 * a1 + b0 * b0 + b1 * b1;
#pragma unroll
            for (int j = 0; j < 4; ++j) { x[2 * j] = bflo(nw[j]); x[2 * j + 1] = bfhi(nw[j]); ss += x[2 * j] * x[2 * j] + x[2 * j + 1] * x[2 * j + 1]; }
            const float rstd = __builtin_amdgcn_rsqf(sum16(ss, lane) * (1.0f / MLA_QK) + EPS); const float* gn = which == 0 ? A.qn_g : A.kn_g;
            const f32x4 g0 = *(const f32x4*)(gn + 8 * g), g1 = *(const f32x4*)(gn + 8 * g + 4);
#pragma unroll
            for (int j = 0; j < 4; ++j) { x[j] *= rstd * g0[j]; x[4 + j] *= rstd * g1[j]; }
            a0 *= rstd * gn[MLA_NOPE + 2 * g]; a1 *= rstd * gn[MLA_NOPE + 2 * g + 1]; b0 *= rstd * gn[MLA_NOPE + 32 + 2 * g]; b1 *= rstd * gn[MLA_NOPE + 32 + 2 * g + 1];
            const float ya0 = a0 * c0 - b0 * s0, yb0 = a0 * s0 + b0 * c0, ya1 = a1 * c1 - b1 * s1, yb1 = a1 * s1 + b1 * c1;
            bf16_t* O = (which == 0 ? A.QM : A.KM) + (size_t)r * NQ_MLA + hh * MLA_QK;
            *(u32x4*)(O + 8 * g) = (u32x4){pk2(x[0], x[1]), pk2(x[2], x[3]), pk2(x[4], x[5]), pk2(x[6], x[7])};
            *(unsigned*)(O + MLA_NOPE + 2 * g) = pk2(ya0, ya1); *(unsigned*)(O + MLA_NOPE + 32 + 2 * g) = pk2(yb0, yb1);
        }
        *(u32x4*)(A.VM + (size_t)r * (NH * MLA_V) + hh * MLA_V + 8 * g) = *(const u32x4*)(A.KVR + (size_t)r * NKV_MLA + hh * (MLA_NOPE + MLA_V) + MLA_NOPE + 8 * g);
    }
}
constexpr int ACT_RUN = 32;
__device__ __forceinline__ void act_phase(const bf16_t* UP, const float* cw, const float* cb, bf16_t* ACT, int nrows, int gtid, int gthreads) {
    constexpr int NC8 = D_FF / 8; static_assert(SEQ % ACT_RUN == 0 && CTX_LEN % ACT_RUN == 0, "row runs stay inside one sequence");
    const int nruns = nrows / ACT_RUN;
    for (long it = gtid; it < (long)nruns * NC8; it += gthreads) { const int run = (int)(it / NC8), j0 = (int)(it % NC8) * 8, r0 = run * ACT_RUN; const RowInfo ri = row_info(r0);
        float wa[3][8], wg[3][8], ba[8], bg[8];
#pragma unroll
        for (int k = 0; k < 3; ++k) { const float* p = cw + (size_t)k * 2 * D_FF + j0; const f32x4 a0 = *(const f32x4*)p, a1 = *(const f32x4*)(p + 4), g0 = *(const f32x4*)(p + D_FF), g1 = *(const f32x4*)(p + D_FF + 4);
#pragma unroll
            for (int e = 0; e < 4; ++e) { wa[k][e] = a0[e]; wa[k][4 + e] = a1[e]; wg[k][e] = g0[e]; wg[k][4 + e] = g1[e]; } }
        { const f32x4 a0 = *(const f32x4*)(cb + j0), a1 = *(const f32x4*)(cb + j0 + 4), g0 = *(const f32x4*)(cb + D_FF + j0), g1 = *(const f32x4*)(cb + D_FF + j0 + 4);
#pragma unroll
          for (int e = 0; e < 4; ++e) { ba[e] = a0[e]; ba[4 + e] = a1[e]; bg[e] = g0[e]; bg[4 + e] = g1[e]; } }
        const u32x4 zero = {0u, 0u, 0u, 0u};
        const bf16_t* ub = UP + (size_t)ri.base * (2 * D_FF) + j0;
        u32x4 am, ac, gm, gc;
        { const int t = ri.t; am = t > 0 ? *(const u32x4*)(ub + (size_t)(t - 1) * (2 * D_FF)) : zero; gm = t > 0 ? *(const u32x4*)(ub + (size_t)(t - 1) * (2 * D_FF) + D_FF) : zero;
          ac = *(const u32x4*)(ub + (size_t)t * (2 * D_FF)); gc = *(const u32x4*)(ub + (size_t)t * (2 * D_FF) + D_FF); }
#pragma unroll 4
        for (int i = 0; i < ACT_RUN; ++i) { const int t = ri.t + i;
            const u32x4 ap = t + 1 < ri.T ? *(const u32x4*)(ub + (size_t)(t + 1) * (2 * D_FF)) : zero, gp = t + 1 < ri.T ? *(const u32x4*)(ub + (size_t)(t + 1) * (2 * D_FF) + D_FF) : zero;
            float y[8];
#pragma unroll
            for (int e = 0; e < 4; ++e) {
                const float a0 = ba[2 * e] + wa[0][2 * e] * bflo(am[e]) + wa[1][2 * e] * bflo(ac[e]) + wa[2][2 * e] * bflo(ap[e]);
                const float a1 = ba[2 * e + 1] + wa[0][2 * e + 1] * bfhi(am[e]) + wa[1][2 * e + 1] * bfhi(ac[e]) + wa[2][2 * e + 1] * bfhi(ap[e]);
                const float g0 = bg[2 * e] + wg[0][2 * e] * bflo(gm[e]) + wg[1][2 * e] * bflo(gc[e]) + wg[2][2 * e] * bflo(gp[e]);
                const float g1 = bg[2 * e + 1] + wg[0][2 * e + 1] * bfhi(gm[e]) + wg[1][2 * e + 1] * bfhi(gc[e]) + wg[2][2 * e + 1] * bfhi(gp[e]);
                y[2 * e] = a0 * (g0 / (1.0f + __expf(-g0))); y[2 * e + 1] = a1 * (g1 / (1.0f + __expf(-g1))); }
            *(u32x4*)(ACT + (size_t)(r0 + i) * D_FF + j0) = (u32x4){pk2(y[0], y[1]), pk2(y[2], y[3]), pk2(y[4], y[5]), pk2(y[6], y[7])};
            am = ac; ac = ap; gm = gc; gc = gp; }
    }
}
__device__ __forceinline__ void act_fix_phase(const bf16_t* HALO, const float* cw, const float* cb, bf16_t* ACT, int nrows, int gtid, int gthreads) {
    constexpr int NC8 = D_FF / 8; const int nblk = nrows / 64;
    for (long it = gtid; it < (long)nblk * 2 * NC8; it += gthreads) { const int j0 = (int)(it % NC8) * 8, be = (int)(it / NC8), blk = be >> 1, edge = be & 1; const int row = blk * 64 + (edge ? 63 : 0);
        const RowInfo ri = row_info(row);
        const bf16_t* hb = HALO + (size_t)blk * 4 * (2 * D_FF) + j0;
        const bool has_prev = ri.t > 0, has_next = ri.t + 1 < ri.T; const u32x4 zero = {0u, 0u, 0u, 0u};
        const bf16_t* pc = hb + (size_t)(edge ? 3 : 0) * (2 * D_FF);
        const bf16_t* pp_ = edge ? hb + (size_t)2 * (2 * D_FF) : hb - (size_t)4 * (2 * D_FF) + (size_t)3 * (2 * D_FF);
        const bf16_t* pn = edge ? hb + (size_t)4 * (2 * D_FF) : hb + (size_t)1 * (2 * D_FF);
        const u32x4 ac = *(const u32x4*)pc, gc = *(const u32x4*)(pc + D_FF);
        const u32x4 am = has_prev ? *(const u32x4*)pp_ : zero, gm = has_prev ? *(const u32x4*)(pp_ + D_FF) : zero;
        const u32x4 ap = has_next ? *(const u32x4*)pn : zero, gp = has_next ? *(const u32x4*)(pn + D_FF) : zero;
        float y[8];
#pragma unroll
        for (int e = 0; e < 4; ++e) {
#pragma unroll
            for (int hh = 0; hh < 2; ++hh) { const int c = j0 + 2 * e + hh;
                const float xam = hh ? bfhi(am[e]) : bflo(am[e]), xac = hh ? bfhi(ac[e]) : bflo(ac[e]), xap = hh ? bfhi(ap[e]) : bflo(ap[e]);
                const float xgm = hh ? bfhi(gm[e]) : bflo(gm[e]), xgc = hh ? bfhi(gc[e]) : bflo(gc[e]), xgp = hh ? bfhi(gp[e]) : bflo(gp[e]);
                const float a = cb[c] + cw[c] * xam + cw[2 * D_FF + c] * xac + cw[4 * D_FF + c] * xap;
                const float g = cb[D_FF + c] + cw[D_FF + c] * xgm + cw[2 * D_FF + D_FF + c] * xgc + cw[4 * D_FF + D_FF + c] * xgp;
                y[2 * e + hh] = a * (g * __builtin_amdgcn_rcpf(1.0f + __expf(-g))); } }
        *(u32x4*)(ACT + (size_t)row * D_FF + j0) = (u32x4){pk2(y[0], y[1]), pk2(y[2], y[3]), pk2(y[4], y[5]), pk2(y[6], y[7])};
    }
}
__device__ __forceinline__ void transpose_item(const float* W, int K, int N, int Npad, bf16_t* WT, float* scr, int item, int lane, int pairF = 0) {
    const int nblk = Npad / 32, kb = item / nblk, nb = item % nblk, k0 = 64 * kb, n0 = 32 * nb; const int n = n0 + (lane & 31); const bool ok = n < N;
#pragma unroll 8
    for (int i = 0; i < 32; ++i) { const int kk = 2 * i + (lane >> 5); scr[kk * 33 + (lane & 31)] = ok ? W[(size_t)(k0 + kk) * N + n] : 0.f; }
    asm volatile("s_waitcnt lgkmcnt(0)" ::: "memory");
    const int c = lane & 7;
#pragma unroll
    for (int j = 0; j < 4; ++j) { const int nn = (lane >> 3) + 8 * j; const float* s = scr + (8 * c) * 33 + nn;
        u32x4 o; o.x = pk2(s[0 * 33], s[1 * 33]); o.y = pk2(s[2 * 33], s[3 * 33]); o.z = pk2(s[4 * 33], s[5 * 33]); o.w = pk2(s[6 * 33], s[7 * 33]);
        const int nsrc = n0 + nn; const int nd = pairF == 0 ? nsrc : (nsrc < pairF ? (nsrc >> 7) * 256 + (nsrc & 127) : ((nsrc - pairF) >> 7) * 256 + 128 + ((nsrc - pairF) & 127));
        *(u32x4*)(WT + (size_t)nd * K + k0 + 8 * c) = o; }
    asm volatile("s_waitcnt lgkmcnt(0)" ::: "memory");
}
}

__device__ __forceinline__ gdn::Bufs gdn_bufs(const WS& w, int l) { gdn::Bufs B; B.UT = w.gUT; B.WP = w.gWP; B.KDT = w.gKDT; B.QD = w.gQD; B.QK = w.gQK; B.SIT = w.gSIT; B.VNT = w.gVNT; B.GT = w.gGT + (size_t)l * gdn::NTASK; return B; }
__device__ __forceinline__ lru::Bufs lru_bufs(const WS& w) { lru::Bufs B; B.HLOC = w.lHLOC; B.ACUM = w.lACUM; B.LSUM = w.lLSUM; B.HIN = w.lHIN; return B; }

#define LAS __attribute__((address_space(3)))
#define XB_TMO      128
#define XB_XCNT(j)  (256  + 64 * (j))
#define XB_XSUB(j)  (1280 + 64 * (j))
#define XB_XGEN(j)  (2304 + 64 * (j))
#define XB_TOP      3328
#define XB_TOPGEN   3392
#define XCD_BAR_WORDS 3456
#define XB_SPIN_CAP (1u << 18)
__device__ __forceinline__ unsigned xb_ld(unsigned* p)              { return __hip_atomic_load(p, __ATOMIC_RELAXED, __HIP_MEMORY_SCOPE_AGENT); }
__device__ __forceinline__ unsigned xb_add(unsigned* p, unsigned v) { return __hip_atomic_fetch_add(p, v, __ATOMIC_RELAXED, __HIP_MEMORY_SCOPE_AGENT); }
__device__ __forceinline__ unsigned xb_xcc_id() { return (unsigned)__builtin_amdgcn_s_getreg((3 << 11) | 20) & 0xFu; }
#define XB_SPIN(cond, bar) do { unsigned _sp = 0; while (cond) { __builtin_amdgcn_s_sleep(1); \
    if ((++_sp & 255u) == 0u) { if (xb_ld(&(bar)[XB_TMO])) break; if (_sp > XB_SPIN_CAP) { atomicAdd(&(bar)[XB_TMO], 1u); break; } } } } while (0)
struct XcdBarrier { unsigned* bar; unsigned x; volatile LAS unsigned* st; };
__device__ __forceinline__ XcdBarrier xcd_barrier_post(unsigned* bar, volatile LAS unsigned* st, const bool leader) {
    XcdBarrier b; b.bar = bar; b.x = xb_xcc_id(); b.st = st;
    if (leader) (void)xb_add(&bar[XB_XCNT(b.x)], 1u);
    return b;
}
__device__ __forceinline__ void xcd_barrier_complete(unsigned* bar, unsigned x, unsigned& nloc, unsigned& nx) {
    const unsigned G = gridDim.x * gridDim.y * gridDim.z;
    unsigned sum, cnt, mine, sp = 0u;
    for (;;) {
        sum = 0u; cnt = 0u; mine = 0u;
#pragma unroll
        for (unsigned j = 0; j < 16; ++j) { const unsigned c = xb_ld(&bar[XB_XCNT(j)]); sum += c; cnt += (c > 0u) ? 1u : 0u; mine = (j == x) ? c : mine; }
        if (sum == G) break;
        __builtin_amdgcn_s_sleep(1);
        if ((++sp & 255u) == 0u) { if (xb_ld(&bar[XB_TMO])) break; if (sp > XB_SPIN_CAP) { atomicAdd(&bar[XB_TMO], 1u); break; } }
    }
    nloc = mine > 0u ? mine : 1u; nx = cnt > 0u ? cnt : 1u;
}
__device__ __forceinline__ void xcd_barrier(const XcdBarrier& b, const bool leader) {
    asm volatile("s_waitcnt vmcnt(0)" ::: "memory");
    __syncthreads();
    if (leader) {
        unsigned* bar = b.bar;
        __builtin_amdgcn_s_waitcnt(0);
        unsigned nloc = b.st[0], nx = b.st[1];
        if (nloc == 0u) { xcd_barrier_complete(bar, b.x, nloc, nx); b.st[0] = nloc; b.st[1] = nx; }
        const unsigned old = xb_add(&bar[XB_XSUB(b.x)], 1u);
        const unsigned gen = old / nloc;
        if (old + 1u == (gen + 1u) * nloc) {
            __builtin_amdgcn_fence(__ATOMIC_RELEASE, "agent");
            asm volatile("s_waitcnt vmcnt(0)" ::: "memory");
            const unsigned og = xb_add(&bar[XB_TOP], 1u);
            const unsigned tg = og / nx;
            if (og + 1u == (tg + 1u) * nx) xb_add(&bar[XB_TOPGEN], 1u);
            else XB_SPIN(xb_ld(&bar[XB_TOPGEN]) == tg, bar);
            __builtin_amdgcn_fence(__ATOMIC_ACQUIRE, "agent");
            xb_add(&bar[XB_XGEN(b.x)], 1u);
            asm volatile("s_waitcnt vmcnt(0)" ::: "memory");
        } else {
            XB_SPIN(xb_ld(&bar[XB_XGEN(b.x)]) == gen, bar);
            __builtin_amdgcn_fence(__ATOMIC_ACQUIRE, "agent");
            asm volatile("s_waitcnt vmcnt(0)" ::: "memory");
        }
    }
    __syncthreads();
}

constexpr int NWAVES = 8, NTHR = 512;
constexpr int LDS_MISC = 147456, LDS_BYTES = 148480;
static_assert(sizeof(Inputs) == 34 * 8, "Inputs mirrors Params::in");
static_assert(gdn::G1_LDS <= LDS_MISC && pg8::STAGE_BYTES <= LDS_MISC && att::Cfg<MLA_QK>::LDS_BYTES <= LDS_MISC && gdn::G2_LDS <= LDS_MISC, "LDS map");
constexpr int CW_BAR = 4096;
constexpr int G2_CUT1 = 52, G2_CUT2 = 52;
constexpr int SK_OUT = 4, SK_DOWN = 5;
constexpr int PH_PRO = 0, PH_PER_LAYER = 12, NPH = 1 + PH_PER_LAYER * DEPTH;
struct Params { const float* in[34]; float* out; unsigned char* ws; int ph_lo, ph_hi, li, pad; };

struct SplitOrder {
    int nN, nM, S, G, c;
    __device__ __forceinline__ void init(int M, int N, int S_, int G_, int c_) { nM = M / pg8::BM; nN = N / pg8::BM; S = S_; G = G_; c = c_; }
    __device__ __forceinline__ bool next(int i, pg8::Unit& u) const { const int g = c + i * G; if (g >= nM * nN * S) return false; u.ks = g / (nM * nN); const int loc = g % (nM * nN); u.pm = loc / nN; u.pn = loc % nN; return true; }
    __device__ __forceinline__ void a_ready(const pg8::Unit&) const {}
    __device__ __forceinline__ void done(const pg8::Unit&) const {}
};
struct SpanOrder {
    int nN, lo, hi, G, g0;
    __device__ __forceinline__ void init(int N, int lo_, int hi_, int G_, int c) { nN = N / pg8::BM; lo = lo_; hi = hi_; G = G_; int i0 = 0; if (c < lo_) i0 = (lo_ - c + G_ - 1) / G_; g0 = c + i0 * G_; }
    __device__ __forceinline__ bool next(int i, pg8::Unit& u) const { const int g = g0 + i * G; if (g >= hi) return false; const int loc = g - lo; u.pm = loc / nN; u.pn = loc % nN; u.ks = 0; return true; }
    __device__ __forceinline__ void a_ready(const pg8::Unit&) const {}
    __device__ __forceinline__ void done(const pg8::Unit&) const {}
};

#define AS4 __attribute__((address_space(4)))
#define PHASE_WS const AS4 Params* pp = (const AS4 Params*)__builtin_amdgcn_kernarg_segment_ptr(); asm volatile("" : "+s"(pp)); const AS4 Inputs* I = (const AS4 Inputs*)pp; (void)I; unsigned char* wsb_ = pp->ws; const WS w = ws_carve(wsb_)
#define PHASE_IDS int tid = C_wave0 * 64 + (int)__builtin_amdgcn_mbcnt_hi(~0u, __builtin_amdgcn_mbcnt_lo(~0u, 0u)); asm volatile("" : "+v"(tid)); const int lane = tid & 63, wave = __builtin_amdgcn_readfirstlane(tid >> 6), gwave = wg * NWAVES + wave, gtid = wg * NTHR + tid; (void)lane; (void)gwave; (void)gtid
#ifndef DBG_MASK
#define DBG_MASK 0xFFFFFF
#endif
#define IN(k) (lo <= (k) && (k) < hi)
#define ON(j) (((DBG_MASK) >> (j)) & 1)
#define SEAM(k) do { if (IN(k) && IN((k) + 1)) xcd_barrier(bar, C_wave0 == 0 && __builtin_amdgcn_mbcnt_hi(~0u, __builtin_amdgcn_mbcnt_lo(~0u, 0u)) == 0u); } while (0)

struct LayerCtx { int lo, hi, G, wg, nwaves, gthreads, wave0; XcdBarrier bar; char* lds; unsigned char* lds_raw; };
template <int l> __device__ __forceinline__ void layer_body(const LayerCtx& C) {
    const int lo = C.lo, hi = C.hi, G = C.G, wg = C.wg, nwaves = C.nwaves, gthreads = C.gthreads, C_wave0 = C.wave0; const XcdBarrier& bar = C.bar; char* lds = C.lds; unsigned char* lds_raw = C.lds_raw;
    (void)G; (void)nwaves; (void)gthreads;
        const int pb = 1 + PH_PER_LAYER * l;
        const bool want_ctx = l < DEPTH - 1; const int Mo = want_ctx ? M_ALL : M_LAT;
        if (ON(0) && IN(pb + 0)) { PHASE_WS; PHASE_IDS; const float* MODl = w.MOD + (size_t)l * (BATCH + 1) * NMODV; (void)MODl; misc::norm_phase(w.H, I->norm_mix_g + (size_t)l * D_MODEL, MODl, 0, w.U, M_ALL, gwave, nwaves, lane, l > 0 ? w.PART : nullptr, SK_DOWN, MODl - (size_t)(BATCH + 1) * NMODV + (size_t)BATCH * NMODV + 5 * D_MODEL, l == 0 ? I->x : nullptr, l == 0 ? I->ctx : nullptr); }
        SEAM(pb + 0);
        if (ON(1) && IN(pb + 1)) { PHASE_WS; PHASE_IDS; const float* MODl = w.MOD + (size_t)l * (BATCH + 1) * NMODV; (void)MODl; pg8::Gemm g{w.U, w.WIN + l * SZ_WIN, M_ALL, NP, D_MODEL, D_MODEL}; pg8::StaticOrder S; S.init(M_ALL, NP, G, wg);
            pg8::EpiBf16<0> E{w.P, NP, nullptr, 0, 0, 1.0f};
            pg8::gemm_phase<pg8::EpiBf16<0>, pg8::StaticOrder, true, true>((PG8_LAS unsigned char*)lds_raw, g, S, E, tid); }
        SEAM(pb + 1);
        if (ON(2) && IN(pb + 2)) { PHASE_WS; PHASE_IDS; const float* MODl = w.MOD + (size_t)l * (BATCH + 1) * NMODV; (void)MODl;
            const int pflags = pp->pad;
            if (!(pflags & 16)) { gdn::G1Args A; A.P = w.P; A.conv_w = I->gdn_conv_w + (size_t)l * 4 * 3 * GROUP_W; A.a_log = I->gdn_a_log + (size_t)l * 2 * NH; A.dt_bias = I->gdn_dt_bias + (size_t)l * 2 * NH; A.B = gdn_bufs(w, l); A.pflags = pflags;
              gdn::g1_phase(A, lds, G, wg, tid); }
            if (!(pflags & 32)) { lru::LocalArgs A; A.P = w.P; A.conv_w = I->lru_conv_w + (size_t)l * 4 * LRU_W; A.conv_b = I->lru_conv_b + (size_t)l * LRU_W; A.WG = w.WLRU + (size_t)l * 16 * lru::SZ_WBLK;
              A.ba = I->lru_ba + (size_t)l * 2 * LRU_W; A.bx = I->lru_bx + (size_t)l * 2 * LRU_W; A.lam = I->lru_lam + (size_t)l * 2 * LRU_W; A.B = lru_bufs(w);
              lru::local_phase(A, lds, G, wg, tid); }
            if (!(pflags & 64)) { misc::RowNormArgs A; A.P = w.P; A.qa_g = I->mla_qa_g + (size_t)l * MLA_Q_LORA; A.kva_g = I->mla_kva_g + (size_t)l * MLA_KV_LORA; A.na_qn_g = I->na_qn_g + (size_t)l * HD; A.na_kn_g = I->na_kn_g + (size_t)l * HD;
              A.CQN = w.CQN; A.CKVN = w.CKVN; A.NQ = w.NQ; A.NK = w.NK; misc::rownorm_phase(A, gwave, nwaves, lane); }
        }
        SEAM(pb + 2);
        if (ON(3) && IN(pb + 3)) { PHASE_WS; PHASE_IDS; const float* MODl = w.MOD + (size_t)l * (BATCH + 1) * NMODV; (void)MODl;
            if (wg < gdn::G2_WGS) gdn::g2_chain(gdn_bufs(w, l), lds, wg, tid, 0, G2_CUT1, w.gSS);
            else {
            constexpr int UQ = (M_ALL / 256) * (NQ_MLA / 256), UKV = (M_ALL / 256) * (NKV_MLA / 256); const int G2n = G - gdn::G2_WGS, c2 = wg - gdn::G2_WGS;
            { pg8::Gemm g{w.CQN, w.WUQ + l * SZ_WUQ, M_ALL, NQ_MLA, MLA_Q_LORA, MLA_Q_LORA}; SpanOrder S; S.init(NQ_MLA, 0, UQ, G2n, c2); pg8::EpiBf16<0> E{w.QR, NQ_MLA, nullptr, 0, 0, 1.0f};
              pg8::gemm_phase<pg8::EpiBf16<0>, SpanOrder, true, true>((PG8_LAS unsigned char*)lds_raw, g, S, E, tid); }
            { pg8::Gemm g{w.CKVN, w.WUKV + l * SZ_WUKV, M_ALL, NKV_MLA, MLA_KV_LORA, MLA_KV_LORA}; SpanOrder S; S.init(NKV_MLA, UQ, UQ + UKV, G2n, c2); pg8::EpiBf16<0> E{w.KVR, NKV_MLA, nullptr, 0, 0, 1.0f};
              pg8::gemm_phase<pg8::EpiBf16<0>, SpanOrder, true, true>((PG8_LAS unsigned char*)lds_raw, g, S, E, tid); }
            }
        }
        SEAM(pb + 3);
        if (ON(4) && IN(pb + 4)) { PHASE_WS; PHASE_IDS; const float* MODl = w.MOD + (size_t)l * (BATCH + 1) * NMODV; (void)MODl;
            { misc::MlaQkvArgs A; A.QR = w.QR; A.KVR = w.KVR; A.P = w.P; A.qn_g = I->mla_qn_g + (size_t)l * MLA_QK; A.kn_g = I->mla_kn_g + (size_t)l * MLA_QK; A.QM = w.QM; A.KM = w.KM; A.VM = w.VM;
              misc::mlaqkv_phase(A, gwave, nwaves, lane); }
            lru::carry_phase(lru_bufs(w), gtid, gthreads);
        }
        SEAM(pb + 4);
        if (ON(5) && IN(pb + 5)) { PHASE_WS; PHASE_IDS; const float* MODl = w.MOD + (size_t)l * (BATCH + 1) * NMODV; (void)MODl;
            const int pflags = pp->pad;
            if (wg < gdn::G2_WGS && !(pflags & 1)) gdn::g2_chain(gdn_bufs(w, l), lds, wg, tid, G2_CUT2, gdn::G2_NSTEP, w.gSS);
            AttnArgs A; A.QM = w.QM; A.KM = w.KM; A.VM = w.VM; A.NQ = w.NQ; A.NK = w.NK; A.P = w.P; A.Y = w.Y; A.rpb = I->na_rpb + (size_t)l * NH * (2 * NA_KH - 1) * (2 * NA_KW - 1); A.want_ctx = want_ctx ? 1 : 0; A.pad = pflags;
            attention_phase(A, lds, G, wg, tid, gdn::G2_WGS);
        }
        SEAM(pb + 5);
        if (ON(6) && IN(pb + 6)) { PHASE_WS; PHASE_IDS; const float* MODl = w.MOD + (size_t)l * (BATCH + 1) * NMODV; (void)MODl;
            const int pflags = pp->pad;
            if (!(pflags & 128)) { gdn::G3Args A; A.B = gdn_bufs(w, l); A.P = w.P; A.norm_g = I->gdn_norm_g + (size_t)l * HD; A.Y = w.Y; gdn::g3_phase(A, lds, G, wg, tid); }
            if (!(pflags & 256)) lru::finish_phase(lru_bufs(w), w.P, w.Y, gtid, gthreads);
        }
        SEAM(pb + 6);
        if (ON(7) && IN(pb + 7)) { PHASE_WS; PHASE_IDS; const float* MODl = w.MOD + (size_t)l * (BATCH + 1) * NMODV; (void)MODl;
            { pg8::Gemm g{w.Y, w.WOUT + l * SZ_WOUT, M_LAT, D_MODEL, D_MODEL, D_MODEL}; pg8::StaticOrder S; S.init(M_LAT, D_MODEL, G, wg);
              pg8::EpiGateRes E{l == 0 ? I->x : w.H, w.H, D_MODEL, MODl + 2 * D_MODEL, NMODV, SEQ, BATCH, M_LAT};
              pg8::gemm_phase<pg8::EpiGateRes, pg8::StaticOrder, true, true>((PG8_LAS unsigned char*)lds_raw, g, S, E, tid); }
            if (want_ctx) { constexpr int SK = SK_OUT;
              pg8::Gemm g{w.Y + (size_t)M_LAT * D_MODEL, w.WOUT + l * SZ_WOUT, M_CTX, D_MODEL, D_MODEL / SK, D_MODEL}; SplitOrder S; S.init(M_CTX, D_MODEL, SK, G, (wg + G / 2) % G);
              pg8::EpiPart E{w.PART, D_MODEL, (size_t)M_CTX * D_MODEL};
              pg8::gemm_phase<pg8::EpiPart, SplitOrder, true, true>((PG8_LAS unsigned char*)lds_raw, g, S, E, tid); } }
        SEAM(pb + 7);
        if (ON(8) && IN(pb + 8)) { PHASE_WS; PHASE_IDS; const float* MODl = w.MOD + (size_t)l * (BATCH + 1) * NMODV; (void)MODl; misc::norm_phase(w.H, I->norm_ffn_g + (size_t)l * D_MODEL, MODl, 3, w.U, Mo, gwave, nwaves, lane, want_ctx ? w.PART : nullptr, SK_OUT, MODl + (size_t)BATCH * NMODV + 2 * D_MODEL, nullptr, nullptr); }
        SEAM(pb + 8);
        if (ON(9) && IN(pb + 9)) { PHASE_WS; PHASE_IDS; const float* MODl = w.MOD + (size_t)l * (BATCH + 1) * NMODV; (void)MODl; pg8::Gemm g{w.U, w.WUP + l * SZ_WUP, Mo, 2 * D_FF, D_MODEL, D_MODEL}; pg8::StaticOrder S; S.init(Mo, 2 * D_FF, G, wg);
            pg8::EpiConvAct E{w.ACT, w.HALO, I->ffn_conv_w + (size_t)l * 3 * 2 * D_FF, I->ffn_conv_b + (size_t)l * 2 * D_FF, D_FF};
            pg8::gemm_phase<pg8::EpiConvAct, pg8::StaticOrder, true, true>((PG8_LAS unsigned char*)lds_raw, g, S, E, tid); }
        SEAM(pb + 9);
        if (ON(10) && IN(pb + 10)) { PHASE_WS; PHASE_IDS; const float* MODl = w.MOD + (size_t)l * (BATCH + 1) * NMODV; (void)MODl; misc::act_fix_phase(w.HALO, I->ffn_conv_w + (size_t)l * 3 * 2 * D_FF, I->ffn_conv_b + (size_t)l * 2 * D_FF, w.ACT, Mo, gtid, gthreads); }
        SEAM(pb + 10);
        if (ON(11) && IN(pb + 11)) { PHASE_WS; PHASE_IDS; const float* MODl = w.MOD + (size_t)l * (BATCH + 1) * NMODV; (void)MODl;
            { pg8::Gemm g{w.ACT, w.WDOWN + l * SZ_WDOWN, M_LAT, D_MODEL, D_FF, D_FF}; pg8::StaticOrder S; S.init(M_LAT, D_MODEL, G, wg);
              pg8::EpiGateRes E{w.H, want_ctx ? w.H : pp->out, D_MODEL, MODl + 5 * D_MODEL, NMODV, SEQ, BATCH, M_LAT};
              pg8::gemm_phase<pg8::EpiGateRes, pg8::StaticOrder, true, true>((PG8_LAS unsigned char*)lds_raw, g, S, E, tid); }
            if (want_ctx) { constexpr int SK = SK_DOWN;
              pg8::Gemm g{w.ACT + (size_t)M_LAT * D_FF, w.WDOWN + l * SZ_WDOWN, M_CTX, D_MODEL, D_FF / SK, D_FF}; SplitOrder S; S.init(M_CTX, D_MODEL, SK, G, (wg + G / 2) % G);
              pg8::EpiPart E{w.PART, D_MODEL, (size_t)M_CTX * D_MODEL};
              pg8::gemm_phase<pg8::EpiPart, SplitOrder, true, true>((PG8_LAS unsigned char*)lds_raw, g, S, E, tid); } }
        SEAM(pb + 11);

}
__global__ void __launch_bounds__(NTHR, 2) fwd(Params p) {
    extern __shared__ __attribute__((aligned(16))) unsigned char lds_raw[];
    char* lds = (char*)lds_raw;
    const int G = (int)gridDim.x, wg = (int)blockIdx.x, nwaves = G * NWAVES, gthreads = G * NTHR;
    const int C_wave0 = __builtin_amdgcn_readfirstlane((int)threadIdx.x >> 6);
    volatile LAS unsigned* MISC = (volatile LAS unsigned*)(lds_raw + LDS_MISC);
    if (threadIdx.x < 32) MISC[threadIdx.x] = 0u;
    __syncthreads();
    const int lo = p.ph_lo, hi = p.ph_hi;
    unsigned* const barw = (unsigned*)p.ws + CW_BAR + (size_t)p.li * XCD_BAR_WORDS;
    XcdBarrier bar; bar.bar = barw; bar.x = 0; bar.st = MISC + 8;
    if (hi - lo > 1) bar = xcd_barrier_post(barw, MISC + 8, threadIdx.x == 0);

    if (ON(12) && IN(PH_PRO)) { PHASE_WS; PHASE_IDS;
        {
            float* SCs = (float*)lds;
            float* red = (float*)(lds + 3 * D_MODEL * 4);
            constexpr int NT = DEPTH * NMODV / 256;
            if (wg < NT) {
                for (int i = tid; i < (BATCH + 1) * D_MODEL; i += NTHR) { const int s = i / D_MODEL, k = i % D_MODEL; const float v = s < BATCH ? I->c[s * D_MODEL + k] : I->c_ctx[k]; SCs[i] = v / (1.0f + __expf(-v)); }
                __syncthreads();
            }
            for (int t = wg; t < NT; t += G) { const int l = t / (NMODV / 256), j0 = (t % (NMODV / 256)) * 256;
                misc::f32x4 acc[3] = {{0.f, 0.f, 0.f, 0.f}, {0.f, 0.f, 0.f, 0.f}, {0.f, 0.f, 0.f, 0.f}};
                const float* wp = I->ada_w + (size_t)l * D_MODEL * NMODV + (size_t)(256 * wave) * NMODV + j0 + 4 * lane;
#pragma unroll 8
                for (int k = 0; k < 256; ++k) { const misc::f32x4 wv = *(const misc::f32x4*)(wp + (size_t)k * NMODV); const int kk = 256 * wave + k;
                    acc[0] += wv * SCs[kk]; acc[1] += wv * SCs[D_MODEL + kk]; acc[2] += wv * SCs[2 * D_MODEL + kk]; }
                __syncthreads();
#pragma unroll
                for (int s = 0; s < 3; ++s) *(misc::f32x4*)(red + (wave * 3 + s) * 256 + 4 * lane) = acc[s];
                __syncthreads();
                for (int i = tid; i < 3 * 256; i += NTHR) { const int s = i / 256, c = i % 256; float sum = I->ada_b[(size_t)l * NMODV + j0 + c];
#pragma unroll
                    for (int w8 = 0; w8 < 8; ++w8) sum += red[(w8 * 3 + s) * 256 + c];
                    w.MOD[((size_t)l * (BATCH + 1) + s) * NMODV + j0 + c] = sum; }
            }
            __syncthreads();
        }
        {
            float* scr = (float*)(lds + wave * 8448);
            constexpr int I_IN = (D_MODEL / 64) * (NP / 32), I_OUT = (D_MODEL / 64) * (D_MODEL / 32), I_UP = (D_MODEL / 64) * (2 * D_FF / 32), I_DN = (D_FF / 64) * (D_MODEL / 32),
                          I_UQ = (MLA_Q_LORA / 64) * (NQ_MLA / 32), I_UKV = (MLA_KV_LORA / 64) * (NKV_MLA / 32), I_LB = (LRU_BW / 64) * (LRU_BW / 32), I_LRU = 2 * 2 * NH * I_LB;
            constexpr int I_LAYER = I_IN + I_OUT + I_UP + I_DN + I_UQ + I_UKV + I_LRU;
            for (int it = gwave; it < DEPTH * I_LAYER; it += nwaves) { const int l = it / I_LAYER; int r = it % I_LAYER;
                if (r < I_IN) { misc::transpose_item(I->w_in + (size_t)l * D_MODEL * IN_COLS, D_MODEL, IN_COLS, NP, w.WIN + l * SZ_WIN, scr, r, lane); continue; } r -= I_IN;
                if (r < I_OUT) { misc::transpose_item(I->w_out + (size_t)l * D_MODEL * D_MODEL, D_MODEL, D_MODEL, D_MODEL, w.WOUT + l * SZ_WOUT, scr, r, lane); continue; } r -= I_OUT;
                if (r < I_UP) { misc::transpose_item(I->ffn_w_up + (size_t)l * D_MODEL * 2 * D_FF, D_MODEL, 2 * D_FF, 2 * D_FF, w.WUP + l * SZ_WUP, scr, r, lane, D_FF); continue; } r -= I_UP;
                if (r < I_DN) { misc::transpose_item(I->ffn_w_down + (size_t)l * D_FF * D_MODEL, D_FF, D_MODEL, D_MODEL, w.WDOWN + l * SZ_WDOWN, scr, r, lane); continue; } r -= I_DN;
                if (r < I_UQ) { misc::transpose_item(I->mla_w_uq + (size_t)l * MLA_Q_LORA * NQ_MLA, MLA_Q_LORA, NQ_MLA, NQ_MLA, w.WUQ + l * SZ_WUQ, scr, r, lane); continue; } r -= I_UQ;
                if (r < I_UKV) { misc::transpose_item(I->mla_w_ukv + (size_t)l * MLA_KV_LORA * NKV_MLA, MLA_KV_LORA, NKV_MLA, NKV_MLA, w.WUKV + l * SZ_WUKV, scr, r, lane); continue; } r -= I_UKV;
                { const int blk = r / I_LB, item = r % I_LB, d = blk / (2 * NH), wh = (blk / NH) & 1, nb = blk % NH;
                  const float* src = (wh == 0 ? I->lru_wa : I->lru_wx) + ((size_t)(l * 2 + d) * NH + nb) * lru::SZ_WBLK;
                  misc::transpose_item(src, LRU_BW, LRU_BW, LRU_BW, w.WLRU + ((size_t)l * 16 + blk) * lru::SZ_WBLK, scr, item, lane); }
            }
        }
    }
    SEAM(PH_PRO);

    { LayerCtx C; C.lo = lo; C.hi = hi; C.G = G; C.wg = wg; C.nwaves = nwaves; C.gthreads = gthreads; C.wave0 = C_wave0; C.bar = bar; C.lds = lds; C.lds_raw = lds_raw;
      static_assert(DEPTH == 4, "layer calls are written out (a real layer loop lets LICM park loop-invariant values in registers across every phase: spills)");
      layer_body<0>(C); layer_body<1>(C); layer_body<2>(C); layer_body<3>(C); }
#undef IN
#undef SEAM
}

#ifndef MK_PHASES_PER_LAUNCH
#define MK_PHASES_PER_LAUNCH NPH
#endif
extern "C" void kernel_launch(void* const* d_in, const int* in_sizes, int n_in, void* d_out, int out_size, void* d_ws, size_t ws_size, hipStream_t stream) {
    static int grid = 0;
    if (grid == 0) {
        int dev = 0, cus = 0;
        if (hipGetDevice(&dev) != hipSuccess || hipDeviceGetAttribute(&cus, hipDeviceAttributeMultiprocessorCount, dev) != hipSuccess || cus <= 0) { fprintf(stderr, "kernel_launch: no device\n"); grid = -1; return; }
        if (hipFuncSetAttribute((const void*)fwd, hipFuncAttributeMaxDynamicSharedMemorySize, LDS_BYTES) != hipSuccess) { fprintf(stderr, "kernel_launch: hipFuncSetAttribute failed\n"); grid = -1; return; }
        int per_cu = 0; if (hipOccupancyMaxActiveBlocksPerMultiprocessor(&per_cu, (const void*)fwd, NTHR, LDS_BYTES) != hipSuccess || per_cu < 1) fprintf(stderr, "kernel_launch: occupancy query says %d blocks per CU\n", per_cu);
        (void)hipGetLastError();
        grid = cus;
        const WS w0 = ws_carve(nullptr);
        if (n_in != 34 || w0.total > ws_size) { fprintf(stderr, "kernel_launch: bad inputs / workspace (need %zu, have %zu)\n", w0.total, ws_size); grid = -1; return; }
    }
    if (grid < 0) return;
    (void)hipMemsetAsync(d_ws, 0, 1 << 20, stream);
    Params p; memset(&p, 0, sizeof(p));
    for (int i = 0; i < 34; ++i) p.in[i] = (const float*)d_in[i];
    p.out = (float*)d_out; p.ws = (unsigned char*)d_ws;
    int li = 0;
    for (int lo = 0; lo < NPH; lo += MK_PHASES_PER_LAUNCH, ++li) {
        p.ph_lo = lo; p.ph_hi = lo + MK_PHASES_PER_LAUNCH < NPH ? lo + MK_PHASES_PER_LAUNCH : NPH; p.li = li;
#if defined(PROBE_MASK)
        if (MK_PHASES_PER_LAUNCH == 1 && ((((PROBE_MASK) >> 12) & 1 && lo == 0) || (lo > 0 && (((PROBE_MASK) >> ((lo - 1) % PH_PER_LAYER)) & 1))))
            { Params q = p;
#if defined(PROBE_FLAGS)
              q.pad = PROBE_FLAGS;
#endif
              for (int r = 0; r < PROBE_REPS; ++r) hipLaunchKernelGGL(fwd, dim3(grid), dim3(NTHR), LDS_BYTES, stream, q); }
#endif
        hipLaunchKernelGGL(fwd, dim3(grid), dim3(NTHR), LDS_BYTES, stream, p);
    }
}
```

```cpp
#include <hip/hip_runtime.h>
#include <cstdio>
#include <cstdint>
#include <cstring>
#include <math.h>
#include <stdint.h>

#ifdef CFG_SMALL
constexpr int D_MODEL = 256, BATCH = 2, SEQ = 512, DEPTH = 2, CTX_LEN = 64, GRID_W = 32, HEAD_DIM = 16;
#else
constexpr int D_MODEL = 2048, BATCH = 2, SEQ = 8192, DEPTH = 4, CTX_LEN = 256, GRID_W = 64, HEAD_DIM = 128;
#endif
constexpr int GROUP_W = D_MODEL / 4, NH = GROUP_W / HEAD_DIM;
constexpr int HD = HEAD_DIM;
constexpr int N_MOD = 6;
constexpr float EPS = 1e-6f;
constexpr int LRU_W = GROUP_W, LRU_BW = LRU_W / NH;
constexpr float LRU_C = 8.0f;
constexpr int MLA_Q_LORA = 3 * D_MODEL / 16, MLA_KV_LORA = D_MODEL / 8, MLA_NOPE = HD, MLA_ROPE = HD / 2, MLA_V = HD, MLA_QK = MLA_NOPE + MLA_ROPE;
constexpr int GDN_CHUNK = 64;
constexpr int NA_KH = 8, NA_KW = 16;
constexpr int D_FF = 5 * D_MODEL / 2;
constexpr int ROWS = SEQ / GRID_W;
constexpr int C_LRU_X = 0, C_LRU_G = C_LRU_X + LRU_W, C_CQ = C_LRU_G + LRU_W, C_CKV = C_CQ + MLA_Q_LORA, C_KR = C_CKV + MLA_KV_LORA,
              C_GQ = C_KR + MLA_ROPE, C_GK = C_GQ + GROUP_W, C_GV = C_GK + GROUP_W, C_GG = C_GV + GROUP_W, C_GB = C_GG + GROUP_W,
              C_GA = C_GB + 2 * NH, C_NQ = C_GA + 2 * NH, C_NK = C_NQ + GROUP_W, C_NV = C_NK + GROUP_W, IN_COLS = C_NV + GROUP_W;
constexpr int NP = (IN_COLS + 255) / 256 * 256;
constexpr int M_LAT = BATCH * SEQ, M_CTX = BATCH * CTX_LEN, M_ALL = M_LAT + M_CTX;
constexpr int NMODV = N_MOD * D_MODEL;

typedef unsigned short bf16_t;
__host__ __device__ __forceinline__ bf16_t f2bf(float f) { union { float f; unsigned u; } v; v.f = f; unsigned u = v.u; u += 0x7fffu + ((u >> 16) & 1u); return (bf16_t)(u >> 16); }
__host__ __device__ __forceinline__ float bf2f(bf16_t b) { union { float f; unsigned u; } v; v.u = ((unsigned)b) << 16; return v.f; }
__host__ __device__ __forceinline__ float sigmoidf_(float x) { return 1.0f / (1.0f + expf(-x)); }
__host__ __device__ __forceinline__ float siluf_(float x) { return x / (1.0f + expf(-x)); }
__host__ __device__ __forceinline__ float softplusf_(float x) { return fmaxf(x, 0.0f) + log1pf(expf(-fabsf(x))); }
__host__ __device__ __forceinline__ float geluf_(float x) { return 0.5f * x * (1.0f + tanhf(0.7978845608028654f * (x + 0.044715f * x * x * x))); }

struct RowInfo { int b, t, T, base, set; };
__host__ __device__ __forceinline__ RowInfo row_info(int r) {
    RowInfo i;
    if (r < M_LAT) { i.b = r / SEQ; i.t = r % SEQ; i.T = SEQ; i.base = i.b * SEQ; i.set = i.b; }
    else { const int rr = r - M_LAT; i.b = rr / CTX_LEN; i.t = rr % CTX_LEN; i.T = CTX_LEN; i.base = M_LAT + i.b * CTX_LEN; i.set = BATCH; }
    return i;
}


__host__ __device__ __forceinline__ float bflo(unsigned w) { union { float f; unsigned u; } v; v.u = w << 16; return v.f; }
__host__ __device__ __forceinline__ float bfhi(unsigned w) { union { float f; unsigned u; } v; v.u = w & 0xffff0000u; return v.f; }
#define LDS_BARRIER() asm volatile("s_waitcnt lgkmcnt(0)\n\ts_barrier" ::: "memory")
__device__ __forceinline__ float lane_xor(float v, int mask, int lane) { return __int_as_float(__builtin_amdgcn_ds_bpermute((lane ^ mask) << 2, __float_as_int(v))); }
__device__ __forceinline__ float lane_get(float v, int src_lane) { return __int_as_float(__builtin_amdgcn_ds_bpermute(src_lane << 2, __float_as_int(v))); }
struct Inputs {
    const float *x, *c, *ctx, *c_ctx, *ada_w, *ada_b, *norm_mix_g, *norm_ffn_g, *w_in, *w_out,
        *lru_conv_w, *lru_conv_b, *lru_wa, *lru_ba, *lru_wx, *lru_bx, *lru_lam,
        *mla_qa_g, *mla_w_uq, *mla_kva_g, *mla_w_ukv, *mla_qn_g, *mla_kn_g,
        *gdn_conv_w, *gdn_a_log, *gdn_dt_bias, *gdn_norm_g, *na_qn_g, *na_kn_g, *na_rpb,
        *ffn_w_up, *ffn_conv_w, *ffn_conv_b, *ffn_w_down;
};
constexpr int NQ_MLA = NH * MLA_QK, NKV_MLA = NH * (MLA_NOPE + MLA_V);
constexpr size_t SZ_WIN = (size_t)NP * D_MODEL, SZ_WOUT = (size_t)D_MODEL * D_MODEL, SZ_WUP = (size_t)2 * D_FF * D_MODEL, SZ_WDOWN = (size_t)D_MODEL * D_FF,
                 SZ_WUQ = (size_t)NQ_MLA * MLA_Q_LORA, SZ_WUKV = (size_t)NKV_MLA * MLA_KV_LORA, SZ_WLRU = (size_t)16 * LRU_BW * LRU_BW;
struct WS {
    unsigned* ctl; float *MOD, *H, *PART; bf16_t *U, *Y;
    bf16_t *WIN, *WOUT, *WUP, *WDOWN, *WUQ, *WUKV, *WLRU;
    bf16_t* P; bf16_t *CQN, *CKVN, *QR, *KVR, *QM, *KM, *VM, *NQ, *NK;
    bf16_t *gUT, *gWP, *gKDT, *gQD, *gQK, *gSIT, *gVNT; float *gGT, *gSS;
    bf16_t *lHLOC, *lACUM; float *lLSUM, *lHIN;
    bf16_t *HALO, *ACT;
    size_t total;
};
__host__ __device__ inline WS ws_carve(void* base) {
    WS w; size_t off = 0; char* b = (char*)base;
#define WS_TAKE(T, field, bytes) do { w.field = (T*)(b + off); off += (((size_t)(bytes)) + 255) & ~(size_t)255; } while (0)
    WS_TAKE(unsigned, ctl, 1 << 20);
    WS_TAKE(float, MOD, sizeof(float) * (size_t)DEPTH * (BATCH + 1) * NMODV);
    WS_TAKE(float, H, sizeof(float) * (size_t)M_ALL * D_MODEL);
    WS_TAKE(float, PART, sizeof(float) * (size_t)5 * M_CTX * D_MODEL);
    WS_TAKE(bf16_t, U, 2 * (size_t)M_ALL * D_MODEL);
    WS_TAKE(bf16_t, Y, 2 * (size_t)M_ALL * D_MODEL);
    WS_TAKE(bf16_t, WIN, 2 * SZ_WIN * DEPTH); WS_TAKE(bf16_t, WOUT, 2 * SZ_WOUT * DEPTH); WS_TAKE(bf16_t, WUP, 2 * SZ_WUP * DEPTH); WS_TAKE(bf16_t, WDOWN, 2 * SZ_WDOWN * DEPTH);
    WS_TAKE(bf16_t, WUQ, 2 * SZ_WUQ * DEPTH); WS_TAKE(bf16_t, WUKV, 2 * SZ_WUKV * DEPTH); WS_TAKE(bf16_t, WLRU, 2 * SZ_WLRU * DEPTH);
    const size_t r0 = off;
    WS_TAKE(bf16_t, P, 2 * (size_t)M_ALL * NP);
    WS_TAKE(bf16_t, CQN, 2 * (size_t)M_ALL * MLA_Q_LORA); WS_TAKE(bf16_t, CKVN, 2 * (size_t)M_ALL * MLA_KV_LORA);
    WS_TAKE(bf16_t, QR, 2 * (size_t)M_ALL * NQ_MLA); WS_TAKE(bf16_t, KVR, 2 * (size_t)M_ALL * NKV_MLA);
    WS_TAKE(bf16_t, QM, 2 * (size_t)M_ALL * NQ_MLA); WS_TAKE(bf16_t, KM, 2 * (size_t)M_ALL * NQ_MLA); WS_TAKE(bf16_t, VM, 2 * (size_t)M_ALL * NH * MLA_V);
    WS_TAKE(bf16_t, NQ, 2 * (size_t)M_ALL * GROUP_W); WS_TAKE(bf16_t, NK, 2 * (size_t)M_ALL * GROUP_W);
    { constexpr size_t NT_ = (size_t)(M_ALL / 64) * NH * 2;
      WS_TAKE(bf16_t, gUT, 2 * NT_ * 128 * 64); WS_TAKE(bf16_t, gWP, 2 * NT_ * 64 * 128); WS_TAKE(bf16_t, gKDT, 2 * NT_ * 128 * 64); WS_TAKE(bf16_t, gQD, 2 * NT_ * 64 * 128);
      WS_TAKE(bf16_t, gQK, 2 * NT_ * 64 * 64); WS_TAKE(bf16_t, gSIT, 2 * NT_ * 128 * 128); WS_TAKE(bf16_t, gVNT, 2 * NT_ * 128 * 64); WS_TAKE(float, gGT, 4 * NT_ * DEPTH); WS_TAKE(float, gSS, 4 * (size_t)BATCH * NH * 2 * HD * HD); }
    WS_TAKE(bf16_t, lHLOC, 2 * (size_t)2 * M_ALL * LRU_W); WS_TAKE(bf16_t, lACUM, 2 * (size_t)2 * M_ALL * LRU_W);
    WS_TAKE(float, lLSUM, 4 * (size_t)(M_ALL / 64) * 2 * 2 * LRU_W); WS_TAKE(float, lHIN, 4 * (size_t)(M_ALL / 64) * 2 * LRU_W);
    const size_t r1 = off;
    off = r0;
    WS_TAKE(bf16_t, HALO, 2 * (size_t)(M_ALL / 64) * 4 * 2 * D_FF); WS_TAKE(bf16_t, ACT, 2 * (size_t)M_ALL * D_FF);
    const size_t f1 = off;
#undef WS_TAKE
    w.total = r1 > f1 ? r1 : f1;
    return w;
}

namespace pg8 {
#define PG8_LAS __attribute__((address_space(3)))
typedef unsigned short bf16_t;
typedef short bf16x8 __attribute__((ext_vector_type(8)));
typedef float f32x4 __attribute__((ext_vector_type(4)));
typedef unsigned u32x4 __attribute__((ext_vector_type(4)));
constexpr int BM = 256, BK = 64, HALF = 128, HTB = HALF * BK * 2  , STAGE_BYTES = 8 * HTB, NXCD = 8, WGM = 8;

__host__ __device__ __forceinline__ int lds_byte(int r, int c) { const int st = (r >> 4) * 2 + (c >> 5), rr = r & 15, cc = c & 31, ob = rr * 64 + cc * 2; return st * 1024 + (ob ^ (((ob >> 9) & 1) << 5)); }
__host__ __device__ __forceinline__ void stage_rc(int b, int& R, int& C) { const int st = b / 1024, sb = b % 1024, swz = sb ^ (((sb >> 9) & 1) << 5); R = (st >> 1) * 16 + swz / 64; C = (st & 1) * 32 + (swz % 64) / 2; }
__host__ __device__ __forceinline__ int perm32(int rho) { const int n = rho >> 4, i = rho & 15; return 8 * (i >> 2) + 4 * n + (i & 3); }

struct Unit { int pm, pn, ks; };
struct Gemm { const bf16_t* A; const bf16_t* Bt; int M, N, K, ld; };

struct StaticOrder {
    int nM, nN, nwg, G, c;
    __host__ __device__ void init(int M, int N, int G_, int c_) { nM = M / BM; nN = N / BM; nwg = nM * nN; G = G_; c = c_; }
    __host__ __device__ bool next(int i, Unit& u) const {
        const long L = (long)i * G + c; if (L >= nwg) return false;
        int wgid = (int)L; { const int q = nwg / NXCD, r = nwg % NXCD, xcd = wgid % NXCD, off = wgid / NXCD; wgid = (xcd < r ? xcd * (q + 1) : r * (q + 1) + (xcd - r) * q) + off; }
        const int nig = WGM * nN, gid = wgid / nig, fm = gid * WGM, gsz = (nM - fm) < WGM ? (nM - fm) : WGM;
        u.pm = fm + ((wgid % nig) % gsz); u.pn = (wgid % nig) / gsz; u.ks = 0; return true;
    }
    __device__ __forceinline__ void a_ready(const Unit&) const {}
    __device__ __forceinline__ void done(const Unit&) const {}
};
__device__ __forceinline__ unsigned cvt_pk_bf16(float lo, float hi) { unsigned r; asm volatile("v_cvt_pk_bf16_f32 %0, %1, %2" : "=v"(r) : "v"(lo), "v"(hi)); return r; }
typedef float f32x2 __attribute__((ext_vector_type(2)));
__device__ __forceinline__ f32x2 gelu_pk(f32x2 v) {
    const f32x2 av = __builtin_elementwise_abs(v), d = av * 0.2316418882f + 1.0f;
    f32x2 t; t.x = __builtin_amdgcn_rcpf(d.x); t.y = __builtin_amdgcn_rcpf(d.y);
    f32x2 q = t * 0.5307027145f + (-0.7265760135f); q = q * t + 0.7107068705f; q = q * t + (-0.142248368f); q = q * t + 0.127414796f; q = q * t;
    const f32x2 s = (v * v) * (-0.72134752044f);
    f32x2 e; e.x = __builtin_amdgcn_exp2f(s.x); e.y = __builtin_amdgcn_exp2f(s.y);
    const f32x2 m = v * (q * e), r = v - m;
    f32x2 o; o.x = v.x < 0.f ? m.x : r.x; o.y = v.y < 0.f ? m.y : r.y; return o;
}

template <int ACT  > struct EpiBf16 {
    static constexpr bool PERM = true, AFTER_DRAIN = false; static_assert(ACT == 0 || ACT == 1, "EpiBf16: ACT is 0 (none) or 1 (gelu_pk)");
    bf16_t* O; int ldc; const float* bias; int split_cols; size_t split_stride; float scale0;
    __device__ __forceinline__ void operator()(const f32x4 (&acc)[2][2][4][2], const Unit& u, int wr, int wc, int fr, int fq) const {
        const int row0 = u.pm * BM + wr * 64 + fr; int colt = u.pn * BM; bf16_t* base = O;
        float sc = 1.f; if (split_cols) { const int t = colt / split_cols; base += (size_t)t * split_stride; colt -= t * split_cols; if (t == 0) sc = scale0; }
        const int col0 = colt + wc * 32 + 8 * fq, bcol0 = u.pn * BM + wc * 32 + 8 * fq;
        f32x4 bv[2][2];
#pragma unroll
        for (int bj = 0; bj < 2; ++bj)
#pragma unroll
            for (int n = 0; n < 2; ++n) bv[bj][n] = bias ? *(const f32x4*)(bias + bcol0 + bj * HALF + 4 * n) : (f32x4){0.f, 0.f, 0.f, 0.f};
#pragma unroll
        for (int ai = 0; ai < 2; ++ai)
#pragma unroll
            for (int m = 0; m < 4; ++m) { bf16_t* rowp = base + (size_t)(row0 + ai * HALF + m * 16) * ldc + col0;
#pragma unroll
                for (int bj = 0; bj < 2; ++bj) { f32x4 v0 = acc[ai][bj][m][0] + bv[bj][0], v1 = acc[ai][bj][m][1] + bv[bj][1];
                    if (ACT == 1) { f32x2 a = gelu_pk((f32x2){v0[0], v0[1]}), b = gelu_pk((f32x2){v0[2], v0[3]}), c = gelu_pk((f32x2){v1[0], v1[1]}), d = gelu_pk((f32x2){v1[2], v1[3]});
                        v0 = (f32x4){a.x, a.y, b.x, b.y}; v1 = (f32x4){c.x, c.y, d.x, d.y}; }
                    v0 = v0 * sc; v1 = v1 * sc; u32x4 w; w.x = cvt_pk_bf16(v0[0], v0[1]); w.y = cvt_pk_bf16(v0[2], v0[3]); w.z = cvt_pk_bf16(v1[0], v1[1]); w.w = cvt_pk_bf16(v1[2], v1[3]);
                    *(u32x4*)(rowp + bj * HALF) = w; } }
    }
};

struct EpiF32 {
    static constexpr bool PERM = false, AFTER_DRAIN = false;
    float* C; int ldc;
    __device__ __forceinline__ void operator()(const f32x4 (&acc)[2][2][4][2], const Unit& u, int wr, int wc, int fr, int fq) const {
        const int row0 = u.pm * BM + wr * 64 + fr, col0 = u.pn * BM + wc * 32 + 4 * fq;
#pragma unroll
        for (int ai = 0; ai < 2; ++ai)
#pragma unroll
            for (int m = 0; m < 4; ++m) { float* rowp = C + (size_t)(row0 + ai * HALF + m * 16) * ldc + col0;
#pragma unroll
                for (int bj = 0; bj < 2; ++bj)
#pragma unroll
                    for (int n = 0; n < 2; ++n) *(f32x4*)(rowp + bj * HALF + n * 16) = acc[ai][bj][m][n]; }
    }
};
struct EpiGateRes {
    static constexpr bool PERM = false, AFTER_DRAIN = false;
    const float* base; float* out; int ldc; const float* gate; int set_stride; int rows_per_set; int nsets_lat; int lat_rows;
    __device__ __forceinline__ void operator()(const f32x4 (&acc)[2][2][4][2], const Unit& u, int wr, int wc, int fr, int fq) const {
        const int row0 = u.pm * BM + wr * 64 + fr, col0 = u.pn * BM + wc * 32 + 4 * fq;
        const int set = (u.pm * BM >= lat_rows) ? nsets_lat : (u.pm * BM) / rows_per_set;
        const float* gp = gate + (size_t)set * set_stride + col0;
        f32x4 gv[2][2];
#pragma unroll
        for (int bj = 0; bj < 2; ++bj)
#pragma unroll
            for (int n = 0; n < 2; ++n) gv[bj][n] = *(const f32x4*)(gp + bj * HALF + n * 16);
#pragma unroll
        for (int ai = 0; ai < 2; ++ai)
#pragma unroll
            for (int m = 0; m < 4; ++m) { const size_t off = (size_t)(row0 + ai * HALF + m * 16) * ldc + col0;
#pragma unroll
                for (int bj = 0; bj < 2; ++bj)
#pragma unroll
                    for (int n = 0; n < 2; ++n) { const f32x4 b = *(const f32x4*)(base + off + bj * HALF + n * 16); *(f32x4*)(out + off + bj * HALF + n * 16) = b + gv[bj][n] * acc[ai][bj][m][n]; } }
    }
};

struct EpiConvAct {
    static constexpr bool PERM = false, AFTER_DRAIN = false;
    bf16_t* ACT; bf16_t* HALO; const float* cw; const float* cb; int dff;
    __device__ __forceinline__ static float ror1(float v) { return __int_as_float(__builtin_amdgcn_update_dpp(0, __float_as_int(v), 0x121, 0xf, 0xf, false)); }
    __device__ __forceinline__ static float rol1(float v) { return __int_as_float(__builtin_amdgcn_update_dpp(0, __float_as_int(v), 0x12f, 0xf, 0xf, false)); }
    __device__ __forceinline__ void operator()(const f32x4 (&acc)[2][2][4][2], const Unit& u, int wr, int wc, int fr, int fq) const {
        const int rowb = u.pm * BM + wr * 64, chb = u.pn * HALF + wc * 32 + 4 * fq;
        const bool f0 = fr == 0, f15 = fr == 15;
        typedef float f32x2 __attribute__((ext_vector_type(2)));
#pragma unroll
        for (int n = 0; n < 2; ++n)
#pragma unroll
            for (int ep = 0; ep < 2; ++ep) { const int ch = chb + 16 * n + 2 * ep;
                f32x2 wa[3], wg[3], ba, bg;
#pragma unroll
                for (int k = 0; k < 3; ++k) { wa[k] = *(const f32x2*)(cw + (size_t)k * 2 * dff + ch); wg[k] = *(const f32x2*)(cw + (size_t)k * 2 * dff + dff + ch); }
                ba = *(const f32x2*)(cb + ch); bg = *(const f32x2*)(cb + dff + ch);
#pragma unroll
                for (int ai = 0; ai < 2; ++ai) { const int blk = (rowb + ai * HALF) >> 6;
                    float y[4][2];
#pragma unroll
                    for (int eo = 0; eo < 2; ++eo) { const int e = 2 * ep + eo;
                        float Ra[4], La[4], Rg[4], Lg[4];
#pragma unroll
                        for (int m = 0; m < 4; ++m) { Ra[m] = ror1(acc[ai][0][m][n][e]); La[m] = rol1(acc[ai][0][m][n][e]); Rg[m] = ror1(acc[ai][1][m][n][e]); Lg[m] = rol1(acc[ai][1][m][n][e]); }
#pragma unroll
                        for (int m = 0; m < 4; ++m) {
                            const float ap = f0 ? Ra[m > 0 ? m - 1 : 0] : Ra[m], an = f15 ? La[m < 3 ? m + 1 : 3] : La[m];
                            const float gp = f0 ? Rg[m > 0 ? m - 1 : 0] : Rg[m], gn = f15 ? Lg[m < 3 ? m + 1 : 3] : Lg[m];
                            const float a = ba[eo] + wa[0][eo] * ap + wa[1][eo] * acc[ai][0][m][n][e] + wa[2][eo] * an;
                            const float g = bg[eo] + wg[0][eo] * gp + wg[1][eo] * acc[ai][1][m][n][e] + wg[2][eo] * gn;
                            y[m][eo] = a * (g * __builtin_amdgcn_rcpf(1.0f + __expf(-g))); }
                    }
#pragma unroll
                    for (int m = 0; m < 4; ++m) { const int row = rowb + ai * HALF + 16 * m + fr;
                        *(unsigned*)(ACT + (size_t)row * dff + ch) = cvt_pk_bf16(y[m][0], y[m][1]);
                        if ((m == 0 && fr < 2) || (m == 3 && fr >= 14)) { const int slot = m == 0 ? fr : fr - 12; bf16_t* hp = HALO + ((size_t)blk * 4 + slot) * (2 * dff) + ch;
                            *(unsigned*)hp = cvt_pk_bf16(acc[ai][0][m][n][2 * ep], acc[ai][0][m][n][2 * ep + 1]);
                            *(unsigned*)(hp + dff) = cvt_pk_bf16(acc[ai][1][m][n][2 * ep], acc[ai][1][m][n][2 * ep + 1]); }
                    }
                }
            }
    }
};

struct EpiPart {
    static constexpr bool PERM = false, AFTER_DRAIN = false;
    float* C; int ldc; size_t ks_stride;
    __device__ __forceinline__ void operator()(const f32x4 (&acc)[2][2][4][2], const Unit& u, int wr, int wc, int fr, int fq) const {
        const int row0 = u.pm * BM + wr * 64 + fr, col0 = u.pn * BM + wc * 32 + 4 * fq; float* Cb = C + (size_t)u.ks * ks_stride;
#pragma unroll
        for (int ai = 0; ai < 2; ++ai)
#pragma unroll
            for (int m = 0; m < 4; ++m) { float* rowp = Cb + (size_t)(row0 + ai * HALF + m * 16) * ldc + col0;
#pragma unroll
                for (int bj = 0; bj < 2; ++bj)
#pragma unroll
                    for (int n = 0; n < 2; ++n) *(f32x4*)(rowp + bj * HALF + n * 16) = acc[ai][bj][m][n]; }
    }
};

template <class Epi, class Sched, bool ALIGN_EPI = false, bool SP2 = false>
__device__ __forceinline__ void gemm_phase(PG8_LAS unsigned char* lds, const Gemm g, const Sched& S, const Epi& E, const int tid_in) {
    int tid_ = tid_in; asm volatile("" : "+v"(tid_));
    const int tid = tid_, wid = __builtin_amdgcn_readfirstlane(tid >> 6), lane = tid & 63, wr = wid >> 2, wc = wid & 3, fr = lane & 15, fq = lane >> 4;
    const int K = g.K, nt = K / BK;
    unsigned voffA[2], voffB[2];
#pragma unroll
    for (int i = 0; i < 2; ++i) { int R, C; stage_rc(tid * 16 + i * 8192, R, C); const int Rb = Epi::PERM ? ((R & ~31) + perm32(R & 31)) : R;
        voffA[i] = (unsigned)(R * g.ld + C) * 2u; voffB[i] = (unsigned)(Rb * g.ld + C) * 2u; }
    const size_t kstep = (size_t)(BK * 2);
    const size_t hstep = (size_t)HALF * g.ld * 2;
    const size_t tstep = 2 * hstep;
    const unsigned ldsw = (unsigned)wid * 1024u;
    const int aoff = lds_byte(wr * 64 + fr, fq * 8), boff = lds_byte(wc * 32 + fr, fq * 8);
#define PG8_SA(b, h) (((b) * 2 + (h)) * HTB)
#define PG8_SB(b, h) ((4 + (b) * 2 + (h)) * HTB)
#define PG8_STAGE(bufoff, gbase, voff) do { _Pragma("unroll") for (int _i = 0; _i < 2; ++_i) \
        __builtin_amdgcn_global_load_lds((const unsigned*)((const char*)(gbase) + (voff)[_i]), (PG8_LAS unsigned*)(lds + (bufoff) + ldsw + _i * 8192), 16, 0, 0); } while (0)
#define PG8_LDA(dst, b, h) do { _Pragma("unroll") for (int m = 0; m < 4; ++m) _Pragma("unroll") for (int k = 0; k < 2; ++k) dst[m][k] = *(const PG8_LAS bf16x8*)(lds + PG8_SA(b, h) + aoff + m * 2048 + k * 1024); } while (0)
#define PG8_LDB(dst, b, h) do { _Pragma("unroll") for (int n = 0; n < 2; ++n) _Pragma("unroll") for (int k = 0; k < 2; ++k) dst[n][k] = *(const PG8_LAS bf16x8*)(lds + PG8_SB(b, h) + boff + n * 2048 + k * 1024); } while (0)
#define PG8_MMA(ai, bj, At, Bt) do { __builtin_amdgcn_s_setprio(1); _Pragma("unroll") for (int m = 0; m < 4; ++m) _Pragma("unroll") for (int n = 0; n < 2; ++n) _Pragma("unroll") for (int k = 0; k < 2; ++k) \
        acc[ai][bj][m][n] = __builtin_amdgcn_mfma_f32_16x16x32_bf16(Bt[n][k], At[m][k], acc[ai][bj][m][n], 0, 0, 0); __builtin_amdgcn_s_setprio(0); } while (0)
#define PG8_WAIT_V(n) asm volatile("s_waitcnt vmcnt(" #n ")" ::: "memory")
#define PG8_WAIT_L(n) asm volatile("s_waitcnt lgkmcnt(" #n ")" ::: "memory")
#define PG8_BAR __builtin_amdgcn_s_barrier()
#define PG8_SCHED __builtin_amdgcn_sched_barrier(0)
    Unit cur, nxt; int ui = 0;
    if (!S.next(0, cur)) return;
    f32x4 acc[2][2][4][2];
#pragma unroll
    for (int a = 0; a < 2; ++a)
#pragma unroll
        for (int b = 0; b < 2; ++b)
#pragma unroll
            for (int m = 0; m < 4; ++m)
#pragma unroll
                for (int n = 0; n < 2; ++n) acc[a][b][m][n] = (f32x4){0.f, 0.f, 0.f, 0.f};
    bf16x8 At[4][2], B0[2][2], B1[2][2];
    const size_t ksb = (size_t)K * 2;
    const char* cA = (const char*)g.A + (size_t)cur.pm * tstep + (size_t)cur.ks * ksb; const char* cB = (const char*)g.Bt + (size_t)cur.pn * tstep + (size_t)cur.ks * ksb;
    S.a_ready(cur);
    if constexpr (SP2) {
        PG8_STAGE(PG8_SB(0, 0), cB, voffB); PG8_STAGE(PG8_SB(0, 1), cB + hstep, voffB); PG8_STAGE(PG8_SA(0, 0), cA, voffA); PG8_STAGE(PG8_SA(0, 1), cA + hstep, voffA);
        if (wr == 1) PG8_BAR;
        PG8_WAIT_V(2); PG8_BAR;
        PG8_STAGE(PG8_SB(1, 0), cB + kstep, voffB); PG8_STAGE(PG8_SA(1, 0), cA + kstep, voffA); PG8_STAGE(PG8_SB(1, 1), cB + hstep + kstep, voffB);
        PG8_WAIT_V(6); PG8_BAR;
    } else {
        PG8_STAGE(PG8_SB(0, 0), cB, voffB); PG8_STAGE(PG8_SA(0, 0), cA, voffA); PG8_STAGE(PG8_SB(0, 1), cB + hstep, voffB); PG8_STAGE(PG8_SA(0, 1), cA + hstep, voffA);
        if (wr == 1) PG8_BAR;
        PG8_WAIT_V(4); PG8_BAR;
        PG8_STAGE(PG8_SB(1, 0), cB + kstep, voffB); PG8_STAGE(PG8_SA(1, 0), cA + kstep, voffA); PG8_STAGE(PG8_SB(1, 1), cB + hstep + kstep, voffB);
        PG8_WAIT_V(6); PG8_BAR;
    }
    for (;;) {
        const bool has_next = S.next(ui + 1, nxt);
        const char* nA = has_next ? (const char*)g.A + (size_t)nxt.pm * tstep + (size_t)nxt.ks * ksb : cA; const char* nB = has_next ? (const char*)g.Bt + (size_t)nxt.pn * tstep + (size_t)nxt.ks * ksb : cB;
        for (int t = 0; t < nt; t += 2) {
            const bool last = (t == nt - 2);
            const char* a1 = cA + (size_t)(t + 1) * kstep;
            const char* a2 = last ? nA : cA + (size_t)(t + 2) * kstep; const char* b2 = last ? nB : cB + (size_t)(t + 2) * kstep;
            const char* a3 = a2 + kstep; const char* b3 = b2 + kstep;
            if (last && has_next) S.a_ready(nxt);
            if constexpr (SP2) {
            PG8_LDB(B0, 0, 0); PG8_LDB(B1, 0, 1); PG8_SCHED; PG8_LDA(At, 0, 0); PG8_STAGE(PG8_SA(1, 1), a1 + hstep, voffA);
            PG8_WAIT_V(8); PG8_WAIT_L(0); PG8_BAR; PG8_MMA(0, 0, At, B0); PG8_MMA(0, 1, At, B1); PG8_BAR; PG8_SCHED;
            PG8_LDA(At, 0, 1); PG8_STAGE(PG8_SB(0, 0), b2, voffB); PG8_STAGE(PG8_SB(0, 1), b2 + hstep, voffB); PG8_STAGE(PG8_SA(0, 0), a2, voffA);
            PG8_WAIT_V(8); PG8_WAIT_L(0); PG8_BAR; PG8_MMA(1, 0, At, B0); PG8_MMA(1, 1, At, B1); PG8_BAR; PG8_SCHED;
            PG8_LDB(B0, 1, 0); PG8_LDB(B1, 1, 1); PG8_SCHED; PG8_LDA(At, 1, 0); PG8_STAGE(PG8_SA(0, 1), a2 + hstep, voffA);
            PG8_WAIT_V(8); PG8_WAIT_L(0); PG8_BAR; PG8_MMA(0, 0, At, B0); PG8_MMA(0, 1, At, B1); PG8_BAR; PG8_SCHED;
            PG8_LDA(At, 1, 1); PG8_STAGE(PG8_SB(1, 0), b3, voffB); PG8_STAGE(PG8_SB(1, 1), b3 + hstep, voffB); PG8_STAGE(PG8_SA(1, 0), a3, voffA);
            PG8_WAIT_V(8); PG8_WAIT_L(0); PG8_BAR; PG8_MMA(1, 0, At, B0); PG8_MMA(1, 1, At, B1); PG8_BAR; PG8_SCHED;
            } else {
            PG8_LDB(B0, 0, 0); PG8_SCHED; PG8_LDA(At, 0, 0); PG8_STAGE(PG8_SA(1, 1), a1 + hstep, voffA);
            PG8_WAIT_L(8); PG8_BAR; PG8_WAIT_L(0); PG8_MMA(0, 0, At, B0); PG8_BAR; PG8_SCHED;
            PG8_LDB(B1, 0, 1); PG8_STAGE(PG8_SB(0, 0), b2, voffB);
            PG8_BAR; PG8_WAIT_L(0); PG8_MMA(0, 1, At, B1); PG8_BAR;
            PG8_LDA(At, 0, 1); PG8_STAGE(PG8_SA(0, 0), a2, voffA);
            PG8_BAR; PG8_WAIT_L(0); PG8_MMA(1, 0, At, B0); PG8_BAR; PG8_SCHED;
            PG8_STAGE(PG8_SB(0, 1), b2 + hstep, voffB);
            PG8_WAIT_V(6); PG8_BAR; PG8_MMA(1, 1, At, B1); PG8_BAR;
            PG8_LDB(B0, 1, 0); PG8_SCHED; PG8_LDA(At, 1, 0); PG8_STAGE(PG8_SA(0, 1), a2 + hstep, voffA);
            PG8_WAIT_L(8); PG8_BAR; PG8_WAIT_L(0); PG8_MMA(0, 0, At, B0); PG8_BAR; PG8_SCHED;
            PG8_LDB(B1, 1, 1); PG8_STAGE(PG8_SB(1, 0), b3, voffB);
            PG8_BAR; PG8_WAIT_L(0); PG8_MMA(0, 1, At, B1); PG8_BAR;
            PG8_LDA(At, 1, 1); PG8_STAGE(PG8_SA(1, 0), a3, voffA);
            PG8_BAR; PG8_WAIT_L(0); PG8_MMA(1, 0, At, B0); PG8_BAR; PG8_SCHED;
            PG8_STAGE(PG8_SB(1, 1), b3 + hstep, voffB);
            PG8_WAIT_V(6); PG8_BAR; PG8_MMA(1, 1, At, B1); PG8_BAR;
            }
        }
        if constexpr (ALIGN_EPI) { if (wr == 0) PG8_BAR; }
        if constexpr (!Epi::AFTER_DRAIN) { E(acc, cur, wr, wc, fr, fq); S.done(cur); }
        if (!has_next) break;
#pragma unroll
        for (int a = 0; a < 2; ++a)
#pragma unroll
            for (int b = 0; b < 2; ++b)
#pragma unroll
                for (int m = 0; m < 4; ++m)
#pragma unroll
                    for (int n = 0; n < 2; ++n) acc[a][b][m][n] = (f32x4){0.f, 0.f, 0.f, 0.f};
        cur = nxt; cA = nA; cB = nB; ++ui;
        if constexpr (ALIGN_EPI) { if (wr == 1) PG8_BAR; }
    }
    PG8_WAIT_V(0);
    if constexpr (!ALIGN_EPI) { if (wr == 0) PG8_BAR; }
    PG8_BAR;
    if constexpr (Epi::AFTER_DRAIN) { E.fused(acc, cur, wr, wc, fr, fq, lds, wid, lane); S.done(cur); }
#undef PG8_SA
#undef PG8_SB
#undef PG8_STAGE
#undef PG8_LDA
#undef PG8_LDB
#undef PG8_MMA
#undef PG8_WAIT_V
#undef PG8_WAIT_L
#undef PG8_BAR
#undef PG8_SCHED
}
}

namespace att {
using bf16x8 = __attribute__((ext_vector_type(8))) short;
using s16x4  = __attribute__((ext_vector_type(4))) short;
using f32x16 = __attribute__((ext_vector_type(16))) float;
using u32x4  = __attribute__((ext_vector_type(4))) unsigned;
constexpr int NW = 8, QBLK = 32, KVBLK = 64, DV = 128;
#define ATT_SBAR() __builtin_amdgcn_sched_barrier(0)
__device__ __forceinline__ int crow(int r, int hi) { return (r & 3) + 8 * (r >> 2) + 4 * hi; }
__device__ __forceinline__ unsigned cvtpk(float lo, float hi) { unsigned r; asm volatile("v_cvt_pk_bf16_f32 %0, %1, %2" : "=v"(r) : "v"(lo), "v"(hi)); return r; }
template <int DQK> __device__ __forceinline__ int kswz(int row, int colB) { return row * (DQK * 2) + (colB ^ ((row & 7) << 4)); }
constexpr float THR = 8.f;

template <int DQK> struct Cfg {
    static constexpr int SHM_V = KVBLK * DV * 2, SHM_K = KVBLK * DQK * 2;
    static constexpr int OFF_V = 0, OFF_K = 2 * SHM_V, OFF_WS = OFF_K + 2 * SHM_K, OFF_BIAS = OFF_WS + NW * 64 * 4, LDS_BYTES = OFF_BIAS + 10240;
    static constexpr int KCH = DQK / 8;
    static constexpr int KLD = (64 * KCH) / 512;
};

struct Job {
    const bf16_t* Q;
    const bf16_t* K;
    const bf16_t* V;
    bf16_t* O;
    int nt;
    int seg0_tiles, row_seg0, row_seg1;
    int R0; int rlo;
};

__device__ __forceinline__ int tile_row(const Job& J, int j) {
    if (j < J.seg0_tiles) return J.row_seg0 + 64 * j;
    int jj = j - J.seg0_tiles; if (jj > 3) jj = 0; return J.row_seg1 + 64 * jj;
}

__device__ __forceinline__ void partialSM(f32x16& p0, f32x16& p1, float& m_reg, float& mn, float& alpha, float C, float thr_raw) {
    float pmax = p0[0];
#pragma unroll
    for (int r = 1; r < 16; ++r) pmax = fmaxf(pmax, p0[r]);
#pragma unroll
    for (int r = 0; r < 16; ++r) pmax = fmaxf(pmax, p1[r]);
    { auto rr = __builtin_amdgcn_permlane32_swap(__float_as_uint(pmax), __float_as_uint(pmax), false, false);
      pmax = fmaxf(__uint_as_float(rr[0]), __uint_as_float(rr[1])); }
    if (__builtin_expect(__all(pmax - m_reg <= thr_raw), 1)) { mn = m_reg; alpha = 1.f; }
    else { mn = fmaxf(m_reg, pmax); alpha = __builtin_amdgcn_exp2f((m_reg - mn) * C); m_reg = mn; }
    const float mnC = -mn * C;
#pragma unroll
    for (int r = 0; r < 16; ++r) p0[r] = fmaf(p0[r], C, mnC);
#pragma unroll
    for (int r = 0; r < 16; ++r) p1[r] = fmaf(p1[r], C, mnC);
#pragma unroll
    for (int r = 0; r < 16; ++r) p0[r] = __builtin_amdgcn_exp2f(p0[r]);
}
__device__ __forceinline__ void finishSM(f32x16& p0, f32x16& p1, float alpha, float& l_reg, bf16x8& pa0, bf16x8& pa1, bf16x8& pa2, bf16x8& pa3) {
#pragma unroll
    for (int r = 0; r < 16; ++r) p1[r] = __builtin_amdgcn_exp2f(p1[r]);
    float ps = 0;
#pragma unroll
    for (int r = 0; r < 16; ++r) ps += p0[r];
#pragma unroll
    for (int r = 0; r < 16; ++r) ps += p1[r];
    { auto rr = __builtin_amdgcn_permlane32_swap(__float_as_uint(ps), __float_as_uint(ps), false, false);
      ps = __uint_as_float(rr[0]) + __uint_as_float(rr[1]); }
    l_reg = l_reg * alpha + ps;
#define ATT_PK4(P, BASE, OUT) do { unsigned a0 = cvtpk(P[BASE + 0], P[BASE + 1]), a1 = cvtpk(P[BASE + 2], P[BASE + 3]);   \
    unsigned b0 = cvtpk(P[BASE + 4], P[BASE + 5]), b1 = cvtpk(P[BASE + 6], P[BASE + 7]);                              \
    auto r0 = __builtin_amdgcn_permlane32_swap(a0, b0, false, false); auto r1 = __builtin_amdgcn_permlane32_swap(a1, b1, false, false); \
    u32x4 w = {r0[0], r1[0], r0[1], r1[1]}; OUT = *reinterpret_cast<bf16x8*>(&w); } while (0)
    ATT_PK4(p0, 0, pa0); ATT_PK4(p0, 8, pa1); ATT_PK4(p1, 0, pa2); ATT_PK4(p1, 8, pa3);
#undef ATT_PK4
}
template <int DQK> __device__ __forceinline__ void qkt(f32x16& p0, f32x16& p1, const char* Ks, const bf16x8* qr, int r32, int hi) {
    p0 = f32x16{}; p1 = f32x16{};
#pragma unroll
    for (int d0 = 0; d0 < DQK / 16; ++d0) { const int cb = (d0 * 16 + hi * 8) * 2;
        const bf16x8 b0 = *reinterpret_cast<const bf16x8*>(Ks + kswz<DQK>(r32, cb));
        const bf16x8 b1 = *reinterpret_cast<const bf16x8*>(Ks + kswz<DQK>(32 + r32, cb));
        p0 = __builtin_amdgcn_mfma_f32_32x32x16_bf16(b0, qr[d0], p0, 0, 0, 0);
        p1 = __builtin_amdgcn_mfma_f32_32x32x16_bf16(b1, qr[d0], p1, 0, 0, 0); }
}
__device__ __forceinline__ int v_st(int k, int c) { const int kk = (k & ~0xC) | ((k & 4) << 1) | ((k & 8) >> 1); return ((kk >> 3) * 4 + (c >> 5)) * 512 + ((kk & 7) * 32 + (c & 31)) * 2; }
__device__ __forceinline__ int v_rd_base(int lane) { return ((lane & 3) << 3) | (((lane >> 2) & 3) << 6) | (((lane >> 4) & 1) << 5) | (((lane >> 5) & 1) << 8); }
constexpr int v_rd_off(int d0, int ks, int half) { return d0 * 512 + ks * 4096 + half * 2048; }
template <int OFF> __device__ __forceinline__ s16x4 tr_read(int vb) { s16x4 r; asm volatile("ds_read_b64_tr_b16 %0, %1 offset:%2" : "=&v"(r) : "v"(vb), "i"(OFF) : "memory"); return r; }
template <int D0> __device__ __forceinline__ void pv_one(f32x16& od, int vb, bf16x8 pa0, bf16x8 pa1, bf16x8 pa2, bf16x8 pa3) {
    const s16x4 l0 = tr_read<v_rd_off(D0, 0, 0)>(vb), h0 = tr_read<v_rd_off(D0, 0, 1)>(vb), l1 = tr_read<v_rd_off(D0, 1, 0)>(vb), h1 = tr_read<v_rd_off(D0, 1, 1)>(vb);
    const s16x4 l2 = tr_read<v_rd_off(D0, 2, 0)>(vb), h2 = tr_read<v_rd_off(D0, 2, 1)>(vb), l3 = tr_read<v_rd_off(D0, 3, 0)>(vb), h3 = tr_read<v_rd_off(D0, 3, 1)>(vb);
    asm volatile("s_waitcnt lgkmcnt(0)" ::: "memory"); ATT_SBAR();
#define ATT_PK(L, H) (bf16x8){L[0], L[1], L[2], L[3], H[0], H[1], H[2], H[3]}
    od = __builtin_amdgcn_mfma_f32_32x32x16_bf16(pa0, ATT_PK(l0, h0), od, 0, 0, 0);
    od = __builtin_amdgcn_mfma_f32_32x32x16_bf16(pa1, ATT_PK(l1, h1), od, 0, 0, 0);
    od = __builtin_amdgcn_mfma_f32_32x32x16_bf16(pa2, ATT_PK(l2, h2), od, 0, 0, 0);
    od = __builtin_amdgcn_mfma_f32_32x32x16_bf16(pa3, ATT_PK(l3, h3), od, 0, 0, 0);
#undef ATT_PK
}
__device__ __forceinline__ void pv_d0(f32x16* o, int vb, bf16x8 pa0, bf16x8 pa1, bf16x8 pa2, bf16x8 pa3) {
    pv_one<0>(o[0], vb, pa0, pa1, pa2, pa3); pv_one<1>(o[1], vb, pa0, pa1, pa2, pa3); pv_one<2>(o[2], vb, pa0, pa1, pa2, pa3); pv_one<3>(o[3], vb, pa0, pa1, pa2, pa3);
}
constexpr int NA_BROW = 160, NA_BORG = 64 + (NA_KW - 1);
__device__ __forceinline__ void na_bias(f32x16& p0, f32x16& p1, const Job& J, int j, int R, int c, int hi, const float* biasq) {
    const int nloc = J.seg0_tiles;
    if (j >= nloc && j < nloc + 4) return;
    const int rr = J.rlo + j; int r0 = R - NA_KH / 2; r0 = r0 < 0 ? 0 : (r0 > ROWS - NA_KH ? ROWS - NA_KH : r0);
    const bool rowok = (j < nloc) && rr >= r0 && rr < r0 + NA_KH;
    if (!rowok) {
#pragma unroll
        for (int r = 0; r < 16; ++r) { p0[r] = -1e30f; p1[r] = -1e30f; }
        return; }
    int c0 = c - NA_KW / 2; c0 = c0 < 0 ? 0 : (c0 > GRID_W - NA_KW ? GRID_W - NA_KW : c0);
    const int dr = rr - R + (NA_KH - 1);
    const float* bl = biasq + dr * NA_BROW + NA_BORG + 4 * hi - c;
    const int vb = 4 * hi - c0;
#pragma unroll
    for (int r = 0; r < 16; ++r) { const int cc = (r & 3) + 8 * (r >> 2);
        p0[r] = ((unsigned)(cc + vb) < (unsigned)NA_KW) ? p0[r] + bl[cc] : -1e30f;
        p1[r] = ((unsigned)(cc + 32 + vb) < (unsigned)NA_KW) ? p1[r] + bl[cc + 32] : -1e30f; }
}

#define ATT_LAS __attribute__((address_space(3)))
template <int DQK, bool NA, int LDQ, int LDK, int LDV, int LDO>
__device__ __forceinline__ void attn_unit(const Job& J, char* lds, const float scale, const int tid_in) {
    using C_ = Cfg<DQK>;
    int tid_ = tid_in; asm volatile("" : "+v"(tid_));
    const int tid = tid_, wid = __builtin_amdgcn_readfirstlane(tid >> 6), lane = tid & 63, r32 = lane & 31, hi = lane >> 5;
    char* V_lds = lds + C_::OFF_V; char* K_lds = lds + C_::OFF_K;
    const unsigned ldsb = (unsigned)(uintptr_t)lds;
    float* wsf = (float*)(lds + C_::OFF_WS) + wid * 64; float* li_l = wsf; float* al_l = wsf + 32;
    const float* biasq = (const float*)(lds + C_::OFF_BIAS);
    const float Cc = scale * 1.4426950408889634f, thr_raw = THR / scale;
    float m_reg = -1e5f, l_reg = 0; f32x16 o[4] = {}; bf16x8 qr[DQK / 16];
    const bf16_t* Qw = J.Q + (long)(wid * QBLK + r32) * LDQ + hi * 8;
#pragma unroll
    for (int d0 = 0; d0 < DQK / 16; ++d0) qr[d0] = *reinterpret_cast<const bf16x8*>(Qw + d0 * 16);
    const int naR = J.R0 + (wid >> 1), nac = (wid & 1) * 32 + r32;
    const int vb0 = (int)(uintptr_t)V_lds + v_rd_base(lane);
    unsigned koff[C_::KLD], voff[2];
#pragma unroll
    for (int i = 0; i < C_::KLD; ++i) { const int sl = 512 * i + tid, row = sl / C_::KCH, cs = sl % C_::KCH, chunk = (cs & ~7) | ((cs & 7) ^ (row & 7)); koff[i] = (unsigned)(row * LDK * 2 + chunk * 16); }
#pragma unroll
    for (int i = 0; i < 2; ++i) { const int sl = 512 * i + tid, sub = sl >> 5, wi = sl & 31, kk = (sub >> 2) * 8 + (wi >> 2), k = (kk & ~0xC) | ((kk & 4) << 1) | ((kk & 8) >> 1), c = (sub & 3) * 32 + (wi & 3) * 8;
        voff[i] = (unsigned)(k * LDV * 2 + c * 2); }
#define ATT_STAGE(j, b) do { const int row0_ = tile_row(J, (j)); const char* vp_ = (const char*)(J.V + (size_t)row0_ * LDV); const char* kp_ = (const char*)(J.K + (size_t)row0_ * LDK); \
        _Pragma("unroll") for (int i_ = 0; i_ < C_::KLD; ++i_) __builtin_amdgcn_global_load_lds((const unsigned*)(kp_ + koff[i_]), (ATT_LAS unsigned*)(ldsb + C_::OFF_K + (b) * C_::SHM_K + (512 * i_ + 64 * wid) * 16), 16, 0, 0); \
        _Pragma("unroll") for (int i_ = 0; i_ < 2; ++i_) __builtin_amdgcn_global_load_lds((const unsigned*)(vp_ + voff[i_]), (ATT_LAS unsigned*)(ldsb + C_::OFF_V + (b) * C_::SHM_V + (512 * i_ + 64 * wid) * 16), 16, 0, 0); } while (0)
    const int NT = J.nt;
    __syncthreads();
    ATT_STAGE(0, 0); asm volatile("s_waitcnt vmcnt(0)" ::: "memory"); __syncthreads();
    for (int j = 0; j < NT; ++j) {
        const int buf = j & 1;
        if (j + 1 < NT) ATT_STAGE(j + 1, buf ^ 1);
        bool live = true;
        if (NA) { const int nloc = J.seg0_tiles; if (j >= nloc + 4) live = false; else if (j < nloc) { const int rr = J.rlo + j; int r0 = naR - NA_KH / 2; r0 = r0 < 0 ? 0 : (r0 > ROWS - NA_KH ? ROWS - NA_KH : r0); live = rr >= r0 && rr < r0 + NA_KH; } }
        if (live) {
        f32x16 p0, p1; float mn, al; bf16x8 pa0, pa1, pa2, pa3;
        qkt<DQK>(p0, p1, K_lds + buf * C_::SHM_K, qr, r32, hi);
        if (NA) na_bias(p0, p1, J, j, naR, nac, hi, biasq);
        partialSM(p0, p1, m_reg, mn, al, Cc, thr_raw);
        finishSM(p0, p1, al, l_reg, pa0, pa1, pa2, pa3);
        if (__any(al < 1.f)) { if (hi == 0) al_l[r32] = al; asm volatile("s_waitcnt lgkmcnt(0)" ::: "memory");
#pragma unroll
            for (int d = 0; d < 4; ++d)
#pragma unroll
                for (int r = 0; r < 16; ++r) o[d][r] *= al_l[crow(r, hi)]; }
        ATT_SBAR();
        pv_d0(o, vb0 + buf * C_::SHM_V, pa0, pa1, pa2, pa3);
        }
        asm volatile("s_waitcnt vmcnt(0)" ::: "memory");
        __syncthreads();
    }
    if (hi == 0) li_l[r32] = l_reg; asm volatile("s_waitcnt lgkmcnt(0)" ::: "memory");
    float rli[16];
#pragma unroll
    for (int r = 0; r < 16; ++r) rli[r] = __builtin_amdgcn_rcpf(li_l[crow(r, hi)]);
    bf16_t* Ow = J.O + (long)(wid * QBLK) * LDO;
#pragma unroll
    for (int r = 0; r < 16; ++r) { const int orow = crow(r, hi);
#pragma unroll
        for (int d0 = 0; d0 < 4; ++d0) Ow[(long)orow * LDO + d0 * 32 + r32] = f2bf(o[d0][r] * rli[r]); }
#undef ATT_STAGE
}
}

struct AttnArgs { const bf16_t *QM, *KM, *VM, *NQ, *NK, *P; bf16_t* Y; const float* rpb; int want_ctx; int pad; };
__device__ __forceinline__ void attention_phase(const AttnArgs& A, char* lds, int G, int wg, const int tid, const int nskip) {
    static_assert(GRID_W == 64 && SEQ % 256 == 0 && CTX_LEN == 256 && HD == 128, "attention phase geometry");
    constexpr int NQB = SEQ / 256;
    constexpr float sc_mla = 0.07216878364870323f, sc_na = 0.08838834764831845f;
    static_assert(MLA_QK == 192 && HD == 128, "softmax scales");
    if (!(A.pad & 2)) for (int u = wg; u < BATCH * NH * NQB; u += G) {
        const int bh = u % (BATCH * NH), qb = u / (BATCH * NH), b = bh / NH, h = bh % NH;
        att::Job J{};
        J.Q = A.QM + (size_t)(b * SEQ + qb * 256) * NQ_MLA + h * MLA_QK; J.K = A.KM + h * MLA_QK; J.V = A.VM + h * MLA_V;
        J.O = A.Y + (size_t)(b * SEQ + qb * 256) * D_MODEL + GROUP_W + h * MLA_V;
        J.nt = SEQ / 64 + CTX_LEN / 64; J.seg0_tiles = SEQ / 64; J.row_seg0 = b * SEQ; J.row_seg1 = M_LAT + b * CTX_LEN;
        att::attn_unit<MLA_QK, false, NQ_MLA, NQ_MLA, NH * MLA_V, D_MODEL>(J, lds, sc_mla, tid);
    }
    const int G2n = G - nskip, c2 = wg - nskip;
    if (!(A.pad & 4) && c2 >= 0) for (int u = c2; u < BATCH * NH * NQB; u += G2n) {
        const int bh = u % (BATCH * NH), qb = u / (BATCH * NH), b = bh / NH, h = bh % NH, R0 = qb * 4;
        __syncthreads();
        { float* bq = (float*)(lds + att::Cfg<HD>::OFF_BIAS); const float* src = A.rpb + (size_t)h * (2 * NA_KH - 1) * (2 * NA_KW - 1);
          for (int i = tid; i < (2 * NA_KH - 1) * att::NA_BROW; i += 512) { const int dr = i / att::NA_BROW; int dc = i % att::NA_BROW - att::NA_BORG + (NA_KW - 1); dc = dc < 0 ? 0 : (dc > 2 * NA_KW - 2 ? 2 * NA_KW - 2 : dc);
              bq[i] = src[dr * (2 * NA_KW - 1) + dc] * 11.313708498984761f; } }
        int rlo = R0 - NA_KH / 2; rlo = rlo < 0 ? 0 : (rlo > ROWS - NA_KH ? ROWS - NA_KH : rlo);
        int rhi = R0 + 3 - NA_KH / 2; rhi = (rhi < 0 ? 0 : (rhi > ROWS - NA_KH ? ROWS - NA_KH : rhi)) + NA_KH - 1;
        const int nloc = rhi - rlo + 1;
        att::Job J{};
        J.Q = A.NQ + (size_t)(b * SEQ + R0 * 64) * GROUP_W + h * HD; J.K = A.NK + h * HD; J.V = A.P + C_NV + h * HD;
        J.O = A.Y + (size_t)(b * SEQ + R0 * 64) * D_MODEL + 3 * GROUP_W + h * HD;
        J.nt = (nloc + 4 + 1) & ~1; J.seg0_tiles = nloc; J.row_seg0 = b * SEQ + rlo * 64; J.row_seg1 = M_LAT + b * CTX_LEN;  J.R0 = R0; J.rlo = rlo;
        att::attn_unit<HD, true, GROUP_W, GROUP_W, NP, D_MODEL>(J, lds, sc_na, tid);
    }
    if (A.want_ctx && !(A.pad & 8)) {
        for (int u = c2 - 64; u >= 0 && u < BATCH * NH; u += G) {
            const int b = u / NH, h = u % NH; const int crow0 = M_LAT + b * CTX_LEN;
            att::Job J{}; J.nt = CTX_LEN / 64; J.seg0_tiles = 0; J.row_seg0 = crow0; J.row_seg1 = crow0;
            J.Q = A.QM + (size_t)crow0 * NQ_MLA + h * MLA_QK; J.K = A.KM + h * MLA_QK; J.V = A.VM + h * MLA_V;
            J.O = A.Y + (size_t)crow0 * D_MODEL + GROUP_W + h * MLA_V; att::attn_unit<MLA_QK, false, NQ_MLA, NQ_MLA, NH * MLA_V, D_MODEL>(J, lds, sc_mla, tid);
        }
        for (int u = c2 - 64 - BATCH * NH; u >= 0 && u < BATCH * NH; u += G) {
            const int b = u / NH, h = u % NH; const int crow0 = M_LAT + b * CTX_LEN;
            att::Job J{}; J.nt = CTX_LEN / 64; J.seg0_tiles = 0; J.row_seg0 = crow0; J.row_seg1 = crow0;
            J.Q = A.NQ + (size_t)crow0 * GROUP_W + h * HD; J.K = A.NK + h * HD; J.V = A.P + C_NV + h * HD;
            J.O = A.Y + (size_t)crow0 * D_MODEL + 3 * GROUP_W + h * HD; att::attn_unit<HD, false, GROUP_W, GROUP_W, NP, D_MODEL>(J, lds, sc_na, tid);
        }
    }
}

namespace gdn {
typedef short bf16x8 __attribute__((ext_vector_type(8)));
typedef float f32x4 __attribute__((ext_vector_type(4)));
typedef float f32x16 __attribute__((ext_vector_type(16)));
typedef unsigned u32x2 __attribute__((ext_vector_type(2)));
typedef unsigned u32x4 __attribute__((ext_vector_type(4)));
constexpr int CH = 64, NCHUNK = M_ALL / CH;
constexpr int NTASK = NCHUNK * NH * 2;
constexpr size_t SZ_UT = 128 * 64, SZ_WP = 64 * 128, SZ_KDT = 128 * 64, SZ_QD = 64 * 128, SZ_QK = 64 * 64, SZ_SIT = 128 * 128, SZ_VNT = 128 * 64;
struct Bufs { bf16_t *UT, *WP, *KDT, *QD, *QK, *SIT, *VNT; float* GT; };
__device__ __forceinline__ int perm32(int o) { return (o & ~31) | (((o & 15) >> 2) * 8 + ((o >> 4) & 1) * 4 + (o & 3)); }
__device__ __forceinline__ unsigned pk2(float lo, float hi) { return (unsigned)f2bf(lo) | ((unsigned)f2bf(hi) << 16); }

constexpr int QS = 132;
constexpr int AS = 68;
constexpr int G1_OFF_Q = 0, G1_OFF_K = G1_OFF_Q + CH * QS * 4, G1_OFF_V = G1_OFF_K + CH * QS * 4, G1_OFF_AA = G1_OFF_V + CH * QS * 4, G1_OFF_SM = G1_OFF_AA + 2 * CH * AS * 4,
              G1_LDS = G1_OFF_SM + 12 * 64 * 4;
struct G1Args { const bf16_t* P; const float* conv_w; const float* a_log; const float* dt_bias; Bufs B; int pflags; };

__device__ __forceinline__ void g1_task(const G1Args& A, char* lds, int cix, int h, const int tid_in) {
    int tid_ = tid_in; asm volatile("" : "+v"(tid_));
    const int tid = tid_, wid = __builtin_amdgcn_readfirstlane(tid >> 6), lane = tid & 63;
    float* Qs = (float*)(lds + G1_OFF_Q); float* Ks = (float*)(lds + G1_OFF_K); float* Vs = (float*)(lds + G1_OFF_V); float* AA = (float*)(lds + G1_OFF_AA);
    float* sm = (float*)(lds + G1_OFF_SM); float* g_s = sm;   float* beta_s = sm + 128;   float* gc_s = sm + 256;
    const int row0 = cix * CH; const RowInfo r0i = row_info(row0);
    LDS_BARRIER();
    if (tid < 48 * 8) {
        const int grp = tid % 48, ts = tid / 48, which = grp >> 4, cc0 = (grp & 15) * 8, ch0 = which * GROUP_W + h * HD + cc0;
        float wgt[4][8];
#pragma unroll
        for (int j = 0; j < 4; ++j) { const f32x4 w0 = *(const f32x4*)(A.conv_w + j * 3 * GROUP_W + ch0), w1 = *(const f32x4*)(A.conv_w + j * 3 * GROUP_W + ch0 + 4);
#pragma unroll
            for (int e = 0; e < 4; ++e) { wgt[j][e] = w0[e]; wgt[j][4 + e] = w1[e]; } }
        u32x4 xr[11];
#pragma unroll
        for (int k = 0; k < 11; ++k) { const int tt = r0i.t + 8 * ts + k - 1;
            xr[k] = (tt >= 0 && tt < r0i.T && !(A.pflags & 4096)) ? *(const u32x4*)(A.P + (size_t)(r0i.base + tt) * NP + C_GQ + ch0) : (u32x4){0u, 0u, 0u, 0u}; }
        float* dstp = (which == 0 ? Qs : which == 1 ? Ks : Vs) + cc0;
#pragma unroll
        for (int i = 0; i < 8; ++i) { float acc[8];
#pragma unroll
            for (int e = 0; e < 8; ++e) acc[e] = 0.f;
#pragma unroll
            for (int j = 0; j < 4; ++j) { const u32x4 xv = xr[i + j];
#pragma unroll
                for (int e = 0; e < 4; ++e) { acc[2 * e] += wgt[j][2 * e] * bflo(xv[e]); acc[2 * e + 1] += wgt[j][2 * e + 1] * bfhi(xv[e]); } }
            f32x4 y0, y1;
#pragma unroll
            for (int e = 0; e < 4; ++e) { y0[e] = acc[e] * __builtin_amdgcn_rcpf(1.0f + __expf(-acc[e])); y1[e] = acc[4 + e] * __builtin_amdgcn_rcpf(1.0f + __expf(-acc[4 + e])); }
            *(f32x4*)(dstp + (8 * ts + i) * QS) = y0; *(f32x4*)(dstp + (8 * ts + i) * QS + 4) = y1; }
    }
    if (tid < 128) { const int d = tid >> 6, i = tid & 63; const size_t r = (size_t)(row0 + i) * NP;
        beta_s[d * 64 + i] = 1.0f / (1.0f + __expf(-bf2f(A.P[r + C_GB + d * NH + h])));
        g_s[d * 64 + i] = -__expf(A.a_log[d * NH + h]) * softplusf_(bf2f(A.P[r + C_GA + d * NH + h]) + A.dt_bias[d * NH + h]); }
    LDS_BARRIER();
    for (int rr = wid * 4 + (lane >> 4); rr < 2 * CH; rr += 32) { float* rowp = (rr < CH ? Qs : Ks) + (rr & 63) * QS + (lane & 15) * 8;
        f32x4 a = *(const f32x4*)rowp, b = *(const f32x4*)(rowp + 4); float ss = (a[0] * a[0] + a[1] * a[1]) + (a[2] * a[2] + a[3] * a[3]) + (b[0] * b[0] + b[1] * b[1]) + (b[2] * b[2] + b[3] * b[3]);
#pragma unroll
        for (int o = 1; o < 16; o <<= 1) ss += lane_xor(ss, o, lane);
        const float scl = __builtin_amdgcn_rsqf(ss + EPS) * (rr < CH ? 0.08838834764831845f : 1.0f);
        *(f32x4*)rowp = a * scl; *(f32x4*)(rowp + 4) = b * scl; }
    if (tid < 2) {
        f32x4 gv[16];
#pragma unroll
        for (int m = 0; m < 16; ++m) gv[m] = *(const f32x4*)(g_s + tid * 64 + 4 * m);
        float run = 0.f;
        if (tid == 0) {
#pragma unroll
            for (int m = 0; m < 16; ++m) { f32x4 o4;
#pragma unroll
                for (int e = 0; e < 4; ++e) { run += gv[m][e]; o4[e] = run; }
                *(f32x4*)(gc_s + 4 * m) = o4; }
        } else {
#pragma unroll
            for (int m = 15; m >= 0; --m) { f32x4 o4;
#pragma unroll
                for (int e = 3; e >= 0; --e) { run += gv[m][e]; o4[e] = run; }
                *(f32x4*)(gc_s + 64 + 4 * m) = o4; }
        }
    }
    LDS_BARRIER();
    float* eq_s = sm + 384; float* ek_s = sm + 512;
    if (tid < 128) { const int d = tid >> 6, i = tid & 63; const float gci = gc_s[d * 64 + i], glast = d == 0 ? gc_s[63] : gc_s[64];
        eq_s[tid] = __expf(gci); ek_s[tid] = __expf(glast - gci); }
    const int gwhich = wid >> 2, gI = (wid >> 1) & 1, gJ = wid & 1, r32 = lane & 31, hi = lane >> 5;
    f32x16 acc = {};
    if (!(A.pflags & 1024)) {
        const float* X = (gwhich ? Qs : Ks) + (32 * gI + r32) * QS + 4 * hi; const float* Yp = Ks + (32 * gJ + r32) * QS + 4 * hi;
#pragma unroll
        for (int s = 0; s < 16; ++s) { const f32x4 a4 = *(const f32x4*)(X + 8 * s), b4 = *(const f32x4*)(Yp + 8 * s);
#pragma unroll
            for (int e = 0; e < 4; ++e) acc = __builtin_amdgcn_mfma_f32_32x32x2f32(a4[e], b4[e], acc, 0, 0, 0); }
        const int j = 32 * gJ + r32;
        if (gwhich == 0) {
            const float b1j = beta_s[64 + j], g0j = gc_s[j], g1j = gc_s[64 + j];
#pragma unroll
            for (int r = 0; r < 16; ++r) { const int i = 32 * gI + (r & 3) + 8 * (r >> 2) + 4 * hi;
                if (i > j) { const float kk = acc[r];
                    AA[(63 - j) * AS + (63 - i)] = beta_s[i] * kk * __expf(gc_s[i] - g0j);
                    AA[CH * AS + i * AS + j] = b1j * kk * __expf(g1j - gc_s[64 + i]); } }
        }
    }
    LDS_BARRIER();
    const size_t t0 = ((size_t)cix * NH + h) * 2;
    if (!(A.pflags & 2048)) {
#pragma unroll
        for (int n = 0; n < 4; ++n) { const int it = tid + 512 * n, d = it >> 10, p = (it >> 4) & 63, m = it & 15, i = d == 0 ? p : 63 - p, k0 = 32 * (m >> 2) + 4 * (m & 3);
            const float e = eq_s[d * 64 + i]; const f32x4 lo = *(const f32x4*)(Qs + i * QS + k0), hi4 = *(const f32x4*)(Qs + i * QS + k0 + 16);
            *(u32x4*)(A.B.QD + (t0 + d) * SZ_QD + (size_t)p * 128 + m * 8) = (u32x4){pk2(lo[0] * e, lo[1] * e), pk2(lo[2] * e, lo[3] * e), pk2(hi4[0] * e, hi4[1] * e), pk2(hi4[2] * e, hi4[3] * e)}; }
#pragma unroll
        for (int n = 0; n < 4; ++n) { const int it = tid + 512 * n, k = it & 127, d = (it >> 7) & 1, m = it >> 8, p0 = 32 * (m >> 2) + 4 * (m & 3);
            float v[8];
#pragma unroll
            for (int jj = 0; jj < 8; ++jj) { const int p = p0 + (jj < 4 ? jj : 12 + jj), i = d == 0 ? p : 63 - p; v[jj] = Ks[i * QS + k] * ek_s[d * 64 + i]; }
            *(u32x4*)(A.B.KDT + (t0 + d) * SZ_KDT + (size_t)k * 64 + m * 8) = (u32x4){pk2(v[0], v[1]), pk2(v[2], v[3]), pk2(v[4], v[5]), pk2(v[6], v[7])}; }
        if (tid == 0) { A.B.GT[t0] = __expf(gc_s[63]); A.B.GT[t0 + 1] = __expf(gc_s[64]); }
    }
    LDS_BARRIER();
    bf16_t* stg = (bf16_t*)Qs;
    if (gwhich == 1) { const int j = 32 * gJ + r32; const float g0j = gc_s[j], g1j = gc_s[64 + j];
#pragma unroll
        for (int r = 0; r < 16; ++r) { const int i = 32 * gI + (r & 3) + 8 * (r >> 2) + 4 * hi; const float qk = acc[r];
            stg[i * 64 + perm32(j)] = f2bf(i >= j ? qk * __expf(gc_s[i] - g0j) : 0.f);
            stg[4096 + (63 - i) * 64 + perm32(63 - j)] = f2bf(i <= j ? qk * __expf(gc_s[64 + i] - g1j) : 0.f); } }
    LDS_BARRIER();
#pragma unroll
    for (int n = 0; n < 2; ++n) { const int c16 = tid + 512 * n; *(u32x4*)(A.B.QK + t0 * SZ_QK + (size_t)c16 * 8) = *(const u32x4*)(stg + c16 * 8); }
    if (!(A.pflags & 512)) {
        int tidv = tid; asm volatile("" : "+v"(tidv));
        const int d = tidv >> 8, c = tidv & 255; const bool isw = c >= 128; const int cc = c & 127;
        const float* src = isw ? Ks : Vs;
        int lz; asm volatile("v_mov_b32 %0, 0" : "=v"(lz));
        const float* AAv = AA + lz + d * (CH * AS);
        float x[CH];
#pragma unroll
        for (int p = 0; p < CH; ++p) { const int i = d == 0 ? p : 63 - p; float f = beta_s[d * 64 + i]; if (isw) f *= eq_s[d * 64 + i]; x[p] = f * src[i * QS + cc]; }
        {
#pragma unroll
            for (int p = 0; p < CH - 1; ++p) { const float xp = x[p]; const float* rowp = AAv + (63 - p) * AS;
#pragma unroll
                for (int m = 0; m <= (62 - p) / 4; ++m) { const f32x4 a4 = *(const f32x4*)(rowp + 4 * m);
#pragma unroll
                    for (int e = 0; e < 4; ++e) { const int col = 4 * m + e; if (col <= 62 - p) x[63 - col] -= a4[e] * xp; } } }
        }
        LDS_BARRIER();
        if (!isw) { bf16_t* dst = A.B.UT + (t0 + d) * SZ_UT + (size_t)((cc >> 4) * 2 * 64 + (cc & 15)) * 8;
#pragma unroll
            for (int s = 0; s < 2; ++s)
#pragma unroll
                for (int qq = 0; qq < 4; ++qq) { const int p0 = 32 * s + 4 * qq; u32x4 w4; w4.x = pk2(x[p0], x[p0 + 1]); w4.y = pk2(x[p0 + 2], x[p0 + 3]); w4.z = pk2(x[p0 + 16], x[p0 + 17]); w4.w = pk2(x[p0 + 18], x[p0 + 19]);
                    *(u32x4*)(dst + (size_t)(s * 64 + qq * 16) * 8) = w4; }
        } else { bf16_t* dst = stg + d * 8192 + perm32(cc);
#pragma unroll
            for (int p = 0; p < CH; ++p) dst[p * 128] = f2bf(x[p]); }
    }
    LDS_BARRIER();
#pragma unroll
    for (int n = 0; n < 4; ++n) { const int c16 = tid + 512 * n; *(u32x4*)(A.B.WP + t0 * SZ_WP + (size_t)c16 * 8) = *(const u32x4*)(stg + c16 * 8); }
}
__device__ __forceinline__ void g1_phase(const G1Args& A, char* lds, int G, int wg, const int tid) {
    for (int t = wg; t < NCHUNK * NH; t += G) g1_task(A, lds, t / NH, t % NH, tid);
}

constexpr int G2_SPLIT = 4, G2_NACT = 8 / G2_SPLIT, G2_NSTEP = CTX_LEN / CH + SEQ / CH, G2_WGS = BATCH * NH * 2 * G2_SPLIT;
constexpr int G2_USL = G2_NACT * 2 * 64 * 16;
constexpr int G2_BUF = 16384 + 16384 + G2_USL, G2_NB = 4, G2_LDS = G2_NB * G2_BUF;
static_assert(G2_SPLIT == 4 && G2_USL == 4096, "G2 staging map below assumes 4 KB of u per step");
__device__ __forceinline__ int g2_task_index(int b, int h, int d, int step) {
    constexpr int NC = CTX_LEN / CH, NL = SEQ / CH; int cix;
    if (step < NC) { const int n = d ? NC - 1 - step : step; cix = M_LAT / CH + b * NC + n; }
    else { const int s2 = step - NC, n = d ? NL - 1 - s2 : s2; cix = b * NL + n; }
    return (cix * NH + h) * 2 + d;
}
__device__ __forceinline__ void g2_chain(const Bufs& B, char* lds, int chain_part, const int tid_in, const int step_lo, const int step_hi, float* Ssave) {
    int tid_ = tid_in; asm volatile("" : "+v"(tid_));
    const int tid = tid_, wid = __builtin_amdgcn_readfirstlane(tid >> 6), lane = tid & 63, q = lane >> 4, vl = lane & 15;
    const int chain = chain_part / G2_SPLIT, part = chain_part % G2_SPLIT;
    const bool active = wid < G2_NACT; const int vt = part * G2_NACT + (active ? wid : 0);
    const int d = chain & 1, h = (chain >> 1) % NH, b = chain / (2 * NH);
    constexpr int NSTEP = CTX_LEN / CH + SEQ / CH;
    const unsigned ldsb = (unsigned)(uintptr_t)lds;
    f32x4 S[8];
    f32x4* sv = (f32x4*)Ssave + ((size_t)chain_part * G2_NACT + (active ? wid : 0)) * 8 * 64 + lane;
#pragma unroll
    for (int kb = 0; kb < 8; ++kb) S[kb] = (step_lo > 0 && active) ? sv[kb * 64] : (f32x4){0.f, 0.f, 0.f, 0.f};
    unsigned offw[2], offk[2], offu;
#pragma unroll
    for (int i = 0; i < 2; ++i) { const int sl = 128 * wid + 64 * i + lane;
        { const int row = sl >> 4, pc = sl & 15, c = pc ^ (row & 15); offw[i] = (unsigned)(row * 256 + c * 16); }
        { const int row = sl >> 3, pc = sl & 7, c = pc ^ ((row >> 1) & 7); offk[i] = (unsigned)(row * 128 + c * 16); } }
    offu = (unsigned)((part * G2_NACT * 2 * 64 + (wid & 3) * 64 + lane) * 16);
#define G2_DMA(ti, slot) do { const char* wp_ = (const char*)(B.WP + (size_t)(ti) * SZ_WP); const char* kp_ = (const char*)(B.KDT + (size_t)(ti) * SZ_KDT); const unsigned base_ = ldsb + (unsigned)(slot) * G2_BUF; \
        _Pragma("unroll") for (int i_ = 0; i_ < 2; ++i_) { \
            __builtin_amdgcn_global_load_lds((const unsigned*)(wp_ + offw[i_]), (ATT_LAS unsigned*)(base_ + (128 * wid + 64 * i_) * 16), 16, 0, 0); \
            __builtin_amdgcn_global_load_lds((const unsigned*)(kp_ + offk[i_]), (ATT_LAS unsigned*)(base_ + 16384 + (128 * wid + 64 * i_) * 16), 16, 0, 0); } \
        if (wid >= 4) __builtin_amdgcn_global_load_lds((const unsigned*)((const char*)(B.UT + (size_t)(ti) * SZ_UT) + offu), (ATT_LAS unsigned*)(base_ + 32768 + ((wid & 3) * 64) * 16), 16, 0, 0); } while (0)
#define G2_TI(step) g2_task_index(b, h, d, (step) < NSTEP ? (step) : NSTEP - 1)
    __syncthreads();
    G2_DMA(G2_TI(step_lo), step_lo & 3); G2_DMA(G2_TI(step_lo + 1), (step_lo + 1) & 3); G2_DMA(G2_TI(step_lo + 2), (step_lo + 2) & 3);
    asm volatile("s_waitcnt vmcnt(0)" ::: "memory");
    __syncthreads();
    for (int step = step_lo; step < step_hi; ++step) {
        const int ti = G2_TI(step), slot = step & 3;
        G2_DMA(G2_TI(step + 3), (step + 3) & 3);
        unsigned gtb; { const float* gp = B.GT + ti; asm volatile("s_load_dword %0, %1, 0x0" : "=s"(gtb) : "s"(gp)); }
        const char* wl = lds + slot * G2_BUF; const char* kl = wl + 16384; const char* ul = kl + 16384;
        if (active) {
            bf16x8 aw[16], ak[16];
#pragma unroll
            for (int rb = 0; rb < 4; ++rb)
#pragma unroll
                for (int s = 0; s < 4; ++s) aw[rb * 4 + s] = *(const bf16x8*)(wl + (16 * rb + vl) * 256 + (((4 * s + q) ^ vl) << 4));
#pragma unroll
            for (int kb = 0; kb < 8; ++kb)
#pragma unroll
                for (int s = 0; s < 2; ++s) ak[kb * 2 + s] = *(const bf16x8*)(kl + (16 * kb + vl) * 128 + (((4 * s + q) ^ ((vl >> 1) & 7)) << 4));
            u32x4 uu[2];
#pragma unroll
            for (int s = 0; s < 2; ++s) uu[s] = *(const u32x4*)(ul + ((wid * 2 + s) * 64 + lane) * 16);
            bf16_t* sit = B.SIT + (size_t)ti * SZ_SIT + (size_t)(vt * 4 * 64 + lane) * 8;
            bf16x8 sf[4];
#pragma unroll
            for (int s = 0; s < 4; ++s) { u32x4 w4; w4.x = pk2(S[2 * s][0], S[2 * s][1]); w4.y = pk2(S[2 * s][2], S[2 * s][3]); w4.z = pk2(S[2 * s + 1][0], S[2 * s + 1][1]); w4.w = pk2(S[2 * s + 1][2], S[2 * s + 1][3]);
                sf[s] = __builtin_bit_cast(bf16x8, w4); *(u32x4*)(sit + (size_t)s * 64 * 8) = w4; }
            __builtin_amdgcn_sched_barrier(0);
            f32x4 vn[4];
#pragma unroll
            for (int rb = 0; rb < 4; ++rb) vn[rb] = (f32x4){0.f, 0.f, 0.f, 0.f};
#pragma unroll
            for (int s = 0; s < 4; ++s)
#pragma unroll
                for (int rb = 0; rb < 4; ++rb) vn[rb] = __builtin_amdgcn_mfma_f32_16x16x32_bf16(aw[rb * 4 + s], sf[s], vn[rb], 0, 0, 0);
#pragma unroll
            for (int s = 0; s < 2; ++s) { const f32x4 a0 = vn[2 * s], a1 = vn[2 * s + 1];
                vn[2 * s][0] = bflo(uu[s].x) - a0[0]; vn[2 * s][1] = bfhi(uu[s].x) - a0[1]; vn[2 * s][2] = bflo(uu[s].y) - a0[2]; vn[2 * s][3] = bfhi(uu[s].y) - a0[3];
                vn[2 * s + 1][0] = bflo(uu[s].z) - a1[0]; vn[2 * s + 1][1] = bfhi(uu[s].z) - a1[1]; vn[2 * s + 1][2] = bflo(uu[s].w) - a1[2]; vn[2 * s + 1][3] = bfhi(uu[s].w) - a1[3]; }
            bf16_t* vnt = B.VNT + (size_t)ti * SZ_VNT + (size_t)(vt * 2 * 64 + lane) * 8;
            bf16x8 vf[2];
#pragma unroll
            for (int s = 0; s < 2; ++s) { u32x4 w4; w4.x = pk2(vn[2 * s][0], vn[2 * s][1]); w4.y = pk2(vn[2 * s][2], vn[2 * s][3]); w4.z = pk2(vn[2 * s + 1][0], vn[2 * s + 1][1]); w4.w = pk2(vn[2 * s + 1][2], vn[2 * s + 1][3]);
                vf[s] = __builtin_bit_cast(bf16x8, w4); *(u32x4*)(vnt + (size_t)s * 64 * 8) = w4; }
            asm volatile("s_waitcnt lgkmcnt(0)" ::: "memory");
            const float gt = __uint_as_float(gtb);
#pragma unroll
            for (int kb = 0; kb < 8; ++kb) S[kb] = S[kb] * gt;
#pragma unroll
            for (int s = 0; s < 2; ++s)
#pragma unroll
                for (int kb = 0; kb < 8; ++kb) S[kb] = __builtin_amdgcn_mfma_f32_16x16x32_bf16(ak[kb * 2 + s], vf[s], S[kb], 0, 0, 0);
            __builtin_amdgcn_sched_barrier(0);
            asm volatile("s_waitcnt vmcnt(26) lgkmcnt(0)\n\ts_barrier" ::: "memory");
        } else if (wid >= 4) {
            asm volatile("s_waitcnt vmcnt(10) lgkmcnt(0)\n\ts_barrier" ::: "memory");
        } else {
            asm volatile("s_waitcnt vmcnt(8) lgkmcnt(0)\n\ts_barrier" ::: "memory");
        }
    }
    if (step_hi < NSTEP && active) {
#pragma unroll
        for (int kb = 0; kb < 8; ++kb) sv[kb * 64] = S[kb]; }
    asm volatile("s_waitcnt vmcnt(0)" ::: "memory");
    __syncthreads();
#undef G2_DMA
#undef G2_TI
}

constexpr int G3_OS = 132, G3_LDS = 64 * G3_OS * 4;
struct G3Args { Bufs B; const bf16_t* P; const float* norm_g; bf16_t* Y; };
__device__ __forceinline__ void g3_task(const G3Args& A, char* lds, int cix, int h, const int tid_in) {
    int tid_ = tid_in; asm volatile("" : "+v"(tid_));
    const int tid = tid_, wid = __builtin_amdgcn_readfirstlane(tid >> 6), lane = tid & 63, q = lane >> 4, vl = lane & 15;
    f32x4 o[2][4];
#pragma unroll
    for (int d = 0; d < 2; ++d) {
        const size_t t = ((size_t)cix * NH + h) * 2 + d;
        const bf16_t* sit = A.B.SIT + t * SZ_SIT + (size_t)(wid * 4 * 64 + lane) * 8;
        const bf16_t* vnt = A.B.VNT + t * SZ_VNT + (size_t)(wid * 2 * 64 + lane) * 8;
        const bf16_t* qd = A.B.QD + t * SZ_QD + (size_t)vl * 128 + 8 * q;
        const bf16_t* qk = A.B.QK + t * SZ_QK + (size_t)vl * 64 + 8 * q;
        bf16x8 sf[4], vf[2];
#pragma unroll
        for (int s = 0; s < 4; ++s) sf[s] = *(const bf16x8*)(sit + (size_t)s * 64 * 8);
#pragma unroll
        for (int s = 0; s < 2; ++s) vf[s] = *(const bf16x8*)(vnt + (size_t)s * 64 * 8);
#pragma unroll
        for (int rb = 0; rb < 4; ++rb) { f32x4 acc = {0.f, 0.f, 0.f, 0.f};
#pragma unroll
            for (int s = 0; s < 4; ++s) acc = __builtin_amdgcn_mfma_f32_16x16x32_bf16(*(const bf16x8*)(qd + (size_t)rb * 16 * 128 + 32 * s), sf[s], acc, 0, 0, 0);
#pragma unroll
            for (int s = 0; s < 2; ++s) acc = __builtin_amdgcn_mfma_f32_16x16x32_bf16(*(const bf16x8*)(qk + (size_t)rb * 16 * 64 + 32 * s), vf[s], acc, 0, 0, 0);
            o[d][rb] = acc; }
    }
    f32x4 ot[4];
#pragma unroll
    for (int rb = 0; rb < 4; ++rb)
#pragma unroll
        for (int r = 0; r < 4; ++r) ot[rb][r] = o[0][rb][r] + lane_xor(o[1][3 - rb][3 - r], 48, lane);
    float* Ot = (float*)lds;
    LDS_BARRIER();
#pragma unroll
    for (int rb = 0; rb < 4; ++rb)
#pragma unroll
        for (int r = 0; r < 4; ++r) Ot[(16 * rb + 4 * q + r) * G3_OS + 16 * wid + vl] = ot[rb][r];
    LDS_BARRIER();
#pragma unroll
    for (int n = 0; n < 2; ++n) { const int item = tid + 512 * n, tok = item >> 4, c8 = (item & 15) * 8;
        const f32x4 o0 = *(const f32x4*)(Ot + tok * G3_OS + c8), o1 = *(const f32x4*)(Ot + tok * G3_OS + c8 + 4);
        float ss = (o0[0] * o0[0] + o0[1] * o0[1]) + (o0[2] * o0[2] + o0[3] * o0[3]) + (o1[0] * o1[0] + o1[1] * o1[1]) + (o1[2] * o1[2] + o1[3] * o1[3]);
#pragma unroll
        for (int of = 1; of < 16; of <<= 1) ss += lane_xor(ss, of, lane);
        const float rstd = __builtin_amdgcn_rsqf(ss * (1.0f / HD) + EPS);
        const f32x4 g0 = *(const f32x4*)(A.norm_g + c8), g1 = *(const f32x4*)(A.norm_g + c8 + 4);
        const size_t row = (size_t)cix * CH + tok; const u32x4 gw = *(const u32x4*)(A.P + row * NP + C_GG + h * HD + c8);
        float y[8];
#pragma unroll
        for (int e = 0; e < 4; ++e) { const float ga = bflo(gw[e]), gb = bfhi(gw[e]); const float oa = e < 2 ? o0[2 * e] : o1[2 * e - 4], ob = e < 2 ? o0[2 * e + 1] : o1[2 * e - 3];
            const float na = e < 2 ? g0[2 * e] : g1[2 * e - 4], nb = e < 2 ? g0[2 * e + 1] : g1[2 * e - 3];
            y[2 * e] = oa * rstd * na * (ga * __builtin_amdgcn_rcpf(1.0f + __expf(-ga))); y[2 * e + 1] = ob * rstd * nb * (gb * __builtin_amdgcn_rcpf(1.0f + __expf(-gb))); }
        *(u32x4*)(A.Y + row * D_MODEL + 2 * GROUP_W + h * HD + c8) = (u32x4){pk2(y[0], y[1]), pk2(y[2], y[3]), pk2(y[4], y[5]), pk2(y[6], y[7])};
    }
}
__device__ __forceinline__ void g3_phase(const G3Args& A, char* lds, int G, int wg, const int tid) {
    for (int t = wg; t < NCHUNK * NH; t += G) g3_task(A, lds, t / NH, t % NH, tid);
}
}

namespace lru {
typedef short bf16x8 __attribute__((ext_vector_type(8)));
typedef float f32x4 __attribute__((ext_vector_type(4)));
typedef unsigned u32x2 __attribute__((ext_vector_type(2)));
typedef unsigned u32x4 __attribute__((ext_vector_type(4)));
constexpr int CH = 64, NCHUNK = M_ALL / CH;
constexpr int US = 129;
constexpr int UBS = 272;
constexpr int L_OFF_U = 0, L_OFF_UB = CH * US * 4, L_LDS = L_OFF_UB + CH * UBS;
constexpr size_t SZ_WBLK = (size_t)LRU_BW * LRU_BW;
struct Bufs { bf16_t* HLOC; bf16_t* ACUM; float* LSUM; float* HIN; };
struct LocalArgs { const bf16_t* P; const float* conv_w; const float* conv_b; const bf16_t* WG;   const float* ba; const float* bx; const float* lam; Bufs B; };

__device__ __forceinline__ unsigned pk2(float lo, float hi) { return (unsigned)f2bf(lo) | ((unsigned)f2bf(hi) << 16); }

__device__ __forceinline__ void local_task(const LocalArgs& A, char* lds, int cix, int nb, const int tid_in) {
    int tid_ = tid_in; asm volatile("" : "+v"(tid_));
    const int tid = tid_, wid = __builtin_amdgcn_readfirstlane(tid >> 6), lane = tid & 63, q = lane >> 4, tl = lane & 15;
    float* Us = (float*)(lds + L_OFF_U); char* Ub = lds + L_OFF_UB;
    const int row0 = cix * CH; const RowInfo r0i = row_info(row0);
    LDS_BARRIER();
    {
        const int grp = tid & 15, t2 = tid >> 4, c0 = grp * 8, ch0 = nb * LRU_BW + c0;
        float wgt[4][8], bia[8];
#pragma unroll
        for (int j = 0; j < 4; ++j) { const f32x4 w0 = *(const f32x4*)(A.conv_w + j * LRU_W + ch0), w1 = *(const f32x4*)(A.conv_w + j * LRU_W + ch0 + 4);
#pragma unroll
            for (int e = 0; e < 4; ++e) { wgt[j][e] = w0[e]; wgt[j][4 + e] = w1[e]; } }
        { const f32x4 b0 = *(const f32x4*)(A.conv_b + ch0), b1 = *(const f32x4*)(A.conv_b + ch0 + 4);
#pragma unroll
          for (int e = 0; e < 4; ++e) { bia[e] = b0[e]; bia[4 + e] = b1[e]; } }
        u32x4 xr[5];
#pragma unroll
        for (int k = 0; k < 5; ++k) { const int tt = r0i.t + 2 * t2 + k - 1;
            xr[k] = (tt >= 0 && tt < r0i.T) ? *(const u32x4*)(A.P + (size_t)(r0i.base + tt) * NP + C_LRU_X + ch0) : (u32x4){0u, 0u, 0u, 0u}; }
#pragma unroll
        for (int i = 0; i < 2; ++i) { float acc[8];
#pragma unroll
            for (int e = 0; e < 8; ++e) acc[e] = bia[e];
#pragma unroll
            for (int j = 0; j < 4; ++j) { const u32x4 xv = xr[i + j];
#pragma unroll
                for (int e = 0; e < 4; ++e) { acc[2 * e] += wgt[j][2 * e] * bflo(xv[e]); acc[2 * e + 1] += wgt[j][2 * e + 1] * bfhi(xv[e]); } }
            const int tok = 2 * t2 + i;
#pragma unroll
            for (int e = 0; e < 8; ++e) Us[tok * US + c0 + e] = acc[e];
            *(u32x4*)(Ub + tok * UBS + c0 * 2) = (u32x4){pk2(acc[0], acc[1]), pk2(acc[2], acc[3]), pk2(acc[4], acc[5]), pk2(acc[6], acc[7])}; }
    }
    LDS_BARRIER();
    f32x4 acc[2][2][4];
#pragma unroll
    for (int d = 0; d < 2; ++d)
#pragma unroll
        for (int wh = 0; wh < 2; ++wh)
#pragma unroll
            for (int tb = 0; tb < 4; ++tb) acc[d][wh][tb] = (f32x4){0.f, 0.f, 0.f, 0.f};
#pragma unroll
    for (int s = 0; s < 4; ++s) {
        bf16x8 bfr[4];
#pragma unroll
        for (int tb = 0; tb < 4; ++tb) bfr[tb] = *(const bf16x8*)(Ub + (16 * tb + tl) * UBS + (32 * s + 8 * q) * 2);
#pragma unroll
        for (int d = 0; d < 2; ++d)
#pragma unroll
            for (int wh = 0; wh < 2; ++wh) { const bf16x8 a = *(const bf16x8*)(A.WG + ((size_t)((d * 2 + wh) * NH + nb)) * SZ_WBLK + (size_t)(16 * wid + tl) * LRU_BW + 32 * s + 8 * q);
#pragma unroll
                for (int tb = 0; tb < 4; ++tb) acc[d][wh][tb] = __builtin_amdgcn_mfma_f32_16x16x32_bf16(a, bfr[tb], acc[d][wh][tb], 0, 0, 0); }
    }
    const int chb = nb * LRU_BW + 16 * wid + 4 * q;
#pragma unroll
    for (int d = 0; d < 2; ++d) {
        float sp[4], bav[4], bxv[4];
#pragma unroll
        for (int r = 0; r < 4; ++r) { sp[r] = -LRU_C * softplusf_(-A.lam[d * LRU_W + chb + r]); bav[r] = A.ba[d * LRU_W + chb + r]; bxv[r] = A.bx[d * LRU_W + chb + r]; }
        float Ac[4], Bc[4];
#pragma unroll
        for (int r = 0; r < 4; ++r) { Ac[r] = 1.f; Bc[r] = 0.f; }
#pragma unroll
        for (int tbi = 0; tbi < 4; ++tbi) { const int tb = d == 0 ? tbi : 3 - tbi; const int tok = 16 * tb + tl;
            float a[4], b[4];
#pragma unroll
            for (int r = 0; r < 4; ++r) { const float rr = __builtin_amdgcn_rcpf(1.0f + __expf(-(acc[d][0][tb][r] + bav[r]))), ii = __builtin_amdgcn_rcpf(1.0f + __expf(-(acc[d][1][tb][r] + bxv[r])));
                const float log_a = sp[r] * rr, x2 = 2.0f * log_a; a[r] = __expf(log_a);
                float em = 1.0f + x2 * (1.0f / 6.0f); em = 1.0f + x2 * 0.2f * em; em = 1.0f + x2 * 0.25f * em; em = 1.0f + x2 * (1.0f / 3.0f) * em; em = 1.0f + x2 * 0.5f * em; em = -x2 * em;
                if (__builtin_expect(x2 < -0.25f, 0)) em = -expm1f(x2);
                b[r] = __builtin_amdgcn_sqrtf(em) * ii * Us[tok * US + 16 * wid + 4 * q + r]; }
#define LRU_SCAN_STEP(CTRL) do { _Pragma("unroll") for (int r = 0; r < 4; ++r) { \
                const float ap = __int_as_float(__builtin_amdgcn_update_dpp(0x3f800000, __float_as_int(a[r]), (CTRL), 0xf, 0xf, false)); \
                const float bp = __int_as_float(__builtin_amdgcn_update_dpp(0, __float_as_int(b[r]), (CTRL), 0xf, 0xf, false)); \
                b[r] = a[r] * bp + b[r]; a[r] = a[r] * ap; } } while (0)
            if (d == 0) { LRU_SCAN_STEP(0x111); LRU_SCAN_STEP(0x112); LRU_SCAN_STEP(0x114); LRU_SCAN_STEP(0x118); }
            else        { LRU_SCAN_STEP(0x101); LRU_SCAN_STEP(0x102); LRU_SCAN_STEP(0x104); LRU_SCAN_STEP(0x108); }
#undef LRU_SCAN_STEP
#pragma unroll
            for (int r = 0; r < 4; ++r) { b[r] = a[r] * Bc[r] + b[r]; a[r] = a[r] * Ac[r]; }
            { const size_t o = ((size_t)d * M_ALL + row0 + tok) * LRU_W + chb;
              *(u32x2*)(A.B.HLOC + o) = (u32x2){pk2(b[0], b[1]), pk2(b[2], b[3])}; *(u32x2*)(A.B.ACUM + o) = (u32x2){pk2(a[0], a[1]), pk2(a[2], a[3])}; }
#pragma unroll
            for (int r = 0; r < 4; ++r) { const int sl = (lane & ~15) | (d == 0 ? 15 : 0); Ac[r] = lane_get(a[r], sl); Bc[r] = lane_get(b[r], sl); }
        }
        if (tl == 0) { float* ls = A.B.LSUM + (((size_t)cix * 2 + d) * 2) * LRU_W + chb;
            *(f32x4*)ls = (f32x4){Ac[0], Ac[1], Ac[2], Ac[3]}; *(f32x4*)(ls + LRU_W) = (f32x4){Bc[0], Bc[1], Bc[2], Bc[3]}; }
    }
}
__device__ __forceinline__ void local_phase(const LocalArgs& A, char* lds, int G, int wg, const int tid) {
    for (int j = wg; j < 2 * NCHUNK * NH; j += G) if (j >= NCHUNK * NH) { const int t = j - NCHUNK * NH; local_task(A, lds, t / NH, t % NH, tid); }
}
__device__ __forceinline__ void carry_phase(const Bufs& B, int gtid, int gthreads) {
    constexpr int NC = CTX_LEN / CH, NL = SEQ / CH;
    for (int i = gtid; i < BATCH * 2 * LRU_W; i += gthreads) { const int ch = i % LRU_W, d = (i / LRU_W) & 1, b = i / (2 * LRU_W);
        float h = 0.f;
        for (int s0 = 0; s0 < NC + NL; s0 += 12) {
            float av[12], bv[12]; int cx[12];
#pragma unroll
            for (int u = 0; u < 12; ++u) { const int step = s0 + u; int cix = 0;
                if (step < NC) { const int n = d ? NC - 1 - step : step; cix = M_LAT / CH + b * NC + n; }
                else if (step < NC + NL) { const int s2 = step - NC, n = d ? NL - 1 - s2 : s2; cix = b * NL + n; }
                cx[u] = cix; const float* ls = B.LSUM + (((size_t)cix * 2 + d) * 2) * LRU_W + ch; av[u] = ls[0]; bv[u] = ls[LRU_W]; }
#pragma unroll
            for (int u = 0; u < 12; ++u) if (s0 + u < NC + NL) { B.HIN[((size_t)cx[u] * 2 + d) * LRU_W + ch] = h; h = av[u] * h + bv[u]; }
        }
    }
}
__device__ __forceinline__ void finish_phase(const Bufs& B, const bf16_t* P, bf16_t* Y, int gtid, int gthreads) {
    for (int it = gtid; it < M_ALL * (LRU_W / 8); it += gthreads) { const int row = it / (LRU_W / 8), c0 = (it % (LRU_W / 8)) * 8, cix = row / CH;
        const u32x4 h0 = *(const u32x4*)(B.HLOC + (size_t)row * LRU_W + c0), a0 = *(const u32x4*)(B.ACUM + (size_t)row * LRU_W + c0);
        const u32x4 h1 = *(const u32x4*)(B.HLOC + ((size_t)M_ALL + row) * LRU_W + c0), a1 = *(const u32x4*)(B.ACUM + ((size_t)M_ALL + row) * LRU_W + c0);
        const u32x4 gt = *(const u32x4*)(P + (size_t)row * NP + C_LRU_G + c0);
        const float* i0 = B.HIN + ((size_t)cix * 2 + 0) * LRU_W + c0; const float* i1 = B.HIN + ((size_t)cix * 2 + 1) * LRU_W + c0;
        const f32x4 i0a = *(const f32x4*)i0, i0b = *(const f32x4*)(i0 + 4), i1a = *(const f32x4*)i1, i1b = *(const f32x4*)(i1 + 4);
        float y[8];
#pragma unroll
        for (int j = 0; j < 4; ++j) { const unsigned hw0 = h0[j], aw0 = a0[j], hw1 = h1[j], aw1 = a1[j], gw = gt[j];
            const float in0l = j < 2 ? i0a[2 * j] : i0b[2 * j - 4], in0h = j < 2 ? i0a[2 * j + 1] : i0b[2 * j - 3], in1l = j < 2 ? i1a[2 * j] : i1b[2 * j - 4], in1h = j < 2 ? i1a[2 * j + 1] : i1b[2 * j - 3];
            y[2 * j] = (bflo(hw0) + bflo(aw0) * in0l + bflo(hw1) + bflo(aw1) * in1l) * geluf_(bflo(gw));
            y[2 * j + 1] = (bfhi(hw0) + bfhi(aw0) * in0h + bfhi(hw1) + bfhi(aw1) * in1h) * geluf_(bfhi(gw)); }
        *(u32x4*)(Y + (size_t)row * D_MODEL + c0) = (u32x4){pk2(y[0], y[1]), pk2(y[2], y[3]), pk2(y[4], y[5]), pk2(y[6], y[7])};
    }
}
}

namespace misc {
typedef float f32x4 __attribute__((ext_vector_type(4)));
typedef unsigned u32x2 __attribute__((ext_vector_type(2)));
typedef unsigned u32x4 __attribute__((ext_vector_type(4)));
__device__ __forceinline__ unsigned pk2(float lo, float hi) { return (unsigned)f2bf(lo) | ((unsigned)f2bf(hi) << 16); }
__device__ __forceinline__ float wave_sum(float v, int lane) {
#pragma unroll
    for (int o = 1; o < 64; o <<= 1) v += lane_xor(v, o, lane);
    return v;
}
__device__ __forceinline__ float sum16(float v, int lane) {
#pragma unroll
    for (int o = 1; o < 16; o <<= 1) v += lane_xor(v, o, lane);
    return v;
}
__device__ __forceinline__ void norm_phase(float* H, const float* g, const float* MODl, int sh_idx, bf16_t* U, int nrows, int gwave, int nwaves, int lane,
                                           const float* PART, int nparts, const float* pgate, const float* xin, const float* cin) {
    static_assert(D_MODEL == 2048, "norm_phase geometry");
    for (int r = gwave; r < nrows; r += nwaves) {
        const int set = r < M_LAT ? r / SEQ : BATCH;
        f32x4* hr = (f32x4*)(H + (size_t)r * D_MODEL) + lane;
        const f32x4* src = xin == nullptr ? hr : (r < M_LAT ? (const f32x4*)(xin + (size_t)r * D_MODEL) + lane : (const f32x4*)(cin + (size_t)(r - M_LAT) * D_MODEL) + lane);
        f32x4 v[8]; float ss = 0.f;
#pragma unroll
        for (int j = 0; j < 8; ++j) v[j] = src[64 * j];
        if (xin != nullptr && r >= M_LAT) {
#pragma unroll
            for (int j = 0; j < 8; ++j) hr[64 * j] = v[j]; }
        if (PART != nullptr && r >= M_LAT) {
            const f32x4* gp = (const f32x4*)pgate + lane;
#pragma unroll
            for (int j = 0; j < 8; ++j) { f32x4 acc = {0.f, 0.f, 0.f, 0.f};
                for (int s = 0; s < nparts; ++s) acc += *((const f32x4*)(PART + ((size_t)s * M_CTX + (r - M_LAT)) * D_MODEL) + lane + 64 * j);
                v[j] += gp[64 * j] * acc; hr[64 * j] = v[j]; }
        }
#pragma unroll
        for (int j = 0; j < 8; ++j) ss += (v[j][0] * v[j][0] + v[j][1] * v[j][1]) + (v[j][2] * v[j][2] + v[j][3] * v[j][3]);
        const float rstd = 1.0f / sqrtf(wave_sum(ss, lane) * (1.0f / D_MODEL) + EPS);
        const f32x4* gp = (const f32x4*)g + lane; const f32x4* shp = (const f32x4*)(MODl + (size_t)set * NMODV + (size_t)sh_idx * D_MODEL) + lane; const f32x4* scp = shp + D_MODEL / 4;
        u32x2* o = (u32x2*)(U + (size_t)r * D_MODEL) + lane;
#pragma unroll
        for (int j = 0; j < 8; ++j) { const f32x4 gg = gp[64 * j], sh = shp[64 * j], sc = scp[64 * j]; f32x4 y;
#pragma unroll
            for (int e = 0; e < 4; ++e) y[e] = v[j][e] * rstd * gg[e] * (1.0f + sc[e]) + sh[e];
            o[64 * j] = (u32x2){pk2(y[0], y[1]), pk2(y[2], y[3])}; }
    }
}
struct RowNormArgs { const bf16_t* P; const float *qa_g, *kva_g, *na_qn_g, *na_kn_g; bf16_t *CQN, *CKVN, *NQ, *NK; };
__device__ __forceinline__ void rownorm_phase(const RowNormArgs& A, int gwave, int nwaves, int lane) {
    static_assert(MLA_Q_LORA == 384 && MLA_KV_LORA == 256 && GROUP_W == 512 && HD == 128, "rownorm geometry");
    for (int r = gwave; r < M_ALL; r += nwaves) { const bf16_t* p = A.P + (size_t)r * NP;
        { float x[6], ss = 0.f;
#pragma unroll
          for (int j = 0; j < 3; ++j) { const unsigned w = *(const unsigned*)(p + C_CQ + 2 * lane + 128 * j); x[2 * j] = bflo(w); x[2 * j + 1] = bfhi(w); ss += x[2 * j] * x[2 * j] + x[2 * j + 1] * x[2 * j + 1]; }
          const float rstd = 1.0f / sqrtf(wave_sum(ss, lane) * (1.0f / MLA_Q_LORA) + EPS);
#pragma unroll
          for (int j = 0; j < 3; ++j) { const int c = 2 * lane + 128 * j; *(unsigned*)(A.CQN + (size_t)r * MLA_Q_LORA + c) = pk2(x[2 * j] * rstd * A.qa_g[c], x[2 * j + 1] * rstd * A.qa_g[c + 1]); } }
        { float x[4], ss = 0.f;
#pragma unroll
          for (int j = 0; j < 2; ++j) { const unsigned w = *(const unsigned*)(p + C_CKV + 2 * lane + 128 * j); x[2 * j] = bflo(w); x[2 * j + 1] = bfhi(w); ss += x[2 * j] * x[2 * j] + x[2 * j + 1] * x[2 * j + 1]; }
          const float rstd = 1.0f / sqrtf(wave_sum(ss, lane) * (1.0f / MLA_KV_LORA) + EPS);
#pragma unroll
          for (int j = 0; j < 2; ++j) { const int c = 2 * lane + 128 * j; *(unsigned*)(A.CKVN + (size_t)r * MLA_KV_LORA + c) = pk2(x[2 * j] * rstd * A.kva_g[c], x[2 * j + 1] * rstd * A.kva_g[c + 1]); } }
#pragma unroll
        for (int which = 0; which < 2; ++which) {
            const int hh = lane >> 4, d0 = (lane & 15) * 8; const u32x4 w = *(const u32x4*)(p + (which == 0 ? C_NQ : C_NK) + hh * HD + d0);
            float x[8]; float ss = 0.f;
#pragma unroll
            for (int j = 0; j < 4; ++j) { x[2 * j] = bflo(w[j]); x[2 * j + 1] = bfhi(w[j]); ss += x[2 * j] * x[2 * j] + x[2 * j + 1] * x[2 * j + 1]; }
            const float rstd = 1.0f / sqrtf(sum16(ss, lane) * (1.0f / HD) + EPS); const float* g = (which == 0 ? A.na_qn_g : A.na_kn_g) + d0;
            *(u32x4*)((which == 0 ? A.NQ : A.NK) + (size_t)r * GROUP_W + hh * HD + d0) =
                (u32x4){pk2(x[0] * rstd * g[0], x[1] * rstd * g[1]), pk2(x[2] * rstd * g[2], x[3] * rstd * g[3]), pk2(x[4] * rstd * g[4], x[5] * rstd * g[5]), pk2(x[6] * rstd * g[6], x[7] * rstd * g[7])};
        }
    }
}
struct MlaQkvArgs { const bf16_t* QR; const bf16_t* KVR; const bf16_t* P; const float *qn_g, *kn_g; bf16_t *QM, *KM, *VM; };
__device__ __forceinline__ void mlaqkv_phase(const MlaQkvArgs& A, int gwave, int nwaves, int lane) {
    static_assert(MLA_QK == 192 && MLA_NOPE == 128 && MLA_ROPE == 64 && NH == 4 && GRID_W == 64, "mla qkv geometry");
    const int hh = lane >> 4, g = lane & 15;
    const int f0 = (2 * g) & 15; const float inv0 = powf(10000.0f, -(float)f0 / 16.0f), inv1 = powf(10000.0f, -(float)(f0 + 1) / 16.0f);
    for (int r = gwave; r < M_ALL; r += nwaves) {
        const bool lat = r < M_LAT; const int t = lat ? r % SEQ : 0; const float pos = g < 8 ? (float)(t / GRID_W) : (float)(t % GRID_W);
        float c0 = 1.f, s0 = 0.f, c1 = 1.f, s1 = 0.f;
        if (lat) { sincosf(pos * inv0, &s0, &c0); sincosf(pos * inv1, &s1, &c1); }
#pragma unroll
        for (int which = 0; which < 2; ++which) {
            const bf16_t* nsrc = which == 0 ? A.QR + (size_t)r * NQ_MLA + hh * MLA_QK : A.KVR + (size_t)r * NKV_MLA + hh * (MLA_NOPE + MLA_V);
            const bf16_t* rsrc = which == 0 ? nsrc + MLA_NOPE : A.P + (size_t)r * NP + C_KR;
            const u32x4 nw = *(const u32x4*)(nsrc + 8 * g); const unsigned ra = *(const unsigned*)(rsrc + 2 * g), rb = *(const unsigned*)(rsrc + 32 + 2 * g);
            float x[8], a0 = bflo(ra), a1 = bfhi(ra), b0 = bflo(rb), b1 = bfhi(rb);
            float ss = a0 * a0 + a1 * a1 + b0 * b0 + b1 * b1;
#pragma unroll
            for (int j = 0; j < 4; ++j) { x[2 * j] = bflo(nw[j]); x[2 * j + 1] = bfhi(nw[j]); ss += x[2 * j] * x[2 * j] + x[2 * j + 1] * x[2 * j + 1]; }
            const float rstd = __builtin_amdgcn_rsqf(sum16(ss, lane) * (1.0f / MLA_QK) + EPS); const float* gn = which == 0 ? A.qn_g : A.kn_g;
            const f32x4 g0 = *(const f32x4*)(gn + 8 * g), g1 = *(const f32x4*)(gn + 8 * g + 4);
#pragma unroll
            for (int j = 0; j < 4; ++j) { x[j] *= rstd * g0[j]; x[4 + j] *= rstd * g1[j]; }
            a0 *= rstd * gn[MLA_NOPE + 2 * g]; a1 *= rstd * gn[MLA_NOPE + 2 * g + 1]; b0 *= rstd * gn[MLA_NOPE + 32 + 2 * g]; b1 *= rstd * gn[MLA_NOPE + 32 + 2 * g + 1];
            const float ya0 = a0 * c0 - b0 * s0, yb0 = a0 * s0 + b0 * c0, ya1 = a1 * c1 - b1 * s1, yb1 = a1 * s1 + b1 * c1;
            bf16_t* O = (which == 0 ? A.QM : A.KM) + (size_t)r * NQ_MLA + hh * MLA_QK;
            *(u32x4*)(O + 8 * g) = (u32x4){pk2(x[0], x[1]), pk2(x[2], x[3]), pk2(x[4], x[5]), pk2(x[6], x[7])};
            *(unsigned*)(O + MLA_NOPE + 2 * g) = pk2(ya0, ya1); *(unsigned*)(O + MLA_NOPE + 32 + 2 * g) = pk2(yb0, yb1);
        }
        *(u32x4*)(A.VM + (size_t)r * (NH * MLA_V) + hh * MLA_V + 8 * g) = *(const u32x4*)(A.KVR + (size_t)r * NKV_MLA + hh * (MLA_NOPE + MLA_V) + MLA_NOPE + 8 * g);
    }
}
constexpr int ACT_RUN = 32;
__device__ __forceinline__ void act_phase(const bf16_t* UP, const float* cw, const float* cb, bf16_t* ACT, int nrows, int gtid, int gthreads) {
    constexpr int NC8 = D_FF / 8; static_assert(SEQ % ACT_RUN == 0 && CTX_LEN % ACT_RUN == 0, "row runs stay inside one sequence");
    const int nruns = nrows / ACT_RUN;
    for (long it = gtid; it < (long)nruns * NC8; it += gthreads) { const int run = (int)(it / NC8), j0 = (int)(it % NC8) * 8, r0 = run * ACT_RUN; const RowInfo ri = row_info(r0);
        float wa[3][8], wg[3][8], ba[8], bg[8];
#pragma unroll
        for (int k = 0; k < 3; ++k) { const float* p = cw + (size_t)k * 2 * D_FF + j0; const f32x4 a0 = *(const f32x4*)p, a1 = *(const f32x4*)(p + 4), g0 = *(const f32x4*)(p + D_FF), g1 = *(const f32x4*)(p + D_FF + 4);
#pragma unroll
            for (int e = 0; e < 4; ++e) { wa[k][e] = a0[e]; wa[k][4 + e] = a1[e]; wg[k][e] = g0[e]; wg[k][4 + e] = g1[e]; } }
        { const f32x4 a0 = *(const f32x4*)(cb + j0), a1 = *(const f32x4*)(cb + j0 + 4), g0 = *(const f32x4*)(cb + D_FF + j0), g1 = *(const f32x4*)(cb + D_FF + j0 + 4);
#pragma unroll
          for (int e = 0; e < 4; ++e) { ba[e] = a0[e]; ba[4 + e] = a1[e]; bg[e] = g0[e]; bg[4 + e] = g1[e]; } }
        const u32x4 zero = {0u, 0u, 0u, 0u};
        const bf16_t* ub = UP + (size_t)ri.base * (2 * D_FF) + j0;
        u32x4 am, ac, gm, gc;
        { const int t = ri.t; am = t > 0 ? *(const u32x4*)(ub + (size_t)(t - 1) * (2 * D_FF)) : zero; gm = t > 0 ? *(const u32x4*)(ub + (size_t)(t - 1) * (2 * D_FF) + D_FF) : zero;
          ac = *(const u32x4*)(ub + (size_t)t * (2 * D_FF)); gc = *(const u32x4*)(ub + (size_t)t * (2 * D_FF) + D_FF); }
#pragma unroll 4
        for (int i = 0; i < ACT_RUN; ++i) { const int t = ri.t + i;
            const u32x4 ap = t + 1 < ri.T ? *(const u32x4*)(ub + (size_t)(t + 1) * (2 * D_FF)) : zero, gp = t + 1 < ri.T ? *(const u32x4*)(ub + (size_t)(t + 1) * (2 * D_FF) + D_FF) : zero;
            float y[8];
#pragma unroll
            for (int e = 0; e < 4; ++e) {
                const float a0 = ba[2 * e] + wa[0][2 * e] * bflo(am[e]) + wa[1][2 * e] * bflo(ac[e]) + wa[2][2 * e] * bflo(ap[e]);
                const float a1 = ba[2 * e + 1] + wa[0][2 * e + 1] * bfhi(am[e]) + wa[1][2 * e + 1] * bfhi(ac[e]) + wa[2][2 * e + 1] * bfhi(ap[e]);
                const float g0 = bg[2 * e] + wg[0][2 * e] * bflo(gm[e]) + wg[1][2 * e] * bflo(gc[e]) + wg[2][2 * e] * bflo(gp[e]);
                const float g1 = bg[2 * e + 1] + wg[0][2 * e + 1] * bfhi(gm[e]) + wg[1][2 * e + 1] * bfhi(gc[e]) + wg[2][2 * e + 1] * bfhi(gp[e]);
                y[2 * e] = a0 * (g0 / (1.0f + __expf(-g0))); y[2 * e + 1] = a1 * (g1 / (1.0f + __expf(-g1))); }
            *(u32x4*)(ACT + (size_t)(r0 + i) * D_FF + j0) = (u32x4){pk2(y[0], y[1]), pk2(y[2], y[3]), pk2(y[4], y[5]), pk2(y[6], y[7])};
            am = ac; ac = ap; gm = gc; gc = gp; }
    }
}
__device__ __forceinline__ void act_fix_phase(const bf16_t* HALO, const float* cw, const float* cb, bf16_t* ACT, int nrows, int gtid, int gthreads) {
    constexpr int NC8 = D_FF / 8; const int nblk = nrows / 64;
    for (long it = gtid; it < (long)nblk * 2 * NC8; it += gthreads) { const int j0 = (int)(it % NC8) * 8, be = (int)(it / NC8), blk = be >> 1, edge = be & 1; const int row = blk * 64 + (edge ? 63 : 0);
        const RowInfo ri = row_info(row);
        const bf16_t* hb = HALO + (size_t)blk * 4 * (2 * D_FF) + j0;
        const bool has_prev = ri.t > 0, has_next = ri.t + 1 < ri.T; const u32x4 zero = {0u, 0u, 0u, 0u};
        const bf16_t* pc = hb + (size_t)(edge ? 3 : 0) * (2 * D_FF);
        const bf16_t* pp_ = edge ? hb + (size_t)2 * (2 * D_FF) : hb - (size_t)4 * (2 * D_FF) + (size_t)3 * (2 * D_FF);
        const bf16_t* pn = edge ? hb + (size_t)4 * (2 * D_FF) : hb + (size_t)1 * (2 * D_FF);
        const u32x4 ac = *(const u32x4*)pc, gc = *(const u32x4*)(pc + D_FF);
        const u32x4 am = has_prev ? *(const u32x4*)pp_ : zero, gm = has_prev ? *(const u32x4*)(pp_ + D_FF) : zero;
        const u32x4 ap = has_next ? *(const u32x4*)pn : zero, gp = has_next ? *(const u32x4*)(pn + D_FF) : zero;
        float y[8];
#pragma unroll
        for (int e = 0; e < 4; ++e) {
#pragma unroll
            for (int hh = 0; hh < 2; ++hh) { const int c = j0 + 2 * e + hh;
                const float xam = hh ? bfhi(am[e]) : bflo(am[e]), xac = hh ? bfhi(ac[e]) : bflo(ac[e]), xap = hh ? bfhi(ap[e]) : bflo(ap[e]);
                const float xgm = hh ? bfhi(gm[e]) : bflo(gm[e]), xgc = hh ? bfhi(gc[e]) : bflo(gc[e]), xgp = hh ? bfhi(gp[e]) : bflo(gp[e]);
                const float a = cb[c] + cw[c] * xam + cw[2 * D_FF + c] * xac + cw[4 * D_FF + c] * xap;
                const float g = cb[D_FF + c] + cw[D_FF + c] * xgm + cw[2 * D_FF + D_FF + c] * xgc + cw[4 * D_FF + D_FF + c] * xgp;
                y[2 * e + hh] = a * (g * __builtin_amdgcn_rcpf(1.0f + __expf(-g))); } }
        *(u32x4*)(ACT + (size_t)row * D_FF + j0) = (u32x4){pk2(y[0], y[1]), pk2(y[2], y[3]), pk2(y[4], y[5]), pk2(y[6], y[7])};
    }
}
__device__ __forceinline__ void transpose_item(const float* W, int K, int N, int Npad, bf16_t* WT, float* scr, int item, int lane, int pairF = 0) {
    const int nblk = Npad / 32, kb = item / nblk, nb = item % nblk, k0 = 64 * kb, n0 = 32 * nb; const int n = n0 + (lane & 31); const bool ok = n < N;
#pragma unroll 8
    for (int i = 0; i < 32; ++i) { const int kk = 2 * i + (lane >> 5); scr[kk * 33 + (lane & 31)] = ok ? W[(size_t)(k0 + kk) * N + n] : 0.f; }
    asm volatile("s_waitcnt lgkmcnt(0)" ::: "memory");
    const int c = lane & 7;
#pragma unroll
    for (int j = 0; j < 4; ++j) { const int nn = (lane >> 3) + 8 * j; const float* s = scr + (8 * c) * 33 + nn;
        u32x4 o; o.x = pk2(s[0 * 33], s[1 * 33]); o.y = pk2(s[2 * 33], s[3 * 33]); o.z = pk2(s[4 * 33], s[5 * 33]); o.w = pk2(s[6 * 33], s[7 * 33]);
        const int nsrc = n0 + nn; const int nd = pairF == 0 ? nsrc : (nsrc < pairF ? (nsrc >> 7) * 256 + (nsrc & 127) : ((nsrc - pairF) >> 7) * 256 + 128 + ((nsrc - pairF) & 127));
        *(u32x4*)(WT + (size_t)nd * K + k0 + 8 * c) = o; }
    asm volatile("s_waitcnt lgkmcnt(0)" ::: "memory");
}
}

__device__ __forceinline__ gdn::Bufs gdn_bufs(const WS& w, int l) { gdn::Bufs B; B.UT = w.gUT; B.WP = w.gWP; B.KDT = w.gKDT; B.QD = w.gQD; B.QK = w.gQK; B.SIT = w.gSIT; B.VNT = w.gVNT; B.GT = w.gGT + (size_t)l * gdn::NTASK; return B; }
__device__ __forceinline__ lru::Bufs lru_bufs(const WS& w) { lru::Bufs B; B.HLOC = w.lHLOC; B.ACUM = w.lACUM; B.LSUM = w.lLSUM; B.HIN = w.lHIN; return B; }

#define LAS __attribute__((address_space(3)))
#define XB_TMO      128
#define XB_XCNT(j)  (256  + 64 * (j))
#define XB_XSUB(j)  (1280 + 64 * (j))
#define XB_XGEN(j)  (2304 + 64 * (j))
#define XB_TOP      3328
#define XB_TOPGEN   3392
#define XCD_BAR_WORDS 3456
#define XB_SPIN_CAP (1u << 18)
__device__ __forceinline__ unsigned xb_ld(unsigned* p)              { return __hip_atomic_load(p, __ATOMIC_RELAXED, __HIP_MEMORY_SCOPE_AGENT); }
__device__ __forceinline__ unsigned xb_add(unsigned* p, unsigned v) { return __hip_atomic_fetch_add(p, v, __ATOMIC_RELAXED, __HIP_MEMORY_SCOPE_AGENT); }
__device__ __forceinline__ unsigned xb_xcc_id() { return (unsigned)__builtin_amdgcn_s_getreg((3 << 11) | 20) & 0xFu; }
#define XB_SPIN(cond, bar) do { unsigned _sp = 0; while (cond) { __builtin_amdgcn_s_sleep(1); \
    if ((++_sp & 255u) == 0u) { if (xb_ld(&(bar)[XB_TMO])) break; if (_sp > XB_SPIN_CAP) { atomicAdd(&(bar)[XB_TMO], 1u); break; } } } } while (0)
struct XcdBarrier { unsigned* bar; unsigned x; volatile LAS unsigned* st; };
__device__ __forceinline__ XcdBarrier xcd_barrier_post(unsigned* bar, volatile LAS unsigned* st, const bool leader) {
    XcdBarrier b; b.bar = bar; b.x = xb_xcc_id(); b.st = st;
    if (leader) (void)xb_add(&bar[XB_XCNT(b.x)], 1u);
    return b;
}
__device__ __forceinline__ void xcd_barrier_complete(unsigned* bar, unsigned x, unsigned& nloc, unsigned& nx) {
    const unsigned G = gridDim.x * gridDim.y * gridDim.z;
    unsigned sum, cnt, mine, sp = 0u;
    for (;;) {
        sum = 0u; cnt = 0u; mine = 0u;
#pragma unroll
        for (unsigned j = 0; j < 16; ++j) { const unsigned c = xb_ld(&bar[XB_XCNT(j)]); sum += c; cnt += (c > 0u) ? 1u : 0u; mine = (j == x) ? c : mine; }
        if (sum == G) break;
        __builtin_amdgcn_s_sleep(1);
        if ((++sp & 255u) == 0u) { if (xb_ld(&bar[XB_TMO])) break; if (sp > XB_SPIN_CAP) { atomicAdd(&bar[XB_TMO], 1u); break; } }
    }
    nloc = mine > 0u ? mine : 1u; nx = cnt > 0u ? cnt : 1u;
}
__device__ __forceinline__ void xcd_barrier(const XcdBarrier& b, const bool leader) {
    asm volatile("s_waitcnt vmcnt(0)" ::: "memory");
    __syncthreads();
    if (leader) {
        unsigned* bar = b.bar;
        __builtin_amdgcn_s_waitcnt(0);
        unsigned nloc = b.st[0], nx = b.st[1];
        if (nloc == 0u) { xcd_barrier_complete(bar, b.x, nloc, nx); b.st[0] = nloc; b.st[1] = nx; }
        const unsigned old = xb_add(&bar[XB_XSUB(b.x)], 1u);
        const unsigned gen = old / nloc;
        if (old + 1u == (gen + 1u) * nloc) {
            __builtin_amdgcn_fence(__ATOMIC_RELEASE, "agent");
            asm volatile("s_waitcnt vmcnt(0)" ::: "memory");
            const unsigned og = xb_add(&bar[XB_TOP], 1u);
            const unsigned tg = og / nx;
            if (og + 1u == (tg + 1u) * nx) xb_add(&bar[XB_TOPGEN], 1u);
            else XB_SPIN(xb_ld(&bar[XB_TOPGEN]) == tg, bar);
            __builtin_amdgcn_fence(__ATOMIC_ACQUIRE, "agent");
            xb_add(&bar[XB_XGEN(b.x)], 1u);
            asm volatile("s_waitcnt vmcnt(0)" ::: "memory");
        } else {
            XB_SPIN(xb_ld(&bar[XB_XGEN(b.x)]) == gen, bar);
            __builtin_amdgcn_fence(__ATOMIC_ACQUIRE, "agent");
            asm volatile("s_waitcnt vmcnt(0)" ::: "memory");
        }
    }
    __syncthreads();
}

constexpr int NWAVES = 8, NTHR = 512;
constexpr int LDS_MISC = 147456, LDS_BYTES = 148480;
static_assert(sizeof(Inputs) == 34 * 8, "Inputs mirrors Params::in");
static_assert(gdn::G1_LDS <= LDS_MISC && pg8::STAGE_BYTES <= LDS_MISC && att::Cfg<MLA_QK>::LDS_BYTES <= LDS_MISC && gdn::G2_LDS <= LDS_MISC, "LDS map");
constexpr int CW_BAR = 4096;
constexpr int G2_CUT1 = 52, G2_CUT2 = 52;
constexpr int SK_OUT = 4, SK_DOWN = 5;
constexpr int PH_PRO = 0, PH_PER_LAYER = 12, NPH = 1 + PH_PER_LAYER * DEPTH;
struct Params { const float* in[34]; float* out; unsigned char* ws; int ph_lo, ph_hi, li, pad; };

struct SplitOrder {
    int nN, nM, S, G, c;
    __device__ __forceinline__ void init(int M, int N, int S_, int G_, int c_) { nM = M / pg8::BM; nN = N / pg8::BM; S = S_; G = G_; c = c_; }
    __device__ __forceinline__ bool next(int i, pg8::Unit& u) const { const int g = c + i * G; if (g >= nM * nN * S) return false; u.ks = g / (nM * nN); const int loc = g % (nM * nN); u.pm = loc / nN; u.pn = loc % nN; return true; }
    __device__ __forceinline__ void a_ready(const pg8::Unit&) const {}
    __device__ __forceinline__ void done(const pg8::Unit&) const {}
};
struct SpanOrder {
    int nN, lo, hi, G, g0;
    __device__ __forceinline__ void init(int N, int lo_, int hi_, int G_, int c) { nN = N / pg8::BM; lo = lo_; hi = hi_; G = G_; int i0 = 0; if (c < lo_) i0 = (lo_ - c + G_ - 1) / G_; g0 = c + i0 * G_; }
    __device__ __forceinline__ bool next(int i, pg8::Unit& u) const { const int g = g0 + i * G; if (g >= hi) return false; const int loc = g - lo; u.pm = loc / nN; u.pn = loc % nN; u.ks = 0; return true; }
    __device__ __forceinline__ void a_ready(const pg8::Unit&) const {}
    __device__ __forceinline__ void done(const pg8::Unit&) const {}
};

#define AS4 __attribute__((address_space(4)))
#define PHASE_WS const AS4 Params* pp = (const AS4 Params*)__builtin_amdgcn_kernarg_segment_ptr(); asm volatile("" : "+s"(pp)); const AS4 Inputs* I = (const AS4 Inputs*)pp; (void)I; unsigned char* wsb_ = pp->ws; const WS w = ws_carve(wsb_)
#define PHASE_IDS int tid = C_wave0 * 64 + (int)__builtin_amdgcn_mbcnt_hi(~0u, __builtin_amdgcn_mbcnt_lo(~0u, 0u)); asm volatile("" : "+v"(tid)); const int lane = tid & 63, wave = __builtin_amdgcn_readfirstlane(tid >> 6), gwave = wg * NWAVES + wave, gtid = wg * NTHR + tid; (void)lane; (void)gwave; (void)gtid
#ifndef DBG_MASK
#define DBG_MASK 0xFFFFFF
#endif
#define IN(k) (lo <= (k) && (k) < hi)
#define ON(j) (((DBG_MASK) >> (j)) & 1)
#define SEAM(k) do { if (IN(k) && IN((k) + 1)) xcd_barrier(bar, C_wave0 == 0 && __builtin_amdgcn_mbcnt_hi(~0u, __builtin_amdgcn_mbcnt_lo(~0u, 0u)) == 0u); } while (0)

struct LayerCtx { int lo, hi, G, wg, nwaves, gthreads, wave0; XcdBarrier bar; char* lds; unsigned char* lds_raw; };
template <int l> __device__ __forceinline__ void layer_body(const LayerCtx& C) {
    const int lo = C.lo, hi = C.hi, G = C.G, wg = C.wg, nwaves = C.nwaves, gthreads = C.gthreads, C_wave0 = C.wave0; const XcdBarrier& bar = C.bar; char* lds = C.lds; unsigned char* lds_raw = C.lds_raw;
    (void)G; (void)nwaves; (void)gthreads;
        const int pb = 1 + PH_PER_LAYER * l;
        const bool want_ctx = l < DEPTH - 1; const int Mo = want_ctx ? M_ALL : M_LAT;
        if (ON(0) && IN(pb + 0)) { PHASE_WS; PHASE_IDS; const float* MODl = w.MOD + (size_t)l * (BATCH + 1) * NMODV; (void)MODl; misc::norm_phase(w.H, I->norm_mix_g + (size_t)l * D_MODEL, MODl, 0, w.U, M_ALL, gwave, nwaves, lane, l > 0 ? w.PART : nullptr, SK_DOWN, MODl - (size_t)(BATCH + 1) * NMODV + (size_t)BATCH * NMODV + 5 * D_MODEL, l == 0 ? I->x : nullptr, l == 0 ? I->ctx : nullptr); }
        SEAM(pb + 0);
        if (ON(1) && IN(pb + 1)) { PHASE_WS; PHASE_IDS; const float* MODl = w.MOD + (size_t)l * (BATCH + 1) * NMODV; (void)MODl; pg8::Gemm g{w.U, w.WIN + l * SZ_WIN, M_ALL, NP, D_MODEL, D_MODEL}; pg8::StaticOrder S; S.init(M_ALL, NP, G, wg);
            pg8::EpiBf16<0> E{w.P, NP, nullptr, 0, 0, 1.0f};
            pg8::gemm_phase<pg8::EpiBf16<0>, pg8::StaticOrder, true, true>((PG8_LAS unsigned char*)lds_raw, g, S, E, tid); }
        SEAM(pb + 1);
        if (ON(2) && IN(pb + 2)) { PHASE_WS; PHASE_IDS; const float* MODl = w.MOD + (size_t)l * (BATCH + 1) * NMODV; (void)MODl;
            const int pflags = pp->pad;
            if (!(pflags & 16)) { gdn::G1Args A; A.P = w.P; A.conv_w = I->gdn_conv_w + (size_t)l * 4 * 3 * GROUP_W; A.a_log = I->gdn_a_log + (size_t)l * 2 * NH; A.dt_bias = I->gdn_dt_bias + (size_t)l * 2 * NH; A.B = gdn_bufs(w, l); A.pflags = pflags;
              gdn::g1_phase(A, lds, G, wg, tid); }
            if (!(pflags & 32)) { lru::LocalArgs A; A.P = w.P; A.conv_w = I->lru_conv_w + (size_t)l * 4 * LRU_W; A.conv_b = I->lru_conv_b + (size_t)l * LRU_W; A.WG = w.WLRU + (size_t)l * 16 * lru::SZ_WBLK;
              A.ba = I->lru_ba + (size_t)l * 2 * LRU_W; A.bx = I->lru_bx + (size_t)l * 2 * LRU_W; A.lam = I->lru_lam + (size_t)l * 2 * LRU_W; A.B = lru_bufs(w);
              lru::local_phase(A, lds, G, wg, tid); }
            if (!(pflags & 64)) { misc::RowNormArgs A; A.P = w.P; A.qa_g = I->mla_qa_g + (size_t)l * MLA_Q_LORA; A.kva_g = I->mla_kva_g + (size_t)l * MLA_KV_LORA; A.na_qn_g = I->na_qn_g + (size_t)l * HD; A.na_kn_g = I->na_kn_g + (size_t)l * HD;
              A.CQN = w.CQN; A.CKVN = w.CKVN; A.NQ = w.NQ; A.NK = w.NK; misc::rownorm_phase(A, gwave, nwaves, lane); }
        }
        SEAM(pb + 2);
        if (ON(3) && IN(pb + 3)) { PHASE_WS; PHASE_IDS; const float* MODl = w.MOD + (size_t)l * (BATCH + 1) * NMODV; (void)MODl;
            if (wg < gdn::G2_WGS) gdn::g2_chain(gdn_bufs(w, l), lds, wg, tid, 0, G2_CUT1, w.gSS);
            else {
            constexpr int UQ = (M_ALL / 256) * (NQ_MLA / 256), UKV = (M_ALL / 256) * (NKV_MLA / 256); const int G2n = G - gdn::G2_WGS, c2 = wg - gdn::G2_WGS;
            { pg8::Gemm g{w.CQN, w.WUQ + l * SZ_WUQ, M_ALL, NQ_MLA, MLA_Q_LORA, MLA_Q_LORA}; SpanOrder S; S.init(NQ_MLA, 0, UQ, G2n, c2); pg8::EpiBf16<0> E{w.QR, NQ_MLA, nullptr, 0, 0, 1.0f};
              pg8::gemm_phase<pg8::EpiBf16<0>, SpanOrder, true, true>((PG8_LAS unsigned char*)lds_raw, g, S, E, tid); }
            { pg8::Gemm g{w.CKVN, w.WUKV + l * SZ_WUKV, M_ALL, NKV_MLA, MLA_KV_LORA, MLA_KV_LORA}; SpanOrder S; S.init(NKV_MLA, UQ, UQ + UKV, G2n, c2); pg8::EpiBf16<0> E{w.KVR, NKV_MLA, nullptr, 0, 0, 1.0f};
              pg8::gemm_phase<pg8::EpiBf16<0>, SpanOrder, true, true>((PG8_LAS unsigned char*)lds_raw, g, S, E, tid); }
            }
        }
        SEAM(pb + 3);
        if (ON(4) && IN(pb + 4)) { PHASE_WS; PHASE_IDS; const float* MODl = w.MOD + (size_t)l * (BATCH + 1) * NMODV; (void)MODl;
            { misc::MlaQkvArgs A; A.QR = w.QR; A.KVR = w.KVR; A.P = w.P; A.qn_g = I->mla_qn_g + (size_t)l * MLA_QK; A.kn_g = I->mla_kn_g + (size_t)l * MLA_QK; A.QM = w.QM; A.KM = w.KM; A.VM = w.VM;
              misc::mlaqkv_phase(A, gwave, nwaves, lane); }
            lru::carry_phase(lru_bufs(w), gtid, gthreads);
        }
        SEAM(pb + 4);
        if (ON(5) && IN(pb + 5)) { PHASE_WS; PHASE_IDS; const float* MODl = w.MOD + (size_t)l * (BATCH + 1) * NMODV; (void)MODl;
            const int pflags = pp->pad;
            if (wg < gdn::G2_WGS && !(pflags & 1)) gdn::g2_chain(gdn_bufs(w, l), lds, wg, tid, G2_CUT2, gdn::G2_NSTEP, w.gSS);
            AttnArgs A; A.QM = w.QM; A.KM = w.KM; A.VM = w.VM; A.NQ = w.NQ; A.NK = w.NK; A.P = w.P; A.Y = w.Y; A.rpb = I->na_rpb + (size_t)l * NH * (2 * NA_KH - 1) * (2 * NA_KW - 1); A.want_ctx = want_ctx ? 1 : 0; A.pad = pflags;
            attention_phase(A, lds, G, wg, tid, gdn::G2_WGS);
        }
        SEAM(pb + 5);
        if (ON(6) && IN(pb + 6)) { PHASE_WS; PHASE_IDS; const float* MODl = w.MOD + (size_t)l * (BATCH + 1) * NMODV; (void)MODl;
            const int pflags = pp->pad;
            if (!(pflags & 128)) { gdn::G3Args A; A.B = gdn_bufs(w, l); A.P = w.P; A.norm_g = I->gdn_norm_g + (size_t)l * HD; A.Y = w.Y; gdn::g3_phase(A, lds, G, wg, tid); }
            if (!(pflags & 256)) lru::finish_phase(lru_bufs(w), w.P, w.Y, gtid, gthreads);
        }
        SEAM(pb + 6);
        if (ON(7) && IN(pb + 7)) { PHASE_WS; PHASE_IDS; const float* MODl = w.MOD + (size_t)l * (BATCH + 1) * NMODV; (void)MODl;
            { pg8::Gemm g{w.Y, w.WOUT + l * SZ_WOUT, M_LAT, D_MODEL, D_MODEL, D_MODEL}; pg8::StaticOrder S; S.init(M_LAT, D_MODEL, G, wg);
              pg8::EpiGateRes E{l == 0 ? I->x : w.H, w.H, D_MODEL, MODl + 2 * D_MODEL, NMODV, SEQ, BATCH, M_LAT};
              pg8::gemm_phase<pg8::EpiGateRes, pg8::StaticOrder, true, true>((PG8_LAS unsigned char*)lds_raw, g, S, E, tid); }
            if (want_ctx) { constexpr int SK = SK_OUT;
              pg8::Gemm g{w.Y + (size_t)M_LAT * D_MODEL, w.WOUT + l * SZ_WOUT, M_CTX, D_MODEL, D_MODEL / SK, D_MODEL}; SplitOrder S; S.init(M_CTX, D_MODEL, SK, G, (wg + G / 2) % G);
              pg8::EpiPart E{w.PART, D_MODEL, (size_t)M_CTX * D_MODEL};
              pg8::gemm_phase<pg8::EpiPart, SplitOrder, true, true>((PG8_LAS unsigned char*)lds_raw, g, S, E, tid); } }
        SEAM(pb + 7);
        if (ON(8) && IN(pb + 8)) { PHASE_WS; PHASE_IDS; const float* MODl = w.MOD + (size_t)l * (BATCH + 1) * NMODV; (void)MODl; misc::norm_phase(w.H, I->norm_ffn_g + (size_t)l * D_MODEL, MODl, 3, w.U, Mo, gwave, nwaves, lane, want_ctx ? w.PART : nullptr, SK_OUT, MODl + (size_t)BATCH * NMODV + 2 * D_MODEL, nullptr, nullptr); }
        SEAM(pb + 8);
        if (ON(9) && IN(pb + 9)) { PHASE_WS; PHASE_IDS; const float* MODl = w.MOD + (size_t)l * (BATCH + 1) * NMODV; (void)MODl; pg8::Gemm g{w.U, w.WUP + l * SZ_WUP, Mo, 2 * D_FF, D_MODEL, D_MODEL}; pg8::StaticOrder S; S.init(Mo, 2 * D_FF, G, wg);
            pg8::EpiConvAct E{w.ACT, w.HALO, I->ffn_conv_w + (size_t)l * 3 * 2 * D_FF, I->ffn_conv_b + (size_t)l * 2 * D_FF, D_FF};
            pg8::gemm_phase<pg8::EpiConvAct, pg8::StaticOrder, false, true>((PG8_LAS unsigned char*)lds_raw, g, S, E, tid); }
        SEAM(pb + 9);
        if (ON(10) && IN(pb + 10)) { PHASE_WS; PHASE_IDS; const float* MODl = w.MOD + (size_t)l * (BATCH + 1) * NMODV; (void)MODl; misc::act_fix_phase(w.HALO, I->ffn_conv_w + (size_t)l * 3 * 2 * D_FF, I->ffn_conv_b + (size_t)l * 2 * D_FF, w.ACT, Mo, gtid, gthreads); }
        SEAM(pb + 10);
        if (ON(11) && IN(pb + 11)) { PHASE_WS; PHASE_IDS; const float* MODl = w.MOD + (size_t)l * (BATCH + 1) * NMODV; (void)MODl;
            { pg8::Gemm g{w.ACT, w.WDOWN + l * SZ_WDOWN, M_LAT, D_MODEL, D_FF, D_FF}; pg8::StaticOrder S; S.init(M_LAT, D_MODEL, G, wg);
              pg8::EpiGateRes E{w.H, want_ctx ? w.H : pp->out, D_MODEL, MODl + 5 * D_MODEL, NMODV, SEQ, BATCH, M_LAT};
              pg8::gemm_phase<pg8::EpiGateRes, pg8::StaticOrder, true, true>((PG8_LAS unsigned char*)lds_raw, g, S, E, tid); }
            if (want_ctx) { constexpr int SK = SK_DOWN;
              pg8::Gemm g{w.ACT + (size_t)M_LAT * D_FF, w.WDOWN + l * SZ_WDOWN, M_CTX, D_MODEL, D_FF / SK, D_FF}; SplitOrder S; S.init(M_CTX, D_MODEL, SK, G, (wg + G / 2) % G);
              pg8::EpiPart E{w.PART, D_MODEL, (size_t)M_CTX * D_MODEL};
              pg8::gemm_phase<pg8::EpiPart, SplitOrder, true, true>((PG8_LAS unsigned char*)lds_raw, g, S, E, tid); } }
        SEAM(pb + 11);

}
__global__ void __launch_bounds__(NTHR, 2) fwd(Params p) {
    extern __shared__ __attribute__((aligned(16))) unsigned char lds_raw[];
    char* lds = (char*)lds_raw;
    const int G = (int)gridDim.x, wg = (int)blockIdx.x, nwaves = G * NWAVES, gthreads = G * NTHR;
    const int C_wave0 = __builtin_amdgcn_readfirstlane((int)threadIdx.x >> 6);
    volatile LAS unsigned* MISC = (volatile LAS unsigned*)(lds_raw + LDS_MISC);
    if (threadIdx.x < 32) MISC[threadIdx.x] = 0u;
    __syncthreads();
    const int lo = p.ph_lo, hi = p.ph_hi;
    unsigned* const barw = (unsigned*)p.ws + CW_BAR + (size_t)p.li * XCD_BAR_WORDS;
    XcdBarrier bar; bar.bar = barw; bar.x = 0; bar.st = MISC + 8;
    if (hi - lo > 1) bar = xcd_barrier_post(barw, MISC + 8, threadIdx.x == 0);

    if (ON(12) && IN(PH_PRO)) { PHASE_WS; PHASE_IDS;
        {
            float* SCs = (float*)lds;
            float* red = (float*)(lds + 3 * D_MODEL * 4);
            constexpr int NT = DEPTH * NMODV / 256;
            if (wg < NT) {
                for (int i = tid; i < (BATCH + 1) * D_MODEL; i += NTHR) { const int s = i / D_MODEL, k = i % D_MODEL; const float v = s < BATCH ? I->c[s * D_MODEL + k] : I->c_ctx[k]; SCs[i] = v / (1.0f + __expf(-v)); }
                __syncthreads();
            }
            for (int t = wg; t < NT; t += G) { const int l = t / (NMODV / 256), j0 = (t % (NMODV / 256)) * 256;
                misc::f32x4 acc[3] = {{0.f, 0.f, 0.f, 0.f}, {0.f, 0.f, 0.f, 0.f}, {0.f, 0.f, 0.f, 0.f}};
                const float* wp = I->ada_w + (size_t)l * D_MODEL * NMODV + (size_t)(256 * wave) * NMODV + j0 + 4 * lane;
#pragma unroll 8
                for (int k = 0; k < 256; ++k) { const misc::f32x4 wv = *(const misc::f32x4*)(wp + (size_t)k * NMODV); const int kk = 256 * wave + k;
                    acc[0] += wv * SCs[kk]; acc[1] += wv * SCs[D_MODEL + kk]; acc[2] += wv * SCs[2 * D_MODEL + kk]; }
                __syncthreads();
#pragma unroll
                for (int s = 0; s < 3; ++s) *(misc::f32x4*)(red + (wave * 3 + s) * 256 + 4 * lane) = acc[s];
                __syncthreads();
                for (int i = tid; i < 3 * 256; i += NTHR) { const int s = i / 256, c = i % 256; float sum = I->ada_b[(size_t)l * NMODV + j0 + c];
#pragma unroll
                    for (int w8 = 0; w8 < 8; ++w8) sum += red[(w8 * 3 + s) * 256 + c];
                    w.MOD[((size_t)l * (BATCH + 1) + s) * NMODV + j0 + c] = sum; }
            }
            __syncthreads();
        }
        {
            float* scr = (float*)(lds + wave * 8448);
            constexpr int I_IN = (D_MODEL / 64) * (NP / 32), I_OUT = (D_MODEL / 64) * (D_MODEL / 32), I_UP = (D_MODEL / 64) * (2 * D_FF / 32), I_DN = (D_FF / 64) * (D_MODEL / 32),
                          I_UQ = (MLA_Q_LORA / 64) * (NQ_MLA / 32), I_UKV = (MLA_KV_LORA / 64) * (NKV_MLA / 32), I_LB = (LRU_BW / 64) * (LRU_BW / 32), I_LRU = 2 * 2 * NH * I_LB;
            constexpr int I_LAYER = I_IN + I_OUT + I_UP + I_DN + I_UQ + I_UKV + I_LRU;
            for (int it = gwave; it < DEPTH * I_LAYER; it += nwaves) { const int l = it / I_LAYER; int r = it % I_LAYER;
                if (r < I_IN) { misc::transpose_item(I->w_in + (size_t)l * D_MODEL * IN_COLS, D_MODEL, IN_COLS, NP, w.WIN + l * SZ_WIN, scr, r, lane); continue; } r -= I_IN;
                if (r < I_OUT) { misc::transpose_item(I->w_out + (size_t)l * D_MODEL * D_MODEL, D_MODEL, D_MODEL, D_MODEL, w.WOUT + l * SZ_WOUT, scr, r, lane); continue; } r -= I_OUT;
                if (r < I_UP) { misc::transpose_item(I->ffn_w_up + (size_t)l * D_MODEL * 2 * D_FF, D_MODEL, 2 * D_FF, 2 * D_FF, w.WUP + l * SZ_WUP, scr, r, lane, D_FF); continue; } r -= I_UP;
                if (r < I_DN) { misc::transpose_item(I->ffn_w_down + (size_t)l * D_FF * D_MODEL, D_FF, D_MODEL, D_MODEL, w.WDOWN + l * SZ_WDOWN, scr, r, lane); continue; } r -= I_DN;
                if (r < I_UQ) { misc::transpose_item(I->mla_w_uq + (size_t)l * MLA_Q_LORA * NQ_MLA, MLA_Q_LORA, NQ_MLA, NQ_MLA, w.WUQ + l * SZ_WUQ, scr, r, lane); continue; } r -= I_UQ;
                if (r < I_UKV) { misc::transpose_item(I->mla_w_ukv + (size_t)l * MLA_KV_LORA * NKV_MLA, MLA_KV_LORA, NKV_MLA, NKV_MLA, w.WUKV + l * SZ_WUKV, scr, r, lane); continue; } r -= I_UKV;
                { const int blk = r / I_LB, item = r % I_LB, d = blk / (2 * NH), wh = (blk / NH) & 1, nb = blk % NH;
                  const float* src = (wh == 0 ? I->lru_wa : I->lru_wx) + ((size_t)(l * 2 + d) * NH + nb) * lru::SZ_WBLK;
                  misc::transpose_item(src, LRU_BW, LRU_BW, LRU_BW, w.WLRU + ((size_t)l * 16 + blk) * lru::SZ_WBLK, scr, item, lane); }
            }
        }
    }
    SEAM(PH_PRO);

    { LayerCtx C; C.lo = lo; C.hi = hi; C.G = G; C.wg = wg; C.nwaves = nwaves; C.gthreads = gthreads; C.wave0 = C_wave0; C.bar = bar; C.lds = lds; C.lds_raw = lds_raw;
      static_assert(DEPTH == 4, "layer calls are written out (a real layer loop lets LICM park loop-invariant values in registers across every phase: spills)");
      layer_body<0>(C); layer_body<1>(C); layer_body<2>(C); layer_body<3>(C); }
#undef IN
#undef SEAM
}

#ifndef MK_PHASES_PER_LAUNCH
#define MK_PHASES_PER_LAUNCH NPH
#endif
extern "C" void kernel_launch(void* const* d_in, const int* in_sizes, int n_in, void* d_out, int out_size, void* d_ws, size_t ws_size, hipStream_t stream) {
    static int grid = 0;
    if (grid == 0) {
        int dev = 0, cus = 0;
        if (hipGetDevice(&dev) != hipSuccess || hipDeviceGetAttribute(&cus, hipDeviceAttributeMultiprocessorCount, dev) != hipSuccess || cus <= 0) { fprintf(stderr, "kernel_launch: no device\n"); grid = -1; return; }
        if (hipFuncSetAttribute((const void*)fwd, hipFuncAttributeMaxDynamicSharedMemorySize, LDS_BYTES) != hipSuccess) { fprintf(stderr, "kernel_launch: hipFuncSetAttribute failed\n"); grid = -1; return; }
        int per_cu = 0; if (hipOccupancyMaxActiveBlocksPerMultiprocessor(&per_cu, (const void*)fwd, NTHR, LDS_BYTES) != hipSuccess || per_cu < 1) fprintf(stderr, "kernel_launch: occupancy query says %d blocks per CU\n", per_cu);
        (void)hipGetLastError();
        grid = cus;
        const WS w0 = ws_carve(nullptr);
        if (n_in != 34 || w0.total > ws_size) { fprintf(stderr, "kernel_launch: bad inputs / workspace (need %zu, have %zu)\n", w0.total, ws_size); grid = -1; return; }
    }
    if (grid < 0) return;
    (void)hipMemsetAsync(d_ws, 0, 1 << 20, stream);
    Params p; memset(&p, 0, sizeof(p));
    for (int i = 0; i < 34; ++i) p.in[i] = (const float*)d_in[i];
    p.out = (float*)d_out; p.ws = (unsigned char*)d_ws;
    int li = 0;
    for (int lo = 0; lo < NPH; lo += MK_PHASES_PER_LAUNCH, ++li) {
        p.ph_lo = lo; p.ph_hi = lo + MK_PHASES_PER_LAUNCH < NPH ? lo + MK_PHASES_PER_LAUNCH : NPH; p.li = li;
#if defined(PROBE_MASK)
        if (MK_PHASES_PER_LAUNCH == 1 && ((((PROBE_MASK) >> 12) & 1 && lo == 0) || (lo > 0 && (((PROBE_MASK) >> ((lo - 1) % PH_PER_LAYER)) & 1))))
            { Params q = p;
#if defined(PROBE_FLAGS)
              q.pad = PROBE_FLAGS;
#endif
              for (int r = 0; r < PROBE_REPS; ++r) hipLaunchKernelGGL(fwd, dim3(grid), dim3(NTHR), LDS_BYTES, stream, q); }
#endif
        hipLaunchKernelGGL(fwd, dim3(grid), dim3(NTHR), LDS_BYTES, stream, p);
    }
}
```

```cpp
#include <hip/hip_runtime.h>
#include <cstdio>
#include <cstdint>
#include <cstring>
#include <math.h>
#include <stdint.h>

#ifdef CFG_SMALL
constexpr int D_MODEL = 256, BATCH = 2, SEQ = 512, DEPTH = 2, CTX_LEN = 64, GRID_W = 32, HEAD_DIM = 16;
#else
constexpr int D_MODEL = 2048, BATCH = 2, SEQ = 8192, DEPTH = 4, CTX_LEN = 256, GRID_W = 64, HEAD_DIM = 128;
#endif
constexpr int GROUP_W = D_MODEL / 4, NH = GROUP_W / HEAD_DIM;
constexpr int HD = HEAD_DIM;
constexpr int N_MOD = 6;
constexpr float EPS = 1e-6f;
constexpr int LRU_W = GROUP_W, LRU_BW = LRU_W / NH;
constexpr float LRU_C = 8.0f;
constexpr int MLA_Q_LORA = 3 * D_MODEL / 16, MLA_KV_LORA = D_MODEL / 8, MLA_NOPE = HD, MLA_ROPE = HD / 2, MLA_V = HD, MLA_QK = MLA_NOPE + MLA_ROPE;
constexpr int GDN_CHUNK = 64;
constexpr int NA_KH = 8, NA_KW = 16;
constexpr int D_FF = 5 * D_MODEL / 2;
constexpr int ROWS = SEQ / GRID_W;
constexpr int C_LRU_X = 0, C_LRU_G = C_LRU_X + LRU_W, C_CQ = C_LRU_G + LRU_W, C_CKV = C_CQ + MLA_Q_LORA, C_KR = C_CKV + MLA_KV_LORA,
              C_GQ = C_KR + MLA_ROPE, C_GK = C_GQ + GROUP_W, C_GV = C_GK + GROUP_W, C_GG = C_GV + GROUP_W, C_GB = C_GG + GROUP_W,
              C_GA = C_GB + 2 * NH, C_NQ = C_GA + 2 * NH, C_NK = C_NQ + GROUP_W, C_NV = C_NK + GROUP_W, IN_COLS = C_NV + GROUP_W;
constexpr int NP = (IN_COLS + 255) / 256 * 256;
constexpr int M_LAT = BATCH * SEQ, M_CTX = BATCH * CTX_LEN, M_ALL = M_LAT + M_CTX;
constexpr int NMODV = N_MOD * D_MODEL;

typedef unsigned short bf16_t;
__host__ __device__ __forceinline__ bf16_t f2bf(float f) { union { float f; unsigned u; } v; v.f = f; unsigned u = v.u; u += 0x7fffu + ((u >> 16) & 1u); return (bf16_t)(u >> 16); }
__host__ __device__ __forceinline__ float bf2f(bf16_t b) { union { float f; unsigned u; } v; v.u = ((unsigned)b) << 16; return v.f; }
__host__ __device__ __forceinline__ float sigmoidf_(float x) { return 1.0f / (1.0f + expf(-x)); }
__host__ __device__ __forceinline__ float siluf_(float x) { return x / (1.0f + expf(-x)); }
__host__ __device__ __forceinline__ float softplusf_(float x) { return fmaxf(x, 0.0f) + log1pf(expf(-fabsf(x))); }
__host__ __device__ __forceinline__ float geluf_(float x) { return 0.5f * x * (1.0f + tanhf(0.7978845608028654f * (x + 0.044715f * x * x * x))); }

struct RowInfo { int b, t, T, base, set; };
__host__ __device__ __forceinline__ RowInfo row_info(int r) {
    RowInfo i;
    if (r < M_LAT) { i.b = r / SEQ; i.t = r % SEQ; i.T = SEQ; i.base = i.b * SEQ; i.set = i.b; }
    else { const int rr = r - M_LAT; i.b = rr / CTX_LEN; i.t = rr % CTX_LEN; i.T = CTX_LEN; i.base = M_LAT + i.b * CTX_LEN; i.set = BATCH; }
    return i;
}


__host__ __device__ __forceinline__ float bflo(unsigned w) { union { float f; unsigned u; } v; v.u = w << 16; return v.f; }
__host__ __device__ __forceinline__ float bfhi(unsigned w) { union { float f; unsigned u; } v; v.u = w & 0xffff0000u; return v.f; }
#define LDS_BARRIER() asm volatile("s_waitcnt lgkmcnt(0)\n\ts_barrier" ::: "memory")
__device__ __forceinline__ float lane_xor(float v, int mask, int lane) { return __int_as_float(__builtin_amdgcn_ds_bpermute((lane ^ mask) << 2, __float_as_int(v))); }
__device__ __forceinline__ float lane_get(float v, int src_lane) { return __int_as_float(__builtin_amdgcn_ds_bpermute(src_lane << 2, __float_as_int(v))); }
struct Inputs {
    const float *x, *c, *ctx, *c_ctx, *ada_w, *ada_b, *norm_mix_g, *norm_ffn_g, *w_in, *w_out,
        *lru_conv_w, *lru_conv_b, *lru_wa, *lru_ba, *lru_wx, *lru_bx, *lru_lam,
        *mla_qa_g, *mla_w_uq, *mla_kva_g, *mla_w_ukv, *mla_qn_g, *mla_kn_g,
        *gdn_conv_w, *gdn_a_log, *gdn_dt_bias, *gdn_norm_g, *na_qn_g, *na_kn_g, *na_rpb,
        *ffn_w_up, *ffn_conv_w, *ffn_conv_b, *ffn_w_down;
};
constexpr int NQ_MLA = NH * MLA_QK, NKV_MLA = NH * (MLA_NOPE + MLA_V);
constexpr size_t SZ_WIN = (size_t)NP * D_MODEL, SZ_WOUT = (size_t)D_MODEL * D_MODEL, SZ_WUP = (size_t)2 * D_FF * D_MODEL, SZ_WDOWN = (size_t)D_MODEL * D_FF,
                 SZ_WUQ = (size_t)NQ_MLA * MLA_Q_LORA, SZ_WUKV = (size_t)NKV_MLA * MLA_KV_LORA, SZ_WLRU = (size_t)16 * LRU_BW * LRU_BW;
struct WS {
    unsigned* ctl; float *MOD, *H, *PART; bf16_t *U, *Y;
    bf16_t *WIN, *WOUT, *WUP, *WDOWN, *WUQ, *WUKV, *WLRU;
    bf16_t* P; bf16_t *CQN, *CKVN, *QR, *KVR, *QM, *KM, *VM, *NQ, *NK;
    bf16_t *gUT, *gWP, *gKDT, *gQD, *gQK, *gSIT, *gVNT; float *gGT, *gSS;
    bf16_t *lHLOC, *lACUM; float *lLSUM, *lHIN;
    bf16_t *HALO, *ACT;
    size_t total;
};
__host__ __device__ inline WS ws_carve(void* base) {
    WS w; size_t off = 0; char* b = (char*)base;
#define WS_TAKE(T, field, bytes) do { w.field = (T*)(b + off); off += (((size_t)(bytes)) + 255) & ~(size_t)255; } while (0)
    WS_TAKE(unsigned, ctl, 1 << 20);
    WS_TAKE(float, MOD, sizeof(float) * (size_t)DEPTH * (BATCH + 1) * NMODV);
    WS_TAKE(float, H, sizeof(float) * (size_t)M_ALL * D_MODEL);
    WS_TAKE(float, PART, sizeof(float) * (size_t)5 * M_CTX * D_MODEL);
    WS_TAKE(bf16_t, U, 2 * (size_t)M_ALL * D_MODEL);
    WS_TAKE(bf16_t, Y, 2 * (size_t)M_ALL * D_MODEL);
    WS_TAKE(bf16_t, WIN, 2 * SZ_WIN * DEPTH); WS_TAKE(bf16_t, WOUT, 2 * SZ_WOUT * DEPTH); WS_TAKE(bf16_t, WUP, 2 * SZ_WUP * DEPTH); WS_TAKE(bf16_t, WDOWN, 2 * SZ_WDOWN * DEPTH);
    WS_TAKE(bf16_t, WUQ, 2 * SZ_WUQ * DEPTH); WS_TAKE(bf16_t, WUKV, 2 * SZ_WUKV * DEPTH); WS_TAKE(bf16_t, WLRU, 2 * SZ_WLRU * DEPTH);
    const size_t r0 = off;
    WS_TAKE(bf16_t, P, 2 * (size_t)M_ALL * NP);
    WS_TAKE(bf16_t, CQN, 2 * (size_t)M_ALL * MLA_Q_LORA); WS_TAKE(bf16_t, CKVN, 2 * (size_t)M_ALL * MLA_KV_LORA);
    WS_TAKE(bf16_t, QR, 2 * (size_t)M_ALL * NQ_MLA); WS_TAKE(bf16_t, KVR, 2 * (size_t)M_ALL * NKV_MLA);
    WS_TAKE(bf16_t, QM, 2 * (size_t)M_ALL * NQ_MLA); WS_TAKE(bf16_t, KM, 2 * (size_t)M_ALL * NQ_MLA); WS_TAKE(bf16_t, VM, 2 * (size_t)M_ALL * NH * MLA_V);
    WS_TAKE(bf16_t, NQ, 2 * (size_t)M_ALL * GROUP_W); WS_TAKE(bf16_t, NK, 2 * (size_t)M_ALL * GROUP_W);
    { constexpr size_t NT_ = (size_t)(M_ALL / 64) * NH * 2;
      WS_TAKE(bf16_t, gUT, 2 * NT_ * 128 * 64); WS_TAKE(bf16_t, gWP, 2 * NT_ * 64 * 128); WS_TAKE(bf16_t, gKDT, 2 * NT_ * 128 * 64); WS_TAKE(bf16_t, gQD, 2 * NT_ * 64 * 128);
      WS_TAKE(bf16_t, gQK, 2 * NT_ * 64 * 64); WS_TAKE(bf16_t, gSIT, 2 * NT_ * 128 * 128); WS_TAKE(bf16_t, gVNT, 2 * NT_ * 128 * 64); WS_TAKE(float, gGT, 4 * NT_ * DEPTH); WS_TAKE(float, gSS, 4 * (size_t)BATCH * NH * 2 * HD * HD); }
    WS_TAKE(bf16_t, lHLOC, 2 * (size_t)2 * M_ALL * LRU_W); WS_TAKE(bf16_t, lACUM, 2 * (size_t)2 * M_ALL * LRU_W);
    WS_TAKE(float, lLSUM, 4 * (size_t)(M_ALL / 64) * 2 * 2 * LRU_W); WS_TAKE(float, lHIN, 4 * (size_t)(M_ALL / 64) * 2 * LRU_W);
    const size_t r1 = off;
    off = r0;
    WS_TAKE(bf16_t, HALO, 2 * (size_t)(M_ALL / 64) * 4 * 2 * D_FF); WS_TAKE(bf16_t, ACT, 2 * (size_t)M_ALL * D_FF);
    const size_t f1 = off;
#undef WS_TAKE
    w.total = r1 > f1 ? r1 : f1;
    return w;
}

namespace pg8 {
#define PG8_LAS __attribute__((address_space(3)))
typedef unsigned short bf16_t;
typedef short bf16x8 __attribute__((ext_vector_type(8)));
typedef float f32x4 __attribute__((ext_vector_type(4)));
typedef unsigned u32x4 __attribute__((ext_vector_type(4)));
constexpr int BM = 256, BK = 64, HALF = 128, HTB = HALF * BK * 2  , STAGE_BYTES = 8 * HTB, NXCD = 8, WGM = 8;

__host__ __device__ __forceinline__ int lds_byte(int r, int c) { const int st = (r >> 4) * 2 + (c >> 5), rr = r & 15, cc = c & 31, ob = rr * 64 + cc * 2; return st * 1024 + (ob ^ (((ob >> 9) & 1) << 5)); }
__host__ __device__ __forceinline__ void stage_rc(int b, int& R, int& C) { const int st = b / 1024, sb = b % 1024, swz = sb ^ (((sb >> 9) & 1) << 5); R = (st >> 1) * 16 + swz / 64; C = (st & 1) * 32 + (swz % 64) / 2; }
__host__ __device__ __forceinline__ int perm32(int rho) { const int n = rho >> 4, i = rho & 15; return 8 * (i >> 2) + 4 * n + (i & 3); }

struct Unit { int pm, pn, ks; };
struct Gemm { const bf16_t* A; const bf16_t* Bt; int M, N, K, ld; };

struct StaticOrder {
    int nM, nN, nwg, G, c;
    __host__ __device__ void init(int M, int N, int G_, int c_) { nM = M / BM; nN = N / BM; nwg = nM * nN; G = G_; c = c_; }
    __host__ __device__ bool next(int i, Unit& u) const {
        const long L = (long)i * G + c; if (L >= nwg) return false;
        int wgid = (int)L; { const int q = nwg / NXCD, r = nwg % NXCD, xcd = wgid % NXCD, off = wgid / NXCD; wgid = (xcd < r ? xcd * (q + 1) : r * (q + 1) + (xcd - r) * q) + off; }
        const int nig = WGM * nN, gid = wgid / nig, fm = gid * WGM, gsz = (nM - fm) < WGM ? (nM - fm) : WGM;
        u.pm = fm + ((wgid % nig) % gsz); u.pn = (wgid % nig) / gsz; u.ks = 0; return true;
    }
    __device__ __forceinline__ void a_ready(const Unit&) const {}
    __device__ __forceinline__ void done(const Unit&) const {}
};
__device__ __forceinline__ unsigned cvt_pk_bf16(float lo, float hi) { unsigned r; asm volatile("v_cvt_pk_bf16_f32 %0, %1, %2" : "=v"(r) : "v"(lo), "v"(hi)); return r; }
typedef float f32x2 __attribute__((ext_vector_type(2)));
__device__ __forceinline__ f32x2 gelu_pk(f32x2 v) {
    const f32x2 av = __builtin_elementwise_abs(v), d = av * 0.2316418882f + 1.0f;
    f32x2 t; t.x = __builtin_amdgcn_rcpf(d.x); t.y = __builtin_amdgcn_rcpf(d.y);
    f32x2 q = t * 0.5307027145f + (-0.7265760135f); q = q * t + 0.7107068705f; q = q * t + (-0.142248368f); q = q * t + 0.127414796f; q = q * t;
    const f32x2 s = (v * v) * (-0.72134752044f);
    f32x2 e; e.x = __builtin_amdgcn_exp2f(s.x); e.y = __builtin_amdgcn_exp2f(s.y);
    const f32x2 m = v * (q * e), r = v - m;
    f32x2 o; o.x = v.x < 0.f ? m.x : r.x; o.y = v.y < 0.f ? m.y : r.y; return o;
}

template <int ACT  > struct EpiBf16 {
    static constexpr bool PERM = true, AFTER_DRAIN = false; static_assert(ACT == 0 || ACT == 1, "EpiBf16: ACT is 0 (none) or 1 (gelu_pk)");
    bf16_t* O; int ldc; const float* bias; int split_cols; size_t split_stride; float scale0;
    __device__ __forceinline__ void operator()(const f32x4 (&acc)[2][2][4][2], const Unit& u, int wr, int wc, int fr, int fq) const {
        const int row0 = u.pm * BM + wr * 64 + fr; int colt = u.pn * BM; bf16_t* base = O;
        float sc = 1.f; if (split_cols) { const int t = colt / split_cols; base += (size_t)t * split_stride; colt -= t * split_cols; if (t == 0) sc = scale0; }
        const int col0 = colt + wc * 32 + 8 * fq, bcol0 = u.pn * BM + wc * 32 + 8 * fq;
        f32x4 bv[2][2];
#pragma unroll
        for (int bj = 0; bj < 2; ++bj)
#pragma unroll
            for (int n = 0; n < 2; ++n) bv[bj][n] = bias ? *(const f32x4*)(bias + bcol0 + bj * HALF + 4 * n) : (f32x4){0.f, 0.f, 0.f, 0.f};
#pragma unroll
        for (int ai = 0; ai < 2; ++ai)
#pragma unroll
            for (int m = 0; m < 4; ++m) { bf16_t* rowp = base + (size_t)(row0 + ai * HALF + m * 16) * ldc + col0;
#pragma unroll
                for (int bj = 0; bj < 2; ++bj) { f32x4 v0 = acc[ai][bj][m][0] + bv[bj][0], v1 = acc[ai][bj][m][1] + bv[bj][1];
                    if (ACT == 1) { f32x2 a = gelu_pk((f32x2){v0[0], v0[1]}), b = gelu_pk((f32x2){v0[2], v0[3]}), c = gelu_pk((f32x2){v1[0], v1[1]}), d = gelu_pk((f32x2){v1[2], v1[3]});
                        v0 = (f32x4){a.x, a.y, b.x, b.y}; v1 = (f32x4){c.x, c.y, d.x, d.y}; }
                    v0 = v0 * sc; v1 = v1 * sc; u32x4 w; w.x = cvt_pk_bf16(v0[0], v0[1]); w.y = cvt_pk_bf16(v0[2], v0[3]); w.z = cvt_pk_bf16(v1[0], v1[1]); w.w = cvt_pk_bf16(v1[2], v1[3]);
                    *(u32x4*)(rowp + bj * HALF) = w; } }
    }
};

struct EpiF32 {
    static constexpr bool PERM = false, AFTER_DRAIN = false;
    float* C; int ldc;
    __device__ __forceinline__ void operator()(const f32x4 (&acc)[2][2][4][2], const Unit& u, int wr, int wc, int fr, int fq) const {
        const int row0 = u.pm * BM + wr * 64 + fr, col0 = u.pn * BM + wc * 32 + 4 * fq;
#pragma unroll
        for (int ai = 0; ai < 2; ++ai)
#pragma unroll
            for (int m = 0; m < 4; ++m) { float* rowp = C + (size_t)(row0 + ai * HALF + m * 16) * ldc + col0;
#pragma unroll
                for (int bj = 0; bj < 2; ++bj)
#pragma unroll
                    for (int n = 0; n < 2; ++n) *(f32x4*)(rowp + bj * HALF + n * 16) = acc[ai][bj][m][n]; }
    }
};
struct EpiGateRes {
    static constexpr bool PERM = false, AFTER_DRAIN = false;
    const float* base; float* out; int ldc; const float* gate; int set_stride; int rows_per_set; int nsets_lat; int lat_rows;
    __device__ __forceinline__ void operator()(const f32x4 (&acc)[2][2][4][2], const Unit& u, int wr, int wc, int fr, int fq) const {
        const int row0 = u.pm * BM + wr * 64 + fr, col0 = u.pn * BM + wc * 32 + 4 * fq;
        const int set = (u.pm * BM >= lat_rows) ? nsets_lat : (u.pm * BM) / rows_per_set;
        const float* gp = gate + (size_t)set * set_stride + col0;
        f32x4 gv[2][2];
#pragma unroll
        for (int bj = 0; bj < 2; ++bj)
#pragma unroll
            for (int n = 0; n < 2; ++n) gv[bj][n] = *(const f32x4*)(gp + bj * HALF + n * 16);
#pragma unroll
        for (int ai = 0; ai < 2; ++ai)
#pragma unroll
            for (int m = 0; m < 4; ++m) { const size_t off = (size_t)(row0 + ai * HALF + m * 16) * ldc + col0;
#pragma unroll
                for (int bj = 0; bj < 2; ++bj)
#pragma unroll
                    for (int n = 0; n < 2; ++n) { const f32x4 b = *(const f32x4*)(base + off + bj * HALF + n * 16); *(f32x4*)(out + off + bj * HALF + n * 16) = b + gv[bj][n] * acc[ai][bj][m][n]; } }
    }
};

struct EpiConvAct {
    static constexpr bool PERM = false, AFTER_DRAIN = false;
    bf16_t* ACT; bf16_t* HALO; const float* cw; const float* cb; int dff;
    __device__ __forceinline__ static float ror1(float v) { return __int_as_float(__builtin_amdgcn_update_dpp(0, __float_as_int(v), 0x121, 0xf, 0xf, false)); }
    __device__ __forceinline__ static float rol1(float v) { return __int_as_float(__builtin_amdgcn_update_dpp(0, __float_as_int(v), 0x12f, 0xf, 0xf, false)); }
    __device__ __forceinline__ void operator()(const f32x4 (&acc)[2][2][4][2], const Unit& u, int wr, int wc, int fr, int fq) const {
        const int rowb = u.pm * BM + wr * 64, chb = u.pn * HALF + wc * 32 + 4 * fq;
        const bool f0 = fr == 0, f15 = fr == 15;
        typedef float f32x2 __attribute__((ext_vector_type(2)));
#pragma unroll
        for (int n = 0; n < 2; ++n)
#pragma unroll
            for (int ep = 0; ep < 2; ++ep) { const int ch = chb + 16 * n + 2 * ep;
                f32x2 wa[3], wg[3], ba, bg;
#pragma unroll
                for (int k = 0; k < 3; ++k) { wa[k] = *(const f32x2*)(cw + (size_t)k * 2 * dff + ch); wg[k] = *(const f32x2*)(cw + (size_t)k * 2 * dff + dff + ch); }
                ba = *(const f32x2*)(cb + ch); bg = *(const f32x2*)(cb + dff + ch);
#pragma unroll
                for (int ai = 0; ai < 2; ++ai) { const int blk = (rowb + ai * HALF) >> 6;
                    float y[4][2];
#pragma unroll
                    for (int eo = 0; eo < 2; ++eo) { const int e = 2 * ep + eo;
                        float Ra[4], La[4], Rg[4], Lg[4];
#pragma unroll
                        for (int m = 0; m < 4; ++m) { Ra[m] = ror1(acc[ai][0][m][n][e]); La[m] = rol1(acc[ai][0][m][n][e]); Rg[m] = ror1(acc[ai][1][m][n][e]); Lg[m] = rol1(acc[ai][1][m][n][e]); }
#pragma unroll
                        for (int m = 0; m < 4; ++m) {
                            const float ap = f0 ? Ra[m > 0 ? m - 1 : 0] : Ra[m], an = f15 ? La[m < 3 ? m + 1 : 3] : La[m];
                            const float gp = f0 ? Rg[m > 0 ? m - 1 : 0] : Rg[m], gn = f15 ? Lg[m < 3 ? m + 1 : 3] : Lg[m];
                            const float a = ba[eo] + wa[0][eo] * ap + wa[1][eo] * acc[ai][0][m][n][e] + wa[2][eo] * an;
                            const float g = bg[eo] + wg[0][eo] * gp + wg[1][eo] * acc[ai][1][m][n][e] + wg[2][eo] * gn;
                            y[m][eo] = a * (g * __builtin_amdgcn_rcpf(1.0f + __expf(-g))); }
                    }
#pragma unroll
                    for (int m = 0; m < 4; ++m) { const int row = rowb + ai * HALF + 16 * m + fr;
                        *(unsigned*)(ACT + (size_t)row * dff + ch) = cvt_pk_bf16(y[m][0], y[m][1]);
                        if ((m == 0 && fr < 2) || (m == 3 && fr >= 14)) { const int slot = m == 0 ? fr : fr - 12; bf16_t* hp = HALO + ((size_t)blk * 4 + slot) * (2 * dff) + ch;
                            *(unsigned*)hp = cvt_pk_bf16(acc[ai][0][m][n][2 * ep], acc[ai][0][m][n][2 * ep + 1]);
                            *(unsigned*)(hp + dff) = cvt_pk_bf16(acc[ai][1][m][n][2 * ep], acc[ai][1][m][n][2 * ep + 1]); }
                    }
                }
            }
    }
};

struct EpiPart {
    static constexpr bool PERM = false, AFTER_DRAIN = false;
    float* C; int ldc; size_t ks_stride;
    __device__ __forceinline__ void operator()(const f32x4 (&acc)[2][2][4][2], const Unit& u, int wr, int wc, int fr, int fq) const {
        const int row0 = u.pm * BM + wr * 64 + fr, col0 = u.pn * BM + wc * 32 + 4 * fq; float* Cb = C + (size_t)u.ks * ks_stride;
#pragma unroll
        for (int ai = 0; ai < 2; ++ai)
#pragma unroll
            for (int m = 0; m < 4; ++m) { float* rowp = Cb + (size_t)(row0 + ai * HALF + m * 16) * ldc + col0;
#pragma unroll
                for (int bj = 0; bj < 2; ++bj)
#pragma unroll
                    for (int n = 0; n < 2; ++n) *(f32x4*)(rowp + bj * HALF + n * 16) = acc[ai][bj][m][n]; }
    }
};

template <class Epi, class Sched, bool ALIGN_EPI = false, bool SP2 = false>
__device__ __forceinline__ void gemm_phase(PG8_LAS unsigned char* lds, const Gemm g, const Sched& S, const Epi& E, const int tid_in) {
    int tid_ = tid_in; asm volatile("" : "+v"(tid_));
    const int tid = tid_, wid = __builtin_amdgcn_readfirstlane(tid >> 6), lane = tid & 63, wr = wid >> 2, wc = wid & 3, fr = lane & 15, fq = lane >> 4;
    const int K = g.K, nt = K / BK;
    unsigned voffA[2], voffB[2];
#pragma unroll
    for (int i = 0; i < 2; ++i) { int R, C; stage_rc(tid * 16 + i * 8192, R, C); const int Rb = Epi::PERM ? ((R & ~31) + perm32(R & 31)) : R;
        voffA[i] = (unsigned)(R * g.ld + C) * 2u; voffB[i] = (unsigned)(Rb * g.ld + C) * 2u; }
    const size_t kstep = (size_t)(BK * 2);
    const size_t hstep = (size_t)HALF * g.ld * 2;
    const size_t tstep = 2 * hstep;
    const unsigned ldsw = (unsigned)wid * 1024u;
    const int aoff = lds_byte(wr * 64 + fr, fq * 8), boff = lds_byte(wc * 32 + fr, fq * 8);
#define PG8_SA(b, h) (((b) * 2 + (h)) * HTB)
#define PG8_SB(b, h) ((4 + (b) * 2 + (h)) * HTB)
#define PG8_STAGE(bufoff, gbase, voff) do { _Pragma("unroll") for (int _i = 0; _i < 2; ++_i) \
        __builtin_amdgcn_global_load_lds((const unsigned*)((const char*)(gbase) + (voff)[_i]), (PG8_LAS unsigned*)(lds + (bufoff) + ldsw + _i * 8192), 16, 0, 0); } while (0)
#define PG8_LDA(dst, b, h) do { _Pragma("unroll") for (int m = 0; m < 4; ++m) _Pragma("unroll") for (int k = 0; k < 2; ++k) dst[m][k] = *(const PG8_LAS bf16x8*)(lds + PG8_SA(b, h) + aoff + m * 2048 + k * 1024); } while (0)
#define PG8_LDB(dst, b, h) do { _Pragma("unroll") for (int n = 0; n < 2; ++n) _Pragma("unroll") for (int k = 0; k < 2; ++k) dst[n][k] = *(const PG8_LAS bf16x8*)(lds + PG8_SB(b, h) + boff + n * 2048 + k * 1024); } while (0)
#define PG8_MMA(ai, bj, At, Bt) do { __builtin_amdgcn_s_setprio(1); _Pragma("unroll") for (int m = 0; m < 4; ++m) _Pragma("unroll") for (int n = 0; n < 2; ++n) _Pragma("unroll") for (int k = 0; k < 2; ++k) \
        acc[ai][bj][m][n] = __builtin_amdgcn_mfma_f32_16x16x32_bf16(Bt[n][k], At[m][k], acc[ai][bj][m][n], 0, 0, 0); __builtin_amdgcn_s_setprio(0); } while (0)
#define PG8_WAIT_V(n) asm volatile("s_waitcnt vmcnt(" #n ")" ::: "memory")
#define PG8_WAIT_L(n) asm volatile("s_waitcnt lgkmcnt(" #n ")" ::: "memory")
#define PG8_BAR __builtin_amdgcn_s_barrier()
#define PG8_SCHED __builtin_amdgcn_sched_barrier(0)
    Unit cur, nxt; int ui = 0;
    if (!S.next(0, cur)) return;
    f32x4 acc[2][2][4][2];
#pragma unroll
    for (int a = 0; a < 2; ++a)
#pragma unroll
        for (int b = 0; b < 2; ++b)
#pragma unroll
            for (int m = 0; m < 4; ++m)
#pragma unroll
                for (int n = 0; n < 2; ++n) acc[a][b][m][n] = (f32x4){0.f, 0.f, 0.f, 0.f};
    bf16x8 At[4][2], B0[2][2], B1[2][2];
    const size_t ksb = (size_t)K * 2;
    const char* cA = (const char*)g.A + (size_t)cur.pm * tstep + (size_t)cur.ks * ksb; const char* cB = (const char*)g.Bt + (size_t)cur.pn * tstep + (size_t)cur.ks * ksb;
    S.a_ready(cur);
    if constexpr (SP2) {
        PG8_STAGE(PG8_SB(0, 0), cB, voffB); PG8_STAGE(PG8_SB(0, 1), cB + hstep, voffB); PG8_STAGE(PG8_SA(0, 0), cA, voffA); PG8_STAGE(PG8_SA(0, 1), cA + hstep, voffA);
        if (wr == 1) PG8_BAR;
        PG8_WAIT_V(2); PG8_BAR;
        PG8_STAGE(PG8_SB(1, 0), cB + kstep, voffB); PG8_STAGE(PG8_SA(1, 0), cA + kstep, voffA); PG8_STAGE(PG8_SB(1, 1), cB + hstep + kstep, voffB);
        PG8_WAIT_V(6); PG8_BAR;
    } else {
        PG8_STAGE(PG8_SB(0, 0), cB, voffB); PG8_STAGE(PG8_SA(0, 0), cA, voffA); PG8_STAGE(PG8_SB(0, 1), cB + hstep, voffB); PG8_STAGE(PG8_SA(0, 1), cA + hstep, voffA);
        if (wr == 1) PG8_BAR;
        PG8_WAIT_V(4); PG8_BAR;
        PG8_STAGE(PG8_SB(1, 0), cB + kstep, voffB); PG8_STAGE(PG8_SA(1, 0), cA + kstep, voffA); PG8_STAGE(PG8_SB(1, 1), cB + hstep + kstep, voffB);
        PG8_WAIT_V(6); PG8_BAR;
    }
    for (;;) {
        const bool has_next = S.next(ui + 1, nxt);
        const char* nA = has_next ? (const char*)g.A + (size_t)nxt.pm * tstep + (size_t)nxt.ks * ksb : cA; const char* nB = has_next ? (const char*)g.Bt + (size_t)nxt.pn * tstep + (size_t)nxt.ks * ksb : cB;
        for (int t = 0; t < nt; t += 2) {
            const bool last = (t == nt - 2);
            const char* a1 = cA + (size_t)(t + 1) * kstep;
            const char* a2 = last ? nA : cA + (size_t)(t + 2) * kstep; const char* b2 = last ? nB : cB + (size_t)(t + 2) * kstep;
            const char* a3 = a2 + kstep; const char* b3 = b2 + kstep;
            if (last && has_next) S.a_ready(nxt);
            if constexpr (SP2) {
            PG8_LDB(B0, 0, 0); PG8_LDB(B1, 0, 1); PG8_SCHED; PG8_LDA(At, 0, 0); PG8_STAGE(PG8_SA(1, 1), a1 + hstep, voffA);
            PG8_WAIT_V(8); PG8_WAIT_L(0); PG8_BAR; PG8_MMA(0, 0, At, B0); PG8_MMA(0, 1, At, B1); PG8_BAR; PG8_SCHED;
            PG8_LDA(At, 0, 1); PG8_STAGE(PG8_SB(0, 0), b2, voffB); PG8_STAGE(PG8_SB(0, 1), b2 + hstep, voffB); PG8_STAGE(PG8_SA(0, 0), a2, voffA);
            PG8_WAIT_V(8); PG8_WAIT_L(0); PG8_BAR; PG8_MMA(1, 0, At, B0); PG8_MMA(1, 1, At, B1); PG8_BAR; PG8_SCHED;
            PG8_LDB(B0, 1, 0); PG8_LDB(B1, 1, 1); PG8_SCHED; PG8_LDA(At, 1, 0); PG8_STAGE(PG8_SA(0, 1), a2 + hstep, voffA);
            PG8_WAIT_V(8); PG8_WAIT_L(0); PG8_BAR; PG8_MMA(0, 0, At, B0); PG8_MMA(0, 1, At, B1); PG8_BAR; PG8_SCHED;
            PG8_LDA(At, 1, 1); PG8_STAGE(PG8_SB(1, 0), b3, voffB); PG8_STAGE(PG8_SB(1, 1), b3 + hstep, voffB); PG8_STAGE(PG8_SA(1, 0), a3, voffA);
            PG8_WAIT_V(8); PG8_WAIT_L(0); PG8_BAR; PG8_MMA(1, 0, At, B0); PG8_MMA(1, 1, At, B1); PG8_BAR; PG8_SCHED;
            } else {
            PG8_LDB(B0, 0, 0); PG8_SCHED; PG8_LDA(At, 0, 0); PG8_STAGE(PG8_SA(1, 1), a1 + hstep, voffA);
            PG8_WAIT_L(8); PG8_BAR; PG8_WAIT_L(0); PG8_MMA(0, 0, At, B0); PG8_BAR; PG8_SCHED;
            PG8_LDB(B1, 0, 1); PG8_STAGE(PG8_SB(0, 0), b2, voffB);
            PG8_BAR; PG8_WAIT_L(0); PG8_MMA(0, 1, At, B1); PG8_BAR;
            PG8_LDA(At, 0, 1); PG8_STAGE(PG8_SA(0, 0), a2, voffA);
            PG8_BAR; PG8_WAIT_L(0); PG8_MMA(1, 0, At, B0); PG8_BAR; PG8_SCHED;
            PG8_STAGE(PG8_SB(0, 1), b2 + hstep, voffB);
            PG8_WAIT_V(6); PG8_BAR; PG8_MMA(1, 1, At, B1); PG8_BAR;
            PG8_LDB(B0, 1, 0); PG8_SCHED; PG8_LDA(At, 1, 0); PG8_STAGE(PG8_SA(0, 1), a2 + hstep, voffA);
            PG8_WAIT_L(8); PG8_BAR; PG8_WAIT_L(0); PG8_MMA(0, 0, At, B0); PG8_BAR; PG8_SCHED;
            PG8_LDB(B1, 1, 1); PG8_STAGE(PG8_SB(1, 0), b3, voffB);
            PG8_BAR; PG8_WAIT_L(0); PG8_MMA(0, 1, At, B1); PG8_BAR;
            PG8_LDA(At, 1, 1); PG8_STAGE(PG8_SA(1, 0), a3, voffA);
            PG8_BAR; PG8_WAIT_L(0); PG8_MMA(1, 0, At, B0); PG8_BAR; PG8_SCHED;
            PG8_STAGE(PG8_SB(1, 1), b3 + hstep, voffB);
            PG8_WAIT_V(6); PG8_BAR; PG8_MMA(1, 1, At, B1); PG8_BAR;
            }
        }
        if constexpr (ALIGN_EPI) { if (wr == 0) PG8_BAR; }
        if constexpr (!Epi::AFTER_DRAIN) { E(acc, cur, wr, wc, fr, fq); S.done(cur); }
        if (!has_next) break;
#pragma unroll
        for (int a = 0; a < 2; ++a)
#pragma unroll
            for (int b = 0; b < 2; ++b)
#pragma unroll
                for (int m = 0; m < 4; ++m)
#pragma unroll
                    for (int n = 0; n < 2; ++n) acc[a][b][m][n] = (f32x4){0.f, 0.f, 0.f, 0.f};
        cur = nxt; cA = nA; cB = nB; ++ui;
        if constexpr (ALIGN_EPI) { if (wr == 1) PG8_BAR; }
    }
    PG8_WAIT_V(0);
    if constexpr (!ALIGN_EPI) { if (wr == 0) PG8_BAR; }
    PG8_BAR;
    if constexpr (Epi::AFTER_DRAIN) { E.fused(acc, cur, wr, wc, fr, fq, lds, wid, lane); S.done(cur); }
#undef PG8_SA
#undef PG8_SB
#undef PG8_STAGE
#undef PG8_LDA
#undef PG8_LDB
#undef PG8_MMA
#undef PG8_WAIT_V
#undef PG8_WAIT_L
#undef PG8_BAR
#undef PG8_SCHED
}
}

namespace att {
using bf16x8 = __attribute__((ext_vector_type(8))) short;
using s16x4  = __attribute__((ext_vector_type(4))) short;
using f32x16 = __attribute__((ext_vector_type(16))) float;
using u32x4  = __attribute__((ext_vector_type(4))) unsigned;
constexpr int NW = 8, QBLK = 32, KVBLK = 64, DV = 128;
#define ATT_SBAR() __builtin_amdgcn_sched_barrier(0)
__device__ __forceinline__ int crow(int r, int hi) { return (r & 3) + 8 * (r >> 2) + 4 * hi; }
__device__ __forceinline__ unsigned cvtpk(float lo, float hi) { unsigned r; asm volatile("v_cvt_pk_bf16_f32 %0, %1, %2" : "=v"(r) : "v"(lo), "v"(hi)); return r; }
template <int DQK> __device__ __forceinline__ int kswz(int row, int colB) { return row * (DQK * 2) + (colB ^ ((row & 7) << 4)); }
constexpr float THR = 8.f;

template <int DQK> struct Cfg {
    static constexpr int SHM_V = KVBLK * DV * 2, SHM_K = KVBLK * DQK * 2;
    static constexpr int OFF_V = 0, OFF_K = 2 * SHM_V, OFF_WS = OFF_K + 2 * SHM_K, OFF_BIAS = OFF_WS + NW * 64 * 4, LDS_BYTES = OFF_BIAS + 10240;
    static constexpr int KCH = DQK / 8;
    static constexpr int KLD = (64 * KCH) / 512;
};

struct Job {
    const bf16_t* Q;
    const bf16_t* K;
    const bf16_t* V;
    bf16_t* O;
    int nt;
    int seg0_tiles, row_seg0, row_seg1;
    int R0; int rlo;
};

__device__ __forceinline__ int tile_row(const Job& J, int j) {
    if (j < J.seg0_tiles) return J.row_seg0 + 64 * j;
    int jj = j - J.seg0_tiles; if (jj > 3) jj = 0; return J.row_seg1 + 64 * jj;
}

__device__ __forceinline__ void partialSM(f32x16& p0, f32x16& p1, float& m_reg, float& mn, float& alpha, float C, float thr_raw) {
    float pmax = p0[0];
#pragma unroll
    for (int r = 1; r < 16; ++r) pmax = fmaxf(pmax, p0[r]);
#pragma unroll
    for (int r = 0; r < 16; ++r) pmax = fmaxf(pmax, p1[r]);
    { auto rr = __builtin_amdgcn_permlane32_swap(__float_as_uint(pmax), __float_as_uint(pmax), false, false);
      pmax = fmaxf(__uint_as_float(rr[0]), __uint_as_float(rr[1])); }
    if (__builtin_expect(__all(pmax - m_reg <= thr_raw), 1)) { mn = m_reg; alpha = 1.f; }
    else { mn = fmaxf(m_reg, pmax); alpha = __builtin_amdgcn_exp2f((m_reg - mn) * C); m_reg = mn; }
    const float mnC = -mn * C;
#pragma unroll
    for (int r = 0; r < 16; ++r) p0[r] = fmaf(p0[r], C, mnC);
#pragma unroll
    for (int r = 0; r < 16; ++r) p1[r] = fmaf(p1[r], C, mnC);
#pragma unroll
    for (int r = 0; r < 16; ++r) p0[r] = __builtin_amdgcn_exp2f(p0[r]);
}
__device__ __forceinline__ void finishSM(f32x16& p0, f32x16& p1, float alpha, float& l_reg, bf16x8& pa0, bf16x8& pa1, bf16x8& pa2, bf16x8& pa3) {
#pragma unroll
    for (int r = 0; r < 16; ++r) p1[r] = __builtin_amdgcn_exp2f(p1[r]);
    float ps = 0;
#pragma unroll
    for (int r = 0; r < 16; ++r) ps += p0[r];
#pragma unroll
    for (int r = 0; r < 16; ++r) ps += p1[r];
    { auto rr = __builtin_amdgcn_permlane32_swap(__float_as_uint(ps), __float_as_uint(ps), false, false);
      ps = __uint_as_float(rr[0]) + __uint_as_float(rr[1]); }
    l_reg = l_reg * alpha + ps;
#define ATT_PK4(P, BASE, OUT) do { unsigned a0 = cvtpk(P[BASE + 0], P[BASE + 1]), a1 = cvtpk(P[BASE + 2], P[BASE + 3]);   \
    unsigned b0 = cvtpk(P[BASE + 4], P[BASE + 5]), b1 = cvtpk(P[BASE + 6], P[BASE + 7]);                              \
    auto r0 = __builtin_amdgcn_permlane32_swap(a0, b0, false, false); auto r1 = __builtin_amdgcn_permlane32_swap(a1, b1, false, false); \
    u32x4 w = {r0[0], r1[0], r0[1], r1[1]}; OUT = *reinterpret_cast<bf16x8*>(&w); } while (0)
    ATT_PK4(p0, 0, pa0); ATT_PK4(p0, 8, pa1); ATT_PK4(p1, 0, pa2); ATT_PK4(p1, 8, pa3);
#undef ATT_PK4
}
template <int DQK> __device__ __forceinline__ void qkt(f32x16& p0, f32x16& p1, const char* Ks, const bf16x8* qr, int r32, int hi) {
    p0 = f32x16{}; p1 = f32x16{};
#pragma unroll
    for (int d0 = 0; d0 < DQK / 16; ++d0) { const int cb = (d0 * 16 + hi * 8) * 2;
        const bf16x8 b0 = *reinterpret_cast<const bf16x8*>(Ks + kswz<DQK>(r32, cb));
        const bf16x8 b1 = *reinterpret_cast<const bf16x8*>(Ks + kswz<DQK>(32 + r32, cb));
        p0 = __builtin_amdgcn_mfma_f32_32x32x16_bf16(b0, qr[d0], p0, 0, 0, 0);
        p1 = __builtin_amdgcn_mfma_f32_32x32x16_bf16(b1, qr[d0], p1, 0, 0, 0); }
}
__device__ __forceinline__ int v_st(int k, int c) { const int kk = (k & ~0xC) | ((k & 4) << 1) | ((k & 8) >> 1); return ((kk >> 3) * 4 + (c >> 5)) * 512 + ((kk & 7) * 32 + (c & 31)) * 2; }
__device__ __forceinline__ int v_rd_base(int lane) { return ((lane & 3) << 3) | (((lane >> 2) & 3) << 6) | (((lane >> 4) & 1) << 5) | (((lane >> 5) & 1) << 8); }
constexpr int v_rd_off(int d0, int ks, int half) { return d0 * 512 + ks * 4096 + half * 2048; }
template <int OFF> __device__ __forceinline__ s16x4 tr_read(int vb) { s16x4 r; asm volatile("ds_read_b64_tr_b16 %0, %1 offset:%2" : "=&v"(r) : "v"(vb), "i"(OFF) : "memory"); return r; }
template <int D0> __device__ __forceinline__ void pv_one(f32x16& od, int vb, bf16x8 pa0, bf16x8 pa1, bf16x8 pa2, bf16x8 pa3) {
    const s16x4 l0 = tr_read<v_rd_off(D0, 0, 0)>(vb), h0 = tr_read<v_rd_off(D0, 0, 1)>(vb), l1 = tr_read<v_rd_off(D0, 1, 0)>(vb), h1 = tr_read<v_rd_off(D0, 1, 1)>(vb);
    const s16x4 l2 = tr_read<v_rd_off(D0, 2, 0)>(vb), h2 = tr_read<v_rd_off(D0, 2, 1)>(vb), l3 = tr_read<v_rd_off(D0, 3, 0)>(vb), h3 = tr_read<v_rd_off(D0, 3, 1)>(vb);
    asm volatile("s_waitcnt lgkmcnt(0)" ::: "memory"); ATT_SBAR();
#define ATT_PK(L, H) (bf16x8){L[0], L[1], L[2], L[3], H[0], H[1], H[2], H[3]}
    od = __builtin_amdgcn_mfma_f32_32x32x16_bf16(pa0, ATT_PK(l0, h0), od, 0, 0, 0);
    od = __builtin_amdgcn_mfma_f32_32x32x16_bf16(pa1, ATT_PK(l1, h1), od, 0, 0, 0);
    od = __builtin_amdgcn_mfma_f32_32x32x16_bf16(pa2, ATT_PK(l2, h2), od, 0, 0, 0);
    od = __builtin_amdgcn_mfma_f32_32x32x16_bf16(pa3, ATT_PK(l3, h3), od, 0, 0, 0);
#undef ATT_PK
}
__device__ __forceinline__ void pv_d0(f32x16* o, int vb, bf16x8 pa0, bf16x8 pa1, bf16x8 pa2, bf16x8 pa3) {
    pv_one<0>(o[0], vb, pa0, pa1, pa2, pa3); pv_one<1>(o[1], vb, pa0, pa1, pa2, pa3); pv_one<2>(o[2], vb, pa0, pa1, pa2, pa3); pv_one<3>(o[3], vb, pa0, pa1, pa2, pa3);
}
constexpr int NA_BROW = 160, NA_BORG = 64 + (NA_KW - 1);
__device__ __forceinline__ void na_bias(f32x16& p0, f32x16& p1, const Job& J, int j, int R, int c, int hi, const float* biasq) {
    const int nloc = J.seg0_tiles;
    if (j >= nloc && j < nloc + 4) return;
    const int rr = J.rlo + j; int r0 = R - NA_KH / 2; r0 = r0 < 0 ? 0 : (r0 > ROWS - NA_KH ? ROWS - NA_KH : r0);
    const bool rowok = (j < nloc) && rr >= r0 && rr < r0 + NA_KH;
    if (!rowok) {
#pragma unroll
        for (int r = 0; r < 16; ++r) { p0[r] = -1e30f; p1[r] = -1e30f; }
        return; }
    int c0 = c - NA_KW / 2; c0 = c0 < 0 ? 0 : (c0 > GRID_W - NA_KW ? GRID_W - NA_KW : c0);
    const int dr = rr - R + (NA_KH - 1);
    const float* bl = biasq + dr * NA_BROW + NA_BORG + 4 * hi - c;
    const int vb = 4 * hi - c0;
#pragma unroll
    for (int r = 0; r < 16; ++r) { const int cc = (r & 3) + 8 * (r >> 2);
        p0[r] = ((unsigned)(cc + vb) < (unsigned)NA_KW) ? p0[r] + bl[cc] : -1e30f;
        p1[r] = ((unsigned)(cc + 32 + vb) < (unsigned)NA_KW) ? p1[r] + bl[cc + 32] : -1e30f; }
}

#define ATT_LAS __attribute__((address_space(3)))
template <int DQK, bool NA, int LDQ, int LDK, int LDV, int LDO>
__device__ __forceinline__ void attn_unit(const Job& J, char* lds, const float scale, const int tid_in) {
    using C_ = Cfg<DQK>;
    int tid_ = tid_in; asm volatile("" : "+v"(tid_));
    const int tid = tid_, wid = __builtin_amdgcn_readfirstlane(tid >> 6), lane = tid & 63, r32 = lane & 31, hi = lane >> 5;
    char* V_lds = lds + C_::OFF_V; char* K_lds = lds + C_::OFF_K;
    const unsigned ldsb = (unsigned)(uintptr_t)lds;
    float* wsf = (float*)(lds + C_::OFF_WS) + wid * 64; float* li_l = wsf; float* al_l = wsf + 32;
    const float* biasq = (const float*)(lds + C_::OFF_BIAS);
    const float Cc = scale * 1.4426950408889634f, thr_raw = THR / scale;
    float m_reg = -1e5f, l_reg = 0; f32x16 o[4] = {}; bf16x8 qr[DQK / 16];
    const bf16_t* Qw = J.Q + (long)(wid * QBLK + r32) * LDQ + hi * 8;
#pragma unroll
    for (int d0 = 0; d0 < DQK / 16; ++d0) qr[d0] = *reinterpret_cast<const bf16x8*>(Qw + d0 * 16);
    const int naR = J.R0 + (wid >> 1), nac = (wid & 1) * 32 + r32;
    const int vb0 = (int)(uintptr_t)V_lds + v_rd_base(lane);
    unsigned koff[C_::KLD], voff[2];
#pragma unroll
    for (int i = 0; i < C_::KLD; ++i) { const int sl = 512 * i + tid, row = sl / C_::KCH, cs = sl % C_::KCH, chunk = (cs & ~7) | ((cs & 7) ^ (row & 7)); koff[i] = (unsigned)(row * LDK * 2 + chunk * 16); }
#pragma unroll
    for (int i = 0; i < 2; ++i) { const int sl = 512 * i + tid, sub = sl >> 5, wi = sl & 31, kk = (sub >> 2) * 8 + (wi >> 2), k = (kk & ~0xC) | ((kk & 4) << 1) | ((kk & 8) >> 1), c = (sub & 3) * 32 + (wi & 3) * 8;
        voff[i] = (unsigned)(k * LDV * 2 + c * 2); }
#define ATT_STAGE(j, b) do { const int row0_ = tile_row(J, (j)); const char* vp_ = (const char*)(J.V + (size_t)row0_ * LDV); const char* kp_ = (const char*)(J.K + (size_t)row0_ * LDK); \
        _Pragma("unroll") for (int i_ = 0; i_ < C_::KLD; ++i_) __builtin_amdgcn_global_load_lds((const unsigned*)(kp_ + koff[i_]), (ATT_LAS unsigned*)(ldsb + C_::OFF_K + (b) * C_::SHM_K + (512 * i_ + 64 * wid) * 16), 16, 0, 0); \
        _Pragma("unroll") for (int i_ = 0; i_ < 2; ++i_) __builtin_amdgcn_global_load_lds((const unsigned*)(vp_ + voff[i_]), (ATT_LAS unsigned*)(ldsb + C_::OFF_V + (b) * C_::SHM_V + (512 * i_ + 64 * wid) * 16), 16, 0, 0); } while (0)
    const int NT = J.nt;
    __syncthreads();
    ATT_STAGE(0, 0); asm volatile("s_waitcnt vmcnt(0)" ::: "memory"); __syncthreads();
    for (int j = 0; j < NT; ++j) {
        const int buf = j & 1;
        if (j + 1 < NT) ATT_STAGE(j + 1, buf ^ 1);
        bool live = true;
        if (NA) { const int nloc = J.seg0_tiles; if (j >= nloc + 4) live = false; else if (j < nloc) { const int rr = J.rlo + j; int r0 = naR - NA_KH / 2; r0 = r0 < 0 ? 0 : (r0 > ROWS - NA_KH ? ROWS - NA_KH : r0); live = rr >= r0 && rr < r0 + NA_KH; } }
        if (live) {
        f32x16 p0, p1; float mn, al; bf16x8 pa0, pa1, pa2, pa3;
        qkt<DQK>(p0, p1, K_lds + buf * C_::SHM_K, qr, r32, hi);
        if (NA) na_bias(p0, p1, J, j, naR, nac, hi, biasq);
        partialSM(p0, p1, m_reg, mn, al, Cc, thr_raw);
        finishSM(p0, p1, al, l_reg, pa0, pa1, pa2, pa3);
        if (__any(al < 1.f)) { if (hi == 0) al_l[r32] = al; asm volatile("s_waitcnt lgkmcnt(0)" ::: "memory");
#pragma unroll
            for (int d = 0; d < 4; ++d)
#pragma unroll
                for (int r = 0; r < 16; ++r) o[d][r] *= al_l[crow(r, hi)]; }
        ATT_SBAR();
        pv_d0(o, vb0 + buf * C_::SHM_V, pa0, pa1, pa2, pa3);
        }
        asm volatile("s_waitcnt vmcnt(0)" ::: "memory");
        __syncthreads();
    }
    if (hi == 0) li_l[r32] = l_reg; asm volatile("s_waitcnt lgkmcnt(0)" ::: "memory");
    float rli[16];
#pragma unroll
    for (int r = 0; r < 16; ++r) rli[r] = __builtin_amdgcn_rcpf(li_l[crow(r, hi)]);
    bf16_t* Ow = J.O + (long)(wid * QBLK) * LDO;
#pragma unroll
    for (int r = 0; r < 16; ++r) { const int orow = crow(r, hi);
#pragma unroll
        for (int d0 = 0; d0 < 4; ++d0) Ow[(long)orow * LDO + d0 * 32 + r32] = f2bf(o[d0][r] * rli[r]); }
#undef ATT_STAGE
}
}

struct AttnArgs { const bf16_t *QM, *KM, *VM, *NQ, *NK, *P; bf16_t* Y; const float* rpb; int want_ctx; int pad; };
__device__ __forceinline__ void attention_phase(const AttnArgs& A, char* lds, int G, int wg, const int tid, const int nskip) {
    static_assert(GRID_W == 64 && SEQ % 256 == 0 && CTX_LEN == 256 && HD == 128, "attention phase geometry");
    constexpr int NQB = SEQ / 256;
    constexpr float sc_mla = 0.07216878364870323f, sc_na = 0.08838834764831845f;
    static_assert(MLA_QK == 192 && HD == 128, "softmax scales");
    if (!(A.pad & 2)) for (int u = wg; u < BATCH * NH * NQB; u += G) {
        const int bh = u % (BATCH * NH), qb = u / (BATCH * NH), b = bh / NH, h = bh % NH;
        att::Job J{};
        J.Q = A.QM + (size_t)(b * SEQ + qb * 256) * NQ_MLA + h * MLA_QK; J.K = A.KM + h * MLA_QK; J.V = A.VM + h * MLA_V;
        J.O = A.Y + (size_t)(b * SEQ + qb * 256) * D_MODEL + GROUP_W + h * MLA_V;
        J.nt = SEQ / 64 + CTX_LEN / 64; J.seg0_tiles = SEQ / 64; J.row_seg0 = b * SEQ; J.row_seg1 = M_LAT + b * CTX_LEN;
        att::attn_unit<MLA_QK, false, NQ_MLA, NQ_MLA, NH * MLA_V, D_MODEL>(J, lds, sc_mla, tid);
    }
    const int G2n = G - nskip, c2 = wg - nskip;
    if (!(A.pad & 4) && c2 >= 0) for (int u = c2; u < BATCH * NH * NQB; u += G2n) {
        const int bh = u % (BATCH * NH), qb = u / (BATCH * NH), b = bh / NH, h = bh % NH, R0 = qb * 4;
        __syncthreads();
        { float* bq = (float*)(lds + att::Cfg<HD>::OFF_BIAS); const float* src = A.rpb + (size_t)h * (2 * NA_KH - 1) * (2 * NA_KW - 1);
          for (int i = tid; i < (2 * NA_KH - 1) * att::NA_BROW; i += 512) { const int dr = i / att::NA_BROW; int dc = i % att::NA_BROW - att::NA_BORG + (NA_KW - 1); dc = dc < 0 ? 0 : (dc > 2 * NA_KW - 2 ? 2 * NA_KW - 2 : dc);
              bq[i] = src[dr * (2 * NA_KW - 1) + dc] * 11.313708498984761f; } }
        int rlo = R0 - NA_KH / 2; rlo = rlo < 0 ? 0 : (rlo > ROWS - NA_KH ? ROWS - NA_KH : rlo);
        int rhi = R0 + 3 - NA_KH / 2; rhi = (rhi < 0 ? 0 : (rhi > ROWS - NA_KH ? ROWS - NA_KH : rhi)) + NA_KH - 1;
        const int nloc = rhi - rlo + 1;
        att::Job J{};
        J.Q = A.NQ + (size_t)(b * SEQ + R0 * 64) * GROUP_W + h * HD; J.K = A.NK + h * HD; J.V = A.P + C_NV + h * HD;
        J.O = A.Y + (size_t)(b * SEQ + R0 * 64) * D_MODEL + 3 * GROUP_W + h * HD;
        J.nt = (nloc + 4 + 1) & ~1; J.seg0_tiles = nloc; J.row_seg0 = b * SEQ + rlo * 64; J.row_seg1 = M_LAT + b * CTX_LEN;  J.R0 = R0; J.rlo = rlo;
        att::attn_unit<HD, true, GROUP_W, GROUP_W, NP, D_MODEL>(J, lds, sc_na, tid);
    }
    if (A.want_ctx && !(A.pad & 8)) {
        for (int u = c2 - 64; u >= 0 && u < BATCH * NH; u += G) {
            const int b = u / NH, h = u % NH; const int crow0 = M_LAT + b * CTX_LEN;
            att::Job J{}; J.nt = CTX_LEN / 64; J.seg0_tiles = 0; J.row_seg0 = crow0; J.row_seg1 = crow0;
            J.Q = A.QM + (size_t)crow0 * NQ_MLA + h * MLA_QK; J.K = A.KM + h * MLA_QK; J.V = A.VM + h * MLA_V;
            J.O = A.Y + (size_t)crow0 * D_MODEL + GROUP_W + h * MLA_V; att::attn_unit<MLA_QK, false, NQ_MLA, NQ_MLA, NH * MLA_V, D_MODEL>(J, lds, sc_mla, tid);
        }
        for (int u = c2 - 64 - BATCH * NH; u >= 0 && u < BATCH * NH; u += G) {
            const int b = u / NH, h = u % NH; const int crow0 = M_LAT + b * CTX_LEN;
            att::Job J{}; J.nt = CTX_LEN / 64; J.seg0_tiles = 0; J.row_seg0 = crow0; J.row_seg1 = crow0;
            J.Q = A.NQ + (size_t)crow0 * GROUP_W + h * HD; J.K = A.NK + h * HD; J.V = A.P + C_NV + h * HD;
            J.O = A.Y + (size_t)crow0 * D_MODEL + 3 * GROUP_W + h * HD; att::attn_unit<HD, false, GROUP_W, GROUP_W, NP, D_MODEL>(J, lds, sc_na, tid);
        }
    }
}

namespace gdn {
typedef short bf16x8 __attribute__((ext_vector_type(8)));
typedef float f32x4 __attribute__((ext_vector_type(4)));
typedef float f32x16 __attribute__((ext_vector_type(16)));
typedef unsigned u32x2 __attribute__((ext_vector_type(2)));
typedef unsigned u32x4 __attribute__((ext_vector_type(4)));
constexpr int CH = 64, NCHUNK = M_ALL / CH;
constexpr int NTASK = NCHUNK * NH * 2;
constexpr size_t SZ_UT = 128 * 64, SZ_WP = 64 * 128, SZ_KDT = 128 * 64, SZ_QD = 64 * 128, SZ_QK = 64 * 64, SZ_SIT = 128 * 128, SZ_VNT = 128 * 64;
struct Bufs { bf16_t *UT, *WP, *KDT, *QD, *QK, *SIT, *VNT; float* GT; };
__device__ __forceinline__ int perm32(int o) { return (o & ~31) | (((o & 15) >> 2) * 8 + ((o >> 4) & 1) * 4 + (o & 3)); }
__device__ __forceinline__ unsigned pk2(float lo, float hi) { return (unsigned)f2bf(lo) | ((unsigned)f2bf(hi) << 16); }

constexpr int QS = 132;
constexpr int AS = 68;
constexpr int G1_OFF_Q = 0, G1_OFF_K = G1_OFF_Q + CH * QS * 4, G1_OFF_V = G1_OFF_K + CH * QS * 4, G1_OFF_AA = G1_OFF_V + CH * QS * 4, G1_OFF_SM = G1_OFF_AA + 2 * CH * AS * 4,
              G1_LDS = G1_OFF_SM + 12 * 64 * 4;
struct G1Args { const bf16_t* P; const float* conv_w; const float* a_log; const float* dt_bias; Bufs B; int pflags; };

__device__ __forceinline__ void g1_task(const G1Args& A, char* lds, int cix, int h, const int tid_in) {
    int tid_ = tid_in; asm volatile("" : "+v"(tid_));
    const int tid = tid_, wid = __builtin_amdgcn_readfirstlane(tid >> 6), lane = tid & 63;
    float* Qs = (float*)(lds + G1_OFF_Q); float* Ks = (float*)(lds + G1_OFF_K); float* Vs = (float*)(lds + G1_OFF_V); float* AA = (float*)(lds + G1_OFF_AA);
    float* sm = (float*)(lds + G1_OFF_SM); float* g_s = sm;   float* beta_s = sm + 128;   float* gc_s = sm + 256;
    const int row0 = cix * CH; const RowInfo r0i = row_info(row0);
    LDS_BARRIER();
    if (tid < 48 * 8) {
        const int grp = tid % 48, ts = tid / 48, which = grp >> 4, cc0 = (grp & 15) * 8, ch0 = which * GROUP_W + h * HD + cc0;
        float wgt[4][8];
#pragma unroll
        for (int j = 0; j < 4; ++j) { const f32x4 w0 = *(const f32x4*)(A.conv_w + j * 3 * GROUP_W + ch0), w1 = *(const f32x4*)(A.conv_w + j * 3 * GROUP_W + ch0 + 4);
#pragma unroll
            for (int e = 0; e < 4; ++e) { wgt[j][e] = w0[e]; wgt[j][4 + e] = w1[e]; } }
        u32x4 xr[11];
#pragma unroll
        for (int k = 0; k < 11; ++k) { const int tt = r0i.t + 8 * ts + k - 1;
            xr[k] = (tt >= 0 && tt < r0i.T && !(A.pflags & 4096)) ? *(const u32x4*)(A.P + (size_t)(r0i.base + tt) * NP + C_GQ + ch0) : (u32x4){0u, 0u, 0u, 0u}; }
        float* dstp = (which == 0 ? Qs : which == 1 ? Ks : Vs) + cc0;
#pragma unroll
        for (int i = 0; i < 8; ++i) { float acc[8];
#pragma unroll
            for (int e = 0; e < 8; ++e) acc[e] = 0.f;
#pragma unroll
            for (int j = 0; j < 4; ++j) { const u32x4 xv = xr[i + j];
#pragma unroll
                for (int e = 0; e < 4; ++e) { acc[2 * e] += wgt[j][2 * e] * bflo(xv[e]); acc[2 * e + 1] += wgt[j][2 * e + 1] * bfhi(xv[e]); } }
            f32x4 y0, y1;
#pragma unroll
            for (int e = 0; e < 4; ++e) { y0[e] = acc[e] * __builtin_amdgcn_rcpf(1.0f + __expf(-acc[e])); y1[e] = acc[4 + e] * __builtin_amdgcn_rcpf(1.0f + __expf(-acc[4 + e])); }
            *(f32x4*)(dstp + (8 * ts + i) * QS) = y0; *(f32x4*)(dstp + (8 * ts + i) * QS + 4) = y1; }
    }
    if (tid < 128) { const int d = tid >> 6, i = tid & 63; const size_t r = (size_t)(row0 + i) * NP;
        beta_s[d * 64 + i] = 1.0f / (1.0f + __expf(-bf2f(A.P[r + C_GB + d * NH + h])));
        g_s[d * 64 + i] = -__expf(A.a_log[d * NH + h]) * softplusf_(bf2f(A.P[r + C_GA + d * NH + h]) + A.dt_bias[d * NH + h]); }
    LDS_BARRIER();
    for (int rr = wid * 4 + (lane >> 4); rr < 2 * CH; rr += 32) { float* rowp = (rr < CH ? Qs : Ks) + (rr & 63) * QS + (lane & 15) * 8;
        f32x4 a = *(const f32x4*)rowp, b = *(const f32x4*)(rowp + 4); float ss = (a[0] * a[0] + a[1] * a[1]) + (a[2] * a[2] + a[3] * a[3]) + (b[0] * b[0] + b[1] * b[1]) + (b[2] * b[2] + b[3] * b[3]);
#pragma unroll
        for (int o = 1; o < 16; o <<= 1) ss += lane_xor(ss, o, lane);
        const float scl = __builtin_amdgcn_rsqf(ss + EPS) * (rr < CH ? 0.08838834764831845f : 1.0f);
        *(f32x4*)rowp = a * scl; *(f32x4*)(rowp + 4) = b * scl; }
    if (tid < 2) {
        f32x4 gv[16];
#pragma unroll
        for (int m = 0; m < 16; ++m) gv[m] = *(const f32x4*)(g_s + tid * 64 + 4 * m);
        float run = 0.f;
        if (tid == 0) {
#pragma unroll
            for (int m = 0; m < 16; ++m) { f32x4 o4;
#pragma unroll
                for (int e = 0; e < 4; ++e) { run += gv[m][e]; o4[e] = run; }
                *(f32x4*)(gc_s + 4 * m) = o4; }
        } else {
#pragma unroll
            for (int m = 15; m >= 0; --m) { f32x4 o4;
#pragma unroll
                for (int e = 3; e >= 0; --e) { run += gv[m][e]; o4[e] = run; }
                *(f32x4*)(gc_s + 64 + 4 * m) = o4; }
        }
    }
    LDS_BARRIER();
    float* eq_s = sm + 384; float* ek_s = sm + 512;
    if (tid < 128) { const int d = tid >> 6, i = tid & 63; const float gci = gc_s[d * 64 + i], glast = d == 0 ? gc_s[63] : gc_s[64];
        eq_s[tid] = __expf(gci); ek_s[tid] = __expf(glast - gci); }
    const int gwhich = wid >> 2, gI = (wid >> 1) & 1, gJ = wid & 1, r32 = lane & 31, hi = lane >> 5;
    f32x16 acc = {};
    if (!(A.pflags & 1024)) {
        const float* X = (gwhich ? Qs : Ks) + (32 * gI + r32) * QS + 4 * hi; const float* Yp = Ks + (32 * gJ + r32) * QS + 4 * hi;
#pragma unroll
        for (int s = 0; s < 16; ++s) { const f32x4 a4 = *(const f32x4*)(X + 8 * s), b4 = *(const f32x4*)(Yp + 8 * s);
#pragma unroll
            for (int e = 0; e < 4; ++e) acc = __builtin_amdgcn_mfma_f32_32x32x2f32(a4[e], b4[e], acc, 0, 0, 0); }
        const int j = 32 * gJ + r32;
        if (gwhich == 0) {
            const float b1j = beta_s[64 + j], g0j = gc_s[j], g1j = gc_s[64 + j];
#pragma unroll
            for (int r = 0; r < 16; ++r) { const int i = 32 * gI + (r & 3) + 8 * (r >> 2) + 4 * hi;
                if (i > j) { const float kk = acc[r];
                    AA[(63 - j) * AS + (63 - i)] = beta_s[i] * kk * __expf(gc_s[i] - g0j);
                    AA[CH * AS + i * AS + j] = b1j * kk * __expf(g1j - gc_s[64 + i]); } }
        }
    }
    LDS_BARRIER();
    const size_t t0 = ((size_t)cix * NH + h) * 2;
    if (!(A.pflags & 2048)) {
#pragma unroll
        for (int n = 0; n < 4; ++n) { const int it = tid + 512 * n, d = it >> 10, p = (it >> 4) & 63, m = it & 15, i = d == 0 ? p : 63 - p, k0 = 32 * (m >> 2) + 4 * (m & 3);
            const float e = eq_s[d * 64 + i]; const f32x4 lo = *(const f32x4*)(Qs + i * QS + k0), hi4 = *(const f32x4*)(Qs + i * QS + k0 + 16);
            *(u32x4*)(A.B.QD + (t0 + d) * SZ_QD + (size_t)p * 128 + m * 8) = (u32x4){pk2(lo[0] * e, lo[1] * e), pk2(lo[2] * e, lo[3] * e), pk2(hi4[0] * e, hi4[1] * e), pk2(hi4[2] * e, hi4[3] * e)}; }
#pragma unroll
        for (int n = 0; n < 4; ++n) { const int it = tid + 512 * n, k = it & 127, d = (it >> 7) & 1, m = it >> 8, p0 = 32 * (m >> 2) + 4 * (m & 3);
            float v[8];
#pragma unroll
            for (int jj = 0; jj < 8; ++jj) { const int p = p0 + (jj < 4 ? jj : 12 + jj), i = d == 0 ? p : 63 - p; v[jj] = Ks[i * QS + k] * ek_s[d * 64 + i]; }
            *(u32x4*)(A.B.KDT + (t0 + d) * SZ_KDT + (size_t)k * 64 + m * 8) = (u32x4){pk2(v[0], v[1]), pk2(v[2], v[3]), pk2(v[4], v[5]), pk2(v[6], v[7])}; }
        if (tid == 0) { A.B.GT[t0] = __expf(gc_s[63]); A.B.GT[t0 + 1] = __expf(gc_s[64]); }
    }
    LDS_BARRIER();
    bf16_t* stg = (bf16_t*)Qs;
    if (gwhich == 1) { const int j = 32 * gJ + r32; const float g0j = gc_s[j], g1j = gc_s[64 + j];
#pragma unroll
        for (int r = 0; r < 16; ++r) { const int i = 32 * gI + (r & 3) + 8 * (r >> 2) + 4 * hi; const float qk = acc[r];
            stg[i * 64 + perm32(j)] = f2bf(i >= j ? qk * __expf(gc_s[i] - g0j) : 0.f);
            stg[4096 + (63 - i) * 64 + perm32(63 - j)] = f2bf(i <= j ? qk * __expf(gc_s[64 + i] - g1j) : 0.f); } }
    LDS_BARRIER();
#pragma unroll
    for (int n = 0; n < 2; ++n) { const int c16 = tid + 512 * n; *(u32x4*)(A.B.QK + t0 * SZ_QK + (size_t)c16 * 8) = *(const u32x4*)(stg + c16 * 8); }
    if (!(A.pflags & 512)) {
        int tidv = tid; asm volatile("" : "+v"(tidv));
        const int d = tidv >> 8, c = tidv & 255; const bool isw = c >= 128; const int cc = c & 127;
        const float* src = isw ? Ks : Vs;
        int lz; asm volatile("v_mov_b32 %0, 0" : "=v"(lz));
        const float* AAv = AA + lz + d * (CH * AS);
        float x[CH];
#pragma unroll
        for (int p = 0; p < CH; ++p) { const int i = d == 0 ? p : 63 - p; float f = beta_s[d * 64 + i]; if (isw) f *= eq_s[d * 64 + i]; x[p] = f * src[i * QS + cc]; }
        {
#pragma unroll
            for (int p = 0; p < CH - 1; ++p) { const float xp = x[p]; const float* rowp = AAv + (63 - p) * AS;
#pragma unroll
                for (int m = 0; m <= (62 - p) / 4; ++m) { const f32x4 a4 = *(const f32x4*)(rowp + 4 * m);
#pragma unroll
                    for (int e = 0; e < 4; ++e) { const int col = 4 * m + e; if (col <= 62 - p) x[63 - col] -= a4[e] * xp; } } }
        }
        LDS_BARRIER();
        if (!isw) { bf16_t* dst = A.B.UT + (t0 + d) * SZ_UT + (size_t)((cc >> 4) * 2 * 64 + (cc & 15)) * 8;
#pragma unroll
            for (int s = 0; s < 2; ++s)
#pragma unroll
                for (int qq = 0; qq < 4; ++qq) { const int p0 = 32 * s + 4 * qq; u32x4 w4; w4.x = pk2(x[p0], x[p0 + 1]); w4.y = pk2(x[p0 + 2], x[p0 + 3]); w4.z = pk2(x[p0 + 16], x[p0 + 17]); w4.w = pk2(x[p0 + 18], x[p0 + 19]);
                    *(u32x4*)(dst + (size_t)(s * 64 + qq * 16) * 8) = w4; }
        } else { bf16_t* dst = stg + d * 8192 + perm32(cc);
#pragma unroll
            for (int p = 0; p < CH; ++p) dst[p * 128] = f2bf(x[p]); }
    }
    LDS_BARRIER();
#pragma unroll
    for (int n = 0; n < 4; ++n) { const int c16 = tid + 512 * n; *(u32x4*)(A.B.WP + t0 * SZ_WP + (size_t)c16 * 8) = *(const u32x4*)(stg + c16 * 8); }
}
__device__ __forceinline__ void g1_phase(const G1Args& A, char* lds, int G, int wg, const int tid) {
    for (int t = wg; t < NCHUNK * NH; t += G) g1_task(A, lds, t / NH, t % NH, tid);
}

constexpr int G2_SPLIT = 4, G2_NACT = 8 / G2_SPLIT, G2_NSTEP = CTX_LEN / CH + SEQ / CH, G2_WGS = BATCH * NH * 2 * G2_SPLIT;
constexpr int G2_USL = G2_NACT * 2 * 64 * 16;
constexpr int G2_BUF = 16384 + 16384 + G2_USL, G2_NB = 4, G2_LDS = G2_NB * G2_BUF;
static_assert(G2_SPLIT == 4 && G2_USL == 4096, "G2 staging map below assumes 4 KB of u per step");
__device__ __forceinline__ int g2_task_index(int b, int h, int d, int step) {
    constexpr int NC = CTX_LEN / CH, NL = SEQ / CH; int cix;
    if (step < NC) { const int n = d ? NC - 1 - step : step; cix = M_LAT / CH + b * NC + n; }
    else { const int s2 = step - NC, n = d ? NL - 1 - s2 : s2; cix = b * NL + n; }
    return (cix * NH + h) * 2 + d;
}
__device__ __forceinline__ void g2_chain(const Bufs& B, char* lds, int chain_part, const int tid_in, const int step_lo, const int step_hi, float* Ssave) {
    int tid_ = tid_in; asm volatile("" : "+v"(tid_));
    const int tid = tid_, wid = __builtin_amdgcn_readfirstlane(tid >> 6), lane = tid & 63, q = lane >> 4, vl = lane & 15;
    const int chain = chain_part / G2_SPLIT, part = chain_part % G2_SPLIT;
    const bool active = wid < G2_NACT; const int vt = part * G2_NACT + (active ? wid : 0);
    const int d = chain & 1, h = (chain >> 1) % NH, b = chain / (2 * NH);
    constexpr int NSTEP = CTX_LEN / CH + SEQ / CH;
    const unsigned ldsb = (unsigned)(uintptr_t)lds;
    f32x4 S[8];
    f32x4* sv = (f32x4*)Ssave + ((size_t)chain_part * G2_NACT + (active ? wid : 0)) * 8 * 64 + lane;
#pragma unroll
    for (int kb = 0; kb < 8; ++kb) S[kb] = (step_lo > 0 && active) ? sv[kb * 64] : (f32x4){0.f, 0.f, 0.f, 0.f};
    unsigned offw[2], offk[2], offu;
#pragma unroll
    for (int i = 0; i < 2; ++i) { const int sl = 128 * wid + 64 * i + lane;
        { const int row = sl >> 4, pc = sl & 15, c = pc ^ (row & 15); offw[i] = (unsigned)(row * 256 + c * 16); }
        { const int row = sl >> 3, pc = sl & 7, c = pc ^ ((row >> 1) & 7); offk[i] = (unsigned)(row * 128 + c * 16); } }
    offu = (unsigned)((part * G2_NACT * 2 * 64 + (wid & 3) * 64 + lane) * 16);
#define G2_DMA(ti, slot) do { const char* wp_ = (const char*)(B.WP + (size_t)(ti) * SZ_WP); const char* kp_ = (const char*)(B.KDT + (size_t)(ti) * SZ_KDT); const unsigned base_ = ldsb + (unsigned)(slot) * G2_BUF; \
        _Pragma("unroll") for (int i_ = 0; i_ < 2; ++i_) { \
            __builtin_amdgcn_global_load_lds((const unsigned*)(wp_ + offw[i_]), (ATT_LAS unsigned*)(base_ + (128 * wid + 64 * i_) * 16), 16, 0, 0); \
            __builtin_amdgcn_global_load_lds((const unsigned*)(kp_ + offk[i_]), (ATT_LAS unsigned*)(base_ + 16384 + (128 * wid + 64 * i_) * 16), 16, 0, 0); } \
        if (wid >= 4) __builtin_amdgcn_global_load_lds((const unsigned*)((const char*)(B.UT + (size_t)(ti) * SZ_UT) + offu), (ATT_LAS unsigned*)(base_ + 32768 + ((wid & 3) * 64) * 16), 16, 0, 0); } while (0)
#define G2_TI(step) g2_task_index(b, h, d, (step) < NSTEP ? (step) : NSTEP - 1)
    __syncthreads();
    G2_DMA(G2_TI(step_lo), step_lo & 3); G2_DMA(G2_TI(step_lo + 1), (step_lo + 1) & 3); G2_DMA(G2_TI(step_lo + 2), (step_lo + 2) & 3);
    asm volatile("s_waitcnt vmcnt(0)" ::: "memory");
    __syncthreads();
    for (int step = step_lo; step < step_hi; ++step) {
        const int ti = G2_TI(step), slot = step & 3;
        G2_DMA(G2_TI(step + 3), (step + 3) & 3);
        unsigned gtb; { const float* gp = B.GT + ti; asm volatile("s_load_dword %0, %1, 0x0" : "=s"(gtb) : "s"(gp)); }
        const char* wl = lds + slot * G2_BUF; const char* kl = wl + 16384; const char* ul = kl + 16384;
        if (active) {
            bf16x8 aw[16], ak[16];
#pragma unroll
            for (int rb = 0; rb < 4; ++rb)
#pragma unroll
                for (int s = 0; s < 4; ++s) aw[rb * 4 + s] = *(const bf16x8*)(wl + (16 * rb + vl) * 256 + (((4 * s + q) ^ vl) << 4));
#pragma unroll
            for (int kb = 0; kb < 8; ++kb)
#pragma unroll
                for (int s = 0; s < 2; ++s) ak[kb * 2 + s] = *(const bf16x8*)(kl + (16 * kb + vl) * 128 + (((4 * s + q) ^ ((vl >> 1) & 7)) << 4));
            u32x4 uu[2];
#pragma unroll
            for (int s = 0; s < 2; ++s) uu[s] = *(const u32x4*)(ul + ((wid * 2 + s) * 64 + lane) * 16);
            bf16_t* sit = B.SIT + (size_t)ti * SZ_SIT + (size_t)(vt * 4 * 64 + lane) * 8;
            bf16x8 sf[4];
#pragma unroll
            for (int s = 0; s < 4; ++s) { u32x4 w4; w4.x = pk2(S[2 * s][0], S[2 * s][1]); w4.y = pk2(S[2 * s][2], S[2 * s][3]); w4.z = pk2(S[2 * s + 1][0], S[2 * s + 1][1]); w4.w = pk2(S[2 * s + 1][2], S[2 * s + 1][3]);
                sf[s] = __builtin_bit_cast(bf16x8, w4); *(u32x4*)(sit + (size_t)s * 64 * 8) = w4; }
            __builtin_amdgcn_sched_barrier(0);
            f32x4 vn[4];
#pragma unroll
            for (int rb = 0; rb < 4; ++rb) vn[rb] = (f32x4){0.f, 0.f, 0.f, 0.f};
#pragma unroll
            for (int s = 0; s < 4; ++s)
#pragma unroll
                for (int rb = 0; rb < 4; ++rb) vn[rb] = __builtin_amdgcn_mfma_f32_16x16x32_bf16(aw[rb * 4 + s], sf[s], vn[rb], 0, 0, 0);
#pragma unroll
            for (int s = 0; s < 2; ++s) { const f32x4 a0 = vn[2 * s], a1 = vn[2 * s + 1];
                vn[2 * s][0] = bflo(uu[s].x) - a0[0]; vn[2 * s][1] = bfhi(uu[s].x) - a0[1]; vn[2 * s][2] = bflo(uu[s].y) - a0[2]; vn[2 * s][3] = bfhi(uu[s].y) - a0[3];
                vn[2 * s + 1][0] = bflo(uu[s].z) - a1[0]; vn[2 * s + 1][1] = bfhi(uu[s].z) - a1[1]; vn[2 * s + 1][2] = bflo(uu[s].w) - a1[2]; vn[2 * s + 1][3] = bfhi(uu[s].w) - a1[3]; }
            bf16_t* vnt = B.VNT + (size_t)ti * SZ_VNT + (size_t)(vt * 2 * 64 + lane) * 8;
            bf16x8 vf[2];
#pragma unroll
            for (int s = 0; s < 2; ++s) { u32x4 w4; w4.x = pk2(vn[2 * s][0], vn[2 * s][1]); w4.y = pk2(vn[2 * s][2], vn[2 * s][3]); w4.z = pk2(vn[2 * s + 1][0], vn[2 * s + 1][1]); w4.w = pk2(vn[2 * s + 1][2], vn[2 * s + 1][3]);
                vf[s] = __builtin_bit_cast(bf16x8, w4); *(u32x4*)(vnt + (size_t)s * 64 * 8) = w4; }
            asm volatile("s_waitcnt lgkmcnt(0)" ::: "memory");
            const float gt = __uint_as_float(gtb);
#pragma unroll
            for (int kb = 0; kb < 8; ++kb) S[kb] = S[kb] * gt;
#pragma unroll
            for (int s = 0; s < 2; ++s)
#pragma unroll
                for (int kb = 0; kb < 8; ++kb) S[kb] = __builtin_amdgcn_mfma_f32_16x16x32_bf16(ak[kb * 2 + s], vf[s], S[kb], 0, 0, 0);
            __builtin_amdgcn_sched_barrier(0);
            asm volatile("s_waitcnt vmcnt(26) lgkmcnt(0)\n\ts_barrier" ::: "memory");
        } else if (wid >= 4) {
            asm volatile("s_waitcnt vmcnt(10) lgkmcnt(0)\n\ts_barrier" ::: "memory");
        } else {
            asm volatile("s_waitcnt vmcnt(8) lgkmcnt(0)\n\ts_barrier" ::: "memory");
        }
    }
    if (step_hi < NSTEP && active) {
#pragma unroll
        for (int kb = 0; kb < 8; ++kb) sv[kb * 64] = S[kb]; }
    asm volatile("s_waitcnt vmcnt(0)" ::: "memory");
    __syncthreads();
#undef G2_DMA
#undef G2_TI
}

constexpr int G3_OS = 132, G3_LDS = 64 * G3_OS * 4;
struct G3Args { Bufs B; const bf16_t* P; const float* norm_g; bf16_t* Y; };
__device__ __forceinline__ void g3_task(const G3Args& A, char* lds, int cix, int h, const int tid_in) {
    int tid_ = tid_in; asm volatile("" : "+v"(tid_));
    const int tid = tid_, wid = __builtin_amdgcn_readfirstlane(tid >> 6), lane = tid & 63, q = lane >> 4, vl = lane & 15;
    f32x4 o[2][4];
#pragma unroll
    for (int d = 0; d < 2; ++d) {
        const size_t t = ((size_t)cix * NH + h) * 2 + d;
        const bf16_t* sit = A.B.SIT + t * SZ_SIT + (size_t)(wid * 4 * 64 + lane) * 8;
        const bf16_t* vnt = A.B.VNT + t * SZ_VNT + (size_t)(wid * 2 * 64 + lane) * 8;
        const bf16_t* qd = A.B.QD + t * SZ_QD + (size_t)vl * 128 + 8 * q;
        const bf16_t* qk = A.B.QK + t * SZ_QK + (size_t)vl * 64 + 8 * q;
        bf16x8 sf[4], vf[2];
#pragma unroll
        for (int s = 0; s < 4; ++s) sf[s] = *(const bf16x8*)(sit + (size_t)s * 64 * 8);
#pragma unroll
        for (int s = 0; s < 2; ++s) vf[s] = *(const bf16x8*)(vnt + (size_t)s * 64 * 8);
#pragma unroll
        for (int rb = 0; rb < 4; ++rb) { f32x4 acc = {0.f, 0.f, 0.f, 0.f};
#pragma unroll
            for (int s = 0; s < 4; ++s) acc = __builtin_amdgcn_mfma_f32_16x16x32_bf16(*(const bf16x8*)(qd + (size_t)rb * 16 * 128 + 32 * s), sf[s], acc, 0, 0, 0);
#pragma unroll
            for (int s = 0; s < 2; ++s) acc = __builtin_amdgcn_mfma_f32_16x16x32_bf16(*(const bf16x8*)(qk + (size_t)rb * 16 * 64 + 32 * s), vf[s], acc, 0, 0, 0);
            o[d][rb] = acc; }
    }
    f32x4 ot[4];
#pragma unroll
    for (int rb = 0; rb < 4; ++rb)
#pragma unroll
        for (int r = 0; r < 4; ++r) ot[rb][r] = o[0][rb][r] + lane_xor(o[1][3 - rb][3 - r], 48, lane);
    float* Ot = (float*)lds;
    LDS_BARRIER();
#pragma unroll
    for (int rb = 0; rb < 4; ++rb)
#pragma unroll
        for (int r = 0; r < 4; ++r) Ot[(16 * rb + 4 * q + r) * G3_OS + 16 * wid + vl] = ot[rb][r];
    LDS_BARRIER();
#pragma unroll
    for (int n = 0; n < 2; ++n) { const int item = tid + 512 * n, tok = item >> 4, c8 = (item & 15) * 8;
        const f32x4 o0 = *(const f32x4*)(Ot + tok * G3_OS + c8), o1 = *(const f32x4*)(Ot + tok * G3_OS + c8 + 4);
        float ss = (o0[0] * o0[0] + o0[1] * o0[1]) + (o0[2] * o0[2] + o0[3] * o0[3]) + (o1[0] * o1[0] + o1[1] * o1[1]) + (o1[2] * o1[2] + o1[3] * o1[3]);
#pragma unroll
        for (int of = 1; of < 16; of <<= 1) ss += lane_xor(ss, of, lane);
        const float rstd = __builtin_amdgcn_rsqf(ss * (1.0f / HD) + EPS);
        const f32x4 g0 = *(const f32x4*)(A.norm_g + c8), g1 = *(const f32x4*)(A.norm_g + c8 + 4);
        const size_t row = (size_t)cix * CH + tok; const u32x4 gw = *(const u32x4*)(A.P + row * NP + C_GG + h * HD + c8);
        float y[8];
#pragma unroll
        for (int e = 0; e < 4; ++e) { const float ga = bflo(gw[e]), gb = bfhi(gw[e]); const float oa = e < 2 ? o0[2 * e] : o1[2 * e - 4], ob = e < 2 ? o0[2 * e + 1] : o1[2 * e - 3];
            const float na = e < 2 ? g0[2 * e] : g1[2 * e - 4], nb = e < 2 ? g0[2 * e + 1] : g1[2 * e - 3];
            y[2 * e] = oa * rstd * na * (ga * __builtin_amdgcn_rcpf(1.0f + __expf(-ga))); y[2 * e + 1] = ob * rstd * nb * (gb * __builtin_amdgcn_rcpf(1.0f + __expf(-gb))); }
        *(u32x4*)(A.Y + row * D_MODEL + 2 * GROUP_W + h * HD + c8) = (u32x4){pk2(y[0], y[1]), pk2(y[2], y[3]), pk2(y[4], y[5]), pk2(y[6], y[7])};
    }
}
__device__ __forceinline__ void g3_phase(const G3Args& A, char* lds, int G, int wg, const int tid) {
    for (int t = wg; t < NCHUNK * NH; t += G) g3_task(A, lds, t / NH, t % NH, tid);
}
}

namespace lru {
typedef short bf16x8 __attribute__((ext_vector_type(8)));
typedef float f32x4 __attribute__((ext_vector_type(4)));
typedef unsigned u32x2 __attribute__((ext_vector_type(2)));
typedef unsigned u32x4 __attribute__((ext_vector_type(4)));
constexpr int CH = 64, NCHUNK = M_ALL / CH;
constexpr int US = 129;
constexpr int UBS = 272;
constexpr int L_OFF_U = 0, L_OFF_UB = CH * US * 4, L_LDS = L_OFF_UB + CH * UBS;
constexpr size_t SZ_WBLK = (size_t)LRU_BW * LRU_BW;
struct Bufs { bf16_t* HLOC; bf16_t* ACUM; float* LSUM; float* HIN; };
struct LocalArgs { const bf16_t* P; const float* conv_w; const float* conv_b; const bf16_t* WG;   const float* ba; const float* bx; const float* lam; Bufs B; };

__device__ __forceinline__ unsigned pk2(float lo, float hi) { return (unsigned)f2bf(lo) | ((unsigned)f2bf(hi) << 16); }

__device__ __forceinline__ void local_task(const LocalArgs& A, char* lds, int cix, int nb, const int tid_in) {
    int tid_ = tid_in; asm volatile("" : "+v"(tid_));
    const int tid = tid_, wid = __builtin_amdgcn_readfirstlane(tid >> 6), lane = tid & 63, q = lane >> 4, tl = lane & 15;
    float* Us = (float*)(lds + L_OFF_U); char* Ub = lds + L_OFF_UB;
    const int row0 = cix * CH; const RowInfo r0i = row_info(row0);
    LDS_BARRIER();
    {
        const int grp = tid & 15, t2 = tid >> 4, c0 = grp * 8, ch0 = nb * LRU_BW + c0;
        float wgt[4][8], bia[8];
#pragma unroll
        for (int j = 0; j < 4; ++j) { const f32x4 w0 = *(const f32x4*)(A.conv_w + j * LRU_W + ch0), w1 = *(const f32x4*)(A.conv_w + j * LRU_W + ch0 + 4);
#pragma unroll
            for (int e = 0; e < 4; ++e) { wgt[j][e] = w0[e]; wgt[j][4 + e] = w1[e]; } }
        { const f32x4 b0 = *(const f32x4*)(A.conv_b + ch0), b1 = *(const f32x4*)(A.conv_b + ch0 + 4);
#pragma unroll
          for (int e = 0; e < 4; ++e) { bia[e] = b0[e]; bia[4 + e] = b1[e]; } }
        u32x4 xr[5];
#pragma unroll
        for (int k = 0; k < 5; ++k) { const int tt = r0i.t + 2 * t2 + k - 1;
            xr[k] = (tt >= 0 && tt < r0i.T) ? *(const u32x4*)(A.P + (size_t)(r0i.base + tt) * NP + C_LRU_X + ch0) : (u32x4){0u, 0u, 0u, 0u}; }
#pragma unroll
        for (int i = 0; i < 2; ++i) { float acc[8];
#pragma unroll
            for (int e = 0; e < 8; ++e) acc[e] = bia[e];
#pragma unroll
            for (int j = 0; j < 4; ++j) { const u32x4 xv = xr[i + j];
#pragma unroll
                for (int e = 0; e < 4; ++e) { acc[2 * e] += wgt[j][2 * e] * bflo(xv[e]); acc[2 * e + 1] += wgt[j][2 * e + 1] * bfhi(xv[e]); } }
            const int tok = 2 * t2 + i;
#pragma unroll
            for (int e = 0; e < 8; ++e) Us[tok * US + c0 + e] = acc[e];
            *(u32x4*)(Ub + tok * UBS + c0 * 2) = (u32x4){pk2(acc[0], acc[1]), pk2(acc[2], acc[3]), pk2(acc[4], acc[5]), pk2(acc[6], acc[7])}; }
    }
    LDS_BARRIER();
    f32x4 acc[2][2][4];
#pragma unroll
    for (int d = 0; d < 2; ++d)
#pragma unroll
        for (int wh = 0; wh < 2; ++wh)
#pragma unroll
            for (int tb = 0; tb < 4; ++tb) acc[d][wh][tb] = (f32x4){0.f, 0.f, 0.f, 0.f};
#pragma unroll
    for (int s = 0; s < 4; ++s) {
        bf16x8 bfr[4];
#pragma unroll
        for (int tb = 0; tb < 4; ++tb) bfr[tb] = *(const bf16x8*)(Ub + (16 * tb + tl) * UBS + (32 * s + 8 * q) * 2);
#pragma unroll
        for (int d = 0; d < 2; ++d)
#pragma unroll
            for (int wh = 0; wh < 2; ++wh) { const bf16x8 a = *(const bf16x8*)(A.WG + ((size_t)((d * 2 + wh) * NH + nb)) * SZ_WBLK + (size_t)(16 * wid + tl) * LRU_BW + 32 * s + 8 * q);
#pragma unroll
                for (int tb = 0; tb < 4; ++tb) acc[d][wh][tb] = __builtin_amdgcn_mfma_f32_16x16x32_bf16(a, bfr[tb], acc[d][wh][tb], 0, 0, 0); }
    }
    const int chb = nb * LRU_BW + 16 * wid + 4 * q;
#pragma unroll
    for (int d = 0; d < 2; ++d) {
        float sp[4], bav[4], bxv[4];
#pragma unroll
        for (int r = 0; r < 4; ++r) { sp[r] = -LRU_C * softplusf_(-A.lam[d * LRU_W + chb + r]); bav[r] = A.ba[d * LRU_W + chb + r]; bxv[r] = A.bx[d * LRU_W + chb + r]; }
        float Ac[4], Bc[4];
#pragma unroll
        for (int r = 0; r < 4; ++r) { Ac[r] = 1.f; Bc[r] = 0.f; }
#pragma unroll
        for (int tbi = 0; tbi < 4; ++tbi) { const int tb = d == 0 ? tbi : 3 - tbi; const int tok = 16 * tb + tl;
            float a[4], b[4];
#pragma unroll
            for (int r = 0; r < 4; ++r) { const float rr = __builtin_amdgcn_rcpf(1.0f + __expf(-(acc[d][0][tb][r] + bav[r]))), ii = __builtin_amdgcn_rcpf(1.0f + __expf(-(acc[d][1][tb][r] + bxv[r])));
                const float log_a = sp[r] * rr, x2 = 2.0f * log_a; a[r] = __expf(log_a);
                float em = 1.0f + x2 * (1.0f / 6.0f); em = 1.0f + x2 * 0.2f * em; em = 1.0f + x2 * 0.25f * em; em = 1.0f + x2 * (1.0f / 3.0f) * em; em = 1.0f + x2 * 0.5f * em; em = -x2 * em;
                if (__builtin_expect(x2 < -0.25f, 0)) em = -expm1f(x2);
                b[r] = __builtin_amdgcn_sqrtf(em) * ii * Us[tok * US + 16 * wid + 4 * q + r]; }
#define LRU_SCAN_STEP(CTRL) do { _Pragma("unroll") for (int r = 0; r < 4; ++r) { \
                const float ap = __int_as_float(__builtin_amdgcn_update_dpp(0x3f800000, __float_as_int(a[r]), (CTRL), 0xf, 0xf, false)); \
                const float bp = __int_as_float(__builtin_amdgcn_update_dpp(0, __float_as_int(b[r]), (CTRL), 0xf, 0xf, false)); \
                b[r] = a[r] * bp + b[r]; a[r] = a[r] * ap; } } while (0)
            if (d == 0) { LRU_SCAN_STEP(0x111); LRU_SCAN_STEP(0x112); LRU_SCAN_STEP(0x114); LRU_SCAN_STEP(0x118); }
            else        { LRU_SCAN_STEP(0x101); LRU_SCAN_STEP(0x102); LRU_SCAN_STEP(0x104); LRU_SCAN_STEP(0x108); }
#undef LRU_SCAN_STEP
#pragma unroll
            for (int r = 0; r < 4; ++r) { b[r] = a[r] * Bc[r] + b[r]; a[r] = a[r] * Ac[r]; }
            { const size_t o = ((size_t)d * M_ALL + row0 + tok) * LRU_W + chb;
              *(u32x2*)(A.B.HLOC + o) = (u32x2){pk2(b[0], b[1]), pk2(b[2], b[3])}; *(u32x2*)(A.B.ACUM + o) = (u32x2){pk2(a[0], a[1]), pk2(a[2], a[3])}; }
#pragma unroll
            for (int r = 0; r < 4; ++r) { const int sl = (lane & ~15) | (d == 0 ? 15 : 0); Ac[r] = lane_get(a[r], sl); Bc[r] = lane_get(b[r], sl); }
        }
        if (tl == 0) { float* ls = A.B.LSUM + (((size_t)cix * 2 + d) * 2) * LRU_W + chb;
            *(f32x4*)ls = (f32x4){Ac[0], Ac[1], Ac[2], Ac[3]}; *(f32x4*)(ls + LRU_W) = (f32x4){Bc[0], Bc[1], Bc[2], Bc[3]}; }
    }
}
__device__ __forceinline__ void local_phase(const LocalArgs& A, char* lds, int G, int wg, const int tid) {
    for (int j = wg; j < 2 * NCHUNK * NH; j += G) if (j >= NCHUNK * NH) { const int t = j - NCHUNK * NH; local_task(A, lds, t / NH, t % NH, tid); }
}
__device__ __forceinline__ void carry_phase(const Bufs& B, int gtid, int gthreads) {
    constexpr int NC = CTX_LEN / CH, NL = SEQ / CH;
    for (int i = gtid; i < BATCH * 2 * LRU_W; i += gthreads) { const int ch = i % LRU_W, d = (i / LRU_W) & 1, b = i / (2 * LRU_W);
        float h = 0.f;
        for (int s0 = 0; s0 < NC + NL; s0 += 12) {
            float av[12], bv[12]; int cx[12];
#pragma unroll
            for (int u = 0; u < 12; ++u) { const int step = s0 + u; int cix = 0;
                if (step < NC) { const int n = d ? NC - 1 - step : step; cix = M_LAT / CH + b * NC + n; }
                else if (step < NC + NL) { const int s2 = step - NC, n = d ? NL - 1 - s2 : s2; cix = b * NL + n; }
                cx[u] = cix; const float* ls = B.LSUM + (((size_t)cix * 2 + d) * 2) * LRU_W + ch; av[u] = ls[0]; bv[u] = ls[LRU_W]; }
#pragma unroll
            for (int u = 0; u < 12; ++u) if (s0 + u < NC + NL) { B.HIN[((size_t)cx[u] * 2 + d) * LRU_W + ch] = h; h = av[u] * h + bv[u]; }
        }
    }
}
__device__ __forceinline__ void finish_phase(const Bufs& B, const bf16_t* P, bf16_t* Y, int gtid, int gthreads) {
    for (int it = gtid; it < M_ALL * (LRU_W / 8); it += gthreads) { const int row = it / (LRU_W / 8), c0 = (it % (LRU_W / 8)) * 8, cix = row / CH;
        const u32x4 h0 = *(const u32x4*)(B.HLOC + (size_t)row * LRU_W + c0), a0 = *(const u32x4*)(B.ACUM + (size_t)row * LRU_W + c0);
        const u32x4 h1 = *(const u32x4*)(B.HLOC + ((size_t)M_ALL + row) * LRU_W + c0), a1 = *(const u32x4*)(B.ACUM + ((size_t)M_ALL + row) * LRU_W + c0);
        const u32x4 gt = *(const u32x4*)(P + (size_t)row * NP + C_LRU_G + c0);
        const float* i0 = B.HIN + ((size_t)cix * 2 + 0) * LRU_W + c0; const float* i1 = B.HIN + ((size_t)cix * 2 + 1) * LRU_W + c0;
        const f32x4 i0a = *(const f32x4*)i0, i0b = *(const f32x4*)(i0 + 4), i1a = *(const f32x4*)i1, i1b = *(const f32x4*)(i1 + 4);
        float y[8];
#pragma unroll
        for (int j = 0; j < 4; ++j) { const unsigned hw0 = h0[j], aw0 = a0[j], hw1 = h1[j], aw1 = a1[j], gw = gt[j];
            const float in0l = j < 2 ? i0a[2 * j] : i0b[2 * j - 4], in0h = j < 2 ? i0a[2 * j + 1] : i0b[2 * j - 3], in1l = j < 2 ? i1a[2 * j] : i1b[2 * j - 4], in1h = j < 2 ? i1a[2 * j + 1] : i1b[2 * j - 3];
            y[2 * j] = (bflo(hw0) + bflo(aw0) * in0l + bflo(hw1) + bflo(aw1) * in1l) * geluf_(bflo(gw));
            y[2 * j + 1] = (bfhi(hw0) + bfhi(aw0) * in0h + bfhi(hw1) + bfhi(aw1) * in1h) * geluf_(bfhi(gw)); }
        *(u32x4*)(Y + (size_t)row * D_MODEL + c0) = (u32x4){pk2(y[0], y[1]), pk2(y[2], y[3]), pk2(y[4], y[5]), pk2(y[6], y[7])};
    }
}
}

namespace misc {
typedef float f32x4 __attribute__((ext_vector_type(4)));
typedef unsigned u32x2 __attribute__((ext_vector_type(2)));
typedef unsigned u32x4 __attribute__((ext_vector_type(4)));
__device__ __forceinline__ unsigned pk2(float lo, float hi) { return (unsigned)f2bf(lo) | ((unsigned)f2bf(hi) << 16); }
__device__ __forceinline__ float wave_sum(float v, int lane) {
#pragma unroll
    for (int o = 1; o < 64; o <<= 1) v += lane_xor(v, o, lane);
    return v;
}
__device__ __forceinline__ float sum16(float v, int lane) {
#pragma unroll
    for (int o = 1; o < 16; o <<= 1) v += lane_xor(v, o, lane);
    return v;
}
__device__ __forceinline__ void norm_phase(float* H, const float* g, const float* MODl, int sh_idx, bf16_t* U, int nrows, int gwave, int nwaves, int lane,
                                           const float* PART, int nparts, const float* pgate, const float* xin, const float* cin) {
    static_assert(D_MODEL == 2048, "norm_phase geometry");
    int cset = -1; f32x4 gsv[8], shv[8];
    for (int r = gwave; r < nrows; r += nwaves) {
        const int set = r < M_LAT ? r / SEQ : BATCH;
        if (set != cset) { cset = set; const f32x4* gp = (const f32x4*)g + lane; const f32x4* shp = (const f32x4*)(MODl + (size_t)set * NMODV + (size_t)sh_idx * D_MODEL) + lane; const f32x4* scp = shp + D_MODEL / 4;
#pragma unroll
            for (int j = 0; j < 8; ++j) { gsv[j] = gp[64 * j] * (scp[64 * j] + 1.0f); shv[j] = shp[64 * j]; } }
        f32x4* hr = (f32x4*)(H + (size_t)r * D_MODEL) + lane;
        const f32x4* src = xin == nullptr ? hr : (r < M_LAT ? (const f32x4*)(xin + (size_t)r * D_MODEL) + lane : (const f32x4*)(cin + (size_t)(r - M_LAT) * D_MODEL) + lane);
        f32x4 v[8]; float ss = 0.f;
#pragma unroll
        for (int j = 0; j < 8; ++j) v[j] = src[64 * j];
        if (xin != nullptr && r >= M_LAT) {
#pragma unroll
            for (int j = 0; j < 8; ++j) hr[64 * j] = v[j]; }
        if (PART != nullptr && r >= M_LAT) {
            const f32x4* gp = (const f32x4*)pgate + lane;
#pragma unroll
            for (int j = 0; j < 8; ++j) { f32x4 acc = {0.f, 0.f, 0.f, 0.f};
                for (int s = 0; s < nparts; ++s) acc += *((const f32x4*)(PART + ((size_t)s * M_CTX + (r - M_LAT)) * D_MODEL) + lane + 64 * j);
                v[j] += gp[64 * j] * acc; hr[64 * j] = v[j]; }
        }
#pragma unroll
        for (int j = 0; j < 8; ++j) ss += (v[j][0] * v[j][0] + v[j][1] * v[j][1]) + (v[j][2] * v[j][2] + v[j][3] * v[j][3]);
        const float rstd = __builtin_amdgcn_rsqf(wave_sum(ss, lane) * (1.0f / D_MODEL) + EPS);
        u32x2* o = (u32x2*)(U + (size_t)r * D_MODEL) + lane;
#pragma unroll
        for (int j = 0; j < 8; ++j) { const f32x4 y = v[j] * rstd * gsv[j] + shv[j];
            o[64 * j] = (u32x2){pk2(y[0], y[1]), pk2(y[2], y[3])}; }
    }
}
struct RowNormArgs { const bf16_t* P; const float *qa_g, *kva_g, *na_qn_g, *na_kn_g; bf16_t *CQN, *CKVN, *NQ, *NK; };
__device__ __forceinline__ void rownorm_phase(const RowNormArgs& A, int gwave, int nwaves, int lane) {
    static_assert(MLA_Q_LORA == 384 && MLA_KV_LORA == 256 && GROUP_W == 512 && HD == 128, "rownorm geometry");
    float gq[6], gkv[4], gnq[8], gnk[8];
#pragma unroll
    for (int j = 0; j < 3; ++j) { gq[2 * j] = A.qa_g[2 * lane + 128 * j]; gq[2 * j + 1] = A.qa_g[2 * lane + 128 * j + 1]; }
#pragma unroll
    for (int j = 0; j < 2; ++j) { gkv[2 * j] = A.kva_g[2 * lane + 128 * j]; gkv[2 * j + 1] = A.kva_g[2 * lane + 128 * j + 1]; }
#pragma unroll
    for (int j = 0; j < 8; ++j) { gnq[j] = A.na_qn_g[(lane & 15) * 8 + j]; gnk[j] = A.na_kn_g[(lane & 15) * 8 + j]; }
    for (int r = gwave; r < M_ALL; r += nwaves) { const bf16_t* p = A.P + (size_t)r * NP;
        { float x[6], ss = 0.f;
#pragma unroll
          for (int j = 0; j < 3; ++j) { const unsigned w = *(const unsigned*)(p + C_CQ + 2 * lane + 128 * j); x[2 * j] = bflo(w); x[2 * j + 1] = bfhi(w); ss += x[2 * j] * x[2 * j] + x[2 * j + 1] * x[2 * j + 1]; }
          const float rstd = 1.0f / sqrtf(wave_sum(ss, lane) * (1.0f / MLA_Q_LORA) + EPS);
#pragma unroll
          for (int j = 0; j < 3; ++j) { const int c = 2 * lane + 128 * j; *(unsigned*)(A.CQN + (size_t)r * MLA_Q_LORA + c) = pk2(x[2 * j] * rstd * gq[2 * j], x[2 * j + 1] * rstd * gq[2 * j + 1]); } }
        { float x[4], ss = 0.f;
#pragma unroll
          for (int j = 0; j < 2; ++j) { const unsigned w = *(const unsigned*)(p + C_CKV + 2 * lane + 128 * j); x[2 * j] = bflo(w); x[2 * j + 1] = bfhi(w); ss += x[2 * j] * x[2 * j] + x[2 * j + 1] * x[2 * j + 1]; }
          const float rstd = 1.0f / sqrtf(wave_sum(ss, lane) * (1.0f / MLA_KV_LORA) + EPS);
#pragma unroll
          for (int j = 0; j < 2; ++j) { const int c = 2 * lane + 128 * j; *(unsigned*)(A.CKVN + (size_t)r * MLA_KV_LORA + c) = pk2(x[2 * j] * rstd * gkv[2 * j], x[2 * j + 1] * rstd * gkv[2 * j + 1]); } }
#pragma unroll
        for (int which = 0; which < 2; ++which) {
            const int hh = lane >> 4, d0 = (lane & 15) * 8; const u32x4 w = *(const u32x4*)(p + (which == 0 ? C_NQ : C_NK) + hh * HD + d0);
            float x[8]; float ss = 0.f;
#pragma unroll
            for (int j = 0; j < 4; ++j) { x[2 * j] = bflo(w[j]); x[2 * j + 1] = bfhi(w[j]); ss += x[2 * j] * x[2 * j] + x[2 * j + 1] * x[2 * j + 1]; }
            const float rstd = __builtin_amdgcn_rsqf(sum16(ss, lane) * (1.0f / HD) + EPS); const float* g = which == 0 ? gnq : gnk;
            *(u32x4*)((which == 0 ? A.NQ : A.NK) + (size_t)r * GROUP_W + hh * HD + d0) =
                (u32x4){pk2(x[0] * rstd * g[0], x[1] * rstd * g[1]), pk2(x[2] * rstd * g[2], x[3] * rstd * g[3]), pk2(x[4] * rstd * g[4], x[5] * rstd * g[5]), pk2(x[6] * rstd * g[6], x[7] * rstd * g[7])};
        }
    }
}
struct MlaQkvArgs { const bf16_t* QR; const bf16_t* KVR; const bf16_t* P; const float *qn_g, *kn_g; bf16_t *QM, *KM, *VM; };
__device__ __forceinline__ void mlaqkv_phase(const MlaQkvArgs& A, int gwave, int nwaves, int lane) {
    static_assert(MLA_QK == 192 && MLA_NOPE == 128 && MLA_ROPE == 64 && NH == 4 && GRID_W == 64, "mla qkv geometry");
    const int hh = lane >> 4, g = lane & 15;
    const int f0 = (2 * g) & 15; const float inv0 = powf(10000.0f, -(float)f0 / 16.0f), inv1 = powf(10000.0f, -(float)(f0 + 1) / 16.0f);
    f32x4 gq0 = *(const f32x4*)(A.qn_g + 8 * g), gq1 = *(const f32x4*)(A.qn_g + 8 * g + 4), gk0 = *(const f32x4*)(A.kn_g + 8 * g), gk1 = *(const f32x4*)(A.kn_g + 8 * g + 4);
    const float gqr[4] = {A.qn_g[MLA_NOPE + 2 * g], A.qn_g[MLA_NOPE + 2 * g + 1], A.qn_g[MLA_NOPE + 32 + 2 * g], A.qn_g[MLA_NOPE + 32 + 2 * g + 1]};
    const float gkr[4] = {A.kn_g[MLA_NOPE + 2 * g], A.kn_g[MLA_NOPE + 2 * g + 1], A.kn_g[MLA_NOPE + 32 + 2 * g], A.kn_g[MLA_NOPE + 32 + 2 * g + 1]};
    for (int r = gwave; r < M_ALL; r += nwaves) {
        const bool lat = r < M_LAT; const int t = lat ? r % SEQ : 0; const float pos = g < 8 ? (float)(t / GRID_W) : (float)(t % GRID_W);
        float c0 = 1.f, s0 = 0.f, c1 = 1.f, s1 = 0.f;
        if (lat) { sincosf(pos * inv0, &s0, &c0); sincosf(pos * inv1, &s1, &c1); }
#pragma unroll
        for (int which = 0; which < 2; ++which) {
            const bf16_t* nsrc = which == 0 ? A.QR + (size_t)r * NQ_MLA + hh * MLA_QK : A.KVR + (size_t)r * NKV_MLA + hh * (MLA_NOPE + MLA_V);
            const bf16_t* rsrc = which == 0 ? nsrc + MLA_NOPE : A.P + (size_t)r * NP + C_KR;
            const u32x4 nw = *(const u32x4*)(nsrc + 8 * g); const unsigned ra = *(const unsigned*)(rsrc + 2 * g), rb = *(const unsigned*)(rsrc + 32 + 2 * g);
            float x[8], a0 = bflo(ra), a1 = bfhi(ra), b0 = bflo(rb), b1 = bfhi(rb);
            float ss = a0 * a0 + a1 * a1 + b0 * b0 + b1 * b1;
#pragma unroll
            for (int j = 0; j < 4; ++j) { x[2 * j] = bflo(nw[j]); x[2 * j + 1] = bfhi(nw[j]); ss += x[2 * j] * x[2 * j] + x[2 * j + 1] * x[2 * j + 1]; }
            const float rstd = __builtin_amdgcn_rsqf(sum16(ss, lane) * (1.0f / MLA_QK) + EPS);
            const f32x4 g0 = which == 0 ? gq0 : gk0, g1 = which == 0 ? gq1 : gk1;
#pragma unroll
            for (int j = 0; j < 4; ++j) { x[j] *= rstd * g0[j]; x[4 + j] *= rstd * g1[j]; }
            a0 *= rstd * (which == 0 ? gqr[0] : gkr[0]); a1 *= rstd * (which == 0 ? gqr[1] : gkr[1]); b0 *= rstd * (which == 0 ? gqr[2] : gkr[2]); b1 *= rstd * (which == 0 ? gqr[3] : gkr[3]);
            const float ya0 = a0 * c0 - b0 * s0, yb0 = a0 * s0 + b0 * c0, ya1 = a1 * c1 - b1 * s1, yb1 = a1 * s1 + b1 * c1;
            bf16_t* O = (which == 0 ? A.QM : A.KM) + (size_t)r * NQ_MLA + hh * MLA_QK;
            *(u32x4*)(O + 8 * g) = (u32x4){pk2(x[0], x[1]), pk2(x[2], x[3]), pk2(x[4], x[5]), pk2(x[6], x[7])};
            *(unsigned*)(O + MLA_NOPE + 2 * g) = pk2(ya0, ya1); *(unsigned*)(O + MLA_NOPE + 32 + 2 * g) = pk2(yb0, yb1);
        }
        *(u32x4*)(A.VM + (size_t)r * (NH * MLA_V) + hh * MLA_V + 8 * g) = *(const u32x4*)(A.KVR + (size_t)r * NKV_MLA + hh * (MLA_NOPE + MLA_V) + MLA_NOPE + 8 * g);
    }
}
constexpr int ACT_RUN = 32;
__device__ __forceinline__ void act_phase(const bf16_t* UP, const float* cw, const float* cb, bf16_t* ACT, int nrows, int gtid, int gthreads) {
    constexpr int NC8 = D_FF / 8; static_assert(SEQ % ACT_RUN == 0 && CTX_LEN % ACT_RUN == 0, "row runs stay inside one sequence");
    const int nruns = nrows / ACT_RUN;
    for (long it = gtid; it < (long)nruns * NC8; it += gthreads) { const int run = (int)(it / NC8), j0 = (int)(it % NC8) * 8, r0 = run * ACT_RUN; const RowInfo ri = row_info(r0);
        float wa[3][8], wg[3][8], ba[8], bg[8];
#pragma unroll
        for (int k = 0; k < 3; ++k) { const float* p = cw + (size_t)k * 2 * D_FF + j0; const f32x4 a0 = *(const f32x4*)p, a1 = *(const f32x4*)(p + 4), g0 = *(const f32x4*)(p + D_FF), g1 = *(const f32x4*)(p + D_FF + 4);
#pragma unroll
            for (int e = 0; e < 4; ++e) { wa[k][e] = a0[e]; wa[k][4 + e] = a1[e]; wg[k][e] = g0[e]; wg[k][4 + e] = g1[e]; } }
        { const f32x4 a0 = *(const f32x4*)(cb + j0), a1 = *(const f32x4*)(cb + j0 + 4), g0 = *(const f32x4*)(cb + D_FF + j0), g1 = *(const f32x4*)(cb + D_FF + j0 + 4);
#pragma unroll
          for (int e = 0; e < 4; ++e) { ba[e] = a0[e]; ba[4 + e] = a1[e]; bg[e] = g0[e]; bg[4 + e] = g1[e]; } }
        const u32x4 zero = {0u, 0u, 0u, 0u};
        const bf16_t* ub = UP + (size_t)ri.base * (2 * D_FF) + j0;
        u32x4 am, ac, gm, gc;
        { const int t = ri.t; am = t > 0 ? *(const u32x4*)(ub + (size_t)(t - 1) * (2 * D_FF)) : zero; gm = t > 0 ? *(const u32x4*)(ub + (size_t)(t - 1) * (2 * D_FF) + D_FF) : zero;
          ac = *(const u32x4*)(ub + (size_t)t * (2 * D_FF)); gc = *(const u32x4*)(ub + (size_t)t * (2 * D_FF) + D_FF); }
#pragma unroll 4
        for (int i = 0; i < ACT_RUN; ++i) { const int t = ri.t + i;
            const u32x4 ap = t + 1 < ri.T ? *(const u32x4*)(ub + (size_t)(t + 1) * (2 * D_FF)) : zero, gp = t + 1 < ri.T ? *(const u32x4*)(ub + (size_t)(t + 1) * (2 * D_FF) + D_FF) : zero;
            float y[8];
#pragma unroll
            for (int e = 0; e < 4; ++e) {
                const float a0 = ba[2 * e] + wa[0][2 * e] * bflo(am[e]) + wa[1][2 * e] * bflo(ac[e]) + wa[2][2 * e] * bflo(ap[e]);
                const float a1 = ba[2 * e + 1] + wa[0][2 * e + 1] * bfhi(am[e]) + wa[1][2 * e + 1] * bfhi(ac[e]) + wa[2][2 * e + 1] * bfhi(ap[e]);
                const float g0 = bg[2 * e] + wg[0][2 * e] * bflo(gm[e]) + wg[1][2 * e] * bflo(gc[e]) + wg[2][2 * e] * bflo(gp[e]);
                const float g1 = bg[2 * e + 1] + wg[0][2 * e + 1] * bfhi(gm[e]) + wg[1][2 * e + 1] * bfhi(gc[e]) + wg[2][2 * e + 1] * bfhi(gp[e]);
                y[2 * e] = a0 * (g0 / (1.0f + __expf(-g0))); y[2 * e + 1] = a1 * (g1 / (1.0f + __expf(-g1))); }
            *(u32x4*)(ACT + (size_t)(r0 + i) * D_FF + j0) = (u32x4){pk2(y[0], y[1]), pk2(y[2], y[3]), pk2(y[4], y[5]), pk2(y[6], y[7])};
            am = ac; ac = ap; gm = gc; gc = gp; }
    }
}
__device__ __forceinline__ void act_fix_phase(const bf16_t* HALO, const float* cw, const float* cb, bf16_t* ACT, int nrows, int gtid, int gthreads) {
    constexpr int NC8 = D_FF / 8; const int nblk = nrows / 64;
    for (long it = gtid; it < (long)nblk * 2 * NC8; it += gthreads) { const int j0 = (int)(it % NC8) * 8, be = (int)(it / NC8), blk = be >> 1, edge = be & 1; const int row = blk * 64 + (edge ? 63 : 0);
        const RowInfo ri = row_info(row);
        const bf16_t* hb = HALO + (size_t)blk * 4 * (2 * D_FF) + j0;
        const bool has_prev = ri.t > 0, has_next = ri.t + 1 < ri.T; const u32x4 zero = {0u, 0u, 0u, 0u};
        const bf16_t* pc = hb + (size_t)(edge ? 3 : 0) * (2 * D_FF);
        const bf16_t* pp_ = edge ? hb + (size_t)2 * (2 * D_FF) : hb - (size_t)4 * (2 * D_FF) + (size_t)3 * (2 * D_FF);
        const bf16_t* pn = edge ? hb + (size_t)4 * (2 * D_FF) : hb + (size_t)1 * (2 * D_FF);
        const u32x4 ac = *(const u32x4*)pc, gc = *(const u32x4*)(pc + D_FF);
        const u32x4 am = has_prev ? *(const u32x4*)pp_ : zero, gm = has_prev ? *(const u32x4*)(pp_ + D_FF) : zero;
        const u32x4 ap = has_next ? *(const u32x4*)pn : zero, gp = has_next ? *(const u32x4*)(pn + D_FF) : zero;
        float y[8];
#pragma unroll
        for (int e = 0; e < 4; ++e) {
#pragma unroll
            for (int hh = 0; hh < 2; ++hh) { const int c = j0 + 2 * e + hh;
                const float xam = hh ? bfhi(am[e]) : bflo(am[e]), xac = hh ? bfhi(ac[e]) : bflo(ac[e]), xap = hh ? bfhi(ap[e]) : bflo(ap[e]);
                const float xgm = hh ? bfhi(gm[e]) : bflo(gm[e]), xgc = hh ? bfhi(gc[e]) : bflo(gc[e]), xgp = hh ? bfhi(gp[e]) : bflo(gp[e]);
                const float a = cb[c] + cw[c] * xam + cw[2 * D_FF + c] * xac + cw[4 * D_FF + c] * xap;
                const float g = cb[D_FF + c] + cw[D_FF + c] * xgm + cw[2 * D_FF + D_FF + c] * xgc + cw[4 * D_FF + D_FF + c] * xgp;
                y[2 * e + hh] = a * (g * __builtin_amdgcn_rcpf(1.0f + __expf(-g))); } }
        *(u32x4*)(ACT + (size_t)row * D_FF + j0) = (u32x4){pk2(y[0], y[1]), pk2(y[2], y[3]), pk2(y[4], y[5]), pk2(y[6], y[7])};
    }
}
__device__ __forceinline__ void transpose_item(const float* W, int K, int N, int Npad, bf16_t* WT, float* scr, int item, int lane, int pairF = 0) {
    const int nblk = Npad / 32, kb = item / nblk, nb = item % nblk, k0 = 64 * kb, n0 = 32 * nb; const int n = n0 + (lane & 31); const bool ok = n < N;
#pragma unroll 8
    for (int i = 0; i < 32; ++i) { const int kk = 2 * i + (lane >> 5); scr[kk * 33 + (lane & 31)] = ok ? W[(size_t)(k0 + kk) * N + n] : 0.f; }
    asm volatile("s_waitcnt lgkmcnt(0)" ::: "memory");
    const int c = lane & 7;
#pragma unroll
    for (int j = 0; j < 4; ++j) { const int nn = (lane >> 3) + 8 * j; const float* s = scr + (8 * c) * 33 + nn;
        u32x4 o; o.x = pk2(s[0 * 33], s[1 * 33]); o.y = pk2(s[2 * 33], s[3 * 33]); o.z = pk2(s[4 * 33], s[5 * 33]); o.w = pk2(s[6 * 33], s[7 * 33]);
        const int nsrc = n0 + nn; const int nd = pairF == 0 ? nsrc : (nsrc < pairF ? (nsrc >> 7) * 256 + (nsrc & 127) : ((nsrc - pairF) >> 7) * 256 + 128 + ((nsrc - pairF) & 127));
        *(u32x4*)(WT + (size_t)nd * K + k0 + 8 * c) = o; }
    asm volatile("s_waitcnt lgkmcnt(0)" ::: "memory");
}
}

__device__ __forceinline__ gdn::Bufs gdn_bufs(const WS& w, int l) { gdn::Bufs B; B.UT = w.gUT; B.WP = w.gWP; B.KDT = w.gKDT; B.QD = w.gQD; B.QK = w.gQK; B.SIT = w.gSIT; B.VNT = w.gVNT; B.GT = w.gGT + (size_t)l * gdn::NTASK; return B; }
__device__ __forceinline__ lru::Bufs lru_bufs(const WS& w) { lru::Bufs B; B.HLOC = w.lHLOC; B.ACUM = w.lACUM; B.LSUM = w.lLSUM; B.HIN = w.lHIN; return B; }

#define LAS __attribute__((address_space(3)))
#define XB_TMO      128
#define XB_XCNT(j)  (256  + 64 * (j))
#define XB_XSUB(j)  (1280 + 64 * (j))
#define XB_XGEN(j)  (2304 + 64 * (j))
#define XB_TOP      3328
#define XB_TOPGEN   3392
#define XCD_BAR_WORDS 3456
#define XB_SPIN_CAP (1u << 18)
__device__ __forceinline__ unsigned xb_ld(unsigned* p)              { return __hip_atomic_load(p, __ATOMIC_RELAXED, __HIP_MEMORY_SCOPE_AGENT); }
__device__ __forceinline__ unsigned xb_add(unsigned* p, unsigned v) { return __hip_atomic_fetch_add(p, v, __ATOMIC_RELAXED, __HIP_MEMORY_SCOPE_AGENT); }
__device__ __forceinline__ unsigned xb_xcc_id() { return (unsigned)__builtin_amdgcn_s_getreg((3 << 11) | 20) & 0xFu; }
#define XB_SPIN(cond, bar) do { unsigned _sp = 0; while (cond) { __builtin_amdgcn_s_sleep(1); \
    if ((++_sp & 255u) == 0u) { if (xb_ld(&(bar)[XB_TMO])) break; if (_sp > XB_SPIN_CAP) { atomicAdd(&(bar)[XB_TMO], 1u); break; } } } } while (0)
struct XcdBarrier { unsigned* bar; unsigned x; volatile LAS unsigned* st; };
__device__ __forceinline__ XcdBarrier xcd_barrier_post(unsigned* bar, volatile LAS unsigned* st, const bool leader) {
    XcdBarrier b; b.bar = bar; b.x = xb_xcc_id(); b.st = st;
    if (leader) (void)xb_add(&bar[XB_XCNT(b.x)], 1u);
    return b;
}
__device__ __forceinline__ void xcd_barrier_complete(unsigned* bar, unsigned x, unsigned& nloc, unsigned& nx) {
    const unsigned G = gridDim.x * gridDim.y * gridDim.z;
    unsigned sum, cnt, mine, sp = 0u;
    for (;;) {
        sum = 0u; cnt = 0u; mine = 0u;
#pragma unroll
        for (unsigned j = 0; j < 16; ++j) { const unsigned c = xb_ld(&bar[XB_XCNT(j)]); sum += c; cnt += (c > 0u) ? 1u : 0u; mine = (j == x) ? c : mine; }
        if (sum == G) break;
        __builtin_amdgcn_s_sleep(1);
        if ((++sp & 255u) == 0u) { if (xb_ld(&bar[XB_TMO])) break; if (sp > XB_SPIN_CAP) { atomicAdd(&bar[XB_TMO], 1u); break; } }
    }
    nloc = mine > 0u ? mine : 1u; nx = cnt > 0u ? cnt : 1u;
}
__device__ __forceinline__ void xcd_barrier(const XcdBarrier& b, const bool leader) {
    asm volatile("s_waitcnt vmcnt(0)" ::: "memory");
    __syncthreads();
    if (leader) {
        unsigned* bar = b.bar;
        __builtin_amdgcn_s_waitcnt(0);
        unsigned nloc = b.st[0], nx = b.st[1];
        if (nloc == 0u) { xcd_barrier_complete(bar, b.x, nloc, nx); b.st[0] = nloc; b.st[1] = nx; }
        const unsigned old = xb_add(&bar[XB_XSUB(b.x)], 1u);
        const unsigned gen = old / nloc;
        if (old + 1u == (gen + 1u) * nloc) {
            __builtin_amdgcn_fence(__ATOMIC_RELEASE, "agent");
            asm volatile("s_waitcnt vmcnt(0)" ::: "memory");
            const unsigned og = xb_add(&bar[XB_TOP], 1u);
            const unsigned tg = og / nx;
            if (og + 1u == (tg + 1u) * nx) xb_add(&bar[XB_TOPGEN], 1u);
            else XB_SPIN(xb_ld(&bar[XB_TOPGEN]) == tg, bar);
            __builtin_amdgcn_fence(__ATOMIC_ACQUIRE, "agent");
            xb_add(&bar[XB_XGEN(b.x)], 1u);
            asm volatile("s_waitcnt vmcnt(0)" ::: "memory");
        } else {
            XB_SPIN(xb_ld(&bar[XB_XGEN(b.x)]) == gen, bar);
            __builtin_amdgcn_fence(__ATOMIC_ACQUIRE, "agent");
            asm volatile("s_waitcnt vmcnt(0)" ::: "memory");
        }
    }
    __syncthreads();
}

constexpr int NWAVES = 8, NTHR = 512;
constexpr int LDS_MISC = 147456, LDS_BYTES = 148480;
static_assert(sizeof(Inputs) == 34 * 8, "Inputs mirrors Params::in");
static_assert(gdn::G1_LDS <= LDS_MISC && pg8::STAGE_BYTES <= LDS_MISC && att::Cfg<MLA_QK>::LDS_BYTES <= LDS_MISC && gdn::G2_LDS <= LDS_MISC, "LDS map");
constexpr int CW_BAR = 4096;
constexpr int G2_CUT1 = 52, G2_CUT2 = 52;
constexpr int SK_OUT = 4, SK_DOWN = 5;
constexpr int PH_PRO = 0, PH_PER_LAYER = 12, NPH = 1 + PH_PER_LAYER * DEPTH;
struct Params { const float* in[34]; float* out; unsigned char* ws; int ph_lo, ph_hi, li, pad; };

struct SplitOrder {
    int nN, nM, S, G, c;
    __device__ __forceinline__ void init(int M, int N, int S_, int G_, int c_) { nM = M / pg8::BM; nN = N / pg8::BM; S = S_; G = G_; c = c_; }
    __device__ __forceinline__ bool next(int i, pg8::Unit& u) const { const int g = c + i * G; if (g >= nM * nN * S) return false; u.ks = g / (nM * nN); const int loc = g % (nM * nN); u.pm = loc / nN; u.pn = loc % nN; return true; }
    __device__ __forceinline__ void a_ready(const pg8::Unit&) const {}
    __device__ __forceinline__ void done(const pg8::Unit&) const {}
};
struct SpanOrder {
    int nN, lo, hi, G, g0;
    __device__ __forceinline__ void init(int N, int lo_, int hi_, int G_, int c) { nN = N / pg8::BM; lo = lo_; hi = hi_; G = G_; int i0 = 0; if (c < lo_) i0 = (lo_ - c + G_ - 1) / G_; g0 = c + i0 * G_; }
    __device__ __forceinline__ bool next(int i, pg8::Unit& u) const { const int g = g0 + i * G; if (g >= hi) return false; const int loc = g - lo; u.pm = loc / nN; u.pn = loc % nN; u.ks = 0; return true; }
    __device__ __forceinline__ void a_ready(const pg8::Unit&) const {}
    __device__ __forceinline__ void done(const pg8::Unit&) const {}
};

#define AS4 __attribute__((address_space(4)))
#define PHASE_WS const AS4 Params* pp = (const AS4 Params*)__builtin_amdgcn_kernarg_segment_ptr(); asm volatile("" : "+s"(pp)); const AS4 Inputs* I = (const AS4 Inputs*)pp; (void)I; unsigned char* wsb_ = pp->ws; const WS w = ws_carve(wsb_)
#define PHASE_IDS int tid = C_wave0 * 64 + (int)__builtin_amdgcn_mbcnt_hi(~0u, __builtin_amdgcn_mbcnt_lo(~0u, 0u)); asm volatile("" : "+v"(tid)); const int lane = tid & 63, wave = __builtin_amdgcn_readfirstlane(tid >> 6), gwave = wg * NWAVES + wave, gtid = wg * NTHR + tid; (void)lane; (void)gwave; (void)gtid
#ifndef DBG_MASK
#define DBG_MASK 0xFFFFFF
#endif
#define IN(k) (lo <= (k) && (k) < hi)
#define ON(j) (((DBG_MASK) >> (j)) & 1)
#define SEAM(k) do { if (IN(k) && IN((k) + 1)) xcd_barrier(bar, C_wave0 == 0 && __builtin_amdgcn_mbcnt_hi(~0u, __builtin_amdgcn_mbcnt_lo(~0u, 0u)) == 0u); } while (0)

struct LayerCtx { int lo, hi, G, wg, nwaves, gthreads, wave0; XcdBarrier bar; char* lds; unsigned char* lds_raw; };
template <int l> __device__ __forceinline__ void layer_body(const LayerCtx& C) {
    const int lo = C.lo, hi = C.hi, G = C.G, wg = C.wg, nwaves = C.nwaves, gthreads = C.gthreads, C_wave0 = C.wave0; const XcdBarrier& bar = C.bar; char* lds = C.lds; unsigned char* lds_raw = C.lds_raw;
    (void)G; (void)nwaves; (void)gthreads;
        const int pb = 1 + PH_PER_LAYER * l;
        const bool want_ctx = l < DEPTH - 1; const int Mo = want_ctx ? M_ALL : M_LAT;
        if (ON(0) && IN(pb + 0)) { PHASE_WS; PHASE_IDS; const float* MODl = w.MOD + (size_t)l * (BATCH + 1) * NMODV; (void)MODl; misc::norm_phase(w.H, I->norm_mix_g + (size_t)l * D_MODEL, MODl, 0, w.U, M_ALL, gwave, nwaves, lane, l > 0 ? w.PART : nullptr, SK_DOWN, MODl - (size_t)(BATCH + 1) * NMODV + (size_t)BATCH * NMODV + 5 * D_MODEL, l == 0 ? I->x : nullptr, l == 0 ? I->ctx : nullptr); }
        SEAM(pb + 0);
        if (ON(1) && IN(pb + 1)) { PHASE_WS; PHASE_IDS; const float* MODl = w.MOD + (size_t)l * (BATCH + 1) * NMODV; (void)MODl; pg8::Gemm g{w.U, w.WIN + l * SZ_WIN, M_ALL, NP, D_MODEL, D_MODEL}; pg8::StaticOrder S; S.init(M_ALL, NP, G, wg);
            pg8::EpiBf16<0> E{w.P, NP, nullptr, 0, 0, 1.0f};
            pg8::gemm_phase<pg8::EpiBf16<0>, pg8::StaticOrder, true, true>((PG8_LAS unsigned char*)lds_raw, g, S, E, tid); }
        SEAM(pb + 1);
        if (ON(2) && IN(pb + 2)) { PHASE_WS; PHASE_IDS; const float* MODl = w.MOD + (size_t)l * (BATCH + 1) * NMODV; (void)MODl;
            const int pflags = pp->pad;
            if (!(pflags & 16)) { gdn::G1Args A; A.P = w.P; A.conv_w = I->gdn_conv_w + (size_t)l * 4 * 3 * GROUP_W; A.a_log = I->gdn_a_log + (size_t)l * 2 * NH; A.dt_bias = I->gdn_dt_bias + (size_t)l * 2 * NH; A.B = gdn_bufs(w, l); A.pflags = pflags;
              gdn::g1_phase(A, lds, G, wg, tid); }
            if (!(pflags & 32)) { lru::LocalArgs A; A.P = w.P; A.conv_w = I->lru_conv_w + (size_t)l * 4 * LRU_W; A.conv_b = I->lru_conv_b + (size_t)l * LRU_W; A.WG = w.WLRU + (size_t)l * 16 * lru::SZ_WBLK;
              A.ba = I->lru_ba + (size_t)l * 2 * LRU_W; A.bx = I->lru_bx + (size_t)l * 2 * LRU_W; A.lam = I->lru_lam + (size_t)l * 2 * LRU_W; A.B = lru_bufs(w);
              lru::local_phase(A, lds, G, wg, tid); }
            if (!(pflags & 64)) { misc::RowNormArgs A; A.P = w.P; A.qa_g = I->mla_qa_g + (size_t)l * MLA_Q_LORA; A.kva_g = I->mla_kva_g + (size_t)l * MLA_KV_LORA; A.na_qn_g = I->na_qn_g + (size_t)l * HD; A.na_kn_g = I->na_kn_g + (size_t)l * HD;
              A.CQN = w.CQN; A.CKVN = w.CKVN; A.NQ = w.NQ; A.NK = w.NK; misc::rownorm_phase(A, gwave, nwaves, lane); }
        }
        SEAM(pb + 2);
        if (ON(3) && IN(pb + 3)) { PHASE_WS; PHASE_IDS; const float* MODl = w.MOD + (size_t)l * (BATCH + 1) * NMODV; (void)MODl;
            if (wg < gdn::G2_WGS) gdn::g2_chain(gdn_bufs(w, l), lds, wg, tid, 0, G2_CUT1, w.gSS);
            else {
            constexpr int UQ = (M_ALL / 256) * (NQ_MLA / 256), UKV = (M_ALL / 256) * (NKV_MLA / 256); const int G2n = G - gdn::G2_WGS, c2 = wg - gdn::G2_WGS;
            { pg8::Gemm g{w.CQN, w.WUQ + l * SZ_WUQ, M_ALL, NQ_MLA, MLA_Q_LORA, MLA_Q_LORA}; SpanOrder S; S.init(NQ_MLA, 0, UQ, G2n, c2); pg8::EpiBf16<0> E{w.QR, NQ_MLA, nullptr, 0, 0, 1.0f};
              pg8::gemm_phase<pg8::EpiBf16<0>, SpanOrder, true, true>((PG8_LAS unsigned char*)lds_raw, g, S, E, tid); }
            { pg8::Gemm g{w.CKVN, w.WUKV + l * SZ_WUKV, M_ALL, NKV_MLA, MLA_KV_LORA, MLA_KV_LORA}; SpanOrder S; S.init(NKV_MLA, UQ, UQ + UKV, G2n, c2); pg8::EpiBf16<0> E{w.KVR, NKV_MLA, nullptr, 0, 0, 1.0f};
              pg8::gemm_phase<pg8::EpiBf16<0>, SpanOrder, true, true>((PG8_LAS unsigned char*)lds_raw, g, S, E, tid); }
            }
        }
        SEAM(pb + 3);
        if (ON(4) && IN(pb + 4)) { PHASE_WS; PHASE_IDS; const float* MODl = w.MOD + (size_t)l * (BATCH + 1) * NMODV; (void)MODl;
            { misc::MlaQkvArgs A; A.QR = w.QR; A.KVR = w.KVR; A.P = w.P; A.qn_g = I->mla_qn_g + (size_t)l * MLA_QK; A.kn_g = I->mla_kn_g + (size_t)l * MLA_QK; A.QM = w.QM; A.KM = w.KM; A.VM = w.VM;
              misc::mlaqkv_phase(A, gwave, nwaves, lane); }
            lru::carry_phase(lru_bufs(w), gtid, gthreads);
        }
        SEAM(pb + 4);
        if (ON(5) && IN(pb + 5)) { PHASE_WS; PHASE_IDS; const float* MODl = w.MOD + (size_t)l * (BATCH + 1) * NMODV; (void)MODl;
            const int pflags = pp->pad;
            if (wg < gdn::G2_WGS && !(pflags & 1)) gdn::g2_chain(gdn_bufs(w, l), lds, wg, tid, G2_CUT2, gdn::G2_NSTEP, w.gSS);
            AttnArgs A; A.QM = w.QM; A.KM = w.KM; A.VM = w.VM; A.NQ = w.NQ; A.NK = w.NK; A.P = w.P; A.Y = w.Y; A.rpb = I->na_rpb + (size_t)l * NH * (2 * NA_KH - 1) * (2 * NA_KW - 1); A.want_ctx = want_ctx ? 1 : 0; A.pad = pflags;
            attention_phase(A, lds, G, wg, tid, gdn::G2_WGS);
        }
        SEAM(pb + 5);
        if (ON(6) && IN(pb + 6)) { PHASE_WS; PHASE_IDS; const float* MODl = w.MOD + (size_t)l * (BATCH + 1) * NMODV; (void)MODl;
            const int pflags = pp->pad;
            if (!(pflags & 128)) { gdn::G3Args A; A.B = gdn_bufs(w, l); A.P = w.P; A.norm_g = I->gdn_norm_g + (size_t)l * HD; A.Y = w.Y; gdn::g3_phase(A, lds, G, wg, tid); }
            if (!(pflags & 256)) lru::finish_phase(lru_bufs(w), w.P, w.Y, gtid, gthreads);
        }
        SEAM(pb + 6);
        if (ON(7) && IN(pb + 7)) { PHASE_WS; PHASE_IDS; const float* MODl = w.MOD + (size_t)l * (BATCH + 1) * NMODV; (void)MODl;
            { pg8::Gemm g{w.Y, w.WOUT + l * SZ_WOUT, M_LAT, D_MODEL, D_MODEL, D_MODEL}; pg8::StaticOrder S; S.init(M_LAT, D_MODEL, G, wg);
              pg8::EpiGateRes E{l == 0 ? I->x : w.H, w.H, D_MODEL, MODl + 2 * D_MODEL, NMODV, SEQ, BATCH, M_LAT};
              pg8::gemm_phase<pg8::EpiGateRes, pg8::StaticOrder, true, true>((PG8_LAS unsigned char*)lds_raw, g, S, E, tid); }
            if (want_ctx) { constexpr int SK = SK_OUT;
              pg8::Gemm g{w.Y + (size_t)M_LAT * D_MODEL, w.WOUT + l * SZ_WOUT, M_CTX, D_MODEL, D_MODEL / SK, D_MODEL}; SplitOrder S; S.init(M_CTX, D_MODEL, SK, G, (wg + G / 2) % G);
              pg8::EpiPart E{w.PART, D_MODEL, (size_t)M_CTX * D_MODEL};
              pg8::gemm_phase<pg8::EpiPart, SplitOrder, true, true>((PG8_LAS unsigned char*)lds_raw, g, S, E, tid); } }
        SEAM(pb + 7);
        if (ON(8) && IN(pb + 8)) { PHASE_WS; PHASE_IDS; const float* MODl = w.MOD + (size_t)l * (BATCH + 1) * NMODV; (void)MODl; misc::norm_phase(w.H, I->norm_ffn_g + (size_t)l * D_MODEL, MODl, 3, w.U, Mo, gwave, nwaves, lane, want_ctx ? w.PART : nullptr, SK_OUT, MODl + (size_t)BATCH * NMODV + 2 * D_MODEL, nullptr, nullptr); }
        SEAM(pb + 8);
        if (ON(9) && IN(pb + 9)) { PHASE_WS; PHASE_IDS; const float* MODl = w.MOD + (size_t)l * (BATCH + 1) * NMODV; (void)MODl; pg8::Gemm g{w.U, w.WUP + l * SZ_WUP, Mo, 2 * D_FF, D_MODEL, D_MODEL}; pg8::StaticOrder S; S.init(Mo, 2 * D_FF, G, wg);
            pg8::EpiConvAct E{w.ACT, w.HALO, I->ffn_conv_w + (size_t)l * 3 * 2 * D_FF, I->ffn_conv_b + (size_t)l * 2 * D_FF, D_FF};
            pg8::gemm_phase<pg8::EpiConvAct, pg8::StaticOrder, false, true>((PG8_LAS unsigned char*)lds_raw, g, S, E, tid); }
        SEAM(pb + 9);
        if (ON(10) && IN(pb + 10)) { PHASE_WS; PHASE_IDS; const float* MODl = w.MOD + (size_t)l * (BATCH + 1) * NMODV; (void)MODl; misc::act_fix_phase(w.HALO, I->ffn_conv_w + (size_t)l * 3 * 2 * D_FF, I->ffn_conv_b + (size_t)l * 2 * D_FF, w.ACT, Mo, gtid, gthreads); }
        SEAM(pb + 10);
        if (ON(11) && IN(pb + 11)) { PHASE_WS; PHASE_IDS; const float* MODl = w.MOD + (size_t)l * (BATCH + 1) * NMODV; (void)MODl;
            { pg8::Gemm g{w.ACT, w.WDOWN + l * SZ_WDOWN, M_LAT, D_MODEL, D_FF, D_FF}; pg8::StaticOrder S; S.init(M_LAT, D_MODEL, G, wg);
              pg8::EpiGateRes E{w.H, want_ctx ? w.H : pp->out, D_MODEL, MODl + 5 * D_MODEL, NMODV, SEQ, BATCH, M_LAT};
              pg8::gemm_phase<pg8::EpiGateRes, pg8::StaticOrder, true, true>((PG8_LAS unsigned char*)lds_raw, g, S, E, tid); }
            if (want_ctx) { constexpr int SK = SK_DOWN;
              pg8::Gemm g{w.ACT + (size_t)M_LAT * D_FF, w.WDOWN + l * SZ_WDOWN, M_CTX, D_MODEL, D_FF / SK, D_FF}; SplitOrder S; S.init(M_CTX, D_MODEL, SK, G, (wg + G / 2) % G);
              pg8::EpiPart E{w.PART, D_MODEL, (size_t)M_CTX * D_MODEL};
              pg8::gemm_phase<pg8::EpiPart, SplitOrder, true, true>((PG8_LAS unsigned char*)lds_raw, g, S, E, tid); } }
        SEAM(pb + 11);

}
__global__ void __launch_bounds__(NTHR, 2) fwd(Params p) {
    extern __shared__ __attribute__((aligned(16))) unsigned char lds_raw[];
    char* lds = (char*)lds_raw;
    const int G = (int)gridDim.x, wg = (int)blockIdx.x, nwaves = G * NWAVES, gthreads = G * NTHR;
    const int C_wave0 = __builtin_amdgcn_readfirstlane((int)threadIdx.x >> 6);
    volatile LAS unsigned* MISC = (volatile LAS unsigned*)(lds_raw + LDS_MISC);
    if (threadIdx.x < 32) MISC[threadIdx.x] = 0u;
    __syncthreads();
    const int lo = p.ph_lo, hi = p.ph_hi;
    unsigned* const barw = (unsigned*)p.ws + CW_BAR + (size_t)p.li * XCD_BAR_WORDS;
    XcdBarrier bar; bar.bar = barw; bar.x = 0; bar.st = MISC + 8;
    if (hi - lo > 1) bar = xcd_barrier_post(barw, MISC + 8, threadIdx.x == 0);

    if (ON(12) && IN(PH_PRO)) { PHASE_WS; PHASE_IDS;
        {
            float* SCs = (float*)lds;
            float* red = (float*)(lds + 3 * D_MODEL * 4);
            constexpr int NT = DEPTH * NMODV / 256;
            if (wg < NT) {
                for (int i = tid; i < (BATCH + 1) * D_MODEL; i += NTHR) { const int s = i / D_MODEL, k = i % D_MODEL; const float v = s < BATCH ? I->c[s * D_MODEL + k] : I->c_ctx[k]; SCs[i] = v / (1.0f + __expf(-v)); }
                __syncthreads();
            }
            for (int t = wg; t < NT; t += G) { const int l = t / (NMODV / 256), j0 = (t % (NMODV / 256)) * 256;
                misc::f32x4 acc[3] = {{0.f, 0.f, 0.f, 0.f}, {0.f, 0.f, 0.f, 0.f}, {0.f, 0.f, 0.f, 0.f}};
                const float* wp = I->ada_w + (size_t)l * D_MODEL * NMODV + (size_t)(256 * wave) * NMODV + j0 + 4 * lane;
#pragma unroll 8
                for (int k = 0; k < 256; ++k) { const misc::f32x4 wv = *(const misc::f32x4*)(wp + (size_t)k * NMODV); const int kk = 256 * wave + k;
                    acc[0] += wv * SCs[kk]; acc[1] += wv * SCs[D_MODEL + kk]; acc[2] += wv * SCs[2 * D_MODEL + kk]; }
                __syncthreads();
#pragma unroll
                for (int s = 0; s < 3; ++s) *(misc::f32x4*)(red + (wave * 3 + s) * 256 + 4 * lane) = acc[s];
                __syncthreads();
                for (int i = tid; i < 3 * 256; i += NTHR) { const int s = i / 256, c = i % 256; float sum = I->ada_b[(size_t)l * NMODV + j0 + c];
#pragma unroll
                    for (int w8 = 0; w8 < 8; ++w8) sum += red[(w8 * 3 + s) * 256 + c];
                    w.MOD[((size_t)l * (BATCH + 1) + s) * NMODV + j0 + c] = sum; }
            }
            __syncthreads();
        }
        {
            float* scr = (float*)(lds + wave * 8448);
            constexpr int I_IN = (D_MODEL / 64) * (NP / 32), I_OUT = (D_MODEL / 64) * (D_MODEL / 32), I_UP = (D_MODEL / 64) * (2 * D_FF / 32), I_DN = (D_FF / 64) * (D_MODEL / 32),
                          I_UQ = (MLA_Q_LORA / 64) * (NQ_MLA / 32), I_UKV = (MLA_KV_LORA / 64) * (NKV_MLA / 32), I_LB = (LRU_BW / 64) * (LRU_BW / 32), I_LRU = 2 * 2 * NH * I_LB;
            constexpr int I_LAYER = I_IN + I_OUT + I_UP + I_DN + I_UQ + I_UKV + I_LRU;
            for (int it = gwave; it < DEPTH * I_LAYER; it += nwaves) { const int l = it / I_LAYER; int r = it % I_LAYER;
                if (r < I_IN) { misc::transpose_item(I->w_in + (size_t)l * D_MODEL * IN_COLS, D_MODEL, IN_COLS, NP, w.WIN + l * SZ_WIN, scr, r, lane); continue; } r -= I_IN;
                if (r < I_OUT) { misc::transpose_item(I->w_out + (size_t)l * D_MODEL * D_MODEL, D_MODEL, D_MODEL, D_MODEL, w.WOUT + l * SZ_WOUT, scr, r, lane); continue; } r -= I_OUT;
                if (r < I_UP) { misc::transpose_item(I->ffn_w_up + (size_t)l * D_MODEL * 2 * D_FF, D_MODEL, 2 * D_FF, 2 * D_FF, w.WUP + l * SZ_WUP, scr, r, lane, D_FF); continue; } r -= I_UP;
                if (r < I_DN) { misc::transpose_item(I->ffn_w_down + (size_t)l * D_FF * D_MODEL, D_FF, D_MODEL, D_MODEL, w.WDOWN + l * SZ_WDOWN, scr, r, lane); continue; } r -= I_DN;
                if (r < I_UQ) { misc::transpose_item(I->mla_w_uq + (size_t)l * MLA_Q_LORA * NQ_MLA, MLA_Q_LORA, NQ_MLA, NQ_MLA, w.WUQ + l * SZ_WUQ, scr, r, lane); continue; } r -= I_UQ;
                if (r < I_UKV) { misc::transpose_item(I->mla_w_ukv + (size_t)l * MLA_KV_LORA * NKV_MLA, MLA_KV_LORA, NKV_MLA, NKV_MLA, w.WUKV + l * SZ_WUKV, scr, r, lane); continue; } r -= I_UKV;
                { const int blk = r / I_LB, item = r % I_LB, d = blk / (2 * NH), wh = (blk / NH) & 1, nb = blk % NH;
                  const float* src = (wh == 0 ? I->lru_wa : I->lru_wx) + ((size_t)(l * 2 + d) * NH + nb) * lru::SZ_WBLK;
                  misc::transpose_item(src, LRU_BW, LRU_BW, LRU_BW, w.WLRU + ((size_t)l * 16 + blk) * lru::SZ_WBLK, scr, item, lane); }
            }
        }
    }
    SEAM(PH_PRO);

    { LayerCtx C; C.lo = lo; C.hi = hi; C.G = G; C.wg = wg; C.nwaves = nwaves; C.gthreads = gthreads; C.wave0 = C_wave0; C.bar = bar; C.lds = lds; C.lds_raw = lds_raw;
      static_assert(DEPTH == 4, "layer calls are written out (a real layer loop lets LICM park loop-invariant values in registers across every phase: spills)");
      layer_body<0>(C); layer_body<1>(C); layer_body<2>(C); layer_body<3>(C); }
#undef IN
#undef SEAM
}

#ifndef MK_PHASES_PER_LAUNCH
#define MK_PHASES_PER_LAUNCH NPH
#endif
extern "C" void kernel_launch(void* const* d_in, const int* in_sizes, int n_in, void* d_out, int out_size, void* d_ws, size_t ws_size, hipStream_t stream) {
    static int grid = 0;
    if (grid == 0) {
        int dev = 0, cus = 0;
        if (hipGetDevice(&dev) != hipSuccess || hipDeviceGetAttribute(&cus, hipDeviceAttributeMultiprocessorCount, dev) != hipSuccess || cus <= 0) { fprintf(stderr, "kernel_launch: no device\n"); grid = -1; return; }
        if (hipFuncSetAttribute((const void*)fwd, hipFuncAttributeMaxDynamicSharedMemorySize, LDS_BYTES) != hipSuccess) { fprintf(stderr, "kernel_launch: hipFuncSetAttribute failed\n"); grid = -1; return; }
        int per_cu = 0; if (hipOccupancyMaxActiveBlocksPerMultiprocessor(&per_cu, (const void*)fwd, NTHR, LDS_BYTES) != hipSuccess || per_cu < 1) fprintf(stderr, "kernel_launch: occupancy query says %d blocks per CU\n", per_cu);
        (void)hipGetLastError();
        grid = cus;
        const WS w0 = ws_carve(nullptr);
        if (n_in != 34 || w0.total > ws_size) { fprintf(stderr, "kernel_launch: bad inputs / workspace (need %zu, have %zu)\n", w0.total, ws_size); grid = -1; return; }
    }
    if (grid < 0) return;
    (void)hipMemsetAsync(d_ws, 0, 1 << 20, stream);
    Params p; memset(&p, 0, sizeof(p));
    for (int i = 0; i < 34; ++i) p.in[i] = (const float*)d_in[i];
    p.out = (float*)d_out; p.ws = (unsigned char*)d_ws;
    int li = 0;
    for (int lo = 0; lo < NPH; lo += MK_PHASES_PER_LAUNCH, ++li) {
        p.ph_lo = lo; p.ph_hi = lo + MK_PHASES_PER_LAUNCH < NPH ? lo + MK_PHASES_PER_LAUNCH : NPH; p.li = li;
#if defined(PROBE_MASK)
        if (MK_PHASES_PER_LAUNCH == 1 && ((((PROBE_MASK) >> 12) & 1 && lo == 0) || (lo > 0 && (((PROBE_MASK) >> ((lo - 1) % PH_PER_LAYER)) & 1))))
            { Params q = p;
#if defined(PROBE_FLAGS)
              q.pad = PROBE_FLAGS;
#endif
              for (int r = 0; r < PROBE_REPS; ++r) hipLaunchKernelGGL(fwd, dim3(grid), dim3(NTHR), LDS_BYTES, stream, q); }
#endif
        hipLaunchKernelGGL(fwd, dim3(grid), dim3(NTHR), LDS_BYTES, stream, p);
    }
}
```

```cpp
#include <hip/hip_runtime.h>
#include <cstdio>
#include <cstdint>
#include <cstring>
#include <math.h>
#include <stdint.h>

#ifdef CFG_SMALL
constexpr int D_MODEL = 256, BATCH = 2, SEQ = 512, DEPTH = 2, CTX_LEN = 64, GRID_W = 32, HEAD_DIM = 16;
#else
constexpr int D_MODEL = 2048, BATCH = 2, SEQ = 8192, DEPTH = 4, CTX_LEN = 256, GRID_W = 64, HEAD_DIM = 128;
#endif
constexpr int GROUP_W = D_MODEL / 4, NH = GROUP_W / HEAD_DIM;
constexpr int HD = HEAD_DIM;
constexpr int N_MOD = 6;
constexpr float EPS = 1e-6f;
constexpr int LRU_W = GROUP_W, LRU_BW = LRU_W / NH;
constexpr float LRU_C = 8.0f;
constexpr int MLA_Q_LORA = 3 * D_MODEL / 16, MLA_KV_LORA = D_MODEL / 8, MLA_NOPE = HD, MLA_ROPE = HD / 2, MLA_V = HD, MLA_QK = MLA_NOPE + MLA_ROPE;
constexpr int GDN_CHUNK = 64;
constexpr int NA_KH = 8, NA_KW = 16;
constexpr int D_FF = 5 * D_MODEL / 2;
constexpr int ROWS = SEQ / GRID_W;
constexpr int C_LRU_X = 0, C_LRU_G = C_LRU_X + LRU_W, C_CQ = C_LRU_G + LRU_W, C_CKV = C_CQ + MLA_Q_LORA, C_KR = C_CKV + MLA_KV_LORA,
              C_GQ = C_KR + MLA_ROPE, C_GK = C_GQ + GROUP_W, C_GV = C_GK + GROUP_W, C_GG = C_GV + GROUP_W, C_GB = C_GG + GROUP_W,
              C_GA = C_GB + 2 * NH, C_NQ = C_GA + 2 * NH, C_NK = C_NQ + GROUP_W, C_NV = C_NK + GROUP_W, IN_COLS = C_NV + GROUP_W;
constexpr int NP = (IN_COLS + 255) / 256 * 256;
constexpr int M_LAT = BATCH * SEQ, M_CTX = BATCH * CTX_LEN, M_ALL = M_LAT + M_CTX;
constexpr int NMODV = N_MOD * D_MODEL;

typedef unsigned short bf16_t;
__host__ __device__ __forceinline__ bf16_t f2bf(float f) { union { float f; unsigned u; } v; v.f = f; unsigned u = v.u; u += 0x7fffu + ((u >> 16) & 1u); return (bf16_t)(u >> 16); }
__host__ __device__ __forceinline__ float bf2f(bf16_t b) { union { float f; unsigned u; } v; v.u = ((unsigned)b) << 16; return v.f; }
__host__ __device__ __forceinline__ float sigmoidf_(float x) { return 1.0f / (1.0f + expf(-x)); }
__host__ __device__ __forceinline__ float siluf_(float x) { return x / (1.0f + expf(-x)); }
__host__ __device__ __forceinline__ float softplusf_(float x) { return fmaxf(x, 0.0f) + log1pf(expf(-fabsf(x))); }
__host__ __device__ __forceinline__ float geluf_(float x) { return 0.5f * x * (1.0f + tanhf(0.7978845608028654f * (x + 0.044715f * x * x * x))); }

struct RowInfo { int b, t, T, base, set; };
__host__ __device__ __forceinline__ RowInfo row_info(int r) {
    RowInfo i;
    if (r < M_LAT) { i.b = r / SEQ; i.t = r % SEQ; i.T = SEQ; i.base = i.b * SEQ; i.set = i.b; }
    else { const int rr = r - M_LAT; i.b = rr / CTX_LEN; i.t = rr % CTX_LEN; i.T = CTX_LEN; i.base = M_LAT + i.b * CTX_LEN; i.set = BATCH; }
    return i;
}


__host__ __device__ __forceinline__ float bflo(unsigned w) { union { float f; unsigned u; } v; v.u = w << 16; return v.f; }
__host__ __device__ __forceinline__ float bfhi(unsigned w) { union { float f; unsigned u; } v; v.u = w & 0xffff0000u; return v.f; }
#define LDS_BARRIER() asm volatile("s_waitcnt lgkmcnt(0)\n\ts_barrier" ::: "memory")
__device__ __forceinline__ float lane_xor(float v, int mask, int lane) { return __int_as_float(__builtin_amdgcn_ds_bpermute((lane ^ mask) << 2, __float_as_int(v))); }
__device__ __forceinline__ float lane_get(float v, int src_lane) { return __int_as_float(__builtin_amdgcn_ds_bpermute(src_lane << 2, __float_as_int(v))); }
struct Inputs {
    const float *x, *c, *ctx, *c_ctx, *ada_w, *ada_b, *norm_mix_g, *norm_ffn_g, *w_in, *w_out,
        *lru_conv_w, *lru_conv_b, *lru_wa, *lru_ba, *lru_wx, *lru_bx, *lru_lam,
        *mla_qa_g, *mla_w_uq, *mla_kva_g, *mla_w_ukv, *mla_qn_g, *mla_kn_g,
        *gdn_conv_w, *gdn_a_log, *gdn_dt_bias, *gdn_norm_g, *na_qn_g, *na_kn_g, *na_rpb,
        *ffn_w_up, *ffn_conv_w, *ffn_conv_b, *ffn_w_down;
};
constexpr int NQ_MLA = NH * MLA_QK, NKV_MLA = NH * (MLA_NOPE + MLA_V);
constexpr size_t SZ_WIN = (size_t)NP * D_MODEL, SZ_WOUT = (size_t)D_MODEL * D_MODEL, SZ_WUP = (size_t)2 * D_FF * D_MODEL, SZ_WDOWN = (size_t)D_MODEL * D_FF,
                 SZ_WUQ = (size_t)NQ_MLA * MLA_Q_LORA, SZ_WUKV = (size_t)NKV_MLA * MLA_KV_LORA, SZ_WLRU = (size_t)16 * LRU_BW * LRU_BW;
struct WS {
    unsigned* ctl; float *MOD, *H, *PART; bf16_t *U, *Y;
    bf16_t *WIN, *WOUT, *WUP, *WDOWN, *WUQ, *WUKV, *WLRU;
    bf16_t* P; bf16_t *CQN, *CKVN, *QR, *KVR, *QM, *KM, *VM, *NQ, *NK;
    bf16_t *gUT, *gWP, *gKDT, *gQD, *gQK, *gSIT, *gVNT; float *gGT, *gSS;
    bf16_t *lHLOC, *lACUM; float *lLSUM, *lHIN;
    bf16_t *HALO, *ACT;
    size_t total;
};
__host__ __device__ inline WS ws_carve(void* base) {
    WS w; size_t off = 0; char* b = (char*)base;
#define WS_TAKE(T, field, bytes) do { w.field = (T*)(b + off); off += (((size_t)(bytes)) + 255) & ~(size_t)255; } while (0)
    WS_TAKE(unsigned, ctl, 1 << 20);
    WS_TAKE(float, MOD, sizeof(float) * (size_t)DEPTH * (BATCH + 1) * NMODV);
    WS_TAKE(float, H, sizeof(float) * (size_t)M_ALL * D_MODEL);
    WS_TAKE(float, PART, sizeof(float) * (size_t)5 * M_CTX * D_MODEL);
    WS_TAKE(bf16_t, U, 2 * (size_t)M_ALL * D_MODEL);
    WS_TAKE(bf16_t, Y, 2 * (size_t)M_ALL * D_MODEL);
    WS_TAKE(bf16_t, WIN, 2 * SZ_WIN * DEPTH); WS_TAKE(bf16_t, WOUT, 2 * SZ_WOUT * DEPTH); WS_TAKE(bf16_t, WUP, 2 * SZ_WUP * DEPTH); WS_TAKE(bf16_t, WDOWN, 2 * SZ_WDOWN * DEPTH);
    WS_TAKE(bf16_t, WUQ, 2 * SZ_WUQ * DEPTH); WS_TAKE(bf16_t, WUKV, 2 * SZ_WUKV * DEPTH); WS_TAKE(bf16_t, WLRU, 2 * SZ_WLRU * DEPTH);
    const size_t r0 = off;
    WS_TAKE(bf16_t, P, 2 * (size_t)M_ALL * NP);
    WS_TAKE(bf16_t, CQN, 2 * (size_t)M_ALL * MLA_Q_LORA); WS_TAKE(bf16_t, CKVN, 2 * (size_t)M_ALL * MLA_KV_LORA);
    WS_TAKE(bf16_t, QR, 2 * (size_t)M_ALL * NQ_MLA); WS_TAKE(bf16_t, KVR, 2 * (size_t)M_ALL * NKV_MLA);
    WS_TAKE(bf16_t, QM, 2 * (size_t)M_ALL * NQ_MLA); WS_TAKE(bf16_t, KM, 2 * (size_t)M_ALL * NQ_MLA); WS_TAKE(bf16_t, VM, 2 * (size_t)M_ALL * NH * MLA_V);
    WS_TAKE(bf16_t, NQ, 2 * (size_t)M_ALL * GROUP_W); WS_TAKE(bf16_t, NK, 2 * (size_t)M_ALL * GROUP_W);
    { constexpr size_t NT_ = (size_t)(M_ALL / 64) * NH * 2;
      WS_TAKE(bf16_t, gUT, 2 * NT_ * 128 * 64); WS_TAKE(bf16_t, gWP, 2 * NT_ * 64 * 128); WS_TAKE(bf16_t, gKDT, 2 * NT_ * 128 * 64); WS_TAKE(bf16_t, gQD, 2 * NT_ * 64 * 128);
      WS_TAKE(bf16_t, gQK, 2 * NT_ * 64 * 64); WS_TAKE(bf16_t, gSIT, 2 * NT_ * 128 * 128); WS_TAKE(bf16_t, gVNT, 2 * NT_ * 128 * 64); WS_TAKE(float, gGT, 4 * NT_ * DEPTH); WS_TAKE(float, gSS, 4 * (size_t)BATCH * NH * 2 * HD * HD); }
    WS_TAKE(bf16_t, lHLOC, 2 * (size_t)2 * M_ALL * LRU_W); WS_TAKE(bf16_t, lACUM, 2 * (size_t)2 * M_ALL * LRU_W);
    WS_TAKE(float, lLSUM, 4 * (size_t)(M_ALL / 64) * 2 * 2 * LRU_W); WS_TAKE(float, lHIN, 4 * (size_t)(M_ALL / 64) * 2 * LRU_W);
    const size_t r1 = off;
    off = r0;
    WS_TAKE(bf16_t, HALO, 2 * (size_t)(M_ALL / 64) * 4 * 2 * D_FF); WS_TAKE(bf16_t, ACT, 2 * (size_t)M_ALL * D_FF);
    const size_t f1 = off;
#undef WS_TAKE
    w.total = r1 > f1 ? r1 : f1;
    return w;
}

namespace pg8 {
#define PG8_LAS __attribute__((address_space(3)))
typedef unsigned short bf16_t;
typedef short bf16x8 __attribute__((ext_vector_type(8)));
typedef float f32x4 __attribute__((ext_vector_type(4)));
typedef unsigned u32x4 __attribute__((ext_vector_type(4)));
constexpr int BM = 256, BK = 64, HALF = 128, HTB = HALF * BK * 2  , STAGE_BYTES = 8 * HTB, NXCD = 8, WGM = 8;

__host__ __device__ __forceinline__ int lds_byte(int r, int c) { const int st = (r >> 4) * 2 + (c >> 5), rr = r & 15, cc = c & 31, ob = rr * 64 + cc * 2; return st * 1024 + (ob ^ (((ob >> 9) & 1) << 5)); }
__host__ __device__ __forceinline__ void stage_rc(int b, int& R, int& C) { const int st = b / 1024, sb = b % 1024, swz = sb ^ (((sb >> 9) & 1) << 5); R = (st >> 1) * 16 + swz / 64; C = (st & 1) * 32 + (swz % 64) / 2; }
__host__ __device__ __forceinline__ int perm32(int rho) { const int n = rho >> 4, i = rho & 15; return 8 * (i >> 2) + 4 * n + (i & 3); }

struct Unit { int pm, pn, ks; };
struct Gemm { const bf16_t* A; const bf16_t* Bt; int M, N, K, ld; };

struct StaticOrder {
    int nM, nN, nwg, G, c;
    __host__ __device__ void init(int M, int N, int G_, int c_) { nM = M / BM; nN = N / BM; nwg = nM * nN; G = G_; c = c_; }
    __host__ __device__ bool next(int i, Unit& u) const {
        const long L = (long)i * G + c; if (L >= nwg) return false;
        int wgid = (int)L; { const int q = nwg / NXCD, r = nwg % NXCD, xcd = wgid % NXCD, off = wgid / NXCD; wgid = (xcd < r ? xcd * (q + 1) : r * (q + 1) + (xcd - r) * q) + off; }
        const int nig = WGM * nN, gid = wgid / nig, fm = gid * WGM, gsz = (nM - fm) < WGM ? (nM - fm) : WGM;
        u.pm = fm + ((wgid % nig) % gsz); u.pn = (wgid % nig) / gsz; u.ks = 0; return true;
    }
    __device__ __forceinline__ void a_ready(const Unit&) const {}
    __device__ __forceinline__ void done(const Unit&) const {}
};
__device__ __forceinline__ unsigned cvt_pk_bf16(float lo, float hi) { unsigned r; asm volatile("v_cvt_pk_bf16_f32 %0, %1, %2" : "=v"(r) : "v"(lo), "v"(hi)); return r; }
typedef float f32x2 __attribute__((ext_vector_type(2)));
__device__ __forceinline__ f32x2 gelu_pk(f32x2 v) {
    const f32x2 av = __builtin_elementwise_abs(v), d = av * 0.2316418882f + 1.0f;
    f32x2 t; t.x = __builtin_amdgcn_rcpf(d.x); t.y = __builtin_amdgcn_rcpf(d.y);
    f32x2 q = t * 0.5307027145f + (-0.7265760135f); q = q * t + 0.7107068705f; q = q * t + (-0.142248368f); q = q * t + 0.127414796f; q = q * t;
    const f32x2 s = (v * v) * (-0.72134752044f);
    f32x2 e; e.x = __builtin_amdgcn_exp2f(s.x); e.y = __builtin_amdgcn_exp2f(s.y);
    const f32x2 m = v * (q * e), r = v - m;
    f32x2 o; o.x = v.x < 0.f ? m.x : r.x; o.y = v.y < 0.f ? m.y : r.y; return o;
}

template <int ACT  > struct EpiBf16 {
    static constexpr bool PERM = true, AFTER_DRAIN = false; static_assert(ACT == 0 || ACT == 1, "EpiBf16: ACT is 0 (none) or 1 (gelu_pk)");
    bf16_t* O; int ldc; const float* bias; int split_cols; size_t split_stride; float scale0;
    __device__ __forceinline__ void operator()(const f32x4 (&acc)[2][2][4][2], const Unit& u, int wr, int wc, int fr, int fq) const {
        const int row0 = u.pm * BM + wr * 64 + fr; int colt = u.pn * BM; bf16_t* base = O;
        float sc = 1.f; if (split_cols) { const int t = colt / split_cols; base += (size_t)t * split_stride; colt -= t * split_cols; if (t == 0) sc = scale0; }
        const int col0 = colt + wc * 32 + 8 * fq, bcol0 = u.pn * BM + wc * 32 + 8 * fq;
        f32x4 bv[2][2];
#pragma unroll
        for (int bj = 0; bj < 2; ++bj)
#pragma unroll
            for (int n = 0; n < 2; ++n) bv[bj][n] = bias ? *(const f32x4*)(bias + bcol0 + bj * HALF + 4 * n) : (f32x4){0.f, 0.f, 0.f, 0.f};
#pragma unroll
        for (int ai = 0; ai < 2; ++ai)
#pragma unroll
            for (int m = 0; m < 4; ++m) { bf16_t* rowp = base + (size_t)(row0 + ai * HALF + m * 16) * ldc + col0;
#pragma unroll
                for (int bj = 0; bj < 2; ++bj) { f32x4 v0 = acc[ai][bj][m][0] + bv[bj][0], v1 = acc[ai][bj][m][1] + bv[bj][1];
                    if (ACT == 1) { f32x2 a = gelu_pk((f32x2){v0[0], v0[1]}), b = gelu_pk((f32x2){v0[2], v0[3]}), c = gelu_pk((f32x2){v1[0], v1[1]}), d = gelu_pk((f32x2){v1[2], v1[3]});
                        v0 = (f32x4){a.x, a.y, b.x, b.y}; v1 = (f32x4){c.x, c.y, d.x, d.y}; }
                    v0 = v0 * sc; v1 = v1 * sc; u32x4 w; w.x = cvt_pk_bf16(v0[0], v0[1]); w.y = cvt_pk_bf16(v0[2], v0[3]); w.z = cvt_pk_bf16(v1[0], v1[1]); w.w = cvt_pk_bf16(v1[2], v1[3]);
                    *(u32x4*)(rowp + bj * HALF) = w; } }
    }
};

struct EpiF32 {
    static constexpr bool PERM = false, AFTER_DRAIN = false;
    float* C; int ldc;
    __device__ __forceinline__ void operator()(const f32x4 (&acc)[2][2][4][2], const Unit& u, int wr, int wc, int fr, int fq) const {
        const int row0 = u.pm * BM + wr * 64 + fr, col0 = u.pn * BM + wc * 32 + 4 * fq;
#pragma unroll
        for (int ai = 0; ai < 2; ++ai)
#pragma unroll
            for (int m = 0; m < 4; ++m) { float* rowp = C + (size_t)(row0 + ai * HALF + m * 16) * ldc + col0;
#pragma unroll
                for (int bj = 0; bj < 2; ++bj)
#pragma unroll
                    for (int n = 0; n < 2; ++n) *(f32x4*)(rowp + bj * HALF + n * 16) = acc[ai][bj][m][n]; }
    }
};
struct EpiGateRes {
    static constexpr bool PERM = false, AFTER_DRAIN = false;
    const float* base; float* out; int ldc; const float* gate; int set_stride; int rows_per_set; int nsets_lat; int lat_rows;
    __device__ __forceinline__ void operator()(const f32x4 (&acc)[2][2][4][2], const Unit& u, int wr, int wc, int fr, int fq) const {
        const int row0 = u.pm * BM + wr * 64 + fr, col0 = u.pn * BM + wc * 32 + 4 * fq;
        const int set = (u.pm * BM >= lat_rows) ? nsets_lat : (u.pm * BM) / rows_per_set;
        const float* gp = gate + (size_t)set * set_stride + col0;
        f32x4 gv[2][2];
#pragma unroll
        for (int bj = 0; bj < 2; ++bj)
#pragma unroll
            for (int n = 0; n < 2; ++n) gv[bj][n] = *(const f32x4*)(gp + bj * HALF + n * 16);
#pragma unroll
        for (int ai = 0; ai < 2; ++ai)
#pragma unroll
            for (int m = 0; m < 4; ++m) { const size_t off = (size_t)(row0 + ai * HALF + m * 16) * ldc + col0;
#pragma unroll
                for (int bj = 0; bj < 2; ++bj)
#pragma unroll
                    for (int n = 0; n < 2; ++n) { const f32x4 b = *(const f32x4*)(base + off + bj * HALF + n * 16); *(f32x4*)(out + off + bj * HALF + n * 16) = b + gv[bj][n] * acc[ai][bj][m][n]; } }
    }
};

struct EpiConvAct {
    static constexpr bool PERM = false, AFTER_DRAIN = false;
    bf16_t* ACT; bf16_t* HALO; const float* cw; const float* cb; int dff;
    __device__ __forceinline__ static float ror1(float v) { return __int_as_float(__builtin_amdgcn_update_dpp(0, __float_as_int(v), 0x121, 0xf, 0xf, false)); }
    __device__ __forceinline__ static float rol1(float v) { return __int_as_float(__builtin_amdgcn_update_dpp(0, __float_as_int(v), 0x12f, 0xf, 0xf, false)); }
    __device__ __forceinline__ void operator()(const f32x4 (&acc)[2][2][4][2], const Unit& u, int wr, int wc, int fr, int fq) const {
        const int rowb = u.pm * BM + wr * 64, chb = u.pn * HALF + wc * 32 + 4 * fq;
        const bool f0 = fr == 0, f15 = fr == 15;
        typedef float f32x2 __attribute__((ext_vector_type(2)));
#pragma unroll
        for (int n = 0; n < 2; ++n)
#pragma unroll
            for (int ep = 0; ep < 2; ++ep) { const int ch = chb + 16 * n + 2 * ep;
                f32x2 wa[3], wg[3], ba, bg;
#pragma unroll
                for (int k = 0; k < 3; ++k) { wa[k] = *(const f32x2*)(cw + (size_t)k * 2 * dff + ch); wg[k] = *(const f32x2*)(cw + (size_t)k * 2 * dff + dff + ch); }
                ba = *(const f32x2*)(cb + ch); bg = *(const f32x2*)(cb + dff + ch);
#pragma unroll
                for (int ai = 0; ai < 2; ++ai) { const int blk = (rowb + ai * HALF) >> 6;
                    float y[4][2];
#pragma unroll
                    for (int eo = 0; eo < 2; ++eo) { const int e = 2 * ep + eo;
                        float Ra[4], La[4], Rg[4], Lg[4];
#pragma unroll
                        for (int m = 0; m < 4; ++m) { Ra[m] = ror1(acc[ai][0][m][n][e]); La[m] = rol1(acc[ai][0][m][n][e]); Rg[m] = ror1(acc[ai][1][m][n][e]); Lg[m] = rol1(acc[ai][1][m][n][e]); }
#pragma unroll
                        for (int m = 0; m < 4; ++m) {
                            const float ap = f0 ? Ra[m > 0 ? m - 1 : 0] : Ra[m], an = f15 ? La[m < 3 ? m + 1 : 3] : La[m];
                            const float gp = f0 ? Rg[m > 0 ? m - 1 : 0] : Rg[m], gn = f15 ? Lg[m < 3 ? m + 1 : 3] : Lg[m];
                            const float a = ba[eo] + wa[0][eo] * ap + wa[1][eo] * acc[ai][0][m][n][e] + wa[2][eo] * an;
                            const float g = bg[eo] + wg[0][eo] * gp + wg[1][eo] * acc[ai][1][m][n][e] + wg[2][eo] * gn;
                            y[m][eo] = a * (g * __builtin_amdgcn_rcpf(1.0f + __expf(-g))); }
                    }
#pragma unroll
                    for (int m = 0; m < 4; ++m) { const int row = rowb + ai * HALF + 16 * m + fr;
                        *(unsigned*)(ACT + (size_t)row * dff + ch) = cvt_pk_bf16(y[m][0], y[m][1]);
                        if ((m == 0 && fr < 2) || (m == 3 && fr >= 14)) { const int slot = m == 0 ? fr : fr - 12; bf16_t* hp = HALO + ((size_t)blk * 4 + slot) * (2 * dff) + ch;
                            *(unsigned*)hp = cvt_pk_bf16(acc[ai][0][m][n][2 * ep], acc[ai][0][m][n][2 * ep + 1]);
                            *(unsigned*)(hp + dff) = cvt_pk_bf16(acc[ai][1][m][n][2 * ep], acc[ai][1][m][n][2 * ep + 1]); }
                    }
                }
            }
    }
};

struct EpiPart {
    static constexpr bool PERM = false, AFTER_DRAIN = false;
    float* C; int ldc; size_t ks_stride;
    __device__ __forceinline__ void operator()(const f32x4 (&acc)[2][2][4][2], const Unit& u, int wr, int wc, int fr, int fq) const {
        const int row0 = u.pm * BM + wr * 64 + fr, col0 = u.pn * BM + wc * 32 + 4 * fq; float* Cb = C + (size_t)u.ks * ks_stride;
#pragma unroll
        for (int ai = 0; ai < 2; ++ai)
#pragma unroll
            for (int m = 0; m < 4; ++m) { float* rowp = Cb + (size_t)(row0 + ai * HALF + m * 16) * ldc + col0;
#pragma unroll
                for (int bj = 0; bj < 2; ++bj)
#pragma unroll
                    for (int n = 0; n < 2; ++n) *(f32x4*)(rowp + bj * HALF + n * 16) = acc[ai][bj][m][n]; }
    }
};

template <class Epi, class Sched, bool ALIGN_EPI = false, bool SP2 = false>
__device__ __forceinline__ void gemm_phase(PG8_LAS unsigned char* lds, const Gemm g, const Sched& S, const Epi& E, const int tid_in) {
    int tid_ = tid_in; asm volatile("" : "+v"(tid_));
    const int tid = tid_, wid = __builtin_amdgcn_readfirstlane(tid >> 6), lane = tid & 63, wr = wid >> 2, wc = wid & 3, fr = lane & 15, fq = lane >> 4;
    const int K = g.K, nt = K / BK;
    unsigned voffA[2], voffB[2];
#pragma unroll
    for (int i = 0; i < 2; ++i) { int R, C; stage_rc(tid * 16 + i * 8192, R, C); const int Rb = Epi::PERM ? ((R & ~31) + perm32(R & 31)) : R;
        voffA[i] = (unsigned)(R * g.ld + C) * 2u; voffB[i] = (unsigned)(Rb * g.ld + C) * 2u; }
    const size_t kstep = (size_t)(BK * 2);
    const size_t hstep = (size_t)HALF * g.ld * 2;
    const size_t tstep = 2 * hstep;
    const unsigned ldsw = (unsigned)wid * 1024u;
    const int aoff = lds_byte(wr * 64 + fr, fq * 8), boff = lds_byte(wc * 32 + fr, fq * 8);
#define PG8_SA(b, h) (((b) * 2 + (h)) * HTB)
#define PG8_SB(b, h) ((4 + (b) * 2 + (h)) * HTB)
#define PG8_STAGE(bufoff, gbase, voff) do { _Pragma("unroll") for (int _i = 0; _i < 2; ++_i) \
        __builtin_amdgcn_global_load_lds((const unsigned*)((const char*)(gbase) + (voff)[_i]), (PG8_LAS unsigned*)(lds + (bufoff) + ldsw + _i * 8192), 16, 0, 0); } while (0)
#define PG8_LDA(dst, b, h) do { _Pragma("unroll") for (int m = 0; m < 4; ++m) _Pragma("unroll") for (int k = 0; k < 2; ++k) dst[m][k] = *(const PG8_LAS bf16x8*)(lds + PG8_SA(b, h) + aoff + m * 2048 + k * 1024); } while (0)
#define PG8_LDB(dst, b, h) do { _Pragma("unroll") for (int n = 0; n < 2; ++n) _Pragma("unroll") for (int k = 0; k < 2; ++k) dst[n][k] = *(const PG8_LAS bf16x8*)(lds + PG8_SB(b, h) + boff + n * 2048 + k * 1024); } while (0)
#define PG8_MMA(ai, bj, At, Bt) do { __builtin_amdgcn_s_setprio(1); _Pragma("unroll") for (int m = 0; m < 4; ++m) _Pragma("unroll") for (int n = 0; n < 2; ++n) _Pragma("unroll") for (int k = 0; k < 2; ++k) \
        acc[ai][bj][m][n] = __builtin_amdgcn_mfma_f32_16x16x32_bf16(Bt[n][k], At[m][k], acc[ai][bj][m][n], 0, 0, 0); __builtin_amdgcn_s_setprio(0); } while (0)
#define PG8_WAIT_V(n) asm volatile("s_waitcnt vmcnt(" #n ")" ::: "memory")
#define PG8_WAIT_L(n) asm volatile("s_waitcnt lgkmcnt(" #n ")" ::: "memory")
#define PG8_BAR __builtin_amdgcn_s_barrier()
#define PG8_SCHED __builtin_amdgcn_sched_barrier(0)
    Unit cur, nxt; int ui = 0;
    if (!S.next(0, cur)) return;
    f32x4 acc[2][2][4][2];
#pragma unroll
    for (int a = 0; a < 2; ++a)
#pragma unroll
        for (int b = 0; b < 2; ++b)
#pragma unroll
            for (int m = 0; m < 4; ++m)
#pragma unroll
                for (int n = 0; n < 2; ++n) acc[a][b][m][n] = (f32x4){0.f, 0.f, 0.f, 0.f};
    bf16x8 At[4][2], B0[2][2], B1[2][2];
    const size_t ksb = (size_t)K * 2;
    const char* cA = (const char*)g.A + (size_t)cur.pm * tstep + (size_t)cur.ks * ksb; const char* cB = (const char*)g.Bt + (size_t)cur.pn * tstep + (size_t)cur.ks * ksb;
    S.a_ready(cur);
    if constexpr (SP2) {
        PG8_STAGE(PG8_SB(0, 0), cB, voffB); PG8_STAGE(PG8_SB(0, 1), cB + hstep, voffB); PG8_STAGE(PG8_SA(0, 0), cA, voffA); PG8_STAGE(PG8_SA(0, 1), cA + hstep, voffA);
        if (wr == 1) PG8_BAR;
        PG8_WAIT_V(2); PG8_BAR;
        PG8_STAGE(PG8_SB(1, 0), cB + kstep, voffB); PG8_STAGE(PG8_SA(1, 0), cA + kstep, voffA); PG8_STAGE(PG8_SB(1, 1), cB + hstep + kstep, voffB);
        PG8_WAIT_V(6); PG8_BAR;
    } else {
        PG8_STAGE(PG8_SB(0, 0), cB, voffB); PG8_STAGE(PG8_SA(0, 0), cA, voffA); PG8_STAGE(PG8_SB(0, 1), cB + hstep, voffB); PG8_STAGE(PG8_SA(0, 1), cA + hstep, voffA);
        if (wr == 1) PG8_BAR;
        PG8_WAIT_V(4); PG8_BAR;
        PG8_STAGE(PG8_SB(1, 0), cB + kstep, voffB); PG8_STAGE(PG8_SA(1, 0), cA + kstep, voffA); PG8_STAGE(PG8_SB(1, 1), cB + hstep + kstep, voffB);
        PG8_WAIT_V(6); PG8_BAR;
    }
    for (;;) {
        const bool has_next = S.next(ui + 1, nxt);
        const char* nA = has_next ? (const char*)g.A + (size_t)nxt.pm * tstep + (size_t)nxt.ks * ksb : cA; const char* nB = has_next ? (const char*)g.Bt + (size_t)nxt.pn * tstep + (size_t)nxt.ks * ksb : cB;
        for (int t = 0; t < nt; t += 2) {
            const bool last = (t == nt - 2);
            const char* a1 = cA + (size_t)(t + 1) * kstep;
            const char* a2 = last ? nA : cA + (size_t)(t + 2) * kstep; const char* b2 = last ? nB : cB + (size_t)(t + 2) * kstep;
            const char* a3 = a2 + kstep; const char* b3 = b2 + kstep;
            if (last && has_next) S.a_ready(nxt);
            if constexpr (SP2) {
            PG8_LDB(B0, 0, 0); PG8_LDB(B1, 0, 1); PG8_SCHED; PG8_LDA(At, 0, 0); PG8_STAGE(PG8_SA(1, 1), a1 + hstep, voffA);
            PG8_WAIT_V(8); PG8_WAIT_L(0); PG8_BAR; PG8_MMA(0, 0, At, B0); PG8_MMA(0, 1, At, B1); PG8_BAR; PG8_SCHED;
            PG8_LDA(At, 0, 1); PG8_STAGE(PG8_SB(0, 0), b2, voffB); PG8_STAGE(PG8_SB(0, 1), b2 + hstep, voffB); PG8_STAGE(PG8_SA(0, 0), a2, voffA);
            PG8_WAIT_V(8); PG8_WAIT_L(0); PG8_BAR; PG8_MMA(1, 0, At, B0); PG8_MMA(1, 1, At, B1); PG8_BAR; PG8_SCHED;
            PG8_LDB(B0, 1, 0); PG8_LDB(B1, 1, 1); PG8_SCHED; PG8_LDA(At, 1, 0); PG8_STAGE(PG8_SA(0, 1), a2 + hstep, voffA);
            PG8_WAIT_V(8); PG8_WAIT_L(0); PG8_BAR; PG8_MMA(0, 0, At, B0); PG8_MMA(0, 1, At, B1); PG8_BAR; PG8_SCHED;
            PG8_LDA(At, 1, 1); PG8_STAGE(PG8_SB(1, 0), b3, voffB); PG8_STAGE(PG8_SB(1, 1), b3 + hstep, voffB); PG8_STAGE(PG8_SA(1, 0), a3, voffA);
            PG8_WAIT_V(8); PG8_WAIT_L(0); PG8_BAR; PG8_MMA(1, 0, At, B0); PG8_MMA(1, 1, At, B1); PG8_BAR; PG8_SCHED;
            } else {
            PG8_LDB(B0, 0, 0); PG8_SCHED; PG8_LDA(At, 0, 0); PG8_STAGE(PG8_SA(1, 1), a1 + hstep, voffA);
            PG8_WAIT_L(8); PG8_BAR; PG8_WAIT_L(0); PG8_MMA(0, 0, At, B0); PG8_BAR; PG8_SCHED;
            PG8_LDB(B1, 0, 1); PG8_STAGE(PG8_SB(0, 0), b2, voffB);
            PG8_BAR; PG8_WAIT_L(0); PG8_MMA(0, 1, At, B1); PG8_BAR;
            PG8_LDA(At, 0, 1); PG8_STAGE(PG8_SA(0, 0), a2, voffA);
            PG8_BAR; PG8_WAIT_L(0); PG8_MMA(1, 0, At, B0); PG8_BAR; PG8_SCHED;
            PG8_STAGE(PG8_SB(0, 1), b2 + hstep, voffB);
            PG8_WAIT_V(6); PG8_BAR; PG8_MMA(1, 1, At, B1); PG8_BAR;
            PG8_LDB(B0, 1, 0); PG8_SCHED; PG8_LDA(At, 1, 0); PG8_STAGE(PG8_SA(0, 1), a2 + hstep, voffA);
            PG8_WAIT_L(8); PG8_BAR; PG8_WAIT_L(0); PG8_MMA(0, 0, At, B0); PG8_BAR; PG8_SCHED;
            PG8_LDB(B1, 1, 1); PG8_STAGE(PG8_SB(1, 0), b3, voffB);
            PG8_BAR; PG8_WAIT_L(0); PG8_MMA(0, 1, At, B1); PG8_BAR;
            PG8_LDA(At, 1, 1); PG8_STAGE(PG8_SA(1, 0), a3, voffA);
            PG8_BAR; PG8_WAIT_L(0); PG8_MMA(1, 0, At, B0); PG8_BAR; PG8_SCHED;
            PG8_STAGE(PG8_SB(1, 1), b3 + hstep, voffB);
            PG8_WAIT_V(6); PG8_BAR; PG8_MMA(1, 1, At, B1); PG8_BAR;
            }
        }
        if constexpr (ALIGN_EPI) { if (wr == 0) PG8_BAR; }
        if constexpr (!Epi::AFTER_DRAIN) { E(acc, cur, wr, wc, fr, fq); S.done(cur); }
        if (!has_next) break;
#pragma unroll
        for (int a = 0; a < 2; ++a)
#pragma unroll
            for (int b = 0; b < 2; ++b)
#pragma unroll
                for (int m = 0; m < 4; ++m)
#pragma unroll
                    for (int n = 0; n < 2; ++n) acc[a][b][m][n] = (f32x4){0.f, 0.f, 0.f, 0.f};
        cur = nxt; cA = nA; cB = nB; ++ui;
        if constexpr (ALIGN_EPI) { if (wr == 1) PG8_BAR; }
    }
    PG8_WAIT_V(0);
    if constexpr (!ALIGN_EPI) { if (wr == 0) PG8_BAR; }
    PG8_BAR;
    if constexpr (Epi::AFTER_DRAIN) { E.fused(acc, cur, wr, wc, fr, fq, lds, wid, lane); S.done(cur); }
#undef PG8_SA
#undef PG8_SB
#undef PG8_STAGE
#undef PG8_LDA
#undef PG8_LDB
#undef PG8_MMA
#undef PG8_WAIT_V
#undef PG8_WAIT_L
#undef PG8_BAR
#undef PG8_SCHED
}
}

namespace att {
using bf16x8 = __attribute__((ext_vector_type(8))) short;
using s16x4  = __attribute__((ext_vector_type(4))) short;
using f32x16 = __attribute__((ext_vector_type(16))) float;
using u32x4  = __attribute__((ext_vector_type(4))) unsigned;
constexpr int NW = 8, QBLK = 32, KVBLK = 64, DV = 128;
#define ATT_SBAR() __builtin_amdgcn_sched_barrier(0)
__device__ __forceinline__ int crow(int r, int hi) { return (r & 3) + 8 * (r >> 2) + 4 * hi; }
__device__ __forceinline__ unsigned cvtpk(float lo, float hi) { unsigned r; asm volatile("v_cvt_pk_bf16_f32 %0, %1, %2" : "=v"(r) : "v"(lo), "v"(hi)); return r; }
template <int DQK> __device__ __forceinline__ int kswz(int row, int colB) { return row * (DQK * 2) + (colB ^ ((row & 7) << 4)); }
constexpr float THR = 8.f;

template <int DQK> struct Cfg {
    static constexpr int SHM_V = KVBLK * DV * 2, SHM_K = KVBLK * DQK * 2;
    static constexpr int OFF_V = 0, OFF_K = 2 * SHM_V, OFF_WS = OFF_K + 2 * SHM_K, OFF_BIAS = OFF_WS + NW * 64 * 4, LDS_BYTES = OFF_BIAS + 10240;
    static constexpr int KCH = DQK / 8;
    static constexpr int KLD = (64 * KCH) / 512;
};

struct Job {
    const bf16_t* Q;
    const bf16_t* K;
    const bf16_t* V;
    bf16_t* O;
    int nt;
    int seg0_tiles, row_seg0, row_seg1;
    int R0; int rlo;
};

__device__ __forceinline__ int tile_row(const Job& J, int j) {
    if (j < J.seg0_tiles) return J.row_seg0 + 64 * j;
    int jj = j - J.seg0_tiles; if (jj > 3) jj = 0; return J.row_seg1 + 64 * jj;
}

__device__ __forceinline__ void partialSM(f32x16& p0, f32x16& p1, float& m_reg, float& mn, float& alpha, float C, float thr_raw) {
    float pmax = p0[0];
#pragma unroll
    for (int r = 1; r < 16; ++r) pmax = fmaxf(pmax, p0[r]);
#pragma unroll
    for (int r = 0; r < 16; ++r) pmax = fmaxf(pmax, p1[r]);
    { auto rr = __builtin_amdgcn_permlane32_swap(__float_as_uint(pmax), __float_as_uint(pmax), false, false);
      pmax = fmaxf(__uint_as_float(rr[0]), __uint_as_float(rr[1])); }
    if (__builtin_expect(__all(pmax - m_reg <= thr_raw), 1)) { mn = m_reg; alpha = 1.f; }
    else { mn = fmaxf(m_reg, pmax); alpha = __builtin_amdgcn_exp2f((m_reg - mn) * C); m_reg = mn; }
    const float mnC = -mn * C;
#pragma unroll
    for (int r = 0; r < 16; ++r) p0[r] = fmaf(p0[r], C, mnC);
#pragma unroll
    for (int r = 0; r < 16; ++r) p1[r] = fmaf(p1[r], C, mnC);
#pragma unroll
    for (int r = 0; r < 16; ++r) p0[r] = __builtin_amdgcn_exp2f(p0[r]);
}
__device__ __forceinline__ void finishSM(f32x16& p0, f32x16& p1, float alpha, float& l_reg, bf16x8& pa0, bf16x8& pa1, bf16x8& pa2, bf16x8& pa3) {
#pragma unroll
    for (int r = 0; r < 16; ++r) p1[r] = __builtin_amdgcn_exp2f(p1[r]);
    float ps = 0;
#pragma unroll
    for (int r = 0; r < 16; ++r) ps += p0[r];
#pragma unroll
    for (int r = 0; r < 16; ++r) ps += p1[r];
    { auto rr = __builtin_amdgcn_permlane32_swap(__float_as_uint(ps), __float_as_uint(ps), false, false);
      ps = __uint_as_float(rr[0]) + __uint_as_float(rr[1]); }
    l_reg = l_reg * alpha + ps;
#define ATT_PK4(P, BASE, OUT) do { unsigned a0 = cvtpk(P[BASE + 0], P[BASE + 1]), a1 = cvtpk(P[BASE + 2], P[BASE + 3]);   \
    unsigned b0 = cvtpk(P[BASE + 4], P[BASE + 5]), b1 = cvtpk(P[BASE + 6], P[BASE + 7]);                              \
    auto r0 = __builtin_amdgcn_permlane32_swap(a0, b0, false, false); auto r1 = __builtin_amdgcn_permlane32_swap(a1, b1, false, false); \
    u32x4 w = {r0[0], r1[0], r0[1], r1[1]}; OUT = *reinterpret_cast<bf16x8*>(&w); } while (0)
    ATT_PK4(p0, 0, pa0); ATT_PK4(p0, 8, pa1); ATT_PK4(p1, 0, pa2); ATT_PK4(p1, 8, pa3);
#undef ATT_PK4
}
template <int DQK> __device__ __forceinline__ void qkt(f32x16& p0, f32x16& p1, const char* Ks, const bf16x8* qr, int r32, int hi) {
    p0 = f32x16{}; p1 = f32x16{};
#pragma unroll
    for (int d0 = 0; d0 < DQK / 16; ++d0) { const int cb = (d0 * 16 + hi * 8) * 2;
        const bf16x8 b0 = *reinterpret_cast<const bf16x8*>(Ks + kswz<DQK>(r32, cb));
        const bf16x8 b1 = *reinterpret_cast<const bf16x8*>(Ks + kswz<DQK>(32 + r32, cb));
        p0 = __builtin_amdgcn_mfma_f32_32x32x16_bf16(b0, qr[d0], p0, 0, 0, 0);
        p1 = __builtin_amdgcn_mfma_f32_32x32x16_bf16(b1, qr[d0], p1, 0, 0, 0); }
}
__device__ __forceinline__ int v_st(int k, int c) { const int kk = (k & ~0xC) | ((k & 4) << 1) | ((k & 8) >> 1); return ((kk >> 3) * 4 + (c >> 5)) * 512 + ((kk & 7) * 32 + (c & 31)) * 2; }
__device__ __forceinline__ int v_rd_base(int lane) { return ((lane & 3) << 3) | (((lane >> 2) & 3) << 6) | (((lane >> 4) & 1) << 5) | (((lane >> 5) & 1) << 8); }
constexpr int v_rd_off(int d0, int ks, int half) { return d0 * 512 + ks * 4096 + half * 2048; }
template <int OFF> __device__ __forceinline__ s16x4 tr_read(int vb) { s16x4 r; asm volatile("ds_read_b64_tr_b16 %0, %1 offset:%2" : "=&v"(r) : "v"(vb), "i"(OFF) : "memory"); return r; }
template <int D0> __device__ __forceinline__ void pv_one(f32x16& od, int vb, bf16x8 pa0, bf16x8 pa1, bf16x8 pa2, bf16x8 pa3) {
    const s16x4 l0 = tr_read<v_rd_off(D0, 0, 0)>(vb), h0 = tr_read<v_rd_off(D0, 0, 1)>(vb), l1 = tr_read<v_rd_off(D0, 1, 0)>(vb), h1 = tr_read<v_rd_off(D0, 1, 1)>(vb);
    const s16x4 l2 = tr_read<v_rd_off(D0, 2, 0)>(vb), h2 = tr_read<v_rd_off(D0, 2, 1)>(vb), l3 = tr_read<v_rd_off(D0, 3, 0)>(vb), h3 = tr_read<v_rd_off(D0, 3, 1)>(vb);
    asm volatile("s_waitcnt lgkmcnt(0)" ::: "memory"); ATT_SBAR();
#define ATT_PK(L, H) (bf16x8){L[0], L[1], L[2], L[3], H[0], H[1], H[2], H[3]}
    od = __builtin_amdgcn_mfma_f32_32x32x16_bf16(pa0, ATT_PK(l0, h0), od, 0, 0, 0);
    od = __builtin_amdgcn_mfma_f32_32x32x16_bf16(pa1, ATT_PK(l1, h1), od, 0, 0, 0);
    od = __builtin_amdgcn_mfma_f32_32x32x16_bf16(pa2, ATT_PK(l2, h2), od, 0, 0, 0);
    od = __builtin_amdgcn_mfma_f32_32x32x16_bf16(pa3, ATT_PK(l3, h3), od, 0, 0, 0);
#undef ATT_PK
}
__device__ __forceinline__ void pv_d0(f32x16* o, int vb, bf16x8 pa0, bf16x8 pa1, bf16x8 pa2, bf16x8 pa3) {
    pv_one<0>(o[0], vb, pa0, pa1, pa2, pa3); pv_one<1>(o[1], vb, pa0, pa1, pa2, pa3); pv_one<2>(o[2], vb, pa0, pa1, pa2, pa3); pv_one<3>(o[3], vb, pa0, pa1, pa2, pa3);
}
constexpr int NA_BROW = 160, NA_BORG = 64 + (NA_KW - 1);
__device__ __forceinline__ void na_bias(f32x16& p0, f32x16& p1, const Job& J, int j, int R, int c, int hi, const float* biasq) {
    const int nloc = J.seg0_tiles;
    if (j >= nloc && j < nloc + 4) return;
    const int rr = J.rlo + j; int r0 = R - NA_KH / 2; r0 = r0 < 0 ? 0 : (r0 > ROWS - NA_KH ? ROWS - NA_KH : r0);
    const bool rowok = (j < nloc) && rr >= r0 && rr < r0 + NA_KH;
    if (!rowok) {
#pragma unroll
        for (int r = 0; r < 16; ++r) { p0[r] = -1e30f; p1[r] = -1e30f; }
        return; }
    int c0 = c - NA_KW / 2; c0 = c0 < 0 ? 0 : (c0 > GRID_W - NA_KW ? GRID_W - NA_KW : c0);
    const int dr = rr - R + (NA_KH - 1);
    const float* bl = biasq + dr * NA_BROW + NA_BORG + 4 * hi - c;
    const int vb = 4 * hi - c0;
#pragma unroll
    for (int r = 0; r < 16; ++r) { const int cc = (r & 3) + 8 * (r >> 2);
        p0[r] = ((unsigned)(cc + vb) < (unsigned)NA_KW) ? p0[r] + bl[cc] : -1e30f;
        p1[r] = ((unsigned)(cc + 32 + vb) < (unsigned)NA_KW) ? p1[r] + bl[cc + 32] : -1e30f; }
}

#define ATT_LAS __attribute__((address_space(3)))
template <int DQK, bool NA, int LDQ, int LDK, int LDV, int LDO>
__device__ __forceinline__ void attn_unit(const Job& J, char* lds, const float scale, const int tid_in) {
    using C_ = Cfg<DQK>;
    int tid_ = tid_in; asm volatile("" : "+v"(tid_));
    const int tid = tid_, wid = __builtin_amdgcn_readfirstlane(tid >> 6), lane = tid & 63, r32 = lane & 31, hi = lane >> 5;
    char* V_lds = lds + C_::OFF_V; char* K_lds = lds + C_::OFF_K;
    const unsigned ldsb = (unsigned)(uintptr_t)lds;
    float* wsf = (float*)(lds + C_::OFF_WS) + wid * 64; float* li_l = wsf; float* al_l = wsf + 32;
    const float* biasq = (const float*)(lds + C_::OFF_BIAS);
    const float Cc = scale * 1.4426950408889634f, thr_raw = THR / scale;
    float m_reg = -1e5f, l_reg = 0; f32x16 o[4] = {}; bf16x8 qr[DQK / 16];
    const bf16_t* Qw = J.Q + (long)(wid * QBLK + r32) * LDQ + hi * 8;
#pragma unroll
    for (int d0 = 0; d0 < DQK / 16; ++d0) qr[d0] = *reinterpret_cast<const bf16x8*>(Qw + d0 * 16);
    const int naR = J.R0 + (wid >> 1), nac = (wid & 1) * 32 + r32;
    const int vb0 = (int)(uintptr_t)V_lds + v_rd_base(lane);
    unsigned koff[C_::KLD], voff[2];
#pragma unroll
    for (int i = 0; i < C_::KLD; ++i) { const int sl = 512 * i + tid, row = sl / C_::KCH, cs = sl % C_::KCH, chunk = (cs & ~7) | ((cs & 7) ^ (row & 7)); koff[i] = (unsigned)(row * LDK * 2 + chunk * 16); }
#pragma unroll
    for (int i = 0; i < 2; ++i) { const int sl = 512 * i + tid, sub = sl >> 5, wi = sl & 31, kk = (sub >> 2) * 8 + (wi >> 2), k = (kk & ~0xC) | ((kk & 4) << 1) | ((kk & 8) >> 1), c = (sub & 3) * 32 + (wi & 3) * 8;
        voff[i] = (unsigned)(k * LDV * 2 + c * 2); }
#define ATT_STAGE(j, b) do { const int row0_ = tile_row(J, (j)); const char* vp_ = (const char*)(J.V + (size_t)row0_ * LDV); const char* kp_ = (const char*)(J.K + (size_t)row0_ * LDK); \
        _Pragma("unroll") for (int i_ = 0; i_ < C_::KLD; ++i_) __builtin_amdgcn_global_load_lds((const unsigned*)(kp_ + koff[i_]), (ATT_LAS unsigned*)(ldsb + C_::OFF_K + (b) * C_::SHM_K + (512 * i_ + 64 * wid) * 16), 16, 0, 0); \
        _Pragma("unroll") for (int i_ = 0; i_ < 2; ++i_) __builtin_amdgcn_global_load_lds((const unsigned*)(vp_ + voff[i_]), (ATT_LAS unsigned*)(ldsb + C_::OFF_V + (b) * C_::SHM_V + (512 * i_ + 64 * wid) * 16), 16, 0, 0); } while (0)
    const int NT = J.nt;
    __syncthreads();
    ATT_STAGE(0, 0); asm volatile("s_waitcnt vmcnt(0)" ::: "memory"); __syncthreads();
    for (int j = 0; j < NT; ++j) {
        const int buf = j & 1;
        if (j + 1 < NT) ATT_STAGE(j + 1, buf ^ 1);
        bool live = true;
        if (NA) { const int nloc = J.seg0_tiles; if (j >= nloc + 4) live = false; else if (j < nloc) { const int rr = J.rlo + j; int r0 = naR - NA_KH / 2; r0 = r0 < 0 ? 0 : (r0 > ROWS - NA_KH ? ROWS - NA_KH : r0); live = rr >= r0 && rr < r0 + NA_KH; } }
        if (live) {
        f32x16 p0, p1; float mn, al; bf16x8 pa0, pa1, pa2, pa3;
        qkt<DQK>(p0, p1, K_lds + buf * C_::SHM_K, qr, r32, hi);
        if (NA) na_bias(p0, p1, J, j, naR, nac, hi, biasq);
        partialSM(p0, p1, m_reg, mn, al, Cc, thr_raw);
        finishSM(p0, p1, al, l_reg, pa0, pa1, pa2, pa3);
        if (__any(al < 1.f)) { if (hi == 0) al_l[r32] = al; asm volatile("s_waitcnt lgkmcnt(0)" ::: "memory");
#pragma unroll
            for (int d = 0; d < 4; ++d)
#pragma unroll
                for (int r = 0; r < 16; ++r) o[d][r] *= al_l[crow(r, hi)]; }
        ATT_SBAR();
        pv_d0(o, vb0 + buf * C_::SHM_V, pa0, pa1, pa2, pa3);
        }
        asm volatile("s_waitcnt vmcnt(0)" ::: "memory");
        __syncthreads();
    }
    if (hi == 0) li_l[r32] = l_reg; asm volatile("s_waitcnt lgkmcnt(0)" ::: "memory");
    float rli[16];
#pragma unroll
    for (int r = 0; r < 16; ++r) rli[r] = __builtin_amdgcn_rcpf(li_l[crow(r, hi)]);
    bf16_t* Ow = J.O + (long)(wid * QBLK) * LDO;
#pragma unroll
    for (int r = 0; r < 16; ++r) { const int orow = crow(r, hi);
#pragma unroll
        for (int d0 = 0; d0 < 4; ++d0) Ow[(long)orow * LDO + d0 * 32 + r32] = f2bf(o[d0][r] * rli[r]); }
#undef ATT_STAGE
}
}

struct AttnArgs { const bf16_t *QM, *KM, *VM, *NQ, *NK, *P; bf16_t* Y; const float* rpb; int want_ctx; int pad; };
__device__ __forceinline__ void attention_phase(const AttnArgs& A, char* lds, int G, int wg, const int tid, const int nskip) {
    static_assert(GRID_W == 64 && SEQ % 256 == 0 && CTX_LEN == 256 && HD == 128, "attention phase geometry");
    constexpr int NQB = SEQ / 256;
    constexpr float sc_mla = 0.07216878364870323f, sc_na = 0.08838834764831845f;
    static_assert(MLA_QK == 192 && HD == 128, "softmax scales");
    if (!(A.pad & 2)) for (int u = wg; u < BATCH * NH * NQB; u += G) {
        const int bh = u % (BATCH * NH), qb = u / (BATCH * NH), b = bh / NH, h = bh % NH;
        att::Job J{};
        J.Q = A.QM + (size_t)(b * SEQ + qb * 256) * NQ_MLA + h * MLA_QK; J.K = A.KM + h * MLA_QK; J.V = A.VM + h * MLA_V;
        J.O = A.Y + (size_t)(b * SEQ + qb * 256) * D_MODEL + GROUP_W + h * MLA_V;
        J.nt = SEQ / 64 + CTX_LEN / 64; J.seg0_tiles = SEQ / 64; J.row_seg0 = b * SEQ; J.row_seg1 = M_LAT + b * CTX_LEN;
        att::attn_unit<MLA_QK, false, NQ_MLA, NQ_MLA, NH * MLA_V, D_MODEL>(J, lds, sc_mla, tid);
    }
    const int G2n = G - nskip, c2 = wg - nskip;
    if (!(A.pad & 4) && c2 >= 0) for (int u = c2; u < BATCH * NH * NQB; u += G2n) {
        const int bh = u % (BATCH * NH), qb = u / (BATCH * NH), b = bh / NH, h = bh % NH, R0 = qb * 4;
        __syncthreads();
        { float* bq = (float*)(lds + att::Cfg<HD>::OFF_BIAS); const float* src = A.rpb + (size_t)h * (2 * NA_KH - 1) * (2 * NA_KW - 1);
          for (int i = tid; i < (2 * NA_KH - 1) * att::NA_BROW; i += 512) { const int dr = i / att::NA_BROW; int dc = i % att::NA_BROW - att::NA_BORG + (NA_KW - 1); dc = dc < 0 ? 0 : (dc > 2 * NA_KW - 2 ? 2 * NA_KW - 2 : dc);
              bq[i] = src[dr * (2 * NA_KW - 1) + dc] * 11.313708498984761f; } }
        int rlo = R0 - NA_KH / 2; rlo = rlo < 0 ? 0 : (rlo > ROWS - NA_KH ? ROWS - NA_KH : rlo);
        int rhi = R0 + 3 - NA_KH / 2; rhi = (rhi < 0 ? 0 : (rhi > ROWS - NA_KH ? ROWS - NA_KH : rhi)) + NA_KH - 1;
        const int nloc = rhi - rlo + 1;
        att::Job J{};
        J.Q = A.NQ + (size_t)(b * SEQ + R0 * 64) * GROUP_W + h * HD; J.K = A.NK + h * HD; J.V = A.P + C_NV + h * HD;
        J.O = A.Y + (size_t)(b * SEQ + R0 * 64) * D_MODEL + 3 * GROUP_W + h * HD;
        J.nt = (nloc + 4 + 1) & ~1; J.seg0_tiles = nloc; J.row_seg0 = b * SEQ + rlo * 64; J.row_seg1 = M_LAT + b * CTX_LEN;  J.R0 = R0; J.rlo = rlo;
        att::attn_unit<HD, true, GROUP_W, GROUP_W, NP, D_MODEL>(J, lds, sc_na, tid);
    }
    if (A.want_ctx && !(A.pad & 8)) {
        for (int u = c2 - 64; u >= 0 && u < BATCH * NH; u += G) {
            const int b = u / NH, h = u % NH; const int crow0 = M_LAT + b * CTX_LEN;
            att::Job J{}; J.nt = CTX_LEN / 64; J.seg0_tiles = 0; J.row_seg0 = crow0; J.row_seg1 = crow0;
            J.Q = A.QM + (size_t)crow0 * NQ_MLA + h * MLA_QK; J.K = A.KM + h * MLA_QK; J.V = A.VM + h * MLA_V;
            J.O = A.Y + (size_t)crow0 * D_MODEL + GROUP_W + h * MLA_V; att::attn_unit<MLA_QK, false, NQ_MLA, NQ_MLA, NH * MLA_V, D_MODEL>(J, lds, sc_mla, tid);
        }
        for (int u = c2 - 64 - BATCH * NH; u >= 0 && u < BATCH * NH; u += G) {
            const int b = u / NH, h = u % NH; const int crow0 = M_LAT + b * CTX_LEN;
            att::Job J{}; J.nt = CTX_LEN / 64; J.seg0_tiles = 0; J.row_seg0 = crow0; J.row_seg1 = crow0;
            J.Q = A.NQ + (size_t)crow0 * GROUP_W + h * HD; J.K = A.NK + h * HD; J.V = A.P + C_NV + h * HD;
            J.O = A.Y + (size_t)crow0 * D_MODEL + 3 * GROUP_W + h * HD; att::attn_unit<HD, false, GROUP_W, GROUP_W, NP, D_MODEL>(J, lds, sc_na, tid);
        }
    }
}

namespace gdn {
typedef short bf16x8 __attribute__((ext_vector_type(8)));
typedef float f32x4 __attribute__((ext_vector_type(4)));
typedef float f32x16 __attribute__((ext_vector_type(16)));
typedef unsigned u32x2 __attribute__((ext_vector_type(2)));
typedef unsigned u32x4 __attribute__((ext_vector_type(4)));
constexpr int CH = 64, NCHUNK = M_ALL / CH;
constexpr int NTASK = NCHUNK * NH * 2;
constexpr size_t SZ_UT = 128 * 64, SZ_WP = 64 * 128, SZ_KDT = 128 * 64, SZ_QD = 64 * 128, SZ_QK = 64 * 64, SZ_SIT = 128 * 128, SZ_VNT = 128 * 64;
struct Bufs { bf16_t *UT, *WP, *KDT, *QD, *QK, *SIT, *VNT; float* GT; };
__device__ __forceinline__ int perm32(int o) { return (o & ~31) | (((o & 15) >> 2) * 8 + ((o >> 4) & 1) * 4 + (o & 3)); }
__device__ __forceinline__ unsigned pk2(float lo, float hi) { return (unsigned)f2bf(lo) | ((unsigned)f2bf(hi) << 16); }

constexpr int QS = 132;
constexpr int AS = 68;
constexpr int AH = 72;
typedef _Float16 h16x8 __attribute__((ext_vector_type(8)));
constexpr int G1_OFF_Q = 0, G1_OFF_K = G1_OFF_Q + CH * QS * 4, G1_OFF_V = G1_OFF_K + CH * QS * 4, G1_OFF_AA = G1_OFF_V + CH * QS * 4, G1_OFF_SM = G1_OFF_AA + 2 * CH * AS * 4,
              G1_LDS = G1_OFF_SM + 12 * 64 * 4;
struct G1Args { const bf16_t* P; const float* conv_w; const float* a_log; const float* dt_bias; Bufs B; int pflags; };

template <int P, int M> __device__ __forceinline__ void g1_sweep_m(float (&x)[CH], const _Float16* rowp, const float xp) {
    constexpr int N = 63 - P;
    if constexpr (8 * M < N) {
        const h16x8 a8 = *(const h16x8*)(rowp + 8 * M);
        constexpr int NE = (N - 8 * M) < 8 ? (N - 8 * M) : 8;
#pragma unroll
        for (int e = 0; e < NE; ++e) x[63 - (8 * M + e)] = __builtin_fmaf(-(float)a8[e], xp, x[63 - (8 * M + e)]);
        g1_sweep_m<P, M + 1>(x, rowp, xp);
    }
}
template <int P> __device__ __forceinline__ void g1_sweep(float (&x)[CH], const _Float16* AAv) {
    if constexpr (P < CH - 1) { g1_sweep_m<P, 0>(x, AAv + (63 - P) * AH, x[P]); g1_sweep<P + 1>(x, AAv); }
}

__device__ __forceinline__ void g1_load(const G1Args& A, int cix, int h, int tid, u32x4 (&xr)[11], float (&gin)[4]) {
    const RowInfo r0i = row_info(cix * CH);
    if (tid < 128) { const int d = tid >> 6, i = tid & 63; const size_t r = (size_t)(cix * CH + i) * NP;
        gin[0] = bf2f(A.P[r + C_GB + d * NH + h]); gin[1] = bf2f(A.P[r + C_GA + d * NH + h]); gin[2] = A.a_log[d * NH + h]; gin[3] = A.dt_bias[d * NH + h]; }
    if (tid < 48 * 8) { const int grp = tid % 48, ts = tid / 48, which = grp >> 4, cc0 = (grp & 15) * 8, ch0 = which * GROUP_W + h * HD + cc0;
#pragma unroll
        for (int k = 0; k < 11; ++k) { const int tt = r0i.t + 8 * ts + k - 1;
            xr[k] = (tt >= 0 && tt < r0i.T && !(A.pflags & 4096)) ? *(const u32x4*)(A.P + (size_t)(r0i.base + tt) * NP + C_GQ + ch0) : (u32x4){0u, 0u, 0u, 0u}; } }
}
__device__ __forceinline__ void g1_weights(const G1Args& A, int h, int tid, float (&cw)[4][8]) {
    if (tid < 48 * 8) { const int grp = tid % 48, which = grp >> 4, cc0 = (grp & 15) * 8, ch0 = which * GROUP_W + h * HD + cc0;
#pragma unroll
        for (int j = 0; j < 4; ++j) { const f32x4 w0 = *(const f32x4*)(A.conv_w + j * 3 * GROUP_W + ch0), w1 = *(const f32x4*)(A.conv_w + j * 3 * GROUP_W + ch0 + 4);
#pragma unroll
            for (int e = 0; e < 4; ++e) { cw[j][e] = w0[e]; cw[j][4 + e] = w1[e]; } } }
}
__device__ __forceinline__ void g1_task(const G1Args& A, char* lds, int cix, int h, const int tid_in, u32x4 (&xr)[11], float (&gin)[4], float (&wgt)[4][8], const int ncix, const int nh, const bool has_next) {
    int tid_ = tid_in; asm volatile("" : "+v"(tid_));
    const int tid = tid_, wid = __builtin_amdgcn_readfirstlane(tid >> 6), lane = tid & 63;
    float* Qs = (float*)(lds + G1_OFF_Q); float* Ks = (float*)(lds + G1_OFF_K); float* Vs = (float*)(lds + G1_OFF_V); _Float16* AA = (_Float16*)(lds + G1_OFF_AA);
    float* sm = (float*)(lds + G1_OFF_SM); float* g_s = sm;   float* beta_s = sm + 128;   float* gc_s = sm + 256;
    const int row0 = cix * CH; const RowInfo r0i = row_info(row0);
    LDS_BARRIER();
    if (tid < 48 * 8) {
        const int grp = tid % 48, ts = tid / 48, which = grp >> 4, cc0 = (grp & 15) * 8, ch0 = which * GROUP_W + h * HD + cc0;
        float* dstp = (which == 0 ? Qs : which == 1 ? Ks : Vs) + cc0;
#pragma unroll
        for (int i = 0; i < 8; ++i) { float acc[8];
#pragma unroll
            for (int e = 0; e < 8; ++e) acc[e] = 0.f;
#pragma unroll
            for (int j = 0; j < 4; ++j) { const u32x4 xv = xr[i + j];
#pragma unroll
                for (int e = 0; e < 4; ++e) { acc[2 * e] += wgt[j][2 * e] * bflo(xv[e]); acc[2 * e + 1] += wgt[j][2 * e + 1] * bfhi(xv[e]); } }
            f32x4 y0, y1;
#pragma unroll
            for (int e = 0; e < 4; ++e) { y0[e] = acc[e] * __builtin_amdgcn_rcpf(1.0f + __expf(-acc[e])); y1[e] = acc[4 + e] * __builtin_amdgcn_rcpf(1.0f + __expf(-acc[4 + e])); }
            *(f32x4*)(dstp + (8 * ts + i) * QS) = y0; *(f32x4*)(dstp + (8 * ts + i) * QS + 4) = y1; }
    }
    if (tid < 128) { const int d = tid >> 6, i = tid & 63;
        beta_s[d * 64 + i] = 1.0f / (1.0f + __expf(-gin[0]));
        g_s[d * 64 + i] = -__expf(gin[2]) * softplusf_(gin[1] + gin[3]); }
    if (has_next) g1_load(A, ncix, nh, tid, xr, gin);
    LDS_BARRIER();
    for (int rr = wid * 4 + (lane >> 4); rr < 2 * CH; rr += 32) { float* rowp = (rr < CH ? Qs : Ks) + (rr & 63) * QS + (lane & 15) * 8;
        f32x4 a = *(const f32x4*)rowp, b = *(const f32x4*)(rowp + 4); float ss = (a[0] * a[0] + a[1] * a[1]) + (a[2] * a[2] + a[3] * a[3]) + (b[0] * b[0] + b[1] * b[1]) + (b[2] * b[2] + b[3] * b[3]);
#pragma unroll
        for (int o = 1; o < 16; o <<= 1) ss += lane_xor(ss, o, lane);
        const float scl = __builtin_amdgcn_rsqf(ss + EPS) * (rr < CH ? 0.08838834764831845f : 1.0f);
        *(f32x4*)rowp = a * scl; *(f32x4*)(rowp + 4) = b * scl; }
    if (tid < 2) {
        f32x4 gv[16];
#pragma unroll
        for (int m = 0; m < 16; ++m) gv[m] = *(const f32x4*)(g_s + tid * 64 + 4 * m);
        float run = 0.f;
        if (tid == 0) {
#pragma unroll
            for (int m = 0; m < 16; ++m) { f32x4 o4;
#pragma unroll
                for (int e = 0; e < 4; ++e) { run += gv[m][e]; o4[e] = run; }
                *(f32x4*)(gc_s + 4 * m) = o4; }
        } else {
#pragma unroll
            for (int m = 15; m >= 0; --m) { f32x4 o4;
#pragma unroll
                for (int e = 3; e >= 0; --e) { run += gv[m][e]; o4[e] = run; }
                *(f32x4*)(gc_s + 64 + 4 * m) = o4; }
        }
    }
    LDS_BARRIER();
    float* eq_s = sm + 384; float* ek_s = sm + 512;
    if (tid < 128) { const int d = tid >> 6, i = tid & 63; const float gci = gc_s[d * 64 + i], glast = d == 0 ? gc_s[63] : gc_s[64];
        eq_s[tid] = __expf(gci); ek_s[tid] = __expf(glast - gci); }
    const int gwhich = wid >> 2, gI = (wid >> 1) & 1, gJ = wid & 1, r32 = lane & 31, hi = lane >> 5;
    f32x16 acc = {};
    if (!(A.pflags & 1024)) {
        const float* X = (gwhich ? Qs : Ks) + (32 * gI + r32) * QS + 4 * hi; const float* Yp = Ks + (32 * gJ + r32) * QS + 4 * hi;
#pragma unroll
        for (int s = 0; s < 16; ++s) { const f32x4 a4 = *(const f32x4*)(X + 8 * s), b4 = *(const f32x4*)(Yp + 8 * s);
#pragma unroll
            for (int e = 0; e < 4; ++e) acc = __builtin_amdgcn_mfma_f32_32x32x2f32(a4[e], b4[e], acc, 0, 0, 0); }
        const int j = 32 * gJ + r32;
        if (gwhich == 0) {
            const float b1j = beta_s[64 + j], g0j = gc_s[j], g1j = gc_s[64 + j];
#pragma unroll
            for (int r = 0; r < 16; ++r) { const int i = 32 * gI + (r & 3) + 8 * (r >> 2) + 4 * hi;
                if (i > j) { const float kk = acc[r];
                    AA[(63 - j) * AH + (63 - i)] = (_Float16)(beta_s[i] * kk * __expf(gc_s[i] - g0j));
                    AA[CH * AH + i * AH + j] = (_Float16)(b1j * kk * __expf(g1j - gc_s[64 + i])); } }
        }
    }
    LDS_BARRIER();
    const size_t t0 = ((size_t)cix * NH + h) * 2;
    if (!(A.pflags & 2048)) {
#pragma unroll
        for (int n = 0; n < 4; ++n) { const int it = tid + 512 * n, d = it >> 10, p = (it >> 4) & 63, m = it & 15, i = d == 0 ? p : 63 - p, k0 = 32 * (m >> 2) + 4 * (m & 3);
            const float e = eq_s[d * 64 + i]; const f32x4 lo = *(const f32x4*)(Qs + i * QS + k0), hi4 = *(const f32x4*)(Qs + i * QS + k0 + 16);
            *(u32x4*)(A.B.QD + (t0 + d) * SZ_QD + (size_t)p * 128 + m * 8) = (u32x4){pk2(lo[0] * e, lo[1] * e), pk2(lo[2] * e, lo[3] * e), pk2(hi4[0] * e, hi4[1] * e), pk2(hi4[2] * e, hi4[3] * e)}; }
#pragma unroll
        for (int n = 0; n < 4; ++n) { const int it = tid + 512 * n, k = it & 127, d = (it >> 7) & 1, m = it >> 8, p0 = 32 * (m >> 2) + 4 * (m & 3);
            float v[8];
#pragma unroll
            for (int jj = 0; jj < 8; ++jj) { const int p = p0 + (jj < 4 ? jj : 12 + jj), i = d == 0 ? p : 63 - p; v[jj] = Ks[i * QS + k] * ek_s[d * 64 + i]; }
            *(u32x4*)(A.B.KDT + (t0 + d) * SZ_KDT + (size_t)k * 64 + m * 8) = (u32x4){pk2(v[0], v[1]), pk2(v[2], v[3]), pk2(v[4], v[5]), pk2(v[6], v[7])}; }
        if (tid == 0) { A.B.GT[t0] = __expf(gc_s[63]); A.B.GT[t0 + 1] = __expf(gc_s[64]); }
    }
    LDS_BARRIER();
    bf16_t* stg = (bf16_t*)Qs;
    if (gwhich == 1) { const int j = 32 * gJ + r32; const float g0j = gc_s[j], g1j = gc_s[64 + j];
#pragma unroll
        for (int r = 0; r < 16; ++r) { const int i = 32 * gI + (r & 3) + 8 * (r >> 2) + 4 * hi; const float qk = acc[r];
            stg[i * 64 + perm32(j)] = f2bf(i >= j ? qk * __expf(gc_s[i] - g0j) : 0.f);
            stg[4096 + (63 - i) * 64 + perm32(63 - j)] = f2bf(i <= j ? qk * __expf(gc_s[64 + i] - g1j) : 0.f); } }
    LDS_BARRIER();
#pragma unroll
    for (int n = 0; n < 2; ++n) { const int c16 = tid + 512 * n; *(u32x4*)(A.B.QK + t0 * SZ_QK + (size_t)c16 * 8) = *(const u32x4*)(stg + c16 * 8); }
    if (!(A.pflags & 512)) {
        int tidv = tid; asm volatile("" : "+v"(tidv));
        const int d = tidv >> 8, c = tidv & 255; const bool isw = c >= 128; const int cc = c & 127;
        const float* src = isw ? Ks : Vs;
        int lz; asm volatile("v_mov_b32 %0, 0" : "=v"(lz));
        const _Float16* AAv = AA + lz + d * (CH * AH);
        float x[CH];
#pragma unroll
        for (int p = 0; p < CH; ++p) { const int i = d == 0 ? p : 63 - p; float f = beta_s[d * 64 + i]; if (isw) f *= eq_s[d * 64 + i]; x[p] = f * src[i * QS + cc]; }
        {
            g1_sweep<0>(x, AAv);

        }
        LDS_BARRIER();
        if (!isw) { bf16_t* dst = A.B.UT + (t0 + d) * SZ_UT + (size_t)((cc >> 4) * 2 * 64 + (cc & 15)) * 8;
#pragma unroll
            for (int s = 0; s < 2; ++s)
#pragma unroll
                for (int qq = 0; qq < 4; ++qq) { const int p0 = 32 * s + 4 * qq; u32x4 w4; w4.x = pk2(x[p0], x[p0 + 1]); w4.y = pk2(x[p0 + 2], x[p0 + 3]); w4.z = pk2(x[p0 + 16], x[p0 + 17]); w4.w = pk2(x[p0 + 18], x[p0 + 19]);
                    *(u32x4*)(dst + (size_t)(s * 64 + qq * 16) * 8) = w4; }
        } else { bf16_t* dst = stg + d * 8192 + perm32(cc);
#pragma unroll
            for (int p = 0; p < CH; ++p) dst[p * 128] = f2bf(x[p]); }
    }
    LDS_BARRIER();
#pragma unroll
    for (int n = 0; n < 4; ++n) { const int c16 = tid + 512 * n; *(u32x4*)(A.B.WP + t0 * SZ_WP + (size_t)c16 * 8) = *(const u32x4*)(stg + c16 * 8); }
    if (has_next && nh != h) g1_weights(A, nh, tid, wgt);
}
__device__ __forceinline__ void g1_phase(const G1Args& A, char* lds, int G, int wg, const int tid) {
    u32x4 xr[11]; float gin[4], cw[4][8];
    if (wg < NCHUNK * NH) { g1_weights(A, wg % NH, tid, cw); g1_load(A, wg / NH, wg % NH, tid, xr, gin); }
    for (int t = wg; t < NCHUNK * NH; t += G) { const int tn = t + G; g1_task(A, lds, t / NH, t % NH, tid, xr, gin, cw, tn / NH, tn % NH, tn < NCHUNK * NH); }
}

constexpr int G2_SPLIT = 4, G2_NACT = 8 / G2_SPLIT, G2_NSTEP = CTX_LEN / CH + SEQ / CH, G2_WGS = BATCH * NH * 2 * G2_SPLIT;
constexpr int G2_USL = G2_NACT * 2 * 64 * 16;
constexpr int G2_BUF = 16384 + 16384 + G2_USL, G2_NB = 4, G2_LDS = G2_NB * G2_BUF;
static_assert(G2_SPLIT == 4 && G2_USL == 4096, "G2 staging map below assumes 4 KB of u per step");
__device__ __forceinline__ int g2_task_index(int b, int h, int d, int step) {
    constexpr int NC = CTX_LEN / CH, NL = SEQ / CH; int cix;
    if (step < NC) { const int n = d ? NC - 1 - step : step; cix = M_LAT / CH + b * NC + n; }
    else { const int s2 = step - NC, n = d ? NL - 1 - s2 : s2; cix = b * NL + n; }
    return (cix * NH + h) * 2 + d;
}
__device__ __forceinline__ void g2_chain(const Bufs& B, char* lds, int chain_part, const int tid_in, const int step_lo, const int step_hi, float* Ssave) {
    int tid_ = tid_in; asm volatile("" : "+v"(tid_));
    const int tid = tid_, wid = __builtin_amdgcn_readfirstlane(tid >> 6), lane = tid & 63, q = lane >> 4, vl = lane & 15;
    const int chain = chain_part / G2_SPLIT, part = chain_part % G2_SPLIT;
    const bool active = wid < G2_NACT; const int vt = part * G2_NACT + (active ? wid : 0);
    const int d = chain & 1, h = (chain >> 1) % NH, b = chain / (2 * NH);
    constexpr int NSTEP = CTX_LEN / CH + SEQ / CH;
    const unsigned ldsb = (unsigned)(uintptr_t)lds;
    f32x4 S[8];
    f32x4* sv = (f32x4*)Ssave + ((size_t)chain_part * G2_NACT + (active ? wid : 0)) * 8 * 64 + lane;
#pragma unroll
    for (int kb = 0; kb < 8; ++kb) S[kb] = (step_lo > 0 && active) ? sv[kb * 64] : (f32x4){0.f, 0.f, 0.f, 0.f};
    unsigned offw[2], offk[2], offu;
#pragma unroll
    for (int i = 0; i < 2; ++i) { const int sl = 128 * wid + 64 * i + lane;
        { const int row = sl >> 4, pc = sl & 15, c = pc ^ (row & 15); offw[i] = (unsigned)(row * 256 + c * 16); }
        { const int row = sl >> 3, pc = sl & 7, c = pc ^ ((row >> 1) & 7); offk[i] = (unsigned)(row * 128 + c * 16); } }
    offu = (unsigned)((part * G2_NACT * 2 * 64 + (wid & 3) * 64 + lane) * 16);
#define G2_DMA(ti, slot) do { const char* wp_ = (const char*)(B.WP + (size_t)(ti) * SZ_WP); const char* kp_ = (const char*)(B.KDT + (size_t)(ti) * SZ_KDT); const unsigned base_ = ldsb + (unsigned)(slot) * G2_BUF; \
        _Pragma("unroll") for (int i_ = 0; i_ < 2; ++i_) { \
            __builtin_amdgcn_global_load_lds((const unsigned*)(wp_ + offw[i_]), (ATT_LAS unsigned*)(base_ + (128 * wid + 64 * i_) * 16), 16, 0, 0); \
            __builtin_amdgcn_global_load_lds((const unsigned*)(kp_ + offk[i_]), (ATT_LAS unsigned*)(base_ + 16384 + (128 * wid + 64 * i_) * 16), 16, 0, 0); } \
        if (wid >= 4) __builtin_amdgcn_global_load_lds((const unsigned*)((const char*)(B.UT + (size_t)(ti) * SZ_UT) + offu), (ATT_LAS unsigned*)(base_ + 32768 + ((wid & 3) * 64) * 16), 16, 0, 0); } while (0)
#define G2_TI(step) g2_task_index(b, h, d, (step) < NSTEP ? (step) : NSTEP - 1)
    __syncthreads();
    G2_DMA(G2_TI(step_lo), step_lo & 3); G2_DMA(G2_TI(step_lo + 1), (step_lo + 1) & 3); G2_DMA(G2_TI(step_lo + 2), (step_lo + 2) & 3);
    asm volatile("s_waitcnt vmcnt(0)" ::: "memory");
    __syncthreads();
    for (int step = step_lo; step < step_hi; ++step) {
        const int ti = G2_TI(step), slot = step & 3;
        G2_DMA(G2_TI(step + 3), (step + 3) & 3);
        unsigned gtb; { const float* gp = B.GT + ti; asm volatile("s_load_dword %0, %1, 0x0" : "=s"(gtb) : "s"(gp)); }
        const char* wl = lds + slot * G2_BUF; const char* kl = wl + 16384; const char* ul = kl + 16384;
        if (active) {
            bf16x8 aw[16], ak[16];
#pragma unroll
            for (int rb = 0; rb < 4; ++rb)
#pragma unroll
                for (int s = 0; s < 4; ++s) aw[rb * 4 + s] = *(const bf16x8*)(wl + (16 * rb + vl) * 256 + (((4 * s + q) ^ vl) << 4));
#pragma unroll
            for (int kb = 0; kb < 8; ++kb)
#pragma unroll
                for (int s = 0; s < 2; ++s) ak[kb * 2 + s] = *(const bf16x8*)(kl + (16 * kb + vl) * 128 + (((4 * s + q) ^ ((vl >> 1) & 7)) << 4));
            u32x4 uu[2];
#pragma unroll
            for (int s = 0; s < 2; ++s) uu[s] = *(const u32x4*)(ul + ((wid * 2 + s) * 64 + lane) * 16);
            bf16_t* sit = B.SIT + (size_t)ti * SZ_SIT + (size_t)(vt * 4 * 64 + lane) * 8;
            bf16x8 sf[4];
#pragma unroll
            for (int s = 0; s < 4; ++s) { u32x4 w4; w4.x = pk2(S[2 * s][0], S[2 * s][1]); w4.y = pk2(S[2 * s][2], S[2 * s][3]); w4.z = pk2(S[2 * s + 1][0], S[2 * s + 1][1]); w4.w = pk2(S[2 * s + 1][2], S[2 * s + 1][3]);
                sf[s] = __builtin_bit_cast(bf16x8, w4); *(u32x4*)(sit + (size_t)s * 64 * 8) = w4; }
            __builtin_amdgcn_sched_barrier(0);
            f32x4 vn[4];
#pragma unroll
            for (int rb = 0; rb < 4; ++rb) vn[rb] = (f32x4){0.f, 0.f, 0.f, 0.f};
#pragma unroll
            for (int s = 0; s < 4; ++s)
#pragma unroll
                for (int rb = 0; rb < 4; ++rb) vn[rb] = __builtin_amdgcn_mfma_f32_16x16x32_bf16(aw[rb * 4 + s], sf[s], vn[rb], 0, 0, 0);
#pragma unroll
            for (int s = 0; s < 2; ++s) { const f32x4 a0 = vn[2 * s], a1 = vn[2 * s + 1];
                vn[2 * s][0] = bflo(uu[s].x) - a0[0]; vn[2 * s][1] = bfhi(uu[s].x) - a0[1]; vn[2 * s][2] = bflo(uu[s].y) - a0[2]; vn[2 * s][3] = bfhi(uu[s].y) - a0[3];
                vn[2 * s + 1][0] = bflo(uu[s].z) - a1[0]; vn[2 * s + 1][1] = bfhi(uu[s].z) - a1[1]; vn[2 * s + 1][2] = bflo(uu[s].w) - a1[2]; vn[2 * s + 1][3] = bfhi(uu[s].w) - a1[3]; }
            bf16_t* vnt = B.VNT + (size_t)ti * SZ_VNT + (size_t)(vt * 2 * 64 + lane) * 8;
            bf16x8 vf[2];
#pragma unroll
            for (int s = 0; s < 2; ++s) { u32x4 w4; w4.x = pk2(vn[2 * s][0], vn[2 * s][1]); w4.y = pk2(vn[2 * s][2], vn[2 * s][3]); w4.z = pk2(vn[2 * s + 1][0], vn[2 * s + 1][1]); w4.w = pk2(vn[2 * s + 1][2], vn[2 * s + 1][3]);
                vf[s] = __builtin_bit_cast(bf16x8, w4); *(u32x4*)(vnt + (size_t)s * 64 * 8) = w4; }
            asm volatile("s_waitcnt lgkmcnt(0)" ::: "memory");
            const float gt = __uint_as_float(gtb);
#pragma unroll
            for (int kb = 0; kb < 8; ++kb) S[kb] = S[kb] * gt;
#pragma unroll
            for (int s = 0; s < 2; ++s)
#pragma unroll
                for (int kb = 0; kb < 8; ++kb) S[kb] = __builtin_amdgcn_mfma_f32_16x16x32_bf16(ak[kb * 2 + s], vf[s], S[kb], 0, 0, 0);
            __builtin_amdgcn_sched_barrier(0);
            asm volatile("s_waitcnt vmcnt(26) lgkmcnt(0)\n\ts_barrier" ::: "memory");
        } else if (wid >= 4) {
            asm volatile("s_waitcnt vmcnt(10) lgkmcnt(0)\n\ts_barrier" ::: "memory");
        } else {
            asm volatile("s_waitcnt vmcnt(8) lgkmcnt(0)\n\ts_barrier" ::: "memory");
        }
    }
    if (step_hi < NSTEP && active) {
#pragma unroll
        for (int kb = 0; kb < 8; ++kb) sv[kb * 64] = S[kb]; }
    asm volatile("s_waitcnt vmcnt(0)" ::: "memory");
    __syncthreads();
#undef G2_DMA
#undef G2_TI
}

constexpr int G3_OS = 132, G3_LDS = 64 * G3_OS * 4;
struct G3Args { Bufs B; const bf16_t* P; const float* norm_g; bf16_t* Y; };
__device__ __forceinline__ void g3_task(const G3Args& A, char* lds, int cix, int h, const int tid_in, const f32x4 g0, const f32x4 g1) {
    int tid_ = tid_in; asm volatile("" : "+v"(tid_));
    const int tid = tid_, wid = __builtin_amdgcn_readfirstlane(tid >> 6), lane = tid & 63, q = lane >> 4, vl = lane & 15;
    u32x4 gwv[2];
#pragma unroll
    for (int n = 0; n < 2; ++n) { const int item = tid + 512 * n, tok = item >> 4, c8 = (item & 15) * 8; gwv[n] = *(const u32x4*)(A.P + ((size_t)cix * CH + tok) * NP + C_GG + h * HD + c8); }
    f32x4 o[2][4];
#pragma unroll
    for (int d = 0; d < 2; ++d) {
        const size_t t = ((size_t)cix * NH + h) * 2 + d;
        const bf16_t* sit = A.B.SIT + t * SZ_SIT + (size_t)(wid * 4 * 64 + lane) * 8;
        const bf16_t* vnt = A.B.VNT + t * SZ_VNT + (size_t)(wid * 2 * 64 + lane) * 8;
        const bf16_t* qd = A.B.QD + t * SZ_QD + (size_t)vl * 128 + 8 * q;
        const bf16_t* qk = A.B.QK + t * SZ_QK + (size_t)vl * 64 + 8 * q;
        bf16x8 sf[4], vf[2];
#pragma unroll
        for (int s = 0; s < 4; ++s) sf[s] = *(const bf16x8*)(sit + (size_t)s * 64 * 8);
#pragma unroll
        for (int s = 0; s < 2; ++s) vf[s] = *(const bf16x8*)(vnt + (size_t)s * 64 * 8);
#pragma unroll
        for (int rb = 0; rb < 4; ++rb) { f32x4 acc = {0.f, 0.f, 0.f, 0.f};
#pragma unroll
            for (int s = 0; s < 4; ++s) acc = __builtin_amdgcn_mfma_f32_16x16x32_bf16(*(const bf16x8*)(qd + (size_t)rb * 16 * 128 + 32 * s), sf[s], acc, 0, 0, 0);
#pragma unroll
            for (int s = 0; s < 2; ++s) acc = __builtin_amdgcn_mfma_f32_16x16x32_bf16(*(const bf16x8*)(qk + (size_t)rb * 16 * 64 + 32 * s), vf[s], acc, 0, 0, 0);
            o[d][rb] = acc; }
    }
    f32x4 ot[4];
#pragma unroll
    for (int rb = 0; rb < 4; ++rb)
#pragma unroll
        for (int r = 0; r < 4; ++r) ot[rb][r] = o[0][rb][r] + lane_xor(o[1][3 - rb][3 - r], 48, lane);
    float* Ot = (float*)lds;
    LDS_BARRIER();
#pragma unroll
    for (int rb = 0; rb < 4; ++rb)
#pragma unroll
        for (int r = 0; r < 4; ++r) Ot[(16 * rb + 4 * q + r) * G3_OS + 16 * wid + vl] = ot[rb][r];
    LDS_BARRIER();
#pragma unroll
    for (int n = 0; n < 2; ++n) { const int item = tid + 512 * n, tok = item >> 4, c8 = (item & 15) * 8;
        const f32x4 o0 = *(const f32x4*)(Ot + tok * G3_OS + c8), o1 = *(const f32x4*)(Ot + tok * G3_OS + c8 + 4);
        float ss = (o0[0] * o0[0] + o0[1] * o0[1]) + (o0[2] * o0[2] + o0[3] * o0[3]) + (o1[0] * o1[0] + o1[1] * o1[1]) + (o1[2] * o1[2] + o1[3] * o1[3]);
#pragma unroll
        for (int of = 1; of < 16; of <<= 1) ss += lane_xor(ss, of, lane);
        const float rstd = __builtin_amdgcn_rsqf(ss * (1.0f / HD) + EPS);
        const size_t row = (size_t)cix * CH + tok; const u32x4 gw = gwv[n];
        float y[8];
#pragma unroll
        for (int e = 0; e < 4; ++e) { const float ga = bflo(gw[e]), gb = bfhi(gw[e]); const float oa = e < 2 ? o0[2 * e] : o1[2 * e - 4], ob = e < 2 ? o0[2 * e + 1] : o1[2 * e - 3];
            const float na = e < 2 ? g0[2 * e] : g1[2 * e - 4], nb = e < 2 ? g0[2 * e + 1] : g1[2 * e - 3];
            y[2 * e] = oa * rstd * na * (ga * __builtin_amdgcn_rcpf(1.0f + __expf(-ga))); y[2 * e + 1] = ob * rstd * nb * (gb * __builtin_amdgcn_rcpf(1.0f + __expf(-gb))); }
        *(u32x4*)(A.Y + row * D_MODEL + 2 * GROUP_W + h * HD + c8) = (u32x4){pk2(y[0], y[1]), pk2(y[2], y[3]), pk2(y[4], y[5]), pk2(y[6], y[7])};
    }
}
__device__ __forceinline__ void g3_phase(const G3Args& A, char* lds, int G, int wg, const int tid) {
    const int c8 = (tid & 15) * 8; const f32x4 g0 = *(const f32x4*)(A.norm_g + c8), g1 = *(const f32x4*)(A.norm_g + c8 + 4);
    for (int t = wg; t < NCHUNK * NH; t += G) g3_task(A, lds, t / NH, t % NH, tid, g0, g1);
}
}

namespace lru {
typedef short bf16x8 __attribute__((ext_vector_type(8)));
typedef float f32x4 __attribute__((ext_vector_type(4)));
typedef unsigned u32x2 __attribute__((ext_vector_type(2)));
typedef unsigned u32x4 __attribute__((ext_vector_type(4)));
constexpr int CH = 64, NCHUNK = M_ALL / CH;
constexpr int US = 129;
constexpr int UBS = 272;
constexpr int L_OFF_U = 0, L_OFF_UB = CH * US * 4, L_LDS = L_OFF_UB + CH * UBS;
constexpr size_t SZ_WBLK = (size_t)LRU_BW * LRU_BW;
struct Bufs { bf16_t* HLOC; bf16_t* ACUM; float* LSUM; float* HIN; };
struct LocalArgs { const bf16_t* P; const float* conv_w; const float* conv_b; const bf16_t* WG;   const float* ba; const float* bx; const float* lam; Bufs B; };

__device__ __forceinline__ unsigned pk2(float lo, float hi) { return (unsigned)f2bf(lo) | ((unsigned)f2bf(hi) << 16); }

struct LocalPre { float wgt[4][8]; float bia[8]; float sp[2][4], bav[2][4], bxv[2][4]; u32x4 xr[5]; };
__device__ __forceinline__ void local_weights(const LocalArgs& A, int nb, int tid, LocalPre& R) {
    const int wid = tid >> 6, lane = tid & 63, q = lane >> 4;
    const int grp = tid & 15, c0 = grp * 8, ch0 = nb * LRU_BW + c0;
#pragma unroll
    for (int j = 0; j < 4; ++j) { const f32x4 w0 = *(const f32x4*)(A.conv_w + j * LRU_W + ch0), w1 = *(const f32x4*)(A.conv_w + j * LRU_W + ch0 + 4);
#pragma unroll
        for (int e = 0; e < 4; ++e) { R.wgt[j][e] = w0[e]; R.wgt[j][4 + e] = w1[e]; } }
    { const f32x4 b0 = *(const f32x4*)(A.conv_b + ch0), b1 = *(const f32x4*)(A.conv_b + ch0 + 4);
#pragma unroll
      for (int e = 0; e < 4; ++e) { R.bia[e] = b0[e]; R.bia[4 + e] = b1[e]; } }
    const int chb = nb * LRU_BW + 16 * wid + 4 * q;
#pragma unroll
    for (int d = 0; d < 2; ++d)
#pragma unroll
        for (int r = 0; r < 4; ++r) { R.sp[d][r] = -LRU_C * softplusf_(-A.lam[d * LRU_W + chb + r]); R.bav[d][r] = A.ba[d * LRU_W + chb + r]; R.bxv[d][r] = A.bx[d * LRU_W + chb + r]; }
}
__device__ __forceinline__ void local_load(const LocalArgs& A, int cix, int nb, int tid, LocalPre& R) {
    const RowInfo r0i = row_info(cix * CH); const int grp = tid & 15, t2 = tid >> 4, ch0 = nb * LRU_BW + grp * 8;
#pragma unroll
    for (int k = 0; k < 5; ++k) { const int tt = r0i.t + 2 * t2 + k - 1;
        R.xr[k] = (tt >= 0 && tt < r0i.T) ? *(const u32x4*)(A.P + (size_t)(r0i.base + tt) * NP + C_LRU_X + ch0) : (u32x4){0u, 0u, 0u, 0u}; }
}
__device__ __forceinline__ void local_task(const LocalArgs& A, char* lds, int cix, int nb, const int tid_in, LocalPre& R, const int ncix, const int nnb, const bool has_next) {
    int tid_ = tid_in; asm volatile("" : "+v"(tid_));
    const int tid = tid_, wid = __builtin_amdgcn_readfirstlane(tid >> 6), lane = tid & 63, q = lane >> 4, tl = lane & 15;
    float* Us = (float*)(lds + L_OFF_U); char* Ub = lds + L_OFF_UB;
    const int row0 = cix * CH; const RowInfo r0i = row_info(row0);
    LDS_BARRIER();
    {
        const int grp = tid & 15, t2 = tid >> 4, c0 = grp * 8;
#pragma unroll
        for (int i = 0; i < 2; ++i) { float acc[8];
#pragma unroll
            for (int e = 0; e < 8; ++e) acc[e] = R.bia[e];
#pragma unroll
            for (int j = 0; j < 4; ++j) { const u32x4 xv = R.xr[i + j];
#pragma unroll
                for (int e = 0; e < 4; ++e) { acc[2 * e] += R.wgt[j][2 * e] * bflo(xv[e]); acc[2 * e + 1] += R.wgt[j][2 * e + 1] * bfhi(xv[e]); } }
            const int tok = 2 * t2 + i;
#pragma unroll
            for (int e = 0; e < 8; ++e) Us[tok * US + c0 + e] = acc[e];
            *(u32x4*)(Ub + tok * UBS + c0 * 2) = (u32x4){pk2(acc[0], acc[1]), pk2(acc[2], acc[3]), pk2(acc[4], acc[5]), pk2(acc[6], acc[7])}; }
    }
    LDS_BARRIER();
    f32x4 acc[2][2][4];
#pragma unroll
    for (int d = 0; d < 2; ++d)
#pragma unroll
        for (int wh = 0; wh < 2; ++wh)
#pragma unroll
            for (int tb = 0; tb < 4; ++tb) acc[d][wh][tb] = (f32x4){0.f, 0.f, 0.f, 0.f};
#pragma unroll
    for (int s = 0; s < 4; ++s) {
        bf16x8 bfr[4];
#pragma unroll
        for (int tb = 0; tb < 4; ++tb) bfr[tb] = *(const bf16x8*)(Ub + (16 * tb + tl) * UBS + (32 * s + 8 * q) * 2);
#pragma unroll
        for (int d = 0; d < 2; ++d)
#pragma unroll
            for (int wh = 0; wh < 2; ++wh) { const bf16x8 a = *(const bf16x8*)(A.WG + ((size_t)((d * 2 + wh) * NH + nb)) * SZ_WBLK + (size_t)(16 * wid + tl) * LRU_BW + 32 * s + 8 * q);
#pragma unroll
                for (int tb = 0; tb < 4; ++tb) acc[d][wh][tb] = __builtin_amdgcn_mfma_f32_16x16x32_bf16(a, bfr[tb], acc[d][wh][tb], 0, 0, 0); }
    }
    if (has_next) local_load(A, ncix, nnb, tid, R);
    const int chb = nb * LRU_BW + 16 * wid + 4 * q;
#pragma unroll
    for (int d = 0; d < 2; ++d) {
        float sp[4], bav[4], bxv[4];
#pragma unroll
        for (int r = 0; r < 4; ++r) { sp[r] = R.sp[d][r]; bav[r] = R.bav[d][r]; bxv[r] = R.bxv[d][r]; }
        float Ac[4], Bc[4];
#pragma unroll
        for (int r = 0; r < 4; ++r) { Ac[r] = 1.f; Bc[r] = 0.f; }
#pragma unroll
        for (int tbi = 0; tbi < 4; ++tbi) { const int tb = d == 0 ? tbi : 3 - tbi; const int tok = 16 * tb + tl;
            float a[4], b[4];
#pragma unroll
            for (int r = 0; r < 4; ++r) { const float rr = __builtin_amdgcn_rcpf(1.0f + __expf(-(acc[d][0][tb][r] + bav[r]))), ii = __builtin_amdgcn_rcpf(1.0f + __expf(-(acc[d][1][tb][r] + bxv[r])));
                const float log_a = sp[r] * rr, x2 = 2.0f * log_a; a[r] = __expf(log_a);
                float em = 1.0f + x2 * (1.0f / 6.0f); em = 1.0f + x2 * 0.2f * em; em = 1.0f + x2 * 0.25f * em; em = 1.0f + x2 * (1.0f / 3.0f) * em; em = 1.0f + x2 * 0.5f * em; em = -x2 * em;
                if (__builtin_expect(x2 < -0.25f, 0)) em = -expm1f(x2);
                b[r] = __builtin_amdgcn_sqrtf(em) * ii * Us[tok * US + 16 * wid + 4 * q + r]; }
#define LRU_SCAN_STEP(CTRL) do { _Pragma("unroll") for (int r = 0; r < 4; ++r) { \
                const float ap = __int_as_float(__builtin_amdgcn_update_dpp(0x3f800000, __float_as_int(a[r]), (CTRL), 0xf, 0xf, false)); \
                const float bp = __int_as_float(__builtin_amdgcn_update_dpp(0, __float_as_int(b[r]), (CTRL), 0xf, 0xf, false)); \
                b[r] = a[r] * bp + b[r]; a[r] = a[r] * ap; } } while (0)
            if (d == 0) { LRU_SCAN_STEP(0x111); LRU_SCAN_STEP(0x112); LRU_SCAN_STEP(0x114); LRU_SCAN_STEP(0x118); }
            else        { LRU_SCAN_STEP(0x101); LRU_SCAN_STEP(0x102); LRU_SCAN_STEP(0x104); LRU_SCAN_STEP(0x108); }
#undef LRU_SCAN_STEP
#pragma unroll
            for (int r = 0; r < 4; ++r) { b[r] = a[r] * Bc[r] + b[r]; a[r] = a[r] * Ac[r]; }
            { const size_t o = ((size_t)d * M_ALL + row0 + tok) * LRU_W + chb;
              *(u32x2*)(A.B.HLOC + o) = (u32x2){pk2(b[0], b[1]), pk2(b[2], b[3])}; *(u32x2*)(A.B.ACUM + o) = (u32x2){pk2(a[0], a[1]), pk2(a[2], a[3])}; }
#pragma unroll
            for (int r = 0; r < 4; ++r) { const int sl = (lane & ~15) | (d == 0 ? 15 : 0); Ac[r] = lane_get(a[r], sl); Bc[r] = lane_get(b[r], sl); }
        }
        if (tl == 0) { float* ls = A.B.LSUM + (((size_t)cix * 2 + d) * 2) * LRU_W + chb;
            *(f32x4*)ls = (f32x4){Ac[0], Ac[1], Ac[2], Ac[3]}; *(f32x4*)(ls + LRU_W) = (f32x4){Bc[0], Bc[1], Bc[2], Bc[3]}; }
    }
    if (has_next && nnb != nb) local_weights(A, nnb, tid, R);
}
__device__ __forceinline__ void local_phase(const LocalArgs& A, char* lds, int G, int wg, const int tid) {
    constexpr int NT = NCHUNK * NH;
    int j0 = wg; if (j0 < NT) j0 += (NT - j0 + G - 1) / G * G;
    if (j0 >= 2 * NT) return;
    LocalPre R; { const int t = j0 - NT; local_weights(A, t % NH, tid, R); local_load(A, t / NH, t % NH, tid, R); }
    for (int j = j0; j < 2 * NT; j += G) { const int t = j - NT, tn = t + G; local_task(A, lds, t / NH, t % NH, tid, R, tn / NH, tn % NH, tn < NT); }
}
__device__ __forceinline__ void carry_phase(const Bufs& B, int gtid, int gthreads) {
    constexpr int NC = CTX_LEN / CH, NL = SEQ / CH;
    for (int i = gtid; i < BATCH * 2 * LRU_W; i += gthreads) { const int ch = i % LRU_W, d = (i / LRU_W) & 1, b = i / (2 * LRU_W);
        float h = 0.f;
        for (int s0 = 0; s0 < NC + NL; s0 += 12) {
            float av[12], bv[12]; int cx[12];
#pragma unroll
            for (int u = 0; u < 12; ++u) { const int step = s0 + u; int cix = 0;
                if (step < NC) { const int n = d ? NC - 1 - step : step; cix = M_LAT / CH + b * NC + n; }
                else if (step < NC + NL) { const int s2 = step - NC, n = d ? NL - 1 - s2 : s2; cix = b * NL + n; }
                cx[u] = cix; const float* ls = B.LSUM + (((size_t)cix * 2 + d) * 2) * LRU_W + ch; av[u] = ls[0]; bv[u] = ls[LRU_W]; }
#pragma unroll
            for (int u = 0; u < 12; ++u) if (s0 + u < NC + NL) { B.HIN[((size_t)cx[u] * 2 + d) * LRU_W + ch] = h; h = av[u] * h + bv[u]; }
        }
    }
}
__device__ __forceinline__ void finish_phase(const Bufs& B, const bf16_t* P, bf16_t* Y, int gtid, int gthreads) {
    for (int it = gtid; it < M_ALL * (LRU_W / 8); it += gthreads) { const int row = it / (LRU_W / 8), c0 = (it % (LRU_W / 8)) * 8, cix = row / CH;
        const u32x4 h0 = *(const u32x4*)(B.HLOC + (size_t)row * LRU_W + c0), a0 = *(const u32x4*)(B.ACUM + (size_t)row * LRU_W + c0);
        const u32x4 h1 = *(const u32x4*)(B.HLOC + ((size_t)M_ALL + row) * LRU_W + c0), a1 = *(const u32x4*)(B.ACUM + ((size_t)M_ALL + row) * LRU_W + c0);
        const u32x4 gt = *(const u32x4*)(P + (size_t)row * NP + C_LRU_G + c0);
        const float* i0 = B.HIN + ((size_t)cix * 2 + 0) * LRU_W + c0; const float* i1 = B.HIN + ((size_t)cix * 2 + 1) * LRU_W + c0;
        const f32x4 i0a = *(const f32x4*)i0, i0b = *(const f32x4*)(i0 + 4), i1a = *(const f32x4*)i1, i1b = *(const f32x4*)(i1 + 4);
        float y[8];
#pragma unroll
        for (int j = 0; j < 4; ++j) { const unsigned hw0 = h0[j], aw0 = a0[j], hw1 = h1[j], aw1 = a1[j], gw = gt[j];
            const float in0l = j < 2 ? i0a[2 * j] : i0b[2 * j - 4], in0h = j < 2 ? i0a[2 * j + 1] : i0b[2 * j - 3], in1l = j < 2 ? i1a[2 * j] : i1b[2 * j - 4], in1h = j < 2 ? i1a[2 * j + 1] : i1b[2 * j - 3];
            y[2 * j] = (bflo(hw0) + bflo(aw0) * in0l + bflo(hw1) + bflo(aw1) * in1l) * geluf_(bflo(gw));
            y[2 * j + 1] = (bfhi(hw0) + bfhi(aw0) * in0h + bfhi(hw1) + bfhi(aw1) * in1h) * geluf_(bfhi(gw)); }
        *(u32x4*)(Y + (size_t)row * D_MODEL + c0) = (u32x4){pk2(y[0], y[1]), pk2(y[2], y[3]), pk2(y[4], y[5]), pk2(y[6], y[7])};
    }
}
}

namespace misc {
typedef float f32x4 __attribute__((ext_vector_type(4)));
typedef unsigned u32x2 __attribute__((ext_vector_type(2)));
typedef unsigned u32x4 __attribute__((ext_vector_type(4)));
__device__ __forceinline__ unsigned pk2(float lo, float hi) { return (unsigned)f2bf(lo) | ((unsigned)f2bf(hi) << 16); }
__device__ __forceinline__ float wave_sum(float v, int lane) {
#pragma unroll
    for (int o = 1; o < 64; o <<= 1) v += lane_xor(v, o, lane);
    return v;
}
__device__ __forceinline__ float sum16(float v, int lane) {
#pragma unroll
    for (int o = 1; o < 16; o <<= 1) v += lane_xor(v, o, lane);
    return v;
}
__device__ __forceinline__ void norm_phase(float* H, const float* g, const float* MODl, int sh_idx, bf16_t* U, int nrows, int gwave, int nwaves, int lane,
                                           const float* PART, int nparts, const float* pgate, const float* xin, const float* cin) {
    static_assert(D_MODEL == 2048, "norm_phase geometry");
    int cset = -1; f32x4 gsv[8], shv[8];
    for (int r = gwave; r < nrows; r += nwaves) {
        const int set = r < M_LAT ? r / SEQ : BATCH;
        if (set != cset) { cset = set; const f32x4* gp = (const f32x4*)g + lane; const f32x4* shp = (const f32x4*)(MODl + (size_t)set * NMODV + (size_t)sh_idx * D_MODEL) + lane; const f32x4* scp = shp + D_MODEL / 4;
#pragma unroll
            for (int j = 0; j < 8; ++j) { gsv[j] = gp[64 * j] * (scp[64 * j] + 1.0f); shv[j] = shp[64 * j]; } }
        f32x4* hr = (f32x4*)(H + (size_t)r * D_MODEL) + lane;
        const f32x4* src = xin == nullptr ? hr : (r < M_LAT ? (const f32x4*)(xin + (size_t)r * D_MODEL) + lane : (const f32x4*)(cin + (size_t)(r - M_LAT) * D_MODEL) + lane);
        f32x4 v[8]; float ss = 0.f;
#pragma unroll
        for (int j = 0; j < 8; ++j) v[j] = src[64 * j];
        if (xin != nullptr && r >= M_LAT) {
#pragma unroll
            for (int j = 0; j < 8; ++j) hr[64 * j] = v[j]; }
        if (PART != nullptr && r >= M_LAT) {
            const f32x4* gp = (const f32x4*)pgate + lane;
#pragma unroll
            for (int j = 0; j < 8; ++j) { f32x4 acc = {0.f, 0.f, 0.f, 0.f};
                for (int s = 0; s < nparts; ++s) acc += *((const f32x4*)(PART + ((size_t)s * M_CTX + (r - M_LAT)) * D_MODEL) + lane + 64 * j);
                v[j] += gp[64 * j] * acc; hr[64 * j] = v[j]; }
        }
#pragma unroll
        for (int j = 0; j < 8; ++j) ss += (v[j][0] * v[j][0] + v[j][1] * v[j][1]) + (v[j][2] * v[j][2] + v[j][3] * v[j][3]);
        const float rstd = __builtin_amdgcn_rsqf(wave_sum(ss, lane) * (1.0f / D_MODEL) + EPS);
        u32x2* o = (u32x2*)(U + (size_t)r * D_MODEL) + lane;
#pragma unroll
        for (int j = 0; j < 8; ++j) { const f32x4 y = v[j] * rstd * gsv[j] + shv[j];
            o[64 * j] = (u32x2){pk2(y[0], y[1]), pk2(y[2], y[3])}; }
    }
}
struct RowNormArgs { const bf16_t* P; const float *qa_g, *kva_g, *na_qn_g, *na_kn_g; bf16_t *CQN, *CKVN, *NQ, *NK; };
__device__ __forceinline__ void rownorm_phase(const RowNormArgs& A, int gwave, int nwaves, int lane) {
    static_assert(MLA_Q_LORA == 384 && MLA_KV_LORA == 256 && GROUP_W == 512 && HD == 128, "rownorm geometry");
    float gq[6], gkv[4], gnq[8], gnk[8];
#pragma unroll
    for (int j = 0; j < 3; ++j) { gq[2 * j] = A.qa_g[2 * lane + 128 * j]; gq[2 * j + 1] = A.qa_g[2 * lane + 128 * j + 1]; }
#pragma unroll
    for (int j = 0; j < 2; ++j) { gkv[2 * j] = A.kva_g[2 * lane + 128 * j]; gkv[2 * j + 1] = A.kva_g[2 * lane + 128 * j + 1]; }
#pragma unroll
    for (int j = 0; j < 8; ++j) { gnq[j] = A.na_qn_g[(lane & 15) * 8 + j]; gnk[j] = A.na_kn_g[(lane & 15) * 8 + j]; }
    for (int r = gwave; r < M_ALL; r += nwaves) { const bf16_t* p = A.P + (size_t)r * NP;
        { float x[6], ss = 0.f;
#pragma unroll
          for (int j = 0; j < 3; ++j) { const unsigned w = *(const unsigned*)(p + C_CQ + 2 * lane + 128 * j); x[2 * j] = bflo(w); x[2 * j + 1] = bfhi(w); ss += x[2 * j] * x[2 * j] + x[2 * j + 1] * x[2 * j + 1]; }
          const float rstd = 1.0f / sqrtf(wave_sum(ss, lane) * (1.0f / MLA_Q_LORA) + EPS);
#pragma unroll
          for (int j = 0; j < 3; ++j) { const int c = 2 * lane + 128 * j; *(unsigned*)(A.CQN + (size_t)r * MLA_Q_LORA + c) = pk2(x[2 * j] * rstd * gq[2 * j], x[2 * j + 1] * rstd * gq[2 * j + 1]); } }
        { float x[4], ss = 0.f;
#pragma unroll
          for (int j = 0; j < 2; ++j) { const unsigned w = *(const unsigned*)(p + C_CKV + 2 * lane + 128 * j); x[2 * j] = bflo(w); x[2 * j + 1] = bfhi(w); ss += x[2 * j] * x[2 * j] + x[2 * j + 1] * x[2 * j + 1]; }
          const float rstd = 1.0f / sqrtf(wave_sum(ss, lane) * (1.0f / MLA_KV_LORA) + EPS);
#pragma unroll
          for (int j = 0; j < 2; ++j) { const int c = 2 * lane + 128 * j; *(unsigned*)(A.CKVN + (size_t)r * MLA_KV_LORA + c) = pk2(x[2 * j] * rstd * gkv[2 * j], x[2 * j + 1] * rstd * gkv[2 * j + 1]); } }
#pragma unroll
        for (int which = 0; which < 2; ++which) {
            const int hh = lane >> 4, d0 = (lane & 15) * 8; const u32x4 w = *(const u32x4*)(p + (which == 0 ? C_NQ : C_NK) + hh * HD + d0);
            float x[8]; float ss = 0.f;
#pragma unroll
            for (int j = 0; j < 4; ++j) { x[2 * j] = bflo(w[j]); x[2 * j + 1] = bfhi(w[j]); ss += x[2 * j] * x[2 * j] + x[2 * j + 1] * x[2 * j + 1]; }
            const float rstd = __builtin_amdgcn_rsqf(sum16(ss, lane) * (1.0f / HD) + EPS); const float* g = which == 0 ? gnq : gnk;
            *(u32x4*)((which == 0 ? A.NQ : A.NK) + (size_t)r * GROUP_W + hh * HD + d0) =
                (u32x4){pk2(x[0] * rstd * g[0], x[1] * rstd * g[1]), pk2(x[2] * rstd * g[2], x[3] * rstd * g[3]), pk2(x[4] * rstd * g[4], x[5] * rstd * g[5]), pk2(x[6] * rstd * g[6], x[7] * rstd * g[7])};
        }
    }
}
struct MlaQkvArgs { const bf16_t* QR; const bf16_t* KVR; const bf16_t* P; const float *qn_g, *kn_g; bf16_t *QM, *KM, *VM; };
__device__ __forceinline__ void mlaqkv_phase(const MlaQkvArgs& A, int gwave, int nwaves, int lane) {
    static_assert(MLA_QK == 192 && MLA_NOPE == 128 && MLA_ROPE == 64 && NH == 4 && GRID_W == 64, "mla qkv geometry");
    const int hh = lane >> 4, g = lane & 15;
    const int f0 = (2 * g) & 15; const float inv0 = powf(10000.0f, -(float)f0 / 16.0f), inv1 = powf(10000.0f, -(float)(f0 + 1) / 16.0f);
    f32x4 gq0 = *(const f32x4*)(A.qn_g + 8 * g), gq1 = *(const f32x4*)(A.qn_g + 8 * g + 4), gk0 = *(const f32x4*)(A.kn_g + 8 * g), gk1 = *(const f32x4*)(A.kn_g + 8 * g + 4);
    const float gqr[4] = {A.qn_g[MLA_NOPE + 2 * g], A.qn_g[MLA_NOPE + 2 * g + 1], A.qn_g[MLA_NOPE + 32 + 2 * g], A.qn_g[MLA_NOPE + 32 + 2 * g + 1]};
    const float gkr[4] = {A.kn_g[MLA_NOPE + 2 * g], A.kn_g[MLA_NOPE + 2 * g + 1], A.kn_g[MLA_NOPE + 32 + 2 * g], A.kn_g[MLA_NOPE + 32 + 2 * g + 1]};
    for (int r = gwave; r < M_ALL; r += nwaves) {
        const bool lat = r < M_LAT; const int t = lat ? r % SEQ : 0; const float pos = g < 8 ? (float)(t / GRID_W) : (float)(t % GRID_W);
        float c0 = 1.f, s0 = 0.f, c1 = 1.f, s1 = 0.f;
        if (lat) { sincosf(pos * inv0, &s0, &c0); sincosf(pos * inv1, &s1, &c1); }
#pragma unroll
        for (int which = 0; which < 2; ++which) {
            const bf16_t* nsrc = which == 0 ? A.QR + (size_t)r * NQ_MLA + hh * MLA_QK : A.KVR + (size_t)r * NKV_MLA + hh * (MLA_NOPE + MLA_V);
            const bf16_t* rsrc = which == 0 ? nsrc + MLA_NOPE : A.P + (size_t)r * NP + C_KR;
            const u32x4 nw = *(const u32x4*)(nsrc + 8 * g); const unsigned ra = *(const unsigned*)(rsrc + 2 * g), rb = *(const unsigned*)(rsrc + 32 + 2 * g);
            float x[8], a0 = bflo(ra), a1 = bfhi(ra), b0 = bflo(rb), b1 = bfhi(rb);
            float ss = a0 * a0 + a1 * a1 + b0 * b0 + b1 * b1;
#pragma unroll
            for (int j = 0; j < 4; ++j) { x[2 * j] = bflo(nw[j]); x[2 * j + 1] = bfhi(nw[j]); ss += x[2 * j] * x[2 * j] + x[2 * j + 1] * x[2 * j + 1]; }
            const float rstd = __builtin_amdgcn_rsqf(sum16(ss, lane) * (1.0f / MLA_QK) + EPS);
            const f32x4 g0 = which == 0 ? gq0 : gk0, g1 = which == 0 ? gq1 : gk1;
#pragma unroll
            for (int j = 0; j < 4; ++j) { x[j] *= rstd * g0[j]; x[4 + j] *= rstd * g1[j]; }
            a0 *= rstd * (which == 0 ? gqr[0] : gkr[0]); a1 *= rstd * (which == 0 ? gqr[1] : gkr[1]); b0 *= rstd * (which == 0 ? gqr[2] : gkr[2]); b1 *= rstd * (which == 0 ? gqr[3] : gkr[3]);
            const float ya0 = a0 * c0 - b0 * s0, yb0 = a0 * s0 + b0 * c0, ya1 = a1 * c1 - b1 * s1, yb1 = a1 * s1 + b1 * c1;
            bf16_t* O = (which == 0 ? A.QM : A.KM) + (size_t)r * NQ_MLA + hh * MLA_QK;
            *(u32x4*)(O + 8 * g) = (u32x4){pk2(x[0], x[1]), pk2(x[2], x[3]), pk2(x[4], x[5]), pk2(x[6], x[7])};
            *(unsigned*)(O + MLA_NOPE + 2 * g) = pk2(ya0, ya1); *(unsigned*)(O + MLA_NOPE + 32 + 2 * g) = pk2(yb0, yb1);
        }
        *(u32x4*)(A.VM + (size_t)r * (NH * MLA_V) + hh * MLA_V + 8 * g) = *(const u32x4*)(A.KVR + (size_t)r * NKV_MLA + hh * (MLA_NOPE + MLA_V) + MLA_NOPE + 8 * g);
    }
}
constexpr int ACT_RUN = 32;
__device__ __forceinline__ void act_phase(const bf16_t* UP, const float* cw, const float* cb, bf16_t* ACT, int nrows, int gtid, int gthreads) {
    constexpr int NC8 = D_FF / 8; static_assert(SEQ % ACT_RUN == 0 && CTX_LEN % ACT_RUN == 0, "row runs stay inside one sequence");
    const int nruns = nrows / ACT_RUN;
    for (long it = gtid; it < (long)nruns * NC8; it += gthreads) { const int run = (int)(it / NC8), j0 = (int)(it % NC8) * 8, r0 = run * ACT_RUN; const RowInfo ri = row_info(r0);
        float wa[3][8], wg[3][8], ba[8], bg[8];
#pragma unroll
        for (int k = 0; k < 3; ++k) { const float* p = cw + (size_t)k * 2 * D_FF + j0; const f32x4 a0 = *(const f32x4*)p, a1 = *(const f32x4*)(p + 4), g0 = *(const f32x4*)(p + D_FF), g1 = *(const f32x4*)(p + D_FF + 4);
#pragma unroll
            for (int e = 0; e < 4; ++e) { wa[k][e] = a0[e]; wa[k][4 + e] = a1[e]; wg[k][e] = g0[e]; wg[k][4 + e] = g1[e]; } }
        { const f32x4 a0 = *(const f32x4*)(cb + j0), a1 = *(const f32x4*)(cb + j0 + 4), g0 = *(const f32x4*)(cb + D_FF + j0), g1 = *(const f32x4*)(cb + D_FF + j0 + 4);
#pragma unroll
          for (int e = 0; e < 4; ++e) { ba[e] = a0[e]; ba[4 + e] = a1[e]; bg[e] = g0[e]; bg[4 + e] = g1[e]; } }
        const u32x4 zero = {0u, 0u, 0u, 0u};
        const bf16_t* ub = UP + (size_t)ri.base * (2 * D_FF) + j0;
        u32x4 am, ac, gm, gc;
        { const int t = ri.t; am = t > 0 ? *(const u32x4*)(ub + (size_t)(t - 1) * (2 * D_FF)) : zero; gm = t > 0 ? *(const u32x4*)(ub + (size_t)(t - 1) * (2 * D_FF) + D_FF) : zero;
          ac = *(const u32x4*)(ub + (size_t)t * (2 * D_FF)); gc = *(const u32x4*)(ub + (size_t)t * (2 * D_FF) + D_FF); }
#pragma unroll 4
        for (int i = 0; i < ACT_RUN; ++i) { const int t = ri.t + i;
            const u32x4 ap = t + 1 < ri.T ? *(const u32x4*)(ub + (size_t)(t + 1) * (2 * D_FF)) : zero, gp = t + 1 < ri.T ? *(const u32x4*)(ub + (size_t)(t + 1) * (2 * D_FF) + D_FF) : zero;
            float y[8];
#pragma unroll
            for (int e = 0; e < 4; ++e) {
                const float a0 = ba[2 * e] + wa[0][2 * e] * bflo(am[e]) + wa[1][2 * e] * bflo(ac[e]) + wa[2][2 * e] * bflo(ap[e]);
                const float a1 = ba[2 * e + 1] + wa[0][2 * e + 1] * bfhi(am[e]) + wa[1][2 * e + 1] * bfhi(ac[e]) + wa[2][2 * e + 1] * bfhi(ap[e]);
                const float g0 = bg[2 * e] + wg[0][2 * e] * bflo(gm[e]) + wg[1][2 * e] * bflo(gc[e]) + wg[2][2 * e] * bflo(gp[e]);
                const float g1 = bg[2 * e + 1] + wg[0][2 * e + 1] * bfhi(gm[e]) + wg[1][2 * e + 1] * bfhi(gc[e]) + wg[2][2 * e + 1] * bfhi(gp[e]);
                y[2 * e] = a0 * (g0 / (1.0f + __expf(-g0))); y[2 * e + 1] = a1 * (g1 / (1.0f + __expf(-g1))); }
            *(u32x4*)(ACT + (size_t)(r0 + i) * D_FF + j0) = (u32x4){pk2(y[0], y[1]), pk2(y[2], y[3]), pk2(y[4], y[5]), pk2(y[6], y[7])};
            am = ac; ac = ap; gm = gc; gc = gp; }
    }
}
__device__ __forceinline__ void act_fix_phase(const bf16_t* HALO, const float* cw, const float* cb, bf16_t* ACT, int nrows, int gtid, int gthreads) {
    constexpr int NC8 = D_FF / 8; const int nblk = nrows / 64;
    for (long it = gtid; it < (long)nblk * 2 * NC8; it += gthreads) { const int j0 = (int)(it % NC8) * 8, be = (int)(it / NC8), blk = be >> 1, edge = be & 1; const int row = blk * 64 + (edge ? 63 : 0);
        const RowInfo ri = row_info(row);
        const bf16_t* hb = HALO + (size_t)blk * 4 * (2 * D_FF) + j0;
        const bool has_prev = ri.t > 0, has_next = ri.t + 1 < ri.T; const u32x4 zero = {0u, 0u, 0u, 0u};
        const bf16_t* pc = hb + (size_t)(edge ? 3 : 0) * (2 * D_FF);
        const bf16_t* pp_ = edge ? hb + (size_t)2 * (2 * D_FF) : hb - (size_t)4 * (2 * D_FF) + (size_t)3 * (2 * D_FF);
        const bf16_t* pn = edge ? hb + (size_t)4 * (2 * D_FF) : hb + (size_t)1 * (2 * D_FF);
        const u32x4 ac = *(const u32x4*)pc, gc = *(const u32x4*)(pc + D_FF);
        const u32x4 am = has_prev ? *(const u32x4*)pp_ : zero, gm = has_prev ? *(const u32x4*)(pp_ + D_FF) : zero;
        const u32x4 ap = has_next ? *(const u32x4*)pn : zero, gp = has_next ? *(const u32x4*)(pn + D_FF) : zero;
        float y[8];
#pragma unroll
        for (int e = 0; e < 4; ++e) {
#pragma unroll
            for (int hh = 0; hh < 2; ++hh) { const int c = j0 + 2 * e + hh;
                const float xam = hh ? bfhi(am[e]) : bflo(am[e]), xac = hh ? bfhi(ac[e]) : bflo(ac[e]), xap = hh ? bfhi(ap[e]) : bflo(ap[e]);
                const float xgm = hh ? bfhi(gm[e]) : bflo(gm[e]), xgc = hh ? bfhi(gc[e]) : bflo(gc[e]), xgp = hh ? bfhi(gp[e]) : bflo(gp[e]);
                const float a = cb[c] + cw[c] * xam + cw[2 * D_FF + c] * xac + cw[4 * D_FF + c] * xap;
                const float g = cb[D_FF + c] + cw[D_FF + c] * xgm + cw[2 * D_FF + D_FF + c] * xgc + cw[4 * D_FF + D_FF + c] * xgp;
                y[2 * e + hh] = a * (g * __builtin_amdgcn_rcpf(1.0f + __expf(-g))); } }
        *(u32x4*)(ACT + (size_t)row * D_FF + j0) = (u32x4){pk2(y[0], y[1]), pk2(y[2], y[3]), pk2(y[4], y[5]), pk2(y[6], y[7])};
    }
}
__device__ __forceinline__ void transpose_item(const float* W, int K, int N, int Npad, bf16_t* WT, float* scr  , int item, int lane, int pairF = 0) {
    const int nblk = Npad / 64, kb = item / nblk, nb = item % nblk, k0 = 64 * kb, n0 = 64 * nb; const int nq = lane & 15, kq = lane >> 4, n = n0 + 4 * nq; const bool ok = n < N;
    f32x4 v[16];
#pragma unroll
    for (int i = 0; i < 16; ++i) v[i] = ok ? *(const f32x4*)(W + (size_t)(k0 + 4 * i + kq) * N + n) : (f32x4){0.f, 0.f, 0.f, 0.f};
#pragma unroll
    for (int i = 0; i < 16; ++i)
#pragma unroll
        for (int e = 0; e < 4; ++e) scr[(4 * nq + e) * 65 + 4 * i + kq] = v[i][e];
    asm volatile("s_waitcnt lgkmcnt(0)" ::: "memory");
    const int c = lane & 7;
#pragma unroll
    for (int j = 0; j < 8; ++j) { const int nn = (lane >> 3) + 8 * j; const float* s = scr + nn * 65 + 8 * c;
        u32x4 o; o.x = pk2(s[0], s[1]); o.y = pk2(s[2], s[3]); o.z = pk2(s[4], s[5]); o.w = pk2(s[6], s[7]);
        const int nsrc = n0 + nn; const int nd = pairF == 0 ? nsrc : (nsrc < pairF ? (nsrc >> 7) * 256 + (nsrc & 127) : ((nsrc - pairF) >> 7) * 256 + 128 + ((nsrc - pairF) & 127));
        *(u32x4*)(WT + (size_t)nd * K + k0 + 8 * c) = o; }
    asm volatile("s_waitcnt lgkmcnt(0)" ::: "memory");
}
}

__device__ __forceinline__ gdn::Bufs gdn_bufs(const WS& w, int l) { gdn::Bufs B; B.UT = w.gUT; B.WP = w.gWP; B.KDT = w.gKDT; B.QD = w.gQD; B.QK = w.gQK; B.SIT = w.gSIT; B.VNT = w.gVNT; B.GT = w.gGT + (size_t)l * gdn::NTASK; return B; }
__device__ __forceinline__ lru::Bufs lru_bufs(const WS& w) { lru::Bufs B; B.HLOC = w.lHLOC; B.ACUM = w.lACUM; B.LSUM = w.lLSUM; B.HIN = w.lHIN; return B; }

#define LAS __attribute__((address_space(3)))
#define XB_TMO      128
#define XB_XCNT(j)  (256  + 64 * (j))
#define XB_XSUB(j)  (1280 + 64 * (j))
#define XB_XGEN(j)  (2304 + 64 * (j))
#define XB_TOP      3328
#define XB_TOPGEN   3392
#define XCD_BAR_WORDS 3456
#define XB_SPIN_CAP (1u << 18)
__device__ __forceinline__ unsigned xb_ld(unsigned* p)              { return __hip_atomic_load(p, __ATOMIC_RELAXED, __HIP_MEMORY_SCOPE_AGENT); }
__device__ __forceinline__ unsigned xb_add(unsigned* p, unsigned v) { return __hip_atomic_fetch_add(p, v, __ATOMIC_RELAXED, __HIP_MEMORY_SCOPE_AGENT); }
__device__ __forceinline__ unsigned xb_xcc_id() { return (unsigned)__builtin_amdgcn_s_getreg((3 << 11) | 20) & 0xFu; }
#define XB_SPIN(cond, bar) do { unsigned _sp = 0; while (cond) { __builtin_amdgcn_s_sleep(1); \
    if ((++_sp & 255u) == 0u) { if (xb_ld(&(bar)[XB_TMO])) break; if (_sp > XB_SPIN_CAP) { atomicAdd(&(bar)[XB_TMO], 1u); break; } } } } while (0)
struct XcdBarrier { unsigned* bar; unsigned x; volatile LAS unsigned* st; };
__device__ __forceinline__ XcdBarrier xcd_barrier_post(unsigned* bar, volatile LAS unsigned* st, const bool leader) {
    XcdBarrier b; b.bar = bar; b.x = xb_xcc_id(); b.st = st;
    if (leader) (void)xb_add(&bar[XB_XCNT(b.x)], 1u);
    return b;
}
__device__ __forceinline__ void xcd_barrier_complete(unsigned* bar, unsigned x, unsigned& nloc, unsigned& nx) {
    const unsigned G = gridDim.x * gridDim.y * gridDim.z;
    unsigned sum, cnt, mine, sp = 0u;
    for (;;) {
        sum = 0u; cnt = 0u; mine = 0u;
#pragma unroll
        for (unsigned j = 0; j < 16; ++j) { const unsigned c = xb_ld(&bar[XB_XCNT(j)]); sum += c; cnt += (c > 0u) ? 1u : 0u; mine = (j == x) ? c : mine; }
        if (sum == G) break;
        __builtin_amdgcn_s_sleep(1);
        if ((++sp & 255u) == 0u) { if (xb_ld(&bar[XB_TMO])) break; if (sp > XB_SPIN_CAP) { atomicAdd(&bar[XB_TMO], 1u); break; } }
    }
    nloc = mine > 0u ? mine : 1u; nx = cnt > 0u ? cnt : 1u;
}
__device__ __forceinline__ void xcd_barrier(const XcdBarrier& b, const bool leader) {
    asm volatile("s_waitcnt vmcnt(0)" ::: "memory");
    __syncthreads();
    if (leader) {
        unsigned* bar = b.bar;
        __builtin_amdgcn_s_waitcnt(0);
        unsigned nloc = b.st[0], nx = b.st[1];
        if (nloc == 0u) { xcd_barrier_complete(bar, b.x, nloc, nx); b.st[0] = nloc; b.st[1] = nx; }
        const unsigned old = xb_add(&bar[XB_XSUB(b.x)], 1u);
        const unsigned gen = old / nloc;
        if (old + 1u == (gen + 1u) * nloc) {
            __builtin_amdgcn_fence(__ATOMIC_RELEASE, "agent");
            asm volatile("s_waitcnt vmcnt(0)" ::: "memory");
            const unsigned og = xb_add(&bar[XB_TOP], 1u);
            const unsigned tg = og / nx;
            if (og + 1u == (tg + 1u) * nx) xb_add(&bar[XB_TOPGEN], 1u);
            else XB_SPIN(xb_ld(&bar[XB_TOPGEN]) == tg, bar);
            __builtin_amdgcn_fence(__ATOMIC_ACQUIRE, "agent");
            xb_add(&bar[XB_XGEN(b.x)], 1u);
            asm volatile("s_waitcnt vmcnt(0)" ::: "memory");
        } else {
            XB_SPIN(xb_ld(&bar[XB_XGEN(b.x)]) == gen, bar);
            __builtin_amdgcn_fence(__ATOMIC_ACQUIRE, "agent");
            asm volatile("s_waitcnt vmcnt(0)" ::: "memory");
        }
    }
    __syncthreads();
}

constexpr int NWAVES = 8, NTHR = 512;
constexpr int LDS_MISC = 147456, LDS_BYTES = 148480;
static_assert(sizeof(Inputs) == 34 * 8, "Inputs mirrors Params::in");
static_assert(gdn::G1_LDS <= LDS_MISC && pg8::STAGE_BYTES <= LDS_MISC && att::Cfg<MLA_QK>::LDS_BYTES <= LDS_MISC && gdn::G2_LDS <= LDS_MISC, "LDS map");
constexpr int CW_BAR = 4096;
constexpr int G2_CUT1 = 52, G2_CUT2 = 52;
constexpr int SK_OUT = 4, SK_DOWN = 5;
constexpr int PH_PRO = 0, PH_PER_LAYER = 12, NPH = 1 + PH_PER_LAYER * DEPTH;
struct Params { const float* in[34]; float* out; unsigned char* ws; int ph_lo, ph_hi, li, pad; };

struct SplitOrder {
    int nN, nM, S, G, c;
    __device__ __forceinline__ void init(int M, int N, int S_, int G_, int c_) { nM = M / pg8::BM; nN = N / pg8::BM; S = S_; G = G_; c = c_; }
    __device__ __forceinline__ bool next(int i, pg8::Unit& u) const { const int g = c + i * G; if (g >= nM * nN * S) return false; u.ks = g / (nM * nN); const int loc = g % (nM * nN); u.pm = loc / nN; u.pn = loc % nN; return true; }
    __device__ __forceinline__ void a_ready(const pg8::Unit&) const {}
    __device__ __forceinline__ void done(const pg8::Unit&) const {}
};
struct SpanOrder {
    int nN, lo, hi, G, g0;
    __device__ __forceinline__ void init(int N, int lo_, int hi_, int G_, int c) { nN = N / pg8::BM; lo = lo_; hi = hi_; G = G_; int i0 = 0; if (c < lo_) i0 = (lo_ - c + G_ - 1) / G_; g0 = c + i0 * G_; }
    __device__ __forceinline__ bool next(int i, pg8::Unit& u) const { const int g = g0 + i * G; if (g >= hi) return false; const int loc = g - lo; u.pm = loc / nN; u.pn = loc % nN; u.ks = 0; return true; }
    __device__ __forceinline__ void a_ready(const pg8::Unit&) const {}
    __device__ __forceinline__ void done(const pg8::Unit&) const {}
};

#define AS4 __attribute__((address_space(4)))
#define PHASE_WS const AS4 Params* pp = (const AS4 Params*)__builtin_amdgcn_kernarg_segment_ptr(); asm volatile("" : "+s"(pp)); const AS4 Inputs* I = (const AS4 Inputs*)pp; (void)I; unsigned char* wsb_ = pp->ws; const WS w = ws_carve(wsb_)
#define PHASE_IDS int tid = C_wave0 * 64 + (int)__builtin_amdgcn_mbcnt_hi(~0u, __builtin_amdgcn_mbcnt_lo(~0u, 0u)); asm volatile("" : "+v"(tid)); const int lane = tid & 63, wave = __builtin_amdgcn_readfirstlane(tid >> 6), gwave = wg * NWAVES + wave, gtid = wg * NTHR + tid; (void)lane; (void)gwave; (void)gtid
#ifndef DBG_MASK
#define DBG_MASK 0xFFFFFF
#endif
#define IN(k) (lo <= (k) && (k) < hi)
#define ON(j) (((DBG_MASK) >> (j)) & 1)
#define SEAM(k) do { if (IN(k) && IN((k) + 1)) xcd_barrier(bar, C_wave0 == 0 && __builtin_amdgcn_mbcnt_hi(~0u, __builtin_amdgcn_mbcnt_lo(~0u, 0u)) == 0u); } while (0)

constexpr int I_IN = (D_MODEL / 64) * (NP / 64), I_OUT = (D_MODEL / 64) * (D_MODEL / 64), I_UP = (D_MODEL / 64) * (2 * D_FF / 64), I_DN = (D_FF / 64) * (D_MODEL / 64),
              I_UQ = (MLA_Q_LORA / 64) * (NQ_MLA / 64), I_UKV = (MLA_KV_LORA / 64) * (NKV_MLA / 64), I_LB = (LRU_BW / 64) * (LRU_BW / 64), I_LRU = 2 * 2 * NH * I_LB;
constexpr int I_PA = I_IN + I_OUT + I_UQ + I_UKV + I_LRU, I_PB = I_UP + I_DN;
constexpr int PREP_SCR = 16640;
__device__ __forceinline__ void prep_item_a(const AS4 Inputs* I, const WS& w, int l, int r, float* scr, int lane) {
    if (r < I_IN) { misc::transpose_item(I->w_in + (size_t)l * D_MODEL * IN_COLS, D_MODEL, IN_COLS, NP, w.WIN + l * SZ_WIN, scr, r, lane); return; } r -= I_IN;
    if (r < I_OUT) { misc::transpose_item(I->w_out + (size_t)l * D_MODEL * D_MODEL, D_MODEL, D_MODEL, D_MODEL, w.WOUT + l * SZ_WOUT, scr, r, lane); return; } r -= I_OUT;
    if (r < I_UQ) { misc::transpose_item(I->mla_w_uq + (size_t)l * MLA_Q_LORA * NQ_MLA, MLA_Q_LORA, NQ_MLA, NQ_MLA, w.WUQ + l * SZ_WUQ, scr, r, lane); return; } r -= I_UQ;
    if (r < I_UKV) { misc::transpose_item(I->mla_w_ukv + (size_t)l * MLA_KV_LORA * NKV_MLA, MLA_KV_LORA, NKV_MLA, NKV_MLA, w.WUKV + l * SZ_WUKV, scr, r, lane); return; } r -= I_UKV;
    { const int blk = r / I_LB, item = r % I_LB, d = blk / (2 * NH), wh = (blk / NH) & 1, nb = blk % NH;
      const float* src = (wh == 0 ? I->lru_wa : I->lru_wx) + ((size_t)(l * 2 + d) * NH + nb) * lru::SZ_WBLK;
      misc::transpose_item(src, LRU_BW, LRU_BW, LRU_BW, w.WLRU + ((size_t)l * 16 + blk) * lru::SZ_WBLK, scr, item, lane); }
}
__device__ __forceinline__ void prep_item_b(const AS4 Inputs* I, const WS& w, int l, int r, float* scr, int lane) {
    if (r < I_UP) { misc::transpose_item(I->ffn_w_up + (size_t)l * D_MODEL * 2 * D_FF, D_MODEL, 2 * D_FF, 2 * D_FF, w.WUP + l * SZ_WUP, scr, r, lane, D_FF); return; } r -= I_UP;
    misc::transpose_item(I->ffn_w_down + (size_t)l * D_FF * D_MODEL, D_FF, D_MODEL, D_MODEL, w.WDOWN + l * SZ_WDOWN, scr, r, lane);
}
constexpr int NMT = NMODV / 128;
__device__ __forceinline__ void mod_fill(const AS4 Inputs* I, char* lds, int tid) {
    float* SCs = (float*)lds;
    for (int i = tid; i < (BATCH + 1) * D_MODEL; i += 512) { const int s = i / D_MODEL, k = i % D_MODEL; const float v = s < BATCH ? I->c[s * D_MODEL + k] : I->c_ctx[k]; SCs[i] = v / (1.0f + __expf(-v)); }
    __syncthreads();
}
__device__ __forceinline__ void mod_task(const AS4 Inputs* I, const WS& w, int l, int t, char* lds, int tid, int wave, int lane) {
    const float* SCs = (const float*)lds; float* red = (float*)(lds + 3 * D_MODEL * 4);
    const int j0 = t * 128, h = lane >> 5, cl = lane & 31;
    misc::f32x4 acc[3] = {{0.f, 0.f, 0.f, 0.f}, {0.f, 0.f, 0.f, 0.f}, {0.f, 0.f, 0.f, 0.f}};
    const float* wp = I->ada_w + (size_t)l * D_MODEL * NMODV + (size_t)(256 * wave + h) * NMODV + j0 + 4 * cl;
#pragma unroll 8
    for (int k = 0; k < 128; ++k) { const misc::f32x4 wv = *(const misc::f32x4*)(wp + (size_t)(2 * k) * NMODV); const int kk = 256 * wave + 2 * k + h;
        acc[0] += wv * SCs[kk]; acc[1] += wv * SCs[D_MODEL + kk]; acc[2] += wv * SCs[2 * D_MODEL + kk]; }
#pragma unroll
    for (int s = 0; s < 3; ++s)
#pragma unroll
        for (int e = 0; e < 4; ++e) acc[s][e] += lane_xor(acc[s][e], 32, lane);
    __syncthreads();
    if (h == 0) {
#pragma unroll
        for (int s = 0; s < 3; ++s) *(misc::f32x4*)(red + (wave * 3 + s) * 128 + 4 * cl) = acc[s]; }
    __syncthreads();
    for (int i = tid; i < 3 * 128; i += 512) { const int s = i / 128, c = i % 128; float sum = I->ada_b[(size_t)l * NMODV + j0 + c];
#pragma unroll
        for (int w8 = 0; w8 < 8; ++w8) sum += red[(w8 * 3 + s) * 128 + c];
        w.MOD[((size_t)l * (BATCH + 1) + s) * NMODV + j0 + c] = sum; }
}
#define PREP_IDLE(nunits, nitems, CALL) do { const int r_ = (nunits) % G, first_ = r_, nid_ = G - r_; \
        if (wg >= first_) { float* scr = (float*)(lds + wave * PREP_SCR); for (int it = (wg - first_) * NWAVES + wave; it < (nitems); it += nid_ * NWAVES) { CALL; } } } while (0)

struct LayerCtx { int lo, hi, G, wg, nwaves, gthreads, wave0; XcdBarrier bar; char* lds; unsigned char* lds_raw; };
template <int l> __device__ __forceinline__ void layer_body(const LayerCtx& C) {
    const int lo = C.lo, hi = C.hi, G = C.G, wg = C.wg, nwaves = C.nwaves, gthreads = C.gthreads, C_wave0 = C.wave0; const XcdBarrier& bar = C.bar; char* lds = C.lds; unsigned char* lds_raw = C.lds_raw;
    (void)G; (void)nwaves; (void)gthreads;
        const int pb = 1 + PH_PER_LAYER * l;
        const bool want_ctx = l < DEPTH - 1; const int Mo = want_ctx ? M_ALL : M_LAT;
        if (ON(0) && IN(pb + 0)) { PHASE_WS; PHASE_IDS; const float* MODl = w.MOD + (size_t)l * (BATCH + 1) * NMODV; (void)MODl; misc::norm_phase(w.H, I->norm_mix_g + (size_t)l * D_MODEL, MODl, 0, w.U, M_ALL, gwave, nwaves, lane, l > 0 ? w.PART : nullptr, SK_DOWN, MODl - (size_t)(BATCH + 1) * NMODV + (size_t)BATCH * NMODV + 5 * D_MODEL, l == 0 ? I->x : nullptr, l == 0 ? I->ctx : nullptr); }
        SEAM(pb + 0);
        if (ON(1) && IN(pb + 1)) { PHASE_WS; PHASE_IDS; const float* MODl = w.MOD + (size_t)l * (BATCH + 1) * NMODV; (void)MODl; pg8::Gemm g{w.U, w.WIN + l * SZ_WIN, M_ALL, NP, D_MODEL, D_MODEL}; pg8::StaticOrder S; S.init(M_ALL, NP, G, wg);
            pg8::EpiBf16<0> E{w.P, NP, nullptr, 0, 0, 1.0f};
            pg8::gemm_phase<pg8::EpiBf16<0>, pg8::StaticOrder, true, true>((PG8_LAS unsigned char*)lds_raw, g, S, E, tid);
            if constexpr (l < DEPTH - 1) PREP_IDLE((M_ALL / 256) * (NP / 256), I_PA, prep_item_a(I, w, l + 1, it, scr, lane)); }
        SEAM(pb + 1);
        if (ON(2) && IN(pb + 2)) { PHASE_WS; PHASE_IDS; const float* MODl = w.MOD + (size_t)l * (BATCH + 1) * NMODV; (void)MODl;
            const int pflags = pp->pad;
            if (!(pflags & 16)) { gdn::G1Args A; A.P = w.P; A.conv_w = I->gdn_conv_w + (size_t)l * 4 * 3 * GROUP_W; A.a_log = I->gdn_a_log + (size_t)l * 2 * NH; A.dt_bias = I->gdn_dt_bias + (size_t)l * 2 * NH; A.B = gdn_bufs(w, l); A.pflags = pflags;
              gdn::g1_phase(A, lds, G, wg, tid); }
            if (!(pflags & 32)) { lru::LocalArgs A; A.P = w.P; A.conv_w = I->lru_conv_w + (size_t)l * 4 * LRU_W; A.conv_b = I->lru_conv_b + (size_t)l * LRU_W; A.WG = w.WLRU + (size_t)l * 16 * lru::SZ_WBLK;
              A.ba = I->lru_ba + (size_t)l * 2 * LRU_W; A.bx = I->lru_bx + (size_t)l * 2 * LRU_W; A.lam = I->lru_lam + (size_t)l * 2 * LRU_W; A.B = lru_bufs(w);
              lru::local_phase(A, lds, G, wg, tid); }
            if (!(pflags & 64)) { misc::RowNormArgs A; A.P = w.P; A.qa_g = I->mla_qa_g + (size_t)l * MLA_Q_LORA; A.kva_g = I->mla_kva_g + (size_t)l * MLA_KV_LORA; A.na_qn_g = I->na_qn_g + (size_t)l * HD; A.na_kn_g = I->na_kn_g + (size_t)l * HD;
              A.CQN = w.CQN; A.CKVN = w.CKVN; A.NQ = w.NQ; A.NK = w.NK; misc::rownorm_phase(A, gwave, nwaves, lane); }
        }
        SEAM(pb + 2);
        if (ON(3) && IN(pb + 3)) { PHASE_WS; PHASE_IDS; const float* MODl = w.MOD + (size_t)l * (BATCH + 1) * NMODV; (void)MODl;
            if (wg < gdn::G2_WGS) gdn::g2_chain(gdn_bufs(w, l), lds, wg, tid, 0, G2_CUT1, w.gSS);
            else {
            constexpr int UQ = (M_ALL / 256) * (NQ_MLA / 256), UKV = (M_ALL / 256) * (NKV_MLA / 256); const int G2n = G - gdn::G2_WGS, c2 = wg - gdn::G2_WGS;
            { pg8::Gemm g{w.CQN, w.WUQ + l * SZ_WUQ, M_ALL, NQ_MLA, MLA_Q_LORA, MLA_Q_LORA}; SpanOrder S; S.init(NQ_MLA, 0, UQ, G2n, c2); pg8::EpiBf16<0> E{w.QR, NQ_MLA, nullptr, 0, 0, 1.0f};
              pg8::gemm_phase<pg8::EpiBf16<0>, SpanOrder, true, true>((PG8_LAS unsigned char*)lds_raw, g, S, E, tid); }
            { pg8::Gemm g{w.CKVN, w.WUKV + l * SZ_WUKV, M_ALL, NKV_MLA, MLA_KV_LORA, MLA_KV_LORA}; SpanOrder S; S.init(NKV_MLA, UQ, UQ + UKV, G2n, c2); pg8::EpiBf16<0> E{w.KVR, NKV_MLA, nullptr, 0, 0, 1.0f};
              pg8::gemm_phase<pg8::EpiBf16<0>, SpanOrder, true, true>((PG8_LAS unsigned char*)lds_raw, g, S, E, tid); }
            }
        }
        SEAM(pb + 3);
        if (ON(4) && IN(pb + 4)) { PHASE_WS; PHASE_IDS; const float* MODl = w.MOD + (size_t)l * (BATCH + 1) * NMODV; (void)MODl;
            { misc::MlaQkvArgs A; A.QR = w.QR; A.KVR = w.KVR; A.P = w.P; A.qn_g = I->mla_qn_g + (size_t)l * MLA_QK; A.kn_g = I->mla_kn_g + (size_t)l * MLA_QK; A.QM = w.QM; A.KM = w.KM; A.VM = w.VM;
              misc::mlaqkv_phase(A, gwave, nwaves, lane); }
            lru::carry_phase(lru_bufs(w), gtid, gthreads);
        }
        SEAM(pb + 4);
        if (ON(5) && IN(pb + 5)) { PHASE_WS; PHASE_IDS; const float* MODl = w.MOD + (size_t)l * (BATCH + 1) * NMODV; (void)MODl;
            const int pflags = pp->pad;
            if (wg < gdn::G2_WGS && !(pflags & 1)) gdn::g2_chain(gdn_bufs(w, l), lds, wg, tid, G2_CUT2, gdn::G2_NSTEP, w.gSS);
            AttnArgs A; A.QM = w.QM; A.KM = w.KM; A.VM = w.VM; A.NQ = w.NQ; A.NK = w.NK; A.P = w.P; A.Y = w.Y; A.rpb = I->na_rpb + (size_t)l * NH * (2 * NA_KH - 1) * (2 * NA_KW - 1); A.want_ctx = want_ctx ? 1 : 0; A.pad = pflags;
            attention_phase(A, lds, G, wg, tid, gdn::G2_WGS);
        }
        SEAM(pb + 5);
        if (ON(6) && IN(pb + 6)) { PHASE_WS; PHASE_IDS; const float* MODl = w.MOD + (size_t)l * (BATCH + 1) * NMODV; (void)MODl;
            const int pflags = pp->pad;
            if (!(pflags & 128)) { gdn::G3Args A; A.B = gdn_bufs(w, l); A.P = w.P; A.norm_g = I->gdn_norm_g + (size_t)l * HD; A.Y = w.Y; gdn::g3_phase(A, lds, G, wg, tid); }
            if (!(pflags & 256)) lru::finish_phase(lru_bufs(w), w.P, w.Y, gtid, gthreads);
        }
        SEAM(pb + 6);
        if (ON(7) && IN(pb + 7)) { PHASE_WS; PHASE_IDS; const float* MODl = w.MOD + (size_t)l * (BATCH + 1) * NMODV; (void)MODl;
            { pg8::Gemm g{w.Y, w.WOUT + l * SZ_WOUT, M_LAT, D_MODEL, D_MODEL, D_MODEL}; pg8::StaticOrder S; S.init(M_LAT, D_MODEL, G, wg);
              pg8::EpiGateRes E{l == 0 ? I->x : w.H, w.H, D_MODEL, MODl + 2 * D_MODEL, NMODV, SEQ, BATCH, M_LAT};
              pg8::gemm_phase<pg8::EpiGateRes, pg8::StaticOrder, true, true>((PG8_LAS unsigned char*)lds_raw, g, S, E, tid); }
            if (want_ctx) { constexpr int SK = SK_OUT;
              pg8::Gemm g{w.Y + (size_t)M_LAT * D_MODEL, w.WOUT + l * SZ_WOUT, M_CTX, D_MODEL, D_MODEL / SK, D_MODEL}; SplitOrder S; S.init(M_CTX, D_MODEL, SK, G, (wg + G / 2) % G);
              pg8::EpiPart E{w.PART, D_MODEL, (size_t)M_CTX * D_MODEL};
              pg8::gemm_phase<pg8::EpiPart, SplitOrder, true, true>((PG8_LAS unsigned char*)lds_raw, g, S, E, tid); } }
        SEAM(pb + 7);
        if (ON(8) && IN(pb + 8)) { PHASE_WS; PHASE_IDS; const float* MODl = w.MOD + (size_t)l * (BATCH + 1) * NMODV; (void)MODl; misc::norm_phase(w.H, I->norm_ffn_g + (size_t)l * D_MODEL, MODl, 3, w.U, Mo, gwave, nwaves, lane, want_ctx ? w.PART : nullptr, SK_OUT, MODl + (size_t)BATCH * NMODV + 2 * D_MODEL, nullptr, nullptr); }
        SEAM(pb + 8);
        if (ON(9) && IN(pb + 9)) { PHASE_WS; PHASE_IDS; const float* MODl = w.MOD + (size_t)l * (BATCH + 1) * NMODV; (void)MODl; pg8::Gemm g{w.U, w.WUP + l * SZ_WUP, Mo, 2 * D_FF, D_MODEL, D_MODEL}; pg8::StaticOrder S; S.init(Mo, 2 * D_FF, G, wg);
            pg8::EpiConvAct E{w.ACT, w.HALO, I->ffn_conv_w + (size_t)l * 3 * 2 * D_FF, I->ffn_conv_b + (size_t)l * 2 * D_FF, D_FF};
            pg8::gemm_phase<pg8::EpiConvAct, pg8::StaticOrder, false, true>((PG8_LAS unsigned char*)lds_raw, g, S, E, tid);
            if constexpr (l < DEPTH - 1) PREP_IDLE((M_ALL / 256) * (2 * D_FF / 256), I_PB, prep_item_b(I, w, l + 1, it, scr, lane)); }
        SEAM(pb + 9);
        if (ON(10) && IN(pb + 10)) { PHASE_WS; PHASE_IDS; const float* MODl = w.MOD + (size_t)l * (BATCH + 1) * NMODV; (void)MODl; misc::act_fix_phase(w.HALO, I->ffn_conv_w + (size_t)l * 3 * 2 * D_FF, I->ffn_conv_b + (size_t)l * 2 * D_FF, w.ACT, Mo, gtid, gthreads); }
        SEAM(pb + 10);
        if (ON(11) && IN(pb + 11)) { PHASE_WS; PHASE_IDS; const float* MODl = w.MOD + (size_t)l * (BATCH + 1) * NMODV; (void)MODl;
            { pg8::Gemm g{w.ACT, w.WDOWN + l * SZ_WDOWN, M_LAT, D_MODEL, D_FF, D_FF}; pg8::StaticOrder S; S.init(M_LAT, D_MODEL, G, wg);
              pg8::EpiGateRes E{w.H, want_ctx ? w.H : pp->out, D_MODEL, MODl + 5 * D_MODEL, NMODV, SEQ, BATCH, M_LAT};
              pg8::gemm_phase<pg8::EpiGateRes, pg8::StaticOrder, true, true>((PG8_LAS unsigned char*)lds_raw, g, S, E, tid); }
            if (want_ctx) { constexpr int SK = SK_DOWN;
              pg8::Gemm g{w.ACT + (size_t)M_LAT * D_FF, w.WDOWN + l * SZ_WDOWN, M_CTX, D_MODEL, D_FF / SK, D_FF}; SplitOrder S; S.init(M_CTX, D_MODEL, SK, G, (wg + G / 2) % G);
              pg8::EpiPart E{w.PART, D_MODEL, (size_t)M_CTX * D_MODEL};
              pg8::gemm_phase<pg8::EpiPart, SplitOrder, true, true>((PG8_LAS unsigned char*)lds_raw, g, S, E, tid); }
            if constexpr (l < DEPTH - 1) {
              constexpr int NCI = (M_CTX / 256) * (D_MODEL / 256) * SK_DOWN; const int first = NCI < G ? NCI : 0, rank = (wg + G / 2) % G;
              if (rank >= first && rank - first < NMT) { mod_fill(I, lds, tid); for (int t = rank - first; t < NMT; t += G - first) mod_task(I, w, l + 1, t, lds, tid, wave, lane); } } }
        SEAM(pb + 11);

}
__global__ void __launch_bounds__(NTHR, 2) fwd(Params p) {
    extern __shared__ __attribute__((aligned(16))) unsigned char lds_raw[];
    char* lds = (char*)lds_raw;
    const int G = (int)gridDim.x, wg = (int)blockIdx.x, nwaves = G * NWAVES, gthreads = G * NTHR;
    const int C_wave0 = __builtin_amdgcn_readfirstlane((int)threadIdx.x >> 6);
    volatile LAS unsigned* MISC = (volatile LAS unsigned*)(lds_raw + LDS_MISC);
    if (threadIdx.x < 32) MISC[threadIdx.x] = 0u;
    __syncthreads();
    const int lo = p.ph_lo, hi = p.ph_hi;
    unsigned* const barw = (unsigned*)p.ws + CW_BAR + (size_t)p.li * XCD_BAR_WORDS;
    XcdBarrier bar; bar.bar = barw; bar.x = 0; bar.st = MISC + 8;
    if (hi - lo > 1) bar = xcd_barrier_post(barw, MISC + 8, threadIdx.x == 0);

    if (ON(12) && IN(PH_PRO)) { PHASE_WS; PHASE_IDS;
        const bool split = G > NMT;
        if (wg < NMT) { mod_fill(I, lds, tid); for (int t = wg; t < NMT; t += G) mod_task(I, w, 0, t, lds, tid, wave, lane); __syncthreads(); }
        {
            float* scr = (float*)(lds + wave * PREP_SCR);
            constexpr int T = I_PA + I_PB;
            const int nmw = NMT * NWAVES;
            int it0, itn, its;
            if (!split) { it0 = gwave; itn = T; its = nwaves; } else if (wg < NMT) { it0 = gwave; itn = 2 * nmw; its = nmw; } else { it0 = 2 * nmw + (gwave - nmw); itn = T; its = nwaves - nmw; }
            for (int it = it0; it < itn; it += its) { if (it < I_PA) prep_item_a(I, w, 0, it, scr, lane); else prep_item_b(I, w, 0, it - I_PA, scr, lane); }
        }
    }
    SEAM(PH_PRO);

    { LayerCtx C; C.lo = lo; C.hi = hi; C.G = G; C.wg = wg; C.nwaves = nwaves; C.gthreads = gthreads; C.wave0 = C_wave0; C.bar = bar; C.lds = lds; C.lds_raw = lds_raw;
      static_assert(DEPTH == 4, "layer calls are written out (a real layer loop lets LICM park loop-invariant values in registers across every phase: spills)");
      layer_body<0>(C); layer_body<1>(C); layer_body<2>(C); layer_body<3>(C); }
#undef IN
#undef SEAM
}

#ifndef MK_PHASES_PER_LAUNCH
#define MK_PHASES_PER_LAUNCH NPH
#endif
extern "C" void kernel_launch(void* const* d_in, const int* in_sizes, int n_in, void* d_out, int out_size, void* d_ws, size_t ws_size, hipStream_t stream) {
    static int grid = 0;
    if (grid == 0) {
        int dev = 0, cus = 0;
        if (hipGetDevice(&dev) != hipSuccess || hipDeviceGetAttribute(&cus, hipDeviceAttributeMultiprocessorCount, dev) != hipSuccess || cus <= 0) { fprintf(stderr, "kernel_launch: no device\n"); grid = -1; return; }
        if (hipFuncSetAttribute((const void*)fwd, hipFuncAttributeMaxDynamicSharedMemorySize, LDS_BYTES) != hipSuccess) { fprintf(stderr, "kernel_launch: hipFuncSetAttribute failed\n"); grid = -1; return; }
        int per_cu = 0; if (hipOccupancyMaxActiveBlocksPerMultiprocessor(&per_cu, (const void*)fwd, NTHR, LDS_BYTES) != hipSuccess || per_cu < 1) fprintf(stderr, "kernel_launch: occupancy query says %d blocks per CU\n", per_cu);
        (void)hipGetLastError();
        grid = cus;
        const WS w0 = ws_carve(nullptr);
        if (n_in != 34 || w0.total > ws_size) { fprintf(stderr, "kernel_launch: bad inputs / workspace (need %zu, have %zu)\n", w0.total, ws_size); grid = -1; return; }
    }
    if (grid < 0) return;
    (void)hipMemsetAsync(d_ws, 0, 1 << 20, stream);
    Params p; memset(&p, 0, sizeof(p));
    for (int i = 0; i < 34; ++i) p.in[i] = (const float*)d_in[i];
    p.out = (float*)d_out; p.ws = (unsigned char*)d_ws;
    int li = 0;
    for (int lo = 0; lo < NPH; lo += MK_PHASES_PER_LAUNCH, ++li) {
        p.ph_lo = lo; p.ph_hi = lo + MK_PHASES_PER_LAUNCH < NPH ? lo + MK_PHASES_PER_LAUNCH : NPH; p.li = li;
#if defined(PROBE_MASK)
        if (MK_PHASES_PER_LAUNCH == 1 && ((((PROBE_MASK) >> 12) & 1 && lo == 0) || (lo > 0 && (((PROBE_MASK) >> ((lo - 1) % PH_PER_LAYER)) & 1))))
            { Params q = p;
#if defined(PROBE_FLAGS)
              q.pad = PROBE_FLAGS;
#endif
              for (int r = 0; r < PROBE_REPS; ++r) hipLaunchKernelGGL(fwd, dim3(grid), dim3(NTHR), LDS_BYTES, stream, q); }
#endif
        hipLaunchKernelGGL(fwd, dim3(grid), dim3(NTHR), LDS_BYTES, stream, p);
    }
}
```

```cpp
#include <hip/hip_runtime.h>
#include <cstdio>
#include <cstdint>
#include <cstring>
#include <math.h>
#include <stdint.h>

#ifdef CFG_SMALL
constexpr int D_MODEL = 256, BATCH = 2, SEQ = 512, DEPTH = 2, CTX_LEN = 64, GRID_W = 32, HEAD_DIM = 16;
#else
constexpr int D_MODEL = 2048, BATCH = 2, SEQ = 8192, DEPTH = 4, CTX_LEN = 256, GRID_W = 64, HEAD_DIM = 128;
#endif
constexpr int GROUP_W = D_MODEL / 4, NH = GROUP_W / HEAD_DIM;
constexpr int HD = HEAD_DIM;
constexpr int N_MOD = 6;
constexpr float EPS = 1e-6f;
constexpr int LRU_W = GROUP_W, LRU_BW = LRU_W / NH;
constexpr float LRU_C = 8.0f;
constexpr int MLA_Q_LORA = 3 * D_MODEL / 16, MLA_KV_LORA = D_MODEL / 8, MLA_NOPE = HD, MLA_ROPE = HD / 2, MLA_V = HD, MLA_QK = MLA_NOPE + MLA_ROPE;
constexpr int GDN_CHUNK = 64;
constexpr int NA_KH = 8, NA_KW = 16;
constexpr int D_FF = 5 * D_MODEL / 2;
constexpr int ROWS = SEQ / GRID_W;
constexpr int C_LRU_X = 0, C_LRU_G = C_LRU_X + LRU_W, C_CQ = C_LRU_G + LRU_W, C_CKV = C_CQ + MLA_Q_LORA, C_KR = C_CKV + MLA_KV_LORA,
              C_GQ = C_KR + MLA_ROPE, C_GK = C_GQ + GROUP_W, C_GV = C_GK + GROUP_W, C_GG = C_GV + GROUP_W, C_GB = C_GG + GROUP_W,
              C_GA = C_GB + 2 * NH, C_NQ = C_GA + 2 * NH, C_NK = C_NQ + GROUP_W, C_NV = C_NK + GROUP_W, IN_COLS = C_NV + GROUP_W;
constexpr int NP = (IN_COLS + 255) / 256 * 256;
constexpr int M_LAT = BATCH * SEQ, M_CTX = BATCH * CTX_LEN, M_ALL = M_LAT + M_CTX;
constexpr int NMODV = N_MOD * D_MODEL;

typedef unsigned short bf16_t;
__host__ __device__ __forceinline__ bf16_t f2bf(float f) { union { float f; unsigned u; } v; v.f = f; unsigned u = v.u; u += 0x7fffu + ((u >> 16) & 1u); return (bf16_t)(u >> 16); }
__host__ __device__ __forceinline__ float bf2f(bf16_t b) { union { float f; unsigned u; } v; v.u = ((unsigned)b) << 16; return v.f; }
__host__ __device__ __forceinline__ float sigmoidf_(float x) { return 1.0f / (1.0f + expf(-x)); }
__host__ __device__ __forceinline__ float siluf_(float x) { return x / (1.0f + expf(-x)); }
__host__ __device__ __forceinline__ float softplusf_(float x) { return fmaxf(x, 0.0f) + log1pf(expf(-fabsf(x))); }
__host__ __device__ __forceinline__ float geluf_(float x) { return 0.5f * x * (1.0f + tanhf(0.7978845608028654f * (x + 0.044715f * x * x * x))); }

struct RowInfo { int b, t, T, base, set; };
__host__ __device__ __forceinline__ RowInfo row_info(int r) {
    RowInfo i;
    if (r < M_LAT) { i.b = r / SEQ; i.t = r % SEQ; i.T = SEQ; i.base = i.b * SEQ; i.set = i.b; }
    else { const int rr = r - M_LAT; i.b = rr / CTX_LEN; i.t = rr % CTX_LEN; i.T = CTX_LEN; i.base = M_LAT + i.b * CTX_LEN; i.set = BATCH; }
    return i;
}


__host__ __device__ __forceinline__ float bflo(unsigned w) { union { float f; unsigned u; } v; v.u = w << 16; return v.f; }
__host__ __device__ __forceinline__ float bfhi(unsigned w) { union { float f; unsigned u; } v; v.u = w & 0xffff0000u; return v.f; }
#define LDS_BARRIER() asm volatile("s_waitcnt lgkmcnt(0)\n\ts_barrier" ::: "memory")
__device__ __forceinline__ float lane_xor(float v, int mask, int lane) { return __int_as_float(__builtin_amdgcn_ds_bpermute((lane ^ mask) << 2, __float_as_int(v))); }
__device__ __forceinline__ float lane_get(float v, int src_lane) { return __int_as_float(__builtin_amdgcn_ds_bpermute(src_lane << 2, __float_as_int(v))); }
struct Inputs {
    const float *x, *c, *ctx, *c_ctx, *ada_w, *ada_b, *norm_mix_g, *norm_ffn_g, *w_in, *w_out,
        *lru_conv_w, *lru_conv_b, *lru_wa, *lru_ba, *lru_wx, *lru_bx, *lru_lam,
        *mla_qa_g, *mla_w_uq, *mla_kva_g, *mla_w_ukv, *mla_qn_g, *mla_kn_g,
        *gdn_conv_w, *gdn_a_log, *gdn_dt_bias, *gdn_norm_g, *na_qn_g, *na_kn_g, *na_rpb,
        *ffn_w_up, *ffn_conv_w, *ffn_conv_b, *ffn_w_down;
};
constexpr int NQ_MLA = NH * MLA_QK, NKV_MLA = NH * (MLA_NOPE + MLA_V);
constexpr size_t SZ_WIN = (size_t)NP * D_MODEL, SZ_WOUT = (size_t)D_MODEL * D_MODEL, SZ_WUP = (size_t)2 * D_FF * D_MODEL, SZ_WDOWN = (size_t)D_MODEL * D_FF,
                 SZ_WUQ = (size_t)NQ_MLA * MLA_Q_LORA, SZ_WUKV = (size_t)NKV_MLA * MLA_KV_LORA, SZ_WLRU = (size_t)16 * LRU_BW * LRU_BW;
struct WS {
    unsigned* ctl; float *MOD, *H, *PART; bf16_t *U, *Y;
    bf16_t *WIN, *WOUT, *WUP, *WDOWN, *WUQ, *WUKV, *WLRU;
    bf16_t* P; bf16_t *CQN, *CKVN, *QR, *KVR, *QM, *KM, *VM, *NQ, *NK;
    bf16_t *gUT, *gWP, *gKDT, *gQD, *gQK, *gSIT, *gVNT; float *gGT, *gSS;
    bf16_t *lHLOC, *lACUM; float *lLSUM, *lHIN;
    bf16_t *HALO, *ACT;
    size_t total;
};
__host__ __device__ inline WS ws_carve(void* base) {
    WS w; size_t off = 0; char* b = (char*)base;
#define WS_TAKE(T, field, bytes) do { w.field = (T*)(b + off); off += (((size_t)(bytes)) + 255) & ~(size_t)255; } while (0)
    WS_TAKE(unsigned, ctl, 1 << 20);
    WS_TAKE(float, MOD, sizeof(float) * (size_t)DEPTH * (BATCH + 1) * NMODV);
    WS_TAKE(float, H, sizeof(float) * (size_t)M_ALL * D_MODEL);
    WS_TAKE(float, PART, sizeof(float) * (size_t)5 * M_CTX * D_MODEL);
    WS_TAKE(bf16_t, U, 2 * (size_t)M_ALL * D_MODEL);
    WS_TAKE(bf16_t, Y, 2 * (size_t)M_ALL * D_MODEL);
    WS_TAKE(bf16_t, WIN, 2 * SZ_WIN * DEPTH); WS_TAKE(bf16_t, WOUT, 2 * SZ_WOUT * DEPTH); WS_TAKE(bf16_t, WUP, 2 * SZ_WUP * DEPTH); WS_TAKE(bf16_t, WDOWN, 2 * SZ_WDOWN * DEPTH);
    WS_TAKE(bf16_t, WUQ, 2 * SZ_WUQ * DEPTH); WS_TAKE(bf16_t, WUKV, 2 * SZ_WUKV * DEPTH); WS_TAKE(bf16_t, WLRU, 2 * SZ_WLRU * DEPTH);
    const size_t r0 = off;
    WS_TAKE(bf16_t, P, 2 * (size_t)M_ALL * NP);
    WS_TAKE(bf16_t, CQN, 2 * (size_t)M_ALL * MLA_Q_LORA); WS_TAKE(bf16_t, CKVN, 2 * (size_t)M_ALL * MLA_KV_LORA);
    WS_TAKE(bf16_t, QR, 2 * (size_t)M_ALL * NQ_MLA); WS_TAKE(bf16_t, KVR, 2 * (size_t)M_ALL * NKV_MLA);
    WS_TAKE(bf16_t, QM, 2 * (size_t)M_ALL * NQ_MLA); WS_TAKE(bf16_t, KM, 2 * (size_t)M_ALL * NQ_MLA); WS_TAKE(bf16_t, VM, 2 * (size_t)M_ALL * NH * MLA_V);
    WS_TAKE(bf16_t, NQ, 2 * (size_t)M_ALL * GROUP_W); WS_TAKE(bf16_t, NK, 2 * (size_t)M_ALL * GROUP_W);
    { constexpr size_t NT_ = (size_t)(M_ALL / 64) * NH * 2;
      WS_TAKE(bf16_t, gUT, 2 * NT_ * 128 * 64); WS_TAKE(bf16_t, gWP, 2 * NT_ * 64 * 128); WS_TAKE(bf16_t, gKDT, 2 * NT_ * 128 * 64); WS_TAKE(bf16_t, gQD, 2 * NT_ * 64 * 128);
      WS_TAKE(bf16_t, gQK, 2 * NT_ * 64 * 64); WS_TAKE(bf16_t, gSIT, 2 * NT_ * 128 * 128); WS_TAKE(bf16_t, gVNT, 2 * NT_ * 128 * 64); WS_TAKE(float, gGT, 4 * NT_ * DEPTH); WS_TAKE(float, gSS, 4 * (size_t)BATCH * NH * 2 * HD * HD); }
    WS_TAKE(bf16_t, lHLOC, 2 * (size_t)2 * M_ALL * LRU_W); WS_TAKE(bf16_t, lACUM, 2 * (size_t)2 * M_ALL * LRU_W);
    WS_TAKE(float, lLSUM, 4 * (size_t)(M_ALL / 64) * 2 * 2 * LRU_W); WS_TAKE(float, lHIN, 4 * (size_t)(M_ALL / 64) * 2 * LRU_W);
    const size_t r1 = off;
    off = r0;
    WS_TAKE(bf16_t, HALO, 2 * (size_t)(M_ALL / 64) * 4 * 2 * D_FF); WS_TAKE(bf16_t, ACT, 2 * (size_t)M_ALL * D_FF);
    const size_t f1 = off;
#undef WS_TAKE
    w.total = r1 > f1 ? r1 : f1;
    return w;
}

namespace pg8 {
#define PG8_LAS __attribute__((address_space(3)))
typedef unsigned short bf16_t;
typedef short bf16x8 __attribute__((ext_vector_type(8)));
typedef float f32x4 __attribute__((ext_vector_type(4)));
typedef unsigned u32x4 __attribute__((ext_vector_type(4)));
constexpr int BM = 256, BK = 64, HALF = 128, HTB = HALF * BK * 2  , STAGE_BYTES = 8 * HTB, NXCD = 8, WGM = 8;

__host__ __device__ __forceinline__ int lds_byte(int r, int c) { const int st = (r >> 4) * 2 + (c >> 5), rr = r & 15, cc = c & 31, ob = rr * 64 + cc * 2; return st * 1024 + (ob ^ (((ob >> 9) & 1) << 5)); }
__host__ __device__ __forceinline__ void stage_rc(int b, int& R, int& C) { const int st = b / 1024, sb = b % 1024, swz = sb ^ (((sb >> 9) & 1) << 5); R = (st >> 1) * 16 + swz / 64; C = (st & 1) * 32 + (swz % 64) / 2; }
__host__ __device__ __forceinline__ int perm32(int rho) { const int n = rho >> 4, i = rho & 15; return 8 * (i >> 2) + 4 * n + (i & 3); }

struct Unit { int pm, pn, ks; };
struct Gemm { const bf16_t* A; const bf16_t* Bt; int M, N, K, ld; };

struct StaticOrder {
    int nM, nN, nwg, G, c;
    __host__ __device__ void init(int M, int N, int G_, int c_) { nM = M / BM; nN = N / BM; nwg = nM * nN; G = G_; c = c_; }
    __host__ __device__ bool next(int i, Unit& u) const {
        const long L = (long)i * G + c; if (L >= nwg) return false;
        int wgid = (int)L; { const int q = nwg / NXCD, r = nwg % NXCD, xcd = wgid % NXCD, off = wgid / NXCD; wgid = (xcd < r ? xcd * (q + 1) : r * (q + 1) + (xcd - r) * q) + off; }
        const int nig = WGM * nN, gid = wgid / nig, fm = gid * WGM, gsz = (nM - fm) < WGM ? (nM - fm) : WGM;
        u.pm = fm + ((wgid % nig) % gsz); u.pn = (wgid % nig) / gsz; u.ks = 0; return true;
    }
    __device__ __forceinline__ void a_ready(const Unit&) const {}
    __device__ __forceinline__ void done(const Unit&) const {}
};
__device__ __forceinline__ unsigned cvt_pk_bf16(float lo, float hi) { unsigned r; asm volatile("v_cvt_pk_bf16_f32 %0, %1, %2" : "=v"(r) : "v"(lo), "v"(hi)); return r; }
typedef float f32x2 __attribute__((ext_vector_type(2)));
__device__ __forceinline__ f32x2 gelu_pk(f32x2 v) {
    const f32x2 av = __builtin_elementwise_abs(v), d = av * 0.2316418882f + 1.0f;
    f32x2 t; t.x = __builtin_amdgcn_rcpf(d.x); t.y = __builtin_amdgcn_rcpf(d.y);
    f32x2 q = t * 0.5307027145f + (-0.7265760135f); q = q * t + 0.7107068705f; q = q * t + (-0.142248368f); q = q * t + 0.127414796f; q = q * t;
    const f32x2 s = (v * v) * (-0.72134752044f);
    f32x2 e; e.x = __builtin_amdgcn_exp2f(s.x); e.y = __builtin_amdgcn_exp2f(s.y);
    const f32x2 m = v * (q * e), r = v - m;
    f32x2 o; o.x = v.x < 0.f ? m.x : r.x; o.y = v.y < 0.f ? m.y : r.y; return o;
}

template <int ACT  > struct EpiBf16 {
    static constexpr bool PERM = true, AFTER_DRAIN = false; static_assert(ACT == 0 || ACT == 1, "EpiBf16: ACT is 0 (none) or 1 (gelu_pk)");
    bf16_t* O; int ldc; const float* bias; int split_cols; size_t split_stride; float scale0;
    __device__ __forceinline__ void operator()(const f32x4 (&acc)[2][2][4][2], const Unit& u, int wr, int wc, int fr, int fq) const {
        const int row0 = u.pm * BM + wr * 64 + fr; int colt = u.pn * BM; bf16_t* base = O;
        float sc = 1.f; if (split_cols) { const int t = colt / split_cols; base += (size_t)t * split_stride; colt -= t * split_cols; if (t == 0) sc = scale0; }
        const int col0 = colt + wc * 32 + 8 * fq, bcol0 = u.pn * BM + wc * 32 + 8 * fq;
        f32x4 bv[2][2];
#pragma unroll
        for (int bj = 0; bj < 2; ++bj)
#pragma unroll
            for (int n = 0; n < 2; ++n) bv[bj][n] = bias ? *(const f32x4*)(bias + bcol0 + bj * HALF + 4 * n) : (f32x4){0.f, 0.f, 0.f, 0.f};
#pragma unroll
        for (int ai = 0; ai < 2; ++ai)
#pragma unroll
            for (int m = 0; m < 4; ++m) { bf16_t* rowp = base + (size_t)(row0 + ai * HALF + m * 16) * ldc + col0;
#pragma unroll
                for (int bj = 0; bj < 2; ++bj) { f32x4 v0 = acc[ai][bj][m][0] + bv[bj][0], v1 = acc[ai][bj][m][1] + bv[bj][1];
                    if (ACT == 1) { f32x2 a = gelu_pk((f32x2){v0[0], v0[1]}), b = gelu_pk((f32x2){v0[2], v0[3]}), c = gelu_pk((f32x2){v1[0], v1[1]}), d = gelu_pk((f32x2){v1[2], v1[3]});
                        v0 = (f32x4){a.x, a.y, b.x, b.y}; v1 = (f32x4){c.x, c.y, d.x, d.y}; }
                    v0 = v0 * sc; v1 = v1 * sc; u32x4 w; w.x = cvt_pk_bf16(v0[0], v0[1]); w.y = cvt_pk_bf16(v0[2], v0[3]); w.z = cvt_pk_bf16(v1[0], v1[1]); w.w = cvt_pk_bf16(v1[2], v1[3]);
                    *(u32x4*)(rowp + bj * HALF) = w; } }
    }
};

struct EpiF32 {
    static constexpr bool PERM = false, AFTER_DRAIN = false;
    float* C; int ldc;
    __device__ __forceinline__ void operator()(const f32x4 (&acc)[2][2][4][2], const Unit& u, int wr, int wc, int fr, int fq) const {
        const int row0 = u.pm * BM + wr * 64 + fr, col0 = u.pn * BM + wc * 32 + 4 * fq;
#pragma unroll
        for (int ai = 0; ai < 2; ++ai)
#pragma unroll
            for (int m = 0; m < 4; ++m) { float* rowp = C + (size_t)(row0 + ai * HALF + m * 16) * ldc + col0;
#pragma unroll
                for (int bj = 0; bj < 2; ++bj)
#pragma unroll
                    for (int n = 0; n < 2; ++n) *(f32x4*)(rowp + bj * HALF + n * 16) = acc[ai][bj][m][n]; }
    }
};
struct EpiGateRes {
    static constexpr bool PERM = false, AFTER_DRAIN = false;
    const float* base; float* out; int ldc; const float* gate; int set_stride; int rows_per_set; int nsets_lat; int lat_rows;
    __device__ __forceinline__ void operator()(const f32x4 (&acc)[2][2][4][2], const Unit& u, int wr, int wc, int fr, int fq) const {
        const int row0 = u.pm * BM + wr * 64 + fr, col0 = u.pn * BM + wc * 32 + 4 * fq;
        const int set = (u.pm * BM >= lat_rows) ? nsets_lat : (u.pm * BM) / rows_per_set;
        const float* gp = gate + (size_t)set * set_stride + col0;
        f32x4 gv[2][2];
#pragma unroll
        for (int bj = 0; bj < 2; ++bj)
#pragma unroll
            for (int n = 0; n < 2; ++n) gv[bj][n] = *(const f32x4*)(gp + bj * HALF + n * 16);
#pragma unroll
        for (int ai = 0; ai < 2; ++ai)
#pragma unroll
            for (int m = 0; m < 4; ++m) { const size_t off = (size_t)(row0 + ai * HALF + m * 16) * ldc + col0;
#pragma unroll
                for (int bj = 0; bj < 2; ++bj)
#pragma unroll
                    for (int n = 0; n < 2; ++n) { const f32x4 b = *(const f32x4*)(base + off + bj * HALF + n * 16); *(f32x4*)(out + off + bj * HALF + n * 16) = b + gv[bj][n] * acc[ai][bj][m][n]; } }
    }
};

struct EpiConvAct {
    static constexpr bool PERM = false, AFTER_DRAIN = false;
    bf16_t* ACT; bf16_t* HALO; const float* cw; const float* cb; int dff;
    __device__ __forceinline__ static float ror1(float v) { return __int_as_float(__builtin_amdgcn_update_dpp(0, __float_as_int(v), 0x121, 0xf, 0xf, false)); }
    __device__ __forceinline__ static float rol1(float v) { return __int_as_float(__builtin_amdgcn_update_dpp(0, __float_as_int(v), 0x12f, 0xf, 0xf, false)); }
    __device__ __forceinline__ void operator()(const f32x4 (&acc)[2][2][4][2], const Unit& u, int wr, int wc, int fr, int fq) const {
        const int rowb = u.pm * BM + wr * 64, chb = u.pn * HALF + wc * 32 + 4 * fq;
        const bool f0 = fr == 0, f15 = fr == 15;
        typedef float f32x2 __attribute__((ext_vector_type(2)));
#pragma unroll
        for (int n = 0; n < 2; ++n)
#pragma unroll
            for (int ep = 0; ep < 2; ++ep) { const int ch = chb + 16 * n + 2 * ep;
                f32x2 wa[3], wg[3], ba, bg;
#pragma unroll
                for (int k = 0; k < 3; ++k) { wa[k] = *(const f32x2*)(cw + (size_t)k * 2 * dff + ch); wg[k] = *(const f32x2*)(cw + (size_t)k * 2 * dff + dff + ch); }
                ba = *(const f32x2*)(cb + ch); bg = *(const f32x2*)(cb + dff + ch);
#pragma unroll
                for (int ai = 0; ai < 2; ++ai) { const int blk = (rowb + ai * HALF) >> 6;
                    float y[4][2];
#pragma unroll
                    for (int eo = 0; eo < 2; ++eo) { const int e = 2 * ep + eo;
                        float Ra[4], La[4], Rg[4], Lg[4];
#pragma unroll
                        for (int m = 0; m < 4; ++m) { Ra[m] = ror1(acc[ai][0][m][n][e]); La[m] = rol1(acc[ai][0][m][n][e]); Rg[m] = ror1(acc[ai][1][m][n][e]); Lg[m] = rol1(acc[ai][1][m][n][e]); }
#pragma unroll
                        for (int m = 0; m < 4; ++m) {
                            const float ap = f0 ? Ra[m > 0 ? m - 1 : 0] : Ra[m], an = f15 ? La[m < 3 ? m + 1 : 3] : La[m];
                            const float gp = f0 ? Rg[m > 0 ? m - 1 : 0] : Rg[m], gn = f15 ? Lg[m < 3 ? m + 1 : 3] : Lg[m];
                            const float a = ba[eo] + wa[0][eo] * ap + wa[1][eo] * acc[ai][0][m][n][e] + wa[2][eo] * an;
                            const float g = bg[eo] + wg[0][eo] * gp + wg[1][eo] * acc[ai][1][m][n][e] + wg[2][eo] * gn;
                            y[m][eo] = a * (g * __builtin_amdgcn_rcpf(1.0f + __expf(-g))); }
                    }
#pragma unroll
                    for (int m = 0; m < 4; ++m) { const int row = rowb + ai * HALF + 16 * m + fr;
                        *(unsigned*)(ACT + (size_t)row * dff + ch) = cvt_pk_bf16(y[m][0], y[m][1]);
                        if ((m == 0 && fr < 2) || (m == 3 && fr >= 14)) { const int slot = m == 0 ? fr : fr - 12; bf16_t* hp = HALO + ((size_t)blk * 4 + slot) * (2 * dff) + ch;
                            *(unsigned*)hp = cvt_pk_bf16(acc[ai][0][m][n][2 * ep], acc[ai][0][m][n][2 * ep + 1]);
                            *(unsigned*)(hp + dff) = cvt_pk_bf16(acc[ai][1][m][n][2 * ep], acc[ai][1][m][n][2 * ep + 1]); }
                    }
                }
            }
    }
};

struct EpiPart {
    static constexpr bool PERM = false, AFTER_DRAIN = false;
    float* C; int ldc; size_t ks_stride;
    __device__ __forceinline__ void operator()(const f32x4 (&acc)[2][2][4][2], const Unit& u, int wr, int wc, int fr, int fq) const {
        const int row0 = u.pm * BM + wr * 64 + fr, col0 = u.pn * BM + wc * 32 + 4 * fq; float* Cb = C + (size_t)u.ks * ks_stride;
#pragma unroll
        for (int ai = 0; ai < 2; ++ai)
#pragma unroll
            for (int m = 0; m < 4; ++m) { float* rowp = Cb + (size_t)(row0 + ai * HALF + m * 16) * ldc + col0;
#pragma unroll
                for (int bj = 0; bj < 2; ++bj)
#pragma unroll
                    for (int n = 0; n < 2; ++n) *(f32x4*)(rowp + bj * HALF + n * 16) = acc[ai][bj][m][n]; }
    }
};

template <class Epi, class Sched, bool ALIGN_EPI = false, bool SP2 = false>
__device__ __forceinline__ void gemm_phase(PG8_LAS unsigned char* lds, const Gemm g, const Sched& S, const Epi& E, const int tid_in) {
    int tid_ = tid_in; asm volatile("" : "+v"(tid_));
    const int tid = tid_, wid = __builtin_amdgcn_readfirstlane(tid >> 6), lane = tid & 63, wr = wid >> 2, wc = wid & 3, fr = lane & 15, fq = lane >> 4;
    const int K = g.K, nt = K / BK;
    unsigned voffA[2], voffB[2];
#pragma unroll
    for (int i = 0; i < 2; ++i) { int R, C; stage_rc(tid * 16 + i * 8192, R, C); const int Rb = Epi::PERM ? ((R & ~31) + perm32(R & 31)) : R;
        voffA[i] = (unsigned)(R * g.ld + C) * 2u; voffB[i] = (unsigned)(Rb * g.ld + C) * 2u; }
    const size_t kstep = (size_t)(BK * 2);
    const size_t hstep = (size_t)HALF * g.ld * 2;
    const size_t tstep = 2 * hstep;
    const unsigned ldsw = (unsigned)wid * 1024u;
    const int aoff = lds_byte(wr * 64 + fr, fq * 8), boff = lds_byte(wc * 32 + fr, fq * 8);
#define PG8_SA(b, h) (((b) * 2 + (h)) * HTB)
#define PG8_SB(b, h) ((4 + (b) * 2 + (h)) * HTB)
#define PG8_STAGE(bufoff, gbase, voff) do { _Pragma("unroll") for (int _i = 0; _i < 2; ++_i) \
        __builtin_amdgcn_global_load_lds((const unsigned*)((const char*)(gbase) + (voff)[_i]), (PG8_LAS unsigned*)(lds + (bufoff) + ldsw + _i * 8192), 16, 0, 0); } while (0)
#define PG8_LDA(dst, b, h) do { _Pragma("unroll") for (int m = 0; m < 4; ++m) _Pragma("unroll") for (int k = 0; k < 2; ++k) dst[m][k] = *(const PG8_LAS bf16x8*)(lds + PG8_SA(b, h) + aoff + m * 2048 + k * 1024); } while (0)
#define PG8_LDB(dst, b, h) do { _Pragma("unroll") for (int n = 0; n < 2; ++n) _Pragma("unroll") for (int k = 0; k < 2; ++k) dst[n][k] = *(const PG8_LAS bf16x8*)(lds + PG8_SB(b, h) + boff + n * 2048 + k * 1024); } while (0)
#define PG8_MMA(ai, bj, At, Bt) do { __builtin_amdgcn_s_setprio(1); _Pragma("unroll") for (int m = 0; m < 4; ++m) _Pragma("unroll") for (int n = 0; n < 2; ++n) _Pragma("unroll") for (int k = 0; k < 2; ++k) \
        acc[ai][bj][m][n] = __builtin_amdgcn_mfma_f32_16x16x32_bf16(Bt[n][k], At[m][k], acc[ai][bj][m][n], 0, 0, 0); __builtin_amdgcn_s_setprio(0); } while (0)
#define PG8_WAIT_V(n) asm volatile("s_waitcnt vmcnt(" #n ")" ::: "memory")
#define PG8_WAIT_L(n) asm volatile("s_waitcnt lgkmcnt(" #n ")" ::: "memory")
#define PG8_BAR __builtin_amdgcn_s_barrier()
#define PG8_SCHED __builtin_amdgcn_sched_barrier(0)
    Unit cur, nxt; int ui = 0;
    if (!S.next(0, cur)) return;
    f32x4 acc[2][2][4][2];
#pragma unroll
    for (int a = 0; a < 2; ++a)
#pragma unroll
        for (int b = 0; b < 2; ++b)
#pragma unroll
            for (int m = 0; m < 4; ++m)
#pragma unroll
                for (int n = 0; n < 2; ++n) acc[a][b][m][n] = (f32x4){0.f, 0.f, 0.f, 0.f};
    bf16x8 At[4][2], B0[2][2], B1[2][2];
    const size_t ksb = (size_t)K * 2;
    const char* cA = (const char*)g.A + (size_t)cur.pm * tstep + (size_t)cur.ks * ksb; const char* cB = (const char*)g.Bt + (size_t)cur.pn * tstep + (size_t)cur.ks * ksb;
    S.a_ready(cur);
    if constexpr (SP2) {
        PG8_STAGE(PG8_SB(0, 0), cB, voffB); PG8_STAGE(PG8_SB(0, 1), cB + hstep, voffB); PG8_STAGE(PG8_SA(0, 0), cA, voffA); PG8_STAGE(PG8_SA(0, 1), cA + hstep, voffA);
        if (wr == 1) PG8_BAR;
        PG8_WAIT_V(2); PG8_BAR;
        PG8_STAGE(PG8_SB(1, 0), cB + kstep, voffB); PG8_STAGE(PG8_SA(1, 0), cA + kstep, voffA); PG8_STAGE(PG8_SB(1, 1), cB + hstep + kstep, voffB);
        PG8_WAIT_V(6); PG8_BAR;
    } else {
        PG8_STAGE(PG8_SB(0, 0), cB, voffB); PG8_STAGE(PG8_SA(0, 0), cA, voffA); PG8_STAGE(PG8_SB(0, 1), cB + hstep, voffB); PG8_STAGE(PG8_SA(0, 1), cA + hstep, voffA);
        if (wr == 1) PG8_BAR;
        PG8_WAIT_V(4); PG8_BAR;
        PG8_STAGE(PG8_SB(1, 0), cB + kstep, voffB); PG8_STAGE(PG8_SA(1, 0), cA + kstep, voffA); PG8_STAGE(PG8_SB(1, 1), cB + hstep + kstep, voffB);
        PG8_WAIT_V(6); PG8_BAR;
    }
    for (;;) {
        const bool has_next = S.next(ui + 1, nxt);
        const char* nA = has_next ? (const char*)g.A + (size_t)nxt.pm * tstep + (size_t)nxt.ks * ksb : cA; const char* nB = has_next ? (const char*)g.Bt + (size_t)nxt.pn * tstep + (size_t)nxt.ks * ksb : cB;
        for (int t = 0; t < nt; t += 2) {
            const bool last = (t == nt - 2);
            const char* a1 = cA + (size_t)(t + 1) * kstep;
            const char* a2 = last ? nA : cA + (size_t)(t + 2) * kstep; const char* b2 = last ? nB : cB + (size_t)(t + 2) * kstep;
            const char* a3 = a2 + kstep; const char* b3 = b2 + kstep;
            if (last && has_next) S.a_ready(nxt);
            if constexpr (SP2) {
            PG8_LDB(B0, 0, 0); PG8_LDB(B1, 0, 1); PG8_SCHED; PG8_LDA(At, 0, 0); PG8_STAGE(PG8_SA(1, 1), a1 + hstep, voffA);
            PG8_WAIT_V(8); PG8_WAIT_L(0); PG8_BAR; PG8_MMA(0, 0, At, B0); PG8_MMA(0, 1, At, B1); PG8_BAR; PG8_SCHED;
            PG8_LDA(At, 0, 1); PG8_STAGE(PG8_SB(0, 0), b2, voffB); PG8_STAGE(PG8_SB(0, 1), b2 + hstep, voffB); PG8_STAGE(PG8_SA(0, 0), a2, voffA);
            PG8_WAIT_V(8); PG8_WAIT_L(0); PG8_BAR; PG8_MMA(1, 0, At, B0); PG8_MMA(1, 1, At, B1); PG8_BAR; PG8_SCHED;
            PG8_LDB(B0, 1, 0); PG8_LDB(B1, 1, 1); PG8_SCHED; PG8_LDA(At, 1, 0); PG8_STAGE(PG8_SA(0, 1), a2 + hstep, voffA);
            PG8_WAIT_V(8); PG8_WAIT_L(0); PG8_BAR; PG8_MMA(0, 0, At, B0); PG8_MMA(0, 1, At, B1); PG8_BAR; PG8_SCHED;
            PG8_LDA(At, 1, 1); PG8_STAGE(PG8_SB(1, 0), b3, voffB); PG8_STAGE(PG8_SB(1, 1), b3 + hstep, voffB); PG8_STAGE(PG8_SA(1, 0), a3, voffA);
            PG8_WAIT_V(8); PG8_WAIT_L(0); PG8_BAR; PG8_MMA(1, 0, At, B0); PG8_MMA(1, 1, At, B1); PG8_BAR; PG8_SCHED;
            } else {
            PG8_LDB(B0, 0, 0); PG8_SCHED; PG8_LDA(At, 0, 0); PG8_STAGE(PG8_SA(1, 1), a1 + hstep, voffA);
            PG8_WAIT_L(8); PG8_BAR; PG8_WAIT_L(0); PG8_MMA(0, 0, At, B0); PG8_BAR; PG8_SCHED;
            PG8_LDB(B1, 0, 1); PG8_STAGE(PG8_SB(0, 0), b2, voffB);
            PG8_BAR; PG8_WAIT_L(0); PG8_MMA(0, 1, At, B1); PG8_BAR;
            PG8_LDA(At, 0, 1); PG8_STAGE(PG8_SA(0, 0), a2, voffA);
            PG8_BAR; PG8_WAIT_L(0); PG8_MMA(1, 0, At, B0); PG8_BAR; PG8_SCHED;
            PG8_STAGE(PG8_SB(0, 1), b2 + hstep, voffB);
            PG8_WAIT_V(6); PG8_BAR; PG8_MMA(1, 1, At, B1); PG8_BAR;
            PG8_LDB(B0, 1, 0); PG8_SCHED; PG8_LDA(At, 1, 0); PG8_STAGE(PG8_SA(0, 1), a2 + hstep, voffA);
            PG8_WAIT_L(8); PG8_BAR; PG8_WAIT_L(0); PG8_MMA(0, 0, At, B0); PG8_BAR; PG8_SCHED;
            PG8_LDB(B1, 1, 1); PG8_STAGE(PG8_SB(1, 0), b3, voffB);
            PG8_BAR; PG8_WAIT_L(0); PG8_MMA(0, 1, At, B1); PG8_BAR;
            PG8_LDA(At, 1, 1); PG8_STAGE(PG8_SA(1, 0), a3, voffA);
            PG8_BAR; PG8_WAIT_L(0); PG8_MMA(1, 0, At, B0); PG8_BAR; PG8_SCHED;
            PG8_STAGE(PG8_SB(1, 1), b3 + hstep, voffB);
            PG8_WAIT_V(6); PG8_BAR; PG8_MMA(1, 1, At, B1); PG8_BAR;
            }
        }
        if constexpr (ALIGN_EPI) { if (wr == 0) PG8_BAR; }
        if constexpr (!Epi::AFTER_DRAIN) { E(acc, cur, wr, wc, fr, fq); S.done(cur); }
        if (!has_next) break;
#pragma unroll
        for (int a = 0; a < 2; ++a)
#pragma unroll
            for (int b = 0; b < 2; ++b)
#pragma unroll
                for (int m = 0; m < 4; ++m)
#pragma unroll
                    for (int n = 0; n < 2; ++n) acc[a][b][m][n] = (f32x4){0.f, 0.f, 0.f, 0.f};
        cur = nxt; cA = nA; cB = nB; ++ui;
        if constexpr (ALIGN_EPI) { if (wr == 1) PG8_BAR; }
    }
    PG8_WAIT_V(0);
    if constexpr (!ALIGN_EPI) { if (wr == 0) PG8_BAR; }
    PG8_BAR;
    if constexpr (Epi::AFTER_DRAIN) { E.fused(acc, cur, wr, wc, fr, fq, lds, wid, lane); S.done(cur); }
#undef PG8_SA
#undef PG8_SB
#undef PG8_STAGE
#undef PG8_LDA
#undef PG8_LDB
#undef PG8_MMA
#undef PG8_WAIT_V
#undef PG8_WAIT_L
#undef PG8_BAR
#undef PG8_SCHED
}
}

namespace att {
using bf16x8 = __attribute__((ext_vector_type(8))) short;
using s16x4  = __attribute__((ext_vector_type(4))) short;
using f32x16 = __attribute__((ext_vector_type(16))) float;
using u32x4  = __attribute__((ext_vector_type(4))) unsigned;
constexpr int NW = 8, QBLK = 32, KVBLK = 64, DV = 128;
#define ATT_SBAR() __builtin_amdgcn_sched_barrier(0)
__device__ __forceinline__ int crow(int r, int hi) { return (r & 3) + 8 * (r >> 2) + 4 * hi; }
__device__ __forceinline__ unsigned cvtpk(float lo, float hi) { unsigned r; asm volatile("v_cvt_pk_bf16_f32 %0, %1, %2" : "=v"(r) : "v"(lo), "v"(hi)); return r; }
template <int DQK> __device__ __forceinline__ int kswz(int row, int colB) { return row * (DQK * 2) + (colB ^ ((row & 7) << 4)); }
constexpr float THR = 8.f;

template <int DQK> struct Cfg {
    static constexpr int SHM_V = KVBLK * DV * 2, SHM_K = KVBLK * DQK * 2;
    static constexpr int OFF_V = 0, OFF_K = 2 * SHM_V, OFF_WS = OFF_K + 2 * SHM_K, OFF_BIAS = OFF_WS + NW * 64 * 4, LDS_BYTES = OFF_BIAS + 10240;
    static constexpr int KCH = DQK / 8;
    static constexpr int KLD = (64 * KCH) / 512;
};

struct Job {
    const bf16_t* Q;
    const bf16_t* K;
    const bf16_t* V;
    bf16_t* O;
    int nt;
    int seg0_tiles, row_seg0, row_seg1;
    int R0; int rlo;
};

__device__ __forceinline__ int tile_row(const Job& J, int j) {
    if (j < J.seg0_tiles) return J.row_seg0 + 64 * j;
    int jj = j - J.seg0_tiles; if (jj > 3) jj = 0; return J.row_seg1 + 64 * jj;
}

__device__ __forceinline__ void partialSM(f32x16& p0, f32x16& p1, float& m_reg, float& mn, float& alpha, float C, float thr_raw) {
    float pmax = p0[0];
#pragma unroll
    for (int r = 1; r < 16; ++r) pmax = fmaxf(pmax, p0[r]);
#pragma unroll
    for (int r = 0; r < 16; ++r) pmax = fmaxf(pmax, p1[r]);
    { auto rr = __builtin_amdgcn_permlane32_swap(__float_as_uint(pmax), __float_as_uint(pmax), false, false);
      pmax = fmaxf(__uint_as_float(rr[0]), __uint_as_float(rr[1])); }
    if (__builtin_expect(__all(pmax - m_reg <= thr_raw), 1)) { mn = m_reg; alpha = 1.f; }
    else { mn = fmaxf(m_reg, pmax); alpha = __builtin_amdgcn_exp2f((m_reg - mn) * C); m_reg = mn; }
    const float mnC = -mn * C;
#pragma unroll
    for (int r = 0; r < 16; ++r) p0[r] = fmaf(p0[r], C, mnC);
#pragma unroll
    for (int r = 0; r < 16; ++r) p1[r] = fmaf(p1[r], C, mnC);
#pragma unroll
    for (int r = 0; r < 16; ++r) p0[r] = __builtin_amdgcn_exp2f(p0[r]);
}
__device__ __forceinline__ void finishSM(f32x16& p0, f32x16& p1, float alpha, float& l_reg, bf16x8& pa0, bf16x8& pa1, bf16x8& pa2, bf16x8& pa3) {
#pragma unroll
    for (int r = 0; r < 16; ++r) p1[r] = __builtin_amdgcn_exp2f(p1[r]);
    float ps = 0;
#pragma unroll
    for (int r = 0; r < 16; ++r) ps += p0[r];
#pragma unroll
    for (int r = 0; r < 16; ++r) ps += p1[r];
    { auto rr = __builtin_amdgcn_permlane32_swap(__float_as_uint(ps), __float_as_uint(ps), false, false);
      ps = __uint_as_float(rr[0]) + __uint_as_float(rr[1]); }
    l_reg = l_reg * alpha + ps;
#define ATT_PK4(P, BASE, OUT) do { unsigned a0 = cvtpk(P[BASE + 0], P[BASE + 1]), a1 = cvtpk(P[BASE + 2], P[BASE + 3]);   \
    unsigned b0 = cvtpk(P[BASE + 4], P[BASE + 5]), b1 = cvtpk(P[BASE + 6], P[BASE + 7]);                              \
    auto r0 = __builtin_amdgcn_permlane32_swap(a0, b0, false, false); auto r1 = __builtin_amdgcn_permlane32_swap(a1, b1, false, false); \
    u32x4 w = {r0[0], r1[0], r0[1], r1[1]}; OUT = *reinterpret_cast<bf16x8*>(&w); } while (0)
    ATT_PK4(p0, 0, pa0); ATT_PK4(p0, 8, pa1); ATT_PK4(p1, 0, pa2); ATT_PK4(p1, 8, pa3);
#undef ATT_PK4
}
template <int DQK> __device__ __forceinline__ void qkt(f32x16& p0, f32x16& p1, const char* Ks, const bf16x8* qr, int r32, int hi) {
    p0 = f32x16{}; p1 = f32x16{};
#pragma unroll
    for (int d0 = 0; d0 < DQK / 16; ++d0) { const int cb = (d0 * 16 + hi * 8) * 2;
        const bf16x8 b0 = *reinterpret_cast<const bf16x8*>(Ks + kswz<DQK>(r32, cb));
        const bf16x8 b1 = *reinterpret_cast<const bf16x8*>(Ks + kswz<DQK>(32 + r32, cb));
        p0 = __builtin_amdgcn_mfma_f32_32x32x16_bf16(b0, qr[d0], p0, 0, 0, 0);
        p1 = __builtin_amdgcn_mfma_f32_32x32x16_bf16(b1, qr[d0], p1, 0, 0, 0); }
}
__device__ __forceinline__ int v_st(int k, int c) { const int kk = (k & ~0xC) | ((k & 4) << 1) | ((k & 8) >> 1); return ((kk >> 3) * 4 + (c >> 5)) * 512 + ((kk & 7) * 32 + (c & 31)) * 2; }
__device__ __forceinline__ int v_rd_base(int lane) { return ((lane & 3) << 3) | (((lane >> 2) & 3) << 6) | (((lane >> 4) & 1) << 5) | (((lane >> 5) & 1) << 8); }
constexpr int v_rd_off(int d0, int ks, int half) { return d0 * 512 + ks * 4096 + half * 2048; }
template <int OFF> __device__ __forceinline__ s16x4 tr_read(int vb) { s16x4 r; asm volatile("ds_read_b64_tr_b16 %0, %1 offset:%2" : "=&v"(r) : "v"(vb), "i"(OFF) : "memory"); return r; }
template <int D0> __device__ __forceinline__ void pv_one(f32x16& od, int vb, bf16x8 pa0, bf16x8 pa1, bf16x8 pa2, bf16x8 pa3) {
    const s16x4 l0 = tr_read<v_rd_off(D0, 0, 0)>(vb), h0 = tr_read<v_rd_off(D0, 0, 1)>(vb), l1 = tr_read<v_rd_off(D0, 1, 0)>(vb), h1 = tr_read<v_rd_off(D0, 1, 1)>(vb);
    const s16x4 l2 = tr_read<v_rd_off(D0, 2, 0)>(vb), h2 = tr_read<v_rd_off(D0, 2, 1)>(vb), l3 = tr_read<v_rd_off(D0, 3, 0)>(vb), h3 = tr_read<v_rd_off(D0, 3, 1)>(vb);
    asm volatile("s_waitcnt lgkmcnt(0)" ::: "memory"); ATT_SBAR();
#define ATT_PK(L, H) (bf16x8){L[0], L[1], L[2], L[3], H[0], H[1], H[2], H[3]}
    od = __builtin_amdgcn_mfma_f32_32x32x16_bf16(pa0, ATT_PK(l0, h0), od, 0, 0, 0);
    od = __builtin_amdgcn_mfma_f32_32x32x16_bf16(pa1, ATT_PK(l1, h1), od, 0, 0, 0);
    od = __builtin_amdgcn_mfma_f32_32x32x16_bf16(pa2, ATT_PK(l2, h2), od, 0, 0, 0);
    od = __builtin_amdgcn_mfma_f32_32x32x16_bf16(pa3, ATT_PK(l3, h3), od, 0, 0, 0);
#undef ATT_PK
}
__device__ __forceinline__ void pv_d0(f32x16* o, int vb, bf16x8 pa0, bf16x8 pa1, bf16x8 pa2, bf16x8 pa3) {
    pv_one<0>(o[0], vb, pa0, pa1, pa2, pa3); pv_one<1>(o[1], vb, pa0, pa1, pa2, pa3); pv_one<2>(o[2], vb, pa0, pa1, pa2, pa3); pv_one<3>(o[3], vb, pa0, pa1, pa2, pa3);
}
constexpr int NA_BROW = 160, NA_BORG = 64 + (NA_KW - 1);
__device__ __forceinline__ void na_bias(f32x16& p0, f32x16& p1, const Job& J, int j, int R, int c, int hi, const float* biasq) {
    const int nloc = J.seg0_tiles;
    if (j >= nloc && j < nloc + 4) return;
    const int rr = J.rlo + j; int r0 = R - NA_KH / 2; r0 = r0 < 0 ? 0 : (r0 > ROWS - NA_KH ? ROWS - NA_KH : r0);
    const bool rowok = (j < nloc) && rr >= r0 && rr < r0 + NA_KH;
    if (!rowok) {
#pragma unroll
        for (int r = 0; r < 16; ++r) { p0[r] = -1e30f; p1[r] = -1e30f; }
        return; }
    int c0 = c - NA_KW / 2; c0 = c0 < 0 ? 0 : (c0 > GRID_W - NA_KW ? GRID_W - NA_KW : c0);
    const int dr = rr - R + (NA_KH - 1);
    const float* bl = biasq + dr * NA_BROW + NA_BORG + 4 * hi - c;
    const int vb = 4 * hi - c0;
#pragma unroll
    for (int r = 0; r < 16; ++r) { const int cc = (r & 3) + 8 * (r >> 2);
        p0[r] = ((unsigned)(cc + vb) < (unsigned)NA_KW) ? p0[r] + bl[cc] : -1e30f;
        p1[r] = ((unsigned)(cc + 32 + vb) < (unsigned)NA_KW) ? p1[r] + bl[cc + 32] : -1e30f; }
}

#define ATT_LAS __attribute__((address_space(3)))
template <int DQK, bool NA, int LDQ, int LDK, int LDV, int LDO>
__device__ __forceinline__ void attn_unit(const Job& J, char* lds, const float scale, const int tid_in) {
    using C_ = Cfg<DQK>;
    int tid_ = tid_in; asm volatile("" : "+v"(tid_));
    const int tid = tid_, wid = __builtin_amdgcn_readfirstlane(tid >> 6), lane = tid & 63, r32 = lane & 31, hi = lane >> 5;
    char* V_lds = lds + C_::OFF_V; char* K_lds = lds + C_::OFF_K;
    const unsigned ldsb = (unsigned)(uintptr_t)lds;
    float* wsf = (float*)(lds + C_::OFF_WS) + wid * 64; float* li_l = wsf; float* al_l = wsf + 32;
    const float* biasq = (const float*)(lds + C_::OFF_BIAS);
    const float Cc = scale * 1.4426950408889634f, thr_raw = THR / scale;
    float m_reg = -1e5f, l_reg = 0; f32x16 o[4] = {}; bf16x8 qr[DQK / 16];
    const bf16_t* Qw = J.Q + (long)(wid * QBLK + r32) * LDQ + hi * 8;
#pragma unroll
    for (int d0 = 0; d0 < DQK / 16; ++d0) qr[d0] = *reinterpret_cast<const bf16x8*>(Qw + d0 * 16);
    const int naR = J.R0 + (wid >> 1), nac = (wid & 1) * 32 + r32;
    const int vb0 = (int)(uintptr_t)V_lds + v_rd_base(lane);
    unsigned koff[C_::KLD], voff[2];
#pragma unroll
    for (int i = 0; i < C_::KLD; ++i) { const int sl = 512 * i + tid, row = sl / C_::KCH, cs = sl % C_::KCH, chunk = (cs & ~7) | ((cs & 7) ^ (row & 7)); koff[i] = (unsigned)(row * LDK * 2 + chunk * 16); }
#pragma unroll
    for (int i = 0; i < 2; ++i) { const int sl = 512 * i + tid, sub = sl >> 5, wi = sl & 31, kk = (sub >> 2) * 8 + (wi >> 2), k = (kk & ~0xC) | ((kk & 4) << 1) | ((kk & 8) >> 1), c = (sub & 3) * 32 + (wi & 3) * 8;
        voff[i] = (unsigned)(k * LDV * 2 + c * 2); }
#define ATT_STAGE(j, b) do { const int row0_ = tile_row(J, (j)); const char* vp_ = (const char*)(J.V + (size_t)row0_ * LDV); const char* kp_ = (const char*)(J.K + (size_t)row0_ * LDK); \
        _Pragma("unroll") for (int i_ = 0; i_ < C_::KLD; ++i_) __builtin_amdgcn_global_load_lds((const unsigned*)(kp_ + koff[i_]), (ATT_LAS unsigned*)(ldsb + C_::OFF_K + (b) * C_::SHM_K + (512 * i_ + 64 * wid) * 16), 16, 0, 0); \
        _Pragma("unroll") for (int i_ = 0; i_ < 2; ++i_) __builtin_amdgcn_global_load_lds((const unsigned*)(vp_ + voff[i_]), (ATT_LAS unsigned*)(ldsb + C_::OFF_V + (b) * C_::SHM_V + (512 * i_ + 64 * wid) * 16), 16, 0, 0); } while (0)
    const int NT = J.nt;
    __syncthreads();
    ATT_STAGE(0, 0); asm volatile("s_waitcnt vmcnt(0)" ::: "memory"); __syncthreads();
    for (int j = 0; j < NT; ++j) {
        const int buf = j & 1;
        if (j + 1 < NT) ATT_STAGE(j + 1, buf ^ 1);
        bool live = true;
        if (NA) { const int nloc = J.seg0_tiles; if (j >= nloc + 4) live = false; else if (j < nloc) { const int rr = J.rlo + j; int r0 = naR - NA_KH / 2; r0 = r0 < 0 ? 0 : (r0 > ROWS - NA_KH ? ROWS - NA_KH : r0); live = rr >= r0 && rr < r0 + NA_KH; } }
        if (live) {
        f32x16 p0, p1; float mn, al; bf16x8 pa0, pa1, pa2, pa3;
        qkt<DQK>(p0, p1, K_lds + buf * C_::SHM_K, qr, r32, hi);
        if (NA) na_bias(p0, p1, J, j, naR, nac, hi, biasq);
        partialSM(p0, p1, m_reg, mn, al, Cc, thr_raw);
        finishSM(p0, p1, al, l_reg, pa0, pa1, pa2, pa3);
        if (__any(al < 1.f)) { if (hi == 0) al_l[r32] = al; asm volatile("s_waitcnt lgkmcnt(0)" ::: "memory");
#pragma unroll
            for (int d = 0; d < 4; ++d)
#pragma unroll
                for (int r = 0; r < 16; ++r) o[d][r] *= al_l[crow(r, hi)]; }
        ATT_SBAR();
        pv_d0(o, vb0 + buf * C_::SHM_V, pa0, pa1, pa2, pa3);
        }
        asm volatile("s_waitcnt vmcnt(0)" ::: "memory");
        __syncthreads();
    }
    if (hi == 0) li_l[r32] = l_reg; asm volatile("s_waitcnt lgkmcnt(0)" ::: "memory");
    float rli[16];
#pragma unroll
    for (int r = 0; r < 16; ++r) rli[r] = __builtin_amdgcn_rcpf(li_l[crow(r, hi)]);
    bf16_t* Ow = J.O + (long)(wid * QBLK) * LDO;
#pragma unroll
    for (int r = 0; r < 16; ++r) { const int orow = crow(r, hi);
#pragma unroll
        for (int d0 = 0; d0 < 4; ++d0) Ow[(long)orow * LDO + d0 * 32 + r32] = f2bf(o[d0][r] * rli[r]); }
#undef ATT_STAGE
}
}

struct AttnArgs { const bf16_t *QM, *KM, *VM, *NQ, *NK, *P; bf16_t* Y; const float* rpb; int want_ctx; int pad; };
__device__ __forceinline__ void attention_phase(const AttnArgs& A, char* lds, int G, int wg, const int tid, const int nskip) {
    static_assert(GRID_W == 64 && SEQ % 256 == 0 && CTX_LEN == 256 && HD == 128, "attention phase geometry");
    constexpr int NQB = SEQ / 256;
    constexpr float sc_mla = 0.07216878364870323f, sc_na = 0.08838834764831845f;
    static_assert(MLA_QK == 192 && HD == 128, "softmax scales");
    if (!(A.pad & 2)) for (int u = wg; u < BATCH * NH * NQB; u += G) {
        const int bh = u % (BATCH * NH), qb = u / (BATCH * NH), b = bh / NH, h = bh % NH;
        att::Job J{};
        J.Q = A.QM + (size_t)(b * SEQ + qb * 256) * NQ_MLA + h * MLA_QK; J.K = A.KM + h * MLA_QK; J.V = A.VM + h * MLA_V;
        J.O = A.Y + (size_t)(b * SEQ + qb * 256) * D_MODEL + GROUP_W + h * MLA_V;
        J.nt = SEQ / 64 + CTX_LEN / 64; J.seg0_tiles = SEQ / 64; J.row_seg0 = b * SEQ; J.row_seg1 = M_LAT + b * CTX_LEN;
        att::attn_unit<MLA_QK, false, NQ_MLA, NQ_MLA, NH * MLA_V, D_MODEL>(J, lds, sc_mla, tid);
    }
    const int G2n = G - nskip, c2 = wg - nskip;
    if (!(A.pad & 4) && c2 >= 0) for (int u = c2; u < BATCH * NH * NQB; u += G2n) {
        const int bh = u % (BATCH * NH), qb = u / (BATCH * NH), b = bh / NH, h = bh % NH, R0 = qb * 4;
        __syncthreads();
        { float* bq = (float*)(lds + att::Cfg<HD>::OFF_BIAS); const float* src = A.rpb + (size_t)h * (2 * NA_KH - 1) * (2 * NA_KW - 1);
          for (int i = tid; i < (2 * NA_KH - 1) * att::NA_BROW; i += 512) { const int dr = i / att::NA_BROW; int dc = i % att::NA_BROW - att::NA_BORG + (NA_KW - 1); dc = dc < 0 ? 0 : (dc > 2 * NA_KW - 2 ? 2 * NA_KW - 2 : dc);
              bq[i] = src[dr * (2 * NA_KW - 1) + dc] * 11.313708498984761f; } }
        int rlo = R0 - NA_KH / 2; rlo = rlo < 0 ? 0 : (rlo > ROWS - NA_KH ? ROWS - NA_KH : rlo);
        int rhi = R0 + 3 - NA_KH / 2; rhi = (rhi < 0 ? 0 : (rhi > ROWS - NA_KH ? ROWS - NA_KH : rhi)) + NA_KH - 1;
        const int nloc = rhi - rlo + 1;
        att::Job J{};
        J.Q = A.NQ + (size_t)(b * SEQ + R0 * 64) * GROUP_W + h * HD; J.K = A.NK + h * HD; J.V = A.P + C_NV + h * HD;
        J.O = A.Y + (size_t)(b * SEQ + R0 * 64) * D_MODEL + 3 * GROUP_W + h * HD;
        J.nt = (nloc + 4 + 1) & ~1; J.seg0_tiles = nloc; J.row_seg0 = b * SEQ + rlo * 64; J.row_seg1 = M_LAT + b * CTX_LEN;  J.R0 = R0; J.rlo = rlo;
        att::attn_unit<HD, true, GROUP_W, GROUP_W, NP, D_MODEL>(J, lds, sc_na, tid);
    }
    if (A.want_ctx && !(A.pad & 8)) {
        for (int u = c2 - 64; u >= 0 && u < BATCH * NH; u += G) {
            const int b = u / NH, h = u % NH; const int crow0 = M_LAT + b * CTX_LEN;
            att::Job J{}; J.nt = CTX_LEN / 64; J.seg0_tiles = 0; J.row_seg0 = crow0; J.row_seg1 = crow0;
            J.Q = A.QM + (size_t)crow0 * NQ_MLA + h * MLA_QK; J.K = A.KM + h * MLA_QK; J.V = A.VM + h * MLA_V;
            J.O = A.Y + (size_t)crow0 * D_MODEL + GROUP_W + h * MLA_V; att::attn_unit<MLA_QK, false, NQ_MLA, NQ_MLA, NH * MLA_V, D_MODEL>(J, lds, sc_mla, tid);
        }
        for (int u = c2 - 64 - BATCH * NH; u >= 0 && u < BATCH * NH; u += G) {
            const int b = u / NH, h = u % NH; const int crow0 = M_LAT + b * CTX_LEN;
            att::Job J{}; J.nt = CTX_LEN / 64; J.seg0_tiles = 0; J.row_seg0 = crow0; J.row_seg1 = crow0;
            J.Q = A.NQ + (size_t)crow0 * GROUP_W + h * HD; J.K = A.NK + h * HD; J.V = A.P + C_NV + h * HD;
            J.O = A.Y + (size_t)crow0 * D_MODEL + 3 * GROUP_W + h * HD; att::attn_unit<HD, false, GROUP_W, GROUP_W, NP, D_MODEL>(J, lds, sc_na, tid);
        }
    }
}

namespace gdn {
typedef short bf16x8 __attribute__((ext_vector_type(8)));
typedef float f32x4 __attribute__((ext_vector_type(4)));
typedef float f32x16 __attribute__((ext_vector_type(16)));
typedef unsigned u32x2 __attribute__((ext_vector_type(2)));
typedef unsigned u32x4 __attribute__((ext_vector_type(4)));
constexpr int CH = 64, NCHUNK = M_ALL / CH;
constexpr int NTASK = NCHUNK * NH * 2;
constexpr size_t SZ_UT = 128 * 64, SZ_WP = 64 * 128, SZ_KDT = 128 * 64, SZ_QD = 64 * 128, SZ_QK = 64 * 64, SZ_SIT = 128 * 128, SZ_VNT = 128 * 64;
struct Bufs { bf16_t *UT, *WP, *KDT, *QD, *QK, *SIT, *VNT; float* GT; };
__device__ __forceinline__ int perm32(int o) { return (o & ~31) | (((o & 15) >> 2) * 8 + ((o >> 4) & 1) * 4 + (o & 3)); }
__device__ __forceinline__ unsigned pk2(float lo, float hi) { return (unsigned)f2bf(lo) | ((unsigned)f2bf(hi) << 16); }

constexpr int QS = 132;
constexpr int AS = 68;
constexpr int AH = 72;
typedef _Float16 h16x8 __attribute__((ext_vector_type(8)));
constexpr int G1_OFF_Q = 0, G1_OFF_K = G1_OFF_Q + CH * QS * 4, G1_OFF_V = G1_OFF_K + CH * QS * 4, G1_OFF_AA = G1_OFF_V + CH * QS * 4, G1_OFF_SM = G1_OFF_AA + 2 * CH * AS * 4,
              G1_LDS = G1_OFF_SM + 12 * 64 * 4;
struct G1Args { const bf16_t* P; const float* conv_w; const float* a_log; const float* dt_bias; Bufs B; int pflags; };

template <int P, int M> __device__ __forceinline__ void g1_sweep_m(float (&x)[CH], const _Float16* rowp, const float xp) {
    constexpr int N = 63 - P;
    if constexpr (8 * M < N) {
        const h16x8 a8 = *(const h16x8*)(rowp + 8 * M);
        constexpr int NE = (N - 8 * M) < 8 ? (N - 8 * M) : 8;
#pragma unroll
        for (int e = 0; e < NE; ++e) x[63 - (8 * M + e)] = __builtin_fmaf(-(float)a8[e], xp, x[63 - (8 * M + e)]);
        g1_sweep_m<P, M + 1>(x, rowp, xp);
    }
}
template <int P> __device__ __forceinline__ void g1_sweep(float (&x)[CH], const _Float16* AAv) {
    if constexpr (P < CH - 1) { g1_sweep_m<P, 0>(x, AAv + (63 - P) * AH, x[P]); g1_sweep<P + 1>(x, AAv); }
}

__device__ __forceinline__ void g1_load(const G1Args& A, int cix, int h, int tid, u32x4 (&xr)[11], float (&gin)[4]) {
    const RowInfo r0i = row_info(cix * CH);
    if (tid < 128) { const int d = tid >> 6, i = tid & 63; const size_t r = (size_t)(cix * CH + i) * NP;
        gin[0] = bf2f(A.P[r + C_GB + d * NH + h]); gin[1] = bf2f(A.P[r + C_GA + d * NH + h]); gin[2] = A.a_log[d * NH + h]; gin[3] = A.dt_bias[d * NH + h]; }
    if (tid < 48 * 8) { const int grp = tid % 48, ts = tid / 48, which = grp >> 4, cc0 = (grp & 15) * 8, ch0 = which * GROUP_W + h * HD + cc0;
#pragma unroll
        for (int k = 0; k < 11; ++k) { const int tt = r0i.t + 8 * ts + k - 1;
            xr[k] = (tt >= 0 && tt < r0i.T && !(A.pflags & 4096)) ? *(const u32x4*)(A.P + (size_t)(r0i.base + tt) * NP + C_GQ + ch0) : (u32x4){0u, 0u, 0u, 0u}; } }
}
__device__ __forceinline__ void g1_task(const G1Args& A, char* lds, int cix, int h, const int tid_in, u32x4 (&xr)[11], float (&gin)[4], const int ncix, const int nh, const bool has_next) {
    int tid_ = tid_in; asm volatile("" : "+v"(tid_));
    const int tid = tid_, wid = __builtin_amdgcn_readfirstlane(tid >> 6), lane = tid & 63;
    float* Qs = (float*)(lds + G1_OFF_Q); float* Ks = (float*)(lds + G1_OFF_K); float* Vs = (float*)(lds + G1_OFF_V); _Float16* AA = (_Float16*)(lds + G1_OFF_AA);
    float* sm = (float*)(lds + G1_OFF_SM); float* g_s = sm;   float* beta_s = sm + 128;   float* gc_s = sm + 256;
    const int row0 = cix * CH; const RowInfo r0i = row_info(row0);
    LDS_BARRIER();
    if (tid < 48 * 8) {
        const int grp = tid % 48, ts = tid / 48, which = grp >> 4, cc0 = (grp & 15) * 8, ch0 = which * GROUP_W + h * HD + cc0;
        float wgt[4][8];
#pragma unroll
        for (int j = 0; j < 4; ++j) { const f32x4 w0 = *(const f32x4*)(A.conv_w + j * 3 * GROUP_W + ch0), w1 = *(const f32x4*)(A.conv_w + j * 3 * GROUP_W + ch0 + 4);
#pragma unroll
            for (int e = 0; e < 4; ++e) { wgt[j][e] = w0[e]; wgt[j][4 + e] = w1[e]; } }
        float* dstp = (which == 0 ? Qs : which == 1 ? Ks : Vs) + cc0;
#pragma unroll
        for (int i = 0; i < 8; ++i) { float acc[8];
#pragma unroll
            for (int e = 0; e < 8; ++e) acc[e] = 0.f;
#pragma unroll
            for (int j = 0; j < 4; ++j) { const u32x4 xv = xr[i + j];
#pragma unroll
                for (int e = 0; e < 4; ++e) { acc[2 * e] += wgt[j][2 * e] * bflo(xv[e]); acc[2 * e + 1] += wgt[j][2 * e + 1] * bfhi(xv[e]); } }
            f32x4 y0, y1;
#pragma unroll
            for (int e = 0; e < 4; ++e) { y0[e] = acc[e] * __builtin_amdgcn_rcpf(1.0f + __expf(-acc[e])); y1[e] = acc[4 + e] * __builtin_amdgcn_rcpf(1.0f + __expf(-acc[4 + e])); }
            *(f32x4*)(dstp + (8 * ts + i) * QS) = y0; *(f32x4*)(dstp + (8 * ts + i) * QS + 4) = y1; }
    }
    if (tid < 128) { const int d = tid >> 6, i = tid & 63;
        beta_s[d * 64 + i] = 1.0f / (1.0f + __expf(-gin[0]));
        g_s[d * 64 + i] = -__expf(gin[2]) * softplusf_(gin[1] + gin[3]); }
    if (has_next) g1_load(A, ncix, nh, tid, xr, gin);
    LDS_BARRIER();
    for (int rr = wid * 4 + (lane >> 4); rr < 2 * CH; rr += 32) { float* rowp = (rr < CH ? Qs : Ks) + (rr & 63) * QS + (lane & 15) * 8;
        f32x4 a = *(const f32x4*)rowp, b = *(const f32x4*)(rowp + 4); float ss = (a[0] * a[0] + a[1] * a[1]) + (a[2] * a[2] + a[3] * a[3]) + (b[0] * b[0] + b[1] * b[1]) + (b[2] * b[2] + b[3] * b[3]);
#pragma unroll
        for (int o = 1; o < 16; o <<= 1) ss += lane_xor(ss, o, lane);
        const float scl = __builtin_amdgcn_rsqf(ss + EPS) * (rr < CH ? 0.08838834764831845f : 1.0f);
        *(f32x4*)rowp = a * scl; *(f32x4*)(rowp + 4) = b * scl; }
    if (tid < 2) {
        f32x4 gv[16];
#pragma unroll
        for (int m = 0; m < 16; ++m) gv[m] = *(const f32x4*)(g_s + tid * 64 + 4 * m);
        float run = 0.f;
        if (tid == 0) {
#pragma unroll
            for (int m = 0; m < 16; ++m) { f32x4 o4;
#pragma unroll
                for (int e = 0; e < 4; ++e) { run += gv[m][e]; o4[e] = run; }
                *(f32x4*)(gc_s + 4 * m) = o4; }
        } else {
#pragma unroll
            for (int m = 15; m >= 0; --m) { f32x4 o4;
#pragma unroll
                for (int e = 3; e >= 0; --e) { run += gv[m][e]; o4[e] = run; }
                *(f32x4*)(gc_s + 64 + 4 * m) = o4; }
        }
    }
    LDS_BARRIER();
    float* eq_s = sm + 384; float* ek_s = sm + 512;
    if (tid < 128) { const int d = tid >> 6, i = tid & 63; const float gci = gc_s[d * 64 + i], glast = d == 0 ? gc_s[63] : gc_s[64];
        eq_s[tid] = __expf(gci); ek_s[tid] = __expf(glast - gci); }
    const int gwhich = wid >> 2, gI = (wid >> 1) & 1, gJ = wid & 1, r32 = lane & 31, hi = lane >> 5;
    f32x16 acc = {};
    if (!(A.pflags & 1024)) {
        const float* X = (gwhich ? Qs : Ks) + (32 * gI + r32) * QS + 4 * hi; const float* Yp = Ks + (32 * gJ + r32) * QS + 4 * hi;
#pragma unroll
        for (int s = 0; s < 16; ++s) { const f32x4 a4 = *(const f32x4*)(X + 8 * s), b4 = *(const f32x4*)(Yp + 8 * s);
#pragma unroll
            for (int e = 0; e < 4; ++e) acc = __builtin_amdgcn_mfma_f32_32x32x2f32(a4[e], b4[e], acc, 0, 0, 0); }
        const int j = 32 * gJ + r32;
        if (gwhich == 0) {
            const float b1j = beta_s[64 + j], g0j = gc_s[j], g1j = gc_s[64 + j];
#pragma unroll
            for (int r = 0; r < 16; ++r) { const int i = 32 * gI + (r & 3) + 8 * (r >> 2) + 4 * hi;
                if (i > j) { const float kk = acc[r];
                    AA[(63 - j) * AH + (63 - i)] = (_Float16)(beta_s[i] * kk * __expf(gc_s[i] - g0j));
                    AA[CH * AH + i * AH + j] = (_Float16)(b1j * kk * __expf(g1j - gc_s[64 + i])); } }
        }
    }
    LDS_BARRIER();
    const size_t t0 = ((size_t)cix * NH + h) * 2;
    if (!(A.pflags & 2048)) {
#pragma unroll
        for (int n = 0; n < 4; ++n) { const int it = tid + 512 * n, d = it >> 10, p = (it >> 4) & 63, m = it & 15, i = d == 0 ? p : 63 - p, k0 = 32 * (m >> 2) + 4 * (m & 3);
            const float e = eq_s[d * 64 + i]; const f32x4 lo = *(const f32x4*)(Qs + i * QS + k0), hi4 = *(const f32x4*)(Qs + i * QS + k0 + 16);
            *(u32x4*)(A.B.QD + (t0 + d) * SZ_QD + (size_t)p * 128 + m * 8) = (u32x4){pk2(lo[0] * e, lo[1] * e), pk2(lo[2] * e, lo[3] * e), pk2(hi4[0] * e, hi4[1] * e), pk2(hi4[2] * e, hi4[3] * e)}; }
#pragma unroll
        for (int n = 0; n < 4; ++n) { const int it = tid + 512 * n, k = it & 127, d = (it >> 7) & 1, m = it >> 8, p0 = 32 * (m >> 2) + 4 * (m & 3);
            float v[8];
#pragma unroll
            for (int jj = 0; jj < 8; ++jj) { const int p = p0 + (jj < 4 ? jj : 12 + jj), i = d == 0 ? p : 63 - p; v[jj] = Ks[i * QS + k] * ek_s[d * 64 + i]; }
            *(u32x4*)(A.B.KDT + (t0 + d) * SZ_KDT + (size_t)k * 64 + m * 8) = (u32x4){pk2(v[0], v[1]), pk2(v[2], v[3]), pk2(v[4], v[5]), pk2(v[6], v[7])}; }
        if (tid == 0) { A.B.GT[t0] = __expf(gc_s[63]); A.B.GT[t0 + 1] = __expf(gc_s[64]); }
    }
    LDS_BARRIER();
    bf16_t* stg = (bf16_t*)Qs;
    if (gwhich == 1) { const int j = 32 * gJ + r32; const float g0j = gc_s[j], g1j = gc_s[64 + j];
#pragma unroll
        for (int r = 0; r < 16; ++r) { const int i = 32 * gI + (r & 3) + 8 * (r >> 2) + 4 * hi; const float qk = acc[r];
            stg[i * 64 + perm32(j)] = f2bf(i >= j ? qk * __expf(gc_s[i] - g0j) : 0.f);
            stg[4096 + (63 - i) * 64 + perm32(63 - j)] = f2bf(i <= j ? qk * __expf(gc_s[64 + i] - g1j) : 0.f); } }
    LDS_BARRIER();
#pragma unroll
    for (int n = 0; n < 2; ++n) { const int c16 = tid + 512 * n; *(u32x4*)(A.B.QK + t0 * SZ_QK + (size_t)c16 * 8) = *(const u32x4*)(stg + c16 * 8); }
    if (!(A.pflags & 512)) {
        int tidv = tid; asm volatile("" : "+v"(tidv));
        const int d = tidv >> 8, c = tidv & 255; const bool isw = c >= 128; const int cc = c & 127;
        const float* src = isw ? Ks : Vs;
        int lz; asm volatile("v_mov_b32 %0, 0" : "=v"(lz));
        const _Float16* AAv = AA + lz + d * (CH * AH);
        float x[CH];
#pragma unroll
        for (int p = 0; p < CH; ++p) { const int i = d == 0 ? p : 63 - p; float f = beta_s[d * 64 + i]; if (isw) f *= eq_s[d * 64 + i]; x[p] = f * src[i * QS + cc]; }
        {
            g1_sweep<0>(x, AAv);

        }
        LDS_BARRIER();
        if (!isw) { bf16_t* dst = A.B.UT + (t0 + d) * SZ_UT + (size_t)((cc >> 4) * 2 * 64 + (cc & 15)) * 8;
#pragma unroll
            for (int s = 0; s < 2; ++s)
#pragma unroll
                for (int qq = 0; qq < 4; ++qq) { const int p0 = 32 * s + 4 * qq; u32x4 w4; w4.x = pk2(x[p0], x[p0 + 1]); w4.y = pk2(x[p0 + 2], x[p0 + 3]); w4.z = pk2(x[p0 + 16], x[p0 + 17]); w4.w = pk2(x[p0 + 18], x[p0 + 19]);
                    *(u32x4*)(dst + (size_t)(s * 64 + qq * 16) * 8) = w4; }
        } else { bf16_t* dst = stg + d * 8192 + perm32(cc);
#pragma unroll
            for (int p = 0; p < CH; ++p) dst[p * 128] = f2bf(x[p]); }
    }
    LDS_BARRIER();
#pragma unroll
    for (int n = 0; n < 4; ++n) { const int c16 = tid + 512 * n; *(u32x4*)(A.B.WP + t0 * SZ_WP + (size_t)c16 * 8) = *(const u32x4*)(stg + c16 * 8); }
}
__device__ __forceinline__ void g1_phase(const G1Args& A, char* lds, int G, int wg, const int tid) {
    u32x4 xr[11]; float gin[4];
    if (wg < NCHUNK * NH) g1_load(A, wg / NH, wg % NH, tid, xr, gin);
    for (int t = wg; t < NCHUNK * NH; t += G) { const int tn = t + G; g1_task(A, lds, t / NH, t % NH, tid, xr, gin, tn / NH, tn % NH, tn < NCHUNK * NH); }
}

constexpr int G2_SPLIT = 4, G2_NACT = 8 / G2_SPLIT, G2_NSTEP = CTX_LEN / CH + SEQ / CH, G2_WGS = BATCH * NH * 2 * G2_SPLIT;
constexpr int G2_USL = G2_NACT * 2 * 64 * 16;
constexpr int G2_BUF = 16384 + 16384 + G2_USL, G2_NB = 4, G2_LDS = G2_NB * G2_BUF;
static_assert(G2_SPLIT == 4 && G2_USL == 4096, "G2 staging map below assumes 4 KB of u per step");
__device__ __forceinline__ int g2_task_index(int b, int h, int d, int step) {
    constexpr int NC = CTX_LEN / CH, NL = SEQ / CH; int cix;
    if (step < NC) { const int n = d ? NC - 1 - step : step; cix = M_LAT / CH + b * NC + n; }
    else { const int s2 = step - NC, n = d ? NL - 1 - s2 : s2; cix = b * NL + n; }
    return (cix * NH + h) * 2 + d;
}
__device__ __forceinline__ void g2_chain(const Bufs& B, char* lds, int chain_part, const int tid_in, const int step_lo, const int step_hi, float* Ssave) {
    int tid_ = tid_in; asm volatile("" : "+v"(tid_));
    const int tid = tid_, wid = __builtin_amdgcn_readfirstlane(tid >> 6), lane = tid & 63, q = lane >> 4, vl = lane & 15;
    const int chain = chain_part / G2_SPLIT, part = chain_part % G2_SPLIT;
    const bool active = wid < G2_NACT; const int vt = part * G2_NACT + (active ? wid : 0);
    const int d = chain & 1, h = (chain >> 1) % NH, b = chain / (2 * NH);
    constexpr int NSTEP = CTX_LEN / CH + SEQ / CH;
    const unsigned ldsb = (unsigned)(uintptr_t)lds;
    f32x4 S[8];
    f32x4* sv = (f32x4*)Ssave + ((size_t)chain_part * G2_NACT + (active ? wid : 0)) * 8 * 64 + lane;
#pragma unroll
    for (int kb = 0; kb < 8; ++kb) S[kb] = (step_lo > 0 && active) ? sv[kb * 64] : (f32x4){0.f, 0.f, 0.f, 0.f};
    unsigned offw[2], offk[2], offu;
#pragma unroll
    for (int i = 0; i < 2; ++i) { const int sl = 128 * wid + 64 * i + lane;
        { const int row = sl >> 4, pc = sl & 15, c = pc ^ (row & 15); offw[i] = (unsigned)(row * 256 + c * 16); }
        { const int row = sl >> 3, pc = sl & 7, c = pc ^ ((row >> 1) & 7); offk[i] = (unsigned)(row * 128 + c * 16); } }
    offu = (unsigned)((part * G2_NACT * 2 * 64 + (wid & 3) * 64 + lane) * 16);
#define G2_DMA(ti, slot) do { const char* wp_ = (const char*)(B.WP + (size_t)(ti) * SZ_WP); const char* kp_ = (const char*)(B.KDT + (size_t)(ti) * SZ_KDT); const unsigned base_ = ldsb + (unsigned)(slot) * G2_BUF; \
        _Pragma("unroll") for (int i_ = 0; i_ < 2; ++i_) { \
            __builtin_amdgcn_global_load_lds((const unsigned*)(wp_ + offw[i_]), (ATT_LAS unsigned*)(base_ + (128 * wid + 64 * i_) * 16), 16, 0, 0); \
            __builtin_amdgcn_global_load_lds((const unsigned*)(kp_ + offk[i_]), (ATT_LAS unsigned*)(base_ + 16384 + (128 * wid + 64 * i_) * 16), 16, 0, 0); } \
        if (wid >= 4) __builtin_amdgcn_global_load_lds((const unsigned*)((const char*)(B.UT + (size_t)(ti) * SZ_UT) + offu), (ATT_LAS unsigned*)(base_ + 32768 + ((wid & 3) * 64) * 16), 16, 0, 0); } while (0)
#define G2_TI(step) g2_task_index(b, h, d, (step) < NSTEP ? (step) : NSTEP - 1)
    __syncthreads();
    G2_DMA(G2_TI(step_lo), step_lo & 3); G2_DMA(G2_TI(step_lo + 1), (step_lo + 1) & 3); G2_DMA(G2_TI(step_lo + 2), (step_lo + 2) & 3);
    asm volatile("s_waitcnt vmcnt(0)" ::: "memory");
    __syncthreads();
    for (int step = step_lo; step < step_hi; ++step) {
        const int ti = G2_TI(step), slot = step & 3;
        G2_DMA(G2_TI(step + 3), (step + 3) & 3);
        unsigned gtb; { const float* gp = B.GT + ti; asm volatile("s_load_dword %0, %1, 0x0" : "=s"(gtb) : "s"(gp)); }
        const char* wl = lds + slot * G2_BUF; const char* kl = wl + 16384; const char* ul = kl + 16384;
        if (active) {
            bf16x8 aw[16], ak[16];
#pragma unroll
            for (int rb = 0; rb < 4; ++rb)
#pragma unroll
                for (int s = 0; s < 4; ++s) aw[rb * 4 + s] = *(const bf16x8*)(wl + (16 * rb + vl) * 256 + (((4 * s + q) ^ vl) << 4));
#pragma unroll
            for (int kb = 0; kb < 8; ++kb)
#pragma unroll
                for (int s = 0; s < 2; ++s) ak[kb * 2 + s] = *(const bf16x8*)(kl + (16 * kb + vl) * 128 + (((4 * s + q) ^ ((vl >> 1) & 7)) << 4));
            u32x4 uu[2];
#pragma unroll
            for (int s = 0; s < 2; ++s) uu[s] = *(const u32x4*)(ul + ((wid * 2 + s) * 64 + lane) * 16);
            bf16_t* sit = B.SIT + (size_t)ti * SZ_SIT + (size_t)(vt * 4 * 64 + lane) * 8;
            bf16x8 sf[4];
#pragma unroll
            for (int s = 0; s < 4; ++s) { u32x4 w4; w4.x = pk2(S[2 * s][0], S[2 * s][1]); w4.y = pk2(S[2 * s][2], S[2 * s][3]); w4.z = pk2(S[2 * s + 1][0], S[2 * s + 1][1]); w4.w = pk2(S[2 * s + 1][2], S[2 * s + 1][3]);
                sf[s] = __builtin_bit_cast(bf16x8, w4); *(u32x4*)(sit + (size_t)s * 64 * 8) = w4; }
            __builtin_amdgcn_sched_barrier(0);
            f32x4 vn[4];
#pragma unroll
            for (int rb = 0; rb < 4; ++rb) vn[rb] = (f32x4){0.f, 0.f, 0.f, 0.f};
#pragma unroll
            for (int s = 0; s < 4; ++s)
#pragma unroll
                for (int rb = 0; rb < 4; ++rb) vn[rb] = __builtin_amdgcn_mfma_f32_16x16x32_bf16(aw[rb * 4 + s], sf[s], vn[rb], 0, 0, 0);
#pragma unroll
            for (int s = 0; s < 2; ++s) { const f32x4 a0 = vn[2 * s], a1 = vn[2 * s + 1];
                vn[2 * s][0] = bflo(uu[s].x) - a0[0]; vn[2 * s][1] = bfhi(uu[s].x) - a0[1]; vn[2 * s][2] = bflo(uu[s].y) - a0[2]; vn[2 * s][3] = bfhi(uu[s].y) - a0[3];
                vn[2 * s + 1][0] = bflo(uu[s].z) - a1[0]; vn[2 * s + 1][1] = bfhi(uu[s].z) - a1[1]; vn[2 * s + 1][2] = bflo(uu[s].w) - a1[2]; vn[2 * s + 1][3] = bfhi(uu[s].w) - a1[3]; }
            bf16_t* vnt = B.VNT + (size_t)ti * SZ_VNT + (size_t)(vt * 2 * 64 + lane) * 8;
            bf16x8 vf[2];
#pragma unroll
            for (int s = 0; s < 2; ++s) { u32x4 w4; w4.x = pk2(vn[2 * s][0], vn[2 * s][1]); w4.y = pk2(vn[2 * s][2], vn[2 * s][3]); w4.z = pk2(vn[2 * s + 1][0], vn[2 * s + 1][1]); w4.w = pk2(vn[2 * s + 1][2], vn[2 * s + 1][3]);
                vf[s] = __builtin_bit_cast(bf16x8, w4); *(u32x4*)(vnt + (size_t)s * 64 * 8) = w4; }
            asm volatile("s_waitcnt lgkmcnt(0)" ::: "memory");
            const float gt = __uint_as_float(gtb);
#pragma unroll
            for (int kb = 0; kb < 8; ++kb) S[kb] = S[kb] * gt;
#pragma unroll
            for (int s = 0; s < 2; ++s)
#pragma unroll
                for (int kb = 0; kb < 8; ++kb) S[kb] = __builtin_amdgcn_mfma_f32_16x16x32_bf16(ak[kb * 2 + s], vf[s], S[kb], 0, 0, 0);
            __builtin_amdgcn_sched_barrier(0);
            asm volatile("s_waitcnt vmcnt(26) lgkmcnt(0)\n\ts_barrier" ::: "memory");
        } else if (wid >= 4) {
            asm volatile("s_waitcnt vmcnt(10) lgkmcnt(0)\n\ts_barrier" ::: "memory");
        } else {
            asm volatile("s_waitcnt vmcnt(8) lgkmcnt(0)\n\ts_barrier" ::: "memory");
        }
    }
    if (step_hi < NSTEP && active) {
#pragma unroll
        for (int kb = 0; kb < 8; ++kb) sv[kb * 64] = S[kb]; }
    asm volatile("s_waitcnt vmcnt(0)" ::: "memory");
    __syncthreads();
#undef G2_DMA
#undef G2_TI
}

constexpr int G3_OS = 132, G3_LDS = 64 * G3_OS * 4;
struct G3Args { Bufs B; const bf16_t* P; const float* norm_g; bf16_t* Y; };
__device__ __forceinline__ void g3_task(const G3Args& A, char* lds, int cix, int h, const int tid_in, const f32x4 g0, const f32x4 g1) {
    int tid_ = tid_in; asm volatile("" : "+v"(tid_));
    const int tid = tid_, wid = __builtin_amdgcn_readfirstlane(tid >> 6), lane = tid & 63, q = lane >> 4, vl = lane & 15;
    u32x4 gwv[2];
#pragma unroll
    for (int n = 0; n < 2; ++n) { const int item = tid + 512 * n, tok = item >> 4, c8 = (item & 15) * 8; gwv[n] = *(const u32x4*)(A.P + ((size_t)cix * CH + tok) * NP + C_GG + h * HD + c8); }
    f32x4 o[2][4];
#pragma unroll
    for (int d = 0; d < 2; ++d) {
        const size_t t = ((size_t)cix * NH + h) * 2 + d;
        const bf16_t* sit = A.B.SIT + t * SZ_SIT + (size_t)(wid * 4 * 64 + lane) * 8;
        const bf16_t* vnt = A.B.VNT + t * SZ_VNT + (size_t)(wid * 2 * 64 + lane) * 8;
        const bf16_t* qd = A.B.QD + t * SZ_QD + (size_t)vl * 128 + 8 * q;
        const bf16_t* qk = A.B.QK + t * SZ_QK + (size_t)vl * 64 + 8 * q;
        bf16x8 sf[4], vf[2];
#pragma unroll
        for (int s = 0; s < 4; ++s) sf[s] = *(const bf16x8*)(sit + (size_t)s * 64 * 8);
#pragma unroll
        for (int s = 0; s < 2; ++s) vf[s] = *(const bf16x8*)(vnt + (size_t)s * 64 * 8);
#pragma unroll
        for (int rb = 0; rb < 4; ++rb) { f32x4 acc = {0.f, 0.f, 0.f, 0.f};
#pragma unroll
            for (int s = 0; s < 4; ++s) acc = __builtin_amdgcn_mfma_f32_16x16x32_bf16(*(const bf16x8*)(qd + (size_t)rb * 16 * 128 + 32 * s), sf[s], acc, 0, 0, 0);
#pragma unroll
            for (int s = 0; s < 2; ++s) acc = __builtin_amdgcn_mfma_f32_16x16x32_bf16(*(const bf16x8*)(qk + (size_t)rb * 16 * 64 + 32 * s), vf[s], acc, 0, 0, 0);
            o[d][rb] = acc; }
    }
    f32x4 ot[4];
#pragma unroll
    for (int rb = 0; rb < 4; ++rb)
#pragma unroll
        for (int r = 0; r < 4; ++r) ot[rb][r] = o[0][rb][r] + lane_xor(o[1][3 - rb][3 - r], 48, lane);
    float* Ot = (float*)lds;
    LDS_BARRIER();
#pragma unroll
    for (int rb = 0; rb < 4; ++rb)
#pragma unroll
        for (int r = 0; r < 4; ++r) Ot[(16 * rb + 4 * q + r) * G3_OS + 16 * wid + vl] = ot[rb][r];
    LDS_BARRIER();
#pragma unroll
    for (int n = 0; n < 2; ++n) { const int item = tid + 512 * n, tok = item >> 4, c8 = (item & 15) * 8;
        const f32x4 o0 = *(const f32x4*)(Ot + tok * G3_OS + c8), o1 = *(const f32x4*)(Ot + tok * G3_OS + c8 + 4);
        float ss = (o0[0] * o0[0] + o0[1] * o0[1]) + (o0[2] * o0[2] + o0[3] * o0[3]) + (o1[0] * o1[0] + o1[1] * o1[1]) + (o1[2] * o1[2] + o1[3] * o1[3]);
#pragma unroll
        for (int of = 1; of < 16; of <<= 1) ss += lane_xor(ss, of, lane);
        const float rstd = __builtin_amdgcn_rsqf(ss * (1.0f / HD) + EPS);
        const size_t row = (size_t)cix * CH + tok; const u32x4 gw = gwv[n];
        float y[8];
#pragma unroll
        for (int e = 0; e < 4; ++e) { const float ga = bflo(gw[e]), gb = bfhi(gw[e]); const float oa = e < 2 ? o0[2 * e] : o1[2 * e - 4], ob = e < 2 ? o0[2 * e + 1] : o1[2 * e - 3];
            const float na = e < 2 ? g0[2 * e] : g1[2 * e - 4], nb = e < 2 ? g0[2 * e + 1] : g1[2 * e - 3];
            y[2 * e] = oa * rstd * na * (ga * __builtin_amdgcn_rcpf(1.0f + __expf(-ga))); y[2 * e + 1] = ob * rstd * nb * (gb * __builtin_amdgcn_rcpf(1.0f + __expf(-gb))); }
        *(u32x4*)(A.Y + row * D_MODEL + 2 * GROUP_W + h * HD + c8) = (u32x4){pk2(y[0], y[1]), pk2(y[2], y[3]), pk2(y[4], y[5]), pk2(y[6], y[7])};
    }
}
__device__ __forceinline__ void g3_phase(const G3Args& A, char* lds, int G, int wg, const int tid) {
    const int c8 = (tid & 15) * 8; const f32x4 g0 = *(const f32x4*)(A.norm_g + c8), g1 = *(const f32x4*)(A.norm_g + c8 + 4);
    for (int t = wg; t < NCHUNK * NH; t += G) g3_task(A, lds, t / NH, t % NH, tid, g0, g1);
}
}

namespace lru {
typedef short bf16x8 __attribute__((ext_vector_type(8)));
typedef float f32x4 __attribute__((ext_vector_type(4)));
typedef unsigned u32x2 __attribute__((ext_vector_type(2)));
typedef unsigned u32x4 __attribute__((ext_vector_type(4)));
constexpr int CH = 64, NCHUNK = M_ALL / CH;
constexpr int US = 129;
constexpr int UBS = 272;
constexpr int L_OFF_U = 0, L_OFF_UB = CH * US * 4, L_LDS = L_OFF_UB + CH * UBS;
constexpr size_t SZ_WBLK = (size_t)LRU_BW * LRU_BW;
struct Bufs { bf16_t* HLOC; bf16_t* ACUM; float* LSUM; float* HIN; };
struct LocalArgs { const bf16_t* P; const float* conv_w; const float* conv_b; const bf16_t* WG;   const float* ba; const float* bx; const float* lam; Bufs B; };

__device__ __forceinline__ unsigned pk2(float lo, float hi) { return (unsigned)f2bf(lo) | ((unsigned)f2bf(hi) << 16); }

struct LocalPre { float wgt[4][8]; float bia[8]; float sp[2][4], bav[2][4], bxv[2][4]; u32x4 xr[5]; };
__device__ __forceinline__ void local_weights(const LocalArgs& A, int nb, int tid, LocalPre& R) {
    const int wid = tid >> 6, lane = tid & 63, q = lane >> 4;
    const int grp = tid & 15, c0 = grp * 8, ch0 = nb * LRU_BW + c0;
#pragma unroll
    for (int j = 0; j < 4; ++j) { const f32x4 w0 = *(const f32x4*)(A.conv_w + j * LRU_W + ch0), w1 = *(const f32x4*)(A.conv_w + j * LRU_W + ch0 + 4);
#pragma unroll
        for (int e = 0; e < 4; ++e) { R.wgt[j][e] = w0[e]; R.wgt[j][4 + e] = w1[e]; } }
    { const f32x4 b0 = *(const f32x4*)(A.conv_b + ch0), b1 = *(const f32x4*)(A.conv_b + ch0 + 4);
#pragma unroll
      for (int e = 0; e < 4; ++e) { R.bia[e] = b0[e]; R.bia[4 + e] = b1[e]; } }
    const int chb = nb * LRU_BW + 16 * wid + 4 * q;
#pragma unroll
    for (int d = 0; d < 2; ++d)
#pragma unroll
        for (int r = 0; r < 4; ++r) { R.sp[d][r] = -LRU_C * softplusf_(-A.lam[d * LRU_W + chb + r]); R.bav[d][r] = A.ba[d * LRU_W + chb + r]; R.bxv[d][r] = A.bx[d * LRU_W + chb + r]; }
}
__device__ __forceinline__ void local_load(const LocalArgs& A, int cix, int nb, int tid, LocalPre& R) {
    const RowInfo r0i = row_info(cix * CH); const int grp = tid & 15, t2 = tid >> 4, ch0 = nb * LRU_BW + grp * 8;
#pragma unroll
    for (int k = 0; k < 5; ++k) { const int tt = r0i.t + 2 * t2 + k - 1;
        R.xr[k] = (tt >= 0 && tt < r0i.T) ? *(const u32x4*)(A.P + (size_t)(r0i.base + tt) * NP + C_LRU_X + ch0) : (u32x4){0u, 0u, 0u, 0u}; }
}
__device__ __forceinline__ void local_task(const LocalArgs& A, char* lds, int cix, int nb, const int tid_in, LocalPre& R, const int ncix, const int nnb, const bool has_next) {
    int tid_ = tid_in; asm volatile("" : "+v"(tid_));
    const int tid = tid_, wid = __builtin_amdgcn_readfirstlane(tid >> 6), lane = tid & 63, q = lane >> 4, tl = lane & 15;
    float* Us = (float*)(lds + L_OFF_U); char* Ub = lds + L_OFF_UB;
    const int row0 = cix * CH; const RowInfo r0i = row_info(row0);
    LDS_BARRIER();
    {
        const int grp = tid & 15, t2 = tid >> 4, c0 = grp * 8;
#pragma unroll
        for (int i = 0; i < 2; ++i) { float acc[8];
#pragma unroll
            for (int e = 0; e < 8; ++e) acc[e] = R.bia[e];
#pragma unroll
            for (int j = 0; j < 4; ++j) { const u32x4 xv = R.xr[i + j];
#pragma unroll
                for (int e = 0; e < 4; ++e) { acc[2 * e] += R.wgt[j][2 * e] * bflo(xv[e]); acc[2 * e + 1] += R.wgt[j][2 * e + 1] * bfhi(xv[e]); } }
            const int tok = 2 * t2 + i;
#pragma unroll
            for (int e = 0; e < 8; ++e) Us[tok * US + c0 + e] = acc[e];
            *(u32x4*)(Ub + tok * UBS + c0 * 2) = (u32x4){pk2(acc[0], acc[1]), pk2(acc[2], acc[3]), pk2(acc[4], acc[5]), pk2(acc[6], acc[7])}; }
    }
    LDS_BARRIER();
    f32x4 acc[2][2][4];
#pragma unroll
    for (int d = 0; d < 2; ++d)
#pragma unroll
        for (int wh = 0; wh < 2; ++wh)
#pragma unroll
            for (int tb = 0; tb < 4; ++tb) acc[d][wh][tb] = (f32x4){0.f, 0.f, 0.f, 0.f};
#pragma unroll
    for (int s = 0; s < 4; ++s) {
        bf16x8 bfr[4];
#pragma unroll
        for (int tb = 0; tb < 4; ++tb) bfr[tb] = *(const bf16x8*)(Ub + (16 * tb + tl) * UBS + (32 * s + 8 * q) * 2);
#pragma unroll
        for (int d = 0; d < 2; ++d)
#pragma unroll
            for (int wh = 0; wh < 2; ++wh) { const bf16x8 a = *(const bf16x8*)(A.WG + ((size_t)((d * 2 + wh) * NH + nb)) * SZ_WBLK + (size_t)(16 * wid + tl) * LRU_BW + 32 * s + 8 * q);
#pragma unroll
                for (int tb = 0; tb < 4; ++tb) acc[d][wh][tb] = __builtin_amdgcn_mfma_f32_16x16x32_bf16(a, bfr[tb], acc[d][wh][tb], 0, 0, 0); }
    }
    if (has_next) local_load(A, ncix, nnb, tid, R);
    const int chb = nb * LRU_BW + 16 * wid + 4 * q;
#pragma unroll
    for (int d = 0; d < 2; ++d) {
        float sp[4], bav[4], bxv[4];
#pragma unroll
        for (int r = 0; r < 4; ++r) { sp[r] = R.sp[d][r]; bav[r] = R.bav[d][r]; bxv[r] = R.bxv[d][r]; }
        float Ac[4], Bc[4];
#pragma unroll
        for (int r = 0; r < 4; ++r) { Ac[r] = 1.f; Bc[r] = 0.f; }
#pragma unroll
        for (int tbi = 0; tbi < 4; ++tbi) { const int tb = d == 0 ? tbi : 3 - tbi; const int tok = 16 * tb + tl;
            float a[4], b[4];
#pragma unroll
            for (int r = 0; r < 4; ++r) { const float rr = __builtin_amdgcn_rcpf(1.0f + __expf(-(acc[d][0][tb][r] + bav[r]))), ii = __builtin_amdgcn_rcpf(1.0f + __expf(-(acc[d][1][tb][r] + bxv[r])));
                const float log_a = sp[r] * rr, x2 = 2.0f * log_a; a[r] = __expf(log_a);
                float em = 1.0f + x2 * (1.0f / 6.0f); em = 1.0f + x2 * 0.2f * em; em = 1.0f + x2 * 0.25f * em; em = 1.0f + x2 * (1.0f / 3.0f) * em; em = 1.0f + x2 * 0.5f * em; em = -x2 * em;
                if (__builtin_expect(x2 < -0.25f, 0)) em = -expm1f(x2);
                b[r] = __builtin_amdgcn_sqrtf(em) * ii * Us[tok * US + 16 * wid + 4 * q + r]; }
#define LRU_SCAN_STEP(CTRL) do { _Pragma("unroll") for (int r = 0; r < 4; ++r) { \
                const float ap = __int_as_float(__builtin_amdgcn_update_dpp(0x3f800000, __float_as_int(a[r]), (CTRL), 0xf, 0xf, false)); \
                const float bp = __int_as_float(__builtin_amdgcn_update_dpp(0, __float_as_int(b[r]), (CTRL), 0xf, 0xf, false)); \
                b[r] = a[r] * bp + b[r]; a[r] = a[r] * ap; } } while (0)
            if (d == 0) { LRU_SCAN_STEP(0x111); LRU_SCAN_STEP(0x112); LRU_SCAN_STEP(0x114); LRU_SCAN_STEP(0x118); }
            else        { LRU_SCAN_STEP(0x101); LRU_SCAN_STEP(0x102); LRU_SCAN_STEP(0x104); LRU_SCAN_STEP(0x108); }
#undef LRU_SCAN_STEP
#pragma unroll
            for (int r = 0; r < 4; ++r) { b[r] = a[r] * Bc[r] + b[r]; a[r] = a[r] * Ac[r]; }
            { const size_t o = ((size_t)d * M_ALL + row0 + tok) * LRU_W + chb;
              *(u32x2*)(A.B.HLOC + o) = (u32x2){pk2(b[0], b[1]), pk2(b[2], b[3])}; *(u32x2*)(A.B.ACUM + o) = (u32x2){pk2(a[0], a[1]), pk2(a[2], a[3])}; }
#pragma unroll
            for (int r = 0; r < 4; ++r) { const int sl = (lane & ~15) | (d == 0 ? 15 : 0); Ac[r] = lane_get(a[r], sl); Bc[r] = lane_get(b[r], sl); }
        }
        if (tl == 0) { float* ls = A.B.LSUM + (((size_t)cix * 2 + d) * 2) * LRU_W + chb;
            *(f32x4*)ls = (f32x4){Ac[0], Ac[1], Ac[2], Ac[3]}; *(f32x4*)(ls + LRU_W) = (f32x4){Bc[0], Bc[1], Bc[2], Bc[3]}; }
    }
    if (has_next && nnb != nb) local_weights(A, nnb, tid, R);
}
__device__ __forceinline__ void local_phase(const LocalArgs& A, char* lds, int G, int wg, const int tid) {
    constexpr int NT = NCHUNK * NH;
    int j0 = wg; if (j0 < NT) j0 += (NT - j0 + G - 1) / G * G;
    if (j0 >= 2 * NT) return;
    LocalPre R; { const int t = j0 - NT; local_weights(A, t % NH, tid, R); local_load(A, t / NH, t % NH, tid, R); }
    for (int j = j0; j < 2 * NT; j += G) { const int t = j - NT, tn = t + G; local_task(A, lds, t / NH, t % NH, tid, R, tn / NH, tn % NH, tn < NT); }
}
__device__ __forceinline__ void carry_phase(const Bufs& B, int gtid, int gthreads) {
    constexpr int NC = CTX_LEN / CH, NL = SEQ / CH;
    for (int i = gtid; i < BATCH * 2 * LRU_W; i += gthreads) { const int ch = i % LRU_W, d = (i / LRU_W) & 1, b = i / (2 * LRU_W);
        float h = 0.f;
        for (int s0 = 0; s0 < NC + NL; s0 += 12) {
            float av[12], bv[12]; int cx[12];
#pragma unroll
            for (int u = 0; u < 12; ++u) { const int step = s0 + u; int cix = 0;
                if (step < NC) { const int n = d ? NC - 1 - step : step; cix = M_LAT / CH + b * NC + n; }
                else if (step < NC + NL) { const int s2 = step - NC, n = d ? NL - 1 - s2 : s2; cix = b * NL + n; }
                cx[u] = cix; const float* ls = B.LSUM + (((size_t)cix * 2 + d) * 2) * LRU_W + ch; av[u] = ls[0]; bv[u] = ls[LRU_W]; }
#pragma unroll
            for (int u = 0; u < 12; ++u) if (s0 + u < NC + NL) { B.HIN[((size_t)cx[u] * 2 + d) * LRU_W + ch] = h; h = av[u] * h + bv[u]; }
        }
    }
}
__device__ __forceinline__ void finish_phase(const Bufs& B, const bf16_t* P, bf16_t* Y, int gtid, int gthreads) {
    for (int it = gtid; it < M_ALL * (LRU_W / 8); it += gthreads) { const int row = it / (LRU_W / 8), c0 = (it % (LRU_W / 8)) * 8, cix = row / CH;
        const u32x4 h0 = *(const u32x4*)(B.HLOC + (size_t)row * LRU_W + c0), a0 = *(const u32x4*)(B.ACUM + (size_t)row * LRU_W + c0);
        const u32x4 h1 = *(const u32x4*)(B.HLOC + ((size_t)M_ALL + row) * LRU_W + c0), a1 = *(const u32x4*)(B.ACUM + ((size_t)M_ALL + row) * LRU_W + c0);
        const u32x4 gt = *(const u32x4*)(P + (size_t)row * NP + C_LRU_G + c0);
        const float* i0 = B.HIN + ((size_t)cix * 2 + 0) * LRU_W + c0; const float* i1 = B.HIN + ((size_t)cix * 2 + 1) * LRU_W + c0;
        const f32x4 i0a = *(const f32x4*)i0, i0b = *(const f32x4*)(i0 + 4), i1a = *(const f32x4*)i1, i1b = *(const f32x4*)(i1 + 4);
        float y[8];
#pragma unroll
        for (int j = 0; j < 4; ++j) { const unsigned hw0 = h0[j], aw0 = a0[j], hw1 = h1[j], aw1 = a1[j], gw = gt[j];
            const float in0l = j < 2 ? i0a[2 * j] : i0b[2 * j - 4], in0h = j < 2 ? i0a[2 * j + 1] : i0b[2 * j - 3], in1l = j < 2 ? i1a[2 * j] : i1b[2 * j - 4], in1h = j < 2 ? i1a[2 * j + 1] : i1b[2 * j - 3];
            y[2 * j] = (bflo(hw0) + bflo(aw0) * in0l + bflo(hw1) + bflo(aw1) * in1l) * geluf_(bflo(gw));
            y[2 * j + 1] = (bfhi(hw0) + bfhi(aw0) * in0h + bfhi(hw1) + bfhi(aw1) * in1h) * geluf_(bfhi(gw)); }
        *(u32x4*)(Y + (size_t)row * D_MODEL + c0) = (u32x4){pk2(y[0], y[1]), pk2(y[2], y[3]), pk2(y[4], y[5]), pk2(y[6], y[7])};
    }
}
}

namespace misc {
typedef float f32x4 __attribute__((ext_vector_type(4)));
typedef unsigned u32x2 __attribute__((ext_vector_type(2)));
typedef unsigned u32x4 __attribute__((ext_vector_type(4)));
__device__ __forceinline__ unsigned pk2(float lo, float hi) { return (unsigned)f2bf(lo) | ((unsigned)f2bf(hi) << 16); }
__device__ __forceinline__ float wave_sum(float v, int lane) {
#pragma unroll
    for (int o = 1; o < 64; o <<= 1) v += lane_xor(v, o, lane);
    return v;
}
__device__ __forceinline__ float sum16(float v, int lane) {
#pragma unroll
    for (int o = 1; o < 16; o <<= 1) v += lane_xor(v, o, lane);
    return v;
}
__device__ __forceinline__ void norm_phase(float* H, const float* g, const float* MODl, int sh_idx, bf16_t* U, int nrows, int gwave, int nwaves, int lane,
                                           const float* PART, int nparts, const float* pgate, const float* xin, const float* cin) {
    static_assert(D_MODEL == 2048, "norm_phase geometry");
    int cset = -1; f32x4 gsv[8], shv[8];
    for (int r = gwave; r < nrows; r += nwaves) {
        const int set = r < M_LAT ? r / SEQ : BATCH;
        if (set != cset) { cset = set; const f32x4* gp = (const f32x4*)g + lane; const f32x4* shp = (const f32x4*)(MODl + (size_t)set * NMODV + (size_t)sh_idx * D_MODEL) + lane; const f32x4* scp = shp + D_MODEL / 4;
#pragma unroll
            for (int j = 0; j < 8; ++j) { gsv[j] = gp[64 * j] * (scp[64 * j] + 1.0f); shv[j] = shp[64 * j]; } }
        f32x4* hr = (f32x4*)(H + (size_t)r * D_MODEL) + lane;
        const f32x4* src = xin == nullptr ? hr : (r < M_LAT ? (const f32x4*)(xin + (size_t)r * D_MODEL) + lane : (const f32x4*)(cin + (size_t)(r - M_LAT) * D_MODEL) + lane);
        f32x4 v[8]; float ss = 0.f;
#pragma unroll
        for (int j = 0; j < 8; ++j) v[j] = src[64 * j];
        if (xin != nullptr && r >= M_LAT) {
#pragma unroll
            for (int j = 0; j < 8; ++j) hr[64 * j] = v[j]; }
        if (PART != nullptr && r >= M_LAT) {
            const f32x4* gp = (const f32x4*)pgate + lane;
#pragma unroll
            for (int j = 0; j < 8; ++j) { f32x4 acc = {0.f, 0.f, 0.f, 0.f};
                for (int s = 0; s < nparts; ++s) acc += *((const f32x4*)(PART + ((size_t)s * M_CTX + (r - M_LAT)) * D_MODEL) + lane + 64 * j);
                v[j] += gp[64 * j] * acc; hr[64 * j] = v[j]; }
        }
#pragma unroll
        for (int j = 0; j < 8; ++j) ss += (v[j][0] * v[j][0] + v[j][1] * v[j][1]) + (v[j][2] * v[j][2] + v[j][3] * v[j][3]);
        const float rstd = __builtin_amdgcn_rsqf(wave_sum(ss, lane) * (1.0f / D_MODEL) + EPS);
        u32x2* o = (u32x2*)(U + (size_t)r * D_MODEL) + lane;
#pragma unroll
        for (int j = 0; j < 8; ++j) { const f32x4 y = v[j] * rstd * gsv[j] + shv[j];
            o[64 * j] = (u32x2){pk2(y[0], y[1]), pk2(y[2], y[3])}; }
    }
}
struct RowNormArgs { const bf16_t* P; const float *qa_g, *kva_g, *na_qn_g, *na_kn_g; bf16_t *CQN, *CKVN, *NQ, *NK; };
__device__ __forceinline__ void rownorm_phase(const RowNormArgs& A, int gwave, int nwaves, int lane) {
    static_assert(MLA_Q_LORA == 384 && MLA_KV_LORA == 256 && GROUP_W == 512 && HD == 128, "rownorm geometry");
    float gq[6], gkv[4], gnq[8], gnk[8];
#pragma unroll
    for (int j = 0; j < 3; ++j) { gq[2 * j] = A.qa_g[2 * lane + 128 * j]; gq[2 * j + 1] = A.qa_g[2 * lane + 128 * j + 1]; }
#pragma unroll
    for (int j = 0; j < 2; ++j) { gkv[2 * j] = A.kva_g[2 * lane + 128 * j]; gkv[2 * j + 1] = A.kva_g[2 * lane + 128 * j + 1]; }
#pragma unroll
    for (int j = 0; j < 8; ++j) { gnq[j] = A.na_qn_g[(lane & 15) * 8 + j]; gnk[j] = A.na_kn_g[(lane & 15) * 8 + j]; }
    for (int r = gwave; r < M_ALL; r += nwaves) { const bf16_t* p = A.P + (size_t)r * NP;
        { float x[6], ss = 0.f;
#pragma unroll
          for (int j = 0; j < 3; ++j) { const unsigned w = *(const unsigned*)(p + C_CQ + 2 * lane + 128 * j); x[2 * j] = bflo(w); x[2 * j + 1] = bfhi(w); ss += x[2 * j] * x[2 * j] + x[2 * j + 1] * x[2 * j + 1]; }
          const float rstd = 1.0f / sqrtf(wave_sum(ss, lane) * (1.0f / MLA_Q_LORA) + EPS);
#pragma unroll
          for (int j = 0; j < 3; ++j) { const int c = 2 * lane + 128 * j; *(unsigned*)(A.CQN + (size_t)r * MLA_Q_LORA + c) = pk2(x[2 * j] * rstd * gq[2 * j], x[2 * j + 1] * rstd * gq[2 * j + 1]); } }
        { float x[4], ss = 0.f;
#pragma unroll
          for (int j = 0; j < 2; ++j) { const unsigned w = *(const unsigned*)(p + C_CKV + 2 * lane + 128 * j); x[2 * j] = bflo(w); x[2 * j + 1] = bfhi(w); ss += x[2 * j] * x[2 * j] + x[2 * j + 1] * x[2 * j + 1]; }
          const float rstd = 1.0f / sqrtf(wave_sum(ss, lane) * (1.0f / MLA_KV_LORA) + EPS);
#pragma unroll
          for (int j = 0; j < 2; ++j) { const int c = 2 * lane + 128 * j; *(unsigned*)(A.CKVN + (size_t)r * MLA_KV_LORA + c) = pk2(x[2 * j] * rstd * gkv[2 * j], x[2 * j + 1] * rstd * gkv[2 * j + 1]); } }
#pragma unroll
        for (int which = 0; which < 2; ++which) {
            const int hh = lane >> 4, d0 = (lane & 15) * 8; const u32x4 w = *(const u32x4*)(p + (which == 0 ? C_NQ : C_NK) + hh * HD + d0);
            float x[8]; float ss = 0.f;
#pragma unroll
            for (int j = 0; j < 4; ++j) { x[2 * j] = bflo(w[j]); x[2 * j + 1] = bfhi(w[j]); ss += x[2 * j] * x[2 * j] + x[2 * j + 1] * x[2 * j + 1]; }
            const float rstd = __builtin_amdgcn_rsqf(sum16(ss, lane) * (1.0f / HD) + EPS); const float* g = which == 0 ? gnq : gnk;
            *(u32x4*)((which == 0 ? A.NQ : A.NK) + (size_t)r * GROUP_W + hh * HD + d0) =
                (u32x4){pk2(x[0] * rstd * g[0], x[1] * rstd * g[1]), pk2(x[2] * rstd * g[2], x[3] * rstd * g[3]), pk2(x[4] * rstd * g[4], x[5] * rstd * g[5]), pk2(x[6] * rstd * g[6], x[7] * rstd * g[7])};
        }
    }
}
struct MlaQkvArgs { const bf16_t* QR; const bf16_t* KVR; const bf16_t* P; const float *qn_g, *kn_g; bf16_t *QM, *KM, *VM; };
__device__ __forceinline__ void mlaqkv_phase(const MlaQkvArgs& A, int gwave, int nwaves, int lane) {
    static_assert(MLA_QK == 192 && MLA_NOPE == 128 && MLA_ROPE == 64 && NH == 4 && GRID_W == 64, "mla qkv geometry");
    const int hh = lane >> 4, g = lane & 15;
    const int f0 = (2 * g) & 15; const float inv0 = powf(10000.0f, -(float)f0 / 16.0f), inv1 = powf(10000.0f, -(float)(f0 + 1) / 16.0f);
    f32x4 gq0 = *(const f32x4*)(A.qn_g + 8 * g), gq1 = *(const f32x4*)(A.qn_g + 8 * g + 4), gk0 = *(const f32x4*)(A.kn_g + 8 * g), gk1 = *(const f32x4*)(A.kn_g + 8 * g + 4);
    const float gqr[4] = {A.qn_g[MLA_NOPE + 2 * g], A.qn_g[MLA_NOPE + 2 * g + 1], A.qn_g[MLA_NOPE + 32 + 2 * g], A.qn_g[MLA_NOPE + 32 + 2 * g + 1]};
    const float gkr[4] = {A.kn_g[MLA_NOPE + 2 * g], A.kn_g[MLA_NOPE + 2 * g + 1], A.kn_g[MLA_NOPE + 32 + 2 * g], A.kn_g[MLA_NOPE + 32 + 2 * g + 1]};
    for (int r = gwave; r < M_ALL; r += nwaves) {
        const bool lat = r < M_LAT; const int t = lat ? r % SEQ : 0; const float pos = g < 8 ? (float)(t / GRID_W) : (float)(t % GRID_W);
        float c0 = 1.f, s0 = 0.f, c1 = 1.f, s1 = 0.f;
        if (lat) { sincosf(pos * inv0, &s0, &c0); sincosf(pos * inv1, &s1, &c1); }
#pragma unroll
        for (int which = 0; which < 2; ++which) {
            const bf16_t* nsrc = which == 0 ? A.QR + (size_t)r * NQ_MLA + hh * MLA_QK : A.KVR + (size_t)r * NKV_MLA + hh * (MLA_NOPE + MLA_V);
            const bf16_t* rsrc = which == 0 ? nsrc + MLA_NOPE : A.P + (size_t)r * NP + C_KR;
            const u32x4 nw = *(const u32x4*)(nsrc + 8 * g); const unsigned ra = *(const unsigned*)(rsrc + 2 * g), rb = *(const unsigned*)(rsrc + 32 + 2 * g);
            float x[8], a0 = bflo(ra), a1 = bfhi(ra), b0 = bflo(rb), b1 = bfhi(rb);
            float ss = a0 * a0 + a1 * a1 + b0 * b0 + b1 * b1;
#pragma unroll
            for (int j = 0; j < 4; ++j) { x[2 * j] = bflo(nw[j]); x[2 * j + 1] = bfhi(nw[j]); ss += x[2 * j] * x[2 * j] + x[2 * j + 1] * x[2 * j + 1]; }
            const float rstd = __builtin_amdgcn_rsqf(sum16(ss, lane) * (1.0f / MLA_QK) + EPS);
            const f32x4 g0 = which == 0 ? gq0 : gk0, g1 = which == 0 ? gq1 : gk1;
#pragma unroll
            for (int j = 0; j < 4; ++j) { x[j] *= rstd * g0[j]; x[4 + j] *= rstd * g1[j]; }
            a0 *= rstd * (which == 0 ? gqr[0] : gkr[0]); a1 *= rstd * (which == 0 ? gqr[1] : gkr[1]); b0 *= rstd * (which == 0 ? gqr[2] : gkr[2]); b1 *= rstd * (which == 0 ? gqr[3] : gkr[3]);
            const float ya0 = a0 * c0 - b0 * s0, yb0 = a0 * s0 + b0 * c0, ya1 = a1 * c1 - b1 * s1, yb1 = a1 * s1 + b1 * c1;
            bf16_t* O = (which == 0 ? A.QM : A.KM) + (size_t)r * NQ_MLA + hh * MLA_QK;
            *(u32x4*)(O + 8 * g) = (u32x4){pk2(x[0], x[1]), pk2(x[2], x[3]), pk2(x[4], x[5]), pk2(x[6], x[7])};
            *(unsigned*)(O + MLA_NOPE + 2 * g) = pk2(ya0, ya1); *(unsigned*)(O + MLA_NOPE + 32 + 2 * g) = pk2(yb0, yb1);
        }
        *(u32x4*)(A.VM + (size_t)r * (NH * MLA_V) + hh * MLA_V + 8 * g) = *(const u32x4*)(A.KVR + (size_t)r * NKV_MLA + hh * (MLA_NOPE + MLA_V) + MLA_NOPE + 8 * g);
    }
}
constexpr int ACT_RUN = 32;
__device__ __forceinline__ void act_phase(const bf16_t* UP, const float* cw, const float* cb, bf16_t* ACT, int nrows, int gtid, int gthreads) {
    constexpr int NC8 = D_FF / 8; static_assert(SEQ % ACT_RUN == 0 && CTX_LEN % ACT_RUN == 0, "row runs stay inside one sequence");
    const int nruns = nrows / ACT_RUN;
    for (long it = gtid; it < (long)nruns * NC8; it += gthreads) { const int run = (int)(it / NC8), j0 = (int)(it % NC8) * 8, r0 = run * ACT_RUN; const RowInfo ri = row_info(r0);
        float wa[3][8], wg[3][8], ba[8], bg[8];
#pragma unroll
        for (int k = 0; k < 3; ++k) { const float* p = cw + (size_t)k * 2 * D_FF + j0; const f32x4 a0 = *(const f32x4*)p, a1 = *(const f32x4*)(p + 4), g0 = *(const f32x4*)(p + D_FF), g1 = *(const f32x4*)(p + D_FF + 4);
#pragma unroll
            for (int e = 0; e < 4; ++e) { wa[k][e] = a0[e]; wa[k][4 + e] = a1[e]; wg[k][e] = g0[e]; wg[k][4 + e] = g1[e]; } }
        { const f32x4 a0 = *(const f32x4*)(cb + j0), a1 = *(const f32x4*)(cb + j0 + 4), g0 = *(const f32x4*)(cb + D_FF + j0), g1 = *(const f32x4*)(cb + D_FF + j0 + 4);
#pragma unroll
          for (int e = 0; e < 4; ++e) { ba[e] = a0[e]; ba[4 + e] = a1[e]; bg[e] = g0[e]; bg[4 + e] = g1[e]; } }
        const u32x4 zero = {0u, 0u, 0u, 0u};
        const bf16_t* ub = UP + (size_t)ri.base * (2 * D_FF) + j0;
        u32x4 am, ac, gm, gc;
        { const int t = ri.t; am = t > 0 ? *(const u32x4*)(ub + (size_t)(t - 1) * (2 * D_FF)) : zero; gm = t > 0 ? *(const u32x4*)(ub + (size_t)(t - 1) * (2 * D_FF) + D_FF) : zero;
          ac = *(const u32x4*)(ub + (size_t)t * (2 * D_FF)); gc = *(const u32x4*)(ub + (size_t)t * (2 * D_FF) + D_FF); }
#pragma unroll 4
        for (int i = 0; i < ACT_RUN; ++i) { const int t = ri.t + i;
            const u32x4 ap = t + 1 < ri.T ? *(const u32x4*)(ub + (size_t)(t + 1) * (2 * D_FF)) : zero, gp = t + 1 < ri.T ? *(const u32x4*)(ub + (size_t)(t + 1) * (2 * D_FF) + D_FF) : zero;
            float y[8];
#pragma unroll
            for (int e = 0; e < 4; ++e) {
                const float a0 = ba[2 * e] + wa[0][2 * e] * bflo(am[e]) + wa[1][2 * e] * bflo(ac[e]) + wa[2][2 * e] * bflo(ap[e]);
                const float a1 = ba[2 * e + 1] + wa[0][2 * e + 1] * bfhi(am[e]) + wa[1][2 * e + 1] * bfhi(ac[e]) + wa[2][2 * e + 1] * bfhi(ap[e]);
                const float g0 = bg[2 * e] + wg[0][2 * e] * bflo(gm[e]) + wg[1][2 * e] * bflo(gc[e]) + wg[2][2 * e] * bflo(gp[e]);
                const float g1 = bg[2 * e + 1] + wg[0][2 * e + 1] * bfhi(gm[e]) + wg[1][2 * e + 1] * bfhi(gc[e]) + wg[2][2 * e + 1] * bfhi(gp[e]);
                y[2 * e] = a0 * (g0 / (1.0f + __expf(-g0))); y[2 * e + 1] = a1 * (g1 / (1.0f + __expf(-g1))); }
            *(u32x4*)(ACT + (size_t)(r0 + i) * D_FF + j0) = (u32x4){pk2(y[0], y[1]), pk2(y[2], y[3]), pk2(y[4], y[5]), pk2(y[6], y[7])};
            am = ac; ac = ap; gm = gc; gc = gp; }
    }
}
__device__ __forceinline__ void act_fix_phase(const bf16_t* HALO, const float* cw, const float* cb, bf16_t* ACT, int nrows, int gtid, int gthreads) {
    constexpr int NC8 = D_FF / 8; const int nblk = nrows / 64;
    for (long it = gtid; it < (long)nblk * 2 * NC8; it += gthreads) { const int j0 = (int)(it % NC8) * 8, be = (int)(it / NC8), blk = be >> 1, edge = be & 1; const int row = blk * 64 + (edge ? 63 : 0);
        const RowInfo ri = row_info(row);
        const bf16_t* hb = HALO + (size_t)blk * 4 * (2 * D_FF) + j0;
        const bool has_prev = ri.t > 0, has_next = ri.t + 1 < ri.T; const u32x4 zero = {0u, 0u, 0u, 0u};
        const bf16_t* pc = hb + (size_t)(edge ? 3 : 0) * (2 * D_FF);
        const bf16_t* pp_ = edge ? hb + (size_t)2 * (2 * D_FF) : hb - (size_t)4 * (2 * D_FF) + (size_t)3 * (2 * D_FF);
        const bf16_t* pn = edge ? hb + (size_t)4 * (2 * D_FF) : hb + (size_t)1 * (2 * D_FF);
        const u32x4 ac = *(const u32x4*)pc, gc = *(const u32x4*)(pc + D_FF);
        const u32x4 am = has_prev ? *(const u32x4*)pp_ : zero, gm = has_prev ? *(const u32x4*)(pp_ + D_FF) : zero;
        const u32x4 ap = has_next ? *(const u32x4*)pn : zero, gp = has_next ? *(const u32x4*)(pn + D_FF) : zero;
        float y[8];
#pragma unroll
        for (int e = 0; e < 4; ++e) {
#pragma unroll
            for (int hh = 0; hh < 2; ++hh) { const int c = j0 + 2 * e + hh;
                const float xam = hh ? bfhi(am[e]) : bflo(am[e]), xac = hh ? bfhi(ac[e]) : bflo(ac[e]), xap = hh ? bfhi(ap[e]) : bflo(ap[e]);
                const float xgm = hh ? bfhi(gm[e]) : bflo(gm[e]), xgc = hh ? bfhi(gc[e]) : bflo(gc[e]), xgp = hh ? bfhi(gp[e]) : bflo(gp[e]);
                const float a = cb[c] + cw[c] * xam + cw[2 * D_FF + c] * xac + cw[4 * D_FF + c] * xap;
                const float g = cb[D_FF + c] + cw[D_FF + c] * xgm + cw[2 * D_FF + D_FF + c] * xgc + cw[4 * D_FF + D_FF + c] * xgp;
                y[2 * e + hh] = a * (g * __builtin_amdgcn_rcpf(1.0f + __expf(-g))); } }
        *(u32x4*)(ACT + (size_t)row * D_FF + j0) = (u32x4){pk2(y[0], y[1]), pk2(y[2], y[3]), pk2(y[4], y[5]), pk2(y[6], y[7])};
    }
}
__device__ __forceinline__ void transpose_item(const float* W, int K, int N, int Npad, bf16_t* WT, float* scr  , int item, int lane, int pairF = 0) {
    const int nblk = Npad / 64, kb = item / nblk, nb = item % nblk, k0 = 64 * kb, n0 = 64 * nb; const int nq = lane & 15, kq = lane >> 4, n = n0 + 4 * nq; const bool ok = n < N;
    f32x4 v[16];
#pragma unroll
    for (int i = 0; i < 16; ++i) v[i] = ok ? *(const f32x4*)(W + (size_t)(k0 + 4 * i + kq) * N + n) : (f32x4){0.f, 0.f, 0.f, 0.f};
#pragma unroll
    for (int i = 0; i < 16; ++i)
#pragma unroll
        for (int e = 0; e < 4; ++e) scr[(4 * nq + e) * 65 + 4 * i + kq] = v[i][e];
    asm volatile("s_waitcnt lgkmcnt(0)" ::: "memory");
    const int c = lane & 7;
#pragma unroll
    for (int j = 0; j < 8; ++j) { const int nn = (lane >> 3) + 8 * j; const float* s = scr + nn * 65 + 8 * c;
        u32x4 o; o.x = pk2(s[0], s[1]); o.y = pk2(s[2], s[3]); o.z = pk2(s[4], s[5]); o.w = pk2(s[6], s[7]);
        const int nsrc = n0 + nn; const int nd = pairF == 0 ? nsrc : (nsrc < pairF ? (nsrc >> 7) * 256 + (nsrc & 127) : ((nsrc - pairF) >> 7) * 256 + 128 + ((nsrc - pairF) & 127));
        *(u32x4*)(WT + (size_t)nd * K + k0 + 8 * c) = o; }
    asm volatile("s_waitcnt lgkmcnt(0)" ::: "memory");
}
}

__device__ __forceinline__ gdn::Bufs gdn_bufs(const WS& w, int l) { gdn::Bufs B; B.UT = w.gUT; B.WP = w.gWP; B.KDT = w.gKDT; B.QD = w.gQD; B.QK = w.gQK; B.SIT = w.gSIT; B.VNT = w.gVNT; B.GT = w.gGT + (size_t)l * gdn::NTASK; return B; }
__device__ __forceinline__ lru::Bufs lru_bufs(const WS& w) { lru::Bufs B; B.HLOC = w.lHLOC; B.ACUM = w.lACUM; B.LSUM = w.lLSUM; B.HIN = w.lHIN; return B; }

#define LAS __attribute__((address_space(3)))
#define XB_TMO      128
#define XB_XCNT(j)  (256  + 64 * (j))
#define XB_XSUB(j)  (1280 + 64 * (j))
#define XB_XGEN(j)  (2304 + 64 * (j))
#define XB_TOP      3328
#define XB_TOPGEN   3392
#define XCD_BAR_WORDS 3456
#define XB_SPIN_CAP (1u << 18)
__device__ __forceinline__ unsigned xb_ld(unsigned* p)              { return __hip_atomic_load(p, __ATOMIC_RELAXED, __HIP_MEMORY_SCOPE_AGENT); }
__device__ __forceinline__ unsigned xb_add(unsigned* p, unsigned v) { return __hip_atomic_fetch_add(p, v, __ATOMIC_RELAXED, __HIP_MEMORY_SCOPE_AGENT); }
__device__ __forceinline__ unsigned xb_xcc_id() { return (unsigned)__builtin_amdgcn_s_getreg((3 << 11) | 20) & 0xFu; }
#define XB_SPIN(cond, bar) do { unsigned _sp = 0; while (cond) { __builtin_amdgcn_s_sleep(1); \
    if ((++_sp & 255u) == 0u) { if (xb_ld(&(bar)[XB_TMO])) break; if (_sp > XB_SPIN_CAP) { atomicAdd(&(bar)[XB_TMO], 1u); break; } } } } while (0)
struct XcdBarrier { unsigned* bar; unsigned x; volatile LAS unsigned* st; };
__device__ __forceinline__ XcdBarrier xcd_barrier_post(unsigned* bar, volatile LAS unsigned* st, const bool leader) {
    XcdBarrier b; b.bar = bar; b.x = xb_xcc_id(); b.st = st;
    if (leader) (void)xb_add(&bar[XB_XCNT(b.x)], 1u);
    return b;
}
__device__ __forceinline__ void xcd_barrier_complete(unsigned* bar, unsigned x, unsigned& nloc, unsigned& nx) {
    const unsigned G = gridDim.x * gridDim.y * gridDim.z;
    unsigned sum, cnt, mine, sp = 0u;
    for (;;) {
        sum = 0u; cnt = 0u; mine = 0u;
#pragma unroll
        for (unsigned j = 0; j < 16; ++j) { const unsigned c = xb_ld(&bar[XB_XCNT(j)]); sum += c; cnt += (c > 0u) ? 1u : 0u; mine = (j == x) ? c : mine; }
        if (sum == G) break;
        __builtin_amdgcn_s_sleep(1);
        if ((++sp & 255u) == 0u) { if (xb_ld(&bar[XB_TMO])) break; if (sp > XB_SPIN_CAP) { atomicAdd(&bar[XB_TMO], 1u); break; } }
    }
    nloc = mine > 0u ? mine : 1u; nx = cnt > 0u ? cnt : 1u;
}
__device__ __forceinline__ void xcd_barrier(const XcdBarrier& b, const bool leader) {
    asm volatile("s_waitcnt vmcnt(0)" ::: "memory");
    __syncthreads();
    if (leader) {
        unsigned* bar = b.bar;
        __builtin_amdgcn_s_waitcnt(0);
        unsigned nloc = b.st[0], nx = b.st[1];
        if (nloc == 0u) { xcd_barrier_complete(bar, b.x, nloc, nx); b.st[0] = nloc; b.st[1] = nx; }
        const unsigned old = xb_add(&bar[XB_XSUB(b.x)], 1u);
        const unsigned gen = old / nloc;
        if (old + 1u == (gen + 1u) * nloc) {
            __builtin_amdgcn_fence(__ATOMIC_RELEASE, "agent");
            asm volatile("s_waitcnt vmcnt(0)" ::: "memory");
            const unsigned og = xb_add(&bar[XB_TOP], 1u);
            const unsigned tg = og / nx;
            if (og + 1u == (tg + 1u) * nx) xb_add(&bar[XB_TOPGEN], 1u);
            else XB_SPIN(xb_ld(&bar[XB_TOPGEN]) == tg, bar);
            __builtin_amdgcn_fence(__ATOMIC_ACQUIRE, "agent");
            xb_add(&bar[XB_XGEN(b.x)], 1u);
            asm volatile("s_waitcnt vmcnt(0)" ::: "memory");
        } else {
            XB_SPIN(xb_ld(&bar[XB_XGEN(b.x)]) == gen, bar);
            __builtin_amdgcn_fence(__ATOMIC_ACQUIRE, "agent");
            asm volatile("s_waitcnt vmcnt(0)" ::: "memory");
        }
    }
    __syncthreads();
}

constexpr int NWAVES = 8, NTHR = 512;
constexpr int LDS_MISC = 147456, LDS_BYTES = 148480;
static_assert(sizeof(Inputs) == 34 * 8, "Inputs mirrors Params::in");
static_assert(gdn::G1_LDS <= LDS_MISC && pg8::STAGE_BYTES <= LDS_MISC && att::Cfg<MLA_QK>::LDS_BYTES <= LDS_MISC && gdn::G2_LDS <= LDS_MISC, "LDS map");
constexpr int CW_BAR = 4096;
constexpr int G2_CUT1 = 52, G2_CUT2 = 52;
constexpr int SK_OUT = 4, SK_DOWN = 5;
constexpr int PH_PRO = 0, PH_PER_LAYER = 12, NPH = 1 + PH_PER_LAYER * DEPTH;
struct Params { const float* in[34]; float* out; unsigned char* ws; int ph_lo, ph_hi, li, pad; };

struct SplitOrder {
    int nN, nM, S, G, c;
    __device__ __forceinline__ void init(int M, int N, int S_, int G_, int c_) { nM = M / pg8::BM; nN = N / pg8::BM; S = S_; G = G_; c = c_; }
    __device__ __forceinline__ bool next(int i, pg8::Unit& u) const { const int g = c + i * G; if (g >= nM * nN * S) return false; u.ks = g / (nM * nN); const int loc = g % (nM * nN); u.pm = loc / nN; u.pn = loc % nN; return true; }
    __device__ __forceinline__ void a_ready(const pg8::Unit&) const {}
    __device__ __forceinline__ void done(const pg8::Unit&) const {}
};
struct SpanOrder {
    int nN, lo, hi, G, g0;
    __device__ __forceinline__ void init(int N, int lo_, int hi_, int G_, int c) { nN = N / pg8::BM; lo = lo_; hi = hi_; G = G_; int i0 = 0; if (c < lo_) i0 = (lo_ - c + G_ - 1) / G_; g0 = c + i0 * G_; }
    __device__ __forceinline__ bool next(int i, pg8::Unit& u) const { const int g = g0 + i * G; if (g >= hi) return false; const int loc = g - lo; u.pm = loc / nN; u.pn = loc % nN; u.ks = 0; return true; }
    __device__ __forceinline__ void a_ready(const pg8::Unit&) const {}
    __device__ __forceinline__ void done(const pg8::Unit&) const {}
};

#define AS4 __attribute__((address_space(4)))
#define PHASE_WS const AS4 Params* pp = (const AS4 Params*)__builtin_amdgcn_kernarg_segment_ptr(); asm volatile("" : "+s"(pp)); const AS4 Inputs* I = (const AS4 Inputs*)pp; (void)I; unsigned char* wsb_ = pp->ws; const WS w = ws_carve(wsb_)
#define PHASE_IDS int tid = C_wave0 * 64 + (int)__builtin_amdgcn_mbcnt_hi(~0u, __builtin_amdgcn_mbcnt_lo(~0u, 0u)); asm volatile("" : "+v"(tid)); const int lane = tid & 63, wave = __builtin_amdgcn_readfirstlane(tid >> 6), gwave = wg * NWAVES + wave, gtid = wg * NTHR + tid; (void)lane; (void)gwave; (void)gtid
#ifndef DBG_MASK
#define DBG_MASK 0xFFFFFF
#endif
#define IN(k) (lo <= (k) && (k) < hi)
#define ON(j) (((DBG_MASK) >> (j)) & 1)
#define SEAM(k) do { if (IN(k) && IN((k) + 1)) xcd_barrier(bar, C_wave0 == 0 && __builtin_amdgcn_mbcnt_hi(~0u, __builtin_amdgcn_mbcnt_lo(~0u, 0u)) == 0u); } while (0)

constexpr int I_IN = (D_MODEL / 64) * (NP / 64), I_OUT = (D_MODEL / 64) * (D_MODEL / 64), I_UP = (D_MODEL / 64) * (2 * D_FF / 64), I_DN = (D_FF / 64) * (D_MODEL / 64),
              I_UQ = (MLA_Q_LORA / 64) * (NQ_MLA / 64), I_UKV = (MLA_KV_LORA / 64) * (NKV_MLA / 64), I_LB = (LRU_BW / 64) * (LRU_BW / 64), I_LRU = 2 * 2 * NH * I_LB;
constexpr int I_PA = I_IN + I_OUT + I_UQ + I_UKV + I_LRU, I_PB = I_UP + I_DN;
constexpr int PREP_SCR = 16640;
__device__ __forceinline__ void prep_item_a(const AS4 Inputs* I, const WS& w, int l, int r, float* scr, int lane) {
    if (r < I_IN) { misc::transpose_item(I->w_in + (size_t)l * D_MODEL * IN_COLS, D_MODEL, IN_COLS, NP, w.WIN + l * SZ_WIN, scr, r, lane); return; } r -= I_IN;
    if (r < I_OUT) { misc::transpose_item(I->w_out + (size_t)l * D_MODEL * D_MODEL, D_MODEL, D_MODEL, D_MODEL, w.WOUT + l * SZ_WOUT, scr, r, lane); return; } r -= I_OUT;
    if (r < I_UQ) { misc::transpose_item(I->mla_w_uq + (size_t)l * MLA_Q_LORA * NQ_MLA, MLA_Q_LORA, NQ_MLA, NQ_MLA, w.WUQ + l * SZ_WUQ, scr, r, lane); return; } r -= I_UQ;
    if (r < I_UKV) { misc::transpose_item(I->mla_w_ukv + (size_t)l * MLA_KV_LORA * NKV_MLA, MLA_KV_LORA, NKV_MLA, NKV_MLA, w.WUKV + l * SZ_WUKV, scr, r, lane); return; } r -= I_UKV;
    { const int blk = r / I_LB, item = r % I_LB, d = blk / (2 * NH), wh = (blk / NH) & 1, nb = blk % NH;
      const float* src = (wh == 0 ? I->lru_wa : I->lru_wx) + ((size_t)(l * 2 + d) * NH + nb) * lru::SZ_WBLK;
      misc::transpose_item(src, LRU_BW, LRU_BW, LRU_BW, w.WLRU + ((size_t)l * 16 + blk) * lru::SZ_WBLK, scr, item, lane); }
}
__device__ __forceinline__ void prep_item_b(const AS4 Inputs* I, const WS& w, int l, int r, float* scr, int lane) {
    if (r < I_UP) { misc::transpose_item(I->ffn_w_up + (size_t)l * D_MODEL * 2 * D_FF, D_MODEL, 2 * D_FF, 2 * D_FF, w.WUP + l * SZ_WUP, scr, r, lane, D_FF); return; } r -= I_UP;
    misc::transpose_item(I->ffn_w_down + (size_t)l * D_FF * D_MODEL, D_FF, D_MODEL, D_MODEL, w.WDOWN + l * SZ_WDOWN, scr, r, lane);
}
constexpr int NMT = NMODV / 128;
__device__ __forceinline__ void mod_fill(const AS4 Inputs* I, char* lds, int tid) {
    float* SCs = (float*)lds;
    for (int i = tid; i < (BATCH + 1) * D_MODEL; i += 512) { const int s = i / D_MODEL, k = i % D_MODEL; const float v = s < BATCH ? I->c[s * D_MODEL + k] : I->c_ctx[k]; SCs[i] = v / (1.0f + __expf(-v)); }
    __syncthreads();
}
__device__ __forceinline__ void mod_task(const AS4 Inputs* I, const WS& w, int l, int t, char* lds, int tid, int wave, int lane) {
    const float* SCs = (const float*)lds; float* red = (float*)(lds + 3 * D_MODEL * 4);
    const int j0 = t * 128, h = lane >> 5, cl = lane & 31;
    misc::f32x4 acc[3] = {{0.f, 0.f, 0.f, 0.f}, {0.f, 0.f, 0.f, 0.f}, {0.f, 0.f, 0.f, 0.f}};
    const float* wp = I->ada_w + (size_t)l * D_MODEL * NMODV + (size_t)(256 * wave + h) * NMODV + j0 + 4 * cl;
#pragma unroll 8
    for (int k = 0; k < 128; ++k) { const misc::f32x4 wv = *(const misc::f32x4*)(wp + (size_t)(2 * k) * NMODV); const int kk = 256 * wave + 2 * k + h;
        acc[0] += wv * SCs[kk]; acc[1] += wv * SCs[D_MODEL + kk]; acc[2] += wv * SCs[2 * D_MODEL + kk]; }
#pragma unroll
    for (int s = 0; s < 3; ++s)
#pragma unroll
        for (int e = 0; e < 4; ++e) acc[s][e] += lane_xor(acc[s][e], 32, lane);
    __syncthreads();
    if (h == 0) {
#pragma unroll
        for (int s = 0; s < 3; ++s) *(misc::f32x4*)(red + (wave * 3 + s) * 128 + 4 * cl) = acc[s]; }
    __syncthreads();
    for (int i = tid; i < 3 * 128; i += 512) { const int s = i / 128, c = i % 128; float sum = I->ada_b[(size_t)l * NMODV + j0 + c];
#pragma unroll
        for (int w8 = 0; w8 < 8; ++w8) sum += red[(w8 * 3 + s) * 128 + c];
        w.MOD[((size_t)l * (BATCH + 1) + s) * NMODV + j0 + c] = sum; }
}
#define PREP_IDLE(nunits, nitems, CALL) do { const int r_ = (nunits) % G, first_ = r_, nid_ = G - r_; \
        if (wg >= first_) { float* scr = (float*)(lds + wave * PREP_SCR); for (int it = (wg - first_) * NWAVES + wave; it < (nitems); it += nid_ * NWAVES) { CALL; } } } while (0)

struct LayerCtx { int lo, hi, G, wg, nwaves, gthreads, wave0; XcdBarrier bar; char* lds; unsigned char* lds_raw; };
template <int l> __device__ __forceinline__ void layer_body(const LayerCtx& C) {
    const int lo = C.lo, hi = C.hi, G = C.G, wg = C.wg, nwaves = C.nwaves, gthreads = C.gthreads, C_wave0 = C.wave0; const XcdBarrier& bar = C.bar; char* lds = C.lds; unsigned char* lds_raw = C.lds_raw;
    (void)G; (void)nwaves; (void)gthreads;
        const int pb = 1 + PH_PER_LAYER * l;
        const bool want_ctx = l < DEPTH - 1; const int Mo = want_ctx ? M_ALL : M_LAT;
        if (ON(0) && IN(pb + 0)) { PHASE_WS; PHASE_IDS; const float* MODl = w.MOD + (size_t)l * (BATCH + 1) * NMODV; (void)MODl; misc::norm_phase(w.H, I->norm_mix_g + (size_t)l * D_MODEL, MODl, 0, w.U, M_ALL, gwave, nwaves, lane, l > 0 ? w.PART : nullptr, SK_DOWN, MODl - (size_t)(BATCH + 1) * NMODV + (size_t)BATCH * NMODV + 5 * D_MODEL, l == 0 ? I->x : nullptr, l == 0 ? I->ctx : nullptr); }
        SEAM(pb + 0);
        if (ON(1) && IN(pb + 1)) { PHASE_WS; PHASE_IDS; const float* MODl = w.MOD + (size_t)l * (BATCH + 1) * NMODV; (void)MODl; pg8::Gemm g{w.U, w.WIN + l * SZ_WIN, M_ALL, NP, D_MODEL, D_MODEL}; pg8::StaticOrder S; S.init(M_ALL, NP, G, wg);
            pg8::EpiBf16<0> E{w.P, NP, nullptr, 0, 0, 1.0f};
            pg8::gemm_phase<pg8::EpiBf16<0>, pg8::StaticOrder, true, true>((PG8_LAS unsigned char*)lds_raw, g, S, E, tid);
            if constexpr (l < DEPTH - 1) PREP_IDLE((M_ALL / 256) * (NP / 256), I_PA, prep_item_a(I, w, l + 1, it, scr, lane)); }
        SEAM(pb + 1);
        if (ON(2) && IN(pb + 2)) { PHASE_WS; PHASE_IDS; const float* MODl = w.MOD + (size_t)l * (BATCH + 1) * NMODV; (void)MODl;
            const int pflags = pp->pad;
            if (!(pflags & 16)) { gdn::G1Args A; A.P = w.P; A.conv_w = I->gdn_conv_w + (size_t)l * 4 * 3 * GROUP_W; A.a_log = I->gdn_a_log + (size_t)l * 2 * NH; A.dt_bias = I->gdn_dt_bias + (size_t)l * 2 * NH; A.B = gdn_bufs(w, l); A.pflags = pflags;
              gdn::g1_phase(A, lds, G, wg, tid); }
            if (!(pflags & 32)) { lru::LocalArgs A; A.P = w.P; A.conv_w = I->lru_conv_w + (size_t)l * 4 * LRU_W; A.conv_b = I->lru_conv_b + (size_t)l * LRU_W; A.WG = w.WLRU + (size_t)l * 16 * lru::SZ_WBLK;
              A.ba = I->lru_ba + (size_t)l * 2 * LRU_W; A.bx = I->lru_bx + (size_t)l * 2 * LRU_W; A.lam = I->lru_lam + (size_t)l * 2 * LRU_W; A.B = lru_bufs(w);
              lru::local_phase(A, lds, G, wg, tid); }
            if (!(pflags & 64)) { misc::RowNormArgs A; A.P = w.P; A.qa_g = I->mla_qa_g + (size_t)l * MLA_Q_LORA; A.kva_g = I->mla_kva_g + (size_t)l * MLA_KV_LORA; A.na_qn_g = I->na_qn_g + (size_t)l * HD; A.na_kn_g = I->na_kn_g + (size_t)l * HD;
              A.CQN = w.CQN; A.CKVN = w.CKVN; A.NQ = w.NQ; A.NK = w.NK; misc::rownorm_phase(A, gwave, nwaves, lane); }
        }
        SEAM(pb + 2);
        if (ON(3) && IN(pb + 3)) { PHASE_WS; PHASE_IDS; const float* MODl = w.MOD + (size_t)l * (BATCH + 1) * NMODV; (void)MODl;
            if (wg < gdn::G2_WGS) gdn::g2_chain(gdn_bufs(w, l), lds, wg, tid, 0, G2_CUT1, w.gSS);
            else {
            constexpr int UQ = (M_ALL / 256) * (NQ_MLA / 256), UKV = (M_ALL / 256) * (NKV_MLA / 256); const int G2n = G - gdn::G2_WGS, c2 = wg - gdn::G2_WGS;
            { pg8::Gemm g{w.CQN, w.WUQ + l * SZ_WUQ, M_ALL, NQ_MLA, MLA_Q_LORA, MLA_Q_LORA}; SpanOrder S; S.init(NQ_MLA, 0, UQ, G2n, c2); pg8::EpiBf16<0> E{w.QR, NQ_MLA, nullptr, 0, 0, 1.0f};
              pg8::gemm_phase<pg8::EpiBf16<0>, SpanOrder, true, true>((PG8_LAS unsigned char*)lds_raw, g, S, E, tid); }
            { pg8::Gemm g{w.CKVN, w.WUKV + l * SZ_WUKV, M_ALL, NKV_MLA, MLA_KV_LORA, MLA_KV_LORA}; SpanOrder S; S.init(NKV_MLA, UQ, UQ + UKV, G2n, c2); pg8::EpiBf16<0> E{w.KVR, NKV_MLA, nullptr, 0, 0, 1.0f};
              pg8::gemm_phase<pg8::EpiBf16<0>, SpanOrder, true, true>((PG8_LAS unsigned char*)lds_raw, g, S, E, tid); }
            }
        }
        SEAM(pb + 3);
        if (ON(4) && IN(pb + 4)) { PHASE_WS; PHASE_IDS; const float* MODl = w.MOD + (size_t)l * (BATCH + 1) * NMODV; (void)MODl;
            { misc::MlaQkvArgs A; A.QR = w.QR; A.KVR = w.KVR; A.P = w.P; A.qn_g = I->mla_qn_g + (size_t)l * MLA_QK; A.kn_g = I->mla_kn_g + (size_t)l * MLA_QK; A.QM = w.QM; A.KM = w.KM; A.VM = w.VM;
              misc::mlaqkv_phase(A, gwave, nwaves, lane); }
            lru::carry_phase(lru_bufs(w), gtid, gthreads);
        }
        SEAM(pb + 4);
        if (ON(5) && IN(pb + 5)) { PHASE_WS; PHASE_IDS; const float* MODl = w.MOD + (size_t)l * (BATCH + 1) * NMODV; (void)MODl;
            const int pflags = pp->pad;
            if (wg < gdn::G2_WGS && !(pflags & 1)) gdn::g2_chain(gdn_bufs(w, l), lds, wg, tid, G2_CUT2, gdn::G2_NSTEP, w.gSS);
            AttnArgs A; A.QM = w.QM; A.KM = w.KM; A.VM = w.VM; A.NQ = w.NQ; A.NK = w.NK; A.P = w.P; A.Y = w.Y; A.rpb = I->na_rpb + (size_t)l * NH * (2 * NA_KH - 1) * (2 * NA_KW - 1); A.want_ctx = want_ctx ? 1 : 0; A.pad = pflags;
            attention_phase(A, lds, G, wg, tid, gdn::G2_WGS);
        }
        SEAM(pb + 5);
        if (ON(6) && IN(pb + 6)) { PHASE_WS; PHASE_IDS; const float* MODl = w.MOD + (size_t)l * (BATCH + 1) * NMODV; (void)MODl;
            const int pflags = pp->pad;
            if (!(pflags & 128)) { gdn::G3Args A; A.B = gdn_bufs(w, l); A.P = w.P; A.norm_g = I->gdn_norm_g + (size_t)l * HD; A.Y = w.Y; gdn::g3_phase(A, lds, G, wg, tid); }
            if (!(pflags & 256)) lru::finish_phase(lru_bufs(w), w.P, w.Y, gtid, gthreads);
        }
        SEAM(pb + 6);
        if (ON(7) && IN(pb + 7)) { PHASE_WS; PHASE_IDS; const float* MODl = w.MOD + (size_t)l * (BATCH + 1) * NMODV; (void)MODl;
            { pg8::Gemm g{w.Y, w.WOUT + l * SZ_WOUT, M_LAT, D_MODEL, D_MODEL, D_MODEL}; pg8::StaticOrder S; S.init(M_LAT, D_MODEL, G, wg);
              pg8::EpiGateRes E{l == 0 ? I->x : w.H, w.H, D_MODEL, MODl + 2 * D_MODEL, NMODV, SEQ, BATCH, M_LAT};
              pg8::gemm_phase<pg8::EpiGateRes, pg8::StaticOrder, true, true>((PG8_LAS unsigned char*)lds_raw, g, S, E, tid); }
            if (want_ctx) { constexpr int SK = SK_OUT;
              pg8::Gemm g{w.Y + (size_t)M_LAT * D_MODEL, w.WOUT + l * SZ_WOUT, M_CTX, D_MODEL, D_MODEL / SK, D_MODEL}; SplitOrder S; S.init(M_CTX, D_MODEL, SK, G, (wg + G / 2) % G);
              pg8::EpiPart E{w.PART, D_MODEL, (size_t)M_CTX * D_MODEL};
              pg8::gemm_phase<pg8::EpiPart, SplitOrder, true, true>((PG8_LAS unsigned char*)lds_raw, g, S, E, tid); } }
        SEAM(pb + 7);
        if (ON(8) && IN(pb + 8)) { PHASE_WS; PHASE_IDS; const float* MODl = w.MOD + (size_t)l * (BATCH + 1) * NMODV; (void)MODl; misc::norm_phase(w.H, I->norm_ffn_g + (size_t)l * D_MODEL, MODl, 3, w.U, Mo, gwave, nwaves, lane, want_ctx ? w.PART : nullptr, SK_OUT, MODl + (size_t)BATCH * NMODV + 2 * D_MODEL, nullptr, nullptr); }
        SEAM(pb + 8);
        if (ON(9) && IN(pb + 9)) { PHASE_WS; PHASE_IDS; const float* MODl = w.MOD + (size_t)l * (BATCH + 1) * NMODV; (void)MODl; pg8::Gemm g{w.U, w.WUP + l * SZ_WUP, Mo, 2 * D_FF, D_MODEL, D_MODEL}; pg8::StaticOrder S; S.init(Mo, 2 * D_FF, G, wg);
            pg8::EpiConvAct E{w.ACT, w.HALO, I->ffn_conv_w + (size_t)l * 3 * 2 * D_FF, I->ffn_conv_b + (size_t)l * 2 * D_FF, D_FF};
            pg8::gemm_phase<pg8::EpiConvAct, pg8::StaticOrder, false, true>((PG8_LAS unsigned char*)lds_raw, g, S, E, tid);
            if constexpr (l < DEPTH - 1) PREP_IDLE((M_ALL / 256) * (2 * D_FF / 256), I_PB, prep_item_b(I, w, l + 1, it, scr, lane)); }
        SEAM(pb + 9);
        if (ON(10) && IN(pb + 10)) { PHASE_WS; PHASE_IDS; const float* MODl = w.MOD + (size_t)l * (BATCH + 1) * NMODV; (void)MODl; misc::act_fix_phase(w.HALO, I->ffn_conv_w + (size_t)l * 3 * 2 * D_FF, I->ffn_conv_b + (size_t)l * 2 * D_FF, w.ACT, Mo, gtid, gthreads); }
        SEAM(pb + 10);
        if (ON(11) && IN(pb + 11)) { PHASE_WS; PHASE_IDS; const float* MODl = w.MOD + (size_t)l * (BATCH + 1) * NMODV; (void)MODl;
            { pg8::Gemm g{w.ACT, w.WDOWN + l * SZ_WDOWN, M_LAT, D_MODEL, D_FF, D_FF}; pg8::StaticOrder S; S.init(M_LAT, D_MODEL, G, wg);
              pg8::EpiGateRes E{w.H, want_ctx ? w.H : pp->out, D_MODEL, MODl + 5 * D_MODEL, NMODV, SEQ, BATCH, M_LAT};
              pg8::gemm_phase<pg8::EpiGateRes, pg8::StaticOrder, true, true>((PG8_LAS unsigned char*)lds_raw, g, S, E, tid); }
            if (want_ctx) { constexpr int SK = SK_DOWN;
              pg8::Gemm g{w.ACT + (size_t)M_LAT * D_FF, w.WDOWN + l * SZ_WDOWN, M_CTX, D_MODEL, D_FF / SK, D_FF}; SplitOrder S; S.init(M_CTX, D_MODEL, SK, G, (wg + G / 2) % G);
              pg8::EpiPart E{w.PART, D_MODEL, (size_t)M_CTX * D_MODEL};
              pg8::gemm_phase<pg8::EpiPart, SplitOrder, true, true>((PG8_LAS unsigned char*)lds_raw, g, S, E, tid); }
            if constexpr (l < DEPTH - 1) {
              constexpr int NCI = (M_CTX / 256) * (D_MODEL / 256) * SK_DOWN; const int first = NCI < G ? NCI : 0, rank = (wg + G / 2) % G;
              if (rank >= first && rank - first < NMT) { mod_fill(I, lds, tid); for (int t = rank - first; t < NMT; t += G - first) mod_task(I, w, l + 1, t, lds, tid, wave, lane); } } }
        SEAM(pb + 11);

}
__global__ void __launch_bounds__(NTHR, 2) fwd(Params p) {
    extern __shared__ __attribute__((aligned(16))) unsigned char lds_raw[];
    char* lds = (char*)lds_raw;
    const int G = (int)gridDim.x, wg = (int)blockIdx.x, nwaves = G * NWAVES, gthreads = G * NTHR;
    const int C_wave0 = __builtin_amdgcn_readfirstlane((int)threadIdx.x >> 6);
    volatile LAS unsigned* MISC = (volatile LAS unsigned*)(lds_raw + LDS_MISC);
    if (threadIdx.x < 32) MISC[threadIdx.x] = 0u;
    __syncthreads();
    const int lo = p.ph_lo, hi = p.ph_hi;
    unsigned* const barw = (unsigned*)p.ws + CW_BAR + (size_t)p.li * XCD_BAR_WORDS;
    XcdBarrier bar; bar.bar = barw; bar.x = 0; bar.st = MISC + 8;
    if (hi - lo > 1) bar = xcd_barrier_post(barw, MISC + 8, threadIdx.x == 0);

    if (ON(12) && IN(PH_PRO)) { PHASE_WS; PHASE_IDS;
        const bool split = G > NMT;
        if (wg < NMT) { mod_fill(I, lds, tid); for (int t = wg; t < NMT; t += G) mod_task(I, w, 0, t, lds, tid, wave, lane); __syncthreads(); }
        {
            float* scr = (float*)(lds + wave * PREP_SCR);
            constexpr int T = I_PA + I_PB;
            const int nmw = NMT * NWAVES;
            int it0, itn, its;
            if (!split) { it0 = gwave; itn = T; its = nwaves; } else if (wg < NMT) { it0 = gwave; itn = 2 * nmw; its = nmw; } else { it0 = 2 * nmw + (gwave - nmw); itn = T; its = nwaves - nmw; }
            for (int it = it0; it < itn; it += its) { if (it < I_PA) prep_item_a(I, w, 0, it, scr, lane); else prep_item_b(I, w, 0, it - I_PA, scr, lane); }
        }
    }
    SEAM(PH_PRO);

    { LayerCtx C; C.lo = lo; C.hi = hi; C.G = G; C.wg = wg; C.nwaves = nwaves; C.gthreads = gthreads; C.wave0 = C_wave0; C.bar = bar; C.lds = lds; C.lds_raw = lds_raw;
      static_assert(DEPTH == 4, "layer calls are written out (a real layer loop lets LICM park loop-invariant values in registers across every phase: spills)");
      layer_body<0>(C); layer_body<1>(C); layer_body<2>(C); layer_body<3>(C); }
#undef IN
#undef SEAM
}

#ifndef MK_PHASES_PER_LAUNCH
#define MK_PHASES_PER_LAUNCH NPH
#endif
extern "C" void kernel_launch(void* const* d_in, const int* in_sizes, int n_in, void* d_out, int out_size, void* d_ws, size_t ws_size, hipStream_t stream) {
    static int grid = 0;
    if (grid == 0) {
        int dev = 0, cus = 0;
        if (hipGetDevice(&dev) != hipSuccess || hipDeviceGetAttribute(&cus, hipDeviceAttributeMultiprocessorCount, dev) != hipSuccess || cus <= 0) { fprintf(stderr, "kernel_launch: no device\n"); grid = -1; return; }
        if (hipFuncSetAttribute((const void*)fwd, hipFuncAttributeMaxDynamicSharedMemorySize, LDS_BYTES) != hipSuccess) { fprintf(stderr, "kernel_launch: hipFuncSetAttribute failed\n"); grid = -1; return; }
        int per_cu = 0; if (hipOccupancyMaxActiveBlocksPerMultiprocessor(&per_cu, (const void*)fwd, NTHR, LDS_BYTES) != hipSuccess || per_cu < 1) fprintf(stderr, "kernel_launch: occupancy query says %d blocks per CU\n", per_cu);
        (void)hipGetLastError();
        grid = cus;
        const WS w0 = ws_carve(nullptr);
        if (n_in != 34 || w0.total > ws_size) { fprintf(stderr, "kernel_launch: bad inputs / workspace (need %zu, have %zu)\n", w0.total, ws_size); grid = -1; return; }
    }
    if (grid < 0) return;
    (void)hipMemsetAsync(d_ws, 0, 1 << 20, stream);
    Params p; memset(&p, 0, sizeof(p));
    for (int i = 0; i < 34; ++i) p.in[i] = (const float*)d_in[i];
    p.out = (float*)d_out; p.ws = (unsigned char*)d_ws;
    int li = 0;
    for (int lo = 0; lo < NPH; lo += MK_PHASES_PER_LAUNCH, ++li) {
        p.ph_lo = lo; p.ph_hi = lo + MK_PHASES_PER_LAUNCH < NPH ? lo + MK_PHASES_PER_LAUNCH : NPH; p.li = li;
#if defined(PROBE_MASK)
        if (MK_PHASES_PER_LAUNCH == 1 && ((((PROBE_MASK) >> 12) & 1 && lo == 0) || (lo > 0 && (((PROBE_MASK) >> ((lo - 1) % PH_PER_LAYER)) & 1))))
            { Params q = p;
#if defined(PROBE_FLAGS)
              q.pad = PROBE_FLAGS;
#endif
              for (int r = 0; r < PROBE_REPS; ++r) hipLaunchKernelGGL(fwd, dim3(grid), dim3(NTHR), LDS_BYTES, stream, q); }
#endif
        hipLaunchKernelGGL(fwd, dim3(grid), dim3(NTHR), LDS_BYTES, stream, p);
    }
}
```

```cpp
#include <hip/hip_runtime.h>
#include <cstdio>
#include <cstdint>
#include <cstring>
#include <math.h>
#include <stdint.h>

#ifdef CFG_SMALL
constexpr int D_MODEL = 256, BATCH = 2, SEQ = 512, DEPTH = 2, CTX_LEN = 64, GRID_W = 32, HEAD_DIM = 16;
#else
constexpr int D_MODEL = 2048, BATCH = 2, SEQ = 8192, DEPTH = 4, CTX_LEN = 256, GRID_W = 64, HEAD_DIM = 128;
#endif
constexpr int GROUP_W = D_MODEL / 4, NH = GROUP_W / HEAD_DIM;
constexpr int HD = HEAD_DIM;
constexpr int N_MOD = 6;
constexpr float EPS = 1e-6f;
constexpr int LRU_W = GROUP_W, LRU_BW = LRU_W / NH;
constexpr float LRU_C = 8.0f;
constexpr int MLA_Q_LORA = 3 * D_MODEL / 16, MLA_KV_LORA = D_MODEL / 8, MLA_NOPE = HD, MLA_ROPE = HD / 2, MLA_V = HD, MLA_QK = MLA_NOPE + MLA_ROPE;
constexpr int GDN_CHUNK = 64;
constexpr int NA_KH = 8, NA_KW = 16;
constexpr int D_FF = 5 * D_MODEL / 2;
constexpr int ROWS = SEQ / GRID_W;
constexpr int C_LRU_X = 0, C_LRU_G = C_LRU_X + LRU_W, C_CQ = C_LRU_G + LRU_W, C_CKV = C_CQ + MLA_Q_LORA, C_KR = C_CKV + MLA_KV_LORA,
              C_GQ = C_KR + MLA_ROPE, C_GK = C_GQ + GROUP_W, C_GV = C_GK + GROUP_W, C_GG = C_GV + GROUP_W, C_GB = C_GG + GROUP_W,
              C_GA = C_GB + 2 * NH, C_NQ = C_GA + 2 * NH, C_NK = C_NQ + GROUP_W, C_NV = C_NK + GROUP_W, IN_COLS = C_NV + GROUP_W;
constexpr int NP = (IN_COLS + 255) / 256 * 256;
constexpr int M_LAT = BATCH * SEQ, M_CTX = BATCH * CTX_LEN, M_ALL = M_LAT + M_CTX;
constexpr int NMODV = N_MOD * D_MODEL;

typedef unsigned short bf16_t;
__host__ __device__ __forceinline__ bf16_t f2bf(float f) { union { float f; unsigned u; } v; v.f = f; unsigned u = v.u; u += 0x7fffu + ((u >> 16) & 1u); return (bf16_t)(u >> 16); }
__host__ __device__ __forceinline__ float bf2f(bf16_t b) { union { float f; unsigned u; } v; v.u = ((unsigned)b) << 16; return v.f; }
__host__ __device__ __forceinline__ float sigmoidf_(float x) { return 1.0f / (1.0f + expf(-x)); }
__host__ __device__ __forceinline__ float siluf_(float x) { return x / (1.0f + expf(-x)); }
__host__ __device__ __forceinline__ float softplusf_(float x) { return fmaxf(x, 0.0f) + log1pf(expf(-fabsf(x))); }
__host__ __device__ __forceinline__ float geluf_(float x) { return 0.5f * x * (1.0f + tanhf(0.7978845608028654f * (x + 0.044715f * x * x * x))); }

struct RowInfo { int b, t, T, base, set; };
__host__ __device__ __forceinline__ RowInfo row_info(int r) {
    RowInfo i;
    if (r < M_LAT) { i.b = r / SEQ; i.t = r % SEQ; i.T = SEQ; i.base = i.b * SEQ; i.set = i.b; }
    else { const int rr = r - M_LAT; i.b = rr / CTX_LEN; i.t = rr % CTX_LEN; i.T = CTX_LEN; i.base = M_LAT + i.b * CTX_LEN; i.set = BATCH; }
    return i;
}


__host__ __device__ __forceinline__ float bflo(unsigned w) { union { float f; unsigned u; } v; v.u = w << 16; return v.f; }
__host__ __device__ __forceinline__ float bfhi(unsigned w) { union { float f; unsigned u; } v; v.u = w & 0xffff0000u; return v.f; }
#define LDS_BARRIER() asm volatile("s_waitcnt lgkmcnt(0)\n\ts_barrier" ::: "memory")
__device__ __forceinline__ float lane_xor(float v, int mask, int lane) { return __int_as_float(__builtin_amdgcn_ds_bpermute((lane ^ mask) << 2, __float_as_int(v))); }
__device__ __forceinline__ float lane_get(float v, int src_lane) { return __int_as_float(__builtin_amdgcn_ds_bpermute(src_lane << 2, __float_as_int(v))); }
struct Inputs {
    const float *x, *c, *ctx, *c_ctx, *ada_w, *ada_b, *norm_mix_g, *norm_ffn_g, *w_in, *w_out,
        *lru_conv_w, *lru_conv_b, *lru_wa, *lru_ba, *lru_wx, *lru_bx, *lru_lam,
        *mla_qa_g, *mla_w_uq, *mla_kva_g, *mla_w_ukv, *mla_qn_g, *mla_kn_g,
        *gdn_conv_w, *gdn_a_log, *gdn_dt_bias, *gdn_norm_g, *na_qn_g, *na_kn_g, *na_rpb,
        *ffn_w_up, *ffn_conv_w, *ffn_conv_b, *ffn_w_down;
};
constexpr int NQ_MLA = NH * MLA_QK, NKV_MLA = NH * (MLA_NOPE + MLA_V);
constexpr size_t SZ_WIN = (size_t)NP * D_MODEL, SZ_WOUT = (size_t)D_MODEL * D_MODEL, SZ_WUP = (size_t)2 * D_FF * D_MODEL, SZ_WDOWN = (size_t)D_MODEL * D_FF,
                 SZ_WUQ = (size_t)NQ_MLA * MLA_Q_LORA, SZ_WUKV = (size_t)NKV_MLA * MLA_KV_LORA, SZ_WLRU = (size_t)16 * LRU_BW * LRU_BW;
struct WS {
    unsigned* ctl; float *MOD, *H, *PART; bf16_t *U, *Y;
    bf16_t *WIN, *WOUT, *WUP, *WDOWN, *WUQ, *WUKV, *WLRU;
    bf16_t* P; bf16_t *CQN, *CKVN, *QR, *KVR, *QM, *KM, *VM, *NQ, *NK;
    bf16_t *gUT, *gWP, *gKDT, *gQD, *gQK, *gSIT, *gVNT; float *gGT, *gSS;
    bf16_t *lHLOC, *lACUM; float *lLSUM, *lHIN;
    bf16_t *HALO, *ACT;
    size_t total;
};
__host__ __device__ inline WS ws_carve(void* base) {
    WS w; size_t off = 0; char* b = (char*)base;
#define WS_TAKE(T, field, bytes) do { w.field = (T*)(b + off); off += (((size_t)(bytes)) + 255) & ~(size_t)255; } while (0)
    WS_TAKE(unsigned, ctl, 1 << 20);
    WS_TAKE(float, MOD, sizeof(float) * (size_t)DEPTH * (BATCH + 1) * NMODV);
    WS_TAKE(float, H, sizeof(float) * (size_t)M_ALL * D_MODEL);
    WS_TAKE(float, PART, sizeof(float) * (size_t)5 * M_CTX * D_MODEL);
    WS_TAKE(bf16_t, U, 2 * (size_t)M_ALL * D_MODEL);
    WS_TAKE(bf16_t, Y, 2 * (size_t)M_ALL * D_MODEL);
    WS_TAKE(bf16_t, WIN, 2 * SZ_WIN * DEPTH); WS_TAKE(bf16_t, WOUT, 2 * SZ_WOUT * DEPTH); WS_TAKE(bf16_t, WUP, 2 * SZ_WUP * DEPTH); WS_TAKE(bf16_t, WDOWN, 2 * SZ_WDOWN * DEPTH);
    WS_TAKE(bf16_t, WUQ, 2 * SZ_WUQ * DEPTH); WS_TAKE(bf16_t, WUKV, 2 * SZ_WUKV * DEPTH); WS_TAKE(bf16_t, WLRU, 2 * SZ_WLRU * DEPTH);
    const size_t r0 = off;
    WS_TAKE(bf16_t, P, 2 * (size_t)M_ALL * NP);
    WS_TAKE(bf16_t, CQN, 2 * (size_t)M_ALL * MLA_Q_LORA); WS_TAKE(bf16_t, CKVN, 2 * (size_t)M_ALL * MLA_KV_LORA);
    WS_TAKE(bf16_t, QR, 2 * (size_t)M_ALL * NQ_MLA); WS_TAKE(bf16_t, KVR, 2 * (size_t)M_ALL * NKV_MLA);
    WS_TAKE(bf16_t, QM, 2 * (size_t)M_ALL * NQ_MLA); WS_TAKE(bf16_t, KM, 2 * (size_t)M_ALL * NQ_MLA); WS_TAKE(bf16_t, VM, 2 * (size_t)M_ALL * NH * MLA_V);
    WS_TAKE(bf16_t, NQ, 2 * (size_t)M_ALL * GROUP_W); WS_TAKE(bf16_t, NK, 2 * (size_t)M_ALL * GROUP_W);
    { constexpr size_t NT_ = (size_t)(M_ALL / 64) * NH * 2;
      WS_TAKE(bf16_t, gUT, 2 * NT_ * 128 * 64); WS_TAKE(bf16_t, gWP, 2 * NT_ * 64 * 128); WS_TAKE(bf16_t, gKDT, 2 * NT_ * 128 * 64); WS_TAKE(bf16_t, gQD, 2 * NT_ * 64 * 128);
      WS_TAKE(bf16_t, gQK, 2 * NT_ * 64 * 64); WS_TAKE(bf16_t, gSIT, 2 * NT_ * 128 * 128); WS_TAKE(bf16_t, gVNT, 2 * NT_ * 128 * 64); WS_TAKE(float, gGT, 4 * NT_ * DEPTH); WS_TAKE(float, gSS, 4 * (size_t)BATCH * NH * 2 * HD * HD); }
    WS_TAKE(bf16_t, lHLOC, 2 * (size_t)2 * M_ALL * LRU_W); WS_TAKE(bf16_t, lACUM, 2 * (size_t)2 * M_ALL * LRU_W);
    WS_TAKE(float, lLSUM, 4 * (size_t)(M_ALL / 64) * 2 * 2 * LRU_W); WS_TAKE(float, lHIN, 4 * (size_t)(M_ALL / 64) * 2 * LRU_W);
    const size_t r1 = off;
    off = r0;
    WS_TAKE(bf16_t, HALO, 2 * (size_t)(M_ALL / 64) * 4 * 2 * D_FF); WS_TAKE(bf16_t, ACT, 2 * (size_t)M_ALL * D_FF);
    const size_t f1 = off;
#undef WS_TAKE
    w.total = r1 > f1 ? r1 : f1;
    return w;
}

namespace pg8 {
#define PG8_LAS __attribute__((address_space(3)))
typedef unsigned short bf16_t;
typedef short bf16x8 __attribute__((ext_vector_type(8)));
typedef float f32x4 __attribute__((ext_vector_type(4)));
typedef unsigned u32x4 __attribute__((ext_vector_type(4)));
constexpr int BM = 256, BK = 64, HALF = 128, HTB = HALF * BK * 2  , STAGE_BYTES = 8 * HTB, NXCD = 8, WGM = 8;

__host__ __device__ __forceinline__ int lds_byte(int r, int c) { const int st = (r >> 4) * 2 + (c >> 5), rr = r & 15, cc = c & 31, ob = rr * 64 + cc * 2; return st * 1024 + (ob ^ (((ob >> 9) & 1) << 5)); }
__host__ __device__ __forceinline__ void stage_rc(int b, int& R, int& C) { const int st = b / 1024, sb = b % 1024, swz = sb ^ (((sb >> 9) & 1) << 5); R = (st >> 1) * 16 + swz / 64; C = (st & 1) * 32 + (swz % 64) / 2; }
__host__ __device__ __forceinline__ int perm32(int rho) { const int n = rho >> 4, i = rho & 15; return 8 * (i >> 2) + 4 * n + (i & 3); }

struct Unit { int pm, pn, ks; };
struct Gemm { const bf16_t* A; const bf16_t* Bt; int M, N, K, ld; };

struct StaticOrder {
    int nM, nN, nwg, G, c;
    __host__ __device__ void init(int M, int N, int G_, int c_) { nM = M / BM; nN = N / BM; nwg = nM * nN; G = G_; c = c_; }
    __host__ __device__ bool next(int i, Unit& u) const {
        const long L = (long)i * G + c; if (L >= nwg) return false;
        int wgid = (int)L; { const int q = nwg / NXCD, r = nwg % NXCD, xcd = wgid % NXCD, off = wgid / NXCD; wgid = (xcd < r ? xcd * (q + 1) : r * (q + 1) + (xcd - r) * q) + off; }
        const int nig = WGM * nN, gid = wgid / nig, fm = gid * WGM, gsz = (nM - fm) < WGM ? (nM - fm) : WGM;
        u.pm = fm + ((wgid % nig) % gsz); u.pn = (wgid % nig) / gsz; u.ks = 0; return true;
    }
    __device__ __forceinline__ void a_ready(const Unit&) const {}
    __device__ __forceinline__ void done(const Unit&) const {}
};
__device__ __forceinline__ unsigned cvt_pk_bf16(float lo, float hi) { unsigned r; asm volatile("v_cvt_pk_bf16_f32 %0, %1, %2" : "=v"(r) : "v"(lo), "v"(hi)); return r; }
typedef float f32x2 __attribute__((ext_vector_type(2)));
__device__ __forceinline__ f32x2 gelu_pk(f32x2 v) {
    const f32x2 av = __builtin_elementwise_abs(v), d = av * 0.2316418882f + 1.0f;
    f32x2 t; t.x = __builtin_amdgcn_rcpf(d.x); t.y = __builtin_amdgcn_rcpf(d.y);
    f32x2 q = t * 0.5307027145f + (-0.7265760135f); q = q * t + 0.7107068705f; q = q * t + (-0.142248368f); q = q * t + 0.127414796f; q = q * t;
    const f32x2 s = (v * v) * (-0.72134752044f);
    f32x2 e; e.x = __builtin_amdgcn_exp2f(s.x); e.y = __builtin_amdgcn_exp2f(s.y);
    const f32x2 m = v * (q * e), r = v - m;
    f32x2 o; o.x = v.x < 0.f ? m.x : r.x; o.y = v.y < 0.f ? m.y : r.y; return o;
}

template <int ACT  > struct EpiBf16 {
    static constexpr bool PERM = true, AFTER_DRAIN = false; static_assert(ACT == 0 || ACT == 1, "EpiBf16: ACT is 0 (none) or 1 (gelu_pk)");
    bf16_t* O; int ldc; const float* bias; int split_cols; size_t split_stride; float scale0;
    __device__ __forceinline__ void operator()(const f32x4 (&acc)[2][2][4][2], const Unit& u, int wr, int wc, int fr, int fq) const {
        const int row0 = u.pm * BM + wr * 64 + fr; int colt = u.pn * BM; bf16_t* base = O;
        float sc = 1.f; if (split_cols) { const int t = colt / split_cols; base += (size_t)t * split_stride; colt -= t * split_cols; if (t == 0) sc = scale0; }
        const int col0 = colt + wc * 32 + 8 * fq, bcol0 = u.pn * BM + wc * 32 + 8 * fq;
        f32x4 bv[2][2];
#pragma unroll
        for (int bj = 0; bj < 2; ++bj)
#pragma unroll
            for (int n = 0; n < 2; ++n) bv[bj][n] = bias ? *(const f32x4*)(bias + bcol0 + bj * HALF + 4 * n) : (f32x4){0.f, 0.f, 0.f, 0.f};
#pragma unroll
        for (int ai = 0; ai < 2; ++ai)
#pragma unroll
            for (int m = 0; m < 4; ++m) { bf16_t* rowp = base + (size_t)(row0 + ai * HALF + m * 16) * ldc + col0;
#pragma unroll
                for (int bj = 0; bj < 2; ++bj) { f32x4 v0 = acc[ai][bj][m][0] + bv[bj][0], v1 = acc[ai][bj][m][1] + bv[bj][1];
                    if (ACT == 1) { f32x2 a = gelu_pk((f32x2){v0[0], v0[1]}), b = gelu_pk((f32x2){v0[2], v0[3]}), c = gelu_pk((f32x2){v1[0], v1[1]}), d = gelu_pk((f32x2){v1[2], v1[3]});
                        v0 = (f32x4){a.x, a.y, b.x, b.y}; v1 = (f32x4){c.x, c.y, d.x, d.y}; }
                    v0 = v0 * sc; v1 = v1 * sc; u32x4 w; w.x = cvt_pk_bf16(v0[0], v0[1]); w.y = cvt_pk_bf16(v0[2], v0[3]); w.z = cvt_pk_bf16(v1[0], v1[1]); w.w = cvt_pk_bf16(v1[2], v1[3]);
                    *(u32x4*)(rowp + bj * HALF) = w; } }
    }
};

struct EpiF32 {
    static constexpr bool PERM = false, AFTER_DRAIN = false;
    float* C; int ldc;
    __device__ __forceinline__ void operator()(const f32x4 (&acc)[2][2][4][2], const Unit& u, int wr, int wc, int fr, int fq) const {
        const int row0 = u.pm * BM + wr * 64 + fr, col0 = u.pn * BM + wc * 32 + 4 * fq;
#pragma unroll
        for (int ai = 0; ai < 2; ++ai)
#pragma unroll
            for (int m = 0; m < 4; ++m) { float* rowp = C + (size_t)(row0 + ai * HALF + m * 16) * ldc + col0;
#pragma unroll
                for (int bj = 0; bj < 2; ++bj)
#pragma unroll
                    for (int n = 0; n < 2; ++n) *(f32x4*)(rowp + bj * HALF + n * 16) = acc[ai][bj][m][n]; }
    }
};
struct EpiGateRes {
    static constexpr bool PERM = false, AFTER_DRAIN = false;
    const float* base; float* out; int ldc; const float* gate; int set_stride; int rows_per_set; int nsets_lat; int lat_rows;
    __device__ __forceinline__ void operator()(const f32x4 (&acc)[2][2][4][2], const Unit& u, int wr, int wc, int fr, int fq) const {
        const int row0 = u.pm * BM + wr * 64 + fr, col0 = u.pn * BM + wc * 32 + 4 * fq;
        const int set = (u.pm * BM >= lat_rows) ? nsets_lat : (u.pm * BM) / rows_per_set;
        const float* gp = gate + (size_t)set * set_stride + col0;
        f32x4 gv[2][2];
#pragma unroll
        for (int bj = 0; bj < 2; ++bj)
#pragma unroll
            for (int n = 0; n < 2; ++n) gv[bj][n] = *(const f32x4*)(gp + bj * HALF + n * 16);
#pragma unroll
        for (int ai = 0; ai < 2; ++ai)
#pragma unroll
            for (int m = 0; m < 4; ++m) { const size_t off = (size_t)(row0 + ai * HALF + m * 16) * ldc + col0;
#pragma unroll
                for (int bj = 0; bj < 2; ++bj)
#pragma unroll
                    for (int n = 0; n < 2; ++n) { const f32x4 b = *(const f32x4*)(base + off + bj * HALF + n * 16); *(f32x4*)(out + off + bj * HALF + n * 16) = b + gv[bj][n] * acc[ai][bj][m][n]; } }
    }
};

struct EpiConvAct {
    static constexpr bool PERM = false, AFTER_DRAIN = false;
    bf16_t* ACT; bf16_t* HALO; const float* cw; const float* cb; int dff;
    __device__ __forceinline__ static float ror1(float v) { return __int_as_float(__builtin_amdgcn_update_dpp(0, __float_as_int(v), 0x121, 0xf, 0xf, false)); }
    __device__ __forceinline__ static float rol1(float v) { return __int_as_float(__builtin_amdgcn_update_dpp(0, __float_as_int(v), 0x12f, 0xf, 0xf, false)); }
    __device__ __forceinline__ void operator()(const f32x4 (&acc)[2][2][4][2], const Unit& u, int wr, int wc, int fr, int fq) const {
        const int rowb = u.pm * BM + wr * 64, chb = u.pn * HALF + wc * 32 + 4 * fq;
        const bool f0 = fr == 0, f15 = fr == 15;
        typedef float f32x2 __attribute__((ext_vector_type(2)));
#pragma unroll
        for (int n = 0; n < 2; ++n)
#pragma unroll
            for (int ep = 0; ep < 2; ++ep) { const int ch = chb + 16 * n + 2 * ep;
                f32x2 wa[3], wg[3], ba, bg;
#pragma unroll
                for (int k = 0; k < 3; ++k) { wa[k] = *(const f32x2*)(cw + (size_t)k * 2 * dff + ch); wg[k] = *(const f32x2*)(cw + (size_t)k * 2 * dff + dff + ch); }
                ba = *(const f32x2*)(cb + ch); bg = *(const f32x2*)(cb + dff + ch);
#pragma unroll
                for (int ai = 0; ai < 2; ++ai) { const int blk = (rowb + ai * HALF) >> 6;
                    float y[4][2];
#pragma unroll
                    for (int eo = 0; eo < 2; ++eo) { const int e = 2 * ep + eo;
                        float Ra[4], La[4], Rg[4], Lg[4];
#pragma unroll
                        for (int m = 0; m < 4; ++m) { Ra[m] = ror1(acc[ai][0][m][n][e]); La[m] = rol1(acc[ai][0][m][n][e]); Rg[m] = ror1(acc[ai][1][m][n][e]); Lg[m] = rol1(acc[ai][1][m][n][e]); }
#pragma unroll
                        for (int m = 0; m < 4; ++m) {
                            const float ap = f0 ? Ra[m > 0 ? m - 1 : 0] : Ra[m], an = f15 ? La[m < 3 ? m + 1 : 3] : La[m];
                            const float gp = f0 ? Rg[m > 0 ? m - 1 : 0] : Rg[m], gn = f15 ? Lg[m < 3 ? m + 1 : 3] : Lg[m];
                            const float a = ba[eo] + wa[0][eo] * ap + wa[1][eo] * acc[ai][0][m][n][e] + wa[2][eo] * an;
                            const float g = bg[eo] + wg[0][eo] * gp + wg[1][eo] * acc[ai][1][m][n][e] + wg[2][eo] * gn;
                            y[m][eo] = a * (g * __builtin_amdgcn_rcpf(1.0f + __expf(-g))); }
                    }
#pragma unroll
                    for (int m = 0; m < 4; ++m) { const int row = rowb + ai * HALF + 16 * m + fr;
                        *(unsigned*)(ACT + (size_t)row * dff + ch) = cvt_pk_bf16(y[m][0], y[m][1]);
                        if ((m == 0 && fr < 2) || (m == 3 && fr >= 14)) { const int slot = m == 0 ? fr : fr - 12; bf16_t* hp = HALO + ((size_t)blk * 4 + slot) * (2 * dff) + ch;
                            *(unsigned*)hp = cvt_pk_bf16(acc[ai][0][m][n][2 * ep], acc[ai][0][m][n][2 * ep + 1]);
                            *(unsigned*)(hp + dff) = cvt_pk_bf16(acc[ai][1][m][n][2 * ep], acc[ai][1][m][n][2 * ep + 1]); }
                    }
                }
            }
    }
};

struct EpiPart {
    static constexpr bool PERM = false, AFTER_DRAIN = false;
    float* C; int ldc; size_t ks_stride;
    __device__ __forceinline__ void operator()(const f32x4 (&acc)[2][2][4][2], const Unit& u, int wr, int wc, int fr, int fq) const {
        const int row0 = u.pm * BM + wr * 64 + fr, col0 = u.pn * BM + wc * 32 + 4 * fq; float* Cb = C + (size_t)u.ks * ks_stride;
#pragma unroll
        for (int ai = 0; ai < 2; ++ai)
#pragma unroll
            for (int m = 0; m < 4; ++m) { float* rowp = Cb + (size_t)(row0 + ai * HALF + m * 16) * ldc + col0;
#pragma unroll
                for (int bj = 0; bj < 2; ++bj)
#pragma unroll
                    for (int n = 0; n < 2; ++n) *(f32x4*)(rowp + bj * HALF + n * 16) = acc[ai][bj][m][n]; }
    }
};

template <class Epi, class Sched, bool ALIGN_EPI = false, bool SP2 = false>
__device__ __forceinline__ void gemm_phase(PG8_LAS unsigned char* lds, const Gemm g, const Sched& S, const Epi& E, const int tid_in) {
    int tid_ = tid_in; asm volatile("" : "+v"(tid_));
    const int tid = tid_, wid = __builtin_amdgcn_readfirstlane(tid >> 6), lane = tid & 63, wr = wid >> 2, wc = wid & 3, fr = lane & 15, fq = lane >> 4;
    const int K = g.K, nt = K / BK;
    unsigned voffA[2], voffB[2];
#pragma unroll
    for (int i = 0; i < 2; ++i) { int R, C; stage_rc(tid * 16 + i * 8192, R, C); const int Rb = Epi::PERM ? ((R & ~31) + perm32(R & 31)) : R;
        voffA[i] = (unsigned)(R * g.ld + C) * 2u; voffB[i] = (unsigned)(Rb * g.ld + C) * 2u; }
    const size_t kstep = (size_t)(BK * 2);
    const size_t hstep = (size_t)HALF * g.ld * 2;
    const size_t tstep = 2 * hstep;
    const unsigned ldsw = (unsigned)wid * 1024u;
    const int aoff = lds_byte(wr * 64 + fr, fq * 8), boff = lds_byte(wc * 32 + fr, fq * 8);
#define PG8_SA(b, h) (((b) * 2 + (h)) * HTB)
#define PG8_SB(b, h) ((4 + (b) * 2 + (h)) * HTB)
#define PG8_STAGE(bufoff, gbase, voff) do { _Pragma("unroll") for (int _i = 0; _i < 2; ++_i) \
        __builtin_amdgcn_global_load_lds((const unsigned*)((const char*)(gbase) + (voff)[_i]), (PG8_LAS unsigned*)(lds + (bufoff) + ldsw + _i * 8192), 16, 0, 0); } while (0)
#define PG8_LDA(dst, b, h) do { _Pragma("unroll") for (int m = 0; m < 4; ++m) _Pragma("unroll") for (int k = 0; k < 2; ++k) dst[m][k] = *(const PG8_LAS bf16x8*)(lds + PG8_SA(b, h) + aoff + m * 2048 + k * 1024); } while (0)
#define PG8_LDB(dst, b, h) do { _Pragma("unroll") for (int n = 0; n < 2; ++n) _Pragma("unroll") for (int k = 0; k < 2; ++k) dst[n][k] = *(const PG8_LAS bf16x8*)(lds + PG8_SB(b, h) + boff + n * 2048 + k * 1024); } while (0)
#define PG8_MMA(ai, bj, At, Bt) do { __builtin_amdgcn_s_setprio(1); _Pragma("unroll") for (int m = 0; m < 4; ++m) _Pragma("unroll") for (int n = 0; n < 2; ++n) _Pragma("unroll") for (int k = 0; k < 2; ++k) \
        acc[ai][bj][m][n] = __builtin_amdgcn_mfma_f32_16x16x32_bf16(Bt[n][k], At[m][k], acc[ai][bj][m][n], 0, 0, 0); __builtin_amdgcn_s_setprio(0); } while (0)
#define PG8_WAIT_V(n) asm volatile("s_waitcnt vmcnt(" #n ")" ::: "memory")
#define PG8_WAIT_L(n) asm volatile("s_waitcnt lgkmcnt(" #n ")" ::: "memory")
#define PG8_BAR __builtin_amdgcn_s_barrier()
#define PG8_SCHED __builtin_amdgcn_sched_barrier(0)
    Unit cur, nxt; int ui = 0;
    if (!S.next(0, cur)) return;
    f32x4 acc[2][2][4][2];
#pragma unroll
    for (int a = 0; a < 2; ++a)
#pragma unroll
        for (int b = 0; b < 2; ++b)
#pragma unroll
            for (int m = 0; m < 4; ++m)
#pragma unroll
                for (int n = 0; n < 2; ++n) acc[a][b][m][n] = (f32x4){0.f, 0.f, 0.f, 0.f};
    bf16x8 At[4][2], B0[2][2], B1[2][2];
    const size_t ksb = (size_t)K * 2;
    const char* cA = (const char*)g.A + (size_t)cur.pm * tstep + (size_t)cur.ks * ksb; const char* cB = (const char*)g.Bt + (size_t)cur.pn * tstep + (size_t)cur.ks * ksb;
    S.a_ready(cur);
    if constexpr (SP2) {
        PG8_STAGE(PG8_SB(0, 0), cB, voffB); PG8_STAGE(PG8_SB(0, 1), cB + hstep, voffB); PG8_STAGE(PG8_SA(0, 0), cA, voffA); PG8_STAGE(PG8_SA(0, 1), cA + hstep, voffA);
        if (wr == 1) PG8_BAR;
        PG8_WAIT_V(2); PG8_BAR;
        PG8_STAGE(PG8_SB(1, 0), cB + kstep, voffB); PG8_STAGE(PG8_SA(1, 0), cA + kstep, voffA); PG8_STAGE(PG8_SB(1, 1), cB + hstep + kstep, voffB);
        PG8_WAIT_V(6); PG8_BAR;
    } else {
        PG8_STAGE(PG8_SB(0, 0), cB, voffB); PG8_STAGE(PG8_SA(0, 0), cA, voffA); PG8_STAGE(PG8_SB(0, 1), cB + hstep, voffB); PG8_STAGE(PG8_SA(0, 1), cA + hstep, voffA);
        if (wr == 1) PG8_BAR;
        PG8_WAIT_V(4); PG8_BAR;
        PG8_STAGE(PG8_SB(1, 0), cB + kstep, voffB); PG8_STAGE(PG8_SA(1, 0), cA + kstep, voffA); PG8_STAGE(PG8_SB(1, 1), cB + hstep + kstep, voffB);
        PG8_WAIT_V(6); PG8_BAR;
    }
    for (;;) {
        const bool has_next = S.next(ui + 1, nxt);
        const char* nA = has_next ? (const char*)g.A + (size_t)nxt.pm * tstep + (size_t)nxt.ks * ksb : cA; const char* nB = has_next ? (const char*)g.Bt + (size_t)nxt.pn * tstep + (size_t)nxt.ks * ksb : cB;
        for (int t = 0; t < nt; t += 2) {
            const bool last = (t == nt - 2);
            const char* a1 = cA + (size_t)(t + 1) * kstep;
            const char* a2 = last ? nA : cA + (size_t)(t + 2) * kstep; const char* b2 = last ? nB : cB + (size_t)(t + 2) * kstep;
            const char* a3 = a2 + kstep; const char* b3 = b2 + kstep;
            if (last && has_next) S.a_ready(nxt);
            if constexpr (SP2) {
            PG8_LDB(B0, 0, 0); PG8_LDB(B1, 0, 1); PG8_SCHED; PG8_LDA(At, 0, 0); PG8_STAGE(PG8_SA(1, 1), a1 + hstep, voffA);
            PG8_WAIT_V(8); PG8_WAIT_L(0); PG8_BAR; PG8_MMA(0, 0, At, B0); PG8_MMA(0, 1, At, B1); PG8_BAR; PG8_SCHED;
            PG8_LDA(At, 0, 1); PG8_STAGE(PG8_SB(0, 0), b2, voffB); PG8_STAGE(PG8_SB(0, 1), b2 + hstep, voffB); PG8_STAGE(PG8_SA(0, 0), a2, voffA);
            PG8_WAIT_V(8); PG8_WAIT_L(0); PG8_BAR; PG8_MMA(1, 0, At, B0); PG8_MMA(1, 1, At, B1); PG8_BAR; PG8_SCHED;
            PG8_LDB(B0, 1, 0); PG8_LDB(B1, 1, 1); PG8_SCHED; PG8_LDA(At, 1, 0); PG8_STAGE(PG8_SA(0, 1), a2 + hstep, voffA);
            PG8_WAIT_V(8); PG8_WAIT_L(0); PG8_BAR; PG8_MMA(0, 0, At, B0); PG8_MMA(0, 1, At, B1); PG8_BAR; PG8_SCHED;
            PG8_LDA(At, 1, 1); PG8_STAGE(PG8_SB(1, 0), b3, voffB); PG8_STAGE(PG8_SB(1, 1), b3 + hstep, voffB); PG8_STAGE(PG8_SA(1, 0), a3, voffA);
            PG8_WAIT_V(8); PG8_WAIT_L(0); PG8_BAR; PG8_MMA(1, 0, At, B0); PG8_MMA(1, 1, At, B1); PG8_BAR; PG8_SCHED;
            } else {
            PG8_LDB(B0, 0, 0); PG8_SCHED; PG8_LDA(At, 0, 0); PG8_STAGE(PG8_SA(1, 1), a1 + hstep, voffA);
            PG8_WAIT_L(8); PG8_BAR; PG8_WAIT_L(0); PG8_MMA(0, 0, At, B0); PG8_BAR; PG8_SCHED;
            PG8_LDB(B1, 0, 1); PG8_STAGE(PG8_SB(0, 0), b2, voffB);
            PG8_BAR; PG8_WAIT_L(0); PG8_MMA(0, 1, At, B1); PG8_BAR;
            PG8_LDA(At, 0, 1); PG8_STAGE(PG8_SA(0, 0), a2, voffA);
            PG8_BAR; PG8_WAIT_L(0); PG8_MMA(1, 0, At, B0); PG8_BAR; PG8_SCHED;
            PG8_STAGE(PG8_SB(0, 1), b2 + hstep, voffB);
            PG8_WAIT_V(6); PG8_BAR; PG8_MMA(1, 1, At, B1); PG8_BAR;
            PG8_LDB(B0, 1, 0); PG8_SCHED; PG8_LDA(At, 1, 0); PG8_STAGE(PG8_SA(0, 1), a2 + hstep, voffA);
            PG8_WAIT_L(8); PG8_BAR; PG8_WAIT_L(0); PG8_MMA(0, 0, At, B0); PG8_BAR; PG8_SCHED;
            PG8_LDB(B1, 1, 1); PG8_STAGE(PG8_SB(1, 0), b3, voffB);
            PG8_BAR; PG8_WAIT_L(0); PG8_MMA(0, 1, At, B1); PG8_BAR;
            PG8_LDA(At, 1, 1); PG8_STAGE(PG8_SA(1, 0), a3, voffA);
            PG8_BAR; PG8_WAIT_L(0); PG8_MMA(1, 0, At, B0); PG8_BAR; PG8_SCHED;
            PG8_STAGE(PG8_SB(1, 1), b3 + hstep, voffB);
            PG8_WAIT_V(6); PG8_BAR; PG8_MMA(1, 1, At, B1); PG8_BAR;
            }
        }
        if constexpr (ALIGN_EPI) { if (wr == 0) PG8_BAR; }
        if constexpr (!Epi::AFTER_DRAIN) { E(acc, cur, wr, wc, fr, fq); S.done(cur); }
        if (!has_next) break;
#pragma unroll
        for (int a = 0; a < 2; ++a)
#pragma unroll
            for (int b = 0; b < 2; ++b)
#pragma unroll
                for (int m = 0; m < 4; ++m)
#pragma unroll
                    for (int n = 0; n < 2; ++n) acc[a][b][m][n] = (f32x4){0.f, 0.f, 0.f, 0.f};
        cur = nxt; cA = nA; cB = nB; ++ui;
        if constexpr (ALIGN_EPI) { if (wr == 1) PG8_BAR; }
    }
    PG8_WAIT_V(0);
    if constexpr (!ALIGN_EPI) { if (wr == 0) PG8_BAR; }
    PG8_BAR;
    if constexpr (Epi::AFTER_DRAIN) { E.fused(acc, cur, wr, wc, fr, fq, lds, wid, lane); S.done(cur); }
#undef PG8_SA
#undef PG8_SB
#undef PG8_STAGE
#undef PG8_LDA
#undef PG8_LDB
#undef PG8_MMA
#undef PG8_WAIT_V
#undef PG8_WAIT_L
#undef PG8_BAR
#undef PG8_SCHED
}
}

namespace att {
using bf16x8 = __attribute__((ext_vector_type(8))) short;
using s16x4  = __attribute__((ext_vector_type(4))) short;
using f32x16 = __attribute__((ext_vector_type(16))) float;
using u32x4  = __attribute__((ext_vector_type(4))) unsigned;
constexpr int NW = 8, QBLK = 32, KVBLK = 64, DV = 128;
#define ATT_SBAR() __builtin_amdgcn_sched_barrier(0)
__device__ __forceinline__ int crow(int r, int hi) { return (r & 3) + 8 * (r >> 2) + 4 * hi; }
__device__ __forceinline__ unsigned cvtpk(float lo, float hi) { unsigned r; asm volatile("v_cvt_pk_bf16_f32 %0, %1, %2" : "=v"(r) : "v"(lo), "v"(hi)); return r; }
template <int DQK> __device__ __forceinline__ int kswz(int row, int colB) { return row * (DQK * 2) + (colB ^ ((row & 7) << 4)); }
constexpr float THR = 8.f;

template <int DQK> struct Cfg {
    static constexpr int SHM_V = KVBLK * DV * 2, SHM_K = KVBLK * DQK * 2;
    static constexpr int OFF_V = 0, OFF_K = 2 * SHM_V, OFF_WS = OFF_K + 2 * SHM_K, OFF_BIAS = OFF_WS + NW * 64 * 4, LDS_BYTES = OFF_BIAS + 10240;
    static constexpr int KCH = DQK / 8;
    static constexpr int KLD = (64 * KCH) / 512;
};

struct Job {
    const bf16_t* Q;
    const bf16_t* K;
    const bf16_t* V;
    bf16_t* O;
    int nt;
    int seg0_tiles, row_seg0, row_seg1;
    int R0; int rlo;
};

__device__ __forceinline__ int tile_row(const Job& J, int j) {
    if (j < J.seg0_tiles) return J.row_seg0 + 64 * j;
    int jj = j - J.seg0_tiles; if (jj > 3) jj = 0; return J.row_seg1 + 64 * jj;
}

__device__ __forceinline__ void partialSM(f32x16& p0, f32x16& p1, float& m_reg, float& mn, float& alpha, float C, float thr_raw) {
    float pmax = p0[0];
#pragma unroll
    for (int r = 1; r < 16; ++r) pmax = fmaxf(pmax, p0[r]);
#pragma unroll
    for (int r = 0; r < 16; ++r) pmax = fmaxf(pmax, p1[r]);
    { auto rr = __builtin_amdgcn_permlane32_swap(__float_as_uint(pmax), __float_as_uint(pmax), false, false);
      pmax = fmaxf(__uint_as_float(rr[0]), __uint_as_float(rr[1])); }
    if (__builtin_expect(__all(pmax - m_reg <= thr_raw), 1)) { mn = m_reg; alpha = 1.f; }
    else { mn = fmaxf(m_reg, pmax); alpha = __builtin_amdgcn_exp2f((m_reg - mn) * C); m_reg = mn; }
    const float mnC = -mn * C;
#pragma unroll
    for (int r = 0; r < 16; ++r) p0[r] = fmaf(p0[r], C, mnC);
#pragma unroll
    for (int r = 0; r < 16; ++r) p1[r] = fmaf(p1[r], C, mnC);
#pragma unroll
    for (int r = 0; r < 16; ++r) p0[r] = __builtin_amdgcn_exp2f(p0[r]);
}
__device__ __forceinline__ void finishSM(f32x16& p0, f32x16& p1, float alpha, float& l_reg, bf16x8& pa0, bf16x8& pa1, bf16x8& pa2, bf16x8& pa3) {
#pragma unroll
    for (int r = 0; r < 16; ++r) p1[r] = __builtin_amdgcn_exp2f(p1[r]);
    float ps = 0;
#pragma unroll
    for (int r = 0; r < 16; ++r) ps += p0[r];
#pragma unroll
    for (int r = 0; r < 16; ++r) ps += p1[r];
    { auto rr = __builtin_amdgcn_permlane32_swap(__float_as_uint(ps), __float_as_uint(ps), false, false);
      ps = __uint_as_float(rr[0]) + __uint_as_float(rr[1]); }
    l_reg = l_reg * alpha + ps;
#define ATT_PK4(P, BASE, OUT) do { unsigned a0 = cvtpk(P[BASE + 0], P[BASE + 1]), a1 = cvtpk(P[BASE + 2], P[BASE + 3]);   \
    unsigned b0 = cvtpk(P[BASE + 4], P[BASE + 5]), b1 = cvtpk(P[BASE + 6], P[BASE + 7]);                              \
    auto r0 = __builtin_amdgcn_permlane32_swap(a0, b0, false, false); auto r1 = __builtin_amdgcn_permlane32_swap(a1, b1, false, false); \
    u32x4 w = {r0[0], r1[0], r0[1], r1[1]}; OUT = *reinterpret_cast<bf16x8*>(&w); } while (0)
    ATT_PK4(p0, 0, pa0); ATT_PK4(p0, 8, pa1); ATT_PK4(p1, 0, pa2); ATT_PK4(p1, 8, pa3);
#undef ATT_PK4
}
template <int DQK> __device__ __forceinline__ void qkt(f32x16& p0, f32x16& p1, const char* Ks, const bf16x8* qr, int r32, int hi) {
    p0 = f32x16{}; p1 = f32x16{};
#pragma unroll
    for (int d0 = 0; d0 < DQK / 16; ++d0) { const int cb = (d0 * 16 + hi * 8) * 2;
        const bf16x8 b0 = *reinterpret_cast<const bf16x8*>(Ks + kswz<DQK>(r32, cb));
        const bf16x8 b1 = *reinterpret_cast<const bf16x8*>(Ks + kswz<DQK>(32 + r32, cb));
        p0 = __builtin_amdgcn_mfma_f32_32x32x16_bf16(b0, qr[d0], p0, 0, 0, 0);
        p1 = __builtin_amdgcn_mfma_f32_32x32x16_bf16(b1, qr[d0], p1, 0, 0, 0); }
}
__device__ __forceinline__ int v_st(int k, int c) { const int kk = (k & ~0xC) | ((k & 4) << 1) | ((k & 8) >> 1); return ((kk >> 3) * 4 + (c >> 5)) * 512 + ((kk & 7) * 32 + (c & 31)) * 2; }
__device__ __forceinline__ int v_rd_base(int lane) { return ((lane & 3) << 3) | (((lane >> 2) & 3) << 6) | (((lane >> 4) & 1) << 5) | (((lane >> 5) & 1) << 8); }
constexpr int v_rd_off(int d0, int ks, int half) { return d0 * 512 + ks * 4096 + half * 2048; }
template <int OFF> __device__ __forceinline__ s16x4 tr_read(int vb) { s16x4 r; asm volatile("ds_read_b64_tr_b16 %0, %1 offset:%2" : "=&v"(r) : "v"(vb), "i"(OFF) : "memory"); return r; }
template <int D0> __device__ __forceinline__ void pv_one(f32x16& od, int vb, bf16x8 pa0, bf16x8 pa1, bf16x8 pa2, bf16x8 pa3) {
    const s16x4 l0 = tr_read<v_rd_off(D0, 0, 0)>(vb), h0 = tr_read<v_rd_off(D0, 0, 1)>(vb), l1 = tr_read<v_rd_off(D0, 1, 0)>(vb), h1 = tr_read<v_rd_off(D0, 1, 1)>(vb);
    const s16x4 l2 = tr_read<v_rd_off(D0, 2, 0)>(vb), h2 = tr_read<v_rd_off(D0, 2, 1)>(vb), l3 = tr_read<v_rd_off(D0, 3, 0)>(vb), h3 = tr_read<v_rd_off(D0, 3, 1)>(vb);
    asm volatile("s_waitcnt lgkmcnt(0)" ::: "memory"); ATT_SBAR();
#define ATT_PK(L, H) (bf16x8){L[0], L[1], L[2], L[3], H[0], H[1], H[2], H[3]}
    od = __builtin_amdgcn_mfma_f32_32x32x16_bf16(pa0, ATT_PK(l0, h0), od, 0, 0, 0);
    od = __builtin_amdgcn_mfma_f32_32x32x16_bf16(pa1, ATT_PK(l1, h1), od, 0, 0, 0);
    od = __builtin_amdgcn_mfma_f32_32x32x16_bf16(pa2, ATT_PK(l2, h2), od, 0, 0, 0);
    od = __builtin_amdgcn_mfma_f32_32x32x16_bf16(pa3, ATT_PK(l3, h3), od, 0, 0, 0);
#undef ATT_PK
}
__device__ __forceinline__ void pv_d0(f32x16* o, int vb, bf16x8 pa0, bf16x8 pa1, bf16x8 pa2, bf16x8 pa3) {
    pv_one<0>(o[0], vb, pa0, pa1, pa2, pa3); pv_one<1>(o[1], vb, pa0, pa1, pa2, pa3); pv_one<2>(o[2], vb, pa0, pa1, pa2, pa3); pv_one<3>(o[3], vb, pa0, pa1, pa2, pa3);
}
constexpr int NA_BROW = 160, NA_BORG = 64 + (NA_KW - 1);
__device__ __forceinline__ void na_bias(f32x16& p0, f32x16& p1, const Job& J, int j, int R, int c, int hi, const float* biasq) {
    const int nloc = J.seg0_tiles;
    if (j >= nloc && j < nloc + 4) return;
    const int rr = J.rlo + j; int r0 = R - NA_KH / 2; r0 = r0 < 0 ? 0 : (r0 > ROWS - NA_KH ? ROWS - NA_KH : r0);
    const bool rowok = (j < nloc) && rr >= r0 && rr < r0 + NA_KH;
    if (!rowok) {
#pragma unroll
        for (int r = 0; r < 16; ++r) { p0[r] = -1e30f; p1[r] = -1e30f; }
        return; }
    int c0 = c - NA_KW / 2; c0 = c0 < 0 ? 0 : (c0 > GRID_W - NA_KW ? GRID_W - NA_KW : c0);
    const int dr = rr - R + (NA_KH - 1);
    const float* bl = biasq + dr * NA_BROW + NA_BORG + 4 * hi - c;
    const int vb = 4 * hi - c0;
#pragma unroll
    for (int r = 0; r < 16; ++r) { const int cc = (r & 3) + 8 * (r >> 2);
        p0[r] = ((unsigned)(cc + vb) < (unsigned)NA_KW) ? p0[r] + bl[cc] : -1e30f;
        p1[r] = ((unsigned)(cc + 32 + vb) < (unsigned)NA_KW) ? p1[r] + bl[cc + 32] : -1e30f; }
}

#define ATT_LAS __attribute__((address_space(3)))
template <int DQK, bool NA, int LDQ, int LDK, int LDV, int LDO>
__device__ __forceinline__ void attn_unit(const Job& J, char* lds, const float scale, const int tid_in) {
    using C_ = Cfg<DQK>;
    int tid_ = tid_in; asm volatile("" : "+v"(tid_));
    const int tid = tid_, wid = __builtin_amdgcn_readfirstlane(tid >> 6), lane = tid & 63, r32 = lane & 31, hi = lane >> 5;
    char* V_lds = lds + C_::OFF_V; char* K_lds = lds + C_::OFF_K;
    const unsigned ldsb = (unsigned)(uintptr_t)lds;
    float* wsf = (float*)(lds + C_::OFF_WS) + wid * 64; float* li_l = wsf; float* al_l = wsf + 32;
    const float* biasq = (const float*)(lds + C_::OFF_BIAS);
    const float Cc = scale * 1.4426950408889634f, thr_raw = THR / scale;
    float m_reg = -1e5f, l_reg = 0; f32x16 o[4] = {}; bf16x8 qr[DQK / 16];
    const bf16_t* Qw = J.Q + (long)(wid * QBLK + r32) * LDQ + hi * 8;
#pragma unroll
    for (int d0 = 0; d0 < DQK / 16; ++d0) qr[d0] = *reinterpret_cast<const bf16x8*>(Qw + d0 * 16);
    const int naR = J.R0 + (wid >> 1), nac = (wid & 1) * 32 + r32;
    const int vb0 = (int)(uintptr_t)V_lds + v_rd_base(lane);
    unsigned koff[C_::KLD], voff[2];
#pragma unroll
    for (int i = 0; i < C_::KLD; ++i) { const int sl = 512 * i + tid, row = sl / C_::KCH, cs = sl % C_::KCH, chunk = (cs & ~7) | ((cs & 7) ^ (row & 7)); koff[i] = (unsigned)(row * LDK * 2 + chunk * 16); }
#pragma unroll
    for (int i = 0; i < 2; ++i) { const int sl = 512 * i + tid, sub = sl >> 5, wi = sl & 31, kk = (sub >> 2) * 8 + (wi >> 2), k = (kk & ~0xC) | ((kk & 4) << 1) | ((kk & 8) >> 1), c = (sub & 3) * 32 + (wi & 3) * 8;
        voff[i] = (unsigned)(k * LDV * 2 + c * 2); }
#define ATT_STAGE(j, b) do { const int row0_ = tile_row(J, (j)); const char* vp_ = (const char*)(J.V + (size_t)row0_ * LDV); const char* kp_ = (const char*)(J.K + (size_t)row0_ * LDK); \
        _Pragma("unroll") for (int i_ = 0; i_ < C_::KLD; ++i_) __builtin_amdgcn_global_load_lds((const unsigned*)(kp_ + koff[i_]), (ATT_LAS unsigned*)(ldsb + C_::OFF_K + (b) * C_::SHM_K + (512 * i_ + 64 * wid) * 16), 16, 0, 0); \
        _Pragma("unroll") for (int i_ = 0; i_ < 2; ++i_) __builtin_amdgcn_global_load_lds((const unsigned*)(vp_ + voff[i_]), (ATT_LAS unsigned*)(ldsb + C_::OFF_V + (b) * C_::SHM_V + (512 * i_ + 64 * wid) * 16), 16, 0, 0); } while (0)
    const int NT = J.nt;
    __syncthreads();
    ATT_STAGE(0, 0); asm volatile("s_waitcnt vmcnt(0)" ::: "memory"); __syncthreads();
    for (int j = 0; j < NT; ++j) {
        const int buf = j & 1;
        if (j + 1 < NT) ATT_STAGE(j + 1, buf ^ 1);
        bool live = true;
        if (NA) { const int nloc = J.seg0_tiles; if (j >= nloc + 4) live = false; else if (j < nloc) { const int rr = J.rlo + j; int r0 = naR - NA_KH / 2; r0 = r0 < 0 ? 0 : (r0 > ROWS - NA_KH ? ROWS - NA_KH : r0); live = rr >= r0 && rr < r0 + NA_KH; } }
        if (live) {
        f32x16 p0, p1; float mn, al; bf16x8 pa0, pa1, pa2, pa3;
        qkt<DQK>(p0, p1, K_lds + buf * C_::SHM_K, qr, r32, hi);
        if (NA) na_bias(p0, p1, J, j, naR, nac, hi, biasq);
        partialSM(p0, p1, m_reg, mn, al, Cc, thr_raw);
        finishSM(p0, p1, al, l_reg, pa0, pa1, pa2, pa3);
        if (__any(al < 1.f)) { if (hi == 0) al_l[r32] = al; asm volatile("s_waitcnt lgkmcnt(0)" ::: "memory");
#pragma unroll
            for (int d = 0; d < 4; ++d)
#pragma unroll
                for (int r = 0; r < 16; ++r) o[d][r] *= al_l[crow(r, hi)]; }
        ATT_SBAR();
        pv_d0(o, vb0 + buf * C_::SHM_V, pa0, pa1, pa2, pa3);
        }
        asm volatile("s_waitcnt vmcnt(0)" ::: "memory");
        __syncthreads();
    }
    if (hi == 0) li_l[r32] = l_reg; asm volatile("s_waitcnt lgkmcnt(0)" ::: "memory");
    float rli[16];
#pragma unroll
    for (int r = 0; r < 16; ++r) rli[r] = __builtin_amdgcn_rcpf(li_l[crow(r, hi)]);
    bf16_t* Ow = J.O + (long)(wid * QBLK) * LDO;
#pragma unroll
    for (int r = 0; r < 16; ++r) { const int orow = crow(r, hi);
#pragma unroll
        for (int d0 = 0; d0 < 4; ++d0) Ow[(long)orow * LDO + d0 * 32 + r32] = f2bf(o[d0][r] * rli[r]); }
#undef ATT_STAGE
}
}

struct AttnArgs { const bf16_t *QM, *KM, *VM, *NQ, *NK, *P; bf16_t* Y; const float* rpb; int want_ctx; int pad; };
__device__ __forceinline__ void attention_phase(const AttnArgs& A, char* lds, int G, int wg, const int tid, const int nskip) {
    static_assert(GRID_W == 64 && SEQ % 256 == 0 && CTX_LEN == 256 && HD == 128, "attention phase geometry");
    constexpr int NQB = SEQ / 256;
    constexpr float sc_mla = 0.07216878364870323f, sc_na = 0.08838834764831845f;
    static_assert(MLA_QK == 192 && HD == 128, "softmax scales");
    if (!(A.pad & 2)) for (int u = wg; u < BATCH * NH * NQB; u += G) {
        const int bh = u % (BATCH * NH), qb = u / (BATCH * NH), b = bh / NH, h = bh % NH;
        att::Job J{};
        J.Q = A.QM + (size_t)(b * SEQ + qb * 256) * NQ_MLA + h * MLA_QK; J.K = A.KM + h * MLA_QK; J.V = A.VM + h * MLA_V;
        J.O = A.Y + (size_t)(b * SEQ + qb * 256) * D_MODEL + GROUP_W + h * MLA_V;
        J.nt = SEQ / 64 + CTX_LEN / 64; J.seg0_tiles = SEQ / 64; J.row_seg0 = b * SEQ; J.row_seg1 = M_LAT + b * CTX_LEN;
        att::attn_unit<MLA_QK, false, NQ_MLA, NQ_MLA, NH * MLA_V, D_MODEL>(J, lds, sc_mla, tid);
    }
    const int G2n = G - nskip, c2 = wg - nskip;
    if (!(A.pad & 4) && c2 >= 0) for (int u = c2; u < BATCH * NH * NQB; u += G2n) {
        const int bh = u % (BATCH * NH), qb = u / (BATCH * NH), b = bh / NH, h = bh % NH, R0 = qb * 4;
        __syncthreads();
        { float* bq = (float*)(lds + att::Cfg<HD>::OFF_BIAS); const float* src = A.rpb + (size_t)h * (2 * NA_KH - 1) * (2 * NA_KW - 1);
          for (int i = tid; i < (2 * NA_KH - 1) * att::NA_BROW; i += 512) { const int dr = i / att::NA_BROW; int dc = i % att::NA_BROW - att::NA_BORG + (NA_KW - 1); dc = dc < 0 ? 0 : (dc > 2 * NA_KW - 2 ? 2 * NA_KW - 2 : dc);
              bq[i] = src[dr * (2 * NA_KW - 1) + dc] * 11.313708498984761f; } }
        int rlo = R0 - NA_KH / 2; rlo = rlo < 0 ? 0 : (rlo > ROWS - NA_KH ? ROWS - NA_KH : rlo);
        int rhi = R0 + 3 - NA_KH / 2; rhi = (rhi < 0 ? 0 : (rhi > ROWS - NA_KH ? ROWS - NA_KH : rhi)) + NA_KH - 1;
        const int nloc = rhi - rlo + 1;
        att::Job J{};
        J.Q = A.NQ + (size_t)(b * SEQ + R0 * 64) * GROUP_W + h * HD; J.K = A.NK + h * HD; J.V = A.P + C_NV + h * HD;
        J.O = A.Y + (size_t)(b * SEQ + R0 * 64) * D_MODEL + 3 * GROUP_W + h * HD;
        J.nt = (nloc + 4 + 1) & ~1; J.seg0_tiles = nloc; J.row_seg0 = b * SEQ + rlo * 64; J.row_seg1 = M_LAT + b * CTX_LEN;  J.R0 = R0; J.rlo = rlo;
        att::attn_unit<HD, true, GROUP_W, GROUP_W, NP, D_MODEL>(J, lds, sc_na, tid);
    }
    if (A.want_ctx && !(A.pad & 8)) {
        for (int u = c2 - 64; u >= 0 && u < BATCH * NH; u += G) {
            const int b = u / NH, h = u % NH; const int crow0 = M_LAT + b * CTX_LEN;
            att::Job J{}; J.nt = CTX_LEN / 64; J.seg0_tiles = 0; J.row_seg0 = crow0; J.row_seg1 = crow0;
            J.Q = A.QM + (size_t)crow0 * NQ_MLA + h * MLA_QK; J.K = A.KM + h * MLA_QK; J.V = A.VM + h * MLA_V;
            J.O = A.Y + (size_t)crow0 * D_MODEL + GROUP_W + h * MLA_V; att::attn_unit<MLA_QK, false, NQ_MLA, NQ_MLA, NH * MLA_V, D_MODEL>(J, lds, sc_mla, tid);
        }
        for (int u = c2 - 64 - BATCH * NH; u >= 0 && u < BATCH * NH; u += G) {
            const int b = u / NH, h = u % NH; const int crow0 = M_LAT + b * CTX_LEN;
            att::Job J{}; J.nt = CTX_LEN / 64; J.seg0_tiles = 0; J.row_seg0 = crow0; J.row_seg1 = crow0;
            J.Q = A.NQ + (size_t)crow0 * GROUP_W + h * HD; J.K = A.NK + h * HD; J.V = A.P + C_NV + h * HD;
            J.O = A.Y + (size_t)crow0 * D_MODEL + 3 * GROUP_W + h * HD; att::attn_unit<HD, false, GROUP_W, GROUP_W, NP, D_MODEL>(J, lds, sc_na, tid);
        }
    }
}

namespace gdn {
typedef short bf16x8 __attribute__((ext_vector_type(8)));
typedef float f32x4 __attribute__((ext_vector_type(4)));
typedef float f32x16 __attribute__((ext_vector_type(16)));
typedef unsigned u32x2 __attribute__((ext_vector_type(2)));
typedef unsigned u32x4 __attribute__((ext_vector_type(4)));
constexpr int CH = 64, NCHUNK = M_ALL / CH;
constexpr int NTASK = NCHUNK * NH * 2;
constexpr size_t SZ_UT = 128 * 64, SZ_WP = 64 * 128, SZ_KDT = 128 * 64, SZ_QD = 64 * 128, SZ_QK = 64 * 64, SZ_SIT = 128 * 128, SZ_VNT = 128 * 64;
struct Bufs { bf16_t *UT, *WP, *KDT, *QD, *QK, *SIT, *VNT; float* GT; };
__device__ __forceinline__ int perm32(int o) { return (o & ~31) | (((o & 15) >> 2) * 8 + ((o >> 4) & 1) * 4 + (o & 3)); }
__device__ __forceinline__ unsigned pk2(float lo, float hi) { return (unsigned)f2bf(lo) | ((unsigned)f2bf(hi) << 16); }

constexpr int QS = 132;
constexpr int AS = 68;
constexpr int AH = 72;
typedef _Float16 h16x8 __attribute__((ext_vector_type(8)));
constexpr int G1_OFF_Q = 0, G1_OFF_K = G1_OFF_Q + CH * QS * 4, G1_OFF_V = G1_OFF_K + CH * QS * 4, G1_OFF_AA = G1_OFF_V + CH * QS * 4, G1_OFF_SM = G1_OFF_AA + 2 * CH * AS * 4,
              G1_LDS = G1_OFF_SM + 12 * 64 * 4;
struct G1Args { const bf16_t* P; const float* conv_w; const float* a_log; const float* dt_bias; Bufs B; int pflags; };

template <int P, int M> __device__ __forceinline__ void g1_sweep_m(float (&x)[CH], const _Float16* rowp, const float xp) {
    constexpr int N = 63 - P;
    if constexpr (8 * M < N) {
        const h16x8 a8 = *(const h16x8*)(rowp + 8 * M);
        constexpr int NE = (N - 8 * M) < 8 ? (N - 8 * M) : 8;
#pragma unroll
        for (int e = 0; e < NE; ++e) x[63 - (8 * M + e)] = __builtin_fmaf(-(float)a8[e], xp, x[63 - (8 * M + e)]);
        g1_sweep_m<P, M + 1>(x, rowp, xp);
    }
}
template <int P> __device__ __forceinline__ void g1_sweep(float (&x)[CH], const _Float16* AAv) {
    if constexpr (P < CH - 1) { g1_sweep_m<P, 0>(x, AAv + (63 - P) * AH, x[P]); g1_sweep<P + 1>(x, AAv); }
}

__device__ __forceinline__ void g1_load(const G1Args& A, int cix, int h, int tid, u32x4 (&xr)[11], float (&gin)[4]) {
    const RowInfo r0i = row_info(cix * CH);
    if (tid < 128) { const int d = tid >> 6, i = tid & 63; const size_t r = (size_t)(cix * CH + i) * NP;
        gin[0] = bf2f(A.P[r + C_GB + d * NH + h]); gin[1] = bf2f(A.P[r + C_GA + d * NH + h]); gin[2] = A.a_log[d * NH + h]; gin[3] = A.dt_bias[d * NH + h]; }
    if (tid < 48 * 8) { const int grp = tid % 48, ts = tid / 48, which = grp >> 4, cc0 = (grp & 15) * 8, ch0 = which * GROUP_W + h * HD + cc0;
#pragma unroll
        for (int k = 0; k < 11; ++k) { const int tt = r0i.t + 8 * ts + k - 1;
            xr[k] = (tt >= 0 && tt < r0i.T && !(A.pflags & 4096)) ? *(const u32x4*)(A.P + (size_t)(r0i.base + tt) * NP + C_GQ + ch0) : (u32x4){0u, 0u, 0u, 0u}; } }
}
__device__ __forceinline__ void g1_task(const G1Args& A, char* lds, int cix, int h, const int tid_in, u32x4 (&xr)[11], float (&gin)[4], const int ncix, const int nh, const bool has_next) {
    int tid_ = tid_in; asm volatile("" : "+v"(tid_));
    const int tid = tid_, wid = __builtin_amdgcn_readfirstlane(tid >> 6), lane = tid & 63;
    float* Qs = (float*)(lds + G1_OFF_Q); float* Ks = (float*)(lds + G1_OFF_K); float* Vs = (float*)(lds + G1_OFF_V); _Float16* AA = (_Float16*)(lds + G1_OFF_AA);
    float* sm = (float*)(lds + G1_OFF_SM); float* g_s = sm;   float* beta_s = sm + 128;   float* gc_s = sm + 256;
    const int row0 = cix * CH; const RowInfo r0i = row_info(row0);
    LDS_BARRIER();
    if (tid < 48 * 8) {
        const int grp = tid % 48, ts = tid / 48, which = grp >> 4, cc0 = (grp & 15) * 8, ch0 = which * GROUP_W + h * HD + cc0;
        float wgt[4][8];
#pragma unroll
        for (int j = 0; j < 4; ++j) { const f32x4 w0 = *(const f32x4*)(A.conv_w + j * 3 * GROUP_W + ch0), w1 = *(const f32x4*)(A.conv_w + j * 3 * GROUP_W + ch0 + 4);
#pragma unroll
            for (int e = 0; e < 4; ++e) { wgt[j][e] = w0[e]; wgt[j][4 + e] = w1[e]; } }
        float* dstp = (which == 0 ? Qs : which == 1 ? Ks : Vs) + cc0;
#pragma unroll
        for (int i = 0; i < 8; ++i) { float acc[8];
#pragma unroll
            for (int e = 0; e < 8; ++e) acc[e] = 0.f;
#pragma unroll
            for (int j = 0; j < 4; ++j) { const u32x4 xv = xr[i + j];
#pragma unroll
                for (int e = 0; e < 4; ++e) { acc[2 * e] += wgt[j][2 * e] * bflo(xv[e]); acc[2 * e + 1] += wgt[j][2 * e + 1] * bfhi(xv[e]); } }
            f32x4 y0, y1;
#pragma unroll
            for (int e = 0; e < 4; ++e) { y0[e] = acc[e] * __builtin_amdgcn_rcpf(1.0f + __expf(-acc[e])); y1[e] = acc[4 + e] * __builtin_amdgcn_rcpf(1.0f + __expf(-acc[4 + e])); }
            *(f32x4*)(dstp + (8 * ts + i) * QS) = y0; *(f32x4*)(dstp + (8 * ts + i) * QS + 4) = y1; }
    }
    if (tid < 128) { const int d = tid >> 6, i = tid & 63;
        beta_s[d * 64 + i] = 1.0f / (1.0f + __expf(-gin[0]));
        g_s[d * 64 + i] = -__expf(gin[2]) * softplusf_(gin[1] + gin[3]); }
    if (has_next) g1_load(A, ncix, nh, tid, xr, gin);
    LDS_BARRIER();
    for (int rr = wid * 4 + (lane >> 4); rr < 2 * CH; rr += 32) { float* rowp = (rr < CH ? Qs : Ks) + (rr & 63) * QS + (lane & 15) * 8;
        f32x4 a = *(const f32x4*)rowp, b = *(const f32x4*)(rowp + 4); float ss = (a[0] * a[0] + a[1] * a[1]) + (a[2] * a[2] + a[3] * a[3]) + (b[0] * b[0] + b[1] * b[1]) + (b[2] * b[2] + b[3] * b[3]);
#pragma unroll
        for (int o = 1; o < 16; o <<= 1) ss += lane_xor(ss, o, lane);
        const float scl = __builtin_amdgcn_rsqf(ss + EPS) * (rr < CH ? 0.08838834764831845f : 1.0f);
        *(f32x4*)rowp = a * scl; *(f32x4*)(rowp + 4) = b * scl; }
    if (tid < 2) {
        f32x4 gv[16];
#pragma unroll
        for (int m = 0; m < 16; ++m) gv[m] = *(const f32x4*)(g_s + tid * 64 + 4 * m);
        float run = 0.f;
        if (tid == 0) {
#pragma unroll
            for (int m = 0; m < 16; ++m) { f32x4 o4;
#pragma unroll
                for (int e = 0; e < 4; ++e) { run += gv[m][e]; o4[e] = run; }
                *(f32x4*)(gc_s + 4 * m) = o4; }
        } else {
#pragma unroll
            for (int m = 15; m >= 0; --m) { f32x4 o4;
#pragma unroll
                for (int e = 3; e >= 0; --e) { run += gv[m][e]; o4[e] = run; }
                *(f32x4*)(gc_s + 64 + 4 * m) = o4; }
        }
    }
    LDS_BARRIER();
    float* eq_s = sm + 384; float* ek_s = sm + 512;
    if (tid < 128) { const int d = tid >> 6, i = tid & 63; const float gci = gc_s[d * 64 + i], glast = d == 0 ? gc_s[63] : gc_s[64];
        eq_s[tid] = __expf(gci); ek_s[tid] = __expf(glast - gci); }
    const int gwhich = wid >> 2, gI = (wid >> 1) & 1, gJ = wid & 1, r32 = lane & 31, hi = lane >> 5;
    f32x16 acc = {};
    if (!(A.pflags & 1024)) {
        const float* X = (gwhich ? Qs : Ks) + (32 * gI + r32) * QS + 4 * hi; const float* Yp = Ks + (32 * gJ + r32) * QS + 4 * hi;
#pragma unroll
        for (int s = 0; s < 16; ++s) { const f32x4 a4 = *(const f32x4*)(X + 8 * s), b4 = *(const f32x4*)(Yp + 8 * s);
#pragma unroll
            for (int e = 0; e < 4; ++e) acc = __builtin_amdgcn_mfma_f32_32x32x2f32(a4[e], b4[e], acc, 0, 0, 0); }
        const int j = 32 * gJ + r32;
        if (gwhich == 0) {
            const float b1j = beta_s[64 + j], g0j = gc_s[j], g1j = gc_s[64 + j];
#pragma unroll
            for (int r = 0; r < 16; ++r) { const int i = 32 * gI + (r & 3) + 8 * (r >> 2) + 4 * hi;
                if (i > j) { const float kk = acc[r];
                    AA[(63 - j) * AH + (63 - i)] = (_Float16)(beta_s[i] * kk * __expf(gc_s[i] - g0j));
                    AA[CH * AH + i * AH + j] = (_Float16)(b1j * kk * __expf(g1j - gc_s[64 + i])); } }
        }
    }
    LDS_BARRIER();
    const size_t t0 = ((size_t)cix * NH + h) * 2;
    if (!(A.pflags & 2048)) {
#pragma unroll
        for (int n = 0; n < 4; ++n) { const int it = tid + 512 * n, d = it >> 10, p = (it >> 4) & 63, m = it & 15, i = d == 0 ? p : 63 - p, k0 = 32 * (m >> 2) + 4 * (m & 3);
            const float e = eq_s[d * 64 + i]; const f32x4 lo = *(const f32x4*)(Qs + i * QS + k0), hi4 = *(const f32x4*)(Qs + i * QS + k0 + 16);
            *(u32x4*)(A.B.QD + (t0 + d) * SZ_QD + (size_t)p * 128 + m * 8) = (u32x4){pk2(lo[0] * e, lo[1] * e), pk2(lo[2] * e, lo[3] * e), pk2(hi4[0] * e, hi4[1] * e), pk2(hi4[2] * e, hi4[3] * e)}; }
#pragma unroll
        for (int n = 0; n < 4; ++n) { const int it = tid + 512 * n, k = it & 127, d = (it >> 7) & 1, m = it >> 8, p0 = 32 * (m >> 2) + 4 * (m & 3);
            float v[8];
#pragma unroll
            for (int jj = 0; jj < 8; ++jj) { const int p = p0 + (jj < 4 ? jj : 12 + jj), i = d == 0 ? p : 63 - p; v[jj] = Ks[i * QS + k] * ek_s[d * 64 + i]; }
            *(u32x4*)(A.B.KDT + (t0 + d) * SZ_KDT + (size_t)k * 64 + m * 8) = (u32x4){pk2(v[0], v[1]), pk2(v[2], v[3]), pk2(v[4], v[5]), pk2(v[6], v[7])}; }
        if (tid == 0) { A.B.GT[t0] = __expf(gc_s[63]); A.B.GT[t0 + 1] = __expf(gc_s[64]); }
    }
    LDS_BARRIER();
    bf16_t* stg = (bf16_t*)Qs;
    if (gwhich == 1) { const int j = 32 * gJ + r32; const float g0j = gc_s[j], g1j = gc_s[64 + j];
#pragma unroll
        for (int r = 0; r < 16; ++r) { const int i = 32 * gI + (r & 3) + 8 * (r >> 2) + 4 * hi; const float qk = acc[r];
            stg[i * 64 + perm32(j)] = f2bf(i >= j ? qk * __expf(gc_s[i] - g0j) : 0.f);
            stg[4096 + (63 - i) * 64 + perm32(63 - j)] = f2bf(i <= j ? qk * __expf(gc_s[64 + i] - g1j) : 0.f); } }
    LDS_BARRIER();
#pragma unroll
    for (int n = 0; n < 2; ++n) { const int c16 = tid + 512 * n; *(u32x4*)(A.B.QK + t0 * SZ_QK + (size_t)c16 * 8) = *(const u32x4*)(stg + c16 * 8); }
    if (!(A.pflags & 512)) {
        int tidv = tid; asm volatile("" : "+v"(tidv));
        const int d = tidv >> 8, c = tidv & 255; const bool isw = c >= 128; const int cc = c & 127;
        const float* src = isw ? Ks : Vs;
        int lz; asm volatile("v_mov_b32 %0, 0" : "=v"(lz));
        const _Float16* AAv = AA + lz + d * (CH * AH);
        float x[CH];
#pragma unroll
        for (int p = 0; p < CH; ++p) { const int i = d == 0 ? p : 63 - p; float f = beta_s[d * 64 + i]; if (isw) f *= eq_s[d * 64 + i]; x[p] = f * src[i * QS + cc]; }
        {
            g1_sweep<0>(x, AAv);

        }
        LDS_BARRIER();
        if (!isw) { bf16_t* dst = A.B.UT + (t0 + d) * SZ_UT + (size_t)((cc >> 4) * 2 * 64 + (cc & 15)) * 8;
#pragma unroll
            for (int s = 0; s < 2; ++s)
#pragma unroll
                for (int qq = 0; qq < 4; ++qq) { const int p0 = 32 * s + 4 * qq; u32x4 w4; w4.x = pk2(x[p0], x[p0 + 1]); w4.y = pk2(x[p0 + 2], x[p0 + 3]); w4.z = pk2(x[p0 + 16], x[p0 + 17]); w4.w = pk2(x[p0 + 18], x[p0 + 19]);
                    *(u32x4*)(dst + (size_t)(s * 64 + qq * 16) * 8) = w4; }
        } else { bf16_t* dst = stg + d * 8192 + perm32(cc);
#pragma unroll
            for (int p = 0; p < CH; ++p) dst[p * 128] = f2bf(x[p]); }
    }
    LDS_BARRIER();
#pragma unroll
    for (int n = 0; n < 4; ++n) { const int c16 = tid + 512 * n; *(u32x4*)(A.B.WP + t0 * SZ_WP + (size_t)c16 * 8) = *(const u32x4*)(stg + c16 * 8); }
}
__device__ __forceinline__ void g1_phase(const G1Args& A, char* lds, int G, int wg, const int tid) {
    u32x4 xr[11]; float gin[4];
    if (wg < NCHUNK * NH) g1_load(A, wg / NH, wg % NH, tid, xr, gin);
    for (int t = wg; t < NCHUNK * NH; t += G) { const int tn = t + G; g1_task(A, lds, t / NH, t % NH, tid, xr, gin, tn / NH, tn % NH, tn < NCHUNK * NH); }
}

constexpr int G2_SPLIT = 4, G2_NACT = 8 / G2_SPLIT, G2_NSTEP = CTX_LEN / CH + SEQ / CH, G2_WGS = BATCH * NH * 2 * G2_SPLIT;
constexpr int G2_USL = G2_NACT * 2 * 64 * 16;
constexpr int G2_BUF = 16384 + 16384 + G2_USL, G2_NB = 4, G2_LDS = G2_NB * G2_BUF;
static_assert(G2_SPLIT == 4 && G2_USL == 4096, "G2 staging map below assumes 4 KB of u per step");
__device__ __forceinline__ int g2_task_index(int b, int h, int d, int step) {
    constexpr int NC = CTX_LEN / CH, NL = SEQ / CH; int cix;
    if (step < NC) { const int n = d ? NC - 1 - step : step; cix = M_LAT / CH + b * NC + n; }
    else { const int s2 = step - NC, n = d ? NL - 1 - s2 : s2; cix = b * NL + n; }
    return (cix * NH + h) * 2 + d;
}
__device__ __forceinline__ void g2_chain(const Bufs& B, char* lds, int chain_part, const int tid_in, const int step_lo, const int step_hi, float* Ssave) {
    int tid_ = tid_in; asm volatile("" : "+v"(tid_));
    const int tid = tid_, wid = __builtin_amdgcn_readfirstlane(tid >> 6), lane = tid & 63, q = lane >> 4, vl = lane & 15;
    const int chain = chain_part / G2_SPLIT, part = chain_part % G2_SPLIT;
    const bool active = wid < G2_NACT; const int vt = part * G2_NACT + (active ? wid : 0);
    const int d = chain & 1, h = (chain >> 1) % NH, b = chain / (2 * NH);
    constexpr int NSTEP = CTX_LEN / CH + SEQ / CH;
    const unsigned ldsb = (unsigned)(uintptr_t)lds;
    f32x4 S[8];
    f32x4* sv = (f32x4*)Ssave + ((size_t)chain_part * G2_NACT + (active ? wid : 0)) * 8 * 64 + lane;
#pragma unroll
    for (int kb = 0; kb < 8; ++kb) S[kb] = (step_lo > 0 && active) ? sv[kb * 64] : (f32x4){0.f, 0.f, 0.f, 0.f};
    unsigned offw[2], offk[2], offu;
#pragma unroll
    for (int i = 0; i < 2; ++i) { const int sl = 128 * wid + 64 * i + lane;
        { const int row = sl >> 4, pc = sl & 15, c = pc ^ (row & 15); offw[i] = (unsigned)(row * 256 + c * 16); }
        { const int row = sl >> 3, pc = sl & 7, c = pc ^ ((row >> 1) & 7); offk[i] = (unsigned)(row * 128 + c * 16); } }
    offu = (unsigned)((part * G2_NACT * 2 * 64 + (wid & 3) * 64 + lane) * 16);
#define G2_DMA(ti, slot) do { const char* wp_ = (const char*)(B.WP + (size_t)(ti) * SZ_WP); const char* kp_ = (const char*)(B.KDT + (size_t)(ti) * SZ_KDT); const unsigned base_ = ldsb + (unsigned)(slot) * G2_BUF; \
        _Pragma("unroll") for (int i_ = 0; i_ < 2; ++i_) { \
            __builtin_amdgcn_global_load_lds((const unsigned*)(wp_ + offw[i_]), (ATT_LAS unsigned*)(base_ + (128 * wid + 64 * i_) * 16), 16, 0, 0); \
            __builtin_amdgcn_global_load_lds((const unsigned*)(kp_ + offk[i_]), (ATT_LAS unsigned*)(base_ + 16384 + (128 * wid + 64 * i_) * 16), 16, 0, 0); } \
        if (wid >= 4) __builtin_amdgcn_global_load_lds((const unsigned*)((const char*)(B.UT + (size_t)(ti) * SZ_UT) + offu), (ATT_LAS unsigned*)(base_ + 32768 + ((wid & 3) * 64) * 16), 16, 0, 0); } while (0)
#define G2_TI(step) g2_task_index(b, h, d, (step) < NSTEP ? (step) : NSTEP - 1)
    __syncthreads();
    G2_DMA(G2_TI(step_lo), step_lo & 3); G2_DMA(G2_TI(step_lo + 1), (step_lo + 1) & 3); G2_DMA(G2_TI(step_lo + 2), (step_lo + 2) & 3);
    asm volatile("s_waitcnt vmcnt(0)" ::: "memory");
    __syncthreads();
    for (int step = step_lo; step < step_hi; ++step) {
        const int ti = G2_TI(step), slot = step & 3;
        G2_DMA(G2_TI(step + 3), (step + 3) & 3);
        unsigned gtb; { const float* gp = B.GT + ti; asm volatile("s_load_dword %0, %1, 0x0" : "=s"(gtb) : "s"(gp)); }
        const char* wl = lds + slot * G2_BUF; const char* kl = wl + 16384; const char* ul = kl + 16384;
        if (active) {
            bf16x8 aw[16], ak[16];
#pragma unroll
            for (int rb = 0; rb < 4; ++rb)
#pragma unroll
                for (int s = 0; s < 4; ++s) aw[rb * 4 + s] = *(const bf16x8*)(wl + (16 * rb + vl) * 256 + (((4 * s + q) ^ vl) << 4));
#pragma unroll
            for (int kb = 0; kb < 8; ++kb)
#pragma unroll
                for (int s = 0; s < 2; ++s) ak[kb * 2 + s] = *(const bf16x8*)(kl + (16 * kb + vl) * 128 + (((4 * s + q) ^ ((vl >> 1) & 7)) << 4));
            u32x4 uu[2];
#pragma unroll
            for (int s = 0; s < 2; ++s) uu[s] = *(const u32x4*)(ul + ((wid * 2 + s) * 64 + lane) * 16);
            bf16_t* sit = B.SIT + (size_t)ti * SZ_SIT + (size_t)(vt * 4 * 64 + lane) * 8;
            bf16x8 sf[4];
#pragma unroll
            for (int s = 0; s < 4; ++s) { u32x4 w4; w4.x = pk2(S[2 * s][0], S[2 * s][1]); w4.y = pk2(S[2 * s][2], S[2 * s][3]); w4.z = pk2(S[2 * s + 1][0], S[2 * s + 1][1]); w4.w = pk2(S[2 * s + 1][2], S[2 * s + 1][3]);
                sf[s] = __builtin_bit_cast(bf16x8, w4); *(u32x4*)(sit + (size_t)s * 64 * 8) = w4; }
            __builtin_amdgcn_sched_barrier(0);
            f32x4 vn[4];
#pragma unroll
            for (int rb = 0; rb < 4; ++rb) vn[rb] = (f32x4){0.f, 0.f, 0.f, 0.f};
#pragma unroll
            for (int s = 0; s < 4; ++s)
#pragma unroll
                for (int rb = 0; rb < 4; ++rb) vn[rb] = __builtin_amdgcn_mfma_f32_16x16x32_bf16(aw[rb * 4 + s], sf[s], vn[rb], 0, 0, 0);
#pragma unroll
            for (int s = 0; s < 2; ++s) { const f32x4 a0 = vn[2 * s], a1 = vn[2 * s + 1];
                vn[2 * s][0] = bflo(uu[s].x) - a0[0]; vn[2 * s][1] = bfhi(uu[s].x) - a0[1]; vn[2 * s][2] = bflo(uu[s].y) - a0[2]; vn[2 * s][3] = bfhi(uu[s].y) - a0[3];
                vn[2 * s + 1][0] = bflo(uu[s].z) - a1[0]; vn[2 * s + 1][1] = bfhi(uu[s].z) - a1[1]; vn[2 * s + 1][2] = bflo(uu[s].w) - a1[2]; vn[2 * s + 1][3] = bfhi(uu[s].w) - a1[3]; }
            bf16_t* vnt = B.VNT + (size_t)ti * SZ_VNT + (size_t)(vt * 2 * 64 + lane) * 8;
            bf16x8 vf[2];
#pragma unroll
            for (int s = 0; s < 2; ++s) { u32x4 w4; w4.x = pk2(vn[2 * s][0], vn[2 * s][1]); w4.y = pk2(vn[2 * s][2], vn[2 * s][3]); w4.z = pk2(vn[2 * s + 1][0], vn[2 * s + 1][1]); w4.w = pk2(vn[2 * s + 1][2], vn[2 * s + 1][3]);
                vf[s] = __builtin_bit_cast(bf16x8, w4); *(u32x4*)(vnt + (size_t)s * 64 * 8) = w4; }
            asm volatile("s_waitcnt lgkmcnt(0)" ::: "memory");
            const float gt = __uint_as_float(gtb);
#pragma unroll
            for (int kb = 0; kb < 8; ++kb) S[kb] = S[kb] * gt;
#pragma unroll
            for (int s = 0; s < 2; ++s)
#pragma unroll
                for (int kb = 0; kb < 8; ++kb) S[kb] = __builtin_amdgcn_mfma_f32_16x16x32_bf16(ak[kb * 2 + s], vf[s], S[kb], 0, 0, 0);
            __builtin_amdgcn_sched_barrier(0);
            asm volatile("s_waitcnt vmcnt(26) lgkmcnt(0)\n\ts_barrier" ::: "memory");
        } else if (wid >= 4) {
            asm volatile("s_waitcnt vmcnt(10) lgkmcnt(0)\n\ts_barrier" ::: "memory");
        } else {
            asm volatile("s_waitcnt vmcnt(8) lgkmcnt(0)\n\ts_barrier" ::: "memory");
        }
    }
    if (step_hi < NSTEP && active) {
#pragma unroll
        for (int kb = 0; kb < 8; ++kb) sv[kb * 64] = S[kb]; }
    asm volatile("s_waitcnt vmcnt(0)" ::: "memory");
    __syncthreads();
#undef G2_DMA
#undef G2_TI
}

constexpr int G3_OS = 132, G3_LDS = 64 * G3_OS * 4;
struct G3Args { Bufs B; const bf16_t* P; const float* norm_g; bf16_t* Y; };
__device__ __forceinline__ void g3_task(const G3Args& A, char* lds, int cix, int h, const int tid_in, const f32x4 g0, const f32x4 g1) {
    int tid_ = tid_in; asm volatile("" : "+v"(tid_));
    const int tid = tid_, wid = __builtin_amdgcn_readfirstlane(tid >> 6), lane = tid & 63, q = lane >> 4, vl = lane & 15;
    u32x4 gwv[2];
#pragma unroll
    for (int n = 0; n < 2; ++n) { const int item = tid + 512 * n, tok = item >> 4, c8 = (item & 15) * 8; gwv[n] = *(const u32x4*)(A.P + ((size_t)cix * CH + tok) * NP + C_GG + h * HD + c8); }
    f32x4 o[2][4];
#pragma unroll
    for (int d = 0; d < 2; ++d) {
        const size_t t = ((size_t)cix * NH + h) * 2 + d;
        const bf16_t* sit = A.B.SIT + t * SZ_SIT + (size_t)(wid * 4 * 64 + lane) * 8;
        const bf16_t* vnt = A.B.VNT + t * SZ_VNT + (size_t)(wid * 2 * 64 + lane) * 8;
        const bf16_t* qd = A.B.QD + t * SZ_QD + (size_t)vl * 128 + 8 * q;
        const bf16_t* qk = A.B.QK + t * SZ_QK + (size_t)vl * 64 + 8 * q;
        bf16x8 sf[4], vf[2];
#pragma unroll
        for (int s = 0; s < 4; ++s) sf[s] = *(const bf16x8*)(sit + (size_t)s * 64 * 8);
#pragma unroll
        for (int s = 0; s < 2; ++s) vf[s] = *(const bf16x8*)(vnt + (size_t)s * 64 * 8);
#pragma unroll
        for (int rb = 0; rb < 4; ++rb) { f32x4 acc = {0.f, 0.f, 0.f, 0.f};
#pragma unroll
            for (int s = 0; s < 4; ++s) acc = __builtin_amdgcn_mfma_f32_16x16x32_bf16(*(const bf16x8*)(qd + (size_t)rb * 16 * 128 + 32 * s), sf[s], acc, 0, 0, 0);
#pragma unroll
            for (int s = 0; s < 2; ++s) acc = __builtin_amdgcn_mfma_f32_16x16x32_bf16(*(const bf16x8*)(qk + (size_t)rb * 16 * 64 + 32 * s), vf[s], acc, 0, 0, 0);
            o[d][rb] = acc; }
    }
    f32x4 ot[4];
#pragma unroll
    for (int rb = 0; rb < 4; ++rb)
#pragma unroll
        for (int r = 0; r < 4; ++r) ot[rb][r] = o[0][rb][r] + lane_xor(o[1][3 - rb][3 - r], 48, lane);
    float* Ot = (float*)lds;
    LDS_BARRIER();
#pragma unroll
    for (int rb = 0; rb < 4; ++rb)
#pragma unroll
        for (int r = 0; r < 4; ++r) Ot[(16 * rb + 4 * q + r) * G3_OS + 16 * wid + vl] = ot[rb][r];
    LDS_BARRIER();
#pragma unroll
    for (int n = 0; n < 2; ++n) { const int item = tid + 512 * n, tok = item >> 4, c8 = (item & 15) * 8;
        const f32x4 o0 = *(const f32x4*)(Ot + tok * G3_OS + c8), o1 = *(const f32x4*)(Ot + tok * G3_OS + c8 + 4);
        float ss = (o0[0] * o0[0] + o0[1] * o0[1]) + (o0[2] * o0[2] + o0[3] * o0[3]) + (o1[0] * o1[0] + o1[1] * o1[1]) + (o1[2] * o1[2] + o1[3] * o1[3]);
#pragma unroll
        for (int of = 1; of < 16; of <<= 1) ss += lane_xor(ss, of, lane);
        const float rstd = __builtin_amdgcn_rsqf(ss * (1.0f / HD) + EPS);
        const size_t row = (size_t)cix * CH + tok; const u32x4 gw = gwv[n];
        float y[8];
#pragma unroll
        for (int e = 0; e < 4; ++e) { const float ga = bflo(gw[e]), gb = bfhi(gw[e]); const float oa = e < 2 ? o0[2 * e] : o1[2 * e - 4], ob = e < 2 ? o0[2 * e + 1] : o1[2 * e - 3];
            const float na = e < 2 ? g0[2 * e] : g1[2 * e - 4], nb = e < 2 ? g0[2 * e + 1] : g1[2 * e - 3];
            y[2 * e] = oa * rstd * na * (ga * __builtin_amdgcn_rcpf(1.0f + __expf(-ga))); y[2 * e + 1] = ob * rstd * nb * (gb * __builtin_amdgcn_rcpf(1.0f + __expf(-gb))); }
        *(u32x4*)(A.Y + row * D_MODEL + 2 * GROUP_W + h * HD + c8) = (u32x4){pk2(y[0], y[1]), pk2(y[2], y[3]), pk2(y[4], y[5]), pk2(y[6], y[7])};
    }
}
__device__ __forceinline__ void g3_phase(const G3Args& A, char* lds, int G, int wg, const int tid) {
    const int c8 = (tid & 15) * 8; const f32x4 g0 = *(const f32x4*)(A.norm_g + c8), g1 = *(const f32x4*)(A.norm_g + c8 + 4);
    for (int t = wg; t < NCHUNK * NH; t += G) g3_task(A, lds, t / NH, t % NH, tid, g0, g1);
}
}

namespace lru {
typedef short bf16x8 __attribute__((ext_vector_type(8)));
typedef float f32x4 __attribute__((ext_vector_type(4)));
typedef unsigned u32x2 __attribute__((ext_vector_type(2)));
typedef unsigned u32x4 __attribute__((ext_vector_type(4)));
constexpr int CH = 64, NCHUNK = M_ALL / CH;
constexpr int US = 129;
constexpr int UBS = 272;
constexpr int L_OFF_U = 0, L_OFF_UB = CH * US * 4, L_LDS = L_OFF_UB + CH * UBS;
constexpr size_t SZ_WBLK = (size_t)LRU_BW * LRU_BW;
struct Bufs { bf16_t* HLOC; bf16_t* ACUM; float* LSUM; float* HIN; };
struct LocalArgs { const bf16_t* P; const float* conv_w; const float* conv_b; const bf16_t* WG;   const float* ba; const float* bx; const float* lam; Bufs B; };

__device__ __forceinline__ unsigned pk2(float lo, float hi) { return (unsigned)f2bf(lo) | ((unsigned)f2bf(hi) << 16); }

struct LocalPre { float wgt[4][8]; float bia[8]; float sp[2][4], bav[2][4], bxv[2][4]; u32x4 xr[5]; };
__device__ __forceinline__ void local_weights(const LocalArgs& A, int nb, int tid, LocalPre& R) {
    const int wid = tid >> 6, lane = tid & 63, q = lane >> 4;
    const int grp = tid & 15, c0 = grp * 8, ch0 = nb * LRU_BW + c0;
#pragma unroll
    for (int j = 0; j < 4; ++j) { const f32x4 w0 = *(const f32x4*)(A.conv_w + j * LRU_W + ch0), w1 = *(const f32x4*)(A.conv_w + j * LRU_W + ch0 + 4);
#pragma unroll
        for (int e = 0; e < 4; ++e) { R.wgt[j][e] = w0[e]; R.wgt[j][4 + e] = w1[e]; } }
    { const f32x4 b0 = *(const f32x4*)(A.conv_b + ch0), b1 = *(const f32x4*)(A.conv_b + ch0 + 4);
#pragma unroll
      for (int e = 0; e < 4; ++e) { R.bia[e] = b0[e]; R.bia[4 + e] = b1[e]; } }
    const int chb = nb * LRU_BW + 16 * wid + 4 * q;
#pragma unroll
    for (int d = 0; d < 2; ++d)
#pragma unroll
        for (int r = 0; r < 4; ++r) { R.sp[d][r] = -LRU_C * softplusf_(-A.lam[d * LRU_W + chb + r]); R.bav[d][r] = A.ba[d * LRU_W + chb + r]; R.bxv[d][r] = A.bx[d * LRU_W + chb + r]; }
}
__device__ __forceinline__ void local_load(const LocalArgs& A, int cix, int nb, int tid, LocalPre& R) {
    const RowInfo r0i = row_info(cix * CH); const int grp = tid & 15, t2 = tid >> 4, ch0 = nb * LRU_BW + grp * 8;
#pragma unroll
    for (int k = 0; k < 5; ++k) { const int tt = r0i.t + 2 * t2 + k - 1;
        R.xr[k] = (tt >= 0 && tt < r0i.T) ? *(const u32x4*)(A.P + (size_t)(r0i.base + tt) * NP + C_LRU_X + ch0) : (u32x4){0u, 0u, 0u, 0u}; }
}
__device__ __forceinline__ void local_task(const LocalArgs& A, char* lds, int cix, int nb, const int tid_in, LocalPre& R, const int ncix, const int nnb, const bool has_next) {
    int tid_ = tid_in; asm volatile("" : "+v"(tid_));
    const int tid = tid_, wid = __builtin_amdgcn_readfirstlane(tid >> 6), lane = tid & 63, q = lane >> 4, tl = lane & 15;
    float* Us = (float*)(lds + L_OFF_U); char* Ub = lds + L_OFF_UB;
    const int row0 = cix * CH; const RowInfo r0i = row_info(row0);
    LDS_BARRIER();
    {
        const int grp = tid & 15, t2 = tid >> 4, c0 = grp * 8;
#pragma unroll
        for (int i = 0; i < 2; ++i) { float acc[8];
#pragma unroll
            for (int e = 0; e < 8; ++e) acc[e] = R.bia[e];
#pragma unroll
            for (int j = 0; j < 4; ++j) { const u32x4 xv = R.xr[i + j];
#pragma unroll
                for (int e = 0; e < 4; ++e) { acc[2 * e] += R.wgt[j][2 * e] * bflo(xv[e]); acc[2 * e + 1] += R.wgt[j][2 * e + 1] * bfhi(xv[e]); } }
            const int tok = 2 * t2 + i;
#pragma unroll
            for (int e = 0; e < 8; ++e) Us[tok * US + c0 + e] = acc[e];
            *(u32x4*)(Ub + tok * UBS + c0 * 2) = (u32x4){pk2(acc[0], acc[1]), pk2(acc[2], acc[3]), pk2(acc[4], acc[5]), pk2(acc[6], acc[7])}; }
    }
    LDS_BARRIER();
    f32x4 acc[2][2][4];
#pragma unroll
    for (int d = 0; d < 2; ++d)
#pragma unroll
        for (int wh = 0; wh < 2; ++wh)
#pragma unroll
            for (int tb = 0; tb < 4; ++tb) acc[d][wh][tb] = (f32x4){0.f, 0.f, 0.f, 0.f};
#pragma unroll
    for (int s = 0; s < 4; ++s) {
        bf16x8 bfr[4];
#pragma unroll
        for (int tb = 0; tb < 4; ++tb) bfr[tb] = *(const bf16x8*)(Ub + (16 * tb + tl) * UBS + (32 * s + 8 * q) * 2);
#pragma unroll
        for (int d = 0; d < 2; ++d)
#pragma unroll
            for (int wh = 0; wh < 2; ++wh) { const bf16x8 a = *(const bf16x8*)(A.WG + ((size_t)((d * 2 + wh) * NH + nb)) * SZ_WBLK + (size_t)(16 * wid + tl) * LRU_BW + 32 * s + 8 * q);
#pragma unroll
                for (int tb = 0; tb < 4; ++tb) acc[d][wh][tb] = __builtin_amdgcn_mfma_f32_16x16x32_bf16(a, bfr[tb], acc[d][wh][tb], 0, 0, 0); }
    }
    if (has_next) local_load(A, ncix, nnb, tid, R);
    const int chb = nb * LRU_BW + 16 * wid + 4 * q;
#pragma unroll
    for (int d = 0; d < 2; ++d) {
        float sp[4], bav[4], bxv[4];
#pragma unroll
        for (int r = 0; r < 4; ++r) { sp[r] = R.sp[d][r]; bav[r] = R.bav[d][r]; bxv[r] = R.bxv[d][r]; }
        float Ac[4], Bc[4];
#pragma unroll
        for (int r = 0; r < 4; ++r) { Ac[r] = 1.f; Bc[r] = 0.f; }
#pragma unroll
        for (int tbi = 0; tbi < 4; ++tbi) { const int tb = d == 0 ? tbi : 3 - tbi; const int tok = 16 * tb + tl;
            float a[4], b[4];
#pragma unroll
            for (int r = 0; r < 4; ++r) { const float rr = __builtin_amdgcn_rcpf(1.0f + __expf(-(acc[d][0][tb][r] + bav[r]))), ii = __builtin_amdgcn_rcpf(1.0f + __expf(-(acc[d][1][tb][r] + bxv[r])));
                const float log_a = sp[r] * rr, x2 = 2.0f * log_a; a[r] = __expf(log_a);
                float em = 1.0f + x2 * (1.0f / 6.0f); em = 1.0f + x2 * 0.2f * em; em = 1.0f + x2 * 0.25f * em; em = 1.0f + x2 * (1.0f / 3.0f) * em; em = 1.0f + x2 * 0.5f * em; em = -x2 * em;
                if (__builtin_expect(x2 < -0.25f, 0)) em = -expm1f(x2);
                b[r] = __builtin_amdgcn_sqrtf(em) * ii * Us[tok * US + 16 * wid + 4 * q + r]; }
#define LRU_SCAN_STEP(CTRL) do { _Pragma("unroll") for (int r = 0; r < 4; ++r) { \
                const float ap = __int_as_float(__builtin_amdgcn_update_dpp(0x3f800000, __float_as_int(a[r]), (CTRL), 0xf, 0xf, false)); \
                const float bp = __int_as_float(__builtin_amdgcn_update_dpp(0, __float_as_int(b[r]), (CTRL), 0xf, 0xf, false)); \
                b[r] = a[r] * bp + b[r]; a[r] = a[r] * ap; } } while (0)
            if (d == 0) { LRU_SCAN_STEP(0x111); LRU_SCAN_STEP(0x112); LRU_SCAN_STEP(0x114); LRU_SCAN_STEP(0x118); }
            else        { LRU_SCAN_STEP(0x101); LRU_SCAN_STEP(0x102); LRU_SCAN_STEP(0x104); LRU_SCAN_STEP(0x108); }
#undef LRU_SCAN_STEP
#pragma unroll
            for (int r = 0; r < 4; ++r) { b[r] = a[r] * Bc[r] + b[r]; a[r] = a[r] * Ac[r]; }
            { const size_t o = ((size_t)d * M_ALL + row0 + tok) * LRU_W + chb;
              *(u32x2*)(A.B.HLOC + o) = (u32x2){pk2(b[0], b[1]), pk2(b[2], b[3])}; *(u32x2*)(A.B.ACUM + o) = (u32x2){pk2(a[0], a[1]), pk2(a[2], a[3])}; }
#pragma unroll
            for (int r = 0; r < 4; ++r) { const int sl = (lane & ~15) | (d == 0 ? 15 : 0); Ac[r] = lane_get(a[r], sl); Bc[r] = lane_get(b[r], sl); }
        }
        if (tl == 0) { float* ls = A.B.LSUM + (((size_t)cix * 2 + d) * 2) * LRU_W + chb;
            *(f32x4*)ls = (f32x4){Ac[0], Ac[1], Ac[2], Ac[3]}; *(f32x4*)(ls + LRU_W) = (f32x4){Bc[0], Bc[1], Bc[2], Bc[3]}; }
    }
    if (has_next && nnb != nb) local_weights(A, nnb, tid, R);
}
__device__ __forceinline__ void local_phase(const LocalArgs& A, char* lds, int G, int wg, const int tid) {
    constexpr int NT = NCHUNK * NH;
    int j0 = wg; if (j0 < NT) j0 += (NT - j0 + G - 1) / G * G;
    if (j0 >= 2 * NT) return;
    LocalPre R; { const int t = j0 - NT; local_weights(A, t % NH, tid, R); local_load(A, t / NH, t % NH, tid, R); }
    for (int j = j0; j < 2 * NT; j += G) { const int t = j - NT, tn = t + G; local_task(A, lds, t / NH, t % NH, tid, R, tn / NH, tn % NH, tn < NT); }
}
__device__ __forceinline__ void carry_phase(const Bufs& B, int gtid, int gthreads) {
    constexpr int NC = CTX_LEN / CH, NL = SEQ / CH;
    for (int i = gtid; i < BATCH * 2 * LRU_W; i += gthreads) { const int ch = i % LRU_W, d = (i / LRU_W) & 1, b = i / (2 * LRU_W);
        float h = 0.f;
        for (int s0 = 0; s0 < NC + NL; s0 += 12) {
            float av[12], bv[12]; int cx[12];
#pragma unroll
            for (int u = 0; u < 12; ++u) { const int step = s0 + u; int cix = 0;
                if (step < NC) { const int n = d ? NC - 1 - step : step; cix = M_LAT / CH + b * NC + n; }
                else if (step < NC + NL) { const int s2 = step - NC, n = d ? NL - 1 - s2 : s2; cix = b * NL + n; }
                cx[u] = cix; const float* ls = B.LSUM + (((size_t)cix * 2 + d) * 2) * LRU_W + ch; av[u] = ls[0]; bv[u] = ls[LRU_W]; }
#pragma unroll
            for (int u = 0; u < 12; ++u) if (s0 + u < NC + NL) { B.HIN[((size_t)cx[u] * 2 + d) * LRU_W + ch] = h; h = av[u] * h + bv[u]; }
        }
    }
}
__device__ __forceinline__ void finish_phase(const Bufs& B, const bf16_t* P, bf16_t* Y, int gtid, int gthreads) {
    for (int it = gtid; it < M_ALL * (LRU_W / 8); it += gthreads) { const int row = it / (LRU_W / 8), c0 = (it % (LRU_W / 8)) * 8, cix = row / CH;
        const u32x4 h0 = *(const u32x4*)(B.HLOC + (size_t)row * LRU_W + c0), a0 = *(const u32x4*)(B.ACUM + (size_t)row * LRU_W + c0);
        const u32x4 h1 = *(const u32x4*)(B.HLOC + ((size_t)M_ALL + row) * LRU_W + c0), a1 = *(const u32x4*)(B.ACUM + ((size_t)M_ALL + row) * LRU_W + c0);
        const u32x4 gt = *(const u32x4*)(P + (size_t)row * NP + C_LRU_G + c0);
        const float* i0 = B.HIN + ((size_t)cix * 2 + 0) * LRU_W + c0; const float* i1 = B.HIN + ((size_t)cix * 2 + 1) * LRU_W + c0;
        const f32x4 i0a = *(const f32x4*)i0, i0b = *(const f32x4*)(i0 + 4), i1a = *(const f32x4*)i1, i1b = *(const f32x4*)(i1 + 4);
        float y[8];
#pragma unroll
        for (int j = 0; j < 4; ++j) { const unsigned hw0 = h0[j], aw0 = a0[j], hw1 = h1[j], aw1 = a1[j], gw = gt[j];
            const float in0l = j < 2 ? i0a[2 * j] : i0b[2 * j - 4], in0h = j < 2 ? i0a[2 * j + 1] : i0b[2 * j - 3], in1l = j < 2 ? i1a[2 * j] : i1b[2 * j - 4], in1h = j < 2 ? i1a[2 * j + 1] : i1b[2 * j - 3];
            y[2 * j] = (bflo(hw0) + bflo(aw0) * in0l + bflo(hw1) + bflo(aw1) * in1l) * geluf_(bflo(gw));
            y[2 * j + 1] = (bfhi(hw0) + bfhi(aw0) * in0h + bfhi(hw1) + bfhi(aw1) * in1h) * geluf_(bfhi(gw)); }
        *(u32x4*)(Y + (size_t)row * D_MODEL + c0) = (u32x4){pk2(y[0], y[1]), pk2(y[2], y[3]), pk2(y[4], y[5]), pk2(y[6], y[7])};
    }
}
}

namespace misc {
typedef float f32x4 __attribute__((ext_vector_type(4)));
typedef unsigned u32x2 __attribute__((ext_vector_type(2)));
typedef unsigned u32x4 __attribute__((ext_vector_type(4)));
__device__ __forceinline__ unsigned pk2(float lo, float hi) { return (unsigned)f2bf(lo) | ((unsigned)f2bf(hi) << 16); }
__device__ __forceinline__ float wave_sum(float v, int lane) {
#pragma unroll
    for (int o = 1; o < 64; o <<= 1) v += lane_xor(v, o, lane);
    return v;
}
__device__ __forceinline__ float sum16(float v, int lane) {
#pragma unroll
    for (int o = 1; o < 16; o <<= 1) v += lane_xor(v, o, lane);
    return v;
}
__device__ __forceinline__ void norm_phase(float* H, const float* g, const float* MODl, int sh_idx, bf16_t* U, int nrows, int gwave, int nwaves, int lane,
                                           const float* PART, int nparts, const float* pgate, const float* xin, const float* cin) {
    static_assert(D_MODEL == 2048, "norm_phase geometry");
    int cset = -1; f32x4 gsv[8], shv[8];
    for (int r = gwave; r < nrows; r += nwaves) {
        const int set = r < M_LAT ? r / SEQ : BATCH;
        if (set != cset) { cset = set; const f32x4* gp = (const f32x4*)g + lane; const f32x4* shp = (const f32x4*)(MODl + (size_t)set * NMODV + (size_t)sh_idx * D_MODEL) + lane; const f32x4* scp = shp + D_MODEL / 4;
#pragma unroll
            for (int j = 0; j < 8; ++j) { gsv[j] = gp[64 * j] * (scp[64 * j] + 1.0f); shv[j] = shp[64 * j]; } }
        f32x4* hr = (f32x4*)(H + (size_t)r * D_MODEL) + lane;
        const f32x4* src = xin == nullptr ? hr : (r < M_LAT ? (const f32x4*)(xin + (size_t)r * D_MODEL) + lane : (const f32x4*)(cin + (size_t)(r - M_LAT) * D_MODEL) + lane);
        f32x4 v[8]; float ss = 0.f;
#pragma unroll
        for (int j = 0; j < 8; ++j) v[j] = src[64 * j];
        if (xin != nullptr && r >= M_LAT) {
#pragma unroll
            for (int j = 0; j < 8; ++j) hr[64 * j] = v[j]; }
        if (PART != nullptr && r >= M_LAT) {
            const f32x4* gp = (const f32x4*)pgate + lane;
#pragma unroll
            for (int j = 0; j < 8; ++j) { f32x4 acc = {0.f, 0.f, 0.f, 0.f};
                for (int s = 0; s < nparts; ++s) acc += *((const f32x4*)(PART + ((size_t)s * M_CTX + (r - M_LAT)) * D_MODEL) + lane + 64 * j);
                v[j] += gp[64 * j] * acc; hr[64 * j] = v[j]; }
        }
#pragma unroll
        for (int j = 0; j < 8; ++j) ss += (v[j][0] * v[j][0] + v[j][1] * v[j][1]) + (v[j][2] * v[j][2] + v[j][3] * v[j][3]);
        const float rstd = __builtin_amdgcn_rsqf(wave_sum(ss, lane) * (1.0f / D_MODEL) + EPS);
        u32x2* o = (u32x2*)(U + (size_t)r * D_MODEL) + lane;
#pragma unroll
        for (int j = 0; j < 8; ++j) { const f32x4 y = v[j] * rstd * gsv[j] + shv[j];
            o[64 * j] = (u32x2){pk2(y[0], y[1]), pk2(y[2], y[3])}; }
    }
}
struct RowNormArgs { const bf16_t* P; const float *qa_g, *kva_g, *na_qn_g, *na_kn_g; bf16_t *CQN, *CKVN, *NQ, *NK; };
__device__ __forceinline__ void rownorm_phase(const RowNormArgs& A, int gwave, int nwaves, int lane) {
    static_assert(MLA_Q_LORA == 384 && MLA_KV_LORA == 256 && GROUP_W == 512 && HD == 128, "rownorm geometry");
    float gq[6], gkv[4], gnq[8], gnk[8];
#pragma unroll
    for (int j = 0; j < 3; ++j) { gq[2 * j] = A.qa_g[2 * lane + 128 * j]; gq[2 * j + 1] = A.qa_g[2 * lane + 128 * j + 1]; }
#pragma unroll
    for (int j = 0; j < 2; ++j) { gkv[2 * j] = A.kva_g[2 * lane + 128 * j]; gkv[2 * j + 1] = A.kva_g[2 * lane + 128 * j + 1]; }
#pragma unroll
    for (int j = 0; j < 8; ++j) { gnq[j] = A.na_qn_g[(lane & 15) * 8 + j]; gnk[j] = A.na_kn_g[(lane & 15) * 8 + j]; }
    struct In { unsigned cq[3], ckv[2]; u32x4 nqk[2]; };
    auto load_row = [&](int r, In& X) { const bf16_t* p = A.P + (size_t)r * NP;
#pragma unroll
        for (int j = 0; j < 3; ++j) X.cq[j] = *(const unsigned*)(p + C_CQ + 2 * lane + 128 * j);
#pragma unroll
        for (int j = 0; j < 2; ++j) X.ckv[j] = *(const unsigned*)(p + C_CKV + 2 * lane + 128 * j);
#pragma unroll
        for (int which = 0; which < 2; ++which) X.nqk[which] = *(const u32x4*)(p + (which == 0 ? C_NQ : C_NK) + (lane >> 4) * HD + (lane & 15) * 8); };
    In cur; if (gwave < M_ALL) load_row(gwave, cur);
    for (int r = gwave; r < M_ALL; r += nwaves) {
        In nxt = cur; if (r + nwaves < M_ALL) load_row(r + nwaves, nxt);
        { float x[6], ss = 0.f;
#pragma unroll
          for (int j = 0; j < 3; ++j) { const unsigned w = cur.cq[j]; x[2 * j] = bflo(w); x[2 * j + 1] = bfhi(w); ss += x[2 * j] * x[2 * j] + x[2 * j + 1] * x[2 * j + 1]; }
          const float rstd = 1.0f / sqrtf(wave_sum(ss, lane) * (1.0f / MLA_Q_LORA) + EPS);
#pragma unroll
          for (int j = 0; j < 3; ++j) { const int c = 2 * lane + 128 * j; *(unsigned*)(A.CQN + (size_t)r * MLA_Q_LORA + c) = pk2(x[2 * j] * rstd * gq[2 * j], x[2 * j + 1] * rstd * gq[2 * j + 1]); } }
        { float x[4], ss = 0.f;
#pragma unroll
          for (int j = 0; j < 2; ++j) { const unsigned w = cur.ckv[j]; x[2 * j] = bflo(w); x[2 * j + 1] = bfhi(w); ss += x[2 * j] * x[2 * j] + x[2 * j + 1] * x[2 * j + 1]; }
          const float rstd = 1.0f / sqrtf(wave_sum(ss, lane) * (1.0f / MLA_KV_LORA) + EPS);
#pragma unroll
          for (int j = 0; j < 2; ++j) { const int c = 2 * lane + 128 * j; *(unsigned*)(A.CKVN + (size_t)r * MLA_KV_LORA + c) = pk2(x[2 * j] * rstd * gkv[2 * j], x[2 * j + 1] * rstd * gkv[2 * j + 1]); } }
#pragma unroll
        for (int which = 0; which < 2; ++which) {
            const int hh = lane >> 4, d0 = (lane & 15) * 8; const u32x4 w = cur.nqk[which];
            float x[8]; float ss = 0.f;
#pragma unroll
            for (int j = 0; j < 4; ++j) { x[2 * j] = bflo(w[j]); x[2 * j + 1] = bfhi(w[j]); ss += x[2 * j] * x[2 * j] + x[2 * j + 1] * x[2 * j + 1]; }
            const float rstd = __builtin_amdgcn_rsqf(sum16(ss, lane) * (1.0f / HD) + EPS); const float* g = which == 0 ? gnq : gnk;
            *(u32x4*)((which == 0 ? A.NQ : A.NK) + (size_t)r * GROUP_W + hh * HD + d0) =
                (u32x4){pk2(x[0] * rstd * g[0], x[1] * rstd * g[1]), pk2(x[2] * rstd * g[2], x[3] * rstd * g[3]), pk2(x[4] * rstd * g[4], x[5] * rstd * g[5]), pk2(x[6] * rstd * g[6], x[7] * rstd * g[7])};
        }
        cur = nxt;
    }
}
struct MlaQkvArgs { const bf16_t* QR; const bf16_t* KVR; const bf16_t* P; const float *qn_g, *kn_g; bf16_t *QM, *KM, *VM; };
__device__ __forceinline__ void mlaqkv_phase(const MlaQkvArgs& A, int gwave, int nwaves, int lane) {
    static_assert(MLA_QK == 192 && MLA_NOPE == 128 && MLA_ROPE == 64 && NH == 4 && GRID_W == 64, "mla qkv geometry");
    const int hh = lane >> 4, g = lane & 15;
    const int f0 = (2 * g) & 15; const float inv0 = powf(10000.0f, -(float)f0 / 16.0f), inv1 = powf(10000.0f, -(float)(f0 + 1) / 16.0f);
    f32x4 gq0 = *(const f32x4*)(A.qn_g + 8 * g), gq1 = *(const f32x4*)(A.qn_g + 8 * g + 4), gk0 = *(const f32x4*)(A.kn_g + 8 * g), gk1 = *(const f32x4*)(A.kn_g + 8 * g + 4);
    const float gqr[4] = {A.qn_g[MLA_NOPE + 2 * g], A.qn_g[MLA_NOPE + 2 * g + 1], A.qn_g[MLA_NOPE + 32 + 2 * g], A.qn_g[MLA_NOPE + 32 + 2 * g + 1]};
    const float gkr[4] = {A.kn_g[MLA_NOPE + 2 * g], A.kn_g[MLA_NOPE + 2 * g + 1], A.kn_g[MLA_NOPE + 32 + 2 * g], A.kn_g[MLA_NOPE + 32 + 2 * g + 1]};
    struct In { u32x4 nw[2], vv; unsigned ra[2], rb[2]; };
    auto load_row = [&](int r, In& X) {
#pragma unroll
        for (int which = 0; which < 2; ++which) {
            const bf16_t* nsrc = which == 0 ? A.QR + (size_t)r * NQ_MLA + hh * MLA_QK : A.KVR + (size_t)r * NKV_MLA + hh * (MLA_NOPE + MLA_V);
            const bf16_t* rsrc = which == 0 ? nsrc + MLA_NOPE : A.P + (size_t)r * NP + C_KR;
            X.nw[which] = *(const u32x4*)(nsrc + 8 * g); X.ra[which] = *(const unsigned*)(rsrc + 2 * g); X.rb[which] = *(const unsigned*)(rsrc + 32 + 2 * g); }
        X.vv = *(const u32x4*)(A.KVR + (size_t)r * NKV_MLA + hh * (MLA_NOPE + MLA_V) + MLA_NOPE + 8 * g); };
    In cur; if (gwave < M_ALL) load_row(gwave, cur);
    for (int r = gwave; r < M_ALL; r += nwaves) {
        In nxt = cur; if (r + nwaves < M_ALL) load_row(r + nwaves, nxt);
        const bool lat = r < M_LAT; const int t = lat ? r % SEQ : 0; const float pos = g < 8 ? (float)(t / GRID_W) : (float)(t % GRID_W);
        float c0 = 1.f, s0 = 0.f, c1 = 1.f, s1 = 0.f;
        if (lat) { sincosf(pos * inv0, &s0, &c0); sincosf(pos * inv1, &s1, &c1); }
#pragma unroll
        for (int which = 0; which < 2; ++which) {
            const u32x4 nw = cur.nw[which]; const unsigned ra = cur.ra[which], rb = cur.rb[which];
            float x[8], a0 = bflo(ra), a1 = bfhi(ra), b0 = bflo(rb), b1 = bfhi(rb);
            float ss = a0 * a0 + a1 * a1 + b0 * b0 + b1 * b1;
#pragma unroll
            for (int j = 0; j < 4; ++j) { x[2 * j] = bflo(nw[j]); x[2 * j + 1] = bfhi(nw[j]); ss += x[2 * j] * x[2 * j] + x[2 * j + 1] * x[2 * j + 1]; }
            const float rstd = __builtin_amdgcn_rsqf(sum16(ss, lane) * (1.0f / MLA_QK) + EPS);
            const f32x4 g0 = which == 0 ? gq0 : gk0, g1 = which == 0 ? gq1 : gk1;
#pragma unroll
            for (int j = 0; j < 4; ++j) { x[j] *= rstd * g0[j]; x[4 + j] *= rstd * g1[j]; }
            a0 *= rstd * (which == 0 ? gqr[0] : gkr[0]); a1 *= rstd * (which == 0 ? gqr[1] : gkr[1]); b0 *= rstd * (which == 0 ? gqr[2] : gkr[2]); b1 *= rstd * (which == 0 ? gqr[3] : gkr[3]);
            const float ya0 = a0 * c0 - b0 * s0, yb0 = a0 * s0 + b0 * c0, ya1 = a1 * c1 - b1 * s1, yb1 = a1 * s1 + b1 * c1;
            bf16_t* O = (which == 0 ? A.QM : A.KM) + (size_t)r * NQ_MLA + hh * MLA_QK;
            *(u32x4*)(O + 8 * g) = (u32x4){pk2(x[0], x[1]), pk2(x[2], x[3]), pk2(x[4], x[5]), pk2(x[6], x[7])};
            *(unsigned*)(O + MLA_NOPE + 2 * g) = pk2(ya0, ya1); *(unsigned*)(O + MLA_NOPE + 32 + 2 * g) = pk2(yb0, yb1);
        }
        *(u32x4*)(A.VM + (size_t)r * (NH * MLA_V) + hh * MLA_V + 8 * g) = cur.vv;
        cur = nxt;
    }
}
constexpr int ACT_RUN = 32;
__device__ __forceinline__ void act_phase(const bf16_t* UP, const float* cw, const float* cb, bf16_t* ACT, int nrows, int gtid, int gthreads) {
    constexpr int NC8 = D_FF / 8; static_assert(SEQ % ACT_RUN == 0 && CTX_LEN % ACT_RUN == 0, "row runs stay inside one sequence");
    const int nruns = nrows / ACT_RUN;
    for (long it = gtid; it < (long)nruns * NC8; it += gthreads) { const int run = (int)(it / NC8), j0 = (int)(it % NC8) * 8, r0 = run * ACT_RUN; const RowInfo ri = row_info(r0);
        float wa[3][8], wg[3][8], ba[8], bg[8];
#pragma unroll
        for (int k = 0; k < 3; ++k) { const float* p = cw + (size_t)k * 2 * D_FF + j0; const f32x4 a0 = *(const f32x4*)p, a1 = *(const f32x4*)(p + 4), g0 = *(const f32x4*)(p + D_FF), g1 = *(const f32x4*)(p + D_FF + 4);
#pragma unroll
            for (int e = 0; e < 4; ++e) { wa[k][e] = a0[e]; wa[k][4 + e] = a1[e]; wg[k][e] = g0[e]; wg[k][4 + e] = g1[e]; } }
        { const f32x4 a0 = *(const f32x4*)(cb + j0), a1 = *(const f32x4*)(cb + j0 + 4), g0 = *(const f32x4*)(cb + D_FF + j0), g1 = *(const f32x4*)(cb + D_FF + j0 + 4);
#pragma unroll
          for (int e = 0; e < 4; ++e) { ba[e] = a0[e]; ba[4 + e] = a1[e]; bg[e] = g0[e]; bg[4 + e] = g1[e]; } }
        const u32x4 zero = {0u, 0u, 0u, 0u};
        const bf16_t* ub = UP + (size_t)ri.base * (2 * D_FF) + j0;
        u32x4 am, ac, gm, gc;
        { const int t = ri.t; am = t > 0 ? *(const u32x4*)(ub + (size_t)(t - 1) * (2 * D_FF)) : zero; gm = t > 0 ? *(const u32x4*)(ub + (size_t)(t - 1) * (2 * D_FF) + D_FF) : zero;
          ac = *(const u32x4*)(ub + (size_t)t * (2 * D_FF)); gc = *(const u32x4*)(ub + (size_t)t * (2 * D_FF) + D_FF); }
#pragma unroll 4
        for (int i = 0; i < ACT_RUN; ++i) { const int t = ri.t + i;
            const u32x4 ap = t + 1 < ri.T ? *(const u32x4*)(ub + (size_t)(t + 1) * (2 * D_FF)) : zero, gp = t + 1 < ri.T ? *(const u32x4*)(ub + (size_t)(t + 1) * (2 * D_FF) + D_FF) : zero;
            float y[8];
#pragma unroll
            for (int e = 0; e < 4; ++e) {
                const float a0 = ba[2 * e] + wa[0][2 * e] * bflo(am[e]) + wa[1][2 * e] * bflo(ac[e]) + wa[2][2 * e] * bflo(ap[e]);
                const float a1 = ba[2 * e + 1] + wa[0][2 * e + 1] * bfhi(am[e]) + wa[1][2 * e + 1] * bfhi(ac[e]) + wa[2][2 * e + 1] * bfhi(ap[e]);
                const float g0 = bg[2 * e] + wg[0][2 * e] * bflo(gm[e]) + wg[1][2 * e] * bflo(gc[e]) + wg[2][2 * e] * bflo(gp[e]);
                const float g1 = bg[2 * e + 1] + wg[0][2 * e + 1] * bfhi(gm[e]) + wg[1][2 * e + 1] * bfhi(gc[e]) + wg[2][2 * e + 1] * bfhi(gp[e]);
                y[2 * e] = a0 * (g0 / (1.0f + __expf(-g0))); y[2 * e + 1] = a1 * (g1 / (1.0f + __expf(-g1))); }
            *(u32x4*)(ACT + (size_t)(r0 + i) * D_FF + j0) = (u32x4){pk2(y[0], y[1]), pk2(y[2], y[3]), pk2(y[4], y[5]), pk2(y[6], y[7])};
            am = ac; ac = ap; gm = gc; gc = gp; }
    }
}
__device__ __forceinline__ void act_fix_phase(const bf16_t* HALO, const float* cw, const float* cb, bf16_t* ACT, int nrows, int gtid, int gthreads) {
    constexpr int NC8 = D_FF / 8; const int nblk = nrows / 64;
    for (long it = gtid; it < (long)nblk * 2 * NC8; it += gthreads) { const int j0 = (int)(it % NC8) * 8, be = (int)(it / NC8), blk = be >> 1, edge = be & 1; const int row = blk * 64 + (edge ? 63 : 0);
        const RowInfo ri = row_info(row);
        const bf16_t* hb = HALO + (size_t)blk * 4 * (2 * D_FF) + j0;
        const bool has_prev = ri.t > 0, has_next = ri.t + 1 < ri.T; const u32x4 zero = {0u, 0u, 0u, 0u};
        const bf16_t* pc = hb + (size_t)(edge ? 3 : 0) * (2 * D_FF);
        const bf16_t* pp_ = edge ? hb + (size_t)2 * (2 * D_FF) : hb - (size_t)4 * (2 * D_FF) + (size_t)3 * (2 * D_FF);
        const bf16_t* pn = edge ? hb + (size_t)4 * (2 * D_FF) : hb + (size_t)1 * (2 * D_FF);
        const u32x4 ac = *(const u32x4*)pc, gc = *(const u32x4*)(pc + D_FF);
        const u32x4 am = has_prev ? *(const u32x4*)pp_ : zero, gm = has_prev ? *(const u32x4*)(pp_ + D_FF) : zero;
        const u32x4 ap = has_next ? *(const u32x4*)pn : zero, gp = has_next ? *(const u32x4*)(pn + D_FF) : zero;
        float y[8];
#pragma unroll
        for (int e = 0; e < 4; ++e) {
#pragma unroll
            for (int hh = 0; hh < 2; ++hh) { const int c = j0 + 2 * e + hh;
                const float xam = hh ? bfhi(am[e]) : bflo(am[e]), xac = hh ? bfhi(ac[e]) : bflo(ac[e]), xap = hh ? bfhi(ap[e]) : bflo(ap[e]);
                const float xgm = hh ? bfhi(gm[e]) : bflo(gm[e]), xgc = hh ? bfhi(gc[e]) : bflo(gc[e]), xgp = hh ? bfhi(gp[e]) : bflo(gp[e]);
                const float a = cb[c] + cw[c] * xam + cw[2 * D_FF + c] * xac + cw[4 * D_FF + c] * xap;
                const float g = cb[D_FF + c] + cw[D_FF + c] * xgm + cw[2 * D_FF + D_FF + c] * xgc + cw[4 * D_FF + D_FF + c] * xgp;
                y[2 * e + hh] = a * (g * __builtin_amdgcn_rcpf(1.0f + __expf(-g))); } }
        *(u32x4*)(ACT + (size_t)row * D_FF + j0) = (u32x4){pk2(y[0], y[1]), pk2(y[2], y[3]), pk2(y[4], y[5]), pk2(y[6], y[7])};
    }
}
__device__ __forceinline__ void transpose_item(const float* W, int K, int N, int Npad, bf16_t* WT, float* scr  , int item, int lane, int pairF = 0) {
    const int nblk = Npad / 64, kb = item / nblk, nb = item % nblk, k0 = 64 * kb, n0 = 64 * nb; const int nq = lane & 15, kq = lane >> 4, n = n0 + 4 * nq; const bool ok = n < N;
    f32x4 v[16];
#pragma unroll
    for (int i = 0; i < 16; ++i) v[i] = ok ? *(const f32x4*)(W + (size_t)(k0 + 4 * i + kq) * N + n) : (f32x4){0.f, 0.f, 0.f, 0.f};
#pragma unroll
    for (int i = 0; i < 16; ++i)
#pragma unroll
        for (int e = 0; e < 4; ++e) scr[(4 * nq + e) * 65 + 4 * i + kq] = v[i][e];
    asm volatile("s_waitcnt lgkmcnt(0)" ::: "memory");
    const int c = lane & 7;
#pragma unroll
    for (int j = 0; j < 8; ++j) { const int nn = (lane >> 3) + 8 * j; const float* s = scr + nn * 65 + 8 * c;
        u32x4 o; o.x = pk2(s[0], s[1]); o.y = pk2(s[2], s[3]); o.z = pk2(s[4], s[5]); o.w = pk2(s[6], s[7]);
        const int nsrc = n0 + nn; const int nd = pairF == 0 ? nsrc : (nsrc < pairF ? (nsrc >> 7) * 256 + (nsrc & 127) : ((nsrc - pairF) >> 7) * 256 + 128 + ((nsrc - pairF) & 127));
        *(u32x4*)(WT + (size_t)nd * K + k0 + 8 * c) = o; }
    asm volatile("s_waitcnt lgkmcnt(0)" ::: "memory");
}
}

__device__ __forceinline__ gdn::Bufs gdn_bufs(const WS& w, int l) { gdn::Bufs B; B.UT = w.gUT; B.WP = w.gWP; B.KDT = w.gKDT; B.QD = w.gQD; B.QK = w.gQK; B.SIT = w.gSIT; B.VNT = w.gVNT; B.GT = w.gGT + (size_t)l * gdn::NTASK; return B; }
__device__ __forceinline__ lru::Bufs lru_bufs(const WS& w) { lru::Bufs B; B.HLOC = w.lHLOC; B.ACUM = w.lACUM; B.LSUM = w.lLSUM; B.HIN = w.lHIN; return B; }

#define LAS __attribute__((address_space(3)))
#define XB_TMO      128
#define XB_XCNT(j)  (256  + 64 * (j))
#define XB_XSUB(j)  (1280 + 64 * (j))
#define XB_XGEN(j)  (2304 + 64 * (j))
#define XB_TOP      3328
#define XB_TOPGEN   3392
#define XCD_BAR_WORDS 3456
#define XB_SPIN_CAP (1u << 18)
__device__ __forceinline__ unsigned xb_ld(unsigned* p)              { return __hip_atomic_load(p, __ATOMIC_RELAXED, __HIP_MEMORY_SCOPE_AGENT); }
__device__ __forceinline__ unsigned xb_add(unsigned* p, unsigned v) { return __hip_atomic_fetch_add(p, v, __ATOMIC_RELAXED, __HIP_MEMORY_SCOPE_AGENT); }
__device__ __forceinline__ unsigned xb_xcc_id() { return (unsigned)__builtin_amdgcn_s_getreg((3 << 11) | 20) & 0xFu; }
#define XB_SPIN(cond, bar) do { unsigned _sp = 0; while (cond) { __builtin_amdgcn_s_sleep(1); \
    if ((++_sp & 255u) == 0u) { if (xb_ld(&(bar)[XB_TMO])) break; if (_sp > XB_SPIN_CAP) { atomicAdd(&(bar)[XB_TMO], 1u); break; } } } } while (0)
struct XcdBarrier { unsigned* bar; unsigned x; volatile LAS unsigned* st; };
__device__ __forceinline__ XcdBarrier xcd_barrier_post(unsigned* bar, volatile LAS unsigned* st, const bool leader) {
    XcdBarrier b; b.bar = bar; b.x = xb_xcc_id(); b.st = st;
    if (leader) (void)xb_add(&bar[XB_XCNT(b.x)], 1u);
    return b;
}
__device__ __forceinline__ void xcd_barrier_complete(unsigned* bar, unsigned x, unsigned& nloc, unsigned& nx) {
    const unsigned G = gridDim.x * gridDim.y * gridDim.z;
    unsigned sum, cnt, mine, sp = 0u;
    for (;;) {
        sum = 0u; cnt = 0u; mine = 0u;
#pragma unroll
        for (unsigned j = 0; j < 16; ++j) { const unsigned c = xb_ld(&bar[XB_XCNT(j)]); sum += c; cnt += (c > 0u) ? 1u : 0u; mine = (j == x) ? c : mine; }
        if (sum == G) break;
        __builtin_amdgcn_s_sleep(1);
        if ((++sp & 255u) == 0u) { if (xb_ld(&bar[XB_TMO])) break; if (sp > XB_SPIN_CAP) { atomicAdd(&bar[XB_TMO], 1u); break; } }
    }
    nloc = mine > 0u ? mine : 1u; nx = cnt > 0u ? cnt : 1u;
}
__device__ __forceinline__ void xcd_barrier(const XcdBarrier& b, const bool leader) {
    asm volatile("s_waitcnt vmcnt(0)" ::: "memory");
    __syncthreads();
    if (leader) {
        unsigned* bar = b.bar;
        __builtin_amdgcn_s_waitcnt(0);
        unsigned nloc = b.st[0], nx = b.st[1];
        if (nloc == 0u) { xcd_barrier_complete(bar, b.x, nloc, nx); b.st[0] = nloc; b.st[1] = nx; }
        const unsigned old = xb_add(&bar[XB_XSUB(b.x)], 1u);
        const unsigned gen = old / nloc;
        if (old + 1u == (gen + 1u) * nloc) {
            __builtin_amdgcn_fence(__ATOMIC_RELEASE, "agent");
            asm volatile("s_waitcnt vmcnt(0)" ::: "memory");
            const unsigned og = xb_add(&bar[XB_TOP], 1u);
            const unsigned tg = og / nx;
            if (og + 1u == (tg + 1u) * nx) xb_add(&bar[XB_TOPGEN], 1u);
            else XB_SPIN(xb_ld(&bar[XB_TOPGEN]) == tg, bar);
            __builtin_amdgcn_fence(__ATOMIC_ACQUIRE, "agent");
            xb_add(&bar[XB_XGEN(b.x)], 1u);
            asm volatile("s_waitcnt vmcnt(0)" ::: "memory");
        } else {
            XB_SPIN(xb_ld(&bar[XB_XGEN(b.x)]) == gen, bar);
            __builtin_amdgcn_fence(__ATOMIC_ACQUIRE, "agent");
            asm volatile("s_waitcnt vmcnt(0)" ::: "memory");
        }
    }
    __syncthreads();
}

constexpr int NWAVES = 8, NTHR = 512;
constexpr int LDS_MISC = 147456, LDS_BYTES = 148480;
static_assert(sizeof(Inputs) == 34 * 8, "Inputs mirrors Params::in");
static_assert(gdn::G1_LDS <= LDS_MISC && pg8::STAGE_BYTES <= LDS_MISC && att::Cfg<MLA_QK>::LDS_BYTES <= LDS_MISC && gdn::G2_LDS <= LDS_MISC, "LDS map");
constexpr int CW_BAR = 4096;
constexpr int G2_CUT1 = 52, G2_CUT2 = 52;
constexpr int SK_OUT = 4, SK_DOWN = 5;
constexpr int PH_PRO = 0, PH_PER_LAYER = 12, NPH = 1 + PH_PER_LAYER * DEPTH;
struct Params { const float* in[34]; float* out; unsigned char* ws; int ph_lo, ph_hi, li, pad; };

struct SplitOrder {
    int nN, nM, S, G, c;
    __device__ __forceinline__ void init(int M, int N, int S_, int G_, int c_) { nM = M / pg8::BM; nN = N / pg8::BM; S = S_; G = G_; c = c_; }
    __device__ __forceinline__ bool next(int i, pg8::Unit& u) const { const int g = c + i * G; if (g >= nM * nN * S) return false; u.ks = g / (nM * nN); const int loc = g % (nM * nN); u.pm = loc / nN; u.pn = loc % nN; return true; }
    __device__ __forceinline__ void a_ready(const pg8::Unit&) const {}
    __device__ __forceinline__ void done(const pg8::Unit&) const {}
};
struct SpanOrder {
    int nN, lo, hi, G, g0;
    __device__ __forceinline__ void init(int N, int lo_, int hi_, int G_, int c) { nN = N / pg8::BM; lo = lo_; hi = hi_; G = G_; int i0 = 0; if (c < lo_) i0 = (lo_ - c + G_ - 1) / G_; g0 = c + i0 * G_; }
    __device__ __forceinline__ bool next(int i, pg8::Unit& u) const { const int g = g0 + i * G; if (g >= hi) return false; const int loc = g - lo; u.pm = loc / nN; u.pn = loc % nN; u.ks = 0; return true; }
    __device__ __forceinline__ void a_ready(const pg8::Unit&) const {}
    __device__ __forceinline__ void done(const pg8::Unit&) const {}
};

#define AS4 __attribute__((address_space(4)))
#define PHASE_WS const AS4 Params* pp = (const AS4 Params*)__builtin_amdgcn_kernarg_segment_ptr(); asm volatile("" : "+s"(pp)); const AS4 Inputs* I = (const AS4 Inputs*)pp; (void)I; unsigned char* wsb_ = pp->ws; const WS w = ws_carve(wsb_)
#define PHASE_IDS int tid = C_wave0 * 64 + (int)__builtin_amdgcn_mbcnt_hi(~0u, __builtin_amdgcn_mbcnt_lo(~0u, 0u)); asm volatile("" : "+v"(tid)); const int lane = tid & 63, wave = __builtin_amdgcn_readfirstlane(tid >> 6), gwave = wg * NWAVES + wave, gtid = wg * NTHR + tid; (void)lane; (void)gwave; (void)gtid
#ifndef DBG_MASK
#define DBG_MASK 0xFFFFFF
#endif
#define IN(k) (lo <= (k) && (k) < hi)
#define ON(j) (((DBG_MASK) >> (j)) & 1)
#define SEAM(k) do { if (IN(k) && IN((k) + 1)) xcd_barrier(bar, C_wave0 == 0 && __builtin_amdgcn_mbcnt_hi(~0u, __builtin_amdgcn_mbcnt_lo(~0u, 0u)) == 0u); } while (0)

constexpr int I_IN = (D_MODEL / 64) * (NP / 64), I_OUT = (D_MODEL / 64) * (D_MODEL / 64), I_UP = (D_MODEL / 64) * (2 * D_FF / 64), I_DN = (D_FF / 64) * (D_MODEL / 64),
              I_UQ = (MLA_Q_LORA / 64) * (NQ_MLA / 64), I_UKV = (MLA_KV_LORA / 64) * (NKV_MLA / 64), I_LB = (LRU_BW / 64) * (LRU_BW / 64), I_LRU = 2 * 2 * NH * I_LB;
constexpr int I_PA = I_IN + I_OUT + I_UQ + I_UKV + I_LRU, I_PB = I_UP + I_DN;
constexpr int PREP_SCR = 16640;
__device__ __forceinline__ void prep_item_a(const AS4 Inputs* I, const WS& w, int l, int r, float* scr, int lane) {
    if (r < I_IN) { misc::transpose_item(I->w_in + (size_t)l * D_MODEL * IN_COLS, D_MODEL, IN_COLS, NP, w.WIN + l * SZ_WIN, scr, r, lane); return; } r -= I_IN;
    if (r < I_OUT) { misc::transpose_item(I->w_out + (size_t)l * D_MODEL * D_MODEL, D_MODEL, D_MODEL, D_MODEL, w.WOUT + l * SZ_WOUT, scr, r, lane); return; } r -= I_OUT;
    if (r < I_UQ) { misc::transpose_item(I->mla_w_uq + (size_t)l * MLA_Q_LORA * NQ_MLA, MLA_Q_LORA, NQ_MLA, NQ_MLA, w.WUQ + l * SZ_WUQ, scr, r, lane); return; } r -= I_UQ;
    if (r < I_UKV) { misc::transpose_item(I->mla_w_ukv + (size_t)l * MLA_KV_LORA * NKV_MLA, MLA_KV_LORA, NKV_MLA, NKV_MLA, w.WUKV + l * SZ_WUKV, scr, r, lane); return; } r -= I_UKV;
    { const int blk = r / I_LB, item = r % I_LB, d = blk / (2 * NH), wh = (blk / NH) & 1, nb = blk % NH;
      const float* src = (wh == 0 ? I->lru_wa : I->lru_wx) + ((size_t)(l * 2 + d) * NH + nb) * lru::SZ_WBLK;
      misc::transpose_item(src, LRU_BW, LRU_BW, LRU_BW, w.WLRU + ((size_t)l * 16 + blk) * lru::SZ_WBLK, scr, item, lane); }
}
__device__ __forceinline__ void prep_item_b(const AS4 Inputs* I, const WS& w, int l, int r, float* scr, int lane) {
    if (r < I_UP) { misc::transpose_item(I->ffn_w_up + (size_t)l * D_MODEL * 2 * D_FF, D_MODEL, 2 * D_FF, 2 * D_FF, w.WUP + l * SZ_WUP, scr, r, lane, D_FF); return; } r -= I_UP;
    misc::transpose_item(I->ffn_w_down + (size_t)l * D_FF * D_MODEL, D_FF, D_MODEL, D_MODEL, w.WDOWN + l * SZ_WDOWN, scr, r, lane);
}
constexpr int NMT = NMODV / 128;
__device__ __forceinline__ void mod_fill(const AS4 Inputs* I, char* lds, int tid) {
    float* SCs = (float*)lds;
    for (int i = tid; i < (BATCH + 1) * D_MODEL; i += 512) { const int s = i / D_MODEL, k = i % D_MODEL; const float v = s < BATCH ? I->c[s * D_MODEL + k] : I->c_ctx[k]; SCs[i] = v / (1.0f + __expf(-v)); }
    __syncthreads();
}
__device__ __forceinline__ void mod_task(const AS4 Inputs* I, const WS& w, int l, int t, char* lds, int tid, int wave, int lane) {
    const float* SCs = (const float*)lds; float* red = (float*)(lds + 3 * D_MODEL * 4);
    const int j0 = t * 128, h = lane >> 5, cl = lane & 31;
    misc::f32x4 acc[3] = {{0.f, 0.f, 0.f, 0.f}, {0.f, 0.f, 0.f, 0.f}, {0.f, 0.f, 0.f, 0.f}};
    const float* wp = I->ada_w + (size_t)l * D_MODEL * NMODV + (size_t)(256 * wave + h) * NMODV + j0 + 4 * cl;
#pragma unroll 8
    for (int k = 0; k < 128; ++k) { const misc::f32x4 wv = *(const misc::f32x4*)(wp + (size_t)(2 * k) * NMODV); const int kk = 256 * wave + 2 * k + h;
        acc[0] += wv * SCs[kk]; acc[1] += wv * SCs[D_MODEL + kk]; acc[2] += wv * SCs[2 * D_MODEL + kk]; }
#pragma unroll
    for (int s = 0; s < 3; ++s)
#pragma unroll
        for (int e = 0; e < 4; ++e) acc[s][e] += lane_xor(acc[s][e], 32, lane);
    __syncthreads();
    if (h == 0) {
#pragma unroll
        for (int s = 0; s < 3; ++s) *(misc::f32x4*)(red + (wave * 3 + s) * 128 + 4 * cl) = acc[s]; }
    __syncthreads();
    for (int i = tid; i < 3 * 128; i += 512) { const int s = i / 128, c = i % 128; float sum = I->ada_b[(size_t)l * NMODV + j0 + c];
#pragma unroll
        for (int w8 = 0; w8 < 8; ++w8) sum += red[(w8 * 3 + s) * 128 + c];
        w.MOD[((size_t)l * (BATCH + 1) + s) * NMODV + j0 + c] = sum; }
}
#define PREP_IDLE(nunits, nitems, CALL) do { const int r_ = (nunits) % G, first_ = r_, nid_ = G - r_; \
        if (wg >= first_) { float* scr = (float*)(lds + wave * PREP_SCR); for (int it = (wg - first_) * NWAVES + wave; it < (nitems); it += nid_ * NWAVES) { CALL; } } } while (0)

struct LayerCtx { int lo, hi, G, wg, nwaves, gthreads, wave0; XcdBarrier bar; char* lds; unsigned char* lds_raw; };
template <int l> __device__ __forceinline__ void layer_body(const LayerCtx& C) {
    const int lo = C.lo, hi = C.hi, G = C.G, wg = C.wg, nwaves = C.nwaves, gthreads = C.gthreads, C_wave0 = C.wave0; const XcdBarrier& bar = C.bar; char* lds = C.lds; unsigned char* lds_raw = C.lds_raw;
    (void)G; (void)nwaves; (void)gthreads;
        const int pb = 1 + PH_PER_LAYER * l;
        const bool want_ctx = l < DEPTH - 1; const int Mo = want_ctx ? M_ALL : M_LAT;
        if (ON(0) && IN(pb + 0)) { PHASE_WS; PHASE_IDS; const float* MODl = w.MOD + (size_t)l * (BATCH + 1) * NMODV; (void)MODl; misc::norm_phase(w.H, I->norm_mix_g + (size_t)l * D_MODEL, MODl, 0, w.U, M_ALL, gwave, nwaves, lane, l > 0 ? w.PART : nullptr, SK_DOWN, MODl - (size_t)(BATCH + 1) * NMODV + (size_t)BATCH * NMODV + 5 * D_MODEL, l == 0 ? I->x : nullptr, l == 0 ? I->ctx : nullptr); }
        SEAM(pb + 0);
        if (ON(1) && IN(pb + 1)) { PHASE_WS; PHASE_IDS; const float* MODl = w.MOD + (size_t)l * (BATCH + 1) * NMODV; (void)MODl; pg8::Gemm g{w.U, w.WIN + l * SZ_WIN, M_ALL, NP, D_MODEL, D_MODEL}; pg8::StaticOrder S; S.init(M_ALL, NP, G, wg);
            pg8::EpiBf16<0> E{w.P, NP, nullptr, 0, 0, 1.0f};
            pg8::gemm_phase<pg8::EpiBf16<0>, pg8::StaticOrder, true, true>((PG8_LAS unsigned char*)lds_raw, g, S, E, tid);
            if constexpr (l < DEPTH - 1) PREP_IDLE((M_ALL / 256) * (NP / 256), I_PA, prep_item_a(I, w, l + 1, it, scr, lane)); }
        SEAM(pb + 1);
        if (ON(2) && IN(pb + 2)) { PHASE_WS; PHASE_IDS; const float* MODl = w.MOD + (size_t)l * (BATCH + 1) * NMODV; (void)MODl;
            const int pflags = pp->pad;
            if (!(pflags & 16)) { gdn::G1Args A; A.P = w.P; A.conv_w = I->gdn_conv_w + (size_t)l * 4 * 3 * GROUP_W; A.a_log = I->gdn_a_log + (size_t)l * 2 * NH; A.dt_bias = I->gdn_dt_bias + (size_t)l * 2 * NH; A.B = gdn_bufs(w, l); A.pflags = pflags;
              gdn::g1_phase(A, lds, G, wg, tid); }
            if (!(pflags & 32)) { lru::LocalArgs A; A.P = w.P; A.conv_w = I->lru_conv_w + (size_t)l * 4 * LRU_W; A.conv_b = I->lru_conv_b + (size_t)l * LRU_W; A.WG = w.WLRU + (size_t)l * 16 * lru::SZ_WBLK;
              A.ba = I->lru_ba + (size_t)l * 2 * LRU_W; A.bx = I->lru_bx + (size_t)l * 2 * LRU_W; A.lam = I->lru_lam + (size_t)l * 2 * LRU_W; A.B = lru_bufs(w);
              lru::local_phase(A, lds, G, wg, tid); }
            if (!(pflags & 64)) { misc::RowNormArgs A; A.P = w.P; A.qa_g = I->mla_qa_g + (size_t)l * MLA_Q_LORA; A.kva_g = I->mla_kva_g + (size_t)l * MLA_KV_LORA; A.na_qn_g = I->na_qn_g + (size_t)l * HD; A.na_kn_g = I->na_kn_g + (size_t)l * HD;
              A.CQN = w.CQN; A.CKVN = w.CKVN; A.NQ = w.NQ; A.NK = w.NK; misc::rownorm_phase(A, gwave, nwaves, lane); }
        }
        SEAM(pb + 2);
        if (ON(3) && IN(pb + 3)) { PHASE_WS; PHASE_IDS; const float* MODl = w.MOD + (size_t)l * (BATCH + 1) * NMODV; (void)MODl;
            if (wg < gdn::G2_WGS) gdn::g2_chain(gdn_bufs(w, l), lds, wg, tid, 0, G2_CUT1, w.gSS);
            else {
            constexpr int UQ = (M_ALL / 256) * (NQ_MLA / 256), UKV = (M_ALL / 256) * (NKV_MLA / 256); const int G2n = G - gdn::G2_WGS, c2 = wg - gdn::G2_WGS;
            { pg8::Gemm g{w.CQN, w.WUQ + l * SZ_WUQ, M_ALL, NQ_MLA, MLA_Q_LORA, MLA_Q_LORA}; SpanOrder S; S.init(NQ_MLA, 0, UQ, G2n, c2); pg8::EpiBf16<0> E{w.QR, NQ_MLA, nullptr, 0, 0, 1.0f};
              pg8::gemm_phase<pg8::EpiBf16<0>, SpanOrder, true, true>((PG8_LAS unsigned char*)lds_raw, g, S, E, tid); }
            { pg8::Gemm g{w.CKVN, w.WUKV + l * SZ_WUKV, M_ALL, NKV_MLA, MLA_KV_LORA, MLA_KV_LORA}; SpanOrder S; S.init(NKV_MLA, UQ, UQ + UKV, G2n, c2); pg8::EpiBf16<0> E{w.KVR, NKV_MLA, nullptr, 0, 0, 1.0f};
              pg8::gemm_phase<pg8::EpiBf16<0>, SpanOrder, true, true>((PG8_LAS unsigned char*)lds_raw, g, S, E, tid); }
            }
        }
        SEAM(pb + 3);
        if (ON(4) && IN(pb + 4)) { PHASE_WS; PHASE_IDS; const float* MODl = w.MOD + (size_t)l * (BATCH + 1) * NMODV; (void)MODl;
            { misc::MlaQkvArgs A; A.QR = w.QR; A.KVR = w.KVR; A.P = w.P; A.qn_g = I->mla_qn_g + (size_t)l * MLA_QK; A.kn_g = I->mla_kn_g + (size_t)l * MLA_QK; A.QM = w.QM; A.KM = w.KM; A.VM = w.VM;
              misc::mlaqkv_phase(A, gwave, nwaves, lane); }
            lru::carry_phase(lru_bufs(w), gtid, gthreads);
        }
        SEAM(pb + 4);
        if (ON(5) && IN(pb + 5)) { PHASE_WS; PHASE_IDS; const float* MODl = w.MOD + (size_t)l * (BATCH + 1) * NMODV; (void)MODl;
            const int pflags = pp->pad;
            if (wg < gdn::G2_WGS && !(pflags & 1)) gdn::g2_chain(gdn_bufs(w, l), lds, wg, tid, G2_CUT2, gdn::G2_NSTEP, w.gSS);
            AttnArgs A; A.QM = w.QM; A.KM = w.KM; A.VM = w.VM; A.NQ = w.NQ; A.NK = w.NK; A.P = w.P; A.Y = w.Y; A.rpb = I->na_rpb + (size_t)l * NH * (2 * NA_KH - 1) * (2 * NA_KW - 1); A.want_ctx = want_ctx ? 1 : 0; A.pad = pflags;
            attention_phase(A, lds, G, wg, tid, gdn::G2_WGS);
        }
        SEAM(pb + 5);
        if (ON(6) && IN(pb + 6)) { PHASE_WS; PHASE_IDS; const float* MODl = w.MOD + (size_t)l * (BATCH + 1) * NMODV; (void)MODl;
            const int pflags = pp->pad;
            if (!(pflags & 128)) { gdn::G3Args A; A.B = gdn_bufs(w, l); A.P = w.P; A.norm_g = I->gdn_norm_g + (size_t)l * HD; A.Y = w.Y; gdn::g3_phase(A, lds, G, wg, tid); }
            if (!(pflags & 256)) lru::finish_phase(lru_bufs(w), w.P, w.Y, gtid, gthreads);
        }
        SEAM(pb + 6);
        if (ON(7) && IN(pb + 7)) { PHASE_WS; PHASE_IDS; const float* MODl = w.MOD + (size_t)l * (BATCH + 1) * NMODV; (void)MODl;
            { pg8::Gemm g{w.Y, w.WOUT + l * SZ_WOUT, M_LAT, D_MODEL, D_MODEL, D_MODEL}; pg8::StaticOrder S; S.init(M_LAT, D_MODEL, G, wg);
              pg8::EpiGateRes E{l == 0 ? I->x : w.H, w.H, D_MODEL, MODl + 2 * D_MODEL, NMODV, SEQ, BATCH, M_LAT};
              pg8::gemm_phase<pg8::EpiGateRes, pg8::StaticOrder, true, true>((PG8_LAS unsigned char*)lds_raw, g, S, E, tid); }
            if (want_ctx) { constexpr int SK = SK_OUT;
              pg8::Gemm g{w.Y + (size_t)M_LAT * D_MODEL, w.WOUT + l * SZ_WOUT, M_CTX, D_MODEL, D_MODEL / SK, D_MODEL}; SplitOrder S; S.init(M_CTX, D_MODEL, SK, G, (wg + G / 2) % G);
              pg8::EpiPart E{w.PART, D_MODEL, (size_t)M_CTX * D_MODEL};
              pg8::gemm_phase<pg8::EpiPart, SplitOrder, true, true>((PG8_LAS unsigned char*)lds_raw, g, S, E, tid); } }
        SEAM(pb + 7);
        if (ON(8) && IN(pb + 8)) { PHASE_WS; PHASE_IDS; const float* MODl = w.MOD + (size_t)l * (BATCH + 1) * NMODV; (void)MODl; misc::norm_phase(w.H, I->norm_ffn_g + (size_t)l * D_MODEL, MODl, 3, w.U, Mo, gwave, nwaves, lane, want_ctx ? w.PART : nullptr, SK_OUT, MODl + (size_t)BATCH * NMODV + 2 * D_MODEL, nullptr, nullptr); }
        SEAM(pb + 8);
        if (ON(9) && IN(pb + 9)) { PHASE_WS; PHASE_IDS; const float* MODl = w.MOD + (size_t)l * (BATCH + 1) * NMODV; (void)MODl; pg8::Gemm g{w.U, w.WUP + l * SZ_WUP, Mo, 2 * D_FF, D_MODEL, D_MODEL}; pg8::StaticOrder S; S.init(Mo, 2 * D_FF, G, wg);
            pg8::EpiConvAct E{w.ACT, w.HALO, I->ffn_conv_w + (size_t)l * 3 * 2 * D_FF, I->ffn_conv_b + (size_t)l * 2 * D_FF, D_FF};
            pg8::gemm_phase<pg8::EpiConvAct, pg8::StaticOrder, false, true>((PG8_LAS unsigned char*)lds_raw, g, S, E, tid);
            if constexpr (l < DEPTH - 1) PREP_IDLE((M_ALL / 256) * (2 * D_FF / 256), I_PB, prep_item_b(I, w, l + 1, it, scr, lane)); }
        SEAM(pb + 9);
        if (ON(10) && IN(pb + 10)) { PHASE_WS; PHASE_IDS; const float* MODl = w.MOD + (size_t)l * (BATCH + 1) * NMODV; (void)MODl; misc::act_fix_phase(w.HALO, I->ffn_conv_w + (size_t)l * 3 * 2 * D_FF, I->ffn_conv_b + (size_t)l * 2 * D_FF, w.ACT, Mo, gtid, gthreads); }
        SEAM(pb + 10);
        if (ON(11) && IN(pb + 11)) { PHASE_WS; PHASE_IDS; const float* MODl = w.MOD + (size_t)l * (BATCH + 1) * NMODV; (void)MODl;
            { pg8::Gemm g{w.ACT, w.WDOWN + l * SZ_WDOWN, M_LAT, D_MODEL, D_FF, D_FF}; pg8::StaticOrder S; S.init(M_LAT, D_MODEL, G, wg);
              pg8::EpiGateRes E{w.H, want_ctx ? w.H : pp->out, D_MODEL, MODl + 5 * D_MODEL, NMODV, SEQ, BATCH, M_LAT};
              pg8::gemm_phase<pg8::EpiGateRes, pg8::StaticOrder, true, true>((PG8_LAS unsigned char*)lds_raw, g, S, E, tid); }
            if (want_ctx) { constexpr int SK = SK_DOWN;
              pg8::Gemm g{w.ACT + (size_t)M_LAT * D_FF, w.WDOWN + l * SZ_WDOWN, M_CTX, D_MODEL, D_FF / SK, D_FF}; SplitOrder S; S.init(M_CTX, D_MODEL, SK, G, (wg + G / 2) % G);
              pg8::EpiPart E{w.PART, D_MODEL, (size_t)M_CTX * D_MODEL};
              pg8::gemm_phase<pg8::EpiPart, SplitOrder, true, true>((PG8_LAS unsigned char*)lds_raw, g, S, E, tid); }
            if constexpr (l < DEPTH - 1) {
              constexpr int NCI = (M_CTX / 256) * (D_MODEL / 256) * SK_DOWN; const int first = NCI < G ? NCI : 0, rank = (wg + G / 2) % G;
              if (rank >= first && rank - first < NMT) { mod_fill(I, lds, tid); for (int t = rank - first; t < NMT; t += G - first) mod_task(I, w, l + 1, t, lds, tid, wave, lane); } } }
        SEAM(pb + 11);

}
__global__ void __launch_bounds__(NTHR, 2) fwd(Params p) {
    extern __shared__ __attribute__((aligned(16))) unsigned char lds_raw[];
    char* lds = (char*)lds_raw;
    const int G = (int)gridDim.x, wg = (int)blockIdx.x, nwaves = G * NWAVES, gthreads = G * NTHR;
    const int C_wave0 = __builtin_amdgcn_readfirstlane((int)threadIdx.x >> 6);
    volatile LAS unsigned* MISC = (volatile LAS unsigned*)(lds_raw + LDS_MISC);
    if (threadIdx.x < 32) MISC[threadIdx.x] = 0u;
    __syncthreads();
    const int lo = p.ph_lo, hi = p.ph_hi;
    unsigned* const barw = (unsigned*)p.ws + CW_BAR + (size_t)p.li * XCD_BAR_WORDS;
    XcdBarrier bar; bar.bar = barw; bar.x = 0; bar.st = MISC + 8;
    if (hi - lo > 1) bar = xcd_barrier_post(barw, MISC + 8, threadIdx.x == 0);

    if (ON(12) && IN(PH_PRO)) { PHASE_WS; PHASE_IDS;
        const bool split = G > NMT;
        if (wg < NMT) { mod_fill(I, lds, tid); for (int t = wg; t < NMT; t += G) mod_task(I, w, 0, t, lds, tid, wave, lane); __syncthreads(); }
        {
            float* scr = (float*)(lds + wave * PREP_SCR);
            constexpr int T = I_PA + I_PB;
            const int nmw = NMT * NWAVES;
            int it0, itn, its;
            if (!split) { it0 = gwave; itn = T; its = nwaves; } else if (wg < NMT) { it0 = gwave; itn = 2 * nmw; its = nmw; } else { it0 = 2 * nmw + (gwave - nmw); itn = T; its = nwaves - nmw; }
            for (int it = it0; it < itn; it += its) { if (it < I_PA) prep_item_a(I, w, 0, it, scr, lane); else prep_item_b(I, w, 0, it - I_PA, scr, lane); }
        }
    }
    SEAM(PH_PRO);

    { LayerCtx C; C.lo = lo; C.hi = hi; C.G = G; C.wg = wg; C.nwaves = nwaves; C.gthreads = gthreads; C.wave0 = C_wave0; C.bar = bar; C.lds = lds; C.lds_raw = lds_raw;
      static_assert(DEPTH == 4, "layer calls are written out (a real layer loop lets LICM park loop-invariant values in registers across every phase: spills)");
      layer_body<0>(C); layer_body<1>(C); layer_body<2>(C); layer_body<3>(C); }
#undef IN
#undef SEAM
}

#ifndef MK_PHASES_PER_LAUNCH
#define MK_PHASES_PER_LAUNCH NPH
#endif
extern "C" void kernel_launch(void* const* d_in, const int* in_sizes, int n_in, void* d_out, int out_size, void* d_ws, size_t ws_size, hipStream_t stream) {
    static int grid = 0;
    if (grid == 0) {
        int dev = 0, cus = 0;
        if (hipGetDevice(&dev) != hipSuccess || hipDeviceGetAttribute(&cus, hipDeviceAttributeMultiprocessorCount, dev) != hipSuccess || cus <= 0) { fprintf(stderr, "kernel_launch: no device\n"); grid = -1; return; }
        if (hipFuncSetAttribute((const void*)fwd, hipFuncAttributeMaxDynamicSharedMemorySize, LDS_BYTES) != hipSuccess) { fprintf(stderr, "kernel_launch: hipFuncSetAttribute failed\n"); grid = -1; return; }
        int per_cu = 0; if (hipOccupancyMaxActiveBlocksPerMultiprocessor(&per_cu, (const void*)fwd, NTHR, LDS_BYTES) != hipSuccess || per_cu < 1) fprintf(stderr, "kernel_launch: occupancy query says %d blocks per CU\n", per_cu);
        (void)hipGetLastError();
        grid = cus;
        const WS w0 = ws_carve(nullptr);
        if (n_in != 34 || w0.total > ws_size) { fprintf(stderr, "kernel_launch: bad inputs / workspace (need %zu, have %zu)\n", w0.total, ws_size); grid = -1; return; }
    }
    if (grid < 0) return;
    (void)hipMemsetAsync(d_ws, 0, 1 << 20, stream);
    Params p; memset(&p, 0, sizeof(p));
    for (int i = 0; i < 34; ++i) p.in[i] = (const float*)d_in[i];
    p.out = (float*)d_out; p.ws = (unsigned char*)d_ws;
    int li = 0;
    for (int lo = 0; lo < NPH; lo += MK_PHASES_PER_LAUNCH, ++li) {
        p.ph_lo = lo; p.ph_hi = lo + MK_PHASES_PER_LAUNCH < NPH ? lo + MK_PHASES_PER_LAUNCH : NPH; p.li = li;
#if defined(PROBE_MASK)
        if (MK_PHASES_PER_LAUNCH == 1 && ((((PROBE_MASK) >> 12) & 1 && lo == 0) || (lo > 0 && (((PROBE_MASK) >> ((lo - 1) % PH_PER_LAYER)) & 1))))
            { Params q = p;
#if defined(PROBE_FLAGS)
              q.pad = PROBE_FLAGS;
#endif
              for (int r = 0; r < PROBE_REPS; ++r) hipLaunchKernelGGL(fwd, dim3(grid), dim3(NTHR), LDS_BYTES, stream, q); }
#endif
        hipLaunchKernelGGL(fwd, dim3(grid), dim3(NTHR), LDS_BYTES, stream, p);
    }
}
```
